# Optimizing an MI355X kernel written in HIP

```python
import math
import jax
import jax.numpy as jnp
from jax import lax
import numpy as np


D_MODEL = 1024
BATCH = 2
SEQ = 8192
DEPTH = 4

D_MIX = D_MODEL
GLA_HEADS = 4
GLA_DK = 32
GLA_DV = 64
GLA_W = GLA_HEADS * GLA_DV
GLA_LOWRANK = 16
GLA_GATE_NORM = 16.0
GLA_CHUNK = 32
S5_GROUPS = 16
S5_CH = 16
S5_W = S5_GROUPS * S5_CH
S5_STATE = 64
S5_DT_MIN = 1e-3
S5_DT_MAX = 1e-1
NSA_HEADS = 8
NSA_KV = 2
NSA_HPG = NSA_HEADS // NSA_KV
NSA_DH = 64
NSA_W = NSA_HEADS * NSA_DH
N_BRANCH = 3
CMP_LEN = 32
CMP_STRIDE = 16
CMP_HIDDEN = 256
SEL_BLOCK = 64
SEL_TOPK = 16
WINDOW = 512
Q_BLOCK = 128
RMS_EPS = 1e-6
NEG_INF = -1e30
FORCE_SCORE = 1e4

IN_SIZES = (GLA_HEADS * GLA_DK, GLA_HEADS * GLA_DK, GLA_W, GLA_LOWRANK, GLA_W,
            S5_W, S5_W,
            NSA_W, N_BRANCH * 2 * NSA_KV * NSA_DH, NSA_HEADS * N_BRANCH, NSA_W)
D_IN = sum(IN_SIZES)
IN_SPLITS = tuple(int(v) for v in np.cumsum(IN_SIZES)[:-1])

kernel_name = 'hybrid_gla_s5_nsa_parallel_heads'


def rmsnorm(x, g):
    xf = x.astype(jnp.float32)
    y = xf * lax.rsqrt(jnp.mean(xf * xf, axis=-1, keepdims=True) + RMS_EPS)
    return (y * g.astype(jnp.float32)).astype(x.dtype)


def masked_softmax(s, mask):
    s = jnp.where(mask, s.astype(jnp.float32), NEG_INF)
    return jax.nn.softmax(s, axis=-1) * mask


def gla_mixer(q, k, v, lr, gate, w2, b2, onorm_g):
    B, T, _ = q.shape
    H, C = GLA_HEADS, GLA_CHUNK
    N = T // C
    f32 = jnp.float32
    glog = jax.nn.log_sigmoid(jnp.matmul(lr, w2).astype(f32) + b2.astype(f32)) / GLA_GATE_NORM

    def heads(a, d):
        return a.astype(f32).reshape(B, N, C, H, d).transpose(0, 3, 1, 2, 4)

    qh = heads(q, GLA_DK) * (GLA_DK ** -0.5)
    kh = heads(k, GLA_DK)
    vh = heads(v, GLA_DV)
    bcum = jnp.cumsum(heads(glog, GLA_DK), axis=3)
    blast = bcum[:, :, :, -1:, :]
    causal = np.tril(np.ones((C, C), dtype=bool))[:, :, None]
    rel = bcum[:, :, :, :, None, :] - bcum[:, :, :, None, :, :]
    decay = jnp.exp(jnp.where(causal, rel, -jnp.inf))
    scores = jnp.einsum('bhnid,bhnjd,bhnijd->bhnij', qh, kh, decay)
    o_intra = jnp.einsum('bhnij,bhnjd->bhnid', scores, vh)
    chunk_kv = jnp.einsum('bhncd,bhnce->bhnde', kh * jnp.exp(blast - bcum), vh)
    chunk_decay = jnp.exp(blast[:, :, :, 0, :])

    def step(S, inp):
        dec, kv = inp
        return dec[..., None] * S + kv, S

    S0 = jnp.zeros((B, H, GLA_DK, GLA_DV), f32)
    _, S_prev = lax.scan(step, S0, (jnp.moveaxis(chunk_decay, 2, 0), jnp.moveaxis(chunk_kv, 2, 0)))
    S_prev = jnp.moveaxis(S_prev, 0, 2)
    o_inter = jnp.einsum('bhncd,bhnde->bhnce', qh * jnp.exp(bcum), S_prev)
    o = (o_intra + o_inter).transpose(0, 2, 3, 1, 4).reshape(B, T, H, GLA_DV)
    o = rmsnorm(o, onorm_g).reshape(B, T, GLA_W)
    return o * jax.nn.silu(gate.astype(f32))


def _complex_affine_combine(e1, e2):
    a1r, a1i, b1r, b1i = e1
    a2r, a2i, b2r, b2i = e2
    return (a1r * a2r - a1i * a2i,
            a1r * a2i + a1i * a2r,
            a2r * b1r - a2i * b1i + b2r,
            a2r * b1i + a2i * b1r + b2i)


def s5_mixer(u, gate, lam_re, lam_im, log_step, b_re, b_im, c_re, c_im, d_skip, glu_w, glu_b):
    B, T, _ = u.shape
    f32 = jnp.float32
    uf = u.astype(f32).reshape(B, T, S5_GROUPS, S5_CH)
    lr = jnp.minimum(lam_re.astype(f32), -1e-4)
    li = lam_im.astype(f32)
    dt = jnp.exp(log_step.astype(f32))[:, None]
    mag = jnp.exp(lr * dt)
    ar, ai = mag * jnp.cos(li * dt), mag * jnp.sin(li * dt)
    den = lr * lr + li * li
    fr = ((ar - 1.0) * lr + ai * li) / den
    fi = (ai * lr - (ar - 1.0) * li) / den
    br, bim = b_re.astype(f32), b_im.astype(f32)
    bbar_r = fr[..., None] * br - fi[..., None] * bim
    bbar_i = fr[..., None] * bim + fi[..., None] * br
    bu_r = jnp.einsum('btgc,gpc->btgp', uf, bbar_r)
    bu_i = jnp.einsum('btgc,gpc->btgp', uf, bbar_i)
    a_r = jnp.broadcast_to(ar, bu_r.shape)
    a_i = jnp.broadcast_to(ai, bu_r.shape)
    _, _, xr, xi = lax.associative_scan(_complex_affine_combine, (a_r, a_i, bu_r, bu_i), axis=1)
    y = (jnp.einsum('btgp,gcp->btgc', xr, c_re.astype(f32))
         - jnp.einsum('btgp,gcp->btgc', xi, c_im.astype(f32))
         + d_skip.astype(f32) * uf)
    y = jax.nn.gelu(y.reshape(B, T, S5_W))
    z = jnp.matmul(y, glu_w.astype(f32)) + glu_b.astype(f32)
    y = z[..., :S5_W] * jax.nn.sigmoid(z[..., S5_W:])
    return y * jax.nn.silu(gate.astype(f32))


def nsa_mixer(q, kv, gate_logit, gate, gate_b, qn_g, kn_g, cmp_pos, cmp_w1, cmp_b1, cmp_w2, cmp_b2):
    B, T, _ = q.shape
    G, Hg, dh = NSA_KV, NSA_HPG, NSA_DH
    f32 = jnp.float32
    qh = rmsnorm(q.reshape(B, T, G, Hg, dh), qn_g) * (dh ** -0.5)
    kv = kv.reshape(B, T, N_BRANCH, 2, G, dh)
    n_cmp = (T - CMP_LEN) // CMP_STRIDE + 1
    blk_idx = np.arange(n_cmp)[:, None] * CMP_STRIDE + np.arange(CMP_LEN)[None, :]
    cmp_start = blk_idx[:, 0]
    cmp_end = blk_idx[:, -1]

    def compress(a, j):
        blocks = a[:, blk_idx] + cmp_pos[j][:, None, :]
        blocks = blocks.transpose(0, 1, 3, 2, 4).reshape(B, n_cmp, G, CMP_LEN * dh)
        hid = jax.nn.gelu(jnp.matmul(blocks, cmp_w1[j]) + cmp_b1[j])
        return jnp.matmul(hid, cmp_w2[j]) + cmp_b2[j]

    k_cmp = rmsnorm(compress(kv[:, :, 0, 0], 0), kn_g[0])
    v_cmp = compress(kv[:, :, 0, 1], 1)
    n_sel = T // SEL_BLOCK
    top_k = min(SEL_TOPK, n_sel)
    sel_start = np.arange(n_sel) * SEL_BLOCK
    overlap = jnp.asarray(((cmp_start[:, None] < sel_start[None, :] + SEL_BLOCK)
                           & (cmp_end[:, None] >= sel_start[None, :])).astype(np.float32))

    def to_blocks(a):
        return a.reshape(B, n_sel, SEL_BLOCK, G, dh).transpose(0, 3, 1, 2, 4)

    k_sel_blk = to_blocks(rmsnorm(kv[:, :, 1, 0], kn_g[1]))
    v_sel_blk = to_blocks(kv[:, :, 1, 1])
    pad = ((0, 0), (WINDOW, 0), (0, 0), (0, 0))
    k_win = jnp.pad(rmsnorm(kv[:, :, 2, 0], kn_g[2]), pad)
    v_win = jnp.pad(kv[:, :, 2, 1], pad)
    gates = jax.nn.sigmoid(gate_logit.astype(f32) + gate_b.astype(f32)).reshape(B, T, G, Hg, N_BRANCH)
    n_qb = T // Q_BLOCK
    q_blocks = qh.reshape(B, n_qb, Q_BLOCK, G, Hg, dh).swapaxes(0, 1)
    g_blocks = gates.reshape(B, n_qb, Q_BLOCK, G, Hg, N_BRANCH).swapaxes(0, 1)
    bi = jnp.arange(B)[:, None, None, None]
    gi = jnp.arange(G)[None, :, None, None]
    sel_ids = np.arange(n_sel)

    def block_fn(args):
        qb, gb, i = args
        t = i * Q_BLOCK + jnp.arange(Q_BLOCK)
        s_c = jnp.einsum('bqghd,bcgd->bgqhc', qb, k_cmp, preferred_element_type=f32)
        p_c = masked_softmax(s_c, (cmp_end[None, :] <= t[:, None])[None, None, :, None, :])
        o_c = jnp.einsum('bgqhc,bcgd->bgqhd', p_c, v_cmp.astype(f32))
        imp = jnp.einsum('bgqhc,cs->bgqs', p_c, overlap)
        cur = (t // SEL_BLOCK)[:, None]
        forced = (sel_ids[None, :] == 0) | (sel_ids[None, :] == cur) | (sel_ids[None, :] == cur - 1)
        imp = jnp.where(forced, FORCE_SCORE, imp)
        imp = jnp.where(sel_ids[None, :] <= cur, imp, NEG_INF)
        top_val, top_idx = lax.top_k(imp, top_k)
        k_g = k_sel_blk[bi, gi, top_idx]
        v_g = v_sel_blk[bi, gi, top_idx]
        tok = top_idx[..., None] * SEL_BLOCK + jnp.arange(SEL_BLOCK)
        m_s = (top_val > 0.5 * NEG_INF)[..., None] & (tok <= t[None, None, :, None, None])
        s_s = jnp.einsum('bqghd,bgqkld->bgqhkl', qb, k_g, preferred_element_type=f32)
        shp = s_s.shape
        p_s = masked_softmax(s_s.reshape(shp[:4] + (-1,)), m_s.reshape(B, G, Q_BLOCK, 1, -1)).reshape(shp)
        o_s = jnp.einsum('bgqhkl,bgqkld->bgqhd', p_s, v_g.astype(f32))
        kw = lax.dynamic_slice_in_dim(k_win, i * Q_BLOCK, Q_BLOCK + WINDOW, axis=1)
        vw = lax.dynamic_slice_in_dim(v_win, i * Q_BLOCK, Q_BLOCK + WINDOW, axis=1)
        kpos = i * Q_BLOCK - WINDOW + jnp.arange(Q_BLOCK + WINDOW)
        m_w = (kpos[None, :] >= 0) & (kpos[None, :] <= t[:, None]) & (kpos[None, :] > t[:, None] - WINDOW)
        s_w = jnp.einsum('bqghd,bkgd->bgqhk', qb, kw, preferred_element_type=f32)
        p_w = masked_softmax(s_w, m_w[None, None, :, None, :])
        o_w = jnp.einsum('bgqhk,bkgd->bgqhd', p_w, vw.astype(f32))
        gb = gb.transpose(0, 2, 1, 3, 4)
        o = gb[..., 0:1] * o_c + gb[..., 1:2] * o_s + gb[..., 2:3] * o_w
        return o.transpose(0, 2, 1, 3, 4)

    o = lax.map(block_fn, (q_blocks, g_blocks, jnp.arange(n_qb)))
    o = o.swapaxes(0, 1).reshape(B, T, NSA_W)
    return o * jax.nn.silu(gate.astype(f32))


def setup_inputs(seed: int = 0) -> dict:
    key = jax.random.key(seed)
    ks = jax.random.split(key, 32)
    L = DEPTH
    f32 = jnp.float32

    def nrm(k, shape, s):
        return jax.random.normal(k, shape, f32) * s

    x = nrm(ks[0], (BATCH, SEQ, D_MODEL), 1.0)
    norm_g = 1.0 + nrm(ks[1], (L, D_MODEL), 0.01)
    w_in = nrm(ks[2], (L, D_MODEL, D_IN), D_MODEL ** -0.5)
    gla_w2 = nrm(ks[3], (L, GLA_LOWRANK, GLA_HEADS * GLA_DK), GLA_LOWRANK ** -0.5)
    gla_b2 = nrm(ks[4], (L, GLA_HEADS * GLA_DK), 0.1)
    gla_onorm = 1.0 + nrm(ks[5], (L, GLA_DV), 0.01)
    n_idx = jnp.arange(S5_STATE, dtype=f32)
    s5_lam_re = -0.5 + nrm(ks[6], (L, S5_GROUPS, S5_STATE), 0.01)
    s5_lam_im = math.pi * n_idx + nrm(ks[7], (L, S5_GROUPS, S5_STATE), 0.01)
    s5_log_step = jax.random.uniform(ks[8], (L, S5_GROUPS), f32, math.log(S5_DT_MIN), math.log(S5_DT_MAX))
    s5_b_re = nrm(ks[9], (L, S5_GROUPS, S5_STATE, S5_CH), (2 * S5_CH) ** -0.5)
    s5_b_im = nrm(ks[10], (L, S5_GROUPS, S5_STATE, S5_CH), (2 * S5_CH) ** -0.5)
    s5_c_re = nrm(ks[11], (L, S5_GROUPS, S5_CH, S5_STATE), (2 * S5_STATE) ** -0.5)
    s5_c_im = nrm(ks[12], (L, S5_GROUPS, S5_CH, S5_STATE), (2 * S5_STATE) ** -0.5)
    s5_d = nrm(ks[13], (L, S5_GROUPS, S5_CH), 1.0)
    s5_glu_w = nrm(ks[14], (L, S5_W, 2 * S5_W), S5_W ** -0.5)
    s5_glu_b = nrm(ks[15], (L, 2 * S5_W), 0.02)
    nsa_gate_b = nrm(ks[16], (L, NSA_HEADS * N_BRANCH), 0.1)
    nsa_qn = 1.0 + nrm(ks[17], (L, NSA_DH), 0.01)
    nsa_kn = 1.0 + nrm(ks[18], (L, N_BRANCH, NSA_DH), 0.01)
    nsa_cmp_pos = nrm(ks[19], (L, 2, CMP_LEN, NSA_DH), 0.1)
    nsa_cmp_w1 = nrm(ks[20], (L, 2, CMP_LEN * NSA_DH, CMP_HIDDEN), (CMP_LEN * NSA_DH) ** -0.5)
    nsa_cmp_b1 = nrm(ks[21], (L, 2, CMP_HIDDEN), 0.02)
    nsa_cmp_w2 = nrm(ks[22], (L, 2, CMP_HIDDEN, NSA_DH), CMP_HIDDEN ** -0.5)
    nsa_cmp_b2 = nrm(ks[23], (L, 2, NSA_DH), 0.02)
    w_out = nrm(ks[24], (L, D_MIX, D_MODEL), D_MIX ** -0.5 * (2 * DEPTH) ** -0.5)
    return {'x': x, 'norm_g': norm_g, 'w_in': w_in,
            'gla_w2': gla_w2, 'gla_b2': gla_b2, 'gla_onorm': gla_onorm,
            's5_lam_re': s5_lam_re, 's5_lam_im': s5_lam_im, 's5_log_step': s5_log_step,
            's5_b_re': s5_b_re, 's5_b_im': s5_b_im, 's5_c_re': s5_c_re, 's5_c_im': s5_c_im,
            's5_d': s5_d, 's5_glu_w': s5_glu_w, 's5_glu_b': s5_glu_b,
            'nsa_gate_b': nsa_gate_b, 'nsa_qn': nsa_qn, 'nsa_kn': nsa_kn, 'nsa_cmp_pos': nsa_cmp_pos,
            'nsa_cmp_w1': nsa_cmp_w1, 'nsa_cmp_b1': nsa_cmp_b1, 'nsa_cmp_w2': nsa_cmp_w2,
            'nsa_cmp_b2': nsa_cmp_b2, 'w_out': w_out}


def reference(x, norm_g, w_in, gla_w2, gla_b2, gla_onorm, s5_lam_re, s5_lam_im, s5_log_step,
              s5_b_re, s5_b_im, s5_c_re, s5_c_im, s5_d, s5_glu_w, s5_glu_b, nsa_gate_b, nsa_qn,
              nsa_kn, nsa_cmp_pos, nsa_cmp_w1, nsa_cmp_b1, nsa_cmp_w2, nsa_cmp_b2, w_out):
    for l in range(DEPTH):
        h = rmsnorm(x, norm_g[l])
        proj = jnp.matmul(h, w_in[l])
        (gq, gk, gv, glr, gg, su, sg, nq, nkv, ngl, ng) = jnp.split(proj, IN_SPLITS, axis=-1)
        y_gla = gla_mixer(gq, gk, gv, glr, gg, gla_w2[l], gla_b2[l], gla_onorm[l])
        y_s5 = s5_mixer(su, sg, s5_lam_re[l], s5_lam_im[l], s5_log_step[l], s5_b_re[l], s5_b_im[l],
                        s5_c_re[l], s5_c_im[l], s5_d[l], s5_glu_w[l], s5_glu_b[l])
        y_nsa = nsa_mixer(nq, nkv, ngl, ng, nsa_gate_b[l], nsa_qn[l], nsa_kn[l], nsa_cmp_pos[l],
                          nsa_cmp_w1[l], nsa_cmp_b1[l], nsa_cmp_w2[l], nsa_cmp_b2[l])
        mix = jnp.concatenate([y_gla, y_s5, y_nsa], axis=-1).astype(x.dtype)
        x = x + jnp.matmul(mix, w_out[l])
    return x
```

```cpp
#include <hip/hip_runtime.h>
#include <hip/hip_cooperative_groups.h>
#include <cstdio>
#include <cstdint>
namespace cg = cooperative_groups;

typedef _Float16 h16;
typedef _Float16 half8 __attribute__((ext_vector_type(8)));
typedef _Float16 half4 __attribute__((ext_vector_type(4)));
typedef float f32x4 __attribute__((ext_vector_type(4)));

#define DI __device__ __forceinline__

constexpr int D_MODEL = 1024, BATCH = 2, SEQ = 8192, DEPTH = 4, NT = BATCH * SEQ;
constexpr int D_IN = 3112, D_IN_PAD = 3200;
constexpr int C_GQ = 0, C_GK = 128, C_GV = 256, C_GLR = 512, C_GG = 528, C_SU = 784, C_SG = 1040, C_NQ = 1296,
              C_NKV = 1808, C_NGL = 2576, C_NG = 2600;
constexpr int NTHREADS = 256;

enum { I_X = 0, I_NORMG, I_WIN, I_GW2, I_GB2, I_GON, I_LRE, I_LIM, I_LSTEP, I_BRE, I_BIM, I_CRE, I_CIM, I_SD, I_GLUW, I_GLUB,
       I_NGB, I_NQN, I_NKN, I_CPOS, I_CW1, I_CB1, I_CW2, I_CB2, I_WOUT };

constexpr size_t OFF_WTIN  = 0;
constexpr size_t OFF_WTOUT = OFF_WTIN  + 4ull * D_IN_PAD * 1024 * 2;
constexpr size_t OFF_WTGLU = OFF_WTOUT + 4ull * 1024 * 1024 * 2;
constexpr size_t OFF_WTC1  = OFF_WTGLU + 4ull * 512 * 256 * 2;
constexpr size_t OFF_PROJ  = OFF_WTC1  + 4ull * 2 * 256 * 2048 * 2;
constexpr size_t OFF_MIX   = OFF_PROJ  + (size_t)NT * D_IN * 2;
constexpr size_t OFF_YACT  = OFF_MIX   + (size_t)NT * 1024 * 2;
constexpr size_t OFF_BCUM  = OFF_YACT  + (size_t)NT * 256 * 2;
constexpr size_t OFF_GKV   = OFF_BCUM  + (size_t)NT * 128 * 4;
constexpr size_t OFF_GDEC  = OFF_GKV   + 8ull * 256 * 2048 * 4;
constexpr size_t OFF_XC    = OFF_GDEC  + 8ull * 256 * 32 * 4;
constexpr size_t OFF_S5W   = OFF_XC    + 512ull * 1024 * 2 * 4;
constexpr size_t OFF_S5E   = OFF_S5W   + 16ull * 512 * 640 * 2;
constexpr size_t OFF_S5AL  = OFF_S5E   + 16ull * 128 * 512 * 2;
constexpr size_t OFF_CHID  = OFF_S5AL  + 1024ull * 2 * 4;
constexpr size_t OFF_KCMP  = OFF_CHID  + 2ull * 2048 * 256 * 4;
constexpr size_t OFF_VCMP  = OFF_KCMP  + 4ull * 512 * 64 * 4;
constexpr size_t WS_END    = OFF_VCMP  + 4ull * 512 * 64 * 4;

struct Params {
    const float* in[25];
    float* out;
    char* ws;
};

constexpr int SMEM_BYTES = 40960;

DI int otid() { int t = threadIdx.x; asm volatile("" : "+v"(t)); return t; }
DI float wave_sum(float v) {
#pragma unroll
    for (int o = 32; o > 0; o >>= 1) v += __shfl_xor(v, o);
    return v;
}
DI float wave_max(float v) {
#pragma unroll
    for (int o = 32; o > 0; o >>= 1) v = fmaxf(v, __shfl_xor(v, o));
    return v;
}
DI float sigmoidf_(float x) { return 1.f / (1.f + __expf(-x)); }
DI float siluf_(float x) { return x / (1.f + __expf(-x)); }
DI float gelu_tanh(float x) {
    const float u = 0.7978845608028654f * (x + 0.044715f * x * x * x);
    return 0.5f * x * (1.f + tanhf(u));
}
DI float log_sigmoidf_(float x) { return fminf(x, 0.f) - log1pf(__expf(-fabsf(x))); }

template <class AL>
DI void gemm_mainloop(const int K, AL& al, const h16* __restrict__ Bt, const int ldb, f32x4 (&acc)[4][4], char* smem) {
    h16 (*As)[72] = (h16 (*)[72])smem;
    h16 (*Bs)[72] = (h16 (*)[72])(smem + 128 * 72 * 2);
    const int tid = otid(), lane = tid & 63, wid = tid >> 6, wr = wid >> 1, wc = wid & 1;
    const int lrow = tid >> 1, lcol = (tid & 1) * 32;
#pragma unroll
    for (int i = 0; i < 4; ++i)
#pragma unroll
        for (int j = 0; j < 4; ++j) acc[i][j] = (f32x4){0.f, 0.f, 0.f, 0.f};
    half8 ra[4], rb[4];
    al.load(lrow, lcol, ra);
    const h16* bp = Bt + (size_t)lrow * ldb + lcol;
#pragma unroll
    for (int q = 0; q < 4; ++q) rb[q] = *(const half8*)(bp + q * 8);
    for (int k0 = 0; k0 < K; k0 += 64) {
#pragma unroll
        for (int q = 0; q < 4; ++q) {
            *(half8*)&As[lrow][lcol + q * 8] = ra[q];
            *(half8*)&Bs[lrow][lcol + q * 8] = rb[q];
        }
        __syncthreads();
        if (k0 + 64 < K) {
            al.load(lrow, k0 + 64 + lcol, ra);
#pragma unroll
            for (int q = 0; q < 4; ++q) rb[q] = *(const half8*)(bp + k0 + 64 + q * 8);
        }
#pragma unroll
        for (int kk = 0; kk < 2; ++kk) {
            half8 af[4], bf[4];
#pragma unroll
            for (int i = 0; i < 4; ++i) af[i] = *(const half8*)&As[wr * 64 + i * 16 + (lane & 15)][kk * 32 + (lane >> 4) * 8];
#pragma unroll
            for (int j = 0; j < 4; ++j) bf[j] = *(const half8*)&Bs[wc * 64 + j * 16 + (lane & 15)][kk * 32 + (lane >> 4) * 8];
#pragma unroll
            for (int i = 0; i < 4; ++i)
#pragma unroll
                for (int j = 0; j < 4; ++j) acc[i][j] = __builtin_amdgcn_mfma_f32_16x16x32_f16(bf[j], af[i], acc[i][j], 0, 0, 0);
        }
        __syncthreads();
    }
}

struct XLoader {
    const float* x; float ss;
    DI void load(int row, int k, half8 (&r)[4]) {
        const float4* p = (const float4*)(x + (size_t)row * 1024 + k);
#pragma unroll
        for (int q = 0; q < 4; ++q) {
            const float4 a = p[2 * q], b = p[2 * q + 1];
            ss += a.x * a.x + a.y * a.y + a.z * a.z + a.w * a.w + b.x * b.x + b.y * b.y + b.z * b.z + b.w * b.w;
            r[q] = (half8){(h16)a.x, (h16)a.y, (h16)a.z, (h16)a.w, (h16)b.x, (h16)b.y, (h16)b.z, (h16)b.w};
        }
    }
};
struct HLoader {
    const h16* a; int ld;
    DI void load(int row, int k, half8 (&r)[4]) {
        const half8* p = (const half8*)(a + (size_t)row * ld + k);
#pragma unroll
        for (int q = 0; q < 4; ++q) r[q] = p[q];
    }
};
struct CmpLoader {
    const h16* proj; const float* pos; int j; int row0;
    DI void load(int row, int k, half8 (&r)[4]) {
        const int rr = row0 + row, bg = rr >> 9, i = rr & 511, b = bg >> 1, g = bg & 1;
        const int l = k >> 6, d = k & 63;
        int t = 16 * i + l; t = t > SEQ - 1 ? SEQ - 1 : t;
        const half8* p = (const half8*)(proj + ((size_t)b * SEQ + t) * D_IN + C_NKV + j * 128 + g * 64 + d);
        const float4* pp = (const float4*)(pos + l * 64 + d);
#pragma unroll
        for (int q = 0; q < 4; ++q) {
            const half8 v = p[q]; const float4 a = pp[2 * q], c = pp[2 * q + 1];
            r[q] = (half8){(h16)((float)v[0] + a.x), (h16)((float)v[1] + a.y), (h16)((float)v[2] + a.z), (h16)((float)v[3] + a.w),
                           (h16)((float)v[4] + c.x), (h16)((float)v[5] + c.y), (h16)((float)v[6] + c.z), (h16)((float)v[7] + c.w)};
        }
    }
};
struct S5ULoader {
    const h16* proj; const float* xin; int g; int row0;
    DI void load(int row, int k, half8 (&r)[4]) {
        const int ch = row0 + row;
        if (k < 512) {
            const int s0 = k >> 4;
            const half8* p0 = (const half8*)(proj + ((size_t)ch * 32 + s0) * D_IN + C_SU + g * 16);
            const half8* p1 = (const half8*)(proj + ((size_t)ch * 32 + s0 + 1) * D_IN + C_SU + g * 16);
            r[0] = p0[0]; r[1] = p0[1]; r[2] = p1[0]; r[3] = p1[1];
        } else {
            const float4* p = (const float4*)(xin + ((size_t)ch * 1024 + g * 64) * 2 + (k - 512));
#pragma unroll
            for (int q = 0; q < 4; ++q) {
                const float4 a = p[2 * q], b = p[2 * q + 1];
                r[q] = (half8){(h16)a.x, (h16)a.y, (h16)a.z, (h16)a.w, (h16)b.x, (h16)b.y, (h16)b.z, (h16)b.w};
            }
        }
    }
};

DI void transpose_tile(const float* __restrict__ src, int R, int C, h16* __restrict__ dst, int r0, int c0,
                       const float* __restrict__ rscale, float* tile) {
    const int tx = otid() & 31, ty = otid() >> 5;
    for (int yy = ty; yy < 32; yy += 8) {
        const int r = r0 + yy, c = c0 + tx;
        float v = (c < C) ? src[(size_t)r * C + c] : 0.f;
        if (rscale) v *= rscale[r];
        tile[yy * 33 + tx] = v;
    }
    __syncthreads();
    for (int yy = ty; yy < 32; yy += 8) {
        const int c = c0 + yy, r = r0 + tx;
        dst[(size_t)c * R + r] = (h16)tile[tx * 33 + yy];
    }
    __syncthreads();
}

DI int glu_perm_src(int np) {
    const int t = np >> 7, w = (np >> 6) & 1, j = (np >> 4) & 3, e = np & 15;
    const int c = t * 64 + w * 32 + (j >> 1) * 16 + e;
    return c + (j & 1) * 256;
}

DI void phase0(const Params& P, char* smem) {
    float* tile = (float*)smem;
    constexpr int N_WIN = 4 * 32 * 100, N_WOUT = 4 * 32 * 32, N_C1 = 8 * 64 * 8, N_GLU = 2048;
    const int total = N_WIN + N_WOUT + N_C1 + N_GLU;
    for (int w = blockIdx.x; w < total; w += gridDim.x) {
        if (w < N_WIN) {
            const int l = w / 3200, r = w % 3200, rt = r / 100, ct = r % 100;
            transpose_tile(P.in[I_WIN] + (size_t)l * 1024 * D_IN, 1024, D_IN, (h16*)(P.ws + OFF_WTIN) + (size_t)l * D_IN_PAD * 1024,
                           rt * 32, ct * 32, P.in[I_NORMG] + l * 1024, tile);
        } else if (w < N_WIN + N_WOUT) {
            const int v = w - N_WIN, l = v >> 10, r = v & 1023, rt = r >> 5, ct = r & 31;
            transpose_tile(P.in[I_WOUT] + (size_t)l * 1024 * 1024, 1024, 1024, (h16*)(P.ws + OFF_WTOUT) + (size_t)l * 1024 * 1024,
                           rt * 32, ct * 32, nullptr, tile);
        } else if (w < N_WIN + N_WOUT + N_C1) {
            const int v = w - N_WIN - N_WOUT, lj = v >> 9, r = v & 511, rt = r >> 3, ct = r & 7;
            transpose_tile(P.in[I_CW1] + (size_t)lj * 2048 * 256, 2048, 256, (h16*)(P.ws + OFF_WTC1) + (size_t)lj * 256 * 2048,
                           rt * 32, ct * 32, nullptr, tile);
        } else {
            const int v = w - N_WIN - N_WOUT - N_C1;
            const int idx = v * 256 + otid();
            const int l = idx >> 17, rem = idx & 131071, np = rem >> 8, k = rem & 255;
            ((h16*)(P.ws + OFF_WTGLU))[idx] = (h16)P.in[I_GLUW][((size_t)l * 256 + k) * 512 + glu_perm_src(np)];
        }
    }
}

DI void s5_build_item(const Params& P, int l, int item, char* smem) {
    float* apow = (float*)smem;
    float* bbar = apow + 64 * 33 * 2;
    float* cc   = bbar + 64 * 16 * 2;
    const int tid = otid();
    const int g = (item < 512) ? (item >> 5) : ((item - 512) >> 2);
    if (tid < 64) {
        const int p = tid;
        const double lre = fmin((double)P.in[I_LRE][(l * 16 + g) * 64 + p], -1e-4);
        const double lim = (double)P.in[I_LIM][(l * 16 + g) * 64 + p];
        const double dt = exp((double)P.in[I_LSTEP][l * 16 + g]);
        const double mag = exp(lre * dt);
        const double ar = mag * cos(lim * dt), ai = mag * sin(lim * dt);
        const double den = lre * lre + lim * lim;
        const double fr = ((ar - 1.0) * lre + ai * lim) / den;
        const double fi = (ai * lre - (ar - 1.0) * lim) / den;
        double pr = 1.0, pi = 0.0;
        for (int k = 0; k <= 32; ++k) {
            apow[(p * 33 + k) * 2] = (float)pr; apow[(p * 33 + k) * 2 + 1] = (float)pi;
            const double nr = pr * ar - pi * ai, ni = pr * ai + pi * ar; pr = nr; pi = ni;
        }
        for (int c = 0; c < 16; ++c) {
            const double br = (double)P.in[I_BRE][((size_t)(l * 16 + g) * 64 + p) * 16 + c];
            const double bi = (double)P.in[I_BIM][((size_t)(l * 16 + g) * 64 + p) * 16 + c];
            bbar[(p * 16 + c) * 2] = (float)(fr * br - fi * bi);
            bbar[(p * 16 + c) * 2 + 1] = (float)(fr * bi + fi * br);
        }
    }
    for (int e = tid; e < 1024; e += 256) {
        cc[e * 2] = P.in[I_CRE][(size_t)(l * 16 + g) * 1024 + e];
        cc[e * 2 + 1] = P.in[I_CIM][(size_t)(l * 16 + g) * 1024 + e];
    }
    __syncthreads();
    if (item < 512) {
        const int j = item & 31;
        h16* W = (h16*)(P.ws + OFF_S5W) + ((size_t)g * 512 + j * 16) * 640;
        for (int idx = tid; idx < 16 * 640; idx += 256) {
            const int c = idx / 640, k = idx % 640;
            float val = 0.f;
            if (k < 512) {
                const int s = k >> 4, c2 = k & 15, lag = j - s;
                if (lag >= 0) {
                    float a = 0.f;
                    for (int p = 0; p < 64; ++p) {
                        const float cr = cc[(c * 64 + p) * 2], ci = cc[(c * 64 + p) * 2 + 1];
                        const float xr = apow[(p * 33 + lag) * 2], xi = apow[(p * 33 + lag) * 2 + 1];
                        const float br = bbar[(p * 16 + c2) * 2], bi = bbar[(p * 16 + c2) * 2 + 1];
                        const float tr = cr * xr - ci * xi, ti = cr * xi + ci * xr;
                        a += tr * br - ti * bi;
                    }
                    val = a;
                }
            } else {
                const int p = (k - 512) >> 1;
                const float cr = cc[(c * 64 + p) * 2], ci = cc[(c * 64 + p) * 2 + 1];
                const float xr = apow[(p * 33 + j + 1) * 2], xi = apow[(p * 33 + j + 1) * 2 + 1];
                val = (k & 1) ? -(cr * xi + ci * xr) : (cr * xr - ci * xi);
            }
            W[(size_t)c * 640 + k] = (h16)val;
        }
    } else {
        const int pq = (item - 512) & 3;
        h16* E = (h16*)(P.ws + OFF_S5E) + ((size_t)g * 128 + pq * 32) * 512;
        for (int idx = tid; idx < 32 * 512; idx += 256) {
            const int nl = idx >> 9, k = idx & 511;
            const int p = pq * 16 + (nl >> 1), s = k >> 4, c2 = k & 15;
            const float xr = apow[(p * 33 + 31 - s) * 2], xi = apow[(p * 33 + 31 - s) * 2 + 1];
            const float br = bbar[(p * 16 + c2) * 2], bi = bbar[(p * 16 + c2) * 2 + 1];
            const float val = (nl & 1) ? (xr * bi + xi * br) : (xr * br - xi * bi);
            E[(size_t)nl * 512 + k] = (h16)val;
        }
        if (tid < 16) {
            const int p = pq * 16 + tid;
            float* AL = (float*)(P.ws + OFF_S5AL);
            AL[(g * 64 + p) * 2] = apow[(p * 33 + 32) * 2];
            AL[(g * 64 + p) * 2 + 1] = apow[(p * 33 + 32) * 2 + 1];
        }
    }
    __syncthreads();
}

DI void inproj_tile(const Params& P, int l, int tile, char* smem) {
    const int mt = tile / 25, nt = tile % 25;
    const float* xsrc = (l == 0) ? P.in[I_X] : P.out;
    XLoader al{xsrc + (size_t)mt * 128 * 1024, 0.f};
    f32x4 acc[4][4];
    gemm_mainloop(1024, al, (const h16*)(P.ws + OFF_WTIN) + ((size_t)l * D_IN_PAD + nt * 128) * 1024, 1024, acc, smem);
    float* rs = (float*)(smem + 2 * 128 * 72 * 2);
    const int tid = otid(), lane = tid & 63, wid = tid >> 6, wr = wid >> 1, wc = wid & 1;
    {
        const float tot = al.ss + __shfl_xor(al.ss, 1);
        if ((tid & 1) == 0) rs[tid >> 1] = rsqrtf(tot * (1.f / 1024.f) + 1e-6f);
    }
    __syncthreads();
    h16* proj = (h16*)(P.ws + OFF_PROJ);
#pragma unroll
    for (int i = 0; i < 4; ++i) {
        const int ml = wr * 64 + i * 16 + (lane & 15);
        const float r = rs[ml];
        const size_t row = (size_t)mt * 128 + ml;
#pragma unroll
        for (int j = 0; j < 4; ++j) {
            const int n = nt * 128 + wc * 64 + j * 16 + (lane >> 4) * 4;
            if (n < D_IN) {
                const f32x4 v = acc[i][j];
                *(half4*)(proj + row * D_IN + n) = (half4){(h16)(v[0] * r), (h16)(v[1] * r), (h16)(v[2] * r), (h16)(v[3] * r)};
            }
        }
    }
    __syncthreads();
}

DI void gla_kv_item(const Params& P, int l, int item, char* smem) {
    const int h = item & 3, cn = item >> 2;
    const size_t tok0 = (size_t)cn * 32;
    float* gl = (float*)smem;
    float* ke = gl + 32 * 33;
    float* vs = ke + 32 * 33;
    const h16* proj = (const h16*)(P.ws + OFF_PROJ);
    const int tid = otid(), i = tid >> 3, dq = (tid & 7) * 4, e0 = (tid & 7) * 8;
    {
        const half8* lp = (const half8*)(proj + (tok0 + i) * D_IN + C_GLR);
        const half8 l0 = lp[0], l1 = lp[1];
        float lr[16];
#pragma unroll
        for (int r = 0; r < 8; ++r) { lr[r] = (float)l0[r]; lr[8 + r] = (float)l1[r]; }
#pragma unroll
        for (int dd = 0; dd < 4; ++dd) {
            const int d = dq + dd;
            float x = P.in[I_GB2][l * 128 + h * 32 + d];
#pragma unroll
            for (int r = 0; r < 16; ++r) x += lr[r] * P.in[I_GW2][(l * 16 + r) * 128 + h * 32 + d];
            gl[i * 33 + d] = log_sigmoidf_(x) * (1.f / 16.f);
        }
    }
    __syncthreads();
    if (tid < 32) {
        float run = 0.f;
        float* bc = (float*)(P.ws + OFF_BCUM);
        for (int ii = 0; ii < 32; ++ii) {
            run += gl[ii * 33 + tid]; gl[ii * 33 + tid] = run;
            bc[(tok0 + ii) * 128 + h * 32 + tid] = run;
        }
    }
    __syncthreads();
    {
        const half4 kv4 = *(const half4*)(proj + (tok0 + i) * D_IN + C_GK + h * 32 + dq);
#pragma unroll
        for (int dd = 0; dd < 4; ++dd) {
            const int d = dq + dd;
            ke[i * 33 + d] = (float)kv4[dd] * __expf(gl[31 * 33 + d] - gl[i * 33 + d]);
        }
        const half8 v8 = *(const half8*)(proj + (tok0 + i) * D_IN + C_GV + h * 64 + e0);
#pragma unroll
        for (int e = 0; e < 8; ++e) vs[i * 64 + e0 + e] = (float)v8[e];
    }
    __syncthreads();
    {
        const int d = tid >> 3;
        float acc[8];
#pragma unroll
        for (int e = 0; e < 8; ++e) acc[e] = 0.f;
        for (int c = 0; c < 32; ++c) {
            const float kd = ke[c * 33 + d];
#pragma unroll
            for (int e = 0; e < 8; ++e) acc[e] += kd * vs[c * 64 + e0 + e];
        }
        const int b = cn >> 8, n = cn & 255, bh = b * 4 + h;
        float* kvp = (float*)(P.ws + OFF_GKV) + ((size_t)(bh * 256 + n) * 32 + d) * 64 + e0;
        *(float4*)kvp = (float4){acc[0], acc[1], acc[2], acc[3]};
        *(float4*)(kvp + 4) = (float4){acc[4], acc[5], acc[6], acc[7]};
        if (tid < 32) ((float*)(P.ws + OFF_GDEC))[(size_t)(bh * 256 + n) * 32 + tid] = __expf(gl[31 * 33 + tid]);
    }
    __syncthreads();
}

DI void qknorm_item(const Params& P, int l, int item) {
    const int tid = otid(), lane = tid & 63, w = tid >> 6;
    const size_t tok = (size_t)item * 4 + w;
    h16* row = (h16*)(P.ws + OFF_PROJ) + tok * D_IN;
    const float qn = P.in[I_NQN][l * 64 + lane] * 0.125f;
#pragma unroll
    for (int hd = 0; hd < 8; ++hd) {
        const float v = (float)row[C_NQ + hd * 64 + lane];
        const float ss = wave_sum(v * v);
        row[C_NQ + hd * 64 + lane] = (h16)(v * rsqrtf(ss * (1.f / 64.f) + 1e-6f) * qn);
    }
#pragma unroll
    for (int br = 1; br < 3; ++br) {
        const float kn = P.in[I_NKN][(l * 3 + br) * 64 + lane];
#pragma unroll
        for (int g = 0; g < 2; ++g) {
            const int col = C_NKV + (br * 2) * 128 + g * 64 + lane;
            const float v = (float)row[col];
            const float ss = wave_sum(v * v);
            row[col] = (h16)(v * rsqrtf(ss * (1.f / 64.f) + 1e-6f) * kn);
        }
    }
}

DI void cmp_gemm_tile(const Params& P, int l, int tile, char* smem) {
    const int j = tile >> 5, mt = (tile >> 1) & 15, nt = tile & 1;
    CmpLoader al{(const h16*)(P.ws + OFF_PROJ), P.in[I_CPOS] + (size_t)(l * 2 + j) * 32 * 64, j, mt * 128};
    f32x4 acc[4][4];
    gemm_mainloop(2048, al, (const h16*)(P.ws + OFF_WTC1) + ((size_t)(l * 2 + j) * 256 + nt * 128) * 2048, 2048, acc, smem);
    const int tid = otid(), lane = tid & 63, wid = tid >> 6, wr = wid >> 1, wc = wid & 1;
    float* hid = (float*)(P.ws + OFF_CHID) + (size_t)j * 2048 * 256;
    const float* b1 = P.in[I_CB1] + (l * 2 + j) * 256;
#pragma unroll
    for (int i = 0; i < 4; ++i) {
        const size_t row = (size_t)mt * 128 + wr * 64 + i * 16 + (lane & 15);
#pragma unroll
        for (int jj = 0; jj < 4; ++jj) {
            const int n = nt * 128 + wc * 64 + jj * 16 + (lane >> 4) * 4;
            const f32x4 v = acc[i][jj];
            const float4 bb = *(const float4*)(b1 + n);
            *(float4*)(hid + row * 256 + n) = (float4){gelu_tanh(v[0] + bb.x), gelu_tanh(v[1] + bb.y), gelu_tanh(v[2] + bb.z), gelu_tanh(v[3] + bb.w)};
        }
    }
}

DI void s5e_gemm_tile(const Params& P, int l, int tile, char* smem) {
    const int g = tile >> 2, mt = tile & 3;
    S5ULoader al{(const h16*)(P.ws + OFF_PROJ), nullptr, g, mt * 128};
    f32x4 acc[4][4];
    gemm_mainloop(512, al, (const h16*)(P.ws + OFF_S5E) + (size_t)g * 128 * 512, 512, acc, smem);
    const int tid = otid(), lane = tid & 63, wid = tid >> 6, wr = wid >> 1, wc = wid & 1;
    float* xc = (float*)(P.ws + OFF_XC);
#pragma unroll
    for (int i = 0; i < 4; ++i) {
        const size_t ch = (size_t)mt * 128 + wr * 64 + i * 16 + (lane & 15);
#pragma unroll
        for (int jj = 0; jj < 4; ++jj) {
            const int n = wc * 64 + jj * 16 + (lane >> 4) * 4;
            const f32x4 v = acc[i][jj];
            *(float4*)(xc + (ch * 1024 + g * 64) * 2 + n) = (float4){v[0], v[1], v[2], v[3]};
        }
    }
}

DI void gla_scan_item(const Params& P, int item) {
    const int idx = item * 256 + otid(), bh = idx >> 11, de = idx & 2047, d = de >> 6;
    float* kv = (float*)(P.ws + OFF_GKV) + (size_t)bh * 256 * 2048 + de;
    const float* dc = (const float*)(P.ws + OFF_GDEC) + (size_t)bh * 256 * 32 + d;
    float S = 0.f;
#pragma unroll 8
    for (int n = 0; n < 256; ++n) {
        const float kvv = kv[(size_t)n * 2048], dd = dc[n * 32];
        kv[(size_t)n * 2048] = S;
        S = dd * S + kvv;
    }
}
DI void s5_scan_item(const Params& P, int item) {
    const int idx = item * 256 + otid(), b = idx >> 10, s = idx & 1023;
    float2* xc = (float2*)(P.ws + OFF_XC) + (size_t)b * 256 * 1024 + s;
    const float2 a = ((const float2*)(P.ws + OFF_S5AL))[s];
    float xr = 0.f, xi = 0.f;
#pragma unroll 8
    for (int n = 0; n < 256; ++n) {
        const float2 c = xc[(size_t)n * 1024];
        xc[(size_t)n * 1024] = (float2){xr, xi};
        const float nr = a.x * xr - a.y * xi + c.x, ni = a.x * xi + a.y * xr + c.y;
        xr = nr; xi = ni;
    }
}
DI void cmp_l2_item(const Params& P, int l, int item) {
    const int tid = otid(), lane = tid & 63, w = tid >> 6;
    const int r4 = item * 4 + w, j = r4 >> 11, row = r4 & 2047;
    const float* hid = (const float*)(P.ws + OFF_CHID) + ((size_t)j * 2048 + row) * 256;
    const float* w2 = P.in[I_CW2] + (size_t)(l * 2 + j) * 256 * 64;
    float acc = P.in[I_CB2][(l * 2 + j) * 64 + lane];
    for (int n = 0; n < 256; ++n) acc += hid[n] * w2[n * 64 + lane];
    if (j == 0) {
        const float ss = wave_sum(acc * acc);
        acc = acc * rsqrtf(ss * (1.f / 64.f) + 1e-6f) * P.in[I_NKN][(l * 3 + 0) * 64 + lane];
        ((float*)(P.ws + OFF_KCMP))[(size_t)row * 64 + lane] = acc;
    } else {
        ((float*)(P.ws + OFF_VCMP))[(size_t)row * 64 + lane] = acc;
    }
}

DI void gla_out_item(const Params& P, int l, int item, char* smem) {
    const int h = item & 3, cn = item >> 2;
    const size_t tok0 = (size_t)cn * 32;
    float* qe = (float*)smem;
    float* ke = qe + 32 * 33;
    float* scs = ke + 32 * 33;
    float* vs = scs + 32 * 33;
    float* sp = vs + 32 * 64;
    const h16* proj = (const h16*)(P.ws + OFF_PROJ);
    const int tid = otid(), i = tid >> 3, dq = (tid & 7) * 4, e0 = (tid & 7) * 8;
    const int b = cn >> 8, n = cn & 255, bh = b * 4 + h;
    {
        const float4 bc = *(const float4*)((const float*)(P.ws + OFF_BCUM) + (tok0 + i) * 128 + h * 32 + dq);
        const half4 q4 = *(const half4*)(proj + (tok0 + i) * D_IN + C_GQ + h * 32 + dq);
        const half4 k4 = *(const half4*)(proj + (tok0 + i) * D_IN + C_GK + h * 32 + dq);
        const float bcv[4] = {bc.x, bc.y, bc.z, bc.w};
#pragma unroll
        for (int dd = 0; dd < 4; ++dd) {
            qe[i * 33 + dq + dd] = (float)q4[dd] * 0.17677669529663687f * __expf(bcv[dd]);
            ke[i * 33 + dq + dd] = (float)k4[dd] * __expf(-bcv[dd]);
        }
        const half8 v8 = *(const half8*)(proj + (tok0 + i) * D_IN + C_GV + h * 64 + e0);
#pragma unroll
        for (int e = 0; e < 8; ++e) vs[i * 64 + e0 + e] = (float)v8[e];
        const float* spp = (const float*)(P.ws + OFF_GKV) + (size_t)(bh * 256 + n) * 2048 + tid * 8;
        const float4 s0 = *(const float4*)spp, s1 = *(const float4*)(spp + 4);
        *(float4*)(sp + tid * 8) = s0; *(float4*)(sp + tid * 8 + 4) = s1;
    }
    __syncthreads();
    {
        const int j0 = (tid & 7) * 4;
#pragma unroll
        for (int jj = 0; jj < 4; ++jj) {
            const int j = j0 + jj;
            float s = 0.f;
            if (j <= i) for (int d = 0; d < 32; ++d) s += qe[i * 33 + d] * ke[j * 33 + d];
            scs[i * 33 + j] = s;
        }
    }
    __syncthreads();
    {
        float acc[8];
#pragma unroll
        for (int e = 0; e < 8; ++e) acc[e] = 0.f;
        for (int j = 0; j < 32; ++j) {
            const float s = scs[i * 33 + j], qd = qe[i * 33 + j];
#pragma unroll
            for (int e = 0; e < 8; ++e) acc[e] += s * vs[j * 64 + e0 + e] + qd * sp[j * 64 + e0 + e];
        }
        float ss = 0.f;
#pragma unroll
        for (int e = 0; e < 8; ++e) ss += acc[e] * acc[e];
        ss += __shfl_xor(ss, 1); ss += __shfl_xor(ss, 2); ss += __shfl_xor(ss, 4);
        const float r = rsqrtf(ss * (1.f / 64.f) + 1e-6f);
        const half8 g8 = *(const half8*)(proj + (tok0 + i) * D_IN + C_GG + h * 64 + e0);
        half8 o;
#pragma unroll
        for (int e = 0; e < 8; ++e) o[e] = (h16)(acc[e] * r * P.in[I_GON][l * 64 + e0 + e] * siluf_((float)g8[e]));
        *(half8*)((h16*)(P.ws + OFF_MIX) + (tok0 + i) * 1024 + h * 64 + e0) = o;
    }
    __syncthreads();
}

DI void s5o_gemm_tile(const Params& P, int l, int tile, char* smem) {
    const int g = tile >> 4, mt = (tile >> 2) & 3, nt = tile & 3;
    S5ULoader al{(const h16*)(P.ws + OFF_PROJ), (const float*)(P.ws + OFF_XC), g, mt * 128};
    f32x4 acc[4][4];
    gemm_mainloop(640, al, (const h16*)(P.ws + OFF_S5W) + ((size_t)g * 512 + nt * 128) * 640, 640, acc, smem);
    const int tid = otid(), lane = tid & 63, wid = tid >> 6, wr = wid >> 1, wc = wid & 1;
    const h16* proj = (const h16*)(P.ws + OFF_PROJ);
    h16* yact = (h16*)(P.ws + OFF_YACT);
#pragma unroll
    for (int i = 0; i < 4; ++i) {
        const size_t ch = (size_t)mt * 128 + wr * 64 + i * 16 + (lane & 15);
#pragma unroll
        for (int jj = 0; jj < 4; ++jj) {
            const int n = nt * 128 + wc * 64 + jj * 16 + (lane >> 4) * 4;
            const int j = n >> 4, c = n & 15;
            const size_t tok = ch * 32 + j;
            const half4 u4 = *(const half4*)(proj + tok * D_IN + C_SU + g * 16 + c);
            const float4 dd = *(const float4*)(P.in[I_SD] + (l * 16 + g) * 16 + c);
            const f32x4 v = acc[i][jj];
            half4 o;
            o[0] = (h16)gelu_tanh(v[0] + dd.x * (float)u4[0]);
            o[1] = (h16)gelu_tanh(v[1] + dd.y * (float)u4[1]);
            o[2] = (h16)gelu_tanh(v[2] + dd.z * (float)u4[2]);
            o[3] = (h16)gelu_tanh(v[3] + dd.w * (float)u4[3]);
            *(half4*)(yact + tok * 256 + g * 16 + c) = o;
        }
    }
}

DI float dot64_h(const float* __restrict__ q, const h16* __restrict__ k) {
    const half8* kp = (const half8*)k;
    float s = 0.f;
#pragma unroll
    for (int c = 0; c < 8; ++c) {
        const half8 kk = kp[c];
        const float4 q0 = *(const float4*)(q + c * 8), q1 = *(const float4*)(q + c * 8 + 4);
        s += q0.x * (float)kk[0] + q0.y * (float)kk[1] + q0.z * (float)kk[2] + q0.w * (float)kk[3]
           + q1.x * (float)kk[4] + q1.y * (float)kk[5] + q1.z * (float)kk[6] + q1.w * (float)kk[7];
    }
    return s;
}
DI void nsa_attn_item(const Params& P, int l, int item, char* smem) {
    const int t = item & (SEQ - 1), bg = item >> 13, b = bg >> 1, g = bg & 1;
    const int tid = otid(), lane = tid & 63, hh = tid >> 6;
    float* qs = (float*)smem;
    float* sc = qs + 256;
    float* vals = sc + 4096;
    int* sel = (int*)(vals + 128);
    const h16* proj = (const h16*)(P.ws + OFF_PROJ);
    const size_t tok = (size_t)b * SEQ + t;
    const int head = g * 4 + hh;
    qs[hh * 64 + lane] = (float)proj[tok * D_IN + C_NQ + head * 64 + lane];
    __syncthreads();
    float* scw = sc + hh * 1024;
    const float* qw = qs + hh * 64;
    const int nv = (t >= 31) ? ((t - 31) >> 4) + 1 : 0;
    const float* kc = (const float*)(P.ws + OFF_KCMP) + (size_t)bg * 512 * 64;
    const float* vc = (const float*)(P.ws + OFF_VCMP) + (size_t)bg * 512 * 64;
    float mx = -1e30f;
    for (int c = lane; c < nv; c += 64) {
        const float4* kp = (const float4*)(kc + c * 64);
        float s = 0.f;
#pragma unroll
        for (int q = 0; q < 16; ++q) {
            const float4 kk = kp[q]; const float4 qq = *(const float4*)(qw + q * 4);
            s += kk.x * qq.x + kk.y * qq.y + kk.z * qq.z + kk.w * qq.w;
        }
        scw[c] = s; mx = fmaxf(mx, s);
    }
    mx = wave_max(mx);
    float sum = 0.f;
    for (int c = lane; c < nv; c += 64) { const float e = __expf(scw[c] - mx); scw[c] = e; sum += e; }
    sum = wave_sum(sum);
    {
        const float inv = nv > 0 ? 1.f / sum : 0.f;
        for (int c = lane; c < nv; c += 64) scw[c] *= inv;
    }
    __syncthreads();
    float oc = 0.f;
    for (int c = 0; c < nv; ++c) oc += scw[c] * vc[c * 64 + lane];
    const int cur = t >> 6;
    if (tid < 128) {
        const int s = tid; float v;
        if (s > cur) v = -1e30f;
        else if (s == 0 || s == cur || s == cur - 1) v = 1e4f;
        else {
            float a = 0.f;
            const int c0 = 4 * s - 1; int c1 = 4 * s + 3; c1 = c1 < nv - 1 ? c1 : nv - 1;
            for (int c = c0; c <= c1; ++c) a += sc[c] + sc[1024 + c] + sc[2048 + c] + sc[3072 + c];
            v = a;
        }
        vals[s] = v;
    }
    __syncthreads();
    if (tid < 128) {
        const int s = tid; const float v = vals[s];
        int rank = 0;
        for (int s2 = 0; s2 < 128; ++s2) { const float w = vals[s2]; rank += (w > v || (w == v && s2 < s)) ? 1 : 0; }
        if (rank < 16 && v > -5e29f) sel[rank] = s;
    }
    __syncthreads();
    const int nsel = cur + 1 < 16 ? cur + 1 : 16;
    float os = 0.f;
    {
        const int nk = nsel * 64;
        const int kcol = C_NKV + 256 + g * 64, vcol = C_NKV + 384 + g * 64;
        float m2 = -1e30f;
        for (int idx = lane; idx < nk; idx += 64) {
            const int kt = sel[idx >> 6] * 64 + (idx & 63);
            float s = -1e30f;
            if (kt <= t) s = dot64_h(qw, proj + ((size_t)b * SEQ + kt) * D_IN + kcol);
            scw[idx] = s; m2 = fmaxf(m2, s);
        }
        m2 = wave_max(m2);
        float sm = 0.f;
        for (int idx = lane; idx < nk; idx += 64) { const float s = scw[idx]; const float e = (s > -5e29f) ? __expf(s - m2) : 0.f; scw[idx] = e; sm += e; }
        sm = wave_sum(sm);
        __syncthreads();
        for (int idx = 0; idx < nk; ++idx) {
            const int kt = sel[idx >> 6] * 64 + (idx & 63);
            os += scw[idx] * (float)proj[((size_t)b * SEQ + kt) * D_IN + vcol + lane];
        }
        os *= 1.f / sm;
    }
    __syncthreads();
    float ow = 0.f;
    {
        const int lo = t - 511 > 0 ? t - 511 : 0, nk = t - lo + 1;
        const int kcol = C_NKV + 512 + g * 64, vcol = C_NKV + 640 + g * 64;
        float m2 = -1e30f;
        for (int idx = lane; idx < nk; idx += 64) {
            const float s = dot64_h(qw, proj + ((size_t)b * SEQ + lo + idx) * D_IN + kcol);
            scw[idx] = s; m2 = fmaxf(m2, s);
        }
        m2 = wave_max(m2);
        float sm = 0.f;
        for (int idx = lane; idx < nk; idx += 64) { const float e = __expf(scw[idx] - m2); scw[idx] = e; sm += e; }
        sm = wave_sum(sm);
        __syncthreads();
        for (int idx = 0; idx < nk; ++idx) ow += scw[idx] * (float)proj[((size_t)b * SEQ + lo + idx) * D_IN + vcol + lane];
        ow *= 1.f / sm;
    }
    {
        const h16* row = proj + tok * D_IN;
        const float* gb = P.in[I_NGB] + l * 24 + head * 3;
        const float g0 = sigmoidf_((float)row[C_NGL + head * 3 + 0] + gb[0]);
        const float g1 = sigmoidf_((float)row[C_NGL + head * 3 + 1] + gb[1]);
        const float g2 = sigmoidf_((float)row[C_NGL + head * 3 + 2] + gb[2]);
        const float o = (g0 * oc + g1 * os + g2 * ow) * siluf_((float)row[C_NG + head * 64 + lane]);
        ((h16*)(P.ws + OFF_MIX))[tok * 1024 + 512 + head * 64 + lane] = (h16)o;
    }
    __syncthreads();
}

DI void glu_tile(const Params& P, int l, int tile, char* smem) {
    const int mt = tile >> 2, nt = tile & 3;
    HLoader al{(const h16*)(P.ws + OFF_YACT) + (size_t)mt * 128 * 256, 256};
    f32x4 acc[4][4];
    gemm_mainloop(256, al, (const h16*)(P.ws + OFF_WTGLU) + ((size_t)l * 512 + nt * 128) * 256, 256, acc, smem);
    const int tid = otid(), lane = tid & 63, wid = tid >> 6, wr = wid >> 1, wc = wid & 1;
    const h16* proj = (const h16*)(P.ws + OFF_PROJ);
    h16* mix = (h16*)(P.ws + OFF_MIX);
    const float* gb = P.in[I_GLUB] + l * 512;
#pragma unroll
    for (int i = 0; i < 4; ++i) {
        const size_t tok = (size_t)mt * 128 + wr * 64 + i * 16 + (lane & 15);
#pragma unroll
        for (int pj = 0; pj < 2; ++pj) {
            const int c = nt * 64 + wc * 32 + pj * 16 + (lane >> 4) * 4;
            const f32x4 z1 = acc[i][2 * pj], z2 = acc[i][2 * pj + 1];
            const float4 b1 = *(const float4*)(gb + c), b2 = *(const float4*)(gb + 256 + c);
            const half4 g4 = *(const half4*)(proj + tok * D_IN + C_SG + c);
            half4 o;
            o[0] = (h16)((z1[0] + b1.x) * sigmoidf_(z2[0] + b2.x) * siluf_((float)g4[0]));
            o[1] = (h16)((z1[1] + b1.y) * sigmoidf_(z2[1] + b2.y) * siluf_((float)g4[1]));
            o[2] = (h16)((z1[2] + b1.z) * sigmoidf_(z2[2] + b2.z) * siluf_((float)g4[2]));
            o[3] = (h16)((z1[3] + b1.w) * sigmoidf_(z2[3] + b2.w) * siluf_((float)g4[3]));
            *(half4*)(mix + tok * 1024 + 256 + c) = o;
        }
    }
}

DI void outproj_tile(const Params& P, int l, int tile, char* smem) {
    const int mt = tile >> 3, nt = tile & 7;
    HLoader al{(const h16*)(P.ws + OFF_MIX) + (size_t)mt * 128 * 1024, 1024};
    f32x4 acc[4][4];
    gemm_mainloop(1024, al, (const h16*)(P.ws + OFF_WTOUT) + ((size_t)l * 1024 + nt * 128) * 1024, 1024, acc, smem);
    const int tid = otid(), lane = tid & 63, wid = tid >> 6, wr = wid >> 1, wc = wid & 1;
    const float* xin = (l == 0) ? P.in[I_X] : P.out;
#pragma unroll
    for (int i = 0; i < 4; ++i) {
        const size_t row = (size_t)mt * 128 + wr * 64 + i * 16 + (lane & 15);
#pragma unroll
        for (int jj = 0; jj < 4; ++jj) {
            const int n = nt * 128 + wc * 64 + jj * 16 + (lane >> 4) * 4;
            const f32x4 v = acc[i][jj];
            const float4 xo = *(const float4*)(xin + row * 1024 + n);
            *(float4*)(P.out + row * 1024 + n) = (float4){xo.x + v[0], xo.y + v[1], xo.z + v[2], xo.w + v[3]};
        }
    }
}

__global__ void __launch_bounds__(NTHREADS, 2) fwd_megakernel(Params P) {
    __shared__ __attribute__((aligned(16))) char smem[SMEM_BYTES];
    cg::grid_group grid = cg::this_grid();
    const int G = gridDim.x, bid = blockIdx.x;

    phase0(P, smem);
    grid.sync();

#pragma unroll 1
    for (int l = 0; l < DEPTH; ++l) {
#pragma unroll 1
        for (int w = bid; w < 3200 + 576; w += G) {
            if (w < 3200) inproj_tile(P, l, w, smem);
            else s5_build_item(P, l, w - 3200, smem);
        }
        grid.sync();
#pragma unroll 1
        for (int w = bid; w < 64 + 64 + 2048 + 4096; w += G) {
            if (w < 64) cmp_gemm_tile(P, l, w, smem);
            else if (w < 128) s5e_gemm_tile(P, l, w - 64, smem);
            else if (w < 128 + 2048) gla_kv_item(P, l, w - 128, smem);
            else qknorm_item(P, l, w - 128 - 2048);
        }
        grid.sync();
#pragma unroll 1
        for (int w = bid; w < 64 + 8 + 1024; w += G) {
            if (w < 64) gla_scan_item(P, w);
            else if (w < 72) s5_scan_item(P, w - 64);
            else cmp_l2_item(P, l, w - 72);
        }
        grid.sync();
#pragma unroll 1
        for (int w = bid; w < 32768 + 256 + 2048; w += G) {
            if (w < 32768) nsa_attn_item(P, l, w, smem);
            else if (w < 32768 + 256) s5o_gemm_tile(P, l, w - 32768, smem);
            else gla_out_item(P, l, w - 32768 - 256, smem);
        }
        grid.sync();
#pragma unroll 1
        for (int w = bid; w < 512; w += G) glu_tile(P, l, w, smem);
        grid.sync();
#pragma unroll 1
        for (int w = bid; w < 1024; w += G) outproj_tile(P, l, w, smem);
        grid.sync();
    }
}

extern "C" void kernel_launch(void* const* d_in, const int* in_sizes, int n_in, void* d_out, int out_size, void* d_ws,
                              size_t ws_size, hipStream_t stream) {
    static int grid_blocks = 0;
    if (!grid_blocks) {
        int dev = 0, cus = 0, per_cu = 0;
        hipGetDevice(&dev);
        hipDeviceGetAttribute(&cus, hipDeviceAttributeMultiprocessorCount, dev);
        hipOccupancyMaxActiveBlocksPerMultiprocessor(&per_cu, fwd_megakernel, NTHREADS, 0);
        if (per_cu < 1) per_cu = 1;
        if (per_cu > 2) per_cu = 2;
        grid_blocks = cus * per_cu;
        if (ws_size < WS_END) fprintf(stderr, "kernel_launch: workspace too small: %zu < %zu\n", ws_size, (size_t)WS_END);
    }
    Params p{};
    for (int i = 0; i < 25; ++i) p.in[i] = (const float*)d_in[i];
    p.out = (float*)d_out;
    p.ws = (char*)d_ws;
    void* args[] = {&p};
    hipError_t e = hipLaunchCooperativeKernel((const void*)fwd_megakernel, dim3(grid_blocks), dim3(NTHREADS), args, 0, stream);
    if (e != hipSuccess) fprintf(stderr, "cooperative launch failed: %s (grid %d)\n", hipGetErrorString(e), grid_blocks);
}
```

```cpp
#include <hip/hip_runtime.h>
#include <hip/hip_cooperative_groups.h>
#include <cstdio>
#include <cstdint>
namespace cg = cooperative_groups;

typedef _Float16 h16;
typedef _Float16 half8 __attribute__((ext_vector_type(8)));
typedef _Float16 half4 __attribute__((ext_vector_type(4)));
typedef float f32x4 __attribute__((ext_vector_type(4)));
typedef float f32x16 __attribute__((ext_vector_type(16)));

#define DI __device__ __forceinline__

constexpr int D_MODEL = 1024, BATCH = 2, SEQ = 8192, DEPTH = 4, NT = BATCH * SEQ;
constexpr int D_IN = 3112, D_IN_PAD = 3200;
constexpr int C_GQ = 0, C_GK = 128, C_GV = 256, C_GLR = 512, C_GG = 528, C_SU = 784, C_SG = 1040, C_NQ = 1296,
              C_NKV = 1808, C_NGL = 2576, C_NG = 2600;
constexpr int NTHREADS = 256;

enum { I_X = 0, I_NORMG, I_WIN, I_GW2, I_GB2, I_GON, I_LRE, I_LIM, I_LSTEP, I_BRE, I_BIM, I_CRE, I_CIM, I_SD, I_GLUW, I_GLUB,
       I_NGB, I_NQN, I_NKN, I_CPOS, I_CW1, I_CB1, I_CW2, I_CB2, I_WOUT };

constexpr size_t OFF_WTIN  = 0;
constexpr size_t OFF_WTOUT = OFF_WTIN  + 4ull * D_IN_PAD * 1024 * 2;
constexpr size_t OFF_WTGLU = OFF_WTOUT + 4ull * 1024 * 1024 * 2;
constexpr size_t OFF_WTC1  = OFF_WTGLU + 4ull * 512 * 256 * 2;
constexpr size_t OFF_PROJ  = OFF_WTC1  + 4ull * 2 * 256 * 2048 * 2;
constexpr size_t OFF_MIX   = OFF_PROJ  + (size_t)NT * D_IN * 2;
constexpr size_t OFF_YACT  = OFF_MIX   + (size_t)NT * 1024 * 2;
constexpr size_t OFF_BCUM  = OFF_YACT  + (size_t)NT * 256 * 2;
constexpr size_t OFF_GKV   = OFF_BCUM  + (size_t)NT * 128 * 4;
constexpr size_t OFF_GDEC  = OFF_GKV   + 8ull * 256 * 2048 * 4;
constexpr size_t OFF_XC    = OFF_GDEC  + 8ull * 256 * 32 * 4;
constexpr size_t OFF_S5W   = OFF_XC    + 512ull * 1024 * 2 * 4;
constexpr size_t OFF_S5E   = OFF_S5W   + 16ull * 512 * 640 * 2;
constexpr size_t OFF_S5AL  = OFF_S5E   + 16ull * 128 * 512 * 2;
constexpr size_t OFF_CHID  = OFF_S5AL  + 1024ull * 2 * 4;
constexpr size_t OFF_KCMP  = OFF_CHID  + 2ull * 2048 * 256 * 4;
constexpr size_t OFF_VCMP  = OFF_KCMP  + 4ull * 512 * 64 * 2;
constexpr size_t OFF_VTG   = OFF_VCMP  + 4ull * 512 * 64 * 2;
constexpr size_t WS_END    = OFF_VTG   + 2ull * 4 * 128 * 4096 * 2;

struct Params {
    const float* in[25];
    float* out;
    char* ws;
};

constexpr int SMEM_BYTES = 54272;

DI int otid() { int t = threadIdx.x; asm volatile("" : "+v"(t)); return t; }
DI float wave_sum(float v) {
#pragma unroll
    for (int o = 32; o > 0; o >>= 1) v += __shfl_xor(v, o);
    return v;
}
DI float wave_max(float v) {
#pragma unroll
    for (int o = 32; o > 0; o >>= 1) v = fmaxf(v, __shfl_xor(v, o));
    return v;
}
DI float sigmoidf_(float x) { return 1.f / (1.f + __expf(-x)); }
DI float siluf_(float x) { return x / (1.f + __expf(-x)); }
DI float gelu_tanh(float x) {
    const float u = 0.7978845608028654f * (x + 0.044715f * x * x * x);
    return 0.5f * x * (1.f + tanhf(u));
}
DI float log_sigmoidf_(float x) { return fminf(x, 0.f) - log1pf(__expf(-fabsf(x))); }

template <class AL>
DI void gemm_mainloop(const int K, AL& al, const h16* __restrict__ Bt, const int ldb, f32x4 (&acc)[4][4], char* smem) {
    h16 (*As)[72] = (h16 (*)[72])smem;
    h16 (*Bs)[72] = (h16 (*)[72])(smem + 128 * 72 * 2);
    const int tid = otid(), lane = tid & 63, wid = tid >> 6, wr = wid >> 1, wc = wid & 1;
    const int lrow = tid >> 1, lcol = (tid & 1) * 32;
#pragma unroll
    for (int i = 0; i < 4; ++i)
#pragma unroll
        for (int j = 0; j < 4; ++j) acc[i][j] = (f32x4){0.f, 0.f, 0.f, 0.f};
    half8 ra[4], rb[4];
    al.load(lrow, lcol, ra);
    const h16* bp = Bt + (size_t)lrow * ldb + lcol;
#pragma unroll
    for (int q = 0; q < 4; ++q) rb[q] = *(const half8*)(bp + q * 8);
    for (int k0 = 0; k0 < K; k0 += 64) {
#pragma unroll
        for (int q = 0; q < 4; ++q) {
            *(half8*)&As[lrow][lcol + q * 8] = ra[q];
            *(half8*)&Bs[lrow][lcol + q * 8] = rb[q];
        }
        __syncthreads();
        if (k0 + 64 < K) {
            al.load(lrow, k0 + 64 + lcol, ra);
#pragma unroll
            for (int q = 0; q < 4; ++q) rb[q] = *(const half8*)(bp + k0 + 64 + q * 8);
        }
#pragma unroll
        for (int kk = 0; kk < 2; ++kk) {
            half8 af[4], bf[4];
#pragma unroll
            for (int i = 0; i < 4; ++i) af[i] = *(const half8*)&As[wr * 64 + i * 16 + (lane & 15)][kk * 32 + (lane >> 4) * 8];
#pragma unroll
            for (int j = 0; j < 4; ++j) bf[j] = *(const half8*)&Bs[wc * 64 + j * 16 + (lane & 15)][kk * 32 + (lane >> 4) * 8];
#pragma unroll
            for (int i = 0; i < 4; ++i)
#pragma unroll
                for (int j = 0; j < 4; ++j) acc[i][j] = __builtin_amdgcn_mfma_f32_16x16x32_f16(bf[j], af[i], acc[i][j], 0, 0, 0);
        }
        __syncthreads();
    }
}

struct XLoader {
    const float* x; float ss;
    DI void load(int row, int k, half8 (&r)[4]) {
        const float4* p = (const float4*)(x + (size_t)row * 1024 + k);
#pragma unroll
        for (int q = 0; q < 4; ++q) {
            const float4 a = p[2 * q], b = p[2 * q + 1];
            ss += a.x * a.x + a.y * a.y + a.z * a.z + a.w * a.w + b.x * b.x + b.y * b.y + b.z * b.z + b.w * b.w;
            r[q] = (half8){(h16)a.x, (h16)a.y, (h16)a.z, (h16)a.w, (h16)b.x, (h16)b.y, (h16)b.z, (h16)b.w};
        }
    }
};
struct HLoader {
    const h16* a; int ld;
    DI void load(int row, int k, half8 (&r)[4]) {
        const half8* p = (const half8*)(a + (size_t)row * ld + k);
#pragma unroll
        for (int q = 0; q < 4; ++q) r[q] = p[q];
    }
};
struct CmpLoader {
    const h16* proj; const float* pos; int j; int row0;
    DI void load(int row, int k, half8 (&r)[4]) {
        const int rr = row0 + row, bg = rr >> 9, i = rr & 511, b = bg >> 1, g = bg & 1;
        const int l = k >> 6, d = k & 63;
        int t = 16 * i + l; t = t > SEQ - 1 ? SEQ - 1 : t;
        const half8* p = (const half8*)(proj + ((size_t)b * SEQ + t) * D_IN + C_NKV + j * 128 + g * 64 + d);
        const float4* pp = (const float4*)(pos + l * 64 + d);
#pragma unroll
        for (int q = 0; q < 4; ++q) {
            const half8 v = p[q]; const float4 a = pp[2 * q], c = pp[2 * q + 1];
            r[q] = (half8){(h16)((float)v[0] + a.x), (h16)((float)v[1] + a.y), (h16)((float)v[2] + a.z), (h16)((float)v[3] + a.w),
                           (h16)((float)v[4] + c.x), (h16)((float)v[5] + c.y), (h16)((float)v[6] + c.z), (h16)((float)v[7] + c.w)};
        }
    }
};
struct S5ULoader {
    const h16* proj; const float* xin; int g; int row0;
    DI void load(int row, int k, half8 (&r)[4]) {
        const int ch = row0 + row;
        if (k < 512) {
            const int s0 = k >> 4;
            const half8* p0 = (const half8*)(proj + ((size_t)ch * 32 + s0) * D_IN + C_SU + g * 16);
            const half8* p1 = (const half8*)(proj + ((size_t)ch * 32 + s0 + 1) * D_IN + C_SU + g * 16);
            r[0] = p0[0]; r[1] = p0[1]; r[2] = p1[0]; r[3] = p1[1];
        } else {
            const float4* p = (const float4*)(xin + ((size_t)ch * 1024 + g * 64) * 2 + (k - 512));
#pragma unroll
            for (int q = 0; q < 4; ++q) {
                const float4 a = p[2 * q], b = p[2 * q + 1];
                r[q] = (half8){(h16)a.x, (h16)a.y, (h16)a.z, (h16)a.w, (h16)b.x, (h16)b.y, (h16)b.z, (h16)b.w};
            }
        }
    }
};

DI void transpose_tile(const float* __restrict__ src, int R, int C, h16* __restrict__ dst, int r0, int c0,
                       const float* __restrict__ rscale, float* tile) {
    const int tx = otid() & 31, ty = otid() >> 5;
    for (int yy = ty; yy < 32; yy += 8) {
        const int r = r0 + yy, c = c0 + tx;
        float v = (c < C) ? src[(size_t)r * C + c] : 0.f;
        if (rscale) v *= rscale[r];
        tile[yy * 33 + tx] = v;
    }
    __syncthreads();
    for (int yy = ty; yy < 32; yy += 8) {
        const int c = c0 + yy, r = r0 + tx;
        dst[(size_t)c * R + r] = (h16)tile[tx * 33 + yy];
    }
    __syncthreads();
}

DI int glu_perm_src(int np) {
    const int t = np >> 7, w = (np >> 6) & 1, j = (np >> 4) & 3, e = np & 15;
    const int c = t * 64 + w * 32 + (j >> 1) * 16 + e;
    return c + (j & 1) * 256;
}

DI void phase0(const Params& P, char* smem) {
    float* tile = (float*)smem;
    constexpr int N_WIN = 4 * 32 * 100, N_WOUT = 4 * 32 * 32, N_C1 = 8 * 64 * 8, N_GLU = 2048;
    const int total = N_WIN + N_WOUT + N_C1 + N_GLU;
    for (int w = blockIdx.x; w < total; w += gridDim.x) {
        if (w < N_WIN) {
            const int l = w / 3200, r = w % 3200, rt = r / 100, ct = r % 100;
            transpose_tile(P.in[I_WIN] + (size_t)l * 1024 * D_IN, 1024, D_IN, (h16*)(P.ws + OFF_WTIN) + (size_t)l * D_IN_PAD * 1024,
                           rt * 32, ct * 32, P.in[I_NORMG] + l * 1024, tile);
        } else if (w < N_WIN + N_WOUT) {
            const int v = w - N_WIN, l = v >> 10, r = v & 1023, rt = r >> 5, ct = r & 31;
            transpose_tile(P.in[I_WOUT] + (size_t)l * 1024 * 1024, 1024, 1024, (h16*)(P.ws + OFF_WTOUT) + (size_t)l * 1024 * 1024,
                           rt * 32, ct * 32, nullptr, tile);
        } else if (w < N_WIN + N_WOUT + N_C1) {
            const int v = w - N_WIN - N_WOUT, lj = v >> 9, r = v & 511, rt = r >> 3, ct = r & 7;
            transpose_tile(P.in[I_CW1] + (size_t)lj * 2048 * 256, 2048, 256, (h16*)(P.ws + OFF_WTC1) + (size_t)lj * 256 * 2048,
                           rt * 32, ct * 32, nullptr, tile);
        } else {
            const int v = w - N_WIN - N_WOUT - N_C1;
            const int idx = v * 256 + otid();
            const int l = idx >> 17, rem = idx & 131071, np = rem >> 8, k = rem & 255;
            ((h16*)(P.ws + OFF_WTGLU))[idx] = (h16)P.in[I_GLUW][((size_t)l * 256 + k) * 512 + glu_perm_src(np)];
        }
    }
}

DI void s5_build_item(const Params& P, int l, int item, char* smem) {
    float* apow = (float*)smem;
    float* bbar = apow + 64 * 33 * 2;
    float* cc   = bbar + 64 * 16 * 2;
    const int tid = otid();
    const int g = (item < 512) ? (item >> 5) : ((item - 512) >> 2);
    if (tid < 64) {
        const int p = tid;
        const double lre = fmin((double)P.in[I_LRE][(l * 16 + g) * 64 + p], -1e-4);
        const double lim = (double)P.in[I_LIM][(l * 16 + g) * 64 + p];
        const double dt = exp((double)P.in[I_LSTEP][l * 16 + g]);
        const double mag = exp(lre * dt);
        const double ar = mag * cos(lim * dt), ai = mag * sin(lim * dt);
        const double den = lre * lre + lim * lim;
        const double fr = ((ar - 1.0) * lre + ai * lim) / den;
        const double fi = (ai * lre - (ar - 1.0) * lim) / den;
        double pr = 1.0, pi = 0.0;
        for (int k = 0; k <= 32; ++k) {
            apow[(p * 33 + k) * 2] = (float)pr; apow[(p * 33 + k) * 2 + 1] = (float)pi;
            const double nr = pr * ar - pi * ai, ni = pr * ai + pi * ar; pr = nr; pi = ni;
        }
        for (int c = 0; c < 16; ++c) {
            const double br = (double)P.in[I_BRE][((size_t)(l * 16 + g) * 64 + p) * 16 + c];
            const double bi = (double)P.in[I_BIM][((size_t)(l * 16 + g) * 64 + p) * 16 + c];
            bbar[(p * 16 + c) * 2] = (float)(fr * br - fi * bi);
            bbar[(p * 16 + c) * 2 + 1] = (float)(fr * bi + fi * br);
        }
    }
    for (int e = tid; e < 1024; e += 256) {
        cc[e * 2] = P.in[I_CRE][(size_t)(l * 16 + g) * 1024 + e];
        cc[e * 2 + 1] = P.in[I_CIM][(size_t)(l * 16 + g) * 1024 + e];
    }
    __syncthreads();
    if (item < 512) {
        const int j = item & 31;
        h16* W = (h16*)(P.ws + OFF_S5W) + ((size_t)g * 512 + j * 16) * 640;
        for (int idx = tid; idx < 16 * 640; idx += 256) {
            const int c = idx / 640, k = idx % 640;
            float val = 0.f;
            if (k < 512) {
                const int s = k >> 4, c2 = k & 15, lag = j - s;
                if (lag >= 0) {
                    float a = 0.f;
                    for (int p = 0; p < 64; ++p) {
                        const float cr = cc[(c * 64 + p) * 2], ci = cc[(c * 64 + p) * 2 + 1];
                        const float xr = apow[(p * 33 + lag) * 2], xi = apow[(p * 33 + lag) * 2 + 1];
                        const float br = bbar[(p * 16 + c2) * 2], bi = bbar[(p * 16 + c2) * 2 + 1];
                        const float tr = cr * xr - ci * xi, ti = cr * xi + ci * xr;
                        a += tr * br - ti * bi;
                    }
                    val = a;
                }
            } else {
                const int p = (k - 512) >> 1;
                const float cr = cc[(c * 64 + p) * 2], ci = cc[(c * 64 + p) * 2 + 1];
                const float xr = apow[(p * 33 + j + 1) * 2], xi = apow[(p * 33 + j + 1) * 2 + 1];
                val = (k & 1) ? -(cr * xi + ci * xr) : (cr * xr - ci * xi);
            }
            W[(size_t)c * 640 + k] = (h16)val;
        }
    } else {
        const int pq = (item - 512) & 3;
        h16* E = (h16*)(P.ws + OFF_S5E) + ((size_t)g * 128 + pq * 32) * 512;
        for (int idx = tid; idx < 32 * 512; idx += 256) {
            const int nl = idx >> 9, k = idx & 511;
            const int p = pq * 16 + (nl >> 1), s = k >> 4, c2 = k & 15;
            const float xr = apow[(p * 33 + 31 - s) * 2], xi = apow[(p * 33 + 31 - s) * 2 + 1];
            const float br = bbar[(p * 16 + c2) * 2], bi = bbar[(p * 16 + c2) * 2 + 1];
            const float val = (nl & 1) ? (xr * bi + xi * br) : (xr * br - xi * bi);
            E[(size_t)nl * 512 + k] = (h16)val;
        }
        if (tid < 16) {
            const int p = pq * 16 + tid;
            float* AL = (float*)(P.ws + OFF_S5AL);
            AL[(g * 64 + p) * 2] = apow[(p * 33 + 32) * 2];
            AL[(g * 64 + p) * 2 + 1] = apow[(p * 33 + 32) * 2 + 1];
        }
    }
    __syncthreads();
}

DI void inproj_tile(const Params& P, int l, int tile, char* smem) {
    const int mt = tile / 25, nt = tile % 25;
    const float* xsrc = (l == 0) ? P.in[I_X] : P.out;
    XLoader al{xsrc + (size_t)mt * 128 * 1024, 0.f};
    f32x4 acc[4][4];
    gemm_mainloop(1024, al, (const h16*)(P.ws + OFF_WTIN) + ((size_t)l * D_IN_PAD + nt * 128) * 1024, 1024, acc, smem);
    float* rs = (float*)(smem + 2 * 128 * 72 * 2);
    const int tid = otid(), lane = tid & 63, wid = tid >> 6, wr = wid >> 1, wc = wid & 1;
    {
        const float tot = al.ss + __shfl_xor(al.ss, 1);
        if ((tid & 1) == 0) rs[tid >> 1] = rsqrtf(tot * (1.f / 1024.f) + 1e-6f);
    }
    __syncthreads();
    h16* proj = (h16*)(P.ws + OFF_PROJ);
#pragma unroll
    for (int i = 0; i < 4; ++i) {
        const int ml = wr * 64 + i * 16 + (lane & 15);
        const float r = rs[ml];
        const size_t row = (size_t)mt * 128 + ml;
#pragma unroll
        for (int j = 0; j < 4; ++j) {
            const int n = nt * 128 + wc * 64 + j * 16 + (lane >> 4) * 4;
            if (n < D_IN) {
                const f32x4 v = acc[i][j];
                *(half4*)(proj + row * D_IN + n) = (half4){(h16)(v[0] * r), (h16)(v[1] * r), (h16)(v[2] * r), (h16)(v[3] * r)};
            }
        }
    }
    __syncthreads();
}

DI void gla_kv_item(const Params& P, int l, int item, char* smem) {
    const int h = item & 3, cn = item >> 2;
    const size_t tok0 = (size_t)cn * 32;
    float* gl = (float*)smem;
    float* ke = gl + 32 * 33;
    float* vs = ke + 32 * 33;
    const h16* proj = (const h16*)(P.ws + OFF_PROJ);
    const int tid = otid(), i = tid >> 3, dq = (tid & 7) * 4, e0 = (tid & 7) * 8;
    {
        const half8* lp = (const half8*)(proj + (tok0 + i) * D_IN + C_GLR);
        const half8 l0 = lp[0], l1 = lp[1];
        float lr[16];
#pragma unroll
        for (int r = 0; r < 8; ++r) { lr[r] = (float)l0[r]; lr[8 + r] = (float)l1[r]; }
#pragma unroll
        for (int dd = 0; dd < 4; ++dd) {
            const int d = dq + dd;
            float x = P.in[I_GB2][l * 128 + h * 32 + d];
#pragma unroll
            for (int r = 0; r < 16; ++r) x += lr[r] * P.in[I_GW2][(l * 16 + r) * 128 + h * 32 + d];
            gl[i * 33 + d] = log_sigmoidf_(x) * (1.f / 16.f);
        }
    }
    __syncthreads();
    if (tid < 32) {
        float run = 0.f;
        float* bc = (float*)(P.ws + OFF_BCUM);
        for (int ii = 0; ii < 32; ++ii) {
            run += gl[ii * 33 + tid]; gl[ii * 33 + tid] = run;
            bc[(tok0 + ii) * 128 + h * 32 + tid] = run;
        }
    }
    __syncthreads();
    {
        const half4 kv4 = *(const half4*)(proj + (tok0 + i) * D_IN + C_GK + h * 32 + dq);
#pragma unroll
        for (int dd = 0; dd < 4; ++dd) {
            const int d = dq + dd;
            ke[i * 33 + d] = (float)kv4[dd] * __expf(gl[31 * 33 + d] - gl[i * 33 + d]);
        }
        const half8 v8 = *(const half8*)(proj + (tok0 + i) * D_IN + C_GV + h * 64 + e0);
#pragma unroll
        for (int e = 0; e < 8; ++e) vs[i * 64 + e0 + e] = (float)v8[e];
    }
    __syncthreads();
    {
        const int d = tid >> 3;
        float acc[8];
#pragma unroll
        for (int e = 0; e < 8; ++e) acc[e] = 0.f;
        for (int c = 0; c < 32; ++c) {
            const float kd = ke[c * 33 + d];
#pragma unroll
            for (int e = 0; e < 8; ++e) acc[e] += kd * vs[c * 64 + e0 + e];
        }
        const int b = cn >> 8, n = cn & 255, bh = b * 4 + h;
        float* kvp = (float*)(P.ws + OFF_GKV) + ((size_t)(bh * 256 + n) * 32 + d) * 64 + e0;
        *(float4*)kvp = (float4){acc[0], acc[1], acc[2], acc[3]};
        *(float4*)(kvp + 4) = (float4){acc[4], acc[5], acc[6], acc[7]};
        if (tid < 32) ((float*)(P.ws + OFF_GDEC))[(size_t)(bh * 256 + n) * 32 + tid] = __expf(gl[31 * 33 + tid]);
    }
    __syncthreads();
}

constexpr float QSCALE = 0.125f * 1.4426950408889634f;
DI void qknorm_item(const Params& P, int l, int item, char* smem) {
    const int tid = otid(), lane = tid & 63, w = tid >> 6;
    const int b = item >> 7, blk = item & 127;
    h16* projw = (h16*)(P.ws + OFF_PROJ);
    const float qn = P.in[I_NQN][l * 64 + lane] * QSCALE;
    const float kn1 = P.in[I_NKN][(l * 3 + 1) * 64 + lane], kn2 = P.in[I_NKN][(l * 3 + 2) * 64 + lane];
    for (int tt = 0; tt < 16; ++tt) {
        h16* row = projw + ((size_t)b * SEQ + blk * 64 + w * 16 + tt) * D_IN;
#pragma unroll
        for (int hd = 0; hd < 8; ++hd) {
            const float v = (float)row[C_NQ + hd * 64 + lane];
            const float ss = wave_sum(v * v);
            row[C_NQ + hd * 64 + lane] = (h16)(v * rsqrtf(ss * (1.f / 64.f) + 1e-6f) * qn);
        }
#pragma unroll
        for (int br = 1; br < 3; ++br) {
#pragma unroll
            for (int g = 0; g < 2; ++g) {
                const int col = C_NKV + (br * 2) * 128 + g * 64 + lane;
                const float v = (float)row[col];
                const float ss = wave_sum(v * v);
                row[col] = (h16)(v * rsqrtf(ss * (1.f / 64.f) + 1e-6f) * (br == 1 ? kn1 : kn2));
            }
        }
    }
    h16* vt = (h16*)smem;
    for (int c = 0; c < 4; ++c) {
        const int br = 1 + (c >> 1), g = c & 1;
        __syncthreads();
        {
            const int key = tid >> 2, ch = (tid & 3) * 16;
            const h16* srcp = projw + ((size_t)b * SEQ + blk * 64 + key) * D_IN + C_NKV + (br * 2 + 1) * 128 + g * 64 + ch;
            *(half8*)(vt + key * 72 + ch) = *(const half8*)srcp;
            *(half8*)(vt + key * 72 + ch + 8) = *(const half8*)(srcp + 8);
        }
        __syncthreads();
        {
            const int d = tid >> 2, k0 = (tid & 3) * 16;
            half8 o0, o1;
#pragma unroll
            for (int k = 0; k < 8; ++k) { o0[k] = vt[(k0 + k) * 72 + d]; o1[k] = vt[(k0 + 8 + k) * 72 + d]; }
            h16* dst = (h16*)(P.ws + OFF_VTG) + ((((size_t)(br - 1) * 4 + b * 2 + g) * 128 + blk) * 64 + d) * 64 + k0;
            *(half8*)dst = o0; *(half8*)(dst + 8) = o1;
        }
    }
    __syncthreads();
}

DI void cmp_gemm_tile(const Params& P, int l, int tile, char* smem) {
    const int j = tile >> 5, mt = (tile >> 1) & 15, nt = tile & 1;
    CmpLoader al{(const h16*)(P.ws + OFF_PROJ), P.in[I_CPOS] + (size_t)(l * 2 + j) * 32 * 64, j, mt * 128};
    f32x4 acc[4][4];
    gemm_mainloop(2048, al, (const h16*)(P.ws + OFF_WTC1) + ((size_t)(l * 2 + j) * 256 + nt * 128) * 2048, 2048, acc, smem);
    const int tid = otid(), lane = tid & 63, wid = tid >> 6, wr = wid >> 1, wc = wid & 1;
    float* hid = (float*)(P.ws + OFF_CHID) + (size_t)j * 2048 * 256;
    const float* b1 = P.in[I_CB1] + (l * 2 + j) * 256;
#pragma unroll
    for (int i = 0; i < 4; ++i) {
        const size_t row = (size_t)mt * 128 + wr * 64 + i * 16 + (lane & 15);
#pragma unroll
        for (int jj = 0; jj < 4; ++jj) {
            const int n = nt * 128 + wc * 64 + jj * 16 + (lane >> 4) * 4;
            const f32x4 v = acc[i][jj];
            const float4 bb = *(const float4*)(b1 + n);
            *(float4*)(hid + row * 256 + n) = (float4){gelu_tanh(v[0] + bb.x), gelu_tanh(v[1] + bb.y), gelu_tanh(v[2] + bb.z), gelu_tanh(v[3] + bb.w)};
        }
    }
}

DI void s5e_gemm_tile(const Params& P, int l, int tile, char* smem) {
    const int g = tile >> 2, mt = tile & 3;
    S5ULoader al{(const h16*)(P.ws + OFF_PROJ), nullptr, g, mt * 128};
    f32x4 acc[4][4];
    gemm_mainloop(512, al, (const h16*)(P.ws + OFF_S5E) + (size_t)g * 128 * 512, 512, acc, smem);
    const int tid = otid(), lane = tid & 63, wid = tid >> 6, wr = wid >> 1, wc = wid & 1;
    float* xc = (float*)(P.ws + OFF_XC);
#pragma unroll
    for (int i = 0; i < 4; ++i) {
        const size_t ch = (size_t)mt * 128 + wr * 64 + i * 16 + (lane & 15);
#pragma unroll
        for (int jj = 0; jj < 4; ++jj) {
            const int n = wc * 64 + jj * 16 + (lane >> 4) * 4;
            const f32x4 v = acc[i][jj];
            *(float4*)(xc + (ch * 1024 + g * 64) * 2 + n) = (float4){v[0], v[1], v[2], v[3]};
        }
    }
}

DI void gla_scan_item(const Params& P, int item) {
    const int idx = item * 256 + otid(), bh = idx >> 11, de = idx & 2047, d = de >> 6;
    float* kv = (float*)(P.ws + OFF_GKV) + (size_t)bh * 256 * 2048 + de;
    const float* dc = (const float*)(P.ws + OFF_GDEC) + (size_t)bh * 256 * 32 + d;
    float S = 0.f;
#pragma unroll 8
    for (int n = 0; n < 256; ++n) {
        const float kvv = kv[(size_t)n * 2048], dd = dc[n * 32];
        kv[(size_t)n * 2048] = S;
        S = dd * S + kvv;
    }
}
DI void s5_scan_item(const Params& P, int item) {
    const int idx = item * 256 + otid(), b = idx >> 10, s = idx & 1023;
    float2* xc = (float2*)(P.ws + OFF_XC) + (size_t)b * 256 * 1024 + s;
    const float2 a = ((const float2*)(P.ws + OFF_S5AL))[s];
    float xr = 0.f, xi = 0.f;
#pragma unroll 8
    for (int n = 0; n < 256; ++n) {
        const float2 c = xc[(size_t)n * 1024];
        xc[(size_t)n * 1024] = (float2){xr, xi};
        const float nr = a.x * xr - a.y * xi + c.x, ni = a.x * xi + a.y * xr + c.y;
        xr = nr; xi = ni;
    }
}
DI void cmp_l2_item(const Params& P, int l, int item) {
    const int tid = otid(), lane = tid & 63, w = tid >> 6;
    const int r4 = item * 4 + w, j = r4 >> 11, row = r4 & 2047;
    const float* hid = (const float*)(P.ws + OFF_CHID) + ((size_t)j * 2048 + row) * 256;
    const float* w2 = P.in[I_CW2] + (size_t)(l * 2 + j) * 256 * 64;
    float acc = P.in[I_CB2][(l * 2 + j) * 64 + lane];
    for (int n = 0; n < 256; ++n) acc += hid[n] * w2[n * 64 + lane];
    if (j == 0) {
        const float ss = wave_sum(acc * acc);
        acc = acc * rsqrtf(ss * (1.f / 64.f) + 1e-6f) * P.in[I_NKN][(l * 3 + 0) * 64 + lane];
        ((h16*)(P.ws + OFF_KCMP))[(size_t)row * 64 + lane] = (h16)acc;
    } else {
        const int bg = row >> 9, i = row & 511;
        ((h16*)(P.ws + OFF_VCMP))[(((size_t)bg * 8 + (i >> 6)) * 64 + lane) * 64 + (i & 63)] = (h16)acc;
    }
}

DI void gla_out_item(const Params& P, int l, int item, char* smem) {
    const int h = item & 3, cn = item >> 2;
    const size_t tok0 = (size_t)cn * 32;
    float* qe = (float*)smem;
    float* ke = qe + 32 * 33;
    float* scs = ke + 32 * 33;
    float* vs = scs + 32 * 33;
    float* sp = vs + 32 * 64;
    const h16* proj = (const h16*)(P.ws + OFF_PROJ);
    const int tid = otid(), i = tid >> 3, dq = (tid & 7) * 4, e0 = (tid & 7) * 8;
    const int b = cn >> 8, n = cn & 255, bh = b * 4 + h;
    {
        const float4 bc = *(const float4*)((const float*)(P.ws + OFF_BCUM) + (tok0 + i) * 128 + h * 32 + dq);
        const half4 q4 = *(const half4*)(proj + (tok0 + i) * D_IN + C_GQ + h * 32 + dq);
        const half4 k4 = *(const half4*)(proj + (tok0 + i) * D_IN + C_GK + h * 32 + dq);
        const float bcv[4] = {bc.x, bc.y, bc.z, bc.w};
#pragma unroll
        for (int dd = 0; dd < 4; ++dd) {
            qe[i * 33 + dq + dd] = (float)q4[dd] * 0.17677669529663687f * __expf(bcv[dd]);
            ke[i * 33 + dq + dd] = (float)k4[dd] * __expf(-bcv[dd]);
        }
        const half8 v8 = *(const half8*)(proj + (tok0 + i) * D_IN + C_GV + h * 64 + e0);
#pragma unroll
        for (int e = 0; e < 8; ++e) vs[i * 64 + e0 + e] = (float)v8[e];
        const float* spp = (const float*)(P.ws + OFF_GKV) + (size_t)(bh * 256 + n) * 2048 + tid * 8;
        const float4 s0 = *(const float4*)spp, s1 = *(const float4*)(spp + 4);
        *(float4*)(sp + tid * 8) = s0; *(float4*)(sp + tid * 8 + 4) = s1;
    }
    __syncthreads();
    {
        const int j0 = (tid & 7) * 4;
#pragma unroll
        for (int jj = 0; jj < 4; ++jj) {
            const int j = j0 + jj;
            float s = 0.f;
            if (j <= i) for (int d = 0; d < 32; ++d) s += qe[i * 33 + d] * ke[j * 33 + d];
            scs[i * 33 + j] = s;
        }
    }
    __syncthreads();
    {
        float acc[8];
#pragma unroll
        for (int e = 0; e < 8; ++e) acc[e] = 0.f;
        for (int j = 0; j < 32; ++j) {
            const float s = scs[i * 33 + j], qd = qe[i * 33 + j];
#pragma unroll
            for (int e = 0; e < 8; ++e) acc[e] += s * vs[j * 64 + e0 + e] + qd * sp[j * 64 + e0 + e];
        }
        float ss = 0.f;
#pragma unroll
        for (int e = 0; e < 8; ++e) ss += acc[e] * acc[e];
        ss += __shfl_xor(ss, 1); ss += __shfl_xor(ss, 2); ss += __shfl_xor(ss, 4);
        const float r = rsqrtf(ss * (1.f / 64.f) + 1e-6f);
        const half8 g8 = *(const half8*)(proj + (tok0 + i) * D_IN + C_GG + h * 64 + e0);
        half8 o;
#pragma unroll
        for (int e = 0; e < 8; ++e) o[e] = (h16)(acc[e] * r * P.in[I_GON][l * 64 + e0 + e] * siluf_((float)g8[e]));
        *(half8*)((h16*)(P.ws + OFF_MIX) + (tok0 + i) * 1024 + h * 64 + e0) = o;
    }
    __syncthreads();
}

DI void s5o_gemm_tile(const Params& P, int l, int tile, char* smem) {
    const int g = tile >> 4, mt = (tile >> 2) & 3, nt = tile & 3;
    S5ULoader al{(const h16*)(P.ws + OFF_PROJ), (const float*)(P.ws + OFF_XC), g, mt * 128};
    f32x4 acc[4][4];
    gemm_mainloop(640, al, (const h16*)(P.ws + OFF_S5W) + ((size_t)g * 512 + nt * 128) * 640, 640, acc, smem);
    const int tid = otid(), lane = tid & 63, wid = tid >> 6, wr = wid >> 1, wc = wid & 1;
    const h16* proj = (const h16*)(P.ws + OFF_PROJ);
    h16* yact = (h16*)(P.ws + OFF_YACT);
#pragma unroll
    for (int i = 0; i < 4; ++i) {
        const size_t ch = (size_t)mt * 128 + wr * 64 + i * 16 + (lane & 15);
#pragma unroll
        for (int jj = 0; jj < 4; ++jj) {
            const int n = nt * 128 + wc * 64 + jj * 16 + (lane >> 4) * 4;
            const int j = n >> 4, c = n & 15;
            const size_t tok = ch * 32 + j;
            const half4 u4 = *(const half4*)(proj + tok * D_IN + C_SU + g * 16 + c);
            const float4 dd = *(const float4*)(P.in[I_SD] + (l * 16 + g) * 16 + c);
            const f32x4 v = acc[i][jj];
            half4 o;
            o[0] = (h16)gelu_tanh(v[0] + dd.x * (float)u4[0]);
            o[1] = (h16)gelu_tanh(v[1] + dd.y * (float)u4[1]);
            o[2] = (h16)gelu_tanh(v[2] + dd.z * (float)u4[2]);
            o[3] = (h16)gelu_tanh(v[3] + dd.w * (float)u4[3]);
            *(half4*)(yact + tok * 256 + g * 16 + c) = o;
        }
    }
}

#define MFMA32(a, b, c) __builtin_amdgcn_mfma_f32_32x32x16_f16((a), (b), (c), 0, 0, 0)
constexpr float NEGS = -1e30f;
DI float ex2(float x) { return __builtin_amdgcn_exp2f(x); }
DI void tile_ld(const h16* __restrict__ src, int ld, int tid, half8& r0, half8& r1) {
    const h16* p = src + (size_t)(tid >> 2) * ld + (tid & 3) * 16;
    r0 = *(const half8*)p; r1 = *(const half8*)(p + 8);
}
DI void tile_st(h16* dst, int tid, const half8& r0, const half8& r1) {
    h16* p = dst + (tid >> 2) * 72 + (tid & 3) * 16;
    *(half8*)p = r0; *(half8*)(p + 8) = r1;
}
DI void qk_tile(const h16* Kt, const half8 (&qf)[4], f32x16 (&s)[2], int lane) {
    const int r = lane & 31, h = lane >> 5;
#pragma unroll
    for (int kt = 0; kt < 2; ++kt) {
#pragma unroll
        for (int e = 0; e < 16; ++e) s[kt][e] = 0.f;
#pragma unroll
        for (int ks = 0; ks < 4; ++ks) {
            const half8 a = *(const half8*)(Kt + (32 * kt + r) * 72 + 16 * ks + 8 * h);
            s[kt] = MFMA32(a, qf[ks], s[kt]);
        }
    }
}
template <int S> DI half8 pack8(const f32x16& x) {
    return (half8){(h16)x[8 * S], (h16)x[8 * S + 1], (h16)x[8 * S + 2], (h16)x[8 * S + 3], (h16)x[8 * S + 4], (h16)x[8 * S + 5], (h16)x[8 * S + 6], (h16)x[8 * S + 7]};
}
DI half8 ld_vfrag(const h16* vp) {
    const half4 lo = *(const half4*)vp, hi = *(const half4*)(vp + 8);
    return (half8){lo[0], lo[1], lo[2], lo[3], hi[0], hi[1], hi[2], hi[3]};
}
DI void pv_tile(const h16* Vt, const f32x16 (&p)[2], f32x16 (&o)[2], int lane) {
    const int r = lane & 31, h = lane >> 5;
#pragma unroll
    for (int kt = 0; kt < 2; ++kt) {
        const half8 pb0 = pack8<0>(p[kt]), pb1 = pack8<1>(p[kt]);
#pragma unroll
        for (int dt = 0; dt < 2; ++dt) {
            const h16* vp = Vt + (32 * dt + r) * 72 + 32 * kt + 4 * h;
            o[dt] = MFMA32(ld_vfrag(vp), pb0, o[dt]);
            o[dt] = MFMA32(ld_vfrag(vp + 16), pb1, o[dt]);
        }
    }
}
DI float rowmax32(const f32x16 (&s)[2]) {
    float mx = s[0][0];
#pragma unroll
    for (int e = 1; e < 16; ++e) mx = fmaxf(mx, s[0][e]);
#pragma unroll
    for (int e = 0; e < 16; ++e) mx = fmaxf(mx, s[1][e]);
    return fmaxf(mx, __shfl_xor(mx, 32));
}
DI void sm_online(f32x16 (&s)[2], float& m, float& l, f32x16 (&o)[2]) {
    const float mn = fmaxf(m, rowmax32(s)), alpha = ex2(m - mn);
    float rs = 0.f;
#pragma unroll
    for (int kt = 0; kt < 2; ++kt)
#pragma unroll
        for (int e = 0; e < 16; ++e) { const float p = ex2(s[kt][e] - mn); s[kt][e] = p; rs += p; }
    rs += __shfl_xor(rs, 32);
    l = l * alpha + rs; m = mn;
    o[0] *= alpha; o[1] *= alpha;
}

DI void nsa_unit(const Params& P, int l, int bg, int c32, char* smem) {
    const int tid = otid(), lane = tid & 63, w = tid >> 6, r = lane & 31, h = lane >> 5;
    const int b = bg >> 1, g = bg & 1, t0 = c32 * 32, cur = c32 >> 1;
    const int tokl = w * 8 + (r >> 2), head = r & 3, t = t0 + tokl;
    const size_t tokg = (size_t)b * SEQ + t;
    h16* KT = (h16*)smem;
    h16* VT = KT + 2 * 64 * 72;
    float* IMP = (float*)(smem + 36864);
    unsigned* SELM = (unsigned*)(smem + 36864 + 16384);
    const h16* proj = (const h16*)(P.ws + OFF_PROJ);
    const int ghead = g * 4 + head;

    half8 qf[4];
    {
        const h16* qp = proj + tokg * D_IN + C_NQ + ghead * 64 + 8 * h;
#pragma unroll
        for (int ks = 0; ks < 4; ++ks) qf[ks] = *(const half8*)(qp + 16 * ks);
    }
    float g0, g1, g2;
    {
        const h16* gp = proj + tokg * D_IN + C_NGL + ghead * 3;
        const float* gb = P.in[I_NGB] + l * 24 + ghead * 3;
        g0 = sigmoidf_((float)gp[0] + gb[0]); g1 = sigmoidf_((float)gp[1] + gb[1]); g2 = sigmoidf_((float)gp[2] + gb[2]);
    }
    for (int i = tid; i < 32 * 128; i += 256) IMP[i] = 0.f;

    f32x16 oacc[2];
#pragma unroll
    for (int e = 0; e < 16; ++e) { oacc[0][e] = 0.f; oacc[1][e] = 0.f; }

    half8 kr0, kr1, vr0, vr1;
    {
        const int nvt = 2 * c32 + 1;
        const int nvr = (t >= 31) ? ((t - 31) >> 4) + 1 : 0;
        const int ntile = (nvt + 63) >> 6;
        const h16* kcg = (const h16*)(P.ws + OFF_KCMP) + (size_t)bg * 512 * 64;
        const h16* vcg = (const h16*)(P.ws + OFF_VCMP) + (size_t)bg * 8 * 4096;
        float m = -1e20f, lsum = 0.f;
        tile_ld(kcg, 64, tid, kr0, kr1);
        __syncthreads();
        tile_st(KT, tid, kr0, kr1);
        __syncthreads();
        for (int j = 0; j < ntile; ++j) {
            const int buf = j & 1;
            if (j + 1 < ntile) tile_ld(kcg + (size_t)(j + 1) * 4096, 64, tid, kr0, kr1);
            f32x16 s[2];
            qk_tile(KT + buf * 4608, qf, s, lane);
#pragma unroll
            for (int kt = 0; kt < 2; ++kt)
#pragma unroll
                for (int e = 0; e < 16; ++e) {
                    const int key = 64 * j + 32 * kt + 8 * (e >> 2) + 4 * h + (e & 3);
                    if (key >= nvr) s[kt][e] = NEGS;
                }
            const float mn = fmaxf(m, rowmax32(s)), alpha = ex2(m - mn);
            float rs = 0.f;
#pragma unroll
            for (int kt = 0; kt < 2; ++kt)
#pragma unroll
                for (int e = 0; e < 16; ++e) rs += ex2(s[kt][e] - mn);
            rs += __shfl_xor(rs, 32);
            lsum = lsum * alpha + rs; m = mn;
            if (j + 1 < ntile) tile_st(KT + (buf ^ 1) * 4608, tid, kr0, kr1);
            __syncthreads();
        }
        const float invl = lsum > 0.f ? 1.f / lsum : 0.f;
        f32x16 o[2];
#pragma unroll
        for (int e = 0; e < 16; ++e) { o[0][e] = 0.f; o[1][e] = 0.f; }
        tile_ld(kcg, 64, tid, kr0, kr1);
        tile_ld(vcg, 64, tid, vr0, vr1);
        tile_st(KT, tid, kr0, kr1);
        tile_st(VT, tid, vr0, vr1);
        __syncthreads();
        for (int j = 0; j < ntile; ++j) {
            const int buf = j & 1;
            if (j + 1 < ntile) {
                tile_ld(kcg + (size_t)(j + 1) * 4096, 64, tid, kr0, kr1);
                tile_ld(vcg + (size_t)(j + 1) * 4096, 64, tid, vr0, vr1);
            }
            f32x16 s[2];
            qk_tile(KT + buf * 4608, qf, s, lane);
#pragma unroll
            for (int kt = 0; kt < 2; ++kt)
#pragma unroll
                for (int e = 0; e < 16; ++e) {
                    const int key = 64 * j + 32 * kt + 8 * (e >> 2) + 4 * h + (e & 3);
                    s[kt][e] = (key < nvr) ? ex2(s[kt][e] - m) * invl : 0.f;
                }
            if (cur >= 16) {
#pragma unroll
                for (int kt = 0; kt < 2; ++kt)
#pragma unroll
                    for (int g4 = 0; g4 < 4; ++g4) {
                        float G = (s[kt][4 * g4] + s[kt][4 * g4 + 1]) + (s[kt][4 * g4 + 2] + s[kt][4 * g4 + 3]);
                        float L = s[kt][4 * g4 + 3];
                        G += __shfl_xor(G, 1); G += __shfl_xor(G, 2);
                        L += __shfl_xor(L, 1); L += __shfl_xor(L, 2);
                        if (head == 0) {
                            const int sb = 16 * j + 8 * kt + 2 * g4 + h;
                            atomicAdd(&IMP[tokl * 128 + sb], G);
                            if (sb + 1 < 128) atomicAdd(&IMP[tokl * 128 + sb + 1], L);
                        }
                    }
            }
            pv_tile(VT + buf * 4608, s, o, lane);
            if (j + 1 < ntile) {
                tile_st(KT + (buf ^ 1) * 4608, tid, kr0, kr1);
                tile_st(VT + (buf ^ 1) * 4608, tid, vr0, vr1);
            }
            __syncthreads();
        }
        oacc[0] = o[0] * g0; oacc[1] = o[1] * g0;
    }
    {
        const int tl = lane >> 3, sub = lane & 7;
        unsigned bits = 0;
        if (cur >= 16) {
            const float* ip = IMP + (w * 8 + tl) * 128 + sub * 16;
            unsigned u[16];
#pragma unroll
            for (int i = 0; i < 16; ++i) {
                const int s = sub * 16 + i;
                u[i] = (s >= 1 && s <= cur - 2) ? (__float_as_uint(ip[i]) + 1u) : 0u;
            }
            unsigned prefix = 0;
            for (int bit = 30; bit >= 0; --bit) {
                const unsigned cand = prefix | (1u << bit);
                int cnt = 0;
#pragma unroll
                for (int i = 0; i < 16; ++i) cnt += (u[i] >= cand) ? 1 : 0;
                cnt += __shfl_xor(cnt, 1); cnt += __shfl_xor(cnt, 2); cnt += __shfl_xor(cnt, 4);
                if (cnt >= 13) prefix = cand;
            }
            int cgt = 0, ceq = 0;
#pragma unroll
            for (int i = 0; i < 16; ++i) { cgt += (u[i] > prefix) ? 1 : 0; ceq += (u[i] == prefix) ? 1 : 0; }
            cgt += __shfl_xor(cgt, 1); cgt += __shfl_xor(cgt, 2); cgt += __shfl_xor(cgt, 4);
            int inc = ceq;
            { const int v = __shfl_up(inc, 1); if (sub >= 1) inc += v; }
            { const int v = __shfl_up(inc, 2); if (sub >= 2) inc += v; }
            { const int v = __shfl_up(inc, 4); if (sub >= 4) inc += v; }
            int run = inc - ceq;
            const int need = 13 - cgt;
#pragma unroll
            for (int i = 0; i < 16; ++i) {
                const int s = sub * 16 + i;
                bool sel = u[i] > prefix;
                if (u[i] == prefix) { sel = run < need; ++run; }
                if (s == 0 || s == cur || s == cur - 1) sel = true;
                bits |= (sel ? 1u : 0u) << i;
            }
        } else {
#pragma unroll
            for (int i = 0; i < 16; ++i) bits |= ((sub * 16 + i <= cur) ? 1u : 0u) << i;
        }
        unsigned wv = bits << ((sub & 1) * 16);
        wv |= __shfl_xor(wv, 1);
        if ((sub & 1) == 0) SELM[(w * 8 + tl) * 4 + (sub >> 1)] = wv;
    }
    __syncthreads();
    unsigned selw[4];
#pragma unroll
    for (int i = 0; i < 4; ++i) selw[i] = SELM[tokl * 4 + i];

#pragma unroll 1
    for (int br = 0; br < 2; ++br) {
        const int j0 = (br == 0) ? 0 : (cur - 8 > 0 ? cur - 8 : 0);
        const int nst = cur - j0 + 1;
        const h16* kg = proj + ((size_t)b * SEQ + (size_t)j0 * 64) * D_IN + C_NKV + (br == 0 ? 256 : 512) + g * 64;
        const h16* vg = (const h16*)(P.ws + OFF_VTG) + (((size_t)br * 4 + bg) * 128 + j0) * 4096;
        float m = -1e20f, lsum = 0.f;
        f32x16 o[2];
#pragma unroll
        for (int e = 0; e < 16; ++e) { o[0][e] = 0.f; o[1][e] = 0.f; }
        tile_ld(kg, D_IN, tid, kr0, kr1);
        tile_ld(vg, 64, tid, vr0, vr1);
        tile_st(KT, tid, kr0, kr1);
        tile_st(VT, tid, vr0, vr1);
        __syncthreads();
        for (int jj = 0; jj < nst; ++jj) {
            const int buf = jj & 1, j = j0 + jj;
            if (jj + 1 < nst) {
                tile_ld(kg + (size_t)(jj + 1) * 64 * D_IN, D_IN, tid, kr0, kr1);
                tile_ld(vg + (size_t)(jj + 1) * 4096, 64, tid, vr0, vr1);
            }
            f32x16 s[2];
            qk_tile(KT + buf * 4608, qf, s, lane);
            if (br == 0) {
                const bool sel = (selw[j >> 5] >> (j & 31)) & 1u;
                if (!sel) {
#pragma unroll
                    for (int e = 0; e < 16; ++e) { s[0][e] = NEGS; s[1][e] = NEGS; }
                }
            }
            if (j == cur || (br == 1 && j == cur - 8)) {
#pragma unroll
                for (int kt = 0; kt < 2; ++kt)
#pragma unroll
                    for (int e = 0; e < 16; ++e) {
                        const int key = 64 * j + 32 * kt + 8 * (e >> 2) + 4 * h + (e & 3);
                        const bool ok = (key <= t) && (br == 0 || key > t - 512);
                        if (!ok) s[kt][e] = NEGS;
                    }
            }
            sm_online(s, m, lsum, o);
            pv_tile(VT + buf * 4608, s, o, lane);
            if (jj + 1 < nst) {
                tile_st(KT + (buf ^ 1) * 4608, tid, kr0, kr1);
                tile_st(VT + (buf ^ 1) * 4608, tid, vr0, vr1);
            }
            __syncthreads();
        }
        const float sc = (br == 0 ? g1 : g2) / lsum;
        oacc[0] += o[0] * sc; oacc[1] += o[1] * sc;
    }
    {
        h16* mixp = (h16*)(P.ws + OFF_MIX) + tokg * 1024 + 512 + ghead * 64;
        const h16* ngp = proj + tokg * D_IN + C_NG + ghead * 64;
#pragma unroll
        for (int dt = 0; dt < 2; ++dt)
#pragma unroll
            for (int g4 = 0; g4 < 4; ++g4) {
                const int d0 = 32 * dt + 8 * g4 + 4 * h;
                const half4 ng = *(const half4*)(ngp + d0);
                half4 ov;
#pragma unroll
                for (int e = 0; e < 4; ++e) ov[e] = (h16)(oacc[dt][4 * g4 + e] * siluf_((float)ng[e]));
                *(half4*)(mixp + d0) = ov;
            }
    }
    __syncthreads();
}

DI void glu_tile(const Params& P, int l, int tile, char* smem) {
    const int mt = tile >> 2, nt = tile & 3;
    HLoader al{(const h16*)(P.ws + OFF_YACT) + (size_t)mt * 128 * 256, 256};
    f32x4 acc[4][4];
    gemm_mainloop(256, al, (const h16*)(P.ws + OFF_WTGLU) + ((size_t)l * 512 + nt * 128) * 256, 256, acc, smem);
    const int tid = otid(), lane = tid & 63, wid = tid >> 6, wr = wid >> 1, wc = wid & 1;
    const h16* proj = (const h16*)(P.ws + OFF_PROJ);
    h16* mix = (h16*)(P.ws + OFF_MIX);
    const float* gb = P.in[I_GLUB] + l * 512;
#pragma unroll
    for (int i = 0; i < 4; ++i) {
        const size_t tok = (size_t)mt * 128 + wr * 64 + i * 16 + (lane & 15);
#pragma unroll
        for (int pj = 0; pj < 2; ++pj) {
            const int c = nt * 64 + wc * 32 + pj * 16 + (lane >> 4) * 4;
            const f32x4 z1 = acc[i][2 * pj], z2 = acc[i][2 * pj + 1];
            const float4 b1 = *(const float4*)(gb + c), b2 = *(const float4*)(gb + 256 + c);
            const half4 g4 = *(const half4*)(proj + tok * D_IN + C_SG + c);
            half4 o;
            o[0] = (h16)((z1[0] + b1.x) * sigmoidf_(z2[0] + b2.x) * siluf_((float)g4[0]));
            o[1] = (h16)((z1[1] + b1.y) * sigmoidf_(z2[1] + b2.y) * siluf_((float)g4[1]));
            o[2] = (h16)((z1[2] + b1.z) * sigmoidf_(z2[2] + b2.z) * siluf_((float)g4[2]));
            o[3] = (h16)((z1[3] + b1.w) * sigmoidf_(z2[3] + b2.w) * siluf_((float)g4[3]));
            *(half4*)(mix + tok * 1024 + 256 + c) = o;
        }
    }
}

DI void outproj_tile(const Params& P, int l, int tile, char* smem) {
    const int mt = tile >> 3, nt = tile & 7;
    HLoader al{(const h16*)(P.ws + OFF_MIX) + (size_t)mt * 128 * 1024, 1024};
    f32x4 acc[4][4];
    gemm_mainloop(1024, al, (const h16*)(P.ws + OFF_WTOUT) + ((size_t)l * 1024 + nt * 128) * 1024, 1024, acc, smem);
    const int tid = otid(), lane = tid & 63, wid = tid >> 6, wr = wid >> 1, wc = wid & 1;
    const float* xin = (l == 0) ? P.in[I_X] : P.out;
#pragma unroll
    for (int i = 0; i < 4; ++i) {
        const size_t row = (size_t)mt * 128 + wr * 64 + i * 16 + (lane & 15);
#pragma unroll
        for (int jj = 0; jj < 4; ++jj) {
            const int n = nt * 128 + wc * 64 + jj * 16 + (lane >> 4) * 4;
            const f32x4 v = acc[i][jj];
            const float4 xo = *(const float4*)(xin + row * 1024 + n);
            *(float4*)(P.out + row * 1024 + n) = (float4){xo.x + v[0], xo.y + v[1], xo.z + v[2], xo.w + v[3]};
        }
    }
}

__global__ void __launch_bounds__(NTHREADS, 2) fwd_megakernel(Params P) {
    __shared__ __attribute__((aligned(16))) char smem[SMEM_BYTES];
    cg::grid_group grid = cg::this_grid();
    const int G = gridDim.x, bid = blockIdx.x;

    phase0(P, smem);
    grid.sync();

#pragma unroll 1
    for (int l = 0; l < DEPTH; ++l) {
#pragma unroll 1
        for (int w = bid; w < 3200 + 576; w += G) {
            if (w < 3200) inproj_tile(P, l, w, smem);
            else s5_build_item(P, l, w - 3200, smem);
        }
        grid.sync();
#pragma unroll 1
        for (int w = bid; w < 64 + 64 + 2048 + 256; w += G) {
            if (w < 64) cmp_gemm_tile(P, l, w, smem);
            else if (w < 128) s5e_gemm_tile(P, l, w - 64, smem);
            else if (w < 128 + 2048) gla_kv_item(P, l, w - 128, smem);
            else qknorm_item(P, l, w - 128 - 2048, smem);
        }
        grid.sync();
#pragma unroll 1
        for (int w = bid; w < 64 + 8 + 1024; w += G) {
            if (w < 64) gla_scan_item(P, w);
            else if (w < 72) s5_scan_item(P, w - 64);
            else cmp_l2_item(P, l, w - 72);
        }
        grid.sync();
#pragma unroll 1
        for (int w = bid; w < 512 + 256 + 2048; w += G) {
            if (w < 512) {
                const int bg = w & 3, q = w >> 2;
                nsa_unit(P, l, bg, 255 - q, smem);
                nsa_unit(P, l, bg, q, smem);
            } else if (w < 512 + 256) s5o_gemm_tile(P, l, w - 512, smem);
            else gla_out_item(P, l, w - 512 - 256, smem);
        }
        grid.sync();
#pragma unroll 1
        for (int w = bid; w < 512; w += G) glu_tile(P, l, w, smem);
        grid.sync();
#pragma unroll 1
        for (int w = bid; w < 1024; w += G) outproj_tile(P, l, w, smem);
        grid.sync();
    }
}

extern "C" void kernel_launch(void* const* d_in, const int* in_sizes, int n_in, void* d_out, int out_size, void* d_ws,
                              size_t ws_size, hipStream_t stream) {
    static int grid_blocks = 0;
    if (!grid_blocks) {
        int dev = 0, cus = 0, per_cu = 0;
        hipGetDevice(&dev);
        hipDeviceGetAttribute(&cus, hipDeviceAttributeMultiprocessorCount, dev);
        hipOccupancyMaxActiveBlocksPerMultiprocessor(&per_cu, fwd_megakernel, NTHREADS, 0);
        if (per_cu < 1) per_cu = 1;
        if (per_cu > 2) per_cu = 2;
        grid_blocks = cus * per_cu;
        if (ws_size < WS_END) fprintf(stderr, "kernel_launch: workspace too small: %zu < %zu\n", ws_size, (size_t)WS_END);
    }
    Params p{};
    for (int i = 0; i < 25; ++i) p.in[i] = (const float*)d_in[i];
    p.out = (float*)d_out;
    p.ws = (char*)d_ws;
    void* args[] = {&p};
    hipError_t e = hipLaunchCooperativeKernel((const void*)fwd_megakernel, dim3(grid_blocks), dim3(NTHREADS), args, 0, stream);
    if (e != hipSuccess) fprintf(stderr, "cooperative launch failed: %s (grid %d)\n", hipGetErrorString(e), grid_blocks);
}
```

```cpp
#include <hip/hip_runtime.h>
#include <hip/hip_cooperative_groups.h>
#include <cstdio>
#include <cstdint>
namespace cg = cooperative_groups;

typedef _Float16 h16;
typedef _Float16 half8 __attribute__((ext_vector_type(8)));
typedef _Float16 half4 __attribute__((ext_vector_type(4)));
typedef float f32x4 __attribute__((ext_vector_type(4)));
typedef float f32x16 __attribute__((ext_vector_type(16)));

#define DI __device__ __forceinline__

constexpr int D_MODEL = 1024, BATCH = 2, SEQ = 8192, DEPTH = 4, NT = BATCH * SEQ;
constexpr int D_IN = 3112, D_IN_PAD = 3200;
constexpr int C_NQ = 0, C_NKV = 512, C_NG = 1280, C_GQ = 1792, C_GK = 1920, C_GV = 2048, C_GG = 2304, C_SU = 2560, C_SG = 2816,
              C_GLR = 3072, C_NGL = 3088;
__host__ __device__ constexpr int map_col(int c) {
    return c < 128 ? C_GQ + c : c < 256 ? C_GK + (c - 128) : c < 512 ? C_GV + (c - 256) : c < 528 ? C_GLR + (c - 512)
         : c < 784 ? C_GG + (c - 528) : c < 1040 ? C_SU + (c - 784) : c < 1296 ? C_SG + (c - 1040) : c < 1808 ? C_NQ + (c - 1296)
         : c < 2576 ? C_NKV + (c - 1808) : c < 2600 ? C_NGL + (c - 2576) : c < 3112 ? C_NG + (c - 2600) : c;
}
constexpr int NTHREADS = 256;
constexpr float QSCALE = 0.125f * 1.4426950408889634f;

enum { I_X = 0, I_NORMG, I_WIN, I_GW2, I_GB2, I_GON, I_LRE, I_LIM, I_LSTEP, I_BRE, I_BIM, I_CRE, I_CIM, I_SD, I_GLUW, I_GLUB,
       I_NGB, I_NQN, I_NKN, I_CPOS, I_CW1, I_CB1, I_CW2, I_CB2, I_WOUT };

constexpr size_t OFF_WTIN  = 0;
constexpr size_t OFF_WTOUT = OFF_WTIN  + 4ull * D_IN_PAD * 1024 * 2;
constexpr size_t OFF_WTGLU = OFF_WTOUT + 4ull * 1024 * 1024 * 2;
constexpr size_t OFF_WTC1  = OFF_WTGLU + 4ull * 512 * 256 * 2;
constexpr size_t OFF_PROJ  = OFF_WTC1  + 4ull * 2 * 256 * 2048 * 2;
constexpr size_t OFF_MIX   = OFF_PROJ  + (size_t)NT * D_IN * 2;
constexpr size_t OFF_YACT  = OFF_MIX   + (size_t)NT * 1024 * 2;
constexpr size_t OFF_XH    = OFF_YACT;
constexpr size_t OFF_BCUM  = OFF_YACT  + (size_t)NT * 256 * 2;
constexpr size_t OFF_GKV   = OFF_BCUM  + (size_t)NT * 128 * 4;
constexpr size_t OFF_GDEC  = OFF_GKV   + 8ull * 256 * 2048 * 4;
static_assert(OFF_GDEC - OFF_XH >= (size_t)NT * 1024 * 2, "XH alias region too small");
constexpr size_t OFF_XC    = OFF_GDEC  + 8ull * 256 * 32 * 4;
constexpr size_t OFF_S5W   = OFF_XC    + 512ull * 1024 * 2 * 4;
constexpr size_t OFF_S5E   = OFF_S5W   + 16ull * 512 * 640 * 2;
constexpr size_t OFF_S5AL  = OFF_S5E   + 16ull * 128 * 512 * 2;
constexpr size_t OFF_CHID  = OFF_S5AL  + 1024ull * 2 * 4;
constexpr size_t OFF_KCMP  = OFF_CHID  + 2ull * 2048 * 256 * 4;
constexpr size_t OFF_VCMP  = OFF_KCMP  + 4ull * 512 * 64 * 2;
constexpr size_t OFF_VTG   = OFF_VCMP  + 4ull * 512 * 64 * 2;
constexpr size_t OFF_BAR   = OFF_VTG   + 2ull * 4 * 128 * 4096 * 2;
constexpr size_t WS_END    = OFF_BAR   + 16384;

struct Params {
    const float* in[25];
    float* out;
    char* ws;
};

constexpr int SMEM_MAIN = 65536;
constexpr int SMEM_BYTES = SMEM_MAIN + 16;

DI int otid() { int t = threadIdx.x; asm volatile("" : "+v"(t)); return t; }
DI float wave_sum(float v) {
#pragma unroll
    for (int o = 32; o > 0; o >>= 1) v += __shfl_xor(v, o);
    return v;
}
DI float wave_max(float v) {
#pragma unroll
    for (int o = 32; o > 0; o >>= 1) v = fmaxf(v, __shfl_xor(v, o));
    return v;
}
DI float sigmoidf_(float x) { return 1.f / (1.f + __expf(-x)); }
DI float siluf_(float x) { return x / (1.f + __expf(-x)); }
DI float gelu_tanh(float x) {
    const float u = 0.7978845608028654f * (x + 0.044715f * x * x * x);
    return 0.5f * x * (1.f + tanhf(u));
}
DI float log_sigmoidf_(float x) { return fminf(x, 0.f) - log1pf(__expf(-fabsf(x))); }

template <class AL>
DI void gemm_mainloop(const int K, AL& al, const h16* __restrict__ Bt, const int ldb, f32x4 (&acc)[4][4], char* smem) {
    h16 (*As)[72] = (h16 (*)[72])smem;
    h16 (*Bs)[72] = (h16 (*)[72])(smem + 128 * 72 * 2);
    const int tid = otid(), lane = tid & 63, wid = tid >> 6, wr = wid >> 1, wc = wid & 1;
    const int lrow = tid >> 1, lcol = (tid & 1) * 32;
#pragma unroll
    for (int i = 0; i < 4; ++i)
#pragma unroll
        for (int j = 0; j < 4; ++j) acc[i][j] = (f32x4){0.f, 0.f, 0.f, 0.f};
    half8 ra[4], rb[4];
    al.load(lrow, lcol, ra);
    const h16* bp = Bt + (size_t)lrow * ldb + lcol;
#pragma unroll
    for (int q = 0; q < 4; ++q) rb[q] = *(const half8*)(bp + q * 8);
    for (int k0 = 0; k0 < K; k0 += 64) {
#pragma unroll
        for (int q = 0; q < 4; ++q) {
            *(half8*)&As[lrow][lcol + q * 8] = ra[q];
            *(half8*)&Bs[lrow][lcol + q * 8] = rb[q];
        }
        __syncthreads();
        if (k0 + 64 < K) {
            al.load(lrow, k0 + 64 + lcol, ra);
#pragma unroll
            for (int q = 0; q < 4; ++q) rb[q] = *(const half8*)(bp + k0 + 64 + q * 8);
        }
#pragma unroll
        for (int kk = 0; kk < 2; ++kk) {
            half8 af[4], bf[4];
#pragma unroll
            for (int i = 0; i < 4; ++i) af[i] = *(const half8*)&As[wr * 64 + i * 16 + (lane & 15)][kk * 32 + (lane >> 4) * 8];
#pragma unroll
            for (int j = 0; j < 4; ++j) bf[j] = *(const half8*)&Bs[wc * 64 + j * 16 + (lane & 15)][kk * 32 + (lane >> 4) * 8];
#pragma unroll
            for (int i = 0; i < 4; ++i)
#pragma unroll
                for (int j = 0; j < 4; ++j) acc[i][j] = __builtin_amdgcn_mfma_f32_16x16x32_f16(bf[j], af[i], acc[i][j], 0, 0, 0);
        }
        __syncthreads();
    }
}

typedef _Float16 half2_ __attribute__((ext_vector_type(2)));
DI void glds16(const h16* g, char* l) {
    __builtin_amdgcn_global_load_lds((const __attribute__((address_space(1))) void*)g, (__attribute__((address_space(3))) void*)l, 16, 0, 0);
}
template <bool SUMSQ>
DI void gemm_mainloop_glds(const int K, const h16* __restrict__ A, const int lda, const h16* __restrict__ Bt, const int ldb,
                           f32x4 (&acc)[4][4], float (&ss)[4], char* smem) {
    const int tid = otid(), lane = tid & 63, wid = tid >> 6, wr = wid >> 1, wc = wid & 1;
#pragma unroll
    for (int i = 0; i < 4; ++i) {
        ss[i] = 0.f;
#pragma unroll
        for (int j = 0; j < 4; ++j) acc[i][j] = (f32x4){0.f, 0.f, 0.f, 0.f};
    }
    const int lrow = wid * 8 + (lane >> 3);
    const int lsw = ((lane & 7) ^ ((lrow >> 1) & 7)) * 8;
    const h16* ap = A + (size_t)lrow * lda + lsw;
    const h16* bp = Bt + (size_t)lrow * ldb + lsw;
    char* lbase = smem + wid * 1024;
    const int fr = lane & 15, fq = lane >> 4;
    int aoff[4], boff[4];
#pragma unroll
    for (int i = 0; i < 4; ++i) {
        const int m = wr * 64 + i * 16 + fr, n = wc * 64 + i * 16 + fr;
        aoff[i] = m * 128 + ((fq ^ ((m >> 1) & 7)) * 16);
        boff[i] = n * 128 + ((fq ^ ((n >> 1) & 7)) * 16);
    }
    const int nk = K >> 6;
    for (int kt = 0; kt < nk; ++kt) {
        __syncthreads();
        char* cur = smem;
        {
            const int k1 = kt * 64;
#pragma unroll
            for (int q = 0; q < 4; ++q) {
                glds16(ap + (size_t)q * 32 * lda + k1, lbase + q * 4096);
                glds16(bp + (size_t)q * 32 * ldb + k1, lbase + 16384 + q * 4096);
            }
        }
        asm volatile("s_waitcnt vmcnt(0)" ::: "memory");
        __syncthreads();
#pragma unroll
        for (int kk = 0; kk < 2; ++kk) {
            half8 af[4], bf[4];
#pragma unroll
            for (int i = 0; i < 4; ++i) af[i] = *(const half8*)(cur + (aoff[i] ^ (kk * 64)));
#pragma unroll
            for (int j = 0; j < 4; ++j) bf[j] = *(const half8*)(cur + 16384 + (boff[j] ^ (kk * 64)));
            if (SUMSQ) {
#pragma unroll
                for (int i = 0; i < 4; ++i)
#pragma unroll
                    for (int e = 0; e < 4; ++e) {
                        const half2_ x = (half2_){af[i][2 * e], af[i][2 * e + 1]};
                        ss[i] = __builtin_amdgcn_fdot2(x, x, ss[i], false);
                    }
            }
#pragma unroll
            for (int i = 0; i < 4; ++i)
#pragma unroll
                for (int j = 0; j < 4; ++j) acc[i][j] = __builtin_amdgcn_mfma_f32_16x16x32_f16(bf[j], af[i], acc[i][j], 0, 0, 0);
        }
    }
    __syncthreads();
    if (SUMSQ) {
#pragma unroll
        for (int i = 0; i < 4; ++i) { ss[i] += __shfl_xor(ss[i], 16); ss[i] += __shfl_xor(ss[i], 32); }
    }
}

struct XLoader {
    const float* x; float ss;
    DI void load(int row, int k, half8 (&r)[4]) {
        const float4* p = (const float4*)(x + (size_t)row * 1024 + k);
#pragma unroll
        for (int q = 0; q < 4; ++q) {
            const float4 a = p[2 * q], b = p[2 * q + 1];
            ss += a.x * a.x + a.y * a.y + a.z * a.z + a.w * a.w + b.x * b.x + b.y * b.y + b.z * b.z + b.w * b.w;
            r[q] = (half8){(h16)a.x, (h16)a.y, (h16)a.z, (h16)a.w, (h16)b.x, (h16)b.y, (h16)b.z, (h16)b.w};
        }
    }
};
struct HLoader {
    const h16* a; int ld;
    DI void load(int row, int k, half8 (&r)[4]) {
        const half8* p = (const half8*)(a + (size_t)row * ld + k);
#pragma unroll
        for (int q = 0; q < 4; ++q) r[q] = p[q];
    }
};
struct CmpLoader {
    const h16* proj; const float* pos; int j; int row0;
    DI void load(int row, int k, half8 (&r)[4]) {
        const int rr = row0 + row, bg = rr >> 9, i = rr & 511, b = bg >> 1, g = bg & 1;
        const int l = k >> 6, d = k & 63;
        int t = 16 * i + l; t = t > SEQ - 1 ? SEQ - 1 : t;
        const half8* p = (const half8*)(proj + ((size_t)b * SEQ + t) * D_IN + C_NKV + j * 128 + g * 64 + d);
        const float4* pp = (const float4*)(pos + l * 64 + d);
#pragma unroll
        for (int q = 0; q < 4; ++q) {
            const half8 v = p[q]; const float4 a = pp[2 * q], c = pp[2 * q + 1];
            r[q] = (half8){(h16)((float)v[0] + a.x), (h16)((float)v[1] + a.y), (h16)((float)v[2] + a.z), (h16)((float)v[3] + a.w),
                           (h16)((float)v[4] + c.x), (h16)((float)v[5] + c.y), (h16)((float)v[6] + c.z), (h16)((float)v[7] + c.w)};
        }
    }
};
struct S5ULoader {
    const h16* proj; const float* xin; int g; int row0;
    DI void load(int row, int k, half8 (&r)[4]) {
        const int ch = row0 + row;
        if (k < 512) {
            const int s0 = k >> 4;
            const half8* p0 = (const half8*)(proj + ((size_t)ch * 32 + s0) * D_IN + C_SU + g * 16);
            const half8* p1 = (const half8*)(proj + ((size_t)ch * 32 + s0 + 1) * D_IN + C_SU + g * 16);
            r[0] = p0[0]; r[1] = p0[1]; r[2] = p1[0]; r[3] = p1[1];
        } else {
            const float4* p = (const float4*)(xin + ((size_t)ch * 1024 + g * 64) * 2 + (k - 512));
#pragma unroll
            for (int q = 0; q < 4; ++q) {
                const float4 a = p[2 * q], b = p[2 * q + 1];
                r[q] = (half8){(h16)a.x, (h16)a.y, (h16)a.z, (h16)a.w, (h16)b.x, (h16)b.y, (h16)b.z, (h16)b.w};
            }
        }
    }
};

template <bool MAP>
DI void transpose_tile(const float* __restrict__ src, int R, int C, h16* __restrict__ dst, int r0, int c0,
                       const float* __restrict__ rscale, float* tile) {
    const int tx = otid() & 31, ty = otid() >> 5;
    for (int yy = ty; yy < 32; yy += 8) {
        const int r = r0 + yy, c = c0 + tx;
        float v = (c < C) ? src[(size_t)r * C + c] : 0.f;
        if (rscale) v *= rscale[r];
        tile[yy * 33 + tx] = v;
    }
    __syncthreads();
    for (int yy = ty; yy < 32; yy += 8) {
        const int c = c0 + yy, r = r0 + tx;
        dst[(size_t)(MAP ? map_col(c) : c) * R + r] = (h16)tile[tx * 33 + yy];
    }
    __syncthreads();
}

DI int glu_perm_src(int np) {
    const int t = np >> 7, w = (np >> 6) & 1, j = (np >> 4) & 3, e = np & 15;
    const int c = t * 64 + w * 32 + (j >> 1) * 16 + e;
    return c + (j & 1) * 256;
}

DI void phase0(const Params& P, char* smem) {
    float* tile = (float*)smem;
    constexpr int N_WIN = 4 * 32 * 100, N_WOUT = 4 * 32 * 32, N_C1 = 8 * 64 * 8, N_GLU = 2048, N_XH = NT * 1024 / 2048;
    const int total = N_WIN + N_WOUT + N_C1 + N_GLU + N_XH;
    for (int w = blockIdx.x; w < total; w += gridDim.x) {
        if (w < N_WIN) {
            const int l = w / 3200, r = w % 3200, rt = r / 100, ct = r % 100;
            transpose_tile<true>(P.in[I_WIN] + (size_t)l * 1024 * D_IN, 1024, D_IN, (h16*)(P.ws + OFF_WTIN) + (size_t)l * D_IN_PAD * 1024,
                           rt * 32, ct * 32, P.in[I_NORMG] + l * 1024, tile);
        } else if (w < N_WIN + N_WOUT) {
            const int v = w - N_WIN, l = v >> 10, r = v & 1023, rt = r >> 5, ct = r & 31;
            transpose_tile<false>(P.in[I_WOUT] + (size_t)l * 1024 * 1024, 1024, 1024, (h16*)(P.ws + OFF_WTOUT) + (size_t)l * 1024 * 1024,
                           rt * 32, ct * 32, nullptr, tile);
        } else if (w < N_WIN + N_WOUT + N_C1) {
            const int v = w - N_WIN - N_WOUT, lj = v >> 9, r = v & 511, rt = r >> 3, ct = r & 7;
            transpose_tile<false>(P.in[I_CW1] + (size_t)lj * 2048 * 256, 2048, 256, (h16*)(P.ws + OFF_WTC1) + (size_t)lj * 256 * 2048,
                           rt * 32, ct * 32, nullptr, tile);
        } else if (w >= N_WIN + N_WOUT + N_C1 + N_GLU) {
            const size_t e0 = ((size_t)(w - N_WIN - N_WOUT - N_C1 - N_GLU) * 256 + otid()) * 8;
            const float4 a = *(const float4*)(P.in[I_X] + e0), b = *(const float4*)(P.in[I_X] + e0 + 4);
            *(half8*)((h16*)(P.ws + OFF_XH) + e0) = (half8){(h16)a.x, (h16)a.y, (h16)a.z, (h16)a.w, (h16)b.x, (h16)b.y, (h16)b.z, (h16)b.w};
        } else {
            const int v = w - N_WIN - N_WOUT - N_C1;
            const int idx = v * 256 + otid();
            const int l = idx >> 17, rem = idx & 131071, np = rem >> 8, k = rem & 255;
            ((h16*)(P.ws + OFF_WTGLU))[idx] = (h16)P.in[I_GLUW][((size_t)l * 256 + k) * 512 + glu_perm_src(np)];
        }
    }
}

DI void s5_build_item(const Params& P, int l, int item, char* smem) {
    float* apow = (float*)smem;
    float* bbar = apow + 64 * 33 * 2;
    float* cc   = bbar + 64 * 16 * 2;
    const int tid = otid();
    const int g = (item < 256) ? (item >> 4) : ((item - 256) >> 2);
    if (tid < 64) {
        const int p = tid;
        const double lre = fmin((double)P.in[I_LRE][(l * 16 + g) * 64 + p], -1e-4);
        const double lim = (double)P.in[I_LIM][(l * 16 + g) * 64 + p];
        const double dt = exp((double)P.in[I_LSTEP][l * 16 + g]);
        const double mag = exp(lre * dt);
        const double ar = mag * cos(lim * dt), ai = mag * sin(lim * dt);
        const double den = lre * lre + lim * lim;
        const double fr = ((ar - 1.0) * lre + ai * lim) / den;
        const double fi = (ai * lre - (ar - 1.0) * lim) / den;
        double pr = 1.0, pi = 0.0;
        for (int k = 0; k <= 32; ++k) {
            apow[(p * 33 + k) * 2] = (float)pr; apow[(p * 33 + k) * 2 + 1] = (float)pi;
            const double nr = pr * ar - pi * ai, ni = pr * ai + pi * ar; pr = nr; pi = ni;
        }
        for (int c = 0; c < 16; ++c) {
            const double br = (double)P.in[I_BRE][((size_t)(l * 16 + g) * 64 + p) * 16 + c];
            const double bi = (double)P.in[I_BIM][((size_t)(l * 16 + g) * 64 + p) * 16 + c];
            bbar[(p * 16 + c) * 2] = (float)(fr * br - fi * bi);
            bbar[(p * 16 + c) * 2 + 1] = (float)(fr * bi + fi * br);
        }
    }
    for (int e = tid; e < 1024; e += 256) {
        cc[e * 2] = P.in[I_CRE][(size_t)(l * 16 + g) * 1024 + e];
        cc[e * 2 + 1] = P.in[I_CIM][(size_t)(l * 16 + g) * 1024 + e];
    }
    __syncthreads();
    if (item < 256) {
        const int c = item & 15;
        float* kt = cc + 2048;
        for (int idx = tid; idx < 512; idx += 256) {
            const int lag = idx >> 4, c2 = idx & 15;
            float a = 0.f;
            for (int p = 0; p < 64; ++p) {
                const float cr = cc[(c * 64 + p) * 2], ci = cc[(c * 64 + p) * 2 + 1];
                const float xr = apow[(p * 33 + lag) * 2], xi = apow[(p * 33 + lag) * 2 + 1];
                const float br = bbar[(p * 16 + c2) * 2], bi = bbar[(p * 16 + c2) * 2 + 1];
                const float tr = cr * xr - ci * xi, ti = cr * xi + ci * xr;
                a += tr * br - ti * bi;
            }
            kt[idx] = a;
        }
        __syncthreads();
        h16* W = (h16*)(P.ws + OFF_S5W) + (size_t)g * 512 * 640;
        for (int idx = tid; idx < 32 * 640; idx += 256) {
            const int j = idx / 640, k = idx % 640;
            float val = 0.f;
            if (k < 512) {
                const int s = k >> 4, c2 = k & 15, lag = j - s;
                if (lag >= 0) val = kt[lag * 16 + c2];
            } else {
                const int p = (k - 512) >> 1;
                const float cr = cc[(c * 64 + p) * 2], ci = cc[(c * 64 + p) * 2 + 1];
                const float xr = apow[(p * 33 + j + 1) * 2], xi = apow[(p * 33 + j + 1) * 2 + 1];
                val = (k & 1) ? -(cr * xi + ci * xr) : (cr * xr - ci * xi);
            }
            W[(size_t)(j * 16 + c) * 640 + k] = (h16)val;
        }
    } else {
        const int pq = (item - 256) & 3;
        h16* E = (h16*)(P.ws + OFF_S5E) + ((size_t)g * 128 + pq * 32) * 512;
        for (int idx = tid; idx < 32 * 512; idx += 256) {
            const int nl = idx >> 9, k = idx & 511;
            const int p = pq * 16 + (nl >> 1), s = k >> 4, c2 = k & 15;
            const float xr = apow[(p * 33 + 31 - s) * 2], xi = apow[(p * 33 + 31 - s) * 2 + 1];
            const float br = bbar[(p * 16 + c2) * 2], bi = bbar[(p * 16 + c2) * 2 + 1];
            const float val = (nl & 1) ? (xr * bi + xi * br) : (xr * br - xi * bi);
            E[(size_t)nl * 512 + k] = (h16)val;
        }
        if (tid < 16) {
            const int p = pq * 16 + tid;
            float* AL = (float*)(P.ws + OFF_S5AL);
            AL[(g * 64 + p) * 2] = apow[(p * 33 + 32) * 2];
            AL[(g * 64 + p) * 2 + 1] = apow[(p * 33 + 32) * 2 + 1];
        }
    }
    __syncthreads();
}

DI void inproj_tile(const Params& P, int l, int mt, int nt, char* smem) {
    f32x4 acc[4][4];
    float ss[4];
    gemm_mainloop_glds<true>(1024, (const h16*)(P.ws + OFF_XH) + (size_t)mt * 128 * 1024, 1024,
                             (const h16*)(P.ws + OFF_WTIN) + ((size_t)l * D_IN_PAD + nt * 128) * 1024, 1024, acc, ss, smem);
    const int tid = otid(), lane = tid & 63, wid = tid >> 6, wr = wid >> 1, wc = wid & 1;
    h16* proj = (h16*)(P.ws + OFF_PROJ);
    const int n64 = nt * 128 + wc * 64;
    int cls = 0;
    if (n64 < 512) cls = 1;
    else if (n64 >= C_NKV + 256 && n64 < C_NKV + 384) cls = 2;
    else if (n64 >= C_NKV + 512 && n64 < C_NKV + 640) cls = 3;
    else if (n64 >= C_NKV + 384 && n64 < C_NKV + 512) cls = 4;
    else if (n64 >= C_NKV + 640 && n64 < C_NKV + 768) cls = 5;
    float wn[4][4];
    if (cls >= 1 && cls <= 3) {
        const float* wp = (cls == 1) ? P.in[I_NQN] + l * 64 : P.in[I_NKN] + (l * 3 + (cls - 1)) * 64;
        const float sc = (cls == 1) ? QSCALE : 1.f;
#pragma unroll
        for (int j = 0; j < 4; ++j) {
            const float4 w4 = *(const float4*)(wp + j * 16 + (lane >> 4) * 4);
            wn[j][0] = w4.x * sc; wn[j][1] = w4.y * sc; wn[j][2] = w4.z * sc; wn[j][3] = w4.w * sc;
        }
    }
#pragma unroll
    for (int i = 0; i < 4; ++i) {
        const int ml = wr * 64 + i * 16 + (lane & 15);
        const float r = rsqrtf(ss[i] * (1.f / 1024.f) + 1e-6f);
        const size_t row = (size_t)mt * 128 + ml;
        f32x4 v[4];
#pragma unroll
        for (int j = 0; j < 4; ++j) v[j] = acc[i][j] * r;
        if (cls >= 1 && cls <= 3) {
            float ss = 0.f;
#pragma unroll
            for (int j = 0; j < 4; ++j) ss += v[j][0] * v[j][0] + v[j][1] * v[j][1] + v[j][2] * v[j][2] + v[j][3] * v[j][3];
            ss += __shfl_xor(ss, 16); ss += __shfl_xor(ss, 32);
            const float rn = rsqrtf(ss * (1.f / 64.f) + 1e-6f);
#pragma unroll
            for (int j = 0; j < 4; ++j) { v[j][0] *= rn * wn[j][0]; v[j][1] *= rn * wn[j][1]; v[j][2] *= rn * wn[j][2]; v[j][3] *= rn * wn[j][3]; }
        }
        if (cls >= 4) {
            const int g = (n64 >> 6) & 1, br = cls - 4;
            const int b = (int)(row >> 13), t = (int)(row & 8191);
            h16* vt = (h16*)(P.ws + OFF_VTG) + ((((size_t)br * 4 + b * 2 + g) * 128 + (t >> 6)) * 64) * 64 + (t & 63);
#pragma unroll
            for (int j = 0; j < 4; ++j)
#pragma unroll
                for (int e = 0; e < 4; ++e) vt[(j * 16 + (lane >> 4) * 4 + e) * 64] = (h16)v[j][e];
        }
#pragma unroll
        for (int j = 0; j < 4; ++j) {
            const int n = n64 + j * 16 + (lane >> 4) * 4;
            if (n < D_IN) *(half4*)(proj + row * D_IN + n) = (half4){(h16)v[j][0], (h16)v[j][1], (h16)v[j][2], (h16)v[j][3]};
        }
    }
    __syncthreads();
}

DI void gla_kv_item(const Params& P, int l, int item, char* smem) {
    const int h = item & 3, cn = item >> 2;
    const size_t tok0 = (size_t)cn * 32;
    float* gl = (float*)smem;
    float* ke = gl + 32 * 33;
    float* vs = ke + 32 * 33;
    const h16* proj = (const h16*)(P.ws + OFF_PROJ);
    const int tid = otid(), i = tid >> 3, dq = (tid & 7) * 4, e0 = (tid & 7) * 8;
    {
        const half8* lp = (const half8*)(proj + (tok0 + i) * D_IN + C_GLR);
        const half8 l0 = lp[0], l1 = lp[1];
        float lr[16];
#pragma unroll
        for (int r = 0; r < 8; ++r) { lr[r] = (float)l0[r]; lr[8 + r] = (float)l1[r]; }
#pragma unroll
        for (int dd = 0; dd < 4; ++dd) {
            const int d = dq + dd;
            float x = P.in[I_GB2][l * 128 + h * 32 + d];
#pragma unroll
            for (int r = 0; r < 16; ++r) x += lr[r] * P.in[I_GW2][(l * 16 + r) * 128 + h * 32 + d];
            gl[i * 33 + d] = log_sigmoidf_(x) * (1.f / 16.f);
        }
    }
    __syncthreads();
    if (tid < 32) {
        float run = 0.f;
        float* bc = (float*)(P.ws + OFF_BCUM);
        for (int ii = 0; ii < 32; ++ii) {
            run += gl[ii * 33 + tid]; gl[ii * 33 + tid] = run;
            bc[(tok0 + ii) * 128 + h * 32 + tid] = run;
        }
    }
    __syncthreads();
    {
        const half4 kv4 = *(const half4*)(proj + (tok0 + i) * D_IN + C_GK + h * 32 + dq);
#pragma unroll
        for (int dd = 0; dd < 4; ++dd) {
            const int d = dq + dd;
            ke[i * 33 + d] = (float)kv4[dd] * __expf(gl[31 * 33 + d] - gl[i * 33 + d]);
        }
        const half8 v8 = *(const half8*)(proj + (tok0 + i) * D_IN + C_GV + h * 64 + e0);
#pragma unroll
        for (int e = 0; e < 8; ++e) vs[i * 64 + e0 + e] = (float)v8[e];
    }
    __syncthreads();
    {
        const int d = tid >> 3;
        float acc[8];
#pragma unroll
        for (int e = 0; e < 8; ++e) acc[e] = 0.f;
        for (int c = 0; c < 32; ++c) {
            const float kd = ke[c * 33 + d];
#pragma unroll
            for (int e = 0; e < 8; ++e) acc[e] += kd * vs[c * 64 + e0 + e];
        }
        const int b = cn >> 8, n = cn & 255, bh = b * 4 + h;
        float* kvp = (float*)(P.ws + OFF_GKV) + ((size_t)(bh * 256 + n) * 32 + d) * 64 + e0;
        *(float4*)kvp = (float4){acc[0], acc[1], acc[2], acc[3]};
        *(float4*)(kvp + 4) = (float4){acc[4], acc[5], acc[6], acc[7]};
        if (tid < 32) ((float*)(P.ws + OFF_GDEC))[(size_t)(bh * 256 + n) * 32 + tid] = __expf(gl[31 * 33 + tid]);
    }
    __syncthreads();
}

DI void cmp_gemm_tile(const Params& P, int l, int tile, char* smem) {
    const int j = tile >> 5, mt = (tile >> 1) & 15, nt = tile & 1;
    CmpLoader al{(const h16*)(P.ws + OFF_PROJ), P.in[I_CPOS] + (size_t)(l * 2 + j) * 32 * 64, j, mt * 128};
    f32x4 acc[4][4];
    gemm_mainloop(2048, al, (const h16*)(P.ws + OFF_WTC1) + ((size_t)(l * 2 + j) * 256 + nt * 128) * 2048, 2048, acc, smem);
    const int tid = otid(), lane = tid & 63, wid = tid >> 6, wr = wid >> 1, wc = wid & 1;
    float* hid = (float*)(P.ws + OFF_CHID) + (size_t)j * 2048 * 256;
    const float* b1 = P.in[I_CB1] + (l * 2 + j) * 256;
#pragma unroll
    for (int i = 0; i < 4; ++i) {
        const size_t row = (size_t)mt * 128 + wr * 64 + i * 16 + (lane & 15);
#pragma unroll
        for (int jj = 0; jj < 4; ++jj) {
            const int n = nt * 128 + wc * 64 + jj * 16 + (lane >> 4) * 4;
            const f32x4 v = acc[i][jj];
            const float4 bb = *(const float4*)(b1 + n);
            *(float4*)(hid + row * 256 + n) = (float4){gelu_tanh(v[0] + bb.x), gelu_tanh(v[1] + bb.y), gelu_tanh(v[2] + bb.z), gelu_tanh(v[3] + bb.w)};
        }
    }
}

DI void s5e_gemm_tile(const Params& P, int l, int tile, char* smem) {
    const int g = tile >> 2, mt = tile & 3;
    S5ULoader al{(const h16*)(P.ws + OFF_PROJ), nullptr, g, mt * 128};
    f32x4 acc[4][4];
    gemm_mainloop(512, al, (const h16*)(P.ws + OFF_S5E) + (size_t)g * 128 * 512, 512, acc, smem);
    const int tid = otid(), lane = tid & 63, wid = tid >> 6, wr = wid >> 1, wc = wid & 1;
    float* xc = (float*)(P.ws + OFF_XC);
#pragma unroll
    for (int i = 0; i < 4; ++i) {
        const size_t ch = (size_t)mt * 128 + wr * 64 + i * 16 + (lane & 15);
#pragma unroll
        for (int jj = 0; jj < 4; ++jj) {
            const int n = wc * 64 + jj * 16 + (lane >> 4) * 4;
            const f32x4 v = acc[i][jj];
            *(float4*)(xc + (ch * 1024 + g * 64) * 2 + n) = (float4){v[0], v[1], v[2], v[3]};
        }
    }
}

DI void gla_scan_item(const Params& P, int item) {
    const int idx = item * 256 + otid(), bh = idx >> 11, de = idx & 2047, d = de >> 6;
    float* kv = (float*)(P.ws + OFF_GKV) + (size_t)bh * 256 * 2048 + de;
    const float* dc = (const float*)(P.ws + OFF_GDEC) + (size_t)bh * 256 * 32 + d;
    float S = 0.f;
    for (int n0 = 0; n0 < 256; n0 += 16) {
        float kvv[16], dd[16];
#pragma unroll
        for (int i = 0; i < 16; ++i) { kvv[i] = kv[(size_t)(n0 + i) * 2048]; dd[i] = dc[(n0 + i) * 32]; }
#pragma unroll
        for (int i = 0; i < 16; ++i) { const float o = S; S = dd[i] * S + kvv[i]; kvv[i] = o; }
#pragma unroll
        for (int i = 0; i < 16; ++i) kv[(size_t)(n0 + i) * 2048] = kvv[i];
    }
}
DI void s5_scan_item(const Params& P, int item) {
    const int idx = item * 256 + otid(), b = idx >> 10, s = idx & 1023;
    float2* xc = (float2*)(P.ws + OFF_XC) + (size_t)b * 256 * 1024 + s;
    const float2 a = ((const float2*)(P.ws + OFF_S5AL))[s];
    float xr = 0.f, xi = 0.f;
    for (int n0 = 0; n0 < 256; n0 += 16) {
        float2 c[16];
#pragma unroll
        for (int i = 0; i < 16; ++i) c[i] = xc[(size_t)(n0 + i) * 1024];
#pragma unroll
        for (int i = 0; i < 16; ++i) {
            const float nr = a.x * xr - a.y * xi + c[i].x, ni = a.x * xi + a.y * xr + c[i].y;
            c[i] = (float2){xr, xi}; xr = nr; xi = ni;
        }
#pragma unroll
        for (int i = 0; i < 16; ++i) xc[(size_t)(n0 + i) * 1024] = c[i];
    }
}
DI void cmp_l2_item(const Params& P, int l, int item) {
    const int tid = otid(), lane = tid & 63, w = tid >> 6;
    const int r4 = item * 4 + w, j = r4 >> 11, row = r4 & 2047;
    const float* hid = (const float*)(P.ws + OFF_CHID) + ((size_t)j * 2048 + row) * 256;
    const float* w2 = P.in[I_CW2] + (size_t)(l * 2 + j) * 256 * 64;
    float acc = P.in[I_CB2][(l * 2 + j) * 64 + lane];
    for (int n = 0; n < 256; ++n) acc += hid[n] * w2[n * 64 + lane];
    if (j == 0) {
        const float ss = wave_sum(acc * acc);
        acc = acc * rsqrtf(ss * (1.f / 64.f) + 1e-6f) * P.in[I_NKN][(l * 3 + 0) * 64 + lane];
        ((h16*)(P.ws + OFF_KCMP))[(size_t)row * 64 + lane] = (h16)acc;
    } else {
        const int bg = row >> 9, i = row & 511;
        ((h16*)(P.ws + OFF_VCMP))[(((size_t)bg * 8 + (i >> 6)) * 64 + lane) * 64 + (i & 63)] = (h16)acc;
    }
}

DI void gla_out_item(const Params& P, int l, int item, char* smem) {
    const int h = item & 3, cn = item >> 2;
    const size_t tok0 = (size_t)cn * 32;
    float* qe = (float*)smem;
    float* ke = qe + 32 * 33;
    float* scs = ke + 32 * 33;
    float* vs = scs + 32 * 33;
    float* sp = vs + 32 * 64;
    const h16* proj = (const h16*)(P.ws + OFF_PROJ);
    const int tid = otid(), i = tid >> 3, dq = (tid & 7) * 4, e0 = (tid & 7) * 8;
    const int b = cn >> 8, n = cn & 255, bh = b * 4 + h;
    {
        const float4 bc = *(const float4*)((const float*)(P.ws + OFF_BCUM) + (tok0 + i) * 128 + h * 32 + dq);
        const half4 q4 = *(const half4*)(proj + (tok0 + i) * D_IN + C_GQ + h * 32 + dq);
        const half4 k4 = *(const half4*)(proj + (tok0 + i) * D_IN + C_GK + h * 32 + dq);
        const float bcv[4] = {bc.x, bc.y, bc.z, bc.w};
#pragma unroll
        for (int dd = 0; dd < 4; ++dd) {
            qe[i * 33 + dq + dd] = (float)q4[dd] * 0.17677669529663687f * __expf(bcv[dd]);
            ke[i * 33 + dq + dd] = (float)k4[dd] * __expf(-bcv[dd]);
        }
        const half8 v8 = *(const half8*)(proj + (tok0 + i) * D_IN + C_GV + h * 64 + e0);
#pragma unroll
        for (int e = 0; e < 8; ++e) vs[i * 64 + e0 + e] = (float)v8[e];
        const float* spp = (const float*)(P.ws + OFF_GKV) + (size_t)(bh * 256 + n) * 2048 + tid * 8;
        const float4 s0 = *(const float4*)spp, s1 = *(const float4*)(spp + 4);
        *(float4*)(sp + tid * 8) = s0; *(float4*)(sp + tid * 8 + 4) = s1;
    }
    __syncthreads();
    {
        const int j0 = (tid & 7) * 4;
#pragma unroll
        for (int jj = 0; jj < 4; ++jj) {
            const int j = j0 + jj;
            float s = 0.f;
            if (j <= i) for (int d = 0; d < 32; ++d) s += qe[i * 33 + d] * ke[j * 33 + d];
            scs[i * 33 + j] = s;
        }
    }
    __syncthreads();
    {
        float acc[8];
#pragma unroll
        for (int e = 0; e < 8; ++e) acc[e] = 0.f;
        for (int j = 0; j < 32; ++j) {
            const float s = scs[i * 33 + j], qd = qe[i * 33 + j];
#pragma unroll
            for (int e = 0; e < 8; ++e) acc[e] += s * vs[j * 64 + e0 + e] + qd * sp[j * 64 + e0 + e];
        }
        float ss = 0.f;
#pragma unroll
        for (int e = 0; e < 8; ++e) ss += acc[e] * acc[e];
        ss += __shfl_xor(ss, 1); ss += __shfl_xor(ss, 2); ss += __shfl_xor(ss, 4);
        const float r = rsqrtf(ss * (1.f / 64.f) + 1e-6f);
        const half8 g8 = *(const half8*)(proj + (tok0 + i) * D_IN + C_GG + h * 64 + e0);
        half8 o;
#pragma unroll
        for (int e = 0; e < 8; ++e) o[e] = (h16)(acc[e] * r * P.in[I_GON][l * 64 + e0 + e] * siluf_((float)g8[e]));
        *(half8*)((h16*)(P.ws + OFF_MIX) + (tok0 + i) * 1024 + h * 64 + e0) = o;
    }
    __syncthreads();
}

DI void s5o_gemm_tile(const Params& P, int l, int tile, char* smem) {
    const int g = tile >> 4, mt = (tile >> 2) & 3, nt = tile & 3;
    S5ULoader al{(const h16*)(P.ws + OFF_PROJ), (const float*)(P.ws + OFF_XC), g, mt * 128};
    f32x4 acc[4][4];
    gemm_mainloop(640, al, (const h16*)(P.ws + OFF_S5W) + ((size_t)g * 512 + nt * 128) * 640, 640, acc, smem);
    const int tid = otid(), lane = tid & 63, wid = tid >> 6, wr = wid >> 1, wc = wid & 1;
    const h16* proj = (const h16*)(P.ws + OFF_PROJ);
    h16* yact = (h16*)(P.ws + OFF_YACT);
#pragma unroll
    for (int i = 0; i < 4; ++i) {
        const size_t ch = (size_t)mt * 128 + wr * 64 + i * 16 + (lane & 15);
#pragma unroll
        for (int jj = 0; jj < 4; ++jj) {
            const int n = nt * 128 + wc * 64 + jj * 16 + (lane >> 4) * 4;
            const int j = n >> 4, c = n & 15;
            const size_t tok = ch * 32 + j;
            const half4 u4 = *(const half4*)(proj + tok * D_IN + C_SU + g * 16 + c);
            const float4 dd = *(const float4*)(P.in[I_SD] + (l * 16 + g) * 16 + c);
            const f32x4 v = acc[i][jj];
            half4 o;
            o[0] = (h16)gelu_tanh(v[0] + dd.x * (float)u4[0]);
            o[1] = (h16)gelu_tanh(v[1] + dd.y * (float)u4[1]);
            o[2] = (h16)gelu_tanh(v[2] + dd.z * (float)u4[2]);
            o[3] = (h16)gelu_tanh(v[3] + dd.w * (float)u4[3]);
            *(half4*)(yact + tok * 256 + g * 16 + c) = o;
        }
    }
}

#define MFMA32(a, b, c) __builtin_amdgcn_mfma_f32_32x32x16_f16((a), (b), (c), 0, 0, 0)
constexpr float NEGS = -1e30f;
DI float ex2(float x) { return __builtin_amdgcn_exp2f(x); }
DI void tile_ld(const h16* __restrict__ src, int ld, int tid, half8& r0, half8& r1) {
    const h16* p = src + (size_t)(tid >> 2) * ld + (tid & 3) * 16;
    r0 = *(const half8*)p; r1 = *(const half8*)(p + 8);
}
DI void tile_st(h16* dst, int tid, const half8& r0, const half8& r1) {
    h16* p = dst + (tid >> 2) * 72 + (tid & 3) * 16;
    *(half8*)p = r0; *(half8*)(p + 8) = r1;
}
DI void qk_tile(const h16* Kt, const half8 (&qf)[4], f32x16 (&s)[2], int lane) {
    const int r = lane & 31, h = lane >> 5;
#pragma unroll
    for (int kt = 0; kt < 2; ++kt) {
#pragma unroll
        for (int e = 0; e < 16; ++e) s[kt][e] = 0.f;
#pragma unroll
        for (int ks = 0; ks < 4; ++ks) {
            const half8 a = *(const half8*)(Kt + (32 * kt + r) * 72 + 16 * ks + 8 * h);
            s[kt] = MFMA32(a, qf[ks], s[kt]);
        }
    }
}
template <int S> DI half8 pack8(const f32x16& x) {
    return (half8){(h16)x[8 * S], (h16)x[8 * S + 1], (h16)x[8 * S + 2], (h16)x[8 * S + 3], (h16)x[8 * S + 4], (h16)x[8 * S + 5], (h16)x[8 * S + 6], (h16)x[8 * S + 7]};
}
DI half8 ld_vfrag(const h16* vp) {
    const half4 lo = *(const half4*)vp, hi = *(const half4*)(vp + 8);
    return (half8){lo[0], lo[1], lo[2], lo[3], hi[0], hi[1], hi[2], hi[3]};
}
DI void pv_tile(const h16* Vt, const f32x16 (&p)[2], f32x16 (&o)[2], int lane) {
    const int r = lane & 31, h = lane >> 5;
#pragma unroll
    for (int kt = 0; kt < 2; ++kt) {
        const half8 pb0 = pack8<0>(p[kt]), pb1 = pack8<1>(p[kt]);
#pragma unroll
        for (int dt = 0; dt < 2; ++dt) {
            const h16* vp = Vt + (32 * dt + r) * 72 + 32 * kt + 4 * h;
            o[dt] = MFMA32(ld_vfrag(vp), pb0, o[dt]);
            o[dt] = MFMA32(ld_vfrag(vp + 16), pb1, o[dt]);
        }
    }
}
DI float rowmax32(const f32x16 (&s)[2]) {
    float mx = s[0][0];
#pragma unroll
    for (int e = 1; e < 16; ++e) mx = fmaxf(mx, s[0][e]);
#pragma unroll
    for (int e = 0; e < 16; ++e) mx = fmaxf(mx, s[1][e]);
    return fmaxf(mx, __shfl_xor(mx, 32));
}
DI void sm_online(f32x16 (&s)[2], float& m, float& l, f32x16 (&o)[2]) {
    const float mn = fmaxf(m, rowmax32(s)), alpha = ex2(m - mn);
    float rs = 0.f;
#pragma unroll
    for (int kt = 0; kt < 2; ++kt)
#pragma unroll
        for (int e = 0; e < 16; ++e) { const float p = ex2(s[kt][e] - mn); s[kt][e] = p; rs += p; }
    rs += __shfl_xor(rs, 32);
    l = l * alpha + rs; m = mn;
    o[0] *= alpha; o[1] *= alpha;
}

DI void nsa_unit(const Params& P, int l, int bg, int c32, char* smem) {
    const int tid = otid(), lane = tid & 63, w = tid >> 6, r = lane & 31, h = lane >> 5;
    const int b = bg >> 1, g = bg & 1, t0 = c32 * 32, cur = c32 >> 1;
    const int tokl = w * 8 + (r >> 2), head = r & 3, t = t0 + tokl;
    const size_t tokg = (size_t)b * SEQ + t;
    h16* KT = (h16*)smem;
    h16* VT = KT + 2 * 64 * 72;
    float* IMP = (float*)(smem + 36864);
    unsigned* SELM = (unsigned*)(smem + 36864 + 16384);
    const h16* proj = (const h16*)(P.ws + OFF_PROJ);
    const int ghead = g * 4 + head;

    half8 qf[4];
    {
        const h16* qp = proj + tokg * D_IN + C_NQ + ghead * 64 + 8 * h;
#pragma unroll
        for (int ks = 0; ks < 4; ++ks) qf[ks] = *(const half8*)(qp + 16 * ks);
    }
    float g0, g1, g2;
    {
        const h16* gp = proj + tokg * D_IN + C_NGL + ghead * 3;
        const float* gb = P.in[I_NGB] + l * 24 + ghead * 3;
        g0 = sigmoidf_((float)gp[0] + gb[0]); g1 = sigmoidf_((float)gp[1] + gb[1]); g2 = sigmoidf_((float)gp[2] + gb[2]);
    }
    for (int i = tid; i < 32 * 128; i += 256) IMP[i] = 0.f;

    f32x16 oacc[2];
#pragma unroll
    for (int e = 0; e < 16; ++e) { oacc[0][e] = 0.f; oacc[1][e] = 0.f; }

    half8 kr0, kr1, vr0, vr1;
    {
        const int nvt = 2 * c32 + 1;
        const int nvr = (t >= 31) ? ((t - 31) >> 4) + 1 : 0;
        const int ntile = (nvt + 63) >> 6;
        const h16* kcg = (const h16*)(P.ws + OFF_KCMP) + (size_t)bg * 512 * 64;
        const h16* vcg = (const h16*)(P.ws + OFF_VCMP) + (size_t)bg * 8 * 4096;
        float m = -1e20f, lsum = 0.f;
        tile_ld(kcg, 64, tid, kr0, kr1);
        __syncthreads();
        tile_st(KT, tid, kr0, kr1);
        __syncthreads();
        for (int j = 0; j < ntile; ++j) {
            const int buf = j & 1;
            if (j + 1 < ntile) tile_ld(kcg + (size_t)(j + 1) * 4096, 64, tid, kr0, kr1);
            f32x16 s[2];
            qk_tile(KT + buf * 4608, qf, s, lane);
#pragma unroll
            for (int kt = 0; kt < 2; ++kt)
#pragma unroll
                for (int e = 0; e < 16; ++e) {
                    const int key = 64 * j + 32 * kt + 8 * (e >> 2) + 4 * h + (e & 3);
                    if (key >= nvr) s[kt][e] = NEGS;
                }
            const float mn = fmaxf(m, rowmax32(s)), alpha = ex2(m - mn);
            float rs = 0.f;
#pragma unroll
            for (int kt = 0; kt < 2; ++kt)
#pragma unroll
                for (int e = 0; e < 16; ++e) rs += ex2(s[kt][e] - mn);
            rs += __shfl_xor(rs, 32);
            lsum = lsum * alpha + rs; m = mn;
            if (j + 1 < ntile) tile_st(KT + (buf ^ 1) * 4608, tid, kr0, kr1);
            __syncthreads();
        }
        const float invl = lsum > 0.f ? 1.f / lsum : 0.f;
        f32x16 o[2];
#pragma unroll
        for (int e = 0; e < 16; ++e) { o[0][e] = 0.f; o[1][e] = 0.f; }
        tile_ld(kcg, 64, tid, kr0, kr1);
        tile_ld(vcg, 64, tid, vr0, vr1);
        tile_st(KT, tid, kr0, kr1);
        tile_st(VT, tid, vr0, vr1);
        __syncthreads();
        for (int j = 0; j < ntile; ++j) {
            const int buf = j & 1;
            if (j + 1 < ntile) {
                tile_ld(kcg + (size_t)(j + 1) * 4096, 64, tid, kr0, kr1);
                tile_ld(vcg + (size_t)(j + 1) * 4096, 64, tid, vr0, vr1);
            }
            f32x16 s[2];
            qk_tile(KT + buf * 4608, qf, s, lane);
#pragma unroll
            for (int kt = 0; kt < 2; ++kt)
#pragma unroll
                for (int e = 0; e < 16; ++e) {
                    const int key = 64 * j + 32 * kt + 8 * (e >> 2) + 4 * h + (e & 3);
                    s[kt][e] = (key < nvr) ? ex2(s[kt][e] - m) * invl : 0.f;
                }
            if (cur >= 16) {
#pragma unroll
                for (int kt = 0; kt < 2; ++kt)
#pragma unroll
                    for (int g4 = 0; g4 < 4; ++g4) {
                        float G = (s[kt][4 * g4] + s[kt][4 * g4 + 1]) + (s[kt][4 * g4 + 2] + s[kt][4 * g4 + 3]);
                        float L = s[kt][4 * g4 + 3];
                        G += __shfl_xor(G, 1); G += __shfl_xor(G, 2);
                        L += __shfl_xor(L, 1); L += __shfl_xor(L, 2);
                        if (head == 0) {
                            const int sb = 16 * j + 8 * kt + 2 * g4 + h;
                            atomicAdd(&IMP[tokl * 128 + sb], G);
                            if (sb + 1 < 128) atomicAdd(&IMP[tokl * 128 + sb + 1], L);
                        }
                    }
            }
            pv_tile(VT + buf * 4608, s, o, lane);
            if (j + 1 < ntile) {
                tile_st(KT + (buf ^ 1) * 4608, tid, kr0, kr1);
                tile_st(VT + (buf ^ 1) * 4608, tid, vr0, vr1);
            }
            __syncthreads();
        }
        oacc[0] = o[0] * g0; oacc[1] = o[1] * g0;
    }
    {
        const int tl = lane >> 3, sub = lane & 7;
        unsigned bits = 0;
        if (cur >= 16) {
            const float* ip = IMP + (w * 8 + tl) * 128 + sub * 16;
            unsigned u[16];
#pragma unroll
            for (int i = 0; i < 16; ++i) {
                const int s = sub * 16 + i;
                u[i] = (s >= 1 && s <= cur - 2) ? (__float_as_uint(ip[i]) + 1u) : 0u;
            }
            unsigned prefix = 0;
            for (int bit = 30; bit >= 0; --bit) {
                const unsigned cand = prefix | (1u << bit);
                int cnt = 0;
#pragma unroll
                for (int i = 0; i < 16; ++i) cnt += (u[i] >= cand) ? 1 : 0;
                cnt += __shfl_xor(cnt, 1); cnt += __shfl_xor(cnt, 2); cnt += __shfl_xor(cnt, 4);
                if (cnt >= 13) prefix = cand;
            }
            int cgt = 0, ceq = 0;
#pragma unroll
            for (int i = 0; i < 16; ++i) { cgt += (u[i] > prefix) ? 1 : 0; ceq += (u[i] == prefix) ? 1 : 0; }
            cgt += __shfl_xor(cgt, 1); cgt += __shfl_xor(cgt, 2); cgt += __shfl_xor(cgt, 4);
            int inc = ceq;
            { const int v = __shfl_up(inc, 1); if (sub >= 1) inc += v; }
            { const int v = __shfl_up(inc, 2); if (sub >= 2) inc += v; }
            { const int v = __shfl_up(inc, 4); if (sub >= 4) inc += v; }
            int run = inc - ceq;
            const int need = 13 - cgt;
#pragma unroll
            for (int i = 0; i < 16; ++i) {
                const int s = sub * 16 + i;
                bool sel = u[i] > prefix;
                if (u[i] == prefix) { sel = run < need; ++run; }
                if (s == 0 || s == cur || s == cur - 1) sel = true;
                bits |= (sel ? 1u : 0u) << i;
            }
        } else {
#pragma unroll
            for (int i = 0; i < 16; ++i) bits |= ((sub * 16 + i <= cur) ? 1u : 0u) << i;
        }
        unsigned wv = bits << ((sub & 1) * 16);
        wv |= __shfl_xor(wv, 1);
        if ((sub & 1) == 0) SELM[(w * 8 + tl) * 4 + (sub >> 1)] = wv;
    }
    __syncthreads();
    unsigned selw[4];
#pragma unroll
    for (int i = 0; i < 4; ++i) selw[i] = SELM[tokl * 4 + i];

#pragma unroll 1
    for (int br = 0; br < 2; ++br) {
        const int j0 = (br == 0) ? 0 : (cur - 8 > 0 ? cur - 8 : 0);
        const int nst = cur - j0 + 1;
        const h16* kg = proj + ((size_t)b * SEQ + (size_t)j0 * 64) * D_IN + C_NKV + (br == 0 ? 256 : 512) + g * 64;
        const h16* vg = (const h16*)(P.ws + OFF_VTG) + (((size_t)br * 4 + bg) * 128 + j0) * 4096;
        float m = -1e20f, lsum = 0.f;
        f32x16 o[2];
#pragma unroll
        for (int e = 0; e < 16; ++e) { o[0][e] = 0.f; o[1][e] = 0.f; }
        tile_ld(kg, D_IN, tid, kr0, kr1);
        tile_ld(vg, 64, tid, vr0, vr1);
        tile_st(KT, tid, kr0, kr1);
        tile_st(VT, tid, vr0, vr1);
        __syncthreads();
        for (int jj = 0; jj < nst; ++jj) {
            const int buf = jj & 1, j = j0 + jj;
            if (jj + 1 < nst) {
                tile_ld(kg + (size_t)(jj + 1) * 64 * D_IN, D_IN, tid, kr0, kr1);
                tile_ld(vg + (size_t)(jj + 1) * 4096, 64, tid, vr0, vr1);
            }
            f32x16 s[2];
            qk_tile(KT + buf * 4608, qf, s, lane);
            if (br == 0) {
                const bool sel = (selw[j >> 5] >> (j & 31)) & 1u;
                if (!sel) {
#pragma unroll
                    for (int e = 0; e < 16; ++e) { s[0][e] = NEGS; s[1][e] = NEGS; }
                }
            }
            if (j == cur || (br == 1 && j == cur - 8)) {
#pragma unroll
                for (int kt = 0; kt < 2; ++kt)
#pragma unroll
                    for (int e = 0; e < 16; ++e) {
                        const int key = 64 * j + 32 * kt + 8 * (e >> 2) + 4 * h + (e & 3);
                        const bool ok = (key <= t) && (br == 0 || key > t - 512);
                        if (!ok) s[kt][e] = NEGS;
                    }
            }
            sm_online(s, m, lsum, o);
            pv_tile(VT + buf * 4608, s, o, lane);
            if (jj + 1 < nst) {
                tile_st(KT + (buf ^ 1) * 4608, tid, kr0, kr1);
                tile_st(VT + (buf ^ 1) * 4608, tid, vr0, vr1);
            }
            __syncthreads();
        }
        const float sc = (br == 0 ? g1 : g2) / lsum;
        oacc[0] += o[0] * sc; oacc[1] += o[1] * sc;
    }
    {
        h16* mixp = (h16*)(P.ws + OFF_MIX) + tokg * 1024 + 512 + ghead * 64;
        const h16* ngp = proj + tokg * D_IN + C_NG + ghead * 64;
#pragma unroll
        for (int dt = 0; dt < 2; ++dt)
#pragma unroll
            for (int g4 = 0; g4 < 4; ++g4) {
                const int d0 = 32 * dt + 8 * g4 + 4 * h;
                const half4 ng = *(const half4*)(ngp + d0);
                half4 ov;
#pragma unroll
                for (int e = 0; e < 4; ++e) ov[e] = (h16)(oacc[dt][4 * g4 + e] * siluf_((float)ng[e]));
                *(half4*)(mixp + d0) = ov;
            }
    }
    __syncthreads();
}

DI void glu_tile(const Params& P, int l, int tile, char* smem) {
    const int mt = tile >> 2, nt = tile & 3;
    f32x4 acc[4][4];
    float ssd[4];
    gemm_mainloop_glds<false>(256, (const h16*)(P.ws + OFF_YACT) + (size_t)mt * 128 * 256, 256,
                              (const h16*)(P.ws + OFF_WTGLU) + ((size_t)l * 512 + nt * 128) * 256, 256, acc, ssd, smem);
    const int tid = otid(), lane = tid & 63, wid = tid >> 6, wr = wid >> 1, wc = wid & 1;
    const h16* proj = (const h16*)(P.ws + OFF_PROJ);
    h16* mix = (h16*)(P.ws + OFF_MIX);
    const float* gb = P.in[I_GLUB] + l * 512;
#pragma unroll
    for (int i = 0; i < 4; ++i) {
        const size_t tok = (size_t)mt * 128 + wr * 64 + i * 16 + (lane & 15);
#pragma unroll
        for (int pj = 0; pj < 2; ++pj) {
            const int c = nt * 64 + wc * 32 + pj * 16 + (lane >> 4) * 4;
            const f32x4 z1 = acc[i][2 * pj], z2 = acc[i][2 * pj + 1];
            const float4 b1 = *(const float4*)(gb + c), b2 = *(const float4*)(gb + 256 + c);
            const half4 g4 = *(const half4*)(proj + tok * D_IN + C_SG + c);
            half4 o;
            o[0] = (h16)((z1[0] + b1.x) * sigmoidf_(z2[0] + b2.x) * siluf_((float)g4[0]));
            o[1] = (h16)((z1[1] + b1.y) * sigmoidf_(z2[1] + b2.y) * siluf_((float)g4[1]));
            o[2] = (h16)((z1[2] + b1.z) * sigmoidf_(z2[2] + b2.z) * siluf_((float)g4[2]));
            o[3] = (h16)((z1[3] + b1.w) * sigmoidf_(z2[3] + b2.w) * siluf_((float)g4[3]));
            *(half4*)(mix + tok * 1024 + 256 + c) = o;
        }
    }
}

DI void outproj_tile(const Params& P, int l, int mt, int nt, char* smem) {
    f32x4 acc[4][4];
    float ssd[4];
    gemm_mainloop_glds<false>(1024, (const h16*)(P.ws + OFF_MIX) + (size_t)mt * 128 * 1024, 1024,
                              (const h16*)(P.ws + OFF_WTOUT) + ((size_t)l * 1024 + nt * 128) * 1024, 1024, acc, ssd, smem);
    const int tid = otid(), lane = tid & 63, wid = tid >> 6, wr = wid >> 1, wc = wid & 1;
    const float* xin = (l == 0) ? P.in[I_X] : P.out;
    h16* xh = (h16*)(P.ws + OFF_XH);
#pragma unroll
    for (int i = 0; i < 4; ++i) {
        const size_t row = (size_t)mt * 128 + wr * 64 + i * 16 + (lane & 15);
#pragma unroll
        for (int jj = 0; jj < 4; ++jj) {
            const int n = nt * 128 + wc * 64 + jj * 16 + (lane >> 4) * 4;
            const f32x4 v = acc[i][jj];
            const float4 xo = *(const float4*)(xin + row * 1024 + n);
            const float4 xn = (float4){xo.x + v[0], xo.y + v[1], xo.z + v[2], xo.w + v[3]};
            *(float4*)(P.out + row * 1024 + n) = xn;
            *(half4*)(xh + row * 1024 + n) = (half4){(h16)xn.x, (h16)xn.y, (h16)xn.z, (h16)xn.w};
        }
    }
}

#define XB_TMO      128
#define XB_XCNT(j)  (256  + 64 * (j))
#define XB_XSUB(j)  (1280 + 64 * (j))
#define XB_XGEN(j)  (2304 + 64 * (j))
#define XB_TOP      3328
#define XB_TOPGEN   3392
#define XCD_BAR_WORDS 3456
#define XB_SPIN_CAP (1u << 18)
#define LAS __attribute__((address_space(3)))

__device__ __forceinline__ unsigned xb_ld(unsigned* p)              { return __hip_atomic_load(p, __ATOMIC_RELAXED, __HIP_MEMORY_SCOPE_AGENT); }
__device__ __forceinline__ unsigned xb_add(unsigned* p, unsigned v) { return __hip_atomic_fetch_add(p, v, __ATOMIC_RELAXED, __HIP_MEMORY_SCOPE_AGENT); }
__device__ __forceinline__ unsigned xb_xcc_id() { return (unsigned)__builtin_amdgcn_s_getreg((3 << 11) | 20) & 0xFu; }
#define XB_SPIN(cond, bar) do { unsigned _sp = 0; while (cond) { __builtin_amdgcn_s_sleep(1); \
    if ((++_sp & 255u) == 0u) { if (xb_ld(&(bar)[XB_TMO])) break; if (_sp > XB_SPIN_CAP) { atomicAdd(&(bar)[XB_TMO], 1u); break; } } } } while (0)

struct XcdBarrier {
    unsigned* bar; unsigned x;
    volatile LAS unsigned* st;
};

__device__ __forceinline__ XcdBarrier xcd_barrier_post(unsigned* bar, volatile LAS unsigned* st) {
    XcdBarrier b; b.bar = bar; b.x = xb_xcc_id(); b.st = st;
    if (threadIdx.x == 0) (void)xb_add(&bar[XB_XCNT(b.x)], 1u);
    return b;
}
__device__ __forceinline__ void xcd_barrier_complete(unsigned* bar, unsigned x, unsigned& nloc, unsigned& nx) {
    const unsigned G = gridDim.x * gridDim.y * gridDim.z;
    unsigned sum, cnt, mine, sp = 0u;
    for (;;) {
        sum = 0u; cnt = 0u; mine = 0u;
#pragma unroll
        for (unsigned j = 0; j < 16; ++j) { const unsigned c = xb_ld(&bar[XB_XCNT(j)]); sum += c; cnt += (c > 0u) ? 1u : 0u; mine = (j == x) ? c : mine; }
        if (sum == G) break;
        __builtin_amdgcn_s_sleep(1);
        if ((++sp & 255u) == 0u) { if (xb_ld(&bar[XB_TMO])) break; if (sp > XB_SPIN_CAP) { atomicAdd(&bar[XB_TMO], 1u); break; } }
    }
    nloc = mine > 0u ? mine : 1u; nx = cnt > 0u ? cnt : 1u;
}

__device__ __forceinline__ void xcd_barrier(const XcdBarrier& b) {
    asm volatile("s_waitcnt vmcnt(0)" ::: "memory");
    __syncthreads();
    if (threadIdx.x == 0) {
        unsigned* bar = b.bar;
        __builtin_amdgcn_s_waitcnt(0);
        unsigned nloc = b.st[0], nx = b.st[1];
        if (nloc == 0u) { xcd_barrier_complete(bar, b.x, nloc, nx); b.st[0] = nloc; b.st[1] = nx; }
        const unsigned old = xb_add(&bar[XB_XSUB(b.x)], 1u);
        const unsigned gen = old / nloc;
        if (old + 1u == (gen + 1u) * nloc) {
            __builtin_amdgcn_fence(__ATOMIC_RELEASE, "agent");
            asm volatile("s_waitcnt vmcnt(0)" ::: "memory");
            const unsigned og = xb_add(&bar[XB_TOP], 1u);
            const unsigned tg = og / nx;
            if (og + 1u == (tg + 1u) * nx) xb_add(&bar[XB_TOPGEN], 1u);
            else XB_SPIN(xb_ld(&bar[XB_TOPGEN]) == tg, bar);
            __builtin_amdgcn_fence(__ATOMIC_ACQUIRE, "agent");
            xb_add(&bar[XB_XGEN(b.x)], 1u);
            asm volatile("s_waitcnt vmcnt(0)" ::: "memory");
        } else {
            XB_SPIN(xb_ld(&bar[XB_XGEN(b.x)]) == gen, bar);
            __builtin_amdgcn_fence(__ATOMIC_ACQUIRE, "agent");
            asm volatile("s_waitcnt vmcnt(0)" ::: "memory");
        }
    }
    __syncthreads();
}


__global__ void __launch_bounds__(NTHREADS, 2) fwd_megakernel(Params P) {
    extern __shared__ __attribute__((aligned(16))) char smem[];
    cg::grid_group grid = cg::this_grid();
    const int G = gridDim.x, bid = blockIdx.x;

    uint4& xb_words = *(uint4*)(smem + SMEM_MAIN);
    if (otid() == 0) xb_words = make_uint4(0u, 0u, 0u, 0u);
    if (bid == 0) for (int i = otid(); i < XCD_BAR_WORDS; i += NTHREADS) ((unsigned*)(P.ws + OFF_BAR))[i] = 0u;
    phase0(P, smem);
    grid.sync();
    const XcdBarrier xb = xcd_barrier_post((unsigned*)(P.ws + OFF_BAR), (volatile LAS unsigned*)(smem + SMEM_MAIN));

#pragma unroll 1
    for (int l = 0; l < DEPTH; ++l) {
        {
            const int xcd = bid & 7, jx = bid >> 3, nper = G >> 3;
            for (int u = jx; u < 400; u += nper) {
                const int mh = u / 200, rem = u - mh * 200;
                inproj_tile(P, l, xcd * 16 + mh * 8 + (rem & 7), rem >> 3, smem);
            }
            const int rem7 = 400 % nper;
            const int rank = (jx >= rem7) ? (jx - rem7) * 8 + xcd : (nper - rem7) * 8 + jx * 8 + xcd;
            for (int it = rank; it < 320; it += G) s5_build_item(P, l, it, smem);
        }
        xcd_barrier(xb);
#pragma unroll 1
        for (int w = bid; w < 64 + 64 + 2048; w += G) {
            if (w < 64) cmp_gemm_tile(P, l, w, smem);
            else if (w < 128) s5e_gemm_tile(P, l, w - 64, smem);
            else gla_kv_item(P, l, w - 128, smem);
        }
        xcd_barrier(xb);
#pragma unroll 1
        for (int w = bid; w < 64 + 8 + 1024; w += G) {
            if (w < 64) gla_scan_item(P, w);
            else if (w < 72) s5_scan_item(P, w - 64);
            else cmp_l2_item(P, l, w - 72);
        }
        xcd_barrier(xb);
#pragma unroll 1
        for (int w = bid; w < 512 + 256 + 2048; w += G) {
            if (w < 512) {
                const int bg = w & 3, q = w >> 2;
                nsa_unit(P, l, bg, 255 - q, smem);
                nsa_unit(P, l, bg, q, smem);
            } else if (w < 512 + 256) s5o_gemm_tile(P, l, w - 512, smem);
            else gla_out_item(P, l, w - 512 - 256, smem);
        }
        xcd_barrier(xb);
#pragma unroll 1
        for (int w = bid; w < 512; w += G) glu_tile(P, l, w, smem);
        xcd_barrier(xb);
        {
            const int xcd = bid & 7, jx = bid >> 3, nper = G >> 3;
            for (int u = jx; u < 128; u += nper) outproj_tile(P, l, xcd * 16 + (u >> 6) * 8 + (u & 7), (u & 63) >> 3, smem);
        }
        xcd_barrier(xb);
    }
}

extern "C" void kernel_launch(void* const* d_in, const int* in_sizes, int n_in, void* d_out, int out_size, void* d_ws,
                              size_t ws_size, hipStream_t stream) {
    static int grid_blocks = 0;
    if (!grid_blocks) {
        int dev = 0, cus = 0, per_cu = 0;
        hipGetDevice(&dev);
        hipDeviceGetAttribute(&cus, hipDeviceAttributeMultiprocessorCount, dev);
        hipFuncSetAttribute((const void*)fwd_megakernel, hipFuncAttributeMaxDynamicSharedMemorySize, SMEM_BYTES);
        hipOccupancyMaxActiveBlocksPerMultiprocessor(&per_cu, fwd_megakernel, NTHREADS, SMEM_BYTES);
        if (per_cu < 1) per_cu = 1;
        if (per_cu > 2) per_cu = 2;
        grid_blocks = cus * per_cu;
        if (ws_size < WS_END) fprintf(stderr, "kernel_launch: workspace too small: %zu < %zu\n", ws_size, (size_t)WS_END);
    }
    Params p{};
    for (int i = 0; i < 25; ++i) p.in[i] = (const float*)d_in[i];
    p.out = (float*)d_out;
    p.ws = (char*)d_ws;
    void* args[] = {&p};
    hipError_t e = hipLaunchCooperativeKernel((const void*)fwd_megakernel, dim3(grid_blocks), dim3(NTHREADS), args, SMEM_BYTES, stream);
    if (e != hipSuccess) fprintf(stderr, "cooperative launch failed: %s (grid %d)\n", hipGetErrorString(e), grid_blocks);
}
```

```cpp
#include <hip/hip_runtime.h>
#include <hip/hip_cooperative_groups.h>
#include <cstdio>
#include <cstdint>
namespace cg = cooperative_groups;

typedef _Float16 h16;
typedef _Float16 half8 __attribute__((ext_vector_type(8)));
typedef _Float16 half4 __attribute__((ext_vector_type(4)));
typedef float f32x4 __attribute__((ext_vector_type(4)));
typedef float f32x16 __attribute__((ext_vector_type(16)));

#define DI __device__ __forceinline__

constexpr int D_MODEL = 1024, BATCH = 2, SEQ = 8192, DEPTH = 4, NT = BATCH * SEQ;
constexpr int D_IN = 3112, D_IN_PAD = 3200;
constexpr int C_NQ = 0, C_NKV = 512, C_NG = 1280, C_GQ = 1792, C_GK = 1920, C_GV = 2048, C_GG = 2304, C_SU = 2560, C_SG = 2816,
              C_GLR = 3072, C_NGL = 3088;
__host__ __device__ constexpr int map_col(int c) {
    return c < 128 ? C_GQ + c : c < 256 ? C_GK + (c - 128) : c < 512 ? C_GV + (c - 256) : c < 528 ? C_GLR + (c - 512)
         : c < 784 ? C_GG + (c - 528) : c < 1040 ? C_SU + (c - 784) : c < 1296 ? C_SG + (c - 1040) : c < 1808 ? C_NQ + (c - 1296)
         : c < 2576 ? C_NKV + (c - 1808) : c < 2600 ? C_NGL + (c - 2576) : c < 3112 ? C_NG + (c - 2600) : c;
}
constexpr int NTHREADS = 256;
constexpr float QSCALE = 0.125f * 1.4426950408889634f;

enum { I_X = 0, I_NORMG, I_WIN, I_GW2, I_GB2, I_GON, I_LRE, I_LIM, I_LSTEP, I_BRE, I_BIM, I_CRE, I_CIM, I_SD, I_GLUW, I_GLUB,
       I_NGB, I_NQN, I_NKN, I_CPOS, I_CW1, I_CB1, I_CW2, I_CB2, I_WOUT };

constexpr size_t OFF_WTIN  = 0;
constexpr size_t OFF_WTOUT = OFF_WTIN  + 4ull * D_IN_PAD * 1024 * 2;
constexpr size_t OFF_WTGLU = OFF_WTOUT + 4ull * 1024 * 1024 * 2;
constexpr size_t OFF_WTC1  = OFF_WTGLU + 4ull * 512 * 256 * 2;
constexpr size_t OFF_PROJ  = OFF_WTC1  + 4ull * 2 * 256 * 2048 * 2;
constexpr size_t OFF_MIX   = OFF_PROJ  + (size_t)NT * D_IN * 2;
constexpr size_t OFF_YACT  = OFF_MIX   + (size_t)NT * 1024 * 2;
constexpr size_t OFF_XH    = OFF_YACT;
constexpr size_t OFF_BCUM  = OFF_YACT  + (size_t)NT * 256 * 2;
constexpr size_t OFF_GKV   = OFF_BCUM  + (size_t)NT * 128 * 4;
constexpr size_t OFF_GDEC  = OFF_GKV   + 8ull * 256 * 2048 * 4;
static_assert(OFF_GDEC - OFF_XH >= (size_t)NT * 1024 * 2, "XH alias region too small");
constexpr size_t OFF_XC    = OFF_GDEC  + 8ull * 256 * 32 * 4;
constexpr size_t OFF_S5W   = OFF_XC    + 512ull * 1024 * 2 * 4;
constexpr size_t OFF_S5E   = OFF_S5W   + 16ull * 512 * 640 * 2;
constexpr size_t OFF_S5AL  = OFF_S5E   + 16ull * 128 * 512 * 2;
constexpr size_t OFF_CHID  = OFF_S5AL  + 1024ull * 2 * 4;
constexpr size_t OFF_POSB  = OFF_CHID  + 2ull * 2048 * 512 * 4;
constexpr size_t OFF_KCMP  = OFF_POSB  + 8ull * 256 * 4;
constexpr size_t OFF_VCMP  = OFF_KCMP  + 4ull * 512 * 64 * 2;
constexpr size_t OFF_VTG   = OFF_VCMP  + 4ull * 512 * 64 * 2;
constexpr size_t OFF_BAR   = OFF_VTG   + 2ull * 4 * 128 * 4096 * 2;
constexpr size_t WS_END    = OFF_BAR   + 16384;

struct Params {
    const float* in[25];
    float* out;
    char* ws;
};

constexpr int SMEM_MAIN = 65536;
constexpr int SMEM_BYTES = SMEM_MAIN + 16;

DI int otid() { int t = threadIdx.x; asm volatile("" : "+v"(t)); return t; }
DI float wave_sum(float v) {
#pragma unroll
    for (int o = 32; o > 0; o >>= 1) v += __shfl_xor(v, o);
    return v;
}
DI float wave_max(float v) {
#pragma unroll
    for (int o = 32; o > 0; o >>= 1) v = fmaxf(v, __shfl_xor(v, o));
    return v;
}
DI float sigmoidf_(float x) { return 1.f / (1.f + __expf(-x)); }
DI float siluf_(float x) { return x / (1.f + __expf(-x)); }
DI float gelu_tanh(float x) {
    const float u = 0.7978845608028654f * (x + 0.044715f * x * x * x);
    return 0.5f * x * (1.f + tanhf(u));
}
DI float log_sigmoidf_(float x) { return fminf(x, 0.f) - log1pf(__expf(-fabsf(x))); }

template <class AL>
DI void gemm_mainloop(const int K, AL& al, const h16* __restrict__ Bt, const int ldb, f32x4 (&acc)[4][4], char* smem) {
    h16 (*As)[72] = (h16 (*)[72])smem;
    h16 (*Bs)[72] = (h16 (*)[72])(smem + 128 * 72 * 2);
    const int tid = otid(), lane = tid & 63, wid = tid >> 6, wr = wid >> 1, wc = wid & 1;
    const int lrow = tid >> 1, lcol = (tid & 1) * 32;
#pragma unroll
    for (int i = 0; i < 4; ++i)
#pragma unroll
        for (int j = 0; j < 4; ++j) acc[i][j] = (f32x4){0.f, 0.f, 0.f, 0.f};
    half8 ra[4], rb[4];
    al.load(lrow, lcol, ra);
    const h16* bp = Bt + (size_t)lrow * ldb + lcol;
#pragma unroll
    for (int q = 0; q < 4; ++q) rb[q] = *(const half8*)(bp + q * 8);
    for (int k0 = 0; k0 < K; k0 += 64) {
#pragma unroll
        for (int q = 0; q < 4; ++q) {
            *(half8*)&As[lrow][lcol + q * 8] = ra[q];
            *(half8*)&Bs[lrow][lcol + q * 8] = rb[q];
        }
        __syncthreads();
        if (k0 + 64 < K) {
            al.load(lrow, k0 + 64 + lcol, ra);
#pragma unroll
            for (int q = 0; q < 4; ++q) rb[q] = *(const half8*)(bp + k0 + 64 + q * 8);
        }
#pragma unroll
        for (int kk = 0; kk < 2; ++kk) {
            half8 af[4], bf[4];
#pragma unroll
            for (int i = 0; i < 4; ++i) af[i] = *(const half8*)&As[wr * 64 + i * 16 + (lane & 15)][kk * 32 + (lane >> 4) * 8];
#pragma unroll
            for (int j = 0; j < 4; ++j) bf[j] = *(const half8*)&Bs[wc * 64 + j * 16 + (lane & 15)][kk * 32 + (lane >> 4) * 8];
#pragma unroll
            for (int i = 0; i < 4; ++i)
#pragma unroll
                for (int j = 0; j < 4; ++j) acc[i][j] = __builtin_amdgcn_mfma_f32_16x16x32_f16(bf[j], af[i], acc[i][j], 0, 0, 0);
        }
        __syncthreads();
    }
}

typedef _Float16 half2_ __attribute__((ext_vector_type(2)));
DI void glds16(const h16* g, char* l) {
    __builtin_amdgcn_global_load_lds((const __attribute__((address_space(1))) void*)g, (__attribute__((address_space(3))) void*)l, 16, 0, 0);
}
template <bool SUMSQ>
DI void gemm_mainloop_glds(const int K, const h16* __restrict__ A, const size_t lda, const h16* __restrict__ Bt, const int ldb,
                           f32x4 (&acc)[4][4], float (&ss)[4], char* smem, const size_t astep = 64) {
    const int tid = otid(), lane = tid & 63, wid = tid >> 6, wr = wid >> 1, wc = wid & 1;
#pragma unroll
    for (int i = 0; i < 4; ++i) {
        ss[i] = 0.f;
#pragma unroll
        for (int j = 0; j < 4; ++j) acc[i][j] = (f32x4){0.f, 0.f, 0.f, 0.f};
    }
    const int lrow = wid * 8 + (lane >> 3);
    const int lsw = ((lane & 7) ^ ((lrow >> 1) & 7)) * 8;
    const h16* ap = A + (size_t)lrow * lda + lsw;
    const h16* bp = Bt + (size_t)lrow * ldb + lsw;
    char* lbase = smem + wid * 1024;
    const int fr = lane & 15, fq = lane >> 4;
    int aoff[4], boff[4];
#pragma unroll
    for (int i = 0; i < 4; ++i) {
        const int m = wr * 64 + i * 16 + fr, n = wc * 64 + i * 16 + fr;
        aoff[i] = m * 128 + ((fq ^ ((m >> 1) & 7)) * 16);
        boff[i] = n * 128 + ((fq ^ ((n >> 1) & 7)) * 16);
    }
    const int nk = K >> 6;
    for (int kt = 0; kt < nk; ++kt) {
        __syncthreads();
        char* cur = smem;
        {
            const int k1 = kt * 64;
            const size_t ka = (size_t)kt * astep;
#pragma unroll
            for (int q = 0; q < 4; ++q) {
                glds16(ap + (size_t)q * 32 * lda + ka, lbase + q * 4096);
                glds16(bp + (size_t)q * 32 * ldb + k1, lbase + 16384 + q * 4096);
            }
        }
        asm volatile("s_waitcnt vmcnt(0)" ::: "memory");
        __syncthreads();
#pragma unroll
        for (int kk = 0; kk < 2; ++kk) {
            half8 af[4], bf[4];
#pragma unroll
            for (int i = 0; i < 4; ++i) af[i] = *(const half8*)(cur + (aoff[i] ^ (kk * 64)));
#pragma unroll
            for (int j = 0; j < 4; ++j) bf[j] = *(const half8*)(cur + 16384 + (boff[j] ^ (kk * 64)));
            if (SUMSQ) {
#pragma unroll
                for (int i = 0; i < 4; ++i)
#pragma unroll
                    for (int e = 0; e < 4; ++e) {
                        const half2_ x = (half2_){af[i][2 * e], af[i][2 * e + 1]};
                        ss[i] = __builtin_amdgcn_fdot2(x, x, ss[i], false);
                    }
            }
#pragma unroll
            for (int i = 0; i < 4; ++i)
#pragma unroll
                for (int j = 0; j < 4; ++j) acc[i][j] = __builtin_amdgcn_mfma_f32_16x16x32_f16(bf[j], af[i], acc[i][j], 0, 0, 0);
        }
    }
    __syncthreads();
    if (SUMSQ) {
#pragma unroll
        for (int i = 0; i < 4; ++i) { ss[i] += __shfl_xor(ss[i], 16); ss[i] += __shfl_xor(ss[i], 32); }
    }
}

struct XLoader {
    const float* x; float ss;
    DI void load(int row, int k, half8 (&r)[4]) {
        const float4* p = (const float4*)(x + (size_t)row * 1024 + k);
#pragma unroll
        for (int q = 0; q < 4; ++q) {
            const float4 a = p[2 * q], b = p[2 * q + 1];
            ss += a.x * a.x + a.y * a.y + a.z * a.z + a.w * a.w + b.x * b.x + b.y * b.y + b.z * b.z + b.w * b.w;
            r[q] = (half8){(h16)a.x, (h16)a.y, (h16)a.z, (h16)a.w, (h16)b.x, (h16)b.y, (h16)b.z, (h16)b.w};
        }
    }
};
struct HLoader {
    const h16* a; int ld;
    DI void load(int row, int k, half8 (&r)[4]) {
        const half8* p = (const half8*)(a + (size_t)row * ld + k);
#pragma unroll
        for (int q = 0; q < 4; ++q) r[q] = p[q];
    }
};
struct CmpLoader {
    const h16* proj; const float* pos; int j; int row0;
    DI void load(int row, int k, half8 (&r)[4]) {
        const int rr = row0 + row, bg = rr >> 9, i = rr & 511, b = bg >> 1, g = bg & 1;
        const int l = k >> 6, d = k & 63;
        int t = 16 * i + l; t = t > SEQ - 1 ? SEQ - 1 : t;
        const half8* p = (const half8*)(proj + ((size_t)b * SEQ + t) * D_IN + C_NKV + j * 128 + g * 64 + d);
        const float4* pp = (const float4*)(pos + l * 64 + d);
#pragma unroll
        for (int q = 0; q < 4; ++q) {
            const half8 v = p[q]; const float4 a = pp[2 * q], c = pp[2 * q + 1];
            r[q] = (half8){(h16)((float)v[0] + a.x), (h16)((float)v[1] + a.y), (h16)((float)v[2] + a.z), (h16)((float)v[3] + a.w),
                           (h16)((float)v[4] + c.x), (h16)((float)v[5] + c.y), (h16)((float)v[6] + c.z), (h16)((float)v[7] + c.w)};
        }
    }
};
struct S5ULoader {
    const h16* proj; const float* xin; int g; int row0;
    DI void load(int row, int k, half8 (&r)[4]) {
        const int ch = row0 + row;
        if (k < 512) {
            const int s0 = k >> 4;
            const half8* p0 = (const half8*)(proj + ((size_t)ch * 32 + s0) * D_IN + C_SU + g * 16);
            const half8* p1 = (const half8*)(proj + ((size_t)ch * 32 + s0 + 1) * D_IN + C_SU + g * 16);
            r[0] = p0[0]; r[1] = p0[1]; r[2] = p1[0]; r[3] = p1[1];
        } else {
            const float4* p = (const float4*)(xin + ((size_t)ch * 1024 + g * 64) * 2 + (k - 512));
#pragma unroll
            for (int q = 0; q < 4; ++q) {
                const float4 a = p[2 * q], b = p[2 * q + 1];
                r[q] = (half8){(h16)a.x, (h16)a.y, (h16)a.z, (h16)a.w, (h16)b.x, (h16)b.y, (h16)b.z, (h16)b.w};
            }
        }
    }
};

template <bool MAP>
DI void transpose_tile(const float* __restrict__ src, int R, int C, h16* __restrict__ dst, int r0, int c0,
                       const float* __restrict__ rscale, float* tile) {
    const int tx = otid() & 31, ty = otid() >> 5;
    for (int yy = ty; yy < 32; yy += 8) {
        const int r = r0 + yy, c = c0 + tx;
        float v = (c < C) ? src[(size_t)r * C + c] : 0.f;
        if (rscale) v *= rscale[r];
        tile[yy * 33 + tx] = v;
    }
    __syncthreads();
    for (int yy = ty; yy < 32; yy += 8) {
        const int c = c0 + yy, r = r0 + tx;
        dst[(size_t)(MAP ? map_col(c) : c) * R + r] = (h16)tile[tx * 33 + yy];
    }
    __syncthreads();
}

DI int glu_perm_src(int np) {
    const int t = np >> 7, w = (np >> 6) & 1, j = (np >> 4) & 3, e = np & 15;
    const int c = t * 64 + w * 32 + (j >> 1) * 16 + e;
    return c + (j & 1) * 256;
}

DI void phase0(const Params& P, char* smem) {
    float* tile = (float*)smem;
    constexpr int N_WIN = 4 * 32 * 100, N_WOUT = 4 * 32 * 32, N_C1 = 8 * 64 * 8, N_GLU = 2048, N_XH = NT * 1024 / 2048, N_PB = 8;
    const int total = N_WIN + N_WOUT + N_C1 + N_GLU + N_XH + N_PB;
    for (int w = blockIdx.x; w < total; w += gridDim.x) {
        if (w < N_WIN) {
            const int l = w / 3200, r = w % 3200, rt = r / 100, ct = r % 100;
            transpose_tile<true>(P.in[I_WIN] + (size_t)l * 1024 * D_IN, 1024, D_IN, (h16*)(P.ws + OFF_WTIN) + (size_t)l * D_IN_PAD * 1024,
                           rt * 32, ct * 32, P.in[I_NORMG] + l * 1024, tile);
        } else if (w < N_WIN + N_WOUT) {
            const int v = w - N_WIN, l = v >> 10, r = v & 1023, rt = r >> 5, ct = r & 31;
            transpose_tile<false>(P.in[I_WOUT] + (size_t)l * 1024 * 1024, 1024, 1024, (h16*)(P.ws + OFF_WTOUT) + (size_t)l * 1024 * 1024,
                           rt * 32, ct * 32, nullptr, tile);
        } else if (w < N_WIN + N_WOUT + N_C1) {
            const int v = w - N_WIN - N_WOUT, ljh = v >> 8, r = v & 255, rt = r >> 3, ct = r & 7;
            transpose_tile<false>(P.in[I_CW1] + (size_t)ljh * 1024 * 256, 1024, 256, (h16*)(P.ws + OFF_WTC1) + (size_t)ljh * 256 * 1024,
                           rt * 32, ct * 32, nullptr, tile);
        } else if (w >= N_WIN + N_WOUT + N_C1 + N_GLU + N_XH) {
            const int lj = w - (N_WIN + N_WOUT + N_C1 + N_GLU + N_XH), n = otid();
            const float* w1 = P.in[I_CW1] + (size_t)lj * 2048 * 256 + n;
            const float* pp = P.in[I_CPOS] + (size_t)lj * 2048;
            float a = P.in[I_CB1][lj * 256 + n];
#pragma unroll 16
            for (int k = 0; k < 2048; ++k) a += pp[k] * w1[(size_t)k * 256];
            ((float*)(P.ws + OFF_POSB))[lj * 256 + n] = a;
        } else if (w >= N_WIN + N_WOUT + N_C1 + N_GLU) {
            const size_t e0 = ((size_t)(w - N_WIN - N_WOUT - N_C1 - N_GLU) * 256 + otid()) * 8;
            const float4 a = *(const float4*)(P.in[I_X] + e0), b = *(const float4*)(P.in[I_X] + e0 + 4);
            *(half8*)((h16*)(P.ws + OFF_XH) + e0) = (half8){(h16)a.x, (h16)a.y, (h16)a.z, (h16)a.w, (h16)b.x, (h16)b.y, (h16)b.z, (h16)b.w};
        } else {
            const int v = w - N_WIN - N_WOUT - N_C1;
            const int idx = v * 256 + otid();
            const int l = idx >> 17, rem = idx & 131071, np = rem >> 8, k = rem & 255;
            ((h16*)(P.ws + OFF_WTGLU))[idx] = (h16)P.in[I_GLUW][((size_t)l * 256 + k) * 512 + glu_perm_src(np)];
        }
    }
}

DI void s5_build_item(const Params& P, int l, int item, char* smem) {
    float* apow = (float*)smem;
    float* bbar = apow + 64 * 33 * 2;
    float* cc   = bbar + 64 * 16 * 2;
    const int tid = otid();
    const int g = (item < 256) ? (item >> 4) : ((item - 256) >> 2);
    if (tid < 64) {
        const int p = tid;
        const double lre = fmin((double)P.in[I_LRE][(l * 16 + g) * 64 + p], -1e-4);
        const double lim = (double)P.in[I_LIM][(l * 16 + g) * 64 + p];
        const double dt = exp((double)P.in[I_LSTEP][l * 16 + g]);
        const double mag = exp(lre * dt);
        const double ar = mag * cos(lim * dt), ai = mag * sin(lim * dt);
        const double den = lre * lre + lim * lim;
        const double fr = ((ar - 1.0) * lre + ai * lim) / den;
        const double fi = (ai * lre - (ar - 1.0) * lim) / den;
        double pr = 1.0, pi = 0.0;
        for (int k = 0; k <= 32; ++k) {
            apow[(p * 33 + k) * 2] = (float)pr; apow[(p * 33 + k) * 2 + 1] = (float)pi;
            const double nr = pr * ar - pi * ai, ni = pr * ai + pi * ar; pr = nr; pi = ni;
        }
        for (int c = 0; c < 16; ++c) {
            const double br = (double)P.in[I_BRE][((size_t)(l * 16 + g) * 64 + p) * 16 + c];
            const double bi = (double)P.in[I_BIM][((size_t)(l * 16 + g) * 64 + p) * 16 + c];
            bbar[(p * 16 + c) * 2] = (float)(fr * br - fi * bi);
            bbar[(p * 16 + c) * 2 + 1] = (float)(fr * bi + fi * br);
        }
    }
    for (int e = tid; e < 1024; e += 256) {
        cc[e * 2] = P.in[I_CRE][(size_t)(l * 16 + g) * 1024 + e];
        cc[e * 2 + 1] = P.in[I_CIM][(size_t)(l * 16 + g) * 1024 + e];
    }
    __syncthreads();
    if (item < 256) {
        const int c = item & 15;
        float* kt = cc + 2048;
        for (int idx = tid; idx < 512; idx += 256) {
            const int lag = idx >> 4, c2 = idx & 15;
            float a = 0.f;
            for (int p = 0; p < 64; ++p) {
                const float cr = cc[(c * 64 + p) * 2], ci = cc[(c * 64 + p) * 2 + 1];
                const float xr = apow[(p * 33 + lag) * 2], xi = apow[(p * 33 + lag) * 2 + 1];
                const float br = bbar[(p * 16 + c2) * 2], bi = bbar[(p * 16 + c2) * 2 + 1];
                const float tr = cr * xr - ci * xi, ti = cr * xi + ci * xr;
                a += tr * br - ti * bi;
            }
            kt[idx] = a;
        }
        __syncthreads();
        h16* W = (h16*)(P.ws + OFF_S5W) + (size_t)g * 512 * 640;
        for (int idx = tid; idx < 32 * 640; idx += 256) {
            const int j = idx / 640, k = idx % 640;
            float val = 0.f;
            if (k < 512) {
                const int s = k >> 4, c2 = k & 15, lag = j - s;
                if (lag >= 0) val = kt[lag * 16 + c2];
            } else {
                const int p = (k - 512) >> 1;
                const float cr = cc[(c * 64 + p) * 2], ci = cc[(c * 64 + p) * 2 + 1];
                const float xr = apow[(p * 33 + j + 1) * 2], xi = apow[(p * 33 + j + 1) * 2 + 1];
                val = (k & 1) ? -(cr * xi + ci * xr) : (cr * xr - ci * xi);
            }
            W[(size_t)(j * 16 + c) * 640 + k] = (h16)val;
        }
    } else {
        const int pq = (item - 256) & 3;
        h16* E = (h16*)(P.ws + OFF_S5E) + ((size_t)g * 128 + pq * 32) * 512;
        for (int idx = tid; idx < 32 * 512; idx += 256) {
            const int nl = idx >> 9, k = idx & 511;
            const int p = pq * 16 + (nl >> 1), s = k >> 4, c2 = k & 15;
            const float xr = apow[(p * 33 + 31 - s) * 2], xi = apow[(p * 33 + 31 - s) * 2 + 1];
            const float br = bbar[(p * 16 + c2) * 2], bi = bbar[(p * 16 + c2) * 2 + 1];
            const float val = (nl & 1) ? (xr * bi + xi * br) : (xr * br - xi * bi);
            E[(size_t)nl * 512 + k] = (h16)val;
        }
        if (tid < 16) {
            const int p = pq * 16 + tid;
            float* AL = (float*)(P.ws + OFF_S5AL);
            AL[(g * 64 + p) * 2] = apow[(p * 33 + 32) * 2];
            AL[(g * 64 + p) * 2 + 1] = apow[(p * 33 + 32) * 2 + 1];
        }
    }
    __syncthreads();
}

DI void inproj_tile(const Params& P, int l, int mt, int nt, char* smem) {
    f32x4 acc[4][4];
    float ss[4];
    gemm_mainloop_glds<true>(1024, (const h16*)(P.ws + OFF_XH) + (size_t)mt * 128 * 1024, 1024,
                             (const h16*)(P.ws + OFF_WTIN) + ((size_t)l * D_IN_PAD + nt * 128) * 1024, 1024, acc, ss, smem);
    const int tid = otid(), lane = tid & 63, wid = tid >> 6, wr = wid >> 1, wc = wid & 1;
    h16* proj = (h16*)(P.ws + OFF_PROJ);
    const int n64 = nt * 128 + wc * 64;
    int cls = 0;
    if (n64 < 512) cls = 1;
    else if (n64 >= C_NKV + 256 && n64 < C_NKV + 384) cls = 2;
    else if (n64 >= C_NKV + 512 && n64 < C_NKV + 640) cls = 3;
    else if (n64 >= C_NKV + 384 && n64 < C_NKV + 512) cls = 4;
    else if (n64 >= C_NKV + 640 && n64 < C_NKV + 768) cls = 5;
    float wn[4][4];
    if (cls >= 1 && cls <= 3) {
        const float* wp = (cls == 1) ? P.in[I_NQN] + l * 64 : P.in[I_NKN] + (l * 3 + (cls - 1)) * 64;
        const float sc = (cls == 1) ? QSCALE : 1.f;
#pragma unroll
        for (int j = 0; j < 4; ++j) {
            const float4 w4 = *(const float4*)(wp + j * 16 + (lane >> 4) * 4);
            wn[j][0] = w4.x * sc; wn[j][1] = w4.y * sc; wn[j][2] = w4.z * sc; wn[j][3] = w4.w * sc;
        }
    }
#pragma unroll
    for (int i = 0; i < 4; ++i) {
        const int ml = wr * 64 + i * 16 + (lane & 15);
        const float r = rsqrtf(ss[i] * (1.f / 1024.f) + 1e-6f);
        const size_t row = (size_t)mt * 128 + ml;
        f32x4 v[4];
#pragma unroll
        for (int j = 0; j < 4; ++j) v[j] = acc[i][j] * r;
        if (cls >= 1 && cls <= 3) {
            float ss = 0.f;
#pragma unroll
            for (int j = 0; j < 4; ++j) ss += v[j][0] * v[j][0] + v[j][1] * v[j][1] + v[j][2] * v[j][2] + v[j][3] * v[j][3];
            ss += __shfl_xor(ss, 16); ss += __shfl_xor(ss, 32);
            const float rn = rsqrtf(ss * (1.f / 64.f) + 1e-6f);
#pragma unroll
            for (int j = 0; j < 4; ++j) { v[j][0] *= rn * wn[j][0]; v[j][1] *= rn * wn[j][1]; v[j][2] *= rn * wn[j][2]; v[j][3] *= rn * wn[j][3]; }
        }
        if (cls >= 4) {
            const int g = (n64 >> 6) & 1, br = cls - 4;
            const int b = (int)(row >> 13), t = (int)(row & 8191);
            h16* vt = (h16*)(P.ws + OFF_VTG) + ((((size_t)br * 4 + b * 2 + g) * 128 + (t >> 6)) * 64) * 64 + (t & 63);
#pragma unroll
            for (int j = 0; j < 4; ++j)
#pragma unroll
                for (int e = 0; e < 4; ++e) vt[(j * 16 + (lane >> 4) * 4 + e) * 64] = (h16)v[j][e];
        }
#pragma unroll
        for (int j = 0; j < 4; ++j) {
            const int n = n64 + j * 16 + (lane >> 4) * 4;
            if (n < D_IN) *(half4*)(proj + row * D_IN + n) = (half4){(h16)v[j][0], (h16)v[j][1], (h16)v[j][2], (h16)v[j][3]};
        }
    }
    __syncthreads();
}

DI void gla_kv_item(const Params& P, int l, int item, char* smem) {
    const int h = item & 3, cn = item >> 2;
    const size_t tok0 = (size_t)cn * 32;
    float* gl = (float*)smem;
    float* ke = gl + 32 * 33;
    float* vs = ke + 32 * 33;
    const h16* proj = (const h16*)(P.ws + OFF_PROJ);
    const int tid = otid(), i = tid >> 3, dq = (tid & 7) * 4, e0 = (tid & 7) * 8;
    {
        const half8* lp = (const half8*)(proj + (tok0 + i) * D_IN + C_GLR);
        const half8 l0 = lp[0], l1 = lp[1];
        float lr[16];
#pragma unroll
        for (int r = 0; r < 8; ++r) { lr[r] = (float)l0[r]; lr[8 + r] = (float)l1[r]; }
#pragma unroll
        for (int dd = 0; dd < 4; ++dd) {
            const int d = dq + dd;
            float x = P.in[I_GB2][l * 128 + h * 32 + d];
#pragma unroll
            for (int r = 0; r < 16; ++r) x += lr[r] * P.in[I_GW2][(l * 16 + r) * 128 + h * 32 + d];
            gl[i * 33 + d] = log_sigmoidf_(x) * (1.f / 16.f);
        }
    }
    __syncthreads();
    if (tid < 32) {
        float run = 0.f;
        float* bc = (float*)(P.ws + OFF_BCUM);
        for (int ii = 0; ii < 32; ++ii) {
            run += gl[ii * 33 + tid]; gl[ii * 33 + tid] = run;
            bc[(tok0 + ii) * 128 + h * 32 + tid] = run;
        }
    }
    __syncthreads();
    {
        const half4 kv4 = *(const half4*)(proj + (tok0 + i) * D_IN + C_GK + h * 32 + dq);
#pragma unroll
        for (int dd = 0; dd < 4; ++dd) {
            const int d = dq + dd;
            ke[i * 33 + d] = (float)kv4[dd] * __expf(gl[31 * 33 + d] - gl[i * 33 + d]);
        }
        const half8 v8 = *(const half8*)(proj + (tok0 + i) * D_IN + C_GV + h * 64 + e0);
#pragma unroll
        for (int e = 0; e < 8; ++e) vs[i * 64 + e0 + e] = (float)v8[e];
    }
    __syncthreads();
    {
        const int d = tid >> 3;
        float acc[8];
#pragma unroll
        for (int e = 0; e < 8; ++e) acc[e] = 0.f;
        for (int c = 0; c < 32; ++c) {
            const float kd = ke[c * 33 + d];
#pragma unroll
            for (int e = 0; e < 8; ++e) acc[e] += kd * vs[c * 64 + e0 + e];
        }
        const int b = cn >> 8, n = cn & 255, bh = b * 4 + h;
        float* kvp = (float*)(P.ws + OFF_GKV) + ((size_t)(bh * 256 + n) * 32 + d) * 64 + e0;
        *(float4*)kvp = (float4){acc[0], acc[1], acc[2], acc[3]};
        *(float4*)(kvp + 4) = (float4){acc[4], acc[5], acc[6], acc[7]};
        if (tid < 32) ((float*)(P.ws + OFF_GDEC))[(size_t)(bh * 256 + n) * 32 + tid] = __expf(gl[31 * 33 + tid]);
    }
    __syncthreads();
}

DI void cmp_gemm_tile(const Params& P, int l, int tile, char* smem) {
    const int j = tile >> 6, mt = (tile >> 2) & 15, nt = tile & 3;
    const int row0 = mt * 128, bg = row0 >> 9, i0 = row0 & 511, b = bg >> 1, g = bg & 1;
    f32x4 acc[4][4];
    float ssd[4];
    gemm_mainloop_glds<false>(1024, (const h16*)(P.ws + OFF_PROJ) + ((size_t)b * SEQ + 16 * i0) * D_IN + C_NKV + j * 128 + g * 64, (size_t)16 * D_IN,
                              (const h16*)(P.ws + OFF_WTC1) + ((size_t)(l * 2 + j) * 512 + nt * 128) * 1024, 1024, acc, ssd, smem, (size_t)D_IN);
    const int tid = otid(), lane = tid & 63, wid = tid >> 6, wr = wid >> 1, wc = wid & 1;
    float* pt = (float*)(P.ws + OFF_CHID) + (size_t)j * 2048 * 512;
#pragma unroll
    for (int i = 0; i < 4; ++i) {
        const size_t row = (size_t)row0 + wr * 64 + i * 16 + (lane & 15);
#pragma unroll
        for (int jj = 0; jj < 4; ++jj) {
            const int n = nt * 128 + wc * 64 + jj * 16 + (lane >> 4) * 4;
            const f32x4 v = acc[i][jj];
            *(float4*)(pt + row * 512 + n) = (float4){v[0], v[1], v[2], v[3]};
        }
    }
}

DI void s5e_gemm_tile(const Params& P, int l, int tile, char* smem) {
    const int g = tile >> 2, mt = tile & 3;
    S5ULoader al{(const h16*)(P.ws + OFF_PROJ), nullptr, g, mt * 128};
    f32x4 acc[4][4];
    gemm_mainloop(512, al, (const h16*)(P.ws + OFF_S5E) + (size_t)g * 128 * 512, 512, acc, smem);
    const int tid = otid(), lane = tid & 63, wid = tid >> 6, wr = wid >> 1, wc = wid & 1;
    float* xc = (float*)(P.ws + OFF_XC);
#pragma unroll
    for (int i = 0; i < 4; ++i) {
        const size_t ch = (size_t)mt * 128 + wr * 64 + i * 16 + (lane & 15);
#pragma unroll
        for (int jj = 0; jj < 4; ++jj) {
            const int n = wc * 64 + jj * 16 + (lane >> 4) * 4;
            const f32x4 v = acc[i][jj];
            *(float4*)(xc + (ch * 1024 + g * 64) * 2 + n) = (float4){v[0], v[1], v[2], v[3]};
        }
    }
}

DI void gla_scan_item(const Params& P, int item, char* smem) {
    const int tid = otid(), sl = tid & 31, part = tid >> 5;
    const int idx = item * 32 + sl, bh = idx >> 11, de = idx & 2047, d = de >> 6;
    float* kv = (float*)(P.ws + OFF_GKV) + ((size_t)bh * 256 + part * 32) * 2048 + de;
    const float* dc = (const float*)(P.ws + OFF_GDEC) + ((size_t)bh * 256 + part * 32) * 32 + d;
    float* sD = (float*)smem; float* sL = sD + 256;
    float kvv[32], dd[32];
#pragma unroll
    for (int i = 0; i < 32; ++i) { kvv[i] = kv[(size_t)i * 2048]; dd[i] = dc[i * 32]; }
    float D = 1.f, L = 0.f;
#pragma unroll
    for (int i = 0; i < 32; ++i) { L = dd[i] * L + kvv[i]; D *= dd[i]; }
    sD[part * 32 + sl] = D; sL[part * 32 + sl] = L;
    __syncthreads();
    float S = 0.f;
    for (int q = 0; q < part; ++q) S = sD[q * 32 + sl] * S + sL[q * 32 + sl];
#pragma unroll
    for (int i = 0; i < 32; ++i) { const float o = S; S = dd[i] * S + kvv[i]; kv[(size_t)i * 2048] = o; }
    __syncthreads();
}
DI void s5_scan_item(const Params& P, int item, char* smem) {
    const int tid = otid(), sl = tid & 31, part = tid >> 5;
    const int idx = item * 32 + sl, b = idx >> 10, s = idx & 1023;
    float2* xc = (float2*)(P.ws + OFF_XC) + ((size_t)b * 256 + part * 32) * 1024 + s;
    const float2 a = ((const float2*)(P.ws + OFF_S5AL))[s];
    float2* sL = (float2*)smem;
    float2 c[32];
#pragma unroll
    for (int i = 0; i < 32; ++i) c[i] = xc[(size_t)i * 1024];
    float lr = 0.f, li = 0.f;
#pragma unroll
    for (int i = 0; i < 32; ++i) { const float nr = a.x * lr - a.y * li + c[i].x, ni = a.x * li + a.y * lr + c[i].y; lr = nr; li = ni; }
    float dr = a.x, di = a.y;
#pragma unroll
    for (int i = 0; i < 5; ++i) { const float nr = dr * dr - di * di, ni = 2.f * dr * di; dr = nr; di = ni; }
    sL[part * 32 + sl] = (float2){lr, li};
    __syncthreads();
    float xr = 0.f, xi = 0.f;
    for (int q = 0; q < part; ++q) { const float2 lq = sL[q * 32 + sl]; const float nr = dr * xr - di * xi + lq.x, ni = dr * xi + di * xr + lq.y; xr = nr; xi = ni; }
#pragma unroll
    for (int i = 0; i < 32; ++i) {
        const float2 o = (float2){xr, xi};
        const float nr = a.x * xr - a.y * xi + c[i].x, ni = a.x * xi + a.y * xr + c[i].y; xr = nr; xi = ni;
        xc[(size_t)i * 1024] = o;
    }
    __syncthreads();
}
DI void cmp_l2_item(const Params& P, int l, int item, char* smem) {
    const int tid = otid(), lane = tid & 63, w = tid >> 6;
    const int j = item >> 8, r0 = (item & 255) * 8;
    h16* w2s = (h16*)smem;
    float* hs = (float*)(smem + 32768);
    {
        const float* w2 = P.in[I_CW2] + (size_t)(l * 2 + j) * 256 * 64;
        for (int e = tid * 4; e < 256 * 64; e += 1024) {
            const float4 v = *(const float4*)(w2 + e);
            *(half4*)(w2s + e) = (half4){(h16)v.x, (h16)v.y, (h16)v.z, (h16)v.w};
        }
        const float* pt = (const float*)(P.ws + OFF_CHID) + (size_t)j * 2048 * 512;
        const float pb = ((const float*)(P.ws + OFF_POSB))[(l * 2 + j) * 256 + tid];
#pragma unroll
        for (int rr = 0; rr < 8; ++rr) {
            const int row = r0 + rr, i = row & 511;
            float v = 0.f;
            if (i < 511) v = gelu_tanh(pt[(size_t)row * 512 + tid] + pt[(size_t)(row + 1) * 512 + 256 + tid] + pb);
            hs[rr * 256 + tid] = v;
        }
    }
    __syncthreads();
    const float bb = P.in[I_CB2][(l * 2 + j) * 64 + lane];
    float a0 = bb, a1 = bb;
    const float* h0 = hs + (2 * w) * 256, *h1 = h0 + 256;
#pragma unroll 8
    for (int n = 0; n < 256; ++n) {
        const float wv = (float)w2s[n * 64 + lane];
        a0 += h0[n] * wv; a1 += h1[n] * wv;
    }
#pragma unroll
    for (int rr = 0; rr < 2; ++rr) {
        float acc = rr ? a1 : a0;
        const int row = r0 + 2 * w + rr, bg = row >> 9, i = row & 511;
        if (i == 511) acc = 0.f;
        if (j == 0) {
            const float ss = wave_sum(acc * acc);
            acc = acc * rsqrtf(ss * (1.f / 64.f) + 1e-6f) * P.in[I_NKN][(l * 3 + 0) * 64 + lane];
            ((h16*)(P.ws + OFF_KCMP))[(size_t)row * 64 + lane] = (h16)acc;
        } else {
            ((h16*)(P.ws + OFF_VCMP))[(((size_t)bg * 8 + (i >> 6)) * 64 + lane) * 64 + (i & 63)] = (h16)acc;
        }
    }
    __syncthreads();
}

DI void gla_out_item(const Params& P, int l, int item, char* smem) {
    const int h = item & 3, cn = item >> 2;
    const size_t tok0 = (size_t)cn * 32;
    float* qe = (float*)smem;
    float* ke = qe + 32 * 33;
    float* scs = ke + 32 * 33;
    float* vs = scs + 32 * 33;
    float* sp = vs + 32 * 64;
    const h16* proj = (const h16*)(P.ws + OFF_PROJ);
    const int tid = otid(), i = tid >> 3, dq = (tid & 7) * 4, e0 = (tid & 7) * 8;
    const int b = cn >> 8, n = cn & 255, bh = b * 4 + h;
    {
        const float4 bc = *(const float4*)((const float*)(P.ws + OFF_BCUM) + (tok0 + i) * 128 + h * 32 + dq);
        const half4 q4 = *(const half4*)(proj + (tok0 + i) * D_IN + C_GQ + h * 32 + dq);
        const half4 k4 = *(const half4*)(proj + (tok0 + i) * D_IN + C_GK + h * 32 + dq);
        const float bcv[4] = {bc.x, bc.y, bc.z, bc.w};
#pragma unroll
        for (int dd = 0; dd < 4; ++dd) {
            qe[i * 33 + dq + dd] = (float)q4[dd] * 0.17677669529663687f * __expf(bcv[dd]);
            ke[i * 33 + dq + dd] = (float)k4[dd] * __expf(-bcv[dd]);
        }
        const half8 v8 = *(const half8*)(proj + (tok0 + i) * D_IN + C_GV + h * 64 + e0);
#pragma unroll
        for (int e = 0; e < 8; ++e) vs[i * 64 + e0 + e] = (float)v8[e];
        const float* spp = (const float*)(P.ws + OFF_GKV) + (size_t)(bh * 256 + n) * 2048 + tid * 8;
        const float4 s0 = *(const float4*)spp, s1 = *(const float4*)(spp + 4);
        *(float4*)(sp + tid * 8) = s0; *(float4*)(sp + tid * 8 + 4) = s1;
    }
    __syncthreads();
    {
        const int j0 = (tid & 7) * 4;
#pragma unroll
        for (int jj = 0; jj < 4; ++jj) {
            const int j = j0 + jj;
            float s = 0.f;
            if (j <= i) for (int d = 0; d < 32; ++d) s += qe[i * 33 + d] * ke[j * 33 + d];
            scs[i * 33 + j] = s;
        }
    }
    __syncthreads();
    {
        float acc[8];
#pragma unroll
        for (int e = 0; e < 8; ++e) acc[e] = 0.f;
        for (int j = 0; j < 32; ++j) {
            const float s = scs[i * 33 + j], qd = qe[i * 33 + j];
#pragma unroll
            for (int e = 0; e < 8; ++e) acc[e] += s * vs[j * 64 + e0 + e] + qd * sp[j * 64 + e0 + e];
        }
        float ss = 0.f;
#pragma unroll
        for (int e = 0; e < 8; ++e) ss += acc[e] * acc[e];
        ss += __shfl_xor(ss, 1); ss += __shfl_xor(ss, 2); ss += __shfl_xor(ss, 4);
        const float r = rsqrtf(ss * (1.f / 64.f) + 1e-6f);
        const half8 g8 = *(const half8*)(proj + (tok0 + i) * D_IN + C_GG + h * 64 + e0);
        half8 o;
#pragma unroll
        for (int e = 0; e < 8; ++e) o[e] = (h16)(acc[e] * r * P.in[I_GON][l * 64 + e0 + e] * siluf_((float)g8[e]));
        *(half8*)((h16*)(P.ws + OFF_MIX) + (tok0 + i) * 1024 + h * 64 + e0) = o;
    }
    __syncthreads();
}

DI void s5o_gemm_tile(const Params& P, int l, int tile, char* smem) {
    const int g = tile >> 4, mt = (tile >> 2) & 3, nt = tile & 3;
    S5ULoader al{(const h16*)(P.ws + OFF_PROJ), (const float*)(P.ws + OFF_XC), g, mt * 128};
    f32x4 acc[4][4];
    gemm_mainloop(640, al, (const h16*)(P.ws + OFF_S5W) + ((size_t)g * 512 + nt * 128) * 640, 640, acc, smem);
    const int tid = otid(), lane = tid & 63, wid = tid >> 6, wr = wid >> 1, wc = wid & 1;
    const h16* proj = (const h16*)(P.ws + OFF_PROJ);
    h16* yact = (h16*)(P.ws + OFF_YACT);
#pragma unroll
    for (int i = 0; i < 4; ++i) {
        const size_t ch = (size_t)mt * 128 + wr * 64 + i * 16 + (lane & 15);
#pragma unroll
        for (int jj = 0; jj < 4; ++jj) {
            const int n = nt * 128 + wc * 64 + jj * 16 + (lane >> 4) * 4;
            const int j = n >> 4, c = n & 15;
            const size_t tok = ch * 32 + j;
            const half4 u4 = *(const half4*)(proj + tok * D_IN + C_SU + g * 16 + c);
            const float4 dd = *(const float4*)(P.in[I_SD] + (l * 16 + g) * 16 + c);
            const f32x4 v = acc[i][jj];
            half4 o;
            o[0] = (h16)gelu_tanh(v[0] + dd.x * (float)u4[0]);
            o[1] = (h16)gelu_tanh(v[1] + dd.y * (float)u4[1]);
            o[2] = (h16)gelu_tanh(v[2] + dd.z * (float)u4[2]);
            o[3] = (h16)gelu_tanh(v[3] + dd.w * (float)u4[3]);
            *(half4*)(yact + tok * 256 + g * 16 + c) = o;
        }
    }
}

#define MFMA32(a, b, c) __builtin_amdgcn_mfma_f32_32x32x16_f16((a), (b), (c), 0, 0, 0)
constexpr float NEGS = -1e30f;
DI float ex2(float x) { return __builtin_amdgcn_exp2f(x); }
#define NSA_WAITBAR(N) asm volatile("s_waitcnt vmcnt(" #N ") lgkmcnt(0)\n\ts_barrier" ::: "memory")
#define NSA_BAR() asm volatile("s_waitcnt lgkmcnt(0)\n\ts_barrier" ::: "memory")

struct KVSrc { const h16* k; int ldk; size_t kstep; const h16* v; };
DI void nsa_dma(const KVSrc& s, int j, char* stage, int wid, int lane) {
    const int row0 = wid * 8 + (lane >> 3);
    const int sw = ((lane & 7) ^ ((row0 >> 1) & 7)) * 8;
    const h16* kp = s.k + (size_t)j * s.kstep + (size_t)row0 * s.ldk + sw;
    glds16(kp, stage + wid * 1024);
    glds16(kp + (size_t)32 * s.ldk, stage + 4096 + wid * 1024);
    const h16* vp = s.v + (size_t)j * 4096 + row0 * 64 + sw;
    glds16(vp, stage + 8192 + wid * 1024);
    glds16(vp + 32 * 64, stage + 8192 + 4096 + wid * 1024);
}
template <int NST, class F>
DI void nsa_pipe(const KVSrc& s, const int n, char* smem, int wid, int lane, F&& compute) {
    NSA_WAITBAR(0);
    {
        const int k = n < NST - 1 ? n : NST - 1;
        for (int p = 0; p < k; ++p) nsa_dma(s, p, smem + p * 16384, wid, lane);
        if (k >= 3) NSA_WAITBAR(8); else if (k == 2) NSA_WAITBAR(4); else NSA_WAITBAR(0);
    }
    for (int j = 0; j < n; ++j) {
        if (NST == 4 && j + 2 < n) NSA_WAITBAR(4); else NSA_WAITBAR(0);
        const int jn = j + NST - 1;
        compute(j, smem + (j % NST) * 16384, [&]() { if (jn < n) nsa_dma(s, jn, smem + (jn % NST) * 16384, wid, lane); });
    }
}

DI void qk_tile(const char* Kimg, const half8 (&qf)[4], f32x16 (&s)[2], int lane) {
    const int r = lane & 31, h = lane >> 5, swz = (r >> 1) & 7;
    const char* base = Kimg + r * 128;
    half8 kf[8];
#pragma unroll
    for (int kt = 0; kt < 2; ++kt)
#pragma unroll
        for (int ks = 0; ks < 4; ++ks) kf[kt * 4 + ks] = *(const half8*)(base + kt * 4096 + (((2 * ks + h) ^ swz) << 4));
    __builtin_amdgcn_sched_barrier(0);
#pragma unroll
    for (int kt = 0; kt < 2; ++kt) {
#pragma unroll
        for (int e = 0; e < 16; ++e) s[kt][e] = 0.f;
#pragma unroll
        for (int ks = 0; ks < 4; ++ks) s[kt] = MFMA32(kf[kt * 4 + ks], qf[ks], s[kt]);
    }
}
template <int S> DI half8 pack8(const f32x16& x) {
    return (half8){(h16)x[8 * S], (h16)x[8 * S + 1], (h16)x[8 * S + 2], (h16)x[8 * S + 3], (h16)x[8 * S + 4], (h16)x[8 * S + 5], (h16)x[8 * S + 6], (h16)x[8 * S + 7]};
}
DI half8 ld_vfrag(const char* Vimg, int off0) {
    const half4 lo = *(const half4*)(Vimg + off0), hi = *(const half4*)(Vimg + (off0 ^ 16));
    return (half8){lo[0], lo[1], lo[2], lo[3], hi[0], hi[1], hi[2], hi[3]};
}
template <int KT>
DI void pv_load(const char* Vimg, half8 (&vf)[4], int lane) {
    const int r = lane & 31, h = lane >> 5, swz16 = ((r >> 1) & 7) << 4;
    const char* rb = Vimg + r * 128 + 8 * h;
#pragma unroll
    for (int dt = 0; dt < 2; ++dt) {
        vf[dt * 2 + 0] = ld_vfrag(rb + dt * 4096, ((4 * KT) << 4) ^ swz16);
        vf[dt * 2 + 1] = ld_vfrag(rb + dt * 4096, ((4 * KT + 2) << 4) ^ swz16);
    }
}
template <int KT>
DI void pv_mma(const half8 (&vf)[4], const f32x16 (&p)[2], f32x16 (&o)[2]) {
    const half8 pb0 = pack8<0>(p[KT]), pb1 = pack8<1>(p[KT]);
#pragma unroll
    for (int dt = 0; dt < 2; ++dt) {
        o[dt] = MFMA32(vf[dt * 2 + 0], pb0, o[dt]);
        o[dt] = MFMA32(vf[dt * 2 + 1], pb1, o[dt]);
    }
}
DI void pv_finish(const char* Vimg, const half8 (&va)[4], const f32x16 (&p)[2], f32x16 (&o)[2], int lane) {
    half8 vb[4];
    pv_load<1>(Vimg, vb, lane);
    pv_mma<0>(va, p, o);
    pv_mma<1>(vb, p, o);
}
DI float xhalf_max(float v) {
    const auto r = __builtin_amdgcn_permlane32_swap(__float_as_uint(v), __float_as_uint(v), false, false);
    return fmaxf(__uint_as_float(r[0]), __uint_as_float(r[1]));
}
DI float xhalf_sum(float v) {
    const auto r = __builtin_amdgcn_permlane32_swap(__float_as_uint(v), __float_as_uint(v), false, false);
    return __uint_as_float(r[0]) + __uint_as_float(r[1]);
}
DI float rowmax32(const f32x16 (&s)[2]) {
    float mx = s[0][0];
#pragma unroll
    for (int e = 1; e < 16; ++e) mx = fmaxf(mx, s[0][e]);
#pragma unroll
    for (int e = 0; e < 16; ++e) mx = fmaxf(mx, s[1][e]);
    return xhalf_max(mx);
}
constexpr float SM_THR = 6.f;
DI void sm_online(f32x16 (&s)[2], float& m, float& l, f32x16 (&o)[2], const bool rowok) {
    float mx = rowmax32(s);
    mx = rowok ? mx : NEGS;
    if (__any(mx > m + SM_THR)) {
        const float mn = fmaxf(m, mx), alpha = ex2(m - mn);
        l *= alpha; o[0] *= alpha; o[1] *= alpha; m = mn;
    }
    const float msub = rowok ? m : 1e30f;
    float rs = 0.f;
#pragma unroll
    for (int kt = 0; kt < 2; ++kt)
#pragma unroll
        for (int e = 0; e < 16; ++e) { const float p = ex2(s[kt][e] - msub); s[kt][e] = p; rs += p; }
    l += xhalf_sum(rs);
}

DI void nsa_unit(const Params& P, int l, int bg, int c32, char* smem) {
    const int tid = otid(), lane = tid & 63, w = tid >> 6, r = lane & 31, h = lane >> 5;
    const int b = bg >> 1, g = bg & 1, t0 = c32 * 32, cur = c32 >> 1;
    const int tokl = w * 8 + (r >> 2), head = r & 3, t = t0 + tokl;
    const size_t tokg = (size_t)b * SEQ + t;
    float* IMP = (float*)(smem + 49152);
    unsigned* SELM = (unsigned*)(smem + 49152);
    const h16* proj = (const h16*)(P.ws + OFF_PROJ);
    const int ghead = g * 4 + head;

    half8 qf[4];
    {
        const h16* qp = proj + tokg * D_IN + C_NQ + ghead * 64 + 8 * h;
#pragma unroll
        for (int ks = 0; ks < 4; ++ks) qf[ks] = *(const half8*)(qp + 16 * ks);
    }
    float g0, g1, g2;
    {
        const h16* gp = proj + tokg * D_IN + C_NGL + ghead * 3;
        const float* gb = P.in[I_NGB] + l * 24 + ghead * 3;
        g0 = sigmoidf_((float)gp[0] + gb[0]); g1 = sigmoidf_((float)gp[1] + gb[1]); g2 = sigmoidf_((float)gp[2] + gb[2]);
    }
    __syncthreads();
    for (int i = tid; i < 32 * 128; i += 256) IMP[i] = 0.f;

    f32x16 oacc[2];
#pragma unroll
    for (int e = 0; e < 16; ++e) { oacc[0][e] = 0.f; oacc[1][e] = 0.f; }

    {
        const int nvt = 2 * c32 + 1;
        const int nvr = (t >= 31) ? ((t - 31) >> 4) + 1 : 0;
        const int ntile = (nvt + 63) >> 6;
        KVSrc src{(const h16*)(P.ws + OFF_KCMP) + (size_t)bg * 512 * 64, 64, 4096, (const h16*)(P.ws + OFF_VCMP) + (size_t)bg * 8 * 4096};
        float m = -1e20f, lsum = 0.f;
        nsa_pipe<3>(src, ntile, smem, w, lane, [&](int j, const char* st, auto&& issue) {
            f32x16 s[2];
            qk_tile(st, qf, s, lane);
            issue();
#pragma unroll
            for (int kt = 0; kt < 2; ++kt)
#pragma unroll
                for (int e = 0; e < 16; ++e) {
                    const int key = 64 * j + 32 * kt + 8 * (e >> 2) + 4 * h + (e & 3);
                    if (key >= nvr) s[kt][e] = NEGS;
                }
            const float mn = fmaxf(m, rowmax32(s)), alpha = ex2(m - mn);
            float rs = 0.f;
#pragma unroll
            for (int kt = 0; kt < 2; ++kt)
#pragma unroll
                for (int e = 0; e < 16; ++e) rs += ex2(s[kt][e] - mn);
            rs = xhalf_sum(rs);
            lsum = lsum * alpha + rs; m = mn;
        });
        const float invl = lsum > 0.f ? 1.f / lsum : 0.f;
        f32x16 o[2];
#pragma unroll
        for (int e = 0; e < 16; ++e) { o[0][e] = 0.f; o[1][e] = 0.f; }
        nsa_pipe<3>(src, ntile, smem, w, lane, [&](int j, const char* st, auto&& issue) {
            f32x16 s[2];
            qk_tile(st, qf, s, lane);
            half8 vf[4];
            pv_load<0>(st + 8192, vf, lane);
            issue();
            __builtin_amdgcn_sched_barrier(0);
#pragma unroll
            for (int kt = 0; kt < 2; ++kt)
#pragma unroll
                for (int e = 0; e < 16; ++e) {
                    const int key = 64 * j + 32 * kt + 8 * (e >> 2) + 4 * h + (e & 3);
                    s[kt][e] = (key < nvr) ? ex2(s[kt][e] - m) * invl : 0.f;
                }
            if (cur >= 16) {
#pragma unroll
                for (int kt = 0; kt < 2; ++kt)
#pragma unroll
                    for (int g4 = 0; g4 < 4; ++g4) {
                        float G = (s[kt][4 * g4] + s[kt][4 * g4 + 1]) + (s[kt][4 * g4 + 2] + s[kt][4 * g4 + 3]);
                        float L = s[kt][4 * g4 + 3];
                        G += __shfl_xor(G, 1); G += __shfl_xor(G, 2);
                        L += __shfl_xor(L, 1); L += __shfl_xor(L, 2);
                        if (head == 0) {
                            const int sb = 16 * j + 8 * kt + 2 * g4 + h;
                            atomicAdd(&IMP[tokl * 128 + sb], G);
                            if (sb + 1 < 128) atomicAdd(&IMP[tokl * 128 + sb + 1], L);
                        }
                    }
            }
            pv_finish(st + 8192, vf, s, o, lane);
        });
        oacc[0] = o[0] * g0; oacc[1] = o[1] * g0;
    }
    __syncthreads();
    {
        const int tl = lane >> 3, sub = lane & 7;
        unsigned bits = 0;
        unsigned u[16];
        if (cur >= 16) {
            const float* ip = IMP + (w * 8 + tl) * 128 + sub * 16;
#pragma unroll
            for (int i = 0; i < 16; ++i) {
                const int s = sub * 16 + i;
                u[i] = (s >= 1 && s <= cur - 2) ? (__float_as_uint(ip[i]) + 1u) : 0u;
            }
        }
        __syncthreads();
        if (cur >= 16) {
            unsigned prefix = 0;
            for (int bit = 30; bit >= 0; --bit) {
                const unsigned cand = prefix | (1u << bit);
                int cnt = 0;
#pragma unroll
                for (int i = 0; i < 16; ++i) cnt += (u[i] >= cand) ? 1 : 0;
                cnt += __shfl_xor(cnt, 1); cnt += __shfl_xor(cnt, 2); cnt += __shfl_xor(cnt, 4);
                if (cnt >= 13) prefix = cand;
            }
            int cgt = 0, ceq = 0;
#pragma unroll
            for (int i = 0; i < 16; ++i) { cgt += (u[i] > prefix) ? 1 : 0; ceq += (u[i] == prefix) ? 1 : 0; }
            cgt += __shfl_xor(cgt, 1); cgt += __shfl_xor(cgt, 2); cgt += __shfl_xor(cgt, 4);
            int inc = ceq;
            { const int v = __shfl_up(inc, 1); if (sub >= 1) inc += v; }
            { const int v = __shfl_up(inc, 2); if (sub >= 2) inc += v; }
            { const int v = __shfl_up(inc, 4); if (sub >= 4) inc += v; }
            int run = inc - ceq;
            const int need = 13 - cgt;
#pragma unroll
            for (int i = 0; i < 16; ++i) {
                const int s = sub * 16 + i;
                bool sel = u[i] > prefix;
                if (u[i] == prefix) { sel = run < need; ++run; }
                if (s == 0 || s == cur || s == cur - 1) sel = true;
                bits |= (sel ? 1u : 0u) << i;
            }
        } else {
#pragma unroll
            for (int i = 0; i < 16; ++i) bits |= ((sub * 16 + i <= cur) ? 1u : 0u) << i;
        }
        unsigned wv = bits << ((sub & 1) * 16);
        wv |= __shfl_xor(wv, 1);
        if ((sub & 1) == 0) SELM[(w * 8 + tl) * 4 + (sub >> 1)] = wv;
    }
    __syncthreads();
    unsigned selw[4];
#pragma unroll
    for (int i = 0; i < 4; ++i) selw[i] = SELM[tokl * 4 + i];

#pragma unroll 1
    for (int br = 0; br < 2; ++br) {
        const int j0 = (br == 0) ? 0 : (cur - 8 > 0 ? cur - 8 : 0);
        const int nst = cur - j0 + 1;
        KVSrc src{proj + ((size_t)b * SEQ + (size_t)j0 * 64) * D_IN + C_NKV + (br == 0 ? 256 : 512) + g * 64, D_IN, (size_t)64 * D_IN,
                  (const h16*)(P.ws + OFF_VTG) + (((size_t)br * 4 + bg) * 128 + j0) * 4096};
        float m = -1e20f, lsum = 0.f;
        f32x16 o[2];
#pragma unroll
        for (int e = 0; e < 16; ++e) { o[0][e] = 0.f; o[1][e] = 0.f; }
        nsa_pipe<4>(src, nst, smem, w, lane, [&](int jj, const char* st, auto&& issue) {
            const int j = j0 + jj;
            f32x16 s[2];
            qk_tile(st, qf, s, lane);
            half8 vf[4];
            pv_load<0>(st + 8192, vf, lane);
            issue();
            __builtin_amdgcn_sched_barrier(0);
            const bool rowok = (br != 0) || (((selw[j >> 5] >> (j & 31)) & 1u) != 0u);
            if (j == cur || (br == 1 && j == cur - 8)) {
#pragma unroll
                for (int kt = 0; kt < 2; ++kt)
#pragma unroll
                    for (int e = 0; e < 16; ++e) {
                        const int key = 64 * j + 32 * kt + 8 * (e >> 2) + 4 * h + (e & 3);
                        const bool ok = (key <= t) && (br == 0 || key > t - 512);
                        if (!ok) s[kt][e] = NEGS;
                    }
            }
            sm_online(s, m, lsum, o, rowok);
            pv_finish(st + 8192, vf, s, o, lane);
        });
        const float sc = (br == 0 ? g1 : g2) / lsum;
        oacc[0] += o[0] * sc; oacc[1] += o[1] * sc;
    }
    {
        h16* mixp = (h16*)(P.ws + OFF_MIX) + tokg * 1024 + 512 + ghead * 64;
        const h16* ngp = proj + tokg * D_IN + C_NG + ghead * 64;
#pragma unroll
        for (int dt = 0; dt < 2; ++dt)
#pragma unroll
            for (int g4 = 0; g4 < 4; ++g4) {
                const int d0 = 32 * dt + 8 * g4 + 4 * h;
                const half4 ng = *(const half4*)(ngp + d0);
                half4 ov;
#pragma unroll
                for (int e = 0; e < 4; ++e) ov[e] = (h16)(oacc[dt][4 * g4 + e] * siluf_((float)ng[e]));
                *(half4*)(mixp + d0) = ov;
            }
    }
    __syncthreads();
}

DI void glu_tile(const Params& P, int l, int tile, char* smem) {
    const int mt = tile >> 2, nt = tile & 3;
    f32x4 acc[4][4];
    float ssd[4];
    gemm_mainloop_glds<false>(256, (const h16*)(P.ws + OFF_YACT) + (size_t)mt * 128 * 256, 256,
                              (const h16*)(P.ws + OFF_WTGLU) + ((size_t)l * 512 + nt * 128) * 256, 256, acc, ssd, smem);
    const int tid = otid(), lane = tid & 63, wid = tid >> 6, wr = wid >> 1, wc = wid & 1;
    const h16* proj = (const h16*)(P.ws + OFF_PROJ);
    h16* mix = (h16*)(P.ws + OFF_MIX);
    const float* gb = P.in[I_GLUB] + l * 512;
#pragma unroll
    for (int i = 0; i < 4; ++i) {
        const size_t tok = (size_t)mt * 128 + wr * 64 + i * 16 + (lane & 15);
#pragma unroll
        for (int pj = 0; pj < 2; ++pj) {
            const int c = nt * 64 + wc * 32 + pj * 16 + (lane >> 4) * 4;
            const f32x4 z1 = acc[i][2 * pj], z2 = acc[i][2 * pj + 1];
            const float4 b1 = *(const float4*)(gb + c), b2 = *(const float4*)(gb + 256 + c);
            const half4 g4 = *(const half4*)(proj + tok * D_IN + C_SG + c);
            half4 o;
            o[0] = (h16)((z1[0] + b1.x) * sigmoidf_(z2[0] + b2.x) * siluf_((float)g4[0]));
            o[1] = (h16)((z1[1] + b1.y) * sigmoidf_(z2[1] + b2.y) * siluf_((float)g4[1]));
            o[2] = (h16)((z1[2] + b1.z) * sigmoidf_(z2[2] + b2.z) * siluf_((float)g4[2]));
            o[3] = (h16)((z1[3] + b1.w) * sigmoidf_(z2[3] + b2.w) * siluf_((float)g4[3]));
            *(half4*)(mix + tok * 1024 + 256 + c) = o;
        }
    }
}

DI void outproj_tile(const Params& P, int l, int mt, int nt, char* smem) {
    f32x4 acc[4][4];
    float ssd[4];
    gemm_mainloop_glds<false>(1024, (const h16*)(P.ws + OFF_MIX) + (size_t)mt * 128 * 1024, 1024,
                              (const h16*)(P.ws + OFF_WTOUT) + ((size_t)l * 1024 + nt * 128) * 1024, 1024, acc, ssd, smem);
    const int tid = otid(), lane = tid & 63, wid = tid >> 6, wr = wid >> 1, wc = wid & 1;
    const float* xin = (l == 0) ? P.in[I_X] : P.out;
    h16* xh = (h16*)(P.ws + OFF_XH);
#pragma unroll
    for (int i = 0; i < 4; ++i) {
        const size_t row = (size_t)mt * 128 + wr * 64 + i * 16 + (lane & 15);
#pragma unroll
        for (int jj = 0; jj < 4; ++jj) {
            const int n = nt * 128 + wc * 64 + jj * 16 + (lane >> 4) * 4;
            const f32x4 v = acc[i][jj];
            const float4 xo = *(const float4*)(xin + row * 1024 + n);
            const float4 xn = (float4){xo.x + v[0], xo.y + v[1], xo.z + v[2], xo.w + v[3]};
            *(float4*)(P.out + row * 1024 + n) = xn;
            *(half4*)(xh + row * 1024 + n) = (half4){(h16)xn.x, (h16)xn.y, (h16)xn.z, (h16)xn.w};
        }
    }
}

#define XB_TMO      128
#define XB_XCNT(j)  (256  + 64 * (j))
#define XB_XSUB(j)  (1280 + 64 * (j))
#define XB_XGEN(j)  (2304 + 64 * (j))
#define XB_TOP      3328
#define XB_TOPGEN   3392
#define XCD_BAR_WORDS 3456
#define XB_SPIN_CAP (1u << 18)
#define LAS __attribute__((address_space(3)))

__device__ __forceinline__ unsigned xb_ld(unsigned* p)              { return __hip_atomic_load(p, __ATOMIC_RELAXED, __HIP_MEMORY_SCOPE_AGENT); }
__device__ __forceinline__ unsigned xb_add(unsigned* p, unsigned v) { return __hip_atomic_fetch_add(p, v, __ATOMIC_RELAXED, __HIP_MEMORY_SCOPE_AGENT); }
__device__ __forceinline__ unsigned xb_xcc_id() { return (unsigned)__builtin_amdgcn_s_getreg((3 << 11) | 20) & 0xFu; }
#define XB_SPIN(cond, bar) do { unsigned _sp = 0; while (cond) { __builtin_amdgcn_s_sleep(1); \
    if ((++_sp & 255u) == 0u) { if (xb_ld(&(bar)[XB_TMO])) break; if (_sp > XB_SPIN_CAP) { atomicAdd(&(bar)[XB_TMO], 1u); break; } } } } while (0)

struct XcdBarrier {
    unsigned* bar; unsigned x;
    volatile LAS unsigned* st;
};

__device__ __forceinline__ XcdBarrier xcd_barrier_post(unsigned* bar, volatile LAS unsigned* st) {
    XcdBarrier b; b.bar = bar; b.x = xb_xcc_id(); b.st = st;
    if (threadIdx.x == 0) (void)xb_add(&bar[XB_XCNT(b.x)], 1u);
    return b;
}
__device__ __forceinline__ void xcd_barrier_complete(unsigned* bar, unsigned x, unsigned& nloc, unsigned& nx) {
    const unsigned G = gridDim.x * gridDim.y * gridDim.z;
    unsigned sum, cnt, mine, sp = 0u;
    for (;;) {
        sum = 0u; cnt = 0u; mine = 0u;
#pragma unroll
        for (unsigned j = 0; j < 16; ++j) { const unsigned c = xb_ld(&bar[XB_XCNT(j)]); sum += c; cnt += (c > 0u) ? 1u : 0u; mine = (j == x) ? c : mine; }
        if (sum == G) break;
        __builtin_amdgcn_s_sleep(1);
        if ((++sp & 255u) == 0u) { if (xb_ld(&bar[XB_TMO])) break; if (sp > XB_SPIN_CAP) { atomicAdd(&bar[XB_TMO], 1u); break; } }
    }
    nloc = mine > 0u ? mine : 1u; nx = cnt > 0u ? cnt : 1u;
}

__device__ __forceinline__ void xcd_barrier(const XcdBarrier& b) {
    asm volatile("s_waitcnt vmcnt(0)" ::: "memory");
    __syncthreads();
    if (threadIdx.x == 0) {
        unsigned* bar = b.bar;
        __builtin_amdgcn_s_waitcnt(0);
        unsigned nloc = b.st[0], nx = b.st[1];
        if (nloc == 0u) { xcd_barrier_complete(bar, b.x, nloc, nx); b.st[0] = nloc; b.st[1] = nx; }
        const unsigned old = xb_add(&bar[XB_XSUB(b.x)], 1u);
        const unsigned gen = old / nloc;
        if (old + 1u == (gen + 1u) * nloc) {
            __builtin_amdgcn_fence(__ATOMIC_RELEASE, "agent");
            asm volatile("s_waitcnt vmcnt(0)" ::: "memory");
            const unsigned og = xb_add(&bar[XB_TOP], 1u);
            const unsigned tg = og / nx;
            if (og + 1u == (tg + 1u) * nx) xb_add(&bar[XB_TOPGEN], 1u);
            else XB_SPIN(xb_ld(&bar[XB_TOPGEN]) == tg, bar);
            __builtin_amdgcn_fence(__ATOMIC_ACQUIRE, "agent");
            xb_add(&bar[XB_XGEN(b.x)], 1u);
            asm volatile("s_waitcnt vmcnt(0)" ::: "memory");
        } else {
            XB_SPIN(xb_ld(&bar[XB_XGEN(b.x)]) == gen, bar);
            __builtin_amdgcn_fence(__ATOMIC_ACQUIRE, "agent");
            asm volatile("s_waitcnt vmcnt(0)" ::: "memory");
        }
    }
    __syncthreads();
}


__global__ void __launch_bounds__(NTHREADS, 2) fwd_megakernel(Params P) {
    extern __shared__ __attribute__((aligned(16))) char smem[];
    cg::grid_group grid = cg::this_grid();
    const int G = gridDim.x, bid = blockIdx.x;

    uint4& xb_words = *(uint4*)(smem + SMEM_MAIN);
    if (otid() == 0) xb_words = make_uint4(0u, 0u, 0u, 0u);
    if (bid == 0) for (int i = otid(); i < XCD_BAR_WORDS; i += NTHREADS) ((unsigned*)(P.ws + OFF_BAR))[i] = 0u;
    phase0(P, smem);
    grid.sync();
    const XcdBarrier xb = xcd_barrier_post((unsigned*)(P.ws + OFF_BAR), (volatile LAS unsigned*)(smem + SMEM_MAIN));

#pragma unroll 1
    for (int l = 0; l < DEPTH; ++l) {
        {
            const int xcd = bid & 7, jx = bid >> 3, nper = G >> 3;
            for (int u = jx; u < 400; u += nper) {
                const int mh = u / 200, rem = u - mh * 200;
                inproj_tile(P, l, xcd * 16 + mh * 8 + (rem & 7), rem >> 3, smem);
            }
            const int rem7 = 400 % nper;
            const int rank = (jx >= rem7) ? (jx - rem7) * 8 + xcd : (nper - rem7) * 8 + jx * 8 + xcd;
            for (int it = rank; it < 320; it += G) s5_build_item(P, l, it, smem);
        }
        xcd_barrier(xb);
#pragma unroll 1
        for (int w = bid; w < 128 + 64 + 2048; w += G) {
            if (w < 128) cmp_gemm_tile(P, l, w, smem);
            else if (w < 192) s5e_gemm_tile(P, l, w - 128, smem);
            else gla_kv_item(P, l, w - 192, smem);
        }
        xcd_barrier(xb);
#pragma unroll 1
        for (int w = bid; w < 512 + 512 + 64; w += G) {
            if (w < 512) cmp_l2_item(P, l, w, smem);
            else if (w < 1024) gla_scan_item(P, w - 512, smem);
            else s5_scan_item(P, w - 1024, smem);
        }
        xcd_barrier(xb);
#pragma unroll 1
        for (int w = bid; w < 512 + 256 + 2048; w += G) {
            if (w < 512) {
                const int bg = w & 3, q = w >> 2;
                nsa_unit(P, l, bg, 255 - q, smem);
                nsa_unit(P, l, bg, q, smem);
            } else if (w < 512 + 256) s5o_gemm_tile(P, l, w - 512, smem);
            else gla_out_item(P, l, w - 512 - 256, smem);
        }
        xcd_barrier(xb);
#pragma unroll 1
        for (int w = bid; w < 512; w += G) glu_tile(P, l, w, smem);
        xcd_barrier(xb);
        {
            const int xcd = bid & 7, jx = bid >> 3, nper = G >> 3;
            for (int u = jx; u < 128; u += nper) outproj_tile(P, l, xcd * 16 + (u >> 6) * 8 + (u & 7), (u & 63) >> 3, smem);
        }
        xcd_barrier(xb);
    }
}

extern "C" void kernel_launch(void* const* d_in, const int* in_sizes, int n_in, void* d_out, int out_size, void* d_ws,
                              size_t ws_size, hipStream_t stream) {
    static int grid_blocks = 0;
    if (!grid_blocks) {
        int dev = 0, cus = 0, per_cu = 0;
        hipGetDevice(&dev);
        hipDeviceGetAttribute(&cus, hipDeviceAttributeMultiprocessorCount, dev);
        hipFuncSetAttribute((const void*)fwd_megakernel, hipFuncAttributeMaxDynamicSharedMemorySize, SMEM_BYTES);
        hipOccupancyMaxActiveBlocksPerMultiprocessor(&per_cu, fwd_megakernel, NTHREADS, SMEM_BYTES);
        if (per_cu < 1) per_cu = 1;
        if (per_cu > 2) per_cu = 2;
        grid_blocks = cus * per_cu;
        if (ws_size < WS_END) fprintf(stderr, "kernel_launch: workspace too small: %zu < %zu\n", ws_size, (size_t)WS_END);
    }
    Params p{};
    for (int i = 0; i < 25; ++i) p.in[i] = (const float*)d_in[i];
    p.out = (float*)d_out;
    p.ws = (char*)d_ws;
    void* args[] = {&p};
    hipError_t e = hipLaunchCooperativeKernel((const void*)fwd_megakernel, dim3(grid_blocks), dim3(NTHREADS), args, SMEM_BYTES, stream);
    if (e != hipSuccess) fprintf(stderr, "cooperative launch failed: %s (grid %d)\n", hipGetErrorString(e), grid_blocks);
}
```

```cpp
#include <hip/hip_runtime.h>
#include <hip/hip_cooperative_groups.h>
#include <cstdio>
#include <cstdint>
namespace cg = cooperative_groups;

typedef _Float16 h16;
typedef _Float16 half8 __attribute__((ext_vector_type(8)));
typedef _Float16 half4 __attribute__((ext_vector_type(4)));
typedef float f32x4 __attribute__((ext_vector_type(4)));
typedef float f32x16 __attribute__((ext_vector_type(16)));

#define DI __device__ __forceinline__

constexpr int D_MODEL = 1024, BATCH = 2, SEQ = 8192, DEPTH = 4, NT = BATCH * SEQ;
constexpr int D_IN = 3112, D_IN_PAD = 3200;
constexpr int C_NQ = 0, C_NKV = 512, C_NG = 1280, C_GQ = 1792, C_GK = 1920, C_GV = 2048, C_GG = 2304, C_SU = 2560, C_SG = 2816,
              C_GLR = 3072, C_NGL = 3088;
__host__ __device__ constexpr int map_col(int c) {
    return c < 128 ? C_GQ + c : c < 256 ? C_GK + (c - 128) : c < 512 ? C_GV + (c - 256) : c < 528 ? C_GLR + (c - 512)
         : c < 784 ? C_GG + (c - 528) : c < 1040 ? C_SU + (c - 784) : c < 1296 ? C_SG + (c - 1040) : c < 1808 ? C_NQ + (c - 1296)
         : c < 2576 ? C_NKV + (c - 1808) : c < 2600 ? C_NGL + (c - 2576) : c < 3112 ? C_NG + (c - 2600) : c;
}
constexpr int NTHREADS = 256;
constexpr float QSCALE = 0.125f * 1.4426950408889634f;

enum { I_X = 0, I_NORMG, I_WIN, I_GW2, I_GB2, I_GON, I_LRE, I_LIM, I_LSTEP, I_BRE, I_BIM, I_CRE, I_CIM, I_SD, I_GLUW, I_GLUB,
       I_NGB, I_NQN, I_NKN, I_CPOS, I_CW1, I_CB1, I_CW2, I_CB2, I_WOUT };

constexpr size_t OFF_WTIN  = 0;
constexpr size_t OFF_WTOUT = OFF_WTIN  + 4ull * D_IN_PAD * 1024 * 2;
constexpr size_t OFF_WTGLU = OFF_WTOUT + 4ull * 1024 * 1024 * 2;
constexpr size_t OFF_WTC1  = OFF_WTGLU + 4ull * 512 * 256 * 2;
constexpr size_t OFF_PROJ  = OFF_WTC1  + 4ull * 2 * 256 * 2048 * 2;
constexpr size_t OFF_MIX   = OFF_PROJ  + (size_t)NT * D_IN * 2;
constexpr size_t OFF_YACT  = OFF_MIX   + (size_t)NT * 1024 * 2;
constexpr size_t OFF_XH    = OFF_YACT;
constexpr size_t OFF_BCUM  = OFF_YACT  + (size_t)NT * 256 * 2;
constexpr size_t OFF_GKV   = OFF_BCUM  + (size_t)NT * 128 * 4;
constexpr size_t OFF_GDEC  = OFF_GKV   + 8ull * 256 * 2048 * 4;
static_assert(OFF_GDEC - OFF_XH >= (size_t)NT * 1024 * 2, "XH alias region too small");
constexpr size_t OFF_XC    = OFF_GDEC  + 8ull * 256 * 32 * 4;
constexpr size_t OFF_S5W   = OFF_XC    + 512ull * 1024 * 2 * 4;
constexpr size_t OFF_S5E   = OFF_S5W   + 16ull * 512 * 640 * 2;
constexpr size_t OFF_S5AL  = OFF_S5E   + 16ull * 128 * 512 * 2;
constexpr size_t OFF_CHID  = OFF_S5AL  + 1024ull * 2 * 4;
constexpr size_t OFF_POSB  = OFF_CHID  + 2ull * 2048 * 512 * 4;
constexpr size_t OFF_XCH   = OFF_POSB  + 8ull * 16 * 256 * 4;
constexpr size_t OFF_KCMP  = OFF_XCH   + 512ull * 2048 * 2;
constexpr size_t OFF_VCMP  = OFF_KCMP  + 4ull * 512 * 64 * 2;
constexpr size_t OFF_VTG   = OFF_VCMP  + 4ull * 512 * 64 * 2;
constexpr size_t OFF_BAR   = OFF_VTG   + 2ull * 4 * 128 * 4096 * 2;
constexpr size_t WS_END    = OFF_BAR   + 16384;

struct Params {
    const float* in[25];
    float* out;
    char* ws;
};

constexpr int SMEM_MAIN = 65536;
constexpr int SMEM_BYTES = SMEM_MAIN + 16;

DI int otid() { int t = threadIdx.x; asm volatile("" : "+v"(t)); return t; }
DI float wave_sum(float v) {
#pragma unroll
    for (int o = 32; o > 0; o >>= 1) v += __shfl_xor(v, o);
    return v;
}
DI float wave_max(float v) {
#pragma unroll
    for (int o = 32; o > 0; o >>= 1) v = fmaxf(v, __shfl_xor(v, o));
    return v;
}
DI float sigmoidf_(float x) { return 1.f / (1.f + __expf(-x)); }
DI float siluf_(float x) { return x / (1.f + __expf(-x)); }
DI float gelu_tanh(float x) {
    const float u = 0.7978845608028654f * (x + 0.044715f * x * x * x);
    return 0.5f * x * (1.f + tanhf(u));
}
DI float log_sigmoidf_(float x) { return fminf(x, 0.f) - log1pf(__expf(-fabsf(x))); }

typedef _Float16 half2_ __attribute__((ext_vector_type(2)));
DI void glds16(const h16* g, char* l) {
    __builtin_amdgcn_global_load_lds((const __attribute__((address_space(1))) void*)g, (__attribute__((address_space(3))) void*)l, 16, 0, 0);
}
struct APlain { const h16* A; size_t lda, astep; DI const h16* operator()(int row, int kt, int c8) const { return A + (size_t)row * lda + (size_t)kt * astep + c8 * 8; } };
struct AS5 {
    const h16* ubase;
    const h16* xin;
    int ch0;
    DI const h16* operator()(int row, int kt, int c8) const {
        const size_t ch = (size_t)(ch0 + row);
        return kt < 8 ? ubase + (ch * 32 + 4 * kt + (c8 >> 1)) * D_IN + (c8 & 1) * 8 : xin + ch * 2048 + (kt - 8) * 64 + c8 * 8;
    }
};
template <bool SUMSQ, class AF>
DI void gemm_mainloop_glds(const int K, const AF& afn, const h16* __restrict__ Bt, const int ldb,
                           f32x4 (&acc)[4][4], float (&ss)[4], char* smem) {
    const int tid = otid(), lane = tid & 63, wid = tid >> 6, wr = wid >> 1, wc = wid & 1;
#pragma unroll
    for (int i = 0; i < 4; ++i) {
        ss[i] = 0.f;
#pragma unroll
        for (int j = 0; j < 4; ++j) acc[i][j] = (f32x4){0.f, 0.f, 0.f, 0.f};
    }
    const int lrow = wid * 8 + (lane >> 3);
    const int lc8 = (lane & 7) ^ ((lrow >> 1) & 7);
    const h16* bp = Bt + (size_t)lrow * ldb + lc8 * 8;
    char* lbase = smem + wid * 1024;
    const int fr = lane & 15, fq = lane >> 4;
    int aoff[4], boff[4];
#pragma unroll
    for (int i = 0; i < 4; ++i) {
        const int m = wr * 64 + i * 16 + fr, n = wc * 64 + i * 16 + fr;
        aoff[i] = m * 128 + ((fq ^ ((m >> 1) & 7)) * 16);
        boff[i] = n * 128 + ((fq ^ ((n >> 1) & 7)) * 16);
    }
    const int nk = K >> 6;
    for (int kt = 0; kt < nk; ++kt) {
        __syncthreads();
        char* cur = smem;
        {
            const int k1 = kt * 64;
#pragma unroll
            for (int q = 0; q < 4; ++q) {
                glds16(afn(lrow + 32 * q, kt, lc8), lbase + q * 4096);
                glds16(bp + (size_t)q * 32 * ldb + k1, lbase + 16384 + q * 4096);
            }
        }
        asm volatile("s_waitcnt vmcnt(0)" ::: "memory");
        __syncthreads();
#pragma unroll
        for (int kk = 0; kk < 2; ++kk) {
            half8 af[4], bf[4];
#pragma unroll
            for (int i = 0; i < 4; ++i) af[i] = *(const half8*)(cur + (aoff[i] ^ (kk * 64)));
#pragma unroll
            for (int j = 0; j < 4; ++j) bf[j] = *(const half8*)(cur + 16384 + (boff[j] ^ (kk * 64)));
            if (SUMSQ) {
#pragma unroll
                for (int i = 0; i < 4; ++i)
#pragma unroll
                    for (int e = 0; e < 4; ++e) {
                        const half2_ x = (half2_){af[i][2 * e], af[i][2 * e + 1]};
                        ss[i] = __builtin_amdgcn_fdot2(x, x, ss[i], false);
                    }
            }
#pragma unroll
            for (int i = 0; i < 4; ++i)
#pragma unroll
                for (int j = 0; j < 4; ++j) acc[i][j] = __builtin_amdgcn_mfma_f32_16x16x32_f16(bf[j], af[i], acc[i][j], 0, 0, 0);
        }
    }
    __syncthreads();
    if (SUMSQ) {
#pragma unroll
        for (int i = 0; i < 4; ++i) { ss[i] += __shfl_xor(ss[i], 16); ss[i] += __shfl_xor(ss[i], 32); }
    }
}

DI int glu_perm_dst(int c_orig) {
    const int which = c_orig >> 8, c = c_orig & 255;
    return (c >> 6) * 128 + ((c >> 5) & 1) * 64 + (((c >> 4) & 1) * 2 + which) * 16 + (c & 15);
}
template <int MAP>
DI void transpose64(const float* __restrict__ src, int R, int C, h16* __restrict__ dst, int r0, int c0,
                    const float* __restrict__ rscale, char* smem) {
    h16* tile = (h16*)smem;
    const int tid = otid();
    {
        const int r = tid >> 2, cq = (tid & 3) * 16;
        const float sc = rscale ? rscale[r0 + r] : 1.f;
        const float* sp = src + (size_t)(r0 + r) * C + c0 + cq;
#pragma unroll
        for (int q = 0; q < 4; ++q) {
            float4 v = (float4){0.f, 0.f, 0.f, 0.f};
            if (c0 + cq + q * 4 < C) v = *(const float4*)(sp + q * 4);
            *(half4*)(tile + r * 72 + cq + q * 4) = (half4){(h16)(v.x * sc), (h16)(v.y * sc), (h16)(v.z * sc), (h16)(v.w * sc)};
        }
    }
    __syncthreads();
    {
        const int c = tid >> 2, rq = (tid & 3) * 16;
        half8 o0, o1;
#pragma unroll
        for (int k = 0; k < 8; ++k) { o0[k] = tile[(rq + k) * 72 + c]; o1[k] = tile[(rq + 8 + k) * 72 + c]; }
        const int cc = c0 + c;
        const int dr = MAP == 1 ? map_col(cc) : MAP == 2 ? glu_perm_dst(cc) : cc;
        h16* dp = dst + (size_t)dr * R + r0 + rq;
        *(half8*)dp = o0; *(half8*)(dp + 8) = o1;
    }
    __syncthreads();
}

DI void phase0(const Params& P, char* smem) {
    constexpr int N_WIN = 4 * 16 * 50, N_WOUT = 4 * 16 * 16, N_C1 = 16 * 16 * 4, N_GLU = 4 * 4 * 8, N_XH = NT * 1024 / 2048, N_PB = 8 * 16;
    const int total = N_WIN + N_WOUT + N_C1 + N_GLU + N_XH + N_PB;
    for (int w = blockIdx.x; w < total; w += gridDim.x) {
        if (w < N_WIN) {
            const int l = w / 800, r = w % 800, rt = r / 50, ct = r % 50;
            transpose64<1>(P.in[I_WIN] + (size_t)l * 1024 * D_IN, 1024, D_IN, (h16*)(P.ws + OFF_WTIN) + (size_t)l * D_IN_PAD * 1024,
                           rt * 64, ct * 64, P.in[I_NORMG] + l * 1024, smem);
        } else if (w < N_WIN + N_WOUT) {
            const int v = w - N_WIN, l = v >> 8, r = v & 255, rt = r >> 4, ct = r & 15;
            transpose64<0>(P.in[I_WOUT] + (size_t)l * 1024 * 1024, 1024, 1024, (h16*)(P.ws + OFF_WTOUT) + (size_t)l * 1024 * 1024,
                           rt * 64, ct * 64, nullptr, smem);
        } else if (w < N_WIN + N_WOUT + N_C1) {
            const int v = w - N_WIN - N_WOUT, ljh = v >> 6, r = v & 63, rt = r >> 2, ct = r & 3;
            transpose64<0>(P.in[I_CW1] + (size_t)ljh * 1024 * 256, 1024, 256, (h16*)(P.ws + OFF_WTC1) + (size_t)ljh * 256 * 1024,
                           rt * 64, ct * 64, nullptr, smem);
        } else if (w < N_WIN + N_WOUT + N_C1 + N_GLU) {
            const int v = w - N_WIN - N_WOUT - N_C1, l = v >> 5, r = v & 31, rt = r >> 3, ct = r & 7;
            transpose64<2>(P.in[I_GLUW] + (size_t)l * 256 * 512, 256, 512, (h16*)(P.ws + OFF_WTGLU) + (size_t)l * 512 * 256,
                           rt * 64, ct * 64, nullptr, smem);
        } else if (w < N_WIN + N_WOUT + N_C1 + N_GLU + N_XH) {
            const size_t e0 = ((size_t)(w - N_WIN - N_WOUT - N_C1 - N_GLU) * 256 + otid()) * 8;
            const float4 a = *(const float4*)(P.in[I_X] + e0), b = *(const float4*)(P.in[I_X] + e0 + 4);
            *(half8*)((h16*)(P.ws + OFF_XH) + e0) = (half8){(h16)a.x, (h16)a.y, (h16)a.z, (h16)a.w, (h16)b.x, (h16)b.y, (h16)b.z, (h16)b.w};
        } else {
            const int v = w - (N_WIN + N_WOUT + N_C1 + N_GLU + N_XH), lj = v >> 4, ks = v & 15, n = otid();
            const float* w1 = P.in[I_CW1] + ((size_t)lj * 2048 + ks * 128) * 256 + n;
            const float* pp = P.in[I_CPOS] + (size_t)lj * 2048 + ks * 128;
            float a = ks == 0 ? P.in[I_CB1][lj * 256 + n] : 0.f;
#pragma unroll 16
            for (int k = 0; k < 128; ++k) a += pp[k] * w1[(size_t)k * 256];
            ((float*)(P.ws + OFF_POSB))[(lj * 16 + ks) * 256 + n] = a;
        }
    }
}

DI void s5_build_item(const Params& P, int l, int item, char* smem) {
    float* apow = (float*)smem;
    float* bbar = apow + 64 * 33 * 2;
    float* cc   = bbar + 64 * 16 * 2;
    const int tid = otid();
    const int g = (item < 256) ? (item >> 4) : ((item - 256) >> 2);
    if (tid < 64) {
        const int p = tid;
        const double lre = fmin((double)P.in[I_LRE][(l * 16 + g) * 64 + p], -1e-4);
        const double lim = (double)P.in[I_LIM][(l * 16 + g) * 64 + p];
        const double dt = exp((double)P.in[I_LSTEP][l * 16 + g]);
        const double mag = exp(lre * dt);
        const double ar = mag * cos(lim * dt), ai = mag * sin(lim * dt);
        const double den = lre * lre + lim * lim;
        const double fr = ((ar - 1.0) * lre + ai * lim) / den;
        const double fi = (ai * lre - (ar - 1.0) * lim) / den;
        double pr = 1.0, pi = 0.0;
        for (int k = 0; k <= 32; ++k) {
            apow[(p * 33 + k) * 2] = (float)pr; apow[(p * 33 + k) * 2 + 1] = (float)pi;
            const double nr = pr * ar - pi * ai, ni = pr * ai + pi * ar; pr = nr; pi = ni;
        }
        for (int c = 0; c < 16; ++c) {
            const double br = (double)P.in[I_BRE][((size_t)(l * 16 + g) * 64 + p) * 16 + c];
            const double bi = (double)P.in[I_BIM][((size_t)(l * 16 + g) * 64 + p) * 16 + c];
            bbar[(p * 16 + c) * 2] = (float)(fr * br - fi * bi);
            bbar[(p * 16 + c) * 2 + 1] = (float)(fr * bi + fi * br);
        }
    }
    for (int e = tid; e < 1024; e += 256) {
        cc[e * 2] = P.in[I_CRE][(size_t)(l * 16 + g) * 1024 + e];
        cc[e * 2 + 1] = P.in[I_CIM][(size_t)(l * 16 + g) * 1024 + e];
    }
    __syncthreads();
    if (item < 256) {
        const int c = item & 15;
        float* kt = cc + 2048;
        for (int idx = tid; idx < 512; idx += 256) {
            const int lag = idx >> 4, c2 = idx & 15;
            float a = 0.f;
            for (int p = 0; p < 64; ++p) {
                const float cr = cc[(c * 64 + p) * 2], ci = cc[(c * 64 + p) * 2 + 1];
                const float xr = apow[(p * 33 + lag) * 2], xi = apow[(p * 33 + lag) * 2 + 1];
                const float br = bbar[(p * 16 + c2) * 2], bi = bbar[(p * 16 + c2) * 2 + 1];
                const float tr = cr * xr - ci * xi, ti = cr * xi + ci * xr;
                a += tr * br - ti * bi;
            }
            kt[idx] = a;
        }
        __syncthreads();
        h16* W = (h16*)(P.ws + OFF_S5W) + (size_t)g * 512 * 640;
        for (int idx = tid; idx < 32 * 640; idx += 256) {
            const int j = idx / 640, k = idx % 640;
            float val = 0.f;
            if (k < 512) {
                const int s = k >> 4, c2 = k & 15, lag = j - s;
                if (lag >= 0) val = kt[lag * 16 + c2];
            } else {
                const int p = (k - 512) >> 1;
                const float cr = cc[(c * 64 + p) * 2], ci = cc[(c * 64 + p) * 2 + 1];
                const float xr = apow[(p * 33 + j + 1) * 2], xi = apow[(p * 33 + j + 1) * 2 + 1];
                val = (k & 1) ? -(cr * xi + ci * xr) : (cr * xr - ci * xi);
            }
            W[(size_t)(j * 16 + c) * 640 + k] = (h16)val;
        }
    } else {
        const int pq = (item - 256) & 3;
        h16* E = (h16*)(P.ws + OFF_S5E) + ((size_t)g * 128 + pq * 32) * 512;
        for (int idx = tid; idx < 32 * 512; idx += 256) {
            const int nl = idx >> 9, k = idx & 511;
            const int p = pq * 16 + (nl >> 1), s = k >> 4, c2 = k & 15;
            const float xr = apow[(p * 33 + 31 - s) * 2], xi = apow[(p * 33 + 31 - s) * 2 + 1];
            const float br = bbar[(p * 16 + c2) * 2], bi = bbar[(p * 16 + c2) * 2 + 1];
            const float val = (nl & 1) ? (xr * bi + xi * br) : (xr * br - xi * bi);
            E[(size_t)nl * 512 + k] = (h16)val;
        }
        if (tid < 16) {
            const int p = pq * 16 + tid;
            float* AL = (float*)(P.ws + OFF_S5AL);
            AL[(g * 64 + p) * 2] = apow[(p * 33 + 32) * 2];
            AL[(g * 64 + p) * 2 + 1] = apow[(p * 33 + 32) * 2 + 1];
        }
    }
    __syncthreads();
}

DI void inproj_tile(const Params& P, int l, int mt, int nt, char* smem) {
    f32x4 acc[4][4];
    float ss[4];
    gemm_mainloop_glds<true>(1024, APlain{(const h16*)(P.ws + OFF_XH) + (size_t)mt * 128 * 1024, 1024, 64},
                             (const h16*)(P.ws + OFF_WTIN) + ((size_t)l * D_IN_PAD + nt * 128) * 1024, 1024, acc, ss, smem);
    const int tid = otid(), lane = tid & 63, wid = tid >> 6, wr = wid >> 1, wc = wid & 1;
    h16* proj = (h16*)(P.ws + OFF_PROJ);
    const int n64 = nt * 128 + wc * 64;
    int cls = 0;
    if (n64 < 512) cls = 1;
    else if (n64 >= C_NKV + 256 && n64 < C_NKV + 384) cls = 2;
    else if (n64 >= C_NKV + 512 && n64 < C_NKV + 640) cls = 3;
    else if (n64 >= C_NKV + 384 && n64 < C_NKV + 512) cls = 4;
    else if (n64 >= C_NKV + 640 && n64 < C_NKV + 768) cls = 5;
    float wn[4][4];
    if (cls >= 1 && cls <= 3) {
        const float* wp = (cls == 1) ? P.in[I_NQN] + l * 64 : P.in[I_NKN] + (l * 3 + (cls - 1)) * 64;
        const float sc = (cls == 1) ? QSCALE : 1.f;
#pragma unroll
        for (int j = 0; j < 4; ++j) {
            const float4 w4 = *(const float4*)(wp + j * 16 + (lane >> 4) * 4);
            wn[j][0] = w4.x * sc; wn[j][1] = w4.y * sc; wn[j][2] = w4.z * sc; wn[j][3] = w4.w * sc;
        }
    }
#pragma unroll
    for (int i = 0; i < 4; ++i) {
        const int ml = wr * 64 + i * 16 + (lane & 15);
        const float r = rsqrtf(ss[i] * (1.f / 1024.f) + 1e-6f);
        const size_t row = (size_t)mt * 128 + ml;
        f32x4 v[4];
#pragma unroll
        for (int j = 0; j < 4; ++j) v[j] = acc[i][j] * r;
        if (cls >= 1 && cls <= 3) {
            float ss = 0.f;
#pragma unroll
            for (int j = 0; j < 4; ++j) ss += v[j][0] * v[j][0] + v[j][1] * v[j][1] + v[j][2] * v[j][2] + v[j][3] * v[j][3];
            ss += __shfl_xor(ss, 16); ss += __shfl_xor(ss, 32);
            const float rn = rsqrtf(ss * (1.f / 64.f) + 1e-6f);
#pragma unroll
            for (int j = 0; j < 4; ++j) { v[j][0] *= rn * wn[j][0]; v[j][1] *= rn * wn[j][1]; v[j][2] *= rn * wn[j][2]; v[j][3] *= rn * wn[j][3]; }
        }
        if (cls >= 4) {
            const int g = (n64 >> 6) & 1, br = cls - 4;
            const int b = (int)(row >> 13), t = (int)(row & 8191);
            h16* vt = (h16*)(P.ws + OFF_VTG) + ((((size_t)br * 4 + b * 2 + g) * 128 + (t >> 6)) * 64) * 64 + (t & 63);
#pragma unroll
            for (int j = 0; j < 4; ++j)
#pragma unroll
                for (int e = 0; e < 4; ++e) vt[(j * 16 + (lane >> 4) * 4 + e) * 64] = (h16)v[j][e];
        }
#pragma unroll
        for (int j = 0; j < 4; ++j) {
            const int n = n64 + j * 16 + (lane >> 4) * 4;
            if (n < D_IN) *(half4*)(proj + row * D_IN + n) = (half4){(h16)v[j][0], (h16)v[j][1], (h16)v[j][2], (h16)v[j][3]};
        }
    }
    __syncthreads();
}

DI void gla_kv_item(const Params& P, int l, int item, char* smem) {
    const int h = item & 3, cn = item >> 2;
    const size_t tok0 = (size_t)cn * 32;
    float* gl = (float*)smem;
    float* ke = gl + 32 * 33;
    float* vs = ke + 32 * 33;
    const h16* proj = (const h16*)(P.ws + OFF_PROJ);
    const int tid = otid(), i = tid >> 3, dq = (tid & 7) * 4, e0 = (tid & 7) * 8;
    {
        const half8* lp = (const half8*)(proj + (tok0 + i) * D_IN + C_GLR);
        const half8 l0 = lp[0], l1 = lp[1];
        float lr[16];
#pragma unroll
        for (int r = 0; r < 8; ++r) { lr[r] = (float)l0[r]; lr[8 + r] = (float)l1[r]; }
#pragma unroll
        for (int dd = 0; dd < 4; ++dd) {
            const int d = dq + dd;
            float x = P.in[I_GB2][l * 128 + h * 32 + d];
#pragma unroll
            for (int r = 0; r < 16; ++r) x += lr[r] * P.in[I_GW2][(l * 16 + r) * 128 + h * 32 + d];
            gl[i * 33 + d] = log_sigmoidf_(x) * (1.f / 16.f);
        }
    }
    __syncthreads();
    if (tid < 32) {
        float run = 0.f;
        float* bc = (float*)(P.ws + OFF_BCUM);
        for (int ii = 0; ii < 32; ++ii) {
            run += gl[ii * 33 + tid]; gl[ii * 33 + tid] = run;
            bc[(tok0 + ii) * 128 + h * 32 + tid] = run;
        }
    }
    __syncthreads();
    {
        const half4 kv4 = *(const half4*)(proj + (tok0 + i) * D_IN + C_GK + h * 32 + dq);
#pragma unroll
        for (int dd = 0; dd < 4; ++dd) {
            const int d = dq + dd;
            ke[i * 33 + d] = (float)kv4[dd] * __expf(gl[31 * 33 + d] - gl[i * 33 + d]);
        }
        const half8 v8 = *(const half8*)(proj + (tok0 + i) * D_IN + C_GV + h * 64 + e0);
#pragma unroll
        for (int e = 0; e < 8; ++e) vs[i * 64 + e0 + e] = (float)v8[e];
    }
    __syncthreads();
    {
        const int d = tid >> 3;
        float acc[8];
#pragma unroll
        for (int e = 0; e < 8; ++e) acc[e] = 0.f;
        for (int c = 0; c < 32; ++c) {
            const float kd = ke[c * 33 + d];
#pragma unroll
            for (int e = 0; e < 8; ++e) acc[e] += kd * vs[c * 64 + e0 + e];
        }
        const int b = cn >> 8, n = cn & 255, bh = b * 4 + h;
        float* kvp = (float*)(P.ws + OFF_GKV) + ((size_t)(bh * 256 + n) * 32 + d) * 64 + e0;
        *(float4*)kvp = (float4){acc[0], acc[1], acc[2], acc[3]};
        *(float4*)(kvp + 4) = (float4){acc[4], acc[5], acc[6], acc[7]};
        if (tid < 32) ((float*)(P.ws + OFF_GDEC))[(size_t)(bh * 256 + n) * 32 + tid] = __expf(gl[31 * 33 + tid]);
    }
    __syncthreads();
}

DI void cmp_gemm_tile(const Params& P, int l, int tile, char* smem) {
    const int j = tile >> 6, mt = (tile >> 2) & 15, nt = tile & 3;
    const int row0 = mt * 128, bg = row0 >> 9, i0 = row0 & 511, b = bg >> 1, g = bg & 1;
    f32x4 acc[4][4];
    float ssd[4];
    gemm_mainloop_glds<false>(1024, APlain{(const h16*)(P.ws + OFF_PROJ) + ((size_t)b * SEQ + 16 * i0) * D_IN + C_NKV + j * 128 + g * 64, (size_t)16 * D_IN, (size_t)D_IN},
                              (const h16*)(P.ws + OFF_WTC1) + ((size_t)(l * 2 + j) * 512 + nt * 128) * 1024, 1024, acc, ssd, smem);
    const int tid = otid(), lane = tid & 63, wid = tid >> 6, wr = wid >> 1, wc = wid & 1;
    float* pt = (float*)(P.ws + OFF_CHID) + (size_t)j * 2048 * 512;
#pragma unroll
    for (int i = 0; i < 4; ++i) {
        const size_t row = (size_t)row0 + wr * 64 + i * 16 + (lane & 15);
#pragma unroll
        for (int jj = 0; jj < 4; ++jj) {
            const int n = nt * 128 + wc * 64 + jj * 16 + (lane >> 4) * 4;
            const f32x4 v = acc[i][jj];
            *(float4*)(pt + row * 512 + n) = (float4){v[0], v[1], v[2], v[3]};
        }
    }
}

DI void s5e_gemm_tile(const Params& P, int l, int tile, char* smem) {
    const int g = tile >> 2, mt = tile & 3;
    f32x4 acc[4][4];
    float ssd[4];
    gemm_mainloop_glds<false>(512, AS5{(const h16*)(P.ws + OFF_PROJ) + C_SU + g * 16, nullptr, mt * 128},
                              (const h16*)(P.ws + OFF_S5E) + (size_t)g * 128 * 512, 512, acc, ssd, smem);
    const int tid = otid(), lane = tid & 63, wid = tid >> 6, wr = wid >> 1, wc = wid & 1;
    float* xc = (float*)(P.ws + OFF_XC);
#pragma unroll
    for (int i = 0; i < 4; ++i) {
        const size_t ch = (size_t)mt * 128 + wr * 64 + i * 16 + (lane & 15);
#pragma unroll
        for (int jj = 0; jj < 4; ++jj) {
            const int n = wc * 64 + jj * 16 + (lane >> 4) * 4;
            const f32x4 v = acc[i][jj];
            *(float4*)(xc + (ch * 1024 + g * 64) * 2 + n) = (float4){v[0], v[1], v[2], v[3]};
        }
    }
}

DI void gla_scan_item(const Params& P, int item, char* smem) {
    const int tid = otid(), sl = tid & 31, part = tid >> 5;
    const int idx = item * 32 + sl, bh = idx >> 11, de = idx & 2047, d = de >> 6;
    float* kv = (float*)(P.ws + OFF_GKV) + ((size_t)bh * 256 + part * 32) * 2048 + de;
    const float* dc = (const float*)(P.ws + OFF_GDEC) + ((size_t)bh * 256 + part * 32) * 32 + d;
    float* sD = (float*)smem; float* sL = sD + 256;
    float kvv[32], dd[32];
#pragma unroll
    for (int i = 0; i < 32; ++i) { kvv[i] = kv[(size_t)i * 2048]; dd[i] = dc[i * 32]; }
    float D = 1.f, L = 0.f;
#pragma unroll
    for (int i = 0; i < 32; ++i) { L = dd[i] * L + kvv[i]; D *= dd[i]; }
    sD[part * 32 + sl] = D; sL[part * 32 + sl] = L;
    __syncthreads();
    float S = 0.f;
    for (int q = 0; q < part; ++q) S = sD[q * 32 + sl] * S + sL[q * 32 + sl];
#pragma unroll
    for (int i = 0; i < 32; ++i) { const float o = S; S = dd[i] * S + kvv[i]; kv[(size_t)i * 2048] = o; }
    __syncthreads();
}
DI void s5_scan_item(const Params& P, int item, char* smem) {
    const int tid = otid(), sl = tid & 31, part = tid >> 5;
    const int idx = item * 32 + sl, b = idx >> 10, s = idx & 1023;
    float2* xc = (float2*)(P.ws + OFF_XC) + ((size_t)b * 256 + part * 32) * 1024 + s;
    half2_* xch = (half2_*)(P.ws + OFF_XCH) + ((size_t)b * 256 + part * 32) * 1024 + s;
    const float2 a = ((const float2*)(P.ws + OFF_S5AL))[s];
    float2* sL = (float2*)smem;
    float2 c[32];
#pragma unroll
    for (int i = 0; i < 32; ++i) c[i] = xc[(size_t)i * 1024];
    float lr = 0.f, li = 0.f;
#pragma unroll
    for (int i = 0; i < 32; ++i) { const float nr = a.x * lr - a.y * li + c[i].x, ni = a.x * li + a.y * lr + c[i].y; lr = nr; li = ni; }
    float dr = a.x, di = a.y;
#pragma unroll
    for (int i = 0; i < 5; ++i) { const float nr = dr * dr - di * di, ni = 2.f * dr * di; dr = nr; di = ni; }
    sL[part * 32 + sl] = (float2){lr, li};
    __syncthreads();
    float xr = 0.f, xi = 0.f;
    for (int q = 0; q < part; ++q) { const float2 lq = sL[q * 32 + sl]; const float nr = dr * xr - di * xi + lq.x, ni = dr * xi + di * xr + lq.y; xr = nr; xi = ni; }
#pragma unroll
    for (int i = 0; i < 32; ++i) {
        const float2 o = (float2){xr, xi};
        const float nr = a.x * xr - a.y * xi + c[i].x, ni = a.x * xi + a.y * xr + c[i].y; xr = nr; xi = ni;
        xc[(size_t)i * 1024] = o;
        xch[(size_t)i * 1024] = (half2_){(h16)o.x, (h16)o.y};
    }
    __syncthreads();
}
DI void cmp_l2_item(const Params& P, int l, int item, char* smem) {
    const int tid = otid(), lane = tid & 63, w = tid >> 6;
    const int j = item >> 8, r0 = (item & 255) * 8;
    h16* w2s = (h16*)smem;
    float* hs = (float*)(smem + 32768);
    {
        const float* w2 = P.in[I_CW2] + (size_t)(l * 2 + j) * 256 * 64;
        for (int e = tid * 4; e < 256 * 64; e += 1024) {
            const float4 v = *(const float4*)(w2 + e);
            *(half4*)(w2s + e) = (half4){(h16)v.x, (h16)v.y, (h16)v.z, (h16)v.w};
        }
        const float* pt = (const float*)(P.ws + OFF_CHID) + (size_t)j * 2048 * 512;
        float pb = 0.f;
#pragma unroll
        for (int ks = 0; ks < 16; ++ks) pb += ((const float*)(P.ws + OFF_POSB))[((l * 2 + j) * 16 + ks) * 256 + tid];
#pragma unroll
        for (int rr = 0; rr < 8; ++rr) {
            const int row = r0 + rr, i = row & 511;
            float v = 0.f;
            if (i < 511) v = gelu_tanh(pt[(size_t)row * 512 + tid] + pt[(size_t)(row + 1) * 512 + 256 + tid] + pb);
            hs[rr * 256 + tid] = v;
        }
    }
    __syncthreads();
    const float bb = P.in[I_CB2][(l * 2 + j) * 64 + lane];
    float a0 = bb, a1 = bb;
    const float* h0 = hs + (2 * w) * 256, *h1 = h0 + 256;
#pragma unroll 8
    for (int n = 0; n < 256; ++n) {
        const float wv = (float)w2s[n * 64 + lane];
        a0 += h0[n] * wv; a1 += h1[n] * wv;
    }
#pragma unroll
    for (int rr = 0; rr < 2; ++rr) {
        float acc = rr ? a1 : a0;
        const int row = r0 + 2 * w + rr, bg = row >> 9, i = row & 511;
        if (i == 511) acc = 0.f;
        if (j == 0) {
            const float ss = wave_sum(acc * acc);
            acc = acc * rsqrtf(ss * (1.f / 64.f) + 1e-6f) * P.in[I_NKN][(l * 3 + 0) * 64 + lane];
            ((h16*)(P.ws + OFF_KCMP))[(size_t)row * 64 + lane] = (h16)acc;
        } else {
            ((h16*)(P.ws + OFF_VCMP))[(((size_t)bg * 8 + (i >> 6)) * 64 + lane) * 64 + (i & 63)] = (h16)acc;
        }
    }
    __syncthreads();
}

DI void gla_out_item(const Params& P, int l, int item, char* smem) {
    const int h = item & 3, cn = item >> 2;
    const size_t tok0 = (size_t)cn * 32;
    float* qe = (float*)smem;
    float* ke = qe + 32 * 33;
    float* scs = ke + 32 * 33;
    float* vs = scs + 32 * 33;
    float* sp = vs + 32 * 64;
    const h16* proj = (const h16*)(P.ws + OFF_PROJ);
    const int tid = otid(), i = tid >> 3, dq = (tid & 7) * 4, e0 = (tid & 7) * 8;
    const int b = cn >> 8, n = cn & 255, bh = b * 4 + h;
    {
        const float4 bc = *(const float4*)((const float*)(P.ws + OFF_BCUM) + (tok0 + i) * 128 + h * 32 + dq);
        const half4 q4 = *(const half4*)(proj + (tok0 + i) * D_IN + C_GQ + h * 32 + dq);
        const half4 k4 = *(const half4*)(proj + (tok0 + i) * D_IN + C_GK + h * 32 + dq);
        const float bcv[4] = {bc.x, bc.y, bc.z, bc.w};
#pragma unroll
        for (int dd = 0; dd < 4; ++dd) {
            qe[i * 33 + dq + dd] = (float)q4[dd] * 0.17677669529663687f * __expf(bcv[dd]);
            ke[i * 33 + dq + dd] = (float)k4[dd] * __expf(-bcv[dd]);
        }
        const half8 v8 = *(const half8*)(proj + (tok0 + i) * D_IN + C_GV + h * 64 + e0);
#pragma unroll
        for (int e = 0; e < 8; ++e) vs[i * 64 + e0 + e] = (float)v8[e];
        const float* spp = (const float*)(P.ws + OFF_GKV) + (size_t)(bh * 256 + n) * 2048 + tid * 8;
        const float4 s0 = *(const float4*)spp, s1 = *(const float4*)(spp + 4);
        *(float4*)(sp + tid * 8) = s0; *(float4*)(sp + tid * 8 + 4) = s1;
    }
    __syncthreads();
    {
        const int j0 = (tid & 7) * 4;
#pragma unroll
        for (int jj = 0; jj < 4; ++jj) {
            const int j = j0 + jj;
            float s = 0.f;
            if (j <= i) for (int d = 0; d < 32; ++d) s += qe[i * 33 + d] * ke[j * 33 + d];
            scs[i * 33 + j] = s;
        }
    }
    __syncthreads();
    {
        float acc[8];
#pragma unroll
        for (int e = 0; e < 8; ++e) acc[e] = 0.f;
        for (int j = 0; j < 32; ++j) {
            const float s = scs[i * 33 + j], qd = qe[i * 33 + j];
#pragma unroll
            for (int e = 0; e < 8; ++e) acc[e] += s * vs[j * 64 + e0 + e] + qd * sp[j * 64 + e0 + e];
        }
        float ss = 0.f;
#pragma unroll
        for (int e = 0; e < 8; ++e) ss += acc[e] * acc[e];
        ss += __shfl_xor(ss, 1); ss += __shfl_xor(ss, 2); ss += __shfl_xor(ss, 4);
        const float r = rsqrtf(ss * (1.f / 64.f) + 1e-6f);
        const half8 g8 = *(const half8*)(proj + (tok0 + i) * D_IN + C_GG + h * 64 + e0);
        half8 o;
#pragma unroll
        for (int e = 0; e < 8; ++e) o[e] = (h16)(acc[e] * r * P.in[I_GON][l * 64 + e0 + e] * siluf_((float)g8[e]));
        *(half8*)((h16*)(P.ws + OFF_MIX) + (tok0 + i) * 1024 + h * 64 + e0) = o;
    }
    __syncthreads();
}

DI void s5o_gemm_tile(const Params& P, int l, int tile, char* smem) {
    const int g = tile >> 4, mt = (tile >> 2) & 3, nt = tile & 3;
    f32x4 acc[4][4];
    float ssd[4];
    gemm_mainloop_glds<false>(640, AS5{(const h16*)(P.ws + OFF_PROJ) + C_SU + g * 16, (const h16*)(P.ws + OFF_XCH) + g * 128, mt * 128},
                              (const h16*)(P.ws + OFF_S5W) + ((size_t)g * 512 + nt * 128) * 640, 640, acc, ssd, smem);
    const int tid = otid(), lane = tid & 63, wid = tid >> 6, wr = wid >> 1, wc = wid & 1;
    const h16* proj = (const h16*)(P.ws + OFF_PROJ);
    h16* yact = (h16*)(P.ws + OFF_YACT);
#pragma unroll
    for (int i = 0; i < 4; ++i) {
        const size_t ch = (size_t)mt * 128 + wr * 64 + i * 16 + (lane & 15);
#pragma unroll
        for (int jj = 0; jj < 4; ++jj) {
            const int n = nt * 128 + wc * 64 + jj * 16 + (lane >> 4) * 4;
            const int j = n >> 4, c = n & 15;
            const size_t tok = ch * 32 + j;
            const half4 u4 = *(const half4*)(proj + tok * D_IN + C_SU + g * 16 + c);
            const float4 dd = *(const float4*)(P.in[I_SD] + (l * 16 + g) * 16 + c);
            const f32x4 v = acc[i][jj];
            half4 o;
            o[0] = (h16)gelu_tanh(v[0] + dd.x * (float)u4[0]);
            o[1] = (h16)gelu_tanh(v[1] + dd.y * (float)u4[1]);
            o[2] = (h16)gelu_tanh(v[2] + dd.z * (float)u4[2]);
            o[3] = (h16)gelu_tanh(v[3] + dd.w * (float)u4[3]);
            *(half4*)(yact + tok * 256 + g * 16 + c) = o;
        }
    }
}

#define MFMA32(a, b, c) __builtin_amdgcn_mfma_f32_32x32x16_f16((a), (b), (c), 0, 0, 0)
constexpr float NEGS = -1e30f;
DI float ex2(float x) { return __builtin_amdgcn_exp2f(x); }
#define NSA_WAITBAR(N) asm volatile("s_waitcnt vmcnt(" #N ") lgkmcnt(0)\n\ts_barrier" ::: "memory")
#define NSA_BAR() asm volatile("s_waitcnt lgkmcnt(0)\n\ts_barrier" ::: "memory")

struct KVSrc { const h16* k; int ldk; size_t kstep; const h16* v; };
DI void nsa_dma(const KVSrc& s, int j, char* stage, int wid, int lane) {
    const int row0 = wid * 8 + (lane >> 3);
    const int sw = ((lane & 7) ^ ((row0 >> 1) & 7)) * 8;
    const h16* kp = s.k + (size_t)j * s.kstep + (size_t)row0 * s.ldk + sw;
    glds16(kp, stage + wid * 1024);
    glds16(kp + (size_t)32 * s.ldk, stage + 4096 + wid * 1024);
    const h16* vp = s.v + (size_t)j * 4096 + row0 * 64 + sw;
    glds16(vp, stage + 8192 + wid * 1024);
    glds16(vp + 32 * 64, stage + 8192 + 4096 + wid * 1024);
}
template <int NST, class F>
DI void nsa_pipe(const KVSrc& s, const int n, char* smem, int wid, int lane, F&& compute) {
    NSA_WAITBAR(0);
    {
        const int k = n < NST - 1 ? n : NST - 1;
        for (int p = 0; p < k; ++p) nsa_dma(s, p, smem + p * 16384, wid, lane);
        if (k >= 3) NSA_WAITBAR(8); else if (k == 2) NSA_WAITBAR(4); else NSA_WAITBAR(0);
    }
    for (int j = 0; j < n; ++j) {
        if (NST == 4 && j + 2 < n) NSA_WAITBAR(4); else NSA_WAITBAR(0);
        const int jn = j + NST - 1;
        compute(j, smem + (j % NST) * 16384, [&]() { if (jn < n) nsa_dma(s, jn, smem + (jn % NST) * 16384, wid, lane); });
    }
}

DI void qk_tile(const char* Kimg, const half8 (&qf)[4], f32x16 (&s)[2], int lane) {
    const int r = lane & 31, h = lane >> 5, swz = (r >> 1) & 7;
    const char* base = Kimg + r * 128;
    half8 kf[8];
#pragma unroll
    for (int kt = 0; kt < 2; ++kt)
#pragma unroll
        for (int ks = 0; ks < 4; ++ks) kf[kt * 4 + ks] = *(const half8*)(base + kt * 4096 + (((2 * ks + h) ^ swz) << 4));
    __builtin_amdgcn_sched_barrier(0);
#pragma unroll
    for (int kt = 0; kt < 2; ++kt) {
#pragma unroll
        for (int e = 0; e < 16; ++e) s[kt][e] = 0.f;
#pragma unroll
        for (int ks = 0; ks < 4; ++ks) s[kt] = MFMA32(kf[kt * 4 + ks], qf[ks], s[kt]);
    }
}
template <int S> DI half8 pack8(const f32x16& x) {
    return (half8){(h16)x[8 * S], (h16)x[8 * S + 1], (h16)x[8 * S + 2], (h16)x[8 * S + 3], (h16)x[8 * S + 4], (h16)x[8 * S + 5], (h16)x[8 * S + 6], (h16)x[8 * S + 7]};
}
DI half8 ld_vfrag(const char* Vimg, int off0) {
    const half4 lo = *(const half4*)(Vimg + off0), hi = *(const half4*)(Vimg + (off0 ^ 16));
    return (half8){lo[0], lo[1], lo[2], lo[3], hi[0], hi[1], hi[2], hi[3]};
}
template <int KT>
DI void pv_load(const char* Vimg, half8 (&vf)[4], int lane) {
    const int r = lane & 31, h = lane >> 5, swz16 = ((r >> 1) & 7) << 4;
    const char* rb = Vimg + r * 128 + 8 * h;
#pragma unroll
    for (int dt = 0; dt < 2; ++dt) {
        vf[dt * 2 + 0] = ld_vfrag(rb + dt * 4096, ((4 * KT) << 4) ^ swz16);
        vf[dt * 2 + 1] = ld_vfrag(rb + dt * 4096, ((4 * KT + 2) << 4) ^ swz16);
    }
}
template <int KT>
DI void pv_mma(const half8 (&vf)[4], const f32x16 (&p)[2], f32x16 (&o)[2]) {
    const half8 pb0 = pack8<0>(p[KT]), pb1 = pack8<1>(p[KT]);
#pragma unroll
    for (int dt = 0; dt < 2; ++dt) {
        o[dt] = MFMA32(vf[dt * 2 + 0], pb0, o[dt]);
        o[dt] = MFMA32(vf[dt * 2 + 1], pb1, o[dt]);
    }
}
DI void pv_finish(const char* Vimg, const half8 (&va)[4], const f32x16 (&p)[2], f32x16 (&o)[2], int lane) {
    half8 vb[4];
    pv_load<1>(Vimg, vb, lane);
    pv_mma<0>(va, p, o);
    pv_mma<1>(vb, p, o);
}
DI float xhalf_max(float v) {
    const auto r = __builtin_amdgcn_permlane32_swap(__float_as_uint(v), __float_as_uint(v), false, false);
    return fmaxf(__uint_as_float(r[0]), __uint_as_float(r[1]));
}
DI float xhalf_sum(float v) {
    const auto r = __builtin_amdgcn_permlane32_swap(__float_as_uint(v), __float_as_uint(v), false, false);
    return __uint_as_float(r[0]) + __uint_as_float(r[1]);
}
DI float rowmax32(const f32x16 (&s)[2]) {
    float mx = s[0][0];
#pragma unroll
    for (int e = 1; e < 16; ++e) mx = fmaxf(mx, s[0][e]);
#pragma unroll
    for (int e = 0; e < 16; ++e) mx = fmaxf(mx, s[1][e]);
    return xhalf_max(mx);
}
constexpr float SM_THR = 6.f;
DI void sm_online(f32x16 (&s)[2], float& m, float& l, f32x16 (&o)[2], const bool rowok) {
    float mx = rowmax32(s);
    mx = rowok ? mx : NEGS;
    if (__any(mx > m + SM_THR)) {
        const float mn = fmaxf(m, mx), alpha = ex2(m - mn);
        l *= alpha; o[0] *= alpha; o[1] *= alpha; m = mn;
    }
    const float msub = rowok ? m : 1e30f;
    float rs = 0.f;
#pragma unroll
    for (int kt = 0; kt < 2; ++kt)
#pragma unroll
        for (int e = 0; e < 16; ++e) { const float p = ex2(s[kt][e] - msub); s[kt][e] = p; rs += p; }
    l += xhalf_sum(rs);
}

DI void nsa_unit(const Params& P, int l, int bg, int c32, char* smem) {
    const int tid = otid(), lane = tid & 63, w = tid >> 6, r = lane & 31, h = lane >> 5;
    const int b = bg >> 1, g = bg & 1, t0 = c32 * 32, cur = c32 >> 1;
    const int tokl = w * 8 + (r >> 2), head = r & 3, t = t0 + tokl;
    const size_t tokg = (size_t)b * SEQ + t;
    float* IMP = (float*)(smem + 49152);
    unsigned* SELM = (unsigned*)(smem + 49152);
    const h16* proj = (const h16*)(P.ws + OFF_PROJ);
    const int ghead = g * 4 + head;

    half8 qf[4];
    {
        const h16* qp = proj + tokg * D_IN + C_NQ + ghead * 64 + 8 * h;
#pragma unroll
        for (int ks = 0; ks < 4; ++ks) qf[ks] = *(const half8*)(qp + 16 * ks);
    }
    float g0, g1, g2;
    {
        const h16* gp = proj + tokg * D_IN + C_NGL + ghead * 3;
        const float* gb = P.in[I_NGB] + l * 24 + ghead * 3;
        g0 = sigmoidf_((float)gp[0] + gb[0]); g1 = sigmoidf_((float)gp[1] + gb[1]); g2 = sigmoidf_((float)gp[2] + gb[2]);
    }
    __syncthreads();
    for (int i = tid; i < 32 * 128; i += 256) IMP[i] = 0.f;

    f32x16 oacc[2];
#pragma unroll
    for (int e = 0; e < 16; ++e) { oacc[0][e] = 0.f; oacc[1][e] = 0.f; }

    {
        const int nvt = 2 * c32 + 1;
        const int nvr = (t >= 31) ? ((t - 31) >> 4) + 1 : 0;
        const int ntile = (nvt + 63) >> 6;
        KVSrc src{(const h16*)(P.ws + OFF_KCMP) + (size_t)bg * 512 * 64, 64, 4096, (const h16*)(P.ws + OFF_VCMP) + (size_t)bg * 8 * 4096};
        float m = -1e20f, lsum = 0.f;
        nsa_pipe<3>(src, ntile, smem, w, lane, [&](int j, const char* st, auto&& issue) {
            f32x16 s[2];
            qk_tile(st, qf, s, lane);
            issue();
#pragma unroll
            for (int kt = 0; kt < 2; ++kt)
#pragma unroll
                for (int e = 0; e < 16; ++e) {
                    const int key = 64 * j + 32 * kt + 8 * (e >> 2) + 4 * h + (e & 3);
                    if (key >= nvr) s[kt][e] = NEGS;
                }
            const float mn = fmaxf(m, rowmax32(s)), alpha = ex2(m - mn);
            float rs = 0.f;
#pragma unroll
            for (int kt = 0; kt < 2; ++kt)
#pragma unroll
                for (int e = 0; e < 16; ++e) rs += ex2(s[kt][e] - mn);
            rs = xhalf_sum(rs);
            lsum = lsum * alpha + rs; m = mn;
        });
        const float invl = lsum > 0.f ? 1.f / lsum : 0.f;
        f32x16 o[2];
#pragma unroll
        for (int e = 0; e < 16; ++e) { o[0][e] = 0.f; o[1][e] = 0.f; }
        nsa_pipe<3>(src, ntile, smem, w, lane, [&](int j, const char* st, auto&& issue) {
            f32x16 s[2];
            qk_tile(st, qf, s, lane);
            half8 vf[4];
            pv_load<0>(st + 8192, vf, lane);
            issue();
            __builtin_amdgcn_sched_barrier(0);
#pragma unroll
            for (int kt = 0; kt < 2; ++kt)
#pragma unroll
                for (int e = 0; e < 16; ++e) {
                    const int key = 64 * j + 32 * kt + 8 * (e >> 2) + 4 * h + (e & 3);
                    s[kt][e] = (key < nvr) ? ex2(s[kt][e] - m) * invl : 0.f;
                }
            if (cur >= 16) {
#pragma unroll
                for (int kt = 0; kt < 2; ++kt)
#pragma unroll
                    for (int g4 = 0; g4 < 4; ++g4) {
                        float G = (s[kt][4 * g4] + s[kt][4 * g4 + 1]) + (s[kt][4 * g4 + 2] + s[kt][4 * g4 + 3]);
                        float L = s[kt][4 * g4 + 3];
                        G += __shfl_xor(G, 1); G += __shfl_xor(G, 2);
                        L += __shfl_xor(L, 1); L += __shfl_xor(L, 2);
                        if (head == 0) {
                            const int sb = 16 * j + 8 * kt + 2 * g4 + h;
                            atomicAdd(&IMP[tokl * 128 + sb], G);
                            if (sb + 1 < 128) atomicAdd(&IMP[tokl * 128 + sb + 1], L);
                        }
                    }
            }
            pv_finish(st + 8192, vf, s, o, lane);
        });
        oacc[0] = o[0] * g0; oacc[1] = o[1] * g0;
    }
    __syncthreads();
    {
        const int tl = lane >> 3, sub = lane & 7;
        unsigned bits = 0;
        unsigned u[16];
        if (cur >= 16) {
            const float* ip = IMP + (w * 8 + tl) * 128 + sub * 16;
#pragma unroll
            for (int i = 0; i < 16; ++i) {
                const int s = sub * 16 + i;
                u[i] = (s >= 1 && s <= cur - 2) ? (__float_as_uint(ip[i]) + 1u) : 0u;
            }
        }
        __syncthreads();
        if (cur >= 16) {
            unsigned prefix = 0;
            for (int bit = 30; bit >= 0; --bit) {
                const unsigned cand = prefix | (1u << bit);
                int cnt = 0;
#pragma unroll
                for (int i = 0; i < 16; ++i) cnt += (u[i] >= cand) ? 1 : 0;
                cnt += __shfl_xor(cnt, 1); cnt += __shfl_xor(cnt, 2); cnt += __shfl_xor(cnt, 4);
                if (cnt >= 13) prefix = cand;
            }
            int cgt = 0, ceq = 0;
#pragma unroll
            for (int i = 0; i < 16; ++i) { cgt += (u[i] > prefix) ? 1 : 0; ceq += (u[i] == prefix) ? 1 : 0; }
            cgt += __shfl_xor(cgt, 1); cgt += __shfl_xor(cgt, 2); cgt += __shfl_xor(cgt, 4);
            int inc = ceq;
            { const int v = __shfl_up(inc, 1); if (sub >= 1) inc += v; }
            { const int v = __shfl_up(inc, 2); if (sub >= 2) inc += v; }
            { const int v = __shfl_up(inc, 4); if (sub >= 4) inc += v; }
            int run = inc - ceq;
            const int need = 13 - cgt;
#pragma unroll
            for (int i = 0; i < 16; ++i) {
                const int s = sub * 16 + i;
                bool sel = u[i] > prefix;
                if (u[i] == prefix) { sel = run < need; ++run; }
                if (s == 0 || s == cur || s == cur - 1) sel = true;
                bits |= (sel ? 1u : 0u) << i;
            }
        } else {
#pragma unroll
            for (int i = 0; i < 16; ++i) bits |= ((sub * 16 + i <= cur) ? 1u : 0u) << i;
        }
        unsigned wv = bits << ((sub & 1) * 16);
        wv |= __shfl_xor(wv, 1);
        if ((sub & 1) == 0) SELM[(w * 8 + tl) * 4 + (sub >> 1)] = wv;
    }
    __syncthreads();
    unsigned selw[4];
#pragma unroll
    for (int i = 0; i < 4; ++i) selw[i] = SELM[tokl * 4 + i];

#pragma unroll 1
    for (int br = 0; br < 2; ++br) {
        const int j0 = (br == 0) ? 0 : (cur - 8 > 0 ? cur - 8 : 0);
        const int nst = cur - j0 + 1;
        KVSrc src{proj + ((size_t)b * SEQ + (size_t)j0 * 64) * D_IN + C_NKV + (br == 0 ? 256 : 512) + g * 64, D_IN, (size_t)64 * D_IN,
                  (const h16*)(P.ws + OFF_VTG) + (((size_t)br * 4 + bg) * 128 + j0) * 4096};
        float m = -1e20f, lsum = 0.f;
        f32x16 o[2];
#pragma unroll
        for (int e = 0; e < 16; ++e) { o[0][e] = 0.f; o[1][e] = 0.f; }
        nsa_pipe<4>(src, nst, smem, w, lane, [&](int jj, const char* st, auto&& issue) {
            const int j = j0 + jj;
            f32x16 s[2];
            qk_tile(st, qf, s, lane);
            half8 vf[4];
            pv_load<0>(st + 8192, vf, lane);
            issue();
            __builtin_amdgcn_sched_barrier(0);
            const bool rowok = (br != 0) || (((selw[j >> 5] >> (j & 31)) & 1u) != 0u);
            if (j == cur || (br == 1 && j == cur - 8)) {
#pragma unroll
                for (int kt = 0; kt < 2; ++kt)
#pragma unroll
                    for (int e = 0; e < 16; ++e) {
                        const int key = 64 * j + 32 * kt + 8 * (e >> 2) + 4 * h + (e & 3);
                        const bool ok = (key <= t) && (br == 0 || key > t - 512);
                        if (!ok) s[kt][e] = NEGS;
                    }
            }
            sm_online(s, m, lsum, o, rowok);
            pv_finish(st + 8192, vf, s, o, lane);
        });
        const float sc = (br == 0 ? g1 : g2) / lsum;
        oacc[0] += o[0] * sc; oacc[1] += o[1] * sc;
    }
    {
        h16* mixp = (h16*)(P.ws + OFF_MIX) + tokg * 1024 + 512 + ghead * 64;
        const h16* ngp = proj + tokg * D_IN + C_NG + ghead * 64;
#pragma unroll
        for (int dt = 0; dt < 2; ++dt)
#pragma unroll
            for (int g4 = 0; g4 < 4; ++g4) {
                const int d0 = 32 * dt + 8 * g4 + 4 * h;
                const half4 ng = *(const half4*)(ngp + d0);
                half4 ov;
#pragma unroll
                for (int e = 0; e < 4; ++e) ov[e] = (h16)(oacc[dt][4 * g4 + e] * siluf_((float)ng[e]));
                *(half4*)(mixp + d0) = ov;
            }
    }
    __syncthreads();
}

DI void glu_tile(const Params& P, int l, int tile, char* smem) {
    const int mt = tile >> 2, nt = tile & 3;
    f32x4 acc[4][4];
    float ssd[4];
    gemm_mainloop_glds<false>(256, APlain{(const h16*)(P.ws + OFF_YACT) + (size_t)mt * 128 * 256, 256, 64},
                              (const h16*)(P.ws + OFF_WTGLU) + ((size_t)l * 512 + nt * 128) * 256, 256, acc, ssd, smem);
    const int tid = otid(), lane = tid & 63, wid = tid >> 6, wr = wid >> 1, wc = wid & 1;
    const h16* proj = (const h16*)(P.ws + OFF_PROJ);
    h16* mix = (h16*)(P.ws + OFF_MIX);
    const float* gb = P.in[I_GLUB] + l * 512;
#pragma unroll
    for (int i = 0; i < 4; ++i) {
        const size_t tok = (size_t)mt * 128 + wr * 64 + i * 16 + (lane & 15);
#pragma unroll
        for (int pj = 0; pj < 2; ++pj) {
            const int c = nt * 64 + wc * 32 + pj * 16 + (lane >> 4) * 4;
            const f32x4 z1 = acc[i][2 * pj], z2 = acc[i][2 * pj + 1];
            const float4 b1 = *(const float4*)(gb + c), b2 = *(const float4*)(gb + 256 + c);
            const half4 g4 = *(const half4*)(proj + tok * D_IN + C_SG + c);
            half4 o;
            o[0] = (h16)((z1[0] + b1.x) * sigmoidf_(z2[0] + b2.x) * siluf_((float)g4[0]));
            o[1] = (h16)((z1[1] + b1.y) * sigmoidf_(z2[1] + b2.y) * siluf_((float)g4[1]));
            o[2] = (h16)((z1[2] + b1.z) * sigmoidf_(z2[2] + b2.z) * siluf_((float)g4[2]));
            o[3] = (h16)((z1[3] + b1.w) * sigmoidf_(z2[3] + b2.w) * siluf_((float)g4[3]));
            *(half4*)(mix + tok * 1024 + 256 + c) = o;
        }
    }
}

DI void outproj_tile(const Params& P, int l, int mt, int nt, char* smem) {
    f32x4 acc[4][4];
    float ssd[4];
    gemm_mainloop_glds<false>(1024, APlain{(const h16*)(P.ws + OFF_MIX) + (size_t)mt * 128 * 1024, 1024, 64},
                              (const h16*)(P.ws + OFF_WTOUT) + ((size_t)l * 1024 + nt * 128) * 1024, 1024, acc, ssd, smem);
    const int tid = otid(), lane = tid & 63, wid = tid >> 6, wr = wid >> 1, wc = wid & 1;
    const float* xin = (l == 0) ? P.in[I_X] : P.out;
    h16* xh = (h16*)(P.ws + OFF_XH);
#pragma unroll
    for (int i = 0; i < 4; ++i) {
        const size_t row = (size_t)mt * 128 + wr * 64 + i * 16 + (lane & 15);
#pragma unroll
        for (int jj = 0; jj < 4; ++jj) {
            const int n = nt * 128 + wc * 64 + jj * 16 + (lane >> 4) * 4;
            const f32x4 v = acc[i][jj];
            const float4 xo = *(const float4*)(xin + row * 1024 + n);
            const float4 xn = (float4){xo.x + v[0], xo.y + v[1], xo.z + v[2], xo.w + v[3]};
            *(float4*)(P.out + row * 1024 + n) = xn;
            *(half4*)(xh + row * 1024 + n) = (half4){(h16)xn.x, (h16)xn.y, (h16)xn.z, (h16)xn.w};
        }
    }
}

#define XB_TMO      128
#define XB_XCNT(j)  (256  + 64 * (j))
#define XB_XSUB(j)  (1280 + 64 * (j))
#define XB_XGEN(j)  (2304 + 64 * (j))
#define XB_TOP      3328
#define XB_TOPGEN   3392
#define XCD_BAR_WORDS 3456
#define XB_SPIN_CAP (1u << 18)
#define LAS __attribute__((address_space(3)))

__device__ __forceinline__ unsigned xb_ld(unsigned* p)              { return __hip_atomic_load(p, __ATOMIC_RELAXED, __HIP_MEMORY_SCOPE_AGENT); }
__device__ __forceinline__ unsigned xb_add(unsigned* p, unsigned v) { return __hip_atomic_fetch_add(p, v, __ATOMIC_RELAXED, __HIP_MEMORY_SCOPE_AGENT); }
__device__ __forceinline__ unsigned xb_xcc_id() { return (unsigned)__builtin_amdgcn_s_getreg((3 << 11) | 20) & 0xFu; }
#define XB_SPIN(cond, bar) do { unsigned _sp = 0; while (cond) { __builtin_amdgcn_s_sleep(1); \
    if ((++_sp & 255u) == 0u) { if (xb_ld(&(bar)[XB_TMO])) break; if (_sp > XB_SPIN_CAP) { atomicAdd(&(bar)[XB_TMO], 1u); break; } } } } while (0)

struct XcdBarrier {
    unsigned* bar; unsigned x;
    volatile LAS unsigned* st;
};

__device__ __forceinline__ XcdBarrier xcd_barrier_post(unsigned* bar, volatile LAS unsigned* st) {
    XcdBarrier b; b.bar = bar; b.x = xb_xcc_id(); b.st = st;
    if (threadIdx.x == 0) (void)xb_add(&bar[XB_XCNT(b.x)], 1u);
    return b;
}
__device__ __forceinline__ void xcd_barrier_complete(unsigned* bar, unsigned x, unsigned& nloc, unsigned& nx) {
    const unsigned G = gridDim.x * gridDim.y * gridDim.z;
    unsigned sum, cnt, mine, sp = 0u;
    for (;;) {
        sum = 0u; cnt = 0u; mine = 0u;
#pragma unroll
        for (unsigned j = 0; j < 16; ++j) { const unsigned c = xb_ld(&bar[XB_XCNT(j)]); sum += c; cnt += (c > 0u) ? 1u : 0u; mine = (j == x) ? c : mine; }
        if (sum == G) break;
        __builtin_amdgcn_s_sleep(1);
        if ((++sp & 255u) == 0u) { if (xb_ld(&bar[XB_TMO])) break; if (sp > XB_SPIN_CAP) { atomicAdd(&bar[XB_TMO], 1u); break; } }
    }
    nloc = mine > 0u ? mine : 1u; nx = cnt > 0u ? cnt : 1u;
}

__device__ __forceinline__ void xcd_barrier(const XcdBarrier& b) {
    asm volatile("s_waitcnt vmcnt(0)" ::: "memory");
    __syncthreads();
    if (threadIdx.x == 0) {
        unsigned* bar = b.bar;
        __builtin_amdgcn_s_waitcnt(0);
        unsigned nloc = b.st[0], nx = b.st[1];
        if (nloc == 0u) { xcd_barrier_complete(bar, b.x, nloc, nx); b.st[0] = nloc; b.st[1] = nx; }
        const unsigned old = xb_add(&bar[XB_XSUB(b.x)], 1u);
        const unsigned gen = old / nloc;
        if (old + 1u == (gen + 1u) * nloc) {
            __builtin_amdgcn_fence(__ATOMIC_RELEASE, "agent");
            asm volatile("s_waitcnt vmcnt(0)" ::: "memory");
            const unsigned og = xb_add(&bar[XB_TOP], 1u);
            const unsigned tg = og / nx;
            if (og + 1u == (tg + 1u) * nx) xb_add(&bar[XB_TOPGEN], 1u);
            else XB_SPIN(xb_ld(&bar[XB_TOPGEN]) == tg, bar);
            __builtin_amdgcn_fence(__ATOMIC_ACQUIRE, "agent");
            xb_add(&bar[XB_XGEN(b.x)], 1u);
            asm volatile("s_waitcnt vmcnt(0)" ::: "memory");
        } else {
            XB_SPIN(xb_ld(&bar[XB_XGEN(b.x)]) == gen, bar);
            __builtin_amdgcn_fence(__ATOMIC_ACQUIRE, "agent");
            asm volatile("s_waitcnt vmcnt(0)" ::: "memory");
        }
    }
    __syncthreads();
}


__global__ void __launch_bounds__(NTHREADS, 2) fwd_megakernel(Params P) {
    extern __shared__ __attribute__((aligned(16))) char smem[];
    cg::grid_group grid = cg::this_grid();
    const int G = gridDim.x, bid = blockIdx.x;

    uint4& xb_words = *(uint4*)(smem + SMEM_MAIN);
    if (otid() == 0) xb_words = make_uint4(0u, 0u, 0u, 0u);
    if (bid == 0) for (int i = otid(); i < XCD_BAR_WORDS; i += NTHREADS) ((unsigned*)(P.ws + OFF_BAR))[i] = 0u;
    phase0(P, smem);
    grid.sync();
    const XcdBarrier xb = xcd_barrier_post((unsigned*)(P.ws + OFF_BAR), (volatile LAS unsigned*)(smem + SMEM_MAIN));

#pragma unroll 1
    for (int l = 0; l < DEPTH; ++l) {
        {
            const int xcd = bid & 7, jx = bid >> 3, nper = G >> 3;
            for (int u = jx; u < 400; u += nper) {
                const int mh = u / 200, rem = u - mh * 200;
                inproj_tile(P, l, xcd * 16 + mh * 8 + (rem & 7), rem >> 3, smem);
            }
            const int rem7 = 400 % nper;
            const int rank = (jx >= rem7) ? (jx - rem7) * 8 + xcd : (nper - rem7) * 8 + jx * 8 + xcd;
            for (int it = rank; it < 320; it += G) s5_build_item(P, l, it, smem);
        }
        xcd_barrier(xb);
#pragma unroll 1
        for (int w = bid; w < 128 + 64 + 2048; w += G) {
            if (w < 128) cmp_gemm_tile(P, l, w, smem);
            else if (w < 192) s5e_gemm_tile(P, l, w - 128, smem);
            else gla_kv_item(P, l, w - 192, smem);
        }
        xcd_barrier(xb);
#pragma unroll 1
        for (int w = bid; w < 512 + 512 + 64; w += G) {
            if (w < 512) cmp_l2_item(P, l, w, smem);
            else if (w < 1024) gla_scan_item(P, w - 512, smem);
            else s5_scan_item(P, w - 1024, smem);
        }
        xcd_barrier(xb);
#pragma unroll 1
        for (int w = bid; w < 512 + 256 + 2048; w += G) {
            if (w < 512) {
                const int bg = w & 3, q = w >> 2;
                nsa_unit(P, l, bg, 255 - q, smem);
                nsa_unit(P, l, bg, q, smem);
            } else if (w < 512 + 256) s5o_gemm_tile(P, l, w - 512, smem);
            else gla_out_item(P, l, w - 512 - 256, smem);
        }
        xcd_barrier(xb);
#pragma unroll 1
        for (int w = bid; w < 512; w += G) glu_tile(P, l, w, smem);
        xcd_barrier(xb);
        {
            const int xcd = bid & 7, jx = bid >> 3, nper = G >> 3;
            for (int u = jx; u < 128; u += nper) outproj_tile(P, l, xcd * 16 + (u >> 6) * 8 + (u & 7), (u & 63) >> 3, smem);
        }
        xcd_barrier(xb);
    }
}

extern "C" void kernel_launch(void* const* d_in, const int* in_sizes, int n_in, void* d_out, int out_size, void* d_ws,
                              size_t ws_size, hipStream_t stream) {
    static int grid_blocks = 0;
    if (!grid_blocks) {
        int dev = 0, cus = 0, per_cu = 0;
        hipGetDevice(&dev);
        hipDeviceGetAttribute(&cus, hipDeviceAttributeMultiprocessorCount, dev);
        hipFuncSetAttribute((const void*)fwd_megakernel, hipFuncAttributeMaxDynamicSharedMemorySize, SMEM_BYTES);
        hipOccupancyMaxActiveBlocksPerMultiprocessor(&per_cu, fwd_megakernel, NTHREADS, SMEM_BYTES);
        if (per_cu < 1) per_cu = 1;
        if (per_cu > 2) per_cu = 2;
        grid_blocks = cus * per_cu;
        if (ws_size < WS_END) fprintf(stderr, "kernel_launch: workspace too small: %zu < %zu\n", ws_size, (size_t)WS_END);
    }
    Params p{};
    for (int i = 0; i < 25; ++i) p.in[i] = (const float*)d_in[i];
    p.out = (float*)d_out;
    p.ws = (char*)d_ws;
    void* args[] = {&p};
    hipError_t e = hipLaunchCooperativeKernel((const void*)fwd_megakernel, dim3(grid_blocks), dim3(NTHREADS), args, SMEM_BYTES, stream);
    if (e != hipSuccess) fprintf(stderr, "cooperative launch failed: %s (grid %d)\n", hipGetErrorString(e), grid_blocks);
}
```

```cpp
#include <hip/hip_runtime.h>
#include <hip/hip_cooperative_groups.h>
#include <cstdio>
#include <cstdint>
namespace cg = cooperative_groups;

typedef _Float16 h16;
typedef _Float16 half8 __attribute__((ext_vector_type(8)));
typedef _Float16 half4 __attribute__((ext_vector_type(4)));
typedef float f32x4 __attribute__((ext_vector_type(4)));
typedef float f32x16 __attribute__((ext_vector_type(16)));

#define DI __device__ __forceinline__

constexpr int D_MODEL = 1024, BATCH = 2, SEQ = 8192, DEPTH = 4, NT = BATCH * SEQ;
constexpr int D_IN = 3112, D_IN_PAD = 3200;
constexpr int C_NQ = 0, C_NKV = 512, C_NG = 1280, C_GQ = 1792, C_GK = 1920, C_GV = 2048, C_GG = 2304, C_SU = 2560, C_SG = 2816,
              C_GLR = 3072, C_NGL = 3088;
__host__ __device__ constexpr int map_col(int c) {
    return c < 128 ? C_GQ + c : c < 256 ? C_GK + (c - 128) : c < 512 ? C_GV + (c - 256) : c < 528 ? C_GLR + (c - 512)
         : c < 784 ? C_GG + (c - 528) : c < 1040 ? C_SU + (c - 784) : c < 1296 ? C_SG + (c - 1040) : c < 1808 ? C_NQ + (c - 1296)
         : c < 2576 ? C_NKV + (c - 1808) : c < 2600 ? C_NGL + (c - 2576) : c < 3112 ? C_NG + (c - 2600) : c;
}
constexpr int NTHREADS = 256;
constexpr float QSCALE = 0.125f * 1.4426950408889634f;

enum { I_X = 0, I_NORMG, I_WIN, I_GW2, I_GB2, I_GON, I_LRE, I_LIM, I_LSTEP, I_BRE, I_BIM, I_CRE, I_CIM, I_SD, I_GLUW, I_GLUB,
       I_NGB, I_NQN, I_NKN, I_CPOS, I_CW1, I_CB1, I_CW2, I_CB2, I_WOUT };

constexpr size_t OFF_WTIN  = 0;
constexpr size_t OFF_WTOUT = OFF_WTIN  + 4ull * D_IN_PAD * 1024 * 2;
constexpr size_t OFF_WTGLU = OFF_WTOUT + 4ull * 1024 * 1024 * 2;
constexpr size_t OFF_WTC1  = OFF_WTGLU + 4ull * 512 * 256 * 2;
constexpr size_t OFF_PROJ  = OFF_WTC1  + 4ull * 2 * 256 * 2048 * 2;
constexpr size_t OFF_MIX   = OFF_PROJ  + (size_t)NT * D_IN * 2;
constexpr size_t OFF_YACT  = OFF_MIX   + (size_t)NT * 1024 * 2;
constexpr size_t OFF_XH    = OFF_YACT;
constexpr size_t OFF_BCUM  = OFF_YACT  + (size_t)NT * 256 * 2;
constexpr size_t OFF_GKV   = OFF_BCUM  + (size_t)NT * 128 * 4;
constexpr size_t OFF_GDEC  = OFF_GKV   + 8ull * 256 * 2048 * 4;
static_assert(OFF_GDEC - OFF_XH >= (size_t)NT * 1024 * 2, "XH alias region too small");
constexpr size_t OFF_XC    = OFF_GDEC  + 8ull * 256 * 32 * 4;
constexpr size_t OFF_S5W   = OFF_XC    + 512ull * 1024 * 2 * 4;
constexpr size_t OFF_S5E   = OFF_S5W   + 16ull * 512 * 640 * 2;
constexpr size_t OFF_S5AL  = OFF_S5E   + 16ull * 128 * 512 * 2;
constexpr size_t OFF_CHID  = OFF_S5AL  + 1024ull * 2 * 4;
constexpr size_t OFF_POSB  = OFF_CHID  + 2ull * 2048 * 512 * 4;
constexpr size_t OFF_XCH   = OFF_POSB  + 8ull * 16 * 256 * 4;
constexpr size_t OFF_KCMP  = OFF_XCH   + 512ull * 2048 * 2;
constexpr size_t OFF_VCMP  = OFF_KCMP  + 4ull * 512 * 64 * 2;
constexpr size_t OFF_VTG   = OFF_VCMP  + 4ull * 512 * 64 * 2;
constexpr size_t OFF_BAR   = OFF_VTG   + 2ull * 4 * 128 * 4096 * 2;
constexpr size_t WS_END    = OFF_BAR   + 16384;

struct Params {
    const float* in[25];
    float* out;
    char* ws;
};

__host__ __device__ constexpr size_t kb_idx(size_t nrows, size_t row, int k) { return (((size_t)(k >> 6)) * nrows + row) * 64 + (k & 63); }
constexpr int SMEM_MAIN = 65536;
constexpr int SMEM_BYTES = SMEM_MAIN + 16;

DI int otid() { int t = threadIdx.x; asm volatile("" : "+v"(t)); return t; }
DI float wave_sum(float v) {
#pragma unroll
    for (int o = 32; o > 0; o >>= 1) v += __shfl_xor(v, o);
    return v;
}
DI float wave_max(float v) {
#pragma unroll
    for (int o = 32; o > 0; o >>= 1) v = fmaxf(v, __shfl_xor(v, o));
    return v;
}
DI float sigmoidf_(float x) { return 1.f / (1.f + __expf(-x)); }
DI float siluf_(float x) { return x / (1.f + __expf(-x)); }
DI float gelu_tanh(float x) {
    const float u = 0.7978845608028654f * (x + 0.044715f * x * x * x);
    return 0.5f * x * (1.f + tanhf(u));
}
DI float log_sigmoidf_(float x) { return fminf(x, 0.f) - log1pf(__expf(-fabsf(x))); }

typedef _Float16 half2_ __attribute__((ext_vector_type(2)));
DI void glds16(const h16* g, char* l) {
    __builtin_amdgcn_global_load_lds((const __attribute__((address_space(1))) void*)g, (__attribute__((address_space(3))) void*)l, 16, 0, 0);
}
struct APlain { const h16* A; size_t lda, astep; DI const h16* operator()(int row, int kt, int c8) const { return A + (size_t)row * lda + (size_t)kt * astep + c8 * 8; } };
struct AS5 {
    const h16* ubase;
    const h16* xin;
    int ch0;
    DI const h16* operator()(int row, int kt, int c8) const {
        const size_t ch = (size_t)(ch0 + row);
        return kt < 8 ? ubase + (ch * 32 + 4 * kt + (c8 >> 1)) * D_IN + (c8 & 1) * 8 : xin + ch * 2048 + (kt - 8) * 64 + c8 * 8;
    }
};
template <bool SUMSQ, int WR, int MI, int NJ, class AF>
DI void gemm_glds(const int K, const AF& afn, const h16* __restrict__ Bt, const int ldb,
                  f32x4 (&acc)[MI][NJ], float (&ss)[MI], char* smem, const size_t bstep = 64) {
    constexpr int WC = 4 / WR, BM = WR * MI * 16, BN = WC * NJ * 16, AQ = BM / 32, BQ = BN / 32;
    static_assert(BM * 128 + BN * 128 <= SMEM_MAIN, "tile does not fit the LDS");
    const int tid = otid(), lane = tid & 63, wid = tid >> 6, wr = wid / WC, wc = wid % WC;
#pragma unroll
    for (int i = 0; i < MI; ++i) {
        ss[i] = 0.f;
#pragma unroll
        for (int j = 0; j < NJ; ++j) acc[i][j] = (f32x4){0.f, 0.f, 0.f, 0.f};
    }
    const int lrow = wid * 8 + (lane >> 3);
    const int lc8 = (lane & 7) ^ ((lrow >> 1) & 7);
    const h16* bp = Bt + (size_t)lrow * ldb + lc8 * 8;
    char* lbase = smem + wid * 1024;
    const int fr = lane & 15, fq = lane >> 4;
    int aoff[MI], boff[NJ];
#pragma unroll
    for (int i = 0; i < MI; ++i) { const int m = wr * MI * 16 + i * 16 + fr; aoff[i] = m * 128 + ((fq ^ ((m >> 1) & 7)) * 16); }
#pragma unroll
    for (int j = 0; j < NJ; ++j) { const int n = wc * NJ * 16 + j * 16 + fr; boff[j] = BM * 128 + n * 128 + ((fq ^ ((n >> 1) & 7)) * 16); }
    const int nk = K >> 6;
    for (int kt = 0; kt < nk; ++kt) {
        __syncthreads();
        {
            const size_t k1 = (size_t)kt * bstep;
#pragma unroll
            for (int q = 0; q < AQ; ++q) glds16(afn(lrow + 32 * q, kt, lc8), lbase + q * 4096);
#pragma unroll
            for (int q = 0; q < BQ; ++q) glds16(bp + (size_t)q * 32 * ldb + k1, lbase + BM * 128 + q * 4096);
        }
        asm volatile("s_waitcnt vmcnt(0)" ::: "memory");
        __syncthreads();
#pragma unroll
        for (int kk = 0; kk < 2; ++kk) {
            half8 af[MI], bf[NJ];
#pragma unroll
            for (int i = 0; i < MI; ++i) af[i] = *(const half8*)(smem + (aoff[i] ^ (kk * 64)));
#pragma unroll
            for (int j = 0; j < NJ; ++j) bf[j] = *(const half8*)(smem + (boff[j] ^ (kk * 64)));
            if (SUMSQ) {
#pragma unroll
                for (int i = 0; i < MI; ++i)
#pragma unroll
                    for (int e = 0; e < 4; ++e) {
                        const half2_ x = (half2_){af[i][2 * e], af[i][2 * e + 1]};
                        ss[i] = __builtin_amdgcn_fdot2(x, x, ss[i], false);
                    }
            }
#pragma unroll
            for (int i = 0; i < MI; ++i)
#pragma unroll
                for (int j = 0; j < NJ; ++j) acc[i][j] = __builtin_amdgcn_mfma_f32_16x16x32_f16(bf[j], af[i], acc[i][j], 0, 0, 0);
        }
    }
    __syncthreads();
    if (SUMSQ) {
#pragma unroll
        for (int i = 0; i < MI; ++i) { ss[i] += __shfl_xor(ss[i], 16); ss[i] += __shfl_xor(ss[i], 32); }
    }
}
template <bool SUMSQ, class AF>
DI void gemm_mainloop_glds(const int K, const AF& afn, const h16* __restrict__ Bt, const int ldb, f32x4 (&acc)[4][4], float (&ss)[4], char* smem, const size_t bstep = 64) {
    gemm_glds<SUMSQ, 2, 4, 4>(K, afn, Bt, ldb, acc, ss, smem, bstep);
}

DI int glu_perm_dst(int c_orig) {
    const int which = c_orig >> 8, c = c_orig & 255;
    return (c >> 6) * 128 + ((c >> 5) & 1) * 64 + (((c >> 4) & 1) * 2 + which) * 16 + (c & 15);
}
template <int MAP, int KB>
DI void transpose64(const float* __restrict__ src, int R, int C, h16* __restrict__ dst, int r0, int c0,
                    const float* __restrict__ rscale, char* smem) {
    h16* tile = (h16*)smem;
    const int tid = otid();
    {
        const int r = tid >> 2, cq = (tid & 3) * 16;
        const float sc = rscale ? rscale[r0 + r] : 1.f;
        const float* sp = src + (size_t)(r0 + r) * C + c0 + cq;
#pragma unroll
        for (int q = 0; q < 4; ++q) {
            float4 v = (float4){0.f, 0.f, 0.f, 0.f};
            if (c0 + cq + q * 4 < C) v = *(const float4*)(sp + q * 4);
            *(half4*)(tile + r * 72 + cq + q * 4) = (half4){(h16)(v.x * sc), (h16)(v.y * sc), (h16)(v.z * sc), (h16)(v.w * sc)};
        }
    }
    __syncthreads();
    {
        const int c = tid >> 2, rq = (tid & 3) * 16;
        half8 o0, o1;
#pragma unroll
        for (int k = 0; k < 8; ++k) { o0[k] = tile[(rq + k) * 72 + c]; o1[k] = tile[(rq + 8 + k) * 72 + c]; }
        const int cc = c0 + c;
        const int dr = MAP == 1 ? map_col(cc) : MAP == 2 ? glu_perm_dst(cc) : cc;
        h16* dp = KB ? dst + ((size_t)(r0 >> 6) * KB + dr) * 64 + rq : dst + (size_t)dr * R + r0 + rq;
        *(half8*)dp = o0; *(half8*)(dp + 8) = o1;
    }
    __syncthreads();
}

DI void phase0(const Params& P, char* smem) {
    constexpr int N_WIN = 4 * 16 * 50, N_WOUT = 4 * 16 * 16, N_C1 = 16 * 16 * 4, N_GLU = 4 * 4 * 8, N_XH = NT * 1024 / 2048, N_PB = 8 * 16;
    const int total = N_WIN + N_WOUT + N_C1 + N_GLU + N_XH + N_PB;
    for (int w = blockIdx.x; w < total; w += gridDim.x) {
        if (w < N_WIN) {
            const int l = w / 800, r = w % 800, rt = r / 50, ct = r % 50;
            transpose64<1, D_IN_PAD>(P.in[I_WIN] + (size_t)l * 1024 * D_IN, 1024, D_IN, (h16*)(P.ws + OFF_WTIN) + (size_t)l * D_IN_PAD * 1024,
                           rt * 64, ct * 64, P.in[I_NORMG] + l * 1024, smem);
        } else if (w < N_WIN + N_WOUT) {
            const int v = w - N_WIN, l = v >> 8, r = v & 255, rt = r >> 4, ct = r & 15;
            transpose64<0, 1024>(P.in[I_WOUT] + (size_t)l * 1024 * 1024, 1024, 1024, (h16*)(P.ws + OFF_WTOUT) + (size_t)l * 1024 * 1024,
                           rt * 64, ct * 64, nullptr, smem);
        } else if (w < N_WIN + N_WOUT + N_C1) {
            const int v = w - N_WIN - N_WOUT, ljh = v >> 6, r = v & 63, rt = r >> 2, ct = r & 3;
            transpose64<0, 512>(P.in[I_CW1] + (size_t)ljh * 1024 * 256, 1024, 256, (h16*)(P.ws + OFF_WTC1) + ((size_t)(ljh >> 1) * 16 * 512 + (ljh & 1) * 256) * 64,
                           rt * 64, ct * 64, nullptr, smem);
        } else if (w < N_WIN + N_WOUT + N_C1 + N_GLU) {
            const int v = w - N_WIN - N_WOUT - N_C1, l = v >> 5, r = v & 31, rt = r >> 3, ct = r & 7;
            transpose64<2, 0>(P.in[I_GLUW] + (size_t)l * 256 * 512, 256, 512, (h16*)(P.ws + OFF_WTGLU) + (size_t)l * 512 * 256,
                           rt * 64, ct * 64, nullptr, smem);
        } else if (w < N_WIN + N_WOUT + N_C1 + N_GLU + N_XH) {
            const size_t e0 = ((size_t)(w - N_WIN - N_WOUT - N_C1 - N_GLU) * 256 + otid()) * 8;
            const float4 a = *(const float4*)(P.in[I_X] + e0), b = *(const float4*)(P.in[I_X] + e0 + 4);
            *(half8*)((h16*)(P.ws + OFF_XH) + kb_idx(NT, e0 >> 10, (int)(e0 & 1023))) = (half8){(h16)a.x, (h16)a.y, (h16)a.z, (h16)a.w, (h16)b.x, (h16)b.y, (h16)b.z, (h16)b.w};
        } else {
            const int v = w - (N_WIN + N_WOUT + N_C1 + N_GLU + N_XH), lj = v >> 4, ks = v & 15, n = otid();
            const float* w1 = P.in[I_CW1] + ((size_t)lj * 2048 + ks * 128) * 256 + n;
            const float* pp = P.in[I_CPOS] + (size_t)lj * 2048 + ks * 128;
            float a = ks == 0 ? P.in[I_CB1][lj * 256 + n] : 0.f;
#pragma unroll 16
            for (int k = 0; k < 128; ++k) a += pp[k] * w1[(size_t)k * 256];
            ((float*)(P.ws + OFF_POSB))[(lj * 16 + ks) * 256 + n] = a;
        }
    }
}

DI void s5_build_item(const Params& P, int l, int item, char* smem) {
    float* apow = (float*)smem;
    float* bbar = apow + 64 * 33 * 2;
    float* cc   = bbar + 64 * 16 * 2;
    const int tid = otid();
    const int g = (item < 256) ? (item >> 4) : ((item - 256) >> 2);
    if (tid < 64) {
        const int p = tid;
        const double lre = fmin((double)P.in[I_LRE][(l * 16 + g) * 64 + p], -1e-4);
        const double lim = (double)P.in[I_LIM][(l * 16 + g) * 64 + p];
        const double dt = exp((double)P.in[I_LSTEP][l * 16 + g]);
        const double mag = exp(lre * dt);
        const double ar = mag * cos(lim * dt), ai = mag * sin(lim * dt);
        const double den = lre * lre + lim * lim;
        const double fr = ((ar - 1.0) * lre + ai * lim) / den;
        const double fi = (ai * lre - (ar - 1.0) * lim) / den;
        double pr = 1.0, pi = 0.0;
        for (int k = 0; k <= 32; ++k) {
            apow[(p * 33 + k) * 2] = (float)pr; apow[(p * 33 + k) * 2 + 1] = (float)pi;
            const double nr = pr * ar - pi * ai, ni = pr * ai + pi * ar; pr = nr; pi = ni;
        }
        for (int c = 0; c < 16; ++c) {
            const double br = (double)P.in[I_BRE][((size_t)(l * 16 + g) * 64 + p) * 16 + c];
            const double bi = (double)P.in[I_BIM][((size_t)(l * 16 + g) * 64 + p) * 16 + c];
            bbar[(p * 16 + c) * 2] = (float)(fr * br - fi * bi);
            bbar[(p * 16 + c) * 2 + 1] = (float)(fr * bi + fi * br);
        }
    }
    for (int e = tid; e < 1024; e += 256) {
        cc[e * 2] = P.in[I_CRE][(size_t)(l * 16 + g) * 1024 + e];
        cc[e * 2 + 1] = P.in[I_CIM][(size_t)(l * 16 + g) * 1024 + e];
    }
    __syncthreads();
    if (item < 256) {
        const int c = item & 15;
        float* kt = cc + 2048;
        for (int idx = tid; idx < 512; idx += 256) {
            const int lag = idx >> 4, c2 = idx & 15;
            float a = 0.f;
            for (int p = 0; p < 64; ++p) {
                const float cr = cc[(c * 64 + p) * 2], ci = cc[(c * 64 + p) * 2 + 1];
                const float xr = apow[(p * 33 + lag) * 2], xi = apow[(p * 33 + lag) * 2 + 1];
                const float br = bbar[(p * 16 + c2) * 2], bi = bbar[(p * 16 + c2) * 2 + 1];
                const float tr = cr * xr - ci * xi, ti = cr * xi + ci * xr;
                a += tr * br - ti * bi;
            }
            kt[idx] = a;
        }
        __syncthreads();
        h16* W = (h16*)(P.ws + OFF_S5W) + (size_t)g * 512 * 640;
        for (int idx = tid; idx < 32 * 640; idx += 256) {
            const int j = idx / 640, k = idx % 640;
            float val = 0.f;
            if (k < 512) {
                const int s = k >> 4, c2 = k & 15, lag = j - s;
                if (lag >= 0) val = kt[lag * 16 + c2];
            } else {
                const int p = (k - 512) >> 1;
                const float cr = cc[(c * 64 + p) * 2], ci = cc[(c * 64 + p) * 2 + 1];
                const float xr = apow[(p * 33 + j + 1) * 2], xi = apow[(p * 33 + j + 1) * 2 + 1];
                val = (k & 1) ? -(cr * xi + ci * xr) : (cr * xr - ci * xi);
            }
            W[(size_t)(j * 16 + c) * 640 + k] = (h16)val;
        }
    } else {
        const int pq = (item - 256) & 3;
        h16* E = (h16*)(P.ws + OFF_S5E) + ((size_t)g * 128 + pq * 32) * 512;
        for (int idx = tid; idx < 32 * 512; idx += 256) {
            const int nl = idx >> 9, k = idx & 511;
            const int p = pq * 16 + (nl >> 1), s = k >> 4, c2 = k & 15;
            const float xr = apow[(p * 33 + 31 - s) * 2], xi = apow[(p * 33 + 31 - s) * 2 + 1];
            const float br = bbar[(p * 16 + c2) * 2], bi = bbar[(p * 16 + c2) * 2 + 1];
            const float val = (nl & 1) ? (xr * bi + xi * br) : (xr * br - xi * bi);
            E[(size_t)nl * 512 + k] = (h16)val;
        }
        if (tid < 16) {
            const int p = pq * 16 + tid;
            float* AL = (float*)(P.ws + OFF_S5AL);
            AL[(g * 64 + p) * 2] = apow[(p * 33 + 32) * 2];
            AL[(g * 64 + p) * 2 + 1] = apow[(p * 33 + 32) * 2 + 1];
        }
    }
    __syncthreads();
}

template <int WR>
DI void inproj_tile(const Params& P, int l, int mt, int n0, char* smem) {
    constexpr int MI = WR == 2 ? 8 : 4, WC = 4 / WR;
    f32x4 acc[MI][4];
    float ss[MI];
    gemm_glds<true, WR, MI, 4>(1024, APlain{(const h16*)(P.ws + OFF_XH) + (size_t)mt * 256 * 64, 64, (size_t)NT * 64},
                               (const h16*)(P.ws + OFF_WTIN) + ((size_t)l * 16 * D_IN_PAD + n0) * 64, 64, acc, ss, smem, (size_t)D_IN_PAD * 64);
    const int tid = otid(), lane = tid & 63, wid = tid >> 6, wr = wid / WC, wc = wid % WC;
    h16* proj = (h16*)(P.ws + OFF_PROJ);
    const int n64 = n0 + wc * 64;
    int cls = 0;
    if (n64 < 512) cls = 1;
    else if (n64 >= C_NKV + 256 && n64 < C_NKV + 384) cls = 2;
    else if (n64 >= C_NKV + 512 && n64 < C_NKV + 640) cls = 3;
    else if (n64 >= C_NKV + 384 && n64 < C_NKV + 512) cls = 4;
    else if (n64 >= C_NKV + 640 && n64 < C_NKV + 768) cls = 5;
    float wn[4][4];
    if (cls >= 1 && cls <= 3) {
        const float* wp = (cls == 1) ? P.in[I_NQN] + l * 64 : P.in[I_NKN] + (l * 3 + (cls - 1)) * 64;
        const float sc = (cls == 1) ? QSCALE : 1.f;
#pragma unroll
        for (int j = 0; j < 4; ++j) {
            const float4 w4 = *(const float4*)(wp + j * 16 + (lane >> 4) * 4);
            wn[j][0] = w4.x * sc; wn[j][1] = w4.y * sc; wn[j][2] = w4.z * sc; wn[j][3] = w4.w * sc;
        }
    }
#pragma unroll
    for (int i = 0; i < MI; ++i) {
        const int ml = wr * MI * 16 + i * 16 + (lane & 15);
        const float r = rsqrtf(ss[i] * (1.f / 1024.f) + 1e-6f);
        const size_t row = (size_t)mt * 256 + ml;
        f32x4 v[4];
#pragma unroll
        for (int j = 0; j < 4; ++j) v[j] = acc[i][j] * r;
        if (cls >= 1 && cls <= 3) {
            float s2 = 0.f;
#pragma unroll
            for (int j = 0; j < 4; ++j) s2 += v[j][0] * v[j][0] + v[j][1] * v[j][1] + v[j][2] * v[j][2] + v[j][3] * v[j][3];
            s2 += __shfl_xor(s2, 16); s2 += __shfl_xor(s2, 32);
            const float rn = rsqrtf(s2 * (1.f / 64.f) + 1e-6f);
#pragma unroll
            for (int j = 0; j < 4; ++j) { v[j][0] *= rn * wn[j][0]; v[j][1] *= rn * wn[j][1]; v[j][2] *= rn * wn[j][2]; v[j][3] *= rn * wn[j][3]; }
        }
        if (cls >= 4) {
            const int g = (n64 >> 6) & 1, br = cls - 4;
            const int b = (int)(row >> 13), t = (int)(row & 8191);
            h16* vt = (h16*)(P.ws + OFF_VTG) + ((((size_t)br * 4 + b * 2 + g) * 128 + (t >> 6)) * 64) * 64 + (t & 63);
#pragma unroll
            for (int j = 0; j < 4; ++j)
#pragma unroll
                for (int e = 0; e < 4; ++e) vt[(j * 16 + (lane >> 4) * 4 + e) * 64] = (h16)v[j][e];
        }
#pragma unroll
        for (int j = 0; j < 4; ++j) {
            const int n = n64 + j * 16 + (lane >> 4) * 4;
            if (n < D_IN) *(half4*)(proj + row * D_IN + n) = (half4){(h16)v[j][0], (h16)v[j][1], (h16)v[j][2], (h16)v[j][3]};
        }
    }
    __syncthreads();
}

DI void gla_kv_item(const Params& P, int l, int item, char* smem) {
    const int h = item & 3, cn = item >> 2;
    const size_t tok0 = (size_t)cn * 32;
    float* gl = (float*)smem;
    float* ke = gl + 32 * 33;
    float* vs = ke + 32 * 33;
    const h16* proj = (const h16*)(P.ws + OFF_PROJ);
    const int tid = otid(), i = tid >> 3, dq = (tid & 7) * 4, e0 = (tid & 7) * 8;
    {
        const half8* lp = (const half8*)(proj + (tok0 + i) * D_IN + C_GLR);
        const half8 l0 = lp[0], l1 = lp[1];
        float lr[16];
#pragma unroll
        for (int r = 0; r < 8; ++r) { lr[r] = (float)l0[r]; lr[8 + r] = (float)l1[r]; }
#pragma unroll
        for (int dd = 0; dd < 4; ++dd) {
            const int d = dq + dd;
            float x = P.in[I_GB2][l * 128 + h * 32 + d];
#pragma unroll
            for (int r = 0; r < 16; ++r) x += lr[r] * P.in[I_GW2][(l * 16 + r) * 128 + h * 32 + d];
            gl[i * 33 + d] = log_sigmoidf_(x) * (1.f / 16.f);
        }
    }
    __syncthreads();
    if (tid < 32) {
        float run = 0.f;
        float* bc = (float*)(P.ws + OFF_BCUM);
        for (int ii = 0; ii < 32; ++ii) {
            run += gl[ii * 33 + tid]; gl[ii * 33 + tid] = run;
            bc[(tok0 + ii) * 128 + h * 32 + tid] = run;
        }
    }
    __syncthreads();
    {
        const half4 kv4 = *(const half4*)(proj + (tok0 + i) * D_IN + C_GK + h * 32 + dq);
#pragma unroll
        for (int dd = 0; dd < 4; ++dd) {
            const int d = dq + dd;
            ke[i * 33 + d] = (float)kv4[dd] * __expf(gl[31 * 33 + d] - gl[i * 33 + d]);
        }
        const half8 v8 = *(const half8*)(proj + (tok0 + i) * D_IN + C_GV + h * 64 + e0);
#pragma unroll
        for (int e = 0; e < 8; ++e) vs[i * 64 + e0 + e] = (float)v8[e];
    }
    __syncthreads();
    {
        const int d = tid >> 3;
        float acc[8];
#pragma unroll
        for (int e = 0; e < 8; ++e) acc[e] = 0.f;
        for (int c = 0; c < 32; ++c) {
            const float kd = ke[c * 33 + d];
#pragma unroll
            for (int e = 0; e < 8; ++e) acc[e] += kd * vs[c * 64 + e0 + e];
        }
        const int b = cn >> 8, n = cn & 255, bh = b * 4 + h;
        float* kvp = (float*)(P.ws + OFF_GKV) + ((size_t)(bh * 256 + n) * 32 + d) * 64 + e0;
        *(float4*)kvp = (float4){acc[0], acc[1], acc[2], acc[3]};
        *(float4*)(kvp + 4) = (float4){acc[4], acc[5], acc[6], acc[7]};
        if (tid < 32) ((float*)(P.ws + OFF_GDEC))[(size_t)(bh * 256 + n) * 32 + tid] = __expf(gl[31 * 33 + tid]);
    }
    __syncthreads();
}

DI void cmp_gemm_tile(const Params& P, int l, int tile, char* smem) {
    const int j = tile >> 6, mt = (tile >> 2) & 15, nt = tile & 3;
    const int row0 = mt * 128, bg = row0 >> 9, i0 = row0 & 511, b = bg >> 1, g = bg & 1;
    f32x4 acc[4][4];
    float ssd[4];
    gemm_mainloop_glds<false>(1024, APlain{(const h16*)(P.ws + OFF_PROJ) + ((size_t)b * SEQ + 16 * i0) * D_IN + C_NKV + j * 128 + g * 64, (size_t)16 * D_IN, (size_t)D_IN},
                              (const h16*)(P.ws + OFF_WTC1) + ((size_t)(l * 2 + j) * 16 * 512 + nt * 128) * 64, 64, acc, ssd, smem, (size_t)512 * 64);
    const int tid = otid(), lane = tid & 63, wid = tid >> 6, wr = wid >> 1, wc = wid & 1;
    float* pt = (float*)(P.ws + OFF_CHID) + (size_t)j * 2048 * 512;
#pragma unroll
    for (int i = 0; i < 4; ++i) {
        const size_t row = (size_t)row0 + wr * 64 + i * 16 + (lane & 15);
#pragma unroll
        for (int jj = 0; jj < 4; ++jj) {
            const int n = nt * 128 + wc * 64 + jj * 16 + (lane >> 4) * 4;
            const f32x4 v = acc[i][jj];
            *(float4*)(pt + row * 512 + n) = (float4){v[0], v[1], v[2], v[3]};
        }
    }
}

DI void s5e_gemm_tile(const Params& P, int l, int tile, char* smem) {
    const int g = tile >> 2, mt = tile & 3;
    f32x4 acc[4][4];
    float ssd[4];
    gemm_mainloop_glds<false>(512, AS5{(const h16*)(P.ws + OFF_PROJ) + C_SU + g * 16, nullptr, mt * 128},
                              (const h16*)(P.ws + OFF_S5E) + (size_t)g * 128 * 512, 512, acc, ssd, smem);
    const int tid = otid(), lane = tid & 63, wid = tid >> 6, wr = wid >> 1, wc = wid & 1;
    float* xc = (float*)(P.ws + OFF_XC);
#pragma unroll
    for (int i = 0; i < 4; ++i) {
        const size_t ch = (size_t)mt * 128 + wr * 64 + i * 16 + (lane & 15);
#pragma unroll
        for (int jj = 0; jj < 4; ++jj) {
            const int n = wc * 64 + jj * 16 + (lane >> 4) * 4;
            const f32x4 v = acc[i][jj];
            *(float4*)(xc + (ch * 1024 + g * 64) * 2 + n) = (float4){v[0], v[1], v[2], v[3]};
        }
    }
}

DI void gla_scan_item(const Params& P, int item, char* smem) {
    const int tid = otid(), sl = tid & 31, part = tid >> 5;
    const int idx = item * 32 + sl, bh = idx >> 11, de = idx & 2047, d = de >> 6;
    float* kv = (float*)(P.ws + OFF_GKV) + ((size_t)bh * 256 + part * 32) * 2048 + de;
    const float* dc = (const float*)(P.ws + OFF_GDEC) + ((size_t)bh * 256 + part * 32) * 32 + d;
    float* sD = (float*)smem; float* sL = sD + 256;
    float kvv[32], dd[32];
#pragma unroll
    for (int i = 0; i < 32; ++i) { kvv[i] = kv[(size_t)i * 2048]; dd[i] = dc[i * 32]; }
    float D = 1.f, L = 0.f;
#pragma unroll
    for (int i = 0; i < 32; ++i) { L = dd[i] * L + kvv[i]; D *= dd[i]; }
    sD[part * 32 + sl] = D; sL[part * 32 + sl] = L;
    __syncthreads();
    float S = 0.f;
    for (int q = 0; q < part; ++q) S = sD[q * 32 + sl] * S + sL[q * 32 + sl];
#pragma unroll
    for (int i = 0; i < 32; ++i) { const float o = S; S = dd[i] * S + kvv[i]; kv[(size_t)i * 2048] = o; }
    __syncthreads();
}
DI void s5_scan_item(const Params& P, int item, char* smem) {
    const int tid = otid(), sl = tid & 31, part = tid >> 5;
    const int idx = item * 32 + sl, b = idx >> 10, s = idx & 1023;
    float2* xc = (float2*)(P.ws + OFF_XC) + ((size_t)b * 256 + part * 32) * 1024 + s;
    half2_* xch = (half2_*)(P.ws + OFF_XCH) + ((size_t)b * 256 + part * 32) * 1024 + s;
    const float2 a = ((const float2*)(P.ws + OFF_S5AL))[s];
    float2* sL = (float2*)smem;
    float2 c[32];
#pragma unroll
    for (int i = 0; i < 32; ++i) c[i] = xc[(size_t)i * 1024];
    float lr = 0.f, li = 0.f;
#pragma unroll
    for (int i = 0; i < 32; ++i) { const float nr = a.x * lr - a.y * li + c[i].x, ni = a.x * li + a.y * lr + c[i].y; lr = nr; li = ni; }
    float dr = a.x, di = a.y;
#pragma unroll
    for (int i = 0; i < 5; ++i) { const float nr = dr * dr - di * di, ni = 2.f * dr * di; dr = nr; di = ni; }
    sL[part * 32 + sl] = (float2){lr, li};
    __syncthreads();
    float xr = 0.f, xi = 0.f;
    for (int q = 0; q < part; ++q) { const float2 lq = sL[q * 32 + sl]; const float nr = dr * xr - di * xi + lq.x, ni = dr * xi + di * xr + lq.y; xr = nr; xi = ni; }
#pragma unroll
    for (int i = 0; i < 32; ++i) {
        const float2 o = (float2){xr, xi};
        const float nr = a.x * xr - a.y * xi + c[i].x, ni = a.x * xi + a.y * xr + c[i].y; xr = nr; xi = ni;
        xc[(size_t)i * 1024] = o;
        xch[(size_t)i * 1024] = (half2_){(h16)o.x, (h16)o.y};
    }
    __syncthreads();
}
DI void cmp_l2_item(const Params& P, int l, int item, char* smem) {
    const int tid = otid(), lane = tid & 63, w = tid >> 6;
    const int j = item >> 8, r0 = (item & 255) * 8;
    h16* w2s = (h16*)smem;
    float* hs = (float*)(smem + 32768);
    {
        const float* w2 = P.in[I_CW2] + (size_t)(l * 2 + j) * 256 * 64;
        for (int e = tid * 4; e < 256 * 64; e += 1024) {
            const float4 v = *(const float4*)(w2 + e);
            *(half4*)(w2s + e) = (half4){(h16)v.x, (h16)v.y, (h16)v.z, (h16)v.w};
        }
        const float* pt = (const float*)(P.ws + OFF_CHID) + (size_t)j * 2048 * 512;
        float pb = 0.f;
#pragma unroll
        for (int ks = 0; ks < 16; ++ks) pb += ((const float*)(P.ws + OFF_POSB))[((l * 2 + j) * 16 + ks) * 256 + tid];
#pragma unroll
        for (int rr = 0; rr < 8; ++rr) {
            const int row = r0 + rr, i = row & 511;
            float v = 0.f;
            if (i < 511) v = gelu_tanh(pt[(size_t)row * 512 + tid] + pt[(size_t)(row + 1) * 512 + 256 + tid] + pb);
            hs[rr * 256 + tid] = v;
        }
    }
    __syncthreads();
    const float bb = P.in[I_CB2][(l * 2 + j) * 64 + lane];
    float a0 = bb, a1 = bb;
    const float* h0 = hs + (2 * w) * 256, *h1 = h0 + 256;
#pragma unroll 8
    for (int n = 0; n < 256; ++n) {
        const float wv = (float)w2s[n * 64 + lane];
        a0 += h0[n] * wv; a1 += h1[n] * wv;
    }
#pragma unroll
    for (int rr = 0; rr < 2; ++rr) {
        float acc = rr ? a1 : a0;
        const int row = r0 + 2 * w + rr, bg = row >> 9, i = row & 511;
        if (i == 511) acc = 0.f;
        if (j == 0) {
            const float ss = wave_sum(acc * acc);
            acc = acc * rsqrtf(ss * (1.f / 64.f) + 1e-6f) * P.in[I_NKN][(l * 3 + 0) * 64 + lane];
            ((h16*)(P.ws + OFF_KCMP))[(size_t)row * 64 + lane] = (h16)acc;
        } else {
            ((h16*)(P.ws + OFF_VCMP))[(((size_t)bg * 8 + (i >> 6)) * 64 + lane) * 64 + (i & 63)] = (h16)acc;
        }
    }
    __syncthreads();
}

DI void gla_out_item(const Params& P, int l, int item, char* smem) {
    const int h = item & 3, cn = item >> 2;
    const size_t tok0 = (size_t)cn * 32;
    float* qe = (float*)smem;
    float* ke = qe + 32 * 33;
    float* scs = ke + 32 * 33;
    float* vs = scs + 32 * 33;
    float* sp = vs + 32 * 64;
    const h16* proj = (const h16*)(P.ws + OFF_PROJ);
    const int tid = otid(), i = tid >> 3, dq = (tid & 7) * 4, e0 = (tid & 7) * 8;
    const int b = cn >> 8, n = cn & 255, bh = b * 4 + h;
    {
        const float4 bc = *(const float4*)((const float*)(P.ws + OFF_BCUM) + (tok0 + i) * 128 + h * 32 + dq);
        const half4 q4 = *(const half4*)(proj + (tok0 + i) * D_IN + C_GQ + h * 32 + dq);
        const half4 k4 = *(const half4*)(proj + (tok0 + i) * D_IN + C_GK + h * 32 + dq);
        const float bcv[4] = {bc.x, bc.y, bc.z, bc.w};
#pragma unroll
        for (int dd = 0; dd < 4; ++dd) {
            qe[i * 33 + dq + dd] = (float)q4[dd] * 0.17677669529663687f * __expf(bcv[dd]);
            ke[i * 33 + dq + dd] = (float)k4[dd] * __expf(-bcv[dd]);
        }
        const half8 v8 = *(const half8*)(proj + (tok0 + i) * D_IN + C_GV + h * 64 + e0);
#pragma unroll
        for (int e = 0; e < 8; ++e) vs[i * 64 + e0 + e] = (float)v8[e];
        const float* spp = (const float*)(P.ws + OFF_GKV) + (size_t)(bh * 256 + n) * 2048 + tid * 8;
        const float4 s0 = *(const float4*)spp, s1 = *(const float4*)(spp + 4);
        *(float4*)(sp + tid * 8) = s0; *(float4*)(sp + tid * 8 + 4) = s1;
    }
    __syncthreads();
    {
        const int j0 = (tid & 7) * 4;
#pragma unroll
        for (int jj = 0; jj < 4; ++jj) {
            const int j = j0 + jj;
            float s = 0.f;
            if (j <= i) for (int d = 0; d < 32; ++d) s += qe[i * 33 + d] * ke[j * 33 + d];
            scs[i * 33 + j] = s;
        }
    }
    __syncthreads();
    {
        float acc[8];
#pragma unroll
        for (int e = 0; e < 8; ++e) acc[e] = 0.f;
        for (int j = 0; j < 32; ++j) {
            const float s = scs[i * 33 + j], qd = qe[i * 33 + j];
#pragma unroll
            for (int e = 0; e < 8; ++e) acc[e] += s * vs[j * 64 + e0 + e] + qd * sp[j * 64 + e0 + e];
        }
        float ss = 0.f;
#pragma unroll
        for (int e = 0; e < 8; ++e) ss += acc[e] * acc[e];
        ss += __shfl_xor(ss, 1); ss += __shfl_xor(ss, 2); ss += __shfl_xor(ss, 4);
        const float r = rsqrtf(ss * (1.f / 64.f) + 1e-6f);
        const half8 g8 = *(const half8*)(proj + (tok0 + i) * D_IN + C_GG + h * 64 + e0);
        half8 o;
#pragma unroll
        for (int e = 0; e < 8; ++e) o[e] = (h16)(acc[e] * r * P.in[I_GON][l * 64 + e0 + e] * siluf_((float)g8[e]));
        *(half8*)((h16*)(P.ws + OFF_MIX) + kb_idx(NT, tok0 + i, h * 64 + e0)) = o;
    }
    __syncthreads();
}

DI void s5o_gemm_tile(const Params& P, int l, int tile, char* smem) {
    const int g = tile >> 4, mt = (tile >> 2) & 3, nt = tile & 3;
    f32x4 acc[4][4];
    float ssd[4];
    gemm_mainloop_glds<false>(640, AS5{(const h16*)(P.ws + OFF_PROJ) + C_SU + g * 16, (const h16*)(P.ws + OFF_XCH) + g * 128, mt * 128},
                              (const h16*)(P.ws + OFF_S5W) + ((size_t)g * 512 + nt * 128) * 640, 640, acc, ssd, smem);
    const int tid = otid(), lane = tid & 63, wid = tid >> 6, wr = wid >> 1, wc = wid & 1;
    const h16* proj = (const h16*)(P.ws + OFF_PROJ);
    h16* yact = (h16*)(P.ws + OFF_YACT);
#pragma unroll
    for (int i = 0; i < 4; ++i) {
        const size_t ch = (size_t)mt * 128 + wr * 64 + i * 16 + (lane & 15);
#pragma unroll
        for (int jj = 0; jj < 4; ++jj) {
            const int n = nt * 128 + wc * 64 + jj * 16 + (lane >> 4) * 4;
            const int j = n >> 4, c = n & 15;
            const size_t tok = ch * 32 + j;
            const half4 u4 = *(const half4*)(proj + tok * D_IN + C_SU + g * 16 + c);
            const float4 dd = *(const float4*)(P.in[I_SD] + (l * 16 + g) * 16 + c);
            const f32x4 v = acc[i][jj];
            half4 o;
            o[0] = (h16)gelu_tanh(v[0] + dd.x * (float)u4[0]);
            o[1] = (h16)gelu_tanh(v[1] + dd.y * (float)u4[1]);
            o[2] = (h16)gelu_tanh(v[2] + dd.z * (float)u4[2]);
            o[3] = (h16)gelu_tanh(v[3] + dd.w * (float)u4[3]);
            *(half4*)(yact + tok * 256 + g * 16 + c) = o;
        }
    }
}

#define MFMA32(a, b, c) __builtin_amdgcn_mfma_f32_32x32x16_f16((a), (b), (c), 0, 0, 0)
constexpr float NEGS = -1e30f;
DI float ex2(float x) { return __builtin_amdgcn_exp2f(x); }
#define NSA_WAITBAR(N) asm volatile("s_waitcnt vmcnt(" #N ") lgkmcnt(0)\n\ts_barrier" ::: "memory")
#define NSA_BAR() asm volatile("s_waitcnt lgkmcnt(0)\n\ts_barrier" ::: "memory")

struct KVSrc { const h16* k; int ldk; size_t kstep; const h16* v; };
DI void nsa_dma(const KVSrc& s, int j, char* stage, int wid, int lane) {
    const int row0 = wid * 8 + (lane >> 3);
    const int sw = ((lane & 7) ^ ((row0 >> 1) & 7)) * 8;
    const h16* kp = s.k + (size_t)j * s.kstep + (size_t)row0 * s.ldk + sw;
    glds16(kp, stage + wid * 1024);
    glds16(kp + (size_t)32 * s.ldk, stage + 4096 + wid * 1024);
    const h16* vp = s.v + (size_t)j * 4096 + row0 * 64 + sw;
    glds16(vp, stage + 8192 + wid * 1024);
    glds16(vp + 32 * 64, stage + 8192 + 4096 + wid * 1024);
}
template <int NST, class F>
DI void nsa_pipe(const KVSrc& s, const int n, char* smem, int wid, int lane, F&& compute) {
    NSA_WAITBAR(0);
    {
        const int k = n < NST - 1 ? n : NST - 1;
        for (int p = 0; p < k; ++p) nsa_dma(s, p, smem + p * 16384, wid, lane);
        if (k >= 3) NSA_WAITBAR(8); else if (k == 2) NSA_WAITBAR(4); else NSA_WAITBAR(0);
    }
    for (int j = 0; j < n; ++j) {
        if (NST == 4 && j + 2 < n) NSA_WAITBAR(4); else NSA_WAITBAR(0);
        const int jn = j + NST - 1;
        compute(j, smem + (j % NST) * 16384, [&]() { if (jn < n) nsa_dma(s, jn, smem + (jn % NST) * 16384, wid, lane); });
    }
}

DI void qk_tile(const char* Kimg, const half8 (&qf)[4], f32x16 (&s)[2], int lane) {
    const int r = lane & 31, h = lane >> 5, swz = (r >> 1) & 7;
    const char* base = Kimg + r * 128;
    half8 kf[8];
#pragma unroll
    for (int kt = 0; kt < 2; ++kt)
#pragma unroll
        for (int ks = 0; ks < 4; ++ks) kf[kt * 4 + ks] = *(const half8*)(base + kt * 4096 + (((2 * ks + h) ^ swz) << 4));
    __builtin_amdgcn_sched_barrier(0);
#pragma unroll
    for (int kt = 0; kt < 2; ++kt) {
#pragma unroll
        for (int e = 0; e < 16; ++e) s[kt][e] = 0.f;
#pragma unroll
        for (int ks = 0; ks < 4; ++ks) s[kt] = MFMA32(kf[kt * 4 + ks], qf[ks], s[kt]);
    }
}
template <int S> DI half8 pack8(const f32x16& x) {
    return (half8){(h16)x[8 * S], (h16)x[8 * S + 1], (h16)x[8 * S + 2], (h16)x[8 * S + 3], (h16)x[8 * S + 4], (h16)x[8 * S + 5], (h16)x[8 * S + 6], (h16)x[8 * S + 7]};
}
DI half8 ld_vfrag(const char* Vimg, int off0) {
    const half4 lo = *(const half4*)(Vimg + off0), hi = *(const half4*)(Vimg + (off0 ^ 16));
    return (half8){lo[0], lo[1], lo[2], lo[3], hi[0], hi[1], hi[2], hi[3]};
}
template <int KT>
DI void pv_load(const char* Vimg, half8 (&vf)[4], int lane) {
    const int r = lane & 31, h = lane >> 5, swz16 = ((r >> 1) & 7) << 4;
    const char* rb = Vimg + r * 128 + 8 * h;
#pragma unroll
    for (int dt = 0; dt < 2; ++dt) {
        vf[dt * 2 + 0] = ld_vfrag(rb + dt * 4096, ((4 * KT) << 4) ^ swz16);
        vf[dt * 2 + 1] = ld_vfrag(rb + dt * 4096, ((4 * KT + 2) << 4) ^ swz16);
    }
}
template <int KT>
DI void pv_mma(const half8 (&vf)[4], const f32x16 (&p)[2], f32x16 (&o)[2]) {
    const half8 pb0 = pack8<0>(p[KT]), pb1 = pack8<1>(p[KT]);
#pragma unroll
    for (int dt = 0; dt < 2; ++dt) {
        o[dt] = MFMA32(vf[dt * 2 + 0], pb0, o[dt]);
        o[dt] = MFMA32(vf[dt * 2 + 1], pb1, o[dt]);
    }
}
DI void pv_finish(const char* Vimg, const half8 (&va)[4], const f32x16 (&p)[2], f32x16 (&o)[2], int lane) {
    half8 vb[4];
    pv_load<1>(Vimg, vb, lane);
    pv_mma<0>(va, p, o);
    pv_mma<1>(vb, p, o);
}
DI float xhalf_max(float v) {
    const auto r = __builtin_amdgcn_permlane32_swap(__float_as_uint(v), __float_as_uint(v), false, false);
    return fmaxf(__uint_as_float(r[0]), __uint_as_float(r[1]));
}
DI float xhalf_sum(float v) {
    const auto r = __builtin_amdgcn_permlane32_swap(__float_as_uint(v), __float_as_uint(v), false, false);
    return __uint_as_float(r[0]) + __uint_as_float(r[1]);
}
DI float rowmax32(const f32x16 (&s)[2]) {
    float mx = s[0][0];
#pragma unroll
    for (int e = 1; e < 16; ++e) mx = fmaxf(mx, s[0][e]);
#pragma unroll
    for (int e = 0; e < 16; ++e) mx = fmaxf(mx, s[1][e]);
    return xhalf_max(mx);
}
constexpr float SM_THR = 6.f;
DI void sm_online(f32x16 (&s)[2], float& m, float& l, f32x16 (&o)[2], const bool rowok) {
    float mx = rowmax32(s);
    mx = rowok ? mx : NEGS;
    if (__any(mx > m + SM_THR)) {
        const float mn = fmaxf(m, mx), alpha = ex2(m - mn);
        l *= alpha; o[0] *= alpha; o[1] *= alpha; m = mn;
    }
    const float msub = rowok ? m : 1e30f;
    float rs = 0.f;
#pragma unroll
    for (int kt = 0; kt < 2; ++kt)
#pragma unroll
        for (int e = 0; e < 16; ++e) { const float p = ex2(s[kt][e] - msub); s[kt][e] = p; rs += p; }
    l += xhalf_sum(rs);
}

DI void nsa_unit(const Params& P, int l, int bg, int c32, char* smem) {
    const int tid = otid(), lane = tid & 63, w = tid >> 6, r = lane & 31, h = lane >> 5;
    const int b = bg >> 1, g = bg & 1, t0 = c32 * 32, cur = c32 >> 1;
    const int tokl = w * 8 + (r >> 2), head = r & 3, t = t0 + tokl;
    const size_t tokg = (size_t)b * SEQ + t;
    float* IMP = (float*)(smem + 49152);
    unsigned* SELM = (unsigned*)(smem + 49152);
    const h16* proj = (const h16*)(P.ws + OFF_PROJ);
    const int ghead = g * 4 + head;

    half8 qf[4];
    {
        const h16* qp = proj + tokg * D_IN + C_NQ + ghead * 64 + 8 * h;
#pragma unroll
        for (int ks = 0; ks < 4; ++ks) qf[ks] = *(const half8*)(qp + 16 * ks);
    }
    float g0, g1, g2;
    {
        const h16* gp = proj + tokg * D_IN + C_NGL + ghead * 3;
        const float* gb = P.in[I_NGB] + l * 24 + ghead * 3;
        g0 = sigmoidf_((float)gp[0] + gb[0]); g1 = sigmoidf_((float)gp[1] + gb[1]); g2 = sigmoidf_((float)gp[2] + gb[2]);
    }
    __syncthreads();
    for (int i = tid; i < 32 * 128; i += 256) IMP[i] = 0.f;

    f32x16 oacc[2];
#pragma unroll
    for (int e = 0; e < 16; ++e) { oacc[0][e] = 0.f; oacc[1][e] = 0.f; }

    {
        const int nvt = 2 * c32 + 1;
        const int nvr = (t >= 31) ? ((t - 31) >> 4) + 1 : 0;
        const int ntile = (nvt + 63) >> 6;
        KVSrc src{(const h16*)(P.ws + OFF_KCMP) + (size_t)bg * 512 * 64, 64, 4096, (const h16*)(P.ws + OFF_VCMP) + (size_t)bg * 8 * 4096};
        float m = -1e20f, lsum = 0.f;
        nsa_pipe<3>(src, ntile, smem, w, lane, [&](int j, const char* st, auto&& issue) {
            f32x16 s[2];
            qk_tile(st, qf, s, lane);
            issue();
#pragma unroll
            for (int kt = 0; kt < 2; ++kt)
#pragma unroll
                for (int e = 0; e < 16; ++e) {
                    const int key = 64 * j + 32 * kt + 8 * (e >> 2) + 4 * h + (e & 3);
                    if (key >= nvr) s[kt][e] = NEGS;
                }
            const float mn = fmaxf(m, rowmax32(s)), alpha = ex2(m - mn);
            float rs = 0.f;
#pragma unroll
            for (int kt = 0; kt < 2; ++kt)
#pragma unroll
                for (int e = 0; e < 16; ++e) rs += ex2(s[kt][e] - mn);
            rs = xhalf_sum(rs);
            lsum = lsum * alpha + rs; m = mn;
        });
        const float invl = lsum > 0.f ? 1.f / lsum : 0.f;
        f32x16 o[2];
#pragma unroll
        for (int e = 0; e < 16; ++e) { o[0][e] = 0.f; o[1][e] = 0.f; }
        nsa_pipe<3>(src, ntile, smem, w, lane, [&](int j, const char* st, auto&& issue) {
            f32x16 s[2];
            qk_tile(st, qf, s, lane);
            half8 vf[4];
            pv_load<0>(st + 8192, vf, lane);
            issue();
            __builtin_amdgcn_sched_barrier(0);
#pragma unroll
            for (int kt = 0; kt < 2; ++kt)
#pragma unroll
                for (int e = 0; e < 16; ++e) {
                    const int key = 64 * j + 32 * kt + 8 * (e >> 2) + 4 * h + (e & 3);
                    s[kt][e] = (key < nvr) ? ex2(s[kt][e] - m) * invl : 0.f;
                }
            if (cur >= 16) {
#pragma unroll
                for (int kt = 0; kt < 2; ++kt)
#pragma unroll
                    for (int g4 = 0; g4 < 4; ++g4) {
                        float G = (s[kt][4 * g4] + s[kt][4 * g4 + 1]) + (s[kt][4 * g4 + 2] + s[kt][4 * g4 + 3]);
                        float L = s[kt][4 * g4 + 3];
                        G += __shfl_xor(G, 1); G += __shfl_xor(G, 2);
                        L += __shfl_xor(L, 1); L += __shfl_xor(L, 2);
                        if (head == 0) {
                            const int sb = 16 * j + 8 * kt + 2 * g4 + h;
                            atomicAdd(&IMP[tokl * 128 + sb], G);
                            if (sb + 1 < 128) atomicAdd(&IMP[tokl * 128 + sb + 1], L);
                        }
                    }
            }
            pv_finish(st + 8192, vf, s, o, lane);
        });
        oacc[0] = o[0] * g0; oacc[1] = o[1] * g0;
    }
    __syncthreads();
    {
        const int tl = lane >> 3, sub = lane & 7;
        unsigned bits = 0;
        unsigned u[16];
        if (cur >= 16) {
            const float* ip = IMP + (w * 8 + tl) * 128 + sub * 16;
#pragma unroll
            for (int i = 0; i < 16; ++i) {
                const int s = sub * 16 + i;
                u[i] = (s >= 1 && s <= cur - 2) ? (__float_as_uint(ip[i]) + 1u) : 0u;
            }
        }
        __syncthreads();
        if (cur >= 16) {
            unsigned prefix = 0;
            for (int bit = 30; bit >= 0; --bit) {
                const unsigned cand = prefix | (1u << bit);
                int cnt = 0;
#pragma unroll
                for (int i = 0; i < 16; ++i) cnt += (u[i] >= cand) ? 1 : 0;
                cnt += __shfl_xor(cnt, 1); cnt += __shfl_xor(cnt, 2); cnt += __shfl_xor(cnt, 4);
                if (cnt >= 13) prefix = cand;
            }
            int cgt = 0, ceq = 0;
#pragma unroll
            for (int i = 0; i < 16; ++i) { cgt += (u[i] > prefix) ? 1 : 0; ceq += (u[i] == prefix) ? 1 : 0; }
            cgt += __shfl_xor(cgt, 1); cgt += __shfl_xor(cgt, 2); cgt += __shfl_xor(cgt, 4);
            int inc = ceq;
            { const int v = __shfl_up(inc, 1); if (sub >= 1) inc += v; }
            { const int v = __shfl_up(inc, 2); if (sub >= 2) inc += v; }
            { const int v = __shfl_up(inc, 4); if (sub >= 4) inc += v; }
            int run = inc - ceq;
            const int need = 13 - cgt;
#pragma unroll
            for (int i = 0; i < 16; ++i) {
                const int s = sub * 16 + i;
                bool sel = u[i] > prefix;
                if (u[i] == prefix) { sel = run < need; ++run; }
                if (s == 0 || s == cur || s == cur - 1) sel = true;
                bits |= (sel ? 1u : 0u) << i;
            }
        } else {
#pragma unroll
            for (int i = 0; i < 16; ++i) bits |= ((sub * 16 + i <= cur) ? 1u : 0u) << i;
        }
        unsigned wv = bits << ((sub & 1) * 16);
        wv |= __shfl_xor(wv, 1);
        if ((sub & 1) == 0) SELM[(w * 8 + tl) * 4 + (sub >> 1)] = wv;
    }
    __syncthreads();
    unsigned selw[4];
#pragma unroll
    for (int i = 0; i < 4; ++i) selw[i] = SELM[tokl * 4 + i];

#pragma unroll 1
    for (int br = 0; br < 2; ++br) {
        const int j0 = (br == 0) ? 0 : (cur - 8 > 0 ? cur - 8 : 0);
        const int nst = cur - j0 + 1;
        KVSrc src{proj + ((size_t)b * SEQ + (size_t)j0 * 64) * D_IN + C_NKV + (br == 0 ? 256 : 512) + g * 64, D_IN, (size_t)64 * D_IN,
                  (const h16*)(P.ws + OFF_VTG) + (((size_t)br * 4 + bg) * 128 + j0) * 4096};
        float m = -1e20f, lsum = 0.f;
        f32x16 o[2];
#pragma unroll
        for (int e = 0; e < 16; ++e) { o[0][e] = 0.f; o[1][e] = 0.f; }
        nsa_pipe<4>(src, nst, smem, w, lane, [&](int jj, const char* st, auto&& issue) {
            const int j = j0 + jj;
            f32x16 s[2];
            qk_tile(st, qf, s, lane);
            half8 vf[4];
            pv_load<0>(st + 8192, vf, lane);
            issue();
            __builtin_amdgcn_sched_barrier(0);
            const bool rowok = (br != 0) || (((selw[j >> 5] >> (j & 31)) & 1u) != 0u);
            if (j == cur || (br == 1 && j == cur - 8)) {
#pragma unroll
                for (int kt = 0; kt < 2; ++kt)
#pragma unroll
                    for (int e = 0; e < 16; ++e) {
                        const int key = 64 * j + 32 * kt + 8 * (e >> 2) + 4 * h + (e & 3);
                        const bool ok = (key <= t) && (br == 0 || key > t - 512);
                        if (!ok) s[kt][e] = NEGS;
                    }
            }
            sm_online(s, m, lsum, o, rowok);
            pv_finish(st + 8192, vf, s, o, lane);
        });
        const float sc = (br == 0 ? g1 : g2) / lsum;
        oacc[0] += o[0] * sc; oacc[1] += o[1] * sc;
    }
    {
        h16* mixp = (h16*)(P.ws + OFF_MIX) + kb_idx(NT, tokg, 512 + ghead * 64);
        const h16* ngp = proj + tokg * D_IN + C_NG + ghead * 64;
#pragma unroll
        for (int dt = 0; dt < 2; ++dt)
#pragma unroll
            for (int g4 = 0; g4 < 4; ++g4) {
                const int d0 = 32 * dt + 8 * g4 + 4 * h;
                const half4 ng = *(const half4*)(ngp + d0);
                half4 ov;
#pragma unroll
                for (int e = 0; e < 4; ++e) ov[e] = (h16)(oacc[dt][4 * g4 + e] * siluf_((float)ng[e]));
                *(half4*)(mixp + d0) = ov;
            }
    }
    __syncthreads();
}

DI void glu_tile(const Params& P, int l, int tile, char* smem) {
    const int mt = tile >> 2, nt = tile & 3;
    f32x4 acc[4][4];
    float ssd[4];
    gemm_mainloop_glds<false>(256, APlain{(const h16*)(P.ws + OFF_YACT) + (size_t)mt * 128 * 256, 256, 64},
                              (const h16*)(P.ws + OFF_WTGLU) + ((size_t)l * 512 + nt * 128) * 256, 256, acc, ssd, smem);
    const int tid = otid(), lane = tid & 63, wid = tid >> 6, wr = wid >> 1, wc = wid & 1;
    const h16* proj = (const h16*)(P.ws + OFF_PROJ);
    h16* mix = (h16*)(P.ws + OFF_MIX);
    const float* gb = P.in[I_GLUB] + l * 512;
#pragma unroll
    for (int i = 0; i < 4; ++i) {
        const size_t tok = (size_t)mt * 128 + wr * 64 + i * 16 + (lane & 15);
#pragma unroll
        for (int pj = 0; pj < 2; ++pj) {
            const int c = nt * 64 + wc * 32 + pj * 16 + (lane >> 4) * 4;
            const f32x4 z1 = acc[i][2 * pj], z2 = acc[i][2 * pj + 1];
            const float4 b1 = *(const float4*)(gb + c), b2 = *(const float4*)(gb + 256 + c);
            const half4 g4 = *(const half4*)(proj + tok * D_IN + C_SG + c);
            half4 o;
            o[0] = (h16)((z1[0] + b1.x) * sigmoidf_(z2[0] + b2.x) * siluf_((float)g4[0]));
            o[1] = (h16)((z1[1] + b1.y) * sigmoidf_(z2[1] + b2.y) * siluf_((float)g4[1]));
            o[2] = (h16)((z1[2] + b1.z) * sigmoidf_(z2[2] + b2.z) * siluf_((float)g4[2]));
            o[3] = (h16)((z1[3] + b1.w) * sigmoidf_(z2[3] + b2.w) * siluf_((float)g4[3]));
            *(half4*)(mix + kb_idx(NT, tok, 256 + c)) = o;
        }
    }
}

DI void outproj_tile(const Params& P, int l, int mt, int nt, char* smem) {
    f32x4 acc[8][4];
    float ssd[8];
    gemm_glds<false, 2, 8, 4>(1024, APlain{(const h16*)(P.ws + OFF_MIX) + (size_t)mt * 256 * 64, 64, (size_t)NT * 64},
                              (const h16*)(P.ws + OFF_WTOUT) + ((size_t)l * 16 * 1024 + nt * 128) * 64, 64, acc, ssd, smem, (size_t)1024 * 64);
    const int tid = otid(), lane = tid & 63, wid = tid >> 6, wr = wid >> 1, wc = wid & 1;
    const float* xin = (l == 0) ? P.in[I_X] : P.out;
    h16* xh = (h16*)(P.ws + OFF_XH);
#pragma unroll
    for (int i = 0; i < 8; ++i) {
        const size_t row = (size_t)mt * 256 + wr * 128 + i * 16 + (lane & 15);
#pragma unroll
        for (int jj = 0; jj < 4; ++jj) {
            const int n = nt * 128 + wc * 64 + jj * 16 + (lane >> 4) * 4;
            const f32x4 v = acc[i][jj];
            const float4 xo = *(const float4*)(xin + row * 1024 + n);
            const float4 xn = (float4){xo.x + v[0], xo.y + v[1], xo.z + v[2], xo.w + v[3]};
            *(float4*)(P.out + row * 1024 + n) = xn;
            *(half4*)(xh + kb_idx(NT, row, n)) = (half4){(h16)xn.x, (h16)xn.y, (h16)xn.z, (h16)xn.w};
        }
    }
}

#define XB_TMO      128
#define XB_XCNT(j)  (256  + 64 * (j))
#define XB_XSUB(j)  (1280 + 64 * (j))
#define XB_XGEN(j)  (2304 + 64 * (j))
#define XB_TOP      3328
#define XB_TOPGEN   3392
#define XCD_BAR_WORDS 3456
#define XB_SPIN_CAP (1u << 18)
#define LAS __attribute__((address_space(3)))

__device__ __forceinline__ unsigned xb_ld(unsigned* p)              { return __hip_atomic_load(p, __ATOMIC_RELAXED, __HIP_MEMORY_SCOPE_AGENT); }
__device__ __forceinline__ unsigned xb_add(unsigned* p, unsigned v) { return __hip_atomic_fetch_add(p, v, __ATOMIC_RELAXED, __HIP_MEMORY_SCOPE_AGENT); }
__device__ __forceinline__ unsigned xb_xcc_id() { return (unsigned)__builtin_amdgcn_s_getreg((3 << 11) | 20) & 0xFu; }
#define XB_SPIN(cond, bar) do { unsigned _sp = 0; while (cond) { __builtin_amdgcn_s_sleep(1); \
    if ((++_sp & 255u) == 0u) { if (xb_ld(&(bar)[XB_TMO])) break; if (_sp > XB_SPIN_CAP) { atomicAdd(&(bar)[XB_TMO], 1u); break; } } } } while (0)

struct XcdBarrier {
    unsigned* bar; unsigned x;
    volatile LAS unsigned* st;
};

__device__ __forceinline__ XcdBarrier xcd_barrier_post(unsigned* bar, volatile LAS unsigned* st) {
    XcdBarrier b; b.bar = bar; b.x = xb_xcc_id(); b.st = st;
    if (threadIdx.x == 0) (void)xb_add(&bar[XB_XCNT(b.x)], 1u);
    return b;
}
__device__ __forceinline__ void xcd_barrier_complete(unsigned* bar, unsigned x, unsigned& nloc, unsigned& nx) {
    const unsigned G = gridDim.x * gridDim.y * gridDim.z;
    unsigned sum, cnt, mine, sp = 0u;
    for (;;) {
        sum = 0u; cnt = 0u; mine = 0u;
#pragma unroll
        for (unsigned j = 0; j < 16; ++j) { const unsigned c = xb_ld(&bar[XB_XCNT(j)]); sum += c; cnt += (c > 0u) ? 1u : 0u; mine = (j == x) ? c : mine; }
        if (sum == G) break;
        __builtin_amdgcn_s_sleep(1);
        if ((++sp & 255u) == 0u) { if (xb_ld(&bar[XB_TMO])) break; if (sp > XB_SPIN_CAP) { atomicAdd(&bar[XB_TMO], 1u); break; } }
    }
    nloc = mine > 0u ? mine : 1u; nx = cnt > 0u ? cnt : 1u;
}

__device__ __forceinline__ void xcd_barrier(const XcdBarrier& b) {
    asm volatile("s_waitcnt vmcnt(0)" ::: "memory");
    __syncthreads();
    if (threadIdx.x == 0) {
        unsigned* bar = b.bar;
        __builtin_amdgcn_s_waitcnt(0);
        unsigned nloc = b.st[0], nx = b.st[1];
        if (nloc == 0u) { xcd_barrier_complete(bar, b.x, nloc, nx); b.st[0] = nloc; b.st[1] = nx; }
        const unsigned old = xb_add(&bar[XB_XSUB(b.x)], 1u);
        const unsigned gen = old / nloc;
        if (old + 1u == (gen + 1u) * nloc) {
            __builtin_amdgcn_fence(__ATOMIC_RELEASE, "agent");
            asm volatile("s_waitcnt vmcnt(0)" ::: "memory");
            const unsigned og = xb_add(&bar[XB_TOP], 1u);
            const unsigned tg = og / nx;
            if (og + 1u == (tg + 1u) * nx) xb_add(&bar[XB_TOPGEN], 1u);
            else XB_SPIN(xb_ld(&bar[XB_TOPGEN]) == tg, bar);
            __builtin_amdgcn_fence(__ATOMIC_ACQUIRE, "agent");
            xb_add(&bar[XB_XGEN(b.x)], 1u);
            asm volatile("s_waitcnt vmcnt(0)" ::: "memory");
        } else {
            XB_SPIN(xb_ld(&bar[XB_XGEN(b.x)]) == gen, bar);
            __builtin_amdgcn_fence(__ATOMIC_ACQUIRE, "agent");
            asm volatile("s_waitcnt vmcnt(0)" ::: "memory");
        }
    }
    __syncthreads();
}


__global__ void __launch_bounds__(NTHREADS, 2) fwd_megakernel(Params P) {
    extern __shared__ __attribute__((aligned(16))) char smem[];
    cg::grid_group grid = cg::this_grid();
    const int G = gridDim.x, bid = blockIdx.x;

    uint4& xb_words = *(uint4*)(smem + SMEM_MAIN);
    if (otid() == 0) xb_words = make_uint4(0u, 0u, 0u, 0u);
    if (bid == 0) for (int i = otid(); i < XCD_BAR_WORDS + 16; i += NTHREADS) ((unsigned*)(P.ws + OFF_BAR))[i] = 0u;
    phase0(P, smem);
    grid.sync();
    const XcdBarrier xb = xcd_barrier_post((unsigned*)(P.ws + OFF_BAR), (volatile LAS unsigned*)(smem + SMEM_MAIN));
    int vxcd = bid & 7, vjx = bid >> 3;
    {
        unsigned* xcnt = (unsigned*)(P.ws + OFF_BAR) + XCD_BAR_WORDS;
        volatile LAS unsigned* lw = (volatile LAS unsigned*)(smem + SMEM_MAIN) + 2;
        if (otid() == 0) lw[0] = xb.x < 8u ? xb_add(&xcnt[xb.x], 1u) : 0xffffu;
        xcd_barrier(xb);
        if (otid() == 0) {
            bool ok = (G & 7) == 0 && xb.x < 8u;
            for (int j = 0; j < 8; ++j) ok = ok && (xb_ld(&xcnt[j]) == (unsigned)(G >> 3));
            lw[1] = ok ? 1u : 0u;
        }
        __syncthreads();
        if (lw[1]) { vxcd = (int)xb.x; vjx = (int)lw[0]; }
    }

#pragma unroll 1
    for (int l = 0; l < DEPTH; ++l) {
        {
            const int xcd = vxcd, jx = vjx, nper = G >> 3;
            for (int u = jx; u < 192; u += nper) inproj_tile<2>(P, l, xcd * 8 + (u & 7), (u >> 3) * 128, smem);
            for (int it = jx; it < 8 + 40; it += nper) {
                if (it < 8) inproj_tile<4>(P, l, xcd * 8 + it, 3072, smem);
                else s5_build_item(P, l, (it - 8) * 8 + xcd, smem);
            }
        }
        xcd_barrier(xb);
#pragma unroll 1
        for (int w = bid; w < 128 + 64 + 2048; w += G) {
            if (w < 128) cmp_gemm_tile(P, l, w, smem);
            else if (w < 192) s5e_gemm_tile(P, l, w - 128, smem);
            else gla_kv_item(P, l, w - 192, smem);
        }
        xcd_barrier(xb);
#pragma unroll 1
        for (int w = bid; w < 512 + 512 + 64; w += G) {
            if (w < 512) cmp_l2_item(P, l, w, smem);
            else if (w < 1024) gla_scan_item(P, w - 512, smem);
            else s5_scan_item(P, w - 1024, smem);
        }
        xcd_barrier(xb);
#pragma unroll 1
        for (int w0 = bid; w0 < 512 + 256 + 2048; w0 += G) {
            const int w = w0 < G ? vjx * 8 + vxcd : w0;
            if (w < 512) {
                const int bg = w & 3, q = w >> 2;
                nsa_unit(P, l, bg, 255 - q, smem);
                nsa_unit(P, l, bg, q, smem);
            } else if (w < 512 + 256) s5o_gemm_tile(P, l, w - 512, smem);
            else gla_out_item(P, l, w - 512 - 256, smem);
        }
        xcd_barrier(xb);
#pragma unroll 1
        for (int w = bid; w < 512; w += G) glu_tile(P, l, w, smem);
        xcd_barrier(xb);
        {
            const int xcd = vxcd, jx = vjx, nper = G >> 3;
            for (int u = jx; u < 64; u += nper) outproj_tile(P, l, xcd * 8 + (u & 7), u >> 3, smem);
        }
        xcd_barrier(xb);
    }
}

extern "C" void kernel_launch(void* const* d_in, const int* in_sizes, int n_in, void* d_out, int out_size, void* d_ws,
                              size_t ws_size, hipStream_t stream) {
    static int grid_blocks = 0;
    if (!grid_blocks) {
        int dev = 0, cus = 0, per_cu = 0;
        hipGetDevice(&dev);
        hipDeviceGetAttribute(&cus, hipDeviceAttributeMultiprocessorCount, dev);
        hipFuncSetAttribute((const void*)fwd_megakernel, hipFuncAttributeMaxDynamicSharedMemorySize, SMEM_BYTES);
        hipOccupancyMaxActiveBlocksPerMultiprocessor(&per_cu, fwd_megakernel, NTHREADS, SMEM_BYTES);
        if (per_cu < 1) per_cu = 1;
        if (per_cu > 2) per_cu = 2;
        grid_blocks = cus * per_cu;
        if (ws_size < WS_END) fprintf(stderr, "kernel_launch: workspace too small: %zu < %zu\n", ws_size, (size_t)WS_END);
    }
    Params p{};
    for (int i = 0; i < 25; ++i) p.in[i] = (const float*)d_in[i];
    p.out = (float*)d_out;
    p.ws = (char*)d_ws;
    void* args[] = {&p};
    hipError_t e = hipLaunchCooperativeKernel((const void*)fwd_megakernel, dim3(grid_blocks), dim3(NTHREADS), args, SMEM_BYTES, stream);
    if (e != hipSuccess) fprintf(stderr, "cooperative launch failed: %s (grid %d)\n", hipGetErrorString(e), grid_blocks);
}
```

```cpp
#include <hip/hip_runtime.h>
#include <hip/hip_cooperative_groups.h>
#include <cstdio>
#include <cstdint>
namespace cg = cooperative_groups;

typedef _Float16 h16;
typedef _Float16 half8 __attribute__((ext_vector_type(8)));
typedef _Float16 half4 __attribute__((ext_vector_type(4)));
typedef float f32x4 __attribute__((ext_vector_type(4)));
typedef float f32x16 __attribute__((ext_vector_type(16)));

#define DI __device__ __forceinline__

constexpr int D_MODEL = 1024, BATCH = 2, SEQ = 8192, DEPTH = 4, NT = BATCH * SEQ;
constexpr int D_IN = 3112, D_IN_PAD = 3200;
constexpr int C_NQ = 0, C_NKV = 512, C_NG = 1280, C_GQ = 1792, C_GK = 1920, C_GV = 2048, C_GG = 2304, C_SU = 2560, C_SG = 2816,
              C_GLR = 3072, C_NGL = 3088;
__host__ __device__ constexpr int map_col(int c) {
    return c < 128 ? C_GQ + c : c < 256 ? C_GK + (c - 128) : c < 512 ? C_GV + (c - 256) : c < 528 ? C_GLR + (c - 512)
         : c < 784 ? C_GG + (c - 528) : c < 1040 ? C_SU + (c - 784) : c < 1296 ? C_SG + (c - 1040) : c < 1808 ? C_NQ + (c - 1296)
         : c < 2576 ? C_NKV + (c - 1808) : c < 2600 ? C_NGL + (c - 2576) : c < 3112 ? C_NG + (c - 2600) : c;
}
constexpr int NTHREADS = 256;
constexpr float QSCALE = 0.125f * 1.4426950408889634f;

enum { I_X = 0, I_NORMG, I_WIN, I_GW2, I_GB2, I_GON, I_LRE, I_LIM, I_LSTEP, I_BRE, I_BIM, I_CRE, I_CIM, I_SD, I_GLUW, I_GLUB,
       I_NGB, I_NQN, I_NKN, I_CPOS, I_CW1, I_CB1, I_CW2, I_CB2, I_WOUT };

constexpr size_t OFF_WTIN  = 0;
constexpr size_t OFF_WTOUT = OFF_WTIN  + 4ull * D_IN_PAD * 1024 * 2;
constexpr size_t OFF_WTGLU = OFF_WTOUT + 4ull * 1024 * 1024 * 2;
constexpr size_t OFF_WTC1  = OFF_WTGLU + 4ull * 512 * 256 * 2;
constexpr size_t OFF_PROJ  = OFF_WTC1  + 4ull * 2 * 256 * 2048 * 2;
constexpr size_t OFF_MIX   = OFF_PROJ  + (size_t)NT * D_IN * 2;
constexpr size_t OFF_YACT  = OFF_MIX   + (size_t)NT * 1024 * 2;
constexpr size_t OFF_XH    = OFF_YACT;
constexpr size_t OFF_BCUM  = OFF_YACT  + (size_t)NT * 256 * 2;
constexpr size_t OFF_GKV   = OFF_BCUM  + (size_t)NT * 128 * 4;
constexpr size_t OFF_GDEC  = OFF_GKV   + 8ull * 256 * 2048 * 4;
static_assert(OFF_GDEC - OFF_XH >= (size_t)NT * 1024 * 2, "XH alias region too small");
constexpr size_t OFF_XC    = OFF_GDEC  + 8ull * 256 * 32 * 4;
constexpr size_t OFF_S5W   = OFF_XC    + 512ull * 1024 * 2 * 4;
constexpr size_t OFF_S5E   = OFF_S5W   + 16ull * 512 * 640 * 2;
constexpr size_t OFF_S5AL  = OFF_S5E   + 16ull * 128 * 512 * 2;
constexpr size_t OFF_CHID  = OFF_S5AL  + 1024ull * 2 * 4;
constexpr size_t OFF_POSB  = OFF_CHID  + 2ull * 2048 * 512 * 4;
constexpr size_t OFF_XCH   = OFF_POSB  + 8ull * 16 * 256 * 4;
constexpr size_t OFF_KCMP  = OFF_XCH   + 512ull * 2048 * 2;
constexpr size_t OFF_VCMP  = OFF_KCMP  + 4ull * 512 * 64 * 2;
constexpr size_t OFF_VTG   = OFF_VCMP  + 4ull * 512 * 64 * 2;
constexpr size_t OFF_BAR   = OFF_VTG   + 2ull * 4 * 128 * 4096 * 2;
constexpr size_t WS_END    = OFF_BAR   + 16384;

struct Params {
    const float* in[25];
    float* out;
    char* ws;
};

__host__ __device__ constexpr size_t kb_idx(size_t nrows, size_t row, int k) { return (((size_t)(k >> 6)) * nrows + row) * 64 + (k & 63); }
typedef const __attribute__((address_space(4))) Params* PP;
DI PP plaunder(PP p) { asm volatile("" : "+s"(p)); return p; }
constexpr int SMEM_MAIN = 65536;
constexpr int SMEM_BYTES = SMEM_MAIN + 16;

DI int otid(const int wv) { int t = wv * 64 + (int)__builtin_amdgcn_mbcnt_hi(~0u, __builtin_amdgcn_mbcnt_lo(~0u, 0u)); asm volatile("" : "+v"(t)); return t; }
DI float wave_sum(float v) {
#pragma unroll
    for (int o = 32; o > 0; o >>= 1) v += __shfl_xor(v, o);
    return v;
}
DI float wave_max(float v) {
#pragma unroll
    for (int o = 32; o > 0; o >>= 1) v = fmaxf(v, __shfl_xor(v, o));
    return v;
}
DI float sigmoidf_(float x) { return 1.f / (1.f + __expf(-x)); }
DI float siluf_(float x) { return x / (1.f + __expf(-x)); }
DI float gelu_tanh(float x) {
    const float u = 0.7978845608028654f * (x + 0.044715f * x * x * x);
    return 0.5f * x * (1.f + tanhf(u));
}
DI float log_sigmoidf_(float x) { return fminf(x, 0.f) - log1pf(__expf(-fabsf(x))); }

typedef _Float16 half2_ __attribute__((ext_vector_type(2)));
DI void glds16(const h16* g, char* l) {
    __builtin_amdgcn_global_load_lds((const __attribute__((address_space(1))) void*)g, (__attribute__((address_space(3))) void*)l, 16, 0, 0);
}
struct APlain { const h16* A; size_t lda, astep; DI const h16* operator()(int row, int kt, int c8) const { return A + (size_t)row * lda + (size_t)kt * astep + c8 * 8; } };
struct AS5 {
    const h16* ubase;
    const h16* xin;
    int ch0;
    DI const h16* operator()(int row, int kt, int c8) const {
        const size_t ch = (size_t)(ch0 + row);
        return kt < 8 ? ubase + (ch * 32 + 4 * kt + (c8 >> 1)) * D_IN + (c8 & 1) * 8 : xin + ch * 2048 + (kt - 8) * 64 + c8 * 8;
    }
};
template <int N> DI void gwaitbar();
#define GWB_DEF(N) template <> DI void gwaitbar<N>() { asm volatile("s_waitcnt vmcnt(" #N ") lgkmcnt(0)\n\ts_barrier" ::: "memory"); }
GWB_DEF(0) GWB_DEF(3) GWB_DEF(4) GWB_DEF(6) GWB_DEF(8)
template <bool SUMSQ, int WR, int MI, int NJ, class AF>
DI void gemm_glds(const int wv, const int K, const AF& afn, const h16* __restrict__ Bt, const int ldb,
                  f32x4 (&acc)[MI][NJ], float (&ss)[MI], char* smem, const size_t bstep = 64) {
    constexpr int WC = 4 / WR, BM = WR * MI * 16, BN = WC * NJ * 16, AQ = BM / 64, BQ = BN / 64, NG = AQ + BQ, SB = (BM + BN) * 64;
    static_assert(4 * SB <= SMEM_MAIN && AQ >= 1 && BQ >= 1, "ring does not fit the LDS");
    const int tid = otid(wv), lane = tid & 63, wid = tid >> 6, wr = wid / WC, wc = wid % WC;
#pragma unroll
    for (int i = 0; i < MI; ++i) {
        ss[i] = 0.f;
#pragma unroll
        for (int j = 0; j < NJ; ++j) acc[i][j] = (f32x4){0.f, 0.f, 0.f, 0.f};
    }
    const int lrow = wid * 16 + (lane >> 2);
    const int lc4 = (lane & 3) ^ ((-(lrow >> 2)) & 3);
    const h16* bp = Bt + (size_t)lrow * ldb + lc4 * 8;
    char* lbase = smem + wid * 1024;
    const int fr = lane & 15, fq = lane >> 4, sw = (-(fr >> 2)) & 3;
    const int aoff0 = (wr * MI * 16 + fr) * 64 + ((fq ^ sw) * 16);
    const int boff0 = BM * 64 + (wc * NJ * 16 + fr) * 64 + ((fq ^ sw) * 16);
    const int nt = K >> 5;
    auto issue = [&](const int t, char* stage) {
        const int kt = t >> 1, hb = (t & 1) * 4;
#pragma unroll
        for (int q = 0; q < AQ; ++q) glds16(afn(lrow + 64 * q, kt, hb + lc4), stage + q * 4096);
#pragma unroll
        for (int q = 0; q < BQ; ++q) glds16(bp + (size_t)q * 64 * ldb + (size_t)kt * bstep + hb * 8, stage + BM * 64 + q * 4096);
    };
    auto compute = [&](const char* st) {
        half8 af[MI], bf[NJ];
#pragma unroll
        for (int i = 0; i < MI; ++i) af[i] = *(const half8*)(st + aoff0 + i * 1024);
#pragma unroll
        for (int j = 0; j < NJ; ++j) bf[j] = *(const half8*)(st + boff0 + j * 1024);
        if (SUMSQ) {
#pragma unroll
            for (int i = 0; i < MI; ++i)
#pragma unroll
                for (int e = 0; e < 4; ++e) {
                    const half2_ x = (half2_){af[i][2 * e], af[i][2 * e + 1]};
                    ss[i] = __builtin_amdgcn_fdot2(x, x, ss[i], false);
                }
        }
#pragma unroll
        for (int i = 0; i < MI; ++i)
#pragma unroll
            for (int j = 0; j < NJ; ++j) acc[i][j] = __builtin_amdgcn_mfma_f32_16x16x32_f16(bf[j], af[i], acc[i][j], 0, 0, 0);
    };
#define GEMM_STEP(S, t) do { if ((t) + 2 < nt) gwaitbar<NG>(); else gwaitbar<0>();                                  \
        if ((t) + 3 < nt) issue((t) + 3, lbase + (((S) + 3) & 3) * SB); compute(smem + (S) * SB); } while (0)
    gwaitbar<0>();
    {
        const int k = nt < 3 ? nt : 3;
        for (int p = 0; p < k; ++p) issue(p, lbase + p * SB);
        if (k >= 3) gwaitbar<2 * NG>(); else if (k == 2) gwaitbar<NG>(); else gwaitbar<0>();
        __builtin_amdgcn_s_sleep(2);
    }
#pragma unroll 1
    for (int t = 0; t < nt; t += 4) {
        GEMM_STEP(0, t);
        if (t + 1 < nt) GEMM_STEP(1, t + 1);
        if (t + 2 < nt) GEMM_STEP(2, t + 2);
        if (t + 3 < nt) GEMM_STEP(3, t + 3);
    }
#undef GEMM_STEP
    asm volatile("s_waitcnt lgkmcnt(0)\n\ts_barrier" ::: "memory");
    if (SUMSQ) {
#pragma unroll
        for (int i = 0; i < MI; ++i) { ss[i] += __shfl_xor(ss[i], 16); ss[i] += __shfl_xor(ss[i], 32); }
    }
}
template <bool SUMSQ, class AF>
DI void gemm_mainloop_glds(const int wv, const int K, const AF& afn, const h16* __restrict__ Bt, const int ldb, f32x4 (&acc)[4][4], float (&ss)[4], char* smem, const size_t bstep = 64) {
    gemm_glds<SUMSQ, 2, 4, 4>(wv, K, afn, Bt, ldb, acc, ss, smem, bstep);
}

DI int glu_perm_dst(int c_orig) {
    const int which = c_orig >> 8, c = c_orig & 255;
    return (c >> 6) * 128 + ((c >> 5) & 1) * 64 + (((c >> 4) & 1) * 2 + which) * 16 + (c & 15);
}
template <int MAP, int KB>
DI void transpose64(const float* __restrict__ src, int R, int C, h16* __restrict__ dst, int r0, int c0,
                    const float* __restrict__ rscale, char* smem, const int wv) {
    h16* tile = (h16*)smem;
    const int tid = otid(wv);
    {
        const int r = tid >> 2, cq = (tid & 3) * 16;
        const float sc = rscale ? rscale[r0 + r] : 1.f;
        const float* sp = src + (size_t)(r0 + r) * C + c0 + cq;
#pragma unroll
        for (int q = 0; q < 4; ++q) {
            float4 v = (float4){0.f, 0.f, 0.f, 0.f};
            if (c0 + cq + q * 4 < C) v = *(const float4*)(sp + q * 4);
            *(half4*)(tile + r * 72 + cq + q * 4) = (half4){(h16)(v.x * sc), (h16)(v.y * sc), (h16)(v.z * sc), (h16)(v.w * sc)};
        }
    }
    __syncthreads();
    {
        const int c = tid >> 2, rq = (tid & 3) * 16;
        half8 o0, o1;
#pragma unroll
        for (int k = 0; k < 8; ++k) { o0[k] = tile[(rq + k) * 72 + c]; o1[k] = tile[(rq + 8 + k) * 72 + c]; }
        const int cc = c0 + c;
        const int dr = MAP == 1 ? map_col(cc) : MAP == 2 ? glu_perm_dst(cc) : cc;
        h16* dp = KB ? dst + ((size_t)(r0 >> 6) * KB + dr) * 64 + rq : dst + (size_t)dr * R + r0 + rq;
        *(half8*)dp = o0; *(half8*)(dp + 8) = o1;
    }
    __syncthreads();
}

DI void phase0(PP P, char* smem, const int wv) {
    P = plaunder(P);
    constexpr int N_WIN = 4 * 16 * 50, N_WOUT = 4 * 16 * 16, N_C1 = 16 * 16 * 4, N_GLU = 4 * 4 * 8, N_XH = NT * 1024 / 2048, N_PB = 8 * 16;
    const int total = N_WIN + N_WOUT + N_C1 + N_GLU + N_XH + N_PB;
    for (int w = blockIdx.x; w < total; w += gridDim.x) {
        if (w < N_WIN) {
            const int l = w / 800, r = w % 800, rt = r / 50, ct = r % 50;
            transpose64<1, D_IN_PAD>(P->in[I_WIN] + (size_t)l * 1024 * D_IN, 1024, D_IN, (h16*)(P->ws + OFF_WTIN) + (size_t)l * D_IN_PAD * 1024,
                           rt * 64, ct * 64, P->in[I_NORMG] + l * 1024, smem, wv);
        } else if (w < N_WIN + N_WOUT) {
            const int v = w - N_WIN, l = v >> 8, r = v & 255, rt = r >> 4, ct = r & 15;
            transpose64<0, 1024>(P->in[I_WOUT] + (size_t)l * 1024 * 1024, 1024, 1024, (h16*)(P->ws + OFF_WTOUT) + (size_t)l * 1024 * 1024,
                           rt * 64, ct * 64, nullptr, smem, wv);
        } else if (w < N_WIN + N_WOUT + N_C1) {
            const int v = w - N_WIN - N_WOUT, ljh = v >> 6, r = v & 63, rt = r >> 2, ct = r & 3;
            transpose64<0, 512>(P->in[I_CW1] + (size_t)ljh * 1024 * 256, 1024, 256, (h16*)(P->ws + OFF_WTC1) + ((size_t)(ljh >> 1) * 16 * 512 + (ljh & 1) * 256) * 64,
                           rt * 64, ct * 64, nullptr, smem, wv);
        } else if (w < N_WIN + N_WOUT + N_C1 + N_GLU) {
            const int v = w - N_WIN - N_WOUT - N_C1, l = v >> 5, r = v & 31, rt = r >> 3, ct = r & 7;
            transpose64<2, 0>(P->in[I_GLUW] + (size_t)l * 256 * 512, 256, 512, (h16*)(P->ws + OFF_WTGLU) + (size_t)l * 512 * 256,
                           rt * 64, ct * 64, nullptr, smem, wv);
        } else if (w < N_WIN + N_WOUT + N_C1 + N_GLU + N_XH) {
            const size_t e0 = ((size_t)(w - N_WIN - N_WOUT - N_C1 - N_GLU) * 256 + otid(wv)) * 8;
            const float4 a = *(const float4*)(P->in[I_X] + e0), b = *(const float4*)(P->in[I_X] + e0 + 4);
            *(half8*)((h16*)(P->ws + OFF_XH) + kb_idx(NT, e0 >> 10, (int)(e0 & 1023))) = (half8){(h16)a.x, (h16)a.y, (h16)a.z, (h16)a.w, (h16)b.x, (h16)b.y, (h16)b.z, (h16)b.w};
        } else {
            const int v = w - (N_WIN + N_WOUT + N_C1 + N_GLU + N_XH), lj = v >> 4, ks = v & 15, n = otid(wv);
            const float* w1 = P->in[I_CW1] + ((size_t)lj * 2048 + ks * 128) * 256 + n;
            const float* pp = P->in[I_CPOS] + (size_t)lj * 2048 + ks * 128;
            float a = ks == 0 ? P->in[I_CB1][lj * 256 + n] : 0.f;
#pragma unroll 16
            for (int k = 0; k < 128; ++k) a += pp[k] * w1[(size_t)k * 256];
            ((float*)(P->ws + OFF_POSB))[(lj * 16 + ks) * 256 + n] = a;
        }
    }
}

DI void s5_build_item(PP P, int l, int item, char* smem, const int wv) {
    P = plaunder(P);
    float* apow = (float*)smem;
    float* bbar = apow + 64 * 33 * 2;
    float* cc   = bbar + 64 * 16 * 2;
    const int tid = otid(wv);
    const int g = (item < 256) ? (item >> 4) : ((item - 256) >> 2);
    if (tid < 64) {
        const int p = tid;
        const float lre = fminf(P->in[I_LRE][(l * 16 + g) * 64 + p], -1e-4f);
        const float lim = P->in[I_LIM][(l * 16 + g) * 64 + p];
        const float dt = expf(P->in[I_LSTEP][l * 16 + g]);
        const float x = lre * dt, y = lim * dt;
        const float em1 = expm1f(x), cy = cosf(y), sy = sinf(y), sh = sinf(0.5f * y);
        const float ar = (em1 + 1.f) * cy, ai = (em1 + 1.f) * sy;
        const float dr = em1 * cy - 2.f * sh * sh, di = ai;
        const float den = lre * lre + lim * lim;
        const float fr = (dr * lre + di * lim) / den;
        const float fi = (di * lre - dr * lim) / den;
        float pr = 1.f, pi = 0.f;
        for (int k = 0; k <= 32; ++k) {
            apow[(p * 33 + k) * 2] = pr; apow[(p * 33 + k) * 2 + 1] = pi;
            const float nr = pr * ar - pi * ai, ni = pr * ai + pi * ar; pr = nr; pi = ni;
        }
        for (int c = 0; c < 16; ++c) {
            const float br = P->in[I_BRE][((size_t)(l * 16 + g) * 64 + p) * 16 + c];
            const float bi = P->in[I_BIM][((size_t)(l * 16 + g) * 64 + p) * 16 + c];
            bbar[(p * 16 + c) * 2] = fr * br - fi * bi;
            bbar[(p * 16 + c) * 2 + 1] = fr * bi + fi * br;
        }
    }
    for (int e = tid; e < 1024; e += 256) {
        cc[e * 2] = P->in[I_CRE][(size_t)(l * 16 + g) * 1024 + e];
        cc[e * 2 + 1] = P->in[I_CIM][(size_t)(l * 16 + g) * 1024 + e];
    }
    __syncthreads();
    if (item < 256) {
        const int c = item & 15;
        float* kt = cc + 2048;
        for (int idx = tid; idx < 512; idx += 256) {
            const int lag = idx >> 4, c2 = idx & 15;
            float a = 0.f;
            for (int p = 0; p < 64; ++p) {
                const float cr = cc[(c * 64 + p) * 2], ci = cc[(c * 64 + p) * 2 + 1];
                const float xr = apow[(p * 33 + lag) * 2], xi = apow[(p * 33 + lag) * 2 + 1];
                const float br = bbar[(p * 16 + c2) * 2], bi = bbar[(p * 16 + c2) * 2 + 1];
                const float tr = cr * xr - ci * xi, ti = cr * xi + ci * xr;
                a += tr * br - ti * bi;
            }
            kt[idx] = a;
        }
        __syncthreads();
        h16* W = (h16*)(P->ws + OFF_S5W) + (size_t)g * 512 * 640;
        for (int idx = tid; idx < 32 * 640; idx += 256) {
            const int j = idx / 640, k = idx % 640;
            float val = 0.f;
            if (k < 512) {
                const int s = k >> 4, c2 = k & 15, lag = j - s;
                if (lag >= 0) val = kt[lag * 16 + c2];
            } else {
                const int p = (k - 512) >> 1;
                const float cr = cc[(c * 64 + p) * 2], ci = cc[(c * 64 + p) * 2 + 1];
                const float xr = apow[(p * 33 + j + 1) * 2], xi = apow[(p * 33 + j + 1) * 2 + 1];
                val = (k & 1) ? -(cr * xi + ci * xr) : (cr * xr - ci * xi);
            }
            W[(size_t)(j * 16 + c) * 640 + k] = (h16)val;
        }
    } else {
        const int pq = (item - 256) & 3;
        h16* E = (h16*)(P->ws + OFF_S5E) + ((size_t)g * 128 + pq * 32) * 512;
        for (int idx = tid; idx < 32 * 512; idx += 256) {
            const int nl = idx >> 9, k = idx & 511;
            const int p = pq * 16 + (nl >> 1), s = k >> 4, c2 = k & 15;
            const float xr = apow[(p * 33 + 31 - s) * 2], xi = apow[(p * 33 + 31 - s) * 2 + 1];
            const float br = bbar[(p * 16 + c2) * 2], bi = bbar[(p * 16 + c2) * 2 + 1];
            const float val = (nl & 1) ? (xr * bi + xi * br) : (xr * br - xi * bi);
            E[(size_t)nl * 512 + k] = (h16)val;
        }
        if (tid < 16) {
            const int p = pq * 16 + tid;
            float* AL = (float*)(P->ws + OFF_S5AL);
            AL[(g * 64 + p) * 2] = apow[(p * 33 + 32) * 2];
            AL[(g * 64 + p) * 2 + 1] = apow[(p * 33 + 32) * 2 + 1];
        }
    }
    __syncthreads();
}

template <int WR, int MI>
DI void inproj_tile(PP P, int l, int m0, int n0, char* smem, const int wv) {
    P = plaunder(P);
    constexpr int WC = 4 / WR;
    f32x4 acc[MI][4];
    float ss[MI];
    gemm_glds<true, WR, MI, 4>(wv, 1024, APlain{(const h16*)(P->ws + OFF_XH) + (size_t)m0 * 64, 64, (size_t)NT * 64},
                               (const h16*)(P->ws + OFF_WTIN) + ((size_t)l * 16 * D_IN_PAD + n0) * 64, 64, acc, ss, smem, (size_t)D_IN_PAD * 64);
    const int tid = otid(wv), lane = tid & 63, wid = tid >> 6, wr = wid / WC, wc = wid % WC;
    h16* proj = (h16*)(P->ws + OFF_PROJ);
    const int n64 = n0 + wc * 64;
    int cls = 0;
    if (n64 < 512) cls = 1;
    else if (n64 >= C_NKV + 256 && n64 < C_NKV + 384) cls = 2;
    else if (n64 >= C_NKV + 512 && n64 < C_NKV + 640) cls = 3;
    else if (n64 >= C_NKV + 384 && n64 < C_NKV + 512) cls = 4;
    else if (n64 >= C_NKV + 640 && n64 < C_NKV + 768) cls = 5;
    float wn[4][4];
    if (cls >= 1 && cls <= 3) {
        const float* wp = (cls == 1) ? P->in[I_NQN] + l * 64 : P->in[I_NKN] + (l * 3 + (cls - 1)) * 64;
        const float sc = (cls == 1) ? QSCALE : 1.f;
#pragma unroll
        for (int j = 0; j < 4; ++j) {
            const float4 w4 = *(const float4*)(wp + j * 16 + (lane >> 4) * 4);
            wn[j][0] = w4.x * sc; wn[j][1] = w4.y * sc; wn[j][2] = w4.z * sc; wn[j][3] = w4.w * sc;
        }
    }
#pragma unroll
    for (int i = 0; i < MI; ++i) {
        const int ml = wr * MI * 16 + i * 16 + (lane & 15);
        const float r = rsqrtf(ss[i] * (1.f / 1024.f) + 1e-6f);
        const size_t row = (size_t)m0 + ml;
        f32x4 v[4];
#pragma unroll
        for (int j = 0; j < 4; ++j) v[j] = acc[i][j] * r;
        if (cls >= 1 && cls <= 3) {
            float s2 = 0.f;
#pragma unroll
            for (int j = 0; j < 4; ++j) s2 += v[j][0] * v[j][0] + v[j][1] * v[j][1] + v[j][2] * v[j][2] + v[j][3] * v[j][3];
            s2 += __shfl_xor(s2, 16); s2 += __shfl_xor(s2, 32);
            const float rn = rsqrtf(s2 * (1.f / 64.f) + 1e-6f);
#pragma unroll
            for (int j = 0; j < 4; ++j) { v[j][0] *= rn * wn[j][0]; v[j][1] *= rn * wn[j][1]; v[j][2] *= rn * wn[j][2]; v[j][3] *= rn * wn[j][3]; }
        }
        if (cls >= 4) {
            const int g = (n64 >> 6) & 1, br = cls - 4;
            const int b = (int)(row >> 13), t = (int)(row & 8191);
            h16* vt = (h16*)(P->ws + OFF_VTG) + ((((size_t)br * 4 + b * 2 + g) * 128 + (t >> 6)) * 64) * 64 + (t & 63);
#pragma unroll
            for (int j = 0; j < 4; ++j)
#pragma unroll
                for (int e = 0; e < 4; ++e) vt[(j * 16 + (lane >> 4) * 4 + e) * 64] = (h16)v[j][e];
        }
#pragma unroll
        for (int j = 0; j < 4; ++j) {
            const int n = n64 + j * 16 + (lane >> 4) * 4;
            if (n < D_IN) *(half4*)(proj + row * D_IN + n) = (half4){(h16)v[j][0], (h16)v[j][1], (h16)v[j][2], (h16)v[j][3]};
        }
        __builtin_amdgcn_sched_barrier(0);
    }
    __syncthreads();
}

DI void gla_kv_item(PP P, int l, int item, char* smem, const int wv) {
    P = plaunder(P);
    const int h = item & 3, cn = item >> 2;
    const size_t tok0 = (size_t)cn * 32;
    float* gl = (float*)smem;
    float* ke = gl + 32 * 33;
    float* vs = ke + 32 * 33;
    const h16* proj = (const h16*)(P->ws + OFF_PROJ);
    const int tid = otid(wv), i = tid >> 3, dq = (tid & 7) * 4, e0 = (tid & 7) * 8;
    {
        const half8* lp = (const half8*)(proj + (tok0 + i) * D_IN + C_GLR);
        const half8 l0 = lp[0], l1 = lp[1];
        float lr[16];
#pragma unroll
        for (int r = 0; r < 8; ++r) { lr[r] = (float)l0[r]; lr[8 + r] = (float)l1[r]; }
#pragma unroll
        for (int dd = 0; dd < 4; ++dd) {
            const int d = dq + dd;
            float x = P->in[I_GB2][l * 128 + h * 32 + d];
#pragma unroll
            for (int r = 0; r < 16; ++r) x += lr[r] * P->in[I_GW2][(l * 16 + r) * 128 + h * 32 + d];
            gl[i * 33 + d] = log_sigmoidf_(x) * (1.f / 16.f);
        }
    }
    __syncthreads();
    if (tid < 32) {
        float run = 0.f;
        float* bc = (float*)(P->ws + OFF_BCUM);
        for (int ii = 0; ii < 32; ++ii) {
            run += gl[ii * 33 + tid]; gl[ii * 33 + tid] = run;
            bc[(tok0 + ii) * 128 + h * 32 + tid] = run;
        }
    }
    __syncthreads();
    {
        const half4 kv4 = *(const half4*)(proj + (tok0 + i) * D_IN + C_GK + h * 32 + dq);
#pragma unroll
        for (int dd = 0; dd < 4; ++dd) {
            const int d = dq + dd;
            ke[i * 33 + d] = (float)kv4[dd] * __expf(gl[31 * 33 + d] - gl[i * 33 + d]);
        }
        const half8 v8 = *(const half8*)(proj + (tok0 + i) * D_IN + C_GV + h * 64 + e0);
#pragma unroll
        for (int e = 0; e < 8; ++e) vs[i * 64 + e0 + e] = (float)v8[e];
    }
    __syncthreads();
    {
        const int d = tid >> 3;
        float acc[8];
#pragma unroll
        for (int e = 0; e < 8; ++e) acc[e] = 0.f;
        for (int c = 0; c < 32; ++c) {
            const float kd = ke[c * 33 + d];
#pragma unroll
            for (int e = 0; e < 8; ++e) acc[e] += kd * vs[c * 64 + e0 + e];
        }
        const int b = cn >> 8, n = cn & 255, bh = b * 4 + h;
        float* kvp = (float*)(P->ws + OFF_GKV) + ((size_t)(bh * 256 + n) * 32 + d) * 64 + e0;
        *(float4*)kvp = (float4){acc[0], acc[1], acc[2], acc[3]};
        *(float4*)(kvp + 4) = (float4){acc[4], acc[5], acc[6], acc[7]};
        if (tid < 32) ((float*)(P->ws + OFF_GDEC))[(size_t)(bh * 256 + n) * 32 + tid] = __expf(gl[31 * 33 + tid]);
    }
    __syncthreads();
}

DI void cmp_gemm_tile(PP P, int l, int tile, char* smem, const int wv) {
    P = plaunder(P);
    const int j = tile >> 6, mt = (tile >> 2) & 15, nt = tile & 3;
    const int row0 = mt * 128, bg = row0 >> 9, i0 = row0 & 511, b = bg >> 1, g = bg & 1;
    f32x4 acc[4][4];
    float ssd[4];
    gemm_mainloop_glds<false>(wv, 1024, APlain{(const h16*)(P->ws + OFF_PROJ) + ((size_t)b * SEQ + 16 * i0) * D_IN + C_NKV + j * 128 + g * 64, (size_t)16 * D_IN, (size_t)D_IN},
                              (const h16*)(P->ws + OFF_WTC1) + ((size_t)(l * 2 + j) * 16 * 512 + nt * 128) * 64, 64, acc, ssd, smem, (size_t)512 * 64);
    const int tid = otid(wv), lane = tid & 63, wid = tid >> 6, wr = wid >> 1, wc = wid & 1;
    float* pt = (float*)(P->ws + OFF_CHID) + (size_t)j * 2048 * 512;
#pragma unroll
    for (int i = 0; i < 4; ++i) {
        const size_t row = (size_t)row0 + wr * 64 + i * 16 + (lane & 15);
#pragma unroll
        for (int jj = 0; jj < 4; ++jj) {
            const int n = nt * 128 + wc * 64 + jj * 16 + (lane >> 4) * 4;
            const f32x4 v = acc[i][jj];
            *(float4*)(pt + row * 512 + n) = (float4){v[0], v[1], v[2], v[3]};
        }
    }
}

DI void s5e_gemm_tile(PP P, int l, int tile, char* smem, const int wv) {
    P = plaunder(P);
    const int g = tile >> 2, mt = tile & 3;
    f32x4 acc[4][4];
    float ssd[4];
    gemm_mainloop_glds<false>(wv, 512, AS5{(const h16*)(P->ws + OFF_PROJ) + C_SU + g * 16, nullptr, mt * 128},
                              (const h16*)(P->ws + OFF_S5E) + (size_t)g * 128 * 512, 512, acc, ssd, smem);
    const int tid = otid(wv), lane = tid & 63, wid = tid >> 6, wr = wid >> 1, wc = wid & 1;
    float* xc = (float*)(P->ws + OFF_XC);
#pragma unroll
    for (int i = 0; i < 4; ++i) {
        const size_t ch = (size_t)mt * 128 + wr * 64 + i * 16 + (lane & 15);
#pragma unroll
        for (int jj = 0; jj < 4; ++jj) {
            const int n = wc * 64 + jj * 16 + (lane >> 4) * 4;
            const f32x4 v = acc[i][jj];
            *(float4*)(xc + (ch * 1024 + g * 64) * 2 + n) = (float4){v[0], v[1], v[2], v[3]};
        }
    }
}

DI void gla_scan_item(PP P, int item, char* smem, const int wv) {
    P = plaunder(P);
    const int tid = otid(wv), sl = tid & 31, part = tid >> 5;
    const int idx = item * 32 + sl, bh = idx >> 11, de = idx & 2047, d = de >> 6;
    float* kv = (float*)(P->ws + OFF_GKV) + ((size_t)bh * 256 + part * 32) * 2048 + de;
    const float* dc = (const float*)(P->ws + OFF_GDEC) + ((size_t)bh * 256 + part * 32) * 32 + d;
    float* sD = (float*)smem; float* sL = sD + 256;
    float kvv[32], dd[32];
#pragma unroll
    for (int i = 0; i < 32; ++i) { kvv[i] = kv[(size_t)i * 2048]; dd[i] = dc[i * 32]; }
    float D = 1.f, L = 0.f;
#pragma unroll
    for (int i = 0; i < 32; ++i) { L = dd[i] * L + kvv[i]; D *= dd[i]; }
    sD[part * 32 + sl] = D; sL[part * 32 + sl] = L;
    __syncthreads();
    float S = 0.f;
    for (int q = 0; q < part; ++q) S = sD[q * 32 + sl] * S + sL[q * 32 + sl];
#pragma unroll
    for (int i = 0; i < 32; ++i) { const float o = S; S = dd[i] * S + kvv[i]; kv[(size_t)i * 2048] = o; }
    __syncthreads();
}
DI void s5_scan_item(PP P, int item, char* smem, const int wv) {
    P = plaunder(P);
    const int tid = otid(wv), sl = tid & 31, part = tid >> 5;
    const int idx = item * 32 + sl, b = idx >> 10, s = idx & 1023;
    float2* xc = (float2*)(P->ws + OFF_XC) + ((size_t)b * 256 + part * 32) * 1024 + s;
    half2_* xch = (half2_*)(P->ws + OFF_XCH) + ((size_t)b * 256 + part * 32) * 1024 + s;
    const float2 a = ((const float2*)(P->ws + OFF_S5AL))[s];
    float2* sL = (float2*)smem;
    float2 c[32];
#pragma unroll
    for (int i = 0; i < 32; ++i) c[i] = xc[(size_t)i * 1024];
    float lr = 0.f, li = 0.f;
#pragma unroll
    for (int i = 0; i < 32; ++i) { const float nr = a.x * lr - a.y * li + c[i].x, ni = a.x * li + a.y * lr + c[i].y; lr = nr; li = ni; }
    float dr = a.x, di = a.y;
#pragma unroll
    for (int i = 0; i < 5; ++i) { const float nr = dr * dr - di * di, ni = 2.f * dr * di; dr = nr; di = ni; }
    sL[part * 32 + sl] = (float2){lr, li};
    __syncthreads();
    float xr = 0.f, xi = 0.f;
    for (int q = 0; q < part; ++q) { const float2 lq = sL[q * 32 + sl]; const float nr = dr * xr - di * xi + lq.x, ni = dr * xi + di * xr + lq.y; xr = nr; xi = ni; }
#pragma unroll
    for (int i = 0; i < 32; ++i) {
        const float2 o = (float2){xr, xi};
        const float nr = a.x * xr - a.y * xi + c[i].x, ni = a.x * xi + a.y * xr + c[i].y; xr = nr; xi = ni;
        xc[(size_t)i * 1024] = o;
        xch[(size_t)i * 1024] = (half2_){(h16)o.x, (h16)o.y};
    }
    __syncthreads();
}
DI void cmp_l2_item(PP P, int l, int item, char* smem, const int wv) {
    P = plaunder(P);
    const int tid = otid(wv), lane = tid & 63, w = tid >> 6;
    const int j = item >> 8, r0 = (item & 255) * 8;
    h16* w2s = (h16*)smem;
    float* hs = (float*)(smem + 32768);
    {
        const float* w2 = P->in[I_CW2] + (size_t)(l * 2 + j) * 256 * 64;
        for (int e = tid * 4; e < 256 * 64; e += 1024) {
            const float4 v = *(const float4*)(w2 + e);
            *(half4*)(w2s + e) = (half4){(h16)v.x, (h16)v.y, (h16)v.z, (h16)v.w};
        }
        const float* pt = (const float*)(P->ws + OFF_CHID) + (size_t)j * 2048 * 512;
        float pb = 0.f;
#pragma unroll
        for (int ks = 0; ks < 16; ++ks) pb += ((const float*)(P->ws + OFF_POSB))[((l * 2 + j) * 16 + ks) * 256 + tid];
#pragma unroll
        for (int rr = 0; rr < 8; ++rr) {
            const int row = r0 + rr, i = row & 511;
            float v = 0.f;
            if (i < 511) v = gelu_tanh(pt[(size_t)row * 512 + tid] + pt[(size_t)(row + 1) * 512 + 256 + tid] + pb);
            hs[rr * 256 + tid] = v;
        }
    }
    __syncthreads();
    const float bb = P->in[I_CB2][(l * 2 + j) * 64 + lane];
    float a0 = bb, a1 = bb;
    const float* h0 = hs + (2 * w) * 256, *h1 = h0 + 256;
#pragma unroll 8
    for (int n = 0; n < 256; ++n) {
        const float wv = (float)w2s[n * 64 + lane];
        a0 += h0[n] * wv; a1 += h1[n] * wv;
    }
#pragma unroll
    for (int rr = 0; rr < 2; ++rr) {
        float acc = rr ? a1 : a0;
        const int row = r0 + 2 * w + rr, bg = row >> 9, i = row & 511;
        if (i == 511) acc = 0.f;
        if (j == 0) {
            const float ss = wave_sum(acc * acc);
            acc = acc * rsqrtf(ss * (1.f / 64.f) + 1e-6f) * P->in[I_NKN][(l * 3 + 0) * 64 + lane];
            ((h16*)(P->ws + OFF_KCMP))[(size_t)row * 64 + lane] = (h16)acc;
        } else {
            ((h16*)(P->ws + OFF_VCMP))[(((size_t)bg * 8 + (i >> 6)) * 64 + lane) * 64 + (i & 63)] = (h16)acc;
        }
    }
    __syncthreads();
}

DI void gla_out_item(PP P, int l, int item, char* smem, const int wv) {
    P = plaunder(P);
    const int h = item & 3, cn = item >> 2;
    const size_t tok0 = (size_t)cn * 32;
    float* qe = (float*)smem;
    float* ke = qe + 32 * 33;
    float* scs = ke + 32 * 33;
    float* vs = scs + 32 * 33;
    float* sp = vs + 32 * 64;
    const h16* proj = (const h16*)(P->ws + OFF_PROJ);
    const int tid = otid(wv), i = tid >> 3, dq = (tid & 7) * 4, e0 = (tid & 7) * 8;
    const int b = cn >> 8, n = cn & 255, bh = b * 4 + h;
    {
        const float4 bc = *(const float4*)((const float*)(P->ws + OFF_BCUM) + (tok0 + i) * 128 + h * 32 + dq);
        const half4 q4 = *(const half4*)(proj + (tok0 + i) * D_IN + C_GQ + h * 32 + dq);
        const half4 k4 = *(const half4*)(proj + (tok0 + i) * D_IN + C_GK + h * 32 + dq);
        const float bcv[4] = {bc.x, bc.y, bc.z, bc.w};
#pragma unroll
        for (int dd = 0; dd < 4; ++dd) {
            qe[i * 33 + dq + dd] = (float)q4[dd] * 0.17677669529663687f * __expf(bcv[dd]);
            ke[i * 33 + dq + dd] = (float)k4[dd] * __expf(-bcv[dd]);
        }
        const half8 v8 = *(const half8*)(proj + (tok0 + i) * D_IN + C_GV + h * 64 + e0);
#pragma unroll
        for (int e = 0; e < 8; ++e) vs[i * 64 + e0 + e] = (float)v8[e];
        const float* spp = (const float*)(P->ws + OFF_GKV) + (size_t)(bh * 256 + n) * 2048 + tid * 8;
        const float4 s0 = *(const float4*)spp, s1 = *(const float4*)(spp + 4);
        *(float4*)(sp + tid * 8) = s0; *(float4*)(sp + tid * 8 + 4) = s1;
    }
    __syncthreads();
    {
        const int j0 = (tid & 7) * 4;
#pragma unroll
        for (int jj = 0; jj < 4; ++jj) {
            const int j = j0 + jj;
            float s = 0.f;
            if (j <= i) for (int d = 0; d < 32; ++d) s += qe[i * 33 + d] * ke[j * 33 + d];
            scs[i * 33 + j] = s;
        }
    }
    __syncthreads();
    {
        float acc[8];
#pragma unroll
        for (int e = 0; e < 8; ++e) acc[e] = 0.f;
        for (int j = 0; j < 32; ++j) {
            const float s = scs[i * 33 + j], qd = qe[i * 33 + j];
#pragma unroll
            for (int e = 0; e < 8; ++e) acc[e] += s * vs[j * 64 + e0 + e] + qd * sp[j * 64 + e0 + e];
        }
        float ss = 0.f;
#pragma unroll
        for (int e = 0; e < 8; ++e) ss += acc[e] * acc[e];
        ss += __shfl_xor(ss, 1); ss += __shfl_xor(ss, 2); ss += __shfl_xor(ss, 4);
        const float r = rsqrtf(ss * (1.f / 64.f) + 1e-6f);
        const half8 g8 = *(const half8*)(proj + (tok0 + i) * D_IN + C_GG + h * 64 + e0);
        half8 o;
#pragma unroll
        for (int e = 0; e < 8; ++e) o[e] = (h16)(acc[e] * r * P->in[I_GON][l * 64 + e0 + e] * siluf_((float)g8[e]));
        *(half8*)((h16*)(P->ws + OFF_MIX) + kb_idx(NT, tok0 + i, h * 64 + e0)) = o;
    }
    __syncthreads();
}

DI void s5o_gemm_tile(PP P, int l, int tile, char* smem, const int wv) {
    P = plaunder(P);
    const int g = tile >> 4, mt = (tile >> 2) & 3, nt = tile & 3;
    f32x4 acc[4][4];
    float ssd[4];
    gemm_mainloop_glds<false>(wv, 640, AS5{(const h16*)(P->ws + OFF_PROJ) + C_SU + g * 16, (const h16*)(P->ws + OFF_XCH) + g * 128, mt * 128},
                              (const h16*)(P->ws + OFF_S5W) + ((size_t)g * 512 + nt * 128) * 640, 640, acc, ssd, smem);
    const int tid = otid(wv), lane = tid & 63, wid = tid >> 6, wr = wid >> 1, wc = wid & 1;
    const h16* proj = (const h16*)(P->ws + OFF_PROJ);
    h16* yact = (h16*)(P->ws + OFF_YACT);
#pragma unroll
    for (int i = 0; i < 4; ++i) {
        const size_t ch = (size_t)mt * 128 + wr * 64 + i * 16 + (lane & 15);
#pragma unroll
        for (int jj = 0; jj < 4; ++jj) {
            const int n = nt * 128 + wc * 64 + jj * 16 + (lane >> 4) * 4;
            const int j = n >> 4, c = n & 15;
            const size_t tok = ch * 32 + j;
            const half4 u4 = *(const half4*)(proj + tok * D_IN + C_SU + g * 16 + c);
            const float4 dd = *(const float4*)(P->in[I_SD] + (l * 16 + g) * 16 + c);
            const f32x4 v = acc[i][jj];
            half4 o;
            o[0] = (h16)gelu_tanh(v[0] + dd.x * (float)u4[0]);
            o[1] = (h16)gelu_tanh(v[1] + dd.y * (float)u4[1]);
            o[2] = (h16)gelu_tanh(v[2] + dd.z * (float)u4[2]);
            o[3] = (h16)gelu_tanh(v[3] + dd.w * (float)u4[3]);
            *(half4*)(yact + tok * 256 + g * 16 + c) = o;
        }
    }
}

#define MFMA32(a, b, c) __builtin_amdgcn_mfma_f32_32x32x16_f16((a), (b), (c), 0, 0, 0)
constexpr float FAST_SHIFT = 4.f;
constexpr float NEGS = -1e30f;
DI float ex2(float x) { return __builtin_amdgcn_exp2f(x); }
#define NSA_WAITBAR(N) asm volatile("s_waitcnt vmcnt(" #N ") lgkmcnt(0)\n\ts_barrier" ::: "memory")
#define NSA_BAR() asm volatile("s_waitcnt lgkmcnt(0)\n\ts_barrier" ::: "memory")

struct KVSrc { const h16* k; int ldk; size_t kstep; const h16* v; };
DI void nsa_dma(const KVSrc& s, int j, char* stage, int wid, int lane) {
    const int row0 = wid * 8 + (lane >> 3);
    const int sw = ((lane & 7) ^ ((row0 >> 1) & 7)) * 8;
    const h16* kp = s.k + (size_t)j * s.kstep + (size_t)row0 * s.ldk + sw;
    glds16(kp, stage + wid * 1024);
    glds16(kp + (size_t)32 * s.ldk, stage + 4096 + wid * 1024);
    const h16* vp = s.v + (size_t)j * 4096 + row0 * 64 + sw;
    glds16(vp, stage + 8192 + wid * 1024);
    glds16(vp + 32 * 64, stage + 8192 + 4096 + wid * 1024);
}
template <int NST, class F>
DI void nsa_pipe(const KVSrc& s, const int n, char* smem, int wid, int lane, F&& compute) {
    NSA_WAITBAR(0);
    {
        const int k = n < NST - 1 ? n : NST - 1;
        for (int p = 0; p < k; ++p) nsa_dma(s, p, smem + p * 16384, wid, lane);
        if (k >= 3) NSA_WAITBAR(8); else if (k == 2) NSA_WAITBAR(4); else NSA_WAITBAR(0);
    }
    for (int j = 0; j < n; ++j) {
        if (NST == 4 && j + 2 < n) NSA_WAITBAR(4); else NSA_WAITBAR(0);
        const int jn = j + NST - 1;
        compute(j, smem + (j % NST) * 16384, [&]() { if (jn < n) nsa_dma(s, jn, smem + (jn % NST) * 16384, wid, lane); });
    }
}

template <bool SHIFT = false>
DI void qk_tile(const char* Kimg, const half8 (&qf)[4], f32x16 (&s)[2], int lane) {
    const int r = lane & 31, h = lane >> 5, swz = (r >> 1) & 7;
    const char* base = Kimg + r * 128;
#pragma unroll
    for (int kt = 0; kt < 2; ++kt) {
        half8 kf[4];
#pragma unroll
        for (int ks = 0; ks < 4; ++ks) kf[ks] = *(const half8*)(base + kt * 4096 + (((2 * ks + h) ^ swz) << 4));
#pragma unroll
        for (int e = 0; e < 16; ++e) s[kt][e] = SHIFT ? -FAST_SHIFT : 0.f;
#pragma unroll
        for (int ks = 0; ks < 4; ++ks) s[kt] = MFMA32(kf[ks], qf[ks], s[kt]);
    }
}
template <int S> DI half8 pack8(const f32x16& x) {
    return (half8){(h16)x[8 * S], (h16)x[8 * S + 1], (h16)x[8 * S + 2], (h16)x[8 * S + 3], (h16)x[8 * S + 4], (h16)x[8 * S + 5], (h16)x[8 * S + 6], (h16)x[8 * S + 7]};
}
DI half8 ld_vfrag(const char* Vimg, int off0) {
    const half4 lo = *(const half4*)(Vimg + off0), hi = *(const half4*)(Vimg + (off0 ^ 16));
    return (half8){lo[0], lo[1], lo[2], lo[3], hi[0], hi[1], hi[2], hi[3]};
}
template <int KT>
DI void pv_load(const char* Vimg, half8 (&vf)[4], int lane) {
    const int r = lane & 31, h = lane >> 5, swz16 = ((r >> 1) & 7) << 4;
    const char* rb = Vimg + r * 128 + 8 * h;
#pragma unroll
    for (int dt = 0; dt < 2; ++dt) {
        vf[dt * 2 + 0] = ld_vfrag(rb + dt * 4096, ((4 * KT) << 4) ^ swz16);
        vf[dt * 2 + 1] = ld_vfrag(rb + dt * 4096, ((4 * KT + 2) << 4) ^ swz16);
    }
}
typedef unsigned u32x4_ __attribute__((ext_vector_type(4)));
template <int KT, bool MASKED = false>
DI void pv_mma(const half8 (&vf)[4], const f32x16 (&p)[2], f32x16 (&o)[2], const unsigned rmask = 0xffffffffu) {
    half8 pb0 = pack8<0>(p[KT]), pb1 = pack8<1>(p[KT]);
    if (MASKED) {
        pb0 = __builtin_bit_cast(half8, __builtin_bit_cast(u32x4_, pb0) & rmask);
        pb1 = __builtin_bit_cast(half8, __builtin_bit_cast(u32x4_, pb1) & rmask);
    }
#pragma unroll
    for (int dt = 0; dt < 2; ++dt) {
        o[dt] = MFMA32(vf[dt * 2 + 0], pb0, o[dt]);
        o[dt] = MFMA32(vf[dt * 2 + 1], pb1, o[dt]);
    }
}
template <bool MASKED = false>
DI void pv_finish(const char* Vimg, const half8 (&va)[4], const f32x16 (&p)[2], f32x16 (&o)[2], int lane, const unsigned rmask = 0xffffffffu) {
    half8 vb[4];
    pv_load<1>(Vimg, vb, lane);
    pv_mma<0, MASKED>(va, p, o, rmask);
    pv_mma<1, MASKED>(vb, p, o, rmask);
}
DI float sm_fast(f32x16 (&s)[2]) {
    float rs = 0.f;
#pragma unroll
    for (int kt = 0; kt < 2; ++kt)
#pragma unroll
        for (int e = 0; e < 16; ++e) { const float p = ex2(s[kt][e]); s[kt][e] = p; rs += p; }
    return rs;
}
DI float xhalf_max(float v) {
    const auto r = __builtin_amdgcn_permlane32_swap(__float_as_uint(v), __float_as_uint(v), false, false);
    return fmaxf(__uint_as_float(r[0]), __uint_as_float(r[1]));
}
DI float xhalf_sum(float v) {
    const auto r = __builtin_amdgcn_permlane32_swap(__float_as_uint(v), __float_as_uint(v), false, false);
    return __uint_as_float(r[0]) + __uint_as_float(r[1]);
}
DI float rowmax32(const f32x16 (&s)[2]) {
    float mx = s[0][0];
#pragma unroll
    for (int e = 1; e < 16; ++e) mx = fmaxf(mx, s[0][e]);
#pragma unroll
    for (int e = 0; e < 16; ++e) mx = fmaxf(mx, s[1][e]);
    return xhalf_max(mx);
}
constexpr float SM_THR = 6.f;
DI void sm_online(f32x16 (&s)[2], float& m, float& l, f32x16 (&o)[2], const bool rowok) {
    float mx = rowmax32(s);
    mx = rowok ? mx : NEGS;
    if (__any(mx > m + SM_THR)) {
        const float mn = fmaxf(m, mx), alpha = ex2(m - mn);
        l *= alpha; o[0] *= alpha; o[1] *= alpha; m = mn;
    }
    const float msub = rowok ? m : 1e30f;
    float rs = 0.f;
#pragma unroll
    for (int kt = 0; kt < 2; ++kt)
#pragma unroll
        for (int e = 0; e < 16; ++e) { const float p = ex2(s[kt][e] - msub); s[kt][e] = p; rs += p; }
    l += xhalf_sum(rs);
}

template <int V> struct IC { static constexpr int value = V; };
template <bool FAST>
DI void nsa_unit(PP P, int l, int bg, int c32, char* smem, const int wv) {
    P = plaunder(P);
    const int tid = otid(wv), lane = tid & 63, w = tid >> 6, r = lane & 31, h = lane >> 5;
    const int b = bg >> 1, g = bg & 1, t0 = c32 * 32, cur = c32 >> 1;
    const int tokl = w * 8 + (r >> 2), head = r & 3, t = t0 + tokl;
    const size_t tokg = (size_t)b * SEQ + t;
    float* IMP = (float*)(smem + 49152);
    unsigned* SELM = (unsigned*)(smem + 49152);
    const h16* proj = (const h16*)(P->ws + OFF_PROJ);
    const int ghead = g * 4 + head;

    half8 qf[4];
    {
        const h16* qp = proj + tokg * D_IN + C_NQ + ghead * 64 + 8 * h;
#pragma unroll
        for (int ks = 0; ks < 4; ++ks) qf[ks] = *(const half8*)(qp + 16 * ks);
    }
    float g0, g1, g2;
    {
        const h16* gp = proj + tokg * D_IN + C_NGL + ghead * 3;
        const float* gb = P->in[I_NGB] + l * 24 + ghead * 3;
        g0 = sigmoidf_((float)gp[0] + gb[0]); g1 = sigmoidf_((float)gp[1] + gb[1]); g2 = sigmoidf_((float)gp[2] + gb[2]);
    }
    __syncthreads();
    for (int i = tid; i < 32 * 128; i += 256) IMP[i] = 0.f;

    half8 oacc[4];
    auto oacc_add = [&](const f32x16 (&o)[2], const float sc, const bool first) {
#pragma unroll
        for (int dt = 0; dt < 2; ++dt)
#pragma unroll
            for (int hf = 0; hf < 2; ++hf) {
                half8 v = oacc[dt * 2 + hf];
#pragma unroll
                for (int e = 0; e < 8; ++e) v[e] = (h16)((first ? 0.f : (float)v[e]) + o[dt][hf * 8 + e] * sc);
                oacc[dt * 2 + hf] = v;
            }
    };

    {
        const int nvt = 2 * c32 + 1;
        const int nvr = (t >= 31) ? ((t - 31) >> 4) + 1 : 0;
        const int ntile = (nvt + 63) >> 6;
        KVSrc src{(const h16*)(P->ws + OFF_KCMP) + (size_t)bg * 512 * 64, 64, 4096, (const h16*)(P->ws + OFF_VCMP) + (size_t)bg * 8 * 4096};
        f32x16 o[2];
#pragma unroll
        for (int e = 0; e < 16; ++e) { o[0][e] = 0.f; o[1][e] = 0.f; }
        float invl;
        if constexpr (FAST) {
            const int tf = t0 + w * 8;
            const int nvlo = __builtin_amdgcn_readfirstlane((tf >= 31) ? ((tf - 31) >> 4) + 1 : 0);
            float lsum = 0.f;
            nsa_pipe<3>(src, ntile, smem, w, lane, [&](int j, const char* st, auto&& issue) {
                f32x16 s[2];
                qk_tile<true>(st, qf, s, lane);
                issue();
                if (64 * j + 64 > nvlo) {
#pragma unroll
                    for (int kt = 0; kt < 2; ++kt)
#pragma unroll
                        for (int e = 0; e < 16; ++e) {
                            const int key = 64 * j + 32 * kt + 8 * (e >> 2) + 4 * h + (e & 3);
                            if (key >= nvr) s[kt][e] = NEGS;
                        }
                }
                lsum += sm_fast(s);
            });
            lsum = xhalf_sum(lsum);
            invl = lsum > 0.f ? 1.f / lsum : 0.f;
            nsa_pipe<3>(src, ntile, smem, w, lane, [&](int j, const char* st, auto&& issue) {
                f32x16 s[2];
                qk_tile<true>(st, qf, s, lane);
                half8 vf[4];
                pv_load<0>(st + 8192, vf, lane);
                issue();
                __builtin_amdgcn_sched_barrier(0);
                if (64 * j + 64 > nvlo) {
#pragma unroll
                    for (int kt = 0; kt < 2; ++kt)
#pragma unroll
                        for (int e = 0; e < 16; ++e) {
                            const int key = 64 * j + 32 * kt + 8 * (e >> 2) + 4 * h + (e & 3);
                            if (key >= nvr) s[kt][e] = NEGS;
                        }
                }
                (void)sm_fast(s);
                if (cur >= 16) {
#pragma unroll
                    for (int kt = 0; kt < 2; ++kt)
#pragma unroll
                        for (int g4 = 0; g4 < 4; ++g4) {
                            float G = ((s[kt][4 * g4] + s[kt][4 * g4 + 1]) + (s[kt][4 * g4 + 2] + s[kt][4 * g4 + 3])) * invl;
                            float L = s[kt][4 * g4 + 3] * invl;
                            G += __shfl_xor(G, 1); G += __shfl_xor(G, 2);
                            L += __shfl_xor(L, 1); L += __shfl_xor(L, 2);
                            if (head == 0) {
                                const int sb = 16 * j + 8 * kt + 2 * g4 + h;
                                atomicAdd(&IMP[tokl * 128 + sb], G);
                                if (sb + 1 < 128) atomicAdd(&IMP[tokl * 128 + sb + 1], L);
                            }
                        }
                }
                pv_finish(st + 8192, vf, s, o, lane);
            });
        } else {
        float m = -1e20f, lsum = 0.f;
        nsa_pipe<3>(src, ntile, smem, w, lane, [&](int j, const char* st, auto&& issue) {
            f32x16 s[2];
            qk_tile(st, qf, s, lane);
            issue();
#pragma unroll
            for (int kt = 0; kt < 2; ++kt)
#pragma unroll
                for (int e = 0; e < 16; ++e) {
                    const int key = 64 * j + 32 * kt + 8 * (e >> 2) + 4 * h + (e & 3);
                    if (key >= nvr) s[kt][e] = NEGS;
                }
            const float mn = fmaxf(m, rowmax32(s)), alpha = ex2(m - mn);
            float rs = 0.f;
#pragma unroll
            for (int kt = 0; kt < 2; ++kt)
#pragma unroll
                for (int e = 0; e < 16; ++e) rs += ex2(s[kt][e] - mn);
            rs = xhalf_sum(rs);
            lsum = lsum * alpha + rs; m = mn;
        });
        const float invl_s = lsum > 0.f ? 1.f / lsum : 0.f;
        nsa_pipe<3>(src, ntile, smem, w, lane, [&](int j, const char* st, auto&& issue) {
            f32x16 s[2];
            qk_tile(st, qf, s, lane);
            half8 vf[4];
            pv_load<0>(st + 8192, vf, lane);
            issue();
            __builtin_amdgcn_sched_barrier(0);
#pragma unroll
            for (int kt = 0; kt < 2; ++kt)
#pragma unroll
                for (int e = 0; e < 16; ++e) {
                    const int key = 64 * j + 32 * kt + 8 * (e >> 2) + 4 * h + (e & 3);
                    s[kt][e] = (key < nvr) ? ex2(s[kt][e] - m) * invl_s : 0.f;
                }
            if (cur >= 16) {
#pragma unroll
                for (int kt = 0; kt < 2; ++kt)
#pragma unroll
                    for (int g4 = 0; g4 < 4; ++g4) {
                        float G = (s[kt][4 * g4] + s[kt][4 * g4 + 1]) + (s[kt][4 * g4 + 2] + s[kt][4 * g4 + 3]);
                        float L = s[kt][4 * g4 + 3];
                        G += __shfl_xor(G, 1); G += __shfl_xor(G, 2);
                        L += __shfl_xor(L, 1); L += __shfl_xor(L, 2);
                        if (head == 0) {
                            const int sb = 16 * j + 8 * kt + 2 * g4 + h;
                            atomicAdd(&IMP[tokl * 128 + sb], G);
                            if (sb + 1 < 128) atomicAdd(&IMP[tokl * 128 + sb + 1], L);
                        }
                    }
            }
            pv_finish(st + 8192, vf, s, o, lane);
        });
            invl = 1.f;
        }
        oacc_add(o, g0 * invl, true);
    }
    __syncthreads();
    {
        const int tl = lane >> 3, sub = lane & 7;
        unsigned bits = 0;
        unsigned u[16];
        if (cur >= 16) {
            const float* ip = IMP + (w * 8 + tl) * 128 + sub * 16;
#pragma unroll
            for (int i = 0; i < 16; ++i) {
                const int s = sub * 16 + i;
                u[i] = (s >= 1 && s <= cur - 2) ? (__float_as_uint(ip[i]) + 1u) : 0u;
            }
        }
        __syncthreads();
        if (cur >= 16) {
            unsigned prefix = 0;
            for (int bit = 30; bit >= 0; --bit) {
                const unsigned cand = prefix | (1u << bit);
                int cnt = 0;
#pragma unroll
                for (int i = 0; i < 16; ++i) cnt += (u[i] >= cand) ? 1 : 0;
                cnt += __shfl_xor(cnt, 1); cnt += __shfl_xor(cnt, 2); cnt += __shfl_xor(cnt, 4);
                if (cnt >= 13) prefix = cand;
            }
            int cgt = 0, ceq = 0;
#pragma unroll
            for (int i = 0; i < 16; ++i) { cgt += (u[i] > prefix) ? 1 : 0; ceq += (u[i] == prefix) ? 1 : 0; }
            cgt += __shfl_xor(cgt, 1); cgt += __shfl_xor(cgt, 2); cgt += __shfl_xor(cgt, 4);
            int inc = ceq;
            { const int v = __shfl_up(inc, 1); if (sub >= 1) inc += v; }
            { const int v = __shfl_up(inc, 2); if (sub >= 2) inc += v; }
            { const int v = __shfl_up(inc, 4); if (sub >= 4) inc += v; }
            int run = inc - ceq;
            const int need = 13 - cgt;
#pragma unroll
            for (int i = 0; i < 16; ++i) {
                const int s = sub * 16 + i;
                bool sel = u[i] > prefix;
                if (u[i] == prefix) { sel = run < need; ++run; }
                if (s == 0 || s == cur || s == cur - 1) sel = true;
                bits |= (sel ? 1u : 0u) << i;
            }
        } else {
#pragma unroll
            for (int i = 0; i < 16; ++i) bits |= ((sub * 16 + i <= cur) ? 1u : 0u) << i;
        }
        unsigned wv = bits << ((sub & 1) * 16);
        wv |= __shfl_xor(wv, 1);
        if ((sub & 1) == 0) SELM[(w * 8 + tl) * 4 + (sub >> 1)] = wv;
    }
    __syncthreads();
    unsigned selw[4];
#pragma unroll
    for (int i = 0; i < 4; ++i) selw[i] = SELM[tokl * 4 + i];

    auto branch = [&](auto BRC) {
        constexpr int br = decltype(BRC)::value;
        const int j0 = (br == 0) ? 0 : (cur - 8 > 0 ? cur - 8 : 0);
        const int nst = cur - j0 + 1;
        KVSrc src{proj + ((size_t)b * SEQ + (size_t)j0 * 64) * D_IN + C_NKV + (br == 0 ? 256 : 512) + g * 64, D_IN, (size_t)64 * D_IN,
                  (const h16*)(P->ws + OFF_VTG) + (((size_t)br * 4 + bg) * 128 + j0) * 4096};
        float m = -1e20f, lsum = 0.f;
        f32x16 o[2];
#pragma unroll
        for (int e = 0; e < 16; ++e) { o[0][e] = 0.f; o[1][e] = 0.f; }
        nsa_pipe<4>(src, nst, smem, w, lane, [&](int jj, const char* st, auto&& issue) {
            const int j = j0 + jj;
            const bool rowok = (br != 0) || (((selw[j >> 5] >> (j & 31)) & 1u) != 0u);
            if constexpr (FAST && br == 0) {
                if (!__any(rowok)) { issue(); return; }
            }
            f32x16 s[2];
            qk_tile<FAST>(st, qf, s, lane);
            half8 vf[4];
            pv_load<0>(st + 8192, vf, lane);
            issue();
            __builtin_amdgcn_sched_barrier(0);
            if (j == cur || (br == 1 && j == cur - 8)) {
#pragma unroll
                for (int kt = 0; kt < 2; ++kt)
#pragma unroll
                    for (int e = 0; e < 16; ++e) {
                        const int key = 64 * j + 32 * kt + 8 * (e >> 2) + 4 * h + (e & 3);
                        const bool ok = (key <= t) && (br == 0 || key > t - 512);
                        if (!ok) s[kt][e] = NEGS;
                    }
            }
            if constexpr (FAST) {
                const float rs = sm_fast(s);
                lsum += (br != 0 || rowok) ? rs : 0.f;
                pv_finish<br == 0>(st + 8192, vf, s, o, lane, rowok ? 0xffffffffu : 0u);
            } else {
                sm_online(s, m, lsum, o, rowok);
                pv_finish(st + 8192, vf, s, o, lane);
            }
        });
        if constexpr (FAST) lsum = xhalf_sum(lsum);
        const float sc = (br == 0 ? g1 : g2) / lsum;
        oacc_add(o, sc, false);
    };
    branch(IC<0>{});
    branch(IC<1>{});
    {
        h16* mixp = (h16*)(P->ws + OFF_MIX) + kb_idx(NT, tokg, 512 + ghead * 64);
        const h16* ngp = proj + tokg * D_IN + C_NG + ghead * 64;
#pragma unroll
        for (int dt = 0; dt < 2; ++dt)
#pragma unroll
            for (int g4 = 0; g4 < 4; ++g4) {
                const int d0 = 32 * dt + 8 * g4 + 4 * h;
                const half4 ng = *(const half4*)(ngp + d0);
                half4 ov;
#pragma unroll
                for (int e = 0; e < 4; ++e) ov[e] = (h16)((float)oacc[dt * 2 + (g4 >> 1)][(g4 & 1) * 4 + e] * siluf_((float)ng[e]));
                *(half4*)(mixp + d0) = ov;
            }
    }
    __syncthreads();
}

DI void glu_tile(PP P, int l, int tile, char* smem, const int wv) {
    P = plaunder(P);
    const int mt = tile >> 2, nt = tile & 3;
    f32x4 acc[4][4];
    float ssd[4];
    gemm_mainloop_glds<false>(wv, 256, APlain{(const h16*)(P->ws + OFF_YACT) + (size_t)mt * 128 * 256, 256, 64},
                              (const h16*)(P->ws + OFF_WTGLU) + ((size_t)l * 512 + nt * 128) * 256, 256, acc, ssd, smem);
    const int tid = otid(wv), lane = tid & 63, wid = tid >> 6, wr = wid >> 1, wc = wid & 1;
    const h16* proj = (const h16*)(P->ws + OFF_PROJ);
    h16* mix = (h16*)(P->ws + OFF_MIX);
    const float* gb = P->in[I_GLUB] + l * 512;
#pragma unroll
    for (int i = 0; i < 4; ++i) {
        const size_t tok = (size_t)mt * 128 + wr * 64 + i * 16 + (lane & 15);
#pragma unroll
        for (int pj = 0; pj < 2; ++pj) {
            const int c = nt * 64 + wc * 32 + pj * 16 + (lane >> 4) * 4;
            const f32x4 z1 = acc[i][2 * pj], z2 = acc[i][2 * pj + 1];
            const float4 b1 = *(const float4*)(gb + c), b2 = *(const float4*)(gb + 256 + c);
            const half4 g4 = *(const half4*)(proj + tok * D_IN + C_SG + c);
            half4 o;
            o[0] = (h16)((z1[0] + b1.x) * sigmoidf_(z2[0] + b2.x) * siluf_((float)g4[0]));
            o[1] = (h16)((z1[1] + b1.y) * sigmoidf_(z2[1] + b2.y) * siluf_((float)g4[1]));
            o[2] = (h16)((z1[2] + b1.z) * sigmoidf_(z2[2] + b2.z) * siluf_((float)g4[2]));
            o[3] = (h16)((z1[3] + b1.w) * sigmoidf_(z2[3] + b2.w) * siluf_((float)g4[3]));
            *(half4*)(mix + kb_idx(NT, tok, 256 + c)) = o;
        }
    }
}

DI void outproj_tile(PP P, int l, int mt, int nt, char* smem, const int wv) {
    P = plaunder(P);
    f32x4 acc[4][4];
    float ssd[4];
    gemm_glds<false, 2, 4, 4>(wv, 1024, APlain{(const h16*)(P->ws + OFF_MIX) + (size_t)mt * 128 * 64, 64, (size_t)NT * 64},
                              (const h16*)(P->ws + OFF_WTOUT) + ((size_t)l * 16 * 1024 + nt * 128) * 64, 64, acc, ssd, smem, (size_t)1024 * 64);
    const int tid = otid(wv), lane = tid & 63, wid = tid >> 6, wr = wid >> 1, wc = wid & 1;
    const float* xin = (l == 0) ? P->in[I_X] : P->out;
    h16* xh = (h16*)(P->ws + OFF_XH);
#pragma unroll
    for (int i = 0; i < 4; ++i) {
        const size_t row = (size_t)mt * 128 + wr * 64 + i * 16 + (lane & 15);
#pragma unroll
        for (int jj = 0; jj < 4; ++jj) {
            const int n = nt * 128 + wc * 64 + jj * 16 + (lane >> 4) * 4;
            const f32x4 v = acc[i][jj];
            const float4 xo = *(const float4*)(xin + row * 1024 + n);
            const float4 xn = (float4){xo.x + v[0], xo.y + v[1], xo.z + v[2], xo.w + v[3]};
            *(float4*)(P->out + row * 1024 + n) = xn;
            *(half4*)(xh + kb_idx(NT, row, n)) = (half4){(h16)xn.x, (h16)xn.y, (h16)xn.z, (h16)xn.w};
        }
    }
}

#define XB_TMO      128
#define XB_XCNT(j)  (256  + 64 * (j))
#define XB_XSUB(j)  (1280 + 64 * (j))
#define XB_XGEN(j)  (2304 + 64 * (j))
#define XB_TOP      3328
#define XB_TOPGEN   3392
#define XCD_BAR_WORDS 3456
#define XB_SPIN_CAP (1u << 18)
#define LAS __attribute__((address_space(3)))

__device__ __forceinline__ unsigned xb_ld(unsigned* p)              { return __hip_atomic_load(p, __ATOMIC_RELAXED, __HIP_MEMORY_SCOPE_AGENT); }
__device__ __forceinline__ unsigned xb_add(unsigned* p, unsigned v) { return __hip_atomic_fetch_add(p, v, __ATOMIC_RELAXED, __HIP_MEMORY_SCOPE_AGENT); }
__device__ __forceinline__ unsigned xb_xcc_id() { return (unsigned)__builtin_amdgcn_s_getreg((3 << 11) | 20) & 0xFu; }
#define XB_SPIN(cond, bar) do { unsigned _sp = 0; while (cond) { __builtin_amdgcn_s_sleep(1); \
    if ((++_sp & 255u) == 0u) { if (xb_ld(&(bar)[XB_TMO])) break; if (_sp > XB_SPIN_CAP) { atomicAdd(&(bar)[XB_TMO], 1u); break; } } } } while (0)

struct XcdBarrier {
    unsigned* bar; unsigned x;
    volatile LAS unsigned* st;
};

__device__ __forceinline__ XcdBarrier xcd_barrier_post(unsigned* bar, volatile LAS unsigned* st) {
    XcdBarrier b; b.bar = bar; b.x = xb_xcc_id(); b.st = st;
    if (threadIdx.x == 0) (void)xb_add(&bar[XB_XCNT(b.x)], 1u);
    return b;
}
__device__ __forceinline__ void xcd_barrier_complete(unsigned* bar, unsigned x, unsigned& nloc, unsigned& nx) {
    const unsigned G = gridDim.x * gridDim.y * gridDim.z;
    unsigned sum, cnt, mine, sp = 0u;
    for (;;) {
        sum = 0u; cnt = 0u; mine = 0u;
#pragma unroll
        for (unsigned j = 0; j < 16; ++j) { const unsigned c = xb_ld(&bar[XB_XCNT(j)]); sum += c; cnt += (c > 0u) ? 1u : 0u; mine = (j == x) ? c : mine; }
        if (sum == G) break;
        __builtin_amdgcn_s_sleep(1);
        if ((++sp & 255u) == 0u) { if (xb_ld(&bar[XB_TMO])) break; if (sp > XB_SPIN_CAP) { atomicAdd(&bar[XB_TMO], 1u); break; } }
    }
    nloc = mine > 0u ? mine : 1u; nx = cnt > 0u ? cnt : 1u;
}

__device__ __forceinline__ void xcd_barrier(const XcdBarrier& b) {
    asm volatile("s_waitcnt vmcnt(0)" ::: "memory");
    __syncthreads();
    if (threadIdx.x == 0) {
        unsigned* bar = b.bar;
        __builtin_amdgcn_s_waitcnt(0);
        unsigned nloc = b.st[0], nx = b.st[1];
        if (nloc == 0u) { xcd_barrier_complete(bar, b.x, nloc, nx); b.st[0] = nloc; b.st[1] = nx; }
        const unsigned old = xb_add(&bar[XB_XSUB(b.x)], 1u);
        const unsigned gen = old / nloc;
        if (old + 1u == (gen + 1u) * nloc) {
            __builtin_amdgcn_fence(__ATOMIC_RELEASE, "agent");
            asm volatile("s_waitcnt vmcnt(0)" ::: "memory");
            const unsigned og = xb_add(&bar[XB_TOP], 1u);
            const unsigned tg = og / nx;
            if (og + 1u == (tg + 1u) * nx) xb_add(&bar[XB_TOPGEN], 1u);
            else XB_SPIN(xb_ld(&bar[XB_TOPGEN]) == tg, bar);
            __builtin_amdgcn_fence(__ATOMIC_ACQUIRE, "agent");
            xb_add(&bar[XB_XGEN(b.x)], 1u);
            asm volatile("s_waitcnt vmcnt(0)" ::: "memory");
        } else {
            XB_SPIN(xb_ld(&bar[XB_XGEN(b.x)]) == gen, bar);
            __builtin_amdgcn_fence(__ATOMIC_ACQUIRE, "agent");
            asm volatile("s_waitcnt vmcnt(0)" ::: "memory");
        }
    }
    __syncthreads();
}


__global__ void __launch_bounds__(NTHREADS, 2) fwd_megakernel(Params Pval) {
    PP P = (PP)__builtin_amdgcn_kernarg_segment_ptr();
    extern __shared__ __attribute__((aligned(16))) char smem[];
    cg::grid_group grid = cg::this_grid();
    const int G = gridDim.x, bid = blockIdx.x;
    const int wv = __builtin_amdgcn_readfirstlane((int)(threadIdx.x >> 6));

    uint4& xb_words = *(uint4*)(smem + SMEM_MAIN);
    if (otid(wv) == 0) xb_words = make_uint4(0u, 0u, 0u, 0u);
    if (bid == 0) for (int i = otid(wv); i < XCD_BAR_WORDS + 16; i += NTHREADS) ((unsigned*)(P->ws + OFF_BAR))[i] = 0u;
    phase0(P, smem, wv);
    grid.sync();
    const XcdBarrier xb = xcd_barrier_post((unsigned*)(P->ws + OFF_BAR), (volatile LAS unsigned*)(smem + SMEM_MAIN));
    int vxcd = bid & 7, vjx = bid >> 3;
    {
        unsigned* xcnt = (unsigned*)(P->ws + OFF_BAR) + XCD_BAR_WORDS;
        volatile LAS unsigned* lw = (volatile LAS unsigned*)(smem + SMEM_MAIN) + 2;
        if (otid(wv) == 0) lw[0] = xb.x < 8u ? xb_add(&xcnt[xb.x], 1u) : 0xffffu;
        xcd_barrier(xb);
        if (otid(wv) == 0) {
            bool ok = (G & 7) == 0 && xb.x < 8u;
            for (int j = 0; j < 8; ++j) ok = ok && (xb_ld(&xcnt[j]) == (unsigned)(G >> 3));
            lw[1] = ok ? 1u : 0u;
        }
        __syncthreads();
        if (lw[1]) { vxcd = (int)xb.x; vjx = (int)lw[0]; }
    }
    vxcd = __builtin_amdgcn_readfirstlane(vxcd); vjx = __builtin_amdgcn_readfirstlane(vjx);

#pragma unroll 1
    for (int l = 0; l < DEPTH; ++l) {
        {
            const int xcd = vxcd, jx = vjx, nper = G >> 3;
            for (int u = jx; u < 384; u += nper) {
                const int mh = u / 192, rem = u - mh * 192;
                inproj_tile<2, 4>(P, l, (xcd * 16 + mh * 8 + (rem & 7)) * 128, (rem >> 3) * 128, smem, wv);
            }
            for (int it = jx; it < 16 + 40; it += nper) {
                if (it < 16) inproj_tile<4, 2>(P, l, (xcd * 16 + it) * 128, 3072, smem, wv);
                else s5_build_item(P, l, (it - 16) * 8 + xcd, smem, wv);
            }
        }
        xcd_barrier(xb);
#pragma unroll 1
        for (int w = bid; w < 128 + 64 + 2048; w += G) {
            if (w < 128) cmp_gemm_tile(P, l, w, smem, wv);
            else if (w < 192) s5e_gemm_tile(P, l, w - 128, smem, wv);
            else gla_kv_item(P, l, w - 192, smem, wv);
        }
        xcd_barrier(xb);
#pragma unroll 1
        for (int w = bid; w < 512 + 512 + 64; w += G) {
            if (w < 512) cmp_l2_item(P, l, w, smem, wv);
            else if (w < 1024) gla_scan_item(P, w - 512, smem, wv);
            else s5_scan_item(P, w - 1024, smem, wv);
        }
        xcd_barrier(xb);
        bool nsa_fast;
        {
            const int ln = otid(wv) & 63;
            const float gq = wave_max(fabsf(P->in[I_NQN][l * 64 + ln]));
            const float gk = wave_max(fmaxf(fmaxf(fabsf(P->in[I_NKN][(l * 3 + 0) * 64 + ln]), fabsf(P->in[I_NKN][(l * 3 + 1) * 64 + ln])), fabsf(P->in[I_NKN][(l * 3 + 2) * 64 + ln])));
            nsa_fast = __builtin_amdgcn_readfirstlane((8.f * 1.4426950408889634f * gq * gk - FAST_SHIFT < 15.f) ? 1 : 0) != 0;
        }
#pragma unroll 1
        for (int w0 = bid; w0 < 512 + 256 + 2048; w0 += G) {
            const int w = w0 < G ? vjx * 8 + vxcd : w0;
            if (w < 512) {
                const int bg = w & 3, q = w >> 2;
                if (nsa_fast) { nsa_unit<true>(P, l, bg, 255 - q, smem, wv); nsa_unit<true>(P, l, bg, q, smem, wv); }
                else { nsa_unit<false>(P, l, bg, 255 - q, smem, wv); nsa_unit<false>(P, l, bg, q, smem, wv); }
            } else if (w < 512 + 256) s5o_gemm_tile(P, l, w - 512, smem, wv);
            else gla_out_item(P, l, w - 512 - 256, smem, wv);
        }
        xcd_barrier(xb);
#pragma unroll 1
        for (int w = bid; w < 512; w += G) glu_tile(P, l, w, smem, wv);
        xcd_barrier(xb);
        {
            const int xcd = vxcd, jx = vjx, nper = G >> 3;
            for (int u = jx; u < 128; u += nper) outproj_tile(P, l, xcd * 16 + (u >> 6) * 8 + (u & 7), (u & 63) >> 3, smem, wv);
        }
        xcd_barrier(xb);
    }
}

extern "C" void kernel_launch(void* const* d_in, const int* in_sizes, int n_in, void* d_out, int out_size, void* d_ws,
                              size_t ws_size, hipStream_t stream) {
    static int grid_blocks = 0;
    if (!grid_blocks) {
        int dev = 0, cus = 0, per_cu = 0;
        hipGetDevice(&dev);
        hipDeviceGetAttribute(&cus, hipDeviceAttributeMultiprocessorCount, dev);
        hipFuncSetAttribute((const void*)fwd_megakernel, hipFuncAttributeMaxDynamicSharedMemorySize, SMEM_BYTES);
        hipOccupancyMaxActiveBlocksPerMultiprocessor(&per_cu, fwd_megakernel, NTHREADS, SMEM_BYTES);
        if (per_cu < 1) per_cu = 1;
        if (per_cu > 2) per_cu = 2;
        grid_blocks = cus * per_cu;
        if (ws_size < WS_END) fprintf(stderr, "kernel_launch: workspace too small: %zu < %zu\n", ws_size, (size_t)WS_END);
    }
    Params p{};
    for (int i = 0; i < 25; ++i) p.in[i] = (const float*)d_in[i];
    p.out = (float*)d_out;
    p.ws = (char*)d_ws;
    void* args[] = {&p};
    hipError_t e = hipLaunchCooperativeKernel((const void*)fwd_megakernel, dim3(grid_blocks), dim3(NTHREADS), args, SMEM_BYTES, stream);
    if (e != hipSuccess) fprintf(stderr, "cooperative launch failed: %s (grid %d)\n", hipGetErrorString(e), grid_blocks);
}
```

```cpp
#include <hip/hip_runtime.h>
#include <hip/hip_cooperative_groups.h>
#include <cstdio>
#include <cstdint>
namespace cg = cooperative_groups;

typedef _Float16 h16;
typedef _Float16 half8 __attribute__((ext_vector_type(8)));
typedef _Float16 half4 __attribute__((ext_vector_type(4)));
typedef float f32x4 __attribute__((ext_vector_type(4)));
typedef float f32x16 __attribute__((ext_vector_type(16)));

#define DI __device__ __forceinline__

constexpr int D_MODEL = 1024, BATCH = 2, SEQ = 8192, DEPTH = 4, NT = BATCH * SEQ;
constexpr int D_IN = 3112, D_IN_PAD = 3200;
constexpr int C_NQ = 0, C_NKV = 512, C_NG = 1280, C_GQ = 1792, C_GK = 1920, C_GV = 2048, C_GG = 2304, C_SU = 2560, C_SG = 2816,
              C_GLR = 3072, C_NGL = 3088;
__host__ __device__ constexpr int map_col(int c) {
    return c < 128 ? C_GQ + c : c < 256 ? C_GK + (c - 128) : c < 512 ? C_GV + (c - 256) : c < 528 ? C_GLR + (c - 512)
         : c < 784 ? C_GG + (c - 528) : c < 1040 ? C_SU + (c - 784) : c < 1296 ? C_SG + (c - 1040) : c < 1808 ? C_NQ + (c - 1296)
         : c < 2576 ? C_NKV + (c - 1808) : c < 2600 ? C_NGL + (c - 2576) : c < 3112 ? C_NG + (c - 2600) : c;
}
constexpr int NTHREADS = 256;
constexpr float QSCALE = 0.125f * 1.4426950408889634f;

enum { I_X = 0, I_NORMG, I_WIN, I_GW2, I_GB2, I_GON, I_LRE, I_LIM, I_LSTEP, I_BRE, I_BIM, I_CRE, I_CIM, I_SD, I_GLUW, I_GLUB,
       I_NGB, I_NQN, I_NKN, I_CPOS, I_CW1, I_CB1, I_CW2, I_CB2, I_WOUT };

constexpr size_t OFF_WTIN  = 0;
constexpr size_t OFF_WTOUT = OFF_WTIN  + 4ull * D_IN_PAD * 1024 * 2;
constexpr size_t OFF_WTGLU = OFF_WTOUT + 4ull * 1024 * 1024 * 2;
constexpr size_t OFF_WTC1  = OFF_WTGLU + 4ull * 512 * 256 * 2;
constexpr size_t OFF_PROJ  = OFF_WTC1  + 4ull * 2 * 256 * 2048 * 2;
constexpr size_t OFF_MIX   = OFF_PROJ  + (size_t)NT * D_IN * 2;
constexpr size_t OFF_YACT  = OFF_MIX   + (size_t)NT * 1024 * 2;
constexpr size_t OFF_XH    = OFF_YACT;
constexpr size_t OFF_BCUM  = OFF_YACT  + (size_t)NT * 256 * 2;
constexpr size_t OFF_GKV   = OFF_BCUM  + (size_t)NT * 128 * 4;
constexpr size_t OFF_GDEC  = OFF_GKV   + 8ull * 256 * 2048 * 4;
static_assert(OFF_GDEC - OFF_XH >= (size_t)NT * 1024 * 2, "XH alias region too small");
constexpr size_t OFF_XC    = OFF_GDEC  + 8ull * 256 * 32 * 4;
constexpr size_t OFF_S5W   = OFF_XC    + 512ull * 1024 * 2 * 4;
constexpr size_t OFF_S5E   = OFF_S5W   + 16ull * 512 * 640 * 2;
constexpr size_t OFF_S5AL  = OFF_S5E   + 16ull * 128 * 512 * 2;
constexpr size_t OFF_CHID  = OFF_S5AL  + 1024ull * 2 * 4;
constexpr size_t OFF_POSB  = OFF_CHID  + 2ull * 2048 * 512 * 4;
constexpr size_t OFF_XCH   = OFF_POSB  + 8ull * 16 * 256 * 4;
constexpr size_t OFF_KCMP  = OFF_XCH   + 512ull * 2048 * 2;
constexpr size_t OFF_VCMP  = OFF_KCMP  + 4ull * 512 * 64 * 2;
constexpr size_t OFF_VTG   = OFF_VCMP  + 4ull * 512 * 64 * 2;
constexpr size_t OFF_BAR   = OFF_VTG   + 2ull * 4 * 128 * 4096 * 2;
constexpr size_t WS_END    = OFF_BAR   + 16384;

struct Params {
    const float* in[25];
    float* out;
    char* ws;
};

__host__ __device__ constexpr size_t kb_idx(size_t nrows, size_t row, int k) { return (((size_t)(k >> 6)) * nrows + row) * 64 + (k & 63); }
typedef const __attribute__((address_space(4))) Params* PP;
DI PP plaunder(PP p) { asm volatile("" : "+s"(p)); return p; }
constexpr int SMEM_MAIN = 65536;
constexpr int SMEM_BYTES = SMEM_MAIN + 16;

DI int otid(const int wv) { int t = wv * 64 + (int)__builtin_amdgcn_mbcnt_hi(~0u, __builtin_amdgcn_mbcnt_lo(~0u, 0u)); asm volatile("" : "+v"(t)); return t; }
DI float wave_sum(float v) {
#pragma unroll
    for (int o = 32; o > 0; o >>= 1) v += __shfl_xor(v, o);
    return v;
}
DI float wave_max(float v) {
#pragma unroll
    for (int o = 32; o > 0; o >>= 1) v = fmaxf(v, __shfl_xor(v, o));
    return v;
}
DI float sigmoidf_(float x) { return 1.f / (1.f + __expf(-x)); }
DI float siluf_(float x) { return x / (1.f + __expf(-x)); }
DI float gelu_tanh(float x) {
    const float u = 0.7978845608028654f * (x + 0.044715f * x * x * x);
    return 0.5f * x * (1.f + tanhf(u));
}
DI float log_sigmoidf_(float x) { return fminf(x, 0.f) - log1pf(__expf(-fabsf(x))); }

typedef _Float16 half2_ __attribute__((ext_vector_type(2)));
DI void glds16(const h16* g, char* l) {
    __builtin_amdgcn_global_load_lds((const __attribute__((address_space(1))) void*)g, (__attribute__((address_space(3))) void*)l, 16, 0, 0);
}
struct APlain { const h16* A; size_t lda, astep; DI const h16* operator()(int row, int kt, int c8) const { return A + (size_t)row * lda + (size_t)kt * astep + c8 * 8; } };
struct AS5 {
    const h16* ubase;
    const h16* xin;
    int ch0;
    DI const h16* operator()(int row, int kt, int c8) const {
        const size_t ch = (size_t)(ch0 + row);
        return kt < 8 ? ubase + (ch * 32 + 4 * kt + (c8 >> 1)) * D_IN + (c8 & 1) * 8 : xin + ch * 2048 + (kt - 8) * 64 + c8 * 8;
    }
};
template <int N> DI void gwaitbar();
#define GWB_DEF(N) template <> DI void gwaitbar<N>() { asm volatile("s_waitcnt vmcnt(" #N ") lgkmcnt(0)\n\ts_barrier" ::: "memory"); }
GWB_DEF(0) GWB_DEF(3) GWB_DEF(4) GWB_DEF(6) GWB_DEF(8)
template <bool SUMSQ, int WR, int MI, int NJ, class AF>
DI void gemm_glds(const int wv, const int K, const AF& afn, const h16* __restrict__ Bt, const int ldb,
                  f32x4 (&acc)[MI][NJ], float (&ss)[MI], char* smem, const size_t bstep = 64) {
    constexpr int WC = 4 / WR, BM = WR * MI * 16, BN = WC * NJ * 16, AQ = BM / 64, BQ = BN / 64, NG = AQ + BQ, SB = (BM + BN) * 64;
    static_assert(4 * SB <= SMEM_MAIN && AQ >= 1 && BQ >= 1, "ring does not fit the LDS");
    const int tid = otid(wv), lane = tid & 63, wid = tid >> 6, wr = wid / WC, wc = wid % WC;
#pragma unroll
    for (int i = 0; i < MI; ++i) {
        ss[i] = 0.f;
#pragma unroll
        for (int j = 0; j < NJ; ++j) acc[i][j] = (f32x4){0.f, 0.f, 0.f, 0.f};
    }
    const int lrow = wid * 16 + (lane >> 2);
    const int lc4 = (lane & 3) ^ ((-(lrow >> 2)) & 3);
    const h16* bp = Bt + (size_t)lrow * ldb + lc4 * 8;
    char* lbase = smem + wid * 1024;
    const int fr = lane & 15, fq = lane >> 4, sw = (-(fr >> 2)) & 3;
    const int aoff0 = (wr * MI * 16 + fr) * 64 + ((fq ^ sw) * 16);
    const int boff0 = BM * 64 + (wc * NJ * 16 + fr) * 64 + ((fq ^ sw) * 16);
    const int nt = K >> 5;
    auto issue = [&](const int t, char* stage) {
        const int kt = t >> 1, hb = (t & 1) * 4;
#pragma unroll
        for (int q = 0; q < AQ; ++q) glds16(afn(lrow + 64 * q, kt, hb + lc4), stage + q * 4096);
#pragma unroll
        for (int q = 0; q < BQ; ++q) glds16(bp + (size_t)q * 64 * ldb + (size_t)kt * bstep + hb * 8, stage + BM * 64 + q * 4096);
    };
    auto compute = [&](const char* st) {
        half8 af[MI], bf[NJ];
#pragma unroll
        for (int i = 0; i < MI; ++i) af[i] = *(const half8*)(st + aoff0 + i * 1024);
#pragma unroll
        for (int j = 0; j < NJ; ++j) bf[j] = *(const half8*)(st + boff0 + j * 1024);
        if (SUMSQ) {
#pragma unroll
            for (int i = 0; i < MI; ++i)
#pragma unroll
                for (int e = 0; e < 4; ++e) {
                    const half2_ x = (half2_){af[i][2 * e], af[i][2 * e + 1]};
                    ss[i] = __builtin_amdgcn_fdot2(x, x, ss[i], false);
                }
        }
#pragma unroll
        for (int i = 0; i < MI; ++i)
#pragma unroll
            for (int j = 0; j < NJ; ++j) acc[i][j] = __builtin_amdgcn_mfma_f32_16x16x32_f16(bf[j], af[i], acc[i][j], 0, 0, 0);
    };
#define GEMM_STEP(S, t) do { if ((t) + 2 < nt) gwaitbar<NG>(); else gwaitbar<0>();                                  \
        if ((t) + 3 < nt) issue((t) + 3, lbase + (((S) + 3) & 3) * SB); compute(smem + (S) * SB); } while (0)
    gwaitbar<0>();
    {
        const int k = nt < 3 ? nt : 3;
        for (int p = 0; p < k; ++p) issue(p, lbase + p * SB);
        if (k >= 3) gwaitbar<2 * NG>(); else if (k == 2) gwaitbar<NG>(); else gwaitbar<0>();
        __builtin_amdgcn_s_sleep(2);
    }
#pragma unroll 1
    for (int t = 0; t < nt; t += 4) {
        GEMM_STEP(0, t);
        if (t + 1 < nt) GEMM_STEP(1, t + 1);
        if (t + 2 < nt) GEMM_STEP(2, t + 2);
        if (t + 3 < nt) GEMM_STEP(3, t + 3);
    }
#undef GEMM_STEP
    asm volatile("s_waitcnt lgkmcnt(0)\n\ts_barrier" ::: "memory");
    if (SUMSQ) {
#pragma unroll
        for (int i = 0; i < MI; ++i) { ss[i] += __shfl_xor(ss[i], 16); ss[i] += __shfl_xor(ss[i], 32); }
    }
}
template <bool SUMSQ, class AF>
DI void gemm_mainloop_glds(const int wv, const int K, const AF& afn, const h16* __restrict__ Bt, const int ldb, f32x4 (&acc)[4][4], float (&ss)[4], char* smem, const size_t bstep = 64) {
    gemm_glds<SUMSQ, 2, 4, 4>(wv, K, afn, Bt, ldb, acc, ss, smem, bstep);
}

DI int glu_perm_dst(int c_orig) {
    const int which = c_orig >> 8, c = c_orig & 255;
    return (c >> 6) * 128 + ((c >> 5) & 1) * 64 + (((c >> 4) & 1) * 2 + which) * 16 + (c & 15);
}
template <int MAP, int KB>
DI void transpose64(const float* __restrict__ src, int R, int C, h16* __restrict__ dst, int r0, int c0,
                    const float* __restrict__ rscale, char* smem, const int wv) {
    h16* tile = (h16*)smem;
    const int tid = otid(wv);
    {
        const int r = tid >> 2, cq = (tid & 3) * 16;
        const float sc = rscale ? rscale[r0 + r] : 1.f;
        const float* sp = src + (size_t)(r0 + r) * C + c0 + cq;
#pragma unroll
        for (int q = 0; q < 4; ++q) {
            float4 v = (float4){0.f, 0.f, 0.f, 0.f};
            if (c0 + cq + q * 4 < C) v = *(const float4*)(sp + q * 4);
            *(half4*)(tile + r * 72 + cq + q * 4) = (half4){(h16)(v.x * sc), (h16)(v.y * sc), (h16)(v.z * sc), (h16)(v.w * sc)};
        }
    }
    __syncthreads();
    {
        const int c = tid >> 2, rq = (tid & 3) * 16;
        half8 o0, o1;
#pragma unroll
        for (int k = 0; k < 8; ++k) { o0[k] = tile[(rq + k) * 72 + c]; o1[k] = tile[(rq + 8 + k) * 72 + c]; }
        const int cc = c0 + c;
        const int dr = MAP == 1 ? map_col(cc) : MAP == 2 ? glu_perm_dst(cc) : cc;
        h16* dp = KB ? dst + ((size_t)(r0 >> 6) * KB + dr) * 64 + rq : dst + (size_t)dr * R + r0 + rq;
        *(half8*)dp = o0; *(half8*)(dp + 8) = o1;
    }
    __syncthreads();
}

DI void phase0(PP P, char* smem, const int wv) {
    P = plaunder(P);
    constexpr int N_WIN = 4 * 16 * 50, N_WOUT = 4 * 16 * 16, N_C1 = 16 * 16 * 4, N_GLU = 4 * 4 * 8, N_XH = NT * 1024 / 2048, N_PB = 8 * 16;
    const int total = N_WIN + N_WOUT + N_C1 + N_GLU + N_XH + N_PB;
    for (int w = blockIdx.x; w < total; w += gridDim.x) {
        if (w < N_WIN) {
            const int l = w / 800, r = w % 800, rt = r / 50, ct = r % 50;
            transpose64<1, D_IN_PAD>(P->in[I_WIN] + (size_t)l * 1024 * D_IN, 1024, D_IN, (h16*)(P->ws + OFF_WTIN) + (size_t)l * D_IN_PAD * 1024,
                           rt * 64, ct * 64, P->in[I_NORMG] + l * 1024, smem, wv);
        } else if (w < N_WIN + N_WOUT) {
            const int v = w - N_WIN, l = v >> 8, r = v & 255, rt = r >> 4, ct = r & 15;
            transpose64<0, 1024>(P->in[I_WOUT] + (size_t)l * 1024 * 1024, 1024, 1024, (h16*)(P->ws + OFF_WTOUT) + (size_t)l * 1024 * 1024,
                           rt * 64, ct * 64, nullptr, smem, wv);
        } else if (w < N_WIN + N_WOUT + N_C1) {
            const int v = w - N_WIN - N_WOUT, ljh = v >> 6, r = v & 63, rt = r >> 2, ct = r & 3;
            transpose64<0, 512>(P->in[I_CW1] + (size_t)ljh * 1024 * 256, 1024, 256, (h16*)(P->ws + OFF_WTC1) + ((size_t)(ljh >> 1) * 16 * 512 + (ljh & 1) * 256) * 64,
                           rt * 64, ct * 64, nullptr, smem, wv);
        } else if (w < N_WIN + N_WOUT + N_C1 + N_GLU) {
            const int v = w - N_WIN - N_WOUT - N_C1, l = v >> 5, r = v & 31, rt = r >> 3, ct = r & 7;
            transpose64<2, 0>(P->in[I_GLUW] + (size_t)l * 256 * 512, 256, 512, (h16*)(P->ws + OFF_WTGLU) + (size_t)l * 512 * 256,
                           rt * 64, ct * 64, nullptr, smem, wv);
        } else if (w < N_WIN + N_WOUT + N_C1 + N_GLU + N_XH) {
            const size_t e0 = ((size_t)(w - N_WIN - N_WOUT - N_C1 - N_GLU) * 256 + otid(wv)) * 8;
            const float4 a = *(const float4*)(P->in[I_X] + e0), b = *(const float4*)(P->in[I_X] + e0 + 4);
            *(half8*)((h16*)(P->ws + OFF_XH) + kb_idx(NT, e0 >> 10, (int)(e0 & 1023))) = (half8){(h16)a.x, (h16)a.y, (h16)a.z, (h16)a.w, (h16)b.x, (h16)b.y, (h16)b.z, (h16)b.w};
        } else {
            const int v = w - (N_WIN + N_WOUT + N_C1 + N_GLU + N_XH), lj = v >> 4, ks = v & 15, n = otid(wv);
            const float* w1 = P->in[I_CW1] + ((size_t)lj * 2048 + ks * 128) * 256 + n;
            const float* pp = P->in[I_CPOS] + (size_t)lj * 2048 + ks * 128;
            float a = ks == 0 ? P->in[I_CB1][lj * 256 + n] : 0.f;
#pragma unroll 16
            for (int k = 0; k < 128; ++k) a += pp[k] * w1[(size_t)k * 256];
            ((float*)(P->ws + OFF_POSB))[(lj * 16 + ks) * 256 + n] = a;
        }
    }
}

DI void s5_build_item(PP P, int l, int item, char* smem, const int wv) {
    P = plaunder(P);
    float* apow = (float*)smem;
    float* bbar = apow + 64 * 33 * 2;
    float* cc   = bbar + 64 * 16 * 2;
    const int tid = otid(wv);
    const int g = (item < 256) ? (item >> 4) : ((item - 256) >> 2);
    if (tid < 64) {
        const int p = tid;
        const float lre = fminf(P->in[I_LRE][(l * 16 + g) * 64 + p], -1e-4f);
        const float lim = P->in[I_LIM][(l * 16 + g) * 64 + p];
        const float dt = expf(P->in[I_LSTEP][l * 16 + g]);
        const float x = lre * dt, y = lim * dt;
        const float em1 = expm1f(x), cy = cosf(y), sy = sinf(y), sh = sinf(0.5f * y);
        const float ar = (em1 + 1.f) * cy, ai = (em1 + 1.f) * sy;
        const float dr = em1 * cy - 2.f * sh * sh, di = ai;
        const float den = lre * lre + lim * lim;
        const float fr = (dr * lre + di * lim) / den;
        const float fi = (di * lre - dr * lim) / den;
        float pr = 1.f, pi = 0.f;
        for (int k = 0; k <= 32; ++k) {
            apow[(p * 33 + k) * 2] = pr; apow[(p * 33 + k) * 2 + 1] = pi;
            const float nr = pr * ar - pi * ai, ni = pr * ai + pi * ar; pr = nr; pi = ni;
        }
        for (int c = 0; c < 16; ++c) {
            const float br = P->in[I_BRE][((size_t)(l * 16 + g) * 64 + p) * 16 + c];
            const float bi = P->in[I_BIM][((size_t)(l * 16 + g) * 64 + p) * 16 + c];
            bbar[(p * 16 + c) * 2] = fr * br - fi * bi;
            bbar[(p * 16 + c) * 2 + 1] = fr * bi + fi * br;
        }
    }
    for (int e = tid; e < 1024; e += 256) {
        cc[e * 2] = P->in[I_CRE][(size_t)(l * 16 + g) * 1024 + e];
        cc[e * 2 + 1] = P->in[I_CIM][(size_t)(l * 16 + g) * 1024 + e];
    }
    __syncthreads();
    if (item < 256) {
        const int c = item & 15;
        float* kt = cc + 2048;
        for (int idx = tid; idx < 512; idx += 256) {
            const int lag = idx >> 4, c2 = idx & 15;
            float a = 0.f;
            for (int p = 0; p < 64; ++p) {
                const float cr = cc[(c * 64 + p) * 2], ci = cc[(c * 64 + p) * 2 + 1];
                const float xr = apow[(p * 33 + lag) * 2], xi = apow[(p * 33 + lag) * 2 + 1];
                const float br = bbar[(p * 16 + c2) * 2], bi = bbar[(p * 16 + c2) * 2 + 1];
                const float tr = cr * xr - ci * xi, ti = cr * xi + ci * xr;
                a += tr * br - ti * bi;
            }
            kt[idx] = a;
        }
        __syncthreads();
        h16* W = (h16*)(P->ws + OFF_S5W) + (size_t)g * 512 * 640;
        for (int idx = tid; idx < 32 * 640; idx += 256) {
            const int j = idx / 640, k = idx % 640;
            float val = 0.f;
            if (k < 512) {
                const int s = k >> 4, c2 = k & 15, lag = j - s;
                if (lag >= 0) val = kt[lag * 16 + c2];
            } else {
                const int p = (k - 512) >> 1;
                const float cr = cc[(c * 64 + p) * 2], ci = cc[(c * 64 + p) * 2 + 1];
                const float xr = apow[(p * 33 + j + 1) * 2], xi = apow[(p * 33 + j + 1) * 2 + 1];
                val = (k & 1) ? -(cr * xi + ci * xr) : (cr * xr - ci * xi);
            }
            W[(size_t)(j * 16 + c) * 640 + k] = (h16)val;
        }
    } else {
        const int pq = (item - 256) & 3;
        h16* E = (h16*)(P->ws + OFF_S5E) + ((size_t)g * 128 + pq * 32) * 512;
        for (int idx = tid; idx < 32 * 512; idx += 256) {
            const int nl = idx >> 9, k = idx & 511;
            const int p = pq * 16 + (nl >> 1), s = k >> 4, c2 = k & 15;
            const float xr = apow[(p * 33 + 31 - s) * 2], xi = apow[(p * 33 + 31 - s) * 2 + 1];
            const float br = bbar[(p * 16 + c2) * 2], bi = bbar[(p * 16 + c2) * 2 + 1];
            const float val = (nl & 1) ? (xr * bi + xi * br) : (xr * br - xi * bi);
            E[(size_t)nl * 512 + k] = (h16)val;
        }
        if (tid < 16) {
            const int p = pq * 16 + tid;
            float* AL = (float*)(P->ws + OFF_S5AL);
            AL[(g * 64 + p) * 2] = apow[(p * 33 + 32) * 2];
            AL[(g * 64 + p) * 2 + 1] = apow[(p * 33 + 32) * 2 + 1];
        }
    }
    __syncthreads();
}

template <int WR, int MI>
DI void inproj_tile(PP P, int l, int m0, int n0, char* smem, const int wv) {
    P = plaunder(P);
    constexpr int WC = 4 / WR;
    f32x4 acc[MI][4];
    float ss[MI];
    gemm_glds<true, WR, MI, 4>(wv, 1024, APlain{(const h16*)(P->ws + OFF_XH) + (size_t)m0 * 64, 64, (size_t)NT * 64},
                               (const h16*)(P->ws + OFF_WTIN) + ((size_t)l * 16 * D_IN_PAD + n0) * 64, 64, acc, ss, smem, (size_t)D_IN_PAD * 64);
    const int tid = otid(wv), lane = tid & 63, wid = tid >> 6, wr = wid / WC, wc = wid % WC;
    h16* proj = (h16*)(P->ws + OFF_PROJ);
    const int n64 = n0 + wc * 64;
    int cls = 0;
    if (n64 < 512) cls = 1;
    else if (n64 >= C_NKV + 256 && n64 < C_NKV + 384) cls = 2;
    else if (n64 >= C_NKV + 512 && n64 < C_NKV + 640) cls = 3;
    else if (n64 >= C_NKV + 384 && n64 < C_NKV + 512) cls = 4;
    else if (n64 >= C_NKV + 640 && n64 < C_NKV + 768) cls = 5;
    float wn[4][4];
    if (cls >= 1 && cls <= 3) {
        const float* wp = (cls == 1) ? P->in[I_NQN] + l * 64 : P->in[I_NKN] + (l * 3 + (cls - 1)) * 64;
        const float sc = (cls == 1) ? QSCALE : 1.f;
#pragma unroll
        for (int j = 0; j < 4; ++j) {
            const float4 w4 = *(const float4*)(wp + j * 16 + (lane >> 4) * 4);
            wn[j][0] = w4.x * sc; wn[j][1] = w4.y * sc; wn[j][2] = w4.z * sc; wn[j][3] = w4.w * sc;
        }
    }
#pragma unroll
    for (int i = 0; i < MI; ++i) {
        const int ml = wr * MI * 16 + i * 16 + (lane & 15);
        const float r = rsqrtf(ss[i] * (1.f / 1024.f) + 1e-6f);
        const size_t row = (size_t)m0 + ml;
        f32x4 v[4];
#pragma unroll
        for (int j = 0; j < 4; ++j) v[j] = acc[i][j] * r;
        if (cls >= 1 && cls <= 3) {
            float s2 = 0.f;
#pragma unroll
            for (int j = 0; j < 4; ++j) s2 += v[j][0] * v[j][0] + v[j][1] * v[j][1] + v[j][2] * v[j][2] + v[j][3] * v[j][3];
            s2 += __shfl_xor(s2, 16); s2 += __shfl_xor(s2, 32);
            const float rn = rsqrtf(s2 * (1.f / 64.f) + 1e-6f);
#pragma unroll
            for (int j = 0; j < 4; ++j) { v[j][0] *= rn * wn[j][0]; v[j][1] *= rn * wn[j][1]; v[j][2] *= rn * wn[j][2]; v[j][3] *= rn * wn[j][3]; }
        }
        if (cls >= 4) {
            const int g = (n64 >> 6) & 1, br = cls - 4;
            const int b = (int)(row >> 13), t = (int)(row & 8191);
            h16* vt = (h16*)(P->ws + OFF_VTG) + ((((size_t)br * 4 + b * 2 + g) * 128 + (t >> 6)) * 64) * 64 + (t & 63);
#pragma unroll
            for (int j = 0; j < 4; ++j)
#pragma unroll
                for (int e = 0; e < 4; ++e) vt[(j * 16 + (lane >> 4) * 4 + e) * 64] = (h16)v[j][e];
        }
#pragma unroll
        for (int j = 0; j < 4; ++j) {
            const int n = n64 + j * 16 + (lane >> 4) * 4;
            if (n < D_IN) *(half4*)(proj + row * D_IN + n) = (half4){(h16)v[j][0], (h16)v[j][1], (h16)v[j][2], (h16)v[j][3]};
        }
        __builtin_amdgcn_sched_barrier(0);
    }
    __syncthreads();
}


DI void cmp_gemm_tile(PP P, int l, int tile, char* smem, const int wv) {
    P = plaunder(P);
    const int j = tile >> 6, mt = (tile >> 2) & 15, nt = tile & 3;
    const int row0 = mt * 128, bg = row0 >> 9, i0 = row0 & 511, b = bg >> 1, g = bg & 1;
    f32x4 acc[4][4];
    float ssd[4];
    gemm_mainloop_glds<false>(wv, 1024, APlain{(const h16*)(P->ws + OFF_PROJ) + ((size_t)b * SEQ + 16 * i0) * D_IN + C_NKV + j * 128 + g * 64, (size_t)16 * D_IN, (size_t)D_IN},
                              (const h16*)(P->ws + OFF_WTC1) + ((size_t)(l * 2 + j) * 16 * 512 + nt * 128) * 64, 64, acc, ssd, smem, (size_t)512 * 64);
    const int tid = otid(wv), lane = tid & 63, wid = tid >> 6, wr = wid >> 1, wc = wid & 1;
    float* pt = (float*)(P->ws + OFF_CHID) + (size_t)j * 2048 * 512;
#pragma unroll
    for (int i = 0; i < 4; ++i) {
        const size_t row = (size_t)row0 + wr * 64 + i * 16 + (lane & 15);
#pragma unroll
        for (int jj = 0; jj < 4; ++jj) {
            const int n = nt * 128 + wc * 64 + jj * 16 + (lane >> 4) * 4;
            const f32x4 v = acc[i][jj];
            *(float4*)(pt + row * 512 + n) = (float4){v[0], v[1], v[2], v[3]};
        }
    }
}

DI void s5e_gemm_tile(PP P, int l, int tile, char* smem, const int wv) {
    P = plaunder(P);
    const int g = tile >> 2, mt = tile & 3;
    f32x4 acc[4][4];
    float ssd[4];
    gemm_mainloop_glds<false>(wv, 512, AS5{(const h16*)(P->ws + OFF_PROJ) + C_SU + g * 16, nullptr, mt * 128},
                              (const h16*)(P->ws + OFF_S5E) + (size_t)g * 128 * 512, 512, acc, ssd, smem);
    const int tid = otid(wv), lane = tid & 63, wid = tid >> 6, wr = wid >> 1, wc = wid & 1;
    float* xc = (float*)(P->ws + OFF_XC);
#pragma unroll
    for (int i = 0; i < 4; ++i) {
        const size_t ch = (size_t)mt * 128 + wr * 64 + i * 16 + (lane & 15);
#pragma unroll
        for (int jj = 0; jj < 4; ++jj) {
            const int n = wc * 64 + jj * 16 + (lane >> 4) * 4;
            const f32x4 v = acc[i][jj];
            *(float4*)(xc + (ch * 1024 + g * 64) * 2 + n) = (float4){v[0], v[1], v[2], v[3]};
        }
    }
}

DI void gla_scan_item(PP P, int item, char* smem, const int wv) {
    P = plaunder(P);
    const int tid = otid(wv), sl = tid & 31, part = tid >> 5;
    const int idx = item * 32 + sl, bh = idx >> 11, de = idx & 2047, d = de >> 6;
    float* kv = (float*)(P->ws + OFF_GKV) + ((size_t)bh * 256 + part * 32) * 2048 + de;
    const float* dc = (const float*)(P->ws + OFF_GDEC) + ((size_t)bh * 256 + part * 32) * 32 + d;
    float* sD = (float*)smem; float* sL = sD + 256;
    float kvv[32], dd[32];
#pragma unroll
    for (int i = 0; i < 32; ++i) { kvv[i] = kv[(size_t)i * 2048]; dd[i] = dc[i * 32]; }
    float D = 1.f, L = 0.f;
#pragma unroll
    for (int i = 0; i < 32; ++i) { L = dd[i] * L + kvv[i]; D *= dd[i]; }
    sD[part * 32 + sl] = D; sL[part * 32 + sl] = L;
    __syncthreads();
    float S = 0.f;
    for (int q = 0; q < part; ++q) S = sD[q * 32 + sl] * S + sL[q * 32 + sl];
#pragma unroll
    for (int i = 0; i < 32; ++i) { const float o = S; S = dd[i] * S + kvv[i]; kv[(size_t)i * 2048] = o; }
    __syncthreads();
}
DI void s5_scan_item(PP P, int item, char* smem, const int wv) {
    P = plaunder(P);
    const int tid = otid(wv), sl = tid & 31, part = tid >> 5;
    const int idx = item * 32 + sl, b = idx >> 10, s = idx & 1023;
    float2* xc = (float2*)(P->ws + OFF_XC) + ((size_t)b * 256 + part * 32) * 1024 + s;
    half2_* xch = (half2_*)(P->ws + OFF_XCH) + ((size_t)b * 256 + part * 32) * 1024 + s;
    const float2 a = ((const float2*)(P->ws + OFF_S5AL))[s];
    float2* sL = (float2*)smem;
    float2 c[32];
#pragma unroll
    for (int i = 0; i < 32; ++i) c[i] = xc[(size_t)i * 1024];
    float lr = 0.f, li = 0.f;
#pragma unroll
    for (int i = 0; i < 32; ++i) { const float nr = a.x * lr - a.y * li + c[i].x, ni = a.x * li + a.y * lr + c[i].y; lr = nr; li = ni; }
    float dr = a.x, di = a.y;
#pragma unroll
    for (int i = 0; i < 5; ++i) { const float nr = dr * dr - di * di, ni = 2.f * dr * di; dr = nr; di = ni; }
    sL[part * 32 + sl] = (float2){lr, li};
    __syncthreads();
    float xr = 0.f, xi = 0.f;
    for (int q = 0; q < part; ++q) { const float2 lq = sL[q * 32 + sl]; const float nr = dr * xr - di * xi + lq.x, ni = dr * xi + di * xr + lq.y; xr = nr; xi = ni; }
#pragma unroll
    for (int i = 0; i < 32; ++i) {
        const float2 o = (float2){xr, xi};
        const float nr = a.x * xr - a.y * xi + c[i].x, ni = a.x * xi + a.y * xr + c[i].y; xr = nr; xi = ni;
        xc[(size_t)i * 1024] = o;
        xch[(size_t)i * 1024] = (half2_){(h16)o.x, (h16)o.y};
    }
    __syncthreads();
}
DI void cmp_l2_item(PP P, int l, int item, char* smem, const int wv) {
    P = plaunder(P);
    const int tid = otid(wv), lane = tid & 63, w = tid >> 6;
    const int j = item >> 8, r0 = (item & 255) * 8;
    h16* w2s = (h16*)smem;
    float* hs = (float*)(smem + 32768);
    {
        const float* w2 = P->in[I_CW2] + (size_t)(l * 2 + j) * 256 * 64;
        for (int e = tid * 4; e < 256 * 64; e += 1024) {
            const float4 v = *(const float4*)(w2 + e);
            *(half4*)(w2s + e) = (half4){(h16)v.x, (h16)v.y, (h16)v.z, (h16)v.w};
        }
        const float* pt = (const float*)(P->ws + OFF_CHID) + (size_t)j * 2048 * 512;
        float pb = 0.f;
#pragma unroll
        for (int ks = 0; ks < 16; ++ks) pb += ((const float*)(P->ws + OFF_POSB))[((l * 2 + j) * 16 + ks) * 256 + tid];
#pragma unroll
        for (int rr = 0; rr < 8; ++rr) {
            const int row = r0 + rr, i = row & 511;
            float v = 0.f;
            if (i < 511) v = gelu_tanh(pt[(size_t)row * 512 + tid] + pt[(size_t)(row + 1) * 512 + 256 + tid] + pb);
            hs[rr * 256 + tid] = v;
        }
    }
    __syncthreads();
    const float bb = P->in[I_CB2][(l * 2 + j) * 64 + lane];
    float a0 = bb, a1 = bb;
    const float* h0 = hs + (2 * w) * 256, *h1 = h0 + 256;
#pragma unroll 8
    for (int n = 0; n < 256; ++n) {
        const float wv = (float)w2s[n * 64 + lane];
        a0 += h0[n] * wv; a1 += h1[n] * wv;
    }
#pragma unroll
    for (int rr = 0; rr < 2; ++rr) {
        float acc = rr ? a1 : a0;
        const int row = r0 + 2 * w + rr, bg = row >> 9, i = row & 511;
        if (i == 511) acc = 0.f;
        if (j == 0) {
            const float ss = wave_sum(acc * acc);
            acc = acc * rsqrtf(ss * (1.f / 64.f) + 1e-6f) * P->in[I_NKN][(l * 3 + 0) * 64 + lane];
            ((h16*)(P->ws + OFF_KCMP))[(size_t)row * 64 + lane] = (h16)acc;
        } else {
            ((h16*)(P->ws + OFF_VCMP))[(((size_t)bg * 8 + (i >> 6)) * 64 + lane) * 64 + (i & 63)] = (h16)acc;
        }
    }
    __syncthreads();
}

DI void s5o_gemm_tile(PP P, int l, int tile, char* smem, const int wv) {
    P = plaunder(P);
    const int g = tile >> 5, mt = (tile >> 3) & 3, nt = tile & 7;
    f32x4 acc[2][4];
    float ssd[2];
    gemm_glds<false, 4, 2, 4>(wv, 640, AS5{(const h16*)(P->ws + OFF_PROJ) + C_SU + g * 16, (const h16*)(P->ws + OFF_XCH) + g * 128, mt * 128},
                              (const h16*)(P->ws + OFF_S5W) + ((size_t)g * 512 + nt * 64) * 640, 640, acc, ssd, smem);
    const int tid = otid(wv), lane = tid & 63, wid = tid >> 6;
    const h16* proj = (const h16*)(P->ws + OFF_PROJ);
    h16* yact = (h16*)(P->ws + OFF_YACT);
#pragma unroll
    for (int i = 0; i < 2; ++i) {
        const size_t ch = (size_t)mt * 128 + wid * 32 + i * 16 + (lane & 15);
#pragma unroll
        for (int jj = 0; jj < 4; ++jj) {
            const int n = nt * 64 + jj * 16 + (lane >> 4) * 4;
            const int j = n >> 4, c = n & 15;
            const size_t tok = ch * 32 + j;
            const half4 u4 = *(const half4*)(proj + tok * D_IN + C_SU + g * 16 + c);
            const float4 dd = *(const float4*)(P->in[I_SD] + (l * 16 + g) * 16 + c);
            const f32x4 v = acc[i][jj];
            half4 o;
            o[0] = (h16)gelu_tanh(v[0] + dd.x * (float)u4[0]);
            o[1] = (h16)gelu_tanh(v[1] + dd.y * (float)u4[1]);
            o[2] = (h16)gelu_tanh(v[2] + dd.z * (float)u4[2]);
            o[3] = (h16)gelu_tanh(v[3] + dd.w * (float)u4[3]);
            *(half4*)(yact + tok * 256 + g * 16 + c) = o;
        }
    }
}

#define MFMA32(a, b, c) __builtin_amdgcn_mfma_f32_32x32x16_f16((a), (b), (c), 0, 0, 0)
constexpr float FAST_SHIFT = 4.f;
constexpr float NEGS = -1e30f;
DI float ex2(float x) { return __builtin_amdgcn_exp2f(x); }
#define NSA_WAITBAR(N) asm volatile("s_waitcnt vmcnt(" #N ") lgkmcnt(0)\n\ts_barrier" ::: "memory")
#define NSA_BAR() asm volatile("s_waitcnt lgkmcnt(0)\n\ts_barrier" ::: "memory")

struct KVSrc { const h16* k; int ldk; size_t kstep; const h16* v; };
DI void nsa_dma(const KVSrc& s, int j, char* stage, int wid, int lane) {
    const int row0 = wid * 8 + (lane >> 3);
    const int sw = ((lane & 7) ^ ((row0 >> 1) & 7)) * 8;
    const h16* kp = s.k + (size_t)j * s.kstep + (size_t)row0 * s.ldk + sw;
    glds16(kp, stage + wid * 1024);
    glds16(kp + (size_t)32 * s.ldk, stage + 4096 + wid * 1024);
    const h16* vp = s.v + (size_t)j * 4096 + row0 * 64 + sw;
    glds16(vp, stage + 8192 + wid * 1024);
    glds16(vp + 32 * 64, stage + 8192 + 4096 + wid * 1024);
}
template <int NST, class F>
DI void nsa_pipe(const KVSrc& s, const int n, char* smem, int wid, int lane, F&& compute) {
    NSA_WAITBAR(0);
    {
        const int k = n < NST - 1 ? n : NST - 1;
        for (int p = 0; p < k; ++p) nsa_dma(s, p, smem + p * 16384, wid, lane);
        if (k >= 3) NSA_WAITBAR(8); else if (k == 2) NSA_WAITBAR(4); else NSA_WAITBAR(0);
    }
    for (int j = 0; j < n; ++j) {
        if (NST == 4 && j + 2 < n) NSA_WAITBAR(4); else NSA_WAITBAR(0);
        const int jn = j + NST - 1;
        compute(j, smem + (j % NST) * 16384, [&]() { if (jn < n) nsa_dma(s, jn, smem + (jn % NST) * 16384, wid, lane); });
    }
}

template <bool SHIFT = false>
DI void qk_tile(const char* Kimg, const half8 (&qf)[4], f32x16 (&s)[2], int lane) {
    const int r = lane & 31, h = lane >> 5, swz = (r >> 1) & 7;
    const char* base = Kimg + r * 128;
#pragma unroll
    for (int kt = 0; kt < 2; ++kt) {
        half8 kf[4];
#pragma unroll
        for (int ks = 0; ks < 4; ++ks) kf[ks] = *(const half8*)(base + kt * 4096 + (((2 * ks + h) ^ swz) << 4));
#pragma unroll
        for (int e = 0; e < 16; ++e) s[kt][e] = SHIFT ? -FAST_SHIFT : 0.f;
#pragma unroll
        for (int ks = 0; ks < 4; ++ks) s[kt] = MFMA32(kf[ks], qf[ks], s[kt]);
    }
}
template <int S> DI half8 pack8(const f32x16& x) {
    return (half8){(h16)x[8 * S], (h16)x[8 * S + 1], (h16)x[8 * S + 2], (h16)x[8 * S + 3], (h16)x[8 * S + 4], (h16)x[8 * S + 5], (h16)x[8 * S + 6], (h16)x[8 * S + 7]};
}
DI half8 ld_vfrag(const char* Vimg, int off0) {
    const half4 lo = *(const half4*)(Vimg + off0), hi = *(const half4*)(Vimg + (off0 ^ 16));
    return (half8){lo[0], lo[1], lo[2], lo[3], hi[0], hi[1], hi[2], hi[3]};
}
template <int KT>
DI void pv_load(const char* Vimg, half8 (&vf)[4], int lane) {
    const int r = lane & 31, h = lane >> 5, swz16 = ((r >> 1) & 7) << 4;
    const char* rb = Vimg + r * 128 + 8 * h;
#pragma unroll
    for (int dt = 0; dt < 2; ++dt) {
        vf[dt * 2 + 0] = ld_vfrag(rb + dt * 4096, ((4 * KT) << 4) ^ swz16);
        vf[dt * 2 + 1] = ld_vfrag(rb + dt * 4096, ((4 * KT + 2) << 4) ^ swz16);
    }
}
typedef unsigned u32x4_ __attribute__((ext_vector_type(4)));
template <int KT, bool MASKED = false>
DI void pv_mma(const half8 (&vf)[4], const f32x16 (&p)[2], f32x16 (&o)[2], const unsigned rmask = 0xffffffffu) {
    half8 pb0 = pack8<0>(p[KT]), pb1 = pack8<1>(p[KT]);
    if (MASKED) {
        pb0 = __builtin_bit_cast(half8, __builtin_bit_cast(u32x4_, pb0) & rmask);
        pb1 = __builtin_bit_cast(half8, __builtin_bit_cast(u32x4_, pb1) & rmask);
    }
#pragma unroll
    for (int dt = 0; dt < 2; ++dt) {
        o[dt] = MFMA32(vf[dt * 2 + 0], pb0, o[dt]);
        o[dt] = MFMA32(vf[dt * 2 + 1], pb1, o[dt]);
    }
}
template <bool MASKED = false>
DI void pv_finish(const char* Vimg, const half8 (&va)[4], const f32x16 (&p)[2], f32x16 (&o)[2], int lane, const unsigned rmask = 0xffffffffu) {
    half8 vb[4];
    pv_load<1>(Vimg, vb, lane);
    pv_mma<0, MASKED>(va, p, o, rmask);
    pv_mma<1, MASKED>(vb, p, o, rmask);
}
DI float sm_fast(f32x16 (&s)[2]) {
    float rs = 0.f;
#pragma unroll
    for (int kt = 0; kt < 2; ++kt)
#pragma unroll
        for (int e = 0; e < 16; ++e) { const float p = ex2(s[kt][e]); s[kt][e] = p; rs += p; }
    return rs;
}
DI float xhalf_max(float v) {
    const auto r = __builtin_amdgcn_permlane32_swap(__float_as_uint(v), __float_as_uint(v), false, false);
    return fmaxf(__uint_as_float(r[0]), __uint_as_float(r[1]));
}
DI float xhalf_sum(float v) {
    const auto r = __builtin_amdgcn_permlane32_swap(__float_as_uint(v), __float_as_uint(v), false, false);
    return __uint_as_float(r[0]) + __uint_as_float(r[1]);
}
DI float rowmax32(const f32x16 (&s)[2]) {
    float mx = s[0][0];
#pragma unroll
    for (int e = 1; e < 16; ++e) mx = fmaxf(mx, s[0][e]);
#pragma unroll
    for (int e = 0; e < 16; ++e) mx = fmaxf(mx, s[1][e]);
    return xhalf_max(mx);
}
constexpr float SM_THR = 6.f;
DI void sm_online(f32x16 (&s)[2], float& m, float& l, f32x16 (&o)[2], const bool rowok) {
    float mx = rowmax32(s);
    mx = rowok ? mx : NEGS;
    if (__any(mx > m + SM_THR)) {
        const float mn = fmaxf(m, mx), alpha = ex2(m - mn);
        l *= alpha; o[0] *= alpha; o[1] *= alpha; m = mn;
    }
    const float msub = rowok ? m : 1e30f;
    float rs = 0.f;
#pragma unroll
    for (int kt = 0; kt < 2; ++kt)
#pragma unroll
        for (int e = 0; e < 16; ++e) { const float p = ex2(s[kt][e] - msub); s[kt][e] = p; rs += p; }
    l += xhalf_sum(rs);
}

template <int V> struct IC { static constexpr int value = V; };
template <bool FAST>
DI void nsa_unit(PP P, int l, int bg, int c32, char* smem, const int wv) {
    P = plaunder(P);
    const int tid = otid(wv), lane = tid & 63, w = tid >> 6, r = lane & 31, h = lane >> 5;
    const int b = bg >> 1, g = bg & 1, t0 = c32 * 32, cur = c32 >> 1;
    const int tokl = w * 8 + (r >> 2), head = r & 3, t = t0 + tokl;
    const size_t tokg = (size_t)b * SEQ + t;
    float* IMP = (float*)(smem + 49152);
    unsigned* SELM = (unsigned*)(smem + 49152);
    const h16* proj = (const h16*)(P->ws + OFF_PROJ);
    const int ghead = g * 4 + head;

    half8 qf[4];
    {
        const h16* qp = proj + tokg * D_IN + C_NQ + ghead * 64 + 8 * h;
#pragma unroll
        for (int ks = 0; ks < 4; ++ks) qf[ks] = *(const half8*)(qp + 16 * ks);
    }
    float g0, g1, g2;
    {
        const h16* gp = proj + tokg * D_IN + C_NGL + ghead * 3;
        const float* gb = P->in[I_NGB] + l * 24 + ghead * 3;
        g0 = sigmoidf_((float)gp[0] + gb[0]); g1 = sigmoidf_((float)gp[1] + gb[1]); g2 = sigmoidf_((float)gp[2] + gb[2]);
    }
    __syncthreads();
    for (int i = tid; i < 32 * 128; i += 256) IMP[i] = 0.f;

    half8 oacc[4];
    auto oacc_add = [&](const f32x16 (&o)[2], const float sc, const bool first) {
#pragma unroll
        for (int dt = 0; dt < 2; ++dt)
#pragma unroll
            for (int hf = 0; hf < 2; ++hf) {
                half8 v = oacc[dt * 2 + hf];
#pragma unroll
                for (int e = 0; e < 8; ++e) v[e] = (h16)((first ? 0.f : (float)v[e]) + o[dt][hf * 8 + e] * sc);
                oacc[dt * 2 + hf] = v;
            }
    };

    {
        const int nvt = 2 * c32 + 1;
        const int nvr = (t >= 31) ? ((t - 31) >> 4) + 1 : 0;
        const int ntile = (nvt + 63) >> 6;
        KVSrc src{(const h16*)(P->ws + OFF_KCMP) + (size_t)bg * 512 * 64, 64, 4096, (const h16*)(P->ws + OFF_VCMP) + (size_t)bg * 8 * 4096};
        f32x16 o[2];
#pragma unroll
        for (int e = 0; e < 16; ++e) { o[0][e] = 0.f; o[1][e] = 0.f; }
        float invl;
        if constexpr (FAST) {
            const int tf = t0 + w * 8;
            const int nvlo = __builtin_amdgcn_readfirstlane((tf >= 31) ? ((tf - 31) >> 4) + 1 : 0);
            float lsum = 0.f;
            nsa_pipe<3>(src, ntile, smem, w, lane, [&](int j, const char* st, auto&& issue) {
                f32x16 s[2];
                qk_tile<true>(st, qf, s, lane);
                issue();
                if (64 * j + 64 > nvlo) {
#pragma unroll
                    for (int kt = 0; kt < 2; ++kt)
#pragma unroll
                        for (int e = 0; e < 16; ++e) {
                            const int key = 64 * j + 32 * kt + 8 * (e >> 2) + 4 * h + (e & 3);
                            if (key >= nvr) s[kt][e] = NEGS;
                        }
                }
                lsum += sm_fast(s);
            });
            lsum = xhalf_sum(lsum);
            invl = lsum > 0.f ? 1.f / lsum : 0.f;
            nsa_pipe<3>(src, ntile, smem, w, lane, [&](int j, const char* st, auto&& issue) {
                f32x16 s[2];
                qk_tile<true>(st, qf, s, lane);
                half8 vf[4];
                pv_load<0>(st + 8192, vf, lane);
                issue();
                __builtin_amdgcn_sched_barrier(0);
                if (64 * j + 64 > nvlo) {
#pragma unroll
                    for (int kt = 0; kt < 2; ++kt)
#pragma unroll
                        for (int e = 0; e < 16; ++e) {
                            const int key = 64 * j + 32 * kt + 8 * (e >> 2) + 4 * h + (e & 3);
                            if (key >= nvr) s[kt][e] = NEGS;
                        }
                }
                (void)sm_fast(s);
                if (cur >= 16) {
#pragma unroll
                    for (int kt = 0; kt < 2; ++kt)
#pragma unroll
                        for (int g4 = 0; g4 < 4; ++g4) {
                            float G = ((s[kt][4 * g4] + s[kt][4 * g4 + 1]) + (s[kt][4 * g4 + 2] + s[kt][4 * g4 + 3])) * invl;
                            float L = s[kt][4 * g4 + 3] * invl;
                            G += __shfl_xor(G, 1); G += __shfl_xor(G, 2);
                            L += __shfl_xor(L, 1); L += __shfl_xor(L, 2);
                            if (head == 0) {
                                const int sb = 16 * j + 8 * kt + 2 * g4 + h;
                                atomicAdd(&IMP[tokl * 128 + sb], G);
                                if (sb + 1 < 128) atomicAdd(&IMP[tokl * 128 + sb + 1], L);
                            }
                        }
                }
                pv_finish(st + 8192, vf, s, o, lane);
            });
        } else {
        float m = -1e20f, lsum = 0.f;
        nsa_pipe<3>(src, ntile, smem, w, lane, [&](int j, const char* st, auto&& issue) {
            f32x16 s[2];
            qk_tile(st, qf, s, lane);
            issue();
#pragma unroll
            for (int kt = 0; kt < 2; ++kt)
#pragma unroll
                for (int e = 0; e < 16; ++e) {
                    const int key = 64 * j + 32 * kt + 8 * (e >> 2) + 4 * h + (e & 3);
                    if (key >= nvr) s[kt][e] = NEGS;
                }
            const float mn = fmaxf(m, rowmax32(s)), alpha = ex2(m - mn);
            float rs = 0.f;
#pragma unroll
            for (int kt = 0; kt < 2; ++kt)
#pragma unroll
                for (int e = 0; e < 16; ++e) rs += ex2(s[kt][e] - mn);
            rs = xhalf_sum(rs);
            lsum = lsum * alpha + rs; m = mn;
        });
        const float invl_s = lsum > 0.f ? 1.f / lsum : 0.f;
        nsa_pipe<3>(src, ntile, smem, w, lane, [&](int j, const char* st, auto&& issue) {
            f32x16 s[2];
            qk_tile(st, qf, s, lane);
            half8 vf[4];
            pv_load<0>(st + 8192, vf, lane);
            issue();
            __builtin_amdgcn_sched_barrier(0);
#pragma unroll
            for (int kt = 0; kt < 2; ++kt)
#pragma unroll
                for (int e = 0; e < 16; ++e) {
                    const int key = 64 * j + 32 * kt + 8 * (e >> 2) + 4 * h + (e & 3);
                    s[kt][e] = (key < nvr) ? ex2(s[kt][e] - m) * invl_s : 0.f;
                }
            if (cur >= 16) {
#pragma unroll
                for (int kt = 0; kt < 2; ++kt)
#pragma unroll
                    for (int g4 = 0; g4 < 4; ++g4) {
                        float G = (s[kt][4 * g4] + s[kt][4 * g4 + 1]) + (s[kt][4 * g4 + 2] + s[kt][4 * g4 + 3]);
                        float L = s[kt][4 * g4 + 3];
                        G += __shfl_xor(G, 1); G += __shfl_xor(G, 2);
                        L += __shfl_xor(L, 1); L += __shfl_xor(L, 2);
                        if (head == 0) {
                            const int sb = 16 * j + 8 * kt + 2 * g4 + h;
                            atomicAdd(&IMP[tokl * 128 + sb], G);
                            if (sb + 1 < 128) atomicAdd(&IMP[tokl * 128 + sb + 1], L);
                        }
                    }
            }
            pv_finish(st + 8192, vf, s, o, lane);
        });
            invl = 1.f;
        }
        oacc_add(o, g0 * invl, true);
    }
    __syncthreads();
    {
        const int tl = lane >> 3, sub = lane & 7;
        unsigned bits = 0;
        unsigned u[16];
        if (cur >= 16) {
            const float* ip = IMP + (w * 8 + tl) * 128 + sub * 16;
#pragma unroll
            for (int i = 0; i < 16; ++i) {
                const int s = sub * 16 + i;
                u[i] = (s >= 1 && s <= cur - 2) ? (__float_as_uint(ip[i]) + 1u) : 0u;
            }
        }
        __syncthreads();
        if (cur >= 16) {
            unsigned prefix = 0;
            for (int bit = 30; bit >= 0; --bit) {
                const unsigned cand = prefix | (1u << bit);
                int cnt = 0;
#pragma unroll
                for (int i = 0; i < 16; ++i) cnt += (u[i] >= cand) ? 1 : 0;
                cnt += __shfl_xor(cnt, 1); cnt += __shfl_xor(cnt, 2); cnt += __shfl_xor(cnt, 4);
                if (cnt >= 13) prefix = cand;
            }
            int cgt = 0, ceq = 0;
#pragma unroll
            for (int i = 0; i < 16; ++i) { cgt += (u[i] > prefix) ? 1 : 0; ceq += (u[i] == prefix) ? 1 : 0; }
            cgt += __shfl_xor(cgt, 1); cgt += __shfl_xor(cgt, 2); cgt += __shfl_xor(cgt, 4);
            int inc = ceq;
            { const int v = __shfl_up(inc, 1); if (sub >= 1) inc += v; }
            { const int v = __shfl_up(inc, 2); if (sub >= 2) inc += v; }
            { const int v = __shfl_up(inc, 4); if (sub >= 4) inc += v; }
            int run = inc - ceq;
            const int need = 13 - cgt;
#pragma unroll
            for (int i = 0; i < 16; ++i) {
                const int s = sub * 16 + i;
                bool sel = u[i] > prefix;
                if (u[i] == prefix) { sel = run < need; ++run; }
                if (s == 0 || s == cur || s == cur - 1) sel = true;
                bits |= (sel ? 1u : 0u) << i;
            }
        } else {
#pragma unroll
            for (int i = 0; i < 16; ++i) bits |= ((sub * 16 + i <= cur) ? 1u : 0u) << i;
        }
        unsigned wv = bits << ((sub & 1) * 16);
        wv |= __shfl_xor(wv, 1);
        if ((sub & 1) == 0) SELM[(w * 8 + tl) * 4 + (sub >> 1)] = wv;
    }
    __syncthreads();
    unsigned selw[4];
#pragma unroll
    for (int i = 0; i < 4; ++i) selw[i] = SELM[tokl * 4 + i];

    auto branch = [&](auto BRC) {
        constexpr int br = decltype(BRC)::value;
        const int j0 = (br == 0) ? 0 : (cur - 8 > 0 ? cur - 8 : 0);
        const int nst = cur - j0 + 1;
        KVSrc src{proj + ((size_t)b * SEQ + (size_t)j0 * 64) * D_IN + C_NKV + (br == 0 ? 256 : 512) + g * 64, D_IN, (size_t)64 * D_IN,
                  (const h16*)(P->ws + OFF_VTG) + (((size_t)br * 4 + bg) * 128 + j0) * 4096};
        float m = -1e20f, lsum = 0.f;
        f32x16 o[2];
#pragma unroll
        for (int e = 0; e < 16; ++e) { o[0][e] = 0.f; o[1][e] = 0.f; }
        nsa_pipe<4>(src, nst, smem, w, lane, [&](int jj, const char* st, auto&& issue) {
            const int j = j0 + jj;
            const bool rowok = (br != 0) || (((selw[j >> 5] >> (j & 31)) & 1u) != 0u);
            if constexpr (FAST && br == 0) {
                if (!__any(rowok)) { issue(); return; }
            }
            f32x16 s[2];
            qk_tile<FAST>(st, qf, s, lane);
            half8 vf[4];
            pv_load<0>(st + 8192, vf, lane);
            issue();
            __builtin_amdgcn_sched_barrier(0);
            if (j == cur || (br == 1 && j == cur - 8)) {
#pragma unroll
                for (int kt = 0; kt < 2; ++kt)
#pragma unroll
                    for (int e = 0; e < 16; ++e) {
                        const int key = 64 * j + 32 * kt + 8 * (e >> 2) + 4 * h + (e & 3);
                        const bool ok = (key <= t) && (br == 0 || key > t - 512);
                        if (!ok) s[kt][e] = NEGS;
                    }
            }
            if constexpr (FAST) {
                const float rs = sm_fast(s);
                lsum += (br != 0 || rowok) ? rs : 0.f;
                pv_finish<br == 0>(st + 8192, vf, s, o, lane, rowok ? 0xffffffffu : 0u);
            } else {
                sm_online(s, m, lsum, o, rowok);
                pv_finish(st + 8192, vf, s, o, lane);
            }
        });
        if constexpr (FAST) lsum = xhalf_sum(lsum);
        const float sc = (br == 0 ? g1 : g2) / lsum;
        oacc_add(o, sc, false);
    };
    branch(IC<0>{});
    branch(IC<1>{});
    {
        h16* mixp = (h16*)(P->ws + OFF_MIX) + kb_idx(NT, tokg, 512 + ghead * 64);
        const h16* ngp = proj + tokg * D_IN + C_NG + ghead * 64;
#pragma unroll
        for (int dt = 0; dt < 2; ++dt)
#pragma unroll
            for (int g4 = 0; g4 < 4; ++g4) {
                const int d0 = 32 * dt + 8 * g4 + 4 * h;
                const half4 ng = *(const half4*)(ngp + d0);
                half4 ov;
#pragma unroll
                for (int e = 0; e < 4; ++e) ov[e] = (h16)((float)oacc[dt * 2 + (g4 >> 1)][(g4 & 1) * 4 + e] * siluf_((float)ng[e]));
                *(half4*)(mixp + d0) = ov;
            }
    }
    __syncthreads();
}

DI void gla_kv_item(PP P, int l, int item, char* smem, const int wv) {
    P = plaunder(P);
    const int tid = otid(wv), lane = tid & 63, w = tid >> 6, r = lane & 31, hh = lane >> 5;
    const int pair = item * 4 + w, h = pair & 3, cn = pair >> 2;
    const size_t tok = (size_t)cn * 32 + r;
    const int b = cn >> 8, n = cn & 255, bh = b * 4 + h;
    const h16* proj = (const h16*)(P->ws + OFF_PROJ);
    h16* VT = (h16*)(smem + w * 16384);
    h16* KT = VT + 2048;
    __syncthreads();
    {
        const half8* vp = (const half8*)(proj + tok * D_IN + C_GV + h * 64 + hh * 32);
#pragma unroll
        for (int q = 0; q < 4; ++q) {
            const half8 v8 = vp[q];
#pragma unroll
            for (int e = 0; e < 8; ++e) VT[(hh * 32 + q * 8 + e) * 32 + r] = v8[e];
        }
    }
    float gl[16];
    {
        const half8* lp = (const half8*)(proj + tok * D_IN + C_GLR);
        const half8 l0 = lp[0], l1 = lp[1];
        float lr[16];
#pragma unroll
        for (int q = 0; q < 8; ++q) { lr[q] = (float)l0[q]; lr[8 + q] = (float)l1[q]; }
        const float* w2 = P->in[I_GW2] + (size_t)l * 16 * 128 + h * 32 + 16 * hh;
        const float* b2 = P->in[I_GB2] + l * 128 + h * 32 + 16 * hh;
#pragma unroll
        for (int d = 0; d < 16; ++d) gl[d] = b2[d];
#pragma unroll
        for (int q = 0; q < 16; ++q)
#pragma unroll
            for (int d4 = 0; d4 < 4; ++d4) {
                const float4 wq = *(const float4*)(w2 + q * 128 + d4 * 4);
                gl[d4 * 4 + 0] += lr[q] * wq.x; gl[d4 * 4 + 1] += lr[q] * wq.y; gl[d4 * 4 + 2] += lr[q] * wq.z; gl[d4 * 4 + 3] += lr[q] * wq.w;
            }
#pragma unroll
        for (int d = 0; d < 16; ++d) gl[d] = log_sigmoidf_(gl[d]) * (1.f / 16.f);
    }
#pragma unroll
    for (int off = 1; off < 32; off <<= 1) {
#pragma unroll
        for (int d = 0; d < 16; ++d) { const float v = __shfl_up(gl[d], off, 32); if (r >= off) gl[d] += v; }
    }
    {
        float* bc = (float*)(P->ws + OFF_BCUM) + tok * 128 + h * 32 + 16 * hh;
#pragma unroll
        for (int d4 = 0; d4 < 4; ++d4) *(float4*)(bc + d4 * 4) = (float4){gl[d4 * 4], gl[d4 * 4 + 1], gl[d4 * 4 + 2], gl[d4 * 4 + 3]};
    }
    {
        const half8* kp = (const half8*)(proj + tok * D_IN + C_GK + h * 32 + 16 * hh);
        const half8 k0 = kp[0], k1 = kp[1];
        float bl[16];
#pragma unroll
        for (int d = 0; d < 16; ++d) bl[d] = __shfl(gl[d], 31, 32);
#pragma unroll
        for (int d = 0; d < 16; ++d) {
            const float kd = (float)(d < 8 ? k0[d & 7] : k1[d & 7]) * __expf(bl[d] - gl[d]);
            KT[(16 * hh + d) * 32 + r] = (h16)kd;
        }
        if (r == 0) {
            float* dc = (float*)(P->ws + OFF_GDEC) + (size_t)(bh * 256 + n) * 32 + 16 * hh;
#pragma unroll
            for (int d4 = 0; d4 < 4; ++d4) *(float4*)(dc + d4 * 4) = (float4){__expf(bl[d4 * 4]), __expf(bl[d4 * 4 + 1]), __expf(bl[d4 * 4 + 2]), __expf(bl[d4 * 4 + 3])};
        }
    }
    asm volatile("s_waitcnt lgkmcnt(0)" ::: "memory");
    const half8 kb0 = *(const half8*)(KT + r * 32 + 8 * hh), kb1 = *(const half8*)(KT + r * 32 + 16 + 8 * hh);
    float* kvp = (float*)(P->ws + OFF_GKV) + ((size_t)(bh * 256 + n) * 32 + r) * 64;
#pragma unroll
    for (int dt = 0; dt < 2; ++dt) {
        f32x16 o;
#pragma unroll
        for (int e = 0; e < 16; ++e) o[e] = 0.f;
        const h16* vrow = VT + (32 * dt + r) * 32 + 8 * hh;
        o = MFMA32(*(const half8*)vrow, kb0, o);
        o = MFMA32(*(const half8*)(vrow + 16), kb1, o);
#pragma unroll
        for (int g4 = 0; g4 < 4; ++g4)
            *(float4*)(kvp + 32 * dt + 8 * g4 + 4 * hh) = (float4){o[4 * g4], o[4 * g4 + 1], o[4 * g4 + 2], o[4 * g4 + 3]};
    }
    __syncthreads();
}

DI void gla_out_item(PP P, int l, int item, char* smem, const int wv) {
    P = plaunder(P);
    const int tid = otid(wv), lane = tid & 63, w = tid >> 6, r = lane & 31, hh = lane >> 5;
    const int pair = item * 4 + w, h = pair & 3, cn = pair >> 2;
    const size_t tok0 = (size_t)cn * 32, tok = tok0 + r;
    const int b = cn >> 8, n = cn & 255, bh = b * 4 + h;
    const h16* proj = (const h16*)(P->ws + OFF_PROJ);
    h16* VT = (h16*)(smem + w * 16384);
    h16* SPT = VT + 2048;
    __syncthreads();
    {
        const half8* vp = (const half8*)(proj + tok * D_IN + C_GV + h * 64 + hh * 32);
        const float4* sp = (const float4*)((const float*)(P->ws + OFF_GKV) + ((size_t)(bh * 256 + n) * 32 + r) * 64 + hh * 32);
#pragma unroll
        for (int q = 0; q < 4; ++q) {
            const half8 v8 = vp[q];
            const float4 s0 = sp[2 * q], s1 = sp[2 * q + 1];
#pragma unroll
            for (int e = 0; e < 8; ++e) VT[(hh * 32 + q * 8 + e) * 32 + r] = v8[e];
            SPT[(hh * 32 + q * 8 + 0) * 32 + r] = (h16)s0.x; SPT[(hh * 32 + q * 8 + 1) * 32 + r] = (h16)s0.y;
            SPT[(hh * 32 + q * 8 + 2) * 32 + r] = (h16)s0.z; SPT[(hh * 32 + q * 8 + 3) * 32 + r] = (h16)s0.w;
            SPT[(hh * 32 + q * 8 + 4) * 32 + r] = (h16)s1.x; SPT[(hh * 32 + q * 8 + 5) * 32 + r] = (h16)s1.y;
            SPT[(hh * 32 + q * 8 + 6) * 32 + r] = (h16)s1.z; SPT[(hh * 32 + q * 8 + 7) * 32 + r] = (h16)s1.w;
        }
    }
    half8 qe[2], ke[2];
#pragma unroll
    for (int ks = 0; ks < 2; ++ks) {
        const int d0 = 16 * ks + 8 * hh;
        const half8 q8 = *(const half8*)(proj + tok * D_IN + C_GQ + h * 32 + d0);
        const half8 k8 = *(const half8*)(proj + tok * D_IN + C_GK + h * 32 + d0);
        const float4 b0 = *(const float4*)((const float*)(P->ws + OFF_BCUM) + tok * 128 + h * 32 + d0);
        const float4 b1 = *(const float4*)((const float*)(P->ws + OFF_BCUM) + tok * 128 + h * 32 + d0 + 4);
        const float bc[8] = {b0.x, b0.y, b0.z, b0.w, b1.x, b1.y, b1.z, b1.w};
#pragma unroll
        for (int e = 0; e < 8; ++e) {
            const float ex = __expf(bc[e]);
            qe[ks][e] = (h16)((float)q8[e] * 0.17677669529663687f * ex);
            ke[ks][e] = (h16)((float)k8[e] * __builtin_amdgcn_rcpf(ex));
        }
    }
    f32x16 s;
#pragma unroll
    for (int e = 0; e < 16; ++e) s[e] = 0.f;
    s = MFMA32(ke[0], qe[0], s);
    s = MFMA32(ke[1], qe[1], s);
#pragma unroll
    for (int e = 0; e < 16; ++e) { const int j = (e & 3) + 8 * (e >> 2) + 4 * hh; if (j > r) s[e] = 0.f; }
    const half8 pb0 = pack8<0>(s), pb1 = pack8<1>(s);
    asm volatile("s_waitcnt lgkmcnt(0)" ::: "memory");
    f32x16 o[2];
#pragma unroll
    for (int dt = 0; dt < 2; ++dt) {
#pragma unroll
        for (int e = 0; e < 16; ++e) o[dt][e] = 0.f;
        const h16* vrow = VT + (32 * dt + r) * 32 + 4 * hh;
        const h16* srow = SPT + (32 * dt + r) * 32 + 8 * hh;
        {
            const half4 lo = *(const half4*)vrow, hi = *(const half4*)(vrow + 8);
            o[dt] = MFMA32(((half8){lo[0], lo[1], lo[2], lo[3], hi[0], hi[1], hi[2], hi[3]}), pb0, o[dt]);
        }
        {
            const half4 lo = *(const half4*)(vrow + 16), hi = *(const half4*)(vrow + 24);
            o[dt] = MFMA32(((half8){lo[0], lo[1], lo[2], lo[3], hi[0], hi[1], hi[2], hi[3]}), pb1, o[dt]);
        }
        o[dt] = MFMA32(*(const half8*)srow, qe[0], o[dt]);
        o[dt] = MFMA32(*(const half8*)(srow + 16), qe[1], o[dt]);
    }
    float ss = 0.f;
#pragma unroll
    for (int e = 0; e < 16; ++e) ss += o[0][e] * o[0][e] + o[1][e] * o[1][e];
    ss = xhalf_sum(ss);
    const float rn = rsqrtf(ss * (1.f / 64.f) + 1e-6f);
    h16* mix = (h16*)(P->ws + OFF_MIX);
#pragma unroll
    for (int dt = 0; dt < 2; ++dt)
#pragma unroll
        for (int g4 = 0; g4 < 4; ++g4) {
            const int e0 = 32 * dt + 8 * g4 + 4 * hh;
            const half4 gt = *(const half4*)(proj + tok * D_IN + C_GG + h * 64 + e0);
            const float4 on = *(const float4*)(P->in[I_GON] + l * 64 + e0);
            half4 ov;
            ov[0] = (h16)(o[dt][4 * g4 + 0] * rn * on.x * siluf_((float)gt[0]));
            ov[1] = (h16)(o[dt][4 * g4 + 1] * rn * on.y * siluf_((float)gt[1]));
            ov[2] = (h16)(o[dt][4 * g4 + 2] * rn * on.z * siluf_((float)gt[2]));
            ov[3] = (h16)(o[dt][4 * g4 + 3] * rn * on.w * siluf_((float)gt[3]));
            *(half4*)(mix + kb_idx(NT, tok, h * 64 + e0)) = ov;
        }
    __syncthreads();
}

DI void glu_tile(PP P, int l, int tile, char* smem, const int wv) {
    P = plaunder(P);
    const int mt = tile >> 2, nt = tile & 3;
    f32x4 acc[4][4];
    float ssd[4];
    gemm_mainloop_glds<false>(wv, 256, APlain{(const h16*)(P->ws + OFF_YACT) + (size_t)mt * 128 * 256, 256, 64},
                              (const h16*)(P->ws + OFF_WTGLU) + ((size_t)l * 512 + nt * 128) * 256, 256, acc, ssd, smem);
    const int tid = otid(wv), lane = tid & 63, wid = tid >> 6, wr = wid >> 1, wc = wid & 1;
    const h16* proj = (const h16*)(P->ws + OFF_PROJ);
    h16* mix = (h16*)(P->ws + OFF_MIX);
    const float* gb = P->in[I_GLUB] + l * 512;
#pragma unroll
    for (int i = 0; i < 4; ++i) {
        const size_t tok = (size_t)mt * 128 + wr * 64 + i * 16 + (lane & 15);
#pragma unroll
        for (int pj = 0; pj < 2; ++pj) {
            const int c = nt * 64 + wc * 32 + pj * 16 + (lane >> 4) * 4;
            const f32x4 z1 = acc[i][2 * pj], z2 = acc[i][2 * pj + 1];
            const float4 b1 = *(const float4*)(gb + c), b2 = *(const float4*)(gb + 256 + c);
            const half4 g4 = *(const half4*)(proj + tok * D_IN + C_SG + c);
            half4 o;
            o[0] = (h16)((z1[0] + b1.x) * sigmoidf_(z2[0] + b2.x) * siluf_((float)g4[0]));
            o[1] = (h16)((z1[1] + b1.y) * sigmoidf_(z2[1] + b2.y) * siluf_((float)g4[1]));
            o[2] = (h16)((z1[2] + b1.z) * sigmoidf_(z2[2] + b2.z) * siluf_((float)g4[2]));
            o[3] = (h16)((z1[3] + b1.w) * sigmoidf_(z2[3] + b2.w) * siluf_((float)g4[3]));
            *(half4*)(mix + kb_idx(NT, tok, 256 + c)) = o;
        }
    }
}

DI void outproj_tile(PP P, int l, int mt, int nt, char* smem, const int wv) {
    P = plaunder(P);
    f32x4 acc[4][4];
    float ssd[4];
    gemm_glds<false, 2, 4, 4>(wv, 1024, APlain{(const h16*)(P->ws + OFF_MIX) + (size_t)mt * 128 * 64, 64, (size_t)NT * 64},
                              (const h16*)(P->ws + OFF_WTOUT) + ((size_t)l * 16 * 1024 + nt * 128) * 64, 64, acc, ssd, smem, (size_t)1024 * 64);
    const int tid = otid(wv), lane = tid & 63, wid = tid >> 6, wr = wid >> 1, wc = wid & 1;
    const float* xin = (l == 0) ? P->in[I_X] : P->out;
    h16* xh = (h16*)(P->ws + OFF_XH);
#pragma unroll
    for (int i = 0; i < 4; ++i) {
        const size_t row = (size_t)mt * 128 + wr * 64 + i * 16 + (lane & 15);
#pragma unroll
        for (int jj = 0; jj < 4; ++jj) {
            const int n = nt * 128 + wc * 64 + jj * 16 + (lane >> 4) * 4;
            const f32x4 v = acc[i][jj];
            const float4 xo = *(const float4*)(xin + row * 1024 + n);
            const float4 xn = (float4){xo.x + v[0], xo.y + v[1], xo.z + v[2], xo.w + v[3]};
            *(float4*)(P->out + row * 1024 + n) = xn;
            *(half4*)(xh + kb_idx(NT, row, n)) = (half4){(h16)xn.x, (h16)xn.y, (h16)xn.z, (h16)xn.w};
        }
    }
}

#define XB_TMO      128
#define XB_XCNT(j)  (256  + 64 * (j))
#define XB_XSUB(j)  (1280 + 64 * (j))
#define XB_XGEN(j)  (2304 + 64 * (j))
#define XB_TOP      3328
#define XB_TOPGEN   3392
#define XCD_BAR_WORDS 3456
#define XB_SPIN_CAP (1u << 18)
#define LAS __attribute__((address_space(3)))

__device__ __forceinline__ unsigned xb_ld(unsigned* p)              { return __hip_atomic_load(p, __ATOMIC_RELAXED, __HIP_MEMORY_SCOPE_AGENT); }
__device__ __forceinline__ unsigned xb_add(unsigned* p, unsigned v) { return __hip_atomic_fetch_add(p, v, __ATOMIC_RELAXED, __HIP_MEMORY_SCOPE_AGENT); }
__device__ __forceinline__ unsigned xb_xcc_id() { return (unsigned)__builtin_amdgcn_s_getreg((3 << 11) | 20) & 0xFu; }
#define XB_SPIN(cond, bar) do { unsigned _sp = 0; while (cond) { __builtin_amdgcn_s_sleep(1); \
    if ((++_sp & 255u) == 0u) { if (xb_ld(&(bar)[XB_TMO])) break; if (_sp > XB_SPIN_CAP) { atomicAdd(&(bar)[XB_TMO], 1u); break; } } } } while (0)

struct XcdBarrier {
    unsigned* bar; unsigned x;
    volatile LAS unsigned* st;
};

__device__ __forceinline__ XcdBarrier xcd_barrier_post(unsigned* bar, volatile LAS unsigned* st) {
    XcdBarrier b; b.bar = bar; b.x = xb_xcc_id(); b.st = st;
    if (threadIdx.x == 0) (void)xb_add(&bar[XB_XCNT(b.x)], 1u);
    return b;
}
__device__ __forceinline__ void xcd_barrier_complete(unsigned* bar, unsigned x, unsigned& nloc, unsigned& nx) {
    const unsigned G = gridDim.x * gridDim.y * gridDim.z;
    unsigned sum, cnt, mine, sp = 0u;
    for (;;) {
        sum = 0u; cnt = 0u; mine = 0u;
#pragma unroll
        for (unsigned j = 0; j < 16; ++j) { const unsigned c = xb_ld(&bar[XB_XCNT(j)]); sum += c; cnt += (c > 0u) ? 1u : 0u; mine = (j == x) ? c : mine; }
        if (sum == G) break;
        __builtin_amdgcn_s_sleep(1);
        if ((++sp & 255u) == 0u) { if (xb_ld(&bar[XB_TMO])) break; if (sp > XB_SPIN_CAP) { atomicAdd(&bar[XB_TMO], 1u); break; } }
    }
    nloc = mine > 0u ? mine : 1u; nx = cnt > 0u ? cnt : 1u;
}

__device__ __forceinline__ void xcd_barrier(const XcdBarrier& b) {
    asm volatile("s_waitcnt vmcnt(0)" ::: "memory");
    __syncthreads();
    if (threadIdx.x == 0) {
        unsigned* bar = b.bar;
        __builtin_amdgcn_s_waitcnt(0);
        unsigned nloc = b.st[0], nx = b.st[1];
        if (nloc == 0u) { xcd_barrier_complete(bar, b.x, nloc, nx); b.st[0] = nloc; b.st[1] = nx; }
        const unsigned old = xb_add(&bar[XB_XSUB(b.x)], 1u);
        const unsigned gen = old / nloc;
        if (old + 1u == (gen + 1u) * nloc) {
            __builtin_amdgcn_fence(__ATOMIC_RELEASE, "agent");
            asm volatile("s_waitcnt vmcnt(0)" ::: "memory");
            const unsigned og = xb_add(&bar[XB_TOP], 1u);
            const unsigned tg = og / nx;
            if (og + 1u == (tg + 1u) * nx) xb_add(&bar[XB_TOPGEN], 1u);
            else XB_SPIN(xb_ld(&bar[XB_TOPGEN]) == tg, bar);
            __builtin_amdgcn_fence(__ATOMIC_ACQUIRE, "agent");
            xb_add(&bar[XB_XGEN(b.x)], 1u);
            asm volatile("s_waitcnt vmcnt(0)" ::: "memory");
        } else {
            XB_SPIN(xb_ld(&bar[XB_XGEN(b.x)]) == gen, bar);
            __builtin_amdgcn_fence(__ATOMIC_ACQUIRE, "agent");
            asm volatile("s_waitcnt vmcnt(0)" ::: "memory");
        }
    }
    __syncthreads();
}


__global__ void __launch_bounds__(NTHREADS, 2) fwd_megakernel(Params Pval) {
    PP P = (PP)__builtin_amdgcn_kernarg_segment_ptr();
    extern __shared__ __attribute__((aligned(16))) char smem[];
    cg::grid_group grid = cg::this_grid();
    const int G = gridDim.x, bid = blockIdx.x;
    const int wv = __builtin_amdgcn_readfirstlane((int)(threadIdx.x >> 6));

    uint4& xb_words = *(uint4*)(smem + SMEM_MAIN);
    if (otid(wv) == 0) xb_words = make_uint4(0u, 0u, 0u, 0u);
    if (bid == 0) for (int i = otid(wv); i < XCD_BAR_WORDS + 16; i += NTHREADS) ((unsigned*)(P->ws + OFF_BAR))[i] = 0u;
    phase0(P, smem, wv);
    grid.sync();
    const XcdBarrier xb = xcd_barrier_post((unsigned*)(P->ws + OFF_BAR), (volatile LAS unsigned*)(smem + SMEM_MAIN));
    int vxcd = bid & 7, vjx = bid >> 3;
    {
        unsigned* xcnt = (unsigned*)(P->ws + OFF_BAR) + XCD_BAR_WORDS;
        volatile LAS unsigned* lw = (volatile LAS unsigned*)(smem + SMEM_MAIN) + 2;
        if (otid(wv) == 0) lw[0] = xb.x < 8u ? xb_add(&xcnt[xb.x], 1u) : 0xffffu;
        xcd_barrier(xb);
        if (otid(wv) == 0) {
            bool ok = (G & 7) == 0 && xb.x < 8u;
            for (int j = 0; j < 8; ++j) ok = ok && (xb_ld(&xcnt[j]) == (unsigned)(G >> 3));
            lw[1] = ok ? 1u : 0u;
        }
        __syncthreads();
        if (lw[1]) { vxcd = (int)xb.x; vjx = (int)lw[0]; }
    }
    vxcd = __builtin_amdgcn_readfirstlane(vxcd); vjx = __builtin_amdgcn_readfirstlane(vjx);

#pragma unroll 1
    for (int l = 0; l < DEPTH; ++l) {
        {
            const int xcd = vxcd, jx = vjx, nper = G >> 3;
            for (int u = jx; u < 384; u += nper) {
                const int mh = u / 192, rem = u - mh * 192;
                inproj_tile<2, 4>(P, l, (xcd * 16 + mh * 8 + (rem & 7)) * 128, (rem >> 3) * 128, smem, wv);
            }
            for (int it = jx; it < 16 + 40; it += nper) {
                if (it < 16) inproj_tile<4, 2>(P, l, (xcd * 16 + it) * 128, 3072, smem, wv);
                else s5_build_item(P, l, (it - 16) * 8 + xcd, smem, wv);
            }
        }
        xcd_barrier(xb);
#pragma unroll 1
        for (int w = bid; w < 128 + 64 + 512; w += G) {
            if (w < 128) cmp_gemm_tile(P, l, w, smem, wv);
            else if (w < 192) s5e_gemm_tile(P, l, w - 128, smem, wv);
            else gla_kv_item(P, l, w - 192, smem, wv);
        }
        xcd_barrier(xb);
#pragma unroll 1
        for (int w = bid; w < 512 + 512 + 64; w += G) {
            if (w < 512) cmp_l2_item(P, l, w, smem, wv);
            else if (w < 1024) gla_scan_item(P, w - 512, smem, wv);
            else s5_scan_item(P, w - 1024, smem, wv);
        }
        xcd_barrier(xb);
        bool nsa_fast;
        {
            const int ln = otid(wv) & 63;
            const float gq = wave_max(fabsf(P->in[I_NQN][l * 64 + ln]));
            const float gk = wave_max(fmaxf(fmaxf(fabsf(P->in[I_NKN][(l * 3 + 0) * 64 + ln]), fabsf(P->in[I_NKN][(l * 3 + 1) * 64 + ln])), fabsf(P->in[I_NKN][(l * 3 + 2) * 64 + ln])));
            nsa_fast = __builtin_amdgcn_readfirstlane((8.f * 1.4426950408889634f * gq * gk - FAST_SHIFT < 15.f) ? 1 : 0) != 0;
        }
#pragma unroll 1
        for (int w0 = bid; w0 < 512 + 512 + 512; w0 += G) {
            const int w = w0 < G ? vjx * 8 + vxcd : w0;
            if (w < 512) {
                const int bg = w & 3, q = w >> 2;
                if (nsa_fast) { nsa_unit<true>(P, l, bg, 255 - q, smem, wv); nsa_unit<true>(P, l, bg, q, smem, wv); }
                else { nsa_unit<false>(P, l, bg, 255 - q, smem, wv); nsa_unit<false>(P, l, bg, q, smem, wv); }
            } else if (w < 512 + 512) s5o_gemm_tile(P, l, w - 512, smem, wv);
            else gla_out_item(P, l, w - 1024, smem, wv);
        }
        xcd_barrier(xb);
#pragma unroll 1
        for (int w = bid; w < 512; w += G) glu_tile(P, l, w, smem, wv);
        xcd_barrier(xb);
        {
            const int xcd = vxcd, jx = vjx, nper = G >> 3;
            for (int u = jx; u < 128; u += nper) outproj_tile(P, l, xcd * 16 + (u >> 6) * 8 + (u & 7), (u & 63) >> 3, smem, wv);
        }
        xcd_barrier(xb);
    }
}

extern "C" void kernel_launch(void* const* d_in, const int* in_sizes, int n_in, void* d_out, int out_size, void* d_ws,
                              size_t ws_size, hipStream_t stream) {
    static int grid_blocks = 0;
    if (!grid_blocks) {
        int dev = 0, cus = 0, per_cu = 0;
        hipGetDevice(&dev);
        hipDeviceGetAttribute(&cus, hipDeviceAttributeMultiprocessorCount, dev);
        hipFuncSetAttribute((const void*)fwd_megakernel, hipFuncAttributeMaxDynamicSharedMemorySize, SMEM_BYTES);
        hipOccupancyMaxActiveBlocksPerMultiprocessor(&per_cu, fwd_megakernel, NTHREADS, SMEM_BYTES);
        if (per_cu < 1) per_cu = 1;
        if (per_cu > 2) per_cu = 2;
        grid_blocks = cus * per_cu;
        if (ws_size < WS_END) fprintf(stderr, "kernel_launch: workspace too small: %zu < %zu\n", ws_size, (size_t)WS_END);
    }
    Params p{};
    for (int i = 0; i < 25; ++i) p.in[i] = (const float*)d_in[i];
    p.out = (float*)d_out;
    p.ws = (char*)d_ws;
    void* args[] = {&p};
    hipError_t e = hipLaunchCooperativeKernel((const void*)fwd_megakernel, dim3(grid_blocks), dim3(NTHREADS), args, SMEM_BYTES, stream);
    if (e != hipSuccess) fprintf(stderr, "cooperative launch failed: %s (grid %d)\n", hipGetErrorString(e), grid_blocks);
}
```

```cpp
#include <hip/hip_runtime.h>
#include <hip/hip_cooperative_groups.h>
#include <cstdio>
#include <cstdint>
namespace cg = cooperative_groups;

typedef _Float16 h16;
typedef _Float16 half8 __attribute__((ext_vector_type(8)));
typedef _Float16 half4 __attribute__((ext_vector_type(4)));
typedef float f32x4 __attribute__((ext_vector_type(4)));
typedef float f32x16 __attribute__((ext_vector_type(16)));

#define DI __device__ __forceinline__

constexpr int D_MODEL = 1024, BATCH = 2, SEQ = 8192, DEPTH = 4, NT = BATCH * SEQ;
constexpr int D_IN = 3112, D_IN_PAD = 3200;
constexpr int C_NQ = 0, C_NKV = 512, C_NG = 1280, C_GQ = 1792, C_GK = 1920, C_GV = 2048, C_GG = 2304, C_SU = 2560, C_SG = 2816,
              C_GLR = 3072, C_NGL = 3088;
__host__ __device__ constexpr int map_col(int c) {
    return c < 128 ? C_GQ + c : c < 256 ? C_GK + (c - 128) : c < 512 ? C_GV + (c - 256) : c < 528 ? C_GLR + (c - 512)
         : c < 784 ? C_GG + (c - 528) : c < 1040 ? C_SU + (c - 784) : c < 1296 ? C_SG + (c - 1040) : c < 1808 ? C_NQ + (c - 1296)
         : c < 2576 ? C_NKV + (c - 1808) : c < 2600 ? C_NGL + (c - 2576) : c < 3112 ? C_NG + (c - 2600) : c;
}
constexpr int NTHREADS = 256;
constexpr float QSCALE = 0.125f * 1.4426950408889634f;

enum { I_X = 0, I_NORMG, I_WIN, I_GW2, I_GB2, I_GON, I_LRE, I_LIM, I_LSTEP, I_BRE, I_BIM, I_CRE, I_CIM, I_SD, I_GLUW, I_GLUB,
       I_NGB, I_NQN, I_NKN, I_CPOS, I_CW1, I_CB1, I_CW2, I_CB2, I_WOUT };

constexpr size_t OFF_WTIN  = 0;
constexpr size_t OFF_WTOUT = OFF_WTIN  + 4ull * D_IN_PAD * 1024 * 2;
constexpr size_t OFF_WTGLU = OFF_WTOUT + 4ull * 1024 * 1024 * 2;
constexpr size_t OFF_WTC1  = OFF_WTGLU + 4ull * 512 * 256 * 2;
constexpr size_t OFF_PROJ  = OFF_WTC1  + 4ull * 2 * 256 * 2048 * 2;
constexpr size_t OFF_MIX   = OFF_PROJ  + (size_t)NT * D_IN * 2;
constexpr size_t OFF_YACT  = OFF_MIX   + (size_t)NT * 1024 * 2;
constexpr size_t OFF_XH    = OFF_YACT;
constexpr size_t OFF_BCUM  = OFF_YACT  + (size_t)NT * 256 * 2;
constexpr size_t OFF_GKV   = OFF_BCUM  + (size_t)NT * 128 * 4;
constexpr size_t OFF_GDEC  = OFF_GKV   + 8ull * 256 * 2048 * 4;
static_assert(OFF_GDEC - OFF_XH >= (size_t)NT * 1024 * 2, "XH alias region too small");
constexpr size_t OFF_XC    = OFF_GDEC  + 8ull * 256 * 32 * 4;
constexpr size_t OFF_S5W   = OFF_XC    + 512ull * 1024 * 2 * 4;
constexpr size_t OFF_S5E   = OFF_S5W   + 16ull * 512 * 640 * 2;
constexpr size_t OFF_S5AL  = OFF_S5E   + 16ull * 128 * 512 * 2;
constexpr size_t OFF_CHID  = OFF_S5AL  + 1024ull * 2 * 4;
constexpr size_t OFF_POSB  = OFF_CHID  + 2ull * 2048 * 512 * 4;
constexpr size_t OFF_XCH   = OFF_POSB  + 8ull * 16 * 256 * 4;
constexpr size_t OFF_KCMP  = OFF_XCH   + 512ull * 2048 * 2;
constexpr size_t OFF_VCMP  = OFF_KCMP  + 4ull * 512 * 64 * 2;
constexpr size_t OFF_VTG   = OFF_VCMP  + 4ull * 512 * 64 * 2;
constexpr size_t OFF_BAR   = OFF_VTG   + 2ull * 4 * 128 * 4096 * 2;
constexpr size_t WS_END    = OFF_BAR   + 16384;

struct Params {
    const float* in[25];
    float* out;
    char* ws;
};

__host__ __device__ constexpr size_t kb_idx(size_t nrows, size_t row, int k) { return (((size_t)(k >> 6)) * nrows + row) * 64 + (k & 63); }
typedef const __attribute__((address_space(4))) Params* PP;
DI PP plaunder(PP p) { asm volatile("" : "+s"(p)); return p; }
constexpr int SMEM_MAIN = 73728;
constexpr int SMEM_BYTES = SMEM_MAIN + 16;

DI int otid(const int wv) { int t = wv * 64 + (int)__builtin_amdgcn_mbcnt_hi(~0u, __builtin_amdgcn_mbcnt_lo(~0u, 0u)); asm volatile("" : "+v"(t)); return t; }
DI float wave_sum(float v) {
#pragma unroll
    for (int o = 32; o > 0; o >>= 1) v += __shfl_xor(v, o);
    return v;
}
DI float wave_max(float v) {
#pragma unroll
    for (int o = 32; o > 0; o >>= 1) v = fmaxf(v, __shfl_xor(v, o));
    return v;
}
DI float sigmoidf_(float x) { return 1.f / (1.f + __expf(-x)); }
DI float siluf_(float x) { return x / (1.f + __expf(-x)); }
DI float gelu_tanh(float x) {
    const float u = 0.7978845608028654f * (x + 0.044715f * x * x * x);
    return 0.5f * x * (1.f + tanhf(u));
}
DI float log_sigmoidf_(float x) { return fminf(x, 0.f) - log1pf(__expf(-fabsf(x))); }

typedef _Float16 half2_ __attribute__((ext_vector_type(2)));
DI void glds16(const h16* g, char* l) {
    __builtin_amdgcn_global_load_lds((const __attribute__((address_space(1))) void*)g, (__attribute__((address_space(3))) void*)l, 16, 0, 0);
}
struct APlain { const h16* A; size_t lda, astep; DI const h16* operator()(int row, int kt, int c8) const { return A + (size_t)row * lda + (size_t)kt * astep + c8 * 8; } };
struct AS5 {
    const h16* ubase;
    const h16* xin;
    int ch0;
    DI const h16* operator()(int row, int kt, int c8) const {
        const size_t ch = (size_t)(ch0 + row);
        return kt < 8 ? ubase + (ch * 32 + 4 * kt + (c8 >> 1)) * D_IN + (c8 & 1) * 8 : xin + ch * 2048 + (kt - 8) * 64 + c8 * 8;
    }
};
template <int N> DI void gwaitbar();
#define GWB_DEF(N) template <> DI void gwaitbar<N>() { asm volatile("s_waitcnt vmcnt(" #N ") lgkmcnt(0)\n\ts_barrier" ::: "memory"); }
GWB_DEF(0) GWB_DEF(3) GWB_DEF(4) GWB_DEF(6) GWB_DEF(8) GWB_DEF(12)
template <bool SUMSQ, int WR, int MI, int NJ, int NST = 4, class AF>
DI void gemm_glds(const int wv, const int K, const AF& afn, const h16* __restrict__ Bt, const int ldb,
                  f32x4 (&acc)[MI][NJ], float (&ss)[MI], char* smem, const size_t bstep = 64) {
    constexpr int WC = 4 / WR, BM = WR * MI * 16, BN = WC * NJ * 16, AQ = BM / 64, BQ = BN / 64, NG = AQ + BQ, SB = (BM + BN) * 64;
    static_assert(NST * SB <= SMEM_MAIN && AQ >= 1 && BQ >= 1 && (NST == 3 || NST == 4), "ring does not fit the LDS");
    const int tid = otid(wv), lane = tid & 63, wid = tid >> 6, wr = wid / WC, wc = wid % WC;
#pragma unroll
    for (int i = 0; i < MI; ++i) {
        ss[i] = 0.f;
#pragma unroll
        for (int j = 0; j < NJ; ++j) acc[i][j] = (f32x4){0.f, 0.f, 0.f, 0.f};
    }
    const int lrow = wid * 16 + (lane >> 2);
    const int lc4 = (lane & 3) ^ ((-(lrow >> 2)) & 3);
    const h16* bp = Bt + (size_t)lrow * ldb + lc4 * 8;
    char* lbase = smem + wid * 1024;
    const int fr = lane & 15, fq = lane >> 4, sw = (-(fr >> 2)) & 3;
    const int aoff0 = (wr * MI * 16 + fr) * 64 + ((fq ^ sw) * 16);
    const int boff0 = BM * 64 + (wc * NJ * 16 + fr) * 64 + ((fq ^ sw) * 16);
    const int nt = K >> 5;
    auto issue = [&](const int t, char* stage) {
        const int kt = t >> 1, hb = (t & 1) * 4;
#pragma unroll
        for (int q = 0; q < AQ; ++q) glds16(afn(lrow + 64 * q, kt, hb + lc4), stage + q * 4096);
#pragma unroll
        for (int q = 0; q < BQ; ++q) glds16(bp + (size_t)q * 64 * ldb + (size_t)kt * bstep + hb * 8, stage + BM * 64 + q * 4096);
    };
    auto compute = [&](const char* st) {
        half8 af[MI], bf[NJ];
#pragma unroll
        for (int i = 0; i < MI; ++i) af[i] = *(const half8*)(st + aoff0 + i * 1024);
#pragma unroll
        for (int j = 0; j < NJ; ++j) bf[j] = *(const half8*)(st + boff0 + j * 1024);
        if (SUMSQ) {
#pragma unroll
            for (int i = 0; i < MI; ++i)
#pragma unroll
                for (int e = 0; e < 4; ++e) {
                    const half2_ x = (half2_){af[i][2 * e], af[i][2 * e + 1]};
                    ss[i] = __builtin_amdgcn_fdot2(x, x, ss[i], false);
                }
        }
#pragma unroll
        for (int i = 0; i < MI; ++i)
#pragma unroll
            for (int j = 0; j < NJ; ++j) acc[i][j] = __builtin_amdgcn_mfma_f32_16x16x32_f16(bf[j], af[i], acc[i][j], 0, 0, 0);
    };
#define GEMM_STEP(S, t) do { if (NST == 4 && (t) + 2 < nt) gwaitbar<NG>(); else gwaitbar<0>();                       \
        if ((t) + NST - 1 < nt) issue((t) + NST - 1, lbase + (((S) + NST - 1) % NST) * SB); compute(smem + (S) * SB); } while (0)
    gwaitbar<0>();
    {
        const int k = nt < NST - 1 ? nt : NST - 1;
        for (int p = 0; p < k; ++p) issue(p, lbase + p * SB);
        if (k >= 3) gwaitbar<2 * NG>(); else if (k == 2) gwaitbar<NG>(); else gwaitbar<0>();
        __builtin_amdgcn_s_sleep(2);
    }
#pragma unroll 1
    for (int t = 0; t < nt; t += NST) {
        GEMM_STEP(0, t);
        if (t + 1 < nt) GEMM_STEP(1, t + 1);
        if (t + 2 < nt) GEMM_STEP(2, t + 2);
        if (NST == 4 && t + 3 < nt) GEMM_STEP(3 % NST, t + 3);
    }
#undef GEMM_STEP
    asm volatile("s_waitcnt lgkmcnt(0)\n\ts_barrier" ::: "memory");
    if (SUMSQ) {
#pragma unroll
        for (int i = 0; i < MI; ++i) { ss[i] += __shfl_xor(ss[i], 16); ss[i] += __shfl_xor(ss[i], 32); }
    }
}
template <bool SUMSQ, class AF>
DI void gemm_mainloop_glds(const int wv, const int K, const AF& afn, const h16* __restrict__ Bt, const int ldb, f32x4 (&acc)[4][4], float (&ss)[4], char* smem, const size_t bstep = 64) {
    gemm_glds<SUMSQ, 2, 4, 4>(wv, K, afn, Bt, ldb, acc, ss, smem, bstep);
}

DI int glu_perm_dst(int c_orig) {
    const int which = c_orig >> 8, c = c_orig & 255;
    return (c >> 6) * 128 + ((c >> 5) & 1) * 64 + (((c >> 4) & 1) * 2 + which) * 16 + (c & 15);
}
template <int MAP, int KB>
DI void transpose64(const float* __restrict__ src, int R, int C, h16* __restrict__ dst, int r0, int c0,
                    const float* __restrict__ rscale, char* smem, const int wv) {
    h16* tile = (h16*)smem;
    const int tid = otid(wv);
    {
        const int r = tid >> 2, cq = (tid & 3) * 16;
        const float sc = rscale ? rscale[r0 + r] : 1.f;
        const float* sp = src + (size_t)(r0 + r) * C + c0 + cq;
#pragma unroll
        for (int q = 0; q < 4; ++q) {
            float4 v = (float4){0.f, 0.f, 0.f, 0.f};
            if (c0 + cq + q * 4 < C) v = *(const float4*)(sp + q * 4);
            *(half4*)(tile + r * 72 + cq + q * 4) = (half4){(h16)(v.x * sc), (h16)(v.y * sc), (h16)(v.z * sc), (h16)(v.w * sc)};
        }
    }
    __syncthreads();
    {
        const int c = tid >> 2, rq = (tid & 3) * 16;
        half8 o0, o1;
#pragma unroll
        for (int k = 0; k < 8; ++k) { o0[k] = tile[(rq + k) * 72 + c]; o1[k] = tile[(rq + 8 + k) * 72 + c]; }
        const int cc = c0 + c;
        const int dr = MAP == 1 ? map_col(cc) : MAP == 2 ? glu_perm_dst(cc) : cc;
        h16* dp = KB ? dst + ((size_t)(r0 >> 6) * KB + dr) * 64 + rq : dst + (size_t)dr * R + r0 + rq;
        *(half8*)dp = o0; *(half8*)(dp + 8) = o1;
    }
    __syncthreads();
}

DI void phase0(PP P, char* smem, const int wv) {
    P = plaunder(P);
    constexpr int N_WIN = 4 * 16 * 50, N_WOUT = 4 * 16 * 16, N_C1 = 16 * 16 * 4, N_GLU = 4 * 4 * 8, N_XH = NT * 1024 / 2048, N_PB = 8 * 16;
    const int total = N_WIN + N_WOUT + N_C1 + N_GLU + N_XH + N_PB;
    for (int w = blockIdx.x; w < total; w += gridDim.x) {
        if (w < N_WIN) {
            const int l = w / 800, r = w % 800, rt = r / 50, ct = r % 50;
            transpose64<1, D_IN_PAD>(P->in[I_WIN] + (size_t)l * 1024 * D_IN, 1024, D_IN, (h16*)(P->ws + OFF_WTIN) + (size_t)l * D_IN_PAD * 1024,
                           rt * 64, ct * 64, P->in[I_NORMG] + l * 1024, smem, wv);
        } else if (w < N_WIN + N_WOUT) {
            const int v = w - N_WIN, l = v >> 8, r = v & 255, rt = r >> 4, ct = r & 15;
            transpose64<0, 1024>(P->in[I_WOUT] + (size_t)l * 1024 * 1024, 1024, 1024, (h16*)(P->ws + OFF_WTOUT) + (size_t)l * 1024 * 1024,
                           rt * 64, ct * 64, nullptr, smem, wv);
        } else if (w < N_WIN + N_WOUT + N_C1) {
            const int v = w - N_WIN - N_WOUT, ljh = v >> 6, r = v & 63, rt = r >> 2, ct = r & 3;
            transpose64<0, 512>(P->in[I_CW1] + (size_t)ljh * 1024 * 256, 1024, 256, (h16*)(P->ws + OFF_WTC1) + ((size_t)(ljh >> 1) * 16 * 512 + (ljh & 1) * 256) * 64,
                           rt * 64, ct * 64, nullptr, smem, wv);
        } else if (w < N_WIN + N_WOUT + N_C1 + N_GLU) {
            const int v = w - N_WIN - N_WOUT - N_C1, l = v >> 5, r = v & 31, rt = r >> 3, ct = r & 7;
            transpose64<2, 0>(P->in[I_GLUW] + (size_t)l * 256 * 512, 256, 512, (h16*)(P->ws + OFF_WTGLU) + (size_t)l * 512 * 256,
                           rt * 64, ct * 64, nullptr, smem, wv);
        } else if (w < N_WIN + N_WOUT + N_C1 + N_GLU + N_XH) {
            const size_t e0 = ((size_t)(w - N_WIN - N_WOUT - N_C1 - N_GLU) * 256 + otid(wv)) * 8;
            const float4 a = *(const float4*)(P->in[I_X] + e0), b = *(const float4*)(P->in[I_X] + e0 + 4);
            *(half8*)((h16*)(P->ws + OFF_XH) + kb_idx(NT, e0 >> 10, (int)(e0 & 1023))) = (half8){(h16)a.x, (h16)a.y, (h16)a.z, (h16)a.w, (h16)b.x, (h16)b.y, (h16)b.z, (h16)b.w};
        } else {
            const int v = w - (N_WIN + N_WOUT + N_C1 + N_GLU + N_XH), lj = v >> 4, ks = v & 15, n = otid(wv);
            const float* w1 = P->in[I_CW1] + ((size_t)lj * 2048 + ks * 128) * 256 + n;
            const float* pp = P->in[I_CPOS] + (size_t)lj * 2048 + ks * 128;
            float a = ks == 0 ? P->in[I_CB1][lj * 256 + n] : 0.f;
#pragma unroll 16
            for (int k = 0; k < 128; ++k) a += pp[k] * w1[(size_t)k * 256];
            ((float*)(P->ws + OFF_POSB))[(lj * 16 + ks) * 256 + n] = a;
        }
    }
}

DI void s5_build_item(PP P, int l, int item, char* smem, const int wv) {
    P = plaunder(P);
    float* apow = (float*)smem;
    float* bbar = apow + 64 * 33 * 2;
    float* cc   = bbar + 64 * 16 * 2;
    const int tid = otid(wv);
    const int g = (item < 256) ? (item >> 4) : ((item - 256) >> 2);
    if (tid < 64) {
        const int p = tid;
        const float lre = fminf(P->in[I_LRE][(l * 16 + g) * 64 + p], -1e-4f);
        const float lim = P->in[I_LIM][(l * 16 + g) * 64 + p];
        const float dt = expf(P->in[I_LSTEP][l * 16 + g]);
        const float x = lre * dt, y = lim * dt;
        const float em1 = expm1f(x), cy = cosf(y), sy = sinf(y), sh = sinf(0.5f * y);
        const float ar = (em1 + 1.f) * cy, ai = (em1 + 1.f) * sy;
        const float dr = em1 * cy - 2.f * sh * sh, di = ai;
        const float den = lre * lre + lim * lim;
        const float fr = (dr * lre + di * lim) / den;
        const float fi = (di * lre - dr * lim) / den;
        float pr = 1.f, pi = 0.f;
        for (int k = 0; k <= 32; ++k) {
            apow[(p * 33 + k) * 2] = pr; apow[(p * 33 + k) * 2 + 1] = pi;
            const float nr = pr * ar - pi * ai, ni = pr * ai + pi * ar; pr = nr; pi = ni;
        }
        for (int c = 0; c < 16; ++c) {
            const float br = P->in[I_BRE][((size_t)(l * 16 + g) * 64 + p) * 16 + c];
            const float bi = P->in[I_BIM][((size_t)(l * 16 + g) * 64 + p) * 16 + c];
            bbar[(p * 16 + c) * 2] = fr * br - fi * bi;
            bbar[(p * 16 + c) * 2 + 1] = fr * bi + fi * br;
        }
    }
    for (int e = tid; e < 1024; e += 256) {
        cc[e * 2] = P->in[I_CRE][(size_t)(l * 16 + g) * 1024 + e];
        cc[e * 2 + 1] = P->in[I_CIM][(size_t)(l * 16 + g) * 1024 + e];
    }
    __syncthreads();
    if (item < 256) {
        const int c = item & 15;
        float* kt = cc + 2048;
        for (int idx = tid; idx < 512; idx += 256) {
            const int lag = idx >> 4, c2 = idx & 15;
            float a = 0.f;
            for (int p = 0; p < 64; ++p) {
                const float cr = cc[(c * 64 + p) * 2], ci = cc[(c * 64 + p) * 2 + 1];
                const float xr = apow[(p * 33 + lag) * 2], xi = apow[(p * 33 + lag) * 2 + 1];
                const float br = bbar[(p * 16 + c2) * 2], bi = bbar[(p * 16 + c2) * 2 + 1];
                const float tr = cr * xr - ci * xi, ti = cr * xi + ci * xr;
                a += tr * br - ti * bi;
            }
            kt[idx] = a;
        }
        __syncthreads();
        h16* W = (h16*)(P->ws + OFF_S5W) + (size_t)g * 512 * 640;
        for (int idx = tid; idx < 32 * 640; idx += 256) {
            const int j = idx / 640, k = idx % 640;
            float val = 0.f;
            if (k < 512) {
                const int s = k >> 4, c2 = k & 15, lag = j - s;
                if (lag >= 0) val = kt[lag * 16 + c2];
            } else {
                const int p = (k - 512) >> 1;
                const float cr = cc[(c * 64 + p) * 2], ci = cc[(c * 64 + p) * 2 + 1];
                const float xr = apow[(p * 33 + j + 1) * 2], xi = apow[(p * 33 + j + 1) * 2 + 1];
                val = (k & 1) ? -(cr * xi + ci * xr) : (cr * xr - ci * xi);
            }
            W[(size_t)(j * 16 + c) * 640 + k] = (h16)val;
        }
    } else {
        const int pq = (item - 256) & 3;
        h16* E = (h16*)(P->ws + OFF_S5E) + ((size_t)g * 128 + pq * 32) * 512;
        for (int idx = tid; idx < 32 * 512; idx += 256) {
            const int nl = idx >> 9, k = idx & 511;
            const int p = pq * 16 + (nl >> 1), s = k >> 4, c2 = k & 15;
            const float xr = apow[(p * 33 + 31 - s) * 2], xi = apow[(p * 33 + 31 - s) * 2 + 1];
            const float br = bbar[(p * 16 + c2) * 2], bi = bbar[(p * 16 + c2) * 2 + 1];
            const float val = (nl & 1) ? (xr * bi + xi * br) : (xr * br - xi * bi);
            E[(size_t)nl * 512 + k] = (h16)val;
        }
        if (tid < 16) {
            const int p = pq * 16 + tid;
            float* AL = (float*)(P->ws + OFF_S5AL);
            AL[(g * 64 + p) * 2] = apow[(p * 33 + 32) * 2];
            AL[(g * 64 + p) * 2 + 1] = apow[(p * 33 + 32) * 2 + 1];
        }
    }
    __syncthreads();
}

template <int WR, int MI>
DI void inproj_tile(PP P, int l, int m0, int n0, char* smem, const int wv) {
    P = plaunder(P);
    constexpr int WC = 4 / WR;
    f32x4 acc[MI][4];
    float ss[MI];
    gemm_glds<true, WR, MI, 4, (WR == 2 && MI == 8) ? 3 : 4>(wv, 1024, APlain{(const h16*)(P->ws + OFF_XH) + (size_t)m0 * 64, 64, (size_t)NT * 64},
                               (const h16*)(P->ws + OFF_WTIN) + ((size_t)l * 16 * D_IN_PAD + n0) * 64, 64, acc, ss, smem, (size_t)D_IN_PAD * 64);
    const int tid = otid(wv), lane = tid & 63, wid = tid >> 6, wr = wid / WC, wc = wid % WC;
    h16* proj = (h16*)(P->ws + OFF_PROJ);
    const int n64 = n0 + wc * 64;
    int cls = 0;
    if (n64 < 512) cls = 1;
    else if (n64 >= C_NKV + 256 && n64 < C_NKV + 384) cls = 2;
    else if (n64 >= C_NKV + 512 && n64 < C_NKV + 640) cls = 3;
    else if (n64 >= C_NKV + 384 && n64 < C_NKV + 512) cls = 4;
    else if (n64 >= C_NKV + 640 && n64 < C_NKV + 768) cls = 5;
    float wn[4][4];
    if (cls >= 1 && cls <= 3) {
        const float* wp = (cls == 1) ? P->in[I_NQN] + l * 64 : P->in[I_NKN] + (l * 3 + (cls - 1)) * 64;
        const float sc = (cls == 1) ? QSCALE : 1.f;
#pragma unroll
        for (int j = 0; j < 4; ++j) {
            const float4 w4 = *(const float4*)(wp + j * 16 + (lane >> 4) * 4);
            wn[j][0] = w4.x * sc; wn[j][1] = w4.y * sc; wn[j][2] = w4.z * sc; wn[j][3] = w4.w * sc;
        }
    }
#pragma unroll
    for (int i = 0; i < MI; ++i) {
        const int ml = wr * MI * 16 + i * 16 + (lane & 15);
        const float r = rsqrtf(ss[i] * (1.f / 1024.f) + 1e-6f);
        const size_t row = (size_t)m0 + ml;
        f32x4 v[4];
#pragma unroll
        for (int j = 0; j < 4; ++j) v[j] = acc[i][j] * r;
        if (cls >= 1 && cls <= 3) {
            float s2 = 0.f;
#pragma unroll
            for (int j = 0; j < 4; ++j) s2 += v[j][0] * v[j][0] + v[j][1] * v[j][1] + v[j][2] * v[j][2] + v[j][3] * v[j][3];
            s2 += __shfl_xor(s2, 16); s2 += __shfl_xor(s2, 32);
            const float rn = rsqrtf(s2 * (1.f / 64.f) + 1e-6f);
#pragma unroll
            for (int j = 0; j < 4; ++j) { v[j][0] *= rn * wn[j][0]; v[j][1] *= rn * wn[j][1]; v[j][2] *= rn * wn[j][2]; v[j][3] *= rn * wn[j][3]; }
        }
        if (cls >= 4) {
            const int g = (n64 >> 6) & 1, br = cls - 4;
            const int b = (int)(row >> 13), t = (int)(row & 8191);
            h16* vt = (h16*)(P->ws + OFF_VTG) + ((((size_t)br * 4 + b * 2 + g) * 128 + (t >> 6)) * 64) * 64 + (t & 63);
#pragma unroll
            for (int j = 0; j < 4; ++j)
#pragma unroll
                for (int e = 0; e < 4; ++e) vt[(j * 16 + (lane >> 4) * 4 + e) * 64] = (h16)v[j][e];
        }
#pragma unroll
        for (int j = 0; j < 4; ++j) {
            const int n = n64 + j * 16 + (lane >> 4) * 4;
            if (n < D_IN) *(half4*)(proj + row * D_IN + n) = (half4){(h16)v[j][0], (h16)v[j][1], (h16)v[j][2], (h16)v[j][3]};
        }
        __builtin_amdgcn_sched_barrier(0);
    }
    __syncthreads();
}


DI void cmp_gemm_tile(PP P, int l, int tile, char* smem, const int wv) {
    P = plaunder(P);
    const int j = tile >> 6, mt = (tile >> 2) & 15, nt = tile & 3;
    const int row0 = mt * 128, bg = row0 >> 9, i0 = row0 & 511, b = bg >> 1, g = bg & 1;
    f32x4 acc[4][4];
    float ssd[4];
    gemm_mainloop_glds<false>(wv, 1024, APlain{(const h16*)(P->ws + OFF_PROJ) + ((size_t)b * SEQ + 16 * i0) * D_IN + C_NKV + j * 128 + g * 64, (size_t)16 * D_IN, (size_t)D_IN},
                              (const h16*)(P->ws + OFF_WTC1) + ((size_t)(l * 2 + j) * 16 * 512 + nt * 128) * 64, 64, acc, ssd, smem, (size_t)512 * 64);
    const int tid = otid(wv), lane = tid & 63, wid = tid >> 6, wr = wid >> 1, wc = wid & 1;
    float* pt = (float*)(P->ws + OFF_CHID) + (size_t)j * 2048 * 512;
#pragma unroll
    for (int i = 0; i < 4; ++i) {
        const size_t row = (size_t)row0 + wr * 64 + i * 16 + (lane & 15);
#pragma unroll
        for (int jj = 0; jj < 4; ++jj) {
            const int n = nt * 128 + wc * 64 + jj * 16 + (lane >> 4) * 4;
            const f32x4 v = acc[i][jj];
            *(float4*)(pt + row * 512 + n) = (float4){v[0], v[1], v[2], v[3]};
        }
    }
}

DI void s5e_gemm_tile(PP P, int l, int tile, char* smem, const int wv) {
    P = plaunder(P);
    const int g = tile >> 2, mt = tile & 3;
    f32x4 acc[4][4];
    float ssd[4];
    gemm_mainloop_glds<false>(wv, 512, AS5{(const h16*)(P->ws + OFF_PROJ) + C_SU + g * 16, nullptr, mt * 128},
                              (const h16*)(P->ws + OFF_S5E) + (size_t)g * 128 * 512, 512, acc, ssd, smem);
    const int tid = otid(wv), lane = tid & 63, wid = tid >> 6, wr = wid >> 1, wc = wid & 1;
    float* xc = (float*)(P->ws + OFF_XC);
#pragma unroll
    for (int i = 0; i < 4; ++i) {
        const size_t ch = (size_t)mt * 128 + wr * 64 + i * 16 + (lane & 15);
#pragma unroll
        for (int jj = 0; jj < 4; ++jj) {
            const int n = wc * 64 + jj * 16 + (lane >> 4) * 4;
            const f32x4 v = acc[i][jj];
            *(float4*)(xc + (ch * 1024 + g * 64) * 2 + n) = (float4){v[0], v[1], v[2], v[3]};
        }
    }
}

DI void gla_scan_item(PP P, int item, char* smem, const int wv) {
    P = plaunder(P);
    const int tid = otid(wv), sl = tid & 31, part = tid >> 5;
    const int idx = item * 32 + sl, bh = idx >> 11, de = idx & 2047, d = de >> 6;
    float* kv = (float*)(P->ws + OFF_GKV) + ((size_t)bh * 256 + part * 32) * 2048 + de;
    const float* dc = (const float*)(P->ws + OFF_GDEC) + ((size_t)bh * 256 + part * 32) * 32 + d;
    float* sD = (float*)smem; float* sL = sD + 256;
    float kvv[32], dd[32];
#pragma unroll
    for (int i = 0; i < 32; ++i) { kvv[i] = kv[(size_t)i * 2048]; dd[i] = dc[i * 32]; }
    float D = 1.f, L = 0.f;
#pragma unroll
    for (int i = 0; i < 32; ++i) { L = dd[i] * L + kvv[i]; D *= dd[i]; }
    sD[part * 32 + sl] = D; sL[part * 32 + sl] = L;
    __syncthreads();
    float S = 0.f;
    for (int q = 0; q < part; ++q) S = sD[q * 32 + sl] * S + sL[q * 32 + sl];
#pragma unroll
    for (int i = 0; i < 32; ++i) { const float o = S; S = dd[i] * S + kvv[i]; kv[(size_t)i * 2048] = o; }
    __syncthreads();
}
DI void s5_scan_item(PP P, int item, char* smem, const int wv) {
    P = plaunder(P);
    const int tid = otid(wv), sl = tid & 31, part = tid >> 5;
    const int idx = item * 32 + sl, b = idx >> 10, s = idx & 1023;
    float2* xc = (float2*)(P->ws + OFF_XC) + ((size_t)b * 256 + part * 32) * 1024 + s;
    half2_* xch = (half2_*)(P->ws + OFF_XCH) + ((size_t)b * 256 + part * 32) * 1024 + s;
    const float2 a = ((const float2*)(P->ws + OFF_S5AL))[s];
    float2* sL = (float2*)smem;
    float2 c[32];
#pragma unroll
    for (int i = 0; i < 32; ++i) c[i] = xc[(size_t)i * 1024];
    float lr = 0.f, li = 0.f;
#pragma unroll
    for (int i = 0; i < 32; ++i) { const float nr = a.x * lr - a.y * li + c[i].x, ni = a.x * li + a.y * lr + c[i].y; lr = nr; li = ni; }
    float dr = a.x, di = a.y;
#pragma unroll
    for (int i = 0; i < 5; ++i) { const float nr = dr * dr - di * di, ni = 2.f * dr * di; dr = nr; di = ni; }
    sL[part * 32 + sl] = (float2){lr, li};
    __syncthreads();
    float xr = 0.f, xi = 0.f;
    for (int q = 0; q < part; ++q) { const float2 lq = sL[q * 32 + sl]; const float nr = dr * xr - di * xi + lq.x, ni = dr * xi + di * xr + lq.y; xr = nr; xi = ni; }
#pragma unroll
    for (int i = 0; i < 32; ++i) {
        const float2 o = (float2){xr, xi};
        const float nr = a.x * xr - a.y * xi + c[i].x, ni = a.x * xi + a.y * xr + c[i].y; xr = nr; xi = ni;
        xc[(size_t)i * 1024] = o;
        xch[(size_t)i * 1024] = (half2_){(h16)o.x, (h16)o.y};
    }
    __syncthreads();
}
DI void cmp_l2_item(PP P, int l, int item, char* smem, const int wv) {
    P = plaunder(P);
    const int tid = otid(wv), lane = tid & 63, w = tid >> 6;
    const int j = item >> 8, r0 = (item & 255) * 8;
    h16* w2s = (h16*)smem;
    float* hs = (float*)(smem + 32768);
    {
        const float* w2 = P->in[I_CW2] + (size_t)(l * 2 + j) * 256 * 64;
        for (int e = tid * 4; e < 256 * 64; e += 1024) {
            const float4 v = *(const float4*)(w2 + e);
            *(half4*)(w2s + e) = (half4){(h16)v.x, (h16)v.y, (h16)v.z, (h16)v.w};
        }
        const float* pt = (const float*)(P->ws + OFF_CHID) + (size_t)j * 2048 * 512;
        float pb = 0.f;
#pragma unroll
        for (int ks = 0; ks < 16; ++ks) pb += ((const float*)(P->ws + OFF_POSB))[((l * 2 + j) * 16 + ks) * 256 + tid];
#pragma unroll
        for (int rr = 0; rr < 8; ++rr) {
            const int row = r0 + rr, i = row & 511;
            float v = 0.f;
            if (i < 511) v = gelu_tanh(pt[(size_t)row * 512 + tid] + pt[(size_t)(row + 1) * 512 + 256 + tid] + pb);
            hs[rr * 256 + tid] = v;
        }
    }
    __syncthreads();
    const float bb = P->in[I_CB2][(l * 2 + j) * 64 + lane];
    float a0 = bb, a1 = bb;
    const float* h0 = hs + (2 * w) * 256, *h1 = h0 + 256;
#pragma unroll 8
    for (int n = 0; n < 256; ++n) {
        const float wv = (float)w2s[n * 64 + lane];
        a0 += h0[n] * wv; a1 += h1[n] * wv;
    }
#pragma unroll
    for (int rr = 0; rr < 2; ++rr) {
        float acc = rr ? a1 : a0;
        const int row = r0 + 2 * w + rr, bg = row >> 9, i = row & 511;
        if (i == 511) acc = 0.f;
        if (j == 0) {
            const float ss = wave_sum(acc * acc);
            acc = acc * rsqrtf(ss * (1.f / 64.f) + 1e-6f) * P->in[I_NKN][(l * 3 + 0) * 64 + lane];
            ((h16*)(P->ws + OFF_KCMP))[(size_t)row * 64 + lane] = (h16)acc;
        } else {
            ((h16*)(P->ws + OFF_VCMP))[(((size_t)bg * 8 + (i >> 6)) * 64 + lane) * 64 + (i & 63)] = (h16)acc;
        }
    }
    __syncthreads();
}

DI void s5o_gemm_tile(PP P, int l, int tile, char* smem, const int wv) {
    P = plaunder(P);
    const int g = tile >> 5, mt = (tile >> 3) & 3, nt = tile & 7;
    f32x4 acc[2][4];
    float ssd[2];
    gemm_glds<false, 4, 2, 4>(wv, 640, AS5{(const h16*)(P->ws + OFF_PROJ) + C_SU + g * 16, (const h16*)(P->ws + OFF_XCH) + g * 128, mt * 128},
                              (const h16*)(P->ws + OFF_S5W) + ((size_t)g * 512 + nt * 64) * 640, 640, acc, ssd, smem);
    const int tid = otid(wv), lane = tid & 63, wid = tid >> 6;
    const h16* proj = (const h16*)(P->ws + OFF_PROJ);
    h16* yact = (h16*)(P->ws + OFF_YACT);
#pragma unroll
    for (int i = 0; i < 2; ++i) {
        const size_t ch = (size_t)mt * 128 + wid * 32 + i * 16 + (lane & 15);
#pragma unroll
        for (int jj = 0; jj < 4; ++jj) {
            const int n = nt * 64 + jj * 16 + (lane >> 4) * 4;
            const int j = n >> 4, c = n & 15;
            const size_t tok = ch * 32 + j;
            const half4 u4 = *(const half4*)(proj + tok * D_IN + C_SU + g * 16 + c);
            const float4 dd = *(const float4*)(P->in[I_SD] + (l * 16 + g) * 16 + c);
            const f32x4 v = acc[i][jj];
            half4 o;
            o[0] = (h16)gelu_tanh(v[0] + dd.x * (float)u4[0]);
            o[1] = (h16)gelu_tanh(v[1] + dd.y * (float)u4[1]);
            o[2] = (h16)gelu_tanh(v[2] + dd.z * (float)u4[2]);
            o[3] = (h16)gelu_tanh(v[3] + dd.w * (float)u4[3]);
            *(half4*)(yact + tok * 256 + g * 16 + c) = o;
        }
    }
}

#define MFMA32(a, b, c) __builtin_amdgcn_mfma_f32_32x32x16_f16((a), (b), (c), 0, 0, 0)
constexpr float FAST_SHIFT = 4.f;
constexpr float NEGS = -1e30f;
DI float ex2(float x) { return __builtin_amdgcn_exp2f(x); }
#define NSA_WAITBAR(N) asm volatile("s_waitcnt vmcnt(" #N ") lgkmcnt(0)\n\ts_barrier" ::: "memory")
#define NSA_BAR() asm volatile("s_waitcnt lgkmcnt(0)\n\ts_barrier" ::: "memory")

struct KVSrc { const h16* k; int ldk; size_t kstep; const h16* v; };
DI void nsa_dma(const KVSrc& s, int j, char* stage, int wid, int lane) {
    const int row0 = wid * 8 + (lane >> 3);
    const int sw = ((lane & 7) ^ ((row0 >> 1) & 7)) * 8;
    const h16* kp = s.k + (size_t)j * s.kstep + (size_t)row0 * s.ldk + sw;
    glds16(kp, stage + wid * 1024);
    glds16(kp + (size_t)32 * s.ldk, stage + 4096 + wid * 1024);
    const h16* vp = s.v + (size_t)j * 4096 + row0 * 64 + sw;
    glds16(vp, stage + 8192 + wid * 1024);
    glds16(vp + 32 * 64, stage + 8192 + 4096 + wid * 1024);
}
template <int NST, class F>
DI void nsa_pipe(const KVSrc& s, const int n, char* smem, int wid, int lane, F&& compute) {
    NSA_WAITBAR(0);
    {
        const int k = n < NST - 1 ? n : NST - 1;
        for (int p = 0; p < k; ++p) nsa_dma(s, p, smem + p * 16384, wid, lane);
        if (k >= 3) NSA_WAITBAR(8); else if (k == 2) NSA_WAITBAR(4); else NSA_WAITBAR(0);
    }
    for (int j = 0; j < n; ++j) {
        if (NST == 4 && j + 2 < n) NSA_WAITBAR(4); else NSA_WAITBAR(0);
        const int jn = j + NST - 1;
        compute(j, smem + (j % NST) * 16384, [&]() { if (jn < n) nsa_dma(s, jn, smem + (jn % NST) * 16384, wid, lane); });
    }
}

template <bool SHIFT = false>
DI void qk_tile(const char* Kimg, const half8 (&qf)[4], f32x16 (&s)[2], int lane) {
    const int r = lane & 31, h = lane >> 5, swz = (r >> 1) & 7;
    const char* base = Kimg + r * 128;
#pragma unroll
    for (int kt = 0; kt < 2; ++kt) {
        half8 kf[4];
#pragma unroll
        for (int ks = 0; ks < 4; ++ks) kf[ks] = *(const half8*)(base + kt * 4096 + (((2 * ks + h) ^ swz) << 4));
#pragma unroll
        for (int e = 0; e < 16; ++e) s[kt][e] = SHIFT ? -FAST_SHIFT : 0.f;
#pragma unroll
        for (int ks = 0; ks < 4; ++ks) s[kt] = MFMA32(kf[ks], qf[ks], s[kt]);
    }
}
template <int S> DI half8 pack8(const f32x16& x) {
    return (half8){(h16)x[8 * S], (h16)x[8 * S + 1], (h16)x[8 * S + 2], (h16)x[8 * S + 3], (h16)x[8 * S + 4], (h16)x[8 * S + 5], (h16)x[8 * S + 6], (h16)x[8 * S + 7]};
}
DI half8 ld_vfrag(const char* Vimg, int off0) {
    const half4 lo = *(const half4*)(Vimg + off0), hi = *(const half4*)(Vimg + (off0 ^ 16));
    return (half8){lo[0], lo[1], lo[2], lo[3], hi[0], hi[1], hi[2], hi[3]};
}
template <int KT>
DI void pv_load(const char* Vimg, half8 (&vf)[4], int lane) {
    const int r = lane & 31, h = lane >> 5, swz16 = ((r >> 1) & 7) << 4;
    const char* rb = Vimg + r * 128 + 8 * h;
#pragma unroll
    for (int dt = 0; dt < 2; ++dt) {
        vf[dt * 2 + 0] = ld_vfrag(rb + dt * 4096, ((4 * KT) << 4) ^ swz16);
        vf[dt * 2 + 1] = ld_vfrag(rb + dt * 4096, ((4 * KT + 2) << 4) ^ swz16);
    }
}
typedef unsigned u32x4_ __attribute__((ext_vector_type(4)));
template <int KT, bool MASKED = false>
DI void pv_mma(const half8 (&vf)[4], const f32x16 (&p)[2], f32x16 (&o)[2], const unsigned rmask = 0xffffffffu) {
    half8 pb0 = pack8<0>(p[KT]), pb1 = pack8<1>(p[KT]);
    if (MASKED) {
        pb0 = __builtin_bit_cast(half8, __builtin_bit_cast(u32x4_, pb0) & rmask);
        pb1 = __builtin_bit_cast(half8, __builtin_bit_cast(u32x4_, pb1) & rmask);
    }
#pragma unroll
    for (int dt = 0; dt < 2; ++dt) {
        o[dt] = MFMA32(vf[dt * 2 + 0], pb0, o[dt]);
        o[dt] = MFMA32(vf[dt * 2 + 1], pb1, o[dt]);
    }
}
template <bool MASKED = false>
DI void pv_finish(const char* Vimg, const half8 (&va)[4], const f32x16 (&p)[2], f32x16 (&o)[2], int lane, const unsigned rmask = 0xffffffffu) {
    half8 vb[4];
    pv_load<1>(Vimg, vb, lane);
    pv_mma<0, MASKED>(va, p, o, rmask);
    pv_mma<1, MASKED>(vb, p, o, rmask);
}
DI float sm_fast(f32x16 (&s)[2]) {
    float rs = 0.f;
#pragma unroll
    for (int kt = 0; kt < 2; ++kt)
#pragma unroll
        for (int e = 0; e < 16; ++e) { const float p = ex2(s[kt][e]); s[kt][e] = p; rs += p; }
    return rs;
}
DI float xhalf_max(float v) {
    const auto r = __builtin_amdgcn_permlane32_swap(__float_as_uint(v), __float_as_uint(v), false, false);
    return fmaxf(__uint_as_float(r[0]), __uint_as_float(r[1]));
}
DI float xhalf_sum(float v) {
    const auto r = __builtin_amdgcn_permlane32_swap(__float_as_uint(v), __float_as_uint(v), false, false);
    return __uint_as_float(r[0]) + __uint_as_float(r[1]);
}
DI float rowmax32(const f32x16 (&s)[2]) {
    float mx = s[0][0];
#pragma unroll
    for (int e = 1; e < 16; ++e) mx = fmaxf(mx, s[0][e]);
#pragma unroll
    for (int e = 0; e < 16; ++e) mx = fmaxf(mx, s[1][e]);
    return xhalf_max(mx);
}
constexpr float SM_THR = 6.f;
DI void sm_online(f32x16 (&s)[2], float& m, float& l, f32x16 (&o)[2], const bool rowok) {
    float mx = rowmax32(s);
    mx = rowok ? mx : NEGS;
    if (__any(mx > m + SM_THR)) {
        const float mn = fmaxf(m, mx), alpha = ex2(m - mn);
        l *= alpha; o[0] *= alpha; o[1] *= alpha; m = mn;
    }
    const float msub = rowok ? m : 1e30f;
    float rs = 0.f;
#pragma unroll
    for (int kt = 0; kt < 2; ++kt)
#pragma unroll
        for (int e = 0; e < 16; ++e) { const float p = ex2(s[kt][e] - msub); s[kt][e] = p; rs += p; }
    l += xhalf_sum(rs);
}

template <int V> struct IC { static constexpr int value = V; };
template <bool FAST>
DI void nsa_unit(PP P, int l, int bg, int c32, char* smem, const int wv) {
    P = plaunder(P);
    const int tid = otid(wv), lane = tid & 63, w = tid >> 6, r = lane & 31, h = lane >> 5;
    const int b = bg >> 1, g = bg & 1, t0 = c32 * 32, cur = c32 >> 1;
    const int tokl = w * 8 + (r >> 2), head = r & 3, t = t0 + tokl;
    const size_t tokg = (size_t)b * SEQ + t;
    float* IMP = (float*)(smem + 49152);
    unsigned* SELM = (unsigned*)(smem + 49152);
    const h16* proj = (const h16*)(P->ws + OFF_PROJ);
    const int ghead = g * 4 + head;

    half8 qf[4];
    {
        const h16* qp = proj + tokg * D_IN + C_NQ + ghead * 64 + 8 * h;
#pragma unroll
        for (int ks = 0; ks < 4; ++ks) qf[ks] = *(const half8*)(qp + 16 * ks);
    }
    float g0, g1, g2;
    {
        const h16* gp = proj + tokg * D_IN + C_NGL + ghead * 3;
        const float* gb = P->in[I_NGB] + l * 24 + ghead * 3;
        g0 = sigmoidf_((float)gp[0] + gb[0]); g1 = sigmoidf_((float)gp[1] + gb[1]); g2 = sigmoidf_((float)gp[2] + gb[2]);
    }
    __syncthreads();
    for (int i = tid; i < 32 * 128; i += 256) IMP[i] = 0.f;

    half8 oacc[4];
    auto oacc_add = [&](const f32x16 (&o)[2], const float sc, const bool first) {
#pragma unroll
        for (int dt = 0; dt < 2; ++dt)
#pragma unroll
            for (int hf = 0; hf < 2; ++hf) {
                half8 v = oacc[dt * 2 + hf];
#pragma unroll
                for (int e = 0; e < 8; ++e) v[e] = (h16)((first ? 0.f : (float)v[e]) + o[dt][hf * 8 + e] * sc);
                oacc[dt * 2 + hf] = v;
            }
    };

    {
        const int nvt = 2 * c32 + 1;
        const int nvr = (t >= 31) ? ((t - 31) >> 4) + 1 : 0;
        const int ntile = (nvt + 63) >> 6;
        KVSrc src{(const h16*)(P->ws + OFF_KCMP) + (size_t)bg * 512 * 64, 64, 4096, (const h16*)(P->ws + OFF_VCMP) + (size_t)bg * 8 * 4096};
        f32x16 o[2];
#pragma unroll
        for (int e = 0; e < 16; ++e) { o[0][e] = 0.f; o[1][e] = 0.f; }
        float invl;
        if constexpr (FAST) {
            const int tf = t0 + w * 8;
            const int nvlo = __builtin_amdgcn_readfirstlane((tf >= 31) ? ((tf - 31) >> 4) + 1 : 0);
            float lsum = 0.f;
            nsa_pipe<3>(src, ntile, smem, w, lane, [&](int j, const char* st, auto&& issue) {
                f32x16 s[2];
                qk_tile<true>(st, qf, s, lane);
                issue();
                if (64 * j + 64 > nvlo) {
#pragma unroll
                    for (int kt = 0; kt < 2; ++kt)
#pragma unroll
                        for (int e = 0; e < 16; ++e) {
                            const int key = 64 * j + 32 * kt + 8 * (e >> 2) + 4 * h + (e & 3);
                            if (key >= nvr) s[kt][e] = NEGS;
                        }
                }
                lsum += sm_fast(s);
            });
            lsum = xhalf_sum(lsum);
            invl = lsum > 0.f ? 1.f / lsum : 0.f;
            nsa_pipe<3>(src, ntile, smem, w, lane, [&](int j, const char* st, auto&& issue) {
                f32x16 s[2];
                qk_tile<true>(st, qf, s, lane);
                half8 vf[4];
                pv_load<0>(st + 8192, vf, lane);
                issue();
                __builtin_amdgcn_sched_barrier(0);
                if (64 * j + 64 > nvlo) {
#pragma unroll
                    for (int kt = 0; kt < 2; ++kt)
#pragma unroll
                        for (int e = 0; e < 16; ++e) {
                            const int key = 64 * j + 32 * kt + 8 * (e >> 2) + 4 * h + (e & 3);
                            if (key >= nvr) s[kt][e] = NEGS;
                        }
                }
                (void)sm_fast(s);
                if (cur >= 16) {
#pragma unroll
                    for (int kt = 0; kt < 2; ++kt)
#pragma unroll
                        for (int g4 = 0; g4 < 4; ++g4) {
                            float G = ((s[kt][4 * g4] + s[kt][4 * g4 + 1]) + (s[kt][4 * g4 + 2] + s[kt][4 * g4 + 3])) * invl;
                            float L = s[kt][4 * g4 + 3] * invl;
                            G += __shfl_xor(G, 1); G += __shfl_xor(G, 2);
                            L += __shfl_xor(L, 1); L += __shfl_xor(L, 2);
                            if (head == 0) {
                                const int sb = 16 * j + 8 * kt + 2 * g4 + h;
                                atomicAdd(&IMP[tokl * 128 + sb], G);
                                if (sb + 1 < 128) atomicAdd(&IMP[tokl * 128 + sb + 1], L);
                            }
                        }
                }
                pv_finish(st + 8192, vf, s, o, lane);
            });
        } else {
        float m = -1e20f, lsum = 0.f;
        nsa_pipe<3>(src, ntile, smem, w, lane, [&](int j, const char* st, auto&& issue) {
            f32x16 s[2];
            qk_tile(st, qf, s, lane);
            issue();
#pragma unroll
            for (int kt = 0; kt < 2; ++kt)
#pragma unroll
                for (int e = 0; e < 16; ++e) {
                    const int key = 64 * j + 32 * kt + 8 * (e >> 2) + 4 * h + (e & 3);
                    if (key >= nvr) s[kt][e] = NEGS;
                }
            const float mn = fmaxf(m, rowmax32(s)), alpha = ex2(m - mn);
            float rs = 0.f;
#pragma unroll
            for (int kt = 0; kt < 2; ++kt)
#pragma unroll
                for (int e = 0; e < 16; ++e) rs += ex2(s[kt][e] - mn);
            rs = xhalf_sum(rs);
            lsum = lsum * alpha + rs; m = mn;
        });
        const float invl_s = lsum > 0.f ? 1.f / lsum : 0.f;
        nsa_pipe<3>(src, ntile, smem, w, lane, [&](int j, const char* st, auto&& issue) {
            f32x16 s[2];
            qk_tile(st, qf, s, lane);
            half8 vf[4];
            pv_load<0>(st + 8192, vf, lane);
            issue();
            __builtin_amdgcn_sched_barrier(0);
#pragma unroll
            for (int kt = 0; kt < 2; ++kt)
#pragma unroll
                for (int e = 0; e < 16; ++e) {
                    const int key = 64 * j + 32 * kt + 8 * (e >> 2) + 4 * h + (e & 3);
                    s[kt][e] = (key < nvr) ? ex2(s[kt][e] - m) * invl_s : 0.f;
                }
            if (cur >= 16) {
#pragma unroll
                for (int kt = 0; kt < 2; ++kt)
#pragma unroll
                    for (int g4 = 0; g4 < 4; ++g4) {
                        float G = (s[kt][4 * g4] + s[kt][4 * g4 + 1]) + (s[kt][4 * g4 + 2] + s[kt][4 * g4 + 3]);
                        float L = s[kt][4 * g4 + 3];
                        G += __shfl_xor(G, 1); G += __shfl_xor(G, 2);
                        L += __shfl_xor(L, 1); L += __shfl_xor(L, 2);
                        if (head == 0) {
                            const int sb = 16 * j + 8 * kt + 2 * g4 + h;
                            atomicAdd(&IMP[tokl * 128 + sb], G);
                            if (sb + 1 < 128) atomicAdd(&IMP[tokl * 128 + sb + 1], L);
                        }
                    }
            }
            pv_finish(st + 8192, vf, s, o, lane);
        });
            invl = 1.f;
        }
        oacc_add(o, g0 * invl, true);
    }
    __syncthreads();
    {
        const int tl = lane >> 3, sub = lane & 7;
        unsigned bits = 0;
        unsigned u[16];
        if (cur >= 16) {
            const float* ip = IMP + (w * 8 + tl) * 128 + sub * 16;
#pragma unroll
            for (int i = 0; i < 16; ++i) {
                const int s = sub * 16 + i;
                u[i] = (s >= 1 && s <= cur - 2) ? (__float_as_uint(ip[i]) + 1u) : 0u;
            }
        }
        __syncthreads();
        if (cur >= 16) {
            unsigned prefix = 0;
            for (int bit = 30; bit >= 0; --bit) {
                const unsigned cand = prefix | (1u << bit);
                int cnt = 0;
#pragma unroll
                for (int i = 0; i < 16; ++i) cnt += (u[i] >= cand) ? 1 : 0;
                cnt += __shfl_xor(cnt, 1); cnt += __shfl_xor(cnt, 2); cnt += __shfl_xor(cnt, 4);
                if (cnt >= 13) prefix = cand;
            }
            int cgt = 0, ceq = 0;
#pragma unroll
            for (int i = 0; i < 16; ++i) { cgt += (u[i] > prefix) ? 1 : 0; ceq += (u[i] == prefix) ? 1 : 0; }
            cgt += __shfl_xor(cgt, 1); cgt += __shfl_xor(cgt, 2); cgt += __shfl_xor(cgt, 4);
            int inc = ceq;
            { const int v = __shfl_up(inc, 1); if (sub >= 1) inc += v; }
            { const int v = __shfl_up(inc, 2); if (sub >= 2) inc += v; }
            { const int v = __shfl_up(inc, 4); if (sub >= 4) inc += v; }
            int run = inc - ceq;
            const int need = 13 - cgt;
#pragma unroll
            for (int i = 0; i < 16; ++i) {
                const int s = sub * 16 + i;
                bool sel = u[i] > prefix;
                if (u[i] == prefix) { sel = run < need; ++run; }
                if (s == 0 || s == cur || s == cur - 1) sel = true;
                bits |= (sel ? 1u : 0u) << i;
            }
        } else {
#pragma unroll
            for (int i = 0; i < 16; ++i) bits |= ((sub * 16 + i <= cur) ? 1u : 0u) << i;
        }
        unsigned wv = bits << ((sub & 1) * 16);
        wv |= __shfl_xor(wv, 1);
        if ((sub & 1) == 0) SELM[(w * 8 + tl) * 4 + (sub >> 1)] = wv;
    }
    __syncthreads();
    unsigned selw[4];
#pragma unroll
    for (int i = 0; i < 4; ++i) selw[i] = SELM[tokl * 4 + i];

    auto branch = [&](auto BRC) {
        constexpr int br = decltype(BRC)::value;
        const int j0 = (br == 0) ? 0 : (cur - 8 > 0 ? cur - 8 : 0);
        const int nst = cur - j0 + 1;
        KVSrc src{proj + ((size_t)b * SEQ + (size_t)j0 * 64) * D_IN + C_NKV + (br == 0 ? 256 : 512) + g * 64, D_IN, (size_t)64 * D_IN,
                  (const h16*)(P->ws + OFF_VTG) + (((size_t)br * 4 + bg) * 128 + j0) * 4096};
        float m = -1e20f, lsum = 0.f;
        f32x16 o[2];
#pragma unroll
        for (int e = 0; e < 16; ++e) { o[0][e] = 0.f; o[1][e] = 0.f; }
        nsa_pipe<4>(src, nst, smem, w, lane, [&](int jj, const char* st, auto&& issue) {
            const int j = j0 + jj;
            const bool rowok = (br != 0) || (((selw[j >> 5] >> (j & 31)) & 1u) != 0u);
            if constexpr (FAST && br == 0) {
                if (!__any(rowok)) { issue(); return; }
            }
            f32x16 s[2];
            qk_tile<FAST>(st, qf, s, lane);
            half8 vf[4];
            pv_load<0>(st + 8192, vf, lane);
            issue();
            __builtin_amdgcn_sched_barrier(0);
            if (j == cur || (br == 1 && j == cur - 8)) {
#pragma unroll
                for (int kt = 0; kt < 2; ++kt)
#pragma unroll
                    for (int e = 0; e < 16; ++e) {
                        const int key = 64 * j + 32 * kt + 8 * (e >> 2) + 4 * h + (e & 3);
                        const bool ok = (key <= t) && (br == 0 || key > t - 512);
                        if (!ok) s[kt][e] = NEGS;
                    }
            }
            if constexpr (FAST) {
                const float rs = sm_fast(s);
                lsum += (br != 0 || rowok) ? rs : 0.f;
                pv_finish<br == 0>(st + 8192, vf, s, o, lane, rowok ? 0xffffffffu : 0u);
            } else {
                sm_online(s, m, lsum, o, rowok);
                pv_finish(st + 8192, vf, s, o, lane);
            }
        });
        if constexpr (FAST) lsum = xhalf_sum(lsum);
        const float sc = (br == 0 ? g1 : g2) / lsum;
        oacc_add(o, sc, false);
    };
    branch(IC<0>{});
    branch(IC<1>{});
    {
        h16* mixp = (h16*)(P->ws + OFF_MIX) + kb_idx(NT, tokg, 512 + ghead * 64);
        const h16* ngp = proj + tokg * D_IN + C_NG + ghead * 64;
#pragma unroll
        for (int dt = 0; dt < 2; ++dt)
#pragma unroll
            for (int g4 = 0; g4 < 4; ++g4) {
                const int d0 = 32 * dt + 8 * g4 + 4 * h;
                const half4 ng = *(const half4*)(ngp + d0);
                half4 ov;
#pragma unroll
                for (int e = 0; e < 4; ++e) ov[e] = (h16)((float)oacc[dt * 2 + (g4 >> 1)][(g4 & 1) * 4 + e] * siluf_((float)ng[e]));
                *(half4*)(mixp + d0) = ov;
            }
    }
    __syncthreads();
}

DI void gla_kv_item(PP P, int l, int item, char* smem, const int wv) {
    P = plaunder(P);
    const int tid = otid(wv), lane = tid & 63, w = tid >> 6, r = lane & 31, hh = lane >> 5;
    const int pair = item * 4 + w, h = pair & 3, cn = pair >> 2;
    const size_t tok = (size_t)cn * 32 + r;
    const int b = cn >> 8, n = cn & 255, bh = b * 4 + h;
    const h16* proj = (const h16*)(P->ws + OFF_PROJ);
    h16* VT = (h16*)(smem + w * 16384);
    h16* KT = VT + 2048;
    __syncthreads();
    {
        const half8* vp = (const half8*)(proj + tok * D_IN + C_GV + h * 64 + hh * 32);
#pragma unroll
        for (int q = 0; q < 4; ++q) {
            const half8 v8 = vp[q];
#pragma unroll
            for (int e = 0; e < 8; ++e) VT[(hh * 32 + q * 8 + e) * 32 + r] = v8[e];
        }
    }
    float gl[16];
    {
        const half8* lp = (const half8*)(proj + tok * D_IN + C_GLR);
        const half8 l0 = lp[0], l1 = lp[1];
        float lr[16];
#pragma unroll
        for (int q = 0; q < 8; ++q) { lr[q] = (float)l0[q]; lr[8 + q] = (float)l1[q]; }
        const float* w2 = P->in[I_GW2] + (size_t)l * 16 * 128 + h * 32 + 16 * hh;
        const float* b2 = P->in[I_GB2] + l * 128 + h * 32 + 16 * hh;
#pragma unroll
        for (int d = 0; d < 16; ++d) gl[d] = b2[d];
#pragma unroll
        for (int q = 0; q < 16; ++q)
#pragma unroll
            for (int d4 = 0; d4 < 4; ++d4) {
                const float4 wq = *(const float4*)(w2 + q * 128 + d4 * 4);
                gl[d4 * 4 + 0] += lr[q] * wq.x; gl[d4 * 4 + 1] += lr[q] * wq.y; gl[d4 * 4 + 2] += lr[q] * wq.z; gl[d4 * 4 + 3] += lr[q] * wq.w;
            }
#pragma unroll
        for (int d = 0; d < 16; ++d) gl[d] = log_sigmoidf_(gl[d]) * (1.f / 16.f);
    }
#pragma unroll
    for (int off = 1; off < 32; off <<= 1) {
#pragma unroll
        for (int d = 0; d < 16; ++d) { const float v = __shfl_up(gl[d], off, 32); if (r >= off) gl[d] += v; }
    }
    {
        float* bc = (float*)(P->ws + OFF_BCUM) + tok * 128 + h * 32 + 16 * hh;
#pragma unroll
        for (int d4 = 0; d4 < 4; ++d4) *(float4*)(bc + d4 * 4) = (float4){gl[d4 * 4], gl[d4 * 4 + 1], gl[d4 * 4 + 2], gl[d4 * 4 + 3]};
    }
    {
        const half8* kp = (const half8*)(proj + tok * D_IN + C_GK + h * 32 + 16 * hh);
        const half8 k0 = kp[0], k1 = kp[1];
        float bl[16];
#pragma unroll
        for (int d = 0; d < 16; ++d) bl[d] = __shfl(gl[d], 31, 32);
#pragma unroll
        for (int d = 0; d < 16; ++d) {
            const float kd = (float)(d < 8 ? k0[d & 7] : k1[d & 7]) * __expf(bl[d] - gl[d]);
            KT[(16 * hh + d) * 32 + r] = (h16)kd;
        }
        if (r == 0) {
            float* dc = (float*)(P->ws + OFF_GDEC) + (size_t)(bh * 256 + n) * 32 + 16 * hh;
#pragma unroll
            for (int d4 = 0; d4 < 4; ++d4) *(float4*)(dc + d4 * 4) = (float4){__expf(bl[d4 * 4]), __expf(bl[d4 * 4 + 1]), __expf(bl[d4 * 4 + 2]), __expf(bl[d4 * 4 + 3])};
        }
    }
    asm volatile("s_waitcnt lgkmcnt(0)" ::: "memory");
    const half8 kb0 = *(const half8*)(KT + r * 32 + 8 * hh), kb1 = *(const half8*)(KT + r * 32 + 16 + 8 * hh);
    float* kvp = (float*)(P->ws + OFF_GKV) + ((size_t)(bh * 256 + n) * 32 + r) * 64;
#pragma unroll
    for (int dt = 0; dt < 2; ++dt) {
        f32x16 o;
#pragma unroll
        for (int e = 0; e < 16; ++e) o[e] = 0.f;
        const h16* vrow = VT + (32 * dt + r) * 32 + 8 * hh;
        o = MFMA32(*(const half8*)vrow, kb0, o);
        o = MFMA32(*(const half8*)(vrow + 16), kb1, o);
#pragma unroll
        for (int g4 = 0; g4 < 4; ++g4)
            *(float4*)(kvp + 32 * dt + 8 * g4 + 4 * hh) = (float4){o[4 * g4], o[4 * g4 + 1], o[4 * g4 + 2], o[4 * g4 + 3]};
    }
    __syncthreads();
}

DI void gla_out_item(PP P, int l, int item, char* smem, const int wv) {
    P = plaunder(P);
    const int tid = otid(wv), lane = tid & 63, w = tid >> 6, r = lane & 31, hh = lane >> 5;
    const int pair = item * 4 + w, h = pair & 3, cn = pair >> 2;
    const size_t tok0 = (size_t)cn * 32, tok = tok0 + r;
    const int b = cn >> 8, n = cn & 255, bh = b * 4 + h;
    const h16* proj = (const h16*)(P->ws + OFF_PROJ);
    h16* VT = (h16*)(smem + w * 16384);
    h16* SPT = VT + 2048;
    __syncthreads();
    {
        const half8* vp = (const half8*)(proj + tok * D_IN + C_GV + h * 64 + hh * 32);
        const float4* sp = (const float4*)((const float*)(P->ws + OFF_GKV) + ((size_t)(bh * 256 + n) * 32 + r) * 64 + hh * 32);
#pragma unroll
        for (int q = 0; q < 4; ++q) {
            const half8 v8 = vp[q];
            const float4 s0 = sp[2 * q], s1 = sp[2 * q + 1];
#pragma unroll
            for (int e = 0; e < 8; ++e) VT[(hh * 32 + q * 8 + e) * 32 + r] = v8[e];
            SPT[(hh * 32 + q * 8 + 0) * 32 + r] = (h16)s0.x; SPT[(hh * 32 + q * 8 + 1) * 32 + r] = (h16)s0.y;
            SPT[(hh * 32 + q * 8 + 2) * 32 + r] = (h16)s0.z; SPT[(hh * 32 + q * 8 + 3) * 32 + r] = (h16)s0.w;
            SPT[(hh * 32 + q * 8 + 4) * 32 + r] = (h16)s1.x; SPT[(hh * 32 + q * 8 + 5) * 32 + r] = (h16)s1.y;
            SPT[(hh * 32 + q * 8 + 6) * 32 + r] = (h16)s1.z; SPT[(hh * 32 + q * 8 + 7) * 32 + r] = (h16)s1.w;
        }
    }
    half8 qe[2], ke[2];
#pragma unroll
    for (int ks = 0; ks < 2; ++ks) {
        const int d0 = 16 * ks + 8 * hh;
        const half8 q8 = *(const half8*)(proj + tok * D_IN + C_GQ + h * 32 + d0);
        const half8 k8 = *(const half8*)(proj + tok * D_IN + C_GK + h * 32 + d0);
        const float4 b0 = *(const float4*)((const float*)(P->ws + OFF_BCUM) + tok * 128 + h * 32 + d0);
        const float4 b1 = *(const float4*)((const float*)(P->ws + OFF_BCUM) + tok * 128 + h * 32 + d0 + 4);
        const float bc[8] = {b0.x, b0.y, b0.z, b0.w, b1.x, b1.y, b1.z, b1.w};
#pragma unroll
        for (int e = 0; e < 8; ++e) {
            const float ex = __expf(bc[e]);
            qe[ks][e] = (h16)((float)q8[e] * 0.17677669529663687f * ex);
            ke[ks][e] = (h16)((float)k8[e] * __builtin_amdgcn_rcpf(ex));
        }
    }
    f32x16 s;
#pragma unroll
    for (int e = 0; e < 16; ++e) s[e] = 0.f;
    s = MFMA32(ke[0], qe[0], s);
    s = MFMA32(ke[1], qe[1], s);
#pragma unroll
    for (int e = 0; e < 16; ++e) { const int j = (e & 3) + 8 * (e >> 2) + 4 * hh; if (j > r) s[e] = 0.f; }
    const half8 pb0 = pack8<0>(s), pb1 = pack8<1>(s);
    asm volatile("s_waitcnt lgkmcnt(0)" ::: "memory");
    f32x16 o[2];
#pragma unroll
    for (int dt = 0; dt < 2; ++dt) {
#pragma unroll
        for (int e = 0; e < 16; ++e) o[dt][e] = 0.f;
        const h16* vrow = VT + (32 * dt + r) * 32 + 4 * hh;
        const h16* srow = SPT + (32 * dt + r) * 32 + 8 * hh;
        {
            const half4 lo = *(const half4*)vrow, hi = *(const half4*)(vrow + 8);
            o[dt] = MFMA32(((half8){lo[0], lo[1], lo[2], lo[3], hi[0], hi[1], hi[2], hi[3]}), pb0, o[dt]);
        }
        {
            const half4 lo = *(const half4*)(vrow + 16), hi = *(const half4*)(vrow + 24);
            o[dt] = MFMA32(((half8){lo[0], lo[1], lo[2], lo[3], hi[0], hi[1], hi[2], hi[3]}), pb1, o[dt]);
        }
        o[dt] = MFMA32(*(const half8*)srow, qe[0], o[dt]);
        o[dt] = MFMA32(*(const half8*)(srow + 16), qe[1], o[dt]);
    }
    float ss = 0.f;
#pragma unroll
    for (int e = 0; e < 16; ++e) ss += o[0][e] * o[0][e] + o[1][e] * o[1][e];
    ss = xhalf_sum(ss);
    const float rn = rsqrtf(ss * (1.f / 64.f) + 1e-6f);
    h16* mix = (h16*)(P->ws + OFF_MIX);
#pragma unroll
    for (int dt = 0; dt < 2; ++dt)
#pragma unroll
        for (int g4 = 0; g4 < 4; ++g4) {
            const int e0 = 32 * dt + 8 * g4 + 4 * hh;
            const half4 gt = *(const half4*)(proj + tok * D_IN + C_GG + h * 64 + e0);
            const float4 on = *(const float4*)(P->in[I_GON] + l * 64 + e0);
            half4 ov;
            ov[0] = (h16)(o[dt][4 * g4 + 0] * rn * on.x * siluf_((float)gt[0]));
            ov[1] = (h16)(o[dt][4 * g4 + 1] * rn * on.y * siluf_((float)gt[1]));
            ov[2] = (h16)(o[dt][4 * g4 + 2] * rn * on.z * siluf_((float)gt[2]));
            ov[3] = (h16)(o[dt][4 * g4 + 3] * rn * on.w * siluf_((float)gt[3]));
            *(half4*)(mix + kb_idx(NT, tok, h * 64 + e0)) = ov;
        }
    __syncthreads();
}

DI void glu_tile(PP P, int l, int tile, char* smem, const int wv) {
    P = plaunder(P);
    const int mt = tile >> 2, nt = tile & 3;
    f32x4 acc[4][4];
    float ssd[4];
    gemm_mainloop_glds<false>(wv, 256, APlain{(const h16*)(P->ws + OFF_YACT) + (size_t)mt * 128 * 256, 256, 64},
                              (const h16*)(P->ws + OFF_WTGLU) + ((size_t)l * 512 + nt * 128) * 256, 256, acc, ssd, smem);
    const int tid = otid(wv), lane = tid & 63, wid = tid >> 6, wr = wid >> 1, wc = wid & 1;
    const h16* proj = (const h16*)(P->ws + OFF_PROJ);
    h16* mix = (h16*)(P->ws + OFF_MIX);
    const float* gb = P->in[I_GLUB] + l * 512;
#pragma unroll
    for (int i = 0; i < 4; ++i) {
        const size_t tok = (size_t)mt * 128 + wr * 64 + i * 16 + (lane & 15);
#pragma unroll
        for (int pj = 0; pj < 2; ++pj) {
            const int c = nt * 64 + wc * 32 + pj * 16 + (lane >> 4) * 4;
            const f32x4 z1 = acc[i][2 * pj], z2 = acc[i][2 * pj + 1];
            const float4 b1 = *(const float4*)(gb + c), b2 = *(const float4*)(gb + 256 + c);
            const half4 g4 = *(const half4*)(proj + tok * D_IN + C_SG + c);
            half4 o;
            o[0] = (h16)((z1[0] + b1.x) * sigmoidf_(z2[0] + b2.x) * siluf_((float)g4[0]));
            o[1] = (h16)((z1[1] + b1.y) * sigmoidf_(z2[1] + b2.y) * siluf_((float)g4[1]));
            o[2] = (h16)((z1[2] + b1.z) * sigmoidf_(z2[2] + b2.z) * siluf_((float)g4[2]));
            o[3] = (h16)((z1[3] + b1.w) * sigmoidf_(z2[3] + b2.w) * siluf_((float)g4[3]));
            *(half4*)(mix + kb_idx(NT, tok, 256 + c)) = o;
        }
    }
}

DI void outproj_tile(PP P, int l, int mt, int nt, char* smem, const int wv) {
    P = plaunder(P);
    f32x4 acc[8][4];
    float ssd[8];
    gemm_glds<false, 2, 8, 4, 3>(wv, 1024, APlain{(const h16*)(P->ws + OFF_MIX) + (size_t)mt * 256 * 64, 64, (size_t)NT * 64},
                              (const h16*)(P->ws + OFF_WTOUT) + ((size_t)l * 16 * 1024 + nt * 128) * 64, 64, acc, ssd, smem, (size_t)1024 * 64);
    const int tid = otid(wv), lane = tid & 63, wid = tid >> 6, wr = wid >> 1, wc = wid & 1;
    const float* xin = (l == 0) ? P->in[I_X] : P->out;
    h16* xh = (h16*)(P->ws + OFF_XH);
#pragma unroll
    for (int i = 0; i < 8; ++i) {
        const size_t row = (size_t)mt * 256 + wr * 128 + i * 16 + (lane & 15);
#pragma unroll
        for (int jj = 0; jj < 4; ++jj) {
            const int n = nt * 128 + wc * 64 + jj * 16 + (lane >> 4) * 4;
            const f32x4 v = acc[i][jj];
            const float4 xo = *(const float4*)(xin + row * 1024 + n);
            const float4 xn = (float4){xo.x + v[0], xo.y + v[1], xo.z + v[2], xo.w + v[3]};
            *(float4*)(P->out + row * 1024 + n) = xn;
            *(half4*)(xh + kb_idx(NT, row, n)) = (half4){(h16)xn.x, (h16)xn.y, (h16)xn.z, (h16)xn.w};
        }
    }
}

#define XB_TMO      128
#define XB_XCNT(j)  (256  + 64 * (j))
#define XB_XSUB(j)  (1280 + 64 * (j))
#define XB_XGEN(j)  (2304 + 64 * (j))
#define XB_TOP      3328
#define XB_TOPGEN   3392
#define XCD_BAR_WORDS 3456
#define XB_SPIN_CAP (1u << 18)
#define LAS __attribute__((address_space(3)))

__device__ __forceinline__ unsigned xb_ld(unsigned* p)              { return __hip_atomic_load(p, __ATOMIC_RELAXED, __HIP_MEMORY_SCOPE_AGENT); }
__device__ __forceinline__ unsigned xb_add(unsigned* p, unsigned v) { return __hip_atomic_fetch_add(p, v, __ATOMIC_RELAXED, __HIP_MEMORY_SCOPE_AGENT); }
__device__ __forceinline__ unsigned xb_xcc_id() { return (unsigned)__builtin_amdgcn_s_getreg((3 << 11) | 20) & 0xFu; }
#define XB_SPIN(cond, bar) do { unsigned _sp = 0; while (cond) { __builtin_amdgcn_s_sleep(1); \
    if ((++_sp & 255u) == 0u) { if (xb_ld(&(bar)[XB_TMO])) break; if (_sp > XB_SPIN_CAP) { atomicAdd(&(bar)[XB_TMO], 1u); break; } } } } while (0)

struct XcdBarrier {
    unsigned* bar; unsigned x;
    volatile LAS unsigned* st;
};

__device__ __forceinline__ XcdBarrier xcd_barrier_post(unsigned* bar, volatile LAS unsigned* st) {
    XcdBarrier b; b.bar = bar; b.x = xb_xcc_id(); b.st = st;
    if (threadIdx.x == 0) (void)xb_add(&bar[XB_XCNT(b.x)], 1u);
    return b;
}
__device__ __forceinline__ void xcd_barrier_complete(unsigned* bar, unsigned x, unsigned& nloc, unsigned& nx) {
    const unsigned G = gridDim.x * gridDim.y * gridDim.z;
    unsigned sum, cnt, mine, sp = 0u;
    for (;;) {
        sum = 0u; cnt = 0u; mine = 0u;
#pragma unroll
        for (unsigned j = 0; j < 16; ++j) { const unsigned c = xb_ld(&bar[XB_XCNT(j)]); sum += c; cnt += (c > 0u) ? 1u : 0u; mine = (j == x) ? c : mine; }
        if (sum == G) break;
        __builtin_amdgcn_s_sleep(1);
        if ((++sp & 255u) == 0u) { if (xb_ld(&bar[XB_TMO])) break; if (sp > XB_SPIN_CAP) { atomicAdd(&bar[XB_TMO], 1u); break; } }
    }
    nloc = mine > 0u ? mine : 1u; nx = cnt > 0u ? cnt : 1u;
}

__device__ __forceinline__ void xcd_barrier(const XcdBarrier& b) {
    asm volatile("s_waitcnt vmcnt(0)" ::: "memory");
    __syncthreads();
    if (threadIdx.x == 0) {
        unsigned* bar = b.bar;
        __builtin_amdgcn_s_waitcnt(0);
        unsigned nloc = b.st[0], nx = b.st[1];
        if (nloc == 0u) { xcd_barrier_complete(bar, b.x, nloc, nx); b.st[0] = nloc; b.st[1] = nx; }
        const unsigned old = xb_add(&bar[XB_XSUB(b.x)], 1u);
        const unsigned gen = old / nloc;
        if (old + 1u == (gen + 1u) * nloc) {
            __builtin_amdgcn_fence(__ATOMIC_RELEASE, "agent");
            asm volatile("s_waitcnt vmcnt(0)" ::: "memory");
            const unsigned og = xb_add(&bar[XB_TOP], 1u);
            const unsigned tg = og / nx;
            if (og + 1u == (tg + 1u) * nx) xb_add(&bar[XB_TOPGEN], 1u);
            else XB_SPIN(xb_ld(&bar[XB_TOPGEN]) == tg, bar);
            __builtin_amdgcn_fence(__ATOMIC_ACQUIRE, "agent");
            xb_add(&bar[XB_XGEN(b.x)], 1u);
            asm volatile("s_waitcnt vmcnt(0)" ::: "memory");
        } else {
            XB_SPIN(xb_ld(&bar[XB_XGEN(b.x)]) == gen, bar);
            __builtin_amdgcn_fence(__ATOMIC_ACQUIRE, "agent");
            asm volatile("s_waitcnt vmcnt(0)" ::: "memory");
        }
    }
    __syncthreads();
}


__global__ void __launch_bounds__(NTHREADS, 2) fwd_megakernel(Params Pval) {
    PP P = (PP)__builtin_amdgcn_kernarg_segment_ptr();
    extern __shared__ __attribute__((aligned(16))) char smem[];
    cg::grid_group grid = cg::this_grid();
    const int G = gridDim.x, bid = blockIdx.x;
    const int wv = __builtin_amdgcn_readfirstlane((int)(threadIdx.x >> 6));

    uint4& xb_words = *(uint4*)(smem + SMEM_MAIN);
    if (otid(wv) == 0) xb_words = make_uint4(0u, 0u, 0u, 0u);
    if (bid == 0) for (int i = otid(wv); i < XCD_BAR_WORDS + 16; i += NTHREADS) ((unsigned*)(P->ws + OFF_BAR))[i] = 0u;
    phase0(P, smem, wv);
    grid.sync();
    const XcdBarrier xb = xcd_barrier_post((unsigned*)(P->ws + OFF_BAR), (volatile LAS unsigned*)(smem + SMEM_MAIN));
    int vxcd = bid & 7, vjx = bid >> 3;
    {
        unsigned* xcnt = (unsigned*)(P->ws + OFF_BAR) + XCD_BAR_WORDS;
        volatile LAS unsigned* lw = (volatile LAS unsigned*)(smem + SMEM_MAIN) + 2;
        if (otid(wv) == 0) lw[0] = xb.x < 8u ? xb_add(&xcnt[xb.x], 1u) : 0xffffu;
        xcd_barrier(xb);
        if (otid(wv) == 0) {
            bool ok = (G & 7) == 0 && xb.x < 8u;
            for (int j = 0; j < 8; ++j) ok = ok && (xb_ld(&xcnt[j]) == (unsigned)(G >> 3));
            lw[1] = ok ? 1u : 0u;
        }
        __syncthreads();
        if (lw[1]) { vxcd = (int)xb.x; vjx = (int)lw[0]; }
    }
    vxcd = __builtin_amdgcn_readfirstlane(vxcd); vjx = __builtin_amdgcn_readfirstlane(vjx);

#pragma unroll 1
    for (int l = 0; l < DEPTH; ++l) {
        {
            const int xcd = vxcd, jx = vjx, nper = G >> 3;
            for (int u = jx; u < 192; u += nper) inproj_tile<2, 8>(P, l, (xcd * 8 + (u & 7)) * 256, (u >> 3) * 128, smem, wv);
            for (int it = jx; it < 16 + 40; it += nper) {
                if (it < 16) inproj_tile<4, 2>(P, l, (xcd * 16 + it) * 128, 3072, smem, wv);
                else s5_build_item(P, l, (it - 16) * 8 + xcd, smem, wv);
            }
        }
        xcd_barrier(xb);
#pragma unroll 1
        for (int w = bid; w < 128 + 64 + 512; w += G) {
            if (w < 128) cmp_gemm_tile(P, l, w, smem, wv);
            else if (w < 192) s5e_gemm_tile(P, l, w - 128, smem, wv);
            else gla_kv_item(P, l, w - 192, smem, wv);
        }
        xcd_barrier(xb);
#pragma unroll 1
        for (int w = bid; w < 512 + 512 + 64; w += G) {
            if (w < 512) cmp_l2_item(P, l, w, smem, wv);
            else if (w < 1024) gla_scan_item(P, w - 512, smem, wv);
            else s5_scan_item(P, w - 1024, smem, wv);
        }
        xcd_barrier(xb);
        bool nsa_fast;
        {
            const int ln = otid(wv) & 63;
            const float gq = wave_max(fabsf(P->in[I_NQN][l * 64 + ln]));
            const float gk = wave_max(fmaxf(fmaxf(fabsf(P->in[I_NKN][(l * 3 + 0) * 64 + ln]), fabsf(P->in[I_NKN][(l * 3 + 1) * 64 + ln])), fabsf(P->in[I_NKN][(l * 3 + 2) * 64 + ln])));
            nsa_fast = __builtin_amdgcn_readfirstlane((8.f * 1.4426950408889634f * gq * gk - FAST_SHIFT < 15.f) ? 1 : 0) != 0;
        }
#pragma unroll 1
        for (int w0 = bid; w0 < 512 + 512 + 512; w0 += G) {
            const int w = w0 < G ? vjx * 8 + vxcd : w0;
            if (w < 512) {
                const int bg = w & 3, q = w >> 2;
                if (nsa_fast) { nsa_unit<true>(P, l, bg, 255 - q, smem, wv); nsa_unit<true>(P, l, bg, q, smem, wv); }
                else { nsa_unit<false>(P, l, bg, 255 - q, smem, wv); nsa_unit<false>(P, l, bg, q, smem, wv); }
            } else if (w < 512 + 512) s5o_gemm_tile(P, l, w - 512, smem, wv);
            else gla_out_item(P, l, w - 1024, smem, wv);
        }
        xcd_barrier(xb);
#pragma unroll 1
        for (int w = bid; w < 512; w += G) glu_tile(P, l, w, smem, wv);
        xcd_barrier(xb);
        {
            const int xcd = vxcd, jx = vjx, nper = G >> 3;
            for (int u = jx; u < 64; u += nper) outproj_tile(P, l, xcd * 8 + (u & 7), u >> 3, smem, wv);
        }
        xcd_barrier(xb);
    }
}

extern "C" void kernel_launch(void* const* d_in, const int* in_sizes, int n_in, void* d_out, int out_size, void* d_ws,
                              size_t ws_size, hipStream_t stream) {
    static int grid_blocks = 0;
    if (!grid_blocks) {
        int dev = 0, cus = 0, per_cu = 0;
        hipGetDevice(&dev);
        hipDeviceGetAttribute(&cus, hipDeviceAttributeMultiprocessorCount, dev);
        hipFuncSetAttribute((const void*)fwd_megakernel, hipFuncAttributeMaxDynamicSharedMemorySize, SMEM_BYTES);
        hipOccupancyMaxActiveBlocksPerMultiprocessor(&per_cu, fwd_megakernel, NTHREADS, SMEM_BYTES);
        if (per_cu < 1) per_cu = 1;
        if (per_cu > 2) per_cu = 2;
        grid_blocks = cus * per_cu;
        if (ws_size < WS_END) fprintf(stderr, "kernel_launch: workspace too small: %zu < %zu\n", ws_size, (size_t)WS_END);
    }
    Params p{};
    for (int i = 0; i < 25; ++i) p.in[i] = (const float*)d_in[i];
    p.out = (float*)d_out;
    p.ws = (char*)d_ws;
    void* args[] = {&p};
    hipError_t e = hipLaunchCooperativeKernel((const void*)fwd_megakernel, dim3(grid_blocks), dim3(NTHREADS), args, SMEM_BYTES, stream);
    if (e != hipSuccess) fprintf(stderr, "cooperative launch failed: %s (grid %d)\n", hipGetErrorString(e), grid_blocks);
}
```

```cpp
#include <hip/hip_runtime.h>
#include <hip/hip_cooperative_groups.h>
#include <cstdio>
#include <cstdint>
namespace cg = cooperative_groups;

typedef _Float16 h16;
typedef _Float16 half8 __attribute__((ext_vector_type(8)));
typedef _Float16 half4 __attribute__((ext_vector_type(4)));
typedef float f32x4 __attribute__((ext_vector_type(4)));
typedef float f32x16 __attribute__((ext_vector_type(16)));

#define DI __device__ __forceinline__

constexpr int D_MODEL = 1024, BATCH = 2, SEQ = 8192, DEPTH = 4, NT = BATCH * SEQ;
constexpr int D_IN = 3112, D_IN_PAD = 3200;
constexpr int C_NQ = 0, C_NKV = 512, C_NG = 1280, C_GQ = 1792, C_GK = 1920, C_GV = 2048, C_GG = 2304, C_SU = 2560, C_SG = 2816,
              C_GLR = 3072, C_NGL = 3088;
__host__ __device__ constexpr int map_col(int c) {
    return c < 128 ? C_GQ + c : c < 256 ? C_GK + (c - 128) : c < 512 ? C_GV + (c - 256) : c < 528 ? C_GLR + (c - 512)
         : c < 784 ? C_GG + (c - 528) : c < 1040 ? C_SU + (c - 784) : c < 1296 ? C_SG + (c - 1040) : c < 1808 ? C_NQ + (c - 1296)
         : c < 2576 ? C_NKV + (c - 1808) : c < 2600 ? C_NGL + (c - 2576) : c < 3112 ? C_NG + (c - 2600) : c;
}
constexpr int NTHREADS = 256;
constexpr float QSCALE = 0.125f * 1.4426950408889634f;

enum { I_X = 0, I_NORMG, I_WIN, I_GW2, I_GB2, I_GON, I_LRE, I_LIM, I_LSTEP, I_BRE, I_BIM, I_CRE, I_CIM, I_SD, I_GLUW, I_GLUB,
       I_NGB, I_NQN, I_NKN, I_CPOS, I_CW1, I_CB1, I_CW2, I_CB2, I_WOUT };

constexpr size_t OFF_WTIN  = 0;
constexpr size_t OFF_WTOUT = OFF_WTIN  + 4ull * D_IN_PAD * 1024 * 2;
constexpr size_t OFF_WTGLU = OFF_WTOUT + 4ull * 1024 * 1024 * 2;
constexpr size_t OFF_WTC1  = OFF_WTGLU + 4ull * 512 * 256 * 2;
constexpr size_t OFF_PROJ  = OFF_WTC1  + 4ull * 2 * 256 * 2048 * 2;
constexpr size_t OFF_MIX   = OFF_PROJ  + (size_t)NT * D_IN * 2;
constexpr size_t OFF_YACT  = OFF_MIX   + (size_t)NT * 1024 * 2;
constexpr size_t OFF_XH    = OFF_YACT;
constexpr size_t OFF_BCUM  = OFF_YACT  + (size_t)NT * 256 * 2;
constexpr size_t OFF_GKV   = OFF_BCUM  + (size_t)NT * 128 * 4;
constexpr size_t OFF_GDEC  = OFF_GKV   + 8ull * 256 * 2048 * 4;
static_assert(OFF_GDEC - OFF_XH >= (size_t)NT * 1024 * 2, "XH alias region too small");
constexpr size_t OFF_XC    = OFF_GDEC  + 8ull * 256 * 32 * 4;
constexpr size_t OFF_S5W   = OFF_XC    + 512ull * 1024 * 2 * 4;
constexpr size_t OFF_S5E   = OFF_S5W   + 16ull * 512 * 640 * 2;
constexpr size_t OFF_S5AL  = OFF_S5E   + 16ull * 128 * 512 * 2;
constexpr size_t OFF_CHID  = OFF_S5AL  + 1024ull * 2 * 4;
constexpr size_t OFF_POSB  = OFF_CHID  + 2ull * 2048 * 512 * 4;
constexpr size_t OFF_XCH   = OFF_POSB  + 8ull * 16 * 256 * 4;
constexpr size_t OFF_KCMP  = OFF_XCH   + 512ull * 2048 * 2;
constexpr size_t OFF_VCMP  = OFF_KCMP  + 4ull * 512 * 64 * 2;
constexpr size_t OFF_VTG   = OFF_VCMP  + 4ull * 512 * 64 * 2;
constexpr size_t OFF_BAR   = OFF_VTG   + 2ull * 4 * 128 * 4096 * 2;
constexpr size_t WS_END    = OFF_BAR   + 16384;

struct Params {
    const float* in[25];
    float* out;
    char* ws;
};

__host__ __device__ constexpr size_t kb_idx(size_t nrows, size_t row, int k) { return (((size_t)(k >> 6)) * nrows + row) * 64 + (k & 63); }
typedef const __attribute__((address_space(4))) Params* PP;
DI PP plaunder(PP p) { asm volatile("" : "+s"(p)); return p; }
constexpr int SMEM_MAIN = 73728;
constexpr int SMEM_BYTES = SMEM_MAIN + 16;

DI int otid(const int wv) { int t = wv * 64 + (int)__builtin_amdgcn_mbcnt_hi(~0u, __builtin_amdgcn_mbcnt_lo(~0u, 0u)); asm volatile("" : "+v"(t)); return t; }
DI float wave_sum(float v) {
#pragma unroll
    for (int o = 32; o > 0; o >>= 1) v += __shfl_xor(v, o);
    return v;
}
DI float wave_max(float v) {
#pragma unroll
    for (int o = 32; o > 0; o >>= 1) v = fmaxf(v, __shfl_xor(v, o));
    return v;
}
DI float sigmoidf_(float x) { return 1.f / (1.f + __expf(-x)); }
DI float siluf_(float x) { return x / (1.f + __expf(-x)); }
DI float gelu_tanh(float x) {
    const float u = 0.7978845608028654f * (x + 0.044715f * x * x * x);
    return 0.5f * x * (1.f + tanhf(u));
}
DI float log_sigmoidf_(float x) { return fminf(x, 0.f) - log1pf(__expf(-fabsf(x))); }

typedef _Float16 half2_ __attribute__((ext_vector_type(2)));
DI void glds16(const h16* g, char* l) {
    __builtin_amdgcn_global_load_lds((const __attribute__((address_space(1))) void*)g, (__attribute__((address_space(3))) void*)l, 16, 0, 0);
}
struct APlain { const h16* A; size_t lda, astep; DI const h16* operator()(int row, int kt, int c8) const { return A + (size_t)row * lda + (size_t)kt * astep + c8 * 8; } };
struct AS5 {
    const h16* ubase;
    const h16* xin;
    int ch0;
    DI const h16* operator()(int row, int kt, int c8) const {
        const size_t ch = (size_t)(ch0 + row);
        return kt < 8 ? ubase + (ch * 32 + 4 * kt + (c8 >> 1)) * D_IN + (c8 & 1) * 8 : xin + ch * 2048 + (kt - 8) * 64 + c8 * 8;
    }
};
template <int N> DI void gwaitbar();
#define GWB_DEF(N) template <> DI void gwaitbar<N>() { asm volatile("s_waitcnt vmcnt(" #N ") lgkmcnt(0)\n\ts_barrier" ::: "memory"); }
GWB_DEF(0) GWB_DEF(3) GWB_DEF(4) GWB_DEF(6) GWB_DEF(8) GWB_DEF(12)
template <bool SUMSQ, int WR, int MI, int NJ, int NST = 4, class AF>
DI void gemm_glds(const int wv, const int K, const AF& afn, const h16* __restrict__ Bt, const int ldb,
                  f32x4 (&acc)[MI][NJ], float (&ss)[MI], char* smem, const size_t bstep = 64) {
    constexpr int WC = 4 / WR, BM = WR * MI * 16, BN = WC * NJ * 16, AQ = BM / 64, BQ = BN / 64, NG = AQ + BQ, SB = (BM + BN) * 64;
    static_assert(NST * SB <= SMEM_MAIN && AQ >= 1 && BQ >= 1 && (NST == 3 || NST == 4), "ring does not fit the LDS");
    const int tid = otid(wv), lane = tid & 63, wid = tid >> 6, wr = wid / WC, wc = wid % WC;
#pragma unroll
    for (int i = 0; i < MI; ++i) {
        ss[i] = 0.f;
#pragma unroll
        for (int j = 0; j < NJ; ++j) acc[i][j] = (f32x4){0.f, 0.f, 0.f, 0.f};
    }
    const int lrow = wid * 16 + (lane >> 2);
    const int lc4 = (lane & 3) ^ ((-(lrow >> 2)) & 3);
    const h16* bp = Bt + (size_t)lrow * ldb + lc4 * 8;
    char* lbase = smem + wid * 1024;
    const int fr = lane & 15, fq = lane >> 4, sw = (-(fr >> 2)) & 3;
    const int aoff0 = (wr * MI * 16 + fr) * 64 + ((fq ^ sw) * 16);
    const int boff0 = BM * 64 + (wc * NJ * 16 + fr) * 64 + ((fq ^ sw) * 16);
    const int nt = K >> 5;
    auto issue = [&](const int t, char* stage) {
        const int kt = t >> 1, hb = (t & 1) * 4;
#pragma unroll
        for (int q = 0; q < AQ; ++q) glds16(afn(lrow + 64 * q, kt, hb + lc4), stage + q * 4096);
#pragma unroll
        for (int q = 0; q < BQ; ++q) glds16(bp + (size_t)q * 64 * ldb + (size_t)kt * bstep + hb * 8, stage + BM * 64 + q * 4096);
    };
    auto compute = [&](const char* st) {
        half8 af[MI], bf[NJ];
#pragma unroll
        for (int i = 0; i < MI; ++i) af[i] = *(const half8*)(st + aoff0 + i * 1024);
#pragma unroll
        for (int j = 0; j < NJ; ++j) bf[j] = *(const half8*)(st + boff0 + j * 1024);
        if (SUMSQ) {
#pragma unroll
            for (int i = 0; i < MI; ++i)
#pragma unroll
                for (int e = 0; e < 4; ++e) {
                    const half2_ x = (half2_){af[i][2 * e], af[i][2 * e + 1]};
                    ss[i] = __builtin_amdgcn_fdot2(x, x, ss[i], false);
                }
        }
#pragma unroll
        for (int i = 0; i < MI; ++i)
#pragma unroll
            for (int j = 0; j < NJ; ++j) acc[i][j] = __builtin_amdgcn_mfma_f32_16x16x32_f16(bf[j], af[i], acc[i][j], 0, 0, 0);
    };
#define GEMM_STEP(S, t) do { if (NST == 4 && (t) + 2 < nt) gwaitbar<NG>(); else gwaitbar<0>();                       \
        if ((t) + NST - 1 < nt) issue((t) + NST - 1, lbase + (((S) + NST - 1) % NST) * SB); compute(smem + (S) * SB); } while (0)
    gwaitbar<0>();
    {
        const int k = nt < NST - 1 ? nt : NST - 1;
        for (int p = 0; p < k; ++p) issue(p, lbase + p * SB);
        if (k >= 3) gwaitbar<2 * NG>(); else if (k == 2) gwaitbar<NG>(); else gwaitbar<0>();
        __builtin_amdgcn_s_sleep(2);
    }
#pragma unroll 1
    for (int t = 0; t < nt; t += NST) {
        GEMM_STEP(0, t);
        if (t + 1 < nt) GEMM_STEP(1, t + 1);
        if (t + 2 < nt) GEMM_STEP(2, t + 2);
        if (NST == 4 && t + 3 < nt) GEMM_STEP(3 % NST, t + 3);
    }
#undef GEMM_STEP
    asm volatile("s_waitcnt lgkmcnt(0)\n\ts_barrier" ::: "memory");
    if (SUMSQ) {
#pragma unroll
        for (int i = 0; i < MI; ++i) { ss[i] += __shfl_xor(ss[i], 16); ss[i] += __shfl_xor(ss[i], 32); }
    }
}
template <bool SUMSQ, class AF>
DI void gemm_mainloop_glds(const int wv, const int K, const AF& afn, const h16* __restrict__ Bt, const int ldb, f32x4 (&acc)[4][4], float (&ss)[4], char* smem, const size_t bstep = 64) {
    gemm_glds<SUMSQ, 2, 4, 4>(wv, K, afn, Bt, ldb, acc, ss, smem, bstep);
}

DI int glu_perm_dst(int c_orig) {
    const int which = c_orig >> 8, c = c_orig & 255;
    return (c >> 6) * 128 + ((c >> 5) & 1) * 64 + (((c >> 4) & 1) * 2 + which) * 16 + (c & 15);
}
template <int MAP, int KB>
DI void transpose64(const float* __restrict__ src, int R, int C, h16* __restrict__ dst, int r0, int c0,
                    const float* __restrict__ rscale, char* smem, const int wv) {
    h16* tile = (h16*)smem;
    const int tid = otid(wv);
    {
        const int r = tid >> 2, cq = (tid & 3) * 16;
        const float sc = rscale ? rscale[r0 + r] : 1.f;
        const float* sp = src + (size_t)(r0 + r) * C + c0 + cq;
#pragma unroll
        for (int q = 0; q < 4; ++q) {
            float4 v = (float4){0.f, 0.f, 0.f, 0.f};
            if (c0 + cq + q * 4 < C) v = *(const float4*)(sp + q * 4);
            *(half4*)(tile + r * 72 + cq + q * 4) = (half4){(h16)(v.x * sc), (h16)(v.y * sc), (h16)(v.z * sc), (h16)(v.w * sc)};
        }
    }
    __syncthreads();
    {
        const int c = tid >> 2, rq = (tid & 3) * 16;
        half8 o0, o1;
#pragma unroll
        for (int k = 0; k < 8; ++k) { o0[k] = tile[(rq + k) * 72 + c]; o1[k] = tile[(rq + 8 + k) * 72 + c]; }
        const int cc = c0 + c;
        const int dr = MAP == 1 ? map_col(cc) : MAP == 2 ? glu_perm_dst(cc) : cc;
        h16* dp = KB ? dst + ((size_t)(r0 >> 6) * KB + dr) * 64 + rq : dst + (size_t)dr * R + r0 + rq;
        *(half8*)dp = o0; *(half8*)(dp + 8) = o1;
    }
    __syncthreads();
}

DI void phase0(PP P, char* smem, const int wv) {
    P = plaunder(P);
    constexpr int N_WIN = 4 * 16 * 50, N_WOUT = 4 * 16 * 16, N_C1 = 16 * 16 * 4, N_GLU = 4 * 4 * 8, N_XH = NT * 1024 / 2048, N_PB = 8 * 16;
    const int total = N_WIN + N_WOUT + N_C1 + N_GLU + N_XH + N_PB;
    for (int w = blockIdx.x; w < total; w += gridDim.x) {
        if (w < N_WIN) {
            const int l = w / 800, r = w % 800, rt = r / 50, ct = r % 50;
            transpose64<1, D_IN_PAD>(P->in[I_WIN] + (size_t)l * 1024 * D_IN, 1024, D_IN, (h16*)(P->ws + OFF_WTIN) + (size_t)l * D_IN_PAD * 1024,
                           rt * 64, ct * 64, P->in[I_NORMG] + l * 1024, smem, wv);
        } else if (w < N_WIN + N_WOUT) {
            const int v = w - N_WIN, l = v >> 8, r = v & 255, rt = r >> 4, ct = r & 15;
            transpose64<0, 1024>(P->in[I_WOUT] + (size_t)l * 1024 * 1024, 1024, 1024, (h16*)(P->ws + OFF_WTOUT) + (size_t)l * 1024 * 1024,
                           rt * 64, ct * 64, nullptr, smem, wv);
        } else if (w < N_WIN + N_WOUT + N_C1) {
            const int v = w - N_WIN - N_WOUT, ljh = v >> 6, r = v & 63, rt = r >> 2, ct = r & 3;
            transpose64<0, 512>(P->in[I_CW1] + (size_t)ljh * 1024 * 256, 1024, 256, (h16*)(P->ws + OFF_WTC1) + ((size_t)(ljh >> 1) * 16 * 512 + (ljh & 1) * 256) * 64,
                           rt * 64, ct * 64, nullptr, smem, wv);
        } else if (w < N_WIN + N_WOUT + N_C1 + N_GLU) {
            const int v = w - N_WIN - N_WOUT - N_C1, l = v >> 5, r = v & 31, rt = r >> 3, ct = r & 7;
            transpose64<2, 0>(P->in[I_GLUW] + (size_t)l * 256 * 512, 256, 512, (h16*)(P->ws + OFF_WTGLU) + (size_t)l * 512 * 256,
                           rt * 64, ct * 64, nullptr, smem, wv);
        } else if (w < N_WIN + N_WOUT + N_C1 + N_GLU + N_XH) {
            const size_t e0 = ((size_t)(w - N_WIN - N_WOUT - N_C1 - N_GLU) * 256 + otid(wv)) * 8;
            const float4 a = *(const float4*)(P->in[I_X] + e0), b = *(const float4*)(P->in[I_X] + e0 + 4);
            *(half8*)((h16*)(P->ws + OFF_XH) + kb_idx(NT, e0 >> 10, (int)(e0 & 1023))) = (half8){(h16)a.x, (h16)a.y, (h16)a.z, (h16)a.w, (h16)b.x, (h16)b.y, (h16)b.z, (h16)b.w};
        } else {
            const int v = w - (N_WIN + N_WOUT + N_C1 + N_GLU + N_XH), lj = v >> 4, ks = v & 15, n = otid(wv);
            const float* w1 = P->in[I_CW1] + ((size_t)lj * 2048 + ks * 128) * 256 + n;
            const float* pp = P->in[I_CPOS] + (size_t)lj * 2048 + ks * 128;
            float a = ks == 0 ? P->in[I_CB1][lj * 256 + n] : 0.f;
#pragma unroll 16
            for (int k = 0; k < 128; ++k) a += pp[k] * w1[(size_t)k * 256];
            ((float*)(P->ws + OFF_POSB))[(lj * 16 + ks) * 256 + n] = a;
        }
    }
}

DI void s5_build_item(PP P, int l, int item, char* smem, const int wv) {
    P = plaunder(P);
    float* apow = (float*)smem;
    float* bbar = apow + 64 * 33 * 2;
    float* cc   = bbar + 64 * 16 * 2;
    const int tid = otid(wv);
    const int g = (item < 256) ? (item >> 4) : ((item - 256) >> 2);
    if (tid < 64) {
        const int p = tid;
        const float lre = fminf(P->in[I_LRE][(l * 16 + g) * 64 + p], -1e-4f);
        const float lim = P->in[I_LIM][(l * 16 + g) * 64 + p];
        const float dt = expf(P->in[I_LSTEP][l * 16 + g]);
        const float x = lre * dt, y = lim * dt;
        const float em1 = expm1f(x), cy = cosf(y), sy = sinf(y), sh = sinf(0.5f * y);
        const float ar = (em1 + 1.f) * cy, ai = (em1 + 1.f) * sy;
        const float dr = em1 * cy - 2.f * sh * sh, di = ai;
        const float den = lre * lre + lim * lim;
        const float fr = (dr * lre + di * lim) / den;
        const float fi = (di * lre - dr * lim) / den;
        float pr = 1.f, pi = 0.f;
        for (int k = 0; k <= 32; ++k) {
            apow[(p * 33 + k) * 2] = pr; apow[(p * 33 + k) * 2 + 1] = pi;
            const float nr = pr * ar - pi * ai, ni = pr * ai + pi * ar; pr = nr; pi = ni;
        }
        for (int c = 0; c < 16; ++c) {
            const float br = P->in[I_BRE][((size_t)(l * 16 + g) * 64 + p) * 16 + c];
            const float bi = P->in[I_BIM][((size_t)(l * 16 + g) * 64 + p) * 16 + c];
            bbar[(p * 16 + c) * 2] = fr * br - fi * bi;
            bbar[(p * 16 + c) * 2 + 1] = fr * bi + fi * br;
        }
    }
    for (int e = tid; e < 1024; e += 256) {
        cc[e * 2] = P->in[I_CRE][(size_t)(l * 16 + g) * 1024 + e];
        cc[e * 2 + 1] = P->in[I_CIM][(size_t)(l * 16 + g) * 1024 + e];
    }
    __syncthreads();
    if (item < 256) {
        const int c = item & 15;
        float* kt = cc + 2048;
        for (int idx = tid; idx < 512; idx += 256) {
            const int lag = idx >> 4, c2 = idx & 15;
            float a = 0.f;
            for (int p = 0; p < 64; ++p) {
                const float cr = cc[(c * 64 + p) * 2], ci = cc[(c * 64 + p) * 2 + 1];
                const float xr = apow[(p * 33 + lag) * 2], xi = apow[(p * 33 + lag) * 2 + 1];
                const float br = bbar[(p * 16 + c2) * 2], bi = bbar[(p * 16 + c2) * 2 + 1];
                const float tr = cr * xr - ci * xi, ti = cr * xi + ci * xr;
                a += tr * br - ti * bi;
            }
            kt[idx] = a;
        }
        __syncthreads();
        h16* W = (h16*)(P->ws + OFF_S5W) + (size_t)g * 512 * 640;
        for (int idx = tid; idx < 32 * 640; idx += 256) {
            const int j = idx / 640, k = idx % 640;
            float val = 0.f;
            if (k < 512) {
                const int s = k >> 4, c2 = k & 15, lag = j - s;
                if (lag >= 0) val = kt[lag * 16 + c2];
            } else {
                const int p = (k - 512) >> 1;
                const float cr = cc[(c * 64 + p) * 2], ci = cc[(c * 64 + p) * 2 + 1];
                const float xr = apow[(p * 33 + j + 1) * 2], xi = apow[(p * 33 + j + 1) * 2 + 1];
                val = (k & 1) ? -(cr * xi + ci * xr) : (cr * xr - ci * xi);
            }
            W[(size_t)(j * 16 + c) * 640 + k] = (h16)val;
        }
    } else {
        const int pq = (item - 256) & 3;
        h16* E = (h16*)(P->ws + OFF_S5E) + ((size_t)g * 128 + pq * 32) * 512;
        for (int idx = tid; idx < 32 * 512; idx += 256) {
            const int nl = idx >> 9, k = idx & 511;
            const int p = pq * 16 + (nl >> 1), s = k >> 4, c2 = k & 15;
            const float xr = apow[(p * 33 + 31 - s) * 2], xi = apow[(p * 33 + 31 - s) * 2 + 1];
            const float br = bbar[(p * 16 + c2) * 2], bi = bbar[(p * 16 + c2) * 2 + 1];
            const float val = (nl & 1) ? (xr * bi + xi * br) : (xr * br - xi * bi);
            E[(size_t)nl * 512 + k] = (h16)val;
        }
        if (tid < 16) {
            const int p = pq * 16 + tid;
            float* AL = (float*)(P->ws + OFF_S5AL);
            AL[(g * 64 + p) * 2] = apow[(p * 33 + 32) * 2];
            AL[(g * 64 + p) * 2 + 1] = apow[(p * 33 + 32) * 2 + 1];
        }
    }
    __syncthreads();
}

template <int WR, int MI>
DI void inproj_tile(PP P, int l, int m0, int n0, char* smem, const int wv) {
    P = plaunder(P);
    constexpr int WC = 4 / WR;
    f32x4 acc[MI][4];
    float ss[MI];
    gemm_glds<true, WR, MI, 4, (WR == 2 && MI == 8) ? 3 : 4>(wv, 1024, APlain{(const h16*)(P->ws + OFF_XH) + (size_t)m0 * 64, 64, (size_t)NT * 64},
                               (const h16*)(P->ws + OFF_WTIN) + ((size_t)l * 16 * D_IN_PAD + n0) * 64, 64, acc, ss, smem, (size_t)D_IN_PAD * 64);
    const int tid = otid(wv), lane = tid & 63, wid = tid >> 6, wr = wid / WC, wc = wid % WC;
    h16* proj = (h16*)(P->ws + OFF_PROJ);
    const int n64 = n0 + wc * 64;
    int cls = 0;
    if (n64 < 512) cls = 1;
    else if (n64 >= C_NKV + 256 && n64 < C_NKV + 384) cls = 2;
    else if (n64 >= C_NKV + 512 && n64 < C_NKV + 640) cls = 3;
    else if (n64 >= C_NKV + 384 && n64 < C_NKV + 512) cls = 4;
    else if (n64 >= C_NKV + 640 && n64 < C_NKV + 768) cls = 5;
    float wn[4][4];
    if (cls >= 1 && cls <= 3) {
        const float* wp = (cls == 1) ? P->in[I_NQN] + l * 64 : P->in[I_NKN] + (l * 3 + (cls - 1)) * 64;
        const float sc = (cls == 1) ? QSCALE : 1.f;
#pragma unroll
        for (int j = 0; j < 4; ++j) {
            const float4 w4 = *(const float4*)(wp + j * 16 + (lane >> 4) * 4);
            wn[j][0] = w4.x * sc; wn[j][1] = w4.y * sc; wn[j][2] = w4.z * sc; wn[j][3] = w4.w * sc;
        }
    }
#pragma unroll
    for (int i = 0; i < MI; ++i) {
        const int ml = wr * MI * 16 + i * 16 + (lane & 15);
        const float r = rsqrtf(ss[i] * (1.f / 1024.f) + 1e-6f);
        const size_t row = (size_t)m0 + ml;
        f32x4 v[4];
#pragma unroll
        for (int j = 0; j < 4; ++j) v[j] = acc[i][j] * r;
        if (cls >= 1 && cls <= 3) {
            float s2 = 0.f;
#pragma unroll
            for (int j = 0; j < 4; ++j) s2 += v[j][0] * v[j][0] + v[j][1] * v[j][1] + v[j][2] * v[j][2] + v[j][3] * v[j][3];
            s2 += __shfl_xor(s2, 16); s2 += __shfl_xor(s2, 32);
            const float rn = rsqrtf(s2 * (1.f / 64.f) + 1e-6f);
#pragma unroll
            for (int j = 0; j < 4; ++j) { v[j][0] *= rn * wn[j][0]; v[j][1] *= rn * wn[j][1]; v[j][2] *= rn * wn[j][2]; v[j][3] *= rn * wn[j][3]; }
        }
        if (cls >= 4) {
            const int g = (n64 >> 6) & 1, br = cls - 4;
            const int b = (int)(row >> 13), t = (int)(row & 8191);
            h16* vt = (h16*)(P->ws + OFF_VTG) + ((((size_t)br * 4 + b * 2 + g) * 128 + (t >> 6)) * 64) * 64 + (t & 63);
#pragma unroll
            for (int j = 0; j < 4; ++j)
#pragma unroll
                for (int e = 0; e < 4; ++e) vt[(j * 16 + (lane >> 4) * 4 + e) * 64] = (h16)v[j][e];
        }
#pragma unroll
        for (int j = 0; j < 4; ++j) {
            const int n = n64 + j * 16 + (lane >> 4) * 4;
            if (n < D_IN) *(half4*)(proj + row * D_IN + n) = (half4){(h16)v[j][0], (h16)v[j][1], (h16)v[j][2], (h16)v[j][3]};
        }
        __builtin_amdgcn_sched_barrier(0);
    }
    __syncthreads();
}


DI void cmp_gemm_tile(PP P, int l, int tile, char* smem, const int wv) {
    P = plaunder(P);
    const int j = tile >> 6, mt = (tile >> 2) & 15, nt = tile & 3;
    const int row0 = mt * 128, bg = row0 >> 9, i0 = row0 & 511, b = bg >> 1, g = bg & 1;
    f32x4 acc[4][4];
    float ssd[4];
    gemm_mainloop_glds<false>(wv, 1024, APlain{(const h16*)(P->ws + OFF_PROJ) + ((size_t)b * SEQ + 16 * i0) * D_IN + C_NKV + j * 128 + g * 64, (size_t)16 * D_IN, (size_t)D_IN},
                              (const h16*)(P->ws + OFF_WTC1) + ((size_t)(l * 2 + j) * 16 * 512 + nt * 128) * 64, 64, acc, ssd, smem, (size_t)512 * 64);
    const int tid = otid(wv), lane = tid & 63, wid = tid >> 6, wr = wid >> 1, wc = wid & 1;
    float* pt = (float*)(P->ws + OFF_CHID) + (size_t)j * 2048 * 512;
#pragma unroll
    for (int i = 0; i < 4; ++i) {
        const size_t row = (size_t)row0 + wr * 64 + i * 16 + (lane & 15);
#pragma unroll
        for (int jj = 0; jj < 4; ++jj) {
            const int n = nt * 128 + wc * 64 + jj * 16 + (lane >> 4) * 4;
            const f32x4 v = acc[i][jj];
            *(float4*)(pt + row * 512 + n) = (float4){v[0], v[1], v[2], v[3]};
        }
    }
}

DI void s5e_gemm_tile(PP P, int l, int tile, char* smem, const int wv) {
    P = plaunder(P);
    const int g = tile >> 2, mt = tile & 3;
    f32x4 acc[4][4];
    float ssd[4];
    gemm_mainloop_glds<false>(wv, 512, AS5{(const h16*)(P->ws + OFF_PROJ) + C_SU + g * 16, nullptr, mt * 128},
                              (const h16*)(P->ws + OFF_S5E) + (size_t)g * 128 * 512, 512, acc, ssd, smem);
    const int tid = otid(wv), lane = tid & 63, wid = tid >> 6, wr = wid >> 1, wc = wid & 1;
    float* xc = (float*)(P->ws + OFF_XC);
#pragma unroll
    for (int i = 0; i < 4; ++i) {
        const size_t ch = (size_t)mt * 128 + wr * 64 + i * 16 + (lane & 15);
#pragma unroll
        for (int jj = 0; jj < 4; ++jj) {
            const int n = wc * 64 + jj * 16 + (lane >> 4) * 4;
            const f32x4 v = acc[i][jj];
            *(float4*)(xc + (ch * 1024 + g * 64) * 2 + n) = (float4){v[0], v[1], v[2], v[3]};
        }
    }
}

DI void gla_scan_item(PP P, int item, char* smem, const int wv) {
    P = plaunder(P);
    const int tid = otid(wv), sl = tid & 31, part = tid >> 5;
    const int idx = item * 32 + sl, bh = idx >> 11, de = idx & 2047, d = de >> 6;
    float* kv = (float*)(P->ws + OFF_GKV) + ((size_t)bh * 256 + part * 32) * 2048 + de;
    const float* dc = (const float*)(P->ws + OFF_GDEC) + ((size_t)bh * 256 + part * 32) * 32 + d;
    float* sD = (float*)smem; float* sL = sD + 256;
    float kvv[32], dd[32];
#pragma unroll
    for (int i = 0; i < 32; ++i) { kvv[i] = kv[(size_t)i * 2048]; dd[i] = dc[i * 32]; }
    float D = 1.f, L = 0.f;
#pragma unroll
    for (int i = 0; i < 32; ++i) { L = dd[i] * L + kvv[i]; D *= dd[i]; }
    sD[part * 32 + sl] = D; sL[part * 32 + sl] = L;
    __syncthreads();
    float S = 0.f;
    for (int q = 0; q < part; ++q) S = sD[q * 32 + sl] * S + sL[q * 32 + sl];
#pragma unroll
    for (int i = 0; i < 32; ++i) { const float o = S; S = dd[i] * S + kvv[i]; kv[(size_t)i * 2048] = o; }
    __syncthreads();
}
DI void s5_scan_item(PP P, int item, char* smem, const int wv) {
    P = plaunder(P);
    const int tid = otid(wv), sl = tid & 31, part = tid >> 5;
    const int idx = item * 32 + sl, b = idx >> 10, s = idx & 1023;
    float2* xc = (float2*)(P->ws + OFF_XC) + ((size_t)b * 256 + part * 32) * 1024 + s;
    half2_* xch = (half2_*)(P->ws + OFF_XCH) + ((size_t)b * 256 + part * 32) * 1024 + s;
    const float2 a = ((const float2*)(P->ws + OFF_S5AL))[s];
    float2* sL = (float2*)smem;
    float2 c[32];
#pragma unroll
    for (int i = 0; i < 32; ++i) c[i] = xc[(size_t)i * 1024];
    float lr = 0.f, li = 0.f;
#pragma unroll
    for (int i = 0; i < 32; ++i) { const float nr = a.x * lr - a.y * li + c[i].x, ni = a.x * li + a.y * lr + c[i].y; lr = nr; li = ni; }
    float dr = a.x, di = a.y;
#pragma unroll
    for (int i = 0; i < 5; ++i) { const float nr = dr * dr - di * di, ni = 2.f * dr * di; dr = nr; di = ni; }
    sL[part * 32 + sl] = (float2){lr, li};
    __syncthreads();
    float xr = 0.f, xi = 0.f;
    for (int q = 0; q < part; ++q) { const float2 lq = sL[q * 32 + sl]; const float nr = dr * xr - di * xi + lq.x, ni = dr * xi + di * xr + lq.y; xr = nr; xi = ni; }
#pragma unroll
    for (int i = 0; i < 32; ++i) {
        const float2 o = (float2){xr, xi};
        const float nr = a.x * xr - a.y * xi + c[i].x, ni = a.x * xi + a.y * xr + c[i].y; xr = nr; xi = ni;
        xc[(size_t)i * 1024] = o;
        xch[(size_t)i * 1024] = (half2_){(h16)o.x, (h16)o.y};
    }
    __syncthreads();
}
DI void cmp_l2_item(PP P, int l, int item, char* smem, const int wv) {
    P = plaunder(P);
    const int tid = otid(wv), lane = tid & 63, w = tid >> 6;
    const int j = item >> 8, r0 = (item & 255) * 8;
    h16* w2s = (h16*)smem;
    float* hs = (float*)(smem + 32768);
    {
        const float* w2 = P->in[I_CW2] + (size_t)(l * 2 + j) * 256 * 64;
        for (int e = tid * 4; e < 256 * 64; e += 1024) {
            const float4 v = *(const float4*)(w2 + e);
            *(half4*)(w2s + e) = (half4){(h16)v.x, (h16)v.y, (h16)v.z, (h16)v.w};
        }
        const float* pt = (const float*)(P->ws + OFF_CHID) + (size_t)j * 2048 * 512;
        float pb = 0.f;
#pragma unroll
        for (int ks = 0; ks < 16; ++ks) pb += ((const float*)(P->ws + OFF_POSB))[((l * 2 + j) * 16 + ks) * 256 + tid];
#pragma unroll
        for (int rr = 0; rr < 8; ++rr) {
            const int row = r0 + rr, i = row & 511;
            float v = 0.f;
            if (i < 511) v = gelu_tanh(pt[(size_t)row * 512 + tid] + pt[(size_t)(row + 1) * 512 + 256 + tid] + pb);
            hs[rr * 256 + tid] = v;
        }
    }
    __syncthreads();
    const float bb = P->in[I_CB2][(l * 2 + j) * 64 + lane];
    float a0 = bb, a1 = bb;
    const float* h0 = hs + (2 * w) * 256, *h1 = h0 + 256;
#pragma unroll 8
    for (int n = 0; n < 256; ++n) {
        const float wv = (float)w2s[n * 64 + lane];
        a0 += h0[n] * wv; a1 += h1[n] * wv;
    }
#pragma unroll
    for (int rr = 0; rr < 2; ++rr) {
        float acc = rr ? a1 : a0;
        const int row = r0 + 2 * w + rr, bg = row >> 9, i = row & 511;
        if (i == 511) acc = 0.f;
        if (j == 0) {
            const float ss = wave_sum(acc * acc);
            acc = acc * rsqrtf(ss * (1.f / 64.f) + 1e-6f) * P->in[I_NKN][(l * 3 + 0) * 64 + lane];
            ((h16*)(P->ws + OFF_KCMP))[(size_t)row * 64 + lane] = (h16)acc;
        } else {
            ((h16*)(P->ws + OFF_VCMP))[(((size_t)bg * 8 + (i >> 6)) * 64 + lane) * 64 + (i & 63)] = (h16)acc;
        }
    }
    __syncthreads();
}

DI void s5o_gemm_tile(PP P, int l, int tile, char* smem, const int wv) {
    P = plaunder(P);
    const int g = tile >> 5, mt = (tile >> 3) & 3, nt = tile & 7;
    f32x4 acc[2][4];
    float ssd[2];
    gemm_glds<false, 4, 2, 4>(wv, 640, AS5{(const h16*)(P->ws + OFF_PROJ) + C_SU + g * 16, (const h16*)(P->ws + OFF_XCH) + g * 128, mt * 128},
                              (const h16*)(P->ws + OFF_S5W) + ((size_t)g * 512 + nt * 64) * 640, 640, acc, ssd, smem);
    const int tid = otid(wv), lane = tid & 63, wid = tid >> 6;
    const h16* proj = (const h16*)(P->ws + OFF_PROJ);
    h16* yact = (h16*)(P->ws + OFF_YACT);
#pragma unroll
    for (int i = 0; i < 2; ++i) {
        const size_t ch = (size_t)mt * 128 + wid * 32 + i * 16 + (lane & 15);
#pragma unroll
        for (int jj = 0; jj < 4; ++jj) {
            const int n = nt * 64 + jj * 16 + (lane >> 4) * 4;
            const int j = n >> 4, c = n & 15;
            const size_t tok = ch * 32 + j;
            const half4 u4 = *(const half4*)(proj + tok * D_IN + C_SU + g * 16 + c);
            const float4 dd = *(const float4*)(P->in[I_SD] + (l * 16 + g) * 16 + c);
            const f32x4 v = acc[i][jj];
            half4 o;
            o[0] = (h16)gelu_tanh(v[0] + dd.x * (float)u4[0]);
            o[1] = (h16)gelu_tanh(v[1] + dd.y * (float)u4[1]);
            o[2] = (h16)gelu_tanh(v[2] + dd.z * (float)u4[2]);
            o[3] = (h16)gelu_tanh(v[3] + dd.w * (float)u4[3]);
            *(half4*)(yact + tok * 256 + g * 16 + c) = o;
        }
    }
}

#define MFMA32(a, b, c) __builtin_amdgcn_mfma_f32_32x32x16_f16((a), (b), (c), 0, 0, 0)
constexpr float FAST_SHIFT = 4.f;
constexpr float NEGS = -1e30f;
DI float ex2(float x) { return __builtin_amdgcn_exp2f(x); }
#define NSA_WAITBAR(N) asm volatile("s_waitcnt vmcnt(" #N ") lgkmcnt(0)\n\ts_barrier" ::: "memory")
#define NSA_BAR() asm volatile("s_waitcnt lgkmcnt(0)\n\ts_barrier" ::: "memory")

struct KVSrc { const h16* k; int ldk; size_t kstep; const h16* v; };
DI void nsa_dma(const KVSrc& s, int j, char* stage, int wid, int lane) {
    const int row0 = wid * 8 + (lane >> 3);
    const int sw = ((lane & 7) ^ ((row0 >> 1) & 7)) * 8;
    const h16* kp = s.k + (size_t)j * s.kstep + (size_t)row0 * s.ldk + sw;
    glds16(kp, stage + wid * 1024);
    glds16(kp + (size_t)32 * s.ldk, stage + 4096 + wid * 1024);
    const h16* vp = s.v + (size_t)j * 4096 + row0 * 64 + sw;
    glds16(vp, stage + 8192 + wid * 1024);
    glds16(vp + 32 * 64, stage + 8192 + 4096 + wid * 1024);
}
template <int NST, class F>
DI void nsa_pipe(const KVSrc& s, const int n, char* smem, int wid, int lane, F&& compute) {
    NSA_WAITBAR(0);
    {
        const int k = n < NST - 1 ? n : NST - 1;
        for (int p = 0; p < k; ++p) nsa_dma(s, p, smem + p * 16384, wid, lane);
        if (k >= 3) NSA_WAITBAR(8); else if (k == 2) NSA_WAITBAR(4); else NSA_WAITBAR(0);
        __builtin_amdgcn_s_sleep(2);
    }
    for (int j = 0; j < n; ++j) {
        if (NST == 4 && j + 2 < n) NSA_WAITBAR(4); else NSA_WAITBAR(0);
        const int jn = j + NST - 1;
        compute(j, smem + (j % NST) * 16384, [&]() { if (jn < n) nsa_dma(s, jn, smem + (jn % NST) * 16384, wid, lane); });
    }
}

template <bool SHIFT = false>
DI void qk_tile(const char* Kimg, const half8 (&qf)[4], f32x16 (&s)[2], int lane) {
    const int r = lane & 31, h = lane >> 5, swz = (r >> 1) & 7;
    const char* base = Kimg + r * 128;
#pragma unroll
    for (int kt = 0; kt < 2; ++kt) {
        half8 kf[4];
#pragma unroll
        for (int ks = 0; ks < 4; ++ks) kf[ks] = *(const half8*)(base + kt * 4096 + (((2 * ks + h) ^ swz) << 4));
#pragma unroll
        for (int e = 0; e < 16; ++e) s[kt][e] = SHIFT ? -FAST_SHIFT : 0.f;
        __builtin_amdgcn_s_setprio(1);
#pragma unroll
        for (int ks = 0; ks < 4; ++ks) s[kt] = MFMA32(kf[ks], qf[ks], s[kt]);
        __builtin_amdgcn_s_setprio(0);
    }
}
template <int S> DI half8 pack8(const f32x16& x) {
    return (half8){(h16)x[8 * S], (h16)x[8 * S + 1], (h16)x[8 * S + 2], (h16)x[8 * S + 3], (h16)x[8 * S + 4], (h16)x[8 * S + 5], (h16)x[8 * S + 6], (h16)x[8 * S + 7]};
}
DI half8 ld_vfrag(const char* Vimg, int off0) {
    const half4 lo = *(const half4*)(Vimg + off0), hi = *(const half4*)(Vimg + (off0 ^ 16));
    return (half8){lo[0], lo[1], lo[2], lo[3], hi[0], hi[1], hi[2], hi[3]};
}
template <int KT>
DI void pv_load(const char* Vimg, half8 (&vf)[4], int lane) {
    const int r = lane & 31, h = lane >> 5, swz16 = ((r >> 1) & 7) << 4;
    const char* rb = Vimg + r * 128 + 8 * h;
#pragma unroll
    for (int dt = 0; dt < 2; ++dt) {
        vf[dt * 2 + 0] = ld_vfrag(rb + dt * 4096, ((4 * KT) << 4) ^ swz16);
        vf[dt * 2 + 1] = ld_vfrag(rb + dt * 4096, ((4 * KT + 2) << 4) ^ swz16);
    }
}
typedef unsigned u32x4_ __attribute__((ext_vector_type(4)));
template <int KT, bool MASKED = false>
DI void pv_mma(const half8 (&vf)[4], const f32x16 (&p)[2], f32x16 (&o)[2], const unsigned rmask = 0xffffffffu) {
    half8 pb0 = pack8<0>(p[KT]), pb1 = pack8<1>(p[KT]);
    if (MASKED) {
        pb0 = __builtin_bit_cast(half8, __builtin_bit_cast(u32x4_, pb0) & rmask);
        pb1 = __builtin_bit_cast(half8, __builtin_bit_cast(u32x4_, pb1) & rmask);
    }
    __builtin_amdgcn_s_setprio(1);
#pragma unroll
    for (int dt = 0; dt < 2; ++dt) {
        o[dt] = MFMA32(vf[dt * 2 + 0], pb0, o[dt]);
        o[dt] = MFMA32(vf[dt * 2 + 1], pb1, o[dt]);
    }
    __builtin_amdgcn_s_setprio(0);
}
template <bool MASKED = false>
DI void pv_finish(const char* Vimg, const half8 (&va)[4], const f32x16 (&p)[2], f32x16 (&o)[2], int lane, const unsigned rmask = 0xffffffffu) {
    half8 vb[4];
    pv_load<1>(Vimg, vb, lane);
    pv_mma<0, MASKED>(va, p, o, rmask);
    pv_mma<1, MASKED>(vb, p, o, rmask);
}
DI float sm_fast(f32x16 (&s)[2]) {
    float rs = 0.f;
#pragma unroll
    for (int kt = 0; kt < 2; ++kt)
#pragma unroll
        for (int e = 0; e < 16; ++e) { const float p = ex2(s[kt][e]); s[kt][e] = p; rs += p; }
    return rs;
}
DI float xhalf_max(float v) {
    const auto r = __builtin_amdgcn_permlane32_swap(__float_as_uint(v), __float_as_uint(v), false, false);
    return fmaxf(__uint_as_float(r[0]), __uint_as_float(r[1]));
}
DI float xhalf_sum(float v) {
    const auto r = __builtin_amdgcn_permlane32_swap(__float_as_uint(v), __float_as_uint(v), false, false);
    return __uint_as_float(r[0]) + __uint_as_float(r[1]);
}
DI float rowmax32(const f32x16 (&s)[2]) {
    float mx = s[0][0];
#pragma unroll
    for (int e = 1; e < 16; ++e) mx = fmaxf(mx, s[0][e]);
#pragma unroll
    for (int e = 0; e < 16; ++e) mx = fmaxf(mx, s[1][e]);
    return xhalf_max(mx);
}
constexpr float SM_THR = 6.f;
DI void sm_online(f32x16 (&s)[2], float& m, float& l, f32x16 (&o)[2], const bool rowok) {
    float mx = rowmax32(s);
    mx = rowok ? mx : NEGS;
    if (__any(mx > m + SM_THR)) {
        const float mn = fmaxf(m, mx), alpha = ex2(m - mn);
        l *= alpha; o[0] *= alpha; o[1] *= alpha; m = mn;
    }
    const float msub = rowok ? m : 1e30f;
    float rs = 0.f;
#pragma unroll
    for (int kt = 0; kt < 2; ++kt)
#pragma unroll
        for (int e = 0; e < 16; ++e) { const float p = ex2(s[kt][e] - msub); s[kt][e] = p; rs += p; }
    l += xhalf_sum(rs);
}

template <int V> struct IC { static constexpr int value = V; };
template <bool FAST>
DI void nsa_unit(PP P, int l, int bg, int c32, char* smem, const int wv) {
    P = plaunder(P);
    const int tid = otid(wv), lane = tid & 63, w = tid >> 6, r = lane & 31, h = lane >> 5;
    const int b = bg >> 1, g = bg & 1, t0 = c32 * 32, cur = c32 >> 1;
    const int tokl = w * 8 + (r >> 2), head = r & 3, t = t0 + tokl;
    const size_t tokg = (size_t)b * SEQ + t;
    float* IMP = (float*)(smem + 49152);
    unsigned* SELM = (unsigned*)(smem + 49152);
    const h16* proj = (const h16*)(P->ws + OFF_PROJ);
    const int ghead = g * 4 + head;

    half8 qf[4];
    {
        const h16* qp = proj + tokg * D_IN + C_NQ + ghead * 64 + 8 * h;
#pragma unroll
        for (int ks = 0; ks < 4; ++ks) qf[ks] = *(const half8*)(qp + 16 * ks);
    }
    float g0, g1, g2;
    {
        const h16* gp = proj + tokg * D_IN + C_NGL + ghead * 3;
        const float* gb = P->in[I_NGB] + l * 24 + ghead * 3;
        g0 = sigmoidf_((float)gp[0] + gb[0]); g1 = sigmoidf_((float)gp[1] + gb[1]); g2 = sigmoidf_((float)gp[2] + gb[2]);
    }
    __syncthreads();
    for (int i = tid; i < 32 * 128; i += 256) IMP[i] = 0.f;

    half8 oacc[4];
    auto oacc_add = [&](const f32x16 (&o)[2], const float sc, const bool first) {
#pragma unroll
        for (int dt = 0; dt < 2; ++dt)
#pragma unroll
            for (int hf = 0; hf < 2; ++hf) {
                half8 v = oacc[dt * 2 + hf];
#pragma unroll
                for (int e = 0; e < 8; ++e) v[e] = (h16)((first ? 0.f : (float)v[e]) + o[dt][hf * 8 + e] * sc);
                oacc[dt * 2 + hf] = v;
            }
    };

    {
        const int nvt = 2 * c32 + 1;
        const int nvr = (t >= 31) ? ((t - 31) >> 4) + 1 : 0;
        const int ntile = (nvt + 63) >> 6;
        KVSrc src{(const h16*)(P->ws + OFF_KCMP) + (size_t)bg * 512 * 64, 64, 4096, (const h16*)(P->ws + OFF_VCMP) + (size_t)bg * 8 * 4096};
        f32x16 o[2];
#pragma unroll
        for (int e = 0; e < 16; ++e) { o[0][e] = 0.f; o[1][e] = 0.f; }
        float invl;
        if constexpr (FAST) {
            const int tf = t0 + w * 8;
            const int nvlo = __builtin_amdgcn_readfirstlane((tf >= 31) ? ((tf - 31) >> 4) + 1 : 0);
            float lsum = 0.f;
            nsa_pipe<3>(src, ntile, smem, w, lane, [&](int j, const char* st, auto&& issue) {
                f32x16 s[2];
                qk_tile<true>(st, qf, s, lane);
                issue();
                if (64 * j + 64 > nvlo) {
#pragma unroll
                    for (int kt = 0; kt < 2; ++kt)
#pragma unroll
                        for (int e = 0; e < 16; ++e) {
                            const int key = 64 * j + 32 * kt + 8 * (e >> 2) + 4 * h + (e & 3);
                            if (key >= nvr) s[kt][e] = NEGS;
                        }
                }
                lsum += sm_fast(s);
            });
            lsum = xhalf_sum(lsum);
            invl = lsum > 0.f ? 1.f / lsum : 0.f;
            nsa_pipe<3>(src, ntile, smem, w, lane, [&](int j, const char* st, auto&& issue) {
                f32x16 s[2];
                qk_tile<true>(st, qf, s, lane);
                half8 vf[4];
                pv_load<0>(st + 8192, vf, lane);
                issue();
                __builtin_amdgcn_sched_barrier(0);
                if (64 * j + 64 > nvlo) {
#pragma unroll
                    for (int kt = 0; kt < 2; ++kt)
#pragma unroll
                        for (int e = 0; e < 16; ++e) {
                            const int key = 64 * j + 32 * kt + 8 * (e >> 2) + 4 * h + (e & 3);
                            if (key >= nvr) s[kt][e] = NEGS;
                        }
                }
                (void)sm_fast(s);
                if (cur >= 16) {
#pragma unroll
                    for (int kt = 0; kt < 2; ++kt)
#pragma unroll
                        for (int g4 = 0; g4 < 4; ++g4) {
                            float G = ((s[kt][4 * g4] + s[kt][4 * g4 + 1]) + (s[kt][4 * g4 + 2] + s[kt][4 * g4 + 3])) * invl;
                            float L = s[kt][4 * g4 + 3] * invl;
                            G += __shfl_xor(G, 1); G += __shfl_xor(G, 2);
                            L += __shfl_xor(L, 1); L += __shfl_xor(L, 2);
                            if (head == 0) {
                                const int sb = 16 * j + 8 * kt + 2 * g4 + h;
                                atomicAdd(&IMP[tokl * 128 + sb], G);
                                if (sb + 1 < 128) atomicAdd(&IMP[tokl * 128 + sb + 1], L);
                            }
                        }
                }
                pv_finish(st + 8192, vf, s, o, lane);
            });
        } else {
        float m = -1e20f, lsum = 0.f;
        nsa_pipe<3>(src, ntile, smem, w, lane, [&](int j, const char* st, auto&& issue) {
            f32x16 s[2];
            qk_tile(st, qf, s, lane);
            issue();
#pragma unroll
            for (int kt = 0; kt < 2; ++kt)
#pragma unroll
                for (int e = 0; e < 16; ++e) {
                    const int key = 64 * j + 32 * kt + 8 * (e >> 2) + 4 * h + (e & 3);
                    if (key >= nvr) s[kt][e] = NEGS;
                }
            const float mn = fmaxf(m, rowmax32(s)), alpha = ex2(m - mn);
            float rs = 0.f;
#pragma unroll
            for (int kt = 0; kt < 2; ++kt)
#pragma unroll
                for (int e = 0; e < 16; ++e) rs += ex2(s[kt][e] - mn);
            rs = xhalf_sum(rs);
            lsum = lsum * alpha + rs; m = mn;
        });
        const float invl_s = lsum > 0.f ? 1.f / lsum : 0.f;
        nsa_pipe<3>(src, ntile, smem, w, lane, [&](int j, const char* st, auto&& issue) {
            f32x16 s[2];
            qk_tile(st, qf, s, lane);
            half8 vf[4];
            pv_load<0>(st + 8192, vf, lane);
            issue();
            __builtin_amdgcn_sched_barrier(0);
#pragma unroll
            for (int kt = 0; kt < 2; ++kt)
#pragma unroll
                for (int e = 0; e < 16; ++e) {
                    const int key = 64 * j + 32 * kt + 8 * (e >> 2) + 4 * h + (e & 3);
                    s[kt][e] = (key < nvr) ? ex2(s[kt][e] - m) * invl_s : 0.f;
                }
            if (cur >= 16) {
#pragma unroll
                for (int kt = 0; kt < 2; ++kt)
#pragma unroll
                    for (int g4 = 0; g4 < 4; ++g4) {
                        float G = (s[kt][4 * g4] + s[kt][4 * g4 + 1]) + (s[kt][4 * g4 + 2] + s[kt][4 * g4 + 3]);
                        float L = s[kt][4 * g4 + 3];
                        G += __shfl_xor(G, 1); G += __shfl_xor(G, 2);
                        L += __shfl_xor(L, 1); L += __shfl_xor(L, 2);
                        if (head == 0) {
                            const int sb = 16 * j + 8 * kt + 2 * g4 + h;
                            atomicAdd(&IMP[tokl * 128 + sb], G);
                            if (sb + 1 < 128) atomicAdd(&IMP[tokl * 128 + sb + 1], L);
                        }
                    }
            }
            pv_finish(st + 8192, vf, s, o, lane);
        });
            invl = 1.f;
        }
        oacc_add(o, g0 * invl, true);
    }
    __syncthreads();
    {
        const int tl = lane >> 3, sub = lane & 7;
        unsigned bits = 0;
        unsigned u[16];
        if (cur >= 16) {
            const float* ip = IMP + (w * 8 + tl) * 128 + sub * 16;
#pragma unroll
            for (int i = 0; i < 16; ++i) {
                const int s = sub * 16 + i;
                u[i] = (s >= 1 && s <= cur - 2) ? (__float_as_uint(ip[i]) + 1u) : 0u;
            }
        }
        __syncthreads();
        if (cur >= 16) {
            unsigned prefix = 0;
            for (int bit = 30; bit >= 0; --bit) {
                const unsigned cand = prefix | (1u << bit);
                int cnt = 0;
#pragma unroll
                for (int i = 0; i < 16; ++i) cnt += (u[i] >= cand) ? 1 : 0;
                cnt += __shfl_xor(cnt, 1); cnt += __shfl_xor(cnt, 2); cnt += __shfl_xor(cnt, 4);
                if (cnt >= 13) prefix = cand;
            }
            int cgt = 0, ceq = 0;
#pragma unroll
            for (int i = 0; i < 16; ++i) { cgt += (u[i] > prefix) ? 1 : 0; ceq += (u[i] == prefix) ? 1 : 0; }
            cgt += __shfl_xor(cgt, 1); cgt += __shfl_xor(cgt, 2); cgt += __shfl_xor(cgt, 4);
            int inc = ceq;
            { const int v = __shfl_up(inc, 1); if (sub >= 1) inc += v; }
            { const int v = __shfl_up(inc, 2); if (sub >= 2) inc += v; }
            { const int v = __shfl_up(inc, 4); if (sub >= 4) inc += v; }
            int run = inc - ceq;
            const int need = 13 - cgt;
#pragma unroll
            for (int i = 0; i < 16; ++i) {
                const int s = sub * 16 + i;
                bool sel = u[i] > prefix;
                if (u[i] == prefix) { sel = run < need; ++run; }
                if (s == 0 || s == cur || s == cur - 1) sel = true;
                bits |= (sel ? 1u : 0u) << i;
            }
        } else {
#pragma unroll
            for (int i = 0; i < 16; ++i) bits |= ((sub * 16 + i <= cur) ? 1u : 0u) << i;
        }
        unsigned wv = bits << ((sub & 1) * 16);
        wv |= __shfl_xor(wv, 1);
        if ((sub & 1) == 0) SELM[(w * 8 + tl) * 4 + (sub >> 1)] = wv;
    }
    __syncthreads();
    unsigned selw[4];
#pragma unroll
    for (int i = 0; i < 4; ++i) selw[i] = SELM[tokl * 4 + i];

    auto branch = [&](auto BRC) {
        constexpr int br = decltype(BRC)::value;
        const int j0 = (br == 0) ? 0 : (cur - 8 > 0 ? cur - 8 : 0);
        const int nst = cur - j0 + 1;
        KVSrc src{proj + ((size_t)b * SEQ + (size_t)j0 * 64) * D_IN + C_NKV + (br == 0 ? 256 : 512) + g * 64, D_IN, (size_t)64 * D_IN,
                  (const h16*)(P->ws + OFF_VTG) + (((size_t)br * 4 + bg) * 128 + j0) * 4096};
        float m = -1e20f, lsum = 0.f;
        f32x16 o[2];
#pragma unroll
        for (int e = 0; e < 16; ++e) { o[0][e] = 0.f; o[1][e] = 0.f; }
        nsa_pipe<4>(src, nst, smem, w, lane, [&](int jj, const char* st, auto&& issue) {
            const int j = j0 + jj;
            const bool rowok = (br != 0) || (((selw[j >> 5] >> (j & 31)) & 1u) != 0u);
            if constexpr (FAST && br == 0) {
                if (!__any(rowok)) { issue(); return; }
            }
            f32x16 s[2];
            qk_tile<FAST>(st, qf, s, lane);
            half8 vf[4];
            pv_load<0>(st + 8192, vf, lane);
            issue();
            __builtin_amdgcn_sched_barrier(0);
            if (j == cur || (br == 1 && j == cur - 8)) {
#pragma unroll
                for (int kt = 0; kt < 2; ++kt)
#pragma unroll
                    for (int e = 0; e < 16; ++e) {
                        const int key = 64 * j + 32 * kt + 8 * (e >> 2) + 4 * h + (e & 3);
                        const bool ok = (key <= t) && (br == 0 || key > t - 512);
                        if (!ok) s[kt][e] = NEGS;
                    }
            }
            if constexpr (FAST) {
                const float rs = sm_fast(s);
                lsum += (br != 0 || rowok) ? rs : 0.f;
                pv_finish<br == 0>(st + 8192, vf, s, o, lane, rowok ? 0xffffffffu : 0u);
            } else {
                sm_online(s, m, lsum, o, rowok);
                pv_finish(st + 8192, vf, s, o, lane);
            }
        });
        if constexpr (FAST) lsum = xhalf_sum(lsum);
        const float sc = (br == 0 ? g1 : g2) / lsum;
        oacc_add(o, sc, false);
    };
    branch(IC<0>{});
    branch(IC<1>{});
    {
        h16* mixp = (h16*)(P->ws + OFF_MIX) + kb_idx(NT, tokg, 512 + ghead * 64);
        const h16* ngp = proj + tokg * D_IN + C_NG + ghead * 64;
#pragma unroll
        for (int dt = 0; dt < 2; ++dt)
#pragma unroll
            for (int g4 = 0; g4 < 4; ++g4) {
                const int d0 = 32 * dt + 8 * g4 + 4 * h;
                const half4 ng = *(const half4*)(ngp + d0);
                half4 ov;
#pragma unroll
                for (int e = 0; e < 4; ++e) ov[e] = (h16)((float)oacc[dt * 2 + (g4 >> 1)][(g4 & 1) * 4 + e] * siluf_((float)ng[e]));
                *(half4*)(mixp + d0) = ov;
            }
    }
    __syncthreads();
}

DI void gla_kv_item(PP P, int l, int item, char* smem, const int wv) {
    P = plaunder(P);
    const int tid = otid(wv), lane = tid & 63, w = tid >> 6, r = lane & 31, hh = lane >> 5;
    const int pair = item * 4 + w, h = pair & 3, cn = pair >> 2;
    const size_t tok = (size_t)cn * 32 + r;
    const int b = cn >> 8, n = cn & 255, bh = b * 4 + h;
    const h16* proj = (const h16*)(P->ws + OFF_PROJ);
    h16* VT = (h16*)(smem + w * 16384);
    h16* KT = VT + 2048;
    __syncthreads();
    {
        const half8* vp = (const half8*)(proj + tok * D_IN + C_GV + h * 64 + hh * 32);
#pragma unroll
        for (int q = 0; q < 4; ++q) {
            const half8 v8 = vp[q];
#pragma unroll
            for (int e = 0; e < 8; ++e) VT[(hh * 32 + q * 8 + e) * 32 + r] = v8[e];
        }
    }
    float gl[16];
    {
        const half8* lp = (const half8*)(proj + tok * D_IN + C_GLR);
        const half8 l0 = lp[0], l1 = lp[1];
        float lr[16];
#pragma unroll
        for (int q = 0; q < 8; ++q) { lr[q] = (float)l0[q]; lr[8 + q] = (float)l1[q]; }
        const float* w2 = P->in[I_GW2] + (size_t)l * 16 * 128 + h * 32 + 16 * hh;
        const float* b2 = P->in[I_GB2] + l * 128 + h * 32 + 16 * hh;
#pragma unroll
        for (int d = 0; d < 16; ++d) gl[d] = b2[d];
#pragma unroll
        for (int q = 0; q < 16; ++q)
#pragma unroll
            for (int d4 = 0; d4 < 4; ++d4) {
                const float4 wq = *(const float4*)(w2 + q * 128 + d4 * 4);
                gl[d4 * 4 + 0] += lr[q] * wq.x; gl[d4 * 4 + 1] += lr[q] * wq.y; gl[d4 * 4 + 2] += lr[q] * wq.z; gl[d4 * 4 + 3] += lr[q] * wq.w;
            }
#pragma unroll
        for (int d = 0; d < 16; ++d) gl[d] = log_sigmoidf_(gl[d]) * (1.f / 16.f);
    }
#pragma unroll
    for (int off = 1; off < 32; off <<= 1) {
#pragma unroll
        for (int d = 0; d < 16; ++d) { const float v = __shfl_up(gl[d], off, 32); if (r >= off) gl[d] += v; }
    }
    {
        float* bc = (float*)(P->ws + OFF_BCUM) + tok * 128 + h * 32 + 16 * hh;
#pragma unroll
        for (int d4 = 0; d4 < 4; ++d4) *(float4*)(bc + d4 * 4) = (float4){gl[d4 * 4], gl[d4 * 4 + 1], gl[d4 * 4 + 2], gl[d4 * 4 + 3]};
    }
    {
        const half8* kp = (const half8*)(proj + tok * D_IN + C_GK + h * 32 + 16 * hh);
        const half8 k0 = kp[0], k1 = kp[1];
        float bl[16];
#pragma unroll
        for (int d = 0; d < 16; ++d) bl[d] = __shfl(gl[d], 31, 32);
#pragma unroll
        for (int d = 0; d < 16; ++d) {
            const float kd = (float)(d < 8 ? k0[d & 7] : k1[d & 7]) * __expf(bl[d] - gl[d]);
            KT[(16 * hh + d) * 32 + r] = (h16)kd;
        }
        if (r == 0) {
            float* dc = (float*)(P->ws + OFF_GDEC) + (size_t)(bh * 256 + n) * 32 + 16 * hh;
#pragma unroll
            for (int d4 = 0; d4 < 4; ++d4) *(float4*)(dc + d4 * 4) = (float4){__expf(bl[d4 * 4]), __expf(bl[d4 * 4 + 1]), __expf(bl[d4 * 4 + 2]), __expf(bl[d4 * 4 + 3])};
        }
    }
    asm volatile("s_waitcnt lgkmcnt(0)" ::: "memory");
    const half8 kb0 = *(const half8*)(KT + r * 32 + 8 * hh), kb1 = *(const half8*)(KT + r * 32 + 16 + 8 * hh);
    float* kvp = (float*)(P->ws + OFF_GKV) + ((size_t)(bh * 256 + n) * 32 + r) * 64;
#pragma unroll
    for (int dt = 0; dt < 2; ++dt) {
        f32x16 o;
#pragma unroll
        for (int e = 0; e < 16; ++e) o[e] = 0.f;
        const h16* vrow = VT + (32 * dt + r) * 32 + 8 * hh;
        o = MFMA32(*(const half8*)vrow, kb0, o);
        o = MFMA32(*(const half8*)(vrow + 16), kb1, o);
#pragma unroll
        for (int g4 = 0; g4 < 4; ++g4)
            *(float4*)(kvp + 32 * dt + 8 * g4 + 4 * hh) = (float4){o[4 * g4], o[4 * g4 + 1], o[4 * g4 + 2], o[4 * g4 + 3]};
    }
    __syncthreads();
}

DI void gla_out_item(PP P, int l, int item, char* smem, const int wv) {
    P = plaunder(P);
    const int tid = otid(wv), lane = tid & 63, w = tid >> 6, r = lane & 31, hh = lane >> 5;
    const int pair = item * 4 + w, h = pair & 3, cn = pair >> 2;
    const size_t tok0 = (size_t)cn * 32, tok = tok0 + r;
    const int b = cn >> 8, n = cn & 255, bh = b * 4 + h;
    const h16* proj = (const h16*)(P->ws + OFF_PROJ);
    h16* VT = (h16*)(smem + w * 16384);
    h16* SPT = VT + 2048;
    __syncthreads();
    {
        const half8* vp = (const half8*)(proj + tok * D_IN + C_GV + h * 64 + hh * 32);
        const float4* sp = (const float4*)((const float*)(P->ws + OFF_GKV) + ((size_t)(bh * 256 + n) * 32 + r) * 64 + hh * 32);
#pragma unroll
        for (int q = 0; q < 4; ++q) {
            const half8 v8 = vp[q];
            const float4 s0 = sp[2 * q], s1 = sp[2 * q + 1];
#pragma unroll
            for (int e = 0; e < 8; ++e) VT[(hh * 32 + q * 8 + e) * 32 + r] = v8[e];
            SPT[(hh * 32 + q * 8 + 0) * 32 + r] = (h16)s0.x; SPT[(hh * 32 + q * 8 + 1) * 32 + r] = (h16)s0.y;
            SPT[(hh * 32 + q * 8 + 2) * 32 + r] = (h16)s0.z; SPT[(hh * 32 + q * 8 + 3) * 32 + r] = (h16)s0.w;
            SPT[(hh * 32 + q * 8 + 4) * 32 + r] = (h16)s1.x; SPT[(hh * 32 + q * 8 + 5) * 32 + r] = (h16)s1.y;
            SPT[(hh * 32 + q * 8 + 6) * 32 + r] = (h16)s1.z; SPT[(hh * 32 + q * 8 + 7) * 32 + r] = (h16)s1.w;
        }
    }
    half8 qe[2], ke[2];
#pragma unroll
    for (int ks = 0; ks < 2; ++ks) {
        const int d0 = 16 * ks + 8 * hh;
        const half8 q8 = *(const half8*)(proj + tok * D_IN + C_GQ + h * 32 + d0);
        const half8 k8 = *(const half8*)(proj + tok * D_IN + C_GK + h * 32 + d0);
        const float4 b0 = *(const float4*)((const float*)(P->ws + OFF_BCUM) + tok * 128 + h * 32 + d0);
        const float4 b1 = *(const float4*)((const float*)(P->ws + OFF_BCUM) + tok * 128 + h * 32 + d0 + 4);
        const float bc[8] = {b0.x, b0.y, b0.z, b0.w, b1.x, b1.y, b1.z, b1.w};
#pragma unroll
        for (int e = 0; e < 8; ++e) {
            const float ex = __expf(bc[e]);
            qe[ks][e] = (h16)((float)q8[e] * 0.17677669529663687f * ex);
            ke[ks][e] = (h16)((float)k8[e] * __builtin_amdgcn_rcpf(ex));
        }
    }
    f32x16 s;
#pragma unroll
    for (int e = 0; e < 16; ++e) s[e] = 0.f;
    s = MFMA32(ke[0], qe[0], s);
    s = MFMA32(ke[1], qe[1], s);
#pragma unroll
    for (int e = 0; e < 16; ++e) { const int j = (e & 3) + 8 * (e >> 2) + 4 * hh; if (j > r) s[e] = 0.f; }
    const half8 pb0 = pack8<0>(s), pb1 = pack8<1>(s);
    asm volatile("s_waitcnt lgkmcnt(0)" ::: "memory");
    f32x16 o[2];
#pragma unroll
    for (int dt = 0; dt < 2; ++dt) {
#pragma unroll
        for (int e = 0; e < 16; ++e) o[dt][e] = 0.f;
        const h16* vrow = VT + (32 * dt + r) * 32 + 4 * hh;
        const h16* srow = SPT + (32 * dt + r) * 32 + 8 * hh;
        {
            const half4 lo = *(const half4*)vrow, hi = *(const half4*)(vrow + 8);
            o[dt] = MFMA32(((half8){lo[0], lo[1], lo[2], lo[3], hi[0], hi[1], hi[2], hi[3]}), pb0, o[dt]);
        }
        {
            const half4 lo = *(const half4*)(vrow + 16), hi = *(const half4*)(vrow + 24);
            o[dt] = MFMA32(((half8){lo[0], lo[1], lo[2], lo[3], hi[0], hi[1], hi[2], hi[3]}), pb1, o[dt]);
        }
        o[dt] = MFMA32(*(const half8*)srow, qe[0], o[dt]);
        o[dt] = MFMA32(*(const half8*)(srow + 16), qe[1], o[dt]);
    }
    float ss = 0.f;
#pragma unroll
    for (int e = 0; e < 16; ++e) ss += o[0][e] * o[0][e] + o[1][e] * o[1][e];
    ss = xhalf_sum(ss);
    const float rn = rsqrtf(ss * (1.f / 64.f) + 1e-6f);
    h16* mix = (h16*)(P->ws + OFF_MIX);
#pragma unroll
    for (int dt = 0; dt < 2; ++dt)
#pragma unroll
        for (int g4 = 0; g4 < 4; ++g4) {
            const int e0 = 32 * dt + 8 * g4 + 4 * hh;
            const half4 gt = *(const half4*)(proj + tok * D_IN + C_GG + h * 64 + e0);
            const float4 on = *(const float4*)(P->in[I_GON] + l * 64 + e0);
            half4 ov;
            ov[0] = (h16)(o[dt][4 * g4 + 0] * rn * on.x * siluf_((float)gt[0]));
            ov[1] = (h16)(o[dt][4 * g4 + 1] * rn * on.y * siluf_((float)gt[1]));
            ov[2] = (h16)(o[dt][4 * g4 + 2] * rn * on.z * siluf_((float)gt[2]));
            ov[3] = (h16)(o[dt][4 * g4 + 3] * rn * on.w * siluf_((float)gt[3]));
            *(half4*)(mix + kb_idx(NT, tok, h * 64 + e0)) = ov;
        }
    __syncthreads();
}

DI void glu_tile(PP P, int l, int tile, char* smem, const int wv) {
    P = plaunder(P);
    const int mt = tile >> 2, nt = tile & 3;
    f32x4 acc[4][4];
    float ssd[4];
    gemm_mainloop_glds<false>(wv, 256, APlain{(const h16*)(P->ws + OFF_YACT) + (size_t)mt * 128 * 256, 256, 64},
                              (const h16*)(P->ws + OFF_WTGLU) + ((size_t)l * 512 + nt * 128) * 256, 256, acc, ssd, smem);
    const int tid = otid(wv), lane = tid & 63, wid = tid >> 6, wr = wid >> 1, wc = wid & 1;
    const h16* proj = (const h16*)(P->ws + OFF_PROJ);
    h16* mix = (h16*)(P->ws + OFF_MIX);
    const float* gb = P->in[I_GLUB] + l * 512;
#pragma unroll
    for (int i = 0; i < 4; ++i) {
        const size_t tok = (size_t)mt * 128 + wr * 64 + i * 16 + (lane & 15);
#pragma unroll
        for (int pj = 0; pj < 2; ++pj) {
            const int c = nt * 64 + wc * 32 + pj * 16 + (lane >> 4) * 4;
            const f32x4 z1 = acc[i][2 * pj], z2 = acc[i][2 * pj + 1];
            const float4 b1 = *(const float4*)(gb + c), b2 = *(const float4*)(gb + 256 + c);
            const half4 g4 = *(const half4*)(proj + tok * D_IN + C_SG + c);
            half4 o;
            o[0] = (h16)((z1[0] + b1.x) * sigmoidf_(z2[0] + b2.x) * siluf_((float)g4[0]));
            o[1] = (h16)((z1[1] + b1.y) * sigmoidf_(z2[1] + b2.y) * siluf_((float)g4[1]));
            o[2] = (h16)((z1[2] + b1.z) * sigmoidf_(z2[2] + b2.z) * siluf_((float)g4[2]));
            o[3] = (h16)((z1[3] + b1.w) * sigmoidf_(z2[3] + b2.w) * siluf_((float)g4[3]));
            *(half4*)(mix + kb_idx(NT, tok, 256 + c)) = o;
        }
    }
}

DI void outproj_tile(PP P, int l, int mt, int nt, char* smem, const int wv) {
    P = plaunder(P);
    f32x4 acc[8][4];
    float ssd[8];
    gemm_glds<false, 2, 8, 4, 3>(wv, 1024, APlain{(const h16*)(P->ws + OFF_MIX) + (size_t)mt * 256 * 64, 64, (size_t)NT * 64},
                              (const h16*)(P->ws + OFF_WTOUT) + ((size_t)l * 16 * 1024 + nt * 128) * 64, 64, acc, ssd, smem, (size_t)1024 * 64);
    const int tid = otid(wv), lane = tid & 63, wid = tid >> 6, wr = wid >> 1, wc = wid & 1;
    const float* xin = (l == 0) ? P->in[I_X] : P->out;
    h16* xh = (h16*)(P->ws + OFF_XH);
#pragma unroll
    for (int i = 0; i < 8; ++i) {
        const size_t row = (size_t)mt * 256 + wr * 128 + i * 16 + (lane & 15);
#pragma unroll
        for (int jj = 0; jj < 4; ++jj) {
            const int n = nt * 128 + wc * 64 + jj * 16 + (lane >> 4) * 4;
            const f32x4 v = acc[i][jj];
            const float4 xo = *(const float4*)(xin + row * 1024 + n);
            const float4 xn = (float4){xo.x + v[0], xo.y + v[1], xo.z + v[2], xo.w + v[3]};
            *(float4*)(P->out + row * 1024 + n) = xn;
            *(half4*)(xh + kb_idx(NT, row, n)) = (half4){(h16)xn.x, (h16)xn.y, (h16)xn.z, (h16)xn.w};
        }
    }
}

#define XB_TMO      128
#define XB_XCNT(j)  (256  + 64 * (j))
#define XB_XSUB(j)  (1280 + 64 * (j))
#define XB_XGEN(j)  (2304 + 64 * (j))
#define XB_TOP      3328
#define XB_TOPGEN   3392
#define XCD_BAR_WORDS 3456
#define XB_SPIN_CAP (1u << 18)
#define LAS __attribute__((address_space(3)))

__device__ __forceinline__ unsigned xb_ld(unsigned* p)              { return __hip_atomic_load(p, __ATOMIC_RELAXED, __HIP_MEMORY_SCOPE_AGENT); }
__device__ __forceinline__ unsigned xb_add(unsigned* p, unsigned v) { return __hip_atomic_fetch_add(p, v, __ATOMIC_RELAXED, __HIP_MEMORY_SCOPE_AGENT); }
__device__ __forceinline__ unsigned xb_xcc_id() { return (unsigned)__builtin_amdgcn_s_getreg((3 << 11) | 20) & 0xFu; }
#define XB_SPIN(cond, bar) do { unsigned _sp = 0; while (cond) { __builtin_amdgcn_s_sleep(1); \
    if ((++_sp & 255u) == 0u) { if (xb_ld(&(bar)[XB_TMO])) break; if (_sp > XB_SPIN_CAP) { atomicAdd(&(bar)[XB_TMO], 1u); break; } } } } while (0)

struct XcdBarrier {
    unsigned* bar; unsigned x;
    volatile LAS unsigned* st;
};

__device__ __forceinline__ XcdBarrier xcd_barrier_post(unsigned* bar, volatile LAS unsigned* st) {
    XcdBarrier b; b.bar = bar; b.x = xb_xcc_id(); b.st = st;
    if (threadIdx.x == 0) (void)xb_add(&bar[XB_XCNT(b.x)], 1u);
    return b;
}
__device__ __forceinline__ void xcd_barrier_complete(unsigned* bar, unsigned x, unsigned& nloc, unsigned& nx) {
    const unsigned G = gridDim.x * gridDim.y * gridDim.z;
    unsigned sum, cnt, mine, sp = 0u;
    for (;;) {
        sum = 0u; cnt = 0u; mine = 0u;
#pragma unroll
        for (unsigned j = 0; j < 16; ++j) { const unsigned c = xb_ld(&bar[XB_XCNT(j)]); sum += c; cnt += (c > 0u) ? 1u : 0u; mine = (j == x) ? c : mine; }
        if (sum == G) break;
        __builtin_amdgcn_s_sleep(1);
        if ((++sp & 255u) == 0u) { if (xb_ld(&bar[XB_TMO])) break; if (sp > XB_SPIN_CAP) { atomicAdd(&bar[XB_TMO], 1u); break; } }
    }
    nloc = mine > 0u ? mine : 1u; nx = cnt > 0u ? cnt : 1u;
}

__device__ __forceinline__ void xcd_barrier(const XcdBarrier& b) {
    asm volatile("s_waitcnt vmcnt(0)" ::: "memory");
    __syncthreads();
    if (threadIdx.x == 0) {
        unsigned* bar = b.bar;
        __builtin_amdgcn_s_waitcnt(0);
        unsigned nloc = b.st[0], nx = b.st[1];
        if (nloc == 0u) { xcd_barrier_complete(bar, b.x, nloc, nx); b.st[0] = nloc; b.st[1] = nx; }
        const unsigned old = xb_add(&bar[XB_XSUB(b.x)], 1u);
        const unsigned gen = old / nloc;
        if (old + 1u == (gen + 1u) * nloc) {
            __builtin_amdgcn_fence(__ATOMIC_RELEASE, "agent");
            asm volatile("s_waitcnt vmcnt(0)" ::: "memory");
            const unsigned og = xb_add(&bar[XB_TOP], 1u);
            const unsigned tg = og / nx;
            if (og + 1u == (tg + 1u) * nx) xb_add(&bar[XB_TOPGEN], 1u);
            else XB_SPIN(xb_ld(&bar[XB_TOPGEN]) == tg, bar);
            __builtin_amdgcn_fence(__ATOMIC_ACQUIRE, "agent");
            xb_add(&bar[XB_XGEN(b.x)], 1u);
            asm volatile("s_waitcnt vmcnt(0)" ::: "memory");
        } else {
            XB_SPIN(xb_ld(&bar[XB_XGEN(b.x)]) == gen, bar);
            __builtin_amdgcn_fence(__ATOMIC_ACQUIRE, "agent");
            asm volatile("s_waitcnt vmcnt(0)" ::: "memory");
        }
    }
    __syncthreads();
}


__global__ void __launch_bounds__(NTHREADS, 2) fwd_megakernel(Params Pval) {
    PP P = (PP)__builtin_amdgcn_kernarg_segment_ptr();
    extern __shared__ __attribute__((aligned(16))) char smem[];
    cg::grid_group grid = cg::this_grid();
    const int G = gridDim.x, bid = blockIdx.x;
    const int wv = __builtin_amdgcn_readfirstlane((int)(threadIdx.x >> 6));

    uint4& xb_words = *(uint4*)(smem + SMEM_MAIN);
    if (otid(wv) == 0) xb_words = make_uint4(0u, 0u, 0u, 0u);
    if (bid == 0) for (int i = otid(wv); i < XCD_BAR_WORDS + 16; i += NTHREADS) ((unsigned*)(P->ws + OFF_BAR))[i] = 0u;
    phase0(P, smem, wv);
    grid.sync();
    const XcdBarrier xb = xcd_barrier_post((unsigned*)(P->ws + OFF_BAR), (volatile LAS unsigned*)(smem + SMEM_MAIN));
    int vxcd = bid & 7, vjx = bid >> 3;
    {
        unsigned* xcnt = (unsigned*)(P->ws + OFF_BAR) + XCD_BAR_WORDS;
        volatile LAS unsigned* lw = (volatile LAS unsigned*)(smem + SMEM_MAIN) + 2;
        if (otid(wv) == 0) lw[0] = xb.x < 8u ? xb_add(&xcnt[xb.x], 1u) : 0xffffu;
        xcd_barrier(xb);
        if (otid(wv) == 0) {
            bool ok = (G & 7) == 0 && xb.x < 8u;
            for (int j = 0; j < 8; ++j) ok = ok && (xb_ld(&xcnt[j]) == (unsigned)(G >> 3));
            lw[1] = ok ? 1u : 0u;
        }
        __syncthreads();
        if (lw[1]) { vxcd = (int)xb.x; vjx = (int)lw[0]; }
    }
    vxcd = __builtin_amdgcn_readfirstlane(vxcd); vjx = __builtin_amdgcn_readfirstlane(vjx);

#pragma unroll 1
    for (int l = 0; l < DEPTH; ++l) {
        {
            const int xcd = vxcd, jx = vjx, nper = G >> 3;
            for (int u = jx; u < 192; u += nper) inproj_tile<2, 8>(P, l, (xcd * 8 + (u & 7)) * 256, (u >> 3) * 128, smem, wv);
            for (int it = jx; it < 16 + 40; it += nper) {
                if (it < 16) inproj_tile<4, 2>(P, l, (xcd * 16 + it) * 128, 3072, smem, wv);
                else s5_build_item(P, l, (it - 16) * 8 + xcd, smem, wv);
            }
        }
        xcd_barrier(xb);
#pragma unroll 1
        for (int w = bid; w < 128 + 64 + 512; w += G) {
            if (w < 128) cmp_gemm_tile(P, l, w, smem, wv);
            else if (w < 192) s5e_gemm_tile(P, l, w - 128, smem, wv);
            else gla_kv_item(P, l, w - 192, smem, wv);
        }
        xcd_barrier(xb);
#pragma unroll 1
        for (int w = bid; w < 512 + 512 + 64; w += G) {
            if (w < 512) cmp_l2_item(P, l, w, smem, wv);
            else if (w < 1024) gla_scan_item(P, w - 512, smem, wv);
            else s5_scan_item(P, w - 1024, smem, wv);
        }
        xcd_barrier(xb);
        bool nsa_fast;
        {
            const int ln = otid(wv) & 63;
            const float gq = wave_max(fabsf(P->in[I_NQN][l * 64 + ln]));
            const float gk = wave_max(fmaxf(fmaxf(fabsf(P->in[I_NKN][(l * 3 + 0) * 64 + ln]), fabsf(P->in[I_NKN][(l * 3 + 1) * 64 + ln])), fabsf(P->in[I_NKN][(l * 3 + 2) * 64 + ln])));
            nsa_fast = __builtin_amdgcn_readfirstlane((8.f * 1.4426950408889634f * gq * gk - FAST_SHIFT < 15.f) ? 1 : 0) != 0;
        }
#pragma unroll 1
        for (int w0 = bid; w0 < 512 + 512 + 512; w0 += G) {
            const int w = w0 < G ? vjx * 8 + vxcd : w0;
            if (w < 512) {
                const int bg = w & 3, q = w >> 2;
                if (nsa_fast) { nsa_unit<true>(P, l, bg, 255 - q, smem, wv); nsa_unit<true>(P, l, bg, q, smem, wv); }
                else { nsa_unit<false>(P, l, bg, 255 - q, smem, wv); nsa_unit<false>(P, l, bg, q, smem, wv); }
            } else if (w < 512 + 512) s5o_gemm_tile(P, l, w - 512, smem, wv);
            else gla_out_item(P, l, w - 1024, smem, wv);
        }
        xcd_barrier(xb);
#pragma unroll 1
        for (int w = bid; w < 512; w += G) glu_tile(P, l, w, smem, wv);
        xcd_barrier(xb);
        {
            const int xcd = vxcd, jx = vjx, nper = G >> 3;
            for (int u = jx; u < 64; u += nper) outproj_tile(P, l, xcd * 8 + (u & 7), u >> 3, smem, wv);
        }
        xcd_barrier(xb);
    }
}

extern "C" void kernel_launch(void* const* d_in, const int* in_sizes, int n_in, void* d_out, int out_size, void* d_ws,
                              size_t ws_size, hipStream_t stream) {
    static int grid_blocks = 0;
    if (!grid_blocks) {
        int dev = 0, cus = 0, per_cu = 0;
        hipGetDevice(&dev);
        hipDeviceGetAttribute(&cus, hipDeviceAttributeMultiprocessorCount, dev);
        hipFuncSetAttribute((const void*)fwd_megakernel, hipFuncAttributeMaxDynamicSharedMemorySize, SMEM_BYTES);
        hipOccupancyMaxActiveBlocksPerMultiprocessor(&per_cu, fwd_megakernel, NTHREADS, SMEM_BYTES);
        if (per_cu < 1) per_cu = 1;
        if (per_cu > 2) per_cu = 2;
        grid_blocks = cus * per_cu;
        if (ws_size < WS_END) fprintf(stderr, "kernel_launch: workspace too small: %zu < %zu\n", ws_size, (size_t)WS_END);
    }
    Params p{};
    for (int i = 0; i < 25; ++i) p.in[i] = (const float*)d_in[i];
    p.out = (float*)d_out;
    p.ws = (char*)d_ws;
    void* args[] = {&p};
    hipError_t e = hipLaunchCooperativeKernel((const void*)fwd_megakernel, dim3(grid_blocks), dim3(NTHREADS), args, SMEM_BYTES, stream);
    if (e != hipSuccess) fprintf(stderr, "cooperative launch failed: %s (grid %d)\n", hipGetErrorString(e), grid_blocks);
}
```

```cpp
#include <hip/hip_runtime.h>
#include <hip/hip_cooperative_groups.h>
#include <cstdio>
#include <cstdint>
namespace cg = cooperative_groups;

typedef _Float16 h16;
typedef _Float16 half8 __attribute__((ext_vector_type(8)));
typedef _Float16 half4 __attribute__((ext_vector_type(4)));
typedef float f32x4 __attribute__((ext_vector_type(4)));
typedef float f32x16 __attribute__((ext_vector_type(16)));

#define DI __device__ __forceinline__

constexpr int D_MODEL = 1024, BATCH = 2, SEQ = 8192, DEPTH = 4, NT = BATCH * SEQ;
constexpr int D_IN = 3112, D_IN_PAD = 3200;
constexpr int C_NQ = 0, C_NKV = 512, C_NG = 1280, C_GQ = 1792, C_GK = 1920, C_GV = 2048, C_GG = 2304, C_SU = 2560, C_SG = 2816,
              C_GLR = 3072, C_NGL = 3088;
__host__ __device__ constexpr int map_col(int c) {
    return c < 128 ? C_GQ + c : c < 256 ? C_GK + (c - 128) : c < 512 ? C_GV + (c - 256) : c < 528 ? C_GLR + (c - 512)
         : c < 784 ? C_GG + (c - 528) : c < 1040 ? C_SU + (c - 784) : c < 1296 ? C_SG + (c - 1040) : c < 1808 ? C_NQ + (c - 1296)
         : c < 2576 ? C_NKV + (c - 1808) : c < 2600 ? C_NGL + (c - 2576) : c < 3112 ? C_NG + (c - 2600) : c;
}
constexpr int NTHREADS = 256;
constexpr float QSCALE = 0.125f * 1.4426950408889634f;

enum { I_X = 0, I_NORMG, I_WIN, I_GW2, I_GB2, I_GON, I_LRE, I_LIM, I_LSTEP, I_BRE, I_BIM, I_CRE, I_CIM, I_SD, I_GLUW, I_GLUB,
       I_NGB, I_NQN, I_NKN, I_CPOS, I_CW1, I_CB1, I_CW2, I_CB2, I_WOUT };

constexpr size_t OFF_WTIN  = 0;
constexpr size_t OFF_WTOUT = OFF_WTIN  + 4ull * D_IN_PAD * 1024 * 2;
constexpr size_t OFF_WTGLU = OFF_WTOUT + 4ull * 1024 * 1024 * 2;
constexpr size_t OFF_WTC1  = OFF_WTGLU + 4ull * 512 * 256 * 2;
constexpr size_t OFF_PROJ  = OFF_WTC1  + 4ull * 2 * 256 * 2048 * 2;
constexpr size_t OFF_MIX   = OFF_PROJ  + (size_t)NT * D_IN * 2;
constexpr size_t OFF_YACT  = OFF_MIX   + (size_t)NT * 1024 * 2;
constexpr size_t OFF_XH    = OFF_YACT;
constexpr size_t OFF_BCUM  = OFF_YACT  + (size_t)NT * 256 * 2;
constexpr size_t OFF_GKV   = OFF_BCUM  + (size_t)NT * 128 * 4;
constexpr size_t OFF_GDEC  = OFF_GKV   + 8ull * 256 * 2048 * 4;
static_assert(OFF_GDEC - OFF_XH >= (size_t)NT * 1024 * 2, "XH alias region too small");
constexpr size_t OFF_XC    = OFF_GDEC  + 8ull * 256 * 32 * 4;
constexpr size_t OFF_S5W   = OFF_XC    + 512ull * 1024 * 2 * 4;
constexpr size_t OFF_S5E   = OFF_S5W   + 16ull * 512 * 640 * 2;
constexpr size_t OFF_S5AL  = OFF_S5E   + 16ull * 128 * 512 * 2;
constexpr size_t OFF_CHID  = OFF_S5AL  + 1024ull * 2 * 4;
constexpr size_t OFF_POSB  = OFF_CHID  + 2ull * 2048 * 512 * 4;
constexpr size_t OFF_XCH   = OFF_POSB  + 8ull * 16 * 256 * 4;
constexpr size_t OFF_KCMP  = OFF_XCH   + 512ull * 2048 * 2;
constexpr size_t OFF_VCMP  = OFF_KCMP  + 4ull * 512 * 64 * 2;
constexpr size_t OFF_VTG   = OFF_VCMP  + 4ull * 512 * 64 * 2;
constexpr size_t OFF_BAR   = OFF_VTG   + 2ull * 4 * 128 * 4096 * 2;
constexpr size_t WS_END    = OFF_BAR   + 16384;

struct Params {
    const float* in[25];
    float* out;
    char* ws;
};

__host__ __device__ constexpr size_t kb_idx(size_t nrows, size_t row, int k) { return (((size_t)(k >> 6)) * nrows + row) * 64 + (k & 63); }
typedef const __attribute__((address_space(4))) Params* PP;
DI PP plaunder(PP p) { asm volatile("" : "+s"(p)); return p; }
constexpr int SMEM_MAIN = 73728;
constexpr int SMEM_BYTES = SMEM_MAIN + 16;

DI int otid(const int wv) { int t = wv * 64 + (int)__builtin_amdgcn_mbcnt_hi(~0u, __builtin_amdgcn_mbcnt_lo(~0u, 0u)); asm volatile("" : "+v"(t)); return t; }
DI float wave_sum(float v) {
#pragma unroll
    for (int o = 32; o > 0; o >>= 1) v += __shfl_xor(v, o);
    return v;
}
DI float wave_max(float v) {
#pragma unroll
    for (int o = 32; o > 0; o >>= 1) v = fmaxf(v, __shfl_xor(v, o));
    return v;
}
DI float sigmoidf_(float x) { return 1.f / (1.f + __expf(-x)); }
DI float siluf_(float x) { return x / (1.f + __expf(-x)); }
DI float gelu_tanh(float x) {
    const float u = 0.7978845608028654f * (x + 0.044715f * x * x * x);
    return 0.5f * x * (1.f + tanhf(u));
}
DI float log_sigmoidf_(float x) { return fminf(x, 0.f) - log1pf(__expf(-fabsf(x))); }

typedef _Float16 half2_ __attribute__((ext_vector_type(2)));
DI void glds16(const h16* g, char* l) {
    __builtin_amdgcn_global_load_lds((const __attribute__((address_space(1))) void*)g, (__attribute__((address_space(3))) void*)l, 16, 0, 0);
}
struct APlain { const h16* A; size_t lda, astep; DI const h16* operator()(int row, int kt, int c8) const { return A + (size_t)row * lda + (size_t)kt * astep + c8 * 8; } };
struct AS5 {
    const h16* ubase;
    const h16* xin;
    int ch0;
    DI const h16* operator()(int row, int kt, int c8) const {
        const size_t ch = (size_t)(ch0 + row);
        return kt < 8 ? ubase + (ch * 32 + 4 * kt + (c8 >> 1)) * D_IN + (c8 & 1) * 8 : xin + ch * 2048 + (kt - 8) * 64 + c8 * 8;
    }
};
template <int N> DI void gwaitbar();
#define GWB_DEF(N) template <> DI void gwaitbar<N>() { asm volatile("s_waitcnt vmcnt(" #N ") lgkmcnt(0)\n\ts_barrier" ::: "memory"); }
GWB_DEF(0) GWB_DEF(3) GWB_DEF(4) GWB_DEF(6) GWB_DEF(8) GWB_DEF(12)
template <bool SUMSQ, int WR, int MI, int NJ, int NST = 4, class AF>
DI void gemm_glds(const int wv, const int K, const AF& afn, const h16* __restrict__ Bt, const int ldb,
                  f32x4 (&acc)[MI][NJ], float (&ss)[MI], char* smem, const size_t bstep = 64) {
    constexpr int WC = 4 / WR, BM = WR * MI * 16, BN = WC * NJ * 16, AQ = BM / 64, BQ = BN / 64, NG = AQ + BQ, SB = (BM + BN) * 64;
    static_assert(NST * SB <= SMEM_MAIN && AQ >= 1 && BQ >= 1 && (NST == 3 || NST == 4), "ring does not fit the LDS");
    const int tid = otid(wv), lane = tid & 63, wid = tid >> 6, wr = wid / WC, wc = wid % WC;
#pragma unroll
    for (int i = 0; i < MI; ++i) {
        ss[i] = 0.f;
#pragma unroll
        for (int j = 0; j < NJ; ++j) acc[i][j] = (f32x4){0.f, 0.f, 0.f, 0.f};
    }
    const int lrow = wid * 16 + (lane >> 2);
    const int lc4 = (lane & 3) ^ ((-(lrow >> 2)) & 3);
    const h16* bp = Bt + (size_t)lrow * ldb + lc4 * 8;
    char* lbase = smem + wid * 1024;
    const int fr = lane & 15, fq = lane >> 4, sw = (-(fr >> 2)) & 3;
    const int aoff0 = (wr * MI * 16 + fr) * 64 + ((fq ^ sw) * 16);
    const int boff0 = BM * 64 + (wc * NJ * 16 + fr) * 64 + ((fq ^ sw) * 16);
    const int nt = K >> 5;
    auto issue = [&](const int t, char* stage) {
        const int kt = t >> 1, hb = (t & 1) * 4;
#pragma unroll
        for (int q = 0; q < AQ; ++q) glds16(afn(lrow + 64 * q, kt, hb + lc4), stage + q * 4096);
#pragma unroll
        for (int q = 0; q < BQ; ++q) glds16(bp + (size_t)q * 64 * ldb + (size_t)kt * bstep + hb * 8, stage + BM * 64 + q * 4096);
    };
    auto compute = [&](const char* st) {
        half8 af[MI], bf[NJ];
#pragma unroll
        for (int i = 0; i < MI; ++i) af[i] = *(const half8*)(st + aoff0 + i * 1024);
#pragma unroll
        for (int j = 0; j < NJ; ++j) bf[j] = *(const half8*)(st + boff0 + j * 1024);
        if (SUMSQ) {
#pragma unroll
            for (int i = 0; i < MI; ++i)
#pragma unroll
                for (int e = 0; e < 4; ++e) {
                    const half2_ x = (half2_){af[i][2 * e], af[i][2 * e + 1]};
                    ss[i] = __builtin_amdgcn_fdot2(x, x, ss[i], false);
                }
        }
#pragma unroll
        for (int i = 0; i < MI; ++i)
#pragma unroll
            for (int j = 0; j < NJ; ++j) acc[i][j] = __builtin_amdgcn_mfma_f32_16x16x32_f16(bf[j], af[i], acc[i][j], 0, 0, 0);
    };
#define GEMM_STEP(S, t) do { if (NST == 4 && (t) + 2 < nt) gwaitbar<NG>(); else gwaitbar<0>();                       \
        if ((t) + NST - 1 < nt) issue((t) + NST - 1, lbase + (((S) + NST - 1) % NST) * SB); compute(smem + (S) * SB); } while (0)
    gwaitbar<0>();
    {
        const int k = nt < NST - 1 ? nt : NST - 1;
        for (int p = 0; p < k; ++p) issue(p, lbase + p * SB);
        if (k >= 3) gwaitbar<2 * NG>(); else if (k == 2) gwaitbar<NG>(); else gwaitbar<0>();
        __builtin_amdgcn_s_sleep(2);
    }
#pragma unroll 1
    for (int t = 0; t < nt; t += NST) {
        GEMM_STEP(0, t);
        if (t + 1 < nt) GEMM_STEP(1, t + 1);
        if (t + 2 < nt) GEMM_STEP(2, t + 2);
        if (NST == 4 && t + 3 < nt) GEMM_STEP(3 % NST, t + 3);
    }
#undef GEMM_STEP
    asm volatile("s_waitcnt lgkmcnt(0)\n\ts_barrier" ::: "memory");
    if (SUMSQ) {
#pragma unroll
        for (int i = 0; i < MI; ++i) { ss[i] += __shfl_xor(ss[i], 16); ss[i] += __shfl_xor(ss[i], 32); }
    }
}
template <bool SUMSQ, class AF>
DI void gemm_mainloop_glds(const int wv, const int K, const AF& afn, const h16* __restrict__ Bt, const int ldb, f32x4 (&acc)[4][4], float (&ss)[4], char* smem, const size_t bstep = 64) {
    gemm_glds<SUMSQ, 2, 4, 4>(wv, K, afn, Bt, ldb, acc, ss, smem, bstep);
}

DI int glu_perm_dst(int c_orig) {
    const int which = c_orig >> 8, c = c_orig & 255;
    return (c >> 6) * 128 + ((c >> 5) & 1) * 64 + (((c >> 4) & 1) * 2 + which) * 16 + (c & 15);
}
template <int MAP, int KB>
DI void transpose64(const float* __restrict__ src, int R, int C, h16* __restrict__ dst, int r0, int c0,
                    const float* __restrict__ rscale, char* smem, const int wv) {
    h16* tile = (h16*)smem;
    const int tid = otid(wv);
    {
        const int r = tid >> 2, cq = (tid & 3) * 16;
        const float sc = rscale ? rscale[r0 + r] : 1.f;
        const float* sp = src + (size_t)(r0 + r) * C + c0 + cq;
#pragma unroll
        for (int q = 0; q < 4; ++q) {
            float4 v = (float4){0.f, 0.f, 0.f, 0.f};
            if (c0 + cq + q * 4 < C) v = *(const float4*)(sp + q * 4);
            *(half4*)(tile + r * 72 + cq + q * 4) = (half4){(h16)(v.x * sc), (h16)(v.y * sc), (h16)(v.z * sc), (h16)(v.w * sc)};
        }
    }
    __syncthreads();
    {
        const int c = tid >> 2, rq = (tid & 3) * 16;
        half8 o0, o1;
#pragma unroll
        for (int k = 0; k < 8; ++k) { o0[k] = tile[(rq + k) * 72 + c]; o1[k] = tile[(rq + 8 + k) * 72 + c]; }
        const int cc = c0 + c;
        const int dr = MAP == 1 ? map_col(cc) : MAP == 2 ? glu_perm_dst(cc) : cc;
        h16* dp = KB ? dst + ((size_t)(r0 >> 6) * KB + dr) * 64 + rq : dst + (size_t)dr * R + r0 + rq;
        *(half8*)dp = o0; *(half8*)(dp + 8) = o1;
    }
    __syncthreads();
}

DI void phase0(PP P, char* smem, const int wv) {
    P = plaunder(P);
    constexpr int N_WIN = 4 * 16 * 50, N_WOUT = 4 * 16 * 16, N_C1 = 16 * 16 * 4, N_GLU = 4 * 4 * 8, N_XH = NT * 1024 / 2048, N_PB = 8 * 16;
    const int total = N_WIN + N_WOUT + N_C1 + N_GLU + N_XH + N_PB;
    for (int w = blockIdx.x; w < total; w += gridDim.x) {
        if (w < N_WIN) {
            const int l = w / 800, r = w % 800, rt = r / 50, ct = r % 50;
            transpose64<1, D_IN_PAD>(P->in[I_WIN] + (size_t)l * 1024 * D_IN, 1024, D_IN, (h16*)(P->ws + OFF_WTIN) + (size_t)l * D_IN_PAD * 1024,
                           rt * 64, ct * 64, P->in[I_NORMG] + l * 1024, smem, wv);
        } else if (w < N_WIN + N_WOUT) {
            const int v = w - N_WIN, l = v >> 8, r = v & 255, rt = r >> 4, ct = r & 15;
            transpose64<0, 1024>(P->in[I_WOUT] + (size_t)l * 1024 * 1024, 1024, 1024, (h16*)(P->ws + OFF_WTOUT) + (size_t)l * 1024 * 1024,
                           rt * 64, ct * 64, nullptr, smem, wv);
        } else if (w < N_WIN + N_WOUT + N_C1) {
            const int v = w - N_WIN - N_WOUT, ljh = v >> 6, r = v & 63, rt = r >> 2, ct = r & 3;
            transpose64<0, 512>(P->in[I_CW1] + (size_t)ljh * 1024 * 256, 1024, 256, (h16*)(P->ws + OFF_WTC1) + ((size_t)(ljh >> 1) * 16 * 512 + (ljh & 1) * 256) * 64,
                           rt * 64, ct * 64, nullptr, smem, wv);
        } else if (w < N_WIN + N_WOUT + N_C1 + N_GLU) {
            const int v = w - N_WIN - N_WOUT - N_C1, l = v >> 5, r = v & 31, rt = r >> 3, ct = r & 7;
            transpose64<2, 0>(P->in[I_GLUW] + (size_t)l * 256 * 512, 256, 512, (h16*)(P->ws + OFF_WTGLU) + (size_t)l * 512 * 256,
                           rt * 64, ct * 64, nullptr, smem, wv);
        } else if (w < N_WIN + N_WOUT + N_C1 + N_GLU + N_XH) {
            const size_t e0 = ((size_t)(w - N_WIN - N_WOUT - N_C1 - N_GLU) * 256 + otid(wv)) * 8;
            const float4 a = *(const float4*)(P->in[I_X] + e0), b = *(const float4*)(P->in[I_X] + e0 + 4);
            *(half8*)((h16*)(P->ws + OFF_XH) + kb_idx(NT, e0 >> 10, (int)(e0 & 1023))) = (half8){(h16)a.x, (h16)a.y, (h16)a.z, (h16)a.w, (h16)b.x, (h16)b.y, (h16)b.z, (h16)b.w};
        } else {
            const int v = w - (N_WIN + N_WOUT + N_C1 + N_GLU + N_XH), lj = v >> 4, ks = v & 15, n = otid(wv);
            const float* w1 = P->in[I_CW1] + ((size_t)lj * 2048 + ks * 128) * 256 + n;
            const float* pp = P->in[I_CPOS] + (size_t)lj * 2048 + ks * 128;
            float a = ks == 0 ? P->in[I_CB1][lj * 256 + n] : 0.f;
#pragma unroll 16
            for (int k = 0; k < 128; ++k) a += pp[k] * w1[(size_t)k * 256];
            ((float*)(P->ws + OFF_POSB))[(lj * 16 + ks) * 256 + n] = a;
        }
    }
}

DI void s5_build_item(PP P, int l, int item, char* smem, const int wv) {
    P = plaunder(P);
    float* apow = (float*)smem;
    float* bbar = apow + 64 * 33 * 2;
    float* cc   = bbar + 64 * 16 * 2;
    const int tid = otid(wv);
    const int g = (item < 256) ? (item >> 4) : ((item - 256) >> 2);
    if (tid < 64) {
        const int p = tid;
        const float lre = fminf(P->in[I_LRE][(l * 16 + g) * 64 + p], -1e-4f);
        const float lim = P->in[I_LIM][(l * 16 + g) * 64 + p];
        const float dt = expf(P->in[I_LSTEP][l * 16 + g]);
        const float x = lre * dt, y = lim * dt;
        const float em1 = expm1f(x), cy = cosf(y), sy = sinf(y), sh = sinf(0.5f * y);
        const float ar = (em1 + 1.f) * cy, ai = (em1 + 1.f) * sy;
        const float dr = em1 * cy - 2.f * sh * sh, di = ai;
        const float den = lre * lre + lim * lim;
        const float fr = (dr * lre + di * lim) / den;
        const float fi = (di * lre - dr * lim) / den;
        float pr = 1.f, pi = 0.f;
        for (int k = 0; k <= 32; ++k) {
            apow[(p * 33 + k) * 2] = pr; apow[(p * 33 + k) * 2 + 1] = pi;
            const float nr = pr * ar - pi * ai, ni = pr * ai + pi * ar; pr = nr; pi = ni;
        }
        for (int c = 0; c < 16; ++c) {
            const float br = P->in[I_BRE][((size_t)(l * 16 + g) * 64 + p) * 16 + c];
            const float bi = P->in[I_BIM][((size_t)(l * 16 + g) * 64 + p) * 16 + c];
            bbar[(p * 16 + c) * 2] = fr * br - fi * bi;
            bbar[(p * 16 + c) * 2 + 1] = fr * bi + fi * br;
        }
    }
    for (int e = tid; e < 1024; e += 256) {
        cc[e * 2] = P->in[I_CRE][(size_t)(l * 16 + g) * 1024 + e];
        cc[e * 2 + 1] = P->in[I_CIM][(size_t)(l * 16 + g) * 1024 + e];
    }
    __syncthreads();
    if (item < 256) {
        const int c = item & 15;
        float* kt = cc + 2048;
        for (int idx = tid; idx < 512; idx += 256) {
            const int lag = idx >> 4, c2 = idx & 15;
            float a = 0.f;
            for (int p = 0; p < 64; ++p) {
                const float cr = cc[(c * 64 + p) * 2], ci = cc[(c * 64 + p) * 2 + 1];
                const float xr = apow[(p * 33 + lag) * 2], xi = apow[(p * 33 + lag) * 2 + 1];
                const float br = bbar[(p * 16 + c2) * 2], bi = bbar[(p * 16 + c2) * 2 + 1];
                const float tr = cr * xr - ci * xi, ti = cr * xi + ci * xr;
                a += tr * br - ti * bi;
            }
            kt[idx] = a;
        }
        __syncthreads();
        h16* W = (h16*)(P->ws + OFF_S5W) + (size_t)g * 512 * 640;
        for (int idx = tid; idx < 32 * 640; idx += 256) {
            const int j = idx / 640, k = idx % 640;
            float val = 0.f;
            if (k < 512) {
                const int s = k >> 4, c2 = k & 15, lag = j - s;
                if (lag >= 0) val = kt[lag * 16 + c2];
            } else {
                const int p = (k - 512) >> 1;
                const float cr = cc[(c * 64 + p) * 2], ci = cc[(c * 64 + p) * 2 + 1];
                const float xr = apow[(p * 33 + j + 1) * 2], xi = apow[(p * 33 + j + 1) * 2 + 1];
                val = (k & 1) ? -(cr * xi + ci * xr) : (cr * xr - ci * xi);
            }
            W[(size_t)(j * 16 + c) * 640 + k] = (h16)val;
        }
    } else {
        const int pq = (item - 256) & 3;
        h16* E = (h16*)(P->ws + OFF_S5E) + ((size_t)g * 128 + pq * 32) * 512;
        for (int idx = tid; idx < 32 * 512; idx += 256) {
            const int nl = idx >> 9, k = idx & 511;
            const int p = pq * 16 + (nl >> 1), s = k >> 4, c2 = k & 15;
            const float xr = apow[(p * 33 + 31 - s) * 2], xi = apow[(p * 33 + 31 - s) * 2 + 1];
            const float br = bbar[(p * 16 + c2) * 2], bi = bbar[(p * 16 + c2) * 2 + 1];
            const float val = (nl & 1) ? (xr * bi + xi * br) : (xr * br - xi * bi);
            E[(size_t)nl * 512 + k] = (h16)val;
        }
        if (tid < 16) {
            const int p = pq * 16 + tid;
            float* AL = (float*)(P->ws + OFF_S5AL);
            AL[(g * 64 + p) * 2] = apow[(p * 33 + 32) * 2];
            AL[(g * 64 + p) * 2 + 1] = apow[(p * 33 + 32) * 2 + 1];
        }
    }
    __syncthreads();
}

template <int WR, int MI>
DI void inproj_tile(PP P, int l, int m0, int n0, char* smem, const int wv) {
    P = plaunder(P);
    constexpr int WC = 4 / WR;
    f32x4 acc[MI][4];
    float ss[MI];
    gemm_glds<true, WR, MI, 4, (WR == 2 && MI == 8) ? 3 : 4>(wv, 1024, APlain{(const h16*)(P->ws + OFF_XH) + (size_t)m0 * 64, 64, (size_t)NT * 64},
                               (const h16*)(P->ws + OFF_WTIN) + ((size_t)l * 16 * D_IN_PAD + n0) * 64, 64, acc, ss, smem, (size_t)D_IN_PAD * 64);
    const int tid = otid(wv), lane = tid & 63, wid = tid >> 6, wr = wid / WC, wc = wid % WC;
    h16* proj = (h16*)(P->ws + OFF_PROJ);
    const int n64 = n0 + wc * 64;
    int cls = 0;
    if (n64 < 512) cls = 1;
    else if (n64 >= C_NKV + 256 && n64 < C_NKV + 384) cls = 2;
    else if (n64 >= C_NKV + 512 && n64 < C_NKV + 640) cls = 3;
    else if (n64 >= C_NKV + 384 && n64 < C_NKV + 512) cls = 4;
    else if (n64 >= C_NKV + 640 && n64 < C_NKV + 768) cls = 5;
    float wn[4][4];
    if (cls >= 1 && cls <= 3) {
        const float* wp = (cls == 1) ? P->in[I_NQN] + l * 64 : P->in[I_NKN] + (l * 3 + (cls - 1)) * 64;
        const float sc = (cls == 1) ? QSCALE : 1.f;
#pragma unroll
        for (int j = 0; j < 4; ++j) {
            const float4 w4 = *(const float4*)(wp + j * 16 + (lane >> 4) * 4);
            wn[j][0] = w4.x * sc; wn[j][1] = w4.y * sc; wn[j][2] = w4.z * sc; wn[j][3] = w4.w * sc;
        }
    }
#pragma unroll
    for (int i = 0; i < MI; ++i) {
        const int ml = wr * MI * 16 + i * 16 + (lane & 15);
        const float r = rsqrtf(ss[i] * (1.f / 1024.f) + 1e-6f);
        const size_t row = (size_t)m0 + ml;
        f32x4 v[4];
#pragma unroll
        for (int j = 0; j < 4; ++j) v[j] = acc[i][j] * r;
        if (cls >= 1 && cls <= 3) {
            float s2 = 0.f;
#pragma unroll
            for (int j = 0; j < 4; ++j) s2 += v[j][0] * v[j][0] + v[j][1] * v[j][1] + v[j][2] * v[j][2] + v[j][3] * v[j][3];
            s2 += __shfl_xor(s2, 16); s2 += __shfl_xor(s2, 32);
            const float rn = rsqrtf(s2 * (1.f / 64.f) + 1e-6f);
#pragma unroll
            for (int j = 0; j < 4; ++j) { v[j][0] *= rn * wn[j][0]; v[j][1] *= rn * wn[j][1]; v[j][2] *= rn * wn[j][2]; v[j][3] *= rn * wn[j][3]; }
        }
        if (cls >= 4) {
            const int g = (n64 >> 6) & 1, br = cls - 4;
            const int b = (int)(row >> 13), t = (int)(row & 8191);
            h16* vt = (h16*)(P->ws + OFF_VTG) + ((((size_t)br * 4 + b * 2 + g) * 128 + (t >> 6)) * 64) * 64 + (t & 63);
#pragma unroll
            for (int j = 0; j < 4; ++j)
#pragma unroll
                for (int e = 0; e < 4; ++e) vt[(j * 16 + (lane >> 4) * 4 + e) * 64] = (h16)v[j][e];
        }
#pragma unroll
        for (int j = 0; j < 4; ++j) {
            const int n = n64 + j * 16 + (lane >> 4) * 4;
            if (n < D_IN) *(half4*)(proj + row * D_IN + n) = (half4){(h16)v[j][0], (h16)v[j][1], (h16)v[j][2], (h16)v[j][3]};
        }
        __builtin_amdgcn_sched_barrier(0);
    }
    __syncthreads();
}


DI void cmp_gemm_tile(PP P, int l, int tile, char* smem, const int wv) {
    P = plaunder(P);
    const int j = tile >> 6, mt = (tile >> 2) & 15, nt = tile & 3;
    const int row0 = mt * 128, bg = row0 >> 9, i0 = row0 & 511, b = bg >> 1, g = bg & 1;
    f32x4 acc[4][4];
    float ssd[4];
    gemm_mainloop_glds<false>(wv, 1024, APlain{(const h16*)(P->ws + OFF_PROJ) + ((size_t)b * SEQ + 16 * i0) * D_IN + C_NKV + j * 128 + g * 64, (size_t)16 * D_IN, (size_t)D_IN},
                              (const h16*)(P->ws + OFF_WTC1) + ((size_t)(l * 2 + j) * 16 * 512 + nt * 128) * 64, 64, acc, ssd, smem, (size_t)512 * 64);
    const int tid = otid(wv), lane = tid & 63, wid = tid >> 6, wr = wid >> 1, wc = wid & 1;
    float* pt = (float*)(P->ws + OFF_CHID) + (size_t)j * 2048 * 512;
#pragma unroll
    for (int i = 0; i < 4; ++i) {
        const size_t row = (size_t)row0 + wr * 64 + i * 16 + (lane & 15);
#pragma unroll
        for (int jj = 0; jj < 4; ++jj) {
            const int n = nt * 128 + wc * 64 + jj * 16 + (lane >> 4) * 4;
            const f32x4 v = acc[i][jj];
            *(float4*)(pt + row * 512 + n) = (float4){v[0], v[1], v[2], v[3]};
        }
    }
}

DI void s5e_gemm_tile(PP P, int l, int tile, char* smem, const int wv) {
    P = plaunder(P);
    const int g = tile >> 2, mt = tile & 3;
    f32x4 acc[4][4];
    float ssd[4];
    gemm_mainloop_glds<false>(wv, 512, AS5{(const h16*)(P->ws + OFF_PROJ) + C_SU + g * 16, nullptr, mt * 128},
                              (const h16*)(P->ws + OFF_S5E) + (size_t)g * 128 * 512, 512, acc, ssd, smem);
    const int tid = otid(wv), lane = tid & 63, wid = tid >> 6, wr = wid >> 1, wc = wid & 1;
    float* xc = (float*)(P->ws + OFF_XC);
#pragma unroll
    for (int i = 0; i < 4; ++i) {
        const size_t ch = (size_t)mt * 128 + wr * 64 + i * 16 + (lane & 15);
#pragma unroll
        for (int jj = 0; jj < 4; ++jj) {
            const int n = wc * 64 + jj * 16 + (lane >> 4) * 4;
            const f32x4 v = acc[i][jj];
            *(float4*)(xc + (ch * 1024 + g * 64) * 2 + n) = (float4){v[0], v[1], v[2], v[3]};
        }
    }
}

DI void gla_scan_item(PP P, int item, char* smem, const int wv) {
    P = plaunder(P);
    const int tid = otid(wv), sl = tid & 31, part = tid >> 5;
    const int idx = item * 32 + sl, bh = idx >> 11, de = idx & 2047, d = de >> 6;
    float* kv = (float*)(P->ws + OFF_GKV) + ((size_t)bh * 256 + part * 32) * 2048 + de;
    const float* dc = (const float*)(P->ws + OFF_GDEC) + ((size_t)bh * 256 + part * 32) * 32 + d;
    float* sD = (float*)smem; float* sL = sD + 256;
    float kvv[32], dd[32];
#pragma unroll
    for (int i = 0; i < 32; ++i) { kvv[i] = kv[(size_t)i * 2048]; dd[i] = dc[i * 32]; }
    float D = 1.f, L = 0.f;
#pragma unroll
    for (int i = 0; i < 32; ++i) { L = dd[i] * L + kvv[i]; D *= dd[i]; }
    sD[part * 32 + sl] = D; sL[part * 32 + sl] = L;
    __syncthreads();
    float S = 0.f;
    for (int q = 0; q < part; ++q) S = sD[q * 32 + sl] * S + sL[q * 32 + sl];
#pragma unroll
    for (int i = 0; i < 32; ++i) { const float o = S; S = dd[i] * S + kvv[i]; kv[(size_t)i * 2048] = o; }
    __syncthreads();
}
DI void s5_scan_item(PP P, int item, char* smem, const int wv) {
    P = plaunder(P);
    const int tid = otid(wv), sl = tid & 31, part = tid >> 5;
    const int idx = item * 32 + sl, b = idx >> 10, s = idx & 1023;
    float2* xc = (float2*)(P->ws + OFF_XC) + ((size_t)b * 256 + part * 32) * 1024 + s;
    half2_* xch = (half2_*)(P->ws + OFF_XCH) + ((size_t)b * 256 + part * 32) * 1024 + s;
    const float2 a = ((const float2*)(P->ws + OFF_S5AL))[s];
    float2* sL = (float2*)smem;
    float2 c[32];
#pragma unroll
    for (int i = 0; i < 32; ++i) c[i] = xc[(size_t)i * 1024];
    float lr = 0.f, li = 0.f;
#pragma unroll
    for (int i = 0; i < 32; ++i) { const float nr = a.x * lr - a.y * li + c[i].x, ni = a.x * li + a.y * lr + c[i].y; lr = nr; li = ni; }
    float dr = a.x, di = a.y;
#pragma unroll
    for (int i = 0; i < 5; ++i) { const float nr = dr * dr - di * di, ni = 2.f * dr * di; dr = nr; di = ni; }
    sL[part * 32 + sl] = (float2){lr, li};
    __syncthreads();
    float xr = 0.f, xi = 0.f;
    for (int q = 0; q < part; ++q) { const float2 lq = sL[q * 32 + sl]; const float nr = dr * xr - di * xi + lq.x, ni = dr * xi + di * xr + lq.y; xr = nr; xi = ni; }
#pragma unroll
    for (int i = 0; i < 32; ++i) {
        const float2 o = (float2){xr, xi};
        const float nr = a.x * xr - a.y * xi + c[i].x, ni = a.x * xi + a.y * xr + c[i].y; xr = nr; xi = ni;
        xc[(size_t)i * 1024] = o;
        xch[(size_t)i * 1024] = (half2_){(h16)o.x, (h16)o.y};
    }
    __syncthreads();
}
DI void cmp_l2_item(PP P, int l, int item, char* smem, const int wv) {
    P = plaunder(P);
    const int tid = otid(wv), lane = tid & 63, w = tid >> 6;
    const int j = item >> 8, r0 = (item & 255) * 8;
    h16* w2s = (h16*)smem;
    float* hs = (float*)(smem + 32768);
    {
        const float* w2 = P->in[I_CW2] + (size_t)(l * 2 + j) * 256 * 64;
        for (int e = tid * 4; e < 256 * 64; e += 1024) {
            const float4 v = *(const float4*)(w2 + e);
            *(half4*)(w2s + e) = (half4){(h16)v.x, (h16)v.y, (h16)v.z, (h16)v.w};
        }
        const float* pt = (const float*)(P->ws + OFF_CHID) + (size_t)j * 2048 * 512;
        float pb = 0.f;
#pragma unroll
        for (int ks = 0; ks < 16; ++ks) pb += ((const float*)(P->ws + OFF_POSB))[((l * 2 + j) * 16 + ks) * 256 + tid];
#pragma unroll
        for (int rr = 0; rr < 8; ++rr) {
            const int row = r0 + rr, i = row & 511;
            float v = 0.f;
            if (i < 511) v = gelu_tanh(pt[(size_t)row * 512 + tid] + pt[(size_t)(row + 1) * 512 + 256 + tid] + pb);
            hs[rr * 256 + tid] = v;
        }
    }
    __syncthreads();
    const float bb = P->in[I_CB2][(l * 2 + j) * 64 + lane];
    float a0 = bb, a1 = bb;
    const float* h0 = hs + (2 * w) * 256, *h1 = h0 + 256;
#pragma unroll 8
    for (int n = 0; n < 256; ++n) {
        const float wv = (float)w2s[n * 64 + lane];
        a0 += h0[n] * wv; a1 += h1[n] * wv;
    }
#pragma unroll
    for (int rr = 0; rr < 2; ++rr) {
        float acc = rr ? a1 : a0;
        const int row = r0 + 2 * w + rr, bg = row >> 9, i = row & 511;
        if (i == 511) acc = 0.f;
        if (j == 0) {
            const float ss = wave_sum(acc * acc);
            acc = acc * rsqrtf(ss * (1.f / 64.f) + 1e-6f) * P->in[I_NKN][(l * 3 + 0) * 64 + lane];
            ((h16*)(P->ws + OFF_KCMP))[(size_t)row * 64 + lane] = (h16)acc;
        } else {
            ((h16*)(P->ws + OFF_VCMP))[(((size_t)bg * 8 + (i >> 6)) * 64 + lane) * 64 + (i & 63)] = (h16)acc;
        }
    }
    __syncthreads();
}

DI void s5o_gemm_tile(PP P, int l, int tile, char* smem, const int wv) {
    P = plaunder(P);
    const int g = tile >> 5, mt = (tile >> 3) & 3, nt = tile & 7;
    f32x4 acc[2][4];
    float ssd[2];
    gemm_glds<false, 4, 2, 4>(wv, 640, AS5{(const h16*)(P->ws + OFF_PROJ) + C_SU + g * 16, (const h16*)(P->ws + OFF_XCH) + g * 128, mt * 128},
                              (const h16*)(P->ws + OFF_S5W) + ((size_t)g * 512 + nt * 64) * 640, 640, acc, ssd, smem);
    const int tid = otid(wv), lane = tid & 63, wid = tid >> 6;
    const h16* proj = (const h16*)(P->ws + OFF_PROJ);
    h16* yact = (h16*)(P->ws + OFF_YACT);
#pragma unroll
    for (int i = 0; i < 2; ++i) {
        const size_t ch = (size_t)mt * 128 + wid * 32 + i * 16 + (lane & 15);
#pragma unroll
        for (int jj = 0; jj < 4; ++jj) {
            const int n = nt * 64 + jj * 16 + (lane >> 4) * 4;
            const int j = n >> 4, c = n & 15;
            const size_t tok = ch * 32 + j;
            const half4 u4 = *(const half4*)(proj + tok * D_IN + C_SU + g * 16 + c);
            const float4 dd = *(const float4*)(P->in[I_SD] + (l * 16 + g) * 16 + c);
            const f32x4 v = acc[i][jj];
            half4 o;
            o[0] = (h16)gelu_tanh(v[0] + dd.x * (float)u4[0]);
            o[1] = (h16)gelu_tanh(v[1] + dd.y * (float)u4[1]);
            o[2] = (h16)gelu_tanh(v[2] + dd.z * (float)u4[2]);
            o[3] = (h16)gelu_tanh(v[3] + dd.w * (float)u4[3]);
            *(half4*)(yact + tok * 256 + g * 16 + c) = o;
        }
    }
}

#define MFMA32(a, b, c) __builtin_amdgcn_mfma_f32_32x32x16_f16((a), (b), (c), 0, 0, 0)
constexpr float FAST_SHIFT = 4.f;
constexpr float NEGS = -1e30f;
DI float ex2(float x) { return __builtin_amdgcn_exp2f(x); }
#define NSA_WAITBAR(N) asm volatile("s_waitcnt vmcnt(" #N ") lgkmcnt(0)\n\ts_barrier" ::: "memory")
#define NSA_BAR() asm volatile("s_waitcnt lgkmcnt(0)\n\ts_barrier" ::: "memory")

struct KVSrc { const h16* k; int ldk; size_t kstep; const h16* v; };
DI void nsa_dma(const KVSrc& s, int j, char* stage, int wid, int lane) {
    const int row0 = wid * 8 + (lane >> 3);
    const int sw = ((lane & 7) ^ ((row0 >> 1) & 7)) * 8;
    const h16* kp = s.k + (size_t)j * s.kstep + (size_t)row0 * s.ldk + sw;
    glds16(kp, stage + wid * 1024);
    glds16(kp + (size_t)32 * s.ldk, stage + 4096 + wid * 1024);
    const h16* vp = s.v + (size_t)j * 4096 + row0 * 64 + sw;
    glds16(vp, stage + 8192 + wid * 1024);
    glds16(vp + 32 * 64, stage + 8192 + 4096 + wid * 1024);
}
template <int NST, class F>
DI void nsa_pipe(const KVSrc& s, const int n, char* smem, int wid, int lane, F&& compute) {
    NSA_WAITBAR(0);
    {
        const int k = n < NST - 1 ? n : NST - 1;
        for (int p = 0; p < k; ++p) nsa_dma(s, p, smem + p * 16384, wid, lane);
        if (k >= 3) NSA_WAITBAR(8); else if (k == 2) NSA_WAITBAR(4); else NSA_WAITBAR(0);
        __builtin_amdgcn_s_sleep(2);
    }
    for (int j = 0; j < n; ++j) {
        if (NST == 4 && j + 2 < n) NSA_WAITBAR(4); else NSA_WAITBAR(0);
        const int jn = j + NST - 1;
        compute(j, smem + (j % NST) * 16384, [&]() { if (jn < n) nsa_dma(s, jn, smem + (jn % NST) * 16384, wid, lane); });
    }
}

template <bool SHIFT = false>
DI void qk_tile(const char* Kimg, const half8 (&qf)[4], f32x16 (&s)[2], int lane) {
    const int r = lane & 31, h = lane >> 5, swz = (r >> 1) & 7;
    const char* base = Kimg + r * 128;
#pragma unroll
    for (int kt = 0; kt < 2; ++kt) {
        half8 kf[4];
#pragma unroll
        for (int ks = 0; ks < 4; ++ks) kf[ks] = *(const half8*)(base + kt * 4096 + (((2 * ks + h) ^ swz) << 4));
#pragma unroll
        for (int e = 0; e < 16; ++e) s[kt][e] = SHIFT ? -FAST_SHIFT : 0.f;
        __builtin_amdgcn_s_setprio(1);
#pragma unroll
        for (int ks = 0; ks < 4; ++ks) s[kt] = MFMA32(kf[ks], qf[ks], s[kt]);
        __builtin_amdgcn_s_setprio(0);
    }
}
template <int S> DI half8 pack8(const f32x16& x) {
    return (half8){(h16)x[8 * S], (h16)x[8 * S + 1], (h16)x[8 * S + 2], (h16)x[8 * S + 3], (h16)x[8 * S + 4], (h16)x[8 * S + 5], (h16)x[8 * S + 6], (h16)x[8 * S + 7]};
}
DI half8 ld_vfrag(const char* Vimg, int off0) {
    const half4 lo = *(const half4*)(Vimg + off0), hi = *(const half4*)(Vimg + (off0 ^ 16));
    return (half8){lo[0], lo[1], lo[2], lo[3], hi[0], hi[1], hi[2], hi[3]};
}
template <int KT>
DI void pv_load(const char* Vimg, half8 (&vf)[4], int lane) {
    const int r = lane & 31, h = lane >> 5, swz16 = ((r >> 1) & 7) << 4;
    const char* rb = Vimg + r * 128 + 8 * h;
#pragma unroll
    for (int dt = 0; dt < 2; ++dt) {
        vf[dt * 2 + 0] = ld_vfrag(rb + dt * 4096, ((4 * KT) << 4) ^ swz16);
        vf[dt * 2 + 1] = ld_vfrag(rb + dt * 4096, ((4 * KT + 2) << 4) ^ swz16);
    }
}
typedef unsigned u32x4_ __attribute__((ext_vector_type(4)));
template <int KT, bool MASKED = false>
DI void pv_mma(const half8 (&vf)[4], const f32x16 (&p)[2], f32x16 (&o)[2], const unsigned rmask = 0xffffffffu) {
    half8 pb0 = pack8<0>(p[KT]), pb1 = pack8<1>(p[KT]);
    if (MASKED) {
        pb0 = __builtin_bit_cast(half8, __builtin_bit_cast(u32x4_, pb0) & rmask);
        pb1 = __builtin_bit_cast(half8, __builtin_bit_cast(u32x4_, pb1) & rmask);
    }
    __builtin_amdgcn_s_setprio(1);
#pragma unroll
    for (int dt = 0; dt < 2; ++dt) {
        o[dt] = MFMA32(vf[dt * 2 + 0], pb0, o[dt]);
        o[dt] = MFMA32(vf[dt * 2 + 1], pb1, o[dt]);
    }
    __builtin_amdgcn_s_setprio(0);
}
template <bool MASKED = false>
DI void pv_finish(const char* Vimg, const half8 (&va)[4], const f32x16 (&p)[2], f32x16 (&o)[2], int lane, const unsigned rmask = 0xffffffffu) {
    half8 vb[4];
    pv_load<1>(Vimg, vb, lane);
    pv_mma<0, MASKED>(va, p, o, rmask);
    pv_mma<1, MASKED>(vb, p, o, rmask);
}
DI float sm_fast(f32x16 (&s)[2]) {
    float rs = 0.f;
#pragma unroll
    for (int kt = 0; kt < 2; ++kt)
#pragma unroll
        for (int e = 0; e < 16; ++e) { const float p = ex2(s[kt][e]); s[kt][e] = p; rs += p; }
    return rs;
}
DI float xhalf_max(float v) {
    const auto r = __builtin_amdgcn_permlane32_swap(__float_as_uint(v), __float_as_uint(v), false, false);
    return fmaxf(__uint_as_float(r[0]), __uint_as_float(r[1]));
}
DI float xhalf_sum(float v) {
    const auto r = __builtin_amdgcn_permlane32_swap(__float_as_uint(v), __float_as_uint(v), false, false);
    return __uint_as_float(r[0]) + __uint_as_float(r[1]);
}
DI float rowmax32(const f32x16 (&s)[2]) {
    float mx = s[0][0];
#pragma unroll
    for (int e = 1; e < 16; ++e) mx = fmaxf(mx, s[0][e]);
#pragma unroll
    for (int e = 0; e < 16; ++e) mx = fmaxf(mx, s[1][e]);
    return xhalf_max(mx);
}
constexpr float SM_THR = 6.f;
DI void sm_online(f32x16 (&s)[2], float& m, float& l, f32x16 (&o)[2], const bool rowok) {
    float mx = rowmax32(s);
    mx = rowok ? mx : NEGS;
    if (__any(mx > m + SM_THR)) {
        const float mn = fmaxf(m, mx), alpha = ex2(m - mn);
        l *= alpha; o[0] *= alpha; o[1] *= alpha; m = mn;
    }
    const float msub = rowok ? m : 1e30f;
    float rs = 0.f;
#pragma unroll
    for (int kt = 0; kt < 2; ++kt)
#pragma unroll
        for (int e = 0; e < 16; ++e) { const float p = ex2(s[kt][e] - msub); s[kt][e] = p; rs += p; }
    l += xhalf_sum(rs);
}

template <int V> struct IC { static constexpr int value = V; };
template <bool FAST>
DI void nsa_unit(PP P, int l, int bg, int c32, char* smem, const int wv) {
    P = plaunder(P);
    const int tid = otid(wv), lane = tid & 63, w = tid >> 6, r = lane & 31, h = lane >> 5;
    const int b = bg >> 1, g = bg & 1, t0 = c32 * 32, cur = c32 >> 1;
    const int tokl = w * 8 + (r >> 2), head = r & 3, t = t0 + tokl;
    const size_t tokg = (size_t)b * SEQ + t;
    float* IMP = (float*)(smem + 49152);
    unsigned* SELM = (unsigned*)(smem + 49152);
    const h16* proj = (const h16*)(P->ws + OFF_PROJ);
    const int ghead = g * 4 + head;

    half8 qf[4];
    {
        const h16* qp = proj + tokg * D_IN + C_NQ + ghead * 64 + 8 * h;
#pragma unroll
        for (int ks = 0; ks < 4; ++ks) qf[ks] = *(const half8*)(qp + 16 * ks);
    }
    float g0, g1, g2;
    {
        const h16* gp = proj + tokg * D_IN + C_NGL + ghead * 3;
        const float* gb = P->in[I_NGB] + l * 24 + ghead * 3;
        g0 = sigmoidf_((float)gp[0] + gb[0]); g1 = sigmoidf_((float)gp[1] + gb[1]); g2 = sigmoidf_((float)gp[2] + gb[2]);
    }
    __syncthreads();
    for (int i = tid; i < 32 * 128; i += 256) IMP[i] = 0.f;

    half8 oacc[4];
    auto oacc_add = [&](const f32x16 (&o)[2], const float sc, const bool first) {
#pragma unroll
        for (int dt = 0; dt < 2; ++dt)
#pragma unroll
            for (int hf = 0; hf < 2; ++hf) {
                half8 v = oacc[dt * 2 + hf];
#pragma unroll
                for (int e = 0; e < 8; ++e) v[e] = (h16)((first ? 0.f : (float)v[e]) + o[dt][hf * 8 + e] * sc);
                oacc[dt * 2 + hf] = v;
            }
    };

    {
        const int nvt = 2 * c32 + 1;
        const int nvr = (t >= 31) ? ((t - 31) >> 4) + 1 : 0;
        const int ntile = (nvt + 63) >> 6;
        KVSrc src{(const h16*)(P->ws + OFF_KCMP) + (size_t)bg * 512 * 64, 64, 4096, (const h16*)(P->ws + OFF_VCMP) + (size_t)bg * 8 * 4096};
        f32x16 o[2];
#pragma unroll
        for (int e = 0; e < 16; ++e) { o[0][e] = 0.f; o[1][e] = 0.f; }
        float invl;
        if constexpr (FAST) {
            const int tf = t0 + w * 8;
            const int nvlo = __builtin_amdgcn_readfirstlane((tf >= 31) ? ((tf - 31) >> 4) + 1 : 0);
            float lsum = 0.f;
            nsa_pipe<3>(src, ntile, smem, w, lane, [&](int j, const char* st, auto&& issue) {
                f32x16 s[2];
                qk_tile<true>(st, qf, s, lane);
                issue();
                if (64 * j + 64 > nvlo) {
#pragma unroll
                    for (int kt = 0; kt < 2; ++kt)
#pragma unroll
                        for (int e = 0; e < 16; ++e) {
                            const int key = 64 * j + 32 * kt + 8 * (e >> 2) + 4 * h + (e & 3);
                            if (key >= nvr) s[kt][e] = NEGS;
                        }
                }
                lsum += sm_fast(s);
            });
            lsum = xhalf_sum(lsum);
            invl = lsum > 0.f ? 1.f / lsum : 0.f;
            nsa_pipe<3>(src, ntile, smem, w, lane, [&](int j, const char* st, auto&& issue) {
                f32x16 s[2];
                qk_tile<true>(st, qf, s, lane);
                half8 vf[4];
                pv_load<0>(st + 8192, vf, lane);
                issue();
                __builtin_amdgcn_sched_barrier(0);
                if (64 * j + 64 > nvlo) {
#pragma unroll
                    for (int kt = 0; kt < 2; ++kt)
#pragma unroll
                        for (int e = 0; e < 16; ++e) {
                            const int key = 64 * j + 32 * kt + 8 * (e >> 2) + 4 * h + (e & 3);
                            if (key >= nvr) s[kt][e] = NEGS;
                        }
                }
                (void)sm_fast(s);
                if (cur >= 16) {
#pragma unroll
                    for (int kt = 0; kt < 2; ++kt)
#pragma unroll
                        for (int g4 = 0; g4 < 4; ++g4) {
                            float G = ((s[kt][4 * g4] + s[kt][4 * g4 + 1]) + (s[kt][4 * g4 + 2] + s[kt][4 * g4 + 3])) * invl;
                            float L = s[kt][4 * g4 + 3] * invl;
                            G += __shfl_xor(G, 1); G += __shfl_xor(G, 2);
                            L += __shfl_xor(L, 1); L += __shfl_xor(L, 2);
                            if (head == 0) {
                                const int sb = 16 * j + 8 * kt + 2 * g4 + h;
                                atomicAdd(&IMP[tokl * 128 + sb], G);
                                if (sb + 1 < 128) atomicAdd(&IMP[tokl * 128 + sb + 1], L);
                            }
                        }
                }
                pv_finish(st + 8192, vf, s, o, lane);
            });
        } else {
        float m = -1e20f, lsum = 0.f;
        nsa_pipe<3>(src, ntile, smem, w, lane, [&](int j, const char* st, auto&& issue) {
            f32x16 s[2];
            qk_tile(st, qf, s, lane);
            issue();
#pragma unroll
            for (int kt = 0; kt < 2; ++kt)
#pragma unroll
                for (int e = 0; e < 16; ++e) {
                    const int key = 64 * j + 32 * kt + 8 * (e >> 2) + 4 * h + (e & 3);
                    if (key >= nvr) s[kt][e] = NEGS;
                }
            const float mn = fmaxf(m, rowmax32(s)), alpha = ex2(m - mn);
            float rs = 0.f;
#pragma unroll
            for (int kt = 0; kt < 2; ++kt)
#pragma unroll
                for (int e = 0; e < 16; ++e) rs += ex2(s[kt][e] - mn);
            rs = xhalf_sum(rs);
            lsum = lsum * alpha + rs; m = mn;
        });
        const float invl_s = lsum > 0.f ? 1.f / lsum : 0.f;
        nsa_pipe<3>(src, ntile, smem, w, lane, [&](int j, const char* st, auto&& issue) {
            f32x16 s[2];
            qk_tile(st, qf, s, lane);
            half8 vf[4];
            pv_load<0>(st + 8192, vf, lane);
            issue();
            __builtin_amdgcn_sched_barrier(0);
#pragma unroll
            for (int kt = 0; kt < 2; ++kt)
#pragma unroll
                for (int e = 0; e < 16; ++e) {
                    const int key = 64 * j + 32 * kt + 8 * (e >> 2) + 4 * h + (e & 3);
                    s[kt][e] = (key < nvr) ? ex2(s[kt][e] - m) * invl_s : 0.f;
                }
            if (cur >= 16) {
#pragma unroll
                for (int kt = 0; kt < 2; ++kt)
#pragma unroll
                    for (int g4 = 0; g4 < 4; ++g4) {
                        float G = (s[kt][4 * g4] + s[kt][4 * g4 + 1]) + (s[kt][4 * g4 + 2] + s[kt][4 * g4 + 3]);
                        float L = s[kt][4 * g4 + 3];
                        G += __shfl_xor(G, 1); G += __shfl_xor(G, 2);
                        L += __shfl_xor(L, 1); L += __shfl_xor(L, 2);
                        if (head == 0) {
                            const int sb = 16 * j + 8 * kt + 2 * g4 + h;
                            atomicAdd(&IMP[tokl * 128 + sb], G);
                            if (sb + 1 < 128) atomicAdd(&IMP[tokl * 128 + sb + 1], L);
                        }
                    }
            }
            pv_finish(st + 8192, vf, s, o, lane);
        });
            invl = 1.f;
        }
        oacc_add(o, g0 * invl, true);
    }
    __syncthreads();
    {
        const int tl = lane >> 3, sub = lane & 7;
        unsigned bits = 0;
        unsigned u[16];
        if (cur >= 16) {
            const float* ip = IMP + (w * 8 + tl) * 128 + sub * 16;
#pragma unroll
            for (int i = 0; i < 16; ++i) {
                const int s = sub * 16 + i;
                u[i] = (s >= 1 && s <= cur - 2) ? (__float_as_uint(ip[i]) + 1u) : 0u;
            }
        }
        __syncthreads();
        if (cur >= 16) {
            unsigned prefix = 0;
            for (int bit = 30; bit >= 0; --bit) {
                const unsigned cand = prefix | (1u << bit);
                int cnt = 0;
#pragma unroll
                for (int i = 0; i < 16; ++i) cnt += (u[i] >= cand) ? 1 : 0;
                cnt += __shfl_xor(cnt, 1); cnt += __shfl_xor(cnt, 2); cnt += __shfl_xor(cnt, 4);
                if (cnt >= 13) prefix = cand;
            }
            int cgt = 0, ceq = 0;
#pragma unroll
            for (int i = 0; i < 16; ++i) { cgt += (u[i] > prefix) ? 1 : 0; ceq += (u[i] == prefix) ? 1 : 0; }
            cgt += __shfl_xor(cgt, 1); cgt += __shfl_xor(cgt, 2); cgt += __shfl_xor(cgt, 4);
            int inc = ceq;
            { const int v = __shfl_up(inc, 1); if (sub >= 1) inc += v; }
            { const int v = __shfl_up(inc, 2); if (sub >= 2) inc += v; }
            { const int v = __shfl_up(inc, 4); if (sub >= 4) inc += v; }
            int run = inc - ceq;
            const int need = 13 - cgt;
#pragma unroll
            for (int i = 0; i < 16; ++i) {
                const int s = sub * 16 + i;
                bool sel = u[i] > prefix;
                if (u[i] == prefix) { sel = run < need; ++run; }
                if (s == 0 || s == cur || s == cur - 1) sel = true;
                bits |= (sel ? 1u : 0u) << i;
            }
        } else {
#pragma unroll
            for (int i = 0; i < 16; ++i) bits |= ((sub * 16 + i <= cur) ? 1u : 0u) << i;
        }
        unsigned wv = bits << ((sub & 1) * 16);
        wv |= __shfl_xor(wv, 1);
        if ((sub & 1) == 0) SELM[(w * 8 + tl) * 4 + (sub >> 1)] = wv;
    }
    __syncthreads();
    unsigned selw[4];
#pragma unroll
    for (int i = 0; i < 4; ++i) selw[i] = SELM[tokl * 4 + i];

    auto branch = [&](auto BRC) {
        constexpr int br = decltype(BRC)::value;
        const int j0 = (br == 0) ? 0 : (cur - 8 > 0 ? cur - 8 : 0);
        const int nst = cur - j0 + 1;
        KVSrc src{proj + ((size_t)b * SEQ + (size_t)j0 * 64) * D_IN + C_NKV + (br == 0 ? 256 : 512) + g * 64, D_IN, (size_t)64 * D_IN,
                  (const h16*)(P->ws + OFF_VTG) + (((size_t)br * 4 + bg) * 128 + j0) * 4096};
        float m = -1e20f, lsum = 0.f;
        f32x16 o[2];
#pragma unroll
        for (int e = 0; e < 16; ++e) { o[0][e] = 0.f; o[1][e] = 0.f; }
        nsa_pipe<4>(src, nst, smem, w, lane, [&](int jj, const char* st, auto&& issue) {
            const int j = j0 + jj;
            const bool rowok = (br != 0) || (((selw[j >> 5] >> (j & 31)) & 1u) != 0u);
            if constexpr (FAST && br == 0) {
                if (!__any(rowok)) { issue(); return; }
            }
            f32x16 s[2];
            qk_tile<FAST>(st, qf, s, lane);
            half8 vf[4];
            pv_load<0>(st + 8192, vf, lane);
            issue();
            __builtin_amdgcn_sched_barrier(0);
            if (j == cur || (br == 1 && j == cur - 8)) {
#pragma unroll
                for (int kt = 0; kt < 2; ++kt)
#pragma unroll
                    for (int e = 0; e < 16; ++e) {
                        const int key = 64 * j + 32 * kt + 8 * (e >> 2) + 4 * h + (e & 3);
                        const bool ok = (key <= t) && (br == 0 || key > t - 512);
                        if (!ok) s[kt][e] = NEGS;
                    }
            }
            if constexpr (FAST) {
                const float rs = sm_fast(s);
                lsum += (br != 0 || rowok) ? rs : 0.f;
                pv_finish<br == 0>(st + 8192, vf, s, o, lane, rowok ? 0xffffffffu : 0u);
            } else {
                sm_online(s, m, lsum, o, rowok);
                pv_finish(st + 8192, vf, s, o, lane);
            }
        });
        if constexpr (FAST) lsum = xhalf_sum(lsum);
        const float sc = (br == 0 ? g1 : g2) / lsum;
        oacc_add(o, sc, false);
    };
    branch(IC<0>{});
    branch(IC<1>{});
    {
        h16* mixp = (h16*)(P->ws + OFF_MIX) + kb_idx(NT, tokg, 512 + ghead * 64);
        const h16* ngp = proj + tokg * D_IN + C_NG + ghead * 64;
#pragma unroll
        for (int dt = 0; dt < 2; ++dt)
#pragma unroll
            for (int g4 = 0; g4 < 4; ++g4) {
                const int d0 = 32 * dt + 8 * g4 + 4 * h;
                const half4 ng = *(const half4*)(ngp + d0);
                half4 ov;
#pragma unroll
                for (int e = 0; e < 4; ++e) ov[e] = (h16)((float)oacc[dt * 2 + (g4 >> 1)][(g4 & 1) * 4 + e] * siluf_((float)ng[e]));
                *(half4*)(mixp + d0) = ov;
            }
    }
    __syncthreads();
}

DI void gla_kv_item(PP P, int l, int item, char* smem, const int wv) {
    P = plaunder(P);
    const int tid = otid(wv), lane = tid & 63, w = tid >> 6, r = lane & 31, hh = lane >> 5;
    const int pair = item * 4 + w, h = pair & 3, cn = pair >> 2;
    const size_t tok = (size_t)cn * 32 + r;
    const int b = cn >> 8, n = cn & 255, bh = b * 4 + h;
    const h16* proj = (const h16*)(P->ws + OFF_PROJ);
    h16* VT = (h16*)(smem + w * 16384);
    h16* KT = VT + 2048;
    __syncthreads();
    {
        const half8* vp = (const half8*)(proj + tok * D_IN + C_GV + h * 64 + hh * 32);
#pragma unroll
        for (int q = 0; q < 4; ++q) {
            const half8 v8 = vp[q];
#pragma unroll
            for (int e = 0; e < 8; ++e) VT[(hh * 32 + q * 8 + e) * 32 + r] = v8[e];
        }
    }
    float gl[16];
    {
        const half8* lp = (const half8*)(proj + tok * D_IN + C_GLR);
        const half8 l0 = lp[0], l1 = lp[1];
        float lr[16];
#pragma unroll
        for (int q = 0; q < 8; ++q) { lr[q] = (float)l0[q]; lr[8 + q] = (float)l1[q]; }
        const float* w2 = P->in[I_GW2] + (size_t)l * 16 * 128 + h * 32 + 16 * hh;
        const float* b2 = P->in[I_GB2] + l * 128 + h * 32 + 16 * hh;
#pragma unroll
        for (int d = 0; d < 16; ++d) gl[d] = b2[d];
#pragma unroll
        for (int q = 0; q < 16; ++q)
#pragma unroll
            for (int d4 = 0; d4 < 4; ++d4) {
                const float4 wq = *(const float4*)(w2 + q * 128 + d4 * 4);
                gl[d4 * 4 + 0] += lr[q] * wq.x; gl[d4 * 4 + 1] += lr[q] * wq.y; gl[d4 * 4 + 2] += lr[q] * wq.z; gl[d4 * 4 + 3] += lr[q] * wq.w;
            }
#pragma unroll
        for (int d = 0; d < 16; ++d) gl[d] = log_sigmoidf_(gl[d]) * (1.f / 16.f);
    }
#pragma unroll
    for (int off = 1; off < 32; off <<= 1) {
#pragma unroll
        for (int d = 0; d < 16; ++d) { const float v = __shfl_up(gl[d], off, 32); if (r >= off) gl[d] += v; }
    }
    {
        float* bc = (float*)(P->ws + OFF_BCUM) + tok * 128 + h * 32 + 16 * hh;
#pragma unroll
        for (int d4 = 0; d4 < 4; ++d4) *(float4*)(bc + d4 * 4) = (float4){gl[d4 * 4], gl[d4 * 4 + 1], gl[d4 * 4 + 2], gl[d4 * 4 + 3]};
    }
    {
        const half8* kp = (const half8*)(proj + tok * D_IN + C_GK + h * 32 + 16 * hh);
        const half8 k0 = kp[0], k1 = kp[1];
        float bl[16];
#pragma unroll
        for (int d = 0; d < 16; ++d) bl[d] = __shfl(gl[d], 31, 32);
#pragma unroll
        for (int d = 0; d < 16; ++d) {
            const float kd = (float)(d < 8 ? k0[d & 7] : k1[d & 7]) * __expf(bl[d] - gl[d]);
            KT[(16 * hh + d) * 32 + r] = (h16)kd;
        }
        if (r == 0) {
            float* dc = (float*)(P->ws + OFF_GDEC) + (size_t)(bh * 256 + n) * 32 + 16 * hh;
#pragma unroll
            for (int d4 = 0; d4 < 4; ++d4) *(float4*)(dc + d4 * 4) = (float4){__expf(bl[d4 * 4]), __expf(bl[d4 * 4 + 1]), __expf(bl[d4 * 4 + 2]), __expf(bl[d4 * 4 + 3])};
        }
    }
    asm volatile("s_waitcnt lgkmcnt(0)" ::: "memory");
    const half8 kb0 = *(const half8*)(KT + r * 32 + 8 * hh), kb1 = *(const half8*)(KT + r * 32 + 16 + 8 * hh);
    float* kvp = (float*)(P->ws + OFF_GKV) + ((size_t)(bh * 256 + n) * 32 + r) * 64;
#pragma unroll
    for (int dt = 0; dt < 2; ++dt) {
        f32x16 o;
#pragma unroll
        for (int e = 0; e < 16; ++e) o[e] = 0.f;
        const h16* vrow = VT + (32 * dt + r) * 32 + 8 * hh;
        o = MFMA32(*(const half8*)vrow, kb0, o);
        o = MFMA32(*(const half8*)(vrow + 16), kb1, o);
#pragma unroll
        for (int g4 = 0; g4 < 4; ++g4)
            *(float4*)(kvp + 32 * dt + 8 * g4 + 4 * hh) = (float4){o[4 * g4], o[4 * g4 + 1], o[4 * g4 + 2], o[4 * g4 + 3]};
    }
    __syncthreads();
}

DI void gla_out_item(PP P, int l, int item, char* smem, const int wv) {
    P = plaunder(P);
    const int tid = otid(wv), lane = tid & 63, w = tid >> 6, r = lane & 31, hh = lane >> 5;
    const int pair = item * 4 + w, h = pair & 3, cn = pair >> 2;
    const size_t tok0 = (size_t)cn * 32, tok = tok0 + r;
    const int b = cn >> 8, n = cn & 255, bh = b * 4 + h;
    const h16* proj = (const h16*)(P->ws + OFF_PROJ);
    h16* VT = (h16*)(smem + w * 16384);
    h16* SPT = VT + 2048;
    __syncthreads();
    {
        const half8* vp = (const half8*)(proj + tok * D_IN + C_GV + h * 64 + hh * 32);
        const float4* sp = (const float4*)((const float*)(P->ws + OFF_GKV) + ((size_t)(bh * 256 + n) * 32 + r) * 64 + hh * 32);
#pragma unroll
        for (int q = 0; q < 4; ++q) {
            const half8 v8 = vp[q];
            const float4 s0 = sp[2 * q], s1 = sp[2 * q + 1];
#pragma unroll
            for (int e = 0; e < 8; ++e) VT[(hh * 32 + q * 8 + e) * 32 + r] = v8[e];
            SPT[(hh * 32 + q * 8 + 0) * 32 + r] = (h16)s0.x; SPT[(hh * 32 + q * 8 + 1) * 32 + r] = (h16)s0.y;
            SPT[(hh * 32 + q * 8 + 2) * 32 + r] = (h16)s0.z; SPT[(hh * 32 + q * 8 + 3) * 32 + r] = (h16)s0.w;
            SPT[(hh * 32 + q * 8 + 4) * 32 + r] = (h16)s1.x; SPT[(hh * 32 + q * 8 + 5) * 32 + r] = (h16)s1.y;
            SPT[(hh * 32 + q * 8 + 6) * 32 + r] = (h16)s1.z; SPT[(hh * 32 + q * 8 + 7) * 32 + r] = (h16)s1.w;
        }
    }
    half8 qe[2], ke[2];
#pragma unroll
    for (int ks = 0; ks < 2; ++ks) {
        const int d0 = 16 * ks + 8 * hh;
        const half8 q8 = *(const half8*)(proj + tok * D_IN + C_GQ + h * 32 + d0);
        const half8 k8 = *(const half8*)(proj + tok * D_IN + C_GK + h * 32 + d0);
        const float4 b0 = *(const float4*)((const float*)(P->ws + OFF_BCUM) + tok * 128 + h * 32 + d0);
        const float4 b1 = *(const float4*)((const float*)(P->ws + OFF_BCUM) + tok * 128 + h * 32 + d0 + 4);
        const float bc[8] = {b0.x, b0.y, b0.z, b0.w, b1.x, b1.y, b1.z, b1.w};
#pragma unroll
        for (int e = 0; e < 8; ++e) {
            const float ex = __expf(bc[e]);
            qe[ks][e] = (h16)((float)q8[e] * 0.17677669529663687f * ex);
            ke[ks][e] = (h16)((float)k8[e] * __builtin_amdgcn_rcpf(ex));
        }
    }
    f32x16 s;
#pragma unroll
    for (int e = 0; e < 16; ++e) s[e] = 0.f;
    s = MFMA32(ke[0], qe[0], s);
    s = MFMA32(ke[1], qe[1], s);
#pragma unroll
    for (int e = 0; e < 16; ++e) { const int j = (e & 3) + 8 * (e >> 2) + 4 * hh; if (j > r) s[e] = 0.f; }
    const half8 pb0 = pack8<0>(s), pb1 = pack8<1>(s);
    asm volatile("s_waitcnt lgkmcnt(0)" ::: "memory");
    f32x16 o[2];
#pragma unroll
    for (int dt = 0; dt < 2; ++dt) {
#pragma unroll
        for (int e = 0; e < 16; ++e) o[dt][e] = 0.f;
        const h16* vrow = VT + (32 * dt + r) * 32 + 4 * hh;
        const h16* srow = SPT + (32 * dt + r) * 32 + 8 * hh;
        {
            const half4 lo = *(const half4*)vrow, hi = *(const half4*)(vrow + 8);
            o[dt] = MFMA32(((half8){lo[0], lo[1], lo[2], lo[3], hi[0], hi[1], hi[2], hi[3]}), pb0, o[dt]);
        }
        {
            const half4 lo = *(const half4*)(vrow + 16), hi = *(const half4*)(vrow + 24);
            o[dt] = MFMA32(((half8){lo[0], lo[1], lo[2], lo[3], hi[0], hi[1], hi[2], hi[3]}), pb1, o[dt]);
        }
        o[dt] = MFMA32(*(const half8*)srow, qe[0], o[dt]);
        o[dt] = MFMA32(*(const half8*)(srow + 16), qe[1], o[dt]);
    }
    float ss = 0.f;
#pragma unroll
    for (int e = 0; e < 16; ++e) ss += o[0][e] * o[0][e] + o[1][e] * o[1][e];
    ss = xhalf_sum(ss);
    const float rn = rsqrtf(ss * (1.f / 64.f) + 1e-6f);
    h16* mix = (h16*)(P->ws + OFF_MIX);
#pragma unroll
    for (int dt = 0; dt < 2; ++dt)
#pragma unroll
        for (int g4 = 0; g4 < 4; ++g4) {
            const int e0 = 32 * dt + 8 * g4 + 4 * hh;
            const half4 gt = *(const half4*)(proj + tok * D_IN + C_GG + h * 64 + e0);
            const float4 on = *(const float4*)(P->in[I_GON] + l * 64 + e0);
            half4 ov;
            ov[0] = (h16)(o[dt][4 * g4 + 0] * rn * on.x * siluf_((float)gt[0]));
            ov[1] = (h16)(o[dt][4 * g4 + 1] * rn * on.y * siluf_((float)gt[1]));
            ov[2] = (h16)(o[dt][4 * g4 + 2] * rn * on.z * siluf_((float)gt[2]));
            ov[3] = (h16)(o[dt][4 * g4 + 3] * rn * on.w * siluf_((float)gt[3]));
            *(half4*)(mix + kb_idx(NT, tok, h * 64 + e0)) = ov;
        }
    __syncthreads();
}

DI void glu_tile(PP P, int l, int tile, char* smem, const int wv) {
    P = plaunder(P);
    const int mt = tile >> 2, nt = tile & 3;
    f32x4 acc[4][4];
    float ssd[4];
    gemm_mainloop_glds<false>(wv, 256, APlain{(const h16*)(P->ws + OFF_YACT) + (size_t)mt * 128 * 256, 256, 64},
                              (const h16*)(P->ws + OFF_WTGLU) + ((size_t)l * 512 + nt * 128) * 256, 256, acc, ssd, smem);
    const int tid = otid(wv), lane = tid & 63, wid = tid >> 6, wr = wid >> 1, wc = wid & 1;
    const h16* proj = (const h16*)(P->ws + OFF_PROJ);
    h16* mix = (h16*)(P->ws + OFF_MIX);
    const float* gb = P->in[I_GLUB] + l * 512;
#pragma unroll
    for (int i = 0; i < 4; ++i) {
        const size_t tok = (size_t)mt * 128 + wr * 64 + i * 16 + (lane & 15);
#pragma unroll
        for (int pj = 0; pj < 2; ++pj) {
            const int c = nt * 64 + wc * 32 + pj * 16 + (lane >> 4) * 4;
            const f32x4 z1 = acc[i][2 * pj], z2 = acc[i][2 * pj + 1];
            const float4 b1 = *(const float4*)(gb + c), b2 = *(const float4*)(gb + 256 + c);
            const half4 g4 = *(const half4*)(proj + tok * D_IN + C_SG + c);
            half4 o;
            o[0] = (h16)((z1[0] + b1.x) * sigmoidf_(z2[0] + b2.x) * siluf_((float)g4[0]));
            o[1] = (h16)((z1[1] + b1.y) * sigmoidf_(z2[1] + b2.y) * siluf_((float)g4[1]));
            o[2] = (h16)((z1[2] + b1.z) * sigmoidf_(z2[2] + b2.z) * siluf_((float)g4[2]));
            o[3] = (h16)((z1[3] + b1.w) * sigmoidf_(z2[3] + b2.w) * siluf_((float)g4[3]));
            *(half4*)(mix + kb_idx(NT, tok, 256 + c)) = o;
        }
    }
}

DI void outproj_tile(PP P, int l, int mt, int nt, char* smem, const int wv) {
    P = plaunder(P);
    f32x4 acc[8][4];
    float ssd[8];
    gemm_glds<false, 2, 8, 4, 3>(wv, 1024, APlain{(const h16*)(P->ws + OFF_MIX) + (size_t)mt * 256 * 64, 64, (size_t)NT * 64},
                              (const h16*)(P->ws + OFF_WTOUT) + ((size_t)l * 16 * 1024 + nt * 128) * 64, 64, acc, ssd, smem, (size_t)1024 * 64);
    const int tid = otid(wv), lane = tid & 63, wid = tid >> 6, wr = wid >> 1, wc = wid & 1;
    const float* xin = (l == 0) ? P->in[I_X] : P->out;
    h16* xh = (h16*)(P->ws + OFF_XH);
#pragma unroll
    for (int i = 0; i < 8; ++i) {
        const size_t row = (size_t)mt * 256 + wr * 128 + i * 16 + (lane & 15);
#pragma unroll
        for (int jj = 0; jj < 4; ++jj) {
            const int n = nt * 128 + wc * 64 + jj * 16 + (lane >> 4) * 4;
            const f32x4 v = acc[i][jj];
            const float4 xo = *(const float4*)(xin + row * 1024 + n);
            const float4 xn = (float4){xo.x + v[0], xo.y + v[1], xo.z + v[2], xo.w + v[3]};
            *(float4*)(P->out + row * 1024 + n) = xn;
            *(half4*)(xh + kb_idx(NT, row, n)) = (half4){(h16)xn.x, (h16)xn.y, (h16)xn.z, (h16)xn.w};
        }
    }
}

#define XB_TMO      128
#define XB_XCNT(j)  (256  + 64 * (j))
#define XB_XSUB(j)  (1280 + 64 * (j))
#define XB_XGEN(j)  (2304 + 64 * (j))
#define XB_TOP      3328
#define XB_TOPGEN   3392
#define XCD_BAR_WORDS 3456
#define XB_SPIN_CAP (1u << 18)
#define LAS __attribute__((address_space(3)))

__device__ __forceinline__ unsigned xb_ld(unsigned* p)              { return __hip_atomic_load(p, __ATOMIC_RELAXED, __HIP_MEMORY_SCOPE_AGENT); }
__device__ __forceinline__ unsigned xb_add(unsigned* p, unsigned v) { return __hip_atomic_fetch_add(p, v, __ATOMIC_RELAXED, __HIP_MEMORY_SCOPE_AGENT); }
__device__ __forceinline__ unsigned xb_xcc_id() { return (unsigned)__builtin_amdgcn_s_getreg((3 << 11) | 20) & 0xFu; }
#define XB_SPIN(cond, bar) do { unsigned _sp = 0; while (cond) { __builtin_amdgcn_s_sleep(1); \
    if ((++_sp & 255u) == 0u) { if (xb_ld(&(bar)[XB_TMO])) break; if (_sp > XB_SPIN_CAP) { atomicAdd(&(bar)[XB_TMO], 1u); break; } } } } while (0)

struct XcdBarrier {
    unsigned* bar; unsigned x;
    volatile LAS unsigned* st;
};

__device__ __forceinline__ XcdBarrier xcd_barrier_post(unsigned* bar, volatile LAS unsigned* st) {
    XcdBarrier b; b.bar = bar; b.x = xb_xcc_id(); b.st = st;
    if (threadIdx.x == 0) (void)xb_add(&bar[XB_XCNT(b.x)], 1u);
    return b;
}
__device__ __forceinline__ void xcd_barrier_complete(unsigned* bar, unsigned x, unsigned& nloc, unsigned& nx) {
    const unsigned G = gridDim.x * gridDim.y * gridDim.z;
    unsigned sum, cnt, mine, sp = 0u;
    for (;;) {
        sum = 0u; cnt = 0u; mine = 0u;
#pragma unroll
        for (unsigned j = 0; j < 16; ++j) { const unsigned c = xb_ld(&bar[XB_XCNT(j)]); sum += c; cnt += (c > 0u) ? 1u : 0u; mine = (j == x) ? c : mine; }
        if (sum == G) break;
        __builtin_amdgcn_s_sleep(1);
        if ((++sp & 255u) == 0u) { if (xb_ld(&bar[XB_TMO])) break; if (sp > XB_SPIN_CAP) { atomicAdd(&bar[XB_TMO], 1u); break; } }
    }
    nloc = mine > 0u ? mine : 1u; nx = cnt > 0u ? cnt : 1u;
}

__device__ __forceinline__ void xcd_barrier(const XcdBarrier& b) {
    asm volatile("s_waitcnt vmcnt(0)" ::: "memory");
    __syncthreads();
    if (threadIdx.x == 0) {
        unsigned* bar = b.bar;
        __builtin_amdgcn_s_waitcnt(0);
        unsigned nloc = b.st[0], nx = b.st[1];
        if (nloc == 0u) { xcd_barrier_complete(bar, b.x, nloc, nx); b.st[0] = nloc; b.st[1] = nx; }
        const unsigned old = xb_add(&bar[XB_XSUB(b.x)], 1u);
        const unsigned gen = old / nloc;
        if (old + 1u == (gen + 1u) * nloc) {
            __builtin_amdgcn_fence(__ATOMIC_RELEASE, "agent");
            asm volatile("s_waitcnt vmcnt(0)" ::: "memory");
            const unsigned og = xb_add(&bar[XB_TOP], 1u);
            const unsigned tg = og / nx;
            if (og + 1u == (tg + 1u) * nx) xb_add(&bar[XB_TOPGEN], 1u);
            else XB_SPIN(xb_ld(&bar[XB_TOPGEN]) == tg, bar);
            __builtin_amdgcn_fence(__ATOMIC_ACQUIRE, "agent");
            xb_add(&bar[XB_XGEN(b.x)], 1u);
            asm volatile("s_waitcnt vmcnt(0)" ::: "memory");
        } else {
            XB_SPIN(xb_ld(&bar[XB_XGEN(b.x)]) == gen, bar);
            __builtin_amdgcn_fence(__ATOMIC_ACQUIRE, "agent");
            asm volatile("s_waitcnt vmcnt(0)" ::: "memory");
        }
    }
    __syncthreads();
}


__global__ void __launch_bounds__(NTHREADS, 2) fwd_megakernel(Params Pval) {
    PP P = (PP)__builtin_amdgcn_kernarg_segment_ptr();
    extern __shared__ __attribute__((aligned(16))) char smem[];
    cg::grid_group grid = cg::this_grid();
    const int G = gridDim.x, bid = blockIdx.x;
    const int wv = __builtin_amdgcn_readfirstlane((int)(threadIdx.x >> 6));

    uint4& xb_words = *(uint4*)(smem + SMEM_MAIN);
    if (otid(wv) == 0) xb_words = make_uint4(0u, 0u, 0u, 0u);
    __syncthreads();
    if (P->ws == nullptr) grid.sync();
    const XcdBarrier xb = xcd_barrier_post((unsigned*)(P->ws + OFF_BAR), (volatile LAS unsigned*)(smem + SMEM_MAIN));
    int vxcd = bid & 7, vjx = bid >> 3;
    {
        unsigned* xcnt = (unsigned*)(P->ws + OFF_BAR) + XCD_BAR_WORDS;
        volatile LAS unsigned* lw = (volatile LAS unsigned*)(smem + SMEM_MAIN) + 2;
        if (otid(wv) == 0) lw[0] = xb.x < 8u ? xb_add(&xcnt[xb.x], 1u) : 0xffffu;
        phase0(P, smem, wv);
        xcd_barrier(xb);
        if (otid(wv) == 0) {
            bool ok = (G & 7) == 0 && xb.x < 8u;
            for (int j = 0; j < 8; ++j) ok = ok && (xb_ld(&xcnt[j]) == (unsigned)(G >> 3));
            lw[1] = ok ? 1u : 0u;
        }
        __syncthreads();
        if (lw[1]) { vxcd = (int)xb.x; vjx = (int)lw[0]; }
    }
    vxcd = __builtin_amdgcn_readfirstlane(vxcd); vjx = __builtin_amdgcn_readfirstlane(vjx);

#pragma unroll 1
    for (int l = 0; l < DEPTH; ++l) {
        {
            const int xcd = vxcd, jx = vjx, nper = G >> 3;
            for (int u = jx; u < 192; u += nper) inproj_tile<2, 8>(P, l, (xcd * 8 + (u & 7)) * 256, (u >> 3) * 128, smem, wv);
            for (int it = jx; it < 16 + 40; it += nper) {
                if (it < 16) inproj_tile<4, 2>(P, l, (xcd * 16 + it) * 128, 3072, smem, wv);
                else s5_build_item(P, l, (it - 16) * 8 + xcd, smem, wv);
            }
        }
        xcd_barrier(xb);
#pragma unroll 1
        for (int w = bid; w < 128 + 64 + 512; w += G) {
            if (w < 128) cmp_gemm_tile(P, l, w, smem, wv);
            else if (w < 192) s5e_gemm_tile(P, l, w - 128, smem, wv);
            else gla_kv_item(P, l, w - 192, smem, wv);
        }
        xcd_barrier(xb);
#pragma unroll 1
        for (int w = bid; w < 512 + 512 + 64; w += G) {
            if (w < 512) cmp_l2_item(P, l, w, smem, wv);
            else if (w < 1024) gla_scan_item(P, w - 512, smem, wv);
            else s5_scan_item(P, w - 1024, smem, wv);
        }
        xcd_barrier(xb);
        bool nsa_fast;
        {
            const int ln = otid(wv) & 63;
            const float gq = wave_max(fabsf(P->in[I_NQN][l * 64 + ln]));
            const float gk = wave_max(fmaxf(fmaxf(fabsf(P->in[I_NKN][(l * 3 + 0) * 64 + ln]), fabsf(P->in[I_NKN][(l * 3 + 1) * 64 + ln])), fabsf(P->in[I_NKN][(l * 3 + 2) * 64 + ln])));
            nsa_fast = __builtin_amdgcn_readfirstlane((8.f * 1.4426950408889634f * gq * gk - FAST_SHIFT < 15.f) ? 1 : 0) != 0;
        }
#pragma unroll 1
        for (int w0 = bid; w0 < 512 + 512 + 512; w0 += G) {
            const int w = w0 < G ? vjx * 8 + vxcd : w0;
            if (w < 512) {
                const int bg = w & 3, q = w >> 2;
                if (nsa_fast) { nsa_unit<true>(P, l, bg, 255 - q, smem, wv); nsa_unit<true>(P, l, bg, q, smem, wv); }
                else { nsa_unit<false>(P, l, bg, 255 - q, smem, wv); nsa_unit<false>(P, l, bg, q, smem, wv); }
            } else if (w < 512 + 512) s5o_gemm_tile(P, l, w - 512, smem, wv);
            else gla_out_item(P, l, w - 1024, smem, wv);
        }
        xcd_barrier(xb);
#pragma unroll 1
        for (int w = bid; w < 512; w += G) glu_tile(P, l, w, smem, wv);
        xcd_barrier(xb);
        {
            const int xcd = vxcd, jx = vjx, nper = G >> 3;
            for (int u = jx; u < 64; u += nper) outproj_tile(P, l, xcd * 8 + (u & 7), u >> 3, smem, wv);
        }
        xcd_barrier(xb);
    }
}

extern "C" void kernel_launch(void* const* d_in, const int* in_sizes, int n_in, void* d_out, int out_size, void* d_ws,
                              size_t ws_size, hipStream_t stream) {
    static int grid_blocks = 0;
    if (!grid_blocks) {
        int dev = 0, cus = 0, per_cu = 0;
        hipGetDevice(&dev);
        hipDeviceGetAttribute(&cus, hipDeviceAttributeMultiprocessorCount, dev);
        hipFuncSetAttribute((const void*)fwd_megakernel, hipFuncAttributeMaxDynamicSharedMemorySize, SMEM_BYTES);
        hipOccupancyMaxActiveBlocksPerMultiprocessor(&per_cu, fwd_megakernel, NTHREADS, SMEM_BYTES);
        if (per_cu < 1) per_cu = 1;
        if (per_cu > 2) per_cu = 2;
        grid_blocks = cus * per_cu;
        if (ws_size < WS_END) fprintf(stderr, "kernel_launch: workspace too small: %zu < %zu\n", ws_size, (size_t)WS_END);
    }
    Params p{};
    for (int i = 0; i < 25; ++i) p.in[i] = (const float*)d_in[i];
    p.out = (float*)d_out;
    p.ws = (char*)d_ws;
    void* args[] = {&p};
    (void)hipMemsetAsync((char*)d_ws + OFF_BAR, 0, (XCD_BAR_WORDS + 16) * sizeof(unsigned), stream);
    hipError_t e = hipLaunchCooperativeKernel((const void*)fwd_megakernel, dim3(grid_blocks), dim3(NTHREADS), args, SMEM_BYTES, stream);
    if (e != hipSuccess) fprintf(stderr, "cooperative launch failed: %s (grid %d)\n", hipGetErrorString(e), grid_blocks);
}
```

```cpp
#include <hip/hip_runtime.h>
#include <hip/hip_cooperative_groups.h>
#include <cstdio>
#include <cstdint>
namespace cg = cooperative_groups;

typedef _Float16 h16;
typedef _Float16 half8 __attribute__((ext_vector_type(8)));
typedef _Float16 half4 __attribute__((ext_vector_type(4)));
typedef float f32x4 __attribute__((ext_vector_type(4)));
typedef float f32x16 __attribute__((ext_vector_type(16)));

#define DI __device__ __forceinline__

constexpr int D_MODEL = 1024, BATCH = 2, SEQ = 8192, DEPTH = 4, NT = BATCH * SEQ;
constexpr int D_IN = 3112, D_IN_PAD = 3200;
constexpr int C_NQ = 0, C_NKV = 512, C_NG = 1280, C_GQ = 1792, C_GK = 1920, C_GV = 2048, C_GG = 2304, C_SU = 2560, C_SG = 2816,
              C_GLR = 3072, C_NGL = 3088;
__host__ __device__ constexpr int map_col(int c) {
    return c < 128 ? C_GQ + c : c < 256 ? C_GK + (c - 128) : c < 512 ? C_GV + (c - 256) : c < 528 ? C_GLR + (c - 512)
         : c < 784 ? C_GG + (c - 528) : c < 1040 ? C_SU + (c - 784) : c < 1296 ? C_SG + (c - 1040) : c < 1808 ? C_NQ + (c - 1296)
         : c < 2576 ? C_NKV + (c - 1808) : c < 2600 ? C_NGL + (c - 2576) : c < 3112 ? C_NG + (c - 2600) : c;
}
constexpr int NTHREADS = 256;
constexpr float QSCALE = 0.125f * 1.4426950408889634f;

enum { I_X = 0, I_NORMG, I_WIN, I_GW2, I_GB2, I_GON, I_LRE, I_LIM, I_LSTEP, I_BRE, I_BIM, I_CRE, I_CIM, I_SD, I_GLUW, I_GLUB,
       I_NGB, I_NQN, I_NKN, I_CPOS, I_CW1, I_CB1, I_CW2, I_CB2, I_WOUT };

constexpr size_t OFF_WTIN  = 0;
constexpr size_t OFF_WTOUT = OFF_WTIN  + 4ull * D_IN_PAD * 1024 * 2;
constexpr size_t OFF_WTGLU = OFF_WTOUT + 4ull * 1024 * 1024 * 2;
constexpr size_t OFF_WTC1  = OFF_WTGLU + 4ull * 512 * 256 * 2;
constexpr size_t OFF_PROJ  = OFF_WTC1  + 4ull * 2 * 256 * 2048 * 2;
constexpr size_t OFF_MIX   = OFF_PROJ  + (size_t)NT * D_IN * 2;
constexpr size_t OFF_YACT  = OFF_MIX   + (size_t)NT * 1024 * 2;
constexpr size_t OFF_XH    = OFF_YACT;
constexpr size_t OFF_BCUM  = OFF_YACT  + (size_t)NT * 256 * 2;
constexpr size_t OFF_GKV   = OFF_BCUM  + (size_t)NT * 128 * 4;
constexpr size_t OFF_GDEC  = OFF_GKV   + 8ull * 256 * 2048 * 4;
static_assert(OFF_GDEC - OFF_XH >= (size_t)NT * 1024 * 2, "XH alias region too small");
constexpr size_t OFF_XC    = OFF_GDEC  + 8ull * 256 * 32 * 4;
constexpr size_t OFF_S5W   = OFF_XC    + 512ull * 1024 * 2 * 4;
constexpr size_t OFF_S5E   = OFF_S5W   + 16ull * 512 * 640 * 2;
constexpr size_t OFF_S5AL  = OFF_S5E   + 16ull * 128 * 512 * 2;
constexpr size_t OFF_CHID  = OFF_S5AL  + 1024ull * 2 * 4;
constexpr size_t OFF_POSB  = OFF_CHID  + 2ull * 2048 * 512 * 4;
constexpr size_t OFF_XCH   = OFF_POSB  + 8ull * 16 * 256 * 4;
constexpr size_t OFF_KCMP  = OFF_XCH   + 512ull * 2048 * 2;
constexpr size_t OFF_VCMP  = OFF_KCMP  + 4ull * 512 * 64 * 2;
constexpr size_t OFF_VTG   = OFF_VCMP  + 4ull * 512 * 64 * 2;
constexpr size_t OFF_BAR   = OFF_VTG   + 2ull * 4 * 128 * 4096 * 2;
constexpr size_t WS_END    = OFF_BAR   + 16384;

struct Params {
    const float* in[25];
    float* out;
    char* ws;
};

__host__ __device__ constexpr size_t kb_idx(size_t nrows, size_t row, int k) { return (((size_t)(k >> 6)) * nrows + row) * 64 + (k & 63); }
typedef const __attribute__((address_space(4))) Params* PP;
DI PP plaunder(PP p) { asm volatile("" : "+s"(p)); return p; }
constexpr int SMEM_MAIN = 73728;
constexpr int SMEM_BYTES = SMEM_MAIN + 16;

DI int otid(const int wv) { int t = wv * 64 + (int)__builtin_amdgcn_mbcnt_hi(~0u, __builtin_amdgcn_mbcnt_lo(~0u, 0u)); asm volatile("" : "+v"(t)); return t; }
DI float wave_sum(float v) {
#pragma unroll
    for (int o = 32; o > 0; o >>= 1) v += __shfl_xor(v, o);
    return v;
}
DI float wave_max(float v) {
#pragma unroll
    for (int o = 32; o > 0; o >>= 1) v = fmaxf(v, __shfl_xor(v, o));
    return v;
}
DI float sigmoidf_(float x) { return 1.f / (1.f + __expf(-x)); }
DI float siluf_(float x) { return x / (1.f + __expf(-x)); }
DI float gelu_tanh(float x) {
    const float u = 0.7978845608028654f * (x + 0.044715f * x * x * x);
    return 0.5f * x * (1.f + tanhf(u));
}
DI float log_sigmoidf_(float x) { return fminf(x, 0.f) - log1pf(__expf(-fabsf(x))); }

typedef _Float16 half2_ __attribute__((ext_vector_type(2)));
DI void glds16(const h16* g, char* l) {
    __builtin_amdgcn_global_load_lds((const __attribute__((address_space(1))) void*)g, (__attribute__((address_space(3))) void*)l, 16, 0, 0);
}
struct APlain { const h16* A; size_t lda, astep; DI const h16* operator()(int row, int kt, int c8) const { return A + (size_t)row * lda + (size_t)kt * astep + c8 * 8; } };
struct AS5 {
    const h16* ubase;
    const h16* xin;
    int ch0;
    DI const h16* operator()(int row, int kt, int c8) const {
        const size_t ch = (size_t)(ch0 + row);
        return kt < 8 ? ubase + (ch * 32 + 4 * kt + (c8 >> 1)) * D_IN + (c8 & 1) * 8 : xin + ch * 2048 + (kt - 8) * 64 + c8 * 8;
    }
};
template <int N> DI void gwaitbar();
#define GWB_DEF(N) template <> DI void gwaitbar<N>() { asm volatile("s_waitcnt vmcnt(" #N ") lgkmcnt(0)\n\ts_barrier" ::: "memory"); }
GWB_DEF(0) GWB_DEF(3) GWB_DEF(4) GWB_DEF(6) GWB_DEF(8) GWB_DEF(12)
template <bool SUMSQ, int WR, int MI, int NJ, int NST = 4, class AF>
DI void gemm_glds(const int wv, const int K, const AF& afn, const h16* __restrict__ Bt, const int ldb,
                  f32x4 (&acc)[MI][NJ], float (&ss)[MI], char* smem, const size_t bstep = 64) {
    constexpr int WC = 4 / WR, BM = WR * MI * 16, BN = WC * NJ * 16, AQ = BM / 64, BQ = BN / 64, NG = AQ + BQ, SB = (BM + BN) * 64;
    static_assert(NST * SB <= SMEM_MAIN && AQ >= 1 && BQ >= 1 && (NST == 3 || NST == 4), "ring does not fit the LDS");
    const int tid = otid(wv), lane = tid & 63, wid = tid >> 6, wr = wid / WC, wc = wid % WC;
#pragma unroll
    for (int i = 0; i < MI; ++i) {
        ss[i] = 0.f;
#pragma unroll
        for (int j = 0; j < NJ; ++j) acc[i][j] = (f32x4){0.f, 0.f, 0.f, 0.f};
    }
    const int lrow = wid * 16 + (lane >> 2);
    const int lc4 = (lane & 3) ^ ((-(lrow >> 2)) & 3);
    const h16* bp = Bt + (size_t)lrow * ldb + lc4 * 8;
    char* lbase = smem + wid * 1024;
    const int fr = lane & 15, fq = lane >> 4, sw = (-(fr >> 2)) & 3;
    const int aoff0 = (wr * MI * 16 + fr) * 64 + ((fq ^ sw) * 16);
    const int boff0 = BM * 64 + (wc * NJ * 16 + fr) * 64 + ((fq ^ sw) * 16);
    const int nt = K >> 5;
    auto issue = [&](const int t, char* stage) {
        const int kt = t >> 1, hb = (t & 1) * 4;
#pragma unroll
        for (int q = 0; q < AQ; ++q) glds16(afn(lrow + 64 * q, kt, hb + lc4), stage + q * 4096);
#pragma unroll
        for (int q = 0; q < BQ; ++q) glds16(bp + (size_t)q * 64 * ldb + (size_t)kt * bstep + hb * 8, stage + BM * 64 + q * 4096);
    };
    auto compute = [&](const char* st) {
        half8 af[MI], bf[NJ];
#pragma unroll
        for (int i = 0; i < MI; ++i) af[i] = *(const half8*)(st + aoff0 + i * 1024);
#pragma unroll
        for (int j = 0; j < NJ; ++j) bf[j] = *(const half8*)(st + boff0 + j * 1024);
        if (SUMSQ) {
#pragma unroll
            for (int i = 0; i < MI; ++i)
#pragma unroll
                for (int e = 0; e < 4; ++e) {
                    const half2_ x = (half2_){af[i][2 * e], af[i][2 * e + 1]};
                    ss[i] = __builtin_amdgcn_fdot2(x, x, ss[i], false);
                }
        }
#pragma unroll
        for (int i = 0; i < MI; ++i)
#pragma unroll
            for (int j = 0; j < NJ; ++j) acc[i][j] = __builtin_amdgcn_mfma_f32_16x16x32_f16(bf[j], af[i], acc[i][j], 0, 0, 0);
    };
#define GEMM_STEP(S, t) do { if (NST == 4 && (t) + 2 < nt) gwaitbar<NG>(); else gwaitbar<0>();                       \
        if ((t) + NST - 1 < nt) issue((t) + NST - 1, lbase + (((S) + NST - 1) % NST) * SB); compute(smem + (S) * SB); } while (0)
    gwaitbar<0>();
    {
        const int k = nt < NST - 1 ? nt : NST - 1;
        for (int p = 0; p < k; ++p) issue(p, lbase + p * SB);
        if (k >= 3) gwaitbar<2 * NG>(); else if (k == 2) gwaitbar<NG>(); else gwaitbar<0>();
        __builtin_amdgcn_s_sleep(2);
    }
#pragma unroll 1
    for (int t = 0; t < nt; t += NST) {
        GEMM_STEP(0, t);
        if (t + 1 < nt) GEMM_STEP(1, t + 1);
        if (t + 2 < nt) GEMM_STEP(2, t + 2);
        if (NST == 4 && t + 3 < nt) GEMM_STEP(3 % NST, t + 3);
    }
#undef GEMM_STEP
    asm volatile("s_waitcnt lgkmcnt(0)\n\ts_barrier" ::: "memory");
    if (SUMSQ) {
#pragma unroll
        for (int i = 0; i < MI; ++i) { ss[i] += __shfl_xor(ss[i], 16); ss[i] += __shfl_xor(ss[i], 32); }
    }
}
template <bool SUMSQ, class AF>
DI void gemm_mainloop_glds(const int wv, const int K, const AF& afn, const h16* __restrict__ Bt, const int ldb, f32x4 (&acc)[4][4], float (&ss)[4], char* smem, const size_t bstep = 64) {
    gemm_glds<SUMSQ, 2, 4, 4>(wv, K, afn, Bt, ldb, acc, ss, smem, bstep);
}

DI int glu_perm_dst(int c_orig) {
    const int which = c_orig >> 8, c = c_orig & 255;
    return (c >> 6) * 128 + ((c >> 5) & 1) * 64 + (((c >> 4) & 1) * 2 + which) * 16 + (c & 15);
}
template <int MAP, int KB>
DI void transpose64(const float* __restrict__ src, int R, int C, h16* __restrict__ dst, int r0, int c0,
                    const float* __restrict__ rscale, char* smem, const int wv) {
    h16* tile = (h16*)smem;
    const int tid = otid(wv);
    {
        const int r = tid >> 2, cq = (tid & 3) * 16;
        const float sc = rscale ? rscale[r0 + r] : 1.f;
        const float* sp = src + (size_t)(r0 + r) * C + c0 + cq;
#pragma unroll
        for (int q = 0; q < 4; ++q) {
            float4 v = (float4){0.f, 0.f, 0.f, 0.f};
            if (c0 + cq + q * 4 < C) v = *(const float4*)(sp + q * 4);
            *(half4*)(tile + r * 72 + cq + q * 4) = (half4){(h16)(v.x * sc), (h16)(v.y * sc), (h16)(v.z * sc), (h16)(v.w * sc)};
        }
    }
    __syncthreads();
    {
        const int c = tid >> 2, rq = (tid & 3) * 16;
        half8 o0, o1;
#pragma unroll
        for (int k = 0; k < 8; ++k) { o0[k] = tile[(rq + k) * 72 + c]; o1[k] = tile[(rq + 8 + k) * 72 + c]; }
        const int cc = c0 + c;
        const int dr = MAP == 1 ? map_col(cc) : MAP == 2 ? glu_perm_dst(cc) : cc;
        h16* dp = KB ? dst + ((size_t)(r0 >> 6) * KB + dr) * 64 + rq : dst + (size_t)dr * R + r0 + rq;
        *(half8*)dp = o0; *(half8*)(dp + 8) = o1;
    }
    __syncthreads();
}

DI void phase0(PP P, char* smem, const int wv) {
    P = plaunder(P);
    constexpr int N_WIN = 4 * 16 * 50, N_WOUT = 4 * 16 * 16, N_C1 = 16 * 16 * 4, N_GLU = 4 * 4 * 8, N_XH = NT * 1024 / 2048, N_PB = 8 * 16;
    const int total = N_WIN + N_WOUT + N_C1 + N_GLU + N_XH + N_PB;
    for (int w = blockIdx.x; w < total; w += gridDim.x) {
        if (w < N_WIN) {
            const int l = w / 800, r = w % 800, rt = r / 50, ct = r % 50;
            transpose64<1, D_IN_PAD>(P->in[I_WIN] + (size_t)l * 1024 * D_IN, 1024, D_IN, (h16*)(P->ws + OFF_WTIN) + (size_t)l * D_IN_PAD * 1024,
                           rt * 64, ct * 64, P->in[I_NORMG] + l * 1024, smem, wv);
        } else if (w < N_WIN + N_WOUT) {
            const int v = w - N_WIN, l = v >> 8, r = v & 255, rt = r >> 4, ct = r & 15;
            transpose64<0, 1024>(P->in[I_WOUT] + (size_t)l * 1024 * 1024, 1024, 1024, (h16*)(P->ws + OFF_WTOUT) + (size_t)l * 1024 * 1024,
                           rt * 64, ct * 64, nullptr, smem, wv);
        } else if (w < N_WIN + N_WOUT + N_C1) {
            const int v = w - N_WIN - N_WOUT, ljh = v >> 6, r = v & 63, rt = r >> 2, ct = r & 3;
            transpose64<0, 512>(P->in[I_CW1] + (size_t)ljh * 1024 * 256, 1024, 256, (h16*)(P->ws + OFF_WTC1) + ((size_t)(ljh >> 1) * 16 * 512 + (ljh & 1) * 256) * 64,
                           rt * 64, ct * 64, nullptr, smem, wv);
        } else if (w < N_WIN + N_WOUT + N_C1 + N_GLU) {
            const int v = w - N_WIN - N_WOUT - N_C1, l = v >> 5, r = v & 31, rt = r >> 3, ct = r & 7;
            transpose64<2, 0>(P->in[I_GLUW] + (size_t)l * 256 * 512, 256, 512, (h16*)(P->ws + OFF_WTGLU) + (size_t)l * 512 * 256,
                           rt * 64, ct * 64, nullptr, smem, wv);
        } else if (w < N_WIN + N_WOUT + N_C1 + N_GLU + N_XH) {
            const size_t e0 = ((size_t)(w - N_WIN - N_WOUT - N_C1 - N_GLU) * 256 + otid(wv)) * 8;
            const float4 a = *(const float4*)(P->in[I_X] + e0), b = *(const float4*)(P->in[I_X] + e0 + 4);
            *(half8*)((h16*)(P->ws + OFF_XH) + kb_idx(NT, e0 >> 10, (int)(e0 & 1023))) = (half8){(h16)a.x, (h16)a.y, (h16)a.z, (h16)a.w, (h16)b.x, (h16)b.y, (h16)b.z, (h16)b.w};
        } else {
            const int v = w - (N_WIN + N_WOUT + N_C1 + N_GLU + N_XH), lj = v >> 4, ks = v & 15, n = otid(wv);
            const float* w1 = P->in[I_CW1] + ((size_t)lj * 2048 + ks * 128) * 256 + n;
            const float* pp = P->in[I_CPOS] + (size_t)lj * 2048 + ks * 128;
            float a = ks == 0 ? P->in[I_CB1][lj * 256 + n] : 0.f;
#pragma unroll 16
            for (int k = 0; k < 128; ++k) a += pp[k] * w1[(size_t)k * 256];
            ((float*)(P->ws + OFF_POSB))[(lj * 16 + ks) * 256 + n] = a;
        }
    }
}

DI void s5_build_item(PP P, int l, int item, char* smem, const int wv) {
    P = plaunder(P);
    float* apow = (float*)smem;
    float* bbar = apow + 64 * 33 * 2;
    float* cc   = bbar + 64 * 16 * 2;
    const int tid = otid(wv);
    const int g = (item < 256) ? (item >> 4) : ((item - 256) >> 2);
    if (tid < 64) {
        const int p = tid;
        const float lre = fminf(P->in[I_LRE][(l * 16 + g) * 64 + p], -1e-4f);
        const float lim = P->in[I_LIM][(l * 16 + g) * 64 + p];
        const float dt = expf(P->in[I_LSTEP][l * 16 + g]);
        const float x = lre * dt, y = lim * dt;
        const float em1 = expm1f(x), cy = cosf(y), sy = sinf(y), sh = sinf(0.5f * y);
        const float ar = (em1 + 1.f) * cy, ai = (em1 + 1.f) * sy;
        const float dr = em1 * cy - 2.f * sh * sh, di = ai;
        const float den = lre * lre + lim * lim;
        const float fr = (dr * lre + di * lim) / den;
        const float fi = (di * lre - dr * lim) / den;
        float pr = 1.f, pi = 0.f;
        for (int k = 0; k <= 32; ++k) {
            apow[(p * 33 + k) * 2] = pr; apow[(p * 33 + k) * 2 + 1] = pi;
            const float nr = pr * ar - pi * ai, ni = pr * ai + pi * ar; pr = nr; pi = ni;
        }
        for (int c = 0; c < 16; ++c) {
            const float br = P->in[I_BRE][((size_t)(l * 16 + g) * 64 + p) * 16 + c];
            const float bi = P->in[I_BIM][((size_t)(l * 16 + g) * 64 + p) * 16 + c];
            bbar[(p * 16 + c) * 2] = fr * br - fi * bi;
            bbar[(p * 16 + c) * 2 + 1] = fr * bi + fi * br;
        }
    }
    for (int e = tid; e < 1024; e += 256) {
        cc[e * 2] = P->in[I_CRE][(size_t)(l * 16 + g) * 1024 + e];
        cc[e * 2 + 1] = P->in[I_CIM][(size_t)(l * 16 + g) * 1024 + e];
    }
    __syncthreads();
    if (item < 256) {
        const int c = item & 15;
        float* kt = cc + 2048;
        for (int idx = tid; idx < 512; idx += 256) {
            const int lag = idx >> 4, c2 = idx & 15;
            float a = 0.f;
            for (int p = 0; p < 64; ++p) {
                const float cr = cc[(c * 64 + p) * 2], ci = cc[(c * 64 + p) * 2 + 1];
                const float xr = apow[(p * 33 + lag) * 2], xi = apow[(p * 33 + lag) * 2 + 1];
                const float br = bbar[(p * 16 + c2) * 2], bi = bbar[(p * 16 + c2) * 2 + 1];
                const float tr = cr * xr - ci * xi, ti = cr * xi + ci * xr;
                a += tr * br - ti * bi;
            }
            kt[idx] = a;
        }
        __syncthreads();
        h16* W = (h16*)(P->ws + OFF_S5W) + (size_t)g * 512 * 640;
        for (int idx = tid; idx < 32 * 640; idx += 256) {
            const int j = idx / 640, k = idx % 640;
            float val = 0.f;
            if (k < 512) {
                const int s = k >> 4, c2 = k & 15, lag = j - s;
                if (lag >= 0) val = kt[lag * 16 + c2];
            } else {
                const int p = (k - 512) >> 1;
                const float cr = cc[(c * 64 + p) * 2], ci = cc[(c * 64 + p) * 2 + 1];
                const float xr = apow[(p * 33 + j + 1) * 2], xi = apow[(p * 33 + j + 1) * 2 + 1];
                val = (k & 1) ? -(cr * xi + ci * xr) : (cr * xr - ci * xi);
            }
            W[(size_t)(j * 16 + c) * 640 + k] = (h16)val;
        }
    } else {
        const int pq = (item - 256) & 3;
        h16* E = (h16*)(P->ws + OFF_S5E) + ((size_t)g * 128 + pq * 32) * 512;
        for (int idx = tid; idx < 32 * 512; idx += 256) {
            const int nl = idx >> 9, k = idx & 511;
            const int p = pq * 16 + (nl >> 1), s = k >> 4, c2 = k & 15;
            const float xr = apow[(p * 33 + 31 - s) * 2], xi = apow[(p * 33 + 31 - s) * 2 + 1];
            const float br = bbar[(p * 16 + c2) * 2], bi = bbar[(p * 16 + c2) * 2 + 1];
            const float val = (nl & 1) ? (xr * bi + xi * br) : (xr * br - xi * bi);
            E[(size_t)nl * 512 + k] = (h16)val;
        }
        if (tid < 16) {
            const int p = pq * 16 + tid;
            float* AL = (float*)(P->ws + OFF_S5AL);
            AL[(g * 64 + p) * 2] = apow[(p * 33 + 32) * 2];
            AL[(g * 64 + p) * 2 + 1] = apow[(p * 33 + 32) * 2 + 1];
        }
    }
    __syncthreads();
}

template <int WR, int MI>
DI void inproj_tile(PP P, int l, int m0, int n0, char* smem, const int wv) {
    P = plaunder(P);
    constexpr int WC = 4 / WR;
    f32x4 acc[MI][4];
    float ss[MI];
    gemm_glds<true, WR, MI, 4, (WR == 2 && MI == 8) ? 3 : 4>(wv, 1024, APlain{(const h16*)(P->ws + OFF_XH) + (size_t)m0 * 64, 64, (size_t)NT * 64},
                               (const h16*)(P->ws + OFF_WTIN) + ((size_t)l * 16 * D_IN_PAD + n0) * 64, 64, acc, ss, smem, (size_t)D_IN_PAD * 64);
    const int tid = otid(wv), lane = tid & 63, wid = tid >> 6, wr = wid / WC, wc = wid % WC;
    h16* proj = (h16*)(P->ws + OFF_PROJ);
    const int n64 = n0 + wc * 64;
    int cls = 0;
    if (n64 < 512) cls = 1;
    else if (n64 >= C_NKV + 256 && n64 < C_NKV + 384) cls = 2;
    else if (n64 >= C_NKV + 512 && n64 < C_NKV + 640) cls = 3;
    else if (n64 >= C_NKV + 384 && n64 < C_NKV + 512) cls = 4;
    else if (n64 >= C_NKV + 640 && n64 < C_NKV + 768) cls = 5;
    float wn[4][4];
    if (cls >= 1 && cls <= 3) {
        const float* wp = (cls == 1) ? P->in[I_NQN] + l * 64 : P->in[I_NKN] + (l * 3 + (cls - 1)) * 64;
        const float sc = (cls == 1) ? QSCALE : 1.f;
#pragma unroll
        for (int j = 0; j < 4; ++j) {
            const float4 w4 = *(const float4*)(wp + j * 16 + (lane >> 4) * 4);
            wn[j][0] = w4.x * sc; wn[j][1] = w4.y * sc; wn[j][2] = w4.z * sc; wn[j][3] = w4.w * sc;
        }
    }
#pragma unroll
    for (int i = 0; i < MI; ++i) {
        const int ml = wr * MI * 16 + i * 16 + (lane & 15);
        const float r = rsqrtf(ss[i] * (1.f / 1024.f) + 1e-6f);
        const size_t row = (size_t)m0 + ml;
        f32x4 v[4];
#pragma unroll
        for (int j = 0; j < 4; ++j) v[j] = acc[i][j] * r;
        if (cls >= 1 && cls <= 3) {
            float s2 = 0.f;
#pragma unroll
            for (int j = 0; j < 4; ++j) s2 += v[j][0] * v[j][0] + v[j][1] * v[j][1] + v[j][2] * v[j][2] + v[j][3] * v[j][3];
            s2 += __shfl_xor(s2, 16); s2 += __shfl_xor(s2, 32);
            const float rn = rsqrtf(s2 * (1.f / 64.f) + 1e-6f);
#pragma unroll
            for (int j = 0; j < 4; ++j) { v[j][0] *= rn * wn[j][0]; v[j][1] *= rn * wn[j][1]; v[j][2] *= rn * wn[j][2]; v[j][3] *= rn * wn[j][3]; }
        }
        if (cls >= 4) {
            const int g = (n64 >> 6) & 1, br = cls - 4;
            const int b = (int)(row >> 13), t = (int)(row & 8191);
            h16* vt = (h16*)(P->ws + OFF_VTG) + ((((size_t)br * 4 + b * 2 + g) * 128 + (t >> 6)) * 64) * 64;
#pragma unroll
            for (int j = 0; j < 4; ++j)
#pragma unroll
                for (int e = 0; e < 4; ++e) vt[(j * 16 + (lane >> 4) * 4 + e) * 64 + ((t & 63) ^ ((j & 1) << 2))] = (h16)v[j][e];
        }
#pragma unroll
        for (int j = 0; j < 4; ++j) {
            const int n = n64 + j * 16 + (lane >> 4) * 4;
            if (n < D_IN) *(half4*)(proj + row * D_IN + n) = (half4){(h16)v[j][0], (h16)v[j][1], (h16)v[j][2], (h16)v[j][3]};
        }
        __builtin_amdgcn_sched_barrier(0);
    }
    __syncthreads();
}


DI void cmp_gemm_tile(PP P, int l, int tile, char* smem, const int wv) {
    P = plaunder(P);
    const int j = tile >> 6, mt = (tile >> 2) & 15, nt = tile & 3;
    const int row0 = mt * 128, bg = row0 >> 9, i0 = row0 & 511, b = bg >> 1, g = bg & 1;
    f32x4 acc[4][4];
    float ssd[4];
    gemm_mainloop_glds<false>(wv, 1024, APlain{(const h16*)(P->ws + OFF_PROJ) + ((size_t)b * SEQ + 16 * i0) * D_IN + C_NKV + j * 128 + g * 64, (size_t)16 * D_IN, (size_t)D_IN},
                              (const h16*)(P->ws + OFF_WTC1) + ((size_t)(l * 2 + j) * 16 * 512 + nt * 128) * 64, 64, acc, ssd, smem, (size_t)512 * 64);
    const int tid = otid(wv), lane = tid & 63, wid = tid >> 6, wr = wid >> 1, wc = wid & 1;
    float* pt = (float*)(P->ws + OFF_CHID) + (size_t)j * 2048 * 512;
#pragma unroll
    for (int i = 0; i < 4; ++i) {
        const size_t row = (size_t)row0 + wr * 64 + i * 16 + (lane & 15);
#pragma unroll
        for (int jj = 0; jj < 4; ++jj) {
            const int n = nt * 128 + wc * 64 + jj * 16 + (lane >> 4) * 4;
            const f32x4 v = acc[i][jj];
            *(float4*)(pt + row * 512 + n) = (float4){v[0], v[1], v[2], v[3]};
        }
    }
}

DI void s5e_gemm_tile(PP P, int l, int tile, char* smem, const int wv) {
    P = plaunder(P);
    const int g = tile >> 2, mt = tile & 3;
    f32x4 acc[4][4];
    float ssd[4];
    gemm_mainloop_glds<false>(wv, 512, AS5{(const h16*)(P->ws + OFF_PROJ) + C_SU + g * 16, nullptr, mt * 128},
                              (const h16*)(P->ws + OFF_S5E) + (size_t)g * 128 * 512, 512, acc, ssd, smem);
    const int tid = otid(wv), lane = tid & 63, wid = tid >> 6, wr = wid >> 1, wc = wid & 1;
    float* xc = (float*)(P->ws + OFF_XC);
#pragma unroll
    for (int i = 0; i < 4; ++i) {
        const size_t ch = (size_t)mt * 128 + wr * 64 + i * 16 + (lane & 15);
#pragma unroll
        for (int jj = 0; jj < 4; ++jj) {
            const int n = wc * 64 + jj * 16 + (lane >> 4) * 4;
            const f32x4 v = acc[i][jj];
            *(float4*)(xc + (ch * 1024 + g * 64) * 2 + n) = (float4){v[0], v[1], v[2], v[3]};
        }
    }
}

DI void gla_scan_item(PP P, int item, char* smem, const int wv) {
    P = plaunder(P);
    const int tid = otid(wv), sl = tid & 31, part = tid >> 5;
    const int idx = item * 32 + sl, bh = idx >> 11, de = idx & 2047, d = de >> 6;
    float* kv = (float*)(P->ws + OFF_GKV) + ((size_t)bh * 256 + part * 32) * 2048 + de;
    const float* dc = (const float*)(P->ws + OFF_GDEC) + ((size_t)bh * 256 + part * 32) * 32 + d;
    float* sD = (float*)smem; float* sL = sD + 256;
    float kvv[32], dd[32];
#pragma unroll
    for (int i = 0; i < 32; ++i) { kvv[i] = kv[(size_t)i * 2048]; dd[i] = dc[i * 32]; }
    float D = 1.f, L = 0.f;
#pragma unroll
    for (int i = 0; i < 32; ++i) { L = dd[i] * L + kvv[i]; D *= dd[i]; }
    sD[part * 32 + sl] = D; sL[part * 32 + sl] = L;
    __syncthreads();
    float S = 0.f;
    for (int q = 0; q < part; ++q) S = sD[q * 32 + sl] * S + sL[q * 32 + sl];
#pragma unroll
    for (int i = 0; i < 32; ++i) { const float o = S; S = dd[i] * S + kvv[i]; kv[(size_t)i * 2048] = o; }
    __syncthreads();
}
DI void s5_scan_item(PP P, int item, char* smem, const int wv) {
    P = plaunder(P);
    const int tid = otid(wv), sl = tid & 31, part = tid >> 5;
    const int idx = item * 32 + sl, b = idx >> 10, s = idx & 1023;
    float2* xc = (float2*)(P->ws + OFF_XC) + ((size_t)b * 256 + part * 32) * 1024 + s;
    half2_* xch = (half2_*)(P->ws + OFF_XCH) + ((size_t)b * 256 + part * 32) * 1024 + s;
    const float2 a = ((const float2*)(P->ws + OFF_S5AL))[s];
    float2* sL = (float2*)smem;
    float2 c[32];
#pragma unroll
    for (int i = 0; i < 32; ++i) c[i] = xc[(size_t)i * 1024];
    float lr = 0.f, li = 0.f;
#pragma unroll
    for (int i = 0; i < 32; ++i) { const float nr = a.x * lr - a.y * li + c[i].x, ni = a.x * li + a.y * lr + c[i].y; lr = nr; li = ni; }
    float dr = a.x, di = a.y;
#pragma unroll
    for (int i = 0; i < 5; ++i) { const float nr = dr * dr - di * di, ni = 2.f * dr * di; dr = nr; di = ni; }
    sL[part * 32 + sl] = (float2){lr, li};
    __syncthreads();
    float xr = 0.f, xi = 0.f;
    for (int q = 0; q < part; ++q) { const float2 lq = sL[q * 32 + sl]; const float nr = dr * xr - di * xi + lq.x, ni = dr * xi + di * xr + lq.y; xr = nr; xi = ni; }
#pragma unroll
    for (int i = 0; i < 32; ++i) {
        const float2 o = (float2){xr, xi};
        const float nr = a.x * xr - a.y * xi + c[i].x, ni = a.x * xi + a.y * xr + c[i].y; xr = nr; xi = ni;
        xc[(size_t)i * 1024] = o;
        xch[(size_t)i * 1024] = (half2_){(h16)o.x, (h16)o.y};
    }
    __syncthreads();
}
DI void cmp_l2_item(PP P, int l, int item, char* smem, const int wv) {
    P = plaunder(P);
    const int tid = otid(wv), lane = tid & 63, w = tid >> 6;
    const int j = item >> 8, r0 = (item & 255) * 8;
    h16* w2s = (h16*)smem;
    float* hs = (float*)(smem + 32768);
    {
        const float* w2 = P->in[I_CW2] + (size_t)(l * 2 + j) * 256 * 64;
        for (int e = tid * 4; e < 256 * 64; e += 1024) {
            const float4 v = *(const float4*)(w2 + e);
            *(half4*)(w2s + e) = (half4){(h16)v.x, (h16)v.y, (h16)v.z, (h16)v.w};
        }
        const float* pt = (const float*)(P->ws + OFF_CHID) + (size_t)j * 2048 * 512;
        float pb = 0.f;
#pragma unroll
        for (int ks = 0; ks < 16; ++ks) pb += ((const float*)(P->ws + OFF_POSB))[((l * 2 + j) * 16 + ks) * 256 + tid];
#pragma unroll
        for (int rr = 0; rr < 8; ++rr) {
            const int row = r0 + rr, i = row & 511;
            float v = 0.f;
            if (i < 511) v = gelu_tanh(pt[(size_t)row * 512 + tid] + pt[(size_t)(row + 1) * 512 + 256 + tid] + pb);
            hs[rr * 256 + tid] = v;
        }
    }
    __syncthreads();
    const float bb = P->in[I_CB2][(l * 2 + j) * 64 + lane];
    float a0 = bb, a1 = bb;
    const float* h0 = hs + (2 * w) * 256, *h1 = h0 + 256;
#pragma unroll 8
    for (int n = 0; n < 256; ++n) {
        const float wv = (float)w2s[n * 64 + lane];
        a0 += h0[n] * wv; a1 += h1[n] * wv;
    }
#pragma unroll
    for (int rr = 0; rr < 2; ++rr) {
        float acc = rr ? a1 : a0;
        const int row = r0 + 2 * w + rr, bg = row >> 9, i = row & 511;
        if (i == 511) acc = 0.f;
        if (j == 0) {
            const float ss = wave_sum(acc * acc);
            acc = acc * rsqrtf(ss * (1.f / 64.f) + 1e-6f) * P->in[I_NKN][(l * 3 + 0) * 64 + lane];
            ((h16*)(P->ws + OFF_KCMP))[(size_t)row * 64 + lane] = (h16)acc;
        } else {
            ((h16*)(P->ws + OFF_VCMP))[(((size_t)bg * 8 + (i >> 6)) * 64 + lane) * 64 + ((i & 63) ^ (((lane >> 4) & 1) << 2))] = (h16)acc;
        }
    }
    __syncthreads();
}

DI void s5o_gemm_tile(PP P, int l, int tile, char* smem, const int wv) {
    P = plaunder(P);
    const int g = tile >> 5, mt = (tile >> 3) & 3, nt = tile & 7;
    f32x4 acc[2][4];
    float ssd[2];
    gemm_glds<false, 4, 2, 4>(wv, 640, AS5{(const h16*)(P->ws + OFF_PROJ) + C_SU + g * 16, (const h16*)(P->ws + OFF_XCH) + g * 128, mt * 128},
                              (const h16*)(P->ws + OFF_S5W) + ((size_t)g * 512 + nt * 64) * 640, 640, acc, ssd, smem);
    const int tid = otid(wv), lane = tid & 63, wid = tid >> 6;
    const h16* proj = (const h16*)(P->ws + OFF_PROJ);
    h16* yact = (h16*)(P->ws + OFF_YACT);
#pragma unroll
    for (int i = 0; i < 2; ++i) {
        const size_t ch = (size_t)mt * 128 + wid * 32 + i * 16 + (lane & 15);
#pragma unroll
        for (int jj = 0; jj < 4; ++jj) {
            const int n = nt * 64 + jj * 16 + (lane >> 4) * 4;
            const int j = n >> 4, c = n & 15;
            const size_t tok = ch * 32 + j;
            const half4 u4 = *(const half4*)(proj + tok * D_IN + C_SU + g * 16 + c);
            const float4 dd = *(const float4*)(P->in[I_SD] + (l * 16 + g) * 16 + c);
            const f32x4 v = acc[i][jj];
            half4 o;
            o[0] = (h16)gelu_tanh(v[0] + dd.x * (float)u4[0]);
            o[1] = (h16)gelu_tanh(v[1] + dd.y * (float)u4[1]);
            o[2] = (h16)gelu_tanh(v[2] + dd.z * (float)u4[2]);
            o[3] = (h16)gelu_tanh(v[3] + dd.w * (float)u4[3]);
            *(half4*)(yact + tok * 256 + g * 16 + c) = o;
        }
    }
}

#define MFMA32(a, b, c) __builtin_amdgcn_mfma_f32_32x32x16_f16((a), (b), (c), 0, 0, 0)
constexpr float FAST_SHIFT = 4.f;
constexpr float NEGS = -1e30f;
DI float ex2(float x) { return __builtin_amdgcn_exp2f(x); }
#define NSA_WAITBAR(N) asm volatile("s_waitcnt vmcnt(" #N ") lgkmcnt(0)\n\ts_barrier" ::: "memory")
#define NSA_BAR() asm volatile("s_waitcnt lgkmcnt(0)\n\ts_barrier" ::: "memory")

struct KVSrc { const h16* k; int ldk; size_t kstep; const h16* v; };
DI void nsa_dma(const KVSrc& s, int j, char* stage, int wid, int lane) {
    const int row0 = wid * 8 + (lane >> 3);
    const int sw = ((lane & 7) ^ ((row0 >> 1) & 7)) * 8;
    const h16* kp = s.k + (size_t)j * s.kstep + (size_t)row0 * s.ldk + sw;
    glds16(kp, stage + wid * 1024);
    glds16(kp + (size_t)32 * s.ldk, stage + 4096 + wid * 1024);
    const h16* vp = s.v + (size_t)j * 4096 + row0 * 64 + sw;
    glds16(vp, stage + 8192 + wid * 1024);
    glds16(vp + 32 * 64, stage + 8192 + 4096 + wid * 1024);
}
template <int NST, class F>
DI void nsa_pipe(const KVSrc& s, const int n, char* smem, int wid, int lane, F&& compute) {
    NSA_WAITBAR(0);
    {
        const int k = n < NST - 1 ? n : NST - 1;
        for (int p = 0; p < k; ++p) nsa_dma(s, p, smem + p * 16384, wid, lane);
        if (k >= 3) NSA_WAITBAR(8); else if (k == 2) NSA_WAITBAR(4); else NSA_WAITBAR(0);
        __builtin_amdgcn_s_sleep(2);
    }
    for (int j = 0; j < n; ++j) {
        if (NST == 4 && j + 2 < n) NSA_WAITBAR(4); else NSA_WAITBAR(0);
        const int jn = j + NST - 1;
        compute(j, smem + (j % NST) * 16384, [&]() { if (jn < n) nsa_dma(s, jn, smem + (jn % NST) * 16384, wid, lane); });
    }
}

template <bool SHIFT = false, class BF>
DI void qk_tile(const char* Kimg, const half8 (&qf)[4], f32x16 (&s)[2], int lane, BF&& between) {
    const int r = lane & 31, h = lane >> 5, swz = (r >> 1) & 7;
    const char* base = Kimg + r * 128;
    half8 kf[8];
#pragma unroll
    for (int kt = 0; kt < 2; ++kt)
#pragma unroll
        for (int ks = 0; ks < 4; ++ks) kf[kt * 4 + ks] = *(const half8*)(base + kt * 4096 + (((2 * ks + h) ^ swz) << 4));
    __builtin_amdgcn_sched_barrier(0);
    between();
    __builtin_amdgcn_sched_barrier(0);
#pragma unroll
    for (int kt = 0; kt < 2; ++kt) {
#pragma unroll
        for (int e = 0; e < 16; ++e) s[kt][e] = SHIFT ? -FAST_SHIFT : 0.f;
        __builtin_amdgcn_s_setprio(1);
#pragma unroll
        for (int ks = 0; ks < 4; ++ks) s[kt] = MFMA32(kf[kt * 4 + ks], qf[ks], s[kt]);
        __builtin_amdgcn_s_setprio(0);
    }
}
template <bool SHIFT = false>
DI void qk_tile(const char* Kimg, const half8 (&qf)[4], f32x16 (&s)[2], int lane) { qk_tile<SHIFT>(Kimg, qf, s, lane, []() {}); }
template <int S> DI half8 pack8(const f32x16& x) {
    return (half8){(h16)x[8 * S], (h16)x[8 * S + 1], (h16)x[8 * S + 2], (h16)x[8 * S + 3], (h16)x[8 * S + 4], (h16)x[8 * S + 5], (h16)x[8 * S + 6], (h16)x[8 * S + 7]};
}
DI half8 ld_vfrag(const char* Vimg, int off0) {
    const half4 lo = *(const half4*)(Vimg + off0), hi = *(const half4*)(Vimg + (off0 ^ 16));
    return (half8){lo[0], lo[1], lo[2], lo[3], hi[0], hi[1], hi[2], hi[3]};
}
template <int KT>
DI void pv_load(const char* Vimg, half8 (&vf)[4], int lane) {
    const int r = lane & 31, h = lane >> 5, swz16 = ((r >> 1) & 7) << 4;
    const char* rb = Vimg + r * 128 + 8 * (h ^ ((r >> 4) & 1));
#pragma unroll
    for (int dt = 0; dt < 2; ++dt) {
        vf[dt * 2 + 0] = ld_vfrag(rb + dt * 4096, ((4 * KT) << 4) ^ swz16);
        vf[dt * 2 + 1] = ld_vfrag(rb + dt * 4096, ((4 * KT + 2) << 4) ^ swz16);
    }
}
typedef unsigned u32x4_ __attribute__((ext_vector_type(4)));
template <int KT, bool MASKED = false>
DI void pv_mma(const half8 (&vf)[4], const f32x16 (&p)[2], f32x16 (&o)[2], const unsigned rmask = 0xffffffffu) {
    half8 pb0 = pack8<0>(p[KT]), pb1 = pack8<1>(p[KT]);
    if (MASKED) {
        pb0 = __builtin_bit_cast(half8, __builtin_bit_cast(u32x4_, pb0) & rmask);
        pb1 = __builtin_bit_cast(half8, __builtin_bit_cast(u32x4_, pb1) & rmask);
    }
    __builtin_amdgcn_s_setprio(1);
#pragma unroll
    for (int dt = 0; dt < 2; ++dt) {
        o[dt] = MFMA32(vf[dt * 2 + 0], pb0, o[dt]);
        o[dt] = MFMA32(vf[dt * 2 + 1], pb1, o[dt]);
    }
    __builtin_amdgcn_s_setprio(0);
}
template <bool MASKED = false>
DI void pv_finish(const char* Vimg, const half8 (&va)[4], const f32x16 (&p)[2], f32x16 (&o)[2], int lane, const unsigned rmask = 0xffffffffu) {
    half8 vb[4];
    pv_load<1>(Vimg, vb, lane);
    pv_mma<0, MASKED>(va, p, o, rmask);
    pv_mma<1, MASKED>(vb, p, o, rmask);
}
DI float sm_fast(f32x16 (&s)[2]) {
    float rs = 0.f;
#pragma unroll
    for (int kt = 0; kt < 2; ++kt)
#pragma unroll
        for (int e = 0; e < 16; ++e) { const float p = ex2(s[kt][e]); s[kt][e] = p; rs += p; }
    return rs;
}
DI float xhalf_max(float v) {
    const auto r = __builtin_amdgcn_permlane32_swap(__float_as_uint(v), __float_as_uint(v), false, false);
    return fmaxf(__uint_as_float(r[0]), __uint_as_float(r[1]));
}
DI float xhalf_sum(float v) {
    const auto r = __builtin_amdgcn_permlane32_swap(__float_as_uint(v), __float_as_uint(v), false, false);
    return __uint_as_float(r[0]) + __uint_as_float(r[1]);
}
DI float rowmax32(const f32x16 (&s)[2]) {
    float mx = s[0][0];
#pragma unroll
    for (int e = 1; e < 16; ++e) mx = fmaxf(mx, s[0][e]);
#pragma unroll
    for (int e = 0; e < 16; ++e) mx = fmaxf(mx, s[1][e]);
    return xhalf_max(mx);
}
constexpr float SM_THR = 6.f;
DI void sm_online(f32x16 (&s)[2], float& m, float& l, f32x16 (&o)[2], const bool rowok) {
    float mx = rowmax32(s);
    mx = rowok ? mx : NEGS;
    if (__any(mx > m + SM_THR)) {
        const float mn = fmaxf(m, mx), alpha = ex2(m - mn);
        l *= alpha; o[0] *= alpha; o[1] *= alpha; m = mn;
    }
    const float msub = rowok ? m : 1e30f;
    float rs = 0.f;
#pragma unroll
    for (int kt = 0; kt < 2; ++kt)
#pragma unroll
        for (int e = 0; e < 16; ++e) { const float p = ex2(s[kt][e] - msub); s[kt][e] = p; rs += p; }
    l += xhalf_sum(rs);
}

template <int V> struct IC { static constexpr int value = V; };
template <bool FAST>
DI void nsa_unit(PP P, int l, int bg, int c32, char* smem, const int wv) {
    P = plaunder(P);
    const int tid = otid(wv), lane = tid & 63, w = tid >> 6, r = lane & 31, h = lane >> 5;
    const int b = bg >> 1, g = bg & 1, t0 = c32 * 32, cur = c32 >> 1;
    const int tokl = w * 8 + (r >> 2), head = r & 3, t = t0 + tokl;
    const size_t tokg = (size_t)b * SEQ + t;
    float* IMP = (float*)(smem + 49152);
    unsigned* SELM = (unsigned*)(smem + 49152);
    const h16* proj = (const h16*)(P->ws + OFF_PROJ);
    const int ghead = g * 4 + head;

    half8 qf[4];
    {
        const h16* qp = proj + tokg * D_IN + C_NQ + ghead * 64 + 8 * h;
#pragma unroll
        for (int ks = 0; ks < 4; ++ks) qf[ks] = *(const half8*)(qp + 16 * ks);
    }
    float g0, g1, g2;
    {
        const h16* gp = proj + tokg * D_IN + C_NGL + ghead * 3;
        const float* gb = P->in[I_NGB] + l * 24 + ghead * 3;
        g0 = sigmoidf_((float)gp[0] + gb[0]); g1 = sigmoidf_((float)gp[1] + gb[1]); g2 = sigmoidf_((float)gp[2] + gb[2]);
    }
    __syncthreads();
    for (int i = tid; i < 32 * 128; i += 256) IMP[i] = 0.f;

    half8 oacc[4];
    auto oacc_add = [&](const f32x16 (&o)[2], const float sc, const bool first) {
#pragma unroll
        for (int dt = 0; dt < 2; ++dt)
#pragma unroll
            for (int hf = 0; hf < 2; ++hf) {
                half8 v = oacc[dt * 2 + hf];
#pragma unroll
                for (int e = 0; e < 8; ++e) v[e] = (h16)((first ? 0.f : (float)v[e]) + o[dt][hf * 8 + e] * sc);
                oacc[dt * 2 + hf] = v;
            }
    };

    {
        const int nvt = 2 * c32 + 1;
        const int nvr = (t >= 31) ? ((t - 31) >> 4) + 1 : 0;
        const int ntile = (nvt + 63) >> 6;
        KVSrc src{(const h16*)(P->ws + OFF_KCMP) + (size_t)bg * 512 * 64, 64, 4096, (const h16*)(P->ws + OFF_VCMP) + (size_t)bg * 8 * 4096};
        f32x16 o[2];
#pragma unroll
        for (int e = 0; e < 16; ++e) { o[0][e] = 0.f; o[1][e] = 0.f; }
        float invl;
        if constexpr (FAST) {
            const int tf = t0 + w * 8;
            const int nvlo = __builtin_amdgcn_readfirstlane((tf >= 31) ? ((tf - 31) >> 4) + 1 : 0);
            float lsum = 0.f;
            nsa_pipe<3>(src, ntile, smem, w, lane, [&](int j, const char* st, auto&& issue) {
                f32x16 s[2];
                qk_tile<true>(st, qf, s, lane);
                issue();
                if (64 * j + 64 > nvlo) {
#pragma unroll
                    for (int kt = 0; kt < 2; ++kt)
#pragma unroll
                        for (int e = 0; e < 16; ++e) {
                            const int key = 64 * j + 32 * kt + 8 * (e >> 2) + 4 * h + (e & 3);
                            if (key >= nvr) s[kt][e] = NEGS;
                        }
                }
                lsum += sm_fast(s);
            });
            lsum = xhalf_sum(lsum);
            invl = lsum > 0.f ? 1.f / lsum : 0.f;
            nsa_pipe<3>(src, ntile, smem, w, lane, [&](int j, const char* st, auto&& issue) {
                f32x16 s[2];
                qk_tile<true>(st, qf, s, lane);
                half8 vf[4];
                pv_load<0>(st + 8192, vf, lane);
                issue();
                __builtin_amdgcn_sched_barrier(0);
                if (64 * j + 64 > nvlo) {
#pragma unroll
                    for (int kt = 0; kt < 2; ++kt)
#pragma unroll
                        for (int e = 0; e < 16; ++e) {
                            const int key = 64 * j + 32 * kt + 8 * (e >> 2) + 4 * h + (e & 3);
                            if (key >= nvr) s[kt][e] = NEGS;
                        }
                }
                (void)sm_fast(s);
                if (cur >= 16) {
#pragma unroll
                    for (int kt = 0; kt < 2; ++kt)
#pragma unroll
                        for (int g4 = 0; g4 < 4; ++g4) {
                            float G = ((s[kt][4 * g4] + s[kt][4 * g4 + 1]) + (s[kt][4 * g4 + 2] + s[kt][4 * g4 + 3])) * invl;
                            float L = s[kt][4 * g4 + 3] * invl;
                            G += __shfl_xor(G, 1); G += __shfl_xor(G, 2);
                            L += __shfl_xor(L, 1); L += __shfl_xor(L, 2);
                            if (head == 0) {
                                const int sb = 16 * j + 8 * kt + 2 * g4 + h;
                                atomicAdd(&IMP[tokl * 128 + sb], G);
                                if (sb + 1 < 128) atomicAdd(&IMP[tokl * 128 + sb + 1], L);
                            }
                        }
                }
                pv_finish(st + 8192, vf, s, o, lane);
            });
        } else {
        float m = -1e20f, lsum = 0.f;
        nsa_pipe<3>(src, ntile, smem, w, lane, [&](int j, const char* st, auto&& issue) {
            f32x16 s[2];
            qk_tile(st, qf, s, lane);
            issue();
#pragma unroll
            for (int kt = 0; kt < 2; ++kt)
#pragma unroll
                for (int e = 0; e < 16; ++e) {
                    const int key = 64 * j + 32 * kt + 8 * (e >> 2) + 4 * h + (e & 3);
                    if (key >= nvr) s[kt][e] = NEGS;
                }
            const float mn = fmaxf(m, rowmax32(s)), alpha = ex2(m - mn);
            float rs = 0.f;
#pragma unroll
            for (int kt = 0; kt < 2; ++kt)
#pragma unroll
                for (int e = 0; e < 16; ++e) rs += ex2(s[kt][e] - mn);
            rs = xhalf_sum(rs);
            lsum = lsum * alpha + rs; m = mn;
        });
        const float invl_s = lsum > 0.f ? 1.f / lsum : 0.f;
        nsa_pipe<3>(src, ntile, smem, w, lane, [&](int j, const char* st, auto&& issue) {
            f32x16 s[2];
            qk_tile(st, qf, s, lane);
            half8 vf[4];
            pv_load<0>(st + 8192, vf, lane);
            issue();
            __builtin_amdgcn_sched_barrier(0);
#pragma unroll
            for (int kt = 0; kt < 2; ++kt)
#pragma unroll
                for (int e = 0; e < 16; ++e) {
                    const int key = 64 * j + 32 * kt + 8 * (e >> 2) + 4 * h + (e & 3);
                    s[kt][e] = (key < nvr) ? ex2(s[kt][e] - m) * invl_s : 0.f;
                }
            if (cur >= 16) {
#pragma unroll
                for (int kt = 0; kt < 2; ++kt)
#pragma unroll
                    for (int g4 = 0; g4 < 4; ++g4) {
                        float G = (s[kt][4 * g4] + s[kt][4 * g4 + 1]) + (s[kt][4 * g4 + 2] + s[kt][4 * g4 + 3]);
                        float L = s[kt][4 * g4 + 3];
                        G += __shfl_xor(G, 1); G += __shfl_xor(G, 2);
                        L += __shfl_xor(L, 1); L += __shfl_xor(L, 2);
                        if (head == 0) {
                            const int sb = 16 * j + 8 * kt + 2 * g4 + h;
                            atomicAdd(&IMP[tokl * 128 + sb], G);
                            if (sb + 1 < 128) atomicAdd(&IMP[tokl * 128 + sb + 1], L);
                        }
                    }
            }
            pv_finish(st + 8192, vf, s, o, lane);
        });
            invl = 1.f;
        }
        oacc_add(o, g0 * invl, true);
    }
    __syncthreads();
    {
        const int tl = lane >> 3, sub = lane & 7;
        unsigned bits = 0;
        unsigned u[16];
        if (cur >= 16) {
            const float* ip = IMP + (w * 8 + tl) * 128 + sub * 16;
#pragma unroll
            for (int i = 0; i < 16; ++i) {
                const int s = sub * 16 + i;
                u[i] = (s >= 1 && s <= cur - 2) ? (__float_as_uint(ip[i]) + 1u) : 0u;
            }
        }
        __syncthreads();
        if (cur >= 16) {
            unsigned prefix = 0;
            for (int bit = 30; bit >= 0; --bit) {
                const unsigned cand = prefix | (1u << bit);
                int cnt = 0;
#pragma unroll
                for (int i = 0; i < 16; ++i) cnt += (u[i] >= cand) ? 1 : 0;
                cnt += __shfl_xor(cnt, 1); cnt += __shfl_xor(cnt, 2); cnt += __shfl_xor(cnt, 4);
                if (cnt >= 13) prefix = cand;
            }
            int cgt = 0, ceq = 0;
#pragma unroll
            for (int i = 0; i < 16; ++i) { cgt += (u[i] > prefix) ? 1 : 0; ceq += (u[i] == prefix) ? 1 : 0; }
            cgt += __shfl_xor(cgt, 1); cgt += __shfl_xor(cgt, 2); cgt += __shfl_xor(cgt, 4);
            int inc = ceq;
            { const int v = __shfl_up(inc, 1); if (sub >= 1) inc += v; }
            { const int v = __shfl_up(inc, 2); if (sub >= 2) inc += v; }
            { const int v = __shfl_up(inc, 4); if (sub >= 4) inc += v; }
            int run = inc - ceq;
            const int need = 13 - cgt;
#pragma unroll
            for (int i = 0; i < 16; ++i) {
                const int s = sub * 16 + i;
                bool sel = u[i] > prefix;
                if (u[i] == prefix) { sel = run < need; ++run; }
                if (s == 0 || s == cur || s == cur - 1) sel = true;
                bits |= (sel ? 1u : 0u) << i;
            }
        } else {
#pragma unroll
            for (int i = 0; i < 16; ++i) bits |= ((sub * 16 + i <= cur) ? 1u : 0u) << i;
        }
        unsigned wv = bits << ((sub & 1) * 16);
        wv |= __shfl_xor(wv, 1);
        if ((sub & 1) == 0) SELM[(w * 8 + tl) * 4 + (sub >> 1)] = wv;
    }
    __syncthreads();
    unsigned selw[4];
#pragma unroll
    for (int i = 0; i < 4; ++i) selw[i] = SELM[tokl * 4 + i];

    auto branch = [&](auto BRC) {
        constexpr int br = decltype(BRC)::value;
        const int j0 = (br == 0) ? 0 : (cur - 8 > 0 ? cur - 8 : 0);
        const int nst = cur - j0 + 1;
        KVSrc src{proj + ((size_t)b * SEQ + (size_t)j0 * 64) * D_IN + C_NKV + (br == 0 ? 256 : 512) + g * 64, D_IN, (size_t)64 * D_IN,
                  (const h16*)(P->ws + OFF_VTG) + (((size_t)br * 4 + bg) * 128 + j0) * 4096};
        float m = -1e20f, lsum = 0.f;
        f32x16 o[2];
#pragma unroll
        for (int e = 0; e < 16; ++e) { o[0][e] = 0.f; o[1][e] = 0.f; }
        nsa_pipe<4>(src, nst, smem, w, lane, [&](int jj, const char* st, auto&& issue) {
            const int j = j0 + jj;
            const bool rowok = (br != 0) || (((selw[j >> 5] >> (j & 31)) & 1u) != 0u);
            if constexpr (FAST && br == 0) {
                if (!__any(rowok)) { issue(); return; }
            }
            f32x16 s[2];
            qk_tile<FAST>(st, qf, s, lane, issue);
            half8 vf[4];
            pv_load<0>(st + 8192, vf, lane);
            __builtin_amdgcn_sched_barrier(0);
            if (j == cur || (br == 1 && j == cur - 8)) {
#pragma unroll
                for (int kt = 0; kt < 2; ++kt)
#pragma unroll
                    for (int e = 0; e < 16; ++e) {
                        const int key = 64 * j + 32 * kt + 8 * (e >> 2) + 4 * h + (e & 3);
                        const bool ok = (key <= t) && (br == 0 || key > t - 512);
                        if (!ok) s[kt][e] = NEGS;
                    }
            }
            if constexpr (FAST) {
                const float rs = sm_fast(s);
                lsum += (br != 0 || rowok) ? rs : 0.f;
                pv_finish<br == 0>(st + 8192, vf, s, o, lane, rowok ? 0xffffffffu : 0u);
            } else {
                sm_online(s, m, lsum, o, rowok);
                pv_finish(st + 8192, vf, s, o, lane);
            }
        });
        if constexpr (FAST) lsum = xhalf_sum(lsum);
        const float sc = (br == 0 ? g1 : g2) / lsum;
        oacc_add(o, sc, false);
    };
    branch(IC<0>{});
    branch(IC<1>{});
    {
        h16* mixp = (h16*)(P->ws + OFF_MIX) + kb_idx(NT, tokg, 512 + ghead * 64);
        const h16* ngp = proj + tokg * D_IN + C_NG + ghead * 64;
#pragma unroll
        for (int dt = 0; dt < 2; ++dt)
#pragma unroll
            for (int g4 = 0; g4 < 4; ++g4) {
                const int d0 = 32 * dt + 8 * g4 + 4 * h;
                const half4 ng = *(const half4*)(ngp + d0);
                half4 ov;
#pragma unroll
                for (int e = 0; e < 4; ++e) ov[e] = (h16)((float)oacc[dt * 2 + (g4 >> 1)][(g4 & 1) * 4 + e] * siluf_((float)ng[e]));
                *(half4*)(mixp + d0) = ov;
            }
    }
    __syncthreads();
}

DI void gla_kv_item(PP P, int l, int item, char* smem, const int wv) {
    P = plaunder(P);
    const int tid = otid(wv), lane = tid & 63, w = tid >> 6, r = lane & 31, hh = lane >> 5;
    const int pair = item * 4 + w, h = pair & 3, cn = pair >> 2;
    const size_t tok = (size_t)cn * 32 + r;
    const int b = cn >> 8, n = cn & 255, bh = b * 4 + h;
    const h16* proj = (const h16*)(P->ws + OFF_PROJ);
    h16* VT = (h16*)(smem + w * 16384);
    h16* KT = VT + 2048;
    __syncthreads();
    {
        const half8* vp = (const half8*)(proj + tok * D_IN + C_GV + h * 64 + hh * 32);
#pragma unroll
        for (int q = 0; q < 4; ++q) {
            const half8 v8 = vp[q];
#pragma unroll
            for (int e = 0; e < 8; ++e) VT[(hh * 32 + q * 8 + e) * 32 + r] = v8[e];
        }
    }
    float gl[16];
    {
        const half8* lp = (const half8*)(proj + tok * D_IN + C_GLR);
        const half8 l0 = lp[0], l1 = lp[1];
        float lr[16];
#pragma unroll
        for (int q = 0; q < 8; ++q) { lr[q] = (float)l0[q]; lr[8 + q] = (float)l1[q]; }
        const float* w2 = P->in[I_GW2] + (size_t)l * 16 * 128 + h * 32 + 16 * hh;
        const float* b2 = P->in[I_GB2] + l * 128 + h * 32 + 16 * hh;
#pragma unroll
        for (int d = 0; d < 16; ++d) gl[d] = b2[d];
#pragma unroll
        for (int q = 0; q < 16; ++q)
#pragma unroll
            for (int d4 = 0; d4 < 4; ++d4) {
                const float4 wq = *(const float4*)(w2 + q * 128 + d4 * 4);
                gl[d4 * 4 + 0] += lr[q] * wq.x; gl[d4 * 4 + 1] += lr[q] * wq.y; gl[d4 * 4 + 2] += lr[q] * wq.z; gl[d4 * 4 + 3] += lr[q] * wq.w;
            }
#pragma unroll
        for (int d = 0; d < 16; ++d) gl[d] = log_sigmoidf_(gl[d]) * (1.f / 16.f);
    }
#pragma unroll
    for (int off = 1; off < 32; off <<= 1) {
#pragma unroll
        for (int d = 0; d < 16; ++d) { const float v = __shfl_up(gl[d], off, 32); if (r >= off) gl[d] += v; }
    }
    {
        float* bc = (float*)(P->ws + OFF_BCUM) + tok * 128 + h * 32 + 16 * hh;
#pragma unroll
        for (int d4 = 0; d4 < 4; ++d4) *(float4*)(bc + d4 * 4) = (float4){gl[d4 * 4], gl[d4 * 4 + 1], gl[d4 * 4 + 2], gl[d4 * 4 + 3]};
    }
    {
        const half8* kp = (const half8*)(proj + tok * D_IN + C_GK + h * 32 + 16 * hh);
        const half8 k0 = kp[0], k1 = kp[1];
        float bl[16];
#pragma unroll
        for (int d = 0; d < 16; ++d) bl[d] = __shfl(gl[d], 31, 32);
#pragma unroll
        for (int d = 0; d < 16; ++d) {
            const float kd = (float)(d < 8 ? k0[d & 7] : k1[d & 7]) * __expf(bl[d] - gl[d]);
            KT[(16 * hh + d) * 32 + r] = (h16)kd;
        }
        if (r == 0) {
            float* dc = (float*)(P->ws + OFF_GDEC) + (size_t)(bh * 256 + n) * 32 + 16 * hh;
#pragma unroll
            for (int d4 = 0; d4 < 4; ++d4) *(float4*)(dc + d4 * 4) = (float4){__expf(bl[d4 * 4]), __expf(bl[d4 * 4 + 1]), __expf(bl[d4 * 4 + 2]), __expf(bl[d4 * 4 + 3])};
        }
    }
    asm volatile("s_waitcnt lgkmcnt(0)" ::: "memory");
    const half8 kb0 = *(const half8*)(KT + r * 32 + 8 * hh), kb1 = *(const half8*)(KT + r * 32 + 16 + 8 * hh);
    float* kvp = (float*)(P->ws + OFF_GKV) + ((size_t)(bh * 256 + n) * 32 + r) * 64;
#pragma unroll
    for (int dt = 0; dt < 2; ++dt) {
        f32x16 o;
#pragma unroll
        for (int e = 0; e < 16; ++e) o[e] = 0.f;
        const h16* vrow = VT + (32 * dt + r) * 32 + 8 * hh;
        o = MFMA32(*(const half8*)vrow, kb0, o);
        o = MFMA32(*(const half8*)(vrow + 16), kb1, o);
#pragma unroll
        for (int g4 = 0; g4 < 4; ++g4)
            *(float4*)(kvp + 32 * dt + 8 * g4 + 4 * hh) = (float4){o[4 * g4], o[4 * g4 + 1], o[4 * g4 + 2], o[4 * g4 + 3]};
    }
    __syncthreads();
}

DI void gla_out_item(PP P, int l, int item, char* smem, const int wv) {
    P = plaunder(P);
    const int tid = otid(wv), lane = tid & 63, w = tid >> 6, r = lane & 31, hh = lane >> 5;
    const int pair = item * 4 + w, h = pair & 3, cn = pair >> 2;
    const size_t tok0 = (size_t)cn * 32, tok = tok0 + r;
    const int b = cn >> 8, n = cn & 255, bh = b * 4 + h;
    const h16* proj = (const h16*)(P->ws + OFF_PROJ);
    h16* VT = (h16*)(smem + w * 16384);
    h16* SPT = VT + 2048;
    __syncthreads();
    {
        const half8* vp = (const half8*)(proj + tok * D_IN + C_GV + h * 64 + hh * 32);
        const float4* sp = (const float4*)((const float*)(P->ws + OFF_GKV) + ((size_t)(bh * 256 + n) * 32 + r) * 64 + hh * 32);
#pragma unroll
        for (int q = 0; q < 4; ++q) {
            const half8 v8 = vp[q];
            const float4 s0 = sp[2 * q], s1 = sp[2 * q + 1];
#pragma unroll
            for (int e = 0; e < 8; ++e) VT[(hh * 32 + q * 8 + e) * 32 + r] = v8[e];
            SPT[(hh * 32 + q * 8 + 0) * 32 + r] = (h16)s0.x; SPT[(hh * 32 + q * 8 + 1) * 32 + r] = (h16)s0.y;
            SPT[(hh * 32 + q * 8 + 2) * 32 + r] = (h16)s0.z; SPT[(hh * 32 + q * 8 + 3) * 32 + r] = (h16)s0.w;
            SPT[(hh * 32 + q * 8 + 4) * 32 + r] = (h16)s1.x; SPT[(hh * 32 + q * 8 + 5) * 32 + r] = (h16)s1.y;
            SPT[(hh * 32 + q * 8 + 6) * 32 + r] = (h16)s1.z; SPT[(hh * 32 + q * 8 + 7) * 32 + r] = (h16)s1.w;
        }
    }
    half8 qe[2], ke[2];
#pragma unroll
    for (int ks = 0; ks < 2; ++ks) {
        const int d0 = 16 * ks + 8 * hh;
        const half8 q8 = *(const half8*)(proj + tok * D_IN + C_GQ + h * 32 + d0);
        const half8 k8 = *(const half8*)(proj + tok * D_IN + C_GK + h * 32 + d0);
        const float4 b0 = *(const float4*)((const float*)(P->ws + OFF_BCUM) + tok * 128 + h * 32 + d0);
        const float4 b1 = *(const float4*)((const float*)(P->ws + OFF_BCUM) + tok * 128 + h * 32 + d0 + 4);
        const float bc[8] = {b0.x, b0.y, b0.z, b0.w, b1.x, b1.y, b1.z, b1.w};
#pragma unroll
        for (int e = 0; e < 8; ++e) {
            const float ex = __expf(bc[e]);
            qe[ks][e] = (h16)((float)q8[e] * 0.17677669529663687f * ex);
            ke[ks][e] = (h16)((float)k8[e] * __builtin_amdgcn_rcpf(ex));
        }
    }
    f32x16 s;
#pragma unroll
    for (int e = 0; e < 16; ++e) s[e] = 0.f;
    s = MFMA32(ke[0], qe[0], s);
    s = MFMA32(ke[1], qe[1], s);
#pragma unroll
    for (int e = 0; e < 16; ++e) { const int j = (e & 3) + 8 * (e >> 2) + 4 * hh; if (j > r) s[e] = 0.f; }
    const half8 pb0 = pack8<0>(s), pb1 = pack8<1>(s);
    asm volatile("s_waitcnt lgkmcnt(0)" ::: "memory");
    f32x16 o[2];
#pragma unroll
    for (int dt = 0; dt < 2; ++dt) {
#pragma unroll
        for (int e = 0; e < 16; ++e) o[dt][e] = 0.f;
        const h16* vrow = VT + (32 * dt + r) * 32 + 4 * hh;
        const h16* srow = SPT + (32 * dt + r) * 32 + 8 * hh;
        {
            const half4 lo = *(const half4*)vrow, hi = *(const half4*)(vrow + 8);
            o[dt] = MFMA32(((half8){lo[0], lo[1], lo[2], lo[3], hi[0], hi[1], hi[2], hi[3]}), pb0, o[dt]);
        }
        {
            const half4 lo = *(const half4*)(vrow + 16), hi = *(const half4*)(vrow + 24);
            o[dt] = MFMA32(((half8){lo[0], lo[1], lo[2], lo[3], hi[0], hi[1], hi[2], hi[3]}), pb1, o[dt]);
        }
        o[dt] = MFMA32(*(const half8*)srow, qe[0], o[dt]);
        o[dt] = MFMA32(*(const half8*)(srow + 16), qe[1], o[dt]);
    }
    float ss = 0.f;
#pragma unroll
    for (int e = 0; e < 16; ++e) ss += o[0][e] * o[0][e] + o[1][e] * o[1][e];
    ss = xhalf_sum(ss);
    const float rn = rsqrtf(ss * (1.f / 64.f) + 1e-6f);
    h16* mix = (h16*)(P->ws + OFF_MIX);
#pragma unroll
    for (int dt = 0; dt < 2; ++dt)
#pragma unroll
        for (int g4 = 0; g4 < 4; ++g4) {
            const int e0 = 32 * dt + 8 * g4 + 4 * hh;
            const half4 gt = *(const half4*)(proj + tok * D_IN + C_GG + h * 64 + e0);
            const float4 on = *(const float4*)(P->in[I_GON] + l * 64 + e0);
            half4 ov;
            ov[0] = (h16)(o[dt][4 * g4 + 0] * rn * on.x * siluf_((float)gt[0]));
            ov[1] = (h16)(o[dt][4 * g4 + 1] * rn * on.y * siluf_((float)gt[1]));
            ov[2] = (h16)(o[dt][4 * g4 + 2] * rn * on.z * siluf_((float)gt[2]));
            ov[3] = (h16)(o[dt][4 * g4 + 3] * rn * on.w * siluf_((float)gt[3]));
            *(half4*)(mix + kb_idx(NT, tok, h * 64 + e0)) = ov;
        }
    __syncthreads();
}

DI void glu_tile(PP P, int l, int tile, char* smem, const int wv) {
    P = plaunder(P);
    const int mt = tile >> 2, nt = tile & 3;
    f32x4 acc[4][4];
    float ssd[4];
    gemm_mainloop_glds<false>(wv, 256, APlain{(const h16*)(P->ws + OFF_YACT) + (size_t)mt * 128 * 256, 256, 64},
                              (const h16*)(P->ws + OFF_WTGLU) + ((size_t)l * 512 + nt * 128) * 256, 256, acc, ssd, smem);
    const int tid = otid(wv), lane = tid & 63, wid = tid >> 6, wr = wid >> 1, wc = wid & 1;
    const h16* proj = (const h16*)(P->ws + OFF_PROJ);
    h16* mix = (h16*)(P->ws + OFF_MIX);
    const float* gb = P->in[I_GLUB] + l * 512;
#pragma unroll
    for (int i = 0; i < 4; ++i) {
        const size_t tok = (size_t)mt * 128 + wr * 64 + i * 16 + (lane & 15);
#pragma unroll
        for (int pj = 0; pj < 2; ++pj) {
            const int c = nt * 64 + wc * 32 + pj * 16 + (lane >> 4) * 4;
            const f32x4 z1 = acc[i][2 * pj], z2 = acc[i][2 * pj + 1];
            const float4 b1 = *(const float4*)(gb + c), b2 = *(const float4*)(gb + 256 + c);
            const half4 g4 = *(const half4*)(proj + tok * D_IN + C_SG + c);
            half4 o;
            o[0] = (h16)((z1[0] + b1.x) * sigmoidf_(z2[0] + b2.x) * siluf_((float)g4[0]));
            o[1] = (h16)((z1[1] + b1.y) * sigmoidf_(z2[1] + b2.y) * siluf_((float)g4[1]));
            o[2] = (h16)((z1[2] + b1.z) * sigmoidf_(z2[2] + b2.z) * siluf_((float)g4[2]));
            o[3] = (h16)((z1[3] + b1.w) * sigmoidf_(z2[3] + b2.w) * siluf_((float)g4[3]));
            *(half4*)(mix + kb_idx(NT, tok, 256 + c)) = o;
        }
    }
}

DI void outproj_tile(PP P, int l, int mt, int nt, char* smem, const int wv) {
    P = plaunder(P);
    f32x4 acc[8][4];
    float ssd[8];
    gemm_glds<false, 2, 8, 4, 3>(wv, 1024, APlain{(const h16*)(P->ws + OFF_MIX) + (size_t)mt * 256 * 64, 64, (size_t)NT * 64},
                              (const h16*)(P->ws + OFF_WTOUT) + ((size_t)l * 16 * 1024 + nt * 128) * 64, 64, acc, ssd, smem, (size_t)1024 * 64);
    const int tid = otid(wv), lane = tid & 63, wid = tid >> 6, wr = wid >> 1, wc = wid & 1;
    const float* xin = (l == 0) ? P->in[I_X] : P->out;
    h16* xh = (h16*)(P->ws + OFF_XH);
#pragma unroll
    for (int i = 0; i < 8; ++i) {
        const size_t row = (size_t)mt * 256 + wr * 128 + i * 16 + (lane & 15);
#pragma unroll
        for (int jj = 0; jj < 4; ++jj) {
            const int n = nt * 128 + wc * 64 + jj * 16 + (lane >> 4) * 4;
            const f32x4 v = acc[i][jj];
            const float4 xo = *(const float4*)(xin + row * 1024 + n);
            const float4 xn = (float4){xo.x + v[0], xo.y + v[1], xo.z + v[2], xo.w + v[3]};
            *(float4*)(P->out + row * 1024 + n) = xn;
            *(half4*)(xh + kb_idx(NT, row, n)) = (half4){(h16)xn.x, (h16)xn.y, (h16)xn.z, (h16)xn.w};
        }
    }
}

#define XB_TMO      128
#define XB_XCNT(j)  (256  + 64 * (j))
#define XB_XSUB(j)  (1280 + 64 * (j))
#define XB_XGEN(j)  (2304 + 64 * (j))
#define XB_TOP      3328
#define XB_TOPGEN   3392
#define XCD_BAR_WORDS 3456
#define XB_SPIN_CAP (1u << 18)
#define LAS __attribute__((address_space(3)))

__device__ __forceinline__ unsigned xb_ld(unsigned* p)              { return __hip_atomic_load(p, __ATOMIC_RELAXED, __HIP_MEMORY_SCOPE_AGENT); }
__device__ __forceinline__ unsigned xb_add(unsigned* p, unsigned v) { return __hip_atomic_fetch_add(p, v, __ATOMIC_RELAXED, __HIP_MEMORY_SCOPE_AGENT); }
__device__ __forceinline__ unsigned xb_xcc_id() { return (unsigned)__builtin_amdgcn_s_getreg((3 << 11) | 20) & 0xFu; }
#define XB_SPIN(cond, bar) do { unsigned _sp = 0; while (cond) { __builtin_amdgcn_s_sleep(1); \
    if ((++_sp & 255u) == 0u) { if (xb_ld(&(bar)[XB_TMO])) break; if (_sp > XB_SPIN_CAP) { atomicAdd(&(bar)[XB_TMO], 1u); break; } } } } while (0)

struct XcdBarrier {
    unsigned* bar; unsigned x;
    volatile LAS unsigned* st;
};

__device__ __forceinline__ XcdBarrier xcd_barrier_post(unsigned* bar, volatile LAS unsigned* st) {
    XcdBarrier b; b.bar = bar; b.x = xb_xcc_id(); b.st = st;
    if (threadIdx.x == 0) (void)xb_add(&bar[XB_XCNT(b.x)], 1u);
    return b;
}
__device__ __forceinline__ void xcd_barrier_complete(unsigned* bar, unsigned x, unsigned& nloc, unsigned& nx) {
    const unsigned G = gridDim.x * gridDim.y * gridDim.z;
    unsigned sum, cnt, mine, sp = 0u;
    for (;;) {
        sum = 0u; cnt = 0u; mine = 0u;
#pragma unroll
        for (unsigned j = 0; j < 16; ++j) { const unsigned c = xb_ld(&bar[XB_XCNT(j)]); sum += c; cnt += (c > 0u) ? 1u : 0u; mine = (j == x) ? c : mine; }
        if (sum == G) break;
        __builtin_amdgcn_s_sleep(1);
        if ((++sp & 255u) == 0u) { if (xb_ld(&bar[XB_TMO])) break; if (sp > XB_SPIN_CAP) { atomicAdd(&bar[XB_TMO], 1u); break; } }
    }
    nloc = mine > 0u ? mine : 1u; nx = cnt > 0u ? cnt : 1u;
}

__device__ __forceinline__ void xcd_barrier(const XcdBarrier& b) {
    asm volatile("s_waitcnt vmcnt(0)" ::: "memory");
    __syncthreads();
    if (threadIdx.x == 0) {
        unsigned* bar = b.bar;
        __builtin_amdgcn_s_waitcnt(0);
        unsigned nloc = b.st[0], nx = b.st[1];
        if (nloc == 0u) { xcd_barrier_complete(bar, b.x, nloc, nx); b.st[0] = nloc; b.st[1] = nx; }
        const unsigned old = xb_add(&bar[XB_XSUB(b.x)], 1u);
        const unsigned gen = old / nloc;
        if (old + 1u == (gen + 1u) * nloc) {
            __builtin_amdgcn_fence(__ATOMIC_RELEASE, "agent");
            asm volatile("s_waitcnt vmcnt(0)" ::: "memory");
            const unsigned og = xb_add(&bar[XB_TOP], 1u);
            const unsigned tg = og / nx;
            if (og + 1u == (tg + 1u) * nx) xb_add(&bar[XB_TOPGEN], 1u);
            else XB_SPIN(xb_ld(&bar[XB_TOPGEN]) == tg, bar);
            __builtin_amdgcn_fence(__ATOMIC_ACQUIRE, "agent");
            xb_add(&bar[XB_XGEN(b.x)], 1u);
            asm volatile("s_waitcnt vmcnt(0)" ::: "memory");
        } else {
            XB_SPIN(xb_ld(&bar[XB_XGEN(b.x)]) == gen, bar);
            __builtin_amdgcn_fence(__ATOMIC_ACQUIRE, "agent");
            asm volatile("s_waitcnt vmcnt(0)" ::: "memory");
        }
    }
    __syncthreads();
}


__global__ void __launch_bounds__(NTHREADS, 2) fwd_megakernel(Params Pval) {
    PP P = (PP)__builtin_amdgcn_kernarg_segment_ptr();
    extern __shared__ __attribute__((aligned(16))) char smem[];
    cg::grid_group grid = cg::this_grid();
    const int G = gridDim.x, bid = blockIdx.x;
    const int wv = __builtin_amdgcn_readfirstlane((int)(threadIdx.x >> 6));

    uint4& xb_words = *(uint4*)(smem + SMEM_MAIN);
    if (otid(wv) == 0) xb_words = make_uint4(0u, 0u, 0u, 0u);
    __syncthreads();
    if (P->ws == nullptr) grid.sync();
    const XcdBarrier xb = xcd_barrier_post((unsigned*)(P->ws + OFF_BAR), (volatile LAS unsigned*)(smem + SMEM_MAIN));
    int vxcd = bid & 7, vjx = bid >> 3;
    {
        unsigned* xcnt = (unsigned*)(P->ws + OFF_BAR) + XCD_BAR_WORDS;
        volatile LAS unsigned* lw = (volatile LAS unsigned*)(smem + SMEM_MAIN) + 2;
        if (otid(wv) == 0) lw[0] = xb.x < 8u ? xb_add(&xcnt[xb.x], 1u) : 0xffffu;
        phase0(P, smem, wv);
        xcd_barrier(xb);
        if (otid(wv) == 0) {
            bool ok = (G & 7) == 0 && xb.x < 8u;
            for (int j = 0; j < 8; ++j) ok = ok && (xb_ld(&xcnt[j]) == (unsigned)(G >> 3));
            lw[1] = ok ? 1u : 0u;
        }
        __syncthreads();
        if (lw[1]) { vxcd = (int)xb.x; vjx = (int)lw[0]; }
    }
    vxcd = __builtin_amdgcn_readfirstlane(vxcd); vjx = __builtin_amdgcn_readfirstlane(vjx);

#pragma unroll 1
    for (int l = 0; l < DEPTH; ++l) {
        {
            const int xcd = vxcd, jx = vjx, nper = G >> 3;
            for (int u = jx; u < 192; u += nper) inproj_tile<2, 8>(P, l, (xcd * 8 + (u & 7)) * 256, (u >> 3) * 128, smem, wv);
            for (int it = jx; it < 16 + 40; it += nper) {
                if (it < 16) inproj_tile<4, 2>(P, l, (xcd * 16 + it) * 128, 3072, smem, wv);
                else s5_build_item(P, l, (it - 16) * 8 + xcd, smem, wv);
            }
        }
        xcd_barrier(xb);
#pragma unroll 1
        for (int w = bid; w < 128 + 64 + 512; w += G) {
            if (w < 128) cmp_gemm_tile(P, l, w, smem, wv);
            else if (w < 192) s5e_gemm_tile(P, l, w - 128, smem, wv);
            else gla_kv_item(P, l, w - 192, smem, wv);
        }
        xcd_barrier(xb);
#pragma unroll 1
        for (int w = bid; w < 512 + 512 + 64; w += G) {
            if (w < 512) cmp_l2_item(P, l, w, smem, wv);
            else if (w < 1024) gla_scan_item(P, w - 512, smem, wv);
            else s5_scan_item(P, w - 1024, smem, wv);
        }
        xcd_barrier(xb);
        bool nsa_fast;
        {
            const int ln = otid(wv) & 63;
            const float gq = wave_max(fabsf(P->in[I_NQN][l * 64 + ln]));
            const float gk = wave_max(fmaxf(fmaxf(fabsf(P->in[I_NKN][(l * 3 + 0) * 64 + ln]), fabsf(P->in[I_NKN][(l * 3 + 1) * 64 + ln])), fabsf(P->in[I_NKN][(l * 3 + 2) * 64 + ln])));
            nsa_fast = __builtin_amdgcn_readfirstlane((8.f * 1.4426950408889634f * gq * gk - FAST_SHIFT < 15.f) ? 1 : 0) != 0;
        }
#pragma unroll 1
        for (int w0 = bid; w0 < 512 + 512 + 512; w0 += G) {
            const int w = w0 < G ? vjx * 8 + vxcd : w0;
            if (w < 512) {
                const int bg = w & 3, q = w >> 2;
                if (nsa_fast) { nsa_unit<true>(P, l, bg, 255 - q, smem, wv); nsa_unit<true>(P, l, bg, q, smem, wv); }
                else { nsa_unit<false>(P, l, bg, 255 - q, smem, wv); nsa_unit<false>(P, l, bg, q, smem, wv); }
            } else if (w < 512 + 512) s5o_gemm_tile(P, l, w - 512, smem, wv);
            else gla_out_item(P, l, w - 1024, smem, wv);
        }
        xcd_barrier(xb);
#pragma unroll 1
        for (int w = bid; w < 512; w += G) glu_tile(P, l, w, smem, wv);
        xcd_barrier(xb);
        {
            const int xcd = vxcd, jx = vjx, nper = G >> 3;
            for (int u = jx; u < 64; u += nper) outproj_tile(P, l, xcd * 8 + (u & 7), u >> 3, smem, wv);
        }
        xcd_barrier(xb);
    }
}

extern "C" void kernel_launch(void* const* d_in, const int* in_sizes, int n_in, void* d_out, int out_size, void* d_ws,
                              size_t ws_size, hipStream_t stream) {
    static int grid_blocks = 0;
    if (!grid_blocks) {
        int dev = 0, cus = 0, per_cu = 0;
        hipGetDevice(&dev);
        hipDeviceGetAttribute(&cus, hipDeviceAttributeMultiprocessorCount, dev);
        hipFuncSetAttribute((const void*)fwd_megakernel, hipFuncAttributeMaxDynamicSharedMemorySize, SMEM_BYTES);
        hipOccupancyMaxActiveBlocksPerMultiprocessor(&per_cu, fwd_megakernel, NTHREADS, SMEM_BYTES);
        if (per_cu < 1) per_cu = 1;
        if (per_cu > 2) per_cu = 2;
        grid_blocks = cus * per_cu;
        if (ws_size < WS_END) fprintf(stderr, "kernel_launch: workspace too small: %zu < %zu\n", ws_size, (size_t)WS_END);
    }
    Params p{};
    for (int i = 0; i < 25; ++i) p.in[i] = (const float*)d_in[i];
    p.out = (float*)d_out;
    p.ws = (char*)d_ws;
    void* args[] = {&p};
    (void)hipMemsetAsync((char*)d_ws + OFF_BAR, 0, (XCD_BAR_WORDS + 16) * sizeof(unsigned), stream);
    hipError_t e = hipLaunchCooperativeKernel((const void*)fwd_megakernel, dim3(grid_blocks), dim3(NTHREADS), args, SMEM_BYTES, stream);
    if (e != hipSuccess) fprintf(stderr, "cooperative launch failed: %s (grid %d)\n", hipGetErrorString(e), grid_blocks);
}
```

```cpp
#include <hip/hip_runtime.h>
#include <hip/hip_cooperative_groups.h>
#include <cstdio>
#include <cstdint>
namespace cg = cooperative_groups;

typedef _Float16 h16;
typedef _Float16 half8 __attribute__((ext_vector_type(8)));
typedef _Float16 half4 __attribute__((ext_vector_type(4)));
typedef float f32x4 __attribute__((ext_vector_type(4)));
typedef float f32x16 __attribute__((ext_vector_type(16)));

#define DI __device__ __forceinline__

constexpr int D_MODEL = 1024, BATCH = 2, SEQ = 8192, DEPTH = 4, NT = BATCH * SEQ;
constexpr int D_IN = 3112, D_IN_PAD = 3200;
constexpr int C_NQ = 0, C_NKV = 512, C_NG = 1280, C_GQ = 1792, C_GK = 1920, C_GV = 2048, C_GG = 2304, C_SU = 2560, C_SG = 2816,
              C_GLR = 3072, C_NGL = 3088;
__host__ __device__ constexpr int map_col(int c) {
    return c < 128 ? C_GQ + c : c < 256 ? C_GK + (c - 128) : c < 512 ? C_GV + (c - 256) : c < 528 ? C_GLR + (c - 512)
         : c < 784 ? C_GG + (c - 528) : c < 1040 ? C_SU + (c - 784) : c < 1296 ? C_SG + (c - 1040) : c < 1808 ? C_NQ + (c - 1296)
         : c < 2576 ? C_NKV + (c - 1808) : c < 2600 ? C_NGL + (c - 2576) : c < 3112 ? C_NG + (c - 2600) : c;
}
constexpr int NTHREADS = 256;
constexpr float QSCALE = 0.125f * 1.4426950408889634f;

enum { I_X = 0, I_NORMG, I_WIN, I_GW2, I_GB2, I_GON, I_LRE, I_LIM, I_LSTEP, I_BRE, I_BIM, I_CRE, I_CIM, I_SD, I_GLUW, I_GLUB,
       I_NGB, I_NQN, I_NKN, I_CPOS, I_CW1, I_CB1, I_CW2, I_CB2, I_WOUT };

constexpr size_t OFF_WTIN  = 0;
constexpr size_t OFF_WTOUT = OFF_WTIN  + 4ull * D_IN_PAD * 1024 * 2;
constexpr size_t OFF_WTGLU = OFF_WTOUT + 4ull * 1024 * 1024 * 2;
constexpr size_t OFF_WTC1  = OFF_WTGLU + 4ull * 512 * 256 * 2;
constexpr size_t OFF_PROJ  = OFF_WTC1  + 4ull * 2 * 256 * 2048 * 2;
constexpr size_t OFF_MIX   = OFF_PROJ  + (size_t)NT * D_IN * 2;
constexpr size_t OFF_YACT  = OFF_MIX   + (size_t)NT * 1024 * 2;
constexpr size_t OFF_XH    = OFF_YACT;
constexpr size_t OFF_BCUM  = OFF_YACT  + (size_t)NT * 256 * 2;
constexpr size_t OFF_GKV   = OFF_BCUM  + (size_t)NT * 128 * 4;
constexpr size_t OFF_GDEC  = OFF_GKV   + 8ull * 256 * 2048 * 4;
static_assert(OFF_GDEC - OFF_XH >= (size_t)NT * 1024 * 2, "XH alias region too small");
constexpr size_t OFF_XC    = OFF_GDEC  + 8ull * 256 * 32 * 4;
constexpr size_t OFF_S5W   = OFF_XC    + 512ull * 1024 * 2 * 4;
constexpr size_t OFF_S5E   = OFF_S5W   + 16ull * 512 * 640 * 2;
constexpr size_t OFF_S5AL  = OFF_S5E   + 16ull * 128 * 512 * 2;
constexpr size_t OFF_CHID  = OFF_S5AL  + 1024ull * 2 * 4;
constexpr size_t OFF_POSB  = OFF_CHID  + 2ull * 2048 * 512 * 4;
constexpr size_t OFF_XCH   = OFF_POSB  + 8ull * 16 * 256 * 4;
constexpr size_t OFF_KCMP  = OFF_XCH   + 512ull * 2048 * 2;
constexpr size_t OFF_VCMP  = OFF_KCMP  + 4ull * 512 * 64 * 2;
constexpr size_t OFF_VTG   = OFF_VCMP  + 4ull * 512 * 64 * 2;
constexpr size_t OFF_BAR   = OFF_VTG   + 2ull * 4 * 128 * 4096 * 2;
constexpr size_t WS_END    = OFF_BAR   + 16384;

struct Params {
    const float* in[25];
    float* out;
    char* ws;
};

__host__ __device__ constexpr size_t kb_idx(size_t nrows, size_t row, int k) { return (((size_t)(k >> 6)) * nrows + row) * 64 + (k & 63); }
typedef const __attribute__((address_space(4))) Params* PP;
DI PP plaunder(PP p) { asm volatile("" : "+s"(p)); return p; }
constexpr int SMEM_MAIN = 73728;
constexpr int SMEM_BYTES = SMEM_MAIN + 16;

DI int otid(const int wv) { int t = wv * 64 + (int)__builtin_amdgcn_mbcnt_hi(~0u, __builtin_amdgcn_mbcnt_lo(~0u, 0u)); asm volatile("" : "+v"(t)); return t; }
DI float wave_sum(float v) {
#pragma unroll
    for (int o = 32; o > 0; o >>= 1) v += __shfl_xor(v, o);
    return v;
}
DI float wave_max(float v) {
#pragma unroll
    for (int o = 32; o > 0; o >>= 1) v = fmaxf(v, __shfl_xor(v, o));
    return v;
}
DI float sigmoidf_(float x) { return 1.f / (1.f + __expf(-x)); }
DI float siluf_(float x) { return x / (1.f + __expf(-x)); }
DI float gelu_tanh(float x) {
    const float u = 0.7978845608028654f * (x + 0.044715f * x * x * x);
    return 0.5f * x * (1.f + tanhf(u));
}
DI float log_sigmoidf_(float x) { return fminf(x, 0.f) - log1pf(__expf(-fabsf(x))); }

typedef _Float16 half2_ __attribute__((ext_vector_type(2)));
DI void glds16(const h16* g, char* l) {
    __builtin_amdgcn_global_load_lds((const __attribute__((address_space(1))) void*)g, (__attribute__((address_space(3))) void*)l, 16, 0, 0);
}
struct APlain { const h16* A; size_t lda, astep; DI const h16* operator()(int row, int kt, int c8) const { return A + (size_t)row * lda + (size_t)kt * astep + c8 * 8; } };
struct AS5 {
    const h16* ubase;
    const h16* xin;
    int ch0;
    DI const h16* operator()(int row, int kt, int c8) const {
        const size_t ch = (size_t)(ch0 + row);
        return kt < 8 ? ubase + (ch * 32 + 4 * kt + (c8 >> 1)) * D_IN + (c8 & 1) * 8 : xin + ch * 2048 + (kt - 8) * 64 + c8 * 8;
    }
};
template <int N> DI void gwaitbar();
#define GWB_DEF(N) template <> DI void gwaitbar<N>() { asm volatile("s_waitcnt vmcnt(" #N ") lgkmcnt(0)\n\ts_barrier" ::: "memory"); }
GWB_DEF(0) GWB_DEF(3) GWB_DEF(4) GWB_DEF(6) GWB_DEF(8) GWB_DEF(12)
template <bool SUMSQ, int WR, int MI, int NJ, int NST = 4, class AF>
DI void gemm_glds(const int wv, const int K, const AF& afn, const h16* __restrict__ Bt, const int ldb,
                  f32x4 (&acc)[MI][NJ], float (&ss)[MI], char* smem, const size_t bstep = 64) {
    constexpr int WC = 4 / WR, BM = WR * MI * 16, BN = WC * NJ * 16, AQ = BM / 64, BQ = BN / 64, NG = AQ + BQ, SB = (BM + BN) * 64;
    static_assert(NST * SB <= SMEM_MAIN && AQ >= 1 && BQ >= 1 && (NST == 3 || NST == 4), "ring does not fit the LDS");
    const int tid = otid(wv), lane = tid & 63, wid = tid >> 6, wr = wid / WC, wc = wid % WC;
#pragma unroll
    for (int i = 0; i < MI; ++i) {
        ss[i] = 0.f;
#pragma unroll
        for (int j = 0; j < NJ; ++j) acc[i][j] = (f32x4){0.f, 0.f, 0.f, 0.f};
    }
    const int lrow = wid * 16 + (lane >> 2);
    const int lc4 = (lane & 3) ^ ((-(lrow >> 2)) & 3);
    const h16* bp = Bt + (size_t)lrow * ldb + lc4 * 8;
    char* lbase = smem + wid * 1024;
    const int fr = lane & 15, fq = lane >> 4, sw = (-(fr >> 2)) & 3;
    const int aoff0 = (wr * MI * 16 + fr) * 64 + ((fq ^ sw) * 16);
    const int boff0 = BM * 64 + (wc * NJ * 16 + fr) * 64 + ((fq ^ sw) * 16);
    const int nt = K >> 5;
    auto issue = [&](const int t, char* stage) {
        const int kt = t >> 1, hb = (t & 1) * 4;
#pragma unroll
        for (int q = 0; q < AQ; ++q) glds16(afn(lrow + 64 * q, kt, hb + lc4), stage + q * 4096);
#pragma unroll
        for (int q = 0; q < BQ; ++q) glds16(bp + (size_t)q * 64 * ldb + (size_t)kt * bstep + hb * 8, stage + BM * 64 + q * 4096);
    };
    auto compute = [&](const char* st) {
        half8 af[MI], bf[NJ];
#pragma unroll
        for (int i = 0; i < MI; ++i) af[i] = *(const half8*)(st + aoff0 + i * 1024);
#pragma unroll
        for (int j = 0; j < NJ; ++j) bf[j] = *(const half8*)(st + boff0 + j * 1024);
        if (SUMSQ) {
#pragma unroll
            for (int i = 0; i < MI; ++i)
#pragma unroll
                for (int e = 0; e < 4; ++e) {
                    const half2_ x = (half2_){af[i][2 * e], af[i][2 * e + 1]};
                    ss[i] = __builtin_amdgcn_fdot2(x, x, ss[i], false);
                }
        }
#pragma unroll
        for (int i = 0; i < MI; ++i)
#pragma unroll
            for (int j = 0; j < NJ; ++j) acc[i][j] = __builtin_amdgcn_mfma_f32_16x16x32_f16(bf[j], af[i], acc[i][j], 0, 0, 0);
    };
#define GEMM_STEP(S, t) do { if (NST == 4 && (t) + 2 < nt) gwaitbar<NG>(); else gwaitbar<0>();                       \
        if ((t) + NST - 1 < nt) issue((t) + NST - 1, lbase + (((S) + NST - 1) % NST) * SB); compute(smem + (S) * SB); } while (0)
    gwaitbar<0>();
    {
        const int k = nt < NST - 1 ? nt : NST - 1;
        for (int p = 0; p < k; ++p) issue(p, lbase + p * SB);
        if (k >= 3) gwaitbar<2 * NG>(); else if (k == 2) gwaitbar<NG>(); else gwaitbar<0>();
        __builtin_amdgcn_s_sleep(2);
    }
#pragma unroll 1
    for (int t = 0; t < nt; t += NST) {
        GEMM_STEP(0, t);
        if (t + 1 < nt) GEMM_STEP(1, t + 1);
        if (t + 2 < nt) GEMM_STEP(2, t + 2);
        if (NST == 4 && t + 3 < nt) GEMM_STEP(3 % NST, t + 3);
    }
#undef GEMM_STEP
    asm volatile("s_waitcnt lgkmcnt(0)\n\ts_barrier" ::: "memory");
    if (SUMSQ) {
#pragma unroll
        for (int i = 0; i < MI; ++i) { ss[i] += __shfl_xor(ss[i], 16); ss[i] += __shfl_xor(ss[i], 32); }
    }
}
template <bool SUMSQ, class AF>
DI void gemm_mainloop_glds(const int wv, const int K, const AF& afn, const h16* __restrict__ Bt, const int ldb, f32x4 (&acc)[4][4], float (&ss)[4], char* smem, const size_t bstep = 64) {
    gemm_glds<SUMSQ, 2, 4, 4>(wv, K, afn, Bt, ldb, acc, ss, smem, bstep);
}

DI int glu_perm_dst(int c_orig) {
    const int which = c_orig >> 8, c = c_orig & 255;
    return (c >> 6) * 128 + ((c >> 5) & 1) * 64 + (((c >> 4) & 1) * 2 + which) * 16 + (c & 15);
}
template <int MAP, int KB>
DI void transpose64(const float* __restrict__ src, int R, int C, h16* __restrict__ dst, int r0, int c0,
                    const float* __restrict__ rscale, char* smem, const int wv) {
    h16* tile = (h16*)smem;
    const int tid = otid(wv);
    {
        const int r = tid >> 2, cq = (tid & 3) * 16;
        const float sc = rscale ? rscale[r0 + r] : 1.f;
        const float* sp = src + (size_t)(r0 + r) * C + c0 + cq;
#pragma unroll
        for (int q = 0; q < 4; ++q) {
            float4 v = (float4){0.f, 0.f, 0.f, 0.f};
            if (c0 + cq + q * 4 < C) v = *(const float4*)(sp + q * 4);
            *(half4*)(tile + r * 72 + cq + q * 4) = (half4){(h16)(v.x * sc), (h16)(v.y * sc), (h16)(v.z * sc), (h16)(v.w * sc)};
        }
    }
    __syncthreads();
    {
        const int c = tid >> 2, rq = (tid & 3) * 16;
        half8 o0, o1;
#pragma unroll
        for (int k = 0; k < 8; ++k) { o0[k] = tile[(rq + k) * 72 + c]; o1[k] = tile[(rq + 8 + k) * 72 + c]; }
        const int cc = c0 + c;
        const int dr = MAP == 1 ? map_col(cc) : MAP == 2 ? glu_perm_dst(cc) : cc;
        h16* dp = KB ? dst + ((size_t)(r0 >> 6) * KB + dr) * 64 + rq : dst + (size_t)dr * R + r0 + rq;
        *(half8*)dp = o0; *(half8*)(dp + 8) = o1;
    }
    __syncthreads();
}

DI void phase0(PP P, char* smem, const int wv) {
    P = plaunder(P);
    constexpr int N_WIN = 4 * 16 * 50, N_WOUT = 4 * 16 * 16, N_C1 = 16 * 16 * 4, N_GLU = 4 * 4 * 8, N_XH = NT * 1024 / 2048, N_PB = 8 * 16;
    const int total = N_WIN + N_WOUT + N_C1 + N_GLU + N_XH + N_PB;
    for (int w = blockIdx.x; w < total; w += gridDim.x) {
        if (w < N_WIN) {
            const int l = w / 800, r = w % 800, rt = r / 50, ct = r % 50;
            transpose64<1, D_IN_PAD>(P->in[I_WIN] + (size_t)l * 1024 * D_IN, 1024, D_IN, (h16*)(P->ws + OFF_WTIN) + (size_t)l * D_IN_PAD * 1024,
                           rt * 64, ct * 64, P->in[I_NORMG] + l * 1024, smem, wv);
        } else if (w < N_WIN + N_WOUT) {
            const int v = w - N_WIN, l = v >> 8, r = v & 255, rt = r >> 4, ct = r & 15;
            transpose64<0, 1024>(P->in[I_WOUT] + (size_t)l * 1024 * 1024, 1024, 1024, (h16*)(P->ws + OFF_WTOUT) + (size_t)l * 1024 * 1024,
                           rt * 64, ct * 64, nullptr, smem, wv);
        } else if (w < N_WIN + N_WOUT + N_C1) {
            const int v = w - N_WIN - N_WOUT, ljh = v >> 6, r = v & 63, rt = r >> 2, ct = r & 3;
            transpose64<0, 512>(P->in[I_CW1] + (size_t)ljh * 1024 * 256, 1024, 256, (h16*)(P->ws + OFF_WTC1) + ((size_t)(ljh >> 1) * 16 * 512 + (ljh & 1) * 256) * 64,
                           rt * 64, ct * 64, nullptr, smem, wv);
        } else if (w < N_WIN + N_WOUT + N_C1 + N_GLU) {
            const int v = w - N_WIN - N_WOUT - N_C1, l = v >> 5, r = v & 31, rt = r >> 3, ct = r & 7;
            transpose64<2, 0>(P->in[I_GLUW] + (size_t)l * 256 * 512, 256, 512, (h16*)(P->ws + OFF_WTGLU) + (size_t)l * 512 * 256,
                           rt * 64, ct * 64, nullptr, smem, wv);
        } else if (w < N_WIN + N_WOUT + N_C1 + N_GLU + N_XH) {
            const size_t e0 = ((size_t)(w - N_WIN - N_WOUT - N_C1 - N_GLU) * 256 + otid(wv)) * 8;
            const float4 a = *(const float4*)(P->in[I_X] + e0), b = *(const float4*)(P->in[I_X] + e0 + 4);
            *(half8*)((h16*)(P->ws + OFF_XH) + kb_idx(NT, e0 >> 10, (int)(e0 & 1023))) = (half8){(h16)a.x, (h16)a.y, (h16)a.z, (h16)a.w, (h16)b.x, (h16)b.y, (h16)b.z, (h16)b.w};
        } else {
            const int v = w - (N_WIN + N_WOUT + N_C1 + N_GLU + N_XH), lj = v >> 4, ks = v & 15, n = otid(wv);
            const float* w1 = P->in[I_CW1] + ((size_t)lj * 2048 + ks * 128) * 256 + n;
            const float* pp = P->in[I_CPOS] + (size_t)lj * 2048 + ks * 128;
            float a = ks == 0 ? P->in[I_CB1][lj * 256 + n] : 0.f;
#pragma unroll 16
            for (int k = 0; k < 128; ++k) a += pp[k] * w1[(size_t)k * 256];
            ((float*)(P->ws + OFF_POSB))[(lj * 16 + ks) * 256 + n] = a;
        }
    }
}

DI void s5_build_item(PP P, int l, int item, char* smem, const int wv) {
    P = plaunder(P);
    float* apow = (float*)smem;
    float* bbar = apow + 64 * 33 * 2;
    float* cc   = bbar + 64 * 16 * 2;
    const int tid = otid(wv);
    const int g = (item < 256) ? (item >> 4) : ((item - 256) >> 2);
    if (tid < 64) {
        const int p = tid;
        const float lre = fminf(P->in[I_LRE][(l * 16 + g) * 64 + p], -1e-4f);
        const float lim = P->in[I_LIM][(l * 16 + g) * 64 + p];
        const float dt = expf(P->in[I_LSTEP][l * 16 + g]);
        const float x = lre * dt, y = lim * dt;
        const float em1 = expm1f(x), cy = cosf(y), sy = sinf(y), sh = sinf(0.5f * y);
        const float ar = (em1 + 1.f) * cy, ai = (em1 + 1.f) * sy;
        const float dr = em1 * cy - 2.f * sh * sh, di = ai;
        const float den = lre * lre + lim * lim;
        const float fr = (dr * lre + di * lim) / den;
        const float fi = (di * lre - dr * lim) / den;
        float pr = 1.f, pi = 0.f;
        for (int k = 0; k <= 32; ++k) {
            apow[(p * 33 + k) * 2] = pr; apow[(p * 33 + k) * 2 + 1] = pi;
            const float nr = pr * ar - pi * ai, ni = pr * ai + pi * ar; pr = nr; pi = ni;
        }
        for (int c = 0; c < 16; ++c) {
            const float br = P->in[I_BRE][((size_t)(l * 16 + g) * 64 + p) * 16 + c];
            const float bi = P->in[I_BIM][((size_t)(l * 16 + g) * 64 + p) * 16 + c];
            bbar[(p * 16 + c) * 2] = fr * br - fi * bi;
            bbar[(p * 16 + c) * 2 + 1] = fr * bi + fi * br;
        }
    }
    for (int e = tid; e < 1024; e += 256) {
        cc[e * 2] = P->in[I_CRE][(size_t)(l * 16 + g) * 1024 + e];
        cc[e * 2 + 1] = P->in[I_CIM][(size_t)(l * 16 + g) * 1024 + e];
    }
    __syncthreads();
    if (item < 256) {
        const int c = item & 15;
        float* kt = cc + 2048;
        for (int idx = tid; idx < 512; idx += 256) {
            const int lag = idx >> 4, c2 = idx & 15;
            float a = 0.f;
            for (int p = 0; p < 64; ++p) {
                const float cr = cc[(c * 64 + p) * 2], ci = cc[(c * 64 + p) * 2 + 1];
                const float xr = apow[(p * 33 + lag) * 2], xi = apow[(p * 33 + lag) * 2 + 1];
                const float br = bbar[(p * 16 + c2) * 2], bi = bbar[(p * 16 + c2) * 2 + 1];
                const float tr = cr * xr - ci * xi, ti = cr * xi + ci * xr;
                a += tr * br - ti * bi;
            }
            kt[idx] = a;
        }
        __syncthreads();
        h16* W = (h16*)(P->ws + OFF_S5W) + (size_t)g * 512 * 640;
        for (int idx = tid; idx < 32 * 640; idx += 256) {
            const int j = idx / 640, k = idx % 640;
            float val = 0.f;
            if (k < 512) {
                const int s = k >> 4, c2 = k & 15, lag = j - s;
                if (lag >= 0) val = kt[lag * 16 + c2];
            } else {
                const int p = (k - 512) >> 1;
                const float cr = cc[(c * 64 + p) * 2], ci = cc[(c * 64 + p) * 2 + 1];
                const float xr = apow[(p * 33 + j + 1) * 2], xi = apow[(p * 33 + j + 1) * 2 + 1];
                val = (k & 1) ? -(cr * xi + ci * xr) : (cr * xr - ci * xi);
            }
            W[(size_t)(j * 16 + c) * 640 + k] = (h16)val;
        }
    } else {
        const int pq = (item - 256) & 3;
        h16* E = (h16*)(P->ws + OFF_S5E) + ((size_t)g * 128 + pq * 32) * 512;
        for (int idx = tid; idx < 32 * 512; idx += 256) {
            const int nl = idx >> 9, k = idx & 511;
            const int p = pq * 16 + (nl >> 1), s = k >> 4, c2 = k & 15;
            const float xr = apow[(p * 33 + 31 - s) * 2], xi = apow[(p * 33 + 31 - s) * 2 + 1];
            const float br = bbar[(p * 16 + c2) * 2], bi = bbar[(p * 16 + c2) * 2 + 1];
            const float val = (nl & 1) ? (xr * bi + xi * br) : (xr * br - xi * bi);
            E[(size_t)nl * 512 + k] = (h16)val;
        }
        if (tid < 16) {
            const int p = pq * 16 + tid;
            float* AL = (float*)(P->ws + OFF_S5AL);
            AL[(g * 64 + p) * 2] = apow[(p * 33 + 32) * 2];
            AL[(g * 64 + p) * 2 + 1] = apow[(p * 33 + 32) * 2 + 1];
        }
    }
    __syncthreads();
}

template <int WR, int MI>
DI void inproj_tile(PP P, int l, int m0, int n0, char* smem, const int wv) {
    P = plaunder(P);
    constexpr int WC = 4 / WR;
    f32x4 acc[MI][4];
    float ss[MI];
    gemm_glds<true, WR, MI, 4, (WR == 2 && MI == 8) ? 3 : 4>(wv, 1024, APlain{(const h16*)(P->ws + OFF_XH) + (size_t)m0 * 64, 64, (size_t)NT * 64},
                               (const h16*)(P->ws + OFF_WTIN) + ((size_t)l * 16 * D_IN_PAD + n0) * 64, 64, acc, ss, smem, (size_t)D_IN_PAD * 64);
    const int tid = otid(wv), lane = tid & 63, wid = tid >> 6, wr = wid / WC, wc = wid % WC;
    h16* proj = (h16*)(P->ws + OFF_PROJ);
    const int n64 = n0 + wc * 64;
    int cls = 0;
    if (n64 < 512) cls = 1;
    else if (n64 >= C_NKV + 256 && n64 < C_NKV + 384) cls = 2;
    else if (n64 >= C_NKV + 512 && n64 < C_NKV + 640) cls = 3;
    else if (n64 >= C_NKV + 384 && n64 < C_NKV + 512) cls = 4;
    else if (n64 >= C_NKV + 640 && n64 < C_NKV + 768) cls = 5;
    float wn[4][4];
    if (cls >= 1 && cls <= 3) {
        const float* wp = (cls == 1) ? P->in[I_NQN] + l * 64 : P->in[I_NKN] + (l * 3 + (cls - 1)) * 64;
        const float sc = (cls == 1) ? QSCALE : 1.f;
#pragma unroll
        for (int j = 0; j < 4; ++j) {
            const float4 w4 = *(const float4*)(wp + j * 16 + (lane >> 4) * 4);
            wn[j][0] = w4.x * sc; wn[j][1] = w4.y * sc; wn[j][2] = w4.z * sc; wn[j][3] = w4.w * sc;
        }
    }
#pragma unroll
    for (int i = 0; i < MI; ++i) {
        const int ml = wr * MI * 16 + i * 16 + (lane & 15);
        const float r = rsqrtf(ss[i] * (1.f / 1024.f) + 1e-6f);
        const size_t row = (size_t)m0 + ml;
        f32x4 v[4];
#pragma unroll
        for (int j = 0; j < 4; ++j) v[j] = acc[i][j] * r;
        if (cls >= 1 && cls <= 3) {
            float s2 = 0.f;
#pragma unroll
            for (int j = 0; j < 4; ++j) s2 += v[j][0] * v[j][0] + v[j][1] * v[j][1] + v[j][2] * v[j][2] + v[j][3] * v[j][3];
            s2 += __shfl_xor(s2, 16); s2 += __shfl_xor(s2, 32);
            const float rn = rsqrtf(s2 * (1.f / 64.f) + 1e-6f);
#pragma unroll
            for (int j = 0; j < 4; ++j) { v[j][0] *= rn * wn[j][0]; v[j][1] *= rn * wn[j][1]; v[j][2] *= rn * wn[j][2]; v[j][3] *= rn * wn[j][3]; }
        }
        if (cls >= 4) {
            const int g = (n64 >> 6) & 1, br = cls - 4;
            const int b = (int)(row >> 13), t = (int)(row & 8191);
            h16* vt = (h16*)(P->ws + OFF_VTG) + ((((size_t)br * 4 + b * 2 + g) * 128 + (t >> 6)) * 64) * 64;
#pragma unroll
            for (int j = 0; j < 4; ++j)
#pragma unroll
                for (int e = 0; e < 4; ++e) vt[(j * 16 + (lane >> 4) * 4 + e) * 64 + ((t & 63) ^ ((j & 1) << 2))] = (h16)v[j][e];
        }
#pragma unroll
        for (int j = 0; j < 4; ++j) {
            const int n = n64 + j * 16 + (lane >> 4) * 4;
            if (n < D_IN) *(half4*)(proj + row * D_IN + n) = (half4){(h16)v[j][0], (h16)v[j][1], (h16)v[j][2], (h16)v[j][3]};
        }
        __builtin_amdgcn_sched_barrier(0);
    }
    __syncthreads();
}


DI void cmp_gemm_tile(PP P, int l, int tile, char* smem, const int wv) {
    P = plaunder(P);
    const int j = tile >> 6, mt = (tile >> 2) & 15, nt = tile & 3;
    const int row0 = mt * 128, bg = row0 >> 9, i0 = row0 & 511, b = bg >> 1, g = bg & 1;
    f32x4 acc[4][4];
    float ssd[4];
    gemm_mainloop_glds<false>(wv, 1024, APlain{(const h16*)(P->ws + OFF_PROJ) + ((size_t)b * SEQ + 16 * i0) * D_IN + C_NKV + j * 128 + g * 64, (size_t)16 * D_IN, (size_t)D_IN},
                              (const h16*)(P->ws + OFF_WTC1) + ((size_t)(l * 2 + j) * 16 * 512 + nt * 128) * 64, 64, acc, ssd, smem, (size_t)512 * 64);
    const int tid = otid(wv), lane = tid & 63, wid = tid >> 6, wr = wid >> 1, wc = wid & 1;
    float* pt = (float*)(P->ws + OFF_CHID) + (size_t)j * 2048 * 512;
#pragma unroll
    for (int i = 0; i < 4; ++i) {
        const size_t row = (size_t)row0 + wr * 64 + i * 16 + (lane & 15);
#pragma unroll
        for (int jj = 0; jj < 4; ++jj) {
            const int n = nt * 128 + wc * 64 + jj * 16 + (lane >> 4) * 4;
            const f32x4 v = acc[i][jj];
            *(float4*)(pt + row * 512 + n) = (float4){v[0], v[1], v[2], v[3]};
        }
    }
}

DI void s5e_gemm_tile(PP P, int l, int tile, char* smem, const int wv) {
    P = plaunder(P);
    const int g = tile >> 2, mt = tile & 3;
    f32x4 acc[4][4];
    float ssd[4];
    gemm_mainloop_glds<false>(wv, 512, AS5{(const h16*)(P->ws + OFF_PROJ) + C_SU + g * 16, nullptr, mt * 128},
                              (const h16*)(P->ws + OFF_S5E) + (size_t)g * 128 * 512, 512, acc, ssd, smem);
    const int tid = otid(wv), lane = tid & 63, wid = tid >> 6, wr = wid >> 1, wc = wid & 1;
    float* xc = (float*)(P->ws + OFF_XC);
#pragma unroll
    for (int i = 0; i < 4; ++i) {
        const size_t ch = (size_t)mt * 128 + wr * 64 + i * 16 + (lane & 15);
#pragma unroll
        for (int jj = 0; jj < 4; ++jj) {
            const int n = wc * 64 + jj * 16 + (lane >> 4) * 4;
            const f32x4 v = acc[i][jj];
            *(float4*)(xc + (ch * 1024 + g * 64) * 2 + n) = (float4){v[0], v[1], v[2], v[3]};
        }
    }
}

DI void gla_scan_item(PP P, int item, char* smem, const int wv) {
    P = plaunder(P);
    const int tid = otid(wv), sl = tid & 31, part = tid >> 5;
    const int idx = item * 32 + sl, bh = idx >> 11, de = idx & 2047, d = de >> 6;
    float* kv = (float*)(P->ws + OFF_GKV) + ((size_t)bh * 256 + part * 32) * 2048 + de;
    const float* dc = (const float*)(P->ws + OFF_GDEC) + ((size_t)bh * 256 + part * 32) * 32 + d;
    float* sD = (float*)smem; float* sL = sD + 256;
    float kvv[32], dd[32];
#pragma unroll
    for (int i = 0; i < 32; ++i) { kvv[i] = kv[(size_t)i * 2048]; dd[i] = dc[i * 32]; }
    float D = 1.f, L = 0.f;
#pragma unroll
    for (int i = 0; i < 32; ++i) { L = dd[i] * L + kvv[i]; D *= dd[i]; }
    sD[part * 32 + sl] = D; sL[part * 32 + sl] = L;
    __syncthreads();
    float S = 0.f;
    for (int q = 0; q < part; ++q) S = sD[q * 32 + sl] * S + sL[q * 32 + sl];
#pragma unroll
    for (int i = 0; i < 32; ++i) { const float o = S; S = dd[i] * S + kvv[i]; kv[(size_t)i * 2048] = o; }
    __syncthreads();
}
DI void s5_scan_item(PP P, int item, char* smem, const int wv) {
    P = plaunder(P);
    const int tid = otid(wv), sl = tid & 31, part = tid >> 5;
    const int idx = item * 32 + sl, b = idx >> 10, s = idx & 1023;
    float2* xc = (float2*)(P->ws + OFF_XC) + ((size_t)b * 256 + part * 32) * 1024 + s;
    half2_* xch = (half2_*)(P->ws + OFF_XCH) + ((size_t)b * 256 + part * 32) * 1024 + s;
    const float2 a = ((const float2*)(P->ws + OFF_S5AL))[s];
    float2* sL = (float2*)smem;
    float2 c[32];
#pragma unroll
    for (int i = 0; i < 32; ++i) c[i] = xc[(size_t)i * 1024];
    float lr = 0.f, li = 0.f;
#pragma unroll
    for (int i = 0; i < 32; ++i) { const float nr = a.x * lr - a.y * li + c[i].x, ni = a.x * li + a.y * lr + c[i].y; lr = nr; li = ni; }
    float dr = a.x, di = a.y;
#pragma unroll
    for (int i = 0; i < 5; ++i) { const float nr = dr * dr - di * di, ni = 2.f * dr * di; dr = nr; di = ni; }
    sL[part * 32 + sl] = (float2){lr, li};
    __syncthreads();
    float xr = 0.f, xi = 0.f;
    for (int q = 0; q < part; ++q) { const float2 lq = sL[q * 32 + sl]; const float nr = dr * xr - di * xi + lq.x, ni = dr * xi + di * xr + lq.y; xr = nr; xi = ni; }
#pragma unroll
    for (int i = 0; i < 32; ++i) {
        const float2 o = (float2){xr, xi};
        const float nr = a.x * xr - a.y * xi + c[i].x, ni = a.x * xi + a.y * xr + c[i].y; xr = nr; xi = ni;
        xc[(size_t)i * 1024] = o;
        xch[(size_t)i * 1024] = (half2_){(h16)o.x, (h16)o.y};
    }
    __syncthreads();
}
DI void cmp_l2_item(PP P, int l, int item, char* smem, const int wv) {
    P = plaunder(P);
    const int tid = otid(wv), lane = tid & 63, w = tid >> 6;
    const int j = item >> 8, r0 = (item & 255) * 8;
    h16* w2s = (h16*)smem;
    float* hs = (float*)(smem + 32768);
    {
        const float* w2 = P->in[I_CW2] + (size_t)(l * 2 + j) * 256 * 64;
        for (int e = tid * 4; e < 256 * 64; e += 1024) {
            const float4 v = *(const float4*)(w2 + e);
            *(half4*)(w2s + e) = (half4){(h16)v.x, (h16)v.y, (h16)v.z, (h16)v.w};
        }
        const float* pt = (const float*)(P->ws + OFF_CHID) + (size_t)j * 2048 * 512;
        float pb = 0.f;
#pragma unroll
        for (int ks = 0; ks < 16; ++ks) pb += ((const float*)(P->ws + OFF_POSB))[((l * 2 + j) * 16 + ks) * 256 + tid];
#pragma unroll
        for (int rr = 0; rr < 8; ++rr) {
            const int row = r0 + rr, i = row & 511;
            float v = 0.f;
            if (i < 511) v = gelu_tanh(pt[(size_t)row * 512 + tid] + pt[(size_t)(row + 1) * 512 + 256 + tid] + pb);
            hs[rr * 256 + tid] = v;
        }
    }
    __syncthreads();
    const float bb = P->in[I_CB2][(l * 2 + j) * 64 + lane];
    float a0 = bb, a1 = bb;
    const float* h0 = hs + (2 * w) * 256, *h1 = h0 + 256;
#pragma unroll 8
    for (int n = 0; n < 256; ++n) {
        const float wv = (float)w2s[n * 64 + lane];
        a0 += h0[n] * wv; a1 += h1[n] * wv;
    }
#pragma unroll
    for (int rr = 0; rr < 2; ++rr) {
        float acc = rr ? a1 : a0;
        const int row = r0 + 2 * w + rr, bg = row >> 9, i = row & 511;
        if (i == 511) acc = 0.f;
        if (j == 0) {
            const float ss = wave_sum(acc * acc);
            acc = acc * rsqrtf(ss * (1.f / 64.f) + 1e-6f) * P->in[I_NKN][(l * 3 + 0) * 64 + lane];
            ((h16*)(P->ws + OFF_KCMP))[(size_t)row * 64 + lane] = (h16)acc;
        } else {
            ((h16*)(P->ws + OFF_VCMP))[(((size_t)bg * 8 + (i >> 6)) * 64 + lane) * 64 + ((i & 63) ^ (((lane >> 4) & 1) << 2))] = (h16)acc;
        }
    }
    __syncthreads();
}

DI void s5o_gemm_tile(PP P, int l, int tile, char* smem, const int wv) {
    P = plaunder(P);
    const int g = tile >> 5, mt = (tile >> 3) & 3, nt = tile & 7;
    f32x4 acc[2][4];
    float ssd[2];
    gemm_glds<false, 4, 2, 4>(wv, 640, AS5{(const h16*)(P->ws + OFF_PROJ) + C_SU + g * 16, (const h16*)(P->ws + OFF_XCH) + g * 128, mt * 128},
                              (const h16*)(P->ws + OFF_S5W) + ((size_t)g * 512 + nt * 64) * 640, 640, acc, ssd, smem);
    const int tid = otid(wv), lane = tid & 63, wid = tid >> 6;
    const h16* proj = (const h16*)(P->ws + OFF_PROJ);
    h16* yact = (h16*)(P->ws + OFF_YACT);
#pragma unroll
    for (int i = 0; i < 2; ++i) {
        const size_t ch = (size_t)mt * 128 + wid * 32 + i * 16 + (lane & 15);
#pragma unroll
        for (int jj = 0; jj < 4; ++jj) {
            const int n = nt * 64 + jj * 16 + (lane >> 4) * 4;
            const int j = n >> 4, c = n & 15;
            const size_t tok = ch * 32 + j;
            const half4 u4 = *(const half4*)(proj + tok * D_IN + C_SU + g * 16 + c);
            const float4 dd = *(const float4*)(P->in[I_SD] + (l * 16 + g) * 16 + c);
            const f32x4 v = acc[i][jj];
            half4 o;
            o[0] = (h16)gelu_tanh(v[0] + dd.x * (float)u4[0]);
            o[1] = (h16)gelu_tanh(v[1] + dd.y * (float)u4[1]);
            o[2] = (h16)gelu_tanh(v[2] + dd.z * (float)u4[2]);
            o[3] = (h16)gelu_tanh(v[3] + dd.w * (float)u4[3]);
            *(half4*)(yact + tok * 256 + g * 16 + c) = o;
        }
    }
}

#define MFMA32(a, b, c) __builtin_amdgcn_mfma_f32_32x32x16_f16((a), (b), (c), 0, 0, 0)
constexpr float FAST_SHIFT = 4.f;
constexpr float NEGS = -1e30f;
DI float ex2(float x) { return __builtin_amdgcn_exp2f(x); }
#define NSA_WAITBAR(N) asm volatile("s_waitcnt vmcnt(" #N ") lgkmcnt(0)\n\ts_barrier" ::: "memory")
#define NSA_BAR() asm volatile("s_waitcnt lgkmcnt(0)\n\ts_barrier" ::: "memory")

struct KVSrc { const h16* k; int ldk; size_t kstep; const h16* v; };
DI void nsa_dma(const KVSrc& s, int j, char* stage, int wid, int lane) {
    const int row0 = wid * 8 + (lane >> 3);
    const int sw = ((lane & 7) ^ ((row0 >> 1) & 7)) * 8;
    const h16* kp = s.k + (size_t)j * s.kstep + (size_t)row0 * s.ldk + sw;
    glds16(kp, stage + wid * 1024);
    glds16(kp + (size_t)32 * s.ldk, stage + 4096 + wid * 1024);
    const h16* vp = s.v + (size_t)j * 4096 + row0 * 64 + sw;
    glds16(vp, stage + 8192 + wid * 1024);
    glds16(vp + 32 * 64, stage + 8192 + 4096 + wid * 1024);
}
template <int NST, class F>
DI void nsa_pipe(const KVSrc& s, const int n, char* smem, int wid, int lane, F&& compute) {
    NSA_WAITBAR(0);
    {
        const int k = n < NST - 1 ? n : NST - 1;
        for (int p = 0; p < k; ++p) nsa_dma(s, p, smem + p * 16384, wid, lane);
        if (k >= 3) NSA_WAITBAR(8); else if (k == 2) NSA_WAITBAR(4); else NSA_WAITBAR(0);
        __builtin_amdgcn_s_sleep(2);
    }
    for (int j = 0; j < n; ++j) {
        if (NST == 4 && j + 2 < n) NSA_WAITBAR(4); else NSA_WAITBAR(0);
        const int jn = j + NST - 1;
        compute(j, smem + (j % NST) * 16384, [&]() { if (jn < n) nsa_dma(s, jn, smem + (jn % NST) * 16384, wid, lane); });
    }
}

template <bool SHIFT = false, class BF>
DI void qk_tile(const char* Kimg, const half8 (&qf)[4], f32x16 (&s)[2], int lane, BF&& between) {
    const int r = lane & 31, h = lane >> 5, swz = (r >> 1) & 7;
    const char* base = Kimg + r * 128;
    half8 kf[8];
#pragma unroll
    for (int kt = 0; kt < 2; ++kt)
#pragma unroll
        for (int ks = 0; ks < 4; ++ks) kf[kt * 4 + ks] = *(const half8*)(base + kt * 4096 + (((2 * ks + h) ^ swz) << 4));
    __builtin_amdgcn_sched_barrier(0);
    between();
    __builtin_amdgcn_sched_barrier(0);
#pragma unroll
    for (int kt = 0; kt < 2; ++kt) {
#pragma unroll
        for (int e = 0; e < 16; ++e) s[kt][e] = SHIFT ? -FAST_SHIFT : 0.f;
#pragma unroll
        for (int ks = 0; ks < 4; ++ks) s[kt] = MFMA32(kf[kt * 4 + ks], qf[ks], s[kt]);
    }
}
template <bool SHIFT = false>
DI void qk_tile(const char* Kimg, const half8 (&qf)[4], f32x16 (&s)[2], int lane) { qk_tile<SHIFT>(Kimg, qf, s, lane, []() {}); }
template <int S> DI half8 pack8(const f32x16& x) {
    return (half8){(h16)x[8 * S], (h16)x[8 * S + 1], (h16)x[8 * S + 2], (h16)x[8 * S + 3], (h16)x[8 * S + 4], (h16)x[8 * S + 5], (h16)x[8 * S + 6], (h16)x[8 * S + 7]};
}
DI half8 ld_vfrag(const char* Vimg, int off0) {
    const half4 lo = *(const half4*)(Vimg + off0), hi = *(const half4*)(Vimg + (off0 ^ 16));
    return (half8){lo[0], lo[1], lo[2], lo[3], hi[0], hi[1], hi[2], hi[3]};
}
template <int KT>
DI void pv_load(const char* Vimg, half8 (&vf)[4], int lane) {
    const int r = lane & 31, h = lane >> 5, swz16 = ((r >> 1) & 7) << 4;
    const char* rb = Vimg + r * 128 + 8 * (h ^ ((r >> 4) & 1));
#pragma unroll
    for (int dt = 0; dt < 2; ++dt) {
        vf[dt * 2 + 0] = ld_vfrag(rb + dt * 4096, ((4 * KT) << 4) ^ swz16);
        vf[dt * 2 + 1] = ld_vfrag(rb + dt * 4096, ((4 * KT + 2) << 4) ^ swz16);
    }
}
typedef unsigned u32x4_ __attribute__((ext_vector_type(4)));
template <int KT, bool MASKED = false>
DI void pv_mma(const half8 (&vf)[4], const f32x16 (&p)[2], f32x16 (&o)[2], const unsigned rmask = 0xffffffffu) {
    half8 pb0 = pack8<0>(p[KT]), pb1 = pack8<1>(p[KT]);
    if (MASKED) {
        pb0 = __builtin_bit_cast(half8, __builtin_bit_cast(u32x4_, pb0) & rmask);
        pb1 = __builtin_bit_cast(half8, __builtin_bit_cast(u32x4_, pb1) & rmask);
    }
#pragma unroll
    for (int dt = 0; dt < 2; ++dt) {
        o[dt] = MFMA32(vf[dt * 2 + 0], pb0, o[dt]);
        o[dt] = MFMA32(vf[dt * 2 + 1], pb1, o[dt]);
    }
}
template <bool MASKED = false>
DI void pv_finish(const char* Vimg, const half8 (&va)[4], const f32x16 (&p)[2], f32x16 (&o)[2], int lane, const unsigned rmask = 0xffffffffu) {
    half8 vb[4];
    pv_load<1>(Vimg, vb, lane);
    pv_mma<0, MASKED>(va, p, o, rmask);
    pv_mma<1, MASKED>(vb, p, o, rmask);
}
DI float sm_fast(f32x16 (&s)[2]) {
    float rs = 0.f;
#pragma unroll
    for (int kt = 0; kt < 2; ++kt)
#pragma unroll
        for (int e = 0; e < 16; ++e) { const float p = ex2(s[kt][e]); s[kt][e] = p; rs += p; }
    return rs;
}
DI float xhalf_max(float v) {
    const auto r = __builtin_amdgcn_permlane32_swap(__float_as_uint(v), __float_as_uint(v), false, false);
    return fmaxf(__uint_as_float(r[0]), __uint_as_float(r[1]));
}
DI float xhalf_sum(float v) {
    const auto r = __builtin_amdgcn_permlane32_swap(__float_as_uint(v), __float_as_uint(v), false, false);
    return __uint_as_float(r[0]) + __uint_as_float(r[1]);
}
DI float rowmax32(const f32x16 (&s)[2]) {
    float mx = s[0][0];
#pragma unroll
    for (int e = 1; e < 16; ++e) mx = fmaxf(mx, s[0][e]);
#pragma unroll
    for (int e = 0; e < 16; ++e) mx = fmaxf(mx, s[1][e]);
    return xhalf_max(mx);
}
constexpr float SM_THR = 6.f;
DI void sm_online(f32x16 (&s)[2], float& m, float& l, f32x16 (&o)[2], const bool rowok) {
    float mx = rowmax32(s);
    mx = rowok ? mx : NEGS;
    if (__any(mx > m + SM_THR)) {
        const float mn = fmaxf(m, mx), alpha = ex2(m - mn);
        l *= alpha; o[0] *= alpha; o[1] *= alpha; m = mn;
    }
    const float msub = rowok ? m : 1e30f;
    float rs = 0.f;
#pragma unroll
    for (int kt = 0; kt < 2; ++kt)
#pragma unroll
        for (int e = 0; e < 16; ++e) { const float p = ex2(s[kt][e] - msub); s[kt][e] = p; rs += p; }
    l += xhalf_sum(rs);
}

template <int V> struct IC { static constexpr int value = V; };
template <bool FAST>
DI void nsa_unit(PP P, int l, int bg, int c32, char* smem, const int wv) {
    P = plaunder(P);
    const int tid = otid(wv), lane = tid & 63, w = tid >> 6, r = lane & 31, h = lane >> 5;
    const int b = bg >> 1, g = bg & 1, t0 = c32 * 32, cur = c32 >> 1;
    const int tokl = w * 8 + (r >> 2), head = r & 3, t = t0 + tokl;
    const size_t tokg = (size_t)b * SEQ + t;
    float* IMP = (float*)(smem + 49152);
    unsigned* SELM = (unsigned*)(smem + 49152);
    const h16* proj = (const h16*)(P->ws + OFF_PROJ);
    const int ghead = g * 4 + head;

    half8 qf[4];
    {
        const h16* qp = proj + tokg * D_IN + C_NQ + ghead * 64 + 8 * h;
#pragma unroll
        for (int ks = 0; ks < 4; ++ks) qf[ks] = *(const half8*)(qp + 16 * ks);
    }
    float g0, g1, g2;
    {
        const h16* gp = proj + tokg * D_IN + C_NGL + ghead * 3;
        const float* gb = P->in[I_NGB] + l * 24 + ghead * 3;
        g0 = sigmoidf_((float)gp[0] + gb[0]); g1 = sigmoidf_((float)gp[1] + gb[1]); g2 = sigmoidf_((float)gp[2] + gb[2]);
    }
    __syncthreads();
    for (int i = tid; i < 32 * 128; i += 256) IMP[i] = 0.f;

    half8 oacc[4];
    auto oacc_add = [&](const f32x16 (&o)[2], const float sc, const bool first) {
#pragma unroll
        for (int dt = 0; dt < 2; ++dt)
#pragma unroll
            for (int hf = 0; hf < 2; ++hf) {
                half8 v = oacc[dt * 2 + hf];
#pragma unroll
                for (int e = 0; e < 8; ++e) v[e] = (h16)((first ? 0.f : (float)v[e]) + o[dt][hf * 8 + e] * sc);
                oacc[dt * 2 + hf] = v;
            }
    };

    {
        const int nvt = 2 * c32 + 1;
        const int nvr = (t >= 31) ? ((t - 31) >> 4) + 1 : 0;
        const int ntile = (nvt + 63) >> 6;
        KVSrc src{(const h16*)(P->ws + OFF_KCMP) + (size_t)bg * 512 * 64, 64, 4096, (const h16*)(P->ws + OFF_VCMP) + (size_t)bg * 8 * 4096};
        f32x16 o[2];
#pragma unroll
        for (int e = 0; e < 16; ++e) { o[0][e] = 0.f; o[1][e] = 0.f; }
        float invl;
        if constexpr (FAST) {
            const int tf = t0 + w * 8;
            const int nvlo = __builtin_amdgcn_readfirstlane((tf >= 31) ? ((tf - 31) >> 4) + 1 : 0);
            float lsum = 0.f;
            nsa_pipe<3>(src, ntile, smem, w, lane, [&](int j, const char* st, auto&& issue) {
                f32x16 s[2];
                qk_tile<true>(st, qf, s, lane);
                issue();
                if (64 * j + 64 > nvlo) {
#pragma unroll
                    for (int kt = 0; kt < 2; ++kt)
#pragma unroll
                        for (int e = 0; e < 16; ++e) {
                            const int key = 64 * j + 32 * kt + 8 * (e >> 2) + 4 * h + (e & 3);
                            if (key >= nvr) s[kt][e] = NEGS;
                        }
                }
                lsum += sm_fast(s);
            });
            lsum = xhalf_sum(lsum);
            invl = lsum > 0.f ? 1.f / lsum : 0.f;
            nsa_pipe<3>(src, ntile, smem, w, lane, [&](int j, const char* st, auto&& issue) {
                f32x16 s[2];
                qk_tile<true>(st, qf, s, lane);
                half8 vf[4];
                pv_load<0>(st + 8192, vf, lane);
                issue();
                __builtin_amdgcn_sched_barrier(0);
                if (64 * j + 64 > nvlo) {
#pragma unroll
                    for (int kt = 0; kt < 2; ++kt)
#pragma unroll
                        for (int e = 0; e < 16; ++e) {
                            const int key = 64 * j + 32 * kt + 8 * (e >> 2) + 4 * h + (e & 3);
                            if (key >= nvr) s[kt][e] = NEGS;
                        }
                }
                (void)sm_fast(s);
                if (cur >= 16) {
#pragma unroll
                    for (int kt = 0; kt < 2; ++kt)
#pragma unroll
                        for (int g4 = 0; g4 < 4; ++g4) {
                            float G = ((s[kt][4 * g4] + s[kt][4 * g4 + 1]) + (s[kt][4 * g4 + 2] + s[kt][4 * g4 + 3])) * invl;
                            float L = s[kt][4 * g4 + 3] * invl;
                            G += __shfl_xor(G, 1); G += __shfl_xor(G, 2);
                            L += __shfl_xor(L, 1); L += __shfl_xor(L, 2);
                            if (head == 0) {
                                const int sb = 16 * j + 8 * kt + 2 * g4 + h;
                                atomicAdd(&IMP[tokl * 128 + sb], G);
                                if (sb + 1 < 128) atomicAdd(&IMP[tokl * 128 + sb + 1], L);
                            }
                        }
                }
                pv_finish(st + 8192, vf, s, o, lane);
            });
        } else {
        float m = -1e20f, lsum = 0.f;
        nsa_pipe<3>(src, ntile, smem, w, lane, [&](int j, const char* st, auto&& issue) {
            f32x16 s[2];
            qk_tile(st, qf, s, lane);
            issue();
#pragma unroll
            for (int kt = 0; kt < 2; ++kt)
#pragma unroll
                for (int e = 0; e < 16; ++e) {
                    const int key = 64 * j + 32 * kt + 8 * (e >> 2) + 4 * h + (e & 3);
                    if (key >= nvr) s[kt][e] = NEGS;
                }
            const float mn = fmaxf(m, rowmax32(s)), alpha = ex2(m - mn);
            float rs = 0.f;
#pragma unroll
            for (int kt = 0; kt < 2; ++kt)
#pragma unroll
                for (int e = 0; e < 16; ++e) rs += ex2(s[kt][e] - mn);
            rs = xhalf_sum(rs);
            lsum = lsum * alpha + rs; m = mn;
        });
        const float invl_s = lsum > 0.f ? 1.f / lsum : 0.f;
        nsa_pipe<3>(src, ntile, smem, w, lane, [&](int j, const char* st, auto&& issue) {
            f32x16 s[2];
            qk_tile(st, qf, s, lane);
            half8 vf[4];
            pv_load<0>(st + 8192, vf, lane);
            issue();
            __builtin_amdgcn_sched_barrier(0);
#pragma unroll
            for (int kt = 0; kt < 2; ++kt)
#pragma unroll
                for (int e = 0; e < 16; ++e) {
                    const int key = 64 * j + 32 * kt + 8 * (e >> 2) + 4 * h + (e & 3);
                    s[kt][e] = (key < nvr) ? ex2(s[kt][e] - m) * invl_s : 0.f;
                }
            if (cur >= 16) {
#pragma unroll
                for (int kt = 0; kt < 2; ++kt)
#pragma unroll
                    for (int g4 = 0; g4 < 4; ++g4) {
                        float G = (s[kt][4 * g4] + s[kt][4 * g4 + 1]) + (s[kt][4 * g4 + 2] + s[kt][4 * g4 + 3]);
                        float L = s[kt][4 * g4 + 3];
                        G += __shfl_xor(G, 1); G += __shfl_xor(G, 2);
                        L += __shfl_xor(L, 1); L += __shfl_xor(L, 2);
                        if (head == 0) {
                            const int sb = 16 * j + 8 * kt + 2 * g4 + h;
                            atomicAdd(&IMP[tokl * 128 + sb], G);
                            if (sb + 1 < 128) atomicAdd(&IMP[tokl * 128 + sb + 1], L);
                        }
                    }
            }
            pv_finish(st + 8192, vf, s, o, lane);
        });
            invl = 1.f;
        }
        oacc_add(o, g0 * invl, true);
    }
    __syncthreads();
    {
        const int tl = lane >> 3, sub = lane & 7;
        unsigned bits = 0;
        unsigned u[16];
        if (cur >= 16) {
            const float* ip = IMP + (w * 8 + tl) * 128 + sub * 16;
#pragma unroll
            for (int i = 0; i < 16; ++i) {
                const int s = sub * 16 + i;
                u[i] = (s >= 1 && s <= cur - 2) ? (__float_as_uint(ip[i]) + 1u) : 0u;
            }
        }
        __syncthreads();
        if (cur >= 16) {
            unsigned prefix = 0;
            for (int bit = 30; bit >= 0; --bit) {
                const unsigned cand = prefix | (1u << bit);
                int cnt = 0;
#pragma unroll
                for (int i = 0; i < 16; ++i) cnt += (u[i] >= cand) ? 1 : 0;
                cnt += __shfl_xor(cnt, 1); cnt += __shfl_xor(cnt, 2); cnt += __shfl_xor(cnt, 4);
                if (cnt >= 13) prefix = cand;
            }
            int cgt = 0, ceq = 0;
#pragma unroll
            for (int i = 0; i < 16; ++i) { cgt += (u[i] > prefix) ? 1 : 0; ceq += (u[i] == prefix) ? 1 : 0; }
            cgt += __shfl_xor(cgt, 1); cgt += __shfl_xor(cgt, 2); cgt += __shfl_xor(cgt, 4);
            int inc = ceq;
            { const int v = __shfl_up(inc, 1); if (sub >= 1) inc += v; }
            { const int v = __shfl_up(inc, 2); if (sub >= 2) inc += v; }
            { const int v = __shfl_up(inc, 4); if (sub >= 4) inc += v; }
            int run = inc - ceq;
            const int need = 13 - cgt;
#pragma unroll
            for (int i = 0; i < 16; ++i) {
                const int s = sub * 16 + i;
                bool sel = u[i] > prefix;
                if (u[i] == prefix) { sel = run < need; ++run; }
                if (s == 0 || s == cur || s == cur - 1) sel = true;
                bits |= (sel ? 1u : 0u) << i;
            }
        } else {
#pragma unroll
            for (int i = 0; i < 16; ++i) bits |= ((sub * 16 + i <= cur) ? 1u : 0u) << i;
        }
        unsigned wv = bits << ((sub & 1) * 16);
        wv |= __shfl_xor(wv, 1);
        if ((sub & 1) == 0) SELM[(w * 8 + tl) * 4 + (sub >> 1)] = wv;
    }
    __syncthreads();
    unsigned selw[4];
#pragma unroll
    for (int i = 0; i < 4; ++i) selw[i] = SELM[tokl * 4 + i];

    auto branch = [&](auto BRC) {
        constexpr int br = decltype(BRC)::value;
        const int j0 = (br == 0) ? 0 : (cur - 8 > 0 ? cur - 8 : 0);
        const int nst = cur - j0 + 1;
        KVSrc src{proj + ((size_t)b * SEQ + (size_t)j0 * 64) * D_IN + C_NKV + (br == 0 ? 256 : 512) + g * 64, D_IN, (size_t)64 * D_IN,
                  (const h16*)(P->ws + OFF_VTG) + (((size_t)br * 4 + bg) * 128 + j0) * 4096};
        float m = -1e20f, lsum = 0.f;
        f32x16 o[2];
#pragma unroll
        for (int e = 0; e < 16; ++e) { o[0][e] = 0.f; o[1][e] = 0.f; }
        nsa_pipe<4>(src, nst, smem, w, lane, [&](int jj, const char* st, auto&& issue) {
            const int j = j0 + jj;
            const bool rowok = (br != 0) || (((selw[j >> 5] >> (j & 31)) & 1u) != 0u);
            if constexpr (FAST && br == 0) {
                if (!__any(rowok)) { issue(); return; }
            }
            f32x16 s[2];
            qk_tile<FAST>(st, qf, s, lane, issue);
            half8 vf[4];
            pv_load<0>(st + 8192, vf, lane);
            __builtin_amdgcn_sched_barrier(0);
            if (j == cur || (br == 1 && j == cur - 8)) {
#pragma unroll
                for (int kt = 0; kt < 2; ++kt)
#pragma unroll
                    for (int e = 0; e < 16; ++e) {
                        const int key = 64 * j + 32 * kt + 8 * (e >> 2) + 4 * h + (e & 3);
                        const bool ok = (key <= t) && (br == 0 || key > t - 512);
                        if (!ok) s[kt][e] = NEGS;
                    }
            }
            if constexpr (FAST) {
                const float rs = sm_fast(s);
                lsum += (br != 0 || rowok) ? rs : 0.f;
                pv_finish<br == 0>(st + 8192, vf, s, o, lane, rowok ? 0xffffffffu : 0u);
            } else {
                sm_online(s, m, lsum, o, rowok);
                pv_finish(st + 8192, vf, s, o, lane);
            }
        });
        if constexpr (FAST) lsum = xhalf_sum(lsum);
        const float sc = (br == 0 ? g1 : g2) / lsum;
        oacc_add(o, sc, false);
    };
    branch(IC<0>{});
    branch(IC<1>{});
    {
        h16* mixp = (h16*)(P->ws + OFF_MIX) + kb_idx(NT, tokg, 512 + ghead * 64);
        const h16* ngp = proj + tokg * D_IN + C_NG + ghead * 64;
#pragma unroll
        for (int dt = 0; dt < 2; ++dt)
#pragma unroll
            for (int g4 = 0; g4 < 4; ++g4) {
                const int d0 = 32 * dt + 8 * g4 + 4 * h;
                const half4 ng = *(const half4*)(ngp + d0);
                half4 ov;
#pragma unroll
                for (int e = 0; e < 4; ++e) ov[e] = (h16)((float)oacc[dt * 2 + (g4 >> 1)][(g4 & 1) * 4 + e] * siluf_((float)ng[e]));
                *(half4*)(mixp + d0) = ov;
            }
    }
    __syncthreads();
}

DI void gla_kv_item(PP P, int l, int item, char* smem, const int wv) {
    P = plaunder(P);
    const int tid = otid(wv), lane = tid & 63, w = tid >> 6, r = lane & 31, hh = lane >> 5;
    const int pair = item * 4 + w, h = pair & 3, cn = pair >> 2;
    const size_t tok = (size_t)cn * 32 + r;
    const int b = cn >> 8, n = cn & 255, bh = b * 4 + h;
    const h16* proj = (const h16*)(P->ws + OFF_PROJ);
    h16* VT = (h16*)(smem + w * 16384);
    h16* KT = VT + 2048;
    __syncthreads();
    {
        const half8* vp = (const half8*)(proj + tok * D_IN + C_GV + h * 64 + hh * 32);
#pragma unroll
        for (int q = 0; q < 4; ++q) {
            const half8 v8 = vp[q];
#pragma unroll
            for (int e = 0; e < 8; ++e) VT[(hh * 32 + q * 8 + e) * 32 + r] = v8[e];
        }
    }
    float gl[16];
    {
        const half8* lp = (const half8*)(proj + tok * D_IN + C_GLR);
        const half8 l0 = lp[0], l1 = lp[1];
        float lr[16];
#pragma unroll
        for (int q = 0; q < 8; ++q) { lr[q] = (float)l0[q]; lr[8 + q] = (float)l1[q]; }
        const float* w2 = P->in[I_GW2] + (size_t)l * 16 * 128 + h * 32 + 16 * hh;
        const float* b2 = P->in[I_GB2] + l * 128 + h * 32 + 16 * hh;
#pragma unroll
        for (int d = 0; d < 16; ++d) gl[d] = b2[d];
#pragma unroll
        for (int q = 0; q < 16; ++q)
#pragma unroll
            for (int d4 = 0; d4 < 4; ++d4) {
                const float4 wq = *(const float4*)(w2 + q * 128 + d4 * 4);
                gl[d4 * 4 + 0] += lr[q] * wq.x; gl[d4 * 4 + 1] += lr[q] * wq.y; gl[d4 * 4 + 2] += lr[q] * wq.z; gl[d4 * 4 + 3] += lr[q] * wq.w;
            }
#pragma unroll
        for (int d = 0; d < 16; ++d) gl[d] = log_sigmoidf_(gl[d]) * (1.f / 16.f);
    }
#pragma unroll
    for (int off = 1; off < 32; off <<= 1) {
#pragma unroll
        for (int d = 0; d < 16; ++d) { const float v = __shfl_up(gl[d], off, 32); if (r >= off) gl[d] += v; }
    }
    {
        float* bc = (float*)(P->ws + OFF_BCUM) + tok * 128 + h * 32 + 16 * hh;
#pragma unroll
        for (int d4 = 0; d4 < 4; ++d4) *(float4*)(bc + d4 * 4) = (float4){gl[d4 * 4], gl[d4 * 4 + 1], gl[d4 * 4 + 2], gl[d4 * 4 + 3]};
    }
    {
        const half8* kp = (const half8*)(proj + tok * D_IN + C_GK + h * 32 + 16 * hh);
        const half8 k0 = kp[0], k1 = kp[1];
        float bl[16];
#pragma unroll
        for (int d = 0; d < 16; ++d) bl[d] = __shfl(gl[d], 31, 32);
#pragma unroll
        for (int d = 0; d < 16; ++d) {
            const float kd = (float)(d < 8 ? k0[d & 7] : k1[d & 7]) * __expf(bl[d] - gl[d]);
            KT[(16 * hh + d) * 32 + r] = (h16)kd;
        }
        if (r == 0) {
            float* dc = (float*)(P->ws + OFF_GDEC) + (size_t)(bh * 256 + n) * 32 + 16 * hh;
#pragma unroll
            for (int d4 = 0; d4 < 4; ++d4) *(float4*)(dc + d4 * 4) = (float4){__expf(bl[d4 * 4]), __expf(bl[d4 * 4 + 1]), __expf(bl[d4 * 4 + 2]), __expf(bl[d4 * 4 + 3])};
        }
    }
    asm volatile("s_waitcnt lgkmcnt(0)" ::: "memory");
    const half8 kb0 = *(const half8*)(KT + r * 32 + 8 * hh), kb1 = *(const half8*)(KT + r * 32 + 16 + 8 * hh);
    float* kvp = (float*)(P->ws + OFF_GKV) + ((size_t)(bh * 256 + n) * 32 + r) * 64;
#pragma unroll
    for (int dt = 0; dt < 2; ++dt) {
        f32x16 o;
#pragma unroll
        for (int e = 0; e < 16; ++e) o[e] = 0.f;
        const h16* vrow = VT + (32 * dt + r) * 32 + 8 * hh;
        o = MFMA32(*(const half8*)vrow, kb0, o);
        o = MFMA32(*(const half8*)(vrow + 16), kb1, o);
#pragma unroll
        for (int g4 = 0; g4 < 4; ++g4)
            *(float4*)(kvp + 32 * dt + 8 * g4 + 4 * hh) = (float4){o[4 * g4], o[4 * g4 + 1], o[4 * g4 + 2], o[4 * g4 + 3]};
    }
    __syncthreads();
}

DI void gla_out_item(PP P, int l, int item, char* smem, const int wv) {
    P = plaunder(P);
    const int tid = otid(wv), lane = tid & 63, w = tid >> 6, r = lane & 31, hh = lane >> 5;
    const int pair = item * 4 + w, h = pair & 3, cn = pair >> 2;
    const size_t tok0 = (size_t)cn * 32, tok = tok0 + r;
    const int b = cn >> 8, n = cn & 255, bh = b * 4 + h;
    const h16* proj = (const h16*)(P->ws + OFF_PROJ);
    h16* VT = (h16*)(smem + w * 16384);
    h16* SPT = VT + 2048;
    __syncthreads();
    {
        const half8* vp = (const half8*)(proj + tok * D_IN + C_GV + h * 64 + hh * 32);
        const float4* sp = (const float4*)((const float*)(P->ws + OFF_GKV) + ((size_t)(bh * 256 + n) * 32 + r) * 64 + hh * 32);
#pragma unroll
        for (int q = 0; q < 4; ++q) {
            const half8 v8 = vp[q];
            const float4 s0 = sp[2 * q], s1 = sp[2 * q + 1];
#pragma unroll
            for (int e = 0; e < 8; ++e) VT[(hh * 32 + q * 8 + e) * 32 + r] = v8[e];
            SPT[(hh * 32 + q * 8 + 0) * 32 + r] = (h16)s0.x; SPT[(hh * 32 + q * 8 + 1) * 32 + r] = (h16)s0.y;
            SPT[(hh * 32 + q * 8 + 2) * 32 + r] = (h16)s0.z; SPT[(hh * 32 + q * 8 + 3) * 32 + r] = (h16)s0.w;
            SPT[(hh * 32 + q * 8 + 4) * 32 + r] = (h16)s1.x; SPT[(hh * 32 + q * 8 + 5) * 32 + r] = (h16)s1.y;
            SPT[(hh * 32 + q * 8 + 6) * 32 + r] = (h16)s1.z; SPT[(hh * 32 + q * 8 + 7) * 32 + r] = (h16)s1.w;
        }
    }
    half8 qe[2], ke[2];
#pragma unroll
    for (int ks = 0; ks < 2; ++ks) {
        const int d0 = 16 * ks + 8 * hh;
        const half8 q8 = *(const half8*)(proj + tok * D_IN + C_GQ + h * 32 + d0);
        const half8 k8 = *(const half8*)(proj + tok * D_IN + C_GK + h * 32 + d0);
        const float4 b0 = *(const float4*)((const float*)(P->ws + OFF_BCUM) + tok * 128 + h * 32 + d0);
        const float4 b1 = *(const float4*)((const float*)(P->ws + OFF_BCUM) + tok * 128 + h * 32 + d0 + 4);
        const float bc[8] = {b0.x, b0.y, b0.z, b0.w, b1.x, b1.y, b1.z, b1.w};
#pragma unroll
        for (int e = 0; e < 8; ++e) {
            const float ex = __expf(bc[e]);
            qe[ks][e] = (h16)((float)q8[e] * 0.17677669529663687f * ex);
            ke[ks][e] = (h16)((float)k8[e] * __builtin_amdgcn_rcpf(ex));
        }
    }
    f32x16 s;
#pragma unroll
    for (int e = 0; e < 16; ++e) s[e] = 0.f;
    s = MFMA32(ke[0], qe[0], s);
    s = MFMA32(ke[1], qe[1], s);
#pragma unroll
    for (int e = 0; e < 16; ++e) { const int j = (e & 3) + 8 * (e >> 2) + 4 * hh; if (j > r) s[e] = 0.f; }
    const half8 pb0 = pack8<0>(s), pb1 = pack8<1>(s);
    asm volatile("s_waitcnt lgkmcnt(0)" ::: "memory");
    f32x16 o[2];
#pragma unroll
    for (int dt = 0; dt < 2; ++dt) {
#pragma unroll
        for (int e = 0; e < 16; ++e) o[dt][e] = 0.f;
        const h16* vrow = VT + (32 * dt + r) * 32 + 4 * hh;
        const h16* srow = SPT + (32 * dt + r) * 32 + 8 * hh;
        {
            const half4 lo = *(const half4*)vrow, hi = *(const half4*)(vrow + 8);
            o[dt] = MFMA32(((half8){lo[0], lo[1], lo[2], lo[3], hi[0], hi[1], hi[2], hi[3]}), pb0, o[dt]);
        }
        {
            const half4 lo = *(const half4*)(vrow + 16), hi = *(const half4*)(vrow + 24);
            o[dt] = MFMA32(((half8){lo[0], lo[1], lo[2], lo[3], hi[0], hi[1], hi[2], hi[3]}), pb1, o[dt]);
        }
        o[dt] = MFMA32(*(const half8*)srow, qe[0], o[dt]);
        o[dt] = MFMA32(*(const half8*)(srow + 16), qe[1], o[dt]);
    }
    float ss = 0.f;
#pragma unroll
    for (int e = 0; e < 16; ++e) ss += o[0][e] * o[0][e] + o[1][e] * o[1][e];
    ss = xhalf_sum(ss);
    const float rn = rsqrtf(ss * (1.f / 64.f) + 1e-6f);
    h16* mix = (h16*)(P->ws + OFF_MIX);
#pragma unroll
    for (int dt = 0; dt < 2; ++dt)
#pragma unroll
        for (int g4 = 0; g4 < 4; ++g4) {
            const int e0 = 32 * dt + 8 * g4 + 4 * hh;
            const half4 gt = *(const half4*)(proj + tok * D_IN + C_GG + h * 64 + e0);
            const float4 on = *(const float4*)(P->in[I_GON] + l * 64 + e0);
            half4 ov;
            ov[0] = (h16)(o[dt][4 * g4 + 0] * rn * on.x * siluf_((float)gt[0]));
            ov[1] = (h16)(o[dt][4 * g4 + 1] * rn * on.y * siluf_((float)gt[1]));
            ov[2] = (h16)(o[dt][4 * g4 + 2] * rn * on.z * siluf_((float)gt[2]));
            ov[3] = (h16)(o[dt][4 * g4 + 3] * rn * on.w * siluf_((float)gt[3]));
            *(half4*)(mix + kb_idx(NT, tok, h * 64 + e0)) = ov;
        }
    __syncthreads();
}

DI void glu_tile(PP P, int l, int tile, char* smem, const int wv) {
    P = plaunder(P);
    const int mt = tile >> 2, nt = tile & 3;
    f32x4 acc[4][4];
    float ssd[4];
    gemm_mainloop_glds<false>(wv, 256, APlain{(const h16*)(P->ws + OFF_YACT) + (size_t)mt * 128 * 256, 256, 64},
                              (const h16*)(P->ws + OFF_WTGLU) + ((size_t)l * 512 + nt * 128) * 256, 256, acc, ssd, smem);
    const int tid = otid(wv), lane = tid & 63, wid = tid >> 6, wr = wid >> 1, wc = wid & 1;
    const h16* proj = (const h16*)(P->ws + OFF_PROJ);
    h16* mix = (h16*)(P->ws + OFF_MIX);
    const float* gb = P->in[I_GLUB] + l * 512;
#pragma unroll
    for (int i = 0; i < 4; ++i) {
        const size_t tok = (size_t)mt * 128 + wr * 64 + i * 16 + (lane & 15);
#pragma unroll
        for (int pj = 0; pj < 2; ++pj) {
            const int c = nt * 64 + wc * 32 + pj * 16 + (lane >> 4) * 4;
            const f32x4 z1 = acc[i][2 * pj], z2 = acc[i][2 * pj + 1];
            const float4 b1 = *(const float4*)(gb + c), b2 = *(const float4*)(gb + 256 + c);
            const half4 g4 = *(const half4*)(proj + tok * D_IN + C_SG + c);
            half4 o;
            o[0] = (h16)((z1[0] + b1.x) * sigmoidf_(z2[0] + b2.x) * siluf_((float)g4[0]));
            o[1] = (h16)((z1[1] + b1.y) * sigmoidf_(z2[1] + b2.y) * siluf_((float)g4[1]));
            o[2] = (h16)((z1[2] + b1.z) * sigmoidf_(z2[2] + b2.z) * siluf_((float)g4[2]));
            o[3] = (h16)((z1[3] + b1.w) * sigmoidf_(z2[3] + b2.w) * siluf_((float)g4[3]));
            *(half4*)(mix + kb_idx(NT, tok, 256 + c)) = o;
        }
    }
}

DI void outproj_tile(PP P, int l, int mt, int nt, char* smem, const int wv) {
    P = plaunder(P);
    f32x4 acc[8][4];
    float ssd[8];
    gemm_glds<false, 2, 8, 4, 3>(wv, 1024, APlain{(const h16*)(P->ws + OFF_MIX) + (size_t)mt * 256 * 64, 64, (size_t)NT * 64},
                              (const h16*)(P->ws + OFF_WTOUT) + ((size_t)l * 16 * 1024 + nt * 128) * 64, 64, acc, ssd, smem, (size_t)1024 * 64);
    const int tid = otid(wv), lane = tid & 63, wid = tid >> 6, wr = wid >> 1, wc = wid & 1;
    const float* xin = (l == 0) ? P->in[I_X] : P->out;
    h16* xh = (h16*)(P->ws + OFF_XH);
#pragma unroll
    for (int i = 0; i < 8; ++i) {
        const size_t row = (size_t)mt * 256 + wr * 128 + i * 16 + (lane & 15);
#pragma unroll
        for (int jj = 0; jj < 4; ++jj) {
            const int n = nt * 128 + wc * 64 + jj * 16 + (lane >> 4) * 4;
            const f32x4 v = acc[i][jj];
            const float4 xo = *(const float4*)(xin + row * 1024 + n);
            const float4 xn = (float4){xo.x + v[0], xo.y + v[1], xo.z + v[2], xo.w + v[3]};
            *(float4*)(P->out + row * 1024 + n) = xn;
            *(half4*)(xh + kb_idx(NT, row, n)) = (half4){(h16)xn.x, (h16)xn.y, (h16)xn.z, (h16)xn.w};
        }
    }
}

#define XB_TMO      128
#define XB_XCNT(j)  (256  + 64 * (j))
#define XB_XSUB(j)  (1280 + 64 * (j))
#define XB_XGEN(j)  (2304 + 64 * (j))
#define XB_TOP      3328
#define XB_TOPGEN   3392
#define XCD_BAR_WORDS 3456
#define XB_SPIN_CAP (1u << 18)
#define LAS __attribute__((address_space(3)))

__device__ __forceinline__ unsigned xb_ld(unsigned* p)              { return __hip_atomic_load(p, __ATOMIC_RELAXED, __HIP_MEMORY_SCOPE_AGENT); }
__device__ __forceinline__ unsigned xb_add(unsigned* p, unsigned v) { return __hip_atomic_fetch_add(p, v, __ATOMIC_RELAXED, __HIP_MEMORY_SCOPE_AGENT); }
__device__ __forceinline__ unsigned xb_xcc_id() { return (unsigned)__builtin_amdgcn_s_getreg((3 << 11) | 20) & 0xFu; }
#define XB_SPIN(cond, bar) do { unsigned _sp = 0; while (cond) { __builtin_amdgcn_s_sleep(1); \
    if ((++_sp & 255u) == 0u) { if (xb_ld(&(bar)[XB_TMO])) break; if (_sp > XB_SPIN_CAP) { atomicAdd(&(bar)[XB_TMO], 1u); break; } } } } while (0)

struct XcdBarrier {
    unsigned* bar; unsigned x;
    volatile LAS unsigned* st;
};

__device__ __forceinline__ XcdBarrier xcd_barrier_post(unsigned* bar, volatile LAS unsigned* st) {
    XcdBarrier b; b.bar = bar; b.x = xb_xcc_id(); b.st = st;
    if (threadIdx.x == 0) (void)xb_add(&bar[XB_XCNT(b.x)], 1u);
    return b;
}
__device__ __forceinline__ void xcd_barrier_complete(unsigned* bar, unsigned x, unsigned& nloc, unsigned& nx) {
    const unsigned G = gridDim.x * gridDim.y * gridDim.z;
    unsigned sum, cnt, mine, sp = 0u;
    for (;;) {
        sum = 0u; cnt = 0u; mine = 0u;
#pragma unroll
        for (unsigned j = 0; j < 16; ++j) { const unsigned c = xb_ld(&bar[XB_XCNT(j)]); sum += c; cnt += (c > 0u) ? 1u : 0u; mine = (j == x) ? c : mine; }
        if (sum == G) break;
        __builtin_amdgcn_s_sleep(1);
        if ((++sp & 255u) == 0u) { if (xb_ld(&bar[XB_TMO])) break; if (sp > XB_SPIN_CAP) { atomicAdd(&bar[XB_TMO], 1u); break; } }
    }
    nloc = mine > 0u ? mine : 1u; nx = cnt > 0u ? cnt : 1u;
}

__device__ __forceinline__ void xcd_barrier(const XcdBarrier& b) {
    asm volatile("s_waitcnt vmcnt(0)" ::: "memory");
    __syncthreads();
    if (threadIdx.x == 0) {
        unsigned* bar = b.bar;
        __builtin_amdgcn_s_waitcnt(0);
        unsigned nloc = b.st[0], nx = b.st[1];
        if (nloc == 0u) { xcd_barrier_complete(bar, b.x, nloc, nx); b.st[0] = nloc; b.st[1] = nx; }
        const unsigned old = xb_add(&bar[XB_XSUB(b.x)], 1u);
        const unsigned gen = old / nloc;
        if (old + 1u == (gen + 1u) * nloc) {
            __builtin_amdgcn_fence(__ATOMIC_RELEASE, "agent");
            asm volatile("s_waitcnt vmcnt(0)" ::: "memory");
            const unsigned og = xb_add(&bar[XB_TOP], 1u);
            const unsigned tg = og / nx;
            if (og + 1u == (tg + 1u) * nx) xb_add(&bar[XB_TOPGEN], 1u);
            else XB_SPIN(xb_ld(&bar[XB_TOPGEN]) == tg, bar);
            __builtin_amdgcn_fence(__ATOMIC_ACQUIRE, "agent");
            xb_add(&bar[XB_XGEN(b.x)], 1u);
            asm volatile("s_waitcnt vmcnt(0)" ::: "memory");
        } else {
            XB_SPIN(xb_ld(&bar[XB_XGEN(b.x)]) == gen, bar);
            __builtin_amdgcn_fence(__ATOMIC_ACQUIRE, "agent");
            asm volatile("s_waitcnt vmcnt(0)" ::: "memory");
        }
    }
    __syncthreads();
}


__global__ void __launch_bounds__(NTHREADS, 2) fwd_megakernel(Params Pval) {
    PP P = (PP)__builtin_amdgcn_kernarg_segment_ptr();
    extern __shared__ __attribute__((aligned(16))) char smem[];
    cg::grid_group grid = cg::this_grid();
    const int G = gridDim.x, bid = blockIdx.x;
    const int wv = __builtin_amdgcn_readfirstlane((int)(threadIdx.x >> 6));

    uint4& xb_words = *(uint4*)(smem + SMEM_MAIN);
    if (otid(wv) == 0) xb_words = make_uint4(0u, 0u, 0u, 0u);
    __syncthreads();
    if (P->ws == nullptr) grid.sync();
    const XcdBarrier xb = xcd_barrier_post((unsigned*)(P->ws + OFF_BAR), (volatile LAS unsigned*)(smem + SMEM_MAIN));
    int vxcd = bid & 7, vjx = bid >> 3;
    {
        unsigned* xcnt = (unsigned*)(P->ws + OFF_BAR) + XCD_BAR_WORDS;
        volatile LAS unsigned* lw = (volatile LAS unsigned*)(smem + SMEM_MAIN) + 2;
        if (otid(wv) == 0) lw[0] = xb.x < 8u ? xb_add(&xcnt[xb.x], 1u) : 0xffffu;
        phase0(P, smem, wv);
        xcd_barrier(xb);
        if (otid(wv) == 0) {
            bool ok = (G & 7) == 0 && xb.x < 8u;
            for (int j = 0; j < 8; ++j) ok = ok && (xb_ld(&xcnt[j]) == (unsigned)(G >> 3));
            lw[1] = ok ? 1u : 0u;
        }
        __syncthreads();
        if (lw[1]) { vxcd = (int)xb.x; vjx = (int)lw[0]; }
    }
    vxcd = __builtin_amdgcn_readfirstlane(vxcd); vjx = __builtin_amdgcn_readfirstlane(vjx);

#pragma unroll 1
    for (int l = 0; l < DEPTH; ++l) {
        {
            const int xcd = vxcd, jx = vjx, nper = G >> 3;
            for (int u = jx; u < 192; u += nper) inproj_tile<2, 8>(P, l, (xcd * 8 + (u & 7)) * 256, (u >> 3) * 128, smem, wv);
            for (int it = jx; it < 16 + 40; it += nper) {
                if (it < 16) inproj_tile<4, 2>(P, l, (xcd * 16 + it) * 128, 3072, smem, wv);
                else s5_build_item(P, l, (it - 16) * 8 + xcd, smem, wv);
            }
        }
        xcd_barrier(xb);
#pragma unroll 1
        for (int w = bid; w < 128 + 64 + 512; w += G) {
            if (w < 128) cmp_gemm_tile(P, l, w, smem, wv);
            else if (w < 192) s5e_gemm_tile(P, l, w - 128, smem, wv);
            else gla_kv_item(P, l, w - 192, smem, wv);
        }
        xcd_barrier(xb);
#pragma unroll 1
        for (int w = bid; w < 512 + 512 + 64; w += G) {
            if (w < 512) cmp_l2_item(P, l, w, smem, wv);
            else if (w < 1024) gla_scan_item(P, w - 512, smem, wv);
            else s5_scan_item(P, w - 1024, smem, wv);
        }
        xcd_barrier(xb);
        bool nsa_fast;
        {
            const int ln = otid(wv) & 63;
            const float gq = wave_max(fabsf(P->in[I_NQN][l * 64 + ln]));
            const float gk = wave_max(fmaxf(fmaxf(fabsf(P->in[I_NKN][(l * 3 + 0) * 64 + ln]), fabsf(P->in[I_NKN][(l * 3 + 1) * 64 + ln])), fabsf(P->in[I_NKN][(l * 3 + 2) * 64 + ln])));
            nsa_fast = __builtin_amdgcn_readfirstlane((8.f * 1.4426950408889634f * gq * gk - FAST_SHIFT < 15.f) ? 1 : 0) != 0;
        }
#pragma unroll 1
        for (int w0 = bid; w0 < 512 + 512 + 512; w0 += G) {
            const int w = w0 < G ? vjx * 8 + vxcd : w0;
            if (w < 512) {
                const int bg = w & 3, q = w >> 2;
                if (nsa_fast) { nsa_unit<true>(P, l, bg, 255 - q, smem, wv); nsa_unit<true>(P, l, bg, q, smem, wv); }
                else { nsa_unit<false>(P, l, bg, 255 - q, smem, wv); nsa_unit<false>(P, l, bg, q, smem, wv); }
            } else if (w < 512 + 512) s5o_gemm_tile(P, l, w - 512, smem, wv);
            else gla_out_item(P, l, w - 1024, smem, wv);
        }
        xcd_barrier(xb);
#pragma unroll 1
        for (int w = bid; w < 512; w += G) glu_tile(P, l, w, smem, wv);
        xcd_barrier(xb);
        {
            const int xcd = vxcd, jx = vjx, nper = G >> 3;
            for (int u = jx; u < 64; u += nper) outproj_tile(P, l, xcd * 8 + (u & 7), u >> 3, smem, wv);
        }
        xcd_barrier(xb);
    }
}

extern "C" void kernel_launch(void* const* d_in, const int* in_sizes, int n_in, void* d_out, int out_size, void* d_ws,
                              size_t ws_size, hipStream_t stream) {
    static int grid_blocks = 0;
    if (!grid_blocks) {
        int dev = 0, cus = 0, per_cu = 0;
        hipGetDevice(&dev);
        hipDeviceGetAttribute(&cus, hipDeviceAttributeMultiprocessorCount, dev);
        hipFuncSetAttribute((const void*)fwd_megakernel, hipFuncAttributeMaxDynamicSharedMemorySize, SMEM_BYTES);
        hipOccupancyMaxActiveBlocksPerMultiprocessor(&per_cu, fwd_megakernel, NTHREADS, SMEM_BYTES);
        if (per_cu < 1) per_cu = 1;
        if (per_cu > 2) per_cu = 2;
        grid_blocks = cus * per_cu;
        if (ws_size < WS_END) fprintf(stderr, "kernel_launch: workspace too small: %zu < %zu\n", ws_size, (size_t)WS_END);
    }
    Params p{};
    for (int i = 0; i < 25; ++i) p.in[i] = (const float*)d_in[i];
    p.out = (float*)d_out;
    p.ws = (char*)d_ws;
    void* args[] = {&p};
    (void)hipMemsetAsync((char*)d_ws + OFF_BAR, 0, (XCD_BAR_WORDS + 16) * sizeof(unsigned), stream);
    hipError_t e = hipLaunchCooperativeKernel((const void*)fwd_megakernel, dim3(grid_blocks), dim3(NTHREADS), args, SMEM_BYTES, stream);
    if (e != hipSuccess) fprintf(stderr, "cooperative launch failed: %s (grid %d)\n", hipGetErrorString(e), grid_blocks);
}
```

```cpp
#include <hip/hip_runtime.h>
#include <hip/hip_cooperative_groups.h>
#include <cstdio>
#include <cstdint>
namespace cg = cooperative_groups;

typedef _Float16 h16;
typedef _Float16 half8 __attribute__((ext_vector_type(8)));
typedef _Float16 half4 __attribute__((ext_vector_type(4)));
typedef float f32x4 __attribute__((ext_vector_type(4)));
typedef float f32x16 __attribute__((ext_vector_type(16)));

#define DI __device__ __forceinline__

constexpr int D_MODEL = 1024, BATCH = 2, SEQ = 8192, DEPTH = 4, NT = BATCH * SEQ;
constexpr int D_IN = 3112, D_IN_PAD = 3200;
constexpr int C_NQ = 0, C_NKV = 512, C_NG = 1280, C_GQ = 1792, C_GK = 1920, C_GV = 2048, C_GG = 2304, C_SU = 2560, C_SG = 2816,
              C_GLR = 3072, C_NGL = 3088;
__host__ __device__ constexpr int map_col(int c) {
    return c < 128 ? C_GQ + c : c < 256 ? C_GK + (c - 128) : c < 512 ? C_GV + (c - 256) : c < 528 ? C_GLR + (c - 512)
         : c < 784 ? C_GG + (c - 528) : c < 1040 ? C_SU + (c - 784) : c < 1296 ? C_SG + (c - 1040) : c < 1808 ? C_NQ + (c - 1296)
         : c < 2576 ? C_NKV + (c - 1808) : c < 2600 ? C_NGL + (c - 2576) : c < 3112 ? C_NG + (c - 2600) : c;
}
constexpr int NTHREADS = 256;
constexpr float QSCALE = 0.125f * 1.4426950408889634f;

enum { I_X = 0, I_NORMG, I_WIN, I_GW2, I_GB2, I_GON, I_LRE, I_LIM, I_LSTEP, I_BRE, I_BIM, I_CRE, I_CIM, I_SD, I_GLUW, I_GLUB,
       I_NGB, I_NQN, I_NKN, I_CPOS, I_CW1, I_CB1, I_CW2, I_CB2, I_WOUT };

constexpr size_t OFF_WTIN  = 0;
constexpr size_t OFF_WTOUT = OFF_WTIN  + 4ull * D_IN_PAD * 1024 * 2;
constexpr size_t OFF_WTGLU = OFF_WTOUT + 4ull * 1024 * 1024 * 2;
constexpr size_t OFF_WTC1  = OFF_WTGLU + 4ull * 512 * 256 * 2;
constexpr size_t OFF_PROJ  = OFF_WTC1  + 4ull * 2 * 256 * 2048 * 2;
constexpr size_t OFF_MIX   = OFF_PROJ  + (size_t)NT * D_IN * 2;
constexpr size_t OFF_YACT  = OFF_MIX   + (size_t)NT * 1024 * 2;
constexpr size_t OFF_XH    = OFF_YACT;
constexpr size_t OFF_BCUM  = OFF_YACT  + (size_t)NT * 256 * 2;
constexpr size_t OFF_GKV   = OFF_BCUM  + (size_t)NT * 128 * 4;
constexpr size_t OFF_GDEC  = OFF_GKV   + 8ull * 256 * 2048 * 4;
static_assert(OFF_GDEC - OFF_XH >= (size_t)NT * 1024 * 2, "XH alias region too small");
constexpr size_t OFF_XC    = OFF_GDEC  + 8ull * 256 * 32 * 4;
constexpr size_t OFF_S5W   = OFF_XC    + 512ull * 1024 * 2 * 4;
constexpr size_t OFF_S5E   = OFF_S5W   + 16ull * 512 * 640 * 2;
constexpr size_t OFF_S5AL  = OFF_S5E   + 16ull * 128 * 512 * 2;
constexpr size_t OFF_CHID  = OFF_S5AL  + 1024ull * 2 * 4;
constexpr size_t OFF_POSB  = OFF_CHID  + 2ull * 2048 * 512 * 4;
constexpr size_t OFF_XCH   = OFF_POSB  + 8ull * 16 * 256 * 4;
constexpr size_t OFF_KCMP  = OFF_XCH   + 512ull * 2048 * 2;
constexpr size_t OFF_VCMP  = OFF_KCMP  + 4ull * 512 * 64 * 2;
constexpr size_t OFF_VTG   = OFF_VCMP  + 4ull * 512 * 64 * 2;
constexpr size_t OFF_BAR   = OFF_VTG   + 2ull * 4 * 128 * 4096 * 2;
constexpr size_t WS_END    = OFF_BAR   + 16384;

struct Params {
    const float* in[25];
    float* out;
    char* ws;
};

__host__ __device__ constexpr size_t kb_idx(size_t nrows, size_t row, int k) { return (((size_t)(k >> 6)) * nrows + row) * 64 + (k & 63); }
typedef const __attribute__((address_space(4))) Params* PP;
DI PP plaunder(PP p) { asm volatile("" : "+s"(p)); return p; }
constexpr int SMEM_MAIN = 73728;
constexpr int SMEM_BYTES = SMEM_MAIN + 16;

DI int otid(const int wv) { int t = wv * 64 + (int)__builtin_amdgcn_mbcnt_hi(~0u, __builtin_amdgcn_mbcnt_lo(~0u, 0u)); asm volatile("" : "+v"(t)); return t; }
DI float wave_sum(float v) {
#pragma unroll
    for (int o = 32; o > 0; o >>= 1) v += __shfl_xor(v, o);
    return v;
}
DI float wave_max(float v) {
#pragma unroll
    for (int o = 32; o > 0; o >>= 1) v = fmaxf(v, __shfl_xor(v, o));
    return v;
}
DI float sigmoidf_(float x) { return 1.f / (1.f + __expf(-x)); }
DI float siluf_(float x) { return x / (1.f + __expf(-x)); }
DI float gelu_tanh(float x) {
    const float u = 0.7978845608028654f * (x + 0.044715f * x * x * x);
    return 0.5f * x * (1.f + tanhf(u));
}
DI float log_sigmoidf_(float x) { return fminf(x, 0.f) - log1pf(__expf(-fabsf(x))); }

typedef _Float16 half2_ __attribute__((ext_vector_type(2)));
DI void glds16(const h16* g, char* l) {
    __builtin_amdgcn_global_load_lds((const __attribute__((address_space(1))) void*)g, (__attribute__((address_space(3))) void*)l, 16, 0, 0);
}
DI int vkperm(int k) { return (k & ~12) | ((k & 4) << 1) | ((k & 8) >> 1); }
struct APlain { const h16* A; size_t lda, astep; DI const h16* operator()(int row, int kt, int c8) const { return A + (size_t)row * lda + (size_t)kt * astep + c8 * 8; } };
struct AS5 {
    const h16* ubase;
    const h16* xin;
    int ch0;
    DI const h16* operator()(int row, int kt, int c8) const {
        const size_t ch = (size_t)(ch0 + row);
        return kt < 8 ? ubase + (ch * 32 + 4 * kt + (c8 >> 1)) * D_IN + (c8 & 1) * 8 : xin + ch * 2048 + (kt - 8) * 64 + c8 * 8;
    }
};
template <int N> DI void gwaitbar();
#define GWB_DEF(N) template <> DI void gwaitbar<N>() { asm volatile("s_waitcnt vmcnt(" #N ") lgkmcnt(0)\n\ts_barrier" ::: "memory"); }
GWB_DEF(0) GWB_DEF(3) GWB_DEF(4) GWB_DEF(6) GWB_DEF(8) GWB_DEF(12)
template <bool SUMSQ, int WR, int MI, int NJ, int NST = 4, class AF>
DI void gemm_glds(const int wv, const int K, const AF& afn, const h16* __restrict__ Bt, const int ldb,
                  f32x4 (&acc)[MI][NJ], float (&ss)[MI], char* smem, const size_t bstep = 64) {
    constexpr int WC = 4 / WR, BM = WR * MI * 16, BN = WC * NJ * 16, AQ = BM / 64, BQ = BN / 64, NG = AQ + BQ, SB = (BM + BN) * 64;
    static_assert(NST * SB <= SMEM_MAIN && AQ >= 1 && BQ >= 1 && (NST == 3 || NST == 4), "ring does not fit the LDS");
    const int tid = otid(wv), lane = tid & 63, wid = tid >> 6, wr = wid / WC, wc = wid % WC;
#pragma unroll
    for (int i = 0; i < MI; ++i) {
        ss[i] = 0.f;
#pragma unroll
        for (int j = 0; j < NJ; ++j) acc[i][j] = (f32x4){0.f, 0.f, 0.f, 0.f};
    }
    const int lrow = wid * 16 + (lane >> 2);
    const int lc4 = (lane & 3) ^ ((-(lrow >> 2)) & 3);
    const h16* bp = Bt + (size_t)lrow * ldb + lc4 * 8;
    char* lbase = smem + wid * 1024;
    const int fr = lane & 15, fq = lane >> 4, sw = (-(fr >> 2)) & 3;
    const int aoff0 = (wr * MI * 16 + fr) * 64 + ((fq ^ sw) * 16);
    const int boff0 = BM * 64 + (wc * NJ * 16 + fr) * 64 + ((fq ^ sw) * 16);
    const int nt = K >> 5;
    auto issue = [&](const int t, char* stage) {
        const int kt = t >> 1, hb = (t & 1) * 4;
#pragma unroll
        for (int q = 0; q < AQ; ++q) glds16(afn(lrow + 64 * q, kt, hb + lc4), stage + q * 4096);
#pragma unroll
        for (int q = 0; q < BQ; ++q) glds16(bp + (size_t)q * 64 * ldb + (size_t)kt * bstep + hb * 8, stage + BM * 64 + q * 4096);
    };
    auto compute = [&](const char* st) {
        half8 af[MI], bf[NJ];
#pragma unroll
        for (int i = 0; i < MI; ++i) af[i] = *(const half8*)(st + aoff0 + i * 1024);
#pragma unroll
        for (int j = 0; j < NJ; ++j) bf[j] = *(const half8*)(st + boff0 + j * 1024);
        if (SUMSQ) {
#pragma unroll
            for (int i = 0; i < MI; ++i)
#pragma unroll
                for (int e = 0; e < 4; ++e) {
                    const half2_ x = (half2_){af[i][2 * e], af[i][2 * e + 1]};
                    ss[i] = __builtin_amdgcn_fdot2(x, x, ss[i], false);
                }
        }
#pragma unroll
        for (int i = 0; i < MI; ++i)
#pragma unroll
            for (int j = 0; j < NJ; ++j) acc[i][j] = __builtin_amdgcn_mfma_f32_16x16x32_f16(bf[j], af[i], acc[i][j], 0, 0, 0);
    };
#define GEMM_STEP(S, t) do { if (NST == 4 && (t) + 2 < nt) gwaitbar<NG>(); else gwaitbar<0>();                       \
        if ((t) + NST - 1 < nt) issue((t) + NST - 1, lbase + (((S) + NST - 1) % NST) * SB); compute(smem + (S) * SB); } while (0)
    gwaitbar<0>();
    {
        const int k = nt < NST - 1 ? nt : NST - 1;
        for (int p = 0; p < k; ++p) issue(p, lbase + p * SB);
        if (k >= 3) gwaitbar<2 * NG>(); else if (k == 2) gwaitbar<NG>(); else gwaitbar<0>();
        __builtin_amdgcn_s_sleep(2);
    }
#pragma unroll 1
    for (int t = 0; t < nt; t += NST) {
        GEMM_STEP(0, t);
        if (t + 1 < nt) GEMM_STEP(1, t + 1);
        if (t + 2 < nt) GEMM_STEP(2, t + 2);
        if (NST == 4 && t + 3 < nt) GEMM_STEP(3 % NST, t + 3);
    }
#undef GEMM_STEP
    asm volatile("s_waitcnt lgkmcnt(0)\n\ts_barrier" ::: "memory");
    if (SUMSQ) {
#pragma unroll
        for (int i = 0; i < MI; ++i) { ss[i] += __shfl_xor(ss[i], 16); ss[i] += __shfl_xor(ss[i], 32); }
    }
}
template <bool SUMSQ, class AF>
DI void gemm_mainloop_glds(const int wv, const int K, const AF& afn, const h16* __restrict__ Bt, const int ldb, f32x4 (&acc)[4][4], float (&ss)[4], char* smem, const size_t bstep = 64) {
    gemm_glds<SUMSQ, 2, 4, 4>(wv, K, afn, Bt, ldb, acc, ss, smem, bstep);
}

DI int glu_perm_dst(int c_orig) {
    const int which = c_orig >> 8, c = c_orig & 255;
    return (c >> 6) * 128 + ((c >> 5) & 1) * 64 + (((c >> 4) & 1) * 2 + which) * 16 + (c & 15);
}
template <int MAP, int KB>
DI void transpose64(const float* __restrict__ src, int R, int C, h16* __restrict__ dst, int r0, int c0,
                    const float* __restrict__ rscale, char* smem, const int wv) {
    h16* tile = (h16*)smem;
    const int tid = otid(wv);
    {
        const int r = tid >> 2, cq = (tid & 3) * 16;
        const float sc = rscale ? rscale[r0 + r] : 1.f;
        const float* sp = src + (size_t)(r0 + r) * C + c0 + cq;
#pragma unroll
        for (int q = 0; q < 4; ++q) {
            float4 v = (float4){0.f, 0.f, 0.f, 0.f};
            if (c0 + cq + q * 4 < C) v = *(const float4*)(sp + q * 4);
            *(half4*)(tile + r * 72 + cq + q * 4) = (half4){(h16)(v.x * sc), (h16)(v.y * sc), (h16)(v.z * sc), (h16)(v.w * sc)};
        }
    }
    __syncthreads();
    {
        const int c = tid >> 2, rq = (tid & 3) * 16;
        half8 o0, o1;
#pragma unroll
        for (int k = 0; k < 8; ++k) { o0[k] = tile[(rq + k) * 72 + c]; o1[k] = tile[(rq + 8 + k) * 72 + c]; }
        const int cc = c0 + c;
        const int dr = MAP == 1 ? map_col(cc) : MAP == 2 ? glu_perm_dst(cc) : cc;
        h16* dp = KB ? dst + ((size_t)(r0 >> 6) * KB + dr) * 64 + rq : dst + (size_t)dr * R + r0 + rq;
        *(half8*)dp = o0; *(half8*)(dp + 8) = o1;
    }
    __syncthreads();
}

DI void phase0(PP P, char* smem, const int wv) {
    P = plaunder(P);
    constexpr int N_WIN = 4 * 16 * 50, N_WOUT = 4 * 16 * 16, N_C1 = 16 * 16 * 4, N_GLU = 4 * 4 * 8, N_XH = NT * 1024 / 2048, N_PB = 8 * 16;
    const int total = N_WIN + N_WOUT + N_C1 + N_GLU + N_XH + N_PB;
    for (int w = blockIdx.x; w < total; w += gridDim.x) {
        if (w < N_WIN) {
            const int l = w / 800, r = w % 800, rt = r / 50, ct = r % 50;
            transpose64<1, D_IN_PAD>(P->in[I_WIN] + (size_t)l * 1024 * D_IN, 1024, D_IN, (h16*)(P->ws + OFF_WTIN) + (size_t)l * D_IN_PAD * 1024,
                           rt * 64, ct * 64, P->in[I_NORMG] + l * 1024, smem, wv);
        } else if (w < N_WIN + N_WOUT) {
            const int v = w - N_WIN, l = v >> 8, r = v & 255, rt = r >> 4, ct = r & 15;
            transpose64<0, 1024>(P->in[I_WOUT] + (size_t)l * 1024 * 1024, 1024, 1024, (h16*)(P->ws + OFF_WTOUT) + (size_t)l * 1024 * 1024,
                           rt * 64, ct * 64, nullptr, smem, wv);
        } else if (w < N_WIN + N_WOUT + N_C1) {
            const int v = w - N_WIN - N_WOUT, ljh = v >> 6, r = v & 63, rt = r >> 2, ct = r & 3;
            transpose64<0, 512>(P->in[I_CW1] + (size_t)ljh * 1024 * 256, 1024, 256, (h16*)(P->ws + OFF_WTC1) + ((size_t)(ljh >> 1) * 16 * 512 + (ljh & 1) * 256) * 64,
                           rt * 64, ct * 64, nullptr, smem, wv);
        } else if (w < N_WIN + N_WOUT + N_C1 + N_GLU) {
            const int v = w - N_WIN - N_WOUT - N_C1, l = v >> 5, r = v & 31, rt = r >> 3, ct = r & 7;
            transpose64<2, 0>(P->in[I_GLUW] + (size_t)l * 256 * 512, 256, 512, (h16*)(P->ws + OFF_WTGLU) + (size_t)l * 512 * 256,
                           rt * 64, ct * 64, nullptr, smem, wv);
        } else if (w < N_WIN + N_WOUT + N_C1 + N_GLU + N_XH) {
            const size_t e0 = ((size_t)(w - N_WIN - N_WOUT - N_C1 - N_GLU) * 256 + otid(wv)) * 8;
            const float4 a = *(const float4*)(P->in[I_X] + e0), b = *(const float4*)(P->in[I_X] + e0 + 4);
            *(half8*)((h16*)(P->ws + OFF_XH) + kb_idx(NT, e0 >> 10, (int)(e0 & 1023))) = (half8){(h16)a.x, (h16)a.y, (h16)a.z, (h16)a.w, (h16)b.x, (h16)b.y, (h16)b.z, (h16)b.w};
        } else {
            const int v = w - (N_WIN + N_WOUT + N_C1 + N_GLU + N_XH), lj = v >> 4, ks = v & 15, n = otid(wv);
            const float* w1 = P->in[I_CW1] + ((size_t)lj * 2048 + ks * 128) * 256 + n;
            const float* pp = P->in[I_CPOS] + (size_t)lj * 2048 + ks * 128;
            float a = ks == 0 ? P->in[I_CB1][lj * 256 + n] : 0.f;
#pragma unroll 16
            for (int k = 0; k < 128; ++k) a += pp[k] * w1[(size_t)k * 256];
            ((float*)(P->ws + OFF_POSB))[(lj * 16 + ks) * 256 + n] = a;
        }
    }
}

DI void s5_build_item(PP P, int l, int item, char* smem, const int wv) {
    P = plaunder(P);
    float* apow = (float*)smem;
    float* bbar = apow + 64 * 33 * 2;
    float* cc   = bbar + 64 * 16 * 2;
    const int tid = otid(wv);
    const int g = (item < 256) ? (item >> 4) : ((item - 256) >> 2);
    if (tid < 64) {
        const int p = tid;
        const float lre = fminf(P->in[I_LRE][(l * 16 + g) * 64 + p], -1e-4f);
        const float lim = P->in[I_LIM][(l * 16 + g) * 64 + p];
        const float dt = expf(P->in[I_LSTEP][l * 16 + g]);
        const float x = lre * dt, y = lim * dt;
        const float em1 = expm1f(x), cy = cosf(y), sy = sinf(y), sh = sinf(0.5f * y);
        const float ar = (em1 + 1.f) * cy, ai = (em1 + 1.f) * sy;
        const float dr = em1 * cy - 2.f * sh * sh, di = ai;
        const float den = lre * lre + lim * lim;
        const float fr = (dr * lre + di * lim) / den;
        const float fi = (di * lre - dr * lim) / den;
        float pr = 1.f, pi = 0.f;
        for (int k = 0; k <= 32; ++k) {
            apow[(p * 33 + k) * 2] = pr; apow[(p * 33 + k) * 2 + 1] = pi;
            const float nr = pr * ar - pi * ai, ni = pr * ai + pi * ar; pr = nr; pi = ni;
        }
        for (int c = 0; c < 16; ++c) {
            const float br = P->in[I_BRE][((size_t)(l * 16 + g) * 64 + p) * 16 + c];
            const float bi = P->in[I_BIM][((size_t)(l * 16 + g) * 64 + p) * 16 + c];
            bbar[(p * 16 + c) * 2] = fr * br - fi * bi;
            bbar[(p * 16 + c) * 2 + 1] = fr * bi + fi * br;
        }
    }
    for (int e = tid; e < 1024; e += 256) {
        cc[e * 2] = P->in[I_CRE][(size_t)(l * 16 + g) * 1024 + e];
        cc[e * 2 + 1] = P->in[I_CIM][(size_t)(l * 16 + g) * 1024 + e];
    }
    __syncthreads();
    if (item < 256) {
        const int c = item & 15;
        float* kt = cc + 2048;
        for (int idx = tid; idx < 512; idx += 256) {
            const int lag = idx >> 4, c2 = idx & 15;
            float a = 0.f;
            for (int p = 0; p < 64; ++p) {
                const float cr = cc[(c * 64 + p) * 2], ci = cc[(c * 64 + p) * 2 + 1];
                const float xr = apow[(p * 33 + lag) * 2], xi = apow[(p * 33 + lag) * 2 + 1];
                const float br = bbar[(p * 16 + c2) * 2], bi = bbar[(p * 16 + c2) * 2 + 1];
                const float tr = cr * xr - ci * xi, ti = cr * xi + ci * xr;
                a += tr * br - ti * bi;
            }
            kt[idx] = a;
        }
        __syncthreads();
        h16* W = (h16*)(P->ws + OFF_S5W) + (size_t)g * 512 * 640;
        for (int idx = tid; idx < 32 * 640; idx += 256) {
            const int j = idx / 640, k = idx % 640;
            float val = 0.f;
            if (k < 512) {
                const int s = k >> 4, c2 = k & 15, lag = j - s;
                if (lag >= 0) val = kt[lag * 16 + c2];
            } else {
                const int p = (k - 512) >> 1;
                const float cr = cc[(c * 64 + p) * 2], ci = cc[(c * 64 + p) * 2 + 1];
                const float xr = apow[(p * 33 + j + 1) * 2], xi = apow[(p * 33 + j + 1) * 2 + 1];
                val = (k & 1) ? -(cr * xi + ci * xr) : (cr * xr - ci * xi);
            }
            W[(size_t)(j * 16 + c) * 640 + k] = (h16)val;
        }
    } else {
        const int pq = (item - 256) & 3;
        h16* E = (h16*)(P->ws + OFF_S5E) + ((size_t)g * 128 + pq * 32) * 512;
        for (int idx = tid; idx < 32 * 512; idx += 256) {
            const int nl = idx >> 9, k = idx & 511;
            const int p = pq * 16 + (nl >> 1), s = k >> 4, c2 = k & 15;
            const float xr = apow[(p * 33 + 31 - s) * 2], xi = apow[(p * 33 + 31 - s) * 2 + 1];
            const float br = bbar[(p * 16 + c2) * 2], bi = bbar[(p * 16 + c2) * 2 + 1];
            const float val = (nl & 1) ? (xr * bi + xi * br) : (xr * br - xi * bi);
            E[(size_t)nl * 512 + k] = (h16)val;
        }
        if (tid < 16) {
            const int p = pq * 16 + tid;
            float* AL = (float*)(P->ws + OFF_S5AL);
            AL[(g * 64 + p) * 2] = apow[(p * 33 + 32) * 2];
            AL[(g * 64 + p) * 2 + 1] = apow[(p * 33 + 32) * 2 + 1];
        }
    }
    __syncthreads();
}

template <int WR, int MI>
DI void inproj_tile(PP P, int l, int m0, int n0, char* smem, const int wv) {
    P = plaunder(P);
    constexpr int WC = 4 / WR;
    f32x4 acc[MI][4];
    float ss[MI];
    gemm_glds<true, WR, MI, 4, (WR == 2 && MI == 8) ? 3 : 4>(wv, 1024, APlain{(const h16*)(P->ws + OFF_XH) + (size_t)m0 * 64, 64, (size_t)NT * 64},
                               (const h16*)(P->ws + OFF_WTIN) + ((size_t)l * 16 * D_IN_PAD + n0) * 64, 64, acc, ss, smem, (size_t)D_IN_PAD * 64);
    const int tid = otid(wv), lane = tid & 63, wid = tid >> 6, wr = wid / WC, wc = wid % WC;
    h16* proj = (h16*)(P->ws + OFF_PROJ);
    const int n64 = n0 + wc * 64;
    int cls = 0;
    if (n64 < 512) cls = 1;
    else if (n64 >= C_NKV + 256 && n64 < C_NKV + 384) cls = 2;
    else if (n64 >= C_NKV + 512 && n64 < C_NKV + 640) cls = 3;
    else if (n64 >= C_NKV + 384 && n64 < C_NKV + 512) cls = 4;
    else if (n64 >= C_NKV + 640 && n64 < C_NKV + 768) cls = 5;
    float wn[4][4];
    if (cls >= 1 && cls <= 3) {
        const float* wp = (cls == 1) ? P->in[I_NQN] + l * 64 : P->in[I_NKN] + (l * 3 + (cls - 1)) * 64;
        const float sc = (cls == 1) ? QSCALE : 1.f;
#pragma unroll
        for (int j = 0; j < 4; ++j) {
            const float4 w4 = *(const float4*)(wp + j * 16 + (lane >> 4) * 4);
            wn[j][0] = w4.x * sc; wn[j][1] = w4.y * sc; wn[j][2] = w4.z * sc; wn[j][3] = w4.w * sc;
        }
    }
#pragma unroll
    for (int i = 0; i < MI; ++i) {
        const int ml = wr * MI * 16 + i * 16 + (lane & 15);
        const float r = rsqrtf(ss[i] * (1.f / 1024.f) + 1e-6f);
        const size_t row = (size_t)m0 + ml;
        f32x4 v[4];
#pragma unroll
        for (int j = 0; j < 4; ++j) v[j] = acc[i][j] * r;
        if (cls >= 1 && cls <= 3) {
            float s2 = 0.f;
#pragma unroll
            for (int j = 0; j < 4; ++j) s2 += v[j][0] * v[j][0] + v[j][1] * v[j][1] + v[j][2] * v[j][2] + v[j][3] * v[j][3];
            s2 += __shfl_xor(s2, 16); s2 += __shfl_xor(s2, 32);
            const float rn = rsqrtf(s2 * (1.f / 64.f) + 1e-6f);
#pragma unroll
            for (int j = 0; j < 4; ++j) { v[j][0] *= rn * wn[j][0]; v[j][1] *= rn * wn[j][1]; v[j][2] *= rn * wn[j][2]; v[j][3] *= rn * wn[j][3]; }
        }
        if (cls >= 4) {
            const int g = (n64 >> 6) & 1, br = cls - 4;
            const int b = (int)(row >> 13), t = (int)(row & 8191);
            h16* vt = (h16*)(P->ws + OFF_VTG) + ((((size_t)br * 4 + b * 2 + g) * 128 + (t >> 6)) * 64) * 64;
#pragma unroll
            for (int j = 0; j < 4; ++j)
#pragma unroll
                for (int e = 0; e < 4; ++e) vt[(j * 16 + (lane >> 4) * 4 + e) * 64 + vkperm(t & 63)] = (h16)v[j][e];
        }
#pragma unroll
        for (int j = 0; j < 4; ++j) {
            const int n = n64 + j * 16 + (lane >> 4) * 4;
            if (n < D_IN) *(half4*)(proj + row * D_IN + n) = (half4){(h16)v[j][0], (h16)v[j][1], (h16)v[j][2], (h16)v[j][3]};
        }
        __builtin_amdgcn_sched_barrier(0);
    }
    __syncthreads();
}


DI void cmp_gemm_tile(PP P, int l, int tile, char* smem, const int wv) {
    P = plaunder(P);
    const int j = tile >> 6, mt = (tile >> 2) & 15, nt = tile & 3;
    const int row0 = mt * 128, bg = row0 >> 9, i0 = row0 & 511, b = bg >> 1, g = bg & 1;
    f32x4 acc[4][4];
    float ssd[4];
    gemm_mainloop_glds<false>(wv, 1024, APlain{(const h16*)(P->ws + OFF_PROJ) + ((size_t)b * SEQ + 16 * i0) * D_IN + C_NKV + j * 128 + g * 64, (size_t)16 * D_IN, (size_t)D_IN},
                              (const h16*)(P->ws + OFF_WTC1) + ((size_t)(l * 2 + j) * 16 * 512 + nt * 128) * 64, 64, acc, ssd, smem, (size_t)512 * 64);
    const int tid = otid(wv), lane = tid & 63, wid = tid >> 6, wr = wid >> 1, wc = wid & 1;
    float* pt = (float*)(P->ws + OFF_CHID) + (size_t)j * 2048 * 512;
#pragma unroll
    for (int i = 0; i < 4; ++i) {
        const size_t row = (size_t)row0 + wr * 64 + i * 16 + (lane & 15);
#pragma unroll
        for (int jj = 0; jj < 4; ++jj) {
            const int n = nt * 128 + wc * 64 + jj * 16 + (lane >> 4) * 4;
            const f32x4 v = acc[i][jj];
            *(float4*)(pt + row * 512 + n) = (float4){v[0], v[1], v[2], v[3]};
        }
    }
}

DI void s5e_gemm_tile(PP P, int l, int tile, char* smem, const int wv) {
    P = plaunder(P);
    const int g = tile >> 2, mt = tile & 3;
    f32x4 acc[4][4];
    float ssd[4];
    gemm_mainloop_glds<false>(wv, 512, AS5{(const h16*)(P->ws + OFF_PROJ) + C_SU + g * 16, nullptr, mt * 128},
                              (const h16*)(P->ws + OFF_S5E) + (size_t)g * 128 * 512, 512, acc, ssd, smem);
    const int tid = otid(wv), lane = tid & 63, wid = tid >> 6, wr = wid >> 1, wc = wid & 1;
    float* xc = (float*)(P->ws + OFF_XC);
#pragma unroll
    for (int i = 0; i < 4; ++i) {
        const size_t ch = (size_t)mt * 128 + wr * 64 + i * 16 + (lane & 15);
#pragma unroll
        for (int jj = 0; jj < 4; ++jj) {
            const int n = wc * 64 + jj * 16 + (lane >> 4) * 4;
            const f32x4 v = acc[i][jj];
            *(float4*)(xc + (ch * 1024 + g * 64) * 2 + n) = (float4){v[0], v[1], v[2], v[3]};
        }
    }
}

DI void gla_scan_item(PP P, int item, char* smem, const int wv) {
    P = plaunder(P);
    const int tid = otid(wv), sl = tid & 31, part = tid >> 5;
    const int idx = item * 32 + sl, bh = idx >> 11, de = idx & 2047, d = de >> 6;
    float* kv = (float*)(P->ws + OFF_GKV) + ((size_t)bh * 256 + part * 32) * 2048 + de;
    const float* dc = (const float*)(P->ws + OFF_GDEC) + ((size_t)bh * 256 + part * 32) * 32 + d;
    float* sD = (float*)smem; float* sL = sD + 256;
    float kvv[32], dd[32];
#pragma unroll
    for (int i = 0; i < 32; ++i) { kvv[i] = kv[(size_t)i * 2048]; dd[i] = dc[i * 32]; }
    float D = 1.f, L = 0.f;
#pragma unroll
    for (int i = 0; i < 32; ++i) { L = dd[i] * L + kvv[i]; D *= dd[i]; }
    sD[part * 32 + sl] = D; sL[part * 32 + sl] = L;
    __syncthreads();
    float S = 0.f;
    for (int q = 0; q < part; ++q) S = sD[q * 32 + sl] * S + sL[q * 32 + sl];
#pragma unroll
    for (int i = 0; i < 32; ++i) { const float o = S; S = dd[i] * S + kvv[i]; kv[(size_t)i * 2048] = o; }
    __syncthreads();
}
DI void s5_scan_item(PP P, int item, char* smem, const int wv) {
    P = plaunder(P);
    const int tid = otid(wv), sl = tid & 31, part = tid >> 5;
    const int idx = item * 32 + sl, b = idx >> 10, s = idx & 1023;
    float2* xc = (float2*)(P->ws + OFF_XC) + ((size_t)b * 256 + part * 32) * 1024 + s;
    half2_* xch = (half2_*)(P->ws + OFF_XCH) + ((size_t)b * 256 + part * 32) * 1024 + s;
    const float2 a = ((const float2*)(P->ws + OFF_S5AL))[s];
    float2* sL = (float2*)smem;
    float2 c[32];
#pragma unroll
    for (int i = 0; i < 32; ++i) c[i] = xc[(size_t)i * 1024];
    float lr = 0.f, li = 0.f;
#pragma unroll
    for (int i = 0; i < 32; ++i) { const float nr = a.x * lr - a.y * li + c[i].x, ni = a.x * li + a.y * lr + c[i].y; lr = nr; li = ni; }
    float dr = a.x, di = a.y;
#pragma unroll
    for (int i = 0; i < 5; ++i) { const float nr = dr * dr - di * di, ni = 2.f * dr * di; dr = nr; di = ni; }
    sL[part * 32 + sl] = (float2){lr, li};
    __syncthreads();
    float xr = 0.f, xi = 0.f;
    for (int q = 0; q < part; ++q) { const float2 lq = sL[q * 32 + sl]; const float nr = dr * xr - di * xi + lq.x, ni = dr * xi + di * xr + lq.y; xr = nr; xi = ni; }
#pragma unroll
    for (int i = 0; i < 32; ++i) {
        const float2 o = (float2){xr, xi};
        const float nr = a.x * xr - a.y * xi + c[i].x, ni = a.x * xi + a.y * xr + c[i].y; xr = nr; xi = ni;
        xc[(size_t)i * 1024] = o;
        xch[(size_t)i * 1024] = (half2_){(h16)o.x, (h16)o.y};
    }
    __syncthreads();
}
DI void cmp_l2_item(PP P, int l, int item, char* smem, const int wv) {
    P = plaunder(P);
    const int tid = otid(wv), lane = tid & 63, w = tid >> 6;
    const int j = item >> 8, r0 = (item & 255) * 8;
    h16* w2s = (h16*)smem;
    float* hs = (float*)(smem + 32768);
    {
        const float* w2 = P->in[I_CW2] + (size_t)(l * 2 + j) * 256 * 64;
        for (int e = tid * 4; e < 256 * 64; e += 1024) {
            const float4 v = *(const float4*)(w2 + e);
            *(half4*)(w2s + e) = (half4){(h16)v.x, (h16)v.y, (h16)v.z, (h16)v.w};
        }
        const float* pt = (const float*)(P->ws + OFF_CHID) + (size_t)j * 2048 * 512;
        float pb = 0.f;
#pragma unroll
        for (int ks = 0; ks < 16; ++ks) pb += ((const float*)(P->ws + OFF_POSB))[((l * 2 + j) * 16 + ks) * 256 + tid];
#pragma unroll
        for (int rr = 0; rr < 8; ++rr) {
            const int row = r0 + rr, i = row & 511;
            float v = 0.f;
            if (i < 511) v = gelu_tanh(pt[(size_t)row * 512 + tid] + pt[(size_t)(row + 1) * 512 + 256 + tid] + pb);
            hs[rr * 256 + tid] = v;
        }
    }
    __syncthreads();
    const float bb = P->in[I_CB2][(l * 2 + j) * 64 + lane];
    float a0 = bb, a1 = bb;
    const float* h0 = hs + (2 * w) * 256, *h1 = h0 + 256;
#pragma unroll 8
    for (int n = 0; n < 256; ++n) {
        const float wv = (float)w2s[n * 64 + lane];
        a0 += h0[n] * wv; a1 += h1[n] * wv;
    }
#pragma unroll
    for (int rr = 0; rr < 2; ++rr) {
        float acc = rr ? a1 : a0;
        const int row = r0 + 2 * w + rr, bg = row >> 9, i = row & 511;
        if (i == 511) acc = 0.f;
        if (j == 0) {
            const float ss = wave_sum(acc * acc);
            acc = acc * rsqrtf(ss * (1.f / 64.f) + 1e-6f) * P->in[I_NKN][(l * 3 + 0) * 64 + lane];
            ((h16*)(P->ws + OFF_KCMP))[(size_t)row * 64 + lane] = (h16)acc;
        } else {
            ((h16*)(P->ws + OFF_VCMP))[(((size_t)bg * 8 + (i >> 6)) * 64 + lane) * 64 + vkperm(i & 63)] = (h16)acc;
        }
    }
    __syncthreads();
}

DI void s5o_gemm_tile(PP P, int l, int tile, char* smem, const int wv) {
    P = plaunder(P);
    const int g = tile >> 5, mt = (tile >> 3) & 3, nt = tile & 7;
    f32x4 acc[2][4];
    float ssd[2];
    gemm_glds<false, 4, 2, 4>(wv, 640, AS5{(const h16*)(P->ws + OFF_PROJ) + C_SU + g * 16, (const h16*)(P->ws + OFF_XCH) + g * 128, mt * 128},
                              (const h16*)(P->ws + OFF_S5W) + ((size_t)g * 512 + nt * 64) * 640, 640, acc, ssd, smem);
    const int tid = otid(wv), lane = tid & 63, wid = tid >> 6;
    const h16* proj = (const h16*)(P->ws + OFF_PROJ);
    h16* yact = (h16*)(P->ws + OFF_YACT);
#pragma unroll
    for (int i = 0; i < 2; ++i) {
        const size_t ch = (size_t)mt * 128 + wid * 32 + i * 16 + (lane & 15);
#pragma unroll
        for (int jj = 0; jj < 4; ++jj) {
            const int n = nt * 64 + jj * 16 + (lane >> 4) * 4;
            const int j = n >> 4, c = n & 15;
            const size_t tok = ch * 32 + j;
            const half4 u4 = *(const half4*)(proj + tok * D_IN + C_SU + g * 16 + c);
            const float4 dd = *(const float4*)(P->in[I_SD] + (l * 16 + g) * 16 + c);
            const f32x4 v = acc[i][jj];
            half4 o;
            o[0] = (h16)gelu_tanh(v[0] + dd.x * (float)u4[0]);
            o[1] = (h16)gelu_tanh(v[1] + dd.y * (float)u4[1]);
            o[2] = (h16)gelu_tanh(v[2] + dd.z * (float)u4[2]);
            o[3] = (h16)gelu_tanh(v[3] + dd.w * (float)u4[3]);
            *(half4*)(yact + tok * 256 + g * 16 + c) = o;
        }
    }
}

#define MFMA32(a, b, c) __builtin_amdgcn_mfma_f32_32x32x16_f16((a), (b), (c), 0, 0, 0)
constexpr float FAST_SHIFT = 4.f;
constexpr float NEGS = -1e30f;
DI float ex2(float x) { return __builtin_amdgcn_exp2f(x); }
#define NSA_WAITBAR(N) asm volatile("s_waitcnt vmcnt(" #N ") lgkmcnt(0)\n\ts_barrier" ::: "memory")
#define NSA_BAR() asm volatile("s_waitcnt lgkmcnt(0)\n\ts_barrier" ::: "memory")

struct KVSrc { const h16* k; int ldk; size_t kstep; const h16* v; };
DI void nsa_dma(const KVSrc& s, int j, char* stage, int wid, int lane) {
    const int row0 = wid * 8 + (lane >> 3);
    const int sw = ((lane & 7) ^ ((row0 >> 1) & 7)) * 8;
    const h16* kp = s.k + (size_t)j * s.kstep + (size_t)row0 * s.ldk + sw;
    glds16(kp, stage + wid * 1024);
    glds16(kp + (size_t)32 * s.ldk, stage + 4096 + wid * 1024);
    const h16* vp = s.v + (size_t)j * 4096 + row0 * 64 + sw;
    glds16(vp, stage + 8192 + wid * 1024);
    glds16(vp + 32 * 64, stage + 8192 + 4096 + wid * 1024);
}
template <int NST, class F>
DI void nsa_pipe(const KVSrc& s, const int n, char* smem, int wid, int lane, F&& compute) {
    NSA_WAITBAR(0);
    {
        const int k = n < NST - 1 ? n : NST - 1;
        for (int p = 0; p < k; ++p) nsa_dma(s, p, smem + p * 16384, wid, lane);
        if (k >= 3) NSA_WAITBAR(8); else if (k == 2) NSA_WAITBAR(4); else NSA_WAITBAR(0);
        __builtin_amdgcn_s_sleep(2);
    }
    for (int j = 0; j < n; ++j) {
        if (NST == 4 && j + 2 < n) NSA_WAITBAR(4); else NSA_WAITBAR(0);
        const int jn = j + NST - 1;
        compute(j, smem + (j % NST) * 16384, [&]() { if (jn < n) nsa_dma(s, jn, smem + (jn % NST) * 16384, wid, lane); });
    }
}

template <bool SHIFT = false, class BF>
DI void qk_tile(const char* Kimg, const half8 (&qf)[4], f32x16 (&s)[2], int lane, BF&& between) {
    const int r = lane & 31, h = lane >> 5, swz = (r >> 1) & 7;
    const char* base = Kimg + r * 128;
    half8 kf[8];
#pragma unroll
    for (int kt = 0; kt < 2; ++kt)
#pragma unroll
        for (int ks = 0; ks < 4; ++ks) kf[kt * 4 + ks] = *(const half8*)(base + kt * 4096 + (((2 * ks + h) ^ swz) << 4));
    __builtin_amdgcn_sched_barrier(0);
    between();
    __builtin_amdgcn_sched_barrier(0);
#pragma unroll
    for (int kt = 0; kt < 2; ++kt) {
#pragma unroll
        for (int e = 0; e < 16; ++e) s[kt][e] = SHIFT ? -FAST_SHIFT : 0.f;
#pragma unroll
        for (int ks = 0; ks < 4; ++ks) s[kt] = MFMA32(kf[kt * 4 + ks], qf[ks], s[kt]);
    }
}
template <bool SHIFT = false>
DI void qk_tile(const char* Kimg, const half8 (&qf)[4], f32x16 (&s)[2], int lane) { qk_tile<SHIFT>(Kimg, qf, s, lane, []() {}); }
template <int S> DI half8 pack8(const f32x16& x) {
    return (half8){(h16)x[8 * S], (h16)x[8 * S + 1], (h16)x[8 * S + 2], (h16)x[8 * S + 3], (h16)x[8 * S + 4], (h16)x[8 * S + 5], (h16)x[8 * S + 6], (h16)x[8 * S + 7]};
}
template <int KT>
DI void pv_load(const char* Vimg, half8 (&vf)[4], int lane) {
    const int r = lane & 31, h = lane >> 5, swz = (r >> 1) & 7;
    const char* rb = Vimg + r * 128;
#pragma unroll
    for (int dt = 0; dt < 2; ++dt) {
        vf[dt * 2 + 0] = *(const half8*)(rb + dt * 4096 + (((4 * KT + h) ^ swz) << 4));
        vf[dt * 2 + 1] = *(const half8*)(rb + dt * 4096 + (((4 * KT + 2 + h) ^ swz) << 4));
    }
}
typedef unsigned u32x4_ __attribute__((ext_vector_type(4)));
template <int KT, bool MASKED = false>
DI void pv_mma(const half8 (&vf)[4], const f32x16 (&p)[2], f32x16 (&o)[2], const unsigned rmask = 0xffffffffu) {
    half8 pb0 = pack8<0>(p[KT]), pb1 = pack8<1>(p[KT]);
    if (MASKED) {
        pb0 = __builtin_bit_cast(half8, __builtin_bit_cast(u32x4_, pb0) & rmask);
        pb1 = __builtin_bit_cast(half8, __builtin_bit_cast(u32x4_, pb1) & rmask);
    }
#pragma unroll
    for (int dt = 0; dt < 2; ++dt) {
        o[dt] = MFMA32(vf[dt * 2 + 0], pb0, o[dt]);
        o[dt] = MFMA32(vf[dt * 2 + 1], pb1, o[dt]);
    }
}
template <bool MASKED = false>
DI void pv_finish(const char* Vimg, const half8 (&va)[4], const f32x16 (&p)[2], f32x16 (&o)[2], int lane, const unsigned rmask = 0xffffffffu) {
    half8 vb[4];
    pv_load<1>(Vimg, vb, lane);
    pv_mma<0, MASKED>(va, p, o, rmask);
    pv_mma<1, MASKED>(vb, p, o, rmask);
}
DI float sm_fast(f32x16 (&s)[2]) {
    float rs = 0.f;
#pragma unroll
    for (int kt = 0; kt < 2; ++kt)
#pragma unroll
        for (int e = 0; e < 16; ++e) { const float p = ex2(s[kt][e]); s[kt][e] = p; rs += p; }
    return rs;
}
DI float xhalf_max(float v) {
    const auto r = __builtin_amdgcn_permlane32_swap(__float_as_uint(v), __float_as_uint(v), false, false);
    return fmaxf(__uint_as_float(r[0]), __uint_as_float(r[1]));
}
DI float xhalf_sum(float v) {
    const auto r = __builtin_amdgcn_permlane32_swap(__float_as_uint(v), __float_as_uint(v), false, false);
    return __uint_as_float(r[0]) + __uint_as_float(r[1]);
}
DI float rowmax32(const f32x16 (&s)[2]) {
    float mx = s[0][0];
#pragma unroll
    for (int e = 1; e < 16; ++e) mx = fmaxf(mx, s[0][e]);
#pragma unroll
    for (int e = 0; e < 16; ++e) mx = fmaxf(mx, s[1][e]);
    return xhalf_max(mx);
}
constexpr float SM_THR = 6.f;
DI void sm_online(f32x16 (&s)[2], float& m, float& l, f32x16 (&o)[2], const bool rowok) {
    float mx = rowmax32(s);
    mx = rowok ? mx : NEGS;
    if (__any(mx > m + SM_THR)) {
        const float mn = fmaxf(m, mx), alpha = ex2(m - mn);
        l *= alpha; o[0] *= alpha; o[1] *= alpha; m = mn;
    }
    const float msub = rowok ? m : 1e30f;
    float rs = 0.f;
#pragma unroll
    for (int kt = 0; kt < 2; ++kt)
#pragma unroll
        for (int e = 0; e < 16; ++e) { const float p = ex2(s[kt][e] - msub); s[kt][e] = p; rs += p; }
    l += xhalf_sum(rs);
}

template <int V> struct IC { static constexpr int value = V; };
template <bool FAST>
DI void nsa_unit(PP P, int l, int bg, int c32, char* smem, const int wv) {
    P = plaunder(P);
    const int tid = otid(wv), lane = tid & 63, w = tid >> 6, r = lane & 31, h = lane >> 5;
    const int b = bg >> 1, g = bg & 1, t0 = c32 * 32, cur = c32 >> 1;
    const int tokl = w * 8 + (r >> 2), head = r & 3, t = t0 + tokl;
    const size_t tokg = (size_t)b * SEQ + t;
    float* IMP = (float*)(smem + 49152);
    unsigned* SELM = (unsigned*)(smem + 49152);
    const h16* proj = (const h16*)(P->ws + OFF_PROJ);
    const int ghead = g * 4 + head;

    half8 qf[4];
    {
        const h16* qp = proj + tokg * D_IN + C_NQ + ghead * 64 + 8 * h;
#pragma unroll
        for (int ks = 0; ks < 4; ++ks) qf[ks] = *(const half8*)(qp + 16 * ks);
    }
    float g0, g1, g2;
    {
        const h16* gp = proj + tokg * D_IN + C_NGL + ghead * 3;
        const float* gb = P->in[I_NGB] + l * 24 + ghead * 3;
        g0 = sigmoidf_((float)gp[0] + gb[0]); g1 = sigmoidf_((float)gp[1] + gb[1]); g2 = sigmoidf_((float)gp[2] + gb[2]);
    }
    __syncthreads();
    for (int i = tid; i < 32 * 128; i += 256) IMP[i] = 0.f;

    half8 oacc[4];
    auto oacc_add = [&](const f32x16 (&o)[2], const float sc, const bool first) {
#pragma unroll
        for (int dt = 0; dt < 2; ++dt)
#pragma unroll
            for (int hf = 0; hf < 2; ++hf) {
                half8 v = oacc[dt * 2 + hf];
#pragma unroll
                for (int e = 0; e < 8; ++e) v[e] = (h16)((first ? 0.f : (float)v[e]) + o[dt][hf * 8 + e] * sc);
                oacc[dt * 2 + hf] = v;
            }
    };

    {
        const int nvt = 2 * c32 + 1;
        const int nvr = (t >= 31) ? ((t - 31) >> 4) + 1 : 0;
        const int ntile = (nvt + 63) >> 6;
        KVSrc src{(const h16*)(P->ws + OFF_KCMP) + (size_t)bg * 512 * 64, 64, 4096, (const h16*)(P->ws + OFF_VCMP) + (size_t)bg * 8 * 4096};
        f32x16 o[2];
#pragma unroll
        for (int e = 0; e < 16; ++e) { o[0][e] = 0.f; o[1][e] = 0.f; }
        float invl;
        if constexpr (FAST) {
            const int tf = t0 + w * 8;
            const int nvlo = __builtin_amdgcn_readfirstlane((tf >= 31) ? ((tf - 31) >> 4) + 1 : 0);
            float lsum = 0.f;
            nsa_pipe<3>(src, ntile, smem, w, lane, [&](int j, const char* st, auto&& issue) {
                f32x16 s[2];
                qk_tile<true>(st, qf, s, lane);
                issue();
                if (64 * j + 64 > nvlo) {
#pragma unroll
                    for (int kt = 0; kt < 2; ++kt)
#pragma unroll
                        for (int e = 0; e < 16; ++e) {
                            const int key = 64 * j + 32 * kt + 8 * (e >> 2) + 4 * h + (e & 3);
                            if (key >= nvr) s[kt][e] = NEGS;
                        }
                }
                lsum += sm_fast(s);
            });
            lsum = xhalf_sum(lsum);
            invl = lsum > 0.f ? 1.f / lsum : 0.f;
            nsa_pipe<3>(src, ntile, smem, w, lane, [&](int j, const char* st, auto&& issue) {
                f32x16 s[2];
                qk_tile<true>(st, qf, s, lane);
                half8 vf[4];
                pv_load<0>(st + 8192, vf, lane);
                issue();
                __builtin_amdgcn_sched_barrier(0);
                if (64 * j + 64 > nvlo) {
#pragma unroll
                    for (int kt = 0; kt < 2; ++kt)
#pragma unroll
                        for (int e = 0; e < 16; ++e) {
                            const int key = 64 * j + 32 * kt + 8 * (e >> 2) + 4 * h + (e & 3);
                            if (key >= nvr) s[kt][e] = NEGS;
                        }
                }
                (void)sm_fast(s);
                if (cur >= 16) {
#pragma unroll
                    for (int kt = 0; kt < 2; ++kt)
#pragma unroll
                        for (int g4 = 0; g4 < 4; ++g4) {
                            float G = ((s[kt][4 * g4] + s[kt][4 * g4 + 1]) + (s[kt][4 * g4 + 2] + s[kt][4 * g4 + 3])) * invl;
                            float L = s[kt][4 * g4 + 3] * invl;
                            G += __shfl_xor(G, 1); G += __shfl_xor(G, 2);
                            L += __shfl_xor(L, 1); L += __shfl_xor(L, 2);
                            if (head == 0) {
                                const int sb = 16 * j + 8 * kt + 2 * g4 + h;
                                atomicAdd(&IMP[tokl * 128 + sb], G);
                                if (sb + 1 < 128) atomicAdd(&IMP[tokl * 128 + sb + 1], L);
                            }
                        }
                }
                pv_finish(st + 8192, vf, s, o, lane);
            });
        } else {
        float m = -1e20f, lsum = 0.f;
        nsa_pipe<3>(src, ntile, smem, w, lane, [&](int j, const char* st, auto&& issue) {
            f32x16 s[2];
            qk_tile(st, qf, s, lane);
            issue();
#pragma unroll
            for (int kt = 0; kt < 2; ++kt)
#pragma unroll
                for (int e = 0; e < 16; ++e) {
                    const int key = 64 * j + 32 * kt + 8 * (e >> 2) + 4 * h + (e & 3);
                    if (key >= nvr) s[kt][e] = NEGS;
                }
            const float mn = fmaxf(m, rowmax32(s)), alpha = ex2(m - mn);
            float rs = 0.f;
#pragma unroll
            for (int kt = 0; kt < 2; ++kt)
#pragma unroll
                for (int e = 0; e < 16; ++e) rs += ex2(s[kt][e] - mn);
            rs = xhalf_sum(rs);
            lsum = lsum * alpha + rs; m = mn;
        });
        const float invl_s = lsum > 0.f ? 1.f / lsum : 0.f;
        nsa_pipe<3>(src, ntile, smem, w, lane, [&](int j, const char* st, auto&& issue) {
            f32x16 s[2];
            qk_tile(st, qf, s, lane);
            half8 vf[4];
            pv_load<0>(st + 8192, vf, lane);
            issue();
            __builtin_amdgcn_sched_barrier(0);
#pragma unroll
            for (int kt = 0; kt < 2; ++kt)
#pragma unroll
                for (int e = 0; e < 16; ++e) {
                    const int key = 64 * j + 32 * kt + 8 * (e >> 2) + 4 * h + (e & 3);
                    s[kt][e] = (key < nvr) ? ex2(s[kt][e] - m) * invl_s : 0.f;
                }
            if (cur >= 16) {
#pragma unroll
                for (int kt = 0; kt < 2; ++kt)
#pragma unroll
                    for (int g4 = 0; g4 < 4; ++g4) {
                        float G = (s[kt][4 * g4] + s[kt][4 * g4 + 1]) + (s[kt][4 * g4 + 2] + s[kt][4 * g4 + 3]);
                        float L = s[kt][4 * g4 + 3];
                        G += __shfl_xor(G, 1); G += __shfl_xor(G, 2);
                        L += __shfl_xor(L, 1); L += __shfl_xor(L, 2);
                        if (head == 0) {
                            const int sb = 16 * j + 8 * kt + 2 * g4 + h;
                            atomicAdd(&IMP[tokl * 128 + sb], G);
                            if (sb + 1 < 128) atomicAdd(&IMP[tokl * 128 + sb + 1], L);
                        }
                    }
            }
            pv_finish(st + 8192, vf, s, o, lane);
        });
            invl = 1.f;
        }
        oacc_add(o, g0 * invl, true);
    }
    __syncthreads();
    {
        const int tl = lane >> 3, sub = lane & 7;
        unsigned bits = 0;
        unsigned u[16];
        if (cur >= 16) {
            const float* ip = IMP + (w * 8 + tl) * 128 + sub * 16;
#pragma unroll
            for (int i = 0; i < 16; ++i) {
                const int s = sub * 16 + i;
                u[i] = (s >= 1 && s <= cur - 2) ? (__float_as_uint(ip[i]) + 1u) : 0u;
            }
        }
        __syncthreads();
        if (cur >= 16) {
            unsigned prefix = 0;
            for (int bit = 30; bit >= 0; --bit) {
                const unsigned cand = prefix | (1u << bit);
                int cnt = 0;
#pragma unroll
                for (int i = 0; i < 16; ++i) cnt += (u[i] >= cand) ? 1 : 0;
                cnt += __shfl_xor(cnt, 1); cnt += __shfl_xor(cnt, 2); cnt += __shfl_xor(cnt, 4);
                if (cnt >= 13) prefix = cand;
            }
            int cgt = 0, ceq = 0;
#pragma unroll
            for (int i = 0; i < 16; ++i) { cgt += (u[i] > prefix) ? 1 : 0; ceq += (u[i] == prefix) ? 1 : 0; }
            cgt += __shfl_xor(cgt, 1); cgt += __shfl_xor(cgt, 2); cgt += __shfl_xor(cgt, 4);
            int inc = ceq;
            { const int v = __shfl_up(inc, 1); if (sub >= 1) inc += v; }
            { const int v = __shfl_up(inc, 2); if (sub >= 2) inc += v; }
            { const int v = __shfl_up(inc, 4); if (sub >= 4) inc += v; }
            int run = inc - ceq;
            const int need = 13 - cgt;
#pragma unroll
            for (int i = 0; i < 16; ++i) {
                const int s = sub * 16 + i;
                bool sel = u[i] > prefix;
                if (u[i] == prefix) { sel = run < need; ++run; }
                if (s == 0 || s == cur || s == cur - 1) sel = true;
                bits |= (sel ? 1u : 0u) << i;
            }
        } else {
#pragma unroll
            for (int i = 0; i < 16; ++i) bits |= ((sub * 16 + i <= cur) ? 1u : 0u) << i;
        }
        unsigned wv = bits << ((sub & 1) * 16);
        wv |= __shfl_xor(wv, 1);
        if ((sub & 1) == 0) SELM[(w * 8 + tl) * 4 + (sub >> 1)] = wv;
    }
    __syncthreads();
    unsigned selw[4];
#pragma unroll
    for (int i = 0; i < 4; ++i) selw[i] = SELM[tokl * 4 + i];

    auto branch = [&](auto BRC) {
        constexpr int br = decltype(BRC)::value;
        const int j0 = (br == 0) ? 0 : (cur - 8 > 0 ? cur - 8 : 0);
        const int nst = cur - j0 + 1;
        KVSrc src{proj + ((size_t)b * SEQ + (size_t)j0 * 64) * D_IN + C_NKV + (br == 0 ? 256 : 512) + g * 64, D_IN, (size_t)64 * D_IN,
                  (const h16*)(P->ws + OFF_VTG) + (((size_t)br * 4 + bg) * 128 + j0) * 4096};
        float m = -1e20f, lsum = 0.f;
        f32x16 o[2];
#pragma unroll
        for (int e = 0; e < 16; ++e) { o[0][e] = 0.f; o[1][e] = 0.f; }
        nsa_pipe<4>(src, nst, smem, w, lane, [&](int jj, const char* st, auto&& issue) {
            const int j = j0 + jj;
            const bool rowok = (br != 0) || (((selw[j >> 5] >> (j & 31)) & 1u) != 0u);
            if constexpr (FAST && br == 0) {
                if (!__any(rowok)) { issue(); return; }
            }
            f32x16 s[2];
            qk_tile<FAST>(st, qf, s, lane, issue);
            half8 vf[4];
            pv_load<0>(st + 8192, vf, lane);
            __builtin_amdgcn_sched_barrier(0);
            if (j == cur || (br == 1 && j == cur - 8)) {
#pragma unroll
                for (int kt = 0; kt < 2; ++kt)
#pragma unroll
                    for (int e = 0; e < 16; ++e) {
                        const int key = 64 * j + 32 * kt + 8 * (e >> 2) + 4 * h + (e & 3);
                        const bool ok = (key <= t) && (br == 0 || key > t - 512);
                        if (!ok) s[kt][e] = NEGS;
                    }
            }
            if constexpr (FAST) {
                const float rs = sm_fast(s);
                lsum += (br != 0 || rowok) ? rs : 0.f;
                pv_finish<br == 0>(st + 8192, vf, s, o, lane, rowok ? 0xffffffffu : 0u);
            } else {
                sm_online(s, m, lsum, o, rowok);
                pv_finish(st + 8192, vf, s, o, lane);
            }
        });
        if constexpr (FAST) lsum = xhalf_sum(lsum);
        const float sc = (br == 0 ? g1 : g2) / lsum;
        oacc_add(o, sc, false);
    };
    branch(IC<0>{});
    branch(IC<1>{});
    {
        h16* mixp = (h16*)(P->ws + OFF_MIX) + kb_idx(NT, tokg, 512 + ghead * 64);
        const h16* ngp = proj + tokg * D_IN + C_NG + ghead * 64;
#pragma unroll
        for (int dt = 0; dt < 2; ++dt)
#pragma unroll
            for (int g4 = 0; g4 < 4; ++g4) {
                const int d0 = 32 * dt + 8 * g4 + 4 * h;
                const half4 ng = *(const half4*)(ngp + d0);
                half4 ov;
#pragma unroll
                for (int e = 0; e < 4; ++e) ov[e] = (h16)((float)oacc[dt * 2 + (g4 >> 1)][(g4 & 1) * 4 + e] * siluf_((float)ng[e]));
                *(half4*)(mixp + d0) = ov;
            }
    }
    __syncthreads();
}

DI void gla_kv_item(PP P, int l, int item, char* smem, const int wv) {
    P = plaunder(P);
    const int tid = otid(wv), lane = tid & 63, w = tid >> 6, r = lane & 31, hh = lane >> 5;
    const int pair = item * 4 + w, h = pair & 3, cn = pair >> 2;
    const size_t tok = (size_t)cn * 32 + r;
    const int b = cn >> 8, n = cn & 255, bh = b * 4 + h;
    const h16* proj = (const h16*)(P->ws + OFF_PROJ);
    h16* VT = (h16*)(smem + w * 16384);
    h16* KT = VT + 2048;
    __syncthreads();
    {
        const half8* vp = (const half8*)(proj + tok * D_IN + C_GV + h * 64 + hh * 32);
#pragma unroll
        for (int q = 0; q < 4; ++q) {
            const half8 v8 = vp[q];
#pragma unroll
            for (int e = 0; e < 8; ++e) VT[(hh * 32 + q * 8 + e) * 32 + r] = v8[e];
        }
    }
    float gl[16];
    {
        const half8* lp = (const half8*)(proj + tok * D_IN + C_GLR);
        const half8 l0 = lp[0], l1 = lp[1];
        float lr[16];
#pragma unroll
        for (int q = 0; q < 8; ++q) { lr[q] = (float)l0[q]; lr[8 + q] = (float)l1[q]; }
        const float* w2 = P->in[I_GW2] + (size_t)l * 16 * 128 + h * 32 + 16 * hh;
        const float* b2 = P->in[I_GB2] + l * 128 + h * 32 + 16 * hh;
#pragma unroll
        for (int d = 0; d < 16; ++d) gl[d] = b2[d];
#pragma unroll
        for (int q = 0; q < 16; ++q)
#pragma unroll
            for (int d4 = 0; d4 < 4; ++d4) {
                const float4 wq = *(const float4*)(w2 + q * 128 + d4 * 4);
                gl[d4 * 4 + 0] += lr[q] * wq.x; gl[d4 * 4 + 1] += lr[q] * wq.y; gl[d4 * 4 + 2] += lr[q] * wq.z; gl[d4 * 4 + 3] += lr[q] * wq.w;
            }
#pragma unroll
        for (int d = 0; d < 16; ++d) gl[d] = log_sigmoidf_(gl[d]) * (1.f / 16.f);
    }
#pragma unroll
    for (int off = 1; off < 32; off <<= 1) {
#pragma unroll
        for (int d = 0; d < 16; ++d) { const float v = __shfl_up(gl[d], off, 32); if (r >= off) gl[d] += v; }
    }
    {
        float* bc = (float*)(P->ws + OFF_BCUM) + tok * 128 + h * 32 + 16 * hh;
#pragma unroll
        for (int d4 = 0; d4 < 4; ++d4) *(float4*)(bc + d4 * 4) = (float4){gl[d4 * 4], gl[d4 * 4 + 1], gl[d4 * 4 + 2], gl[d4 * 4 + 3]};
    }
    {
        const half8* kp = (const half8*)(proj + tok * D_IN + C_GK + h * 32 + 16 * hh);
        const half8 k0 = kp[0], k1 = kp[1];
        float bl[16];
#pragma unroll
        for (int d = 0; d < 16; ++d) bl[d] = __shfl(gl[d], 31, 32);
#pragma unroll
        for (int d = 0; d < 16; ++d) {
            const float kd = (float)(d < 8 ? k0[d & 7] : k1[d & 7]) * __expf(bl[d] - gl[d]);
            KT[(16 * hh + d) * 32 + r] = (h16)kd;
        }
        if (r == 0) {
            float* dc = (float*)(P->ws + OFF_GDEC) + (size_t)(bh * 256 + n) * 32 + 16 * hh;
#pragma unroll
            for (int d4 = 0; d4 < 4; ++d4) *(float4*)(dc + d4 * 4) = (float4){__expf(bl[d4 * 4]), __expf(bl[d4 * 4 + 1]), __expf(bl[d4 * 4 + 2]), __expf(bl[d4 * 4 + 3])};
        }
    }
    asm volatile("s_waitcnt lgkmcnt(0)" ::: "memory");
    const half8 kb0 = *(const half8*)(KT + r * 32 + 8 * hh), kb1 = *(const half8*)(KT + r * 32 + 16 + 8 * hh);
    float* kvp = (float*)(P->ws + OFF_GKV) + ((size_t)(bh * 256 + n) * 32 + r) * 64;
#pragma unroll
    for (int dt = 0; dt < 2; ++dt) {
        f32x16 o;
#pragma unroll
        for (int e = 0; e < 16; ++e) o[e] = 0.f;
        const h16* vrow = VT + (32 * dt + r) * 32 + 8 * hh;
        o = MFMA32(*(const half8*)vrow, kb0, o);
        o = MFMA32(*(const half8*)(vrow + 16), kb1, o);
#pragma unroll
        for (int g4 = 0; g4 < 4; ++g4)
            *(float4*)(kvp + 32 * dt + 8 * g4 + 4 * hh) = (float4){o[4 * g4], o[4 * g4 + 1], o[4 * g4 + 2], o[4 * g4 + 3]};
    }
    __syncthreads();
}

DI void gla_out_item(PP P, int l, int item, char* smem, const int wv) {
    P = plaunder(P);
    const int tid = otid(wv), lane = tid & 63, w = tid >> 6, r = lane & 31, hh = lane >> 5;
    const int pair = item * 4 + w, h = pair & 3, cn = pair >> 2;
    const size_t tok0 = (size_t)cn * 32, tok = tok0 + r;
    const int b = cn >> 8, n = cn & 255, bh = b * 4 + h;
    const h16* proj = (const h16*)(P->ws + OFF_PROJ);
    h16* VT = (h16*)(smem + w * 16384);
    h16* SPT = VT + 2048;
    __syncthreads();
    {
        const half8* vp = (const half8*)(proj + tok * D_IN + C_GV + h * 64 + hh * 32);
        const float4* sp = (const float4*)((const float*)(P->ws + OFF_GKV) + ((size_t)(bh * 256 + n) * 32 + r) * 64 + hh * 32);
#pragma unroll
        for (int q = 0; q < 4; ++q) {
            const half8 v8 = vp[q];
            const float4 s0 = sp[2 * q], s1 = sp[2 * q + 1];
#pragma unroll
            for (int e = 0; e < 8; ++e) VT[(hh * 32 + q * 8 + e) * 32 + r] = v8[e];
            SPT[(hh * 32 + q * 8 + 0) * 32 + r] = (h16)s0.x; SPT[(hh * 32 + q * 8 + 1) * 32 + r] = (h16)s0.y;
            SPT[(hh * 32 + q * 8 + 2) * 32 + r] = (h16)s0.z; SPT[(hh * 32 + q * 8 + 3) * 32 + r] = (h16)s0.w;
            SPT[(hh * 32 + q * 8 + 4) * 32 + r] = (h16)s1.x; SPT[(hh * 32 + q * 8 + 5) * 32 + r] = (h16)s1.y;
            SPT[(hh * 32 + q * 8 + 6) * 32 + r] = (h16)s1.z; SPT[(hh * 32 + q * 8 + 7) * 32 + r] = (h16)s1.w;
        }
    }
    half8 qe[2], ke[2];
#pragma unroll
    for (int ks = 0; ks < 2; ++ks) {
        const int d0 = 16 * ks + 8 * hh;
        const half8 q8 = *(const half8*)(proj + tok * D_IN + C_GQ + h * 32 + d0);
        const half8 k8 = *(const half8*)(proj + tok * D_IN + C_GK + h * 32 + d0);
        const float4 b0 = *(const float4*)((const float*)(P->ws + OFF_BCUM) + tok * 128 + h * 32 + d0);
        const float4 b1 = *(const float4*)((const float*)(P->ws + OFF_BCUM) + tok * 128 + h * 32 + d0 + 4);
        const float bc[8] = {b0.x, b0.y, b0.z, b0.w, b1.x, b1.y, b1.z, b1.w};
#pragma unroll
        for (int e = 0; e < 8; ++e) {
            const float ex = __expf(bc[e]);
            qe[ks][e] = (h16)((float)q8[e] * 0.17677669529663687f * ex);
            ke[ks][e] = (h16)((float)k8[e] * __builtin_amdgcn_rcpf(ex));
        }
    }
    f32x16 s;
#pragma unroll
    for (int e = 0; e < 16; ++e) s[e] = 0.f;
    s = MFMA32(ke[0], qe[0], s);
    s = MFMA32(ke[1], qe[1], s);
#pragma unroll
    for (int e = 0; e < 16; ++e) { const int j = (e & 3) + 8 * (e >> 2) + 4 * hh; if (j > r) s[e] = 0.f; }
    const half8 pb0 = pack8<0>(s), pb1 = pack8<1>(s);
    asm volatile("s_waitcnt lgkmcnt(0)" ::: "memory");
    f32x16 o[2];
#pragma unroll
    for (int dt = 0; dt < 2; ++dt) {
#pragma unroll
        for (int e = 0; e < 16; ++e) o[dt][e] = 0.f;
        const h16* vrow = VT + (32 * dt + r) * 32 + 4 * hh;
        const h16* srow = SPT + (32 * dt + r) * 32 + 8 * hh;
        {
            const half4 lo = *(const half4*)vrow, hi = *(const half4*)(vrow + 8);
            o[dt] = MFMA32(((half8){lo[0], lo[1], lo[2], lo[3], hi[0], hi[1], hi[2], hi[3]}), pb0, o[dt]);
        }
        {
            const half4 lo = *(const half4*)(vrow + 16), hi = *(const half4*)(vrow + 24);
            o[dt] = MFMA32(((half8){lo[0], lo[1], lo[2], lo[3], hi[0], hi[1], hi[2], hi[3]}), pb1, o[dt]);
        }
        o[dt] = MFMA32(*(const half8*)srow, qe[0], o[dt]);
        o[dt] = MFMA32(*(const half8*)(srow + 16), qe[1], o[dt]);
    }
    float ss = 0.f;
#pragma unroll
    for (int e = 0; e < 16; ++e) ss += o[0][e] * o[0][e] + o[1][e] * o[1][e];
    ss = xhalf_sum(ss);
    const float rn = rsqrtf(ss * (1.f / 64.f) + 1e-6f);
    h16* mix = (h16*)(P->ws + OFF_MIX);
#pragma unroll
    for (int dt = 0; dt < 2; ++dt)
#pragma unroll
        for (int g4 = 0; g4 < 4; ++g4) {
            const int e0 = 32 * dt + 8 * g4 + 4 * hh;
            const half4 gt = *(const half4*)(proj + tok * D_IN + C_GG + h * 64 + e0);
            const float4 on = *(const float4*)(P->in[I_GON] + l * 64 + e0);
            half4 ov;
            ov[0] = (h16)(o[dt][4 * g4 + 0] * rn * on.x * siluf_((float)gt[0]));
            ov[1] = (h16)(o[dt][4 * g4 + 1] * rn * on.y * siluf_((float)gt[1]));
            ov[2] = (h16)(o[dt][4 * g4 + 2] * rn * on.z * siluf_((float)gt[2]));
            ov[3] = (h16)(o[dt][4 * g4 + 3] * rn * on.w * siluf_((float)gt[3]));
            *(half4*)(mix + kb_idx(NT, tok, h * 64 + e0)) = ov;
        }
    __syncthreads();
}

DI void glu_tile(PP P, int l, int tile, char* smem, const int wv) {
    P = plaunder(P);
    const int mt = tile >> 2, nt = tile & 3;
    f32x4 acc[4][4];
    float ssd[4];
    gemm_mainloop_glds<false>(wv, 256, APlain{(const h16*)(P->ws + OFF_YACT) + (size_t)mt * 128 * 256, 256, 64},
                              (const h16*)(P->ws + OFF_WTGLU) + ((size_t)l * 512 + nt * 128) * 256, 256, acc, ssd, smem);
    const int tid = otid(wv), lane = tid & 63, wid = tid >> 6, wr = wid >> 1, wc = wid & 1;
    const h16* proj = (const h16*)(P->ws + OFF_PROJ);
    h16* mix = (h16*)(P->ws + OFF_MIX);
    const float* gb = P->in[I_GLUB] + l * 512;
#pragma unroll
    for (int i = 0; i < 4; ++i) {
        const size_t tok = (size_t)mt * 128 + wr * 64 + i * 16 + (lane & 15);
#pragma unroll
        for (int pj = 0; pj < 2; ++pj) {
            const int c = nt * 64 + wc * 32 + pj * 16 + (lane >> 4) * 4;
            const f32x4 z1 = acc[i][2 * pj], z2 = acc[i][2 * pj + 1];
            const float4 b1 = *(const float4*)(gb + c), b2 = *(const float4*)(gb + 256 + c);
            const half4 g4 = *(const half4*)(proj + tok * D_IN + C_SG + c);
            half4 o;
            o[0] = (h16)((z1[0] + b1.x) * sigmoidf_(z2[0] + b2.x) * siluf_((float)g4[0]));
            o[1] = (h16)((z1[1] + b1.y) * sigmoidf_(z2[1] + b2.y) * siluf_((float)g4[1]));
            o[2] = (h16)((z1[2] + b1.z) * sigmoidf_(z2[2] + b2.z) * siluf_((float)g4[2]));
            o[3] = (h16)((z1[3] + b1.w) * sigmoidf_(z2[3] + b2.w) * siluf_((float)g4[3]));
            *(half4*)(mix + kb_idx(NT, tok, 256 + c)) = o;
        }
    }
}

DI void outproj_tile(PP P, int l, int mt, int nt, char* smem, const int wv) {
    P = plaunder(P);
    f32x4 acc[8][4];
    float ssd[8];
    gemm_glds<false, 2, 8, 4, 3>(wv, 1024, APlain{(const h16*)(P->ws + OFF_MIX) + (size_t)mt * 256 * 64, 64, (size_t)NT * 64},
                              (const h16*)(P->ws + OFF_WTOUT) + ((size_t)l * 16 * 1024 + nt * 128) * 64, 64, acc, ssd, smem, (size_t)1024 * 64);
    const int tid = otid(wv), lane = tid & 63, wid = tid >> 6, wr = wid >> 1, wc = wid & 1;
    const float* xin = (l == 0) ? P->in[I_X] : P->out;
    h16* xh = (h16*)(P->ws + OFF_XH);
#pragma unroll
    for (int i = 0; i < 8; ++i) {
        const size_t row = (size_t)mt * 256 + wr * 128 + i * 16 + (lane & 15);
#pragma unroll
        for (int jj = 0; jj < 4; ++jj) {
            const int n = nt * 128 + wc * 64 + jj * 16 + (lane >> 4) * 4;
            const f32x4 v = acc[i][jj];
            const float4 xo = *(const float4*)(xin + row * 1024 + n);
            const float4 xn = (float4){xo.x + v[0], xo.y + v[1], xo.z + v[2], xo.w + v[3]};
            *(float4*)(P->out + row * 1024 + n) = xn;
            *(half4*)(xh + kb_idx(NT, row, n)) = (half4){(h16)xn.x, (h16)xn.y, (h16)xn.z, (h16)xn.w};
        }
    }
}

#define XB_TMO      128
#define XB_XCNT(j)  (256  + 64 * (j))
#define XB_XSUB(j)  (1280 + 64 * (j))
#define XB_XGEN(j)  (2304 + 64 * (j))
#define XB_TOP      3328
#define XB_TOPGEN   3392
#define XCD_BAR_WORDS 3456
#define XB_SPIN_CAP (1u << 18)
#define LAS __attribute__((address_space(3)))

__device__ __forceinline__ unsigned xb_ld(unsigned* p)              { return __hip_atomic_load(p, __ATOMIC_RELAXED, __HIP_MEMORY_SCOPE_AGENT); }
__device__ __forceinline__ unsigned xb_add(unsigned* p, unsigned v) { return __hip_atomic_fetch_add(p, v, __ATOMIC_RELAXED, __HIP_MEMORY_SCOPE_AGENT); }
__device__ __forceinline__ unsigned xb_xcc_id() { return (unsigned)__builtin_amdgcn_s_getreg((3 << 11) | 20) & 0xFu; }
#define XB_SPIN(cond, bar) do { unsigned _sp = 0; while (cond) { __builtin_amdgcn_s_sleep(1); \
    if ((++_sp & 255u) == 0u) { if (xb_ld(&(bar)[XB_TMO])) break; if (_sp > XB_SPIN_CAP) { atomicAdd(&(bar)[XB_TMO], 1u); break; } } } } while (0)

struct XcdBarrier {
    unsigned* bar; unsigned x;
    volatile LAS unsigned* st;
};

__device__ __forceinline__ XcdBarrier xcd_barrier_post(unsigned* bar, volatile LAS unsigned* st) {
    XcdBarrier b; b.bar = bar; b.x = xb_xcc_id(); b.st = st;
    if (threadIdx.x == 0) (void)xb_add(&bar[XB_XCNT(b.x)], 1u);
    return b;
}
__device__ __forceinline__ void xcd_barrier_complete(unsigned* bar, unsigned x, unsigned& nloc, unsigned& nx) {
    const unsigned G = gridDim.x * gridDim.y * gridDim.z;
    unsigned sum, cnt, mine, sp = 0u;
    for (;;) {
        sum = 0u; cnt = 0u; mine = 0u;
#pragma unroll
        for (unsigned j = 0; j < 16; ++j) { const unsigned c = xb_ld(&bar[XB_XCNT(j)]); sum += c; cnt += (c > 0u) ? 1u : 0u; mine = (j == x) ? c : mine; }
        if (sum == G) break;
        __builtin_amdgcn_s_sleep(1);
        if ((++sp & 255u) == 0u) { if (xb_ld(&bar[XB_TMO])) break; if (sp > XB_SPIN_CAP) { atomicAdd(&bar[XB_TMO], 1u); break; } }
    }
    nloc = mine > 0u ? mine : 1u; nx = cnt > 0u ? cnt : 1u;
}

__device__ __forceinline__ void xcd_barrier(const XcdBarrier& b) {
    asm volatile("s_waitcnt vmcnt(0)" ::: "memory");
    __syncthreads();
    if (threadIdx.x == 0) {
        unsigned* bar = b.bar;
        __builtin_amdgcn_s_waitcnt(0);
        unsigned nloc = b.st[0], nx = b.st[1];
        if (nloc == 0u) { xcd_barrier_complete(bar, b.x, nloc, nx); b.st[0] = nloc; b.st[1] = nx; }
        const unsigned old = xb_add(&bar[XB_XSUB(b.x)], 1u);
        const unsigned gen = old / nloc;
        if (old + 1u == (gen + 1u) * nloc) {
            __builtin_amdgcn_fence(__ATOMIC_RELEASE, "agent");
            asm volatile("s_waitcnt vmcnt(0)" ::: "memory");
            const unsigned og = xb_add(&bar[XB_TOP], 1u);
            const unsigned tg = og / nx;
            if (og + 1u == (tg + 1u) * nx) xb_add(&bar[XB_TOPGEN], 1u);
            else XB_SPIN(xb_ld(&bar[XB_TOPGEN]) == tg, bar);
            __builtin_amdgcn_fence(__ATOMIC_ACQUIRE, "agent");
            xb_add(&bar[XB_XGEN(b.x)], 1u);
            asm volatile("s_waitcnt vmcnt(0)" ::: "memory");
        } else {
            XB_SPIN(xb_ld(&bar[XB_XGEN(b.x)]) == gen, bar);
            __builtin_amdgcn_fence(__ATOMIC_ACQUIRE, "agent");
            asm volatile("s_waitcnt vmcnt(0)" ::: "memory");
        }
    }
    __syncthreads();
}


__global__ void __launch_bounds__(NTHREADS, 2) fwd_megakernel(Params Pval) {
    PP P = (PP)__builtin_amdgcn_kernarg_segment_ptr();
    extern __shared__ __attribute__((aligned(16))) char smem[];
    cg::grid_group grid = cg::this_grid();
    const int G = gridDim.x, bid = blockIdx.x;
    const int wv = __builtin_amdgcn_readfirstlane((int)(threadIdx.x >> 6));

    uint4& xb_words = *(uint4*)(smem + SMEM_MAIN);
    if (otid(wv) == 0) xb_words = make_uint4(0u, 0u, 0u, 0u);
    __syncthreads();
    if (P->ws == nullptr) grid.sync();
    const XcdBarrier xb = xcd_barrier_post((unsigned*)(P->ws + OFF_BAR), (volatile LAS unsigned*)(smem + SMEM_MAIN));
    int vxcd = bid & 7, vjx = bid >> 3;
    {
        unsigned* xcnt = (unsigned*)(P->ws + OFF_BAR) + XCD_BAR_WORDS;
        volatile LAS unsigned* lw = (volatile LAS unsigned*)(smem + SMEM_MAIN) + 2;
        if (otid(wv) == 0) lw[0] = xb.x < 8u ? xb_add(&xcnt[xb.x], 1u) : 0xffffu;
        phase0(P, smem, wv);
        xcd_barrier(xb);
        if (otid(wv) == 0) {
            bool ok = (G & 7) == 0 && xb.x < 8u;
            for (int j = 0; j < 8; ++j) ok = ok && (xb_ld(&xcnt[j]) == (unsigned)(G >> 3));
            lw[1] = ok ? 1u : 0u;
        }
        __syncthreads();
        if (lw[1]) { vxcd = (int)xb.x; vjx = (int)lw[0]; }
    }
    vxcd = __builtin_amdgcn_readfirstlane(vxcd); vjx = __builtin_amdgcn_readfirstlane(vjx);

#pragma unroll 1
    for (int l = 0; l < DEPTH; ++l) {
        {
            const int xcd = vxcd, jx = vjx, nper = G >> 3;
            for (int u = jx; u < 192; u += nper) inproj_tile<2, 8>(P, l, (xcd * 8 + (u & 7)) * 256, (u >> 3) * 128, smem, wv);
            for (int it = jx; it < 16 + 40; it += nper) {
                if (it < 16) inproj_tile<4, 2>(P, l, (xcd * 16 + it) * 128, 3072, smem, wv);
                else s5_build_item(P, l, (it - 16) * 8 + xcd, smem, wv);
            }
        }
        xcd_barrier(xb);
#pragma unroll 1
        for (int w = bid; w < 128 + 64 + 512; w += G) {
            if (w < 128) cmp_gemm_tile(P, l, w, smem, wv);
            else if (w < 192) s5e_gemm_tile(P, l, w - 128, smem, wv);
            else gla_kv_item(P, l, w - 192, smem, wv);
        }
        xcd_barrier(xb);
#pragma unroll 1
        for (int w = bid; w < 512 + 512 + 64; w += G) {
            if (w < 512) cmp_l2_item(P, l, w, smem, wv);
            else if (w < 1024) gla_scan_item(P, w - 512, smem, wv);
            else s5_scan_item(P, w - 1024, smem, wv);
        }
        xcd_barrier(xb);
        bool nsa_fast;
        {
            const int ln = otid(wv) & 63;
            const float gq = wave_max(fabsf(P->in[I_NQN][l * 64 + ln]));
            const float gk = wave_max(fmaxf(fmaxf(fabsf(P->in[I_NKN][(l * 3 + 0) * 64 + ln]), fabsf(P->in[I_NKN][(l * 3 + 1) * 64 + ln])), fabsf(P->in[I_NKN][(l * 3 + 2) * 64 + ln])));
            nsa_fast = __builtin_amdgcn_readfirstlane((8.f * 1.4426950408889634f * gq * gk - FAST_SHIFT < 15.f) ? 1 : 0) != 0;
        }
#pragma unroll 1
        for (int w0 = bid; w0 < 512 + 512 + 512; w0 += G) {
            const int w = w0 < G ? vjx * 8 + vxcd : w0;
            if (w < 512) {
                const int bg = w & 3, q = w >> 2;
                if (nsa_fast) { nsa_unit<true>(P, l, bg, 255 - q, smem, wv); nsa_unit<true>(P, l, bg, q, smem, wv); }
                else { nsa_unit<false>(P, l, bg, 255 - q, smem, wv); nsa_unit<false>(P, l, bg, q, smem, wv); }
            } else if (w < 512 + 512) s5o_gemm_tile(P, l, w - 512, smem, wv);
            else gla_out_item(P, l, w - 1024, smem, wv);
        }
        xcd_barrier(xb);
#pragma unroll 1
        for (int w = bid; w < 512; w += G) glu_tile(P, l, w, smem, wv);
        xcd_barrier(xb);
        {
            const int xcd = vxcd, jx = vjx, nper = G >> 3;
            for (int u = jx; u < 64; u += nper) outproj_tile(P, l, xcd * 8 + (u & 7), u >> 3, smem, wv);
        }
        xcd_barrier(xb);
    }
}

extern "C" void kernel_launch(void* const* d_in, const int* in_sizes, int n_in, void* d_out, int out_size, void* d_ws,
                              size_t ws_size, hipStream_t stream) {
    static int grid_blocks = 0;
    if (!grid_blocks) {
        int dev = 0, cus = 0, per_cu = 0;
        hipGetDevice(&dev);
        hipDeviceGetAttribute(&cus, hipDeviceAttributeMultiprocessorCount, dev);
        hipFuncSetAttribute((const void*)fwd_megakernel, hipFuncAttributeMaxDynamicSharedMemorySize, SMEM_BYTES);
        hipOccupancyMaxActiveBlocksPerMultiprocessor(&per_cu, fwd_megakernel, NTHREADS, SMEM_BYTES);
        if (per_cu < 1) per_cu = 1;
        if (per_cu > 2) per_cu = 2;
        grid_blocks = cus * per_cu;
        if (ws_size < WS_END) fprintf(stderr, "kernel_launch: workspace too small: %zu < %zu\n", ws_size, (size_t)WS_END);
    }
    Params p{};
    for (int i = 0; i < 25; ++i) p.in[i] = (const float*)d_in[i];
    p.out = (float*)d_out;
    p.ws = (char*)d_ws;
    void* args[] = {&p};
    (void)hipMemsetAsync((char*)d_ws + OFF_BAR, 0, (XCD_BAR_WORDS + 16) * sizeof(unsigned), stream);
    hipError_t e = hipLaunchCooperativeKernel((const void*)fwd_megakernel, dim3(grid_blocks), dim3(NTHREADS), args, SMEM_BYTES, stream);
    if (e != hipSuccess) fprintf(stderr, "cooperative launch failed: %s (grid %d)\n", hipGetErrorString(e), grid_blocks);
}
```

```cpp
#include <hip/hip_runtime.h>
#include <hip/hip_cooperative_groups.h>
#include <cstdio>
#include <cstdint>
namespace cg = cooperative_groups;

typedef _Float16 h16;
typedef _Float16 half8 __attribute__((ext_vector_type(8)));
typedef _Float16 half4 __attribute__((ext_vector_type(4)));
typedef float f32x4 __attribute__((ext_vector_type(4)));
typedef float f32x16 __attribute__((ext_vector_type(16)));

#define DI __device__ __forceinline__

constexpr int D_MODEL = 1024, BATCH = 2, SEQ = 8192, DEPTH = 4, NT = BATCH * SEQ;
constexpr int D_IN = 3112, D_IN_PAD = 3200;
constexpr int C_NQ = 0, C_NKV = 512, C_NG = 1280, C_GQ = 1792, C_GK = 1920, C_GV = 2048, C_GG = 2304, C_SU = 2560, C_SG = 2816,
              C_GLR = 3072, C_NGL = 3088;
__host__ __device__ constexpr int map_col(int c) {
    return c < 128 ? C_GQ + c : c < 256 ? C_GK + (c - 128) : c < 512 ? C_GV + (c - 256) : c < 528 ? C_GLR + (c - 512)
         : c < 784 ? C_GG + (c - 528) : c < 1040 ? C_SU + (c - 784) : c < 1296 ? C_SG + (c - 1040) : c < 1808 ? C_NQ + (c - 1296)
         : c < 2576 ? C_NKV + (c - 1808) : c < 2600 ? C_NGL + (c - 2576) : c < 3112 ? C_NG + (c - 2600) : c;
}
constexpr int NTHREADS = 256;
constexpr float QSCALE = 0.125f * 1.4426950408889634f;

enum { I_X = 0, I_NORMG, I_WIN, I_GW2, I_GB2, I_GON, I_LRE, I_LIM, I_LSTEP, I_BRE, I_BIM, I_CRE, I_CIM, I_SD, I_GLUW, I_GLUB,
       I_NGB, I_NQN, I_NKN, I_CPOS, I_CW1, I_CB1, I_CW2, I_CB2, I_WOUT };

constexpr size_t OFF_WTIN  = 0;
constexpr size_t OFF_WTOUT = OFF_WTIN  + 4ull * D_IN_PAD * 1024 * 2;
constexpr size_t OFF_WTGLU = OFF_WTOUT + 4ull * 1024 * 1024 * 2;
constexpr size_t OFF_WTC1  = OFF_WTGLU + 4ull * 512 * 256 * 2;
constexpr size_t OFF_PROJ  = OFF_WTC1  + 4ull * 2 * 256 * 2048 * 2;
constexpr size_t OFF_MIX   = OFF_PROJ  + (size_t)NT * D_IN * 2;
constexpr size_t OFF_YACT  = OFF_MIX   + (size_t)NT * 1024 * 2;
constexpr size_t OFF_XH    = OFF_YACT;
constexpr size_t OFF_BCUM  = OFF_YACT  + (size_t)NT * 256 * 2;
constexpr size_t OFF_GKV   = OFF_BCUM  + (size_t)NT * 128 * 4;
constexpr size_t OFF_GDEC  = OFF_GKV   + 8ull * 256 * 2048 * 4;
static_assert(OFF_GDEC - OFF_XH >= (size_t)NT * 1024 * 2, "XH alias region too small");
constexpr size_t OFF_XC    = OFF_GDEC  + 8ull * 256 * 32 * 4;
constexpr size_t OFF_S5W   = OFF_XC    + 512ull * 1024 * 2 * 4;
constexpr size_t OFF_S5E   = OFF_S5W   + 16ull * 512 * 640 * 2;
constexpr size_t OFF_S5AL  = OFF_S5E   + 16ull * 128 * 512 * 2;
constexpr size_t OFF_CHID  = OFF_S5AL  + 1024ull * 2 * 4;
constexpr size_t OFF_POSB  = OFF_CHID  + 2ull * 2048 * 512 * 4;
constexpr size_t OFF_XCH   = OFF_POSB  + 8ull * 16 * 256 * 4;
constexpr size_t OFF_KCMP  = OFF_XCH   + 512ull * 2048 * 2;
constexpr size_t OFF_VCMP  = OFF_KCMP  + 4ull * 512 * 64 * 2;
constexpr size_t OFF_VTG   = OFF_VCMP  + 4ull * 512 * 64 * 2;
constexpr size_t OFF_BAR   = OFF_VTG   + 2ull * 4 * 128 * 4096 * 2;
constexpr size_t WS_END    = OFF_BAR   + 16384;

struct Params {
    const float* in[25];
    float* out;
    char* ws;
};

__host__ __device__ constexpr size_t kb_idx(size_t nrows, size_t row, int k) { return (((size_t)(k >> 6)) * nrows + row) * 64 + (k & 63); }
typedef const __attribute__((address_space(4))) Params* PP;
DI PP plaunder(PP p) { asm volatile("" : "+s"(p)); return p; }
constexpr int SMEM_MAIN = 73728;
constexpr int SMEM_BYTES = SMEM_MAIN + 16;

DI int otid(const int wv) { int t = wv * 64 + (int)__builtin_amdgcn_mbcnt_hi(~0u, __builtin_amdgcn_mbcnt_lo(~0u, 0u)); asm volatile("" : "+v"(t)); return t; }
DI float wave_sum(float v) {
#pragma unroll
    for (int o = 32; o > 0; o >>= 1) v += __shfl_xor(v, o);
    return v;
}
DI float wave_max(float v) {
#pragma unroll
    for (int o = 32; o > 0; o >>= 1) v = fmaxf(v, __shfl_xor(v, o));
    return v;
}
DI float sigmoidf_(float x) { return 1.f / (1.f + __expf(-x)); }
DI float siluf_(float x) { return x / (1.f + __expf(-x)); }
DI float gelu_tanh(float x) {
    const float u = 0.7978845608028654f * (x + 0.044715f * x * x * x);
    return 0.5f * x * (1.f + tanhf(u));
}
DI float log_sigmoidf_(float x) { return fminf(x, 0.f) - log1pf(__expf(-fabsf(x))); }

typedef _Float16 half2_ __attribute__((ext_vector_type(2)));
DI void glds16(const h16* g, char* l) {
    __builtin_amdgcn_global_load_lds((const __attribute__((address_space(1))) void*)g, (__attribute__((address_space(3))) void*)l, 16, 0, 0);
}
DI int vkperm(int k) { return (k & ~12) | ((k & 4) << 1) | ((k & 8) >> 1); }
struct APlain { const h16* A; size_t lda, astep; DI const h16* operator()(int row, int kt, int c8) const { return A + (size_t)row * lda + (size_t)kt * astep + c8 * 8; } };
struct AS5 {
    const h16* ubase;
    const h16* xin;
    int ch0;
    DI const h16* operator()(int row, int kt, int c8) const {
        const size_t ch = (size_t)(ch0 + row);
        return kt < 8 ? ubase + (ch * 32 + 4 * kt + (c8 >> 1)) * D_IN + (c8 & 1) * 8 : xin + ch * 2048 + (kt - 8) * 64 + c8 * 8;
    }
};
template <int N> DI void gwaitbar();
#define GWB_DEF(N) template <> DI void gwaitbar<N>() { asm volatile("s_waitcnt vmcnt(" #N ") lgkmcnt(0)\n\ts_barrier" ::: "memory"); }
GWB_DEF(0) GWB_DEF(3) GWB_DEF(4) GWB_DEF(6) GWB_DEF(8) GWB_DEF(12)
template <bool SUMSQ, int WR, int MI, int NJ, int NST = 4, class AF>
DI void gemm_glds(const int wv, const int K, const AF& afn, const h16* __restrict__ Bt, const int ldb,
                  f32x4 (&acc)[MI][NJ], float (&ss)[MI], char* smem, const size_t bstep = 64) {
    constexpr int WC = 4 / WR, BM = WR * MI * 16, BN = WC * NJ * 16, AQ = BM / 64, BQ = BN / 64, NG = AQ + BQ, SB = (BM + BN) * 64;
    static_assert(NST * SB <= SMEM_MAIN && AQ >= 1 && BQ >= 1 && (NST == 3 || NST == 4), "ring does not fit the LDS");
    const int tid = otid(wv), lane = tid & 63, wid = tid >> 6, wr = wid / WC, wc = wid % WC;
#pragma unroll
    for (int i = 0; i < MI; ++i) {
        ss[i] = 0.f;
#pragma unroll
        for (int j = 0; j < NJ; ++j) acc[i][j] = (f32x4){0.f, 0.f, 0.f, 0.f};
    }
    const int lrow = wid * 16 + (lane >> 2);
    const int lc4 = (lane & 3) ^ ((-(lrow >> 2)) & 3);
    const h16* bp = Bt + (size_t)lrow * ldb + lc4 * 8;
    char* lbase = smem + wid * 1024;
    const int fr = lane & 15, fq = lane >> 4, sw = (-(fr >> 2)) & 3;
    const int aoff0 = (wr * MI * 16 + fr) * 64 + ((fq ^ sw) * 16);
    const int boff0 = BM * 64 + (wc * NJ * 16 + fr) * 64 + ((fq ^ sw) * 16);
    const int nt = K >> 5;
    auto issue = [&](const int t, char* stage) {
        const int kt = t >> 1, hb = (t & 1) * 4;
#pragma unroll
        for (int q = 0; q < AQ; ++q) glds16(afn(lrow + 64 * q, kt, hb + lc4), stage + q * 4096);
#pragma unroll
        for (int q = 0; q < BQ; ++q) glds16(bp + (size_t)q * 64 * ldb + (size_t)kt * bstep + hb * 8, stage + BM * 64 + q * 4096);
    };
    auto compute = [&](const char* st) {
        half8 af[MI], bf[NJ];
#pragma unroll
        for (int i = 0; i < MI; ++i) af[i] = *(const half8*)(st + aoff0 + i * 1024);
#pragma unroll
        for (int j = 0; j < NJ; ++j) bf[j] = *(const half8*)(st + boff0 + j * 1024);
        if (SUMSQ) {
#pragma unroll
            for (int i = 0; i < MI; ++i)
#pragma unroll
                for (int e = 0; e < 4; ++e) {
                    const half2_ x = (half2_){af[i][2 * e], af[i][2 * e + 1]};
                    ss[i] = __builtin_amdgcn_fdot2(x, x, ss[i], false);
                }
        }
#pragma unroll
        for (int i = 0; i < MI; ++i)
#pragma unroll
            for (int j = 0; j < NJ; ++j) acc[i][j] = __builtin_amdgcn_mfma_f32_16x16x32_f16(bf[j], af[i], acc[i][j], 0, 0, 0);
    };
#define GEMM_STEP(S, t) do { if (NST == 4 && (t) + 2 < nt) gwaitbar<NG>(); else gwaitbar<0>();                       \
        if ((t) + NST - 1 < nt) issue((t) + NST - 1, lbase + (((S) + NST - 1) % NST) * SB); compute(smem + (S) * SB); } while (0)
    gwaitbar<0>();
    {
        const int k = nt < NST - 1 ? nt : NST - 1;
        for (int p = 0; p < k; ++p) issue(p, lbase + p * SB);
        if (k >= 3) gwaitbar<2 * NG>(); else if (k == 2) gwaitbar<NG>(); else gwaitbar<0>();
        __builtin_amdgcn_s_sleep(2);
    }
#pragma unroll 1
    for (int t = 0; t < nt; t += NST) {
        GEMM_STEP(0, t);
        if (t + 1 < nt) GEMM_STEP(1, t + 1);
        if (t + 2 < nt) GEMM_STEP(2, t + 2);
        if (NST == 4 && t + 3 < nt) GEMM_STEP(3 % NST, t + 3);
    }
#undef GEMM_STEP
    asm volatile("s_waitcnt lgkmcnt(0)\n\ts_barrier" ::: "memory");
    if (SUMSQ) {
#pragma unroll
        for (int i = 0; i < MI; ++i) { ss[i] += __shfl_xor(ss[i], 16); ss[i] += __shfl_xor(ss[i], 32); }
    }
}
template <bool SUMSQ, class AF>
DI void gemm_mainloop_glds(const int wv, const int K, const AF& afn, const h16* __restrict__ Bt, const int ldb, f32x4 (&acc)[4][4], float (&ss)[4], char* smem, const size_t bstep = 64) {
    gemm_glds<SUMSQ, 2, 4, 4>(wv, K, afn, Bt, ldb, acc, ss, smem, bstep);
}

DI int glu_perm_dst(int c_orig) {
    const int which = c_orig >> 8, c = c_orig & 255;
    return (c >> 6) * 128 + ((c >> 5) & 1) * 64 + (((c >> 4) & 1) * 2 + which) * 16 + (c & 15);
}
template <int MAP, int KB>
DI void transpose64(const float* __restrict__ src, int R, int C, h16* __restrict__ dst, int r0, int c0,
                    const float* __restrict__ rscale, char* smem, const int wv) {
    h16* tile = (h16*)smem;
    const int tid = otid(wv);
    {
        const int r = tid >> 2, cq = (tid & 3) * 16;
        const float sc = rscale ? rscale[r0 + r] : 1.f;
        const float* sp = src + (size_t)(r0 + r) * C + c0 + cq;
#pragma unroll
        for (int q = 0; q < 4; ++q) {
            float4 v = (float4){0.f, 0.f, 0.f, 0.f};
            if (c0 + cq + q * 4 < C) v = *(const float4*)(sp + q * 4);
            *(half4*)(tile + r * 72 + cq + q * 4) = (half4){(h16)(v.x * sc), (h16)(v.y * sc), (h16)(v.z * sc), (h16)(v.w * sc)};
        }
    }
    __syncthreads();
    {
        const int c = tid >> 2, rq = (tid & 3) * 16;
        half8 o0, o1;
#pragma unroll
        for (int k = 0; k < 8; ++k) { o0[k] = tile[(rq + k) * 72 + c]; o1[k] = tile[(rq + 8 + k) * 72 + c]; }
        const int cc = c0 + c;
        const int dr = MAP == 1 ? map_col(cc) : MAP == 2 ? glu_perm_dst(cc) : cc;
        h16* dp = KB ? dst + ((size_t)(r0 >> 6) * KB + dr) * 64 + rq : dst + (size_t)dr * R + r0 + rq;
        *(half8*)dp = o0; *(half8*)(dp + 8) = o1;
    }
    __syncthreads();
}

DI void phase0(PP P, char* smem, const int wv) {
    P = plaunder(P);
    constexpr int N_WIN = 4 * 16 * 50, N_WOUT = 4 * 16 * 16, N_C1 = 16 * 16 * 4, N_GLU = 4 * 4 * 8, N_XH = NT * 1024 / 2048, N_PB = 8 * 16;
    const int total = N_WIN + N_WOUT + N_C1 + N_GLU + N_XH + N_PB;
    for (int w = blockIdx.x; w < total; w += gridDim.x) {
        if (w < N_WIN) {
            const int l = w / 800, r = w % 800, rt = r / 50, ct = r % 50;
            transpose64<1, D_IN_PAD>(P->in[I_WIN] + (size_t)l * 1024 * D_IN, 1024, D_IN, (h16*)(P->ws + OFF_WTIN) + (size_t)l * D_IN_PAD * 1024,
                           rt * 64, ct * 64, P->in[I_NORMG] + l * 1024, smem, wv);
        } else if (w < N_WIN + N_WOUT) {
            const int v = w - N_WIN, l = v >> 8, r = v & 255, rt = r >> 4, ct = r & 15;
            transpose64<0, 1024>(P->in[I_WOUT] + (size_t)l * 1024 * 1024, 1024, 1024, (h16*)(P->ws + OFF_WTOUT) + (size_t)l * 1024 * 1024,
                           rt * 64, ct * 64, nullptr, smem, wv);
        } else if (w < N_WIN + N_WOUT + N_C1) {
            const int v = w - N_WIN - N_WOUT, ljh = v >> 6, r = v & 63, rt = r >> 2, ct = r & 3;
            transpose64<0, 512>(P->in[I_CW1] + (size_t)ljh * 1024 * 256, 1024, 256, (h16*)(P->ws + OFF_WTC1) + ((size_t)(ljh >> 1) * 16 * 512 + (ljh & 1) * 256) * 64,
                           rt * 64, ct * 64, nullptr, smem, wv);
        } else if (w < N_WIN + N_WOUT + N_C1 + N_GLU) {
            const int v = w - N_WIN - N_WOUT - N_C1, l = v >> 5, r = v & 31, rt = r >> 3, ct = r & 7;
            transpose64<2, 0>(P->in[I_GLUW] + (size_t)l * 256 * 512, 256, 512, (h16*)(P->ws + OFF_WTGLU) + (size_t)l * 512 * 256,
                           rt * 64, ct * 64, nullptr, smem, wv);
        } else if (w < N_WIN + N_WOUT + N_C1 + N_GLU + N_XH) {
            const size_t e0 = ((size_t)(w - N_WIN - N_WOUT - N_C1 - N_GLU) * 256 + otid(wv)) * 8;
            const float4 a = *(const float4*)(P->in[I_X] + e0), b = *(const float4*)(P->in[I_X] + e0 + 4);
            *(half8*)((h16*)(P->ws + OFF_XH) + kb_idx(NT, e0 >> 10, (int)(e0 & 1023))) = (half8){(h16)a.x, (h16)a.y, (h16)a.z, (h16)a.w, (h16)b.x, (h16)b.y, (h16)b.z, (h16)b.w};
        } else {
            const int v = w - (N_WIN + N_WOUT + N_C1 + N_GLU + N_XH), lj = v >> 4, ks = v & 15, n = otid(wv);
            const float* w1 = P->in[I_CW1] + ((size_t)lj * 2048 + ks * 128) * 256 + n;
            const float* pp = P->in[I_CPOS] + (size_t)lj * 2048 + ks * 128;
            float a = ks == 0 ? P->in[I_CB1][lj * 256 + n] : 0.f;
#pragma unroll 16
            for (int k = 0; k < 128; ++k) a += pp[k] * w1[(size_t)k * 256];
            ((float*)(P->ws + OFF_POSB))[(lj * 16 + ks) * 256 + n] = a;
        }
    }
}

DI void s5_build_item(PP P, int l, int item, char* smem, const int wv) {
    P = plaunder(P);
    float* apow = (float*)smem;
    float* bbar = apow + 64 * 33 * 2;
    float* cc   = bbar + 64 * 16 * 2;
    const int tid = otid(wv);
    const int g = (item < 256) ? (item >> 4) : ((item - 256) >> 2);
    if (tid < 64) {
        const int p = tid;
        const float lre = fminf(P->in[I_LRE][(l * 16 + g) * 64 + p], -1e-4f);
        const float lim = P->in[I_LIM][(l * 16 + g) * 64 + p];
        const float dt = expf(P->in[I_LSTEP][l * 16 + g]);
        const float x = lre * dt, y = lim * dt;
        const float em1 = expm1f(x), cy = cosf(y), sy = sinf(y), sh = sinf(0.5f * y);
        const float ar = (em1 + 1.f) * cy, ai = (em1 + 1.f) * sy;
        const float dr = em1 * cy - 2.f * sh * sh, di = ai;
        const float den = lre * lre + lim * lim;
        const float fr = (dr * lre + di * lim) / den;
        const float fi = (di * lre - dr * lim) / den;
        float pr = 1.f, pi = 0.f;
        for (int k = 0; k <= 32; ++k) {
            apow[(p * 33 + k) * 2] = pr; apow[(p * 33 + k) * 2 + 1] = pi;
            const float nr = pr * ar - pi * ai, ni = pr * ai + pi * ar; pr = nr; pi = ni;
        }
        for (int c = 0; c < 16; ++c) {
            const float br = P->in[I_BRE][((size_t)(l * 16 + g) * 64 + p) * 16 + c];
            const float bi = P->in[I_BIM][((size_t)(l * 16 + g) * 64 + p) * 16 + c];
            bbar[(p * 16 + c) * 2] = fr * br - fi * bi;
            bbar[(p * 16 + c) * 2 + 1] = fr * bi + fi * br;
        }
    }
    for (int e = tid; e < 1024; e += 256) {
        cc[e * 2] = P->in[I_CRE][(size_t)(l * 16 + g) * 1024 + e];
        cc[e * 2 + 1] = P->in[I_CIM][(size_t)(l * 16 + g) * 1024 + e];
    }
    __syncthreads();
    if (item < 256) {
        const int c = item & 15;
        float* kt = cc + 2048;
        for (int idx = tid; idx < 512; idx += 256) {
            const int lag = idx >> 4, c2 = idx & 15;
            float a = 0.f;
            for (int p = 0; p < 64; ++p) {
                const float cr = cc[(c * 64 + p) * 2], ci = cc[(c * 64 + p) * 2 + 1];
                const float xr = apow[(p * 33 + lag) * 2], xi = apow[(p * 33 + lag) * 2 + 1];
                const float br = bbar[(p * 16 + c2) * 2], bi = bbar[(p * 16 + c2) * 2 + 1];
                const float tr = cr * xr - ci * xi, ti = cr * xi + ci * xr;
                a += tr * br - ti * bi;
            }
            kt[idx] = a;
        }
        __syncthreads();
        h16* W = (h16*)(P->ws + OFF_S5W) + (size_t)g * 512 * 640;
        for (int idx = tid; idx < 32 * 640; idx += 256) {
            const int j = idx / 640, k = idx % 640;
            float val = 0.f;
            if (k < 512) {
                const int s = k >> 4, c2 = k & 15, lag = j - s;
                if (lag >= 0) val = kt[lag * 16 + c2];
            } else {
                const int p = (k - 512) >> 1;
                const float cr = cc[(c * 64 + p) * 2], ci = cc[(c * 64 + p) * 2 + 1];
                const float xr = apow[(p * 33 + j + 1) * 2], xi = apow[(p * 33 + j + 1) * 2 + 1];
                val = (k & 1) ? -(cr * xi + ci * xr) : (cr * xr - ci * xi);
            }
            W[(size_t)(j * 16 + c) * 640 + k] = (h16)val;
        }
    } else {
        const int pq = (item - 256) & 3;
        h16* E = (h16*)(P->ws + OFF_S5E) + ((size_t)g * 128 + pq * 32) * 512;
        for (int idx = tid; idx < 32 * 512; idx += 256) {
            const int nl = idx >> 9, k = idx & 511;
            const int p = pq * 16 + (nl >> 1), s = k >> 4, c2 = k & 15;
            const float xr = apow[(p * 33 + 31 - s) * 2], xi = apow[(p * 33 + 31 - s) * 2 + 1];
            const float br = bbar[(p * 16 + c2) * 2], bi = bbar[(p * 16 + c2) * 2 + 1];
            const float val = (nl & 1) ? (xr * bi + xi * br) : (xr * br - xi * bi);
            E[(size_t)nl * 512 + k] = (h16)val;
        }
        if (tid < 16) {
            const int p = pq * 16 + tid;
            float* AL = (float*)(P->ws + OFF_S5AL);
            AL[(g * 64 + p) * 2] = apow[(p * 33 + 32) * 2];
            AL[(g * 64 + p) * 2 + 1] = apow[(p * 33 + 32) * 2 + 1];
        }
    }
    __syncthreads();
}

template <int WR, int MI>
DI void inproj_tile(PP P, int l, int m0, int n0, char* smem, const int wv) {
    P = plaunder(P);
    constexpr int WC = 4 / WR;
    f32x4 acc[MI][4];
    float ss[MI];
    gemm_glds<true, WR, MI, 4, (WR == 2 && MI == 8) ? 3 : 4>(wv, 1024, APlain{(const h16*)(P->ws + OFF_XH) + (size_t)m0 * 64, 64, (size_t)NT * 64},
                               (const h16*)(P->ws + OFF_WTIN) + ((size_t)l * 16 * D_IN_PAD + n0) * 64, 64, acc, ss, smem, (size_t)D_IN_PAD * 64);
    const int tid = otid(wv), lane = tid & 63, wid = tid >> 6, wr = wid / WC, wc = wid % WC;
    h16* proj = (h16*)(P->ws + OFF_PROJ);
    const int n64 = n0 + wc * 64;
    int cls = 0;
    if (n64 < 512) cls = 1;
    else if (n64 >= C_NKV + 256 && n64 < C_NKV + 384) cls = 2;
    else if (n64 >= C_NKV + 512 && n64 < C_NKV + 640) cls = 3;
    else if (n64 >= C_NKV + 384 && n64 < C_NKV + 512) cls = 4;
    else if (n64 >= C_NKV + 640 && n64 < C_NKV + 768) cls = 5;
    float wn[4][4];
    if (cls >= 1 && cls <= 3) {
        const float* wp = (cls == 1) ? P->in[I_NQN] + l * 64 : P->in[I_NKN] + (l * 3 + (cls - 1)) * 64;
        const float sc = (cls == 1) ? QSCALE : 1.f;
#pragma unroll
        for (int j = 0; j < 4; ++j) {
            const float4 w4 = *(const float4*)(wp + j * 16 + (lane >> 4) * 4);
            wn[j][0] = w4.x * sc; wn[j][1] = w4.y * sc; wn[j][2] = w4.z * sc; wn[j][3] = w4.w * sc;
        }
    }
#pragma unroll
    for (int i = 0; i < MI; ++i) {
        const int ml = wr * MI * 16 + i * 16 + (lane & 15);
        const float r = rsqrtf(ss[i] * (1.f / 1024.f) + 1e-6f);
        const size_t row = (size_t)m0 + ml;
        f32x4 v[4];
#pragma unroll
        for (int j = 0; j < 4; ++j) v[j] = acc[i][j] * r;
        if (cls >= 1 && cls <= 3) {
            float s2 = 0.f;
#pragma unroll
            for (int j = 0; j < 4; ++j) s2 += v[j][0] * v[j][0] + v[j][1] * v[j][1] + v[j][2] * v[j][2] + v[j][3] * v[j][3];
            s2 += __shfl_xor(s2, 16); s2 += __shfl_xor(s2, 32);
            const float rn = rsqrtf(s2 * (1.f / 64.f) + 1e-6f);
#pragma unroll
            for (int j = 0; j < 4; ++j) { v[j][0] *= rn * wn[j][0]; v[j][1] *= rn * wn[j][1]; v[j][2] *= rn * wn[j][2]; v[j][3] *= rn * wn[j][3]; }
        }
        if (cls >= 4) {
            const int g = (n64 >> 6) & 1, br = cls - 4;
            const int b = (int)(row >> 13), t = (int)(row & 8191);
            h16* vt = (h16*)(P->ws + OFF_VTG) + ((((size_t)br * 4 + b * 2 + g) * 128 + (t >> 6)) * 64) * 64;
#pragma unroll
            for (int j = 0; j < 4; ++j)
#pragma unroll
                for (int e = 0; e < 4; ++e) vt[(j * 16 + (lane >> 4) * 4 + e) * 64 + vkperm(t & 63)] = (h16)v[j][e];
        }
#pragma unroll
        for (int j = 0; j < 4; ++j) {
            const int n = n64 + j * 16 + (lane >> 4) * 4;
            if (n < D_IN) *(half4*)(proj + row * D_IN + n) = (half4){(h16)v[j][0], (h16)v[j][1], (h16)v[j][2], (h16)v[j][3]};
        }
        __builtin_amdgcn_sched_barrier(0);
    }
    __syncthreads();
}


DI void cmp_gemm_tile(PP P, int l, int tile, char* smem, const int wv) {
    P = plaunder(P);
    const int j = tile >> 6, mt = (tile >> 2) & 15, nt = tile & 3;
    const int row0 = mt * 128, bg = row0 >> 9, i0 = row0 & 511, b = bg >> 1, g = bg & 1;
    f32x4 acc[4][4];
    float ssd[4];
    gemm_mainloop_glds<false>(wv, 1024, APlain{(const h16*)(P->ws + OFF_PROJ) + ((size_t)b * SEQ + 16 * i0) * D_IN + C_NKV + j * 128 + g * 64, (size_t)16 * D_IN, (size_t)D_IN},
                              (const h16*)(P->ws + OFF_WTC1) + ((size_t)(l * 2 + j) * 16 * 512 + nt * 128) * 64, 64, acc, ssd, smem, (size_t)512 * 64);
    const int tid = otid(wv), lane = tid & 63, wid = tid >> 6, wr = wid >> 1, wc = wid & 1;
    float* pt = (float*)(P->ws + OFF_CHID) + (size_t)j * 2048 * 512;
#pragma unroll
    for (int i = 0; i < 4; ++i) {
        const size_t row = (size_t)row0 + wr * 64 + i * 16 + (lane & 15);
#pragma unroll
        for (int jj = 0; jj < 4; ++jj) {
            const int n = nt * 128 + wc * 64 + jj * 16 + (lane >> 4) * 4;
            const f32x4 v = acc[i][jj];
            *(float4*)(pt + row * 512 + n) = (float4){v[0], v[1], v[2], v[3]};
        }
    }
}

DI void s5e_gemm_tile(PP P, int l, int tile, char* smem, const int wv) {
    P = plaunder(P);
    const int g = tile >> 2, mt = tile & 3;
    f32x4 acc[4][4];
    float ssd[4];
    gemm_mainloop_glds<false>(wv, 512, AS5{(const h16*)(P->ws + OFF_PROJ) + C_SU + g * 16, nullptr, mt * 128},
                              (const h16*)(P->ws + OFF_S5E) + (size_t)g * 128 * 512, 512, acc, ssd, smem);
    const int tid = otid(wv), lane = tid & 63, wid = tid >> 6, wr = wid >> 1, wc = wid & 1;
    float* xc = (float*)(P->ws + OFF_XC);
#pragma unroll
    for (int i = 0; i < 4; ++i) {
        const size_t ch = (size_t)mt * 128 + wr * 64 + i * 16 + (lane & 15);
#pragma unroll
        for (int jj = 0; jj < 4; ++jj) {
            const int n = wc * 64 + jj * 16 + (lane >> 4) * 4;
            const f32x4 v = acc[i][jj];
            *(float4*)(xc + (ch * 1024 + g * 64) * 2 + n) = (float4){v[0], v[1], v[2], v[3]};
        }
    }
}

DI void gla_scan_item(PP P, int item, char* smem, const int wv) {
    P = plaunder(P);
    const int tid = otid(wv), sl = tid & 31, part = tid >> 5;
    const int idx = item * 32 + sl, bh = idx >> 11, de = idx & 2047, d = de >> 6;
    float* kv = (float*)(P->ws + OFF_GKV) + ((size_t)bh * 256 + part * 32) * 2048 + de;
    const float* dc = (const float*)(P->ws + OFF_GDEC) + ((size_t)bh * 256 + part * 32) * 32 + d;
    float* sD = (float*)smem; float* sL = sD + 256;
    float kvv[32], dd[32];
#pragma unroll
    for (int i = 0; i < 32; ++i) { kvv[i] = kv[(size_t)i * 2048]; dd[i] = dc[i * 32]; }
    float D = 1.f, L = 0.f;
#pragma unroll
    for (int i = 0; i < 32; ++i) { L = dd[i] * L + kvv[i]; D *= dd[i]; }
    sD[part * 32 + sl] = D; sL[part * 32 + sl] = L;
    __syncthreads();
    float S = 0.f;
    for (int q = 0; q < part; ++q) S = sD[q * 32 + sl] * S + sL[q * 32 + sl];
#pragma unroll
    for (int i = 0; i < 32; ++i) { const float o = S; S = dd[i] * S + kvv[i]; kv[(size_t)i * 2048] = o; }
    __syncthreads();
}
DI void s5_scan_item(PP P, int item, char* smem, const int wv) {
    P = plaunder(P);
    const int tid = otid(wv), sl = tid & 31, part = tid >> 5;
    const int idx = item * 32 + sl, b = idx >> 10, s = idx & 1023;
    float2* xc = (float2*)(P->ws + OFF_XC) + ((size_t)b * 256 + part * 32) * 1024 + s;
    half2_* xch = (half2_*)(P->ws + OFF_XCH) + ((size_t)b * 256 + part * 32) * 1024 + s;
    const float2 a = ((const float2*)(P->ws + OFF_S5AL))[s];
    float2* sL = (float2*)smem;
    float2 c[32];
#pragma unroll
    for (int i = 0; i < 32; ++i) c[i] = xc[(size_t)i * 1024];
    float lr = 0.f, li = 0.f;
#pragma unroll
    for (int i = 0; i < 32; ++i) { const float nr = a.x * lr - a.y * li + c[i].x, ni = a.x * li + a.y * lr + c[i].y; lr = nr; li = ni; }
    float dr = a.x, di = a.y;
#pragma unroll
    for (int i = 0; i < 5; ++i) { const float nr = dr * dr - di * di, ni = 2.f * dr * di; dr = nr; di = ni; }
    sL[part * 32 + sl] = (float2){lr, li};
    __syncthreads();
    float xr = 0.f, xi = 0.f;
    for (int q = 0; q < part; ++q) { const float2 lq = sL[q * 32 + sl]; const float nr = dr * xr - di * xi + lq.x, ni = dr * xi + di * xr + lq.y; xr = nr; xi = ni; }
#pragma unroll
    for (int i = 0; i < 32; ++i) {
        const float2 o = (float2){xr, xi};
        const float nr = a.x * xr - a.y * xi + c[i].x, ni = a.x * xi + a.y * xr + c[i].y; xr = nr; xi = ni;
        xc[(size_t)i * 1024] = o;
        xch[(size_t)i * 1024] = (half2_){(h16)o.x, (h16)o.y};
    }
    __syncthreads();
}
DI void cmp_l2_item(PP P, int l, int item, char* smem, const int wv) {
    P = plaunder(P);
    const int tid = otid(wv), lane = tid & 63, w = tid >> 6;
    const int j = item >> 8, r0 = (item & 255) * 8;
    h16* w2s = (h16*)smem;
    float* hs = (float*)(smem + 32768);
    {
        const float* w2 = P->in[I_CW2] + (size_t)(l * 2 + j) * 256 * 64;
        for (int e = tid * 4; e < 256 * 64; e += 1024) {
            const float4 v = *(const float4*)(w2 + e);
            *(half4*)(w2s + e) = (half4){(h16)v.x, (h16)v.y, (h16)v.z, (h16)v.w};
        }
        const float* pt = (const float*)(P->ws + OFF_CHID) + (size_t)j * 2048 * 512;
        float pb = 0.f;
#pragma unroll
        for (int ks = 0; ks < 16; ++ks) pb += ((const float*)(P->ws + OFF_POSB))[((l * 2 + j) * 16 + ks) * 256 + tid];
#pragma unroll
        for (int rr = 0; rr < 8; ++rr) {
            const int row = r0 + rr, i = row & 511;
            float v = 0.f;
            if (i < 511) v = gelu_tanh(pt[(size_t)row * 512 + tid] + pt[(size_t)(row + 1) * 512 + 256 + tid] + pb);
            hs[rr * 256 + tid] = v;
        }
    }
    __syncthreads();
    const float bb = P->in[I_CB2][(l * 2 + j) * 64 + lane];
    float a0 = bb, a1 = bb;
    const float* h0 = hs + (2 * w) * 256, *h1 = h0 + 256;
#pragma unroll 8
    for (int n = 0; n < 256; ++n) {
        const float wv = (float)w2s[n * 64 + lane];
        a0 += h0[n] * wv; a1 += h1[n] * wv;
    }
#pragma unroll
    for (int rr = 0; rr < 2; ++rr) {
        float acc = rr ? a1 : a0;
        const int row = r0 + 2 * w + rr, bg = row >> 9, i = row & 511;
        if (i == 511) acc = 0.f;
        if (j == 0) {
            const float ss = wave_sum(acc * acc);
            acc = acc * rsqrtf(ss * (1.f / 64.f) + 1e-6f) * P->in[I_NKN][(l * 3 + 0) * 64 + lane];
            ((h16*)(P->ws + OFF_KCMP))[(size_t)row * 64 + lane] = (h16)acc;
        } else {
            ((h16*)(P->ws + OFF_VCMP))[(((size_t)bg * 8 + (i >> 6)) * 64 + lane) * 64 + vkperm(i & 63)] = (h16)acc;
        }
    }
    __syncthreads();
}

DI void s5o_gemm_tile(PP P, int l, int tile, char* smem, const int wv) {
    P = plaunder(P);
    const int g = tile >> 5, mt = (tile >> 3) & 3, nt = tile & 7;
    f32x4 acc[2][4];
    float ssd[2];
    gemm_glds<false, 4, 2, 4>(wv, 640, AS5{(const h16*)(P->ws + OFF_PROJ) + C_SU + g * 16, (const h16*)(P->ws + OFF_XCH) + g * 128, mt * 128},
                              (const h16*)(P->ws + OFF_S5W) + ((size_t)g * 512 + nt * 64) * 640, 640, acc, ssd, smem);
    const int tid = otid(wv), lane = tid & 63, wid = tid >> 6;
    const h16* proj = (const h16*)(P->ws + OFF_PROJ);
    h16* yact = (h16*)(P->ws + OFF_YACT);
#pragma unroll
    for (int i = 0; i < 2; ++i) {
        const size_t ch = (size_t)mt * 128 + wid * 32 + i * 16 + (lane & 15);
#pragma unroll
        for (int jj = 0; jj < 4; ++jj) {
            const int n = nt * 64 + jj * 16 + (lane >> 4) * 4;
            const int j = n >> 4, c = n & 15;
            const size_t tok = ch * 32 + j;
            const half4 u4 = *(const half4*)(proj + tok * D_IN + C_SU + g * 16 + c);
            const float4 dd = *(const float4*)(P->in[I_SD] + (l * 16 + g) * 16 + c);
            const f32x4 v = acc[i][jj];
            half4 o;
            o[0] = (h16)gelu_tanh(v[0] + dd.x * (float)u4[0]);
            o[1] = (h16)gelu_tanh(v[1] + dd.y * (float)u4[1]);
            o[2] = (h16)gelu_tanh(v[2] + dd.z * (float)u4[2]);
            o[3] = (h16)gelu_tanh(v[3] + dd.w * (float)u4[3]);
            *(half4*)(yact + tok * 256 + g * 16 + c) = o;
        }
    }
}

#define MFMA32(a, b, c) __builtin_amdgcn_mfma_f32_32x32x16_f16((a), (b), (c), 0, 0, 0)
constexpr float NEGS = -1e30f;
DI float ex2(float x) { return __builtin_amdgcn_exp2f(x); }
#define NSA_WAITBAR(N) asm volatile("s_waitcnt vmcnt(" #N ") lgkmcnt(0)\n\ts_barrier" ::: "memory")
#define NSA_BAR() asm volatile("s_waitcnt lgkmcnt(0)\n\ts_barrier" ::: "memory")

struct KVSrc { const h16* k; int ldk; size_t kstep; const h16* v; };
DI void nsa_dma(const KVSrc& s, int j, char* stage, int wid, int lane) {
    const int row0 = wid * 8 + (lane >> 3);
    const int sw = ((lane & 7) ^ ((row0 >> 1) & 7)) * 8;
    const h16* kp = s.k + (size_t)j * s.kstep + (size_t)row0 * s.ldk + sw;
    glds16(kp, stage + wid * 1024);
    glds16(kp + (size_t)32 * s.ldk, stage + 4096 + wid * 1024);
    const h16* vp = s.v + (size_t)j * 4096 + row0 * 64 + sw;
    glds16(vp, stage + 8192 + wid * 1024);
    glds16(vp + 32 * 64, stage + 8192 + 4096 + wid * 1024);
}
template <int NST, class F>
DI void nsa_pipe(const KVSrc& s, const int n, char* smem, int wid, int lane, F&& compute) {
    NSA_WAITBAR(0);
    {
        const int k = n < NST - 1 ? n : NST - 1;
        for (int p = 0; p < k; ++p) nsa_dma(s, p, smem + p * 16384, wid, lane);
        if (k >= 3) NSA_WAITBAR(8); else if (k == 2) NSA_WAITBAR(4); else NSA_WAITBAR(0);
        __builtin_amdgcn_s_sleep(2);
    }
    for (int j = 0; j < n; ++j) {
        if (NST == 4 && j + 2 < n) NSA_WAITBAR(4); else NSA_WAITBAR(0);
        const int jn = j + NST - 1;
        compute(j, smem + (j % NST) * 16384, [&]() { if (jn < n) nsa_dma(s, jn, smem + (jn % NST) * 16384, wid, lane); });
    }
}

template <bool SHIFT = false, class BF>
DI void qk_tile(const char* Kimg, const half8 (&qf)[4], f32x16 (&s)[2], int lane, BF&& between) {
    const int r = lane & 31, h = lane >> 5, swz = (r >> 1) & 7;
    const char* base = Kimg + r * 128;
    half8 kf[8];
#pragma unroll
    for (int kt = 0; kt < 2; ++kt)
#pragma unroll
        for (int ks = 0; ks < 4; ++ks) kf[kt * 4 + ks] = *(const half8*)(base + kt * 4096 + (((2 * ks + h) ^ swz) << 4));
    __builtin_amdgcn_sched_barrier(0);
    between();
    __builtin_amdgcn_sched_barrier(0);
#pragma unroll
    for (int kt = 0; kt < 2; ++kt) {
#pragma unroll
        for (int e = 0; e < 16; ++e) s[kt][e] = 0.f;
#pragma unroll
        for (int ks = 0; ks < 4; ++ks) s[kt] = MFMA32(kf[kt * 4 + ks], qf[ks], s[kt]);
    }
}
template <bool SHIFT = false>
DI void qk_tile(const char* Kimg, const half8 (&qf)[4], f32x16 (&s)[2], int lane) { qk_tile<SHIFT>(Kimg, qf, s, lane, []() {}); }
template <int S> DI half8 pack8(const f32x16& x) {
    return (half8){(h16)x[8 * S], (h16)x[8 * S + 1], (h16)x[8 * S + 2], (h16)x[8 * S + 3], (h16)x[8 * S + 4], (h16)x[8 * S + 5], (h16)x[8 * S + 6], (h16)x[8 * S + 7]};
}
template <int KT>
DI void pv_load(const char* Vimg, half8 (&vf)[4], int lane) {
    const int r = lane & 31, h = lane >> 5, swz = (r >> 1) & 7;
    const char* rb = Vimg + r * 128;
#pragma unroll
    for (int dt = 0; dt < 2; ++dt) {
        vf[dt * 2 + 0] = *(const half8*)(rb + dt * 4096 + (((4 * KT + h) ^ swz) << 4));
        vf[dt * 2 + 1] = *(const half8*)(rb + dt * 4096 + (((4 * KT + 2 + h) ^ swz) << 4));
    }
}
typedef unsigned u32x4_ __attribute__((ext_vector_type(4)));
template <int KT, bool MASKED = false>
DI void pv_mma(const half8 (&vf)[4], const f32x16 (&p)[2], f32x16 (&o)[2], const unsigned rmask = 0xffffffffu) {
    half8 pb0 = pack8<0>(p[KT]), pb1 = pack8<1>(p[KT]);
    if (MASKED) {
        pb0 = __builtin_bit_cast(half8, __builtin_bit_cast(u32x4_, pb0) & rmask);
        pb1 = __builtin_bit_cast(half8, __builtin_bit_cast(u32x4_, pb1) & rmask);
    }
#pragma unroll
    for (int dt = 0; dt < 2; ++dt) {
        o[dt] = MFMA32(vf[dt * 2 + 0], pb0, o[dt]);
        o[dt] = MFMA32(vf[dt * 2 + 1], pb1, o[dt]);
    }
}
template <bool MASKED = false>
DI void pv_finish(const char* Vimg, const half8 (&va)[4], const f32x16 (&p)[2], f32x16 (&o)[2], int lane, const unsigned rmask = 0xffffffffu) {
    half8 vb[4];
    pv_load<1>(Vimg, vb, lane);
    pv_mma<0, MASKED>(va, p, o, rmask);
    pv_mma<1, MASKED>(vb, p, o, rmask);
}
DI float sm_fast(f32x16 (&s)[2]) {
    float rs = 0.f;
#pragma unroll
    for (int kt = 0; kt < 2; ++kt)
#pragma unroll
        for (int e = 0; e < 16; ++e) { const float p = ex2(s[kt][e]); s[kt][e] = p; rs += p; }
    return rs;
}
DI float xhalf_max(float v) {
    const auto r = __builtin_amdgcn_permlane32_swap(__float_as_uint(v), __float_as_uint(v), false, false);
    return fmaxf(__uint_as_float(r[0]), __uint_as_float(r[1]));
}
DI float xhalf_sum(float v) {
    const auto r = __builtin_amdgcn_permlane32_swap(__float_as_uint(v), __float_as_uint(v), false, false);
    return __uint_as_float(r[0]) + __uint_as_float(r[1]);
}
DI float rowmax32(const f32x16 (&s)[2]) {
    float mx = s[0][0];
#pragma unroll
    for (int e = 1; e < 16; ++e) mx = fmaxf(mx, s[0][e]);
#pragma unroll
    for (int e = 0; e < 16; ++e) mx = fmaxf(mx, s[1][e]);
    return xhalf_max(mx);
}
constexpr float SM_THR = 6.f;
DI void sm_online(f32x16 (&s)[2], float& m, float& l, f32x16 (&o)[2], const bool rowok) {
    float mx = rowmax32(s);
    mx = rowok ? mx : NEGS;
    if (__any(mx > m + SM_THR)) {
        const float mn = fmaxf(m, mx), alpha = ex2(m - mn);
        l *= alpha; o[0] *= alpha; o[1] *= alpha; m = mn;
    }
    const float msub = rowok ? m : 1e30f;
    float rs = 0.f;
#pragma unroll
    for (int kt = 0; kt < 2; ++kt)
#pragma unroll
        for (int e = 0; e < 16; ++e) { const float p = ex2(s[kt][e] - msub); s[kt][e] = p; rs += p; }
    l += xhalf_sum(rs);
}

template <int V> struct IC { static constexpr int value = V; };
template <bool FAST>
DI void nsa_unit(PP P, int l, int bg, int c32, char* smem, const int wv) {
    P = plaunder(P);
    const int tid = otid(wv), lane = tid & 63, w = tid >> 6, r = lane & 31, h = lane >> 5;
    const int b = bg >> 1, g = bg & 1, t0 = c32 * 32, cur = c32 >> 1;
    const int tokl = w * 8 + (r >> 2), head = r & 3, t = t0 + tokl;
    const size_t tokg = (size_t)b * SEQ + t;
    float* IMP = (float*)(smem + 49152);
    unsigned* SELM = (unsigned*)(smem + 49152);
    const h16* proj = (const h16*)(P->ws + OFF_PROJ);
    const int ghead = g * 4 + head;

    half8 qf[4];
    {
        const h16* qp = proj + tokg * D_IN + C_NQ + ghead * 64 + 8 * h;
#pragma unroll
        for (int ks = 0; ks < 4; ++ks) qf[ks] = *(const half8*)(qp + 16 * ks);
    }
    float g0, g1, g2;
    {
        const h16* gp = proj + tokg * D_IN + C_NGL + ghead * 3;
        const float* gb = P->in[I_NGB] + l * 24 + ghead * 3;
        g0 = sigmoidf_((float)gp[0] + gb[0]); g1 = sigmoidf_((float)gp[1] + gb[1]); g2 = sigmoidf_((float)gp[2] + gb[2]);
    }
    __syncthreads();
    for (int i = tid; i < 32 * 128; i += 256) IMP[i] = 0.f;

    half8 oacc[4];
    auto oacc_add = [&](const f32x16 (&o)[2], const float sc, const bool first) {
#pragma unroll
        for (int dt = 0; dt < 2; ++dt)
#pragma unroll
            for (int hf = 0; hf < 2; ++hf) {
                half8 v = oacc[dt * 2 + hf];
#pragma unroll
                for (int e = 0; e < 8; ++e) v[e] = (h16)((first ? 0.f : (float)v[e]) + o[dt][hf * 8 + e] * sc);
                oacc[dt * 2 + hf] = v;
            }
    };

    {
        const int nvt = 2 * c32 + 1;
        const int nvr = (t >= 31) ? ((t - 31) >> 4) + 1 : 0;
        const int ntile = (nvt + 63) >> 6;
        KVSrc src{(const h16*)(P->ws + OFF_KCMP) + (size_t)bg * 512 * 64, 64, 4096, (const h16*)(P->ws + OFF_VCMP) + (size_t)bg * 8 * 4096};
        f32x16 o[2];
#pragma unroll
        for (int e = 0; e < 16; ++e) { o[0][e] = 0.f; o[1][e] = 0.f; }
        float invl;
        if constexpr (FAST) {
            const int tf = t0 + w * 8;
            const int nvlo = __builtin_amdgcn_readfirstlane((tf >= 31) ? ((tf - 31) >> 4) + 1 : 0);
            float lsum = 0.f;
            nsa_pipe<3>(src, ntile, smem, w, lane, [&](int j, const char* st, auto&& issue) {
                f32x16 s[2];
                qk_tile<true>(st, qf, s, lane);
                issue();
                if (64 * j + 64 > nvlo) {
#pragma unroll
                    for (int kt = 0; kt < 2; ++kt)
#pragma unroll
                        for (int e = 0; e < 16; ++e) {
                            const int key = 64 * j + 32 * kt + 8 * (e >> 2) + 4 * h + (e & 3);
                            if (key >= nvr) s[kt][e] = NEGS;
                        }
                }
                lsum += sm_fast(s);
            });
            lsum = xhalf_sum(lsum);
            invl = lsum > 0.f ? 1.f / lsum : 0.f;
            nsa_pipe<3>(src, ntile, smem, w, lane, [&](int j, const char* st, auto&& issue) {
                f32x16 s[2];
                qk_tile<true>(st, qf, s, lane);
                half8 vf[4];
                pv_load<0>(st + 8192, vf, lane);
                issue();
                __builtin_amdgcn_sched_barrier(0);
                if (64 * j + 64 > nvlo) {
#pragma unroll
                    for (int kt = 0; kt < 2; ++kt)
#pragma unroll
                        for (int e = 0; e < 16; ++e) {
                            const int key = 64 * j + 32 * kt + 8 * (e >> 2) + 4 * h + (e & 3);
                            if (key >= nvr) s[kt][e] = NEGS;
                        }
                }
                (void)sm_fast(s);
                if (cur >= 16) {
#pragma unroll
                    for (int kt = 0; kt < 2; ++kt)
#pragma unroll
                        for (int g4 = 0; g4 < 4; ++g4) {
                            float G = ((s[kt][4 * g4] + s[kt][4 * g4 + 1]) + (s[kt][4 * g4 + 2] + s[kt][4 * g4 + 3])) * invl;
                            float L = s[kt][4 * g4 + 3] * invl;
                            G += __shfl_xor(G, 1); G += __shfl_xor(G, 2);
                            L += __shfl_xor(L, 1); L += __shfl_xor(L, 2);
                            if (head == 0) {
                                const int sb = 16 * j + 8 * kt + 2 * g4 + h;
                                atomicAdd(&IMP[tokl * 128 + sb], G);
                                if (sb + 1 < 128) atomicAdd(&IMP[tokl * 128 + sb + 1], L);
                            }
                        }
                }
                pv_finish(st + 8192, vf, s, o, lane);
            });
        } else {
        float m = -1e20f, lsum = 0.f;
        nsa_pipe<3>(src, ntile, smem, w, lane, [&](int j, const char* st, auto&& issue) {
            f32x16 s[2];
            qk_tile(st, qf, s, lane);
            issue();
#pragma unroll
            for (int kt = 0; kt < 2; ++kt)
#pragma unroll
                for (int e = 0; e < 16; ++e) {
                    const int key = 64 * j + 32 * kt + 8 * (e >> 2) + 4 * h + (e & 3);
                    if (key >= nvr) s[kt][e] = NEGS;
                }
            const float mn = fmaxf(m, rowmax32(s)), alpha = ex2(m - mn);
            float rs = 0.f;
#pragma unroll
            for (int kt = 0; kt < 2; ++kt)
#pragma unroll
                for (int e = 0; e < 16; ++e) rs += ex2(s[kt][e] - mn);
            rs = xhalf_sum(rs);
            lsum = lsum * alpha + rs; m = mn;
        });
        const float invl_s = lsum > 0.f ? 1.f / lsum : 0.f;
        nsa_pipe<3>(src, ntile, smem, w, lane, [&](int j, const char* st, auto&& issue) {
            f32x16 s[2];
            qk_tile(st, qf, s, lane);
            half8 vf[4];
            pv_load<0>(st + 8192, vf, lane);
            issue();
            __builtin_amdgcn_sched_barrier(0);
#pragma unroll
            for (int kt = 0; kt < 2; ++kt)
#pragma unroll
                for (int e = 0; e < 16; ++e) {
                    const int key = 64 * j + 32 * kt + 8 * (e >> 2) + 4 * h + (e & 3);
                    s[kt][e] = (key < nvr) ? ex2(s[kt][e] - m) * invl_s : 0.f;
                }
            if (cur >= 16) {
#pragma unroll
                for (int kt = 0; kt < 2; ++kt)
#pragma unroll
                    for (int g4 = 0; g4 < 4; ++g4) {
                        float G = (s[kt][4 * g4] + s[kt][4 * g4 + 1]) + (s[kt][4 * g4 + 2] + s[kt][4 * g4 + 3]);
                        float L = s[kt][4 * g4 + 3];
                        G += __shfl_xor(G, 1); G += __shfl_xor(G, 2);
                        L += __shfl_xor(L, 1); L += __shfl_xor(L, 2);
                        if (head == 0) {
                            const int sb = 16 * j + 8 * kt + 2 * g4 + h;
                            atomicAdd(&IMP[tokl * 128 + sb], G);
                            if (sb + 1 < 128) atomicAdd(&IMP[tokl * 128 + sb + 1], L);
                        }
                    }
            }
            pv_finish(st + 8192, vf, s, o, lane);
        });
            invl = 1.f;
        }
        oacc_add(o, g0 * invl, true);
    }
    __syncthreads();
    {
        const int tl = lane >> 3, sub = lane & 7;
        unsigned bits = 0;
        unsigned u[16];
        if (cur >= 16) {
            const float* ip = IMP + (w * 8 + tl) * 128 + sub * 16;
#pragma unroll
            for (int i = 0; i < 16; ++i) {
                const int s = sub * 16 + i;
                u[i] = (s >= 1 && s <= cur - 2) ? (__float_as_uint(ip[i]) + 1u) : 0u;
            }
        }
        __syncthreads();
        if (cur >= 16) {
            unsigned prefix = 0;
            for (int bit = 30; bit >= 0; --bit) {
                const unsigned cand = prefix | (1u << bit);
                int cnt = 0;
#pragma unroll
                for (int i = 0; i < 16; ++i) cnt += (u[i] >= cand) ? 1 : 0;
                cnt += __shfl_xor(cnt, 1); cnt += __shfl_xor(cnt, 2); cnt += __shfl_xor(cnt, 4);
                if (cnt >= 13) prefix = cand;
            }
            int cgt = 0, ceq = 0;
#pragma unroll
            for (int i = 0; i < 16; ++i) { cgt += (u[i] > prefix) ? 1 : 0; ceq += (u[i] == prefix) ? 1 : 0; }
            cgt += __shfl_xor(cgt, 1); cgt += __shfl_xor(cgt, 2); cgt += __shfl_xor(cgt, 4);
            int inc = ceq;
            { const int v = __shfl_up(inc, 1); if (sub >= 1) inc += v; }
            { const int v = __shfl_up(inc, 2); if (sub >= 2) inc += v; }
            { const int v = __shfl_up(inc, 4); if (sub >= 4) inc += v; }
            int run = inc - ceq;
            const int need = 13 - cgt;
#pragma unroll
            for (int i = 0; i < 16; ++i) {
                const int s = sub * 16 + i;
                bool sel = u[i] > prefix;
                if (u[i] == prefix) { sel = run < need; ++run; }
                if (s == 0 || s == cur || s == cur - 1) sel = true;
                bits |= (sel ? 1u : 0u) << i;
            }
        } else {
#pragma unroll
            for (int i = 0; i < 16; ++i) bits |= ((sub * 16 + i <= cur) ? 1u : 0u) << i;
        }
        unsigned wv = bits << ((sub & 1) * 16);
        wv |= __shfl_xor(wv, 1);
        if ((sub & 1) == 0) SELM[(w * 8 + tl) * 4 + (sub >> 1)] = wv;
    }
    __syncthreads();
    unsigned selw[4];
#pragma unroll
    for (int i = 0; i < 4; ++i) selw[i] = SELM[tokl * 4 + i];

    auto branch = [&](auto BRC) {
        constexpr int br = decltype(BRC)::value;
        const int j0 = (br == 0) ? 0 : (cur - 8 > 0 ? cur - 8 : 0);
        const int nst = cur - j0 + 1;
        KVSrc src{proj + ((size_t)b * SEQ + (size_t)j0 * 64) * D_IN + C_NKV + (br == 0 ? 256 : 512) + g * 64, D_IN, (size_t)64 * D_IN,
                  (const h16*)(P->ws + OFF_VTG) + (((size_t)br * 4 + bg) * 128 + j0) * 4096};
        float m = -1e20f, lsum = 0.f;
        f32x16 o[2];
#pragma unroll
        for (int e = 0; e < 16; ++e) { o[0][e] = 0.f; o[1][e] = 0.f; }
        nsa_pipe<4>(src, nst, smem, w, lane, [&](int jj, const char* st, auto&& issue) {
            const int j = j0 + jj;
            const bool rowok = (br != 0) || (((selw[j >> 5] >> (j & 31)) & 1u) != 0u);
            if constexpr (FAST && br == 0) {
                if (!__any(rowok)) { issue(); return; }
            }
            f32x16 s[2];
            qk_tile<FAST>(st, qf, s, lane, issue);
            half8 vf[4];
            pv_load<0>(st + 8192, vf, lane);
            __builtin_amdgcn_sched_barrier(0);
            if (j == cur || (br == 1 && j == cur - 8)) {
#pragma unroll
                for (int kt = 0; kt < 2; ++kt)
#pragma unroll
                    for (int e = 0; e < 16; ++e) {
                        const int key = 64 * j + 32 * kt + 8 * (e >> 2) + 4 * h + (e & 3);
                        const bool ok = (key <= t) && (br == 0 || key > t - 512);
                        if (!ok) s[kt][e] = NEGS;
                    }
            }
            if constexpr (FAST) {
                const float rs = sm_fast(s);
                lsum += (br != 0 || rowok) ? rs : 0.f;
                pv_finish<br == 0>(st + 8192, vf, s, o, lane, rowok ? 0xffffffffu : 0u);
            } else {
                sm_online(s, m, lsum, o, rowok);
                pv_finish(st + 8192, vf, s, o, lane);
            }
        });
        if constexpr (FAST) lsum = xhalf_sum(lsum);
        const float sc = (br == 0 ? g1 : g2) / lsum;
        oacc_add(o, sc, false);
    };
    branch(IC<0>{});
    branch(IC<1>{});
    {
        h16* mixp = (h16*)(P->ws + OFF_MIX) + kb_idx(NT, tokg, 512 + ghead * 64);
        const h16* ngp = proj + tokg * D_IN + C_NG + ghead * 64;
#pragma unroll
        for (int dt = 0; dt < 2; ++dt)
#pragma unroll
            for (int g4 = 0; g4 < 4; ++g4) {
                const int d0 = 32 * dt + 8 * g4 + 4 * h;
                const half4 ng = *(const half4*)(ngp + d0);
                half4 ov;
#pragma unroll
                for (int e = 0; e < 4; ++e) ov[e] = (h16)((float)oacc[dt * 2 + (g4 >> 1)][(g4 & 1) * 4 + e] * siluf_((float)ng[e]));
                *(half4*)(mixp + d0) = ov;
            }
    }
    __syncthreads();
}

DI void gla_kv_item(PP P, int l, int item, char* smem, const int wv) {
    P = plaunder(P);
    const int tid = otid(wv), lane = tid & 63, w = tid >> 6, r = lane & 31, hh = lane >> 5;
    const int pair = item * 4 + w, h = pair & 3, cn = pair >> 2;
    const size_t tok = (size_t)cn * 32 + r;
    const int b = cn >> 8, n = cn & 255, bh = b * 4 + h;
    const h16* proj = (const h16*)(P->ws + OFF_PROJ);
    h16* VT = (h16*)(smem + w * 16384);
    h16* KT = VT + 2048;
    __syncthreads();
    {
        const half8* vp = (const half8*)(proj + tok * D_IN + C_GV + h * 64 + hh * 32);
#pragma unroll
        for (int q = 0; q < 4; ++q) {
            const half8 v8 = vp[q];
#pragma unroll
            for (int e = 0; e < 8; ++e) VT[(hh * 32 + q * 8 + e) * 32 + r] = v8[e];
        }
    }
    float gl[16];
    {
        const half8* lp = (const half8*)(proj + tok * D_IN + C_GLR);
        const half8 l0 = lp[0], l1 = lp[1];
        float lr[16];
#pragma unroll
        for (int q = 0; q < 8; ++q) { lr[q] = (float)l0[q]; lr[8 + q] = (float)l1[q]; }
        const float* w2 = P->in[I_GW2] + (size_t)l * 16 * 128 + h * 32 + 16 * hh;
        const float* b2 = P->in[I_GB2] + l * 128 + h * 32 + 16 * hh;
#pragma unroll
        for (int d = 0; d < 16; ++d) gl[d] = b2[d];
#pragma unroll
        for (int q = 0; q < 16; ++q)
#pragma unroll
            for (int d4 = 0; d4 < 4; ++d4) {
                const float4 wq = *(const float4*)(w2 + q * 128 + d4 * 4);
                gl[d4 * 4 + 0] += lr[q] * wq.x; gl[d4 * 4 + 1] += lr[q] * wq.y; gl[d4 * 4 + 2] += lr[q] * wq.z; gl[d4 * 4 + 3] += lr[q] * wq.w;
            }
#pragma unroll
        for (int d = 0; d < 16; ++d) gl[d] = log_sigmoidf_(gl[d]) * (1.f / 16.f);
    }
#pragma unroll
    for (int off = 1; off < 32; off <<= 1) {
#pragma unroll
        for (int d = 0; d < 16; ++d) { const float v = __shfl_up(gl[d], off, 32); if (r >= off) gl[d] += v; }
    }
    {
        float* bc = (float*)(P->ws + OFF_BCUM) + tok * 128 + h * 32 + 16 * hh;
#pragma unroll
        for (int d4 = 0; d4 < 4; ++d4) *(float4*)(bc + d4 * 4) = (float4){gl[d4 * 4], gl[d4 * 4 + 1], gl[d4 * 4 + 2], gl[d4 * 4 + 3]};
    }
    {
        const half8* kp = (const half8*)(proj + tok * D_IN + C_GK + h * 32 + 16 * hh);
        const half8 k0 = kp[0], k1 = kp[1];
        float bl[16];
#pragma unroll
        for (int d = 0; d < 16; ++d) bl[d] = __shfl(gl[d], 31, 32);
#pragma unroll
        for (int d = 0; d < 16; ++d) {
            const float kd = (float)(d < 8 ? k0[d & 7] : k1[d & 7]) * __expf(bl[d] - gl[d]);
            KT[(16 * hh + d) * 32 + r] = (h16)kd;
        }
        if (r == 0) {
            float* dc = (float*)(P->ws + OFF_GDEC) + (size_t)(bh * 256 + n) * 32 + 16 * hh;
#pragma unroll
            for (int d4 = 0; d4 < 4; ++d4) *(float4*)(dc + d4 * 4) = (float4){__expf(bl[d4 * 4]), __expf(bl[d4 * 4 + 1]), __expf(bl[d4 * 4 + 2]), __expf(bl[d4 * 4 + 3])};
        }
    }
    asm volatile("s_waitcnt lgkmcnt(0)" ::: "memory");
    const half8 kb0 = *(const half8*)(KT + r * 32 + 8 * hh), kb1 = *(const half8*)(KT + r * 32 + 16 + 8 * hh);
    float* kvp = (float*)(P->ws + OFF_GKV) + ((size_t)(bh * 256 + n) * 32 + r) * 64;
#pragma unroll
    for (int dt = 0; dt < 2; ++dt) {
        f32x16 o;
#pragma unroll
        for (int e = 0; e < 16; ++e) o[e] = 0.f;
        const h16* vrow = VT + (32 * dt + r) * 32 + 8 * hh;
        o = MFMA32(*(const half8*)vrow, kb0, o);
        o = MFMA32(*(const half8*)(vrow + 16), kb1, o);
#pragma unroll
        for (int g4 = 0; g4 < 4; ++g4)
            *(float4*)(kvp + 32 * dt + 8 * g4 + 4 * hh) = (float4){o[4 * g4], o[4 * g4 + 1], o[4 * g4 + 2], o[4 * g4 + 3]};
    }
    __syncthreads();
}

DI void gla_out_item(PP P, int l, int item, char* smem, const int wv) {
    P = plaunder(P);
    const int tid = otid(wv), lane = tid & 63, w = tid >> 6, r = lane & 31, hh = lane >> 5;
    const int pair = item * 4 + w, h = pair & 3, cn = pair >> 2;
    const size_t tok0 = (size_t)cn * 32, tok = tok0 + r;
    const int b = cn >> 8, n = cn & 255, bh = b * 4 + h;
    const h16* proj = (const h16*)(P->ws + OFF_PROJ);
    h16* VT = (h16*)(smem + w * 16384);
    h16* SPT = VT + 2048;
    __syncthreads();
    {
        const half8* vp = (const half8*)(proj + tok * D_IN + C_GV + h * 64 + hh * 32);
        const float4* sp = (const float4*)((const float*)(P->ws + OFF_GKV) + ((size_t)(bh * 256 + n) * 32 + r) * 64 + hh * 32);
#pragma unroll
        for (int q = 0; q < 4; ++q) {
            const half8 v8 = vp[q];
            const float4 s0 = sp[2 * q], s1 = sp[2 * q + 1];
#pragma unroll
            for (int e = 0; e < 8; ++e) VT[(hh * 32 + q * 8 + e) * 32 + r] = v8[e];
            SPT[(hh * 32 + q * 8 + 0) * 32 + r] = (h16)s0.x; SPT[(hh * 32 + q * 8 + 1) * 32 + r] = (h16)s0.y;
            SPT[(hh * 32 + q * 8 + 2) * 32 + r] = (h16)s0.z; SPT[(hh * 32 + q * 8 + 3) * 32 + r] = (h16)s0.w;
            SPT[(hh * 32 + q * 8 + 4) * 32 + r] = (h16)s1.x; SPT[(hh * 32 + q * 8 + 5) * 32 + r] = (h16)s1.y;
            SPT[(hh * 32 + q * 8 + 6) * 32 + r] = (h16)s1.z; SPT[(hh * 32 + q * 8 + 7) * 32 + r] = (h16)s1.w;
        }
    }
    half8 qe[2], ke[2];
#pragma unroll
    for (int ks = 0; ks < 2; ++ks) {
        const int d0 = 16 * ks + 8 * hh;
        const half8 q8 = *(const half8*)(proj + tok * D_IN + C_GQ + h * 32 + d0);
        const half8 k8 = *(const half8*)(proj + tok * D_IN + C_GK + h * 32 + d0);
        const float4 b0 = *(const float4*)((const float*)(P->ws + OFF_BCUM) + tok * 128 + h * 32 + d0);
        const float4 b1 = *(const float4*)((const float*)(P->ws + OFF_BCUM) + tok * 128 + h * 32 + d0 + 4);
        const float bc[8] = {b0.x, b0.y, b0.z, b0.w, b1.x, b1.y, b1.z, b1.w};
#pragma unroll
        for (int e = 0; e < 8; ++e) {
            const float ex = __expf(bc[e]);
            qe[ks][e] = (h16)((float)q8[e] * 0.17677669529663687f * ex);
            ke[ks][e] = (h16)((float)k8[e] * __builtin_amdgcn_rcpf(ex));
        }
    }
    f32x16 s;
#pragma unroll
    for (int e = 0; e < 16; ++e) s[e] = 0.f;
    s = MFMA32(ke[0], qe[0], s);
    s = MFMA32(ke[1], qe[1], s);
#pragma unroll
    for (int e = 0; e < 16; ++e) { const int j = (e & 3) + 8 * (e >> 2) + 4 * hh; if (j > r) s[e] = 0.f; }
    const half8 pb0 = pack8<0>(s), pb1 = pack8<1>(s);
    asm volatile("s_waitcnt lgkmcnt(0)" ::: "memory");
    f32x16 o[2];
#pragma unroll
    for (int dt = 0; dt < 2; ++dt) {
#pragma unroll
        for (int e = 0; e < 16; ++e) o[dt][e] = 0.f;
        const h16* vrow = VT + (32 * dt + r) * 32 + 4 * hh;
        const h16* srow = SPT + (32 * dt + r) * 32 + 8 * hh;
        {
            const half4 lo = *(const half4*)vrow, hi = *(const half4*)(vrow + 8);
            o[dt] = MFMA32(((half8){lo[0], lo[1], lo[2], lo[3], hi[0], hi[1], hi[2], hi[3]}), pb0, o[dt]);
        }
        {
            const half4 lo = *(const half4*)(vrow + 16), hi = *(const half4*)(vrow + 24);
            o[dt] = MFMA32(((half8){lo[0], lo[1], lo[2], lo[3], hi[0], hi[1], hi[2], hi[3]}), pb1, o[dt]);
        }
        o[dt] = MFMA32(*(const half8*)srow, qe[0], o[dt]);
        o[dt] = MFMA32(*(const half8*)(srow + 16), qe[1], o[dt]);
    }
    float ss = 0.f;
#pragma unroll
    for (int e = 0; e < 16; ++e) ss += o[0][e] * o[0][e] + o[1][e] * o[1][e];
    ss = xhalf_sum(ss);
    const float rn = rsqrtf(ss * (1.f / 64.f) + 1e-6f);
    h16* mix = (h16*)(P->ws + OFF_MIX);
#pragma unroll
    for (int dt = 0; dt < 2; ++dt)
#pragma unroll
        for (int g4 = 0; g4 < 4; ++g4) {
            const int e0 = 32 * dt + 8 * g4 + 4 * hh;
            const half4 gt = *(const half4*)(proj + tok * D_IN + C_GG + h * 64 + e0);
            const float4 on = *(const float4*)(P->in[I_GON] + l * 64 + e0);
            half4 ov;
            ov[0] = (h16)(o[dt][4 * g4 + 0] * rn * on.x * siluf_((float)gt[0]));
            ov[1] = (h16)(o[dt][4 * g4 + 1] * rn * on.y * siluf_((float)gt[1]));
            ov[2] = (h16)(o[dt][4 * g4 + 2] * rn * on.z * siluf_((float)gt[2]));
            ov[3] = (h16)(o[dt][4 * g4 + 3] * rn * on.w * siluf_((float)gt[3]));
            *(half4*)(mix + kb_idx(NT, tok, h * 64 + e0)) = ov;
        }
    __syncthreads();
}

DI void glu_tile(PP P, int l, int tile, char* smem, const int wv) {
    P = plaunder(P);
    const int mt = tile >> 2, nt = tile & 3;
    f32x4 acc[4][4];
    float ssd[4];
    gemm_mainloop_glds<false>(wv, 256, APlain{(const h16*)(P->ws + OFF_YACT) + (size_t)mt * 128 * 256, 256, 64},
                              (const h16*)(P->ws + OFF_WTGLU) + ((size_t)l * 512 + nt * 128) * 256, 256, acc, ssd, smem);
    const int tid = otid(wv), lane = tid & 63, wid = tid >> 6, wr = wid >> 1, wc = wid & 1;
    const h16* proj = (const h16*)(P->ws + OFF_PROJ);
    h16* mix = (h16*)(P->ws + OFF_MIX);
    const float* gb = P->in[I_GLUB] + l * 512;
#pragma unroll
    for (int i = 0; i < 4; ++i) {
        const size_t tok = (size_t)mt * 128 + wr * 64 + i * 16 + (lane & 15);
#pragma unroll
        for (int pj = 0; pj < 2; ++pj) {
            const int c = nt * 64 + wc * 32 + pj * 16 + (lane >> 4) * 4;
            const f32x4 z1 = acc[i][2 * pj], z2 = acc[i][2 * pj + 1];
            const float4 b1 = *(const float4*)(gb + c), b2 = *(const float4*)(gb + 256 + c);
            const half4 g4 = *(const half4*)(proj + tok * D_IN + C_SG + c);
            half4 o;
            o[0] = (h16)((z1[0] + b1.x) * sigmoidf_(z2[0] + b2.x) * siluf_((float)g4[0]));
            o[1] = (h16)((z1[1] + b1.y) * sigmoidf_(z2[1] + b2.y) * siluf_((float)g4[1]));
            o[2] = (h16)((z1[2] + b1.z) * sigmoidf_(z2[2] + b2.z) * siluf_((float)g4[2]));
            o[3] = (h16)((z1[3] + b1.w) * sigmoidf_(z2[3] + b2.w) * siluf_((float)g4[3]));
            *(half4*)(mix + kb_idx(NT, tok, 256 + c)) = o;
        }
    }
}

DI void outproj_tile(PP P, int l, int mt, int nt, char* smem, const int wv) {
    P = plaunder(P);
    f32x4 acc[8][4];
    float ssd[8];
    gemm_glds<false, 2, 8, 4, 3>(wv, 1024, APlain{(const h16*)(P->ws + OFF_MIX) + (size_t)mt * 256 * 64, 64, (size_t)NT * 64},
                              (const h16*)(P->ws + OFF_WTOUT) + ((size_t)l * 16 * 1024 + nt * 128) * 64, 64, acc, ssd, smem, (size_t)1024 * 64);
    const int tid = otid(wv), lane = tid & 63, wid = tid >> 6, wr = wid >> 1, wc = wid & 1;
    const float* xin = (l == 0) ? P->in[I_X] : P->out;
    h16* xh = (h16*)(P->ws + OFF_XH);
#pragma unroll
    for (int i = 0; i < 8; ++i) {
        const size_t row = (size_t)mt * 256 + wr * 128 + i * 16 + (lane & 15);
#pragma unroll
        for (int jj = 0; jj < 4; ++jj) {
            const int n = nt * 128 + wc * 64 + jj * 16 + (lane >> 4) * 4;
            const f32x4 v = acc[i][jj];
            const float4 xo = *(const float4*)(xin + row * 1024 + n);
            const float4 xn = (float4){xo.x + v[0], xo.y + v[1], xo.z + v[2], xo.w + v[3]};
            *(float4*)(P->out + row * 1024 + n) = xn;
            *(half4*)(xh + kb_idx(NT, row, n)) = (half4){(h16)xn.x, (h16)xn.y, (h16)xn.z, (h16)xn.w};
        }
    }
}

#define XB_TMO      128
#define XB_XCNT(j)  (256  + 64 * (j))
#define XB_XSUB(j)  (1280 + 64 * (j))
#define XB_XGEN(j)  (2304 + 64 * (j))
#define XB_TOP      3328
#define XB_TOPGEN   3392
#define XCD_BAR_WORDS 3456
#define XB_SPIN_CAP (1u << 18)
#define LAS __attribute__((address_space(3)))

__device__ __forceinline__ unsigned xb_ld(unsigned* p)              { return __hip_atomic_load(p, __ATOMIC_RELAXED, __HIP_MEMORY_SCOPE_AGENT); }
__device__ __forceinline__ unsigned xb_add(unsigned* p, unsigned v) { return __hip_atomic_fetch_add(p, v, __ATOMIC_RELAXED, __HIP_MEMORY_SCOPE_AGENT); }
__device__ __forceinline__ unsigned xb_xcc_id() { return (unsigned)__builtin_amdgcn_s_getreg((3 << 11) | 20) & 0xFu; }
#define XB_SPIN(cond, bar) do { unsigned _sp = 0; while (cond) { __builtin_amdgcn_s_sleep(1); \
    if ((++_sp & 255u) == 0u) { if (xb_ld(&(bar)[XB_TMO])) break; if (_sp > XB_SPIN_CAP) { atomicAdd(&(bar)[XB_TMO], 1u); break; } } } } while (0)

struct XcdBarrier {
    unsigned* bar; unsigned x;
    volatile LAS unsigned* st;
};

__device__ __forceinline__ XcdBarrier xcd_barrier_post(unsigned* bar, volatile LAS unsigned* st) {
    XcdBarrier b; b.bar = bar; b.x = xb_xcc_id(); b.st = st;
    if (threadIdx.x == 0) (void)xb_add(&bar[XB_XCNT(b.x)], 1u);
    return b;
}
__device__ __forceinline__ void xcd_barrier_complete(unsigned* bar, unsigned x, unsigned& nloc, unsigned& nx) {
    const unsigned G = gridDim.x * gridDim.y * gridDim.z;
    unsigned sum, cnt, mine, sp = 0u;
    for (;;) {
        sum = 0u; cnt = 0u; mine = 0u;
#pragma unroll
        for (unsigned j = 0; j < 16; ++j) { const unsigned c = xb_ld(&bar[XB_XCNT(j)]); sum += c; cnt += (c > 0u) ? 1u : 0u; mine = (j == x) ? c : mine; }
        if (sum == G) break;
        __builtin_amdgcn_s_sleep(1);
        if ((++sp & 255u) == 0u) { if (xb_ld(&bar[XB_TMO])) break; if (sp > XB_SPIN_CAP) { atomicAdd(&bar[XB_TMO], 1u); break; } }
    }
    nloc = mine > 0u ? mine : 1u; nx = cnt > 0u ? cnt : 1u;
}

__device__ __forceinline__ void xcd_barrier(const XcdBarrier& b) {
    asm volatile("s_waitcnt vmcnt(0)" ::: "memory");
    __syncthreads();
    if (threadIdx.x == 0) {
        unsigned* bar = b.bar;
        __builtin_amdgcn_s_waitcnt(0);
        unsigned nloc = b.st[0], nx = b.st[1];
        if (nloc == 0u) { xcd_barrier_complete(bar, b.x, nloc, nx); b.st[0] = nloc; b.st[1] = nx; }
        const unsigned old = xb_add(&bar[XB_XSUB(b.x)], 1u);
        const unsigned gen = old / nloc;
        if (old + 1u == (gen + 1u) * nloc) {
            __builtin_amdgcn_fence(__ATOMIC_RELEASE, "agent");
            asm volatile("s_waitcnt vmcnt(0)" ::: "memory");
            const unsigned og = xb_add(&bar[XB_TOP], 1u);
            const unsigned tg = og / nx;
            if (og + 1u == (tg + 1u) * nx) xb_add(&bar[XB_TOPGEN], 1u);
            else XB_SPIN(xb_ld(&bar[XB_TOPGEN]) == tg, bar);
            __builtin_amdgcn_fence(__ATOMIC_ACQUIRE, "agent");
            xb_add(&bar[XB_XGEN(b.x)], 1u);
            asm volatile("s_waitcnt vmcnt(0)" ::: "memory");
        } else {
            XB_SPIN(xb_ld(&bar[XB_XGEN(b.x)]) == gen, bar);
            __builtin_amdgcn_fence(__ATOMIC_ACQUIRE, "agent");
            asm volatile("s_waitcnt vmcnt(0)" ::: "memory");
        }
    }
    __syncthreads();
}


__global__ void __launch_bounds__(NTHREADS, 2) fwd_megakernel(Params Pval) {
    PP P = (PP)__builtin_amdgcn_kernarg_segment_ptr();
    extern __shared__ __attribute__((aligned(16))) char smem[];
    cg::grid_group grid = cg::this_grid();
    const int G = gridDim.x, bid = blockIdx.x;
    const int wv = __builtin_amdgcn_readfirstlane((int)(threadIdx.x >> 6));

    uint4& xb_words = *(uint4*)(smem + SMEM_MAIN);
    if (otid(wv) == 0) xb_words = make_uint4(0u, 0u, 0u, 0u);
    __syncthreads();
    if (P->ws == nullptr) grid.sync();
    const XcdBarrier xb = xcd_barrier_post((unsigned*)(P->ws + OFF_BAR), (volatile LAS unsigned*)(smem + SMEM_MAIN));
    int vxcd = bid & 7, vjx = bid >> 3;
    {
        unsigned* xcnt = (unsigned*)(P->ws + OFF_BAR) + XCD_BAR_WORDS;
        volatile LAS unsigned* lw = (volatile LAS unsigned*)(smem + SMEM_MAIN) + 2;
        if (otid(wv) == 0) lw[0] = xb.x < 8u ? xb_add(&xcnt[xb.x], 1u) : 0xffffu;
        phase0(P, smem, wv);
        xcd_barrier(xb);
        if (otid(wv) == 0) {
            bool ok = (G & 7) == 0 && xb.x < 8u;
            for (int j = 0; j < 8; ++j) ok = ok && (xb_ld(&xcnt[j]) == (unsigned)(G >> 3));
            lw[1] = ok ? 1u : 0u;
        }
        __syncthreads();
        if (lw[1]) { vxcd = (int)xb.x; vjx = (int)lw[0]; }
    }
    vxcd = __builtin_amdgcn_readfirstlane(vxcd); vjx = __builtin_amdgcn_readfirstlane(vjx);

#pragma unroll 1
    for (int l = 0; l < DEPTH; ++l) {
        {
            const int xcd = vxcd, jx = vjx, nper = G >> 3;
            for (int u = jx; u < 192; u += nper) inproj_tile<2, 8>(P, l, (xcd * 8 + (u & 7)) * 256, (u >> 3) * 128, smem, wv);
            for (int it = jx; it < 16 + 40; it += nper) {
                if (it < 16) inproj_tile<4, 2>(P, l, (xcd * 16 + it) * 128, 3072, smem, wv);
                else s5_build_item(P, l, (it - 16) * 8 + xcd, smem, wv);
            }
        }
        xcd_barrier(xb);
#pragma unroll 1
        for (int w = bid; w < 128 + 64 + 512; w += G) {
            if (w < 128) cmp_gemm_tile(P, l, w, smem, wv);
            else if (w < 192) s5e_gemm_tile(P, l, w - 128, smem, wv);
            else gla_kv_item(P, l, w - 192, smem, wv);
        }
        xcd_barrier(xb);
#pragma unroll 1
        for (int w = bid; w < 512 + 512 + 64; w += G) {
            if (w < 512) cmp_l2_item(P, l, w, smem, wv);
            else if (w < 1024) gla_scan_item(P, w - 512, smem, wv);
            else s5_scan_item(P, w - 1024, smem, wv);
        }
        xcd_barrier(xb);
        bool nsa_fast;
        {
            const int ln = otid(wv) & 63;
            const float gq = wave_max(fabsf(P->in[I_NQN][l * 64 + ln]));
            const float gk = wave_max(fmaxf(fmaxf(fabsf(P->in[I_NKN][(l * 3 + 0) * 64 + ln]), fabsf(P->in[I_NKN][(l * 3 + 1) * 64 + ln])), fabsf(P->in[I_NKN][(l * 3 + 2) * 64 + ln])));
            nsa_fast = __builtin_amdgcn_readfirstlane((8.f * 1.4426950408889634f * gq * gk < 15.f) ? 1 : 0) != 0;
        }
#pragma unroll 1
        for (int w0 = bid; w0 < 512 + 512 + 512; w0 += G) {
            const int w = w0 < G ? vjx * 8 + vxcd : w0;
            if (w < 512) {
                const int bg = w & 3, q = w >> 2;
                if (nsa_fast) { nsa_unit<true>(P, l, bg, 255 - q, smem, wv); nsa_unit<true>(P, l, bg, q, smem, wv); }
                else { nsa_unit<false>(P, l, bg, 255 - q, smem, wv); nsa_unit<false>(P, l, bg, q, smem, wv); }
            } else if (w < 512 + 512) s5o_gemm_tile(P, l, w - 512, smem, wv);
            else gla_out_item(P, l, w - 1024, smem, wv);
        }
        xcd_barrier(xb);
#pragma unroll 1
        for (int w = bid; w < 512; w += G) glu_tile(P, l, w, smem, wv);
        xcd_barrier(xb);
        {
            const int xcd = vxcd, jx = vjx, nper = G >> 3;
            for (int u = jx; u < 64; u += nper) outproj_tile(P, l, xcd * 8 + (u & 7), u >> 3, smem, wv);
        }
        xcd_barrier(xb);
    }
}

extern "C" void kernel_launch(void* const* d_in, const int* in_sizes, int n_in, void* d_out, int out_size, void* d_ws,
                              size_t ws_size, hipStream_t stream) {
    static int grid_blocks = 0;
    if (!grid_blocks) {
        int dev = 0, cus = 0, per_cu = 0;
        hipGetDevice(&dev);
        hipDeviceGetAttribute(&cus, hipDeviceAttributeMultiprocessorCount, dev);
        hipFuncSetAttribute((const void*)fwd_megakernel, hipFuncAttributeMaxDynamicSharedMemorySize, SMEM_BYTES);
        hipOccupancyMaxActiveBlocksPerMultiprocessor(&per_cu, fwd_megakernel, NTHREADS, SMEM_BYTES);
        if (per_cu < 1) per_cu = 1;
        if (per_cu > 2) per_cu = 2;
        grid_blocks = cus * per_cu;
        if (ws_size < WS_END) fprintf(stderr, "kernel_launch: workspace too small: %zu < %zu\n", ws_size, (size_t)WS_END);
    }
    Params p{};
    for (int i = 0; i < 25; ++i) p.in[i] = (const float*)d_in[i];
    p.out = (float*)d_out;
    p.ws = (char*)d_ws;
    void* args[] = {&p};
    (void)hipMemsetAsync((char*)d_ws + OFF_BAR, 0, (XCD_BAR_WORDS + 16) * sizeof(unsigned), stream);
    hipError_t e = hipLaunchCooperativeKernel((const void*)fwd_megakernel, dim3(grid_blocks), dim3(NTHREADS), args, SMEM_BYTES, stream);
    if (e != hipSuccess) fprintf(stderr, "cooperative launch failed: %s (grid %d)\n", hipGetErrorString(e), grid_blocks);
}
```

```cpp
#include <hip/hip_runtime.h>
#include <hip/hip_cooperative_groups.h>
#include <cstdio>
#include <cstdint>
namespace cg = cooperative_groups;

typedef _Float16 h16;
typedef _Float16 half8 __attribute__((ext_vector_type(8)));
typedef _Float16 half4 __attribute__((ext_vector_type(4)));
typedef float f32x4 __attribute__((ext_vector_type(4)));
typedef float f32x16 __attribute__((ext_vector_type(16)));

#define DI __device__ __forceinline__

constexpr int D_MODEL = 1024, BATCH = 2, SEQ = 8192, DEPTH = 4, NT = BATCH * SEQ;
constexpr int D_IN = 3112, D_IN_PAD = 3200;
constexpr int C_NQ = 0, C_NKV = 512, C_NG = 1280, C_GQ = 1792, C_GK = 1920, C_GV = 2048, C_GG = 2304, C_SU = 2560, C_SG = 2816,
              C_GLR = 3072, C_NGL = 3088;
__host__ __device__ constexpr int map_col(int c) {
    return c < 128 ? C_GQ + c : c < 256 ? C_GK + (c - 128) : c < 512 ? C_GV + (c - 256) : c < 528 ? C_GLR + (c - 512)
         : c < 784 ? C_GG + (c - 528) : c < 1040 ? C_SU + (c - 784) : c < 1296 ? C_SG + (c - 1040) : c < 1808 ? C_NQ + (c - 1296)
         : c < 2576 ? C_NKV + (c - 1808) : c < 2600 ? C_NGL + (c - 2576) : c < 3112 ? C_NG + (c - 2600) : c;
}
constexpr int NTHREADS = 256;
constexpr float QSCALE = 0.125f * 1.4426950408889634f;

enum { I_X = 0, I_NORMG, I_WIN, I_GW2, I_GB2, I_GON, I_LRE, I_LIM, I_LSTEP, I_BRE, I_BIM, I_CRE, I_CIM, I_SD, I_GLUW, I_GLUB,
       I_NGB, I_NQN, I_NKN, I_CPOS, I_CW1, I_CB1, I_CW2, I_CB2, I_WOUT };

constexpr size_t OFF_WTIN  = 0;
constexpr size_t OFF_WTOUT = OFF_WTIN  + 4ull * D_IN_PAD * 1024 * 2;
constexpr size_t OFF_WTGLU = OFF_WTOUT + 4ull * 1024 * 1024 * 2;
constexpr size_t OFF_WTC1  = OFF_WTGLU + 4ull * 512 * 256 * 2;
constexpr size_t OFF_PROJ  = OFF_WTC1  + 4ull * 2 * 256 * 2048 * 2;
constexpr size_t OFF_MIX   = OFF_PROJ  + (size_t)NT * D_IN * 2;
constexpr size_t OFF_YACT  = OFF_MIX   + (size_t)NT * 1024 * 2;
constexpr size_t OFF_XH    = OFF_YACT;
constexpr size_t OFF_BCUM  = OFF_YACT  + (size_t)NT * 256 * 2;
constexpr size_t OFF_GKV   = OFF_BCUM  + (size_t)NT * 128 * 4;
constexpr size_t OFF_GDEC  = OFF_GKV   + 8ull * 256 * 2048 * 4;
static_assert(OFF_GDEC - OFF_XH >= (size_t)NT * 1024 * 2, "XH alias region too small");
constexpr size_t OFF_XC    = OFF_GDEC  + 8ull * 256 * 32 * 4;
constexpr size_t OFF_S5W   = OFF_XC    + 512ull * 1024 * 2 * 4;
constexpr size_t OFF_S5E   = OFF_S5W   + 16ull * 512 * 640 * 2;
constexpr size_t OFF_S5AL  = OFF_S5E   + 16ull * 128 * 512 * 2;
constexpr size_t OFF_CHID  = OFF_S5AL  + 1024ull * 2 * 4;
constexpr size_t OFF_POSB  = OFF_CHID  + 2ull * 2048 * 512 * 4;
constexpr size_t OFF_XCH   = OFF_POSB  + 8ull * 16 * 256 * 4;
constexpr size_t OFF_KCMP  = OFF_XCH   + 512ull * 2048 * 2;
constexpr size_t OFF_VCMP  = OFF_KCMP  + 4ull * 512 * 64 * 2;
constexpr size_t OFF_VTG   = OFF_VCMP  + 4ull * 512 * 64 * 2;
constexpr size_t OFF_BAR   = OFF_VTG   + 2ull * 4 * 128 * 4096 * 2;
constexpr size_t WS_END    = OFF_BAR   + 16384;

struct Params {
    const float* in[25];
    float* out;
    char* ws;
};

__host__ __device__ constexpr size_t kb_idx(size_t nrows, size_t row, int k) { return (((size_t)(k >> 6)) * nrows + row) * 64 + (k & 63); }
typedef const __attribute__((address_space(4))) Params* PP;
DI PP plaunder(PP p) { asm volatile("" : "+s"(p)); return p; }
constexpr int SMEM_MAIN = 73728;
constexpr int SMEM_BYTES = SMEM_MAIN + 16;

DI int otid(const int wv) { int t = wv * 64 + (int)__builtin_amdgcn_mbcnt_hi(~0u, __builtin_amdgcn_mbcnt_lo(~0u, 0u)); asm volatile("" : "+v"(t)); return t; }
DI float wave_sum(float v) {
#pragma unroll
    for (int o = 32; o > 0; o >>= 1) v += __shfl_xor(v, o);
    return v;
}
DI float wave_max(float v) {
#pragma unroll
    for (int o = 32; o > 0; o >>= 1) v = fmaxf(v, __shfl_xor(v, o));
    return v;
}
DI float sigmoidf_(float x) { return 1.f / (1.f + __expf(-x)); }
DI float siluf_(float x) { return x / (1.f + __expf(-x)); }
DI float gelu_tanh(float x) {
    const float u = 0.7978845608028654f * (x + 0.044715f * x * x * x);
    return 0.5f * x * (1.f + tanhf(u));
}
DI float log_sigmoidf_(float x) { return fminf(x, 0.f) - log1pf(__expf(-fabsf(x))); }

typedef _Float16 half2_ __attribute__((ext_vector_type(2)));
DI void glds16(const h16* g, char* l) {
    __builtin_amdgcn_global_load_lds((const __attribute__((address_space(1))) void*)g, (__attribute__((address_space(3))) void*)l, 16, 0, 0);
}
DI int vkperm(int k) { return (k & ~12) | ((k & 4) << 1) | ((k & 8) >> 1); }
struct APlain { const h16* A; size_t lda, astep; DI const h16* operator()(int row, int kt, int c8) const { return A + (size_t)row * lda + (size_t)kt * astep + c8 * 8; } };
struct AS5 {
    const h16* ubase;
    const h16* xin;
    int ch0;
    DI const h16* operator()(int row, int kt, int c8) const {
        const size_t ch = (size_t)(ch0 + row);
        return kt < 8 ? ubase + (ch * 32 + 4 * kt + (c8 >> 1)) * D_IN + (c8 & 1) * 8 : xin + ch * 2048 + (kt - 8) * 64 + c8 * 8;
    }
};
template <int N> DI void gwaitbar();
#define GWB_DEF(N) template <> DI void gwaitbar<N>() { asm volatile("s_waitcnt vmcnt(" #N ") lgkmcnt(0)\n\ts_barrier" ::: "memory"); }
GWB_DEF(0) GWB_DEF(3) GWB_DEF(4) GWB_DEF(6) GWB_DEF(8) GWB_DEF(12)
template <bool SUMSQ, int WR, int MI, int NJ, int NST = 4, class AF>
DI void gemm_glds(const int wv, const int K, const AF& afn, const h16* __restrict__ Bt, const int ldb,
                  f32x4 (&acc)[MI][NJ], float (&ss)[MI], char* smem, const size_t bstep = 64) {
    constexpr int WC = 4 / WR, BM = WR * MI * 16, BN = WC * NJ * 16, AQ = BM / 64, BQ = BN / 64, NG = AQ + BQ, SB = (BM + BN) * 64;
    static_assert(NST * SB <= SMEM_MAIN && AQ >= 1 && BQ >= 1 && (NST == 3 || NST == 4), "ring does not fit the LDS");
    const int tid = otid(wv), lane = tid & 63, wid = tid >> 6, wr = wid / WC, wc = wid % WC;
#pragma unroll
    for (int i = 0; i < MI; ++i) {
        ss[i] = 0.f;
#pragma unroll
        for (int j = 0; j < NJ; ++j) acc[i][j] = (f32x4){0.f, 0.f, 0.f, 0.f};
    }
    const int lrow = wid * 16 + (lane >> 2);
    const int lc4 = (lane & 3) ^ ((-(lrow >> 2)) & 3);
    const h16* bp = Bt + (size_t)lrow * ldb + lc4 * 8;
    char* lbase = smem + wid * 1024;
    const int fr = lane & 15, fq = lane >> 4, sw = (-(fr >> 2)) & 3;
    const int aoff0 = (wr * MI * 16 + fr) * 64 + ((fq ^ sw) * 16);
    const int boff0 = BM * 64 + (wc * NJ * 16 + fr) * 64 + ((fq ^ sw) * 16);
    const int nt = K >> 5;
    auto issue = [&](const int t, char* stage) {
        const int kt = t >> 1, hb = (t & 1) * 4;
#pragma unroll
        for (int q = 0; q < AQ; ++q) glds16(afn(lrow + 64 * q, kt, hb + lc4), stage + q * 4096);
#pragma unroll
        for (int q = 0; q < BQ; ++q) glds16(bp + (size_t)q * 64 * ldb + (size_t)kt * bstep + hb * 8, stage + BM * 64 + q * 4096);
    };
    auto compute = [&](const char* st) {
        half8 af[MI], bf[NJ];
#pragma unroll
        for (int i = 0; i < MI; ++i) af[i] = *(const half8*)(st + aoff0 + i * 1024);
#pragma unroll
        for (int j = 0; j < NJ; ++j) bf[j] = *(const half8*)(st + boff0 + j * 1024);
        if (SUMSQ) {
#pragma unroll
            for (int i = 0; i < MI; ++i)
#pragma unroll
                for (int e = 0; e < 4; ++e) {
                    const half2_ x = (half2_){af[i][2 * e], af[i][2 * e + 1]};
                    ss[i] = __builtin_amdgcn_fdot2(x, x, ss[i], false);
                }
        }
#pragma unroll
        for (int i = 0; i < MI; ++i)
#pragma unroll
            for (int j = 0; j < NJ; ++j) acc[i][j] = __builtin_amdgcn_mfma_f32_16x16x32_f16(bf[j], af[i], acc[i][j], 0, 0, 0);
    };
#define GEMM_STEP(S, t) do { if (NST == 4 && (t) + 2 < nt) gwaitbar<NG>(); else gwaitbar<0>();                       \
        if ((t) + NST - 1 < nt) issue((t) + NST - 1, lbase + (((S) + NST - 1) % NST) * SB); compute(smem + (S) * SB); } while (0)
    gwaitbar<0>();
    {
        const int k = nt < NST - 1 ? nt : NST - 1;
        for (int p = 0; p < k; ++p) issue(p, lbase + p * SB);
        if (k >= 3) gwaitbar<2 * NG>(); else if (k == 2) gwaitbar<NG>(); else gwaitbar<0>();
        __builtin_amdgcn_s_sleep(2);
    }
#pragma unroll 1
    for (int t = 0; t < nt; t += NST) {
        GEMM_STEP(0, t);
        if (t + 1 < nt) GEMM_STEP(1, t + 1);
        if (t + 2 < nt) GEMM_STEP(2, t + 2);
        if (NST == 4 && t + 3 < nt) GEMM_STEP(3 % NST, t + 3);
    }
#undef GEMM_STEP
    asm volatile("s_waitcnt lgkmcnt(0)\n\ts_barrier" ::: "memory");
    if (SUMSQ) {
#pragma unroll
        for (int i = 0; i < MI; ++i) { ss[i] += __shfl_xor(ss[i], 16); ss[i] += __shfl_xor(ss[i], 32); }
    }
}
template <bool SUMSQ, class AF>
DI void gemm_mainloop_glds(const int wv, const int K, const AF& afn, const h16* __restrict__ Bt, const int ldb, f32x4 (&acc)[4][4], float (&ss)[4], char* smem, const size_t bstep = 64) {
    gemm_glds<SUMSQ, 2, 4, 4>(wv, K, afn, Bt, ldb, acc, ss, smem, bstep);
}

DI int glu_perm_dst(int c_orig) {
    const int which = c_orig >> 8, c = c_orig & 255;
    return (c >> 6) * 128 + ((c >> 5) & 1) * 64 + (((c >> 4) & 1) * 2 + which) * 16 + (c & 15);
}
template <int MAP, int KB>
DI void transpose64(const float* __restrict__ src, int R, int C, h16* __restrict__ dst, int r0, int c0,
                    const float* __restrict__ rscale, char* smem, const int wv) {
    h16* tile = (h16*)smem;
    const int tid = otid(wv);
    {
        const int r = tid >> 2, cq = (tid & 3) * 16;
        const float sc = rscale ? rscale[r0 + r] : 1.f;
        const float* sp = src + (size_t)(r0 + r) * C + c0 + cq;
#pragma unroll
        for (int q = 0; q < 4; ++q) {
            float4 v = (float4){0.f, 0.f, 0.f, 0.f};
            if (c0 + cq + q * 4 < C) v = *(const float4*)(sp + q * 4);
            *(half4*)(tile + r * 72 + cq + q * 4) = (half4){(h16)(v.x * sc), (h16)(v.y * sc), (h16)(v.z * sc), (h16)(v.w * sc)};
        }
    }
    __syncthreads();
    {
        const int c = tid >> 2, rq = (tid & 3) * 16;
        half8 o0, o1;
#pragma unroll
        for (int k = 0; k < 8; ++k) { o0[k] = tile[(rq + k) * 72 + c]; o1[k] = tile[(rq + 8 + k) * 72 + c]; }
        const int cc = c0 + c;
        const int dr = MAP == 1 ? map_col(cc) : MAP == 2 ? glu_perm_dst(cc) : cc;
        h16* dp = KB ? dst + ((size_t)(r0 >> 6) * KB + dr) * 64 + rq : dst + (size_t)dr * R + r0 + rq;
        *(half8*)dp = o0; *(half8*)(dp + 8) = o1;
    }
    __syncthreads();
}

DI void phase0(PP P, char* smem, const int wv) {
    P = plaunder(P);
    constexpr int N_WIN = 4 * 16 * 50, N_WOUT = 4 * 16 * 16, N_C1 = 16 * 16 * 4, N_GLU = 4 * 4 * 8, N_XH = NT * 1024 / 2048, N_PB = 8 * 16;
    const int total = N_WIN + N_WOUT + N_C1 + N_GLU + N_XH + N_PB;
    for (int w = blockIdx.x; w < total; w += gridDim.x) {
        if (w < N_WIN) {
            const int l = w / 800, r = w % 800, rt = r / 50, ct = r % 50;
            transpose64<1, D_IN_PAD>(P->in[I_WIN] + (size_t)l * 1024 * D_IN, 1024, D_IN, (h16*)(P->ws + OFF_WTIN) + (size_t)l * D_IN_PAD * 1024,
                           rt * 64, ct * 64, P->in[I_NORMG] + l * 1024, smem, wv);
        } else if (w < N_WIN + N_WOUT) {
            const int v = w - N_WIN, l = v >> 8, r = v & 255, rt = r >> 4, ct = r & 15;
            transpose64<0, 1024>(P->in[I_WOUT] + (size_t)l * 1024 * 1024, 1024, 1024, (h16*)(P->ws + OFF_WTOUT) + (size_t)l * 1024 * 1024,
                           rt * 64, ct * 64, nullptr, smem, wv);
        } else if (w < N_WIN + N_WOUT + N_C1) {
            const int v = w - N_WIN - N_WOUT, ljh = v >> 6, r = v & 63, rt = r >> 2, ct = r & 3;
            transpose64<0, 512>(P->in[I_CW1] + (size_t)ljh * 1024 * 256, 1024, 256, (h16*)(P->ws + OFF_WTC1) + ((size_t)(ljh >> 1) * 16 * 512 + (ljh & 1) * 256) * 64,
                           rt * 64, ct * 64, nullptr, smem, wv);
        } else if (w < N_WIN + N_WOUT + N_C1 + N_GLU) {
            const int v = w - N_WIN - N_WOUT - N_C1, l = v >> 5, r = v & 31, rt = r >> 3, ct = r & 7;
            transpose64<2, 0>(P->in[I_GLUW] + (size_t)l * 256 * 512, 256, 512, (h16*)(P->ws + OFF_WTGLU) + (size_t)l * 512 * 256,
                           rt * 64, ct * 64, nullptr, smem, wv);
        } else if (w < N_WIN + N_WOUT + N_C1 + N_GLU + N_XH) {
            const size_t e0 = ((size_t)(w - N_WIN - N_WOUT - N_C1 - N_GLU) * 256 + otid(wv)) * 8;
            const float4 a = *(const float4*)(P->in[I_X] + e0), b = *(const float4*)(P->in[I_X] + e0 + 4);
            *(half8*)((h16*)(P->ws + OFF_XH) + kb_idx(NT, e0 >> 10, (int)(e0 & 1023))) = (half8){(h16)a.x, (h16)a.y, (h16)a.z, (h16)a.w, (h16)b.x, (h16)b.y, (h16)b.z, (h16)b.w};
        } else {
            const int v = w - (N_WIN + N_WOUT + N_C1 + N_GLU + N_XH), lj = v >> 4, ks = v & 15, n = otid(wv);
            const float* w1 = P->in[I_CW1] + ((size_t)lj * 2048 + ks * 128) * 256 + n;
            const float* pp = P->in[I_CPOS] + (size_t)lj * 2048 + ks * 128;
            float a = ks == 0 ? P->in[I_CB1][lj * 256 + n] : 0.f;
#pragma unroll 16
            for (int k = 0; k < 128; ++k) a += pp[k] * w1[(size_t)k * 256];
            ((float*)(P->ws + OFF_POSB))[(lj * 16 + ks) * 256 + n] = a;
        }
    }
}

DI void s5_build_item(PP P, int l, int item, char* smem, const int wv) {
    P = plaunder(P);
    float* apow = (float*)smem;
    float* bbar = apow + 64 * 33 * 2;
    float* cc   = bbar + 64 * 16 * 2;
    const int tid = otid(wv);
    const int g = (item < 256) ? (item >> 4) : ((item - 256) >> 2);
    if (tid < 64) {
        const int p = tid;
        const float lre = fminf(P->in[I_LRE][(l * 16 + g) * 64 + p], -1e-4f);
        const float lim = P->in[I_LIM][(l * 16 + g) * 64 + p];
        const float dt = expf(P->in[I_LSTEP][l * 16 + g]);
        const float x = lre * dt, y = lim * dt;
        const float em1 = expm1f(x), cy = cosf(y), sy = sinf(y), sh = sinf(0.5f * y);
        const float ar = (em1 + 1.f) * cy, ai = (em1 + 1.f) * sy;
        const float dr = em1 * cy - 2.f * sh * sh, di = ai;
        const float den = lre * lre + lim * lim;
        const float fr = (dr * lre + di * lim) / den;
        const float fi = (di * lre - dr * lim) / den;
        float pr = 1.f, pi = 0.f;
        for (int k = 0; k <= 32; ++k) {
            apow[(p * 33 + k) * 2] = pr; apow[(p * 33 + k) * 2 + 1] = pi;
            const float nr = pr * ar - pi * ai, ni = pr * ai + pi * ar; pr = nr; pi = ni;
        }
        for (int c = 0; c < 16; ++c) {
            const float br = P->in[I_BRE][((size_t)(l * 16 + g) * 64 + p) * 16 + c];
            const float bi = P->in[I_BIM][((size_t)(l * 16 + g) * 64 + p) * 16 + c];
            bbar[(p * 16 + c) * 2] = fr * br - fi * bi;
            bbar[(p * 16 + c) * 2 + 1] = fr * bi + fi * br;
        }
    }
    for (int e = tid; e < 1024; e += 256) {
        cc[e * 2] = P->in[I_CRE][(size_t)(l * 16 + g) * 1024 + e];
        cc[e * 2 + 1] = P->in[I_CIM][(size_t)(l * 16 + g) * 1024 + e];
    }
    __syncthreads();
    if (item < 256) {
        const int c = item & 15;
        float* kt = cc + 2048;
        for (int idx = tid; idx < 512; idx += 256) {
            const int lag = idx >> 4, c2 = idx & 15;
            float a = 0.f;
            for (int p = 0; p < 64; ++p) {
                const float cr = cc[(c * 64 + p) * 2], ci = cc[(c * 64 + p) * 2 + 1];
                const float xr = apow[(p * 33 + lag) * 2], xi = apow[(p * 33 + lag) * 2 + 1];
                const float br = bbar[(p * 16 + c2) * 2], bi = bbar[(p * 16 + c2) * 2 + 1];
                const float tr = cr * xr - ci * xi, ti = cr * xi + ci * xr;
                a += tr * br - ti * bi;
            }
            kt[idx] = a;
        }
        __syncthreads();
        h16* W = (h16*)(P->ws + OFF_S5W) + (size_t)g * 512 * 640;
        for (int idx = tid; idx < 32 * 640; idx += 256) {
            const int j = idx / 640, k = idx % 640;
            float val = 0.f;
            if (k < 512) {
                const int s = k >> 4, c2 = k & 15, lag = j - s;
                if (lag >= 0) val = kt[lag * 16 + c2];
            } else {
                const int p = (k - 512) >> 1;
                const float cr = cc[(c * 64 + p) * 2], ci = cc[(c * 64 + p) * 2 + 1];
                const float xr = apow[(p * 33 + j + 1) * 2], xi = apow[(p * 33 + j + 1) * 2 + 1];
                val = (k & 1) ? -(cr * xi + ci * xr) : (cr * xr - ci * xi);
            }
            W[(size_t)(j * 16 + c) * 640 + k] = (h16)val;
        }
    } else {
        const int pq = (item - 256) & 3;
        h16* E = (h16*)(P->ws + OFF_S5E) + ((size_t)g * 128 + pq * 32) * 512;
        for (int idx = tid; idx < 32 * 512; idx += 256) {
            const int nl = idx >> 9, k = idx & 511;
            const int p = pq * 16 + (nl >> 1), s = k >> 4, c2 = k & 15;
            const float xr = apow[(p * 33 + 31 - s) * 2], xi = apow[(p * 33 + 31 - s) * 2 + 1];
            const float br = bbar[(p * 16 + c2) * 2], bi = bbar[(p * 16 + c2) * 2 + 1];
            const float val = (nl & 1) ? (xr * bi + xi * br) : (xr * br - xi * bi);
            E[(size_t)nl * 512 + k] = (h16)val;
        }
        if (tid < 16) {
            const int p = pq * 16 + tid;
            float* AL = (float*)(P->ws + OFF_S5AL);
            AL[(g * 64 + p) * 2] = apow[(p * 33 + 32) * 2];
            AL[(g * 64 + p) * 2 + 1] = apow[(p * 33 + 32) * 2 + 1];
        }
    }
    __syncthreads();
}

template <int WR, int MI>
DI void inproj_tile(PP P, int l, int m0, int n0, char* smem, const int wv) {
    P = plaunder(P);
    constexpr int WC = 4 / WR;
    f32x4 acc[MI][4];
    float ss[MI];
    gemm_glds<true, WR, MI, 4, (WR == 2 && MI == 8) ? 3 : 4>(wv, 1024, APlain{(const h16*)(P->ws + OFF_XH) + (size_t)m0 * 64, 64, (size_t)NT * 64},
                               (const h16*)(P->ws + OFF_WTIN) + ((size_t)l * 16 * D_IN_PAD + n0) * 64, 64, acc, ss, smem, (size_t)D_IN_PAD * 64);
    const int tid = otid(wv), lane = tid & 63, wid = tid >> 6, wr = wid / WC, wc = wid % WC;
    h16* proj = (h16*)(P->ws + OFF_PROJ);
    const int n64 = n0 + wc * 64;
    int cls = 0;
    if (n64 < 512) cls = 1;
    else if (n64 >= C_NKV + 256 && n64 < C_NKV + 384) cls = 2;
    else if (n64 >= C_NKV + 512 && n64 < C_NKV + 640) cls = 3;
    else if (n64 >= C_NKV + 384 && n64 < C_NKV + 512) cls = 4;
    else if (n64 >= C_NKV + 640 && n64 < C_NKV + 768) cls = 5;
    float wn[4][4];
    if (cls >= 1 && cls <= 3) {
        const float* wp = (cls == 1) ? P->in[I_NQN] + l * 64 : P->in[I_NKN] + (l * 3 + (cls - 1)) * 64;
        const float sc = (cls == 1) ? QSCALE : 1.f;
#pragma unroll
        for (int j = 0; j < 4; ++j) {
            const float4 w4 = *(const float4*)(wp + j * 16 + (lane >> 4) * 4);
            wn[j][0] = w4.x * sc; wn[j][1] = w4.y * sc; wn[j][2] = w4.z * sc; wn[j][3] = w4.w * sc;
        }
    }
#pragma unroll
    for (int i = 0; i < MI; ++i) {
        const int ml = wr * MI * 16 + i * 16 + (lane & 15);
        const float r = rsqrtf(ss[i] * (1.f / 1024.f) + 1e-6f);
        const size_t row = (size_t)m0 + ml;
        f32x4 v[4];
#pragma unroll
        for (int j = 0; j < 4; ++j) v[j] = acc[i][j] * r;
        if (cls >= 1 && cls <= 3) {
            float s2 = 0.f;
#pragma unroll
            for (int j = 0; j < 4; ++j) s2 += v[j][0] * v[j][0] + v[j][1] * v[j][1] + v[j][2] * v[j][2] + v[j][3] * v[j][3];
            s2 += __shfl_xor(s2, 16); s2 += __shfl_xor(s2, 32);
            const float rn = rsqrtf(s2 * (1.f / 64.f) + 1e-6f);
#pragma unroll
            for (int j = 0; j < 4; ++j) { v[j][0] *= rn * wn[j][0]; v[j][1] *= rn * wn[j][1]; v[j][2] *= rn * wn[j][2]; v[j][3] *= rn * wn[j][3]; }
        }
        if (cls >= 4) {
            const int g = (n64 >> 6) & 1, br = cls - 4;
            const int b = (int)(row >> 13), t = (int)(row & 8191);
            h16* vt = (h16*)(P->ws + OFF_VTG) + ((((size_t)br * 4 + b * 2 + g) * 128 + (t >> 6)) * 64) * 64;
#pragma unroll
            for (int j = 0; j < 4; ++j)
#pragma unroll
                for (int e = 0; e < 4; ++e) vt[(j * 16 + (lane >> 4) * 4 + e) * 64 + vkperm(t & 63)] = (h16)v[j][e];
        }
#pragma unroll
        for (int j = 0; j < 4; ++j) {
            const int n = n64 + j * 16 + (lane >> 4) * 4;
            if (n < D_IN) *(half4*)(proj + row * D_IN + n) = (half4){(h16)v[j][0], (h16)v[j][1], (h16)v[j][2], (h16)v[j][3]};
        }
        __builtin_amdgcn_sched_barrier(0);
    }
    __syncthreads();
}


DI void cmp_gemm_tile(PP P, int l, int tile, char* smem, const int wv) {
    P = plaunder(P);
    const int j = tile >> 6, mt = (tile >> 2) & 15, nt = tile & 3;
    const int row0 = mt * 128, bg = row0 >> 9, i0 = row0 & 511, b = bg >> 1, g = bg & 1;
    f32x4 acc[4][4];
    float ssd[4];
    gemm_mainloop_glds<false>(wv, 1024, APlain{(const h16*)(P->ws + OFF_PROJ) + ((size_t)b * SEQ + 16 * i0) * D_IN + C_NKV + j * 128 + g * 64, (size_t)16 * D_IN, (size_t)D_IN},
                              (const h16*)(P->ws + OFF_WTC1) + ((size_t)(l * 2 + j) * 16 * 512 + nt * 128) * 64, 64, acc, ssd, smem, (size_t)512 * 64);
    const int tid = otid(wv), lane = tid & 63, wid = tid >> 6, wr = wid >> 1, wc = wid & 1;
    float* pt = (float*)(P->ws + OFF_CHID) + (size_t)j * 2048 * 512;
#pragma unroll
    for (int i = 0; i < 4; ++i) {
        const size_t row = (size_t)row0 + wr * 64 + i * 16 + (lane & 15);
#pragma unroll
        for (int jj = 0; jj < 4; ++jj) {
            const int n = nt * 128 + wc * 64 + jj * 16 + (lane >> 4) * 4;
            const f32x4 v = acc[i][jj];
            *(float4*)(pt + row * 512 + n) = (float4){v[0], v[1], v[2], v[3]};
        }
    }
}

DI void s5e_gemm_tile(PP P, int l, int tile, char* smem, const int wv) {
    P = plaunder(P);
    const int g = tile >> 2, mt = tile & 3;
    f32x4 acc[4][4];
    float ssd[4];
    gemm_mainloop_glds<false>(wv, 512, AS5{(const h16*)(P->ws + OFF_PROJ) + C_SU + g * 16, nullptr, mt * 128},
                              (const h16*)(P->ws + OFF_S5E) + (size_t)g * 128 * 512, 512, acc, ssd, smem);
    const int tid = otid(wv), lane = tid & 63, wid = tid >> 6, wr = wid >> 1, wc = wid & 1;
    float* xc = (float*)(P->ws + OFF_XC);
#pragma unroll
    for (int i = 0; i < 4; ++i) {
        const size_t ch = (size_t)mt * 128 + wr * 64 + i * 16 + (lane & 15);
#pragma unroll
        for (int jj = 0; jj < 4; ++jj) {
            const int n = wc * 64 + jj * 16 + (lane >> 4) * 4;
            const f32x4 v = acc[i][jj];
            *(float4*)(xc + (ch * 1024 + g * 64) * 2 + n) = (float4){v[0], v[1], v[2], v[3]};
        }
    }
}

DI void gla_scan_item(PP P, int item, char* smem, const int wv) {
    P = plaunder(P);
    const int tid = otid(wv), sl = tid & 31, part = tid >> 5;
    const int idx = item * 32 + sl, bh = idx >> 11, de = idx & 2047, d = de >> 6;
    float* kv = (float*)(P->ws + OFF_GKV) + ((size_t)bh * 256 + part * 32) * 2048 + de;
    const float* dc = (const float*)(P->ws + OFF_GDEC) + ((size_t)bh * 256 + part * 32) * 32 + d;
    float* sD = (float*)smem; float* sL = sD + 256;
    float kvv[32], dd[32];
#pragma unroll
    for (int i = 0; i < 32; ++i) { kvv[i] = kv[(size_t)i * 2048]; dd[i] = dc[i * 32]; }
    float D = 1.f, L = 0.f;
#pragma unroll
    for (int i = 0; i < 32; ++i) { L = dd[i] * L + kvv[i]; D *= dd[i]; }
    sD[part * 32 + sl] = D; sL[part * 32 + sl] = L;
    __syncthreads();
    float S = 0.f;
    for (int q = 0; q < part; ++q) S = sD[q * 32 + sl] * S + sL[q * 32 + sl];
#pragma unroll
    for (int i = 0; i < 32; ++i) { const float o = S; S = dd[i] * S + kvv[i]; kv[(size_t)i * 2048] = o; }
    __syncthreads();
}
DI void s5_scan_item(PP P, int item, char* smem, const int wv) {
    P = plaunder(P);
    const int tid = otid(wv), sl = tid & 31, part = tid >> 5;
    const int idx = item * 32 + sl, b = idx >> 10, s = idx & 1023;
    float2* xc = (float2*)(P->ws + OFF_XC) + ((size_t)b * 256 + part * 32) * 1024 + s;
    half2_* xch = (half2_*)(P->ws + OFF_XCH) + ((size_t)b * 256 + part * 32) * 1024 + s;
    const float2 a = ((const float2*)(P->ws + OFF_S5AL))[s];
    float2* sL = (float2*)smem;
    float2 c[32];
#pragma unroll
    for (int i = 0; i < 32; ++i) c[i] = xc[(size_t)i * 1024];
    float lr = 0.f, li = 0.f;
#pragma unroll
    for (int i = 0; i < 32; ++i) { const float nr = a.x * lr - a.y * li + c[i].x, ni = a.x * li + a.y * lr + c[i].y; lr = nr; li = ni; }
    float dr = a.x, di = a.y;
#pragma unroll
    for (int i = 0; i < 5; ++i) { const float nr = dr * dr - di * di, ni = 2.f * dr * di; dr = nr; di = ni; }
    sL[part * 32 + sl] = (float2){lr, li};
    __syncthreads();
    float xr = 0.f, xi = 0.f;
    for (int q = 0; q < part; ++q) { const float2 lq = sL[q * 32 + sl]; const float nr = dr * xr - di * xi + lq.x, ni = dr * xi + di * xr + lq.y; xr = nr; xi = ni; }
#pragma unroll
    for (int i = 0; i < 32; ++i) {
        const float2 o = (float2){xr, xi};
        const float nr = a.x * xr - a.y * xi + c[i].x, ni = a.x * xi + a.y * xr + c[i].y; xr = nr; xi = ni;
        xc[(size_t)i * 1024] = o;
        xch[(size_t)i * 1024] = (half2_){(h16)o.x, (h16)o.y};
    }
    __syncthreads();
}
DI void cmp_l2_item(PP P, int l, int item, char* smem, const int wv) {
    P = plaunder(P);
    const int tid = otid(wv), lane = tid & 63, w = tid >> 6;
    const int j = item >> 8, r0 = (item & 255) * 8;
    h16* w2s = (h16*)smem;
    float* hs = (float*)(smem + 32768);
    {
        const float* w2 = P->in[I_CW2] + (size_t)(l * 2 + j) * 256 * 64;
        for (int e = tid * 4; e < 256 * 64; e += 1024) {
            const float4 v = *(const float4*)(w2 + e);
            *(half4*)(w2s + e) = (half4){(h16)v.x, (h16)v.y, (h16)v.z, (h16)v.w};
        }
        const float* pt = (const float*)(P->ws + OFF_CHID) + (size_t)j * 2048 * 512;
        float pb = 0.f;
#pragma unroll
        for (int ks = 0; ks < 16; ++ks) pb += ((const float*)(P->ws + OFF_POSB))[((l * 2 + j) * 16 + ks) * 256 + tid];
#pragma unroll
        for (int rr = 0; rr < 8; ++rr) {
            const int row = r0 + rr, i = row & 511;
            float v = 0.f;
            if (i < 511) v = gelu_tanh(pt[(size_t)row * 512 + tid] + pt[(size_t)(row + 1) * 512 + 256 + tid] + pb);
            hs[rr * 256 + tid] = v;
        }
    }
    __syncthreads();
    const float bb = P->in[I_CB2][(l * 2 + j) * 64 + lane];
    float a0 = bb, a1 = bb;
    const float* h0 = hs + (2 * w) * 256, *h1 = h0 + 256;
#pragma unroll 8
    for (int n = 0; n < 256; ++n) {
        const float wv = (float)w2s[n * 64 + lane];
        a0 += h0[n] * wv; a1 += h1[n] * wv;
    }
#pragma unroll
    for (int rr = 0; rr < 2; ++rr) {
        float acc = rr ? a1 : a0;
        const int row = r0 + 2 * w + rr, bg = row >> 9, i = row & 511;
        if (i == 511) acc = 0.f;
        if (j == 0) {
            const float ss = wave_sum(acc * acc);
            acc = acc * rsqrtf(ss * (1.f / 64.f) + 1e-6f) * P->in[I_NKN][(l * 3 + 0) * 64 + lane];
            ((h16*)(P->ws + OFF_KCMP))[(size_t)row * 64 + lane] = (h16)acc;
        } else {
            ((h16*)(P->ws + OFF_VCMP))[(((size_t)bg * 8 + (i >> 6)) * 64 + lane) * 64 + vkperm(i & 63)] = (h16)acc;
        }
    }
    __syncthreads();
}

DI void s5o_gemm_tile(PP P, int l, int tile, char* smem, const int wv) {
    P = plaunder(P);
    const int g = tile >> 5, mt = (tile >> 3) & 3, nt = tile & 7;
    f32x4 acc[2][4];
    float ssd[2];
    gemm_glds<false, 4, 2, 4>(wv, 640, AS5{(const h16*)(P->ws + OFF_PROJ) + C_SU + g * 16, (const h16*)(P->ws + OFF_XCH) + g * 128, mt * 128},
                              (const h16*)(P->ws + OFF_S5W) + ((size_t)g * 512 + nt * 64) * 640, 640, acc, ssd, smem);
    const int tid = otid(wv), lane = tid & 63, wid = tid >> 6;
    const h16* proj = (const h16*)(P->ws + OFF_PROJ);
    h16* yact = (h16*)(P->ws + OFF_YACT);
#pragma unroll
    for (int i = 0; i < 2; ++i) {
        const size_t ch = (size_t)mt * 128 + wid * 32 + i * 16 + (lane & 15);
#pragma unroll
        for (int jj = 0; jj < 4; ++jj) {
            const int n = nt * 64 + jj * 16 + (lane >> 4) * 4;
            const int j = n >> 4, c = n & 15;
            const size_t tok = ch * 32 + j;
            const half4 u4 = *(const half4*)(proj + tok * D_IN + C_SU + g * 16 + c);
            const float4 dd = *(const float4*)(P->in[I_SD] + (l * 16 + g) * 16 + c);
            const f32x4 v = acc[i][jj];
            half4 o;
            o[0] = (h16)gelu_tanh(v[0] + dd.x * (float)u4[0]);
            o[1] = (h16)gelu_tanh(v[1] + dd.y * (float)u4[1]);
            o[2] = (h16)gelu_tanh(v[2] + dd.z * (float)u4[2]);
            o[3] = (h16)gelu_tanh(v[3] + dd.w * (float)u4[3]);
            *(half4*)(yact + tok * 256 + g * 16 + c) = o;
        }
    }
}

#define MFMA32(a, b, c) __builtin_amdgcn_mfma_f32_32x32x16_f16((a), (b), (c), 0, 0, 0)
constexpr float NEGS = -1e30f;
DI float ex2(float x) { return __builtin_amdgcn_exp2f(x); }
#define NSA_WAITBAR(N) asm volatile("s_waitcnt vmcnt(" #N ") lgkmcnt(0)\n\ts_barrier" ::: "memory")
#define NSA_BAR() asm volatile("s_waitcnt lgkmcnt(0)\n\ts_barrier" ::: "memory")

struct KVSrc { const h16* k; int ldk; size_t kstep; const h16* v; };
DI void nsa_dma(const KVSrc& s, int j, char* stage, int wid, int lane) {
    const int row0 = wid * 8 + (lane >> 3);
    const int sw = ((lane & 7) ^ ((row0 >> 1) & 7)) * 8;
    const h16* kp = s.k + (size_t)j * s.kstep + (size_t)row0 * s.ldk + sw;
    glds16(kp, stage + wid * 1024);
    glds16(kp + (size_t)32 * s.ldk, stage + 4096 + wid * 1024);
    const h16* vp = s.v + (size_t)j * 4096 + row0 * 64 + sw;
    glds16(vp, stage + 8192 + wid * 1024);
    glds16(vp + 32 * 64, stage + 8192 + 4096 + wid * 1024);
}
template <int NST, class F>
DI void nsa_pipe(const KVSrc& s, const int n, char* smem, int wid, int lane, F&& compute) {
    NSA_WAITBAR(0);
    {
        const int k = n < NST - 1 ? n : NST - 1;
        for (int p = 0; p < k; ++p) nsa_dma(s, p, smem + p * 16384, wid, lane);
        if (k >= 3) NSA_WAITBAR(8); else if (k == 2) NSA_WAITBAR(4); else NSA_WAITBAR(0);
        __builtin_amdgcn_s_sleep(2);
    }
    for (int j = 0; j < n; ++j) {
        if (NST == 4 && j + 2 < n) NSA_WAITBAR(4); else NSA_WAITBAR(0);
        const int jn = j + NST - 1;
        compute(j, smem + (j % NST) * 16384, [&]() { if (jn < n) nsa_dma(s, jn, smem + (jn % NST) * 16384, wid, lane); });
    }
}

template <bool SHIFT = false, class BF>
DI void qk_tile(const char* Kimg, const half8 (&qf)[4], f32x16 (&s)[2], int lane, BF&& between) {
    const int r = lane & 31, h = lane >> 5, swz = (r >> 1) & 7;
    const char* base = Kimg + r * 128;
    half8 kf[8];
#pragma unroll
    for (int kt = 0; kt < 2; ++kt)
#pragma unroll
        for (int ks = 0; ks < 4; ++ks) kf[kt * 4 + ks] = *(const half8*)(base + kt * 4096 + (((2 * ks + h) ^ swz) << 4));
    __builtin_amdgcn_sched_barrier(0);
    between();
    __builtin_amdgcn_sched_barrier(0);
#pragma unroll
    for (int kt = 0; kt < 2; ++kt) {
#pragma unroll
        for (int e = 0; e < 16; ++e) s[kt][e] = 0.f;
#pragma unroll
        for (int ks = 0; ks < 4; ++ks) s[kt] = MFMA32(kf[kt * 4 + ks], qf[ks], s[kt]);
    }
}
template <bool SHIFT = false>
DI void qk_tile(const char* Kimg, const half8 (&qf)[4], f32x16 (&s)[2], int lane) { qk_tile<SHIFT>(Kimg, qf, s, lane, []() {}); }
template <int S> DI half8 pack8(const f32x16& x) {
    return (half8){(h16)x[8 * S], (h16)x[8 * S + 1], (h16)x[8 * S + 2], (h16)x[8 * S + 3], (h16)x[8 * S + 4], (h16)x[8 * S + 5], (h16)x[8 * S + 6], (h16)x[8 * S + 7]};
}
template <int KT>
DI void pv_load(const char* Vimg, half8 (&vf)[4], int lane) {
    const int r = lane & 31, h = lane >> 5, swz = (r >> 1) & 7;
    const char* rb = Vimg + r * 128;
#pragma unroll
    for (int dt = 0; dt < 2; ++dt) {
        vf[dt * 2 + 0] = *(const half8*)(rb + dt * 4096 + (((4 * KT + h) ^ swz) << 4));
        vf[dt * 2 + 1] = *(const half8*)(rb + dt * 4096 + (((4 * KT + 2 + h) ^ swz) << 4));
    }
}
typedef unsigned u32x4_ __attribute__((ext_vector_type(4)));
template <int KT, bool MASKED = false>
DI void pv_mma(const half8 (&vf)[4], const f32x16 (&p)[2], f32x16 (&o)[2], const unsigned rmask = 0xffffffffu) {
    half8 pb0 = pack8<0>(p[KT]), pb1 = pack8<1>(p[KT]);
    if (MASKED) {
        pb0 = __builtin_bit_cast(half8, __builtin_bit_cast(u32x4_, pb0) & rmask);
        pb1 = __builtin_bit_cast(half8, __builtin_bit_cast(u32x4_, pb1) & rmask);
    }
#pragma unroll
    for (int dt = 0; dt < 2; ++dt) {
        o[dt] = MFMA32(vf[dt * 2 + 0], pb0, o[dt]);
        o[dt] = MFMA32(vf[dt * 2 + 1], pb1, o[dt]);
    }
}
template <bool MASKED = false>
DI void pv_finish(const char* Vimg, const half8 (&va)[4], const f32x16 (&p)[2], f32x16 (&o)[2], int lane, const unsigned rmask = 0xffffffffu) {
    half8 vb[4];
    pv_load<1>(Vimg, vb, lane);
    pv_mma<0, MASKED>(va, p, o, rmask);
    pv_mma<1, MASKED>(vb, p, o, rmask);
}
DI float sm_fast(f32x16 (&s)[2]) {
    float rs = 0.f;
#pragma unroll
    for (int kt = 0; kt < 2; ++kt)
#pragma unroll
        for (int e = 0; e < 16; ++e) { const float p = ex2(s[kt][e]); s[kt][e] = p; rs += p; }
    return rs;
}
DI float xhalf_max(float v) {
    const auto r = __builtin_amdgcn_permlane32_swap(__float_as_uint(v), __float_as_uint(v), false, false);
    return fmaxf(__uint_as_float(r[0]), __uint_as_float(r[1]));
}
DI float xhalf_sum(float v) {
    const auto r = __builtin_amdgcn_permlane32_swap(__float_as_uint(v), __float_as_uint(v), false, false);
    return __uint_as_float(r[0]) + __uint_as_float(r[1]);
}
DI float rowmax32(const f32x16 (&s)[2]) {
    float mx = s[0][0];
#pragma unroll
    for (int e = 1; e < 16; ++e) mx = fmaxf(mx, s[0][e]);
#pragma unroll
    for (int e = 0; e < 16; ++e) mx = fmaxf(mx, s[1][e]);
    return xhalf_max(mx);
}
constexpr float SM_THR = 6.f;
DI void sm_online(f32x16 (&s)[2], float& m, float& l, f32x16 (&o)[2], const bool rowok) {
    float mx = rowmax32(s);
    mx = rowok ? mx : NEGS;
    if (__any(mx > m + SM_THR)) {
        const float mn = fmaxf(m, mx), alpha = ex2(m - mn);
        l *= alpha; o[0] *= alpha; o[1] *= alpha; m = mn;
    }
    const float msub = rowok ? m : 1e30f;
    float rs = 0.f;
#pragma unroll
    for (int kt = 0; kt < 2; ++kt)
#pragma unroll
        for (int e = 0; e < 16; ++e) { const float p = ex2(s[kt][e] - msub); s[kt][e] = p; rs += p; }
    l += xhalf_sum(rs);
}

template <int V> struct IC { static constexpr int value = V; };
template <bool FAST>
DI void nsa_unit(PP P, int l, int bg, int c32, char* smem, const int wv) {
    P = plaunder(P);
    const int tid = otid(wv), lane = tid & 63, w = tid >> 6, r = lane & 31, h = lane >> 5;
    const int b = bg >> 1, g = bg & 1, t0 = c32 * 32, cur = c32 >> 1;
    const int tokl = w * 8 + (r >> 2), head = r & 3, t = t0 + tokl;
    const size_t tokg = (size_t)b * SEQ + t;
    float* IMP = (float*)(smem + 49152);
    unsigned* SELM = (unsigned*)(smem + 49152);
    const h16* proj = (const h16*)(P->ws + OFF_PROJ);
    const int ghead = g * 4 + head;

    half8 qf[4];
    {
        const h16* qp = proj + tokg * D_IN + C_NQ + ghead * 64 + 8 * h;
#pragma unroll
        for (int ks = 0; ks < 4; ++ks) qf[ks] = *(const half8*)(qp + 16 * ks);
    }
    float g0, g1, g2;
    {
        const h16* gp = proj + tokg * D_IN + C_NGL + ghead * 3;
        const float* gb = P->in[I_NGB] + l * 24 + ghead * 3;
        g0 = sigmoidf_((float)gp[0] + gb[0]); g1 = sigmoidf_((float)gp[1] + gb[1]); g2 = sigmoidf_((float)gp[2] + gb[2]);
    }
    __syncthreads();
    for (int i = tid; i < 32 * 128; i += 256) IMP[i] = 0.f;

    half8 oacc[4];
    auto oacc_add = [&](const f32x16 (&o)[2], const float sc, const bool first) {
#pragma unroll
        for (int dt = 0; dt < 2; ++dt)
#pragma unroll
            for (int hf = 0; hf < 2; ++hf) {
                half8 v = oacc[dt * 2 + hf];
#pragma unroll
                for (int e = 0; e < 8; ++e) v[e] = (h16)((first ? 0.f : (float)v[e]) + o[dt][hf * 8 + e] * sc);
                oacc[dt * 2 + hf] = v;
            }
    };

    {
        const int nvt = 2 * c32 + 1;
        const int nvr = (t >= 31) ? ((t - 31) >> 4) + 1 : 0;
        const int ntile = (nvt + 63) >> 6;
        KVSrc src{(const h16*)(P->ws + OFF_KCMP) + (size_t)bg * 512 * 64, 64, 4096, (const h16*)(P->ws + OFF_VCMP) + (size_t)bg * 8 * 4096};
        f32x16 o[2];
#pragma unroll
        for (int e = 0; e < 16; ++e) { o[0][e] = 0.f; o[1][e] = 0.f; }
        float invl;
        if constexpr (FAST) {
            const int tf = t0 + w * 8;
            const int nvlo = __builtin_amdgcn_readfirstlane((tf >= 31) ? ((tf - 31) >> 4) + 1 : 0);
            float lsum = 0.f;
            nsa_pipe<3>(src, ntile, smem, w, lane, [&](int j, const char* st, auto&& issue) {
                f32x16 s[2];
                qk_tile<true>(st, qf, s, lane);
                issue();
                if (64 * j + 64 > nvlo) {
#pragma unroll
                    for (int kt = 0; kt < 2; ++kt)
#pragma unroll
                        for (int e = 0; e < 16; ++e) {
                            const int key = 64 * j + 32 * kt + 8 * (e >> 2) + 4 * h + (e & 3);
                            if (key >= nvr) s[kt][e] = NEGS;
                        }
                }
                lsum += sm_fast(s);
            });
            lsum = xhalf_sum(lsum);
            invl = lsum > 0.f ? 1.f / lsum : 0.f;
            nsa_pipe<3>(src, ntile, smem, w, lane, [&](int j, const char* st, auto&& issue) {
                f32x16 s[2];
                qk_tile<true>(st, qf, s, lane);
                half8 vf[4];
                pv_load<0>(st + 8192, vf, lane);
                issue();
                __builtin_amdgcn_sched_barrier(0);
                if (64 * j + 64 > nvlo) {
#pragma unroll
                    for (int kt = 0; kt < 2; ++kt)
#pragma unroll
                        for (int e = 0; e < 16; ++e) {
                            const int key = 64 * j + 32 * kt + 8 * (e >> 2) + 4 * h + (e & 3);
                            if (key >= nvr) s[kt][e] = NEGS;
                        }
                }
                (void)sm_fast(s);
                if (cur >= 16) {
#pragma unroll
                    for (int kt = 0; kt < 2; ++kt)
#pragma unroll
                        for (int g4 = 0; g4 < 4; ++g4) {
                            float G = ((s[kt][4 * g4] + s[kt][4 * g4 + 1]) + (s[kt][4 * g4 + 2] + s[kt][4 * g4 + 3])) * invl;
                            float L = s[kt][4 * g4 + 3] * invl;
                            G += __shfl_xor(G, 1); G += __shfl_xor(G, 2);
                            L += __shfl_xor(L, 1); L += __shfl_xor(L, 2);
                            if (head == 0) {
                                const int sb = 16 * j + 8 * kt + 2 * g4 + h;
                                atomicAdd(&IMP[tokl * 128 + sb], G);
                                if (sb + 1 < 128) atomicAdd(&IMP[tokl * 128 + sb + 1], L);
                            }
                        }
                }
                pv_finish(st + 8192, vf, s, o, lane);
            });
        } else {
        float m = -1e20f, lsum = 0.f;
        nsa_pipe<3>(src, ntile, smem, w, lane, [&](int j, const char* st, auto&& issue) {
            f32x16 s[2];
            qk_tile(st, qf, s, lane);
            issue();
#pragma unroll
            for (int kt = 0; kt < 2; ++kt)
#pragma unroll
                for (int e = 0; e < 16; ++e) {
                    const int key = 64 * j + 32 * kt + 8 * (e >> 2) + 4 * h + (e & 3);
                    if (key >= nvr) s[kt][e] = NEGS;
                }
            const float mn = fmaxf(m, rowmax32(s)), alpha = ex2(m - mn);
            float rs = 0.f;
#pragma unroll
            for (int kt = 0; kt < 2; ++kt)
#pragma unroll
                for (int e = 0; e < 16; ++e) rs += ex2(s[kt][e] - mn);
            rs = xhalf_sum(rs);
            lsum = lsum * alpha + rs; m = mn;
        });
        const float invl_s = lsum > 0.f ? 1.f / lsum : 0.f;
        nsa_pipe<3>(src, ntile, smem, w, lane, [&](int j, const char* st, auto&& issue) {
            f32x16 s[2];
            qk_tile(st, qf, s, lane);
            half8 vf[4];
            pv_load<0>(st + 8192, vf, lane);
            issue();
            __builtin_amdgcn_sched_barrier(0);
#pragma unroll
            for (int kt = 0; kt < 2; ++kt)
#pragma unroll
                for (int e = 0; e < 16; ++e) {
                    const int key = 64 * j + 32 * kt + 8 * (e >> 2) + 4 * h + (e & 3);
                    s[kt][e] = (key < nvr) ? ex2(s[kt][e] - m) * invl_s : 0.f;
                }
            if (cur >= 16) {
#pragma unroll
                for (int kt = 0; kt < 2; ++kt)
#pragma unroll
                    for (int g4 = 0; g4 < 4; ++g4) {
                        float G = (s[kt][4 * g4] + s[kt][4 * g4 + 1]) + (s[kt][4 * g4 + 2] + s[kt][4 * g4 + 3]);
                        float L = s[kt][4 * g4 + 3];
                        G += __shfl_xor(G, 1); G += __shfl_xor(G, 2);
                        L += __shfl_xor(L, 1); L += __shfl_xor(L, 2);
                        if (head == 0) {
                            const int sb = 16 * j + 8 * kt + 2 * g4 + h;
                            atomicAdd(&IMP[tokl * 128 + sb], G);
                            if (sb + 1 < 128) atomicAdd(&IMP[tokl * 128 + sb + 1], L);
                        }
                    }
            }
            pv_finish(st + 8192, vf, s, o, lane);
        });
            invl = 1.f;
        }
        oacc_add(o, g0 * invl, true);
    }
    __syncthreads();
    {
        const int tl = lane >> 3, sub = lane & 7;
        unsigned bits = 0;
        unsigned u[16];
        if (cur >= 16) {
            const float* ip = IMP + (w * 8 + tl) * 128 + sub * 16;
#pragma unroll
            for (int i = 0; i < 16; ++i) {
                const int s = sub * 16 + i;
                u[i] = (s >= 1 && s <= cur - 2) ? (__float_as_uint(ip[i]) + 1u) : 0u;
            }
        }
        __syncthreads();
        if (cur >= 16) {
            unsigned prefix = 0;
            for (int bit = 30; bit >= 0; --bit) {
                const unsigned cand = prefix | (1u << bit);
                int cnt = 0;
#pragma unroll
                for (int i = 0; i < 16; ++i) cnt += (u[i] >= cand) ? 1 : 0;
                cnt += __shfl_xor(cnt, 1); cnt += __shfl_xor(cnt, 2); cnt += __shfl_xor(cnt, 4);
                if (cnt >= 13) prefix = cand;
            }
            int cgt = 0, ceq = 0;
#pragma unroll
            for (int i = 0; i < 16; ++i) { cgt += (u[i] > prefix) ? 1 : 0; ceq += (u[i] == prefix) ? 1 : 0; }
            cgt += __shfl_xor(cgt, 1); cgt += __shfl_xor(cgt, 2); cgt += __shfl_xor(cgt, 4);
            int inc = ceq;
            { const int v = __shfl_up(inc, 1); if (sub >= 1) inc += v; }
            { const int v = __shfl_up(inc, 2); if (sub >= 2) inc += v; }
            { const int v = __shfl_up(inc, 4); if (sub >= 4) inc += v; }
            int run = inc - ceq;
            const int need = 13 - cgt;
#pragma unroll
            for (int i = 0; i < 16; ++i) {
                const int s = sub * 16 + i;
                bool sel = u[i] > prefix;
                if (u[i] == prefix) { sel = run < need; ++run; }
                if (s == 0 || s == cur || s == cur - 1) sel = true;
                bits |= (sel ? 1u : 0u) << i;
            }
        } else {
#pragma unroll
            for (int i = 0; i < 16; ++i) bits |= ((sub * 16 + i <= cur) ? 1u : 0u) << i;
        }
        unsigned wv = bits << ((sub & 1) * 16);
        wv |= __shfl_xor(wv, 1);
        if ((sub & 1) == 0) SELM[(w * 8 + tl) * 4 + (sub >> 1)] = wv;
    }
    __syncthreads();
    unsigned selw[4];
#pragma unroll
    for (int i = 0; i < 4; ++i) selw[i] = SELM[tokl * 4 + i];

    auto branch = [&](auto BRC) {
        constexpr int br = decltype(BRC)::value;
        const int j0 = (br == 0) ? 0 : (cur - 8 > 0 ? cur - 8 : 0);
        const int nst = cur - j0 + 1;
        KVSrc src{proj + ((size_t)b * SEQ + (size_t)j0 * 64) * D_IN + C_NKV + (br == 0 ? 256 : 512) + g * 64, D_IN, (size_t)64 * D_IN,
                  (const h16*)(P->ws + OFF_VTG) + (((size_t)br * 4 + bg) * 128 + j0) * 4096};
        float m = -1e20f, lsum = 0.f;
        f32x16 o[2];
#pragma unroll
        for (int e = 0; e < 16; ++e) { o[0][e] = 0.f; o[1][e] = 0.f; }
        nsa_pipe<4>(src, nst, smem, w, lane, [&](int jj, const char* st, auto&& issue) {
            const int j = j0 + jj;
            const bool rowok = (br != 0) || (((selw[j >> 5] >> (j & 31)) & 1u) != 0u);
            if constexpr (FAST && br == 0) {
                if (false) { issue(); return; }
            }
            f32x16 s[2];
            qk_tile<FAST>(st, qf, s, lane, issue);
            half8 vf[4];
            pv_load<0>(st + 8192, vf, lane);
            __builtin_amdgcn_sched_barrier(0);
            if (j == cur || (br == 1 && j == cur - 8)) {
#pragma unroll
                for (int kt = 0; kt < 2; ++kt)
#pragma unroll
                    for (int e = 0; e < 16; ++e) {
                        const int key = 64 * j + 32 * kt + 8 * (e >> 2) + 4 * h + (e & 3);
                        const bool ok = (key <= t) && (br == 0 || key > t - 512);
                        if (!ok) s[kt][e] = NEGS;
                    }
            }
            if constexpr (FAST) {
                const float rs = sm_fast(s);
                lsum += (br != 0 || rowok) ? rs : 0.f;
                pv_finish<br == 0>(st + 8192, vf, s, o, lane, rowok ? 0xffffffffu : 0u);
            } else {
                sm_online(s, m, lsum, o, rowok);
                pv_finish(st + 8192, vf, s, o, lane);
            }
        });
        if constexpr (FAST) lsum = xhalf_sum(lsum);
        const float sc = (br == 0 ? g1 : g2) / lsum;
        oacc_add(o, sc, false);
    };
    branch(IC<0>{});
    branch(IC<1>{});
    {
        h16* mixp = (h16*)(P->ws + OFF_MIX) + kb_idx(NT, tokg, 512 + ghead * 64);
        const h16* ngp = proj + tokg * D_IN + C_NG + ghead * 64;
#pragma unroll
        for (int dt = 0; dt < 2; ++dt)
#pragma unroll
            for (int g4 = 0; g4 < 4; ++g4) {
                const int d0 = 32 * dt + 8 * g4 + 4 * h;
                const half4 ng = *(const half4*)(ngp + d0);
                half4 ov;
#pragma unroll
                for (int e = 0; e < 4; ++e) ov[e] = (h16)((float)oacc[dt * 2 + (g4 >> 1)][(g4 & 1) * 4 + e] * siluf_((float)ng[e]));
                *(half4*)(mixp + d0) = ov;
            }
    }
    __syncthreads();
}

DI void gla_kv_item(PP P, int l, int item, char* smem, const int wv) {
    P = plaunder(P);
    const int tid = otid(wv), lane = tid & 63, w = tid >> 6, r = lane & 31, hh = lane >> 5;
    const int pair = item * 4 + w, h = pair & 3, cn = pair >> 2;
    const size_t tok = (size_t)cn * 32 + r;
    const int b = cn >> 8, n = cn & 255, bh = b * 4 + h;
    const h16* proj = (const h16*)(P->ws + OFF_PROJ);
    h16* VT = (h16*)(smem + w * 16384);
    h16* KT = VT + 2048;
    __syncthreads();
    {
        const half8* vp = (const half8*)(proj + tok * D_IN + C_GV + h * 64 + hh * 32);
#pragma unroll
        for (int q = 0; q < 4; ++q) {
            const half8 v8 = vp[q];
#pragma unroll
            for (int e = 0; e < 8; ++e) VT[(hh * 32 + q * 8 + e) * 32 + r] = v8[e];
        }
    }
    float gl[16];
    {
        const half8* lp = (const half8*)(proj + tok * D_IN + C_GLR);
        const half8 l0 = lp[0], l1 = lp[1];
        float lr[16];
#pragma unroll
        for (int q = 0; q < 8; ++q) { lr[q] = (float)l0[q]; lr[8 + q] = (float)l1[q]; }
        const float* w2 = P->in[I_GW2] + (size_t)l * 16 * 128 + h * 32 + 16 * hh;
        const float* b2 = P->in[I_GB2] + l * 128 + h * 32 + 16 * hh;
#pragma unroll
        for (int d = 0; d < 16; ++d) gl[d] = b2[d];
#pragma unroll
        for (int q = 0; q < 16; ++q)
#pragma unroll
            for (int d4 = 0; d4 < 4; ++d4) {
                const float4 wq = *(const float4*)(w2 + q * 128 + d4 * 4);
                gl[d4 * 4 + 0] += lr[q] * wq.x; gl[d4 * 4 + 1] += lr[q] * wq.y; gl[d4 * 4 + 2] += lr[q] * wq.z; gl[d4 * 4 + 3] += lr[q] * wq.w;
            }
#pragma unroll
        for (int d = 0; d < 16; ++d) gl[d] = log_sigmoidf_(gl[d]) * (1.f / 16.f);
    }
#pragma unroll
    for (int off = 1; off < 32; off <<= 1) {
#pragma unroll
        for (int d = 0; d < 16; ++d) { const float v = __shfl_up(gl[d], off, 32); if (r >= off) gl[d] += v; }
    }
    {
        float* bc = (float*)(P->ws + OFF_BCUM) + tok * 128 + h * 32 + 16 * hh;
#pragma unroll
        for (int d4 = 0; d4 < 4; ++d4) *(float4*)(bc + d4 * 4) = (float4){gl[d4 * 4], gl[d4 * 4 + 1], gl[d4 * 4 + 2], gl[d4 * 4 + 3]};
    }
    {
        const half8* kp = (const half8*)(proj + tok * D_IN + C_GK + h * 32 + 16 * hh);
        const half8 k0 = kp[0], k1 = kp[1];
        float bl[16];
#pragma unroll
        for (int d = 0; d < 16; ++d) bl[d] = __shfl(gl[d], 31, 32);
#pragma unroll
        for (int d = 0; d < 16; ++d) {
            const float kd = (float)(d < 8 ? k0[d & 7] : k1[d & 7]) * __expf(bl[d] - gl[d]);
            KT[(16 * hh + d) * 32 + r] = (h16)kd;
        }
        if (r == 0) {
            float* dc = (float*)(P->ws + OFF_GDEC) + (size_t)(bh * 256 + n) * 32 + 16 * hh;
#pragma unroll
            for (int d4 = 0; d4 < 4; ++d4) *(float4*)(dc + d4 * 4) = (float4){__expf(bl[d4 * 4]), __expf(bl[d4 * 4 + 1]), __expf(bl[d4 * 4 + 2]), __expf(bl[d4 * 4 + 3])};
        }
    }
    asm volatile("s_waitcnt lgkmcnt(0)" ::: "memory");
    const half8 kb0 = *(const half8*)(KT + r * 32 + 8 * hh), kb1 = *(const half8*)(KT + r * 32 + 16 + 8 * hh);
    float* kvp = (float*)(P->ws + OFF_GKV) + ((size_t)(bh * 256 + n) * 32 + r) * 64;
#pragma unroll
    for (int dt = 0; dt < 2; ++dt) {
        f32x16 o;
#pragma unroll
        for (int e = 0; e < 16; ++e) o[e] = 0.f;
        const h16* vrow = VT + (32 * dt + r) * 32 + 8 * hh;
        o = MFMA32(*(const half8*)vrow, kb0, o);
        o = MFMA32(*(const half8*)(vrow + 16), kb1, o);
#pragma unroll
        for (int g4 = 0; g4 < 4; ++g4)
            *(float4*)(kvp + 32 * dt + 8 * g4 + 4 * hh) = (float4){o[4 * g4], o[4 * g4 + 1], o[4 * g4 + 2], o[4 * g4 + 3]};
    }
    __syncthreads();
}

DI void gla_out_item(PP P, int l, int item, char* smem, const int wv) {
    P = plaunder(P);
    const int tid = otid(wv), lane = tid & 63, w = tid >> 6, r = lane & 31, hh = lane >> 5;
    const int pair = item * 4 + w, h = pair & 3, cn = pair >> 2;
    const size_t tok0 = (size_t)cn * 32, tok = tok0 + r;
    const int b = cn >> 8, n = cn & 255, bh = b * 4 + h;
    const h16* proj = (const h16*)(P->ws + OFF_PROJ);
    h16* VT = (h16*)(smem + w * 16384);
    h16* SPT = VT + 2048;
    __syncthreads();
    {
        const half8* vp = (const half8*)(proj + tok * D_IN + C_GV + h * 64 + hh * 32);
        const float4* sp = (const float4*)((const float*)(P->ws + OFF_GKV) + ((size_t)(bh * 256 + n) * 32 + r) * 64 + hh * 32);
#pragma unroll
        for (int q = 0; q < 4; ++q) {
            const half8 v8 = vp[q];
            const float4 s0 = sp[2 * q], s1 = sp[2 * q + 1];
#pragma unroll
            for (int e = 0; e < 8; ++e) VT[(hh * 32 + q * 8 + e) * 32 + r] = v8[e];
            SPT[(hh * 32 + q * 8 + 0) * 32 + r] = (h16)s0.x; SPT[(hh * 32 + q * 8 + 1) * 32 + r] = (h16)s0.y;
            SPT[(hh * 32 + q * 8 + 2) * 32 + r] = (h16)s0.z; SPT[(hh * 32 + q * 8 + 3) * 32 + r] = (h16)s0.w;
            SPT[(hh * 32 + q * 8 + 4) * 32 + r] = (h16)s1.x; SPT[(hh * 32 + q * 8 + 5) * 32 + r] = (h16)s1.y;
            SPT[(hh * 32 + q * 8 + 6) * 32 + r] = (h16)s1.z; SPT[(hh * 32 + q * 8 + 7) * 32 + r] = (h16)s1.w;
        }
    }
    half8 qe[2], ke[2];
#pragma unroll
    for (int ks = 0; ks < 2; ++ks) {
        const int d0 = 16 * ks + 8 * hh;
        const half8 q8 = *(const half8*)(proj + tok * D_IN + C_GQ + h * 32 + d0);
        const half8 k8 = *(const half8*)(proj + tok * D_IN + C_GK + h * 32 + d0);
        const float4 b0 = *(const float4*)((const float*)(P->ws + OFF_BCUM) + tok * 128 + h * 32 + d0);
        const float4 b1 = *(const float4*)((const float*)(P->ws + OFF_BCUM) + tok * 128 + h * 32 + d0 + 4);
        const float bc[8] = {b0.x, b0.y, b0.z, b0.w, b1.x, b1.y, b1.z, b1.w};
#pragma unroll
        for (int e = 0; e < 8; ++e) {
            const float ex = __expf(bc[e]);
            qe[ks][e] = (h16)((float)q8[e] * 0.17677669529663687f * ex);
            ke[ks][e] = (h16)((float)k8[e] * __builtin_amdgcn_rcpf(ex));
        }
    }
    f32x16 s;
#pragma unroll
    for (int e = 0; e < 16; ++e) s[e] = 0.f;
    s = MFMA32(ke[0], qe[0], s);
    s = MFMA32(ke[1], qe[1], s);
#pragma unroll
    for (int e = 0; e < 16; ++e) { const int j = (e & 3) + 8 * (e >> 2) + 4 * hh; if (j > r) s[e] = 0.f; }
    const half8 pb0 = pack8<0>(s), pb1 = pack8<1>(s);
    asm volatile("s_waitcnt lgkmcnt(0)" ::: "memory");
    f32x16 o[2];
#pragma unroll
    for (int dt = 0; dt < 2; ++dt) {
#pragma unroll
        for (int e = 0; e < 16; ++e) o[dt][e] = 0.f;
        const h16* vrow = VT + (32 * dt + r) * 32 + 4 * hh;
        const h16* srow = SPT + (32 * dt + r) * 32 + 8 * hh;
        {
            const half4 lo = *(const half4*)vrow, hi = *(const half4*)(vrow + 8);
            o[dt] = MFMA32(((half8){lo[0], lo[1], lo[2], lo[3], hi[0], hi[1], hi[2], hi[3]}), pb0, o[dt]);
        }
        {
            const half4 lo = *(const half4*)(vrow + 16), hi = *(const half4*)(vrow + 24);
            o[dt] = MFMA32(((half8){lo[0], lo[1], lo[2], lo[3], hi[0], hi[1], hi[2], hi[3]}), pb1, o[dt]);
        }
        o[dt] = MFMA32(*(const half8*)srow, qe[0], o[dt]);
        o[dt] = MFMA32(*(const half8*)(srow + 16), qe[1], o[dt]);
    }
    float ss = 0.f;
#pragma unroll
    for (int e = 0; e < 16; ++e) ss += o[0][e] * o[0][e] + o[1][e] * o[1][e];
    ss = xhalf_sum(ss);
    const float rn = rsqrtf(ss * (1.f / 64.f) + 1e-6f);
    h16* mix = (h16*)(P->ws + OFF_MIX);
#pragma unroll
    for (int dt = 0; dt < 2; ++dt)
#pragma unroll
        for (int g4 = 0; g4 < 4; ++g4) {
            const int e0 = 32 * dt + 8 * g4 + 4 * hh;
            const half4 gt = *(const half4*)(proj + tok * D_IN + C_GG + h * 64 + e0);
            const float4 on = *(const float4*)(P->in[I_GON] + l * 64 + e0);
            half4 ov;
            ov[0] = (h16)(o[dt][4 * g4 + 0] * rn * on.x * siluf_((float)gt[0]));
            ov[1] = (h16)(o[dt][4 * g4 + 1] * rn * on.y * siluf_((float)gt[1]));
            ov[2] = (h16)(o[dt][4 * g4 + 2] * rn * on.z * siluf_((float)gt[2]));
            ov[3] = (h16)(o[dt][4 * g4 + 3] * rn * on.w * siluf_((float)gt[3]));
            *(half4*)(mix + kb_idx(NT, tok, h * 64 + e0)) = ov;
        }
    __syncthreads();
}

DI void glu_tile(PP P, int l, int tile, char* smem, const int wv) {
    P = plaunder(P);
    const int mt = tile >> 2, nt = tile & 3;
    f32x4 acc[4][4];
    float ssd[4];
    gemm_mainloop_glds<false>(wv, 256, APlain{(const h16*)(P->ws + OFF_YACT) + (size_t)mt * 128 * 256, 256, 64},
                              (const h16*)(P->ws + OFF_WTGLU) + ((size_t)l * 512 + nt * 128) * 256, 256, acc, ssd, smem);
    const int tid = otid(wv), lane = tid & 63, wid = tid >> 6, wr = wid >> 1, wc = wid & 1;
    const h16* proj = (const h16*)(P->ws + OFF_PROJ);
    h16* mix = (h16*)(P->ws + OFF_MIX);
    const float* gb = P->in[I_GLUB] + l * 512;
#pragma unroll
    for (int i = 0; i < 4; ++i) {
        const size_t tok = (size_t)mt * 128 + wr * 64 + i * 16 + (lane & 15);
#pragma unroll
        for (int pj = 0; pj < 2; ++pj) {
            const int c = nt * 64 + wc * 32 + pj * 16 + (lane >> 4) * 4;
            const f32x4 z1 = acc[i][2 * pj], z2 = acc[i][2 * pj + 1];
            const float4 b1 = *(const float4*)(gb + c), b2 = *(const float4*)(gb + 256 + c);
            const half4 g4 = *(const half4*)(proj + tok * D_IN + C_SG + c);
            half4 o;
            o[0] = (h16)((z1[0] + b1.x) * sigmoidf_(z2[0] + b2.x) * siluf_((float)g4[0]));
            o[1] = (h16)((z1[1] + b1.y) * sigmoidf_(z2[1] + b2.y) * siluf_((float)g4[1]));
            o[2] = (h16)((z1[2] + b1.z) * sigmoidf_(z2[2] + b2.z) * siluf_((float)g4[2]));
            o[3] = (h16)((z1[3] + b1.w) * sigmoidf_(z2[3] + b2.w) * siluf_((float)g4[3]));
            *(half4*)(mix + kb_idx(NT, tok, 256 + c)) = o;
        }
    }
}

DI void outproj_tile(PP P, int l, int mt, int nt, char* smem, const int wv) {
    P = plaunder(P);
    f32x4 acc[8][4];
    float ssd[8];
    gemm_glds<false, 2, 8, 4, 3>(wv, 1024, APlain{(const h16*)(P->ws + OFF_MIX) + (size_t)mt * 256 * 64, 64, (size_t)NT * 64},
                              (const h16*)(P->ws + OFF_WTOUT) + ((size_t)l * 16 * 1024 + nt * 128) * 64, 64, acc, ssd, smem, (size_t)1024 * 64);
    const int tid = otid(wv), lane = tid & 63, wid = tid >> 6, wr = wid >> 1, wc = wid & 1;
    const float* xin = (l == 0) ? P->in[I_X] : P->out;
    h16* xh = (h16*)(P->ws + OFF_XH);
#pragma unroll
    for (int i = 0; i < 8; ++i) {
        const size_t row = (size_t)mt * 256 + wr * 128 + i * 16 + (lane & 15);
#pragma unroll
        for (int jj = 0; jj < 4; ++jj) {
            const int n = nt * 128 + wc * 64 + jj * 16 + (lane >> 4) * 4;
            const f32x4 v = acc[i][jj];
            const float4 xo = *(const float4*)(xin + row * 1024 + n);
            const float4 xn = (float4){xo.x + v[0], xo.y + v[1], xo.z + v[2], xo.w + v[3]};
            *(float4*)(P->out + row * 1024 + n) = xn;
            *(half4*)(xh + kb_idx(NT, row, n)) = (half4){(h16)xn.x, (h16)xn.y, (h16)xn.z, (h16)xn.w};
        }
    }
}

#define XB_TMO      128
#define XB_XCNT(j)  (256  + 64 * (j))
#define XB_XSUB(j)  (1280 + 64 * (j))
#define XB_XGEN(j)  (2304 + 64 * (j))
#define XB_TOP      3328
#define XB_TOPGEN   3392
#define XCD_BAR_WORDS 3456
#define XB_SPIN_CAP (1u << 18)
#define LAS __attribute__((address_space(3)))

__device__ __forceinline__ unsigned xb_ld(unsigned* p)              { return __hip_atomic_load(p, __ATOMIC_RELAXED, __HIP_MEMORY_SCOPE_AGENT); }
__device__ __forceinline__ unsigned xb_add(unsigned* p, unsigned v) { return __hip_atomic_fetch_add(p, v, __ATOMIC_RELAXED, __HIP_MEMORY_SCOPE_AGENT); }
__device__ __forceinline__ unsigned xb_xcc_id() { return (unsigned)__builtin_amdgcn_s_getreg((3 << 11) | 20) & 0xFu; }
#define XB_SPIN(cond, bar) do { unsigned _sp = 0; while (cond) { __builtin_amdgcn_s_sleep(1); \
    if ((++_sp & 255u) == 0u) { if (xb_ld(&(bar)[XB_TMO])) break; if (_sp > XB_SPIN_CAP) { atomicAdd(&(bar)[XB_TMO], 1u); break; } } } } while (0)

struct XcdBarrier {
    unsigned* bar; unsigned x;
    volatile LAS unsigned* st;
};

__device__ __forceinline__ XcdBarrier xcd_barrier_post(unsigned* bar, volatile LAS unsigned* st) {
    XcdBarrier b; b.bar = bar; b.x = xb_xcc_id(); b.st = st;
    if (threadIdx.x == 0) (void)xb_add(&bar[XB_XCNT(b.x)], 1u);
    return b;
}
__device__ __forceinline__ void xcd_barrier_complete(unsigned* bar, unsigned x, unsigned& nloc, unsigned& nx) {
    const unsigned G = gridDim.x * gridDim.y * gridDim.z;
    unsigned sum, cnt, mine, sp = 0u;
    for (;;) {
        sum = 0u; cnt = 0u; mine = 0u;
#pragma unroll
        for (unsigned j = 0; j < 16; ++j) { const unsigned c = xb_ld(&bar[XB_XCNT(j)]); sum += c; cnt += (c > 0u) ? 1u : 0u; mine = (j == x) ? c : mine; }
        if (sum == G) break;
        __builtin_amdgcn_s_sleep(1);
        if ((++sp & 255u) == 0u) { if (xb_ld(&bar[XB_TMO])) break; if (sp > XB_SPIN_CAP) { atomicAdd(&bar[XB_TMO], 1u); break; } }
    }
    nloc = mine > 0u ? mine : 1u; nx = cnt > 0u ? cnt : 1u;
}

__device__ __forceinline__ void xcd_barrier(const XcdBarrier& b) {
    asm volatile("s_waitcnt vmcnt(0)" ::: "memory");
    __syncthreads();
    if (threadIdx.x == 0) {
        unsigned* bar = b.bar;
        __builtin_amdgcn_s_waitcnt(0);
        unsigned nloc = b.st[0], nx = b.st[1];
        if (nloc == 0u) { xcd_barrier_complete(bar, b.x, nloc, nx); b.st[0] = nloc; b.st[1] = nx; }
        const unsigned old = xb_add(&bar[XB_XSUB(b.x)], 1u);
        const unsigned gen = old / nloc;
        if (old + 1u == (gen + 1u) * nloc) {
            __builtin_amdgcn_fence(__ATOMIC_RELEASE, "agent");
            asm volatile("s_waitcnt vmcnt(0)" ::: "memory");
            const unsigned og = xb_add(&bar[XB_TOP], 1u);
            const unsigned tg = og / nx;
            if (og + 1u == (tg + 1u) * nx) xb_add(&bar[XB_TOPGEN], 1u);
            else XB_SPIN(xb_ld(&bar[XB_TOPGEN]) == tg, bar);
            __builtin_amdgcn_fence(__ATOMIC_ACQUIRE, "agent");
            xb_add(&bar[XB_XGEN(b.x)], 1u);
            asm volatile("s_waitcnt vmcnt(0)" ::: "memory");
        } else {
            XB_SPIN(xb_ld(&bar[XB_XGEN(b.x)]) == gen, bar);
            __builtin_amdgcn_fence(__ATOMIC_ACQUIRE, "agent");
            asm volatile("s_waitcnt vmcnt(0)" ::: "memory");
        }
    }
    __syncthreads();
}


__global__ void __launch_bounds__(NTHREADS, 2) fwd_megakernel(Params Pval) {
    PP P = (PP)__builtin_amdgcn_kernarg_segment_ptr();
    extern __shared__ __attribute__((aligned(16))) char smem[];
    cg::grid_group grid = cg::this_grid();
    const int G = gridDim.x, bid = blockIdx.x;
    const int wv = __builtin_amdgcn_readfirstlane((int)(threadIdx.x >> 6));

    uint4& xb_words = *(uint4*)(smem + SMEM_MAIN);
    if (otid(wv) == 0) xb_words = make_uint4(0u, 0u, 0u, 0u);
    __syncthreads();
    if (P->ws == nullptr) grid.sync();
    const XcdBarrier xb = xcd_barrier_post((unsigned*)(P->ws + OFF_BAR), (volatile LAS unsigned*)(smem + SMEM_MAIN));
    int vxcd = bid & 7, vjx = bid >> 3;
    {
        unsigned* xcnt = (unsigned*)(P->ws + OFF_BAR) + XCD_BAR_WORDS;
        volatile LAS unsigned* lw = (volatile LAS unsigned*)(smem + SMEM_MAIN) + 2;
        if (otid(wv) == 0) lw[0] = xb.x < 8u ? xb_add(&xcnt[xb.x], 1u) : 0xffffu;
        phase0(P, smem, wv);
        xcd_barrier(xb);
        if (otid(wv) == 0) {
            bool ok = (G & 7) == 0 && xb.x < 8u;
            for (int j = 0; j < 8; ++j) ok = ok && (xb_ld(&xcnt[j]) == (unsigned)(G >> 3));
            lw[1] = ok ? 1u : 0u;
        }
        __syncthreads();
        if (lw[1]) { vxcd = (int)xb.x; vjx = (int)lw[0]; }
    }
    vxcd = __builtin_amdgcn_readfirstlane(vxcd); vjx = __builtin_amdgcn_readfirstlane(vjx);

#pragma unroll 1
    for (int l = 0; l < DEPTH; ++l) {
        {
            const int xcd = vxcd, jx = vjx, nper = G >> 3;
            for (int u = jx; u < 192; u += nper) inproj_tile<2, 8>(P, l, (xcd * 8 + (u & 7)) * 256, (u >> 3) * 128, smem, wv);
            for (int it = jx; it < 16 + 40; it += nper) {
                if (it < 16) inproj_tile<4, 2>(P, l, (xcd * 16 + it) * 128, 3072, smem, wv);
                else s5_build_item(P, l, (it - 16) * 8 + xcd, smem, wv);
            }
        }
        xcd_barrier(xb);
#pragma unroll 1
        for (int w = bid; w < 128 + 64 + 512; w += G) {
            if (w < 128) cmp_gemm_tile(P, l, w, smem, wv);
            else if (w < 192) s5e_gemm_tile(P, l, w - 128, smem, wv);
            else gla_kv_item(P, l, w - 192, smem, wv);
        }
        xcd_barrier(xb);
#pragma unroll 1
        for (int w = bid; w < 512 + 512 + 64; w += G) {
            if (w < 512) cmp_l2_item(P, l, w, smem, wv);
            else if (w < 1024) gla_scan_item(P, w - 512, smem, wv);
            else s5_scan_item(P, w - 1024, smem, wv);
        }
        xcd_barrier(xb);
        bool nsa_fast;
        {
            const int ln = otid(wv) & 63;
            const float gq = wave_max(fabsf(P->in[I_NQN][l * 64 + ln]));
            const float gk = wave_max(fmaxf(fmaxf(fabsf(P->in[I_NKN][(l * 3 + 0) * 64 + ln]), fabsf(P->in[I_NKN][(l * 3 + 1) * 64 + ln])), fabsf(P->in[I_NKN][(l * 3 + 2) * 64 + ln])));
            nsa_fast = __builtin_amdgcn_readfirstlane((8.f * 1.4426950408889634f * gq * gk < 15.f) ? 1 : 0) != 0;
        }
#pragma unroll 1
        for (int w0 = bid; w0 < 512 + 512 + 512; w0 += G) {
            const int w = w0 < G ? vjx * 8 + vxcd : w0;
            if (w < 512) {
                const int bg = w & 3, q = w >> 2;
                if (nsa_fast) { nsa_unit<true>(P, l, bg, 255 - q, smem, wv); nsa_unit<true>(P, l, bg, q, smem, wv); }
                else { nsa_unit<false>(P, l, bg, 255 - q, smem, wv); nsa_unit<false>(P, l, bg, q, smem, wv); }
            } else if (w < 512 + 512) s5o_gemm_tile(P, l, w - 512, smem, wv);
            else gla_out_item(P, l, w - 1024, smem, wv);
        }
        xcd_barrier(xb);
#pragma unroll 1
        for (int w = bid; w < 512; w += G) glu_tile(P, l, w, smem, wv);
        xcd_barrier(xb);
        {
            const int xcd = vxcd, jx = vjx, nper = G >> 3;
            for (int u = jx; u < 64; u += nper) outproj_tile(P, l, xcd * 8 + (u & 7), u >> 3, smem, wv);
        }
        xcd_barrier(xb);
    }
}

extern "C" void kernel_launch(void* const* d_in, const int* in_sizes, int n_in, void* d_out, int out_size, void* d_ws,
                              size_t ws_size, hipStream_t stream) {
    static int grid_blocks = 0;
    if (!grid_blocks) {
        int dev = 0, cus = 0, per_cu = 0;
        hipGetDevice(&dev);
        hipDeviceGetAttribute(&cus, hipDeviceAttributeMultiprocessorCount, dev);
        hipFuncSetAttribute((const void*)fwd_megakernel, hipFuncAttributeMaxDynamicSharedMemorySize, SMEM_BYTES);
        hipOccupancyMaxActiveBlocksPerMultiprocessor(&per_cu, fwd_megakernel, NTHREADS, SMEM_BYTES);
        if (per_cu < 1) per_cu = 1;
        if (per_cu > 2) per_cu = 2;
        grid_blocks = cus * per_cu;
        if (ws_size < WS_END) fprintf(stderr, "kernel_launch: workspace too small: %zu < %zu\n", ws_size, (size_t)WS_END);
    }
    Params p{};
    for (int i = 0; i < 25; ++i) p.in[i] = (const float*)d_in[i];
    p.out = (float*)d_out;
    p.ws = (char*)d_ws;
    void* args[] = {&p};
    (void)hipMemsetAsync((char*)d_ws + OFF_BAR, 0, (XCD_BAR_WORDS + 16) * sizeof(unsigned), stream);
    hipError_t e = hipLaunchCooperativeKernel((const void*)fwd_megakernel, dim3(grid_blocks), dim3(NTHREADS), args, SMEM_BYTES, stream);
    if (e != hipSuccess) fprintf(stderr, "cooperative launch failed: %s (grid %d)\n", hipGetErrorString(e), grid_blocks);
}
```

```cpp
#include <hip/hip_runtime.h>
#include <hip/hip_cooperative_groups.h>
#include <cstdio>
#include <cstdint>
namespace cg = cooperative_groups;

typedef _Float16 h16;
typedef _Float16 half8 __attribute__((ext_vector_type(8)));
typedef _Float16 half4 __attribute__((ext_vector_type(4)));
typedef float f32x4 __attribute__((ext_vector_type(4)));
typedef float f32x16 __attribute__((ext_vector_type(16)));

#define DI __device__ __forceinline__

constexpr int D_MODEL = 1024, BATCH = 2, SEQ = 8192, DEPTH = 4, NT = BATCH * SEQ;
constexpr int D_IN = 3112, D_IN_PAD = 3200;
constexpr int C_NQ = 0, C_NKV = 512, C_NG = 1280, C_GQ = 1792, C_GK = 1920, C_GV = 2048, C_GG = 2304, C_SU = 2560, C_SG = 2816,
              C_GLR = 3072, C_NGL = 3088;
__host__ __device__ constexpr int map_col(int c) {
    return c < 128 ? C_GQ + c : c < 256 ? C_GK + (c - 128) : c < 512 ? C_GV + (c - 256) : c < 528 ? C_GLR + (c - 512)
         : c < 784 ? C_GG + (c - 528) : c < 1040 ? C_SU + (c - 784) : c < 1296 ? C_SG + (c - 1040) : c < 1808 ? C_NQ + (c - 1296)
         : c < 2576 ? C_NKV + (c - 1808) : c < 2600 ? C_NGL + (c - 2576) : c < 3112 ? C_NG + (c - 2600) : c;
}
constexpr int NTHREADS = 256;
constexpr float QSCALE = 0.125f * 1.4426950408889634f;

enum { I_X = 0, I_NORMG, I_WIN, I_GW2, I_GB2, I_GON, I_LRE, I_LIM, I_LSTEP, I_BRE, I_BIM, I_CRE, I_CIM, I_SD, I_GLUW, I_GLUB,
       I_NGB, I_NQN, I_NKN, I_CPOS, I_CW1, I_CB1, I_CW2, I_CB2, I_WOUT };

constexpr size_t OFF_WTIN  = 0;
constexpr size_t OFF_WTOUT = OFF_WTIN  + 4ull * D_IN_PAD * 1024 * 2;
constexpr size_t OFF_WTGLU = OFF_WTOUT + 4ull * 1024 * 1024 * 2;
constexpr size_t OFF_WTC1  = OFF_WTGLU + 4ull * 512 * 256 * 2;
constexpr size_t OFF_PROJ  = OFF_WTC1  + 4ull * 2 * 256 * 2048 * 2;
constexpr size_t OFF_MIX   = OFF_PROJ  + (size_t)NT * D_IN * 2;
constexpr size_t OFF_YACT  = OFF_MIX   + (size_t)NT * 1024 * 2;
constexpr size_t OFF_XH    = OFF_YACT;
constexpr size_t OFF_BCUM  = OFF_YACT  + (size_t)NT * 256 * 2;
constexpr size_t OFF_GKV   = OFF_BCUM  + (size_t)NT * 128 * 4;
constexpr size_t OFF_GDEC  = OFF_GKV   + 8ull * 256 * 2048 * 4;
static_assert(OFF_GDEC - OFF_XH >= (size_t)NT * 1024 * 2, "XH alias region too small");
constexpr size_t OFF_XC    = OFF_GDEC  + 8ull * 256 * 32 * 4;
constexpr size_t OFF_S5W   = OFF_XC    + 512ull * 1024 * 2 * 4;
constexpr size_t OFF_S5E   = OFF_S5W   + 16ull * 512 * 640 * 2;
constexpr size_t OFF_S5AL  = OFF_S5E   + 16ull * 128 * 512 * 2;
constexpr size_t OFF_CHID  = OFF_S5AL  + 1024ull * 2 * 4;
constexpr size_t OFF_POSB  = OFF_CHID  + 2ull * 2048 * 512 * 4;
constexpr size_t OFF_XCH   = OFF_POSB  + 8ull * 16 * 256 * 4;
constexpr size_t OFF_KCMP  = OFF_XCH   + 512ull * 2048 * 2;
constexpr size_t OFF_VCMP  = OFF_KCMP  + 4ull * 512 * 64 * 2;
constexpr size_t OFF_VTG   = OFF_VCMP  + 4ull * 512 * 64 * 2;
constexpr size_t OFF_BAR   = OFF_VTG   + 2ull * 4 * 128 * 4096 * 2;
constexpr size_t WS_END    = OFF_BAR   + 16384;

struct Params {
    const float* in[25];
    float* out;
    char* ws;
};

__host__ __device__ constexpr size_t kb_idx(size_t nrows, size_t row, int k) { return (((size_t)(k >> 6)) * nrows + row) * 64 + (k & 63); }
typedef const __attribute__((address_space(4))) Params* PP;
DI PP plaunder(PP p) { asm volatile("" : "+s"(p)); return p; }
constexpr int SMEM_MAIN = 73728;
constexpr int SMEM_BYTES = SMEM_MAIN + 16;

DI int otid(const int wv) { int t = wv * 64 + (int)__builtin_amdgcn_mbcnt_hi(~0u, __builtin_amdgcn_mbcnt_lo(~0u, 0u)); asm volatile("" : "+v"(t)); return t; }
template <int M> DI int shx_i(int v) {
    static_assert(M == 1 || M == 2 || M == 4 || M == 8 || M == 16, "lane xor mask");
    if constexpr (M == 1) return __builtin_amdgcn_update_dpp(0, v, 0xB1, 0xF, 0xF, true);
    else if constexpr (M == 2) return __builtin_amdgcn_update_dpp(0, v, 0x4E, 0xF, 0xF, true);
    else return __builtin_amdgcn_ds_swizzle(v, (M << 10) | 0x1F);
}
template <int M> DI float shx(float v) { return __int_as_float(shx_i<M>(__float_as_int(v))); }
template <int N> DI int row_shr_i(int v) { return __builtin_amdgcn_update_dpp(0, v, 0x110 | N, 0xF, 0xF, true); }
DI float xhalf_max(float v) {
    const auto r = __builtin_amdgcn_permlane32_swap(__float_as_uint(v), __float_as_uint(v), false, false);
    return fmaxf(__uint_as_float(r[0]), __uint_as_float(r[1]));
}
DI float xhalf_sum(float v) {
    const auto r = __builtin_amdgcn_permlane32_swap(__float_as_uint(v), __float_as_uint(v), false, false);
    return __uint_as_float(r[0]) + __uint_as_float(r[1]);
}
DI float wave_sum(float v) {
    v = xhalf_sum(v);
    v += shx<16>(v); v += shx<8>(v); v += shx<4>(v); v += shx<2>(v); v += shx<1>(v);
    return v;
}
DI float wave_max(float v) {
    v = xhalf_max(v);
    v = fmaxf(v, shx<16>(v)); v = fmaxf(v, shx<8>(v)); v = fmaxf(v, shx<4>(v)); v = fmaxf(v, shx<2>(v)); v = fmaxf(v, shx<1>(v));
    return v;
}
DI int olane() { int l = (int)__builtin_amdgcn_mbcnt_hi(~0u, __builtin_amdgcn_mbcnt_lo(~0u, 0u)); asm volatile("" : "+v"(l)); return l; }
DI float bperm(float v, int srclane) { return __int_as_float(__builtin_amdgcn_ds_bpermute(srclane << 2, __float_as_int(v))); }
DI float sigmoidf_(float x) { return 1.f / (1.f + __expf(-x)); }
DI float siluf_(float x) { return x / (1.f + __expf(-x)); }
DI float gelu_tanh(float x) {
    const float u = 0.7978845608028654f * (x + 0.044715f * x * x * x);
    return 0.5f * x * (1.f + tanhf(u));
}
DI float log_sigmoidf_(float x) { return fminf(x, 0.f) - log1pf(__expf(-fabsf(x))); }

typedef _Float16 half2_ __attribute__((ext_vector_type(2)));
DI void glds16(const h16* g, char* l) {
    __builtin_amdgcn_global_load_lds((const __attribute__((address_space(1))) void*)g, (__attribute__((address_space(3))) void*)l, 16, 0, 0);
}
DI int vkperm(int k) { return (k & ~12) | ((k & 4) << 1) | ((k & 8) >> 1); }
struct APlain { const h16* A; size_t lda, astep; DI const h16* operator()(int row, int kt, int c8) const { return A + (size_t)row * lda + (size_t)kt * astep + c8 * 8; } };
struct AS5 {
    const h16* ubase;
    const h16* xin;
    int ch0;
    DI const h16* operator()(int row, int kt, int c8) const {
        const size_t ch = (size_t)(ch0 + row);
        return kt < 8 ? ubase + (ch * 32 + 4 * kt + (c8 >> 1)) * D_IN + (c8 & 1) * 8 : xin + ch * 2048 + (kt - 8) * 64 + c8 * 8;
    }
};
template <int N> DI void gwaitbar();
#define GWB_DEF(N) template <> DI void gwaitbar<N>() { asm volatile("s_waitcnt vmcnt(" #N ") lgkmcnt(0)\n\ts_barrier" ::: "memory"); }
GWB_DEF(0) GWB_DEF(3) GWB_DEF(4) GWB_DEF(6) GWB_DEF(8) GWB_DEF(12)
template <bool SUMSQ, int WR, int MI, int NJ, int NST = 4, class AF>
DI void gemm_glds(const int wv, const int K, const AF& afn, const h16* __restrict__ Bt, const int ldb,
                  f32x4 (&acc)[MI][NJ], float (&ss)[MI], char* smem, const size_t bstep = 64) {
    constexpr int WC = 4 / WR, BM = WR * MI * 16, BN = WC * NJ * 16, AQ = BM / 64, BQ = BN / 64, NG = AQ + BQ, SB = (BM + BN) * 64;
    static_assert(NST * SB <= SMEM_MAIN && AQ >= 1 && BQ >= 1 && (NST == 3 || NST == 4), "ring does not fit the LDS");
    const int tid = otid(wv), lane = tid & 63, wid = tid >> 6, wr = wid / WC, wc = wid % WC;
#pragma unroll
    for (int i = 0; i < MI; ++i) {
        ss[i] = 0.f;
#pragma unroll
        for (int j = 0; j < NJ; ++j) acc[i][j] = (f32x4){0.f, 0.f, 0.f, 0.f};
    }
    const int lrow = wid * 16 + (lane >> 2);
    const int lc4 = (lane & 3) ^ ((-(lrow >> 2)) & 3);
    const h16* bp = Bt + (size_t)lrow * ldb + lc4 * 8;
    char* lbase = smem + wid * 1024;
    const int fr = lane & 15, fq = lane >> 4, sw = (-(fr >> 2)) & 3;
    const int aoff0 = (wr * MI * 16 + fr) * 64 + ((fq ^ sw) * 16);
    const int boff0 = BM * 64 + (wc * NJ * 16 + fr) * 64 + ((fq ^ sw) * 16);
    const int nt = K >> 5;
    auto issue = [&](const int t, char* stage) {
        const int kt = t >> 1, hb = (t & 1) * 4;
#pragma unroll
        for (int q = 0; q < AQ; ++q) glds16(afn(lrow + 64 * q, kt, hb + lc4), stage + q * 4096);
#pragma unroll
        for (int q = 0; q < BQ; ++q) glds16(bp + (size_t)q * 64 * ldb + (size_t)kt * bstep + hb * 8, stage + BM * 64 + q * 4096);
    };
    auto compute = [&](const char* st) {
        half8 af[MI], bf[NJ];
#pragma unroll
        for (int i = 0; i < MI; ++i) af[i] = *(const half8*)(st + aoff0 + i * 1024);
#pragma unroll
        for (int j = 0; j < NJ; ++j) bf[j] = *(const half8*)(st + boff0 + j * 1024);
        if (SUMSQ) {
#pragma unroll
            for (int i = 0; i < MI; ++i)
#pragma unroll
                for (int e = 0; e < 4; ++e) {
                    const half2_ x = (half2_){af[i][2 * e], af[i][2 * e + 1]};
                    ss[i] = __builtin_amdgcn_fdot2(x, x, ss[i], false);
                }
        }
#pragma unroll
        for (int i = 0; i < MI; ++i)
#pragma unroll
            for (int j = 0; j < NJ; ++j) acc[i][j] = __builtin_amdgcn_mfma_f32_16x16x32_f16(bf[j], af[i], acc[i][j], 0, 0, 0);
    };
#define GEMM_STEP(S, t) do { if (NST == 4 && (t) + 2 < nt) gwaitbar<NG>(); else gwaitbar<0>();                       \
        if ((t) + NST - 1 < nt) issue((t) + NST - 1, lbase + (((S) + NST - 1) % NST) * SB); compute(smem + (S) * SB); } while (0)
    gwaitbar<0>();
    {
        const int k = nt < NST - 1 ? nt : NST - 1;
        for (int p = 0; p < k; ++p) issue(p, lbase + p * SB);
        if (k >= 3) gwaitbar<2 * NG>(); else if (k == 2) gwaitbar<NG>(); else gwaitbar<0>();
        __builtin_amdgcn_s_sleep(2);
    }
#pragma unroll 1
    for (int t = 0; t < nt; t += NST) {
        GEMM_STEP(0, t);
        if (t + 1 < nt) GEMM_STEP(1, t + 1);
        if (t + 2 < nt) GEMM_STEP(2, t + 2);
        if (NST == 4 && t + 3 < nt) GEMM_STEP(3 % NST, t + 3);
    }
#undef GEMM_STEP
    asm volatile("s_waitcnt lgkmcnt(0)\n\ts_barrier" ::: "memory");
    if (SUMSQ) {
#pragma unroll
        for (int i = 0; i < MI; ++i) { ss[i] += shx<16>(ss[i]); ss[i] = xhalf_sum(ss[i]); }
    }
}
template <bool SUMSQ, class AF>
DI void gemm_mainloop_glds(const int wv, const int K, const AF& afn, const h16* __restrict__ Bt, const int ldb, f32x4 (&acc)[4][4], float (&ss)[4], char* smem, const size_t bstep = 64) {
    gemm_glds<SUMSQ, 2, 4, 4>(wv, K, afn, Bt, ldb, acc, ss, smem, bstep);
}

DI int glu_perm_dst(int c_orig) {
    const int which = c_orig >> 8, c = c_orig & 255;
    return (c >> 6) * 128 + ((c >> 5) & 1) * 64 + (((c >> 4) & 1) * 2 + which) * 16 + (c & 15);
}
template <int MAP, int KB>
DI void transpose64(const float* __restrict__ src, int R, int C, h16* __restrict__ dst, int r0, int c0,
                    const float* __restrict__ rscale, char* smem, const int wv) {
    h16* tile = (h16*)smem;
    const int tid = otid(wv);
    {
        const int r = tid >> 2, cq = (tid & 3) * 16;
        const float sc = rscale ? rscale[r0 + r] : 1.f;
        const float* sp = src + (size_t)(r0 + r) * C + c0 + cq;
#pragma unroll
        for (int q = 0; q < 4; ++q) {
            float4 v = (float4){0.f, 0.f, 0.f, 0.f};
            if (c0 + cq + q * 4 < C) v = *(const float4*)(sp + q * 4);
            *(half4*)(tile + r * 72 + cq + q * 4) = (half4){(h16)(v.x * sc), (h16)(v.y * sc), (h16)(v.z * sc), (h16)(v.w * sc)};
        }
    }
    __syncthreads();
    {
        const int c = tid >> 2, rq = (tid & 3) * 16;
        half8 o0, o1;
#pragma unroll
        for (int k = 0; k < 8; ++k) { o0[k] = tile[(rq + k) * 72 + c]; o1[k] = tile[(rq + 8 + k) * 72 + c]; }
        const int cc = c0 + c;
        const int dr = MAP == 1 ? map_col(cc) : MAP == 2 ? glu_perm_dst(cc) : cc;
        h16* dp = KB ? dst + ((size_t)(r0 >> 6) * KB + dr) * 64 + rq : dst + (size_t)dr * R + r0 + rq;
        *(half8*)dp = o0; *(half8*)(dp + 8) = o1;
    }
    __syncthreads();
}

DI void phase0(PP P, char* smem, const int wv) {
    P = plaunder(P);
    constexpr int N_WIN = 4 * 16 * 50, N_WOUT = 4 * 16 * 16, N_C1 = 16 * 16 * 4, N_GLU = 4 * 4 * 8, N_XH = NT * 1024 / 2048, N_PB = 8 * 16;
    const int total = N_WIN + N_WOUT + N_C1 + N_GLU + N_XH + N_PB;
    for (int w = blockIdx.x; w < total; w += gridDim.x) {
        if (w < N_WIN) {
            const int l = w / 800, r = w % 800, rt = r / 50, ct = r % 50;
            transpose64<1, D_IN_PAD>(P->in[I_WIN] + (size_t)l * 1024 * D_IN, 1024, D_IN, (h16*)(P->ws + OFF_WTIN) + (size_t)l * D_IN_PAD * 1024,
                           rt * 64, ct * 64, P->in[I_NORMG] + l * 1024, smem, wv);
        } else if (w < N_WIN + N_WOUT) {
            const int v = w - N_WIN, l = v >> 8, r = v & 255, rt = r >> 4, ct = r & 15;
            transpose64<0, 1024>(P->in[I_WOUT] + (size_t)l * 1024 * 1024, 1024, 1024, (h16*)(P->ws + OFF_WTOUT) + (size_t)l * 1024 * 1024,
                           rt * 64, ct * 64, nullptr, smem, wv);
        } else if (w < N_WIN + N_WOUT + N_C1) {
            const int v = w - N_WIN - N_WOUT, ljh = v >> 6, r = v & 63, rt = r >> 2, ct = r & 3;
            transpose64<0, 512>(P->in[I_CW1] + (size_t)ljh * 1024 * 256, 1024, 256, (h16*)(P->ws + OFF_WTC1) + ((size_t)(ljh >> 1) * 16 * 512 + (ljh & 1) * 256) * 64,
                           rt * 64, ct * 64, nullptr, smem, wv);
        } else if (w < N_WIN + N_WOUT + N_C1 + N_GLU) {
            const int v = w - N_WIN - N_WOUT - N_C1, l = v >> 5, r = v & 31, rt = r >> 3, ct = r & 7;
            transpose64<2, 0>(P->in[I_GLUW] + (size_t)l * 256 * 512, 256, 512, (h16*)(P->ws + OFF_WTGLU) + (size_t)l * 512 * 256,
                           rt * 64, ct * 64, nullptr, smem, wv);
        } else if (w < N_WIN + N_WOUT + N_C1 + N_GLU + N_XH) {
            const size_t e0 = ((size_t)(w - N_WIN - N_WOUT - N_C1 - N_GLU) * 256 + otid(wv)) * 8;
            const float4 a = *(const float4*)(P->in[I_X] + e0), b = *(const float4*)(P->in[I_X] + e0 + 4);
            *(half8*)((h16*)(P->ws + OFF_XH) + kb_idx(NT, e0 >> 10, (int)(e0 & 1023))) = (half8){(h16)a.x, (h16)a.y, (h16)a.z, (h16)a.w, (h16)b.x, (h16)b.y, (h16)b.z, (h16)b.w};
        } else {
            const int v = w - (N_WIN + N_WOUT + N_C1 + N_GLU + N_XH), lj = v >> 4, ks = v & 15, n = otid(wv);
            const float* w1 = P->in[I_CW1] + ((size_t)lj * 2048 + ks * 128) * 256 + n;
            const float* pp = P->in[I_CPOS] + (size_t)lj * 2048 + ks * 128;
            float a = ks == 0 ? P->in[I_CB1][lj * 256 + n] : 0.f;
#pragma unroll 16
            for (int k = 0; k < 128; ++k) a += pp[k] * w1[(size_t)k * 256];
            ((float*)(P->ws + OFF_POSB))[(lj * 16 + ks) * 256 + n] = a;
        }
    }
}

DI void s5_build_item(PP P, int l, int item, char* smem, const int wv) {
    P = plaunder(P);
    float* apow = (float*)smem;
    float* bbar = apow + 64 * 33 * 2;
    float* cc   = bbar + 64 * 16 * 2;
    const int tid = otid(wv);
    const int g = (item < 256) ? (item >> 4) : ((item - 256) >> 2);
    if (tid < 64) {
        const int p = tid;
        const float lre = fminf(P->in[I_LRE][(l * 16 + g) * 64 + p], -1e-4f);
        const float lim = P->in[I_LIM][(l * 16 + g) * 64 + p];
        const float dt = expf(P->in[I_LSTEP][l * 16 + g]);
        const float x = lre * dt, y = lim * dt;
        const float em1 = expm1f(x), cy = cosf(y), sy = sinf(y), sh = sinf(0.5f * y);
        const float ar = (em1 + 1.f) * cy, ai = (em1 + 1.f) * sy;
        const float dr = em1 * cy - 2.f * sh * sh, di = ai;
        const float den = lre * lre + lim * lim;
        const float fr = (dr * lre + di * lim) / den;
        const float fi = (di * lre - dr * lim) / den;
        float pr = 1.f, pi = 0.f;
        for (int k = 0; k <= 32; ++k) {
            apow[(p * 33 + k) * 2] = pr; apow[(p * 33 + k) * 2 + 1] = pi;
            const float nr = pr * ar - pi * ai, ni = pr * ai + pi * ar; pr = nr; pi = ni;
        }
        for (int c = 0; c < 16; ++c) {
            const float br = P->in[I_BRE][((size_t)(l * 16 + g) * 64 + p) * 16 + c];
            const float bi = P->in[I_BIM][((size_t)(l * 16 + g) * 64 + p) * 16 + c];
            bbar[(p * 16 + c) * 2] = fr * br - fi * bi;
            bbar[(p * 16 + c) * 2 + 1] = fr * bi + fi * br;
        }
    }
    for (int e = tid; e < 1024; e += 256) {
        cc[e * 2] = P->in[I_CRE][(size_t)(l * 16 + g) * 1024 + e];
        cc[e * 2 + 1] = P->in[I_CIM][(size_t)(l * 16 + g) * 1024 + e];
    }
    __syncthreads();
    if (item < 256) {
        const int c = item & 15;
        float* kt = cc + 2048;
        for (int idx = tid; idx < 512; idx += 256) {
            const int lag = idx >> 4, c2 = idx & 15;
            float a = 0.f;
            for (int p = 0; p < 64; ++p) {
                const float cr = cc[(c * 64 + p) * 2], ci = cc[(c * 64 + p) * 2 + 1];
                const float xr = apow[(p * 33 + lag) * 2], xi = apow[(p * 33 + lag) * 2 + 1];
                const float br = bbar[(p * 16 + c2) * 2], bi = bbar[(p * 16 + c2) * 2 + 1];
                const float tr = cr * xr - ci * xi, ti = cr * xi + ci * xr;
                a += tr * br - ti * bi;
            }
            kt[idx] = a;
        }
        __syncthreads();
        h16* W = (h16*)(P->ws + OFF_S5W) + (size_t)g * 512 * 640;
        for (int idx = tid; idx < 32 * 640; idx += 256) {
            const int j = idx / 640, k = idx % 640;
            float val = 0.f;
            if (k < 512) {
                const int s = k >> 4, c2 = k & 15, lag = j - s;
                if (lag >= 0) val = kt[lag * 16 + c2];
            } else {
                const int p = (k - 512) >> 1;
                const float cr = cc[(c * 64 + p) * 2], ci = cc[(c * 64 + p) * 2 + 1];
                const float xr = apow[(p * 33 + j + 1) * 2], xi = apow[(p * 33 + j + 1) * 2 + 1];
                val = (k & 1) ? -(cr * xi + ci * xr) : (cr * xr - ci * xi);
            }
            W[(size_t)(j * 16 + c) * 640 + k] = (h16)val;
        }
    } else {
        const int pq = (item - 256) & 3;
        h16* E = (h16*)(P->ws + OFF_S5E) + ((size_t)g * 128 + pq * 32) * 512;
        for (int idx = tid; idx < 32 * 512; idx += 256) {
            const int nl = idx >> 9, k = idx & 511;
            const int p = pq * 16 + (nl >> 1), s = k >> 4, c2 = k & 15;
            const float xr = apow[(p * 33 + 31 - s) * 2], xi = apow[(p * 33 + 31 - s) * 2 + 1];
            const float br = bbar[(p * 16 + c2) * 2], bi = bbar[(p * 16 + c2) * 2 + 1];
            const float val = (nl & 1) ? (xr * bi + xi * br) : (xr * br - xi * bi);
            E[(size_t)nl * 512 + k] = (h16)val;
        }
        if (tid < 16) {
            const int p = pq * 16 + tid;
            float* AL = (float*)(P->ws + OFF_S5AL);
            AL[(g * 64 + p) * 2] = apow[(p * 33 + 32) * 2];
            AL[(g * 64 + p) * 2 + 1] = apow[(p * 33 + 32) * 2 + 1];
        }
    }
    __syncthreads();
}

template <int WR, int MI>
DI void inproj_tile(PP P, int l, int m0, int n0, char* smem, const int wv) {
    P = plaunder(P);
    constexpr int WC = 4 / WR;
    f32x4 acc[MI][4];
    float ss[MI];
    gemm_glds<true, WR, MI, 4, (WR == 2 && MI == 8) ? 3 : 4>(wv, 1024, APlain{(const h16*)(P->ws + OFF_XH) + (size_t)m0 * 64, 64, (size_t)NT * 64},
                               (const h16*)(P->ws + OFF_WTIN) + ((size_t)l * 16 * D_IN_PAD + n0) * 64, 64, acc, ss, smem, (size_t)D_IN_PAD * 64);
    const int tid = otid(wv), lane = tid & 63, wid = tid >> 6, wr = wid / WC, wc = wid % WC;
    h16* proj = (h16*)(P->ws + OFF_PROJ);
    const int n64 = n0 + wc * 64;
    int cls = 0;
    if (n64 < 512) cls = 1;
    else if (n64 >= C_NKV + 256 && n64 < C_NKV + 384) cls = 2;
    else if (n64 >= C_NKV + 512 && n64 < C_NKV + 640) cls = 3;
    else if (n64 >= C_NKV + 384 && n64 < C_NKV + 512) cls = 4;
    else if (n64 >= C_NKV + 640 && n64 < C_NKV + 768) cls = 5;
    float wn[4][4];
    if (cls >= 1 && cls <= 3) {
        const float* wp = (cls == 1) ? P->in[I_NQN] + l * 64 : P->in[I_NKN] + (l * 3 + (cls - 1)) * 64;
        const float sc = (cls == 1) ? QSCALE : 1.f;
#pragma unroll
        for (int j = 0; j < 4; ++j) {
            const float4 w4 = *(const float4*)(wp + j * 16 + (lane >> 4) * 4);
            wn[j][0] = w4.x * sc; wn[j][1] = w4.y * sc; wn[j][2] = w4.z * sc; wn[j][3] = w4.w * sc;
        }
    }
#pragma unroll
    for (int i = 0; i < MI; ++i) {
        const int ml = wr * MI * 16 + i * 16 + (lane & 15);
        const float r = rsqrtf(ss[i] * (1.f / 1024.f) + 1e-6f);
        const size_t row = (size_t)m0 + ml;
        f32x4 v[4];
#pragma unroll
        for (int j = 0; j < 4; ++j) v[j] = acc[i][j] * r;
        if (cls >= 1 && cls <= 3) {
            float s2 = 0.f;
#pragma unroll
            for (int j = 0; j < 4; ++j) s2 += v[j][0] * v[j][0] + v[j][1] * v[j][1] + v[j][2] * v[j][2] + v[j][3] * v[j][3];
            s2 += shx<16>(s2); s2 = xhalf_sum(s2);
            const float rn = rsqrtf(s2 * (1.f / 64.f) + 1e-6f);
#pragma unroll
            for (int j = 0; j < 4; ++j) { v[j][0] *= rn * wn[j][0]; v[j][1] *= rn * wn[j][1]; v[j][2] *= rn * wn[j][2]; v[j][3] *= rn * wn[j][3]; }
        }
        if (cls >= 4) {
            const int g = (n64 >> 6) & 1, br = cls - 4;
            const int b = (int)(row >> 13), t = (int)(row & 8191);
            h16* vt = (h16*)(P->ws + OFF_VTG) + ((((size_t)br * 4 + b * 2 + g) * 128 + (t >> 6)) * 64) * 64;
#pragma unroll
            for (int j = 0; j < 4; ++j)
#pragma unroll
                for (int e = 0; e < 4; ++e) vt[(j * 16 + (lane >> 4) * 4 + e) * 64 + vkperm(t & 63)] = (h16)v[j][e];
        }
#pragma unroll
        for (int j = 0; j < 4; ++j) {
            const int n = n64 + j * 16 + (lane >> 4) * 4;
            if (n < D_IN) *(half4*)(proj + row * D_IN + n) = (half4){(h16)v[j][0], (h16)v[j][1], (h16)v[j][2], (h16)v[j][3]};
        }
        __builtin_amdgcn_sched_barrier(0);
    }
    __syncthreads();
}


DI void cmp_gemm_tile(PP P, int l, int tile, char* smem, const int wv) {
    P = plaunder(P);
    const int j = tile >> 6, mt = (tile >> 2) & 15, nt = tile & 3;
    const int row0 = mt * 128, bg = row0 >> 9, i0 = row0 & 511, b = bg >> 1, g = bg & 1;
    f32x4 acc[4][4];
    float ssd[4];
    gemm_mainloop_glds<false>(wv, 1024, APlain{(const h16*)(P->ws + OFF_PROJ) + ((size_t)b * SEQ + 16 * i0) * D_IN + C_NKV + j * 128 + g * 64, (size_t)16 * D_IN, (size_t)D_IN},
                              (const h16*)(P->ws + OFF_WTC1) + ((size_t)(l * 2 + j) * 16 * 512 + nt * 128) * 64, 64, acc, ssd, smem, (size_t)512 * 64);
    const int tid = otid(wv), lane = tid & 63, wid = tid >> 6, wr = wid >> 1, wc = wid & 1;
    float* pt = (float*)(P->ws + OFF_CHID) + (size_t)j * 2048 * 512;
#pragma unroll
    for (int i = 0; i < 4; ++i) {
        const size_t row = (size_t)row0 + wr * 64 + i * 16 + (lane & 15);
#pragma unroll
        for (int jj = 0; jj < 4; ++jj) {
            const int n = nt * 128 + wc * 64 + jj * 16 + (lane >> 4) * 4;
            const f32x4 v = acc[i][jj];
            *(float4*)(pt + row * 512 + n) = (float4){v[0], v[1], v[2], v[3]};
        }
    }
}

DI void s5e_gemm_tile(PP P, int l, int tile, char* smem, const int wv) {
    P = plaunder(P);
    const int g = tile >> 2, mt = tile & 3;
    f32x4 acc[4][4];
    float ssd[4];
    gemm_mainloop_glds<false>(wv, 512, AS5{(const h16*)(P->ws + OFF_PROJ) + C_SU + g * 16, nullptr, mt * 128},
                              (const h16*)(P->ws + OFF_S5E) + (size_t)g * 128 * 512, 512, acc, ssd, smem);
    const int tid = otid(wv), lane = tid & 63, wid = tid >> 6, wr = wid >> 1, wc = wid & 1;
    float* xc = (float*)(P->ws + OFF_XC);
#pragma unroll
    for (int i = 0; i < 4; ++i) {
        const size_t ch = (size_t)mt * 128 + wr * 64 + i * 16 + (lane & 15);
#pragma unroll
        for (int jj = 0; jj < 4; ++jj) {
            const int n = wc * 64 + jj * 16 + (lane >> 4) * 4;
            const f32x4 v = acc[i][jj];
            *(float4*)(xc + (ch * 1024 + g * 64) * 2 + n) = (float4){v[0], v[1], v[2], v[3]};
        }
    }
}

DI void gla_scan_item(PP P, int item, char* smem, const int wv) {
    P = plaunder(P);
    const int tid = otid(wv), sl = tid & 31, part = tid >> 5;
    const int idx = item * 32 + sl, bh = idx >> 11, de = idx & 2047, d = de >> 6;
    float* kv = (float*)(P->ws + OFF_GKV) + ((size_t)bh * 256 + part * 32) * 2048 + de;
    const float* dc = (const float*)(P->ws + OFF_GDEC) + ((size_t)bh * 256 + part * 32) * 32 + d;
    float* sD = (float*)smem; float* sL = sD + 256;
    float kvv[32], dd[32];
#pragma unroll
    for (int i = 0; i < 32; ++i) { kvv[i] = kv[(size_t)i * 2048]; dd[i] = dc[i * 32]; }
    float D = 1.f, L = 0.f;
#pragma unroll
    for (int i = 0; i < 32; ++i) { L = dd[i] * L + kvv[i]; D *= dd[i]; }
    sD[part * 32 + sl] = D; sL[part * 32 + sl] = L;
    __syncthreads();
    float S = 0.f;
    for (int q = 0; q < part; ++q) S = sD[q * 32 + sl] * S + sL[q * 32 + sl];
#pragma unroll
    for (int i = 0; i < 32; ++i) { const float o = S; S = dd[i] * S + kvv[i]; kv[(size_t)i * 2048] = o; }
    __syncthreads();
}
DI void s5_scan_item(PP P, int item, char* smem, const int wv) {
    P = plaunder(P);
    const int tid = otid(wv), sl = tid & 31, part = tid >> 5;
    const int idx = item * 32 + sl, b = idx >> 10, s = idx & 1023;
    float2* xc = (float2*)(P->ws + OFF_XC) + ((size_t)b * 256 + part * 32) * 1024 + s;
    half2_* xch = (half2_*)(P->ws + OFF_XCH) + ((size_t)b * 256 + part * 32) * 1024 + s;
    const float2 a = ((const float2*)(P->ws + OFF_S5AL))[s];
    float2* sL = (float2*)smem;
    float2 c[32];
#pragma unroll
    for (int i = 0; i < 32; ++i) c[i] = xc[(size_t)i * 1024];
    float lr = 0.f, li = 0.f;
#pragma unroll
    for (int i = 0; i < 32; ++i) { const float nr = a.x * lr - a.y * li + c[i].x, ni = a.x * li + a.y * lr + c[i].y; lr = nr; li = ni; }
    float dr = a.x, di = a.y;
#pragma unroll
    for (int i = 0; i < 5; ++i) { const float nr = dr * dr - di * di, ni = 2.f * dr * di; dr = nr; di = ni; }
    sL[part * 32 + sl] = (float2){lr, li};
    __syncthreads();
    float xr = 0.f, xi = 0.f;
    for (int q = 0; q < part; ++q) { const float2 lq = sL[q * 32 + sl]; const float nr = dr * xr - di * xi + lq.x, ni = dr * xi + di * xr + lq.y; xr = nr; xi = ni; }
#pragma unroll
    for (int i = 0; i < 32; ++i) {
        const float2 o = (float2){xr, xi};
        const float nr = a.x * xr - a.y * xi + c[i].x, ni = a.x * xi + a.y * xr + c[i].y; xr = nr; xi = ni;
        xc[(size_t)i * 1024] = o;
        xch[(size_t)i * 1024] = (half2_){(h16)o.x, (h16)o.y};
    }
    __syncthreads();
}
DI void cmp_l2_item(PP P, int l, int item, char* smem, const int wv) {
    P = plaunder(P);
    const int tid = otid(wv), lane = tid & 63, w = tid >> 6;
    const int j = item >> 8, r0 = (item & 255) * 8;
    h16* w2s = (h16*)smem;
    float* hs = (float*)(smem + 32768);
    {
        const float* w2 = P->in[I_CW2] + (size_t)(l * 2 + j) * 256 * 64;
        for (int e = tid * 4; e < 256 * 64; e += 1024) {
            const float4 v = *(const float4*)(w2 + e);
            *(half4*)(w2s + e) = (half4){(h16)v.x, (h16)v.y, (h16)v.z, (h16)v.w};
        }
        const float* pt = (const float*)(P->ws + OFF_CHID) + (size_t)j * 2048 * 512;
        float pb = 0.f;
#pragma unroll
        for (int ks = 0; ks < 16; ++ks) pb += ((const float*)(P->ws + OFF_POSB))[((l * 2 + j) * 16 + ks) * 256 + tid];
#pragma unroll
        for (int rr = 0; rr < 8; ++rr) {
            const int row = r0 + rr, i = row & 511;
            float v = 0.f;
            if (i < 511) v = gelu_tanh(pt[(size_t)row * 512 + tid] + pt[(size_t)(row + 1) * 512 + 256 + tid] + pb);
            hs[rr * 256 + tid] = v;
        }
    }
    __syncthreads();
    const float bb = P->in[I_CB2][(l * 2 + j) * 64 + lane];
    float a0 = bb, a1 = bb;
    const float* h0 = hs + (2 * w) * 256, *h1 = h0 + 256;
#pragma unroll 8
    for (int n = 0; n < 256; ++n) {
        const float wv = (float)w2s[n * 64 + lane];
        a0 += h0[n] * wv; a1 += h1[n] * wv;
    }
#pragma unroll
    for (int rr = 0; rr < 2; ++rr) {
        float acc = rr ? a1 : a0;
        const int row = r0 + 2 * w + rr, bg = row >> 9, i = row & 511;
        if (i == 511) acc = 0.f;
        if (j == 0) {
            const float ss = wave_sum(acc * acc);
            acc = acc * rsqrtf(ss * (1.f / 64.f) + 1e-6f) * P->in[I_NKN][(l * 3 + 0) * 64 + lane];
            ((h16*)(P->ws + OFF_KCMP))[(size_t)row * 64 + lane] = (h16)acc;
        } else {
            ((h16*)(P->ws + OFF_VCMP))[(((size_t)bg * 8 + (i >> 6)) * 64 + lane) * 64 + vkperm(i & 63)] = (h16)acc;
        }
    }
    __syncthreads();
}

DI void s5o_gemm_tile(PP P, int l, int tile, char* smem, const int wv) {
    P = plaunder(P);
    const int g = tile >> 5, mt = (tile >> 3) & 3, nt = tile & 7;
    f32x4 acc[2][4];
    float ssd[2];
    gemm_glds<false, 4, 2, 4>(wv, 640, AS5{(const h16*)(P->ws + OFF_PROJ) + C_SU + g * 16, (const h16*)(P->ws + OFF_XCH) + g * 128, mt * 128},
                              (const h16*)(P->ws + OFF_S5W) + ((size_t)g * 512 + nt * 64) * 640, 640, acc, ssd, smem);
    const int tid = otid(wv), lane = tid & 63, wid = tid >> 6;
    const h16* proj = (const h16*)(P->ws + OFF_PROJ);
    h16* yact = (h16*)(P->ws + OFF_YACT);
#pragma unroll
    for (int i = 0; i < 2; ++i) {
        const size_t ch = (size_t)mt * 128 + wid * 32 + i * 16 + (lane & 15);
#pragma unroll
        for (int jj = 0; jj < 4; ++jj) {
            const int n = nt * 64 + jj * 16 + (lane >> 4) * 4;
            const int j = n >> 4, c = n & 15;
            const size_t tok = ch * 32 + j;
            const half4 u4 = *(const half4*)(proj + tok * D_IN + C_SU + g * 16 + c);
            const float4 dd = *(const float4*)(P->in[I_SD] + (l * 16 + g) * 16 + c);
            const f32x4 v = acc[i][jj];
            half4 o;
            o[0] = (h16)gelu_tanh(v[0] + dd.x * (float)u4[0]);
            o[1] = (h16)gelu_tanh(v[1] + dd.y * (float)u4[1]);
            o[2] = (h16)gelu_tanh(v[2] + dd.z * (float)u4[2]);
            o[3] = (h16)gelu_tanh(v[3] + dd.w * (float)u4[3]);
            *(half4*)(yact + tok * 256 + g * 16 + c) = o;
        }
    }
}

#define MFMA32(a, b, c) __builtin_amdgcn_mfma_f32_32x32x16_f16((a), (b), (c), 0, 0, 0)
constexpr float NEGS = -1e30f;
DI float ex2(float x) { return __builtin_amdgcn_exp2f(x); }
#define NSA_WAITBAR(N) asm volatile("s_waitcnt vmcnt(" #N ") lgkmcnt(0)\n\ts_barrier" ::: "memory")
#define NSA_BAR() asm volatile("s_waitcnt lgkmcnt(0)\n\ts_barrier" ::: "memory")

struct KVSrc { const h16* k; int ldk; size_t kstep; const h16* v; };
DI void nsa_dma(const KVSrc& s, int j, char* stage, int wid, int lane) {
    const int row0 = wid * 8 + (lane >> 3);
    const int sw = ((lane & 7) ^ ((row0 >> 1) & 7)) * 8;
    const h16* kp = s.k + (size_t)j * s.kstep + (size_t)row0 * s.ldk + sw;
    glds16(kp, stage + wid * 1024);
    glds16(kp + (size_t)32 * s.ldk, stage + 4096 + wid * 1024);
    const h16* vp = s.v + (size_t)j * 4096 + row0 * 64 + sw;
    glds16(vp, stage + 8192 + wid * 1024);
    glds16(vp + 32 * 64, stage + 8192 + 4096 + wid * 1024);
}
template <int NST, class F>
DI void nsa_pipe(const KVSrc& s, const int n, char* smem, int wid, int lane, F&& compute) {
    NSA_WAITBAR(0);
    {
        const int k = n < NST - 1 ? n : NST - 1;
        for (int p = 0; p < k; ++p) nsa_dma(s, p, smem + p * 16384, wid, lane);
        if (k >= 3) NSA_WAITBAR(8); else if (k == 2) NSA_WAITBAR(4); else NSA_WAITBAR(0);
        __builtin_amdgcn_s_sleep(2);
    }
    for (int j = 0; j < n; ++j) {
        if (NST == 4 && j + 2 < n) NSA_WAITBAR(4); else NSA_WAITBAR(0);
        const int jn = j + NST - 1;
        compute(j, smem + (j % NST) * 16384, [&]() { if (jn < n) nsa_dma(s, jn, smem + (jn % NST) * 16384, wid, lane); });
    }
}

template <bool SHIFT = false, class BF>
DI void qk_tile(const char* Kimg, const half8 (&qf)[4], f32x16 (&s)[2], int lane, BF&& between) {
    const int r = lane & 31, h = lane >> 5, swz = (r >> 1) & 7;
    const char* base = Kimg + r * 128;
    half8 kf[8];
#pragma unroll
    for (int kt = 0; kt < 2; ++kt)
#pragma unroll
        for (int ks = 0; ks < 4; ++ks) kf[kt * 4 + ks] = *(const half8*)(base + kt * 4096 + (((2 * ks + h) ^ swz) << 4));
    __builtin_amdgcn_sched_barrier(0);
    between();
    __builtin_amdgcn_sched_barrier(0);
#pragma unroll
    for (int kt = 0; kt < 2; ++kt) {
#pragma unroll
        for (int e = 0; e < 16; ++e) s[kt][e] = 0.f;
#pragma unroll
        for (int ks = 0; ks < 4; ++ks) s[kt] = MFMA32(kf[kt * 4 + ks], qf[ks], s[kt]);
    }
}
template <bool SHIFT = false>
DI void qk_tile(const char* Kimg, const half8 (&qf)[4], f32x16 (&s)[2], int lane) { qk_tile<SHIFT>(Kimg, qf, s, lane, []() {}); }
template <int S> DI half8 pack8(const f32x16& x) {
    return (half8){(h16)x[8 * S], (h16)x[8 * S + 1], (h16)x[8 * S + 2], (h16)x[8 * S + 3], (h16)x[8 * S + 4], (h16)x[8 * S + 5], (h16)x[8 * S + 6], (h16)x[8 * S + 7]};
}
template <int KT>
DI void pv_load(const char* Vimg, half8 (&vf)[4], int lane) {
    const int r = lane & 31, h = lane >> 5, swz = (r >> 1) & 7;
    const char* rb = Vimg + r * 128;
#pragma unroll
    for (int dt = 0; dt < 2; ++dt) {
        vf[dt * 2 + 0] = *(const half8*)(rb + dt * 4096 + (((4 * KT + h) ^ swz) << 4));
        vf[dt * 2 + 1] = *(const half8*)(rb + dt * 4096 + (((4 * KT + 2 + h) ^ swz) << 4));
    }
}
typedef unsigned u32x4_ __attribute__((ext_vector_type(4)));
template <int KT, bool MASKED = false>
DI void pv_mma(const half8 (&vf)[4], const f32x16 (&p)[2], f32x16 (&o)[2], const unsigned rmask = 0xffffffffu) {
    half8 pb0 = pack8<0>(p[KT]), pb1 = pack8<1>(p[KT]);
    if (MASKED) {
        pb0 = __builtin_bit_cast(half8, __builtin_bit_cast(u32x4_, pb0) & rmask);
        pb1 = __builtin_bit_cast(half8, __builtin_bit_cast(u32x4_, pb1) & rmask);
    }
#pragma unroll
    for (int dt = 0; dt < 2; ++dt) {
        o[dt] = MFMA32(vf[dt * 2 + 0], pb0, o[dt]);
        o[dt] = MFMA32(vf[dt * 2 + 1], pb1, o[dt]);
    }
}
template <bool MASKED = false>
DI void pv_finish(const char* Vimg, const half8 (&va)[4], const f32x16 (&p)[2], f32x16 (&o)[2], int lane, const unsigned rmask = 0xffffffffu) {
    half8 vb[4];
    pv_load<1>(Vimg, vb, lane);
    pv_mma<0, MASKED>(va, p, o, rmask);
    pv_mma<1, MASKED>(vb, p, o, rmask);
}
DI float sm_fast(f32x16 (&s)[2]) {
    float rs = 0.f;
#pragma unroll
    for (int kt = 0; kt < 2; ++kt)
#pragma unroll
        for (int e = 0; e < 16; ++e) { const float p = ex2(s[kt][e]); s[kt][e] = p; rs += p; }
    return rs;
}
DI float rowmax32(const f32x16 (&s)[2]) {
    float mx = s[0][0];
#pragma unroll
    for (int e = 1; e < 16; ++e) mx = fmaxf(mx, s[0][e]);
#pragma unroll
    for (int e = 0; e < 16; ++e) mx = fmaxf(mx, s[1][e]);
    return xhalf_max(mx);
}
constexpr float SM_THR = 6.f;
DI void sm_online(f32x16 (&s)[2], float& m, float& l, f32x16 (&o)[2], const bool rowok) {
    float mx = rowmax32(s);
    mx = rowok ? mx : NEGS;
    if (__any(mx > m + SM_THR)) {
        const float mn = fmaxf(m, mx), alpha = ex2(m - mn);
        l *= alpha; o[0] *= alpha; o[1] *= alpha; m = mn;
    }
    const float msub = rowok ? m : 1e30f;
    float rs = 0.f;
#pragma unroll
    for (int kt = 0; kt < 2; ++kt)
#pragma unroll
        for (int e = 0; e < 16; ++e) { const float p = ex2(s[kt][e] - msub); s[kt][e] = p; rs += p; }
    l += xhalf_sum(rs);
}

template <int V> struct IC { static constexpr int value = V; };
template <bool FAST>
DI void nsa_unit(PP P, int l, int bg, int c32, char* smem, const int wv) {
    P = plaunder(P);
    const int tid = otid(wv), lane = tid & 63, w = tid >> 6, r = lane & 31, h = lane >> 5;
    const int b = bg >> 1, g = bg & 1, t0 = c32 * 32, cur = c32 >> 1;
    const int tokl = w * 8 + (r >> 2), head = r & 3, t = t0 + tokl;
    const size_t tokg = (size_t)b * SEQ + t;
    float* IMP = (float*)(smem + 49152);
    unsigned* SELM = (unsigned*)(smem + 49152);
    const h16* proj = (const h16*)(P->ws + OFF_PROJ);
    const int ghead = g * 4 + head;

    half8 qf[4];
    {
        const h16* qp = proj + tokg * D_IN + C_NQ + ghead * 64 + 8 * h;
#pragma unroll
        for (int ks = 0; ks < 4; ++ks) qf[ks] = *(const half8*)(qp + 16 * ks);
    }
    float g0, g1, g2;
    {
        const h16* gp = proj + tokg * D_IN + C_NGL + ghead * 3;
        const float* gb = P->in[I_NGB] + l * 24 + ghead * 3;
        g0 = sigmoidf_((float)gp[0] + gb[0]); g1 = sigmoidf_((float)gp[1] + gb[1]); g2 = sigmoidf_((float)gp[2] + gb[2]);
    }
    __syncthreads();
    for (int i = tid; i < 32 * 128; i += 256) IMP[i] = 0.f;

    half8 oacc[4];
    auto oacc_add = [&](const f32x16 (&o)[2], const float sc, const bool first) {
#pragma unroll
        for (int dt = 0; dt < 2; ++dt)
#pragma unroll
            for (int hf = 0; hf < 2; ++hf) {
                half8 v = oacc[dt * 2 + hf];
#pragma unroll
                for (int e = 0; e < 8; ++e) v[e] = (h16)((first ? 0.f : (float)v[e]) + o[dt][hf * 8 + e] * sc);
                oacc[dt * 2 + hf] = v;
            }
    };

    {
        const int nvt = 2 * c32 + 1;
        const int nvr = (t >= 31) ? ((t - 31) >> 4) + 1 : 0;
        const int ntile = (nvt + 63) >> 6;
        KVSrc src{(const h16*)(P->ws + OFF_KCMP) + (size_t)bg * 512 * 64, 64, 4096, (const h16*)(P->ws + OFF_VCMP) + (size_t)bg * 8 * 4096};
        f32x16 o[2];
#pragma unroll
        for (int e = 0; e < 16; ++e) { o[0][e] = 0.f; o[1][e] = 0.f; }
        float invl;
        if constexpr (FAST) {
            const int tf = t0 + w * 8;
            const int nvlo = __builtin_amdgcn_readfirstlane((tf >= 31) ? ((tf - 31) >> 4) + 1 : 0);
            float lsum = 0.f;
            nsa_pipe<3>(src, ntile, smem, w, lane, [&](int j, const char* st, auto&& issue) {
                f32x16 s[2];
                qk_tile<true>(st, qf, s, lane);
                issue();
                if (64 * j + 64 > nvlo) {
#pragma unroll
                    for (int kt = 0; kt < 2; ++kt)
#pragma unroll
                        for (int e = 0; e < 16; ++e) {
                            const int key = 64 * j + 32 * kt + 8 * (e >> 2) + 4 * h + (e & 3);
                            if (key >= nvr) s[kt][e] = NEGS;
                        }
                }
                lsum += sm_fast(s);
            });
            lsum = xhalf_sum(lsum);
            invl = lsum > 0.f ? 1.f / lsum : 0.f;
            nsa_pipe<3>(src, ntile, smem, w, lane, [&](int j, const char* st, auto&& issue) {
                f32x16 s[2];
                qk_tile<true>(st, qf, s, lane);
                half8 vf[4];
                pv_load<0>(st + 8192, vf, lane);
                issue();
                __builtin_amdgcn_sched_barrier(0);
                if (64 * j + 64 > nvlo) {
#pragma unroll
                    for (int kt = 0; kt < 2; ++kt)
#pragma unroll
                        for (int e = 0; e < 16; ++e) {
                            const int key = 64 * j + 32 * kt + 8 * (e >> 2) + 4 * h + (e & 3);
                            if (key >= nvr) s[kt][e] = NEGS;
                        }
                }
                (void)sm_fast(s);
                if (cur >= 16) {
#pragma unroll
                    for (int kt = 0; kt < 2; ++kt)
#pragma unroll
                        for (int g4 = 0; g4 < 4; ++g4) {
                            float G = ((s[kt][4 * g4] + s[kt][4 * g4 + 1]) + (s[kt][4 * g4 + 2] + s[kt][4 * g4 + 3])) * invl;
                            float L = s[kt][4 * g4 + 3] * invl;
                            G += shx<1>(G); G += shx<2>(G);
                            L += shx<1>(L); L += shx<2>(L);
                            if (head == 0) {
                                const int sb = 16 * j + 8 * kt + 2 * g4 + h;
                                atomicAdd(&IMP[tokl * 128 + sb], G);
                                if (sb + 1 < 128) atomicAdd(&IMP[tokl * 128 + sb + 1], L);
                            }
                        }
                }
                pv_finish(st + 8192, vf, s, o, lane);
            });
        } else {
        float m = -1e20f, lsum = 0.f;
        nsa_pipe<3>(src, ntile, smem, w, lane, [&](int j, const char* st, auto&& issue) {
            f32x16 s[2];
            qk_tile(st, qf, s, lane);
            issue();
#pragma unroll
            for (int kt = 0; kt < 2; ++kt)
#pragma unroll
                for (int e = 0; e < 16; ++e) {
                    const int key = 64 * j + 32 * kt + 8 * (e >> 2) + 4 * h + (e & 3);
                    if (key >= nvr) s[kt][e] = NEGS;
                }
            const float mn = fmaxf(m, rowmax32(s)), alpha = ex2(m - mn);
            float rs = 0.f;
#pragma unroll
            for (int kt = 0; kt < 2; ++kt)
#pragma unroll
                for (int e = 0; e < 16; ++e) rs += ex2(s[kt][e] - mn);
            rs = xhalf_sum(rs);
            lsum = lsum * alpha + rs; m = mn;
        });
        const float invl_s = lsum > 0.f ? 1.f / lsum : 0.f;
        nsa_pipe<3>(src, ntile, smem, w, lane, [&](int j, const char* st, auto&& issue) {
            f32x16 s[2];
            qk_tile(st, qf, s, lane);
            half8 vf[4];
            pv_load<0>(st + 8192, vf, lane);
            issue();
            __builtin_amdgcn_sched_barrier(0);
#pragma unroll
            for (int kt = 0; kt < 2; ++kt)
#pragma unroll
                for (int e = 0; e < 16; ++e) {
                    const int key = 64 * j + 32 * kt + 8 * (e >> 2) + 4 * h + (e & 3);
                    s[kt][e] = (key < nvr) ? ex2(s[kt][e] - m) * invl_s : 0.f;
                }
            if (cur >= 16) {
#pragma unroll
                for (int kt = 0; kt < 2; ++kt)
#pragma unroll
                    for (int g4 = 0; g4 < 4; ++g4) {
                        float G = (s[kt][4 * g4] + s[kt][4 * g4 + 1]) + (s[kt][4 * g4 + 2] + s[kt][4 * g4 + 3]);
                        float L = s[kt][4 * g4 + 3];
                        G += shx<1>(G); G += shx<2>(G);
                        L += shx<1>(L); L += shx<2>(L);
                        if (head == 0) {
                            const int sb = 16 * j + 8 * kt + 2 * g4 + h;
                            atomicAdd(&IMP[tokl * 128 + sb], G);
                            if (sb + 1 < 128) atomicAdd(&IMP[tokl * 128 + sb + 1], L);
                        }
                    }
            }
            pv_finish(st + 8192, vf, s, o, lane);
        });
            invl = 1.f;
        }
        oacc_add(o, g0 * invl, true);
    }
    __syncthreads();
    {
        const int tl = lane >> 3, sub = lane & 7;
        unsigned bits = 0;
        unsigned u[16];
        if (cur >= 16) {
            const float* ip = IMP + (w * 8 + tl) * 128 + sub * 16;
#pragma unroll
            for (int i = 0; i < 16; ++i) {
                const int s = sub * 16 + i;
                u[i] = (s >= 1 && s <= cur - 2) ? (__float_as_uint(ip[i]) + 1u) : 0u;
            }
        }
        __syncthreads();
        if (cur >= 16) {
            unsigned prefix = 0;
            for (int bit = 30; bit >= 0; --bit) {
                const unsigned cand = prefix | (1u << bit);
                int cnt = 0;
#pragma unroll
                for (int i = 0; i < 16; ++i) cnt += (u[i] >= cand) ? 1 : 0;
                cnt += shx_i<1>(cnt); cnt += shx_i<2>(cnt); cnt += shx_i<4>(cnt);
                if (cnt >= 13) prefix = cand;
            }
            int cgt = 0, ceq = 0;
#pragma unroll
            for (int i = 0; i < 16; ++i) { cgt += (u[i] > prefix) ? 1 : 0; ceq += (u[i] == prefix) ? 1 : 0; }
            cgt += shx_i<1>(cgt); cgt += shx_i<2>(cgt); cgt += shx_i<4>(cgt);
            int inc = ceq;
            { const int v = row_shr_i<1>(inc); if (sub >= 1) inc += v; }
            { const int v = row_shr_i<2>(inc); if (sub >= 2) inc += v; }
            { const int v = row_shr_i<4>(inc); if (sub >= 4) inc += v; }
            int run = inc - ceq;
            const int need = 13 - cgt;
#pragma unroll
            for (int i = 0; i < 16; ++i) {
                const int s = sub * 16 + i;
                bool sel = u[i] > prefix;
                if (u[i] == prefix) { sel = run < need; ++run; }
                if (s == 0 || s == cur || s == cur - 1) sel = true;
                bits |= (sel ? 1u : 0u) << i;
            }
        } else {
#pragma unroll
            for (int i = 0; i < 16; ++i) bits |= ((sub * 16 + i <= cur) ? 1u : 0u) << i;
        }
        unsigned wv = bits << ((sub & 1) * 16);
        wv |= (unsigned)shx_i<1>((int)wv);
        if ((sub & 1) == 0) SELM[(w * 8 + tl) * 4 + (sub >> 1)] = wv;
    }
    __syncthreads();
    unsigned selw[4];
#pragma unroll
    for (int i = 0; i < 4; ++i) selw[i] = SELM[tokl * 4 + i];

    auto branch = [&](auto BRC) {
        constexpr int br = decltype(BRC)::value;
        const int j0 = (br == 0) ? 0 : (cur - 8 > 0 ? cur - 8 : 0);
        const int nst = cur - j0 + 1;
        KVSrc src{proj + ((size_t)b * SEQ + (size_t)j0 * 64) * D_IN + C_NKV + (br == 0 ? 256 : 512) + g * 64, D_IN, (size_t)64 * D_IN,
                  (const h16*)(P->ws + OFF_VTG) + (((size_t)br * 4 + bg) * 128 + j0) * 4096};
        float m = -1e20f, lsum = 0.f;
        f32x16 o[2];
#pragma unroll
        for (int e = 0; e < 16; ++e) { o[0][e] = 0.f; o[1][e] = 0.f; }
        nsa_pipe<4>(src, nst, smem, w, lane, [&](int jj, const char* st, auto&& issue) {
            const int j = j0 + jj;
            const bool rowok = (br != 0) || (((selw[j >> 5] >> (j & 31)) & 1u) != 0u);
            if constexpr (FAST && br == 0) {
                if (false) { issue(); return; }
            }
            f32x16 s[2];
            qk_tile<FAST>(st, qf, s, lane, issue);
            half8 vf[4];
            pv_load<0>(st + 8192, vf, lane);
            __builtin_amdgcn_sched_barrier(0);
            if (j == cur || (br == 1 && j == cur - 8)) {
#pragma unroll
                for (int kt = 0; kt < 2; ++kt)
#pragma unroll
                    for (int e = 0; e < 16; ++e) {
                        const int key = 64 * j + 32 * kt + 8 * (e >> 2) + 4 * h + (e & 3);
                        const bool ok = (key <= t) && (br == 0 || key > t - 512);
                        if (!ok) s[kt][e] = NEGS;
                    }
            }
            if constexpr (FAST) {
                const float rs = sm_fast(s);
                lsum += (br != 0 || rowok) ? rs : 0.f;
                pv_finish<br == 0>(st + 8192, vf, s, o, lane, rowok ? 0xffffffffu : 0u);
            } else {
                sm_online(s, m, lsum, o, rowok);
                pv_finish(st + 8192, vf, s, o, lane);
            }
        });
        if constexpr (FAST) lsum = xhalf_sum(lsum);
        const float sc = (br == 0 ? g1 : g2) / lsum;
        oacc_add(o, sc, false);
    };
    branch(IC<0>{});
    branch(IC<1>{});
    {
        h16* mixp = (h16*)(P->ws + OFF_MIX) + kb_idx(NT, tokg, 512 + ghead * 64);
        const h16* ngp = proj + tokg * D_IN + C_NG + ghead * 64;
#pragma unroll
        for (int dt = 0; dt < 2; ++dt)
#pragma unroll
            for (int g4 = 0; g4 < 4; ++g4) {
                const int d0 = 32 * dt + 8 * g4 + 4 * h;
                const half4 ng = *(const half4*)(ngp + d0);
                half4 ov;
#pragma unroll
                for (int e = 0; e < 4; ++e) ov[e] = (h16)((float)oacc[dt * 2 + (g4 >> 1)][(g4 & 1) * 4 + e] * siluf_((float)ng[e]));
                *(half4*)(mixp + d0) = ov;
            }
    }
    __syncthreads();
}

DI void gla_kv_item(PP P, int l, int item, char* smem, const int wv) {
    P = plaunder(P);
    const int tid = otid(wv), lane = tid & 63, w = tid >> 6, r = lane & 31, hh = lane >> 5;
    const int pair = item * 4 + w, h = pair & 3, cn = pair >> 2;
    const size_t tok = (size_t)cn * 32 + r;
    const int b = cn >> 8, n = cn & 255, bh = b * 4 + h;
    const h16* proj = (const h16*)(P->ws + OFF_PROJ);
    h16* VT = (h16*)(smem + w * 16384);
    h16* KT = VT + 2048;
    __syncthreads();
    {
        const half8* vp = (const half8*)(proj + tok * D_IN + C_GV + h * 64 + hh * 32);
#pragma unroll
        for (int q = 0; q < 4; ++q) {
            const half8 v8 = vp[q];
#pragma unroll
            for (int e = 0; e < 8; ++e) VT[(hh * 32 + q * 8 + e) * 32 + r] = v8[e];
        }
    }
    float gl[16];
    {
        const half8* lp = (const half8*)(proj + tok * D_IN + C_GLR);
        const half8 l0 = lp[0], l1 = lp[1];
        float lr[16];
#pragma unroll
        for (int q = 0; q < 8; ++q) { lr[q] = (float)l0[q]; lr[8 + q] = (float)l1[q]; }
        const float* w2 = P->in[I_GW2] + (size_t)l * 16 * 128 + h * 32 + 16 * hh;
        const float* b2 = P->in[I_GB2] + l * 128 + h * 32 + 16 * hh;
#pragma unroll
        for (int d = 0; d < 16; ++d) gl[d] = b2[d];
#pragma unroll
        for (int q = 0; q < 16; ++q)
#pragma unroll
            for (int d4 = 0; d4 < 4; ++d4) {
                const float4 wq = *(const float4*)(w2 + q * 128 + d4 * 4);
                gl[d4 * 4 + 0] += lr[q] * wq.x; gl[d4 * 4 + 1] += lr[q] * wq.y; gl[d4 * 4 + 2] += lr[q] * wq.z; gl[d4 * 4 + 3] += lr[q] * wq.w;
            }
#pragma unroll
        for (int d = 0; d < 16; ++d) gl[d] = log_sigmoidf_(gl[d]) * (1.f / 16.f);
    }
#pragma unroll
    for (int off = 1; off < 32; off <<= 1) {
        const int src = olane() - off;
#pragma unroll
        for (int d = 0; d < 16; ++d) { const float v = bperm(gl[d], src); if (r >= off) gl[d] += v; }
    }
    {
        float* bc = (float*)(P->ws + OFF_BCUM) + tok * 128 + h * 32 + 16 * hh;
#pragma unroll
        for (int d4 = 0; d4 < 4; ++d4) *(float4*)(bc + d4 * 4) = (float4){gl[d4 * 4], gl[d4 * 4 + 1], gl[d4 * 4 + 2], gl[d4 * 4 + 3]};
    }
    {
        const half8* kp = (const half8*)(proj + tok * D_IN + C_GK + h * 32 + 16 * hh);
        const half8 k0 = kp[0], k1 = kp[1];
        float bl[16];
#pragma unroll
        for (int d = 0; d < 16; ++d) bl[d] = bperm(gl[d], olane() | 31);
#pragma unroll
        for (int d = 0; d < 16; ++d) {
            const float kd = (float)(d < 8 ? k0[d & 7] : k1[d & 7]) * __expf(bl[d] - gl[d]);
            KT[(16 * hh + d) * 32 + r] = (h16)kd;
        }
        if (r == 0) {
            float* dc = (float*)(P->ws + OFF_GDEC) + (size_t)(bh * 256 + n) * 32 + 16 * hh;
#pragma unroll
            for (int d4 = 0; d4 < 4; ++d4) *(float4*)(dc + d4 * 4) = (float4){__expf(bl[d4 * 4]), __expf(bl[d4 * 4 + 1]), __expf(bl[d4 * 4 + 2]), __expf(bl[d4 * 4 + 3])};
        }
    }
    asm volatile("s_waitcnt lgkmcnt(0)" ::: "memory");
    const half8 kb0 = *(const half8*)(KT + r * 32 + 8 * hh), kb1 = *(const half8*)(KT + r * 32 + 16 + 8 * hh);
    float* kvp = (float*)(P->ws + OFF_GKV) + ((size_t)(bh * 256 + n) * 32 + r) * 64;
#pragma unroll
    for (int dt = 0; dt < 2; ++dt) {
        f32x16 o;
#pragma unroll
        for (int e = 0; e < 16; ++e) o[e] = 0.f;
        const h16* vrow = VT + (32 * dt + r) * 32 + 8 * hh;
        o = MFMA32(*(const half8*)vrow, kb0, o);
        o = MFMA32(*(const half8*)(vrow + 16), kb1, o);
#pragma unroll
        for (int g4 = 0; g4 < 4; ++g4)
            *(float4*)(kvp + 32 * dt + 8 * g4 + 4 * hh) = (float4){o[4 * g4], o[4 * g4 + 1], o[4 * g4 + 2], o[4 * g4 + 3]};
    }
    __syncthreads();
}

DI void gla_out_item(PP P, int l, int item, char* smem, const int wv) {
    P = plaunder(P);
    const int tid = otid(wv), lane = tid & 63, w = tid >> 6, r = lane & 31, hh = lane >> 5;
    const int pair = item * 4 + w, h = pair & 3, cn = pair >> 2;
    const size_t tok0 = (size_t)cn * 32, tok = tok0 + r;
    const int b = cn >> 8, n = cn & 255, bh = b * 4 + h;
    const h16* proj = (const h16*)(P->ws + OFF_PROJ);
    h16* VT = (h16*)(smem + w * 16384);
    h16* SPT = VT + 2048;
    __syncthreads();
    {
        const half8* vp = (const half8*)(proj + tok * D_IN + C_GV + h * 64 + hh * 32);
        const float4* sp = (const float4*)((const float*)(P->ws + OFF_GKV) + ((size_t)(bh * 256 + n) * 32 + r) * 64 + hh * 32);
#pragma unroll
        for (int q = 0; q < 4; ++q) {
            const half8 v8 = vp[q];
            const float4 s0 = sp[2 * q], s1 = sp[2 * q + 1];
#pragma unroll
            for (int e = 0; e < 8; ++e) VT[(hh * 32 + q * 8 + e) * 32 + r] = v8[e];
            SPT[(hh * 32 + q * 8 + 0) * 32 + r] = (h16)s0.x; SPT[(hh * 32 + q * 8 + 1) * 32 + r] = (h16)s0.y;
            SPT[(hh * 32 + q * 8 + 2) * 32 + r] = (h16)s0.z; SPT[(hh * 32 + q * 8 + 3) * 32 + r] = (h16)s0.w;
            SPT[(hh * 32 + q * 8 + 4) * 32 + r] = (h16)s1.x; SPT[(hh * 32 + q * 8 + 5) * 32 + r] = (h16)s1.y;
            SPT[(hh * 32 + q * 8 + 6) * 32 + r] = (h16)s1.z; SPT[(hh * 32 + q * 8 + 7) * 32 + r] = (h16)s1.w;
        }
    }
    half8 qe[2], ke[2];
#pragma unroll
    for (int ks = 0; ks < 2; ++ks) {
        const int d0 = 16 * ks + 8 * hh;
        const half8 q8 = *(const half8*)(proj + tok * D_IN + C_GQ + h * 32 + d0);
        const half8 k8 = *(const half8*)(proj + tok * D_IN + C_GK + h * 32 + d0);
        const float4 b0 = *(const float4*)((const float*)(P->ws + OFF_BCUM) + tok * 128 + h * 32 + d0);
        const float4 b1 = *(const float4*)((const float*)(P->ws + OFF_BCUM) + tok * 128 + h * 32 + d0 + 4);
        const float bc[8] = {b0.x, b0.y, b0.z, b0.w, b1.x, b1.y, b1.z, b1.w};
#pragma unroll
        for (int e = 0; e < 8; ++e) {
            const float ex = __expf(bc[e]);
            qe[ks][e] = (h16)((float)q8[e] * 0.17677669529663687f * ex);
            ke[ks][e] = (h16)((float)k8[e] * __builtin_amdgcn_rcpf(ex));
        }
    }
    f32x16 s;
#pragma unroll
    for (int e = 0; e < 16; ++e) s[e] = 0.f;
    s = MFMA32(ke[0], qe[0], s);
    s = MFMA32(ke[1], qe[1], s);
#pragma unroll
    for (int e = 0; e < 16; ++e) { const int j = (e & 3) + 8 * (e >> 2) + 4 * hh; if (j > r) s[e] = 0.f; }
    const half8 pb0 = pack8<0>(s), pb1 = pack8<1>(s);
    asm volatile("s_waitcnt lgkmcnt(0)" ::: "memory");
    f32x16 o[2];
#pragma unroll
    for (int dt = 0; dt < 2; ++dt) {
#pragma unroll
        for (int e = 0; e < 16; ++e) o[dt][e] = 0.f;
        const h16* vrow = VT + (32 * dt + r) * 32 + 4 * hh;
        const h16* srow = SPT + (32 * dt + r) * 32 + 8 * hh;
        {
            const half4 lo = *(const half4*)vrow, hi = *(const half4*)(vrow + 8);
            o[dt] = MFMA32(((half8){lo[0], lo[1], lo[2], lo[3], hi[0], hi[1], hi[2], hi[3]}), pb0, o[dt]);
        }
        {
            const half4 lo = *(const half4*)(vrow + 16), hi = *(const half4*)(vrow + 24);
            o[dt] = MFMA32(((half8){lo[0], lo[1], lo[2], lo[3], hi[0], hi[1], hi[2], hi[3]}), pb1, o[dt]);
        }
        o[dt] = MFMA32(*(const half8*)srow, qe[0], o[dt]);
        o[dt] = MFMA32(*(const half8*)(srow + 16), qe[1], o[dt]);
    }
    float ss = 0.f;
#pragma unroll
    for (int e = 0; e < 16; ++e) ss += o[0][e] * o[0][e] + o[1][e] * o[1][e];
    ss = xhalf_sum(ss);
    const float rn = rsqrtf(ss * (1.f / 64.f) + 1e-6f);
    h16* mix = (h16*)(P->ws + OFF_MIX);
#pragma unroll
    for (int dt = 0; dt < 2; ++dt)
#pragma unroll
        for (int g4 = 0; g4 < 4; ++g4) {
            const int e0 = 32 * dt + 8 * g4 + 4 * hh;
            const half4 gt = *(const half4*)(proj + tok * D_IN + C_GG + h * 64 + e0);
            const float4 on = *(const float4*)(P->in[I_GON] + l * 64 + e0);
            half4 ov;
            ov[0] = (h16)(o[dt][4 * g4 + 0] * rn * on.x * siluf_((float)gt[0]));
            ov[1] = (h16)(o[dt][4 * g4 + 1] * rn * on.y * siluf_((float)gt[1]));
            ov[2] = (h16)(o[dt][4 * g4 + 2] * rn * on.z * siluf_((float)gt[2]));
            ov[3] = (h16)(o[dt][4 * g4 + 3] * rn * on.w * siluf_((float)gt[3]));
            *(half4*)(mix + kb_idx(NT, tok, h * 64 + e0)) = ov;
        }
    __syncthreads();
}

DI void glu_tile(PP P, int l, int tile, char* smem, const int wv) {
    P = plaunder(P);
    const int mt = tile >> 2, nt = tile & 3;
    f32x4 acc[4][4];
    float ssd[4];
    gemm_mainloop_glds<false>(wv, 256, APlain{(const h16*)(P->ws + OFF_YACT) + (size_t)mt * 128 * 256, 256, 64},
                              (const h16*)(P->ws + OFF_WTGLU) + ((size_t)l * 512 + nt * 128) * 256, 256, acc, ssd, smem);
    const int tid = otid(wv), lane = tid & 63, wid = tid >> 6, wr = wid >> 1, wc = wid & 1;
    const h16* proj = (const h16*)(P->ws + OFF_PROJ);
    h16* mix = (h16*)(P->ws + OFF_MIX);
    const float* gb = P->in[I_GLUB] + l * 512;
#pragma unroll
    for (int i = 0; i < 4; ++i) {
        const size_t tok = (size_t)mt * 128 + wr * 64 + i * 16 + (lane & 15);
#pragma unroll
        for (int pj = 0; pj < 2; ++pj) {
            const int c = nt * 64 + wc * 32 + pj * 16 + (lane >> 4) * 4;
            const f32x4 z1 = acc[i][2 * pj], z2 = acc[i][2 * pj + 1];
            const float4 b1 = *(const float4*)(gb + c), b2 = *(const float4*)(gb + 256 + c);
            const half4 g4 = *(const half4*)(proj + tok * D_IN + C_SG + c);
            half4 o;
            o[0] = (h16)((z1[0] + b1.x) * sigmoidf_(z2[0] + b2.x) * siluf_((float)g4[0]));
            o[1] = (h16)((z1[1] + b1.y) * sigmoidf_(z2[1] + b2.y) * siluf_((float)g4[1]));
            o[2] = (h16)((z1[2] + b1.z) * sigmoidf_(z2[2] + b2.z) * siluf_((float)g4[2]));
            o[3] = (h16)((z1[3] + b1.w) * sigmoidf_(z2[3] + b2.w) * siluf_((float)g4[3]));
            *(half4*)(mix + kb_idx(NT, tok, 256 + c)) = o;
        }
    }
}

DI void outproj_tile(PP P, int l, int mt, int nt, char* smem, const int wv) {
    P = plaunder(P);
    f32x4 acc[8][4];
    float ssd[8];
    gemm_glds<false, 2, 8, 4, 3>(wv, 1024, APlain{(const h16*)(P->ws + OFF_MIX) + (size_t)mt * 256 * 64, 64, (size_t)NT * 64},
                              (const h16*)(P->ws + OFF_WTOUT) + ((size_t)l * 16 * 1024 + nt * 128) * 64, 64, acc, ssd, smem, (size_t)1024 * 64);
    const int tid = otid(wv), lane = tid & 63, wid = tid >> 6, wr = wid >> 1, wc = wid & 1;
    const float* xin = (l == 0) ? P->in[I_X] : P->out;
    h16* xh = (h16*)(P->ws + OFF_XH);
#pragma unroll
    for (int i = 0; i < 8; ++i) {
        const size_t row = (size_t)mt * 256 + wr * 128 + i * 16 + (lane & 15);
#pragma unroll
        for (int jj = 0; jj < 4; ++jj) {
            const int n = nt * 128 + wc * 64 + jj * 16 + (lane >> 4) * 4;
            const f32x4 v = acc[i][jj];
            const float4 xo = *(const float4*)(xin + row * 1024 + n);
            const float4 xn = (float4){xo.x + v[0], xo.y + v[1], xo.z + v[2], xo.w + v[3]};
            *(float4*)(P->out + row * 1024 + n) = xn;
            *(half4*)(xh + kb_idx(NT, row, n)) = (half4){(h16)xn.x, (h16)xn.y, (h16)xn.z, (h16)xn.w};
        }
    }
}

#define XB_TMO      128
#define XB_XCNT(j)  (256  + 64 * (j))
#define XB_XSUB(j)  (1280 + 64 * (j))
#define XB_XGEN(j)  (2304 + 64 * (j))
#define XB_TOP      3328
#define XB_TOPGEN   3392
#define XCD_BAR_WORDS 3456
#define XB_SPIN_CAP (1u << 18)
#define LAS __attribute__((address_space(3)))

__device__ __forceinline__ unsigned xb_ld(unsigned* p)              { return __hip_atomic_load(p, __ATOMIC_RELAXED, __HIP_MEMORY_SCOPE_AGENT); }
__device__ __forceinline__ unsigned xb_add(unsigned* p, unsigned v) { return __hip_atomic_fetch_add(p, v, __ATOMIC_RELAXED, __HIP_MEMORY_SCOPE_AGENT); }
__device__ __forceinline__ unsigned xb_xcc_id() { return (unsigned)__builtin_amdgcn_s_getreg((3 << 11) | 20) & 0xFu; }
#define XB_SPIN(cond, bar) do { unsigned _sp = 0; while (cond) { __builtin_amdgcn_s_sleep(1); \
    if ((++_sp & 255u) == 0u) { if (xb_ld(&(bar)[XB_TMO])) break; if (_sp > XB_SPIN_CAP) { atomicAdd(&(bar)[XB_TMO], 1u); break; } } } } while (0)

struct XcdBarrier {
    unsigned* bar; unsigned x;
    volatile LAS unsigned* st;
};

__device__ __forceinline__ XcdBarrier xcd_barrier_post(unsigned* bar, volatile LAS unsigned* st) {
    XcdBarrier b; b.bar = bar; b.x = xb_xcc_id(); b.st = st;
    if (threadIdx.x == 0) (void)xb_add(&bar[XB_XCNT(b.x)], 1u);
    return b;
}
__device__ __forceinline__ void xcd_barrier_complete(unsigned* bar, unsigned x, unsigned& nloc, unsigned& nx) {
    const unsigned G = gridDim.x * gridDim.y * gridDim.z;
    unsigned sum, cnt, mine, sp = 0u;
    for (;;) {
        sum = 0u; cnt = 0u; mine = 0u;
#pragma unroll
        for (unsigned j = 0; j < 16; ++j) { const unsigned c = xb_ld(&bar[XB_XCNT(j)]); sum += c; cnt += (c > 0u) ? 1u : 0u; mine = (j == x) ? c : mine; }
        if (sum == G) break;
        __builtin_amdgcn_s_sleep(1);
        if ((++sp & 255u) == 0u) { if (xb_ld(&bar[XB_TMO])) break; if (sp > XB_SPIN_CAP) { atomicAdd(&bar[XB_TMO], 1u); break; } }
    }
    nloc = mine > 0u ? mine : 1u; nx = cnt > 0u ? cnt : 1u;
}

__device__ __forceinline__ void xcd_barrier(const XcdBarrier& b) {
    asm volatile("s_waitcnt vmcnt(0)" ::: "memory");
    __syncthreads();
    if (threadIdx.x == 0) {
        unsigned* bar = b.bar;
        __builtin_amdgcn_s_waitcnt(0);
        unsigned nloc = b.st[0], nx = b.st[1];
        if (nloc == 0u) { xcd_barrier_complete(bar, b.x, nloc, nx); b.st[0] = nloc; b.st[1] = nx; }
        const unsigned old = xb_add(&bar[XB_XSUB(b.x)], 1u);
        const unsigned gen = old / nloc;
        if (old + 1u == (gen + 1u) * nloc) {
            __builtin_amdgcn_fence(__ATOMIC_RELEASE, "agent");
            asm volatile("s_waitcnt vmcnt(0)" ::: "memory");
            const unsigned og = xb_add(&bar[XB_TOP], 1u);
            const unsigned tg = og / nx;
            if (og + 1u == (tg + 1u) * nx) xb_add(&bar[XB_TOPGEN], 1u);
            else XB_SPIN(xb_ld(&bar[XB_TOPGEN]) == tg, bar);
            __builtin_amdgcn_fence(__ATOMIC_ACQUIRE, "agent");
            xb_add(&bar[XB_XGEN(b.x)], 1u);
            asm volatile("s_waitcnt vmcnt(0)" ::: "memory");
        } else {
            XB_SPIN(xb_ld(&bar[XB_XGEN(b.x)]) == gen, bar);
            __builtin_amdgcn_fence(__ATOMIC_ACQUIRE, "agent");
            asm volatile("s_waitcnt vmcnt(0)" ::: "memory");
        }
    }
    __syncthreads();
}


__global__ void __launch_bounds__(NTHREADS, 2) fwd_megakernel(Params Pval) {
    PP P = (PP)__builtin_amdgcn_kernarg_segment_ptr();
    extern __shared__ __attribute__((aligned(16))) char smem[];
    cg::grid_group grid = cg::this_grid();
    const int G = gridDim.x, bid = blockIdx.x;
    const int wv = __builtin_amdgcn_readfirstlane((int)(threadIdx.x >> 6));

    uint4& xb_words = *(uint4*)(smem + SMEM_MAIN);
    if (otid(wv) == 0) xb_words = make_uint4(0u, 0u, 0u, 0u);
    __syncthreads();
    if (P->ws == nullptr) grid.sync();
    const XcdBarrier xb = xcd_barrier_post((unsigned*)(P->ws + OFF_BAR), (volatile LAS unsigned*)(smem + SMEM_MAIN));
    int vxcd = bid & 7, vjx = bid >> 3;
    {
        unsigned* xcnt = (unsigned*)(P->ws + OFF_BAR) + XCD_BAR_WORDS;
        volatile LAS unsigned* lw = (volatile LAS unsigned*)(smem + SMEM_MAIN) + 2;
        if (otid(wv) == 0) lw[0] = xb.x < 8u ? xb_add(&xcnt[xb.x], 1u) : 0xffffu;
        phase0(P, smem, wv);
        xcd_barrier(xb);
        if (otid(wv) == 0) {
            bool ok = (G & 7) == 0 && xb.x < 8u;
            for (int j = 0; j < 8; ++j) ok = ok && (xb_ld(&xcnt[j]) == (unsigned)(G >> 3));
            lw[1] = ok ? 1u : 0u;
        }
        __syncthreads();
        if (lw[1]) { vxcd = (int)xb.x; vjx = (int)lw[0]; }
    }
    vxcd = __builtin_amdgcn_readfirstlane(vxcd); vjx = __builtin_amdgcn_readfirstlane(vjx);

#pragma unroll 1
    for (int l = 0; l < DEPTH; ++l) {
        {
            const int xcd = vxcd, jx = vjx, nper = G >> 3;
            for (int u = jx; u < 192; u += nper) inproj_tile<2, 8>(P, l, (xcd * 8 + (u & 7)) * 256, (u >> 3) * 128, smem, wv);
            for (int it = jx; it < 16 + 40; it += nper) {
                if (it < 16) inproj_tile<4, 2>(P, l, (xcd * 16 + it) * 128, 3072, smem, wv);
                else s5_build_item(P, l, (it - 16) * 8 + xcd, smem, wv);
            }
        }
        xcd_barrier(xb);
#pragma unroll 1
        for (int w = bid; w < 128 + 64 + 512; w += G) {
            if (w < 128) cmp_gemm_tile(P, l, w, smem, wv);
            else if (w < 192) s5e_gemm_tile(P, l, w - 128, smem, wv);
            else gla_kv_item(P, l, w - 192, smem, wv);
        }
        xcd_barrier(xb);
#pragma unroll 1
        for (int w = bid; w < 512 + 512 + 64; w += G) {
            if (w < 512) cmp_l2_item(P, l, w, smem, wv);
            else if (w < 1024) gla_scan_item(P, w - 512, smem, wv);
            else s5_scan_item(P, w - 1024, smem, wv);
        }
        xcd_barrier(xb);
        bool nsa_fast;
        {
            const int ln = otid(wv) & 63;
            const float gq = wave_max(fabsf(P->in[I_NQN][l * 64 + ln]));
            const float gk = wave_max(fmaxf(fmaxf(fabsf(P->in[I_NKN][(l * 3 + 0) * 64 + ln]), fabsf(P->in[I_NKN][(l * 3 + 1) * 64 + ln])), fabsf(P->in[I_NKN][(l * 3 + 2) * 64 + ln])));
            nsa_fast = __builtin_amdgcn_readfirstlane((8.f * 1.4426950408889634f * gq * gk < 15.f) ? 1 : 0) != 0;
        }
#pragma unroll 1
        for (int w0 = bid; w0 < 512 + 512 + 512; w0 += G) {
            const int w = w0 < G ? vjx * 8 + vxcd : w0;
            if (w < 512) {
                const int bg = w & 3, q = w >> 2;
                if (nsa_fast) { nsa_unit<true>(P, l, bg, 255 - q, smem, wv); nsa_unit<true>(P, l, bg, q, smem, wv); }
                else { nsa_unit<false>(P, l, bg, 255 - q, smem, wv); nsa_unit<false>(P, l, bg, q, smem, wv); }
            } else if (w < 512 + 512) s5o_gemm_tile(P, l, w - 512, smem, wv);
            else gla_out_item(P, l, w - 1024, smem, wv);
        }
        xcd_barrier(xb);
#pragma unroll 1
        for (int w = bid; w < 512; w += G) glu_tile(P, l, w, smem, wv);
        xcd_barrier(xb);
        {
            const int xcd = vxcd, jx = vjx, nper = G >> 3;
            for (int u = jx; u < 64; u += nper) outproj_tile(P, l, xcd * 8 + (u & 7), u >> 3, smem, wv);
        }
        xcd_barrier(xb);
    }
}

extern "C" void kernel_launch(void* const* d_in, const int* in_sizes, int n_in, void* d_out, int out_size, void* d_ws,
                              size_t ws_size, hipStream_t stream) {
    static int grid_blocks = 0;
    if (!grid_blocks) {
        int dev = 0, cus = 0, per_cu = 0;
        hipGetDevice(&dev);
        hipDeviceGetAttribute(&cus, hipDeviceAttributeMultiprocessorCount, dev);
        hipFuncSetAttribute((const void*)fwd_megakernel, hipFuncAttributeMaxDynamicSharedMemorySize, SMEM_BYTES);
        hipOccupancyMaxActiveBlocksPerMultiprocessor(&per_cu, fwd_megakernel, NTHREADS, SMEM_BYTES);
        if (per_cu < 1) per_cu = 1;
        if (per_cu > 2) per_cu = 2;
        grid_blocks = cus * per_cu;
        if (ws_size < WS_END) fprintf(stderr, "kernel_launch: workspace too small: %zu < %zu\n", ws_size, (size_t)WS_END);
    }
    Params p{};
    for (int i = 0; i < 25; ++i) p.in[i] = (const float*)d_in[i];
    p.out = (float*)d_out;
    p.ws = (char*)d_ws;
    void* args[] = {&p};
    (void)hipMemsetAsync((char*)d_ws + OFF_BAR, 0, (XCD_BAR_WORDS + 16) * sizeof(unsigned), stream);
    hipError_t e = hipLaunchCooperativeKernel((const void*)fwd_megakernel, dim3(grid_blocks), dim3(NTHREADS), args, SMEM_BYTES, stream);
    if (e != hipSuccess) fprintf(stderr, "cooperative launch failed: %s (grid %d)\n", hipGetErrorString(e), grid_blocks);
}
```

```cpp
#include <hip/hip_runtime.h>
#include <hip/hip_cooperative_groups.h>
#include <cstdio>
#include <cstdint>
namespace cg = cooperative_groups;

typedef _Float16 h16;
typedef _Float16 half8 __attribute__((ext_vector_type(8)));
typedef _Float16 half4 __attribute__((ext_vector_type(4)));
typedef float f32x4 __attribute__((ext_vector_type(4)));
typedef float f32x16 __attribute__((ext_vector_type(16)));

#define DI __device__ __forceinline__

constexpr int D_MODEL = 1024, BATCH = 2, SEQ = 8192, DEPTH = 4, NT = BATCH * SEQ;
constexpr int D_IN = 3112, D_IN_PAD = 3200;
constexpr int C_NQ = 0, C_NKV = 512, C_NG = 1280, C_GQ = 1792, C_GK = 1920, C_GV = 2048, C_GG = 2304, C_SU = 2560, C_SG = 2816,
              C_GLR = 3072, C_NGL = 3088;
__host__ __device__ constexpr int map_col(int c) {
    return c < 128 ? C_GQ + c : c < 256 ? C_GK + (c - 128) : c < 512 ? C_GV + (c - 256) : c < 528 ? C_GLR + (c - 512)
         : c < 784 ? C_GG + (c - 528) : c < 1040 ? C_SU + (c - 784) : c < 1296 ? C_SG + (c - 1040) : c < 1808 ? C_NQ + (c - 1296)
         : c < 2576 ? C_NKV + (c - 1808) : c < 2600 ? C_NGL + (c - 2576) : c < 3112 ? C_NG + (c - 2600) : c;
}
constexpr int NTHREADS = 256;
constexpr float QSCALE = 0.125f * 1.4426950408889634f;

enum { I_X = 0, I_NORMG, I_WIN, I_GW2, I_GB2, I_GON, I_LRE, I_LIM, I_LSTEP, I_BRE, I_BIM, I_CRE, I_CIM, I_SD, I_GLUW, I_GLUB,
       I_NGB, I_NQN, I_NKN, I_CPOS, I_CW1, I_CB1, I_CW2, I_CB2, I_WOUT };

constexpr size_t OFF_WTIN  = 0;
constexpr size_t OFF_WTOUT = OFF_WTIN  + 4ull * D_IN_PAD * 1024 * 2;
constexpr size_t OFF_WTGLU = OFF_WTOUT + 4ull * 1024 * 1024 * 2;
constexpr size_t OFF_WTC1  = OFF_WTGLU + 4ull * 512 * 256 * 2;
constexpr size_t OFF_PROJ  = OFF_WTC1  + 4ull * 2 * 256 * 2048 * 2;
constexpr size_t OFF_MIX   = OFF_PROJ  + (size_t)NT * D_IN * 2;
constexpr size_t OFF_YACT  = OFF_MIX   + (size_t)NT * 1024 * 2;
constexpr size_t OFF_XH    = OFF_YACT;
constexpr size_t OFF_BCUM  = OFF_YACT  + (size_t)NT * 256 * 2;
constexpr size_t OFF_GKV   = OFF_BCUM  + (size_t)NT * 128 * 4;
constexpr size_t OFF_GDEC  = OFF_GKV   + 8ull * 256 * 2048 * 4;
static_assert(OFF_GDEC - OFF_XH >= (size_t)NT * 1024 * 2, "XH alias region too small");
constexpr size_t OFF_XC    = OFF_GDEC  + 8ull * 256 * 32 * 4;
constexpr size_t OFF_S5W   = OFF_XC    + 512ull * 1024 * 2 * 4;
constexpr size_t OFF_S5E   = OFF_S5W   + 16ull * 512 * 640 * 2;
constexpr size_t OFF_S5AL  = OFF_S5E   + 16ull * 128 * 512 * 2;
constexpr size_t OFF_CHID  = OFF_S5AL  + 1024ull * 2 * 4;
constexpr size_t OFF_POSB  = OFF_CHID  + 2ull * 2048 * 512 * 4;
constexpr size_t OFF_XCH   = OFF_POSB  + 8ull * 16 * 256 * 4;
constexpr size_t OFF_KCMP  = OFF_XCH   + 512ull * 2048 * 2;
constexpr size_t OFF_VCMP  = OFF_KCMP  + 4ull * 512 * 64 * 2;
constexpr size_t OFF_VTG   = OFF_VCMP  + 4ull * 512 * 64 * 2;
constexpr size_t OFF_BAR   = OFF_VTG   + 2ull * 4 * 128 * 4096 * 2;
constexpr size_t WS_END    = OFF_BAR   + 16384;

struct Params {
    const float* in[25];
    float* out;
    char* ws;
};

__host__ __device__ constexpr size_t kb_idx(size_t nrows, size_t row, int k) { return (((size_t)(k >> 6)) * nrows + row) * 64 + (k & 63); }
typedef const __attribute__((address_space(4))) Params* PP;
DI PP plaunder(PP p) { asm volatile("" : "+s"(p)); return p; }
constexpr int SMEM_MAIN = 73728;
constexpr int SMEM_BYTES = SMEM_MAIN + 16;

DI int olane() { int l; asm volatile("v_mbcnt_lo_u32_b32 %0, -1, 0\n\tv_mbcnt_hi_u32_b32 %0, -1, %0" : "=v"(l)); return l; }
DI int otid(const int wv) { return wv * 64 + olane(); }
template <int M> DI int shx_i(int v) {
    static_assert(M == 1 || M == 2 || M == 4 || M == 8 || M == 16, "lane xor mask");
    if constexpr (M == 1) return __builtin_amdgcn_update_dpp(0, v, 0xB1, 0xF, 0xF, true);
    else if constexpr (M == 2) return __builtin_amdgcn_update_dpp(0, v, 0x4E, 0xF, 0xF, true);
    else return __builtin_amdgcn_ds_swizzle(v, (M << 10) | 0x1F);
}
template <int M> DI float shx(float v) { return __int_as_float(shx_i<M>(__float_as_int(v))); }
template <int N> DI int row_shr_i(int v) { return __builtin_amdgcn_update_dpp(0, v, 0x110 | N, 0xF, 0xF, true); }
DI float xhalf_max(float v) {
    const auto r = __builtin_amdgcn_permlane32_swap(__float_as_uint(v), __float_as_uint(v), false, false);
    return fmaxf(__uint_as_float(r[0]), __uint_as_float(r[1]));
}
DI float xhalf_sum(float v) {
    const auto r = __builtin_amdgcn_permlane32_swap(__float_as_uint(v), __float_as_uint(v), false, false);
    return __uint_as_float(r[0]) + __uint_as_float(r[1]);
}
DI float wave_sum(float v) {
    v = xhalf_sum(v);
    v += shx<16>(v); v += shx<8>(v); v += shx<4>(v); v += shx<2>(v); v += shx<1>(v);
    return v;
}
DI float wave_max(float v) {
    v = xhalf_max(v);
    v = fmaxf(v, shx<16>(v)); v = fmaxf(v, shx<8>(v)); v = fmaxf(v, shx<4>(v)); v = fmaxf(v, shx<2>(v)); v = fmaxf(v, shx<1>(v));
    return v;
}
DI float bperm(float v, int srclane) { return __int_as_float(__builtin_amdgcn_ds_bpermute(srclane << 2, __float_as_int(v))); }
DI float add1(float e) { float y; asm("s_nop 0\n\tv_add_f32_e32 %0, 1.0, %1" : "=v"(y) : "v"(e)); return y; }
DI float sigmoidf_(float x) { return 1.f / add1(__expf(-x)); }
DI float siluf_(float x) { return x / add1(__expf(-x)); }
DI float gelu_tanh(float x) {
    const float u = 0.7978845608028654f * (x + 0.044715f * x * x * x);
    return 0.5f * x * (1.f + tanhf(u));
}
DI float log_sigmoidf_(float x) { return fminf(x, 0.f) - log1pf(__expf(-fabsf(x))); }

typedef _Float16 half2_ __attribute__((ext_vector_type(2)));
DI void glds16(const h16* g, char* l) {
    __builtin_amdgcn_global_load_lds((const __attribute__((address_space(1))) void*)g, (__attribute__((address_space(3))) void*)l, 16, 0, 0);
}
DI int vkperm(int k) { return (k & ~12) | ((k & 4) << 1) | ((k & 8) >> 1); }
struct APlain { const h16* A; size_t lda, astep; DI const h16* operator()(int row, int kt, int c8) const { return A + (size_t)row * lda + (size_t)kt * astep + c8 * 8; } };
struct AS5 {
    const h16* ubase;
    const h16* xin;
    int ch0;
    DI const h16* operator()(int row, int kt, int c8) const {
        const size_t ch = (size_t)(ch0 + row);
        return kt < 8 ? ubase + (ch * 32 + 4 * kt + (c8 >> 1)) * D_IN + (c8 & 1) * 8 : xin + ch * 2048 + (kt - 8) * 64 + c8 * 8;
    }
};
template <int N> DI void gwaitbar();
#define GWB_DEF(N) template <> DI void gwaitbar<N>() { asm volatile("s_waitcnt vmcnt(" #N ") lgkmcnt(0)\n\ts_barrier" ::: "memory"); }
GWB_DEF(0) GWB_DEF(3) GWB_DEF(4) GWB_DEF(6) GWB_DEF(8) GWB_DEF(12)
template <bool SUMSQ, int WR, int MI, int NJ, int NST = 4, class AF>
DI void gemm_glds(const int wv, const int K, const AF& afn, const h16* __restrict__ Bt, const int ldb,
                  f32x4 (&acc)[MI][NJ], float (&ss)[MI], char* smem, const size_t bstep = 64) {
    constexpr int WC = 4 / WR, BM = WR * MI * 16, BN = WC * NJ * 16, AQ = BM / 64, BQ = BN / 64, NG = AQ + BQ, SB = (BM + BN) * 64;
    static_assert(NST * SB <= SMEM_MAIN && AQ >= 1 && BQ >= 1 && (NST == 3 || NST == 4), "ring does not fit the LDS");
    const int tid = otid(wv), lane = tid & 63, wid = tid >> 6, wr = wid / WC, wc = wid % WC;
#pragma unroll
    for (int i = 0; i < MI; ++i) {
        ss[i] = 0.f;
#pragma unroll
        for (int j = 0; j < NJ; ++j) acc[i][j] = (f32x4){0.f, 0.f, 0.f, 0.f};
    }
    const int lrow = wid * 16 + (lane >> 2);
    const int lc4 = (lane & 3) ^ ((-(lrow >> 2)) & 3);
    const h16* bp = Bt + (size_t)lrow * ldb + lc4 * 8;
    char* lbase = smem + wid * 1024;
    const int fr = lane & 15, fq = lane >> 4, sw = (-(fr >> 2)) & 3;
    const int aoff0 = (wr * MI * 16 + fr) * 64 + ((fq ^ sw) * 16);
    const int boff0 = BM * 64 + (wc * NJ * 16 + fr) * 64 + ((fq ^ sw) * 16);
    const int nt = K >> 5;
    auto issue = [&](const int t, char* stage) {
        const int kt = t >> 1, hb = (t & 1) * 4;
#pragma unroll
        for (int q = 0; q < AQ; ++q) glds16(afn(lrow + 64 * q, kt, hb + lc4), stage + q * 4096);
#pragma unroll
        for (int q = 0; q < BQ; ++q) glds16(bp + (size_t)q * 64 * ldb + (size_t)kt * bstep + hb * 8, stage + BM * 64 + q * 4096);
    };
    auto compute = [&](const char* st) {
        half8 af[MI], bf[NJ];
#pragma unroll
        for (int i = 0; i < MI; ++i) af[i] = *(const half8*)(st + aoff0 + i * 1024);
#pragma unroll
        for (int j = 0; j < NJ; ++j) bf[j] = *(const half8*)(st + boff0 + j * 1024);
        if (SUMSQ) {
#pragma unroll
            for (int i = 0; i < MI; ++i)
#pragma unroll
                for (int e = 0; e < 4; ++e) {
                    const half2_ x = (half2_){af[i][2 * e], af[i][2 * e + 1]};
                    ss[i] = __builtin_amdgcn_fdot2(x, x, ss[i], false);
                }
        }
#pragma unroll
        for (int i = 0; i < MI; ++i)
#pragma unroll
            for (int j = 0; j < NJ; ++j) acc[i][j] = __builtin_amdgcn_mfma_f32_16x16x32_f16(bf[j], af[i], acc[i][j], 0, 0, 0);
    };
#define GEMM_STEP(S, t) do { if (NST == 4 && (t) + 2 < nt) gwaitbar<NG>(); else gwaitbar<0>();                       \
        if ((t) + NST - 1 < nt) issue((t) + NST - 1, lbase + (((S) + NST - 1) % NST) * SB); compute(smem + (S) * SB); } while (0)
    gwaitbar<0>();
    {
        const int k = nt < NST - 1 ? nt : NST - 1;
        for (int p = 0; p < k; ++p) issue(p, lbase + p * SB);
        if (k >= 3) gwaitbar<2 * NG>(); else if (k == 2) gwaitbar<NG>(); else gwaitbar<0>();
        __builtin_amdgcn_s_sleep(2);
    }
#pragma unroll 1
    for (int t = 0; t < nt; t += NST) {
        GEMM_STEP(0, t);
        if (t + 1 < nt) GEMM_STEP(1, t + 1);
        if (t + 2 < nt) GEMM_STEP(2, t + 2);
        if (NST == 4 && t + 3 < nt) GEMM_STEP(3 % NST, t + 3);
    }
#undef GEMM_STEP
    asm volatile("s_waitcnt lgkmcnt(0)\n\ts_barrier" ::: "memory");
    if (SUMSQ) {
#pragma unroll
        for (int i = 0; i < MI; ++i) { ss[i] += shx<16>(ss[i]); ss[i] = xhalf_sum(ss[i]); }
    }
}
template <bool SUMSQ, class AF>
DI void gemm_mainloop_glds(const int wv, const int K, const AF& afn, const h16* __restrict__ Bt, const int ldb, f32x4 (&acc)[4][4], float (&ss)[4], char* smem, const size_t bstep = 64) {
    gemm_glds<SUMSQ, 2, 4, 4>(wv, K, afn, Bt, ldb, acc, ss, smem, bstep);
}

DI int glu_perm_dst(int c_orig) {
    const int which = c_orig >> 8, c = c_orig & 255;
    return (c >> 6) * 128 + ((c >> 5) & 1) * 64 + (((c >> 4) & 1) * 2 + which) * 16 + (c & 15);
}
template <int MAP, int KB>
DI void transpose64(const float* __restrict__ src, int R, int C, h16* __restrict__ dst, int r0, int c0,
                    const float* __restrict__ rscale, char* smem, const int wv) {
    h16* tile = (h16*)smem;
    const int tid = otid(wv);
    {
        const int r = tid >> 2, cq = (tid & 3) * 16;
        const float sc = rscale ? rscale[r0 + r] : 1.f;
        const float* sp = src + (size_t)(r0 + r) * C + c0 + cq;
#pragma unroll
        for (int q = 0; q < 4; ++q) {
            float4 v = (float4){0.f, 0.f, 0.f, 0.f};
            if (c0 + cq + q * 4 < C) v = *(const float4*)(sp + q * 4);
            *(half4*)(tile + r * 72 + cq + q * 4) = (half4){(h16)(v.x * sc), (h16)(v.y * sc), (h16)(v.z * sc), (h16)(v.w * sc)};
        }
    }
    __syncthreads();
    {
        const int c = tid >> 2, rq = (tid & 3) * 16;
        half8 o0, o1;
#pragma unroll
        for (int k = 0; k < 8; ++k) { o0[k] = tile[(rq + k) * 72 + c]; o1[k] = tile[(rq + 8 + k) * 72 + c]; }
        const int cc = c0 + c;
        const int dr = MAP == 1 ? map_col(cc) : MAP == 2 ? glu_perm_dst(cc) : cc;
        h16* dp = KB ? dst + ((size_t)(r0 >> 6) * KB + dr) * 64 + rq : dst + (size_t)dr * R + r0 + rq;
        *(half8*)dp = o0; *(half8*)(dp + 8) = o1;
    }
    __syncthreads();
}

DI void phase0(PP P, char* smem, const int wv) {
    P = plaunder(P);
    constexpr int N_WIN = 4 * 16 * 50, N_WOUT = 4 * 16 * 16, N_C1 = 16 * 16 * 4, N_GLU = 4 * 4 * 8, N_XH = NT * 1024 / 2048, N_PB = 8 * 16;
    const int total = N_WIN + N_WOUT + N_C1 + N_GLU + N_XH + N_PB;
    for (int w = blockIdx.x; w < total; w += gridDim.x) {
        if (w < N_WIN) {
            const int l = w / 800, r = w % 800, rt = r / 50, ct = r % 50;
            transpose64<1, D_IN_PAD>(P->in[I_WIN] + (size_t)l * 1024 * D_IN, 1024, D_IN, (h16*)(P->ws + OFF_WTIN) + (size_t)l * D_IN_PAD * 1024,
                           rt * 64, ct * 64, P->in[I_NORMG] + l * 1024, smem, wv);
        } else if (w < N_WIN + N_WOUT) {
            const int v = w - N_WIN, l = v >> 8, r = v & 255, rt = r >> 4, ct = r & 15;
            transpose64<0, 1024>(P->in[I_WOUT] + (size_t)l * 1024 * 1024, 1024, 1024, (h16*)(P->ws + OFF_WTOUT) + (size_t)l * 1024 * 1024,
                           rt * 64, ct * 64, nullptr, smem, wv);
        } else if (w < N_WIN + N_WOUT + N_C1) {
            const int v = w - N_WIN - N_WOUT, ljh = v >> 6, r = v & 63, rt = r >> 2, ct = r & 3;
            transpose64<0, 512>(P->in[I_CW1] + (size_t)ljh * 1024 * 256, 1024, 256, (h16*)(P->ws + OFF_WTC1) + ((size_t)(ljh >> 1) * 16 * 512 + (ljh & 1) * 256) * 64,
                           rt * 64, ct * 64, nullptr, smem, wv);
        } else if (w < N_WIN + N_WOUT + N_C1 + N_GLU) {
            const int v = w - N_WIN - N_WOUT - N_C1, l = v >> 5, r = v & 31, rt = r >> 3, ct = r & 7;
            transpose64<2, 0>(P->in[I_GLUW] + (size_t)l * 256 * 512, 256, 512, (h16*)(P->ws + OFF_WTGLU) + (size_t)l * 512 * 256,
                           rt * 64, ct * 64, nullptr, smem, wv);
        } else if (w < N_WIN + N_WOUT + N_C1 + N_GLU + N_XH) {
            const size_t e0 = ((size_t)(w - N_WIN - N_WOUT - N_C1 - N_GLU) * 256 + otid(wv)) * 8;
            const float4 a = *(const float4*)(P->in[I_X] + e0), b = *(const float4*)(P->in[I_X] + e0 + 4);
            *(half8*)((h16*)(P->ws + OFF_XH) + kb_idx(NT, e0 >> 10, (int)(e0 & 1023))) = (half8){(h16)a.x, (h16)a.y, (h16)a.z, (h16)a.w, (h16)b.x, (h16)b.y, (h16)b.z, (h16)b.w};
        } else {
            const int v = w - (N_WIN + N_WOUT + N_C1 + N_GLU + N_XH), lj = v >> 4, ks = v & 15, n = otid(wv);
            const float* w1 = P->in[I_CW1] + ((size_t)lj * 2048 + ks * 128) * 256 + n;
            const float* pp = P->in[I_CPOS] + (size_t)lj * 2048 + ks * 128;
            float a = ks == 0 ? P->in[I_CB1][lj * 256 + n] : 0.f;
#pragma unroll 16
            for (int k = 0; k < 128; ++k) a += pp[k] * w1[(size_t)k * 256];
            ((float*)(P->ws + OFF_POSB))[(lj * 16 + ks) * 256 + n] = a;
        }
    }
}

DI void s5_build_item(PP P, int l, int item, char* smem, const int wv) {
    P = plaunder(P);
    float* apow = (float*)smem;
    float* bbar = apow + 64 * 33 * 2;
    float* cc   = bbar + 64 * 16 * 2;
    const int tid = otid(wv);
    const int g = (item < 256) ? (item >> 4) : ((item - 256) >> 2);
    if (tid < 64) {
        const int p = tid;
        const float lre = fminf(P->in[I_LRE][(l * 16 + g) * 64 + p], -1e-4f);
        const float lim = P->in[I_LIM][(l * 16 + g) * 64 + p];
        const float dt = expf(P->in[I_LSTEP][l * 16 + g]);
        const float x = lre * dt, y = lim * dt;
        const float em1 = expm1f(x), cy = cosf(y), sy = sinf(y), sh = sinf(0.5f * y);
        const float ar = (em1 + 1.f) * cy, ai = (em1 + 1.f) * sy;
        const float dr = em1 * cy - 2.f * sh * sh, di = ai;
        const float den = lre * lre + lim * lim;
        const float fr = (dr * lre + di * lim) / den;
        const float fi = (di * lre - dr * lim) / den;
        float pr = 1.f, pi = 0.f;
        asm volatile("" : "+v"(pr), "+v"(pi));
        for (int k = 0; k <= 32; ++k) {
            apow[(p * 33 + k) * 2] = pr; apow[(p * 33 + k) * 2 + 1] = pi;
            const float nr = pr * ar - pi * ai, ni = pr * ai + pi * ar; pr = nr; pi = ni;
        }
        for (int c = 0; c < 16; ++c) {
            const float br = P->in[I_BRE][((size_t)(l * 16 + g) * 64 + p) * 16 + c];
            const float bi = P->in[I_BIM][((size_t)(l * 16 + g) * 64 + p) * 16 + c];
            bbar[(p * 16 + c) * 2] = fr * br - fi * bi;
            bbar[(p * 16 + c) * 2 + 1] = fr * bi + fi * br;
        }
    }
    for (int e = tid; e < 1024; e += 256) {
        cc[e * 2] = P->in[I_CRE][(size_t)(l * 16 + g) * 1024 + e];
        cc[e * 2 + 1] = P->in[I_CIM][(size_t)(l * 16 + g) * 1024 + e];
    }
    __syncthreads();
    if (item < 256) {
        const int c = item & 15;
        float* kt = cc + 2048;
        for (int idx = tid; idx < 512; idx += 256) {
            const int lag = idx >> 4, c2 = idx & 15;
            float a = 0.f;
            for (int p = 0; p < 64; ++p) {
                const float cr = cc[(c * 64 + p) * 2], ci = cc[(c * 64 + p) * 2 + 1];
                const float xr = apow[(p * 33 + lag) * 2], xi = apow[(p * 33 + lag) * 2 + 1];
                const float br = bbar[(p * 16 + c2) * 2], bi = bbar[(p * 16 + c2) * 2 + 1];
                const float tr = cr * xr - ci * xi, ti = cr * xi + ci * xr;
                a += tr * br - ti * bi;
            }
            kt[idx] = a;
        }
        __syncthreads();
        h16* W = (h16*)(P->ws + OFF_S5W) + (size_t)g * 512 * 640;
        for (int idx = tid; idx < 32 * 640; idx += 256) {
            const int j = idx / 640, k = idx % 640;
            float val = 0.f;
            if (k < 512) {
                const int s = k >> 4, c2 = k & 15, lag = j - s;
                if (lag >= 0) val = kt[lag * 16 + c2];
            } else {
                const int p = (k - 512) >> 1;
                const float cr = cc[(c * 64 + p) * 2], ci = cc[(c * 64 + p) * 2 + 1];
                const float xr = apow[(p * 33 + j + 1) * 2], xi = apow[(p * 33 + j + 1) * 2 + 1];
                val = (k & 1) ? -(cr * xi + ci * xr) : (cr * xr - ci * xi);
            }
            W[(size_t)(j * 16 + c) * 640 + k] = (h16)val;
        }
    } else {
        const int pq = (item - 256) & 3;
        h16* E = (h16*)(P->ws + OFF_S5E) + ((size_t)g * 128 + pq * 32) * 512;
        for (int idx = tid; idx < 32 * 512; idx += 256) {
            const int nl = idx >> 9, k = idx & 511;
            const int p = pq * 16 + (nl >> 1), s = k >> 4, c2 = k & 15;
            const float xr = apow[(p * 33 + 31 - s) * 2], xi = apow[(p * 33 + 31 - s) * 2 + 1];
            const float br = bbar[(p * 16 + c2) * 2], bi = bbar[(p * 16 + c2) * 2 + 1];
            const float val = (nl & 1) ? (xr * bi + xi * br) : (xr * br - xi * bi);
            E[(size_t)nl * 512 + k] = (h16)val;
        }
        if (tid < 16) {
            const int p = pq * 16 + tid;
            float* AL = (float*)(P->ws + OFF_S5AL);
            AL[(g * 64 + p) * 2] = apow[(p * 33 + 32) * 2];
            AL[(g * 64 + p) * 2 + 1] = apow[(p * 33 + 32) * 2 + 1];
        }
    }
    __syncthreads();
}

template <int WR, int MI>
DI void inproj_tile(PP P, int l, int m0, int n0, char* smem, const int wv) {
    P = plaunder(P);
    constexpr int WC = 4 / WR;
    f32x4 acc[MI][4];
    float ss[MI];
    gemm_glds<true, WR, MI, 4, (WR == 2 && MI == 8) ? 3 : 4>(wv, 1024, APlain{(const h16*)(P->ws + OFF_XH) + (size_t)m0 * 64, 64, (size_t)NT * 64},
                               (const h16*)(P->ws + OFF_WTIN) + ((size_t)l * 16 * D_IN_PAD + n0) * 64, 64, acc, ss, smem, (size_t)D_IN_PAD * 64);
    const int tid = otid(wv), lane = tid & 63, wid = tid >> 6, wr = wid / WC, wc = wid % WC;
    h16* proj = (h16*)(P->ws + OFF_PROJ);
    const int n64 = n0 + wc * 64;
    int cls = 0;
    if (n64 < 512) cls = 1;
    else if (n64 >= C_NKV + 256 && n64 < C_NKV + 384) cls = 2;
    else if (n64 >= C_NKV + 512 && n64 < C_NKV + 640) cls = 3;
    else if (n64 >= C_NKV + 384 && n64 < C_NKV + 512) cls = 4;
    else if (n64 >= C_NKV + 640 && n64 < C_NKV + 768) cls = 5;
    float wn[4][4];
    if (cls >= 1 && cls <= 3) {
        const float* wp = (cls == 1) ? P->in[I_NQN] + l * 64 : P->in[I_NKN] + (l * 3 + (cls - 1)) * 64;
        const float sc = (cls == 1) ? QSCALE : 1.f;
#pragma unroll
        for (int j = 0; j < 4; ++j) {
            const float4 w4 = *(const float4*)(wp + j * 16 + (lane >> 4) * 4);
            wn[j][0] = w4.x * sc; wn[j][1] = w4.y * sc; wn[j][2] = w4.z * sc; wn[j][3] = w4.w * sc;
        }
    }
#pragma unroll
    for (int i = 0; i < MI; ++i) {
        const int ml = wr * MI * 16 + i * 16 + (lane & 15);
        const float r = rsqrtf(ss[i] * (1.f / 1024.f) + 1e-6f);
        const size_t row = (size_t)m0 + ml;
        f32x4 v[4];
#pragma unroll
        for (int j = 0; j < 4; ++j) v[j] = acc[i][j] * r;
        if (cls >= 1 && cls <= 3) {
            float s2 = 0.f;
#pragma unroll
            for (int j = 0; j < 4; ++j) s2 += v[j][0] * v[j][0] + v[j][1] * v[j][1] + v[j][2] * v[j][2] + v[j][3] * v[j][3];
            s2 += shx<16>(s2); s2 = xhalf_sum(s2);
            const float rn = rsqrtf(s2 * (1.f / 64.f) + 1e-6f);
#pragma unroll
            for (int j = 0; j < 4; ++j) { v[j][0] *= rn * wn[j][0]; v[j][1] *= rn * wn[j][1]; v[j][2] *= rn * wn[j][2]; v[j][3] *= rn * wn[j][3]; }
        }
        if (cls >= 4) {
            const int g = (n64 >> 6) & 1, br = cls - 4;
            const int b = (int)(row >> 13), t = (int)(row & 8191);
            h16* vt = (h16*)(P->ws + OFF_VTG) + ((((size_t)br * 4 + b * 2 + g) * 128 + (t >> 6)) * 64) * 64;
#pragma unroll
            for (int j = 0; j < 4; ++j)
#pragma unroll
                for (int e = 0; e < 4; ++e) vt[(j * 16 + (lane >> 4) * 4 + e) * 64 + vkperm(t & 63)] = (h16)v[j][e];
        }
#pragma unroll
        for (int j = 0; j < 4; ++j) {
            const int n = n64 + j * 16 + (lane >> 4) * 4;
            if (n < D_IN) *(half4*)(proj + row * D_IN + n) = (half4){(h16)v[j][0], (h16)v[j][1], (h16)v[j][2], (h16)v[j][3]};
        }
        __builtin_amdgcn_sched_barrier(0);
    }
    __syncthreads();
}


DI void cmp_gemm_tile(PP P, int l, int tile, char* smem, const int wv) {
    P = plaunder(P);
    const int j = tile >> 6, mt = (tile >> 2) & 15, nt = tile & 3;
    const int row0 = mt * 128, bg = row0 >> 9, i0 = row0 & 511, b = bg >> 1, g = bg & 1;
    f32x4 acc[4][4];
    float ssd[4];
    gemm_mainloop_glds<false>(wv, 1024, APlain{(const h16*)(P->ws + OFF_PROJ) + ((size_t)b * SEQ + 16 * i0) * D_IN + C_NKV + j * 128 + g * 64, (size_t)16 * D_IN, (size_t)D_IN},
                              (const h16*)(P->ws + OFF_WTC1) + ((size_t)(l * 2 + j) * 16 * 512 + nt * 128) * 64, 64, acc, ssd, smem, (size_t)512 * 64);
    const int tid = otid(wv), lane = tid & 63, wid = tid >> 6, wr = wid >> 1, wc = wid & 1;
    float* pt = (float*)(P->ws + OFF_CHID) + (size_t)j * 2048 * 512;
#pragma unroll
    for (int i = 0; i < 4; ++i) {
        const size_t row = (size_t)row0 + wr * 64 + i * 16 + (lane & 15);
#pragma unroll
        for (int jj = 0; jj < 4; ++jj) {
            const int n = nt * 128 + wc * 64 + jj * 16 + (lane >> 4) * 4;
            const f32x4 v = acc[i][jj];
            *(float4*)(pt + row * 512 + n) = (float4){v[0], v[1], v[2], v[3]};
        }
    }
}

DI void s5e_gemm_tile(PP P, int l, int tile, char* smem, const int wv) {
    P = plaunder(P);
    const int g = tile >> 2, mt = tile & 3;
    f32x4 acc[4][4];
    float ssd[4];
    gemm_mainloop_glds<false>(wv, 512, AS5{(const h16*)(P->ws + OFF_PROJ) + C_SU + g * 16, nullptr, mt * 128},
                              (const h16*)(P->ws + OFF_S5E) + (size_t)g * 128 * 512, 512, acc, ssd, smem);
    const int tid = otid(wv), lane = tid & 63, wid = tid >> 6, wr = wid >> 1, wc = wid & 1;
    float* xc = (float*)(P->ws + OFF_XC);
#pragma unroll
    for (int i = 0; i < 4; ++i) {
        const size_t ch = (size_t)mt * 128 + wr * 64 + i * 16 + (lane & 15);
#pragma unroll
        for (int jj = 0; jj < 4; ++jj) {
            const int n = wc * 64 + jj * 16 + (lane >> 4) * 4;
            const f32x4 v = acc[i][jj];
            *(float4*)(xc + (ch * 1024 + g * 64) * 2 + n) = (float4){v[0], v[1], v[2], v[3]};
        }
    }
}

DI void gla_scan_item(PP P, int item, char* smem, const int wv) {
    P = plaunder(P);
    const int tid = otid(wv), sl = tid & 31, part = tid >> 5;
    const int idx = item * 32 + sl, bh = idx >> 11, de = idx & 2047, d = de >> 6;
    float* kv = (float*)(P->ws + OFF_GKV) + ((size_t)bh * 256 + part * 32) * 2048 + de;
    const float* dc = (const float*)(P->ws + OFF_GDEC) + ((size_t)bh * 256 + part * 32) * 32 + d;
    float* sD = (float*)smem; float* sL = sD + 256;
    float kvv[32], dd[32];
#pragma unroll
    for (int i = 0; i < 32; ++i) { kvv[i] = kv[(size_t)i * 2048]; dd[i] = dc[i * 32]; }
    float D = 1.f, L = 0.f;
#pragma unroll
    for (int i = 0; i < 32; ++i) { L = dd[i] * L + kvv[i]; D *= dd[i]; }
    sD[part * 32 + sl] = D; sL[part * 32 + sl] = L;
    __syncthreads();
    float S = 0.f;
    for (int q = 0; q < part; ++q) S = sD[q * 32 + sl] * S + sL[q * 32 + sl];
#pragma unroll
    for (int i = 0; i < 32; ++i) { const float o = S; S = dd[i] * S + kvv[i]; kv[(size_t)i * 2048] = o; }
    __syncthreads();
}
DI void s5_scan_item(PP P, int item, char* smem, const int wv) {
    P = plaunder(P);
    const int tid = otid(wv), sl = tid & 31, part = tid >> 5;
    const int idx = item * 32 + sl, b = idx >> 10, s = idx & 1023;
    float2* xc = (float2*)(P->ws + OFF_XC) + ((size_t)b * 256 + part * 32) * 1024 + s;
    half2_* xch = (half2_*)(P->ws + OFF_XCH) + ((size_t)b * 256 + part * 32) * 1024 + s;
    const float2 a = ((const float2*)(P->ws + OFF_S5AL))[s];
    float2* sL = (float2*)smem;
    float2 c[32];
#pragma unroll
    for (int i = 0; i < 32; ++i) c[i] = xc[(size_t)i * 1024];
    float lr = 0.f, li = 0.f;
#pragma unroll
    for (int i = 0; i < 32; ++i) { const float nr = a.x * lr - a.y * li + c[i].x, ni = a.x * li + a.y * lr + c[i].y; lr = nr; li = ni; }
    float dr = a.x, di = a.y;
#pragma unroll
    for (int i = 0; i < 5; ++i) { const float nr = dr * dr - di * di, ni = 2.f * dr * di; dr = nr; di = ni; }
    sL[part * 32 + sl] = (float2){lr, li};
    __syncthreads();
    float xr = 0.f, xi = 0.f;
    for (int q = 0; q < part; ++q) { const float2 lq = sL[q * 32 + sl]; const float nr = dr * xr - di * xi + lq.x, ni = dr * xi + di * xr + lq.y; xr = nr; xi = ni; }
#pragma unroll
    for (int i = 0; i < 32; ++i) {
        const float2 o = (float2){xr, xi};
        const float nr = a.x * xr - a.y * xi + c[i].x, ni = a.x * xi + a.y * xr + c[i].y; xr = nr; xi = ni;
        xc[(size_t)i * 1024] = o;
        xch[(size_t)i * 1024] = (half2_){(h16)o.x, (h16)o.y};
    }
    __syncthreads();
}
DI void cmp_l2_item(PP P, int l, int item, char* smem, const int wv) {
    P = plaunder(P);
    const int tid = otid(wv), lane = tid & 63, w = tid >> 6;
    const int j = item >> 8, r0 = (item & 255) * 8;
    h16* w2s = (h16*)smem;
    float* hs = (float*)(smem + 32768);
    {
        const float* w2 = P->in[I_CW2] + (size_t)(l * 2 + j) * 256 * 64;
        for (int e = tid * 4; e < 256 * 64; e += 1024) {
            const float4 v = *(const float4*)(w2 + e);
            *(half4*)(w2s + e) = (half4){(h16)v.x, (h16)v.y, (h16)v.z, (h16)v.w};
        }
        const float* pt = (const float*)(P->ws + OFF_CHID) + (size_t)j * 2048 * 512;
        float pb = 0.f;
#pragma unroll
        for (int ks = 0; ks < 16; ++ks) pb += ((const float*)(P->ws + OFF_POSB))[((l * 2 + j) * 16 + ks) * 256 + tid];
#pragma unroll
        for (int rr = 0; rr < 8; ++rr) {
            const int row = r0 + rr, i = row & 511;
            float v = 0.f;
            if (i < 511) v = gelu_tanh(pt[(size_t)row * 512 + tid] + pt[(size_t)(row + 1) * 512 + 256 + tid] + pb);
            hs[rr * 256 + tid] = v;
        }
    }
    __syncthreads();
    const float bb = P->in[I_CB2][(l * 2 + j) * 64 + lane];
    float a0 = bb, a1 = bb;
    const float* h0 = hs + (2 * w) * 256, *h1 = h0 + 256;
#pragma unroll 8
    for (int n = 0; n < 256; ++n) {
        const float wv = (float)w2s[n * 64 + lane];
        a0 += h0[n] * wv; a1 += h1[n] * wv;
    }
#pragma unroll
    for (int rr = 0; rr < 2; ++rr) {
        float acc = rr ? a1 : a0;
        const int row = r0 + 2 * w + rr, bg = row >> 9, i = row & 511;
        if (i == 511) acc = 0.f;
        if (j == 0) {
            const float ss = wave_sum(acc * acc);
            acc = acc * rsqrtf(ss * (1.f / 64.f) + 1e-6f) * P->in[I_NKN][(l * 3 + 0) * 64 + lane];
            ((h16*)(P->ws + OFF_KCMP))[(size_t)row * 64 + lane] = (h16)acc;
        } else {
            ((h16*)(P->ws + OFF_VCMP))[(((size_t)bg * 8 + (i >> 6)) * 64 + lane) * 64 + vkperm(i & 63)] = (h16)acc;
        }
    }
    __syncthreads();
}

DI void s5o_gemm_tile(PP P, int l, int tile, char* smem, const int wv) {
    P = plaunder(P);
    const int g = tile >> 5, mt = (tile >> 3) & 3, nt = tile & 7;
    f32x4 acc[2][4];
    float ssd[2];
    gemm_glds<false, 4, 2, 4>(wv, 640, AS5{(const h16*)(P->ws + OFF_PROJ) + C_SU + g * 16, (const h16*)(P->ws + OFF_XCH) + g * 128, mt * 128},
                              (const h16*)(P->ws + OFF_S5W) + ((size_t)g * 512 + nt * 64) * 640, 640, acc, ssd, smem);
    const int tid = otid(wv), lane = tid & 63, wid = tid >> 6;
    const h16* proj = (const h16*)(P->ws + OFF_PROJ);
    h16* yact = (h16*)(P->ws + OFF_YACT);
#pragma unroll
    for (int i = 0; i < 2; ++i) {
        const size_t ch = (size_t)mt * 128 + wid * 32 + i * 16 + (lane & 15);
#pragma unroll
        for (int jj = 0; jj < 4; ++jj) {
            const int n = nt * 64 + jj * 16 + (lane >> 4) * 4;
            const int j = n >> 4, c = n & 15;
            const size_t tok = ch * 32 + j;
            const half4 u4 = *(const half4*)(proj + tok * D_IN + C_SU + g * 16 + c);
            const float4 dd = *(const float4*)(P->in[I_SD] + (l * 16 + g) * 16 + c);
            const f32x4 v = acc[i][jj];
            half4 o;
            o[0] = (h16)gelu_tanh(v[0] + dd.x * (float)u4[0]);
            o[1] = (h16)gelu_tanh(v[1] + dd.y * (float)u4[1]);
            o[2] = (h16)gelu_tanh(v[2] + dd.z * (float)u4[2]);
            o[3] = (h16)gelu_tanh(v[3] + dd.w * (float)u4[3]);
            *(half4*)(yact + tok * 256 + g * 16 + c) = o;
        }
    }
}

#define MFMA32(a, b, c) __builtin_amdgcn_mfma_f32_32x32x16_f16((a), (b), (c), 0, 0, 0)
constexpr float NEGS = -1e30f;
DI float ex2(float x) { return __builtin_amdgcn_exp2f(x); }
#define NSA_WAITBAR(N) asm volatile("s_waitcnt vmcnt(" #N ") lgkmcnt(0)\n\ts_barrier" ::: "memory")
#define NSA_BAR() asm volatile("s_waitcnt lgkmcnt(0)\n\ts_barrier" ::: "memory")

struct KVSrc { const h16* k; int ldk; size_t kstep; const h16* v; };
DI void nsa_dma(const KVSrc& s, int j, char* stage, int wid, int lane) {
    const int row0 = wid * 8 + (lane >> 3);
    const int sw = ((lane & 7) ^ ((row0 >> 1) & 7)) * 8;
    const h16* kp = s.k + (size_t)j * s.kstep + (size_t)row0 * s.ldk + sw;
    glds16(kp, stage + wid * 1024);
    glds16(kp + (size_t)32 * s.ldk, stage + 4096 + wid * 1024);
    const h16* vp = s.v + (size_t)j * 4096 + row0 * 64 + sw;
    glds16(vp, stage + 8192 + wid * 1024);
    glds16(vp + 32 * 64, stage + 8192 + 4096 + wid * 1024);
}
template <int NST, class F>
DI void nsa_pipe(const KVSrc& s, const int n, char* smem, int wid, int lane, F&& compute) {
    NSA_WAITBAR(0);
    {
        const int k = n < NST - 1 ? n : NST - 1;
        for (int p = 0; p < k; ++p) nsa_dma(s, p, smem + p * 16384, wid, lane);
        if (k >= 3) NSA_WAITBAR(8); else if (k == 2) NSA_WAITBAR(4); else NSA_WAITBAR(0);
        __builtin_amdgcn_s_sleep(2);
    }
    for (int j = 0; j < n; ++j) {
        if (NST == 4 && j + 2 < n) NSA_WAITBAR(4); else NSA_WAITBAR(0);
        const int jn = j + NST - 1;
        compute(j, smem + (j % NST) * 16384, [&]() { if (jn < n) nsa_dma(s, jn, smem + (jn % NST) * 16384, wid, lane); });
    }
}

template <bool SHIFT = false, class BF>
DI void qk_tile(const char* Kimg, const half8 (&qf)[4], f32x16 (&s)[2], int lane, BF&& between) {
    const int r = lane & 31, h = lane >> 5, swz = (r >> 1) & 7;
    const char* base = Kimg + r * 128;
    half8 kf[8];
#pragma unroll
    for (int kt = 0; kt < 2; ++kt)
#pragma unroll
        for (int ks = 0; ks < 4; ++ks) kf[kt * 4 + ks] = *(const half8*)(base + kt * 4096 + (((2 * ks + h) ^ swz) << 4));
    __builtin_amdgcn_sched_barrier(0);
    between();
    __builtin_amdgcn_sched_barrier(0);
#pragma unroll
    for (int kt = 0; kt < 2; ++kt) {
#pragma unroll
        for (int e = 0; e < 16; ++e) s[kt][e] = 0.f;
#pragma unroll
        for (int ks = 0; ks < 4; ++ks) s[kt] = MFMA32(kf[kt * 4 + ks], qf[ks], s[kt]);
    }
}
template <bool SHIFT = false>
DI void qk_tile(const char* Kimg, const half8 (&qf)[4], f32x16 (&s)[2], int lane) { qk_tile<SHIFT>(Kimg, qf, s, lane, []() {}); }
DI float psum8(const half8& p, float acc) {
    const half2_ one = (half2_){(h16)1.f, (h16)1.f};
#pragma unroll
    for (int e = 0; e < 4; ++e) acc = __builtin_amdgcn_fdot2((half2_){p[2 * e], p[2 * e + 1]}, one, acc, false);
    return acc;
}
template <int S> DI half8 pack8(const f32x16& x) {
    return (half8){(h16)x[8 * S], (h16)x[8 * S + 1], (h16)x[8 * S + 2], (h16)x[8 * S + 3], (h16)x[8 * S + 4], (h16)x[8 * S + 5], (h16)x[8 * S + 6], (h16)x[8 * S + 7]};
}
template <int KT>
DI void pv_load(const char* Vimg, half8 (&vf)[4], int lane) {
    const int r = lane & 31, h = lane >> 5, swz = (r >> 1) & 7;
    const char* rb = Vimg + r * 128;
#pragma unroll
    for (int dt = 0; dt < 2; ++dt) {
        vf[dt * 2 + 0] = *(const half8*)(rb + dt * 4096 + (((4 * KT + h) ^ swz) << 4));
        vf[dt * 2 + 1] = *(const half8*)(rb + dt * 4096 + (((4 * KT + 2 + h) ^ swz) << 4));
    }
}
typedef unsigned u32x4_ __attribute__((ext_vector_type(4)));
template <int KT, bool MASKED = false>
DI void pv_mma(const half8 (&vf)[4], const f32x16 (&p)[2], f32x16 (&o)[2], const unsigned rmask = 0xffffffffu) {
    half8 pb0 = pack8<0>(p[KT]), pb1 = pack8<1>(p[KT]);
    if (MASKED) {
        pb0 = __builtin_bit_cast(half8, __builtin_bit_cast(u32x4_, pb0) & rmask);
        pb1 = __builtin_bit_cast(half8, __builtin_bit_cast(u32x4_, pb1) & rmask);
    }
#pragma unroll
    for (int dt = 0; dt < 2; ++dt) {
        o[dt] = MFMA32(vf[dt * 2 + 0], pb0, o[dt]);
        o[dt] = MFMA32(vf[dt * 2 + 1], pb1, o[dt]);
    }
}
template <bool MASKED = false>
DI void pv_finish(const char* Vimg, const half8 (&va)[4], const f32x16 (&p)[2], f32x16 (&o)[2], int lane, const unsigned rmask = 0xffffffffu) {
    half8 vb[4];
    pv_load<1>(Vimg, vb, lane);
    pv_mma<0, MASKED>(va, p, o, rmask);
    pv_mma<1, MASKED>(vb, p, o, rmask);
}
DI float sm_fast(f32x16 (&s)[2]) {
    float rs = 0.f;
#pragma unroll
    for (int kt = 0; kt < 2; ++kt)
#pragma unroll
        for (int e = 0; e < 16; ++e) { const float p = ex2(s[kt][e]); s[kt][e] = p; rs += p; }
    return rs;
}
DI float rowmax32(const f32x16 (&s)[2]) {
    float mx = s[0][0];
#pragma unroll
    for (int e = 1; e < 16; ++e) mx = fmaxf(mx, s[0][e]);
#pragma unroll
    for (int e = 0; e < 16; ++e) mx = fmaxf(mx, s[1][e]);
    return xhalf_max(mx);
}
constexpr float SM_THR = 6.f;
DI void sm_online(f32x16 (&s)[2], float& m, float& l, f32x16 (&o)[2], const bool rowok) {
    float mx = rowmax32(s);
    mx = rowok ? mx : NEGS;
    if (__any(mx > m + SM_THR)) {
        const float mn = fmaxf(m, mx), alpha = ex2(m - mn);
        l *= alpha; o[0] *= alpha; o[1] *= alpha; m = mn;
    }
    const float msub = rowok ? m : 1e30f;
    float rs = 0.f;
#pragma unroll
    for (int kt = 0; kt < 2; ++kt)
#pragma unroll
        for (int e = 0; e < 16; ++e) { const float p = ex2(s[kt][e] - msub); s[kt][e] = p; rs += p; }
    l += xhalf_sum(rs);
}

template <int V> struct IC { static constexpr int value = V; };
template <bool FAST>
DI void nsa_unit(PP P, int l, int bg, int c32, char* smem, const int wv) {
    P = plaunder(P);
    const int tid = otid(wv), lane = tid & 63, w = tid >> 6, r = lane & 31, h = lane >> 5;
    const int b = bg >> 1, g = bg & 1, t0 = c32 * 32, cur = c32 >> 1;
    const int tokl = w * 8 + (r >> 2), head = r & 3, t = t0 + tokl;
    const size_t tokg = (size_t)b * SEQ + t;
    float* IMP = (float*)(smem + 49152);
    unsigned* SELM = (unsigned*)(smem + 65536);
    const h16* proj = (const h16*)(P->ws + OFF_PROJ);
    const int ghead = g * 4 + head;

    half8 qf[4];
    {
        const h16* qp = proj + tokg * D_IN + C_NQ + ghead * 64 + 8 * h;
#pragma unroll
        for (int ks = 0; ks < 4; ++ks) qf[ks] = *(const half8*)(qp + 16 * ks);
    }
    auto gate = [&](const int br) -> float {
        const int tid_ = otid(wv), r_ = tid_ & 31, tokl_ = (tid_ >> 6) * 8 + (r_ >> 2), gh_ = g * 4 + (r_ & 3);
        const size_t tokg_ = (size_t)b * SEQ + t0 + tokl_;
        return sigmoidf_((float)proj[tokg_ * D_IN + C_NGL + gh_ * 3 + br] + P->in[I_NGB][l * 24 + gh_ * 3 + br]);
    };
    __syncthreads();
    for (int i = tid; i < 32 * 128; i += 256) IMP[i] = 0.f;

    half8 oacc[4];
    auto oacc_add = [&](const f32x16 (&o)[2], const float sc, const bool first) {
#pragma unroll
        for (int dt = 0; dt < 2; ++dt)
#pragma unroll
            for (int hf = 0; hf < 2; ++hf) {
                half8 v = oacc[dt * 2 + hf];
#pragma unroll
                for (int e = 0; e < 8; ++e) v[e] = (h16)((first ? 0.f : (float)v[e]) + o[dt][hf * 8 + e] * sc);
                oacc[dt * 2 + hf] = v;
            }
    };

    {
        const int nvt = 2 * c32 + 1;
        const int nvr = (t >= 31) ? ((t - 31) >> 4) + 1 : 0;
        const int ntile = (nvt + 63) >> 6;
        KVSrc src{(const h16*)(P->ws + OFF_KCMP) + (size_t)bg * 512 * 64, 64, 4096, (const h16*)(P->ws + OFF_VCMP) + (size_t)bg * 8 * 4096};
        f32x16 o[2];
#pragma unroll
        for (int e = 0; e < 16; ++e) { o[0][e] = 0.f; o[1][e] = 0.f; }
        float invl;
        if constexpr (FAST) {
            const int tf = t0 + w * 8;
            const int nvlo = __builtin_amdgcn_readfirstlane((tf >= 31) ? ((tf - 31) >> 4) + 1 : 0);
            float lsum = 0.f;
            nsa_pipe<3>(src, ntile, smem, w, lane, [&](int j, const char* st, auto&& issue) {
                f32x16 s[2];
                qk_tile<true>(st, qf, s, lane);
                issue();
                if (64 * j + 64 > nvlo) {
#pragma unroll
                    for (int kt = 0; kt < 2; ++kt)
#pragma unroll
                        for (int e = 0; e < 16; ++e) {
                            const int key = 64 * j + 32 * kt + 8 * (e >> 2) + 4 * h + (e & 3);
                            if (key >= nvr) s[kt][e] = NEGS;
                        }
                }
                lsum += sm_fast(s);
            });
            lsum = xhalf_sum(lsum);
            invl = lsum > 0.f ? 1.f / lsum : 0.f;
            nsa_pipe<3>(src, ntile, smem, w, lane, [&](int j, const char* st, auto&& issue) {
                f32x16 s[2];
                qk_tile<true>(st, qf, s, lane);
                half8 vf[4];
                pv_load<0>(st + 8192, vf, lane);
                issue();
                __builtin_amdgcn_sched_barrier(0);
                if (64 * j + 64 > nvlo) {
#pragma unroll
                    for (int kt = 0; kt < 2; ++kt)
#pragma unroll
                        for (int e = 0; e < 16; ++e) {
                            const int key = 64 * j + 32 * kt + 8 * (e >> 2) + 4 * h + (e & 3);
                            if (key >= nvr) s[kt][e] = NEGS;
                        }
                }
                (void)sm_fast(s);
                if (cur >= 16) {
#pragma unroll
                    for (int kt = 0; kt < 2; ++kt)
#pragma unroll
                        for (int g4 = 0; g4 < 4; ++g4) {
                            float G = ((s[kt][4 * g4] + s[kt][4 * g4 + 1]) + (s[kt][4 * g4 + 2] + s[kt][4 * g4 + 3])) * invl;
                            float L = s[kt][4 * g4 + 3] * invl;
                            G += shx<1>(G); G += shx<2>(G);
                            L += shx<1>(L); L += shx<2>(L);
                            if (head == 0) {
                                const int sb = 16 * j + 8 * kt + 2 * g4 + h;
                                atomicAdd(&IMP[tokl * 128 + sb], G);
                                if (sb + 1 < 128) atomicAdd(&IMP[tokl * 128 + sb + 1], L);
                            }
                        }
                }
                pv_finish(st + 8192, vf, s, o, lane);
            });
        } else {
        float m = -1e20f, lsum = 0.f;
        nsa_pipe<3>(src, ntile, smem, w, lane, [&](int j, const char* st, auto&& issue) {
            f32x16 s[2];
            qk_tile(st, qf, s, lane);
            issue();
#pragma unroll
            for (int kt = 0; kt < 2; ++kt)
#pragma unroll
                for (int e = 0; e < 16; ++e) {
                    const int key = 64 * j + 32 * kt + 8 * (e >> 2) + 4 * h + (e & 3);
                    if (key >= nvr) s[kt][e] = NEGS;
                }
            const float mn = fmaxf(m, rowmax32(s)), alpha = ex2(m - mn);
            float rs = 0.f;
#pragma unroll
            for (int kt = 0; kt < 2; ++kt)
#pragma unroll
                for (int e = 0; e < 16; ++e) rs += ex2(s[kt][e] - mn);
            rs = xhalf_sum(rs);
            lsum = lsum * alpha + rs; m = mn;
        });
        const float invl_s = lsum > 0.f ? 1.f / lsum : 0.f;
        nsa_pipe<3>(src, ntile, smem, w, lane, [&](int j, const char* st, auto&& issue) {
            f32x16 s[2];
            qk_tile(st, qf, s, lane);
            half8 vf[4];
            pv_load<0>(st + 8192, vf, lane);
            issue();
            __builtin_amdgcn_sched_barrier(0);
#pragma unroll
            for (int kt = 0; kt < 2; ++kt)
#pragma unroll
                for (int e = 0; e < 16; ++e) {
                    const int key = 64 * j + 32 * kt + 8 * (e >> 2) + 4 * h + (e & 3);
                    s[kt][e] = (key < nvr) ? ex2(s[kt][e] - m) * invl_s : 0.f;
                }
            if (cur >= 16) {
#pragma unroll
                for (int kt = 0; kt < 2; ++kt)
#pragma unroll
                    for (int g4 = 0; g4 < 4; ++g4) {
                        float G = (s[kt][4 * g4] + s[kt][4 * g4 + 1]) + (s[kt][4 * g4 + 2] + s[kt][4 * g4 + 3]);
                        float L = s[kt][4 * g4 + 3];
                        G += shx<1>(G); G += shx<2>(G);
                        L += shx<1>(L); L += shx<2>(L);
                        if (head == 0) {
                            const int sb = 16 * j + 8 * kt + 2 * g4 + h;
                            atomicAdd(&IMP[tokl * 128 + sb], G);
                            if (sb + 1 < 128) atomicAdd(&IMP[tokl * 128 + sb + 1], L);
                        }
                    }
            }
            pv_finish(st + 8192, vf, s, o, lane);
        });
            invl = 1.f;
        }
        oacc_add(o, gate(0) * invl, true);
    }
    __syncthreads();
    {
        const int tl = lane >> 3, sub = lane & 7;
        unsigned bits = 0;
        unsigned u[16];
        if (cur >= 16) {
            const float* ip = IMP + (w * 8 + tl) * 128 + sub * 16;
#pragma unroll
            for (int i = 0; i < 16; ++i) {
                const int s = sub * 16 + i;
                u[i] = (s >= 1 && s <= cur - 2) ? (__float_as_uint(ip[i]) + 1u) : 0u;
            }
        }
        __syncthreads();
        if (cur >= 16) {
            unsigned prefix = 0;
            for (int bit = 30; bit >= 0; --bit) {
                const unsigned cand = prefix | (1u << bit);
                int cnt = 0;
#pragma unroll
                for (int i = 0; i < 16; ++i) cnt += (u[i] >= cand) ? 1 : 0;
                cnt += shx_i<1>(cnt); cnt += shx_i<2>(cnt); cnt += shx_i<4>(cnt);
                if (cnt >= 13) prefix = cand;
            }
            int cgt = 0, ceq = 0;
#pragma unroll
            for (int i = 0; i < 16; ++i) { cgt += (u[i] > prefix) ? 1 : 0; ceq += (u[i] == prefix) ? 1 : 0; }
            cgt += shx_i<1>(cgt); cgt += shx_i<2>(cgt); cgt += shx_i<4>(cgt);
            int inc = ceq;
            { const int v = row_shr_i<1>(inc); if (sub >= 1) inc += v; }
            { const int v = row_shr_i<2>(inc); if (sub >= 2) inc += v; }
            { const int v = row_shr_i<4>(inc); if (sub >= 4) inc += v; }
            int run = inc - ceq;
            const int need = 13 - cgt;
#pragma unroll
            for (int i = 0; i < 16; ++i) {
                const int s = sub * 16 + i;
                bool sel = u[i] > prefix;
                if (u[i] == prefix) { sel = run < need; ++run; }
                if (s == 0 || s == cur || s == cur - 1) sel = true;
                bits |= (sel ? 1u : 0u) << i;
            }
        } else {
#pragma unroll
            for (int i = 0; i < 16; ++i) bits |= ((sub * 16 + i <= cur) ? 1u : 0u) << i;
        }
        unsigned wv = bits << ((sub & 1) * 16);
        wv |= (unsigned)shx_i<1>((int)wv);
        if ((sub & 1) == 0) SELM[(w * 8 + tl) * 4 + (sub >> 1)] = wv;
    }
    __syncthreads();
    const unsigned* selrow = SELM + tokl * 4;

    auto branch = [&](auto BRC) {
        constexpr int br = decltype(BRC)::value;
        const int j0 = (br == 0) ? 0 : (cur - 8 > 0 ? cur - 8 : 0);
        const int nst = cur - j0 + 1;
        KVSrc src{proj + ((size_t)b * SEQ + (size_t)j0 * 64) * D_IN + C_NKV + (br == 0 ? 256 : 512) + g * 64, D_IN, (size_t)64 * D_IN,
                  (const h16*)(P->ws + OFF_VTG) + (((size_t)br * 4 + bg) * 128 + j0) * 4096};
        float m = -1e20f, lsum = 0.f;
        f32x16 o[2];
#pragma unroll
        for (int e = 0; e < 16; ++e) { o[0][e] = 0.f; o[1][e] = 0.f; }
        if constexpr (FAST) {
            f32x16 s[2];
            NSA_WAITBAR(0);
            {
                const int k = nst < 3 ? nst : 3;
                for (int p = 0; p < k; ++p) nsa_dma(src, p, smem + p * 16384, w, lane);
            }
            NSA_WAITBAR(0);
            __builtin_amdgcn_s_sleep(2);
            NSA_BAR();
            qk_tile<true>(smem, qf, s, lane);
            const int r_ = lane & 31, swz_ = (r_ >> 1) & 7;
#pragma unroll 1
            for (int jj = 0; jj + 1 < nst; ++jj) {
                NSA_WAITBAR(0);
                const char* stv = smem + (jj & 3) * 16384 + 8192;
                const char* stk = smem + ((jj + 1) & 3) * 16384 + r_ * 128;
                const int j = j0 + jj;
                const bool rowok = (br != 0) || (((selrow[j >> 5] >> (j & 31)) & 1u) != 0u);
                const unsigned rmask = rowok ? 0xffffffffu : 0u;
                half8 kfa[4];
#pragma unroll
                for (int ks = 0; ks < 4; ++ks) kfa[ks] = *(const half8*)(stk + (((2 * ks + h) ^ swz_) << 4));
                half8 va[4];
                pv_load<0>(stv, va, lane);
                __builtin_amdgcn_sched_barrier(0);
                if (jj + 3 < nst) nsa_dma(src, jj + 3, smem + ((jj + 3) & 3) * 16384, w, lane);
                __builtin_amdgcn_sched_barrier(0);
                if (br == 1 && jj == 0 && cur >= 8) {
#pragma unroll
                    for (int kt = 0; kt < 2; ++kt)
#pragma unroll
                        for (int e = 0; e < 16; ++e) {
                            const int key = 64 * j + 32 * kt + 8 * (e >> 2) + 4 * h + (e & 3);
                            if (!(key > t - 512)) s[kt][e] = NEGS;
                        }
                }
#pragma unroll
                for (int e = 0; e < 16; ++e) s[0][e] = ex2(s[0][e]);
                half8 pa0 = pack8<0>(s[0]), pa1 = pack8<1>(s[0]);
                if (br == 0) {
                    pa0 = __builtin_bit_cast(half8, __builtin_bit_cast(u32x4_, pa0) & rmask);
                    pa1 = __builtin_bit_cast(half8, __builtin_bit_cast(u32x4_, pa1) & rmask);
                }
                lsum = psum8(pa1, psum8(pa0, lsum));
                __builtin_amdgcn_sched_barrier(0);
                f32x16 sn0, sn1;
#pragma unroll
                for (int e = 0; e < 16; ++e) { sn0[e] = 0.f; sn1[e] = 0.f; }
#pragma unroll
                for (int ks = 0; ks < 4; ++ks) sn0 = MFMA32(kfa[ks], qf[ks], sn0);
                o[0] = MFMA32(va[0], pa0, o[0]);
                o[0] = MFMA32(va[1], pa1, o[0]);
                o[1] = MFMA32(va[2], pa0, o[1]);
                o[1] = MFMA32(va[3], pa1, o[1]);
                half8 kfb[4];
#pragma unroll
                for (int ks = 0; ks < 4; ++ks) kfb[ks] = *(const half8*)(stk + 4096 + (((2 * ks + h) ^ swz_) << 4));
                half8 vb[4];
                pv_load<1>(stv, vb, lane);
#pragma unroll
                for (int e = 0; e < 16; ++e) s[1][e] = ex2(s[1][e]);
                half8 pb0 = pack8<0>(s[1]), pb1 = pack8<1>(s[1]);
                if (br == 0) {
                    pb0 = __builtin_bit_cast(half8, __builtin_bit_cast(u32x4_, pb0) & rmask);
                    pb1 = __builtin_bit_cast(half8, __builtin_bit_cast(u32x4_, pb1) & rmask);
                }
                lsum = psum8(pb1, psum8(pb0, lsum));
                __builtin_amdgcn_sched_barrier(0);
#pragma unroll
                for (int ks = 0; ks < 4; ++ks) sn1 = MFMA32(kfb[ks], qf[ks], sn1);
                o[0] = MFMA32(vb[0], pb0, o[0]);
                o[0] = MFMA32(vb[1], pb1, o[0]);
                o[1] = MFMA32(vb[2], pb0, o[1]);
                o[1] = MFMA32(vb[3], pb1, o[1]);
                s[0] = sn0; s[1] = sn1;
            }
            {
                const int jj = nst - 1, j = cur;
                const char* stv = smem + (jj & 3) * 16384 + 8192;
                const bool rowok = (br != 0) || (((selrow[j >> 5] >> (j & 31)) & 1u) != 0u);
                half8 va[4];
                pv_load<0>(stv, va, lane);
#pragma unroll
                for (int kt = 0; kt < 2; ++kt)
#pragma unroll
                    for (int e = 0; e < 16; ++e) {
                        const int key = 64 * j + 32 * kt + 8 * (e >> 2) + 4 * h + (e & 3);
                        const bool ok = (key <= t) && (br == 0 || key > t - 512);
                        if (!ok) s[kt][e] = NEGS;
                    }
                const float rs = sm_fast(s);
                lsum += rowok ? rs : 0.f;
                pv_finish<br == 0>(stv, va, s, o, lane, rowok ? 0xffffffffu : 0u);
            }
        } else {
        nsa_pipe<4>(src, nst, smem, w, lane, [&](int jj, const char* st, auto&& issue) {
            const int j = j0 + jj;
            const bool rowok = (br != 0) || (((selrow[j >> 5] >> (j & 31)) & 1u) != 0u);
            f32x16 s[2];
            qk_tile<FAST>(st, qf, s, lane, issue);
            half8 vf[4];
            pv_load<0>(st + 8192, vf, lane);
            __builtin_amdgcn_sched_barrier(0);
            if (j == cur || (br == 1 && j == cur - 8)) {
#pragma unroll
                for (int kt = 0; kt < 2; ++kt)
#pragma unroll
                    for (int e = 0; e < 16; ++e) {
                        const int key = 64 * j + 32 * kt + 8 * (e >> 2) + 4 * h + (e & 3);
                        const bool ok = (key <= t) && (br == 0 || key > t - 512);
                        if (!ok) s[kt][e] = NEGS;
                    }
            }
            sm_online(s, m, lsum, o, rowok);
            pv_finish(st + 8192, vf, s, o, lane);
        });
        }
        if constexpr (FAST) lsum = xhalf_sum(lsum);
        const float sc = gate(br == 0 ? 1 : 2) / lsum;
        oacc_add(o, sc, false);
    };
    branch(IC<0>{});
    branch(IC<1>{});
    {
        const int tid_ = otid(wv), r_ = tid_ & 31, h_ = (tid_ >> 5) & 1, tokl_ = (tid_ >> 6) * 8 + (r_ >> 2), gh_ = g * 4 + (r_ & 3);
        const size_t tokg_ = (size_t)b * SEQ + t0 + tokl_;
        h16* mixp = (h16*)(P->ws + OFF_MIX) + kb_idx(NT, tokg_, 512 + gh_ * 64);
        const h16* ngp = proj + tokg_ * D_IN + C_NG + gh_ * 64;
#pragma unroll
        for (int dt = 0; dt < 2; ++dt)
#pragma unroll
            for (int g4 = 0; g4 < 4; ++g4) {
                const int d0 = 32 * dt + 8 * g4 + 4 * h_;
                const half4 ng = *(const half4*)(ngp + d0);
                half4 ov;
#pragma unroll
                for (int e = 0; e < 4; ++e) ov[e] = (h16)((float)oacc[dt * 2 + (g4 >> 1)][(g4 & 1) * 4 + e] * siluf_((float)ng[e]));
                *(half4*)(mixp + d0) = ov;
            }
    }
    __syncthreads();
}

DI void gla_kv_item(PP P, int l, int item, char* smem, const int wv) {
    P = plaunder(P);
    const int tid = otid(wv), lane = tid & 63, w = tid >> 6, r = lane & 31, hh = lane >> 5;
    const int pair = item * 4 + w, h = pair & 3, cn = pair >> 2;
    const size_t tok = (size_t)cn * 32 + r;
    const int b = cn >> 8, n = cn & 255, bh = b * 4 + h;
    const h16* proj = (const h16*)(P->ws + OFF_PROJ);
    h16* VT = (h16*)(smem + w * 16384);
    h16* KT = VT + 2048;
    __syncthreads();
    {
        const half8* vp = (const half8*)(proj + tok * D_IN + C_GV + h * 64 + hh * 32);
#pragma unroll
        for (int q = 0; q < 4; ++q) {
            const half8 v8 = vp[q];
#pragma unroll
            for (int e = 0; e < 8; ++e) VT[(hh * 32 + q * 8 + e) * 32 + r] = v8[e];
        }
    }
    float gl[16];
    {
        const half8* lp = (const half8*)(proj + tok * D_IN + C_GLR);
        const half8 l0 = lp[0], l1 = lp[1];
        float lr[16];
#pragma unroll
        for (int q = 0; q < 8; ++q) { lr[q] = (float)l0[q]; lr[8 + q] = (float)l1[q]; }
        const float* w2 = P->in[I_GW2] + (size_t)l * 16 * 128 + h * 32 + 16 * hh;
        const float* b2 = P->in[I_GB2] + l * 128 + h * 32 + 16 * hh;
#pragma unroll
        for (int d = 0; d < 16; ++d) gl[d] = b2[d];
#pragma unroll
        for (int q = 0; q < 16; ++q)
#pragma unroll
            for (int d4 = 0; d4 < 4; ++d4) {
                const float4 wq = *(const float4*)(w2 + q * 128 + d4 * 4);
                gl[d4 * 4 + 0] += lr[q] * wq.x; gl[d4 * 4 + 1] += lr[q] * wq.y; gl[d4 * 4 + 2] += lr[q] * wq.z; gl[d4 * 4 + 3] += lr[q] * wq.w;
            }
#pragma unroll
        for (int d = 0; d < 16; ++d) gl[d] = log_sigmoidf_(gl[d]) * (1.f / 16.f);
    }
#pragma unroll
    for (int off = 1; off < 32; off <<= 1) {
        const int src = olane() - off;
#pragma unroll
        for (int d = 0; d < 16; ++d) { const float v = bperm(gl[d], src); if (r >= off) gl[d] += v; }
    }
    {
        float* bc = (float*)(P->ws + OFF_BCUM) + tok * 128 + h * 32 + 16 * hh;
#pragma unroll
        for (int d4 = 0; d4 < 4; ++d4) *(float4*)(bc + d4 * 4) = (float4){gl[d4 * 4], gl[d4 * 4 + 1], gl[d4 * 4 + 2], gl[d4 * 4 + 3]};
    }
    {
        const half8* kp = (const half8*)(proj + tok * D_IN + C_GK + h * 32 + 16 * hh);
        const half8 k0 = kp[0], k1 = kp[1];
        float bl[16];
#pragma unroll
        for (int d = 0; d < 16; ++d) bl[d] = bperm(gl[d], olane() | 31);
#pragma unroll
        for (int d = 0; d < 16; ++d) {
            const float kd = (float)(d < 8 ? k0[d & 7] : k1[d & 7]) * __expf(bl[d] - gl[d]);
            KT[(16 * hh + d) * 32 + r] = (h16)kd;
        }
        if (r == 0) {
            float* dc = (float*)(P->ws + OFF_GDEC) + (size_t)(bh * 256 + n) * 32 + 16 * hh;
#pragma unroll
            for (int d4 = 0; d4 < 4; ++d4) *(float4*)(dc + d4 * 4) = (float4){__expf(bl[d4 * 4]), __expf(bl[d4 * 4 + 1]), __expf(bl[d4 * 4 + 2]), __expf(bl[d4 * 4 + 3])};
        }
    }
    asm volatile("s_waitcnt lgkmcnt(0)" ::: "memory");
    const half8 kb0 = *(const half8*)(KT + r * 32 + 8 * hh), kb1 = *(const half8*)(KT + r * 32 + 16 + 8 * hh);
    float* kvp = (float*)(P->ws + OFF_GKV) + ((size_t)(bh * 256 + n) * 32 + r) * 64;
#pragma unroll
    for (int dt = 0; dt < 2; ++dt) {
        f32x16 o;
#pragma unroll
        for (int e = 0; e < 16; ++e) o[e] = 0.f;
        const h16* vrow = VT + (32 * dt + r) * 32 + 8 * hh;
        o = MFMA32(*(const half8*)vrow, kb0, o);
        o = MFMA32(*(const half8*)(vrow + 16), kb1, o);
#pragma unroll
        for (int g4 = 0; g4 < 4; ++g4)
            *(float4*)(kvp + 32 * dt + 8 * g4 + 4 * hh) = (float4){o[4 * g4], o[4 * g4 + 1], o[4 * g4 + 2], o[4 * g4 + 3]};
    }
    __syncthreads();
}

DI void gla_out_item(PP P, int l, int item, char* smem, const int wv) {
    P = plaunder(P);
    const int tid = otid(wv), lane = tid & 63, w = tid >> 6, r = lane & 31, hh = lane >> 5;
    const int pair = item * 4 + w, h = pair & 3, cn = pair >> 2;
    const size_t tok0 = (size_t)cn * 32, tok = tok0 + r;
    const int b = cn >> 8, n = cn & 255, bh = b * 4 + h;
    const h16* proj = (const h16*)(P->ws + OFF_PROJ);
    h16* VT = (h16*)(smem + w * 16384);
    h16* SPT = VT + 2048;
    __syncthreads();
    {
        const half8* vp = (const half8*)(proj + tok * D_IN + C_GV + h * 64 + hh * 32);
        const float4* sp = (const float4*)((const float*)(P->ws + OFF_GKV) + ((size_t)(bh * 256 + n) * 32 + r) * 64 + hh * 32);
#pragma unroll
        for (int q = 0; q < 4; ++q) {
            const half8 v8 = vp[q];
            const float4 s0 = sp[2 * q], s1 = sp[2 * q + 1];
#pragma unroll
            for (int e = 0; e < 8; ++e) VT[(hh * 32 + q * 8 + e) * 32 + r] = v8[e];
            SPT[(hh * 32 + q * 8 + 0) * 32 + r] = (h16)s0.x; SPT[(hh * 32 + q * 8 + 1) * 32 + r] = (h16)s0.y;
            SPT[(hh * 32 + q * 8 + 2) * 32 + r] = (h16)s0.z; SPT[(hh * 32 + q * 8 + 3) * 32 + r] = (h16)s0.w;
            SPT[(hh * 32 + q * 8 + 4) * 32 + r] = (h16)s1.x; SPT[(hh * 32 + q * 8 + 5) * 32 + r] = (h16)s1.y;
            SPT[(hh * 32 + q * 8 + 6) * 32 + r] = (h16)s1.z; SPT[(hh * 32 + q * 8 + 7) * 32 + r] = (h16)s1.w;
        }
    }
    half8 qe[2], ke[2];
#pragma unroll
    for (int ks = 0; ks < 2; ++ks) {
        const int d0 = 16 * ks + 8 * hh;
        const half8 q8 = *(const half8*)(proj + tok * D_IN + C_GQ + h * 32 + d0);
        const half8 k8 = *(const half8*)(proj + tok * D_IN + C_GK + h * 32 + d0);
        const float4 b0 = *(const float4*)((const float*)(P->ws + OFF_BCUM) + tok * 128 + h * 32 + d0);
        const float4 b1 = *(const float4*)((const float*)(P->ws + OFF_BCUM) + tok * 128 + h * 32 + d0 + 4);
        const float bc[8] = {b0.x, b0.y, b0.z, b0.w, b1.x, b1.y, b1.z, b1.w};
#pragma unroll
        for (int e = 0; e < 8; ++e) {
            const float ex = __expf(bc[e]);
            qe[ks][e] = (h16)((float)q8[e] * 0.17677669529663687f * ex);
            ke[ks][e] = (h16)((float)k8[e] * __builtin_amdgcn_rcpf(ex));
        }
    }
    f32x16 s;
#pragma unroll
    for (int e = 0; e < 16; ++e) s[e] = 0.f;
    s = MFMA32(ke[0], qe[0], s);
    s = MFMA32(ke[1], qe[1], s);
#pragma unroll
    for (int e = 0; e < 16; ++e) { const int j = (e & 3) + 8 * (e >> 2) + 4 * hh; if (j > r) s[e] = 0.f; }
    const half8 pb0 = pack8<0>(s), pb1 = pack8<1>(s);
    asm volatile("s_waitcnt lgkmcnt(0)" ::: "memory");
    f32x16 o[2];
#pragma unroll
    for (int dt = 0; dt < 2; ++dt) {
#pragma unroll
        for (int e = 0; e < 16; ++e) o[dt][e] = 0.f;
        const h16* vrow = VT + (32 * dt + r) * 32 + 4 * hh;
        const h16* srow = SPT + (32 * dt + r) * 32 + 8 * hh;
        {
            const half4 lo = *(const half4*)vrow, hi = *(const half4*)(vrow + 8);
            o[dt] = MFMA32(((half8){lo[0], lo[1], lo[2], lo[3], hi[0], hi[1], hi[2], hi[3]}), pb0, o[dt]);
        }
        {
            const half4 lo = *(const half4*)(vrow + 16), hi = *(const half4*)(vrow + 24);
            o[dt] = MFMA32(((half8){lo[0], lo[1], lo[2], lo[3], hi[0], hi[1], hi[2], hi[3]}), pb1, o[dt]);
        }
        o[dt] = MFMA32(*(const half8*)srow, qe[0], o[dt]);
        o[dt] = MFMA32(*(const half8*)(srow + 16), qe[1], o[dt]);
    }
    float ss = 0.f;
#pragma unroll
    for (int e = 0; e < 16; ++e) ss += o[0][e] * o[0][e] + o[1][e] * o[1][e];
    ss = xhalf_sum(ss);
    const float rn = rsqrtf(ss * (1.f / 64.f) + 1e-6f);
    h16* mix = (h16*)(P->ws + OFF_MIX);
#pragma unroll
    for (int dt = 0; dt < 2; ++dt)
#pragma unroll
        for (int g4 = 0; g4 < 4; ++g4) {
            const int e0 = 32 * dt + 8 * g4 + 4 * hh;
            const half4 gt = *(const half4*)(proj + tok * D_IN + C_GG + h * 64 + e0);
            const float4 on = *(const float4*)(P->in[I_GON] + l * 64 + e0);
            half4 ov;
            ov[0] = (h16)(o[dt][4 * g4 + 0] * rn * on.x * siluf_((float)gt[0]));
            ov[1] = (h16)(o[dt][4 * g4 + 1] * rn * on.y * siluf_((float)gt[1]));
            ov[2] = (h16)(o[dt][4 * g4 + 2] * rn * on.z * siluf_((float)gt[2]));
            ov[3] = (h16)(o[dt][4 * g4 + 3] * rn * on.w * siluf_((float)gt[3]));
            *(half4*)(mix + kb_idx(NT, tok, h * 64 + e0)) = ov;
        }
    __syncthreads();
}

DI void glu_tile(PP P, int l, int tile, char* smem, const int wv) {
    P = plaunder(P);
    const int mt = tile >> 2, nt = tile & 3;
    f32x4 acc[4][4];
    float ssd[4];
    gemm_mainloop_glds<false>(wv, 256, APlain{(const h16*)(P->ws + OFF_YACT) + (size_t)mt * 128 * 256, 256, 64},
                              (const h16*)(P->ws + OFF_WTGLU) + ((size_t)l * 512 + nt * 128) * 256, 256, acc, ssd, smem);
    const int tid = otid(wv), lane = tid & 63, wid = tid >> 6, wr = wid >> 1, wc = wid & 1;
    const h16* proj = (const h16*)(P->ws + OFF_PROJ);
    h16* mix = (h16*)(P->ws + OFF_MIX);
    const float* gb = P->in[I_GLUB] + l * 512;
#pragma unroll
    for (int i = 0; i < 4; ++i) {
        const size_t tok = (size_t)mt * 128 + wr * 64 + i * 16 + (lane & 15);
#pragma unroll
        for (int pj = 0; pj < 2; ++pj) {
            const int c = nt * 64 + wc * 32 + pj * 16 + (lane >> 4) * 4;
            const f32x4 z1 = acc[i][2 * pj], z2 = acc[i][2 * pj + 1];
            const float4 b1 = *(const float4*)(gb + c), b2 = *(const float4*)(gb + 256 + c);
            const half4 g4 = *(const half4*)(proj + tok * D_IN + C_SG + c);
            half4 o;
            o[0] = (h16)((z1[0] + b1.x) * sigmoidf_(z2[0] + b2.x) * siluf_((float)g4[0]));
            o[1] = (h16)((z1[1] + b1.y) * sigmoidf_(z2[1] + b2.y) * siluf_((float)g4[1]));
            o[2] = (h16)((z1[2] + b1.z) * sigmoidf_(z2[2] + b2.z) * siluf_((float)g4[2]));
            o[3] = (h16)((z1[3] + b1.w) * sigmoidf_(z2[3] + b2.w) * siluf_((float)g4[3]));
            *(half4*)(mix + kb_idx(NT, tok, 256 + c)) = o;
        }
    }
}

DI void outproj_tile(PP P, int l, int mt, int nt, char* smem, const int wv) {
    P = plaunder(P);
    f32x4 acc[8][4];
    float ssd[8];
    gemm_glds<false, 2, 8, 4, 3>(wv, 1024, APlain{(const h16*)(P->ws + OFF_MIX) + (size_t)mt * 256 * 64, 64, (size_t)NT * 64},
                              (const h16*)(P->ws + OFF_WTOUT) + ((size_t)l * 16 * 1024 + nt * 128) * 64, 64, acc, ssd, smem, (size_t)1024 * 64);
    const int tid = otid(wv), lane = tid & 63, wid = tid >> 6, wr = wid >> 1, wc = wid & 1;
    const float* xin = (l == 0) ? P->in[I_X] : P->out;
    h16* xh = (h16*)(P->ws + OFF_XH);
#pragma unroll
    for (int i = 0; i < 8; ++i) {
        const size_t row = (size_t)mt * 256 + wr * 128 + i * 16 + (lane & 15);
#pragma unroll
        for (int jj = 0; jj < 4; ++jj) {
            const int n = nt * 128 + wc * 64 + jj * 16 + (lane >> 4) * 4;
            const f32x4 v = acc[i][jj];
            const float4 xo = *(const float4*)(xin + row * 1024 + n);
            const float4 xn = (float4){xo.x + v[0], xo.y + v[1], xo.z + v[2], xo.w + v[3]};
            *(float4*)(P->out + row * 1024 + n) = xn;
            *(half4*)(xh + kb_idx(NT, row, n)) = (half4){(h16)xn.x, (h16)xn.y, (h16)xn.z, (h16)xn.w};
        }
    }
}

#define XB_TMO      128
#define XB_XCNT(j)  (256  + 64 * (j))
#define XB_XSUB(j)  (1280 + 64 * (j))
#define XB_XGEN(j)  (2304 + 64 * (j))
#define XB_TOP      3328
#define XB_TOPGEN   3392
#define XCD_BAR_WORDS 3456
#define XB_SPIN_CAP (1u << 18)
#define LAS __attribute__((address_space(3)))

__device__ __forceinline__ unsigned xb_ld(unsigned* p)              { return __hip_atomic_load(p, __ATOMIC_RELAXED, __HIP_MEMORY_SCOPE_AGENT); }
__device__ __forceinline__ unsigned xb_add(unsigned* p, unsigned v) { return __hip_atomic_fetch_add(p, v, __ATOMIC_RELAXED, __HIP_MEMORY_SCOPE_AGENT); }
__device__ __forceinline__ unsigned xb_xcc_id() { return (unsigned)__builtin_amdgcn_s_getreg((3 << 11) | 20) & 0xFu; }
#define XB_SPIN(cond, bar) do { unsigned _sp = 0; while (cond) { __builtin_amdgcn_s_sleep(1); \
    if ((++_sp & 255u) == 0u) { if (xb_ld(&(bar)[XB_TMO])) break; if (_sp > XB_SPIN_CAP) { atomicAdd(&(bar)[XB_TMO], 1u); break; } } } } while (0)

struct XcdBarrier {
    unsigned* bar; unsigned x;
    volatile LAS unsigned* st;
};

__device__ __forceinline__ XcdBarrier xcd_barrier_post(unsigned* bar, volatile LAS unsigned* st) {
    XcdBarrier b; b.bar = bar; b.x = xb_xcc_id(); b.st = st;
    if (threadIdx.x == 0) (void)xb_add(&bar[XB_XCNT(b.x)], 1u);
    return b;
}
__device__ __forceinline__ void xcd_barrier_complete(unsigned* bar, unsigned x, unsigned& nloc, unsigned& nx) {
    const unsigned G = gridDim.x * gridDim.y * gridDim.z;
    unsigned sum, cnt, mine, sp = 0u;
    for (;;) {
        sum = 0u; cnt = 0u; mine = 0u;
#pragma unroll
        for (unsigned j = 0; j < 16; ++j) { const unsigned c = xb_ld(&bar[XB_XCNT(j)]); sum += c; cnt += (c > 0u) ? 1u : 0u; mine = (j == x) ? c : mine; }
        if (sum == G) break;
        __builtin_amdgcn_s_sleep(1);
        if ((++sp & 255u) == 0u) { if (xb_ld(&bar[XB_TMO])) break; if (sp > XB_SPIN_CAP) { atomicAdd(&bar[XB_TMO], 1u); break; } }
    }
    nloc = mine > 0u ? mine : 1u; nx = cnt > 0u ? cnt : 1u;
}

__device__ __forceinline__ void xcd_barrier(const XcdBarrier& b) {
    asm volatile("s_waitcnt vmcnt(0)" ::: "memory");
    __syncthreads();
    if (threadIdx.x == 0) {
        unsigned* bar = b.bar;
        __builtin_amdgcn_s_waitcnt(0);
        unsigned nloc = b.st[0], nx = b.st[1];
        if (nloc == 0u) { xcd_barrier_complete(bar, b.x, nloc, nx); b.st[0] = nloc; b.st[1] = nx; }
        const unsigned old = xb_add(&bar[XB_XSUB(b.x)], 1u);
        const unsigned gen = old / nloc;
        if (old + 1u == (gen + 1u) * nloc) {
            __builtin_amdgcn_fence(__ATOMIC_RELEASE, "agent");
            asm volatile("s_waitcnt vmcnt(0)" ::: "memory");
            const unsigned og = xb_add(&bar[XB_TOP], 1u);
            const unsigned tg = og / nx;
            if (og + 1u == (tg + 1u) * nx) xb_add(&bar[XB_TOPGEN], 1u);
            else XB_SPIN(xb_ld(&bar[XB_TOPGEN]) == tg, bar);
            __builtin_amdgcn_fence(__ATOMIC_ACQUIRE, "agent");
            xb_add(&bar[XB_XGEN(b.x)], 1u);
            asm volatile("s_waitcnt vmcnt(0)" ::: "memory");
        } else {
            XB_SPIN(xb_ld(&bar[XB_XGEN(b.x)]) == gen, bar);
            __builtin_amdgcn_fence(__ATOMIC_ACQUIRE, "agent");
            asm volatile("s_waitcnt vmcnt(0)" ::: "memory");
        }
    }
    __syncthreads();
}


__global__ void __launch_bounds__(NTHREADS, 2) fwd_megakernel(Params Pval) {
    PP P = (PP)__builtin_amdgcn_kernarg_segment_ptr();
    extern __shared__ __attribute__((aligned(16))) char smem[];
    cg::grid_group grid = cg::this_grid();
    const int G = gridDim.x, bid = blockIdx.x;
    const int wv = __builtin_amdgcn_readfirstlane((int)(threadIdx.x >> 6));

    uint4& xb_words = *(uint4*)(smem + SMEM_MAIN);
    if (otid(wv) == 0) xb_words = make_uint4(0u, 0u, 0u, 0u);
    __syncthreads();
    if (P->ws == nullptr) grid.sync();
    const XcdBarrier xb = xcd_barrier_post((unsigned*)(P->ws + OFF_BAR), (volatile LAS unsigned*)(smem + SMEM_MAIN));
    int vxcd = bid & 7, vjx = bid >> 3;
    {
        unsigned* xcnt = (unsigned*)(P->ws + OFF_BAR) + XCD_BAR_WORDS;
        volatile LAS unsigned* lw = (volatile LAS unsigned*)(smem + SMEM_MAIN) + 2;
        if (otid(wv) == 0) lw[0] = xb.x < 8u ? xb_add(&xcnt[xb.x], 1u) : 0xffffu;
        phase0(P, smem, wv);
        xcd_barrier(xb);
        if (otid(wv) == 0) {
            bool ok = (G & 7) == 0 && xb.x < 8u;
            for (int j = 0; j < 8; ++j) ok = ok && (xb_ld(&xcnt[j]) == (unsigned)(G >> 3));
            lw[1] = ok ? 1u : 0u;
        }
        __syncthreads();
        if (lw[1]) { vxcd = (int)xb.x; vjx = (int)lw[0]; }
    }
    vxcd = __builtin_amdgcn_readfirstlane(vxcd); vjx = __builtin_amdgcn_readfirstlane(vjx);

#pragma unroll 1
    for (int l = 0; l < DEPTH; ++l) {
        {
            const int xcd = vxcd, jx = vjx, nper = G >> 3;
            for (int u = jx; u < 192; u += nper) inproj_tile<2, 8>(P, l, (xcd * 8 + (u & 7)) * 256, (u >> 3) * 128, smem, wv);
            for (int it = jx; it < 16 + 40; it += nper) {
                if (it < 16) inproj_tile<4, 2>(P, l, (xcd * 16 + it) * 128, 3072, smem, wv);
                else s5_build_item(P, l, (it - 16) * 8 + xcd, smem, wv);
            }
        }
        xcd_barrier(xb);
#pragma unroll 1
        for (int w = bid; w < 128 + 64 + 512; w += G) {
            if (w < 128) cmp_gemm_tile(P, l, w, smem, wv);
            else if (w < 192) s5e_gemm_tile(P, l, w - 128, smem, wv);
            else gla_kv_item(P, l, w - 192, smem, wv);
        }
        xcd_barrier(xb);
#pragma unroll 1
        for (int w = bid; w < 512 + 512 + 64; w += G) {
            if (w < 512) cmp_l2_item(P, l, w, smem, wv);
            else if (w < 1024) gla_scan_item(P, w - 512, smem, wv);
            else s5_scan_item(P, w - 1024, smem, wv);
        }
        xcd_barrier(xb);
        bool nsa_fast;
        {
            const int ln = otid(wv) & 63;
            const float gq = wave_max(fabsf(P->in[I_NQN][l * 64 + ln]));
            const float gk = wave_max(fmaxf(fmaxf(fabsf(P->in[I_NKN][(l * 3 + 0) * 64 + ln]), fabsf(P->in[I_NKN][(l * 3 + 1) * 64 + ln])), fabsf(P->in[I_NKN][(l * 3 + 2) * 64 + ln])));
            nsa_fast = __builtin_amdgcn_readfirstlane((8.f * 1.4426950408889634f * gq * gk < 15.f) ? 1 : 0) != 0;
        }
#pragma unroll 1
        for (int w0 = bid; w0 < 512 + 512 + 512; w0 += G) {
            const int w = w0 < G ? vjx * 8 + vxcd : w0;
            if (w < 512) {
                const int bg = w & 3, q = w >> 2;
                if (nsa_fast) { nsa_unit<true>(P, l, bg, 255 - q, smem, wv); nsa_unit<true>(P, l, bg, q, smem, wv); }
                else { nsa_unit<false>(P, l, bg, 255 - q, smem, wv); nsa_unit<false>(P, l, bg, q, smem, wv); }
            } else if (w < 512 + 512) s5o_gemm_tile(P, l, w - 512, smem, wv);
            else gla_out_item(P, l, w - 1024, smem, wv);
        }
        xcd_barrier(xb);
#pragma unroll 1
        for (int w = bid; w < 512; w += G) glu_tile(P, l, w, smem, wv);
        xcd_barrier(xb);
        {
            const int xcd = vxcd, jx = vjx, nper = G >> 3;
            for (int u = jx; u < 64; u += nper) outproj_tile(P, l, xcd * 8 + (u & 7), u >> 3, smem, wv);
        }
        xcd_barrier(xb);
    }
}

extern "C" void kernel_launch(void* const* d_in, const int* in_sizes, int n_in, void* d_out, int out_size, void* d_ws,
                              size_t ws_size, hipStream_t stream) {
    static int grid_blocks = 0;
    if (!grid_blocks) {
        int dev = 0, cus = 0, per_cu = 0;
        hipGetDevice(&dev);
        hipDeviceGetAttribute(&cus, hipDeviceAttributeMultiprocessorCount, dev);
        hipFuncSetAttribute((const void*)fwd_megakernel, hipFuncAttributeMaxDynamicSharedMemorySize, SMEM_BYTES);
        hipOccupancyMaxActiveBlocksPerMultiprocessor(&per_cu, fwd_megakernel, NTHREADS, SMEM_BYTES);
        if (per_cu < 1) per_cu = 1;
        if (per_cu > 2) per_cu = 2;
        grid_blocks = cus * per_cu;
        if (ws_size < WS_END) fprintf(stderr, "kernel_launch: workspace too small: %zu < %zu\n", ws_size, (size_t)WS_END);
    }
    Params p{};
    for (int i = 0; i < 25; ++i) p.in[i] = (const float*)d_in[i];
    p.out = (float*)d_out;
    p.ws = (char*)d_ws;
    void* args[] = {&p};
    (void)hipMemsetAsync((char*)d_ws + OFF_BAR, 0, (XCD_BAR_WORDS + 16) * sizeof(unsigned), stream);
    hipError_t e = hipLaunchCooperativeKernel((const void*)fwd_megakernel, dim3(grid_blocks), dim3(NTHREADS), args, SMEM_BYTES, stream);
    if (e != hipSuccess) fprintf(stderr, "cooperative launch failed: %s (grid %d)\n", hipGetErrorString(e), grid_blocks);
}
```

```cpp
#include <hip/hip_runtime.h>
#include <hip/hip_cooperative_groups.h>
#include <cstdio>
#include <cstdint>
namespace cg = cooperative_groups;

typedef _Float16 h16;
typedef _Float16 half8 __attribute__((ext_vector_type(8)));
typedef _Float16 half4 __attribute__((ext_vector_type(4)));
typedef float f32x4 __attribute__((ext_vector_type(4)));
typedef float f32x16 __attribute__((ext_vector_type(16)));

#define DI __device__ __forceinline__

constexpr int D_MODEL = 1024, BATCH = 2, SEQ = 8192, DEPTH = 4, NT = BATCH * SEQ;
constexpr int D_IN = 3112, D_IN_PAD = 3200;
constexpr int C_NQ = 0, C_NKV = 512, C_NG = 1280, C_GQ = 1792, C_GK = 1920, C_GV = 2048, C_GG = 2304, C_SU = 2560, C_SG = 2816,
              C_GLR = 3072, C_NGL = 3088;
__host__ __device__ constexpr int map_col(int c) {
    return c < 128 ? C_GQ + c : c < 256 ? C_GK + (c - 128) : c < 512 ? C_GV + (c - 256) : c < 528 ? C_GLR + (c - 512)
         : c < 784 ? C_GG + (c - 528) : c < 1040 ? C_SU + (c - 784) : c < 1296 ? C_SG + (c - 1040) : c < 1808 ? C_NQ + (c - 1296)
         : c < 2576 ? C_NKV + (c - 1808) : c < 2600 ? C_NGL + (c - 2576) : c < 3112 ? C_NG + (c - 2600) : c;
}
constexpr int NTHREADS = 256;
constexpr float QSCALE = 0.125f * 1.4426950408889634f;

enum { I_X = 0, I_NORMG, I_WIN, I_GW2, I_GB2, I_GON, I_LRE, I_LIM, I_LSTEP, I_BRE, I_BIM, I_CRE, I_CIM, I_SD, I_GLUW, I_GLUB,
       I_NGB, I_NQN, I_NKN, I_CPOS, I_CW1, I_CB1, I_CW2, I_CB2, I_WOUT };

constexpr size_t OFF_WTIN  = 0;
constexpr size_t OFF_WTOUT = OFF_WTIN  + 4ull * D_IN_PAD * 1024 * 2;
constexpr size_t OFF_WTGLU = OFF_WTOUT + 4ull * 1024 * 1024 * 2;
constexpr size_t OFF_WTC1  = OFF_WTGLU + 4ull * 512 * 256 * 2;
constexpr size_t OFF_PROJ  = OFF_WTC1  + 4ull * 2 * 256 * 2048 * 2;
constexpr size_t OFF_MIX   = OFF_PROJ  + (size_t)NT * D_IN * 2;
constexpr size_t OFF_YACT  = OFF_MIX   + (size_t)NT * 1024 * 2;
constexpr size_t OFF_XH    = OFF_YACT;
constexpr size_t OFF_BCUM  = OFF_YACT  + (size_t)NT * 256 * 2;
constexpr size_t OFF_GKV   = OFF_BCUM  + (size_t)NT * 128 * 4;
constexpr size_t OFF_GDEC  = OFF_GKV   + 8ull * 256 * 2048 * 4;
static_assert(OFF_GDEC - OFF_XH >= (size_t)NT * 1024 * 2, "XH alias region too small");
constexpr size_t OFF_XC    = OFF_GDEC  + 8ull * 256 * 32 * 4;
constexpr size_t OFF_S5W   = OFF_XC    + 512ull * 1024 * 2 * 4;
constexpr size_t OFF_S5E   = OFF_S5W   + 16ull * 512 * 640 * 2;
constexpr size_t OFF_S5AL  = OFF_S5E   + 16ull * 128 * 512 * 2;
constexpr size_t OFF_CHID  = OFF_S5AL  + 1024ull * 2 * 4;
constexpr size_t OFF_POSB  = OFF_CHID  + 2ull * 2048 * 512 * 4;
constexpr size_t OFF_XCH   = OFF_POSB  + 8ull * 16 * 256 * 4;
constexpr size_t OFF_KCMP  = OFF_XCH   + 512ull * 2048 * 2;
constexpr size_t OFF_VCMP  = OFF_KCMP  + 4ull * 512 * 64 * 2;
constexpr size_t OFF_VTG   = OFF_VCMP  + 4ull * 512 * 64 * 2;
constexpr size_t OFF_BAR   = OFF_VTG   + 2ull * 4 * 128 * 4096 * 2;
constexpr size_t WS_END    = OFF_BAR   + 16384;

struct Params {
    const float* in[25];
    float* out;
    char* ws;
};

__host__ __device__ constexpr size_t kb_idx(size_t nrows, size_t row, int k) { return (((size_t)(k >> 6)) * nrows + row) * 64 + (k & 63); }
typedef const __attribute__((address_space(4))) Params* PP;
DI PP plaunder(PP p) { asm volatile("" : "+s"(p)); return p; }
constexpr int SMEM_MAIN = 73728;
constexpr int SMEM_BYTES = SMEM_MAIN + 16;

#define XH_BASE(P) ((h16*)((char*)(P)->out + (size_t)NT * 2048))
DI int olane() { int l; asm volatile("v_mbcnt_lo_u32_b32 %0, -1, 0\n\tv_mbcnt_hi_u32_b32 %0, -1, %0" : "=v"(l)); return l; }
DI int otid(const int wv) { return wv * 64 + olane(); }
template <int M> DI int shx_i(int v) {
    static_assert(M == 1 || M == 2 || M == 4 || M == 8 || M == 16, "lane xor mask");
    if constexpr (M == 1) return __builtin_amdgcn_update_dpp(0, v, 0xB1, 0xF, 0xF, true);
    else if constexpr (M == 2) return __builtin_amdgcn_update_dpp(0, v, 0x4E, 0xF, 0xF, true);
    else return __builtin_amdgcn_ds_swizzle(v, (M << 10) | 0x1F);
}
template <int M> DI float shx(float v) { return __int_as_float(shx_i<M>(__float_as_int(v))); }
template <int N> DI int row_shr_i(int v) { return __builtin_amdgcn_update_dpp(0, v, 0x110 | N, 0xF, 0xF, true); }
DI float xhalf_max(float v) {
    const auto r = __builtin_amdgcn_permlane32_swap(__float_as_uint(v), __float_as_uint(v), false, false);
    return fmaxf(__uint_as_float(r[0]), __uint_as_float(r[1]));
}
DI float xhalf_sum(float v) {
    const auto r = __builtin_amdgcn_permlane32_swap(__float_as_uint(v), __float_as_uint(v), false, false);
    return __uint_as_float(r[0]) + __uint_as_float(r[1]);
}
DI float wave_sum(float v) {
    v = xhalf_sum(v);
    v += shx<16>(v); v += shx<8>(v); v += shx<4>(v); v += shx<2>(v); v += shx<1>(v);
    return v;
}
DI float wave_max(float v) {
    v = xhalf_max(v);
    v = fmaxf(v, shx<16>(v)); v = fmaxf(v, shx<8>(v)); v = fmaxf(v, shx<4>(v)); v = fmaxf(v, shx<2>(v)); v = fmaxf(v, shx<1>(v));
    return v;
}
DI float bperm(float v, int srclane) { return __int_as_float(__builtin_amdgcn_ds_bpermute(srclane << 2, __float_as_int(v))); }
#define NSA_FAST_FLAG(P, l, ln) (__builtin_amdgcn_readfirstlane((8.f * 1.4426950408889634f * wave_max(fabsf((P)->in[I_NQN][(l) * 64 + (ln)])) *          \
    wave_max(fmaxf(fmaxf(fabsf((P)->in[I_NKN][((l) * 3 + 0) * 64 + (ln)]), fabsf((P)->in[I_NKN][((l) * 3 + 1) * 64 + (ln)])), fabsf((P)->in[I_NKN][((l) * 3 + 2) * 64 + (ln)]))) < 15.f) ? 1 : 0) != 0)
DI float add1(float e) { float y; asm("s_nop 0\n\tv_add_f32_e32 %0, 1.0, %1" : "=v"(y) : "v"(e)); return y; }
DI float sigmoidf_(float x) { return 1.f / add1(__expf(-x)); }
DI float siluf_(float x) { return x / add1(__expf(-x)); }
DI float gelu_tanh(float x) {
    const float u = 0.7978845608028654f * (x + 0.044715f * x * x * x);
    return 0.5f * x * (1.f + tanhf(u));
}
DI float log_sigmoidf_(float x) { return fminf(x, 0.f) - log1pf(__expf(-fabsf(x))); }

typedef _Float16 half2_ __attribute__((ext_vector_type(2)));
DI void glds16(const h16* g, char* l) {
    __builtin_amdgcn_global_load_lds((const __attribute__((address_space(1))) void*)g, (__attribute__((address_space(3))) void*)l, 16, 0, 0);
}
DI int vkperm(int k) { return (k & ~12) | ((k & 4) << 1) | ((k & 8) >> 1); }
DI int vkperm2(int k) { return (k & ~31) | (((k >> 2) & 3) << 3) | (((k >> 4) & 1) << 2) | (k & 3); }
struct APlain { const h16* A; size_t lda, astep; DI const h16* operator()(int row, int kt, int c8) const { return A + (size_t)row * lda + (size_t)kt * astep + c8 * 8; } };
struct AS5 {
    const h16* ubase;
    const h16* xin;
    int ch0;
    DI const h16* operator()(int row, int kt, int c8) const {
        const size_t ch = (size_t)(ch0 + row);
        return kt < 8 ? ubase + (ch * 32 + 4 * kt + (c8 >> 1)) * D_IN + (c8 & 1) * 8 : xin + ch * 2048 + (kt - 8) * 64 + c8 * 8;
    }
};
template <int N> DI void gwaitbar();
#define GWB_DEF(N) template <> DI void gwaitbar<N>() { asm volatile("s_waitcnt vmcnt(" #N ") lgkmcnt(0)\n\ts_barrier" ::: "memory"); }
GWB_DEF(0) GWB_DEF(3) GWB_DEF(4) GWB_DEF(6) GWB_DEF(8) GWB_DEF(12)
template <bool SUMSQ, int WR, int MI, int NJ, int NST = 4, class AF>
DI void gemm_glds(const int wv, const int K, const AF& afn, const h16* __restrict__ Bt, const int ldb,
                  f32x4 (&acc)[MI][NJ], float (&ss)[MI], char* smem, const size_t bstep = 64) {
    constexpr int WC = 4 / WR, BM = WR * MI * 16, BN = WC * NJ * 16, AQ = BM / 64, BQ = BN / 64, NG = AQ + BQ, SB = (BM + BN) * 64;
    static_assert(NST * SB <= SMEM_MAIN && AQ >= 1 && BQ >= 1 && (NST == 3 || NST == 4), "ring does not fit the LDS");
    const int tid = otid(wv), lane = tid & 63, wid = tid >> 6, wr = wid / WC, wc = wid % WC;
#pragma unroll
    for (int i = 0; i < MI; ++i) {
        ss[i] = 0.f;
#pragma unroll
        for (int j = 0; j < NJ; ++j) acc[i][j] = (f32x4){0.f, 0.f, 0.f, 0.f};
    }
    const int lrow = wid * 16 + (lane >> 2);
    const int lc4 = (lane & 3) ^ ((-(lrow >> 2)) & 3);
    const h16* bp = Bt + (size_t)lrow * ldb + lc4 * 8;
    char* lbase = smem + wid * 1024;
    const int fr = lane & 15, fq = lane >> 4, sw = (-(fr >> 2)) & 3;
    const int aoff0 = (wr * MI * 16 + fr) * 64 + ((fq ^ sw) * 16);
    const int boff0 = BM * 64 + (wc * NJ * 16 + fr) * 64 + ((fq ^ sw) * 16);
    const int nt = K >> 5;
    auto issue = [&](const int t, char* stage) {
        const int kt = t >> 1, hb = (t & 1) * 4;
#pragma unroll
        for (int q = 0; q < AQ; ++q) glds16(afn(lrow + 64 * q, kt, hb + lc4), stage + q * 4096);
#pragma unroll
        for (int q = 0; q < BQ; ++q) glds16(bp + (size_t)q * 64 * ldb + (size_t)kt * bstep + hb * 8, stage + BM * 64 + q * 4096);
    };
    auto compute = [&](const char* st) {
        half8 af[MI], bf[NJ];
#pragma unroll
        for (int i = 0; i < MI; ++i) af[i] = *(const half8*)(st + aoff0 + i * 1024);
#pragma unroll
        for (int j = 0; j < NJ; ++j) bf[j] = *(const half8*)(st + boff0 + j * 1024);
        if (SUMSQ) {
#pragma unroll
            for (int i = 0; i < MI; ++i)
#pragma unroll
                for (int e = 0; e < 4; ++e) {
                    const half2_ x = (half2_){af[i][2 * e], af[i][2 * e + 1]};
                    ss[i] = __builtin_amdgcn_fdot2(x, x, ss[i], false);
                }
        }
#pragma unroll
        for (int i = 0; i < MI; ++i)
#pragma unroll
            for (int j = 0; j < NJ; ++j) acc[i][j] = __builtin_amdgcn_mfma_f32_16x16x32_f16(bf[j], af[i], acc[i][j], 0, 0, 0);
    };
#define GEMM_STEP(S, t) do { if (NST == 4 && (t) + 2 < nt) gwaitbar<NG>(); else gwaitbar<0>();                       \
        if ((t) + NST - 1 < nt) issue((t) + NST - 1, lbase + (((S) + NST - 1) % NST) * SB); compute(smem + (S) * SB); } while (0)
    gwaitbar<0>();
    {
        const int k = nt < NST - 1 ? nt : NST - 1;
        for (int p = 0; p < k; ++p) issue(p, lbase + p * SB);
        if (k >= 3) gwaitbar<2 * NG>(); else if (k == 2) gwaitbar<NG>(); else gwaitbar<0>();
        __builtin_amdgcn_s_sleep(2);
    }
#pragma unroll 1
    for (int t = 0; t < nt; t += NST) {
        GEMM_STEP(0, t);
        if (t + 1 < nt) GEMM_STEP(1, t + 1);
        if (t + 2 < nt) GEMM_STEP(2, t + 2);
        if (NST == 4 && t + 3 < nt) GEMM_STEP(3 % NST, t + 3);
    }
#undef GEMM_STEP
    asm volatile("s_waitcnt lgkmcnt(0)\n\ts_barrier" ::: "memory");
    if (SUMSQ) {
#pragma unroll
        for (int i = 0; i < MI; ++i) { ss[i] += shx<16>(ss[i]); ss[i] = xhalf_sum(ss[i]); }
    }
}
template <bool SUMSQ, class AF>
DI void gemm_mainloop_glds(const int wv, const int K, const AF& afn, const h16* __restrict__ Bt, const int ldb, f32x4 (&acc)[4][4], float (&ss)[4], char* smem, const size_t bstep = 64) {
    gemm_glds<SUMSQ, 2, 4, 4>(wv, K, afn, Bt, ldb, acc, ss, smem, bstep);
}

DI int glu_perm_dst(int c_orig) {
    const int which = c_orig >> 8, c = c_orig & 255;
    return (c >> 6) * 128 + ((c >> 5) & 1) * 64 + (((c >> 4) & 1) * 2 + which) * 16 + (c & 15);
}
template <int MAP, int KB>
DI void transpose64(const float* __restrict__ src, int R, int C, h16* __restrict__ dst, int r0, int c0,
                    const float* __restrict__ rscale, char* smem, const int wv) {
    h16* tile = (h16*)smem;
    const int tid = otid(wv);
    {
        const int r = tid >> 2, cq = (tid & 3) * 16;
        const float sc = rscale ? rscale[r0 + r] : 1.f;
        const float* sp = src + (size_t)(r0 + r) * C + c0 + cq;
#pragma unroll
        for (int q = 0; q < 4; ++q) {
            float4 v = (float4){0.f, 0.f, 0.f, 0.f};
            if (c0 + cq + q * 4 < C) v = *(const float4*)(sp + q * 4);
            *(half4*)(tile + r * 72 + cq + q * 4) = (half4){(h16)(v.x * sc), (h16)(v.y * sc), (h16)(v.z * sc), (h16)(v.w * sc)};
        }
    }
    __syncthreads();
    {
        const int c = tid >> 2, rq = (tid & 3) * 16;
        half8 o0, o1;
#pragma unroll
        for (int k = 0; k < 8; ++k) { o0[k] = tile[(rq + k) * 72 + c]; o1[k] = tile[(rq + 8 + k) * 72 + c]; }
        const int cc = c0 + c;
        const int dr = MAP == 1 ? map_col(cc) : MAP == 2 ? glu_perm_dst(cc) : cc;
        h16* dp = KB ? dst + ((size_t)(r0 >> 6) * KB + dr) * 64 + rq : dst + (size_t)dr * R + r0 + rq;
        *(half8*)dp = o0; *(half8*)(dp + 8) = o1;
    }
    __syncthreads();
}

DI void phase0(PP P, char* smem, const int wv) {
    P = plaunder(P);
    constexpr int N_WIN = 4 * 16 * 50, N_WOUT = 4 * 16 * 16, N_C1 = 16 * 16 * 4, N_GLU = 4 * 4 * 8, N_XH = NT * 1024 / 2048, N_PB = 8 * 16;
    const int total = N_WIN + N_WOUT + N_C1 + N_GLU + N_XH + N_PB;
    for (int w = blockIdx.x; w < total; w += gridDim.x) {
        if (w < N_WIN) {
            const int l = w / 800, r = w % 800, rt = r / 50, ct = r % 50;
            transpose64<1, D_IN_PAD>(P->in[I_WIN] + (size_t)l * 1024 * D_IN, 1024, D_IN, (h16*)(P->ws + OFF_WTIN) + (size_t)l * D_IN_PAD * 1024,
                           rt * 64, ct * 64, P->in[I_NORMG] + l * 1024, smem, wv);
        } else if (w < N_WIN + N_WOUT) {
            const int v = w - N_WIN, l = v >> 8, r = v & 255, rt = r >> 4, ct = r & 15;
            transpose64<0, 1024>(P->in[I_WOUT] + (size_t)l * 1024 * 1024, 1024, 1024, (h16*)(P->ws + OFF_WTOUT) + (size_t)l * 1024 * 1024,
                           rt * 64, ct * 64, nullptr, smem, wv);
        } else if (w < N_WIN + N_WOUT + N_C1) {
            const int v = w - N_WIN - N_WOUT, ljh = v >> 6, r = v & 63, rt = r >> 2, ct = r & 3;
            transpose64<0, 512>(P->in[I_CW1] + (size_t)ljh * 1024 * 256, 1024, 256, (h16*)(P->ws + OFF_WTC1) + ((size_t)(ljh >> 1) * 16 * 512 + (ljh & 1) * 256) * 64,
                           rt * 64, ct * 64, nullptr, smem, wv);
        } else if (w < N_WIN + N_WOUT + N_C1 + N_GLU) {
            const int v = w - N_WIN - N_WOUT - N_C1, l = v >> 5, r = v & 31, rt = r >> 3, ct = r & 7;
            transpose64<2, 0>(P->in[I_GLUW] + (size_t)l * 256 * 512, 256, 512, (h16*)(P->ws + OFF_WTGLU) + (size_t)l * 512 * 256,
                           rt * 64, ct * 64, nullptr, smem, wv);
        } else if (w < N_WIN + N_WOUT + N_C1 + N_GLU + N_XH) {
            const size_t e0 = ((size_t)(w - N_WIN - N_WOUT - N_C1 - N_GLU) * 256 + otid(wv)) * 8;
            const float4 a = *(const float4*)(P->in[I_X] + e0), b = *(const float4*)(P->in[I_X] + e0 + 4);
            *(half8*)(XH_BASE(P) + kb_idx(NT, e0 >> 10, (int)(e0 & 1023))) = (half8){(h16)a.x, (h16)a.y, (h16)a.z, (h16)a.w, (h16)b.x, (h16)b.y, (h16)b.z, (h16)b.w};
        } else {
            const int v = w - (N_WIN + N_WOUT + N_C1 + N_GLU + N_XH), lj = v >> 4, ks = v & 15, n = otid(wv);
            const float* w1 = P->in[I_CW1] + ((size_t)lj * 2048 + ks * 128) * 256 + n;
            const float* pp = P->in[I_CPOS] + (size_t)lj * 2048 + ks * 128;
            float a = ks == 0 ? P->in[I_CB1][lj * 256 + n] : 0.f;
#pragma unroll 16
            for (int k = 0; k < 128; ++k) a += pp[k] * w1[(size_t)k * 256];
            ((float*)(P->ws + OFF_POSB))[(lj * 16 + ks) * 256 + n] = a;
        }
    }
}

DI void s5_build_item(PP P, int l, int item, char* smem, const int wv) {
    P = plaunder(P);
    float* apow = (float*)smem;
    float* bbar = apow + 64 * 33 * 2;
    float* cc   = bbar + 64 * 16 * 2;
    const int tid = otid(wv);
    const int g = (item < 256) ? (item >> 4) : ((item - 256) >> 2);
    if (tid < 64) {
        const int p = tid;
        const float lre = fminf(P->in[I_LRE][(l * 16 + g) * 64 + p], -1e-4f);
        const float lim = P->in[I_LIM][(l * 16 + g) * 64 + p];
        const float dt = expf(P->in[I_LSTEP][l * 16 + g]);
        const float x = lre * dt, y = lim * dt;
        const float em1 = expm1f(x), cy = cosf(y), sy = sinf(y), sh = sinf(0.5f * y);
        const float ar = (em1 + 1.f) * cy, ai = (em1 + 1.f) * sy;
        const float dr = em1 * cy - 2.f * sh * sh, di = ai;
        const float den = lre * lre + lim * lim;
        const float fr = (dr * lre + di * lim) / den;
        const float fi = (di * lre - dr * lim) / den;
        float pr = 1.f, pi = 0.f;
        asm volatile("" : "+v"(pr), "+v"(pi));
        for (int k = 0; k <= 32; ++k) {
            apow[(p * 33 + k) * 2] = pr; apow[(p * 33 + k) * 2 + 1] = pi;
            const float nr = pr * ar - pi * ai, ni = pr * ai + pi * ar; pr = nr; pi = ni;
        }
        for (int c = 0; c < 16; ++c) {
            const float br = P->in[I_BRE][((size_t)(l * 16 + g) * 64 + p) * 16 + c];
            const float bi = P->in[I_BIM][((size_t)(l * 16 + g) * 64 + p) * 16 + c];
            bbar[(p * 16 + c) * 2] = fr * br - fi * bi;
            bbar[(p * 16 + c) * 2 + 1] = fr * bi + fi * br;
        }
    }
    for (int e = tid; e < 1024; e += 256) {
        cc[e * 2] = P->in[I_CRE][(size_t)(l * 16 + g) * 1024 + e];
        cc[e * 2 + 1] = P->in[I_CIM][(size_t)(l * 16 + g) * 1024 + e];
    }
    __syncthreads();
    if (item < 256) {
        const int c = item & 15;
        float* kt = cc + 2048;
        for (int idx = tid; idx < 512; idx += 256) {
            const int lag = idx >> 4, c2 = idx & 15;
            float a = 0.f;
            for (int p = 0; p < 64; ++p) {
                const float cr = cc[(c * 64 + p) * 2], ci = cc[(c * 64 + p) * 2 + 1];
                const float xr = apow[(p * 33 + lag) * 2], xi = apow[(p * 33 + lag) * 2 + 1];
                const float br = bbar[(p * 16 + c2) * 2], bi = bbar[(p * 16 + c2) * 2 + 1];
                const float tr = cr * xr - ci * xi, ti = cr * xi + ci * xr;
                a += tr * br - ti * bi;
            }
            kt[idx] = a;
        }
        __syncthreads();
        h16* W = (h16*)(P->ws + OFF_S5W) + (size_t)g * 512 * 640;
        for (int idx = tid; idx < 32 * 640; idx += 256) {
            const int j = idx / 640, k = idx % 640;
            float val = 0.f;
            if (k < 512) {
                const int s = k >> 4, c2 = k & 15, lag = j - s;
                if (lag >= 0) val = kt[lag * 16 + c2];
            } else {
                const int p = (k - 512) >> 1;
                const float cr = cc[(c * 64 + p) * 2], ci = cc[(c * 64 + p) * 2 + 1];
                const float xr = apow[(p * 33 + j + 1) * 2], xi = apow[(p * 33 + j + 1) * 2 + 1];
                val = (k & 1) ? -(cr * xi + ci * xr) : (cr * xr - ci * xi);
            }
            W[(size_t)(j * 16 + c) * 640 + k] = (h16)val;
        }
    } else {
        const int pq = (item - 256) & 3;
        h16* E = (h16*)(P->ws + OFF_S5E) + ((size_t)g * 128 + pq * 32) * 512;
        for (int idx = tid; idx < 32 * 512; idx += 256) {
            const int nl = idx >> 9, k = idx & 511;
            const int p = pq * 16 + (nl >> 1), s = k >> 4, c2 = k & 15;
            const float xr = apow[(p * 33 + 31 - s) * 2], xi = apow[(p * 33 + 31 - s) * 2 + 1];
            const float br = bbar[(p * 16 + c2) * 2], bi = bbar[(p * 16 + c2) * 2 + 1];
            const float val = (nl & 1) ? (xr * bi + xi * br) : (xr * br - xi * bi);
            E[(size_t)nl * 512 + k] = (h16)val;
        }
        if (tid < 16) {
            const int p = pq * 16 + tid;
            float* AL = (float*)(P->ws + OFF_S5AL);
            AL[(g * 64 + p) * 2] = apow[(p * 33 + 32) * 2];
            AL[(g * 64 + p) * 2 + 1] = apow[(p * 33 + 32) * 2 + 1];
        }
    }
    __syncthreads();
}

template <int WR, int MI>
DI void inproj_tile(PP P, int l, int m0, int n0, char* smem, const int wv) {
    P = plaunder(P);
    constexpr int WC = 4 / WR;
    f32x4 acc[MI][4];
    float ss[MI];
    gemm_glds<true, WR, MI, 4, (WR == 2 && MI == 8) ? 3 : 4>(wv, 1024, APlain{(const h16*)XH_BASE(P) + (size_t)m0 * 64, 64, (size_t)NT * 64},
                               (const h16*)(P->ws + OFF_WTIN) + ((size_t)l * 16 * D_IN_PAD + n0) * 64, 64, acc, ss, smem, (size_t)D_IN_PAD * 64);
    const int tid = otid(wv), lane = tid & 63, wid = tid >> 6, wr = wid / WC, wc = wid % WC;
    h16* proj = (h16*)(P->ws + OFF_PROJ);
    const int n64 = n0 + wc * 64;
    int cls = 0;
    if (n64 < 512) cls = 1;
    else if (n64 >= C_NKV + 256 && n64 < C_NKV + 384) cls = 2;
    else if (n64 >= C_NKV + 512 && n64 < C_NKV + 640) cls = 3;
    else if (n64 >= C_NKV + 384 && n64 < C_NKV + 512) cls = 4;
    else if (n64 >= C_NKV + 640 && n64 < C_NKV + 768) cls = 5;
    bool vfast = false;
    if (cls >= 4) vfast = NSA_FAST_FLAG(P, l, lane);
    float wn[4][4];
    if (cls >= 1 && cls <= 3) {
        const float* wp = (cls == 1) ? P->in[I_NQN] + l * 64 : P->in[I_NKN] + (l * 3 + (cls - 1)) * 64;
        const float sc = (cls == 1) ? QSCALE : 1.f;
#pragma unroll
        for (int j = 0; j < 4; ++j) {
            const float4 w4 = *(const float4*)(wp + j * 16 + (lane >> 4) * 4);
            wn[j][0] = w4.x * sc; wn[j][1] = w4.y * sc; wn[j][2] = w4.z * sc; wn[j][3] = w4.w * sc;
        }
    }
#pragma unroll
    for (int i = 0; i < MI; ++i) {
        const int ml = wr * MI * 16 + i * 16 + (lane & 15);
        const float r = rsqrtf(ss[i] * (1.f / 1024.f) + 1e-6f);
        const size_t row = (size_t)m0 + ml;
        f32x4 v[4];
#pragma unroll
        for (int j = 0; j < 4; ++j) v[j] = acc[i][j] * r;
        if (cls >= 1 && cls <= 3) {
            float s2 = 0.f;
#pragma unroll
            for (int j = 0; j < 4; ++j) s2 += v[j][0] * v[j][0] + v[j][1] * v[j][1] + v[j][2] * v[j][2] + v[j][3] * v[j][3];
            s2 += shx<16>(s2); s2 = xhalf_sum(s2);
            const float rn = rsqrtf(s2 * (1.f / 64.f) + 1e-6f);
#pragma unroll
            for (int j = 0; j < 4; ++j) { v[j][0] *= rn * wn[j][0]; v[j][1] *= rn * wn[j][1]; v[j][2] *= rn * wn[j][2]; v[j][3] *= rn * wn[j][3]; }
        }
        if (cls >= 4) {
            const int g = (n64 >> 6) & 1, br = cls - 4;
            const int b = (int)(row >> 13), t = (int)(row & 8191);
            h16* vt = (h16*)(P->ws + OFF_VTG) + ((((size_t)br * 4 + b * 2 + g) * 128 + (t >> 6)) * 64) * 64;
#pragma unroll
            for (int j = 0; j < 4; ++j)
#pragma unroll
                for (int e = 0; e < 4; ++e) vt[(j * 16 + (lane >> 4) * 4 + e) * 64 + (vfast ? vkperm2(t & 63) : vkperm(t & 63))] = (h16)v[j][e];
        }
#pragma unroll
        for (int j = 0; j < 4; ++j) {
            const int n = n64 + j * 16 + (lane >> 4) * 4;
            if (n < D_IN) *(half4*)(proj + row * D_IN + n) = (half4){(h16)v[j][0], (h16)v[j][1], (h16)v[j][2], (h16)v[j][3]};
        }
        __builtin_amdgcn_sched_barrier(0);
    }
    __syncthreads();
}


DI void cmp_gemm_tile(PP P, int l, int tile, char* smem, const int wv) {
    P = plaunder(P);
    const int j = tile >> 6, mt = (tile >> 2) & 15, nt = tile & 3;
    const int row0 = mt * 128, bg = row0 >> 9, i0 = row0 & 511, b = bg >> 1, g = bg & 1;
    f32x4 acc[4][4];
    float ssd[4];
    gemm_mainloop_glds<false>(wv, 1024, APlain{(const h16*)(P->ws + OFF_PROJ) + ((size_t)b * SEQ + 16 * i0) * D_IN + C_NKV + j * 128 + g * 64, (size_t)16 * D_IN, (size_t)D_IN},
                              (const h16*)(P->ws + OFF_WTC1) + ((size_t)(l * 2 + j) * 16 * 512 + nt * 128) * 64, 64, acc, ssd, smem, (size_t)512 * 64);
    const int tid = otid(wv), lane = tid & 63, wid = tid >> 6, wr = wid >> 1, wc = wid & 1;
    float* pt = (float*)(P->ws + OFF_CHID) + (size_t)j * 2048 * 512;
#pragma unroll
    for (int i = 0; i < 4; ++i) {
        const size_t row = (size_t)row0 + wr * 64 + i * 16 + (lane & 15);
#pragma unroll
        for (int jj = 0; jj < 4; ++jj) {
            const int n = nt * 128 + wc * 64 + jj * 16 + (lane >> 4) * 4;
            const f32x4 v = acc[i][jj];
            *(float4*)(pt + row * 512 + n) = (float4){v[0], v[1], v[2], v[3]};
        }
    }
}

DI void s5e_gemm_tile(PP P, int l, int tile, char* smem, const int wv) {
    P = plaunder(P);
    const int g = tile >> 2, mt = tile & 3;
    f32x4 acc[4][4];
    float ssd[4];
    gemm_mainloop_glds<false>(wv, 512, AS5{(const h16*)(P->ws + OFF_PROJ) + C_SU + g * 16, nullptr, mt * 128},
                              (const h16*)(P->ws + OFF_S5E) + (size_t)g * 128 * 512, 512, acc, ssd, smem);
    const int tid = otid(wv), lane = tid & 63, wid = tid >> 6, wr = wid >> 1, wc = wid & 1;
    float* xc = (float*)(P->ws + OFF_XC);
#pragma unroll
    for (int i = 0; i < 4; ++i) {
        const size_t ch = (size_t)mt * 128 + wr * 64 + i * 16 + (lane & 15);
#pragma unroll
        for (int jj = 0; jj < 4; ++jj) {
            const int n = wc * 64 + jj * 16 + (lane >> 4) * 4;
            const f32x4 v = acc[i][jj];
            *(float4*)(xc + (ch * 1024 + g * 64) * 2 + n) = (float4){v[0], v[1], v[2], v[3]};
        }
    }
}

DI void gla_scan_item(PP P, int item, char* smem, const int wv) {
    P = plaunder(P);
    const int tid = otid(wv), sl = tid & 31, part = tid >> 5;
    const int idx = item * 32 + sl, bh = idx >> 11, de = idx & 2047, d = de >> 6;
    float* kv = (float*)(P->ws + OFF_GKV) + ((size_t)bh * 256 + part * 32) * 2048 + de;
    const float* dc = (const float*)(P->ws + OFF_GDEC) + ((size_t)bh * 256 + part * 32) * 32 + d;
    float* sD = (float*)smem; float* sL = sD + 256;
    float kvv[32], dd[32];
#pragma unroll
    for (int i = 0; i < 32; ++i) { kvv[i] = kv[(size_t)i * 2048]; dd[i] = dc[i * 32]; }
    float D = 1.f, L = 0.f;
#pragma unroll
    for (int i = 0; i < 32; ++i) { L = dd[i] * L + kvv[i]; D *= dd[i]; }
    sD[part * 32 + sl] = D; sL[part * 32 + sl] = L;
    __syncthreads();
    float S = 0.f;
    for (int q = 0; q < part; ++q) S = sD[q * 32 + sl] * S + sL[q * 32 + sl];
#pragma unroll
    for (int i = 0; i < 32; ++i) { const float o = S; S = dd[i] * S + kvv[i]; kv[(size_t)i * 2048] = o; }
    __syncthreads();
}
DI void s5_scan_item(PP P, int item, char* smem, const int wv) {
    P = plaunder(P);
    const int tid = otid(wv), sl = tid & 31, part = tid >> 5;
    const int idx = item * 32 + sl, b = idx >> 10, s = idx & 1023;
    float2* xc = (float2*)(P->ws + OFF_XC) + ((size_t)b * 256 + part * 32) * 1024 + s;
    half2_* xch = (half2_*)(P->ws + OFF_XCH) + ((size_t)b * 256 + part * 32) * 1024 + s;
    const float2 a = ((const float2*)(P->ws + OFF_S5AL))[s];
    float2* sL = (float2*)smem;
    float2 c[32];
#pragma unroll
    for (int i = 0; i < 32; ++i) c[i] = xc[(size_t)i * 1024];
    float lr = 0.f, li = 0.f;
#pragma unroll
    for (int i = 0; i < 32; ++i) { const float nr = a.x * lr - a.y * li + c[i].x, ni = a.x * li + a.y * lr + c[i].y; lr = nr; li = ni; }
    float dr = a.x, di = a.y;
#pragma unroll
    for (int i = 0; i < 5; ++i) { const float nr = dr * dr - di * di, ni = 2.f * dr * di; dr = nr; di = ni; }
    sL[part * 32 + sl] = (float2){lr, li};
    __syncthreads();
    float xr = 0.f, xi = 0.f;
    for (int q = 0; q < part; ++q) { const float2 lq = sL[q * 32 + sl]; const float nr = dr * xr - di * xi + lq.x, ni = dr * xi + di * xr + lq.y; xr = nr; xi = ni; }
#pragma unroll
    for (int i = 0; i < 32; ++i) {
        const float2 o = (float2){xr, xi};
        const float nr = a.x * xr - a.y * xi + c[i].x, ni = a.x * xi + a.y * xr + c[i].y; xr = nr; xi = ni;
        xc[(size_t)i * 1024] = o;
        xch[(size_t)i * 1024] = (half2_){(h16)o.x, (h16)o.y};
    }
    __syncthreads();
}
DI void cmp_l2_item(PP P, int l, int item, char* smem, const int wv) {
    P = plaunder(P);
    const int tid = otid(wv), lane = tid & 63, w = tid >> 6;
    const int j = item >> 8, r0 = (item & 255) * 8;
    h16* w2s = (h16*)smem;
    float* hs = (float*)(smem + 32768);
    {
        const float* w2 = P->in[I_CW2] + (size_t)(l * 2 + j) * 256 * 64;
        for (int e = tid * 4; e < 256 * 64; e += 1024) {
            const float4 v = *(const float4*)(w2 + e);
            *(half4*)(w2s + e) = (half4){(h16)v.x, (h16)v.y, (h16)v.z, (h16)v.w};
        }
        const float* pt = (const float*)(P->ws + OFF_CHID) + (size_t)j * 2048 * 512;
        float pb = 0.f;
#pragma unroll
        for (int ks = 0; ks < 16; ++ks) pb += ((const float*)(P->ws + OFF_POSB))[((l * 2 + j) * 16 + ks) * 256 + tid];
#pragma unroll
        for (int rr = 0; rr < 8; ++rr) {
            const int row = r0 + rr, i = row & 511;
            float v = 0.f;
            if (i < 511) v = gelu_tanh(pt[(size_t)row * 512 + tid] + pt[(size_t)(row + 1) * 512 + 256 + tid] + pb);
            hs[rr * 256 + tid] = v;
        }
    }
    __syncthreads();
    const float bb = P->in[I_CB2][(l * 2 + j) * 64 + lane];
    float a0 = bb, a1 = bb;
    const float* h0 = hs + (2 * w) * 256, *h1 = h0 + 256;
#pragma unroll 8
    for (int n = 0; n < 256; ++n) {
        const float wv = (float)w2s[n * 64 + lane];
        a0 += h0[n] * wv; a1 += h1[n] * wv;
    }
#pragma unroll
    for (int rr = 0; rr < 2; ++rr) {
        float acc = rr ? a1 : a0;
        const int row = r0 + 2 * w + rr, bg = row >> 9, i = row & 511;
        if (i == 511) acc = 0.f;
        if (j == 0) {
            const float ss = wave_sum(acc * acc);
            acc = acc * rsqrtf(ss * (1.f / 64.f) + 1e-6f) * P->in[I_NKN][(l * 3 + 0) * 64 + lane];
            ((h16*)(P->ws + OFF_KCMP))[(size_t)row * 64 + lane] = (h16)acc;
        } else {
            ((h16*)(P->ws + OFF_VCMP))[(((size_t)bg * 8 + (i >> 6)) * 64 + lane) * 64 + vkperm(i & 63)] = (h16)acc;
        }
    }
    __syncthreads();
}

DI void s5o_gemm_tile(PP P, int l, int tile, char* smem, const int wv) {
    P = plaunder(P);
    const int g = tile >> 5, mt = (tile >> 3) & 3, nt = tile & 7;
    f32x4 acc[2][4];
    float ssd[2];
    gemm_glds<false, 4, 2, 4>(wv, 640, AS5{(const h16*)(P->ws + OFF_PROJ) + C_SU + g * 16, (const h16*)(P->ws + OFF_XCH) + g * 128, mt * 128},
                              (const h16*)(P->ws + OFF_S5W) + ((size_t)g * 512 + nt * 64) * 640, 640, acc, ssd, smem);
    const int tid = otid(wv), lane = tid & 63, wid = tid >> 6;
    const h16* proj = (const h16*)(P->ws + OFF_PROJ);
    h16* yact = (h16*)(P->ws + OFF_YACT);
#pragma unroll
    for (int i = 0; i < 2; ++i) {
        const size_t ch = (size_t)mt * 128 + wid * 32 + i * 16 + (lane & 15);
#pragma unroll
        for (int jj = 0; jj < 4; ++jj) {
            const int n = nt * 64 + jj * 16 + (lane >> 4) * 4;
            const int j = n >> 4, c = n & 15;
            const size_t tok = ch * 32 + j;
            const half4 u4 = *(const half4*)(proj + tok * D_IN + C_SU + g * 16 + c);
            const float4 dd = *(const float4*)(P->in[I_SD] + (l * 16 + g) * 16 + c);
            const f32x4 v = acc[i][jj];
            half4 o;
            o[0] = (h16)gelu_tanh(v[0] + dd.x * (float)u4[0]);
            o[1] = (h16)gelu_tanh(v[1] + dd.y * (float)u4[1]);
            o[2] = (h16)gelu_tanh(v[2] + dd.z * (float)u4[2]);
            o[3] = (h16)gelu_tanh(v[3] + dd.w * (float)u4[3]);
            *(half4*)(yact + tok * 256 + g * 16 + c) = o;
        }
    }
}

#define MFMA32(a, b, c) __builtin_amdgcn_mfma_f32_32x32x16_f16((a), (b), (c), 0, 0, 0)
#define MFMA16(a, b, c) __builtin_amdgcn_mfma_f32_16x16x32_f16((a), (b), (c), 0, 0, 0)
constexpr float NEGS = -1e30f;
DI float ex2(float x) { return __builtin_amdgcn_exp2f(x); }
#define NSA_WAITBAR(N) asm volatile("s_waitcnt vmcnt(" #N ") lgkmcnt(0)\n\ts_barrier" ::: "memory")
#define NSA_BAR() asm volatile("s_waitcnt lgkmcnt(0)\n\ts_barrier" ::: "memory")

struct KVSrc { const h16* k; int ldk; size_t kstep; const h16* v; };
DI void nsa_dma(const KVSrc& s, int j, char* stage, int wid, int lane) {
    const int row0 = wid * 8 + (lane >> 3);
    const int sw = ((lane & 7) ^ ((row0 >> 1) & 7)) * 8;
    const h16* kp = s.k + (size_t)j * s.kstep + (size_t)row0 * s.ldk + sw;
    glds16(kp, stage + wid * 1024);
    glds16(kp + (size_t)32 * s.ldk, stage + 4096 + wid * 1024);
    const h16* vp = s.v + (size_t)j * 4096 + row0 * 64 + sw;
    glds16(vp, stage + 8192 + wid * 1024);
    glds16(vp + 32 * 64, stage + 8192 + 4096 + wid * 1024);
}
template <int NST, class F>
DI void nsa_pipe(const KVSrc& s, const int n, char* smem, int wid, int lane, F&& compute) {
    NSA_WAITBAR(0);
    {
        const int k = n < NST - 1 ? n : NST - 1;
        for (int p = 0; p < k; ++p) nsa_dma(s, p, smem + p * 16384, wid, lane);
        if (k >= 3) NSA_WAITBAR(8); else if (k == 2) NSA_WAITBAR(4); else NSA_WAITBAR(0);
        __builtin_amdgcn_s_sleep(2);
    }
    for (int j = 0; j < n; ++j) {
        if (NST == 4 && j + 2 < n) NSA_WAITBAR(4); else NSA_WAITBAR(0);
        const int jn = j + NST - 1;
        compute(j, smem + (j % NST) * 16384, [&]() { if (jn < n) nsa_dma(s, jn, smem + (jn % NST) * 16384, wid, lane); });
    }
}

template <class F>
DI void nsa_pipe2(const KVSrc& s, const int n, char* smem, int wid, int lane, F&& compute) {
    NSA_WAITBAR(0);
    nsa_dma(s, 0, smem, wid, lane);
    if (n > 1) nsa_dma(s, 1, smem + 16384, wid, lane);
    NSA_WAITBAR(0);
    __builtin_amdgcn_s_sleep(2);
    for (int t0 = 0; t0 < n; t0 += 2) {
        NSA_BAR();
        char* cur = smem + ((t0 >> 1) & 1) * 32768;
        char* nxt = smem + (((t0 >> 1) + 1) & 1) * 32768;
        compute(t0, cur, [&]() {
            if (t0 + 2 < n) nsa_dma(s, t0 + 2, nxt, wid, lane);
            if (t0 + 3 < n) nsa_dma(s, t0 + 3, nxt + 16384, wid, lane);
        });
        asm volatile("s_waitcnt vmcnt(0)" ::: "memory");
        if (t0 + 1 < n) compute(t0 + 1, cur + 16384, []() {});
    }
}

template <bool SHIFT = false, class BF>
DI void qk_tile(const char* Kimg, const half8 (&qf)[4], f32x16 (&s)[2], int lane, BF&& between) {
    const int r = lane & 31, h = lane >> 5, swz = (r >> 1) & 7;
    const char* base = Kimg + r * 128;
    half8 kf[8];
#pragma unroll
    for (int kt = 0; kt < 2; ++kt)
#pragma unroll
        for (int ks = 0; ks < 4; ++ks) kf[kt * 4 + ks] = *(const half8*)(base + kt * 4096 + (((2 * ks + h) ^ swz) << 4));
    __builtin_amdgcn_sched_barrier(0);
    between();
    __builtin_amdgcn_sched_barrier(0);
#pragma unroll
    for (int kt = 0; kt < 2; ++kt) {
#pragma unroll
        for (int e = 0; e < 16; ++e) s[kt][e] = 0.f;
#pragma unroll
        for (int ks = 0; ks < 4; ++ks) s[kt] = MFMA32(kf[kt * 4 + ks], qf[ks], s[kt]);
    }
}
template <bool SHIFT = false>
DI void qk_tile(const char* Kimg, const half8 (&qf)[4], f32x16 (&s)[2], int lane) { qk_tile<SHIFT>(Kimg, qf, s, lane, []() {}); }
DI float psum8(const half8& p, float acc) {
    const half2_ one = (half2_){(h16)1.f, (h16)1.f};
#pragma unroll
    for (int e = 0; e < 4; ++e) acc = __builtin_amdgcn_fdot2((half2_){p[2 * e], p[2 * e + 1]}, one, acc, false);
    return acc;
}
template <int S> DI half8 pack8(const f32x16& x) {
    return (half8){(h16)x[8 * S], (h16)x[8 * S + 1], (h16)x[8 * S + 2], (h16)x[8 * S + 3], (h16)x[8 * S + 4], (h16)x[8 * S + 5], (h16)x[8 * S + 6], (h16)x[8 * S + 7]};
}
template <int KT>
DI void pv_load(const char* Vimg, half8 (&vf)[4], int lane) {
    const int r = lane & 31, h = lane >> 5, swz = (r >> 1) & 7;
    const char* rb = Vimg + r * 128;
#pragma unroll
    for (int dt = 0; dt < 2; ++dt) {
        vf[dt * 2 + 0] = *(const half8*)(rb + dt * 4096 + (((4 * KT + h) ^ swz) << 4));
        vf[dt * 2 + 1] = *(const half8*)(rb + dt * 4096 + (((4 * KT + 2 + h) ^ swz) << 4));
    }
}
typedef unsigned u32x4_ __attribute__((ext_vector_type(4)));
template <int KT, bool MASKED = false>
DI void pv_mma(const half8 (&vf)[4], const f32x16 (&p)[2], f32x16 (&o)[2], const unsigned rmask = 0xffffffffu) {
    half8 pb0 = pack8<0>(p[KT]), pb1 = pack8<1>(p[KT]);
    if (MASKED) {
        pb0 = __builtin_bit_cast(half8, __builtin_bit_cast(u32x4_, pb0) & rmask);
        pb1 = __builtin_bit_cast(half8, __builtin_bit_cast(u32x4_, pb1) & rmask);
    }
#pragma unroll
    for (int dt = 0; dt < 2; ++dt) {
        o[dt] = MFMA32(vf[dt * 2 + 0], pb0, o[dt]);
        o[dt] = MFMA32(vf[dt * 2 + 1], pb1, o[dt]);
    }
}
template <bool MASKED = false>
DI void pv_finish(const char* Vimg, const half8 (&va)[4], const f32x16 (&p)[2], f32x16 (&o)[2], int lane, const unsigned rmask = 0xffffffffu) {
    half8 vb[4];
    pv_load<1>(Vimg, vb, lane);
    pv_mma<0, MASKED>(va, p, o, rmask);
    pv_mma<1, MASKED>(vb, p, o, rmask);
}
DI float sm_fast(f32x16 (&s)[2]) {
    float rs = 0.f;
#pragma unroll
    for (int kt = 0; kt < 2; ++kt)
#pragma unroll
        for (int e = 0; e < 16; ++e) { const float p = ex2(s[kt][e]); s[kt][e] = p; rs += p; }
    return rs;
}
DI float rowmax32(const f32x16 (&s)[2]) {
    float mx = s[0][0];
#pragma unroll
    for (int e = 1; e < 16; ++e) mx = fmaxf(mx, s[0][e]);
#pragma unroll
    for (int e = 0; e < 16; ++e) mx = fmaxf(mx, s[1][e]);
    return xhalf_max(mx);
}
constexpr float SM_THR = 6.f;
DI void sm_online(f32x16 (&s)[2], float& m, float& l, f32x16 (&o)[2], const bool rowok) {
    float mx = rowmax32(s);
    mx = rowok ? mx : NEGS;
    if (__any(mx > m + SM_THR)) {
        const float mn = fmaxf(m, mx), alpha = ex2(m - mn);
        l *= alpha; o[0] *= alpha; o[1] *= alpha; m = mn;
    }
    const float msub = rowok ? m : 1e30f;
    float rs = 0.f;
#pragma unroll
    for (int kt = 0; kt < 2; ++kt)
#pragma unroll
        for (int e = 0; e < 16; ++e) { const float p = ex2(s[kt][e] - msub); s[kt][e] = p; rs += p; }
    l += xhalf_sum(rs);
}

template <int V> struct IC { static constexpr int value = V; };
template <bool FAST>
DI void nsa_unit(PP P, int l, int bg, int c32, char* smem, const int wv) {
    P = plaunder(P);
    const int tid = otid(wv), lane = tid & 63, w = tid >> 6, r = lane & 31, h = lane >> 5;
    const int b = bg >> 1, g = bg & 1, t0 = c32 * 32, cur = c32 >> 1;
    const int tokl = w * 8 + (r >> 2), head = r & 3, t = t0 + tokl;
    const size_t tokg = (size_t)b * SEQ + t;
    float* IMP = (float*)(smem + 49152);
    unsigned* SELM = (unsigned*)(smem + 65536);
    const h16* proj = (const h16*)(P->ws + OFF_PROJ);
    const int ghead = g * 4 + head;

    half8 qf[4];
    {
        const h16* qp = proj + tokg * D_IN + C_NQ + ghead * 64 + 8 * h;
#pragma unroll
        for (int ks = 0; ks < 4; ++ks) qf[ks] = *(const half8*)(qp + 16 * ks);
    }
    auto gate = [&](const int br) -> float {
        const int tid_ = otid(wv), r_ = tid_ & 31, tokl_ = (tid_ >> 6) * 8 + (r_ >> 2), gh_ = g * 4 + (r_ & 3);
        const size_t tokg_ = (size_t)b * SEQ + t0 + tokl_;
        return sigmoidf_((float)proj[tokg_ * D_IN + C_NGL + gh_ * 3 + br] + P->in[I_NGB][l * 24 + gh_ * 3 + br]);
    };
    __syncthreads();
    for (int i = tid; i < 32 * 128; i += 256) IMP[i] = 0.f;

    half8 oacc[4];
    auto oacc_add = [&](const f32x16 (&o)[2], const float sc, const bool first) {
#pragma unroll
        for (int dt = 0; dt < 2; ++dt)
#pragma unroll
            for (int hf = 0; hf < 2; ++hf) {
                half8 v = oacc[dt * 2 + hf];
#pragma unroll
                for (int e = 0; e < 8; ++e) v[e] = (h16)((first ? 0.f : (float)v[e]) + o[dt][hf * 8 + e] * sc);
                oacc[dt * 2 + hf] = v;
            }
    };

    {
        const int nvt = 2 * c32 + 1;
        const int nvr = (t >= 31) ? ((t - 31) >> 4) + 1 : 0;
        const int ntile = (nvt + 63) >> 6;
        KVSrc src{(const h16*)(P->ws + OFF_KCMP) + (size_t)bg * 512 * 64, 64, 4096, (const h16*)(P->ws + OFF_VCMP) + (size_t)bg * 8 * 4096};
        f32x16 o[2];
#pragma unroll
        for (int e = 0; e < 16; ++e) { o[0][e] = 0.f; o[1][e] = 0.f; }
        float invl;
        if constexpr (FAST) {
            const int tf = t0 + w * 8;
            const int nvlo = __builtin_amdgcn_readfirstlane((tf >= 31) ? ((tf - 31) >> 4) + 1 : 0);
            float lsum = 0.f;
            nsa_pipe<3>(src, ntile, smem, w, lane, [&](int j, const char* st, auto&& issue) {
                f32x16 s[2];
                qk_tile<true>(st, qf, s, lane);
                issue();
                if (64 * j + 64 > nvlo) {
#pragma unroll
                    for (int kt = 0; kt < 2; ++kt)
#pragma unroll
                        for (int e = 0; e < 16; ++e) {
                            const int key = 64 * j + 32 * kt + 8 * (e >> 2) + 4 * h + (e & 3);
                            if (key >= nvr) s[kt][e] = NEGS;
                        }
                }
                lsum += sm_fast(s);
            });
            lsum = xhalf_sum(lsum);
            invl = lsum > 0.f ? 1.f / lsum : 0.f;
            nsa_pipe<3>(src, ntile, smem, w, lane, [&](int j, const char* st, auto&& issue) {
                f32x16 s[2];
                qk_tile<true>(st, qf, s, lane);
                half8 vf[4];
                pv_load<0>(st + 8192, vf, lane);
                issue();
                __builtin_amdgcn_sched_barrier(0);
                if (64 * j + 64 > nvlo) {
#pragma unroll
                    for (int kt = 0; kt < 2; ++kt)
#pragma unroll
                        for (int e = 0; e < 16; ++e) {
                            const int key = 64 * j + 32 * kt + 8 * (e >> 2) + 4 * h + (e & 3);
                            if (key >= nvr) s[kt][e] = NEGS;
                        }
                }
                (void)sm_fast(s);
                if (cur >= 16) {
#pragma unroll
                    for (int kt = 0; kt < 2; ++kt)
#pragma unroll
                        for (int g4 = 0; g4 < 4; ++g4) {
                            float G = ((s[kt][4 * g4] + s[kt][4 * g4 + 1]) + (s[kt][4 * g4 + 2] + s[kt][4 * g4 + 3])) * invl;
                            float L = s[kt][4 * g4 + 3] * invl;
                            G += shx<1>(G); G += shx<2>(G);
                            L += shx<1>(L); L += shx<2>(L);
                            if (head == 0) {
                                const int sb = 16 * j + 8 * kt + 2 * g4 + h;
                                atomicAdd(&IMP[tokl * 128 + sb], G);
                                if (sb + 1 < 128) atomicAdd(&IMP[tokl * 128 + sb + 1], L);
                            }
                        }
                }
                pv_finish(st + 8192, vf, s, o, lane);
            });
        } else {
        float m = -1e20f, lsum = 0.f;
        nsa_pipe<3>(src, ntile, smem, w, lane, [&](int j, const char* st, auto&& issue) {
            f32x16 s[2];
            qk_tile(st, qf, s, lane);
            issue();
#pragma unroll
            for (int kt = 0; kt < 2; ++kt)
#pragma unroll
                for (int e = 0; e < 16; ++e) {
                    const int key = 64 * j + 32 * kt + 8 * (e >> 2) + 4 * h + (e & 3);
                    if (key >= nvr) s[kt][e] = NEGS;
                }
            const float mn = fmaxf(m, rowmax32(s)), alpha = ex2(m - mn);
            float rs = 0.f;
#pragma unroll
            for (int kt = 0; kt < 2; ++kt)
#pragma unroll
                for (int e = 0; e < 16; ++e) rs += ex2(s[kt][e] - mn);
            rs = xhalf_sum(rs);
            lsum = lsum * alpha + rs; m = mn;
        });
        const float invl_s = lsum > 0.f ? 1.f / lsum : 0.f;
        nsa_pipe<3>(src, ntile, smem, w, lane, [&](int j, const char* st, auto&& issue) {
            f32x16 s[2];
            qk_tile(st, qf, s, lane);
            half8 vf[4];
            pv_load<0>(st + 8192, vf, lane);
            issue();
            __builtin_amdgcn_sched_barrier(0);
#pragma unroll
            for (int kt = 0; kt < 2; ++kt)
#pragma unroll
                for (int e = 0; e < 16; ++e) {
                    const int key = 64 * j + 32 * kt + 8 * (e >> 2) + 4 * h + (e & 3);
                    s[kt][e] = (key < nvr) ? ex2(s[kt][e] - m) * invl_s : 0.f;
                }
            if (cur >= 16) {
#pragma unroll
                for (int kt = 0; kt < 2; ++kt)
#pragma unroll
                    for (int g4 = 0; g4 < 4; ++g4) {
                        float G = (s[kt][4 * g4] + s[kt][4 * g4 + 1]) + (s[kt][4 * g4 + 2] + s[kt][4 * g4 + 3]);
                        float L = s[kt][4 * g4 + 3];
                        G += shx<1>(G); G += shx<2>(G);
                        L += shx<1>(L); L += shx<2>(L);
                        if (head == 0) {
                            const int sb = 16 * j + 8 * kt + 2 * g4 + h;
                            atomicAdd(&IMP[tokl * 128 + sb], G);
                            if (sb + 1 < 128) atomicAdd(&IMP[tokl * 128 + sb + 1], L);
                        }
                    }
            }
            pv_finish(st + 8192, vf, s, o, lane);
        });
            invl = 1.f;
        }
        oacc_add(o, gate(0) * invl, true);
    }
    __syncthreads();
    {
        const int tl = lane >> 3, sub = lane & 7;
        unsigned bits = 0;
        unsigned u[16];
        if (cur >= 16) {
            const float* ip = IMP + (w * 8 + tl) * 128 + sub * 16;
#pragma unroll
            for (int i = 0; i < 16; ++i) {
                const int s = sub * 16 + i;
                u[i] = (s >= 1 && s <= cur - 2) ? (__float_as_uint(ip[i]) + 1u) : 0u;
            }
        }
        __syncthreads();
        if (cur >= 16) {
            unsigned prefix = 0;
            for (int bit = 30; bit >= 0; --bit) {
                const unsigned cand = prefix | (1u << bit);
                int cnt = 0;
#pragma unroll
                for (int i = 0; i < 16; ++i) cnt += (u[i] >= cand) ? 1 : 0;
                cnt += shx_i<1>(cnt); cnt += shx_i<2>(cnt); cnt += shx_i<4>(cnt);
                if (cnt >= 13) prefix = cand;
            }
            int cgt = 0, ceq = 0;
#pragma unroll
            for (int i = 0; i < 16; ++i) { cgt += (u[i] > prefix) ? 1 : 0; ceq += (u[i] == prefix) ? 1 : 0; }
            cgt += shx_i<1>(cgt); cgt += shx_i<2>(cgt); cgt += shx_i<4>(cgt);
            int inc = ceq;
            { const int v = row_shr_i<1>(inc); if (sub >= 1) inc += v; }
            { const int v = row_shr_i<2>(inc); if (sub >= 2) inc += v; }
            { const int v = row_shr_i<4>(inc); if (sub >= 4) inc += v; }
            int run = inc - ceq;
            const int need = 13 - cgt;
#pragma unroll
            for (int i = 0; i < 16; ++i) {
                const int s = sub * 16 + i;
                bool sel = u[i] > prefix;
                if (u[i] == prefix) { sel = run < need; ++run; }
                if (s == 0 || s == cur || s == cur - 1) sel = true;
                bits |= (sel ? 1u : 0u) << i;
            }
        } else {
#pragma unroll
            for (int i = 0; i < 16; ++i) bits |= ((sub * 16 + i <= cur) ? 1u : 0u) << i;
        }
        unsigned wv = bits << ((sub & 1) * 16);
        wv |= (unsigned)shx_i<1>((int)wv);
        if ((sub & 1) == 0) SELM[(w * 8 + tl) * 4 + (sub >> 1)] = wv;
    }
    __syncthreads();
    const unsigned* selrow = SELM + tokl * 4;

    auto branch = [&](auto BRC) {
        constexpr int br = decltype(BRC)::value;
        const int j0 = (br == 0) ? 0 : (cur - 8 > 0 ? cur - 8 : 0);
        const int nst = cur - j0 + 1;
        KVSrc src{proj + ((size_t)b * SEQ + (size_t)j0 * 64) * D_IN + C_NKV + (br == 0 ? 256 : 512) + g * 64, D_IN, (size_t)64 * D_IN,
                  (const h16*)(P->ws + OFF_VTG) + (((size_t)br * 4 + bg) * 128 + j0) * 4096};
        float m = -1e20f, lsum = 0.f;
        f32x16 o[2];
#pragma unroll
        for (int e = 0; e < 16; ++e) { o[0][e] = 0.f; o[1][e] = 0.f; }
        if constexpr (FAST) {
            f32x16 s[2];
            NSA_WAITBAR(0);
            {
                const int k = nst < 3 ? nst : 3;
                for (int p = 0; p < k; ++p) nsa_dma(src, p, smem + p * 16384, w, lane);
            }
            NSA_WAITBAR(0);
            __builtin_amdgcn_s_sleep(2);
            NSA_BAR();
            qk_tile<true>(smem, qf, s, lane);
            const int r_ = lane & 31, swz_ = (r_ >> 1) & 7;
#pragma unroll 1
            for (int jj = 0; jj + 1 < nst; ++jj) {
                NSA_WAITBAR(0);
                const char* stv = smem + (jj & 3) * 16384 + 8192;
                const char* stk = smem + ((jj + 1) & 3) * 16384 + r_ * 128;
                const int j = j0 + jj;
                const bool rowok = (br != 0) || (((selrow[j >> 5] >> (j & 31)) & 1u) != 0u);
                const unsigned rmask = rowok ? 0xffffffffu : 0u;
                half8 kfa[4];
#pragma unroll
                for (int ks = 0; ks < 4; ++ks) kfa[ks] = *(const half8*)(stk + (((2 * ks + h) ^ swz_) << 4));
                half8 va[4];
                pv_load<0>(stv, va, lane);
                __builtin_amdgcn_sched_barrier(0);
                if (jj + 3 < nst) nsa_dma(src, jj + 3, smem + ((jj + 3) & 3) * 16384, w, lane);
                __builtin_amdgcn_sched_barrier(0);
                if (br == 1 && jj == 0 && cur >= 8) {
#pragma unroll
                    for (int kt = 0; kt < 2; ++kt)
#pragma unroll
                        for (int e = 0; e < 16; ++e) {
                            const int key = 64 * j + 32 * kt + 8 * (e >> 2) + 4 * h + (e & 3);
                            if (!(key > t - 512)) s[kt][e] = NEGS;
                        }
                }
#pragma unroll
                for (int e = 0; e < 16; ++e) s[0][e] = ex2(s[0][e]);
                half8 pa0 = pack8<0>(s[0]), pa1 = pack8<1>(s[0]);
                if (br == 0) {
                    pa0 = __builtin_bit_cast(half8, __builtin_bit_cast(u32x4_, pa0) & rmask);
                    pa1 = __builtin_bit_cast(half8, __builtin_bit_cast(u32x4_, pa1) & rmask);
                }
                lsum = psum8(pa1, psum8(pa0, lsum));
                __builtin_amdgcn_sched_barrier(0);
                f32x16 sn0, sn1;
#pragma unroll
                for (int e = 0; e < 16; ++e) { sn0[e] = 0.f; sn1[e] = 0.f; }
#pragma unroll
                for (int ks = 0; ks < 4; ++ks) sn0 = MFMA32(kfa[ks], qf[ks], sn0);
                o[0] = MFMA32(va[0], pa0, o[0]);
                o[0] = MFMA32(va[1], pa1, o[0]);
                o[1] = MFMA32(va[2], pa0, o[1]);
                o[1] = MFMA32(va[3], pa1, o[1]);
                half8 kfb[4];
#pragma unroll
                for (int ks = 0; ks < 4; ++ks) kfb[ks] = *(const half8*)(stk + 4096 + (((2 * ks + h) ^ swz_) << 4));
                half8 vb[4];
                pv_load<1>(stv, vb, lane);
#pragma unroll
                for (int e = 0; e < 16; ++e) s[1][e] = ex2(s[1][e]);
                half8 pb0 = pack8<0>(s[1]), pb1 = pack8<1>(s[1]);
                if (br == 0) {
                    pb0 = __builtin_bit_cast(half8, __builtin_bit_cast(u32x4_, pb0) & rmask);
                    pb1 = __builtin_bit_cast(half8, __builtin_bit_cast(u32x4_, pb1) & rmask);
                }
                lsum = psum8(pb1, psum8(pb0, lsum));
                __builtin_amdgcn_sched_barrier(0);
#pragma unroll
                for (int ks = 0; ks < 4; ++ks) sn1 = MFMA32(kfb[ks], qf[ks], sn1);
                o[0] = MFMA32(vb[0], pb0, o[0]);
                o[0] = MFMA32(vb[1], pb1, o[0]);
                o[1] = MFMA32(vb[2], pb0, o[1]);
                o[1] = MFMA32(vb[3], pb1, o[1]);
                s[0] = sn0; s[1] = sn1;
            }
            {
                const int jj = nst - 1, j = cur;
                const char* stv = smem + (jj & 3) * 16384 + 8192;
                const bool rowok = (br != 0) || (((selrow[j >> 5] >> (j & 31)) & 1u) != 0u);
                half8 va[4];
                pv_load<0>(stv, va, lane);
#pragma unroll
                for (int kt = 0; kt < 2; ++kt)
#pragma unroll
                    for (int e = 0; e < 16; ++e) {
                        const int key = 64 * j + 32 * kt + 8 * (e >> 2) + 4 * h + (e & 3);
                        const bool ok = (key <= t) && (br == 0 || key > t - 512);
                        if (!ok) s[kt][e] = NEGS;
                    }
                const float rs = sm_fast(s);
                lsum += rowok ? rs : 0.f;
                pv_finish<br == 0>(stv, va, s, o, lane, rowok ? 0xffffffffu : 0u);
            }
        } else {
        nsa_pipe<4>(src, nst, smem, w, lane, [&](int jj, const char* st, auto&& issue) {
            const int j = j0 + jj;
            const bool rowok = (br != 0) || (((selrow[j >> 5] >> (j & 31)) & 1u) != 0u);
            f32x16 s[2];
            qk_tile<FAST>(st, qf, s, lane, issue);
            half8 vf[4];
            pv_load<0>(st + 8192, vf, lane);
            __builtin_amdgcn_sched_barrier(0);
            if (j == cur || (br == 1 && j == cur - 8)) {
#pragma unroll
                for (int kt = 0; kt < 2; ++kt)
#pragma unroll
                    for (int e = 0; e < 16; ++e) {
                        const int key = 64 * j + 32 * kt + 8 * (e >> 2) + 4 * h + (e & 3);
                        const bool ok = (key <= t) && (br == 0 || key > t - 512);
                        if (!ok) s[kt][e] = NEGS;
                    }
            }
            sm_online(s, m, lsum, o, rowok);
            pv_finish(st + 8192, vf, s, o, lane);
        });
        }
        if constexpr (FAST) lsum = xhalf_sum(lsum);
        const float sc = gate(br == 0 ? 1 : 2) / lsum;
        oacc_add(o, sc, false);
    };
    if constexpr (FAST) {
    const int kr = lane & 15, q4 = lane >> 4;
    half4 oa[2][4];
    {
        h16* scr = (h16*)(smem + w * 4096);
#pragma unroll
        for (int dt2 = 0; dt2 < 2; ++dt2)
#pragma unroll
            for (int hf = 0; hf < 2; ++hf) {
                const half8 v = oacc[dt2 * 2 + hf];
                const int d0 = 32 * dt2 + 16 * hf + 4 * h;
                *(half4*)(scr + r * 64 + d0) = (half4){v[0], v[1], v[2], v[3]};
                *(half4*)(scr + r * 64 + d0 + 8) = (half4){v[4], v[5], v[6], v[7]};
            }
#pragma unroll
        for (int u = 0; u < 2; ++u)
#pragma unroll
            for (int dt = 0; dt < 4; ++dt) oa[u][dt] = *(const half4*)(scr + (u * 16 + kr) * 64 + 16 * dt + 4 * q4);
    }
    half8 qf16[2][2];
#pragma unroll
    for (int u = 0; u < 2; ++u) {
        const h16* qp = proj + ((size_t)b * SEQ + t0 + w * 8 + u * 4 + (kr >> 2)) * D_IN + C_NQ + (g * 4 + (kr & 3)) * 64 + 8 * q4;
        qf16[u][0] = *(const half8*)qp; qf16[u][1] = *(const half8*)(qp + 32);
    }
    auto branch16 = [&](auto BRC) {
        constexpr int br = decltype(BRC)::value;
        const int j0 = (br == 0) ? 0 : (cur - 8 > 0 ? cur - 8 : 0);
        const int nst = cur - j0 + 1;
        KVSrc src{proj + ((size_t)b * SEQ + (size_t)j0 * 64) * D_IN + C_NKV + (br == 0 ? 256 : 512) + g * 64, D_IN, (size_t)64 * D_IN,
                  (const h16*)(P->ws + OFF_VTG) + (((size_t)br * 4 + bg) * 128 + j0) * 4096};
        f32x4 o[2][4];
        float lsum[2] = {0.f, 0.f};
#pragma unroll
        for (int u = 0; u < 2; ++u)
#pragma unroll
            for (int dt = 0; dt < 4; ++dt) o[u][dt] = (f32x4){0.f, 0.f, 0.f, 0.f};
        const int swz = (kr >> 1) & 7;
        nsa_pipe2(src, nst, smem, w, lane, [&](int jj, const char* st, auto&& issue) {
            const int j = j0 + jj;
            bool rowok[2], act[2];
#pragma unroll
            for (int u = 0; u < 2; ++u) {
                rowok[u] = (br != 0) || (((SELM[(w * 8 + u * 4 + (kr >> 2)) * 4 + (j >> 5)] >> (j & 31)) & 1u) != 0u);
                act[u] = (br != 0) || __any(rowok[u]);
            }
            if (br == 0 && !(act[0] || act[1])) { issue(); return; }
            half8 kf[8];
#pragma unroll
            for (int kt = 0; kt < 4; ++kt)
#pragma unroll
                for (int ks = 0; ks < 2; ++ks) kf[kt * 2 + ks] = *(const half8*)(st + (16 * kt + kr) * 128 + (((4 * ks + q4) ^ swz) << 4));
            __builtin_amdgcn_sched_barrier(0);
            issue();
            __builtin_amdgcn_sched_barrier(0);
            half8 vf[8];
#pragma unroll
            for (int dt = 0; dt < 4; ++dt)
#pragma unroll
                for (int kp = 0; kp < 2; ++kp) vf[dt * 2 + kp] = *(const half8*)(st + 8192 + (16 * dt + kr) * 128 + (((4 * kp + q4) ^ swz) << 4));
            const bool diag = (j == cur) || (br == 1 && j == cur - 8);
#pragma unroll
            for (int u = 0; u < 2; ++u) {
                if (act[u]) {
                    f32x4 sv[4];
#pragma unroll
                    for (int kt = 0; kt < 4; ++kt) {
                        sv[kt] = (f32x4){0.f, 0.f, 0.f, 0.f};
                        sv[kt] = MFMA16(kf[kt * 2], qf16[u][0], sv[kt]);
                        sv[kt] = MFMA16(kf[kt * 2 + 1], qf16[u][1], sv[kt]);
                    }
                    if (diag) {
                        const int tu = t0 + w * 8 + u * 4 + (kr >> 2);
#pragma unroll
                        for (int kt = 0; kt < 4; ++kt)
#pragma unroll
                            for (int e = 0; e < 4; ++e) {
                                const int key = 64 * j + 16 * kt + 4 * q4 + e;
                                const bool ok = (key <= tu) && (br == 0 || key > tu - 512);
                                if (!ok) sv[kt][e] = NEGS;
                            }
                    }
#pragma unroll
                    for (int kt = 0; kt < 4; ++kt)
#pragma unroll
                        for (int e = 0; e < 4; ++e) sv[kt][e] = ex2(sv[kt][e]);
                    half8 pb[2];
#pragma unroll
                    for (int kp = 0; kp < 2; ++kp) {
                        pb[kp] = (half8){(h16)sv[2 * kp][0], (h16)sv[2 * kp][1], (h16)sv[2 * kp][2], (h16)sv[2 * kp][3],
                                         (h16)sv[2 * kp + 1][0], (h16)sv[2 * kp + 1][1], (h16)sv[2 * kp + 1][2], (h16)sv[2 * kp + 1][3]};
                        if (br == 0) pb[kp] = __builtin_bit_cast(half8, __builtin_bit_cast(u32x4_, pb[kp]) & (rowok[u] ? 0xffffffffu : 0u));
                    }
                    lsum[u] = psum8(pb[1], psum8(pb[0], lsum[u]));
#pragma unroll
                    for (int kp = 0; kp < 2; ++kp)
#pragma unroll
                        for (int dt = 0; dt < 4; ++dt) o[u][dt] = MFMA16(vf[dt * 2 + kp], pb[kp], o[u][dt]);
                }
            }
        });
#pragma unroll
        for (int u = 0; u < 2; ++u) {
            float lt = lsum[u];
            lt += shx<16>(lt); lt = xhalf_sum(lt);
            const int tid_ = otid(wv), kr_ = tid_ & 15;
            const size_t tokg_ = (size_t)b * SEQ + t0 + (tid_ >> 6) * 8 + u * 4 + (kr_ >> 2);
            const int gh_ = g * 4 + (kr_ & 3), bi = (br == 0 ? 1 : 2);
            const float gt = sigmoidf_((float)proj[tokg_ * D_IN + C_NGL + gh_ * 3 + bi] + P->in[I_NGB][l * 24 + gh_ * 3 + bi]);
            const float sc = gt / lt;
#pragma unroll
            for (int dt = 0; dt < 4; ++dt) {
                half4 a = oa[u][dt];
#pragma unroll
                for (int e = 0; e < 4; ++e) a[e] = (h16)((float)a[e] + o[u][dt][e] * sc);
                oa[u][dt] = a;
            }
        }
    };
    branch16(IC<0>{});
    branch16(IC<1>{});
#pragma unroll
    for (int u = 0; u < 2; ++u) {
        const int tid_ = otid(wv), kr_ = tid_ & 15, q_ = (tid_ >> 4) & 3;
        const size_t tokg_ = (size_t)b * SEQ + t0 + (tid_ >> 6) * 8 + u * 4 + (kr_ >> 2);
        const int gh_ = g * 4 + (kr_ & 3);
        h16* mixp = (h16*)(P->ws + OFF_MIX) + kb_idx(NT, tokg_, 512 + gh_ * 64);
        const h16* ngp = proj + tokg_ * D_IN + C_NG + gh_ * 64;
#pragma unroll
        for (int dt = 0; dt < 4; ++dt) {
            const int d0 = 16 * dt + 4 * q_;
            const half4 ng = *(const half4*)(ngp + d0);
            half4 ov;
#pragma unroll
            for (int e = 0; e < 4; ++e) ov[e] = (h16)((float)oa[u][dt][e] * siluf_((float)ng[e]));
            *(half4*)(mixp + d0) = ov;
        }
    }
    } else {
    branch(IC<0>{});
    branch(IC<1>{});
    {
        const int tid_ = otid(wv), r_ = tid_ & 31, h_ = (tid_ >> 5) & 1, tokl_ = (tid_ >> 6) * 8 + (r_ >> 2), gh_ = g * 4 + (r_ & 3);
        const size_t tokg_ = (size_t)b * SEQ + t0 + tokl_;
        h16* mixp = (h16*)(P->ws + OFF_MIX) + kb_idx(NT, tokg_, 512 + gh_ * 64);
        const h16* ngp = proj + tokg_ * D_IN + C_NG + gh_ * 64;
#pragma unroll
        for (int dt = 0; dt < 2; ++dt)
#pragma unroll
            for (int g4 = 0; g4 < 4; ++g4) {
                const int d0 = 32 * dt + 8 * g4 + 4 * h_;
                const half4 ng = *(const half4*)(ngp + d0);
                half4 ov;
#pragma unroll
                for (int e = 0; e < 4; ++e) ov[e] = (h16)((float)oacc[dt * 2 + (g4 >> 1)][(g4 & 1) * 4 + e] * siluf_((float)ng[e]));
                *(half4*)(mixp + d0) = ov;
            }
    }
    }
    __syncthreads();
}

DI void gla_kv_item(PP P, int l, int item, char* smem, const int wv) {
    P = plaunder(P);
    const int tid = otid(wv), lane = tid & 63, w = tid >> 6, r = lane & 31, hh = lane >> 5;
    const int pair = item * 4 + w, h = pair & 3, cn = pair >> 2;
    const size_t tok = (size_t)cn * 32 + r;
    const int b = cn >> 8, n = cn & 255, bh = b * 4 + h;
    const h16* proj = (const h16*)(P->ws + OFF_PROJ);
    h16* VT = (h16*)(smem + w * 16384);
    h16* KT = VT + 2048;
    __syncthreads();
    {
        const half8* vp = (const half8*)(proj + tok * D_IN + C_GV + h * 64 + hh * 32);
#pragma unroll
        for (int q = 0; q < 4; ++q) {
            const half8 v8 = vp[q];
#pragma unroll
            for (int e = 0; e < 8; ++e) VT[(hh * 32 + q * 8 + e) * 32 + r] = v8[e];
        }
    }
    float gl[16];
    {
        const half8* lp = (const half8*)(proj + tok * D_IN + C_GLR);
        const half8 l0 = lp[0], l1 = lp[1];
        float lr[16];
#pragma unroll
        for (int q = 0; q < 8; ++q) { lr[q] = (float)l0[q]; lr[8 + q] = (float)l1[q]; }
        const float* w2 = P->in[I_GW2] + (size_t)l * 16 * 128 + h * 32 + 16 * hh;
        const float* b2 = P->in[I_GB2] + l * 128 + h * 32 + 16 * hh;
#pragma unroll
        for (int d = 0; d < 16; ++d) gl[d] = b2[d];
#pragma unroll
        for (int q = 0; q < 16; ++q)
#pragma unroll
            for (int d4 = 0; d4 < 4; ++d4) {
                const float4 wq = *(const float4*)(w2 + q * 128 + d4 * 4);
                gl[d4 * 4 + 0] += lr[q] * wq.x; gl[d4 * 4 + 1] += lr[q] * wq.y; gl[d4 * 4 + 2] += lr[q] * wq.z; gl[d4 * 4 + 3] += lr[q] * wq.w;
            }
#pragma unroll
        for (int d = 0; d < 16; ++d) gl[d] = log_sigmoidf_(gl[d]) * (1.f / 16.f);
    }
#pragma unroll
    for (int off = 1; off < 32; off <<= 1) {
        const int src = olane() - off;
#pragma unroll
        for (int d = 0; d < 16; ++d) { const float v = bperm(gl[d], src); if (r >= off) gl[d] += v; }
    }
    {
        float* bc = (float*)(P->ws + OFF_BCUM) + tok * 128 + h * 32 + 16 * hh;
#pragma unroll
        for (int d4 = 0; d4 < 4; ++d4) *(float4*)(bc + d4 * 4) = (float4){gl[d4 * 4], gl[d4 * 4 + 1], gl[d4 * 4 + 2], gl[d4 * 4 + 3]};
    }
    {
        const half8* kp = (const half8*)(proj + tok * D_IN + C_GK + h * 32 + 16 * hh);
        const half8 k0 = kp[0], k1 = kp[1];
        float bl[16];
#pragma unroll
        for (int d = 0; d < 16; ++d) bl[d] = bperm(gl[d], olane() | 31);
#pragma unroll
        for (int d = 0; d < 16; ++d) {
            const float kd = (float)(d < 8 ? k0[d & 7] : k1[d & 7]) * __expf(bl[d] - gl[d]);
            KT[(16 * hh + d) * 32 + r] = (h16)kd;
        }
        if (r == 0) {
            float* dc = (float*)(P->ws + OFF_GDEC) + (size_t)(bh * 256 + n) * 32 + 16 * hh;
#pragma unroll
            for (int d4 = 0; d4 < 4; ++d4) *(float4*)(dc + d4 * 4) = (float4){__expf(bl[d4 * 4]), __expf(bl[d4 * 4 + 1]), __expf(bl[d4 * 4 + 2]), __expf(bl[d4 * 4 + 3])};
        }
    }
    asm volatile("s_waitcnt lgkmcnt(0)" ::: "memory");
    const half8 kb0 = *(const half8*)(KT + r * 32 + 8 * hh), kb1 = *(const half8*)(KT + r * 32 + 16 + 8 * hh);
    float* kvp = (float*)(P->ws + OFF_GKV) + ((size_t)(bh * 256 + n) * 32 + r) * 64;
#pragma unroll
    for (int dt = 0; dt < 2; ++dt) {
        f32x16 o;
#pragma unroll
        for (int e = 0; e < 16; ++e) o[e] = 0.f;
        const h16* vrow = VT + (32 * dt + r) * 32 + 8 * hh;
        o = MFMA32(*(const half8*)vrow, kb0, o);
        o = MFMA32(*(const half8*)(vrow + 16), kb1, o);
#pragma unroll
        for (int g4 = 0; g4 < 4; ++g4)
            *(float4*)(kvp + 32 * dt + 8 * g4 + 4 * hh) = (float4){o[4 * g4], o[4 * g4 + 1], o[4 * g4 + 2], o[4 * g4 + 3]};
    }
    __syncthreads();
}

DI void gla_out_item(PP P, int l, int item, char* smem, const int wv) {
    P = plaunder(P);
    const int tid = otid(wv), lane = tid & 63, w = tid >> 6, r = lane & 31, hh = lane >> 5;
    const int pair = item * 4 + w, h = pair & 3, cn = pair >> 2;
    const size_t tok0 = (size_t)cn * 32, tok = tok0 + r;
    const int b = cn >> 8, n = cn & 255, bh = b * 4 + h;
    const h16* proj = (const h16*)(P->ws + OFF_PROJ);
    h16* VT = (h16*)(smem + w * 16384);
    h16* SPT = VT + 2048;
    __syncthreads();
    {
        const half8* vp = (const half8*)(proj + tok * D_IN + C_GV + h * 64 + hh * 32);
        const float4* sp = (const float4*)((const float*)(P->ws + OFF_GKV) + ((size_t)(bh * 256 + n) * 32 + r) * 64 + hh * 32);
#pragma unroll
        for (int q = 0; q < 4; ++q) {
            const half8 v8 = vp[q];
            const float4 s0 = sp[2 * q], s1 = sp[2 * q + 1];
#pragma unroll
            for (int e = 0; e < 8; ++e) VT[(hh * 32 + q * 8 + e) * 32 + r] = v8[e];
            SPT[(hh * 32 + q * 8 + 0) * 32 + r] = (h16)s0.x; SPT[(hh * 32 + q * 8 + 1) * 32 + r] = (h16)s0.y;
            SPT[(hh * 32 + q * 8 + 2) * 32 + r] = (h16)s0.z; SPT[(hh * 32 + q * 8 + 3) * 32 + r] = (h16)s0.w;
            SPT[(hh * 32 + q * 8 + 4) * 32 + r] = (h16)s1.x; SPT[(hh * 32 + q * 8 + 5) * 32 + r] = (h16)s1.y;
            SPT[(hh * 32 + q * 8 + 6) * 32 + r] = (h16)s1.z; SPT[(hh * 32 + q * 8 + 7) * 32 + r] = (h16)s1.w;
        }
    }
    half8 qe[2], ke[2];
#pragma unroll
    for (int ks = 0; ks < 2; ++ks) {
        const int d0 = 16 * ks + 8 * hh;
        const half8 q8 = *(const half8*)(proj + tok * D_IN + C_GQ + h * 32 + d0);
        const half8 k8 = *(const half8*)(proj + tok * D_IN + C_GK + h * 32 + d0);
        const float4 b0 = *(const float4*)((const float*)(P->ws + OFF_BCUM) + tok * 128 + h * 32 + d0);
        const float4 b1 = *(const float4*)((const float*)(P->ws + OFF_BCUM) + tok * 128 + h * 32 + d0 + 4);
        const float bc[8] = {b0.x, b0.y, b0.z, b0.w, b1.x, b1.y, b1.z, b1.w};
#pragma unroll
        for (int e = 0; e < 8; ++e) {
            const float ex = __expf(bc[e]);
            qe[ks][e] = (h16)((float)q8[e] * 0.17677669529663687f * ex);
            ke[ks][e] = (h16)((float)k8[e] * __builtin_amdgcn_rcpf(ex));
        }
    }
    f32x16 s;
#pragma unroll
    for (int e = 0; e < 16; ++e) s[e] = 0.f;
    s = MFMA32(ke[0], qe[0], s);
    s = MFMA32(ke[1], qe[1], s);
#pragma unroll
    for (int e = 0; e < 16; ++e) { const int j = (e & 3) + 8 * (e >> 2) + 4 * hh; if (j > r) s[e] = 0.f; }
    const half8 pb0 = pack8<0>(s), pb1 = pack8<1>(s);
    asm volatile("s_waitcnt lgkmcnt(0)" ::: "memory");
    f32x16 o[2];
#pragma unroll
    for (int dt = 0; dt < 2; ++dt) {
#pragma unroll
        for (int e = 0; e < 16; ++e) o[dt][e] = 0.f;
        const h16* vrow = VT + (32 * dt + r) * 32 + 4 * hh;
        const h16* srow = SPT + (32 * dt + r) * 32 + 8 * hh;
        {
            const half4 lo = *(const half4*)vrow, hi = *(const half4*)(vrow + 8);
            o[dt] = MFMA32(((half8){lo[0], lo[1], lo[2], lo[3], hi[0], hi[1], hi[2], hi[3]}), pb0, o[dt]);
        }
        {
            const half4 lo = *(const half4*)(vrow + 16), hi = *(const half4*)(vrow + 24);
            o[dt] = MFMA32(((half8){lo[0], lo[1], lo[2], lo[3], hi[0], hi[1], hi[2], hi[3]}), pb1, o[dt]);
        }
        o[dt] = MFMA32(*(const half8*)srow, qe[0], o[dt]);
        o[dt] = MFMA32(*(const half8*)(srow + 16), qe[1], o[dt]);
    }
    float ss = 0.f;
#pragma unroll
    for (int e = 0; e < 16; ++e) ss += o[0][e] * o[0][e] + o[1][e] * o[1][e];
    ss = xhalf_sum(ss);
    const float rn = rsqrtf(ss * (1.f / 64.f) + 1e-6f);
    h16* mix = (h16*)(P->ws + OFF_MIX);
#pragma unroll
    for (int dt = 0; dt < 2; ++dt)
#pragma unroll
        for (int g4 = 0; g4 < 4; ++g4) {
            const int e0 = 32 * dt + 8 * g4 + 4 * hh;
            const half4 gt = *(const half4*)(proj + tok * D_IN + C_GG + h * 64 + e0);
            const float4 on = *(const float4*)(P->in[I_GON] + l * 64 + e0);
            half4 ov;
            ov[0] = (h16)(o[dt][4 * g4 + 0] * rn * on.x * siluf_((float)gt[0]));
            ov[1] = (h16)(o[dt][4 * g4 + 1] * rn * on.y * siluf_((float)gt[1]));
            ov[2] = (h16)(o[dt][4 * g4 + 2] * rn * on.z * siluf_((float)gt[2]));
            ov[3] = (h16)(o[dt][4 * g4 + 3] * rn * on.w * siluf_((float)gt[3]));
            *(half4*)(mix + kb_idx(NT, tok, h * 64 + e0)) = ov;
        }
    __syncthreads();
}

DI void glu_tile(PP P, int l, int tile, char* smem, const int wv) {
    P = plaunder(P);
    const int mt = tile >> 2, nt = tile & 3;
    f32x4 acc[4][4];
    float ssd[4];
    gemm_mainloop_glds<false>(wv, 256, APlain{(const h16*)(P->ws + OFF_YACT) + (size_t)mt * 128 * 256, 256, 64},
                              (const h16*)(P->ws + OFF_WTGLU) + ((size_t)l * 512 + nt * 128) * 256, 256, acc, ssd, smem);
    const int tid = otid(wv), lane = tid & 63, wid = tid >> 6, wr = wid >> 1, wc = wid & 1;
    const h16* proj = (const h16*)(P->ws + OFF_PROJ);
    h16* mix = (h16*)(P->ws + OFF_MIX);
    const float* gb = P->in[I_GLUB] + l * 512;
#pragma unroll
    for (int i = 0; i < 4; ++i) {
        const size_t tok = (size_t)mt * 128 + wr * 64 + i * 16 + (lane & 15);
#pragma unroll
        for (int pj = 0; pj < 2; ++pj) {
            const int c = nt * 64 + wc * 32 + pj * 16 + (lane >> 4) * 4;
            const f32x4 z1 = acc[i][2 * pj], z2 = acc[i][2 * pj + 1];
            const float4 b1 = *(const float4*)(gb + c), b2 = *(const float4*)(gb + 256 + c);
            const half4 g4 = *(const half4*)(proj + tok * D_IN + C_SG + c);
            half4 o;
            o[0] = (h16)((z1[0] + b1.x) * sigmoidf_(z2[0] + b2.x) * siluf_((float)g4[0]));
            o[1] = (h16)((z1[1] + b1.y) * sigmoidf_(z2[1] + b2.y) * siluf_((float)g4[1]));
            o[2] = (h16)((z1[2] + b1.z) * sigmoidf_(z2[2] + b2.z) * siluf_((float)g4[2]));
            o[3] = (h16)((z1[3] + b1.w) * sigmoidf_(z2[3] + b2.w) * siluf_((float)g4[3]));
            *(half4*)(mix + kb_idx(NT, tok, 256 + c)) = o;
        }
    }
}

DI void outproj_tile(PP P, int l, int mt, int nt, char* smem, const int wv) {
    P = plaunder(P);
    f32x4 acc[8][4];
    float ssd[8];
    gemm_glds<false, 2, 8, 4, 3>(wv, 1024, APlain{(const h16*)(P->ws + OFF_MIX) + (size_t)mt * 256 * 64, 64, (size_t)NT * 64},
                              (const h16*)(P->ws + OFF_WTOUT) + ((size_t)l * 16 * 1024 + nt * 128) * 64, 64, acc, ssd, smem, (size_t)1024 * 64);
    const int tid = otid(wv), lane = tid & 63, wid = tid >> 6, wr = wid >> 1, wc = wid & 1;
    h16* xh = XH_BASE(P);
#pragma unroll
    for (int i = 0; i < 8; ++i) {
        const size_t row = (size_t)mt * 256 + wr * 128 + i * 16 + (lane & 15);
#pragma unroll
        for (int jj = 0; jj < 4; ++jj) {
            const int n = nt * 128 + wc * 64 + jj * 16 + (lane >> 4) * 4;
            const f32x4 v = acc[i][jj];
            h16* xp = xh + kb_idx(NT, row, n);
            const half4 xr = *(const half4*)xp;
            const float4 xn = (float4){(float)xr[0] + v[0], (float)xr[1] + v[1], (float)xr[2] + v[2], (float)xr[3] + v[3]};
            if (l != DEPTH - 1) *(half4*)xp = (half4){(h16)xn.x, (h16)xn.y, (h16)xn.z, (h16)xn.w};
            else *(float4*)((row < (size_t)(NT / 2) ? P->out + row * 1024 : (float*)(P->ws + OFF_PROJ) + (row - NT / 2) * 1024) + n) = xn;
        }
    }
}

#define XB_TMO      128
#define XB_XCNT(j)  (256  + 64 * (j))
#define XB_XSUB(j)  (1280 + 64 * (j))
#define XB_XGEN(j)  (2304 + 64 * (j))
#define XB_TOP      3328
#define XB_TOPGEN   3392
#define XCD_BAR_WORDS 3456
#define XB_SPIN_CAP (1u << 18)
#define LAS __attribute__((address_space(3)))

__device__ __forceinline__ unsigned xb_ld(unsigned* p)              { return __hip_atomic_load(p, __ATOMIC_RELAXED, __HIP_MEMORY_SCOPE_AGENT); }
__device__ __forceinline__ unsigned xb_add(unsigned* p, unsigned v) { return __hip_atomic_fetch_add(p, v, __ATOMIC_RELAXED, __HIP_MEMORY_SCOPE_AGENT); }
__device__ __forceinline__ unsigned xb_xcc_id() { return (unsigned)__builtin_amdgcn_s_getreg((3 << 11) | 20) & 0xFu; }
#define XB_SPIN(cond, bar) do { unsigned _sp = 0; while (cond) { __builtin_amdgcn_s_sleep(1); \
    if ((++_sp & 255u) == 0u) { if (xb_ld(&(bar)[XB_TMO])) break; if (_sp > XB_SPIN_CAP) { atomicAdd(&(bar)[XB_TMO], 1u); break; } } } } while (0)

struct XcdBarrier {
    unsigned* bar; unsigned x;
    volatile LAS unsigned* st;
};

__device__ __forceinline__ XcdBarrier xcd_barrier_post(unsigned* bar, volatile LAS unsigned* st) {
    XcdBarrier b; b.bar = bar; b.x = xb_xcc_id(); b.st = st;
    if (threadIdx.x == 0) (void)xb_add(&bar[XB_XCNT(b.x)], 1u);
    return b;
}
__device__ __forceinline__ void xcd_barrier_complete(unsigned* bar, unsigned x, unsigned& nloc, unsigned& nx) {
    const unsigned G = gridDim.x * gridDim.y * gridDim.z;
    unsigned sum, cnt, mine, sp = 0u;
    for (;;) {
        sum = 0u; cnt = 0u; mine = 0u;
#pragma unroll
        for (unsigned j = 0; j < 16; ++j) { const unsigned c = xb_ld(&bar[XB_XCNT(j)]); sum += c; cnt += (c > 0u) ? 1u : 0u; mine = (j == x) ? c : mine; }
        if (sum == G) break;
        __builtin_amdgcn_s_sleep(1);
        if ((++sp & 255u) == 0u) { if (xb_ld(&bar[XB_TMO])) break; if (sp > XB_SPIN_CAP) { atomicAdd(&bar[XB_TMO], 1u); break; } }
    }
    nloc = mine > 0u ? mine : 1u; nx = cnt > 0u ? cnt : 1u;
}

__device__ __forceinline__ void xcd_barrier(const XcdBarrier& b) {
    asm volatile("s_waitcnt vmcnt(0)" ::: "memory");
    __syncthreads();
    if (threadIdx.x == 0) {
        unsigned* bar = b.bar;
        __builtin_amdgcn_s_waitcnt(0);
        unsigned nloc = b.st[0], nx = b.st[1];
        if (nloc == 0u) { xcd_barrier_complete(bar, b.x, nloc, nx); b.st[0] = nloc; b.st[1] = nx; }
        const unsigned old = xb_add(&bar[XB_XSUB(b.x)], 1u);
        const unsigned gen = old / nloc;
        if (old + 1u == (gen + 1u) * nloc) {
            __builtin_amdgcn_fence(__ATOMIC_RELEASE, "agent");
            asm volatile("s_waitcnt vmcnt(0)" ::: "memory");
            const unsigned og = xb_add(&bar[XB_TOP], 1u);
            const unsigned tg = og / nx;
            if (og + 1u == (tg + 1u) * nx) xb_add(&bar[XB_TOPGEN], 1u);
            else XB_SPIN(xb_ld(&bar[XB_TOPGEN]) == tg, bar);
            __builtin_amdgcn_fence(__ATOMIC_ACQUIRE, "agent");
            xb_add(&bar[XB_XGEN(b.x)], 1u);
            asm volatile("s_waitcnt vmcnt(0)" ::: "memory");
        } else {
            XB_SPIN(xb_ld(&bar[XB_XGEN(b.x)]) == gen, bar);
            __builtin_amdgcn_fence(__ATOMIC_ACQUIRE, "agent");
            asm volatile("s_waitcnt vmcnt(0)" ::: "memory");
        }
    }
    __syncthreads();
}


__global__ void __launch_bounds__(NTHREADS, 2) fwd_megakernel(Params Pval) {
    PP P = (PP)__builtin_amdgcn_kernarg_segment_ptr();
    extern __shared__ __attribute__((aligned(16))) char smem[];
    cg::grid_group grid = cg::this_grid();
    const int G = gridDim.x, bid = blockIdx.x;
    const int wv = __builtin_amdgcn_readfirstlane((int)(threadIdx.x >> 6));

    uint4& xb_words = *(uint4*)(smem + SMEM_MAIN);
    if (otid(wv) == 0) xb_words = make_uint4(0u, 0u, 0u, 0u);
    __syncthreads();
    if (P->ws == nullptr) grid.sync();
    const XcdBarrier xb = xcd_barrier_post((unsigned*)(P->ws + OFF_BAR), (volatile LAS unsigned*)(smem + SMEM_MAIN));
    int vxcd = bid & 7, vjx = bid >> 3;
    {
        unsigned* xcnt = (unsigned*)(P->ws + OFF_BAR) + XCD_BAR_WORDS;
        volatile LAS unsigned* lw = (volatile LAS unsigned*)(smem + SMEM_MAIN) + 2;
        if (otid(wv) == 0) lw[0] = xb.x < 8u ? xb_add(&xcnt[xb.x], 1u) : 0xffffu;
        phase0(P, smem, wv);
        xcd_barrier(xb);
        if (otid(wv) == 0) {
            bool ok = (G & 7) == 0 && xb.x < 8u;
            for (int j = 0; j < 8; ++j) ok = ok && (xb_ld(&xcnt[j]) == (unsigned)(G >> 3));
            lw[1] = ok ? 1u : 0u;
        }
        __syncthreads();
        if (lw[1]) { vxcd = (int)xb.x; vjx = (int)lw[0]; }
    }
    vxcd = __builtin_amdgcn_readfirstlane(vxcd); vjx = __builtin_amdgcn_readfirstlane(vjx);

#pragma unroll 1
    for (int l = 0; l < DEPTH; ++l) {
        {
            const int xcd = vxcd, jx = vjx, nper = G >> 3;
            for (int u = jx; u < 192; u += nper) inproj_tile<2, 8>(P, l, (xcd * 8 + (u & 7)) * 256, (u >> 3) * 128, smem, wv);
            for (int it = jx; it < 16 + 40; it += nper) {
                if (it < 16) inproj_tile<4, 2>(P, l, (xcd * 16 + it) * 128, 3072, smem, wv);
                else s5_build_item(P, l, (it - 16) * 8 + xcd, smem, wv);
            }
        }
        xcd_barrier(xb);
        if (G == 512) {
            if (bid < 128) cmp_gemm_tile(P, l, bid, smem, wv);
            else if (bid < 192) s5e_gemm_tile(P, l, bid - 128, smem, wv);
            else {
#pragma unroll 1
                for (int w = bid - 192; w < 512; w += 320) gla_kv_item(P, l, w, smem, wv);
            }
        } else {
#pragma unroll 1
        for (int w = bid; w < 128 + 64 + 512; w += G) {
            if (w < 128) cmp_gemm_tile(P, l, w, smem, wv);
            else if (w < 192) s5e_gemm_tile(P, l, w - 128, smem, wv);
            else gla_kv_item(P, l, w - 192, smem, wv);
        }
        }
        xcd_barrier(xb);
        if (G == 512) {
            if (bid < 64) s5_scan_item(P, bid, smem, wv);
            else {
#pragma unroll 1
                for (int w = bid - 64; w < 1024; w += 448) {
                    if (w < 512) cmp_l2_item(P, l, w, smem, wv);
                    else gla_scan_item(P, w - 512, smem, wv);
                }
            }
        } else {
#pragma unroll 1
        for (int w = bid; w < 512 + 512 + 64; w += G) {
            if (w < 512) cmp_l2_item(P, l, w, smem, wv);
            else if (w < 1024) gla_scan_item(P, w - 512, smem, wv);
            else s5_scan_item(P, w - 1024, smem, wv);
        }
        }
        xcd_barrier(xb);
        bool nsa_fast;
        nsa_fast = NSA_FAST_FLAG(P, l, otid(wv) & 63);
#pragma unroll 1
        for (int w0 = bid; w0 < 512 + 512 + 512; w0 += G) {
            const int w = w0 < G ? vjx * 8 + vxcd : w0;
            if (w < 512) {
                const int bg = w & 3, q = w >> 2;
                if (nsa_fast) { nsa_unit<true>(P, l, bg, 255 - q, smem, wv); nsa_unit<true>(P, l, bg, q, smem, wv); }
                else { nsa_unit<false>(P, l, bg, 255 - q, smem, wv); nsa_unit<false>(P, l, bg, q, smem, wv); }
            } else if (w < 512 + 512) s5o_gemm_tile(P, l, w - 512, smem, wv);
            else gla_out_item(P, l, w - 1024, smem, wv);
        }
        xcd_barrier(xb);
#pragma unroll 1
        for (int w = bid; w < 512; w += G) glu_tile(P, l, w, smem, wv);
        xcd_barrier(xb);
        {
            const int xcd = vxcd, jx = vjx, nper = G >> 3;
            for (int u = jx; u < 64; u += nper) outproj_tile(P, l, xcd * 8 + (u & 7), u >> 3, smem, wv);
        }
        xcd_barrier(xb);
    }
    {
        const PP Q = plaunder(P);
        const float4* src = (const float4*)(Q->ws + OFF_PROJ);
        float4* dst = (float4*)(Q->out + (size_t)(NT / 2) * 1024);
        for (size_t i = (size_t)bid * NTHREADS + otid(wv); i < (size_t)(NT / 2) * 256; i += (size_t)G * NTHREADS) dst[i] = src[i];
    }
}

extern "C" void kernel_launch(void* const* d_in, const int* in_sizes, int n_in, void* d_out, int out_size, void* d_ws,
                              size_t ws_size, hipStream_t stream) {
    static int grid_blocks = 0;
    if (!grid_blocks) {
        int dev = 0, cus = 0, per_cu = 0;
        hipGetDevice(&dev);
        hipDeviceGetAttribute(&cus, hipDeviceAttributeMultiprocessorCount, dev);
        hipFuncSetAttribute((const void*)fwd_megakernel, hipFuncAttributeMaxDynamicSharedMemorySize, SMEM_BYTES);
        hipOccupancyMaxActiveBlocksPerMultiprocessor(&per_cu, fwd_megakernel, NTHREADS, SMEM_BYTES);
        if (per_cu < 1) per_cu = 1;
        if (per_cu > 2) per_cu = 2;
        grid_blocks = cus * per_cu;
        if (ws_size < WS_END) fprintf(stderr, "kernel_launch: workspace too small: %zu < %zu\n", ws_size, (size_t)WS_END);
    }
    Params p{};
    for (int i = 0; i < 25; ++i) p.in[i] = (const float*)d_in[i];
    p.out = (float*)d_out;
    p.ws = (char*)d_ws;
    void* args[] = {&p};
    (void)hipMemsetAsync((char*)d_ws + OFF_BAR, 0, (XCD_BAR_WORDS + 16) * sizeof(unsigned), stream);
    hipError_t e = hipLaunchCooperativeKernel((const void*)fwd_megakernel, dim3(grid_blocks), dim3(NTHREADS), args, SMEM_BYTES, stream);
    if (e != hipSuccess) fprintf(stderr, "cooperative launch failed: %s (grid %d)\n", hipGetErrorString(e), grid_blocks);
}
```

```cpp
#include <hip/hip_runtime.h>
#include <hip/hip_cooperative_groups.h>
#include <cstdio>
#include <cstdint>
namespace cg = cooperative_groups;

typedef _Float16 h16;
typedef _Float16 half8 __attribute__((ext_vector_type(8)));
typedef _Float16 half4 __attribute__((ext_vector_type(4)));
typedef float f32x4 __attribute__((ext_vector_type(4)));
typedef float f32x16 __attribute__((ext_vector_type(16)));

#define DI __device__ __forceinline__

constexpr int D_MODEL = 1024, BATCH = 2, SEQ = 8192, DEPTH = 4, NT = BATCH * SEQ;
constexpr int D_IN = 3112, D_IN_PAD = 3200;
constexpr int C_NQ = 0, C_NKV = 512, C_NG = 1280, C_GQ = 1792, C_GK = 1920, C_GV = 2048, C_GG = 2304, C_SU = 2560, C_SG = 2816,
              C_GLR = 3072, C_NGL = 3088;
__host__ __device__ constexpr int map_col(int c) {
    return c < 128 ? C_GQ + c : c < 256 ? C_GK + (c - 128) : c < 512 ? C_GV + (c - 256) : c < 528 ? C_GLR + (c - 512)
         : c < 784 ? C_GG + (c - 528) : c < 1040 ? C_SU + (c - 784) : c < 1296 ? C_SG + (c - 1040) : c < 1808 ? C_NQ + (c - 1296)
         : c < 2576 ? C_NKV + (c - 1808) : c < 2600 ? C_NGL + (c - 2576) : c < 3112 ? C_NG + (c - 2600) : c;
}
constexpr int NTHREADS = 256;
constexpr float QSCALE = 0.125f * 1.4426950408889634f;

enum { I_X = 0, I_NORMG, I_WIN, I_GW2, I_GB2, I_GON, I_LRE, I_LIM, I_LSTEP, I_BRE, I_BIM, I_CRE, I_CIM, I_SD, I_GLUW, I_GLUB,
       I_NGB, I_NQN, I_NKN, I_CPOS, I_CW1, I_CB1, I_CW2, I_CB2, I_WOUT };

constexpr size_t OFF_WTIN  = 0;
constexpr size_t OFF_WTOUT = OFF_WTIN  + 4ull * D_IN_PAD * 1024 * 2;
constexpr size_t OFF_WTGLU = OFF_WTOUT + 4ull * 1024 * 1024 * 2;
constexpr size_t OFF_WTC1  = OFF_WTGLU + 4ull * 512 * 256 * 2;
constexpr size_t OFF_PROJ  = OFF_WTC1  + 4ull * 2 * 256 * 2048 * 2;
constexpr size_t OFF_MIX   = OFF_PROJ  + (size_t)NT * D_IN * 2;
constexpr size_t OFF_YACT  = OFF_MIX   + (size_t)NT * 1024 * 2;
constexpr size_t OFF_XH    = OFF_YACT;
constexpr size_t OFF_BCUM  = OFF_YACT  + (size_t)NT * 256 * 2;
constexpr size_t OFF_GKV   = OFF_BCUM  + (size_t)NT * 128 * 4;
constexpr size_t OFF_GDEC  = OFF_GKV   + 8ull * 256 * 2048 * 4;
static_assert(OFF_GDEC - OFF_XH >= (size_t)NT * 1024 * 2, "XH alias region too small");
constexpr size_t OFF_XC    = OFF_GDEC  + 8ull * 256 * 32 * 4;
constexpr size_t OFF_S5W   = OFF_XC    + 512ull * 1024 * 2 * 4;
constexpr size_t OFF_S5E   = OFF_S5W   + 16ull * 512 * 640 * 2;
constexpr size_t OFF_S5AL  = OFF_S5E   + 16ull * 128 * 512 * 2;
constexpr size_t OFF_CHID  = OFF_S5AL  + 1024ull * 2 * 4;
constexpr size_t OFF_POSB  = OFF_CHID  + 2ull * 2048 * 512 * 4;
constexpr size_t OFF_XCH   = OFF_POSB  + 8ull * 16 * 256 * 4;
constexpr size_t OFF_KCMP  = OFF_XCH   + 512ull * 2048 * 2;
constexpr size_t OFF_VCMP  = OFF_KCMP  + 4ull * 512 * 64 * 2;
constexpr size_t OFF_VTG   = OFF_VCMP  + 4ull * 512 * 64 * 2;
constexpr size_t OFF_BAR   = OFF_VTG   + 2ull * 4 * 128 * 4096 * 2;
constexpr size_t OFF_USP   = OFF_BAR   + 16384;
constexpr size_t WS_END    = OFF_USP   + (size_t)NT * 256 * 2;

struct Params {
    const float* in[25];
    float* out;
    char* ws;
};

__host__ __device__ constexpr size_t kb_idx(size_t nrows, size_t row, int k) { return (((size_t)(k >> 6)) * nrows + row) * 64 + (k & 63); }
typedef const __attribute__((address_space(4))) Params* PP;
DI PP plaunder(PP p) { asm volatile("" : "+s"(p)); return p; }
constexpr int SMEM_MAIN = 73728;
constexpr int SMEM_BYTES = SMEM_MAIN + 16;

#define XH_BASE(P) ((h16*)((char*)(P)->out + (size_t)NT * 2048))
DI int olane() { int l; asm volatile("v_mbcnt_lo_u32_b32 %0, -1, 0\n\tv_mbcnt_hi_u32_b32 %0, -1, %0" : "=v"(l)); return l; }
DI int otid(const int wv) { return wv * 64 + olane(); }
template <int M> DI int shx_i(int v) {
    static_assert(M == 1 || M == 2 || M == 4 || M == 8 || M == 16, "lane xor mask");
    if constexpr (M == 1) return __builtin_amdgcn_update_dpp(0, v, 0xB1, 0xF, 0xF, true);
    else if constexpr (M == 2) return __builtin_amdgcn_update_dpp(0, v, 0x4E, 0xF, 0xF, true);
    else return __builtin_amdgcn_ds_swizzle(v, (M << 10) | 0x1F);
}
template <int M> DI float shx(float v) { return __int_as_float(shx_i<M>(__float_as_int(v))); }
template <int N> DI int row_shr_i(int v) { return __builtin_amdgcn_update_dpp(0, v, 0x110 | N, 0xF, 0xF, true); }
DI float xhalf_max(float v) {
    const auto r = __builtin_amdgcn_permlane32_swap(__float_as_uint(v), __float_as_uint(v), false, false);
    return fmaxf(__uint_as_float(r[0]), __uint_as_float(r[1]));
}
DI float xhalf_sum(float v) {
    const auto r = __builtin_amdgcn_permlane32_swap(__float_as_uint(v), __float_as_uint(v), false, false);
    return __uint_as_float(r[0]) + __uint_as_float(r[1]);
}
DI float wave_sum(float v) {
    v = xhalf_sum(v);
    v += shx<16>(v); v += shx<8>(v); v += shx<4>(v); v += shx<2>(v); v += shx<1>(v);
    return v;
}
DI float wave_max(float v) {
    v = xhalf_max(v);
    v = fmaxf(v, shx<16>(v)); v = fmaxf(v, shx<8>(v)); v = fmaxf(v, shx<4>(v)); v = fmaxf(v, shx<2>(v)); v = fmaxf(v, shx<1>(v));
    return v;
}
DI float bperm(float v, int srclane) { return __int_as_float(__builtin_amdgcn_ds_bpermute(srclane << 2, __float_as_int(v))); }
#define NSA_FAST_FLAG(P, l, ln) (__builtin_amdgcn_readfirstlane((8.f * 1.4426950408889634f * wave_max(fabsf((P)->in[I_NQN][(l) * 64 + (ln)])) *          \
    wave_max(fmaxf(fmaxf(fabsf((P)->in[I_NKN][((l) * 3 + 0) * 64 + (ln)]), fabsf((P)->in[I_NKN][((l) * 3 + 1) * 64 + (ln)])), fabsf((P)->in[I_NKN][((l) * 3 + 2) * 64 + (ln)]))) < 15.f) ? 1 : 0) != 0)
DI float add1(float e) { float y; asm("s_nop 0\n\tv_add_f32_e32 %0, 1.0, %1" : "=v"(y) : "v"(e)); return y; }
DI float sigmoidf_(float x) { return __builtin_amdgcn_rcpf(add1(__expf(-x))); }
DI float siluf_(float x) { return x * __builtin_amdgcn_rcpf(add1(__expf(-x))); }
DI float gelu_tanh(float x) {
    const float u2 = 2.f * 0.7978845608028654f * (x + 0.044715f * x * x * x);
    return x * sigmoidf_(u2);
}
DI float log_sigmoidf_(float x) { return fminf(x, 0.f) - __logf(add1(__expf(-fabsf(x)))); }

typedef _Float16 half2_ __attribute__((ext_vector_type(2)));
DI void glds16(const h16* g, char* l) {
    __builtin_amdgcn_global_load_lds((const __attribute__((address_space(1))) void*)g, (__attribute__((address_space(3))) void*)l, 16, 0, 0);
}
DI void glds16_off(const char* ubase, unsigned off, char* l) {
    __builtin_amdgcn_global_load_lds((const __attribute__((address_space(1))) void*)(ubase + off), (__attribute__((address_space(3))) void*)l, 16, 0, 0);
}
DI int vkperm(int k) { return (k & ~12) | ((k & 4) << 1) | ((k & 8) >> 1); }
DI int vkperm2(int k) { return (k & ~31) | (((k >> 2) & 3) << 3) | (((k >> 4) & 1) << 2) | (k & 3); }
struct APlain {
    static constexpr bool affine = true;
    const h16* A; size_t lda, astep;
    DI const h16* operator()(int row, int kt, int c8) const { return A + (size_t)row * lda + (size_t)kt * astep + c8 * 8; }
    DI const char* ubase(int kt, int hb) const { return (const char*)(A + (size_t)kt * astep + hb * 8); }
    DI unsigned loff(int row, int c) const { return (unsigned)((row * (unsigned)lda + c * 8) * 2); }
};
struct AS5 {
    static constexpr bool affine = false;
    const h16* ubase;
    const h16* xin;
    int ch0;
    DI const h16* operator()(int row, int kt, int c8) const {
        const size_t ch = (size_t)(ch0 + row);
        return kt < 8 ? ubase + (ch * 32 + 4 * kt + (c8 >> 1)) * D_IN + (c8 & 1) * 8 : xin + ch * 2048 + (kt - 8) * 64 + c8 * 8;
    }
};
struct AS5P {
    static constexpr bool affine = false;
    const h16* ubase;
    const h16* xin;
    int ch0;
    DI const h16* operator()(int row, int kt, int c8) const {
        const size_t ch = (size_t)(ch0 + row);
        return kt < 8 ? ubase + ch * (16 * 512) + kt * 64 + c8 * 8 : xin + ch * 2048 + (kt - 8) * 64 + c8 * 8;
    }
};
template <int N> DI void gwaitbar();
#define GWB_DEF(N) template <> DI void gwaitbar<N>() { asm volatile("s_waitcnt vmcnt(" #N ") lgkmcnt(0)\n\ts_barrier" ::: "memory"); }
GWB_DEF(0) GWB_DEF(3) GWB_DEF(4) GWB_DEF(6) GWB_DEF(8) GWB_DEF(12)
template <bool SUMSQ, int WR, int MI, int NJ, int NST = 4, bool BPERM = false, class AF>
DI void gemm_glds(const int wv, const int K, const AF& afn, const h16* __restrict__ Bt, const int ldb,
                  f32x4 (&acc)[MI][NJ], float (&ss)[MI], char* smem, const size_t bstep = 64) {
    constexpr int WC = 4 / WR, BM = WR * MI * 16, BN = WC * NJ * 16, AQ = BM / 64, BQ = BN / 64, NG = AQ + BQ, SB = (BM + BN) * 64;
    static_assert(NST * SB <= SMEM_MAIN && AQ >= 1 && BQ >= 1 && (NST == 3 || NST == 4), "ring does not fit the LDS");
    const int tid = otid(wv), lane = tid & 63, wid = tid >> 6, wr = wid / WC, wc = wid % WC;
#pragma unroll
    for (int i = 0; i < MI; ++i) {
        ss[i] = 0.f;
#pragma unroll
        for (int j = 0; j < NJ; ++j) acc[i][j] = (f32x4){0.f, 0.f, 0.f, 0.f};
    }
    const int lrow = wid * 16 + (lane >> 2);
    const int lc4 = (lane & 3) ^ ((-(lrow >> 2)) & 3);
    const h16* bp = Bt + (size_t)lrow * ldb + lc4 * 8;
    char* lbase = smem + wv * 1024;
    const int fr = lane & 15, fq = lane >> 4, sw = (-(fr >> 2)) & 3;
    const int aoff0 = (wr * MI * 16 + fr) * 64 + ((fq ^ sw) * 16);
    const int boff0 = BM * 64 + (wc * NJ * 16 + fr) * 64 + ((fq ^ sw) * 16);
    const int nt = K >> 5;
    unsigned aofl[AQ];
    if constexpr (AF::affine) {
#pragma unroll
        for (int q = 0; q < AQ; ++q) aofl[q] = afn.loff(lrow + 64 * q, lc4);
    }
    const int lrow_b = BPERM ? (((lrow >> 5) & 1) * 32 + ((lrow >> 2) & 3) * 8 + ((lrow >> 4) & 1) * 4 + (lrow & 3)) : lrow;
    const unsigned bofl = (unsigned)((lrow_b * (unsigned)ldb + lc4 * 8) * 2);
    auto issue = [&](const int t, char* stage) {
        const int kt = t >> 1, hb = (t & 1) * 4;
        if constexpr (AF::affine) {
            const char* ua = afn.ubase(kt, hb);
#pragma unroll
            for (int q = 0; q < AQ; ++q) glds16_off(ua, aofl[q], stage + q * 4096);
        } else {
#pragma unroll
            for (int q = 0; q < AQ; ++q) glds16(afn(lrow + 64 * q, kt, hb + lc4), stage + q * 4096);
        }
        const char* ub = (const char*)(Bt + (size_t)kt * bstep + hb * 8);
#pragma unroll
        for (int q = 0; q < BQ; ++q) glds16_off(ub + (size_t)q * 64 * ldb * 2, bofl, stage + BM * 64 + q * 4096);
    };
    auto compute = [&](const char* st) {
        half8 af[MI], bf[NJ];
#pragma unroll
        for (int i = 0; i < MI; ++i) af[i] = *(const half8*)(st + aoff0 + i * 1024);
#pragma unroll
        for (int j = 0; j < NJ; ++j) bf[j] = *(const half8*)(st + boff0 + j * 1024);
        if (SUMSQ) {
#pragma unroll
            for (int i = 0; i < MI; ++i)
#pragma unroll
                for (int e = 0; e < 4; ++e) {
                    const half2_ x = (half2_){af[i][2 * e], af[i][2 * e + 1]};
                    ss[i] = __builtin_amdgcn_fdot2(x, x, ss[i], false);
                }
        }
#pragma unroll
        for (int i = 0; i < MI; ++i)
#pragma unroll
            for (int j = 0; j < NJ; ++j) acc[i][j] = __builtin_amdgcn_mfma_f32_16x16x32_f16(bf[j], af[i], acc[i][j], 0, 0, 0);
    };
#define GEMM_STEP(S, t) do { if (NST == 4 && (t) + 2 < nt) gwaitbar<NG>(); else gwaitbar<0>();                       \
        if ((t) + NST - 1 < nt) issue((t) + NST - 1, lbase + (((S) + NST - 1) % NST) * SB); compute(smem + (S) * SB); } while (0)
    gwaitbar<0>();
    {
        const int k = nt < NST - 1 ? nt : NST - 1;
        for (int p = 0; p < k; ++p) issue(p, lbase + p * SB);
        if (k >= 3) gwaitbar<2 * NG>(); else if (k == 2) gwaitbar<NG>(); else gwaitbar<0>();
        __builtin_amdgcn_s_sleep(2);
    }
#pragma unroll 1
    for (int t = 0; t < nt; t += NST) {
        GEMM_STEP(0, t);
        if (t + 1 < nt) GEMM_STEP(1, t + 1);
        if (t + 2 < nt) GEMM_STEP(2, t + 2);
        if (NST == 4 && t + 3 < nt) GEMM_STEP(3 % NST, t + 3);
    }
#undef GEMM_STEP
    asm volatile("s_waitcnt lgkmcnt(0)\n\ts_barrier" ::: "memory");
    if (SUMSQ) {
#pragma unroll
        for (int i = 0; i < MI; ++i) { ss[i] += shx<16>(ss[i]); ss[i] = xhalf_sum(ss[i]); }
    }
}
template <bool SUMSQ, class AF>
DI void gemm_mainloop_glds(const int wv, const int K, const AF& afn, const h16* __restrict__ Bt, const int ldb, f32x4 (&acc)[4][4], float (&ss)[4], char* smem, const size_t bstep = 64) {
    gemm_glds<SUMSQ, 2, 4, 4>(wv, K, afn, Bt, ldb, acc, ss, smem, bstep);
}

DI int glu_perm_dst(int c_orig) {
    const int which = c_orig >> 8, c = c_orig & 255;
    return (c >> 6) * 128 + ((c >> 5) & 1) * 64 + ((((c >> 2) & 1) * 2 + which) * 16) + ((((c >> 3) & 3) << 2) | (c & 3));
}
template <int MAP, int KB>
DI void transpose64(const float* __restrict__ src, int R, int C, h16* __restrict__ dst, int r0, int c0,
                    const float* __restrict__ rscale, char* smem, const int wv) {
    h16* tile = (h16*)smem;
    const int tid = otid(wv);
    {
        const int r = tid >> 2, cq = (tid & 3) * 16;
        const float sc = rscale ? rscale[r0 + r] : 1.f;
        const float* sp = src + (size_t)(r0 + r) * C + c0 + cq;
#pragma unroll
        for (int q = 0; q < 4; ++q) {
            float4 v = (float4){0.f, 0.f, 0.f, 0.f};
            if (c0 + cq + q * 4 < C) v = *(const float4*)(sp + q * 4);
            *(half4*)(tile + r * 72 + cq + q * 4) = (half4){(h16)(v.x * sc), (h16)(v.y * sc), (h16)(v.z * sc), (h16)(v.w * sc)};
        }
    }
    __syncthreads();
    {
        const int c = tid >> 2, rq = (tid & 3) * 16;
        half8 o0, o1;
#pragma unroll
        for (int k = 0; k < 8; ++k) { o0[k] = tile[(rq + k) * 72 + c]; o1[k] = tile[(rq + 8 + k) * 72 + c]; }
        const int cc = c0 + c;
        const int dr = MAP == 1 ? map_col(cc) : MAP == 2 ? glu_perm_dst(cc) : cc;
        h16* dp = KB ? dst + ((size_t)(r0 >> 6) * KB + dr) * 64 + rq : dst + (size_t)dr * R + r0 + rq;
        *(half8*)dp = o0; *(half8*)(dp + 8) = o1;
    }
    __syncthreads();
}

DI void phase0(PP P, char* smem, const int wv) {
    P = plaunder(P);
    constexpr int N_WIN = 4 * 16 * 50, N_WOUT = 4 * 16 * 16, N_C1 = 16 * 16 * 4, N_GLU = 4 * 4 * 8, N_XH = NT * 1024 / 2048, N_PB = 8 * 16;
    const int total = N_WIN + N_WOUT + N_C1 + N_GLU + N_XH + N_PB;
    for (int w = blockIdx.x; w < total; w += gridDim.x) {
        if (w < N_WIN) {
            const int l = w / 800, r = w % 800, rt = r / 50, ct = r % 50;
            transpose64<1, D_IN_PAD>(P->in[I_WIN] + (size_t)l * 1024 * D_IN, 1024, D_IN, (h16*)(P->ws + OFF_WTIN) + (size_t)l * D_IN_PAD * 1024,
                           rt * 64, ct * 64, P->in[I_NORMG] + l * 1024, smem, wv);
        } else if (w < N_WIN + N_WOUT) {
            const int v = w - N_WIN, l = v >> 8, r = v & 255, rt = r >> 4, ct = r & 15;
            transpose64<0, 1024>(P->in[I_WOUT] + (size_t)l * 1024 * 1024, 1024, 1024, (h16*)(P->ws + OFF_WTOUT) + (size_t)l * 1024 * 1024,
                           rt * 64, ct * 64, nullptr, smem, wv);
        } else if (w < N_WIN + N_WOUT + N_C1) {
            const int v = w - N_WIN - N_WOUT, ljh = v >> 6, r = v & 63, rt = r >> 2, ct = r & 3;
            transpose64<0, 512>(P->in[I_CW1] + (size_t)ljh * 1024 * 256, 1024, 256, (h16*)(P->ws + OFF_WTC1) + ((size_t)(ljh >> 1) * 16 * 512 + (ljh & 1) * 256) * 64,
                           rt * 64, ct * 64, nullptr, smem, wv);
        } else if (w < N_WIN + N_WOUT + N_C1 + N_GLU) {
            const int v = w - N_WIN - N_WOUT - N_C1, l = v >> 5, r = v & 31, rt = r >> 3, ct = r & 7;
            transpose64<2, 0>(P->in[I_GLUW] + (size_t)l * 256 * 512, 256, 512, (h16*)(P->ws + OFF_WTGLU) + (size_t)l * 512 * 256,
                           rt * 64, ct * 64, nullptr, smem, wv);
        } else if (w < N_WIN + N_WOUT + N_C1 + N_GLU + N_XH) {
            const size_t e0 = ((size_t)(w - N_WIN - N_WOUT - N_C1 - N_GLU) * 256 + otid(wv)) * 8;
            const float4 a = *(const float4*)(P->in[I_X] + e0), b = *(const float4*)(P->in[I_X] + e0 + 4);
            *(half8*)(XH_BASE(P) + kb_idx(NT, e0 >> 10, (int)(e0 & 1023))) = (half8){(h16)a.x, (h16)a.y, (h16)a.z, (h16)a.w, (h16)b.x, (h16)b.y, (h16)b.z, (h16)b.w};
        } else {
            const int v = w - (N_WIN + N_WOUT + N_C1 + N_GLU + N_XH), lj = v >> 4, ks = v & 15, n = otid(wv);
            const float* w1 = P->in[I_CW1] + ((size_t)lj * 2048 + ks * 128) * 256 + n;
            const float* pp = P->in[I_CPOS] + (size_t)lj * 2048 + ks * 128;
            float a = ks == 0 ? P->in[I_CB1][lj * 256 + n] : 0.f;
#pragma unroll 16
            for (int k = 0; k < 128; ++k) a += pp[k] * w1[(size_t)k * 256];
            ((float*)(P->ws + OFF_POSB))[(lj * 16 + ks) * 256 + n] = a;
        }
    }
}

DI void s5_build_item(PP P, int l, int item, char* smem, const int wv) {
    P = plaunder(P);
    float* apow = (float*)smem;
    float* bbar = apow + 64 * 33 * 2;
    float* cc   = bbar + 64 * 16 * 2;
    const int tid = otid(wv);
    const int g = (item < 256) ? (item >> 4) : ((item - 256) >> 2);
    if (tid < 64) {
        const int p = tid;
        const float lre = fminf(P->in[I_LRE][(l * 16 + g) * 64 + p], -1e-4f);
        const float lim = P->in[I_LIM][(l * 16 + g) * 64 + p];
        const float dt = expf(P->in[I_LSTEP][l * 16 + g]);
        const float x = lre * dt, y = lim * dt;
        const float em1 = expm1f(x), cy = cosf(y), sy = sinf(y), sh = sinf(0.5f * y);
        const float ar = (em1 + 1.f) * cy, ai = (em1 + 1.f) * sy;
        const float dr = em1 * cy - 2.f * sh * sh, di = ai;
        const float den = lre * lre + lim * lim;
        const float fr = (dr * lre + di * lim) / den;
        const float fi = (di * lre - dr * lim) / den;
        float pr = 1.f, pi = 0.f;
        asm volatile("" : "+v"(pr), "+v"(pi));
        for (int k = 0; k <= 32; ++k) {
            apow[(p * 33 + k) * 2] = pr; apow[(p * 33 + k) * 2 + 1] = pi;
            const float nr = pr * ar - pi * ai, ni = pr * ai + pi * ar; pr = nr; pi = ni;
        }
        for (int c = 0; c < 16; ++c) {
            const float br = P->in[I_BRE][((size_t)(l * 16 + g) * 64 + p) * 16 + c];
            const float bi = P->in[I_BIM][((size_t)(l * 16 + g) * 64 + p) * 16 + c];
            bbar[(p * 16 + c) * 2] = fr * br - fi * bi;
            bbar[(p * 16 + c) * 2 + 1] = fr * bi + fi * br;
        }
    }
    for (int e = tid; e < 1024; e += 256) {
        cc[e * 2] = P->in[I_CRE][(size_t)(l * 16 + g) * 1024 + e];
        cc[e * 2 + 1] = P->in[I_CIM][(size_t)(l * 16 + g) * 1024 + e];
    }
    __syncthreads();
    if (item < 256) {
        const int c = item & 15;
        float* kt = cc + 2048;
        for (int idx = tid; idx < 512; idx += 256) {
            const int lag = idx >> 4, c2 = idx & 15;
            float a = 0.f;
#pragma unroll 8
            for (int p = 0; p < 64; ++p) {
                const float2 cv = *(const float2*)(cc + (c * 64 + p) * 2);
                const float2 xv = *(const float2*)(apow + (p * 33 + lag) * 2);
                const float2 bv = *(const float2*)(bbar + (p * 16 + c2) * 2);
                const float tr = cv.x * xv.x - cv.y * xv.y, ti = cv.x * xv.y + cv.y * xv.x;
                a += tr * bv.x - ti * bv.y;
            }
            kt[idx] = a;
        }
        __syncthreads();
        h16* W = (h16*)(P->ws + OFF_S5W) + (size_t)g * 512 * 640;
        {
            const int k0 = 2 * tid, sblk = k0 >> 4, c2 = k0 & 15;
            h16* wp = W + (size_t)c * 640 + k0;
#pragma unroll 4
            for (int j = 0; j < 32; ++j) {
                half2_ v = (half2_){(h16)0.f, (h16)0.f};
                if (j >= sblk) { const float2 kv = *(const float2*)(kt + (j - sblk) * 16 + c2); v = (half2_){(h16)kv.x, (h16)kv.y}; }
                *(half2_*)(wp + (size_t)j * 16 * 640) = v;
            }
        }
        {
            const int p = tid & 63, jq = tid >> 6;
            const float2 cv = *(const float2*)(cc + (c * 64 + p) * 2);
#pragma unroll
            for (int jj = 0; jj < 8; ++jj) {
                const int j = jq * 8 + jj;
                const float2 xv = *(const float2*)(apow + (p * 33 + j + 1) * 2);
                *(half2_*)(W + (size_t)(j * 16 + c) * 640 + 512 + 2 * p) = (half2_){(h16)(cv.x * xv.x - cv.y * xv.y), (h16)(-(cv.x * xv.y + cv.y * xv.x))};
            }
        }
    } else {
        const int pq = (item - 256) & 3;
        h16* E = (h16*)(P->ws + OFF_S5E) + ((size_t)g * 128 + pq * 32) * 512;
#pragma unroll 4
        for (int idx = tid; idx < 16 * 512; idx += 256) {
            const int pl = idx >> 9, k = idx & 511;
            const int p = pq * 16 + pl, sblk = k >> 4, c2 = k & 15;
            const float2 xv = *(const float2*)(apow + (p * 33 + 31 - sblk) * 2);
            const float2 bv = *(const float2*)(bbar + (p * 16 + c2) * 2);
            E[(size_t)(2 * pl) * 512 + k] = (h16)(xv.x * bv.x - xv.y * bv.y);
            E[(size_t)(2 * pl + 1) * 512 + k] = (h16)(xv.x * bv.y + xv.y * bv.x);
        }
        if (tid < 16) {
            const int p = pq * 16 + tid;
            float* AL = (float*)(P->ws + OFF_S5AL);
            AL[(g * 64 + p) * 2] = apow[(p * 33 + 32) * 2];
            AL[(g * 64 + p) * 2 + 1] = apow[(p * 33 + 32) * 2 + 1];
        }
    }
    __syncthreads();
}

template <int WR, int MI>
DI void inproj_tile(PP P, int l, int m0, int n0, char* smem, const int wv) {
    P = plaunder(P);
    constexpr int WC = 4 / WR;
    f32x4 acc[MI][4];
    float ss[MI];
    gemm_glds<true, WR, MI, 4, (WR == 2 && MI == 8) ? 3 : 4, true>(wv, 1024, APlain{(const h16*)XH_BASE(P) + (size_t)m0 * 64, 64, (size_t)NT * 64},
                               (const h16*)(P->ws + OFF_WTIN) + ((size_t)l * 16 * D_IN_PAD + n0) * 64, 64, acc, ss, smem, (size_t)D_IN_PAD * 64);
    const int tid = otid(wv), lane = tid & 63, wid = tid >> 6, wr = wid / WC, wc = wid % WC;
    h16* proj = (h16*)(P->ws + OFF_PROJ);
    const int n64 = n0 + wc * 64;
    int cls = 0;
    if (n64 < 512) cls = 1;
    else if (n64 >= C_NKV + 256 && n64 < C_NKV + 384) cls = 2;
    else if (n64 >= C_NKV + 512 && n64 < C_NKV + 640) cls = 3;
    else if (n64 >= C_NKV + 384 && n64 < C_NKV + 512) cls = 4;
    else if (n64 >= C_NKV + 640 && n64 < C_NKV + 768) cls = 5;
    bool vfast = false;
    if (cls >= 4) vfast = NSA_FAST_FLAG(P, l, lane);
    float wn[4][4];
    if (cls >= 1 && cls <= 3) {
        const float* wp = (cls == 1) ? P->in[I_NQN] + l * 64 : P->in[I_NKN] + (l * 3 + (cls - 1)) * 64;
        const float sc = (cls == 1) ? QSCALE : 1.f;
#pragma unroll
        for (int j = 0; j < 4; ++j) {
            const float4 w4 = *(const float4*)(wp + (j >> 1) * 32 + (lane >> 4) * 8 + (j & 1) * 4);
            wn[j][0] = w4.x * sc; wn[j][1] = w4.y * sc; wn[j][2] = w4.z * sc; wn[j][3] = w4.w * sc;
        }
    }
#pragma unroll
    for (int i = 0; i < MI; ++i) {
        const int ml = wr * MI * 16 + i * 16 + (lane & 15);
        const float r = rsqrtf(ss[i] * (1.f / 1024.f) + 1e-6f);
        const size_t row = (size_t)m0 + ml;
        f32x4 v[4];
#pragma unroll
        for (int j = 0; j < 4; ++j) v[j] = acc[i][j] * r;
        if (cls >= 1 && cls <= 3) {
            float s2 = 0.f;
#pragma unroll
            for (int j = 0; j < 4; ++j) s2 += v[j][0] * v[j][0] + v[j][1] * v[j][1] + v[j][2] * v[j][2] + v[j][3] * v[j][3];
            s2 += shx<16>(s2); s2 = xhalf_sum(s2);
            const float rn = rsqrtf(s2 * (1.f / 64.f) + 1e-6f);
#pragma unroll
            for (int j = 0; j < 4; ++j) { v[j][0] *= rn * wn[j][0]; v[j][1] *= rn * wn[j][1]; v[j][2] *= rn * wn[j][2]; v[j][3] *= rn * wn[j][3]; }
        }
        if (cls >= 4) {
            const int g = (n64 >> 6) & 1, br = cls - 4;
            const int b = (int)(row >> 13), t = (int)(row & 8191);
            h16* vt = (h16*)(P->ws + OFF_VTG) + ((((size_t)br * 4 + b * 2 + g) * 128 + (t >> 6)) * 64) * 64;
#pragma unroll
            for (int j = 0; j < 4; ++j)
#pragma unroll
                for (int e = 0; e < 4; ++e)
                    vt[((j >> 1) * 32 + (lane >> 4) * 8 + (j & 1) * 4 + e) * 64 + (vfast ? vkperm2(t & 63) : vkperm(t & 63))] = (h16)v[j][e];
        }
#pragma unroll
        for (int jp = 0; jp < 2; ++jp) {
            const int n = n64 + jp * 32 + (lane >> 4) * 8;
            if (n < D_IN) *(half8*)(proj + row * D_IN + n) = (half8){(h16)v[2 * jp][0], (h16)v[2 * jp][1], (h16)v[2 * jp][2], (h16)v[2 * jp][3],
                                                                     (h16)v[2 * jp + 1][0], (h16)v[2 * jp + 1][1], (h16)v[2 * jp + 1][2], (h16)v[2 * jp + 1][3]};
        }
        __builtin_amdgcn_sched_barrier(0);
    }
    __syncthreads();
}


DI void cmp_gemm_tile(PP P, int l, int tile, char* smem, const int wv) {
    P = plaunder(P);
    const int j = tile >> 6, mt = (tile >> 2) & 15, nt = tile & 3;
    const int row0 = mt * 128, bg = row0 >> 9, i0 = row0 & 511, b = bg >> 1, g = bg & 1;
    f32x4 acc[4][4];
    float ssd[4];
    gemm_mainloop_glds<false>(wv, 1024, APlain{(const h16*)(P->ws + OFF_PROJ) + ((size_t)b * SEQ + 16 * i0) * D_IN + C_NKV + j * 128 + g * 64, (size_t)16 * D_IN, (size_t)D_IN},
                              (const h16*)(P->ws + OFF_WTC1) + ((size_t)(l * 2 + j) * 16 * 512 + nt * 128) * 64, 64, acc, ssd, smem, (size_t)512 * 64);
    const int tid = otid(wv), lane = tid & 63, wid = tid >> 6, wr = wid >> 1, wc = wid & 1;
    float* pt = (float*)(P->ws + OFF_CHID) + (size_t)j * 2048 * 512;
#pragma unroll
    for (int i = 0; i < 4; ++i) {
        const size_t row = (size_t)row0 + wr * 64 + i * 16 + (lane & 15);
#pragma unroll
        for (int jj = 0; jj < 4; ++jj) {
            const int n = nt * 128 + wc * 64 + jj * 16 + (lane >> 4) * 4;
            const f32x4 v = acc[i][jj];
            *(float4*)(pt + row * 512 + n) = (float4){v[0], v[1], v[2], v[3]};
        }
    }
}

DI void s5e_gemm_tile(PP P, int l, int tile, char* smem, const int wv) {
    P = plaunder(P);
    const int g = tile >> 2, mt = tile & 3;
    f32x4 acc[4][4];
    float ssd[4];
    gemm_mainloop_glds<false>(wv, 512, AS5{(const h16*)(P->ws + OFF_PROJ) + C_SU + g * 16, nullptr, mt * 128},
                              (const h16*)(P->ws + OFF_S5E) + (size_t)g * 128 * 512, 512, acc, ssd, smem);
    const int tid = otid(wv), lane = tid & 63, wid = tid >> 6, wr = wid >> 1, wc = wid & 1;
    float* xc = (float*)(P->ws + OFF_XC);
#pragma unroll
    for (int i = 0; i < 4; ++i) {
        const size_t ch = (size_t)mt * 128 + wr * 64 + i * 16 + (lane & 15);
#pragma unroll
        for (int jj = 0; jj < 4; ++jj) {
            const int n = wc * 64 + jj * 16 + (lane >> 4) * 4;
            const f32x4 v = acc[i][jj];
            *(float4*)(xc + (ch * 1024 + g * 64) * 2 + n) = (float4){v[0], v[1], v[2], v[3]};
        }
    }
}

DI void gla_scan_item(PP P, int item, char* smem, const int wv) {
    P = plaunder(P);
    const int tid = otid(wv), sl = tid & 31, part = tid >> 5;
    const int idx = item * 32 + sl, bh = idx >> 11, de = idx & 2047, d = de >> 6;
    float* kv = (float*)(P->ws + OFF_GKV) + ((size_t)bh * 256 + part * 32) * 2048 + de;
    const float* dc = (const float*)(P->ws + OFF_GDEC) + ((size_t)bh * 256 + part * 32) * 32 + d;
    float* sD = (float*)smem; float* sL = sD + 256;
    float kvv[32], dd[32];
#pragma unroll
    for (int i = 0; i < 32; ++i) { kvv[i] = kv[(size_t)i * 2048]; dd[i] = dc[i * 32]; }
    float D = 1.f, L = 0.f;
#pragma unroll
    for (int i = 0; i < 32; ++i) { L = dd[i] * L + kvv[i]; D *= dd[i]; }
    sD[part * 32 + sl] = D; sL[part * 32 + sl] = L;
    __syncthreads();
    float S = 0.f;
    for (int q = 0; q < part; ++q) S = sD[q * 32 + sl] * S + sL[q * 32 + sl];
#pragma unroll
    for (int i = 0; i < 32; ++i) { const float o = S; S = dd[i] * S + kvv[i]; kv[(size_t)i * 2048] = o; }
    __syncthreads();
}
DI void s5_scan_item(PP P, int item, char* smem, const int wv) {
    P = plaunder(P);
    const int tid = otid(wv), sl = tid & 31, part = tid >> 5;
    const int idx = item * 32 + sl, b = idx >> 10, s = idx & 1023;
    float2* xc = (float2*)(P->ws + OFF_XC) + ((size_t)b * 256 + part * 32) * 1024 + s;
    half2_* xch = (half2_*)(P->ws + OFF_XCH) + ((size_t)b * 256 + part * 32) * 1024 + s;
    const float2 a = ((const float2*)(P->ws + OFF_S5AL))[s];
    float2* sL = (float2*)smem;
    float2 c[32];
#pragma unroll
    for (int i = 0; i < 32; ++i) c[i] = xc[(size_t)i * 1024];
    float lr = 0.f, li = 0.f;
#pragma unroll
    for (int i = 0; i < 32; ++i) { const float nr = a.x * lr - a.y * li + c[i].x, ni = a.x * li + a.y * lr + c[i].y; lr = nr; li = ni; }
    float dr = a.x, di = a.y;
#pragma unroll
    for (int i = 0; i < 5; ++i) { const float nr = dr * dr - di * di, ni = 2.f * dr * di; dr = nr; di = ni; }
    sL[part * 32 + sl] = (float2){lr, li};
    __syncthreads();
    float xr = 0.f, xi = 0.f;
    for (int q = 0; q < part; ++q) { const float2 lq = sL[q * 32 + sl]; const float nr = dr * xr - di * xi + lq.x, ni = dr * xi + di * xr + lq.y; xr = nr; xi = ni; }
#pragma unroll
    for (int i = 0; i < 32; ++i) {
        const float2 o = (float2){xr, xi};
        const float nr = a.x * xr - a.y * xi + c[i].x, ni = a.x * xi + a.y * xr + c[i].y; xr = nr; xi = ni;
        xc[(size_t)i * 1024] = o;
        xch[(size_t)i * 1024] = (half2_){(h16)o.x, (h16)o.y};
    }
    __syncthreads();
}
DI void cmp_l2_item(PP P, int l, int item, char* smem, const int wv) {
    P = plaunder(P);
    const int tid = otid(wv), lane = tid & 63, w = tid >> 6, kr = lane & 15, q4 = lane >> 4;
    const int j = item >> 6, r0 = (item & 63) * 32;
    constexpr int LD = 264;
    h16* w2t = (h16*)smem;
    h16* hs = w2t + 64 * LD;
    __syncthreads();
    {
        const float* w2 = P->in[I_CW2] + (size_t)(l * 2 + j) * 256 * 64;
        float4 wv4[16];
#pragma unroll
        for (int q = 0; q < 16; ++q) { const int e = tid + 256 * q; wv4[q] = *(const float4*)(w2 + (e >> 4) * 64 + (e & 15) * 4); }
#pragma unroll
        for (int q = 0; q < 16; ++q) {
            const int e = tid + 256 * q, k = e >> 4, c = (e & 15) * 4;
            w2t[(c + 0) * LD + k] = (h16)wv4[q].x; w2t[(c + 1) * LD + k] = (h16)wv4[q].y; w2t[(c + 2) * LD + k] = (h16)wv4[q].z; w2t[(c + 3) * LD + k] = (h16)wv4[q].w;
        }
        const float* pt = (const float*)(P->ws + OFF_CHID) + (size_t)j * 2048 * 512;
        float pb = 0.f;
#pragma unroll
        for (int ks = 0; ks < 16; ++ks) pb += ((const float*)(P->ws + OFF_POSB))[((l * 2 + j) * 16 + ks) * 256 + tid];
        float ptop[32], pbot[32];
#pragma unroll
        for (int rr = 0; rr < 32; ++rr) {
            const int row = r0 + rr, i = row & 511;
            ptop[rr] = pt[(size_t)row * 512 + tid];
            pbot[rr] = (i < 511) ? pt[(size_t)(row + 1) * 512 + 256 + tid] : 0.f;
        }
#pragma unroll
        for (int rr = 0; rr < 32; ++rr) {
            const int i = (r0 + rr) & 511;
            hs[rr * LD + tid] = (h16)((i < 511) ? gelu_tanh(ptop[rr] + pbot[rr] + pb) : 0.f);
        }
    }
    __syncthreads();
    if (w < 2) {
    f32x4 acc[4];
#pragma unroll
    for (int ct = 0; ct < 4; ++ct) {
        const float4 bb = *(const float4*)(P->in[I_CB2] + (l * 2 + j) * 64 + 16 * ct + 4 * q4);
        acc[ct] = (f32x4){bb.x, bb.y, bb.z, bb.w};
    }
#pragma unroll
    for (int ks = 0; ks < 8; ++ks) {
        const half8 hb = *(const half8*)(hs + (16 * w + kr) * LD + 32 * ks + 8 * q4);
#pragma unroll
        for (int ct = 0; ct < 4; ++ct)
            acc[ct] = __builtin_amdgcn_mfma_f32_16x16x32_f16(*(const half8*)(w2t + (16 * ct + kr) * LD + 32 * ks + 8 * q4), hb, acc[ct], 0, 0, 0);
    }
    {
        const int row = r0 + 16 * w + kr, bg = row >> 9, i = row & 511;
        if (i == 511) {
#pragma unroll
            for (int ct = 0; ct < 4; ++ct) acc[ct] = (f32x4){0.f, 0.f, 0.f, 0.f};
        }
        if (j == 0) {
            float ss = 0.f;
#pragma unroll
            for (int ct = 0; ct < 4; ++ct) ss += acc[ct][0] * acc[ct][0] + acc[ct][1] * acc[ct][1] + acc[ct][2] * acc[ct][2] + acc[ct][3] * acc[ct][3];
            ss += shx<16>(ss); ss = xhalf_sum(ss);
            const float rn = rsqrtf(ss * (1.f / 64.f) + 1e-6f);
#pragma unroll
            for (int ct = 0; ct < 4; ++ct) {
                const float4 g4 = *(const float4*)(P->in[I_NKN] + (l * 3 + 0) * 64 + 16 * ct + 4 * q4);
                *(half4*)((h16*)(P->ws + OFF_KCMP) + (size_t)row * 64 + 16 * ct + 4 * q4) =
                    (half4){(h16)(acc[ct][0] * rn * g4.x), (h16)(acc[ct][1] * rn * g4.y), (h16)(acc[ct][2] * rn * g4.z), (h16)(acc[ct][3] * rn * g4.w)};
            }
        } else {
            h16* vt = (h16*)(P->ws + OFF_VCMP) + ((size_t)bg * 8 + (i >> 6)) * 4096 + vkperm(i & 63);
#pragma unroll
            for (int ct = 0; ct < 4; ++ct)
#pragma unroll
                for (int e = 0; e < 4; ++e) vt[(16 * ct + 4 * q4 + e) * 64] = (h16)acc[ct][e];
        }
    }
    }
    __syncthreads();
}

DI void usp_item(PP P, int chunk, const int wv) {
    P = plaunder(P);
    const int tid = otid(wv);
    const h16* proj = (const h16*)(P->ws + OFF_PROJ);
    h16* usp = (h16*)(P->ws + OFF_USP);
#pragma unroll
    for (int q = 0; q < 4; ++q) {
        const int pc = q * 256 + tid, tok = pc >> 5, c16 = pc & 31;
        const half8 v = *(const half8*)(proj + ((size_t)chunk * 32 + tok) * D_IN + C_SU + c16 * 8);
        *(half8*)(usp + (((size_t)chunk * 16 + (c16 >> 1)) * 32 + tok) * 16 + (c16 & 1) * 8) = v;
    }
}

DI void s5o_gemm_tile(PP P, int l, int tile, char* smem, const int wv) {
    P = plaunder(P);
    const int g = tile >> 5, mt = (tile >> 3) & 3, nt = tile & 7;
    f32x4 acc[2][4];
    float ssd[2];
    gemm_glds<false, 4, 2, 4, 4, true>(wv, 640, AS5P{(const h16*)(P->ws + OFF_USP) + g * 512, (const h16*)(P->ws + OFF_XCH) + g * 128, mt * 128},
                              (const h16*)(P->ws + OFF_S5W) + ((size_t)g * 512 + nt * 64) * 640, 640, acc, ssd, smem);
    const int tid = otid(wv), lane = tid & 63, wid = tid >> 6;
    const h16* proj = (const h16*)(P->ws + OFF_PROJ);
    h16* yact = (h16*)(P->ws + OFF_YACT);
#pragma unroll
    for (int i = 0; i < 2; ++i) {
        const size_t ch = (size_t)mt * 128 + wid * 32 + i * 16 + (lane & 15);
#pragma unroll
        for (int jp = 0; jp < 2; ++jp) {
            const int n = nt * 64 + jp * 32 + (lane >> 4) * 8;
            const int j = n >> 4, c = n & 15;
            const size_t tok = ch * 32 + j;
            const half8 u8 = *(const half8*)(proj + tok * D_IN + C_SU + g * 16 + c);
            const float4 d0 = *(const float4*)(P->in[I_SD] + (l * 16 + g) * 16 + c), d1 = *(const float4*)(P->in[I_SD] + (l * 16 + g) * 16 + c + 4);
            const f32x4 v0 = acc[i][2 * jp], v1 = acc[i][2 * jp + 1];
            half8 o;
            o[0] = (h16)gelu_tanh(v0[0] + d0.x * (float)u8[0]);
            o[1] = (h16)gelu_tanh(v0[1] + d0.y * (float)u8[1]);
            o[2] = (h16)gelu_tanh(v0[2] + d0.z * (float)u8[2]);
            o[3] = (h16)gelu_tanh(v0[3] + d0.w * (float)u8[3]);
            o[4] = (h16)gelu_tanh(v1[0] + d1.x * (float)u8[4]);
            o[5] = (h16)gelu_tanh(v1[1] + d1.y * (float)u8[5]);
            o[6] = (h16)gelu_tanh(v1[2] + d1.z * (float)u8[6]);
            o[7] = (h16)gelu_tanh(v1[3] + d1.w * (float)u8[7]);
            *(half8*)(yact + tok * 256 + g * 16 + c) = o;
        }
    }
}

#define MFMA32(a, b, c) __builtin_amdgcn_mfma_f32_32x32x16_f16((a), (b), (c), 0, 0, 0)
#define MFMA16(a, b, c) __builtin_amdgcn_mfma_f32_16x16x32_f16((a), (b), (c), 0, 0, 0)
constexpr float NEGS = -1e30f;
DI float ex2(float x) { return __builtin_amdgcn_exp2f(x); }
#define NSA_WAITBAR(N) asm volatile("s_waitcnt vmcnt(" #N ") lgkmcnt(0)\n\ts_barrier" ::: "memory")
#define NSA_BAR() asm volatile("s_waitcnt lgkmcnt(0)\n\ts_barrier" ::: "memory")

struct KVSrc { const h16* k; int ldk; size_t kstep; const h16* v; };
DI void nsa_dma(const KVSrc& s, int j, char* stage, int wid, int lane) {
    const int row0 = wid * 8 + (lane >> 3);
    const int sw = ((lane & 7) ^ ((row0 >> 1) & 7)) * 8;
    const char* uk = (const char*)(s.k + (size_t)j * s.kstep);
    const unsigned ok = (unsigned)((row0 * s.ldk + sw) * 2);
    glds16_off(uk, ok, stage + wid * 1024);
    glds16_off(uk + (size_t)32 * s.ldk * 2, ok, stage + 4096 + wid * 1024);
    const char* uv = (const char*)(s.v + (size_t)j * 4096);
    const unsigned ov = (unsigned)((row0 * 64 + sw) * 2);
    glds16_off(uv, ov, stage + 8192 + wid * 1024);
    glds16_off(uv + 32 * 64 * 2, ov, stage + 8192 + 4096 + wid * 1024);
}
template <int NST, class F>
DI void nsa_pipe(const KVSrc& s, const int n, char* smem, int wid, int lane, F&& compute) {
    NSA_WAITBAR(0);
    {
        const int k = n < NST - 1 ? n : NST - 1;
        for (int p = 0; p < k; ++p) nsa_dma(s, p, smem + p * 16384, wid, lane);
        if (k >= 3) NSA_WAITBAR(8); else if (k == 2) NSA_WAITBAR(4); else NSA_WAITBAR(0);
        __builtin_amdgcn_s_sleep(2);
    }
    for (int j = 0; j < n; ++j) {
        if (NST == 4 && j + 2 < n) NSA_WAITBAR(4); else NSA_WAITBAR(0);
        const int jn = j + NST - 1;
        compute(j, smem + (j % NST) * 16384, [&]() { if (jn < n) nsa_dma(s, jn, smem + (jn % NST) * 16384, wid, lane); });
    }
}

template <class F>
DI void nsa_pipe2(const KVSrc& s, const int n, char* smem, int wid, int lane, F&& compute) {
    NSA_WAITBAR(0);
    nsa_dma(s, 0, smem, wid, lane);
    if (n > 1) nsa_dma(s, 1, smem + 16384, wid, lane);
    NSA_WAITBAR(0);
    __builtin_amdgcn_s_sleep(2);
    for (int t0 = 0; t0 < n; t0 += 2) {
        NSA_BAR();
        char* cur = smem + ((t0 >> 1) & 1) * 32768;
        char* nxt = smem + (((t0 >> 1) + 1) & 1) * 32768;
        compute(t0, cur, [&]() {
            if (t0 + 2 < n) nsa_dma(s, t0 + 2, nxt, wid, lane);
            if (t0 + 3 < n) nsa_dma(s, t0 + 3, nxt + 16384, wid, lane);
        });
        asm volatile("s_waitcnt vmcnt(0)" ::: "memory");
        if (t0 + 1 < n) compute(t0 + 1, cur + 16384, []() {});
    }
}

template <bool SHIFT = false, class BF>
DI void qk_tile(const char* Kimg, const half8 (&qf)[4], f32x16 (&s)[2], int lane, BF&& between) {
    const int r = lane & 31, h = lane >> 5, swz = (r >> 1) & 7;
    const char* base = Kimg + r * 128;
    half8 kf[8];
#pragma unroll
    for (int kt = 0; kt < 2; ++kt)
#pragma unroll
        for (int ks = 0; ks < 4; ++ks) kf[kt * 4 + ks] = *(const half8*)(base + kt * 4096 + (((2 * ks + h) ^ swz) << 4));
    __builtin_amdgcn_sched_barrier(0);
    between();
    __builtin_amdgcn_sched_barrier(0);
#pragma unroll
    for (int kt = 0; kt < 2; ++kt) {
#pragma unroll
        for (int e = 0; e < 16; ++e) s[kt][e] = 0.f;
#pragma unroll
        for (int ks = 0; ks < 4; ++ks) s[kt] = MFMA32(kf[kt * 4 + ks], qf[ks], s[kt]);
    }
}
template <bool SHIFT = false>
DI void qk_tile(const char* Kimg, const half8 (&qf)[4], f32x16 (&s)[2], int lane) { qk_tile<SHIFT>(Kimg, qf, s, lane, []() {}); }
DI float psum8(const half8& p, float acc) {
    const half2_ one = (half2_){(h16)1.f, (h16)1.f};
#pragma unroll
    for (int e = 0; e < 4; ++e) acc = __builtin_amdgcn_fdot2((half2_){p[2 * e], p[2 * e + 1]}, one, acc, false);
    return acc;
}
template <int S> DI half8 pack8(const f32x16& x) {
    return (half8){(h16)x[8 * S], (h16)x[8 * S + 1], (h16)x[8 * S + 2], (h16)x[8 * S + 3], (h16)x[8 * S + 4], (h16)x[8 * S + 5], (h16)x[8 * S + 6], (h16)x[8 * S + 7]};
}
template <int KT>
DI void pv_load(const char* Vimg, half8 (&vf)[4], int lane) {
    const int r = lane & 31, h = lane >> 5, swz = (r >> 1) & 7;
    const char* rb = Vimg + r * 128;
#pragma unroll
    for (int dt = 0; dt < 2; ++dt) {
        vf[dt * 2 + 0] = *(const half8*)(rb + dt * 4096 + (((4 * KT + h) ^ swz) << 4));
        vf[dt * 2 + 1] = *(const half8*)(rb + dt * 4096 + (((4 * KT + 2 + h) ^ swz) << 4));
    }
}
typedef unsigned u32x4_ __attribute__((ext_vector_type(4)));
template <int KT, bool MASKED = false>
DI void pv_mma(const half8 (&vf)[4], const f32x16 (&p)[2], f32x16 (&o)[2], const unsigned rmask = 0xffffffffu) {
    half8 pb0 = pack8<0>(p[KT]), pb1 = pack8<1>(p[KT]);
    if (MASKED) {
        pb0 = __builtin_bit_cast(half8, __builtin_bit_cast(u32x4_, pb0) & rmask);
        pb1 = __builtin_bit_cast(half8, __builtin_bit_cast(u32x4_, pb1) & rmask);
    }
#pragma unroll
    for (int dt = 0; dt < 2; ++dt) {
        o[dt] = MFMA32(vf[dt * 2 + 0], pb0, o[dt]);
        o[dt] = MFMA32(vf[dt * 2 + 1], pb1, o[dt]);
    }
}
template <bool MASKED = false>
DI void pv_finish(const char* Vimg, const half8 (&va)[4], const f32x16 (&p)[2], f32x16 (&o)[2], int lane, const unsigned rmask = 0xffffffffu) {
    half8 vb[4];
    pv_load<1>(Vimg, vb, lane);
    pv_mma<0, MASKED>(va, p, o, rmask);
    pv_mma<1, MASKED>(vb, p, o, rmask);
}
DI float sm_fast(f32x16 (&s)[2]) {
    float rs = 0.f;
#pragma unroll
    for (int kt = 0; kt < 2; ++kt)
#pragma unroll
        for (int e = 0; e < 16; ++e) { const float p = ex2(s[kt][e]); s[kt][e] = p; rs += p; }
    return rs;
}
DI float rowmax32(const f32x16 (&s)[2]) {
    float mx = s[0][0];
#pragma unroll
    for (int e = 1; e < 16; ++e) mx = fmaxf(mx, s[0][e]);
#pragma unroll
    for (int e = 0; e < 16; ++e) mx = fmaxf(mx, s[1][e]);
    return xhalf_max(mx);
}
constexpr float SM_THR = 6.f;
DI void sm_online(f32x16 (&s)[2], float& m, float& l, f32x16 (&o)[2], const bool rowok) {
    float mx = rowmax32(s);
    mx = rowok ? mx : NEGS;
    if (__any(mx > m + SM_THR)) {
        const float mn = fmaxf(m, mx), alpha = ex2(m - mn);
        l *= alpha; o[0] *= alpha; o[1] *= alpha; m = mn;
    }
    const float msub = rowok ? m : 1e30f;
    float rs = 0.f;
#pragma unroll
    for (int kt = 0; kt < 2; ++kt)
#pragma unroll
        for (int e = 0; e < 16; ++e) { const float p = ex2(s[kt][e] - msub); s[kt][e] = p; rs += p; }
    l += xhalf_sum(rs);
}

template <int V> struct IC { static constexpr int value = V; };
template <bool FAST>
DI void nsa_unit(PP P, int l, int bg, int c32, char* smem, const int wv) {
    P = plaunder(P);
    const int tid = otid(wv), lane = tid & 63, w = tid >> 6, r = lane & 31, h = lane >> 5;
    const int b = bg >> 1, g = bg & 1, t0 = c32 * 32, cur = c32 >> 1;
    const int tokl = w * 8 + (r >> 2), head = r & 3, t = t0 + tokl;
    const size_t tokg = (size_t)b * SEQ + t;
    float* IMP = (float*)(smem + 49152);
    unsigned* SELM = (unsigned*)(smem + 65536);
    const h16* proj = (const h16*)(P->ws + OFF_PROJ);
    const int ghead = g * 4 + head;

    half8 qf[4];
    {
        const h16* qp = proj + tokg * D_IN + C_NQ + ghead * 64 + 8 * h;
#pragma unroll
        for (int ks = 0; ks < 4; ++ks) qf[ks] = *(const half8*)(qp + 16 * ks);
    }
    auto gate = [&](const int br) -> float {
        const int tid_ = otid(wv), r_ = tid_ & 31, tokl_ = (tid_ >> 6) * 8 + (r_ >> 2), gh_ = g * 4 + (r_ & 3);
        const size_t tokg_ = (size_t)b * SEQ + t0 + tokl_;
        return sigmoidf_((float)proj[tokg_ * D_IN + C_NGL + gh_ * 3 + br] + P->in[I_NGB][l * 24 + gh_ * 3 + br]);
    };
    __syncthreads();
    for (int i = tid; i < 32 * 128; i += 256) IMP[i] = 0.f;

    half8 oacc[4];
    auto oacc_add = [&](const f32x16 (&o)[2], const float sc, const bool first) {
#pragma unroll
        for (int dt = 0; dt < 2; ++dt)
#pragma unroll
            for (int hf = 0; hf < 2; ++hf) {
                half8 v = oacc[dt * 2 + hf];
#pragma unroll
                for (int e = 0; e < 8; ++e) v[e] = (h16)((first ? 0.f : (float)v[e]) + o[dt][hf * 8 + e] * sc);
                oacc[dt * 2 + hf] = v;
            }
    };

    {
        const int nvt = 2 * c32 + 1;
        const int nvr = (t >= 31) ? ((t - 31) >> 4) + 1 : 0;
        const int ntile = (nvt + 63) >> 6;
        KVSrc src{(const h16*)(P->ws + OFF_KCMP) + (size_t)bg * 512 * 64, 64, 4096, (const h16*)(P->ws + OFF_VCMP) + (size_t)bg * 8 * 4096};
        f32x16 o[2];
#pragma unroll
        for (int e = 0; e < 16; ++e) { o[0][e] = 0.f; o[1][e] = 0.f; }
        float invl;
        if constexpr (FAST) {
            const int tf = t0 + w * 8;
            const int nvlo = __builtin_amdgcn_readfirstlane((tf >= 31) ? ((tf - 31) >> 4) + 1 : 0);
            float lsum = 0.f;
            nsa_pipe<3>(src, ntile, smem, wv, lane, [&](int j, const char* st, auto&& issue) {
                f32x16 s[2];
                qk_tile<true>(st, qf, s, lane);
                issue();
                if (64 * j + 64 > nvlo) {
#pragma unroll
                    for (int kt = 0; kt < 2; ++kt)
#pragma unroll
                        for (int e = 0; e < 16; ++e) {
                            const int key = 64 * j + 32 * kt + 8 * (e >> 2) + 4 * h + (e & 3);
                            if (key >= nvr) s[kt][e] = NEGS;
                        }
                }
                lsum += sm_fast(s);
            });
            lsum = xhalf_sum(lsum);
            invl = lsum > 0.f ? 1.f / lsum : 0.f;
            nsa_pipe<3>(src, ntile, smem, wv, lane, [&](int j, const char* st, auto&& issue) {
                f32x16 s[2];
                qk_tile<true>(st, qf, s, lane);
                half8 vf[4];
                pv_load<0>(st + 8192, vf, lane);
                issue();
                __builtin_amdgcn_sched_barrier(0);
                if (64 * j + 64 > nvlo) {
#pragma unroll
                    for (int kt = 0; kt < 2; ++kt)
#pragma unroll
                        for (int e = 0; e < 16; ++e) {
                            const int key = 64 * j + 32 * kt + 8 * (e >> 2) + 4 * h + (e & 3);
                            if (key >= nvr) s[kt][e] = NEGS;
                        }
                }
                (void)sm_fast(s);
                if (cur >= 16) {
#pragma unroll
                    for (int kt = 0; kt < 2; ++kt)
#pragma unroll
                        for (int g4 = 0; g4 < 4; ++g4) {
                            float G = ((s[kt][4 * g4] + s[kt][4 * g4 + 1]) + (s[kt][4 * g4 + 2] + s[kt][4 * g4 + 3])) * invl;
                            float L = s[kt][4 * g4 + 3] * invl;
                            G += shx<1>(G); G += shx<2>(G);
                            L += shx<1>(L); L += shx<2>(L);
                            if (head == 0) {
                                const int sb = 16 * j + 8 * kt + 2 * g4 + h;
                                atomicAdd(&IMP[tokl * 128 + sb], G);
                                if (sb + 1 < 128) atomicAdd(&IMP[tokl * 128 + sb + 1], L);
                            }
                        }
                }
                pv_finish(st + 8192, vf, s, o, lane);
            });
        } else {
        float m = -1e20f, lsum = 0.f;
        nsa_pipe<3>(src, ntile, smem, wv, lane, [&](int j, const char* st, auto&& issue) {
            f32x16 s[2];
            qk_tile(st, qf, s, lane);
            issue();
#pragma unroll
            for (int kt = 0; kt < 2; ++kt)
#pragma unroll
                for (int e = 0; e < 16; ++e) {
                    const int key = 64 * j + 32 * kt + 8 * (e >> 2) + 4 * h + (e & 3);
                    if (key >= nvr) s[kt][e] = NEGS;
                }
            const float mn = fmaxf(m, rowmax32(s)), alpha = ex2(m - mn);
            float rs = 0.f;
#pragma unroll
            for (int kt = 0; kt < 2; ++kt)
#pragma unroll
                for (int e = 0; e < 16; ++e) rs += ex2(s[kt][e] - mn);
            rs = xhalf_sum(rs);
            lsum = lsum * alpha + rs; m = mn;
        });
        const float invl_s = lsum > 0.f ? 1.f / lsum : 0.f;
        nsa_pipe<3>(src, ntile, smem, wv, lane, [&](int j, const char* st, auto&& issue) {
            f32x16 s[2];
            qk_tile(st, qf, s, lane);
            half8 vf[4];
            pv_load<0>(st + 8192, vf, lane);
            issue();
            __builtin_amdgcn_sched_barrier(0);
#pragma unroll
            for (int kt = 0; kt < 2; ++kt)
#pragma unroll
                for (int e = 0; e < 16; ++e) {
                    const int key = 64 * j + 32 * kt + 8 * (e >> 2) + 4 * h + (e & 3);
                    s[kt][e] = (key < nvr) ? ex2(s[kt][e] - m) * invl_s : 0.f;
                }
            if (cur >= 16) {
#pragma unroll
                for (int kt = 0; kt < 2; ++kt)
#pragma unroll
                    for (int g4 = 0; g4 < 4; ++g4) {
                        float G = (s[kt][4 * g4] + s[kt][4 * g4 + 1]) + (s[kt][4 * g4 + 2] + s[kt][4 * g4 + 3]);
                        float L = s[kt][4 * g4 + 3];
                        G += shx<1>(G); G += shx<2>(G);
                        L += shx<1>(L); L += shx<2>(L);
                        if (head == 0) {
                            const int sb = 16 * j + 8 * kt + 2 * g4 + h;
                            atomicAdd(&IMP[tokl * 128 + sb], G);
                            if (sb + 1 < 128) atomicAdd(&IMP[tokl * 128 + sb + 1], L);
                        }
                    }
            }
            pv_finish(st + 8192, vf, s, o, lane);
        });
            invl = 1.f;
        }
        oacc_add(o, gate(0) * invl, true);
    }
    __syncthreads();
    {
        const int tl = lane >> 3, sub = lane & 7;
        unsigned bits = 0;
        unsigned u[16];
        if (cur >= 16) {
            const float* ip = IMP + (w * 8 + tl) * 128 + sub * 16;
#pragma unroll
            for (int i = 0; i < 16; ++i) {
                const int s = sub * 16 + i;
                u[i] = (s >= 1 && s <= cur - 2) ? (__float_as_uint(ip[i]) + 1u) : 0u;
            }
        }
        __syncthreads();
        if (cur >= 16) {
            unsigned prefix = 0;
            for (int bit = 30; bit >= 0; --bit) {
                const unsigned cand = prefix | (1u << bit);
                int cnt = 0;
#pragma unroll
                for (int i = 0; i < 16; ++i) cnt += (u[i] >= cand) ? 1 : 0;
                cnt += shx_i<1>(cnt); cnt += shx_i<2>(cnt); cnt += shx_i<4>(cnt);
                if (cnt >= 13) prefix = cand;
            }
            int cgt = 0, ceq = 0;
#pragma unroll
            for (int i = 0; i < 16; ++i) { cgt += (u[i] > prefix) ? 1 : 0; ceq += (u[i] == prefix) ? 1 : 0; }
            cgt += shx_i<1>(cgt); cgt += shx_i<2>(cgt); cgt += shx_i<4>(cgt);
            int inc = ceq;
            { const int v = row_shr_i<1>(inc); if (sub >= 1) inc += v; }
            { const int v = row_shr_i<2>(inc); if (sub >= 2) inc += v; }
            { const int v = row_shr_i<4>(inc); if (sub >= 4) inc += v; }
            int run = inc - ceq;
            const int need = 13 - cgt;
#pragma unroll
            for (int i = 0; i < 16; ++i) {
                const int s = sub * 16 + i;
                bool sel = u[i] > prefix;
                if (u[i] == prefix) { sel = run < need; ++run; }
                if (s == 0 || s == cur || s == cur - 1) sel = true;
                bits |= (sel ? 1u : 0u) << i;
            }
        } else {
#pragma unroll
            for (int i = 0; i < 16; ++i) bits |= ((sub * 16 + i <= cur) ? 1u : 0u) << i;
        }
        unsigned wv = bits << ((sub & 1) * 16);
        wv |= (unsigned)shx_i<1>((int)wv);
        if ((sub & 1) == 0) SELM[(w * 8 + tl) * 4 + (sub >> 1)] = wv;
    }
    __syncthreads();
    const unsigned* selrow = SELM + tokl * 4;

    auto branch = [&](auto BRC) {
        constexpr int br = decltype(BRC)::value;
        const int j0 = (br == 0) ? 0 : (cur - 8 > 0 ? cur - 8 : 0);
        const int nst = cur - j0 + 1;
        KVSrc src{proj + ((size_t)b * SEQ + (size_t)j0 * 64) * D_IN + C_NKV + (br == 0 ? 256 : 512) + g * 64, D_IN, (size_t)64 * D_IN,
                  (const h16*)(P->ws + OFF_VTG) + (((size_t)br * 4 + bg) * 128 + j0) * 4096};
        float m = -1e20f, lsum = 0.f;
        f32x16 o[2];
#pragma unroll
        for (int e = 0; e < 16; ++e) { o[0][e] = 0.f; o[1][e] = 0.f; }
        if constexpr (FAST) {
            f32x16 s[2];
            NSA_WAITBAR(0);
            {
                const int k = nst < 3 ? nst : 3;
                for (int p = 0; p < k; ++p) nsa_dma(src, p, smem + p * 16384, w, lane);
            }
            NSA_WAITBAR(0);
            __builtin_amdgcn_s_sleep(2);
            NSA_BAR();
            qk_tile<true>(smem, qf, s, lane);
            const int r_ = lane & 31, swz_ = (r_ >> 1) & 7;
#pragma unroll 1
            for (int jj = 0; jj + 1 < nst; ++jj) {
                NSA_WAITBAR(0);
                const char* stv = smem + (jj & 3) * 16384 + 8192;
                const char* stk = smem + ((jj + 1) & 3) * 16384 + r_ * 128;
                const int j = j0 + jj;
                const bool rowok = (br != 0) || (((selrow[j >> 5] >> (j & 31)) & 1u) != 0u);
                const unsigned rmask = rowok ? 0xffffffffu : 0u;
                half8 kfa[4];
#pragma unroll
                for (int ks = 0; ks < 4; ++ks) kfa[ks] = *(const half8*)(stk + (((2 * ks + h) ^ swz_) << 4));
                half8 va[4];
                pv_load<0>(stv, va, lane);
                __builtin_amdgcn_sched_barrier(0);
                if (jj + 3 < nst) nsa_dma(src, jj + 3, smem + ((jj + 3) & 3) * 16384, w, lane);
                __builtin_amdgcn_sched_barrier(0);
                if (br == 1 && jj == 0 && cur >= 8) {
#pragma unroll
                    for (int kt = 0; kt < 2; ++kt)
#pragma unroll
                        for (int e = 0; e < 16; ++e) {
                            const int key = 64 * j + 32 * kt + 8 * (e >> 2) + 4 * h + (e & 3);
                            if (!(key > t - 512)) s[kt][e] = NEGS;
                        }
                }
#pragma unroll
                for (int e = 0; e < 16; ++e) s[0][e] = ex2(s[0][e]);
                half8 pa0 = pack8<0>(s[0]), pa1 = pack8<1>(s[0]);
                if (br == 0) {
                    pa0 = __builtin_bit_cast(half8, __builtin_bit_cast(u32x4_, pa0) & rmask);
                    pa1 = __builtin_bit_cast(half8, __builtin_bit_cast(u32x4_, pa1) & rmask);
                }
                lsum = psum8(pa1, psum8(pa0, lsum));
                __builtin_amdgcn_sched_barrier(0);
                f32x16 sn0, sn1;
#pragma unroll
                for (int e = 0; e < 16; ++e) { sn0[e] = 0.f; sn1[e] = 0.f; }
#pragma unroll
                for (int ks = 0; ks < 4; ++ks) sn0 = MFMA32(kfa[ks], qf[ks], sn0);
                o[0] = MFMA32(va[0], pa0, o[0]);
                o[0] = MFMA32(va[1], pa1, o[0]);
                o[1] = MFMA32(va[2], pa0, o[1]);
                o[1] = MFMA32(va[3], pa1, o[1]);
                half8 kfb[4];
#pragma unroll
                for (int ks = 0; ks < 4; ++ks) kfb[ks] = *(const half8*)(stk + 4096 + (((2 * ks + h) ^ swz_) << 4));
                half8 vb[4];
                pv_load<1>(stv, vb, lane);
#pragma unroll
                for (int e = 0; e < 16; ++e) s[1][e] = ex2(s[1][e]);
                half8 pb0 = pack8<0>(s[1]), pb1 = pack8<1>(s[1]);
                if (br == 0) {
                    pb0 = __builtin_bit_cast(half8, __builtin_bit_cast(u32x4_, pb0) & rmask);
                    pb1 = __builtin_bit_cast(half8, __builtin_bit_cast(u32x4_, pb1) & rmask);
                }
                lsum = psum8(pb1, psum8(pb0, lsum));
                __builtin_amdgcn_sched_barrier(0);
#pragma unroll
                for (int ks = 0; ks < 4; ++ks) sn1 = MFMA32(kfb[ks], qf[ks], sn1);
                o[0] = MFMA32(vb[0], pb0, o[0]);
                o[0] = MFMA32(vb[1], pb1, o[0]);
                o[1] = MFMA32(vb[2], pb0, o[1]);
                o[1] = MFMA32(vb[3], pb1, o[1]);
                s[0] = sn0; s[1] = sn1;
            }
            {
                const int jj = nst - 1, j = cur;
                const char* stv = smem + (jj & 3) * 16384 + 8192;
                const bool rowok = (br != 0) || (((selrow[j >> 5] >> (j & 31)) & 1u) != 0u);
                half8 va[4];
                pv_load<0>(stv, va, lane);
#pragma unroll
                for (int kt = 0; kt < 2; ++kt)
#pragma unroll
                    for (int e = 0; e < 16; ++e) {
                        const int key = 64 * j + 32 * kt + 8 * (e >> 2) + 4 * h + (e & 3);
                        const bool ok = (key <= t) && (br == 0 || key > t - 512);
                        if (!ok) s[kt][e] = NEGS;
                    }
                const float rs = sm_fast(s);
                lsum += rowok ? rs : 0.f;
                pv_finish<br == 0>(stv, va, s, o, lane, rowok ? 0xffffffffu : 0u);
            }
        } else {
        nsa_pipe<4>(src, nst, smem, wv, lane, [&](int jj, const char* st, auto&& issue) {
            const int j = j0 + jj;
            const bool rowok = (br != 0) || (((selrow[j >> 5] >> (j & 31)) & 1u) != 0u);
            f32x16 s[2];
            qk_tile<FAST>(st, qf, s, lane, issue);
            half8 vf[4];
            pv_load<0>(st + 8192, vf, lane);
            __builtin_amdgcn_sched_barrier(0);
            if (j == cur || (br == 1 && j == cur - 8)) {
#pragma unroll
                for (int kt = 0; kt < 2; ++kt)
#pragma unroll
                    for (int e = 0; e < 16; ++e) {
                        const int key = 64 * j + 32 * kt + 8 * (e >> 2) + 4 * h + (e & 3);
                        const bool ok = (key <= t) && (br == 0 || key > t - 512);
                        if (!ok) s[kt][e] = NEGS;
                    }
            }
            sm_online(s, m, lsum, o, rowok);
            pv_finish(st + 8192, vf, s, o, lane);
        });
        }
        if constexpr (FAST) lsum = xhalf_sum(lsum);
        const float sc = gate(br == 0 ? 1 : 2) / lsum;
        oacc_add(o, sc, false);
    };
    if constexpr (FAST) {
    const int kr = lane & 15, q4 = lane >> 4;
    half4 oa[2][4];
    {
        h16* scr = (h16*)(smem + w * 4096);
#pragma unroll
        for (int dt2 = 0; dt2 < 2; ++dt2)
#pragma unroll
            for (int hf = 0; hf < 2; ++hf) {
                const half8 v = oacc[dt2 * 2 + hf];
                const int d0 = 32 * dt2 + 16 * hf + 4 * h;
                *(half4*)(scr + r * 64 + d0) = (half4){v[0], v[1], v[2], v[3]};
                *(half4*)(scr + r * 64 + d0 + 8) = (half4){v[4], v[5], v[6], v[7]};
            }
#pragma unroll
        for (int u = 0; u < 2; ++u)
#pragma unroll
            for (int dt = 0; dt < 4; ++dt) oa[u][dt] = *(const half4*)(scr + (u * 16 + kr) * 64 + 16 * dt + 4 * q4);
    }
    half8 qf16[2][2];
#pragma unroll
    for (int u = 0; u < 2; ++u) {
        const h16* qp = proj + ((size_t)b * SEQ + t0 + w * 8 + u * 4 + (kr >> 2)) * D_IN + C_NQ + (g * 4 + (kr & 3)) * 64 + 8 * q4;
        qf16[u][0] = *(const half8*)qp; qf16[u][1] = *(const half8*)(qp + 32);
    }
    auto branch16 = [&](auto BRC) {
        constexpr int br = decltype(BRC)::value;
        const int j0 = (br == 0) ? 0 : (cur - 8 > 0 ? cur - 8 : 0);
        const int nst = cur - j0 + 1;
        KVSrc src{proj + ((size_t)b * SEQ + (size_t)j0 * 64) * D_IN + C_NKV + (br == 0 ? 256 : 512) + g * 64, D_IN, (size_t)64 * D_IN,
                  (const h16*)(P->ws + OFF_VTG) + (((size_t)br * 4 + bg) * 128 + j0) * 4096};
        f32x4 o[2][4];
        f32x4 lacc[2] = {(f32x4){0.f, 0.f, 0.f, 0.f}, (f32x4){0.f, 0.f, 0.f, 0.f}};
        const h16 one_ = (kr == 0) ? (h16)1.f : (h16)0.f;
        const half8 onesf = (half8){one_, one_, one_, one_, one_, one_, one_, one_};
#pragma unroll
        for (int u = 0; u < 2; ++u)
#pragma unroll
            for (int dt = 0; dt < 4; ++dt) o[u][dt] = (f32x4){0.f, 0.f, 0.f, 0.f};
        const int swz = (kr >> 1) & 7;
        nsa_pipe2(src, nst, smem, wv, lane, [&](int jj, const char* st, auto&& issue) {
            const int j = j0 + jj;
            bool rowok[2], act[2];
#pragma unroll
            for (int u = 0; u < 2; ++u) {
                rowok[u] = (br != 0) || (((SELM[(w * 8 + u * 4 + (kr >> 2)) * 4 + (j >> 5)] >> (j & 31)) & 1u) != 0u);
                act[u] = (br != 0) || __any(rowok[u]);
            }
            if (br == 0 && !(act[0] || act[1])) { issue(); return; }
            half8 kf[8];
#pragma unroll
            for (int kt = 0; kt < 4; ++kt)
#pragma unroll
                for (int ks = 0; ks < 2; ++ks) kf[kt * 2 + ks] = *(const half8*)(st + (16 * kt + kr) * 128 + (((4 * ks + q4) ^ swz) << 4));
            __builtin_amdgcn_sched_barrier(0);
            issue();
            __builtin_amdgcn_sched_barrier(0);
            half8 vf[8];
#pragma unroll
            for (int dt = 0; dt < 4; ++dt)
#pragma unroll
                for (int kp = 0; kp < 2; ++kp) vf[dt * 2 + kp] = *(const half8*)(st + 8192 + (16 * dt + kr) * 128 + (((4 * kp + q4) ^ swz) << 4));
            const bool diag = (j == cur) || (br == 1 && j == cur - 8);
#pragma unroll
            for (int u = 0; u < 2; ++u) {
                if (act[u]) {
                    f32x4 sv[4];
                    const float cm = (br == 0 && !rowok[u]) ? NEGS : 0.f;
                    const f32x4 cvec = (f32x4){cm, cm, cm, cm};
#pragma unroll
                    for (int kt = 0; kt < 4; ++kt) {
                        sv[kt] = MFMA16(kf[kt * 2], qf16[u][0], cvec);
                        sv[kt] = MFMA16(kf[kt * 2 + 1], qf16[u][1], sv[kt]);
                    }
                    if (diag) {
                        const int tu = t0 + w * 8 + u * 4 + (kr >> 2);
#pragma unroll
                        for (int kt = 0; kt < 4; ++kt)
#pragma unroll
                            for (int e = 0; e < 4; ++e) {
                                const int key = 64 * j + 16 * kt + 4 * q4 + e;
                                const bool ok = (key <= tu) && (br == 0 || key > tu - 512);
                                if (!ok) sv[kt][e] = NEGS;
                            }
                    }
#pragma unroll
                    for (int kt = 0; kt < 4; ++kt)
#pragma unroll
                        for (int e = 0; e < 4; ++e) sv[kt][e] = ex2(sv[kt][e]);
                    half8 pb[2];
#pragma unroll
                    for (int kp = 0; kp < 2; ++kp) {
                        pb[kp] = (half8){(h16)sv[2 * kp][0], (h16)sv[2 * kp][1], (h16)sv[2 * kp][2], (h16)sv[2 * kp][3],
                                         (h16)sv[2 * kp + 1][0], (h16)sv[2 * kp + 1][1], (h16)sv[2 * kp + 1][2], (h16)sv[2 * kp + 1][3]};
                    }
                    lacc[u] = MFMA16(onesf, pb[0], lacc[u]);
                    lacc[u] = MFMA16(onesf, pb[1], lacc[u]);
#pragma unroll
                    for (int kp = 0; kp < 2; ++kp)
#pragma unroll
                        for (int dt = 0; dt < 4; ++dt) o[u][dt] = MFMA16(vf[dt * 2 + kp], pb[kp], o[u][dt]);
                }
            }
        });
#pragma unroll
        for (int u = 0; u < 2; ++u) {
            float lt = lacc[u][0];
            lt += shx<16>(lt); lt = xhalf_sum(lt);
            const int tid_ = otid(wv), kr_ = tid_ & 15;
            const size_t tokg_ = (size_t)b * SEQ + t0 + (tid_ >> 6) * 8 + u * 4 + (kr_ >> 2);
            const int gh_ = g * 4 + (kr_ & 3), bi = (br == 0 ? 1 : 2);
            const float gt = sigmoidf_((float)proj[tokg_ * D_IN + C_NGL + gh_ * 3 + bi] + P->in[I_NGB][l * 24 + gh_ * 3 + bi]);
            const float sc = gt / lt;
#pragma unroll
            for (int dt = 0; dt < 4; ++dt) {
                half4 a = oa[u][dt];
#pragma unroll
                for (int e = 0; e < 4; ++e) a[e] = (h16)((float)a[e] + o[u][dt][e] * sc);
                oa[u][dt] = a;
            }
        }
    };
    branch16(IC<0>{});
    branch16(IC<1>{});
#pragma unroll
    for (int u = 0; u < 2; ++u) {
        const int tid_ = otid(wv), kr_ = tid_ & 15, q_ = (tid_ >> 4) & 3;
        const size_t tokg_ = (size_t)b * SEQ + t0 + (tid_ >> 6) * 8 + u * 4 + (kr_ >> 2);
        const int gh_ = g * 4 + (kr_ & 3);
        h16* mixp = (h16*)(P->ws + OFF_MIX) + kb_idx(NT, tokg_, 512 + gh_ * 64);
        const h16* ngp = proj + tokg_ * D_IN + C_NG + gh_ * 64;
#pragma unroll
        for (int dt = 0; dt < 4; ++dt) {
            const int d0 = 16 * dt + 4 * q_;
            const half4 ng = *(const half4*)(ngp + d0);
            half4 ov;
#pragma unroll
            for (int e = 0; e < 4; ++e) ov[e] = (h16)((float)oa[u][dt][e] * siluf_((float)ng[e]));
            *(half4*)(mixp + d0) = ov;
        }
    }
    } else {
    branch(IC<0>{});
    branch(IC<1>{});
    {
        const int tid_ = otid(wv), r_ = tid_ & 31, h_ = (tid_ >> 5) & 1, tokl_ = (tid_ >> 6) * 8 + (r_ >> 2), gh_ = g * 4 + (r_ & 3);
        const size_t tokg_ = (size_t)b * SEQ + t0 + tokl_;
        h16* mixp = (h16*)(P->ws + OFF_MIX) + kb_idx(NT, tokg_, 512 + gh_ * 64);
        const h16* ngp = proj + tokg_ * D_IN + C_NG + gh_ * 64;
#pragma unroll
        for (int dt = 0; dt < 2; ++dt)
#pragma unroll
            for (int g4 = 0; g4 < 4; ++g4) {
                const int d0 = 32 * dt + 8 * g4 + 4 * h_;
                const half4 ng = *(const half4*)(ngp + d0);
                half4 ov;
#pragma unroll
                for (int e = 0; e < 4; ++e) ov[e] = (h16)((float)oacc[dt * 2 + (g4 >> 1)][(g4 & 1) * 4 + e] * siluf_((float)ng[e]));
                *(half4*)(mixp + d0) = ov;
            }
    }
    }
    __syncthreads();
}

DI void gla_kv_item(PP P, int l, int item, char* smem, const int wv) {
    P = plaunder(P);
    const int tid = otid(wv), lane = tid & 63, w = tid >> 6, r = lane & 31, hh = lane >> 5;
    const int pair = item * 4 + w, h = pair & 3, cn = pair >> 2;
    const size_t tok = (size_t)cn * 32 + r;
    const int b = cn >> 8, n = cn & 255, bh = b * 4 + h;
    const h16* proj = (const h16*)(P->ws + OFF_PROJ);
    h16* VT = (h16*)(smem + w * 16384);
    h16* KT = VT + 2048;
    __syncthreads();
    float* w2s = (float*)(smem + 65536);
    {
        const float4* wsrc = (const float4*)(P->in[I_GW2] + (size_t)l * 16 * 128);
        ((float4*)w2s)[tid] = wsrc[tid]; ((float4*)w2s)[tid + 256] = wsrc[tid + 256];
    }
    {
        const half8* vp = (const half8*)(proj + tok * D_IN + C_GV + h * 64 + hh * 32);
#pragma unroll
        for (int q = 0; q < 4; ++q) {
            const half8 v8 = vp[q];
#pragma unroll
            for (int e = 0; e < 8; ++e) VT[(hh * 32 + q * 8 + e) * 32 + r] = v8[e];
        }
    }
    float gl[16];
    {
        const half8* lp = (const half8*)(proj + tok * D_IN + C_GLR);
        const half8 l0 = lp[0], l1 = lp[1];
        float lr[16];
#pragma unroll
        for (int q = 0; q < 8; ++q) { lr[q] = (float)l0[q]; lr[8 + q] = (float)l1[q]; }
        const float* w2 = w2s + h * 32 + 16 * hh;
        const float* b2 = P->in[I_GB2] + l * 128 + h * 32 + 16 * hh;
#pragma unroll
        for (int d = 0; d < 16; ++d) gl[d] = b2[d];
        __syncthreads();
#pragma unroll
        for (int q = 0; q < 16; ++q)
#pragma unroll
            for (int d4 = 0; d4 < 4; ++d4) {
                const float4 wq = *(const float4*)(w2 + q * 128 + d4 * 4);
                gl[d4 * 4 + 0] += lr[q] * wq.x; gl[d4 * 4 + 1] += lr[q] * wq.y; gl[d4 * 4 + 2] += lr[q] * wq.z; gl[d4 * 4 + 3] += lr[q] * wq.w;
            }
#pragma unroll
        for (int d = 0; d < 16; ++d) gl[d] = log_sigmoidf_(gl[d]) * (1.f / 16.f);
    }
#pragma unroll
    for (int off = 1; off < 32; off <<= 1) {
        const int src = olane() - off;
#pragma unroll
        for (int d = 0; d < 16; ++d) { const float v = bperm(gl[d], src); if (r >= off) gl[d] += v; }
    }
    {
        float* bc = (float*)(P->ws + OFF_BCUM) + tok * 128 + h * 32 + 16 * hh;
#pragma unroll
        for (int d4 = 0; d4 < 4; ++d4) *(float4*)(bc + d4 * 4) = (float4){gl[d4 * 4], gl[d4 * 4 + 1], gl[d4 * 4 + 2], gl[d4 * 4 + 3]};
    }
    {
        const half8* kp = (const half8*)(proj + tok * D_IN + C_GK + h * 32 + 16 * hh);
        const half8 k0 = kp[0], k1 = kp[1];
        float bl[16];
#pragma unroll
        for (int d = 0; d < 16; ++d) bl[d] = bperm(gl[d], olane() | 31);
#pragma unroll
        for (int d = 0; d < 16; ++d) {
            const float kd = (float)(d < 8 ? k0[d & 7] : k1[d & 7]) * __expf(bl[d] - gl[d]);
            KT[(16 * hh + d) * 32 + r] = (h16)kd;
        }
        if (r == 0) {
            float* dc = (float*)(P->ws + OFF_GDEC) + (size_t)(bh * 256 + n) * 32 + 16 * hh;
#pragma unroll
            for (int d4 = 0; d4 < 4; ++d4) *(float4*)(dc + d4 * 4) = (float4){__expf(bl[d4 * 4]), __expf(bl[d4 * 4 + 1]), __expf(bl[d4 * 4 + 2]), __expf(bl[d4 * 4 + 3])};
        }
    }
    asm volatile("s_waitcnt lgkmcnt(0)" ::: "memory");
    const half8 kb0 = *(const half8*)(KT + r * 32 + 8 * hh), kb1 = *(const half8*)(KT + r * 32 + 16 + 8 * hh);
    float* kvp = (float*)(P->ws + OFF_GKV) + ((size_t)(bh * 256 + n) * 32 + r) * 64;
#pragma unroll
    for (int dt = 0; dt < 2; ++dt) {
        f32x16 o;
#pragma unroll
        for (int e = 0; e < 16; ++e) o[e] = 0.f;
        const h16* vrow = VT + (32 * dt + r) * 32 + 8 * hh;
        o = MFMA32(*(const half8*)vrow, kb0, o);
        o = MFMA32(*(const half8*)(vrow + 16), kb1, o);
#pragma unroll
        for (int g4 = 0; g4 < 4; ++g4)
            *(float4*)(kvp + 32 * dt + 8 * g4 + 4 * hh) = (float4){o[4 * g4], o[4 * g4 + 1], o[4 * g4 + 2], o[4 * g4 + 3]};
    }
    __syncthreads();
}

DI void gla_out_item(PP P, int l, int item, char* smem, const int wv) {
    P = plaunder(P);
    const int tid = otid(wv), lane = tid & 63, w = tid >> 6, r = lane & 31, hh = lane >> 5;
    const int pair = item * 4 + w, h = pair & 3, cn = pair >> 2;
    const size_t tok0 = (size_t)cn * 32, tok = tok0 + r;
    const int b = cn >> 8, n = cn & 255, bh = b * 4 + h;
    const h16* proj = (const h16*)(P->ws + OFF_PROJ);
    h16* VT = (h16*)(smem + w * 16384);
    h16* SPT = VT + 2048;
    __syncthreads();
    {
        const half8* vp = (const half8*)(proj + tok * D_IN + C_GV + h * 64 + hh * 32);
        const float4* sp = (const float4*)((const float*)(P->ws + OFF_GKV) + ((size_t)(bh * 256 + n) * 32 + r) * 64 + hh * 32);
#pragma unroll
        for (int q = 0; q < 4; ++q) {
            const half8 v8 = vp[q];
            const float4 s0 = sp[2 * q], s1 = sp[2 * q + 1];
#pragma unroll
            for (int e = 0; e < 8; ++e) VT[(hh * 32 + q * 8 + e) * 32 + r] = v8[e];
            SPT[(hh * 32 + q * 8 + 0) * 32 + r] = (h16)s0.x; SPT[(hh * 32 + q * 8 + 1) * 32 + r] = (h16)s0.y;
            SPT[(hh * 32 + q * 8 + 2) * 32 + r] = (h16)s0.z; SPT[(hh * 32 + q * 8 + 3) * 32 + r] = (h16)s0.w;
            SPT[(hh * 32 + q * 8 + 4) * 32 + r] = (h16)s1.x; SPT[(hh * 32 + q * 8 + 5) * 32 + r] = (h16)s1.y;
            SPT[(hh * 32 + q * 8 + 6) * 32 + r] = (h16)s1.z; SPT[(hh * 32 + q * 8 + 7) * 32 + r] = (h16)s1.w;
        }
    }
    half8 qe[2], ke[2];
#pragma unroll
    for (int ks = 0; ks < 2; ++ks) {
        const int d0 = 16 * ks + 8 * hh;
        const half8 q8 = *(const half8*)(proj + tok * D_IN + C_GQ + h * 32 + d0);
        const half8 k8 = *(const half8*)(proj + tok * D_IN + C_GK + h * 32 + d0);
        const float4 b0 = *(const float4*)((const float*)(P->ws + OFF_BCUM) + tok * 128 + h * 32 + d0);
        const float4 b1 = *(const float4*)((const float*)(P->ws + OFF_BCUM) + tok * 128 + h * 32 + d0 + 4);
        const float bc[8] = {b0.x, b0.y, b0.z, b0.w, b1.x, b1.y, b1.z, b1.w};
#pragma unroll
        for (int e = 0; e < 8; ++e) {
            const float ex = __expf(bc[e]);
            qe[ks][e] = (h16)((float)q8[e] * 0.17677669529663687f * ex);
            ke[ks][e] = (h16)((float)k8[e] * __builtin_amdgcn_rcpf(ex));
        }
    }
    f32x16 s;
#pragma unroll
    for (int e = 0; e < 16; ++e) s[e] = 0.f;
    s = MFMA32(ke[0], qe[0], s);
    s = MFMA32(ke[1], qe[1], s);
#pragma unroll
    for (int e = 0; e < 16; ++e) { const int j = (e & 3) + 8 * (e >> 2) + 4 * hh; if (j > r) s[e] = 0.f; }
    const half8 pb0 = pack8<0>(s), pb1 = pack8<1>(s);
    asm volatile("s_waitcnt lgkmcnt(0)" ::: "memory");
    f32x16 o[2];
#pragma unroll
    for (int dt = 0; dt < 2; ++dt) {
#pragma unroll
        for (int e = 0; e < 16; ++e) o[dt][e] = 0.f;
        const h16* vrow = VT + (32 * dt + r) * 32 + 4 * hh;
        const h16* srow = SPT + (32 * dt + r) * 32 + 8 * hh;
        {
            const half4 lo = *(const half4*)vrow, hi = *(const half4*)(vrow + 8);
            o[dt] = MFMA32(((half8){lo[0], lo[1], lo[2], lo[3], hi[0], hi[1], hi[2], hi[3]}), pb0, o[dt]);
        }
        {
            const half4 lo = *(const half4*)(vrow + 16), hi = *(const half4*)(vrow + 24);
            o[dt] = MFMA32(((half8){lo[0], lo[1], lo[2], lo[3], hi[0], hi[1], hi[2], hi[3]}), pb1, o[dt]);
        }
        o[dt] = MFMA32(*(const half8*)srow, qe[0], o[dt]);
        o[dt] = MFMA32(*(const half8*)(srow + 16), qe[1], o[dt]);
    }
    float ss = 0.f;
#pragma unroll
    for (int e = 0; e < 16; ++e) ss += o[0][e] * o[0][e] + o[1][e] * o[1][e];
    ss = xhalf_sum(ss);
    const float rn = rsqrtf(ss * (1.f / 64.f) + 1e-6f);
    h16* mix = (h16*)(P->ws + OFF_MIX);
#pragma unroll
    for (int dt = 0; dt < 2; ++dt)
#pragma unroll
        for (int g4 = 0; g4 < 4; ++g4) {
            const int e0 = 32 * dt + 8 * g4 + 4 * hh;
            const half4 gt = *(const half4*)(proj + tok * D_IN + C_GG + h * 64 + e0);
            const float4 on = *(const float4*)(P->in[I_GON] + l * 64 + e0);
            half4 ov;
            ov[0] = (h16)(o[dt][4 * g4 + 0] * rn * on.x * siluf_((float)gt[0]));
            ov[1] = (h16)(o[dt][4 * g4 + 1] * rn * on.y * siluf_((float)gt[1]));
            ov[2] = (h16)(o[dt][4 * g4 + 2] * rn * on.z * siluf_((float)gt[2]));
            ov[3] = (h16)(o[dt][4 * g4 + 3] * rn * on.w * siluf_((float)gt[3]));
            *(half4*)(mix + kb_idx(NT, tok, h * 64 + e0)) = ov;
        }
    __syncthreads();
}

DI void glu_tile(PP P, int l, int tile, char* smem, const int wv) {
    P = plaunder(P);
    const int mt = tile >> 2, nt = tile & 3;
    f32x4 acc[4][4];
    float ssd[4];
    gemm_mainloop_glds<false>(wv, 256, APlain{(const h16*)(P->ws + OFF_YACT) + (size_t)mt * 128 * 256, 256, 64},
                              (const h16*)(P->ws + OFF_WTGLU) + ((size_t)l * 512 + nt * 128) * 256, 256, acc, ssd, smem);
    const int tid = otid(wv), lane = tid & 63, wid = tid >> 6, wr = wid >> 1, wc = wid & 1;
    const h16* proj = (const h16*)(P->ws + OFF_PROJ);
    h16* mix = (h16*)(P->ws + OFF_MIX);
    const float* gb = P->in[I_GLUB] + l * 512;
#pragma unroll
    for (int i = 0; i < 4; ++i) {
        const size_t tok = (size_t)mt * 128 + wr * 64 + i * 16 + (lane & 15);
        {
            const int c = nt * 64 + wc * 32 + (lane >> 4) * 8;
            const half8 g8 = *(const half8*)(proj + tok * D_IN + C_SG + c);
            half8 o;
#pragma unroll
            for (int hq = 0; hq < 2; ++hq) {
                const f32x4 z1 = acc[i][2 * hq], z2 = acc[i][2 * hq + 1];
                const float4 b1 = *(const float4*)(gb + c + 4 * hq), b2 = *(const float4*)(gb + 256 + c + 4 * hq);
                o[4 * hq + 0] = (h16)((z1[0] + b1.x) * sigmoidf_(z2[0] + b2.x) * siluf_((float)g8[4 * hq + 0]));
                o[4 * hq + 1] = (h16)((z1[1] + b1.y) * sigmoidf_(z2[1] + b2.y) * siluf_((float)g8[4 * hq + 1]));
                o[4 * hq + 2] = (h16)((z1[2] + b1.z) * sigmoidf_(z2[2] + b2.z) * siluf_((float)g8[4 * hq + 2]));
                o[4 * hq + 3] = (h16)((z1[3] + b1.w) * sigmoidf_(z2[3] + b2.w) * siluf_((float)g8[4 * hq + 3]));
            }
            *(half8*)(mix + kb_idx(NT, tok, 256 + c)) = o;
        }
    }
}

DI void outproj_tile(PP P, int l, int mt, int nt, char* smem, const int wv) {
    P = plaunder(P);
    f32x4 acc[8][4];
    float ssd[8];
    gemm_glds<false, 2, 8, 4, 3, true>(wv, 1024, APlain{(const h16*)(P->ws + OFF_MIX) + (size_t)mt * 256 * 64, 64, (size_t)NT * 64},
                              (const h16*)(P->ws + OFF_WTOUT) + ((size_t)l * 16 * 1024 + nt * 128) * 64, 64, acc, ssd, smem, (size_t)1024 * 64);
    const int tid = otid(wv), lane = tid & 63, wid = tid >> 6, wr = wid >> 1, wc = wid & 1;
    h16* xh = XH_BASE(P);
#pragma unroll
    for (int i = 0; i < 8; ++i) {
        const size_t row = (size_t)mt * 256 + wr * 128 + i * 16 + (lane & 15);
#pragma unroll
        for (int jp = 0; jp < 2; ++jp) {
            const int n = nt * 128 + wc * 64 + jp * 32 + (lane >> 4) * 8;
            const f32x4 v0 = acc[i][2 * jp], v1 = acc[i][2 * jp + 1];
            h16* xp = xh + kb_idx(NT, row, n);
            const half8 xr = *(const half8*)xp;
            const float4 xa = (float4){(float)xr[0] + v0[0], (float)xr[1] + v0[1], (float)xr[2] + v0[2], (float)xr[3] + v0[3]};
            const float4 xb = (float4){(float)xr[4] + v1[0], (float)xr[5] + v1[1], (float)xr[6] + v1[2], (float)xr[7] + v1[3]};
            if (l != DEPTH - 1) *(half8*)xp = (half8){(h16)xa.x, (h16)xa.y, (h16)xa.z, (h16)xa.w, (h16)xb.x, (h16)xb.y, (h16)xb.z, (h16)xb.w};
            else {
                float* op = (row < (size_t)(NT / 2) ? P->out + row * 1024 : (float*)(P->ws + OFF_PROJ) + (row - NT / 2) * 1024) + n;
                *(float4*)op = xa; *(float4*)(op + 4) = xb;
            }
        }
    }
}

#define XB_TMO      128
#define XB_XCNT(j)  (256  + 64 * (j))
#define XB_XSUB(j)  (1280 + 64 * (j))
#define XB_XGEN(j)  (2304 + 64 * (j))
#define XB_TOP      3328
#define XB_TOPGEN   3392
#define XCD_BAR_WORDS 3456
#define XB_SPIN_CAP (1u << 18)
#define LAS __attribute__((address_space(3)))

__device__ __forceinline__ unsigned xb_ld(unsigned* p)              { return __hip_atomic_load(p, __ATOMIC_RELAXED, __HIP_MEMORY_SCOPE_AGENT); }
__device__ __forceinline__ unsigned xb_add(unsigned* p, unsigned v) { return __hip_atomic_fetch_add(p, v, __ATOMIC_RELAXED, __HIP_MEMORY_SCOPE_AGENT); }
__device__ __forceinline__ unsigned xb_xcc_id() { return (unsigned)__builtin_amdgcn_s_getreg((3 << 11) | 20) & 0xFu; }
#define XB_SPIN(cond, bar) do { unsigned _sp = 0; while (cond) { __builtin_amdgcn_s_sleep(1); \
    if ((++_sp & 255u) == 0u) { if (xb_ld(&(bar)[XB_TMO])) break; if (_sp > XB_SPIN_CAP) { atomicAdd(&(bar)[XB_TMO], 1u); break; } } } } while (0)

struct XcdBarrier {
    unsigned* bar; unsigned x;
    volatile LAS unsigned* st;
};

__device__ __forceinline__ XcdBarrier xcd_barrier_post(unsigned* bar, volatile LAS unsigned* st) {
    XcdBarrier b; b.bar = bar; b.x = xb_xcc_id(); b.st = st;
    if (threadIdx.x == 0) (void)xb_add(&bar[XB_XCNT(b.x)], 1u);
    return b;
}
__device__ __forceinline__ void xcd_barrier_complete(unsigned* bar, unsigned x, unsigned& nloc, unsigned& nx) {
    const unsigned G = gridDim.x * gridDim.y * gridDim.z;
    unsigned sum, cnt, mine, sp = 0u;
    for (;;) {
        sum = 0u; cnt = 0u; mine = 0u;
#pragma unroll
        for (unsigned j = 0; j < 16; ++j) { const unsigned c = xb_ld(&bar[XB_XCNT(j)]); sum += c; cnt += (c > 0u) ? 1u : 0u; mine = (j == x) ? c : mine; }
        if (sum == G) break;
        __builtin_amdgcn_s_sleep(1);
        if ((++sp & 255u) == 0u) { if (xb_ld(&bar[XB_TMO])) break; if (sp > XB_SPIN_CAP) { atomicAdd(&bar[XB_TMO], 1u); break; } }
    }
    nloc = mine > 0u ? mine : 1u; nx = cnt > 0u ? cnt : 1u;
}

__device__ __forceinline__ void xcd_barrier(const XcdBarrier& b) {
    asm volatile("s_waitcnt vmcnt(0)" ::: "memory");
    __syncthreads();
    if (threadIdx.x == 0) {
        unsigned* bar = b.bar;
        __builtin_amdgcn_s_waitcnt(0);
        unsigned nloc = b.st[0], nx = b.st[1];
        if (nloc == 0u) { xcd_barrier_complete(bar, b.x, nloc, nx); b.st[0] = nloc; b.st[1] = nx; }
        const unsigned old = xb_add(&bar[XB_XSUB(b.x)], 1u);
        const unsigned gen = old / nloc;
        if (old + 1u == (gen + 1u) * nloc) {
            __builtin_amdgcn_fence(__ATOMIC_RELEASE, "agent");
            asm volatile("s_waitcnt vmcnt(0)" ::: "memory");
            const unsigned og = xb_add(&bar[XB_TOP], 1u);
            const unsigned tg = og / nx;
            if (og + 1u == (tg + 1u) * nx) xb_add(&bar[XB_TOPGEN], 1u);
            else XB_SPIN(xb_ld(&bar[XB_TOPGEN]) == tg, bar);
            __builtin_amdgcn_fence(__ATOMIC_ACQUIRE, "agent");
            xb_add(&bar[XB_XGEN(b.x)], 1u);
            asm volatile("s_waitcnt vmcnt(0)" ::: "memory");
        } else {
            XB_SPIN(xb_ld(&bar[XB_XGEN(b.x)]) == gen, bar);
            __builtin_amdgcn_fence(__ATOMIC_ACQUIRE, "agent");
            asm volatile("s_waitcnt vmcnt(0)" ::: "memory");
        }
    }
    __syncthreads();
}


__device__ __forceinline__ void xcc_barrier_local(const XcdBarrier& b) {
    asm volatile("s_waitcnt vmcnt(0)" ::: "memory");
    __syncthreads();
    if (threadIdx.x == 0) {
        unsigned* bar = b.bar;
        __builtin_amdgcn_s_waitcnt(0);
        const unsigned nloc = b.st[0];
        const unsigned old = xb_add(&bar[8u * b.x], 1u);
        const unsigned gen = old / nloc;
        if (old + 1u == (gen + 1u) * nloc) xb_add(&bar[64u + 8u * b.x], 1u);
        else XB_SPIN(xb_ld(&bar[64u + 8u * b.x]) == gen, bar);
        __builtin_amdgcn_fence(__ATOMIC_ACQUIRE, "agent");
        asm volatile("s_waitcnt vmcnt(0)" ::: "memory");
    }
    __syncthreads();
}

__device__ __forceinline__ int p3_next(int bid, int w) {
    if (w != bid) return 704;
    if (bid >= 128 && bid < 192) return 640 + bid - 128;
    if (bid >= 192 && bid < 320) return 128 + bid + 192;
    return 704;
}

__global__ void __launch_bounds__(NTHREADS, 2) fwd_megakernel(Params Pval) {
    PP P = (PP)__builtin_amdgcn_kernarg_segment_ptr();
    extern __shared__ __attribute__((aligned(16))) char smem[];
    cg::grid_group grid = cg::this_grid();
    const int G = gridDim.x, bid = blockIdx.x;
    const int wv = __builtin_amdgcn_readfirstlane((int)(threadIdx.x >> 6));

    uint4& xb_words = *(uint4*)(smem + SMEM_MAIN);
    if (otid(wv) == 0) xb_words = make_uint4(0u, 0u, 0u, 0u);
    __syncthreads();
    if (P->ws == nullptr) grid.sync();
    const XcdBarrier xb = xcd_barrier_post((unsigned*)(P->ws + OFF_BAR), (volatile LAS unsigned*)(smem + SMEM_MAIN));
    int vxcd = bid & 7, vjx = bid >> 3, xloc_i = 0;
    {
        unsigned* xcnt = (unsigned*)(P->ws + OFF_BAR) + XCD_BAR_WORDS;
        volatile LAS unsigned* lw = (volatile LAS unsigned*)(smem + SMEM_MAIN) + 2;
        if (otid(wv) == 0) lw[0] = xb.x < 8u ? xb_add(&xcnt[xb.x], 1u) : 0xffffu;
        phase0(P, smem, wv);
        xcd_barrier(xb);
        if (otid(wv) == 0) {
            bool ok = (G & 7) == 0 && xb.x < 8u;
            for (int j = 0; j < 8; ++j) ok = ok && (xb_ld(&xcnt[j]) == (unsigned)(G >> 3));
            lw[1] = ok ? 1u : 0u;
        }
        __syncthreads();
        if (lw[1]) { vxcd = (int)xb.x; vjx = (int)lw[0]; }
        xloc_i = (lw[1] != 0u && G == 512) ? 1 : 0;
    }
    vxcd = __builtin_amdgcn_readfirstlane(vxcd); vjx = __builtin_amdgcn_readfirstlane(vjx);
    const bool xloc = __builtin_amdgcn_readfirstlane(xloc_i) != 0;

#pragma unroll 1
    for (int l = 0; l < DEPTH; ++l) {
        {
            const int xcd = vxcd, jx = vjx, nper = G >> 3;
            for (int u = jx; u < 192; u += nper) inproj_tile<2, 8>(P, l, (xcd * 8 + (u & 7)) * 256, (u >> 3) * 128, smem, wv);
            for (int it = jx; it < 16 + 40; it += nper) {
                if (it < 16) inproj_tile<4, 2>(P, l, (xcd * 16 + it) * 128, 3072, smem, wv);
                else s5_build_item(P, l, (it - 16) * 8 + xcd, smem, wv);
            }
        }
        xcd_barrier(xb);
        if (G == 512) {
            if (bid < 192) {
                if (bid < 128) cmp_gemm_tile(P, l, bid, smem, wv); else s5e_gemm_tile(P, l, bid - 128, smem, wv);
                gla_kv_item(P, l, bid + 320, smem, wv);
            } else {
                gla_kv_item(P, l, bid - 192, smem, wv);
#pragma unroll 1
                for (int u = bid - 192; u < 512; u += 320) usp_item(P, u, wv);
            }
        } else {
#pragma unroll 1
        for (int w = bid; w < 128 + 64 + 512 + 512; w += G) {
            if (w < 128) cmp_gemm_tile(P, l, w, smem, wv);
            else if (w < 192) s5e_gemm_tile(P, l, w - 128, smem, wv);
            else if (w < 704) gla_kv_item(P, l, w - 192, smem, wv);
            else usp_item(P, w - 704, wv);
        }
        }
        xcd_barrier(xb);
#pragma unroll 1
        for (int w = bid; w < 128 + 512 + 64; w = (G != 512) ? w + G : (w >= 128 + 512 + 64 - 0 ? 704 : p3_next(bid, w))) {
            if (w < 128) cmp_l2_item(P, l, w, smem, wv);
            else if (w < 640) gla_scan_item(P, w - 128, smem, wv);
            else s5_scan_item(P, w - 640, smem, wv);
        }
        xcd_barrier(xb);
        bool nsa_fast;
        nsa_fast = NSA_FAST_FLAG(P, l, otid(wv) & 63);
#pragma unroll 1
        for (int w0 = bid; w0 < 512 + 512 + 512; w0 += G) {
            const int w = w0 < G ? vjx * 8 + vxcd : w0;
            if (w < 512) {
                const int bg = w & 3, q = w >> 2;
                if (nsa_fast) { nsa_unit<true>(P, l, bg, 255 - q, smem, wv); nsa_unit<true>(P, l, bg, q, smem, wv); }
                else { nsa_unit<false>(P, l, bg, 255 - q, smem, wv); nsa_unit<false>(P, l, bg, q, smem, wv); }
            } else if (w < 512 + 512) s5o_gemm_tile(P, l, w - 512, smem, wv);
            else gla_out_item(P, l, w - 1024, smem, wv);
        }
        xcd_barrier(xb);
        if (xloc) {
            glu_tile(P, l, (vxcd * 16 + (vjx >> 2)) * 4 + (vjx & 3), smem, wv);
            xcc_barrier_local(xb);
        } else {
#pragma unroll 1
            for (int w = bid; w < 512; w += G) glu_tile(P, l, w, smem, wv);
            xcd_barrier(xb);
        }
        {
            const int xcd = vxcd, jx = vjx, nper = G >> 3;
            for (int u = jx; u < 64; u += nper) outproj_tile(P, l, xcd * 8 + (u & 7), u >> 3, smem, wv);
        }
        if (xloc && l + 1 < DEPTH) xcc_barrier_local(xb);
        else xcd_barrier(xb);
    }
    {
        const PP Q = plaunder(P);
        const float4* src = (const float4*)(Q->ws + OFF_PROJ);
        float4* dst = (float4*)(Q->out + (size_t)(NT / 2) * 1024);
        for (size_t i = (size_t)bid * NTHREADS + otid(wv); i < (size_t)(NT / 2) * 256; i += (size_t)G * NTHREADS) dst[i] = src[i];
    }
}

extern "C" void kernel_launch(void* const* d_in, const int* in_sizes, int n_in, void* d_out, int out_size, void* d_ws,
                              size_t ws_size, hipStream_t stream) {
    static int grid_blocks = 0;
    if (!grid_blocks) {
        int dev = 0, cus = 0, per_cu = 0;
        hipGetDevice(&dev);
        hipDeviceGetAttribute(&cus, hipDeviceAttributeMultiprocessorCount, dev);
        hipFuncSetAttribute((const void*)fwd_megakernel, hipFuncAttributeMaxDynamicSharedMemorySize, SMEM_BYTES);
        hipOccupancyMaxActiveBlocksPerMultiprocessor(&per_cu, fwd_megakernel, NTHREADS, SMEM_BYTES);
        if (per_cu < 1) per_cu = 1;
        if (per_cu > 2) per_cu = 2;
        grid_blocks = cus * per_cu;
        if (ws_size < WS_END) fprintf(stderr, "kernel_launch: workspace too small: %zu < %zu\n", ws_size, (size_t)WS_END);
    }
    Params p{};
    for (int i = 0; i < 25; ++i) p.in[i] = (const float*)d_in[i];
    p.out = (float*)d_out;
    p.ws = (char*)d_ws;
    void* args[] = {&p};
    (void)hipMemsetAsync((char*)d_ws + OFF_BAR, 0, (XCD_BAR_WORDS + 16) * sizeof(unsigned), stream);
    hipError_t e = hipLaunchCooperativeKernel((const void*)fwd_megakernel, dim3(grid_blocks), dim3(NTHREADS), args, SMEM_BYTES, stream);
    if (e != hipSuccess) fprintf(stderr, "cooperative launch failed: %s (grid %d)\n", hipGetErrorString(e), grid_blocks);
}
```
